# Optimizing an MI355X kernel written in HIP

```python
import numpy as np
import jax
import jax.numpy as jnp
from jax import lax

D_MODEL = 1024
BATCH = 8
SEQ = 4096
DEPTH = 1

HEAD_DIM = 64
ATTN_HEADS = 6
A_WIDTH = ATTN_HEADS * HEAD_DIM
KV_RANK = 128
IDX_HEADS = 4
IDX_DIM = 64
INDEX_TOPK = 256
Q_BLOCK = 128
GDN_HEADS = 6
GDN_WIDTH = GDN_HEADS * HEAD_DIM
GDN_CONV_CH = 3 * GDN_WIDTH
CONV_WIDTH = 4
CHUNK = 64
MEM_HEADS = 4
MEM_WIDTH = MEM_HEADS * HEAD_DIM
N_MEM = 256
MIX_WIDTH = A_WIDTH + GDN_WIDTH + MEM_WIDTH
SPLIT_SIZES = (A_WIDTH, KV_RANK, IDX_HEADS * IDX_DIM, IDX_DIM, IDX_HEADS,
               GDN_WIDTH, GDN_WIDTH, GDN_WIDTH, GDN_WIDTH, GDN_HEADS, GDN_HEADS,
               MEM_WIDTH)
IN_WIDTH = sum(SPLIT_SIZES)
ROPE_THETA = 10000.0
N_GROUPS = 8
EXPERTS_PER_GROUP = 8
N_EXPERTS = N_GROUPS * EXPERTS_PER_GROUP
TOP_K = 2
D_EXPERT = 256
MOE_BLOCK = 128
DEEPNORM_ALPHA = (2 * DEPTH) ** 0.25
DEEPNORM_BETA = (8 * DEPTH) ** -0.25
LN_EPS = 1e-5
RMS_EPS = 1e-6
NEG_INF = -1e30
F32 = jnp.float32

kernel_name = 'hybrid_dsa_gdn_memxattn_hmoe_deepnorm'


def _split_cols(t, sizes):
    offs = np.cumsum(sizes)[:-1].tolist()
    return jnp.split(t, offs, axis=-1)


def _rmsnorm(t, g):
    tf = t.astype(F32)
    y = tf * lax.rsqrt(jnp.mean(tf * tf, axis=-1, keepdims=True) + RMS_EPS)
    return (y * g.astype(F32)).astype(t.dtype)


def _layernorm(t, g, b):
    tf = t.astype(F32)
    mu = jnp.mean(tf, axis=-1, keepdims=True)
    var = jnp.mean(jnp.square(tf - mu), axis=-1, keepdims=True)
    return ((tf - mu) * lax.rsqrt(var + LN_EPS) * g.astype(F32) + b.astype(F32)).astype(t.dtype)


def _l2norm(t):
    tf = t.astype(F32)
    return tf * lax.rsqrt(jnp.sum(tf * tf, axis=-1, keepdims=True) + RMS_EPS)


def _rope_tables(seq):
    inv_freq = 1.0 / (ROPE_THETA ** (jnp.arange(0, HEAD_DIM, 2, dtype=F32) / HEAD_DIM))
    ang = jnp.arange(seq, dtype=F32)[:, None] * inv_freq[None, :]
    return jnp.cos(ang), jnp.sin(ang)


def _rope(t, cos, sin):
    half = t.shape[-1] // 2
    tf = t.astype(F32)
    t1, t2 = tf[..., :half], tf[..., half:]
    return jnp.concatenate([t1 * cos - t2 * sin, t2 * cos + t1 * sin], axis=-1).astype(t.dtype)


def _causal_dwconv(t, w):
    k = w.shape[0]
    return lax.conv_general_dilated(t, w[:, None, :].astype(t.dtype), window_strides=(1,),
                                    padding=[(k - 1, 0)],
                                    dimension_numbers=('NWC', 'WIO', 'NWC'),
                                    feature_group_count=t.shape[-1])


def _dsa_attention(q, k, v, iq, ik, iw):
    bsz, seq, n_h, d_h = q.shape
    n_blk = seq // Q_BLOCK
    top = min(INDEX_TOPK, seq // 4)
    key_pos = jnp.arange(seq)
    scale = d_h ** -0.5
    gather = jax.vmap(lambda t, i: t[i])

    def blocks(t):
        return jnp.moveaxis(t.reshape((bsz, n_blk, Q_BLOCK) + t.shape[2:]), 1, 0)

    def one_block(args):
        qb, iqb, iwb, start = args
        q_pos = start + jnp.arange(Q_BLOCK)
        causal = key_pos[None, :] <= q_pos[:, None]
        idx_dot = jnp.einsum('bqhd,bsd->bqhs', iqb, ik)
        score = jnp.einsum('bqh,bqhs->bqs', iwb, jax.nn.relu(idx_dot)).astype(F32)
        score = jnp.where(causal[None], score, NEG_INF)
        _, sel = lax.top_k(score, top)
        valid = sel <= q_pos[None, :, None]
        k_sel = gather(k, sel)
        v_sel = gather(v, sel)
        logits = jnp.einsum('bqhd,bqkd->bqhk', qb, k_sel).astype(F32) * scale
        logits = jnp.where(valid[:, :, None, :], logits, NEG_INF)
        p = jax.nn.softmax(logits, axis=-1).astype(v.dtype)
        return jnp.einsum('bqhk,bqkd->bqhd', p, v_sel)

    out = lax.map(one_block, (blocks(q), blocks(iq), blocks(iw), jnp.arange(n_blk) * Q_BLOCK))
    return jnp.moveaxis(out, 0, 1).reshape(bsz, seq, n_h, d_h)


def _gated_delta_rule(q, k, v, g, beta):
    bsz, seq, n_h, d_k = q.shape
    d_v = v.shape[-1]
    n_c = seq // CHUNK

    def chunks(t):
        return jnp.moveaxis(t.reshape(bsz, n_c, CHUNK, n_h, -1), 3, 1)

    q, k, v = chunks(q), chunks(k), chunks(v)
    g = chunks(g[..., None])[..., 0]
    beta = chunks(beta[..., None])[..., 0]
    gc = jnp.cumsum(g, axis=-1)
    pos = jnp.arange(CHUNK)
    incl = pos[:, None] >= pos[None, :]
    strict = pos[:, None] > pos[None, :]
    diff = gc[..., :, None] - gc[..., None, :]
    decay = jnp.where(incl, jnp.exp(jnp.where(incl, diff, 0.0)), 0.0)
    kb = k * beta[..., None]
    lower = jnp.where(strict, jnp.einsum('bhnid,bhnjd->bhnij', kb, k) * decay, 0.0)
    t_mat = lower + jnp.eye(CHUNK, dtype=F32)
    u = lax.linalg.triangular_solve(t_mat, v * beta[..., None], left_side=True,
                                    lower=True, unit_diagonal=True)
    w = lax.linalg.triangular_solve(t_mat, kb * jnp.exp(gc)[..., None], left_side=True,
                                    lower=True, unit_diagonal=True)
    a_intra = jnp.where(incl, jnp.einsum('bhnid,bhnjd->bhnij', q, k) * decay, 0.0)
    q_dec = q * jnp.exp(gc)[..., None]
    k_dec = k * jnp.exp(gc[..., -1:] - gc)[..., None]
    g_last = jnp.exp(gc[..., -1])

    def step(state, inp):
        u_n, w_n, qd_n, kd_n, a_n, gl_n = inp
        v_new = u_n - jnp.einsum('bhck,bhkv->bhcv', w_n, state)
        o_n = jnp.einsum('bhck,bhkv->bhcv', qd_n, state) + jnp.einsum('bhcs,bhsv->bhcv', a_n, v_new)
        state = state * gl_n[..., None, None] + jnp.einsum('bhck,bhcv->bhkv', kd_n, v_new)
        return state, o_n

    xs = tuple(jnp.moveaxis(t, 2, 0) for t in (u, w, q_dec, k_dec, a_intra, g_last))
    s0 = jnp.zeros((bsz, n_h, d_k, d_v), F32)
    _, o = lax.scan(step, s0, xs)
    return jnp.transpose(o, (1, 0, 3, 2, 4)).reshape(bsz, seq, n_h, d_v)


def _token_mixer(h, mem, cos, sin, w_in, kv_norm_g, w_k_up, w_v_up, conv_w, A_log, dt_bias,
                 gdn_norm_g, attn_norm_g, mem_norm_g, w_mem_kv, w_out):
    bsz, seq, _ = h.shape
    proj = h @ w_in
    (q_a, c_kv, iq, ik, iw, q_b, k_b, v_b, z_b, a_b, b_b, q_c) = _split_cols(proj, SPLIT_SIZES)
    cos_h, sin_h = cos[None, :, None, :], sin[None, :, None, :]
    cos_t, sin_t = cos[None], sin[None]

    q_a = _rope(q_a.reshape(bsz, seq, ATTN_HEADS, HEAD_DIM), cos_h, sin_h)
    c_kv = _rmsnorm(c_kv, kv_norm_g)
    k_a = _rope(c_kv @ w_k_up, cos_t, sin_t)
    v_a = c_kv @ w_v_up
    iq = _rope(iq.reshape(bsz, seq, IDX_HEADS, IDX_DIM), cos_h, sin_h)
    ik = _rope(ik, cos_t, sin_t)
    iw = iw * (IDX_HEADS ** -0.5 * IDX_DIM ** -0.5)
    o_a = _dsa_attention(q_a, k_a, v_a, iq, ik, iw).reshape(bsz, seq, A_WIDTH)
    o_a = _rmsnorm(o_a, attn_norm_g)

    qkv = jax.nn.silu(_causal_dwconv(jnp.concatenate([q_b, k_b, v_b], axis=-1), conv_w))
    q_b, k_b, v_b = jnp.split(qkv, 3, axis=-1)
    q_b = _l2norm(q_b.reshape(bsz, seq, GDN_HEADS, HEAD_DIM)) * (HEAD_DIM ** -0.5)
    k_b = _l2norm(k_b.reshape(bsz, seq, GDN_HEADS, HEAD_DIM))
    v_b = v_b.reshape(bsz, seq, GDN_HEADS, HEAD_DIM).astype(F32)
    beta = jax.nn.sigmoid(b_b.astype(F32))
    g = -jnp.exp(A_log.astype(F32)) * jax.nn.softplus(a_b.astype(F32) + dt_bias.astype(F32))
    o_b = _gated_delta_rule(q_b, k_b, v_b, g, beta).astype(h.dtype)
    o_b = _rmsnorm(o_b, gdn_norm_g) * jax.nn.silu(z_b.reshape(bsz, seq, GDN_HEADS, HEAD_DIM))
    o_b = o_b.reshape(bsz, seq, GDN_WIDTH)

    m_k, m_v = jnp.split(mem @ w_mem_kv, 2, axis=-1)
    m_k = m_k.reshape(bsz, -1, MEM_HEADS, HEAD_DIM)
    m_v = m_v.reshape(bsz, -1, MEM_HEADS, HEAD_DIM)
    q_c = q_c.reshape(bsz, seq, MEM_HEADS, HEAD_DIM)
    logits = jnp.einsum('bshd,bmhd->bhsm', q_c, m_k).astype(F32) * (HEAD_DIM ** -0.5)
    p = jax.nn.softmax(logits, axis=-1).astype(h.dtype)
    o_c = jnp.einsum('bhsm,bmhd->bshd', p, m_v).reshape(bsz, seq, MEM_WIDTH)
    o_c = _rmsnorm(o_c, mem_norm_g)

    return jnp.concatenate([o_a, o_b, o_c], axis=-1) @ w_out


def _hier_moe(h, w_group, b_group, w_router, b_router, w_gate, w_up, w_down):
    bsz, seq, d = h.shape
    xf = h.reshape(-1, d)
    n_tok = xf.shape[0]
    g_prob = jax.nn.softmax((xf @ w_group + b_group).astype(F32), axis=-1)
    p_grp, grp = lax.top_k(g_prob, 1)
    e_logit = (xf @ w_router + b_router).astype(F32).reshape(n_tok, N_GROUPS, EXPERTS_PER_GROUP)
    e_logit = jnp.take_along_axis(e_logit, grp[:, :, None], axis=1)[:, 0]
    p_loc, loc = lax.top_k(jax.nn.softmax(e_logit, axis=-1), TOP_K)
    gate = p_grp * p_loc / jnp.sum(p_loc, axis=-1, keepdims=True)
    expert = grp * EXPERTS_PER_GROUP + loc

    n_asg = n_tok * TOP_K
    e_flat = expert.reshape(-1)
    tok_flat = jnp.arange(n_asg, dtype=jnp.int32) // TOP_K
    order = jnp.argsort(e_flat)
    e_s = e_flat[order]
    tok_s = tok_flat[order]
    g_s = gate.reshape(-1)[order]
    counts = jnp.zeros((N_EXPERTS,), jnp.int32).at[e_flat].add(1)
    padded = (counts + MOE_BLOCK - 1) // MOE_BLOCK * MOE_BLOCK
    starts = jnp.cumsum(counts) - counts
    pad_ends = jnp.cumsum(padded)
    dest = pad_ends[e_s] - padded[e_s] + jnp.arange(n_asg, dtype=jnp.int32) - starts[e_s]
    cap = (n_asg + MOE_BLOCK - 1) // MOE_BLOCK * MOE_BLOCK + N_EXPERTS * MOE_BLOCK
    n_blk = cap // MOE_BLOCK
    x_buf = jnp.zeros((cap, d), xf.dtype).at[dest].set(xf[tok_s])
    tok_buf = jnp.zeros((cap,), jnp.int32).at[dest].set(tok_s)
    g_buf = jnp.zeros((cap,), F32).at[dest].set(g_s)
    blk_expert = jnp.minimum(
        jnp.searchsorted(pad_ends, jnp.arange(n_blk, dtype=jnp.int32) * MOE_BLOCK, side='right'),
        N_EXPERTS - 1)

    def expert_block(args):
        xb, e = args
        return (jax.nn.silu(xb @ w_gate[e]) * (xb @ w_up[e])) @ w_down[e]

    y_buf = lax.map(expert_block, (x_buf.reshape(n_blk, MOE_BLOCK, d), blk_expert))
    y_buf = (y_buf.reshape(cap, d).astype(F32) * g_buf[:, None]).astype(xf.dtype)
    return jnp.zeros_like(xf).at[tok_buf].add(y_buf).reshape(bsz, seq, d)


def setup_inputs(seed: int = 0) -> dict:
    key = jax.random.key(seed)
    ks = jax.random.split(key, 32)

    def normal(i, shape, scale):
        return jax.random.normal(ks[i], shape, F32) * scale

    def gain(i, shape):
        return 1.0 + normal(i, shape, 0.02)

    dt = jnp.exp(jax.random.uniform(ks[7], (DEPTH, GDN_HEADS), F32,
                                    minval=float(np.log(1e-3)), maxval=float(np.log(1e-1))))
    return {
        'x': normal(0, (BATCH, SEQ, D_MODEL), 1.0),
        'mem': normal(1, (BATCH, N_MEM, D_MODEL), 1.0),
        'w_in': normal(2, (DEPTH, D_MODEL, IN_WIDTH), D_MODEL ** -0.5),
        'kv_norm_g': gain(3, (DEPTH, KV_RANK)),
        'w_k_up': normal(4, (DEPTH, KV_RANK, HEAD_DIM), KV_RANK ** -0.5),
        'w_v_up': normal(5, (DEPTH, KV_RANK, HEAD_DIM), KV_RANK ** -0.5),
        'conv_w': normal(6, (DEPTH, CONV_WIDTH, GDN_CONV_CH), CONV_WIDTH ** -0.5),
        'A_log': jnp.log(jax.random.uniform(ks[8], (DEPTH, GDN_HEADS), F32, minval=1.0, maxval=16.0)),
        'dt_bias': dt + jnp.log(-jnp.expm1(-dt)),
        'gdn_norm_g': gain(9, (DEPTH, HEAD_DIM)),
        'attn_norm_g': gain(10, (DEPTH, A_WIDTH)),
        'mem_norm_g': gain(11, (DEPTH, MEM_WIDTH)),
        'w_mem_kv': normal(12, (DEPTH, D_MODEL, 2 * MEM_WIDTH), D_MODEL ** -0.5),
        'w_out': normal(13, (DEPTH, MIX_WIDTH, D_MODEL), MIX_WIDTH ** -0.5 * DEEPNORM_BETA),
        'ln1_g': gain(14, (DEPTH, D_MODEL)),
        'ln1_b': normal(15, (DEPTH, D_MODEL), 0.02),
        'w_group': normal(16, (DEPTH, D_MODEL, N_GROUPS), D_MODEL ** -0.5),
        'b_group': normal(17, (DEPTH, N_GROUPS), 0.01),
        'w_router': normal(18, (DEPTH, D_MODEL, N_EXPERTS), D_MODEL ** -0.5),
        'b_router': normal(19, (DEPTH, N_EXPERTS), 0.01),
        'w_gate': normal(20, (DEPTH, N_EXPERTS, D_MODEL, D_EXPERT), D_MODEL ** -0.5),
        'w_up': normal(21, (DEPTH, N_EXPERTS, D_MODEL, D_EXPERT), D_MODEL ** -0.5),
        'w_down': normal(22, (DEPTH, N_EXPERTS, D_EXPERT, D_MODEL), D_EXPERT ** -0.5 * DEEPNORM_BETA),
        'ln2_g': gain(23, (DEPTH, D_MODEL)),
        'ln2_b': normal(24, (DEPTH, D_MODEL), 0.02),
    }


def reference(x, mem, w_in, kv_norm_g, w_k_up, w_v_up, conv_w, A_log, dt_bias, gdn_norm_g,
              attn_norm_g, mem_norm_g, w_mem_kv, w_out, ln1_g, ln1_b, w_group, b_group,
              w_router, b_router, w_gate, w_up, w_down, ln2_g, ln2_b):
    cos, sin = _rope_tables(x.shape[1])
    for layer in range(DEPTH):
        mix = _token_mixer(x, mem, cos, sin, w_in[layer], kv_norm_g[layer], w_k_up[layer],
                           w_v_up[layer], conv_w[layer], A_log[layer], dt_bias[layer],
                           gdn_norm_g[layer], attn_norm_g[layer], mem_norm_g[layer],
                           w_mem_kv[layer], w_out[layer])
        x = _layernorm(DEEPNORM_ALPHA * x + mix, ln1_g[layer], ln1_b[layer])
        ffn = _hier_moe(x, w_group[layer], b_group[layer], w_router[layer], b_router[layer],
                        w_gate[layer], w_up[layer], w_down[layer])
        x = _layernorm(DEEPNORM_ALPHA * x + ffn, ln2_g[layer], ln2_b[layer])
    return x
```

```cpp
#include <hip/hip_runtime.h>
#include <cstdio>
#include <cstdint>
#include <cstring>

#ifndef ONE_LAUNCH
#define ONE_LAUNCH 1
#endif

typedef unsigned short bf16_t;
typedef float f32x4 __attribute__((ext_vector_type(4)));
typedef unsigned u32x4 __attribute__((ext_vector_type(4)));
typedef unsigned u32x2 __attribute__((ext_vector_type(2)));

constexpr int T = 32768, DM = 1024, SEQ = 4096, NBATCH = 8;
constexpr int NIN = 2816;
constexpr int NMEM = 256, TM = NBATCH * NMEM;
constexpr int NEXP = 64, DE = 256;
constexpr int NTHREADS = 512, NWAVES = 8;
constexpr float ALPHA = 1.189207115002721f;
constexpr float LOG2E = 1.4426950408889634f;
constexpr float QSCALE = 0.125f * LOG2E;

constexpr size_t MiB = 1ull << 20;
constexpr size_t WS_CTL = 0;
constexpr size_t WS_TSLOT = 512 * 1024;
constexpr size_t WS_ROPE = 1 * MiB;
constexpr size_t WS_WKV = 2 * MiB;
constexpr size_t WS_WR = 2 * MiB + 65536;
constexpr size_t WS_WIN = 3 * MiB;
constexpr size_t WS_WO = 9 * MiB;
constexpr size_t WS_WMKV = 11 * MiB;
constexpr size_t WS_MEMB = 12 * MiB;
constexpr size_t WS_WGU = 16 * MiB;
constexpr size_t WS_WD = 80 * MiB;
constexpr size_t WS_XB = 112 * MiB;
constexpr size_t WS_QA = 176 * MiB;
constexpr size_t WS_CKV = 200 * MiB;
constexpr size_t WS_IQ = 208 * MiB;
constexpr size_t WS_IK = 224 * MiB;
constexpr size_t WS_SM = 228 * MiB;
constexpr size_t WS_QC = 230 * MiB;
constexpr size_t WS_GB = 246 * MiB;
constexpr size_t WS_MK = 342 * MiB;
constexpr size_t WS_MVT = 343 * MiB;
constexpr size_t WS_KVA = 344 * MiB;
constexpr size_t WS_SEL = 352 * MiB;
constexpr size_t WS_CAT = 368 * MiB;
constexpr size_t WS_X1B = 432 * MiB;
constexpr size_t WS_LIST = 496 * MiB;
constexpr size_t WS_GATEL = 504 * MiB;
constexpr size_t WS_END = 512 * MiB;
constexpr size_t WS_H = 112 * MiB;
constexpr size_t WS_Y = 160 * MiB;

constexpr int CW_CNT = 0;
constexpr int CW_Q = 64;
constexpr int CW_BAR = 4096;

struct Ctx {
  const float* in[25];
  float* out;
  unsigned char* ws;
  int ph_lo, ph_hi;
};


extern __shared__ __attribute__((aligned(16))) unsigned char lds_raw[];
constexpr int LDS_BYTES = 157696;
constexpr int LDS_WCTR = LDS_BYTES - 64;
__device__ __forceinline__ int phase_tid() {
  __syncthreads();
  int l; asm volatile("v_mbcnt_lo_u32_b32 %0, -1, 0\n\tv_mbcnt_hi_u32_b32 %0, -1, %0" : "=v"(l));
  unsigned w = 0u;
  if (l == 0) w = __hip_atomic_fetch_add((__attribute__((address_space(3))) unsigned*)(__attribute__((address_space(3))) unsigned char*)(lds_raw + LDS_WCTR), 1u, __ATOMIC_RELAXED, __HIP_MEMORY_SCOPE_WORKGROUP);
  w = (unsigned)__builtin_amdgcn_readfirstlane((int)w) & 7u;
  return (int)(w * 64u) + l;
}


#define XB_TMO      128
#define XB_XCNT(j)  (256  + 64 * (j))
#define XB_XSUB(j)  (1280 + 64 * (j))
#define XB_XGEN(j)  (2304 + 64 * (j))
#define XB_TOP      3328
#define XB_TOPGEN   3392
#define XCD_BAR_WORDS 3456
#define XB_SPIN_CAP (1u << 18)
constexpr int LDS_XBST = LDS_BYTES - 32;
__device__ __forceinline__ unsigned xb_ld(unsigned* p)              { return __hip_atomic_load(p, __ATOMIC_RELAXED, __HIP_MEMORY_SCOPE_AGENT); }
__device__ __forceinline__ unsigned xb_add(unsigned* p, unsigned v) { return __hip_atomic_fetch_add(p, v, __ATOMIC_RELAXED, __HIP_MEMORY_SCOPE_AGENT); }
__device__ __forceinline__ unsigned xb_xcc_id() { return (unsigned)__builtin_amdgcn_s_getreg((3 << 11) | 20) & 0xFu; }
#define XB_SPIN(cond, bar) do { unsigned _sp = 0; while (cond) { __builtin_amdgcn_s_sleep(1); \
    if ((++_sp & 255u) == 0u) { if (xb_ld(&(bar)[XB_TMO])) break; if (_sp > XB_SPIN_CAP) { atomicAdd(&(bar)[XB_TMO], 1u); break; } } } } while (0)
__device__ __forceinline__ void xcd_barrier_complete(unsigned* bar, unsigned x, unsigned& nloc, unsigned& nx) {
    const unsigned G = gridDim.x;
    unsigned sum, cnt, mine, sp = 0u;
    for (;;) {
        sum = 0u; cnt = 0u; mine = 0u;
#pragma unroll
        for (unsigned j = 0; j < 16; ++j) { const unsigned cc = xb_ld(&bar[XB_XCNT(j)]); sum += cc; cnt += (cc > 0u) ? 1u : 0u; mine = (j == x) ? cc : mine; }
        if (sum == G) break;
        __builtin_amdgcn_s_sleep(1);
        if ((++sp & 255u) == 0u) { if (xb_ld(&bar[XB_TMO])) break; if (sp > XB_SPIN_CAP) { atomicAdd(&bar[XB_TMO], 1u); break; } }
    }
    nloc = mine > 0u ? mine : 1u; nx = cnt > 0u ? cnt : 1u;
}
__device__ __forceinline__ void xcd_barrier(unsigned* bar) {
    asm volatile("s_waitcnt vmcnt(0)" ::: "memory");
    __syncthreads();
    const int btid = phase_tid();
    if (btid == 0) {
        volatile __attribute__((address_space(3))) unsigned* st = (volatile __attribute__((address_space(3))) unsigned*)(__attribute__((address_space(3))) unsigned char*)(lds_raw + LDS_XBST);
        const unsigned x = xb_xcc_id();
        __builtin_amdgcn_s_waitcnt(0);
        unsigned nloc = st[0], nx = st[1];
        if (nloc == 0u) { xcd_barrier_complete(bar, x, nloc, nx); st[0] = nloc; st[1] = nx; }
        const unsigned old = xb_add(&bar[XB_XSUB(x)], 1u);
        const unsigned gen = old / nloc;
        if (old + 1u == (gen + 1u) * nloc) {
            __builtin_amdgcn_fence(__ATOMIC_RELEASE, "agent");
            asm volatile("s_waitcnt vmcnt(0)" ::: "memory");
            const unsigned og = xb_add(&bar[XB_TOP], 1u);
            const unsigned tg = og / nx;
            if (og + 1u == (tg + 1u) * nx) xb_add(&bar[XB_TOPGEN], 1u);
            else XB_SPIN(xb_ld(&bar[XB_TOPGEN]) == tg, bar);
            __builtin_amdgcn_fence(__ATOMIC_ACQUIRE, "agent");
            xb_add(&bar[XB_XGEN(x)], 1u);
            asm volatile("s_waitcnt vmcnt(0)" ::: "memory");
        } else {
            XB_SPIN(xb_ld(&bar[XB_XGEN(x)]) == gen, bar);
            __builtin_amdgcn_fence(__ATOMIC_ACQUIRE, "agent");
            asm volatile("s_waitcnt vmcnt(0)" ::: "memory");
        }
    }
    __syncthreads();
}

__device__ __forceinline__ float bf2f(bf16_t v) { return __uint_as_float(((unsigned)v) << 16); }
typedef float hw_f32x2 __attribute__((ext_vector_type(2))); typedef __bf16 hw_bf16x2 __attribute__((ext_vector_type(2)));
__device__ __forceinline__ unsigned pk2(float lo, float hi) { const hw_f32x2 v = {lo, hi}; const hw_bf16x2 b = __builtin_convertvector(v, hw_bf16x2); return __builtin_bit_cast(unsigned, b); }
__device__ __forceinline__ bf16_t f2bf(float f) { return (bf16_t)(pk2(f, f) & 0xffffu); }
__device__ __forceinline__ float wave_sum(float v) {
  int x = __float_as_int(v);
  x = __float_as_int(__int_as_float(x) + __int_as_float(__builtin_amdgcn_update_dpp(0, x, 0x111, 0xF, 0xF, true)));
  x = __float_as_int(__int_as_float(x) + __int_as_float(__builtin_amdgcn_update_dpp(0, x, 0x112, 0xF, 0xF, true)));
  x = __float_as_int(__int_as_float(x) + __int_as_float(__builtin_amdgcn_update_dpp(0, x, 0x114, 0xF, 0xF, true)));
  x = __float_as_int(__int_as_float(x) + __int_as_float(__builtin_amdgcn_update_dpp(0, x, 0x118, 0xF, 0xF, true)));
  x = __float_as_int(__int_as_float(x) + __int_as_float(__builtin_amdgcn_update_dpp(0, x, 0x142, 0xA, 0xF, false)));
  x = __float_as_int(__int_as_float(x) + __int_as_float(__builtin_amdgcn_update_dpp(0, x, 0x143, 0xC, 0xF, false)));
  return __int_as_float(__builtin_amdgcn_readlane(x, 63));
}
__device__ __forceinline__ float wave_max(float v) {
#pragma unroll
  for (int o = 32; o >= 1; o >>= 1) v = fmaxf(v, __shfl_xor(v, o));
  return v;
}
__device__ __forceinline__ float silu_f(float v) { return v * __builtin_amdgcn_rcpf(1.f + __expf(-v)); }

__device__ __forceinline__ int ropeperm(int p) { return (p >> 1) + 32 * (p & 1); }
__device__ __forceinline__ int colmap_in(int cp) {
  const int tile = cp >> 8, w = cp & 255;
  if (tile == 0) return (w >> 6) * 64 + ropeperm(w & 63);
  if (tile == 1) { if (w < 128) { const int c = 256 + w; return (c >> 6) * 64 + ropeperm(c & 63); } return 384 + (w - 128); }
  if (tile == 2) return 512 + (w >> 6) * 64 + ropeperm(w & 63);
  if (tile == 3) { if (w < 64) return 768 + ropeperm(w); if (w < 68) return 832 + (w - 64); if (w < 74) return 2372 + (w - 68); if (w < 80) return 2378 + (w - 74); return -1; }
  if (tile == 4) return 2384 + w;
  return 836 + (cp - 1280);
}

struct WorkQ { unsigned* head; volatile int* slot; int nxt; };
__device__ __forceinline__ void wq_init(WorkQ& q, unsigned* head, volatile int* slot, int tid) { q.head = head; q.slot = slot; q.nxt = 0; if (tid == 0) q.nxt = (int)atomicAdd(head, 1u); }
__device__ __forceinline__ int wq_next(WorkQ& q, int tid) {
  __syncthreads();
  if (tid == 0) { *q.slot = q.nxt; q.nxt = (int)atomicAdd(q.head, 1u); }
  __syncthreads();
  return *q.slot;
}

template <class CM>
__device__ __forceinline__ void tp_tile(const float* src, int ld, bf16_t* dst, int drow0, int K, int k0, CM cm, float* lds, int tid) {
  const int a = tid & 63, b = tid >> 6;
  const int sc = cm(a);
  __syncthreads();
#pragma unroll
  for (int i = 0; i < 8; ++i) { const int kk = b * 8 + i; lds[kk * 65 + a] = sc >= 0 ? src[(size_t)(k0 + kk) * ld + sc] : 0.f; }
  __syncthreads();
  { const int nn = tid >> 3, kc = (tid & 7) * 8;
    const float* p = lds + kc * 65 + nn;
    *(u32x4*)(dst + (size_t)(drow0 + nn) * K + k0 + kc) = (u32x4){pk2(p[0], p[65]), pk2(p[130], p[195]), pk2(p[260], p[325]), pk2(p[390], p[455])}; }
}

__device__ void phase_prologue(const Ctx& c, float* lds) {
  const int tid = phase_tid(), bid = blockIdx.x, G = gridDim.x;
  unsigned char* ws = c.ws;
  const size_t gtid = (size_t)bid * NTHREADS + tid, gstride = (size_t)G * NTHREADS;
  { const f32x4* x4 = (const f32x4*)c.in[0]; u32x2* o = (u32x2*)(ws + WS_XB);
    for (size_t i = gtid; i < (size_t)T * DM / 4; i += gstride) { const f32x4 v = x4[i]; o[i] = (u32x2){pk2(v.x, v.y), pk2(v.z, v.w)}; }
    const f32x4* m4 = (const f32x4*)c.in[1]; u32x2* om = (u32x2*)(ws + WS_MEMB);
    for (size_t i = gtid; i < (size_t)TM * DM / 4; i += gstride) { const f32x4 v = m4[i]; om[i] = (u32x2){pk2(v.x, v.y), pk2(v.z, v.w)}; } }
  { float* cs = (float*)(ws + WS_ROPE); float* sn = cs + SEQ * 32;
    for (size_t i = gtid; i < (size_t)SEQ * 32; i += gstride) { const int s = (int)(i >> 5), d = (int)(i & 31);
      const float inv = 1.0f / powf(10000.0f, (float)d / 32.0f); const float ang = (float)s * inv; float sv, cv; sincosf(ang, &sv, &cv); cs[i] = cv; sn[i] = sv; } }
  { bf16_t* wkv = (bf16_t*)(ws + WS_WKV); const float* g = c.in[3]; const float* wk = c.in[4]; const float* wv = c.in[5];
    for (size_t i = gtid; i < 128 * 128; i += gstride) { const int p = (int)(i >> 7), k = (int)(i & 127);
      const float w = p < 64 ? wk[k * 64 + ropeperm(p)] : wv[k * 64 + (p - 64)]; wkv[i] = f2bf(w * g[k]); }
    bf16_t* wr = (bf16_t*)(ws + WS_WR); const float* wg = c.in[16]; const float* wrt = c.in[18];
    for (size_t i = gtid; i < 80 * 1024; i += gstride) { const int o = (int)(i >> 10), k = (int)(i & 1023); wr[i] = f2bf(o < 8 ? wg[k * 8 + o] : o < 72 ? wrt[k * 64 + (o - 8)] : 0.f); } }
  const int n_win = (NIN / 64) * 16, n_wo = 16 * 16, n_wmkv = 8 * 16, n_wgu = 64 * 8 * 16, n_wd = 64 * 16 * 4;
  const int total = n_win + n_wo + n_wmkv + n_wgu + n_wd;
  for (int it = bid; it < total; it += G) {
    int r = it;
    if (r < n_win) { const int nt = r / 16, kt = r % 16; tp_tile(c.in[2], 2640, (bf16_t*)(ws + WS_WIN), nt * 64, 1024, kt * 64, [&](int a) { return colmap_in(nt * 64 + a); }, lds, tid); continue; } r -= n_win;
    if (r < n_wo) { const int nt = r / 16, kt = r % 16; tp_tile(c.in[13], 1024, (bf16_t*)(ws + WS_WO), nt * 64, 1024, kt * 64, [&](int a) { return nt * 64 + a; }, lds, tid); continue; } r -= n_wo;
    if (r < n_wmkv) { const int nt = r / 16, kt = r % 16; tp_tile(c.in[12], 512, (bf16_t*)(ws + WS_WMKV), nt * 64, 1024, kt * 64, [&](int a) { return nt * 64 + a; }, lds, tid); continue; } r -= n_wmkv;
    if (r < n_wgu) { const int e = r / 128, q = r % 128, nt = q / 16, kt = q % 16;
      const int pn = nt >> 2, sub = nt & 3, isup = sub >> 1, c0 = pn * 128 + (sub & 1) * 64;
      const float* src = (isup ? c.in[21] : c.in[20]) + (size_t)e * 1024 * 256;
      tp_tile(src, 256, (bf16_t*)(ws + WS_WGU), e * 512 + nt * 64, 1024, kt * 64, [&](int a) { return c0 + a; }, lds, tid); continue; } r -= n_wgu;
    { const int e = r / 64, q = r % 64, nt = q / 4, kt = q % 4;
      tp_tile(c.in[22] + (size_t)e * 256 * 1024, 1024, (bf16_t*)(ws + WS_WD), e * 1024 + nt * 64, 256, kt * 64, [&](int a) { return nt * 64 + a; }, lds, tid); }
  }
}

__device__ __forceinline__ void expert_offsets(const Ctx& c, int* offs  , int* cnts  , int tid) {
  const unsigned* ctl = (const unsigned*)(c.ws + WS_CTL);
  __syncthreads();
  if (tid == 0) { int o = 0; for (int e = 0; e < 64; ++e) { const int n = (int)ctl[CW_CNT + e]; cnts[e] = n; offs[e] = o; o += (n + 255) & ~255; } offs[64] = o; }
  __syncthreads();
}


namespace pg8 {
#define PG8_LAS __attribute__((address_space(3)))
typedef short bf16x8 __attribute__((ext_vector_type(8)));
constexpr int BM = 256, BK = 64, HALF = 128, HTB = HALF * BK * 2, STAGE_BYTES = 8 * HTB, NXCD = 8, WGM = 8;
__host__ __device__ __forceinline__ int lds_byte(int r, int c) { const int st = (r >> 4) * 2 + (c >> 5), rr = r & 15, cc = c & 31, ob = rr * 64 + cc * 2; return st * 1024 + (ob ^ (((ob >> 9) & 1) << 5)); }
__host__ __device__ __forceinline__ void stage_rc(int b, int& R, int& C) { const int st = b / 1024, sb = b % 1024, swz = sb ^ (((sb >> 9) & 1) << 5); R = (st >> 1) * 16 + swz / 64; C = (st & 1) * 32 + (swz % 64) / 2; }
__host__ __device__ __forceinline__ int perm32(int rho) { const int n = rho >> 4, i = rho & 15; return 8 * (i >> 2) + 4 * n + (i & 3); }
struct Unit { int pm, pn, e, mt, aux; };
struct Gemm { const bf16_t* A; const bf16_t* Bt; int K; };
struct StaticOrder {
    int nM, nN, nwg, G, c;
    __device__ void init(int M, int N, int G_, int c_) { nM = M / BM; nN = N / BM; nwg = nM * nN; G = G_; c = c_; }
    __device__ bool next(int i, Unit& u) const {
        const long L = (long)i * G + c; if (c < 0 || L >= nwg) return false;
        int wgid = (int)L; { const int q = nwg / NXCD, r = nwg % NXCD, xcd = wgid % NXCD, off = wgid / NXCD; wgid = (xcd < r ? xcd * (q + 1) : r * (q + 1) + (xcd - r) * q) + off; }
        const int nig = WGM * nN, gid = wgid / nig, fm = gid * WGM, gsz = (nM - fm) < WGM ? (nM - fm) : WGM;
        u.pm = fm + ((wgid % nig) % gsz); u.pn = (wgid % nig) / gsz; u.e = 0; u.mt = 0; u.aux = 0; return true;
    }
    __device__ __forceinline__ unsigned arow(const Unit&, int) const { return 0u; }
};
__device__ __forceinline__ unsigned cvt_pk_bf16(float lo, float hi) { unsigned r; asm volatile("v_cvt_pk_bf16_f32 %0, %1, %2" : "=v"(r) : "v"(lo), "v"(hi)); return r; }

template <class Epi, class Sched, bool ALIGN_EPI, bool GATHER>
__device__ __forceinline__ void gemm_phase(PG8_LAS unsigned char* lds, const Gemm g, const Sched& S, const Epi& E, const int tid) {
    const int wid = __builtin_amdgcn_readfirstlane(tid >> 6), lane = tid & 63, wr = wid >> 2, wc = wid & 3, fr = lane & 15, fq = lane >> 4;
    const int K = g.K, nt = K / BK;
    unsigned voffA[2], voffB[2]; int RA[2], CA[2];
#pragma unroll
    for (int i = 0; i < 2; ++i) { int R, C; stage_rc(tid * 16 + i * 8192, R, C); const int Rb = Epi::PERM ? ((R & ~31) + perm32(R & 31)) : R;
        RA[i] = R; CA[i] = C; voffA[i] = (unsigned)(R * K + C) * 2u; voffB[i] = (unsigned)(Rb * K + C) * 2u; }
    const size_t kstep = (size_t)(BK * 2);
    const size_t hstep = (size_t)HALF * K * 2;
    const size_t tstep = 2 * hstep;
    const unsigned ldsw = (unsigned)wid * 1024u;
    const int aoff = lds_byte(wr * 64 + fr, fq * 8), boff = lds_byte(wc * 32 + fr, fq * 8);
#define PG8_SA(b, h) (((b) * 2 + (h)) * HTB)
#define PG8_SB(b, h) ((4 + (b) * 2 + (h)) * HTB)
#define PG8_STAGE(bufoff, gbase, voff) do { _Pragma("unroll") for (int _i = 0; _i < 2; ++_i) \
        __builtin_amdgcn_global_load_lds((const unsigned*)((const char*)(gbase) + (voff)[_i]), (PG8_LAS unsigned*)(lds + (bufoff) + ldsw + _i * 8192), 16, 0, 0); } while (0)
#define PG8_STAGE_A(bufoff, gbase, h, goff) do { if constexpr (GATHER) { PG8_STAGE(bufoff, gbase, (goff)[h]); } else { PG8_STAGE(bufoff, (gbase) + (h) * hstep, voffA); } } while (0)
#define PG8_LDA(dst, b, h) do { _Pragma("unroll") for (int m = 0; m < 4; ++m) _Pragma("unroll") for (int k = 0; k < 2; ++k) dst[m][k] = *(const PG8_LAS bf16x8*)(lds + PG8_SA(b, h) + aoff + m * 2048 + k * 1024); } while (0)
#define PG8_LDB(dst, b, h) do { _Pragma("unroll") for (int n = 0; n < 2; ++n) _Pragma("unroll") for (int k = 0; k < 2; ++k) dst[n][k] = *(const PG8_LAS bf16x8*)(lds + PG8_SB(b, h) + boff + n * 2048 + k * 1024); } while (0)
#define PG8_MMA(ai, bj, At, Bt) do { __builtin_amdgcn_s_setprio(1); _Pragma("unroll") for (int m = 0; m < 4; ++m) _Pragma("unroll") for (int n = 0; n < 2; ++n) _Pragma("unroll") for (int k = 0; k < 2; ++k) \
        acc[ai][bj][m][n] = __builtin_amdgcn_mfma_f32_16x16x32_bf16(Bt[n][k], At[m][k], acc[ai][bj][m][n], 0, 0, 0); __builtin_amdgcn_s_setprio(0); } while (0)
#define PG8_WAIT_V(n) asm volatile("s_waitcnt vmcnt(" #n ")" ::: "memory")
#define PG8_WAIT_L(n) asm volatile("s_waitcnt lgkmcnt(" #n ")" ::: "memory")
#define PG8_BAR __builtin_amdgcn_s_barrier()
#define PG8_SCHED __builtin_amdgcn_sched_barrier(0)
    Unit cur, nxt; int ui = 0;
    if (!S.next(0, cur)) return;
    f32x4 acc[2][2][4][2];
#pragma unroll
    for (int a = 0; a < 2; ++a)
#pragma unroll
        for (int b = 0; b < 2; ++b)
#pragma unroll
            for (int m = 0; m < 4; ++m)
#pragma unroll
                for (int n = 0; n < 2; ++n) acc[a][b][m][n] = (f32x4){0.f, 0.f, 0.f, 0.f};
    bf16x8 At[4][2], B0[2][2], B1[2][2];
    unsigned gc[2][2], gn[2][2];
    const char* cA; const char* cB = (const char*)g.Bt + (size_t)cur.pn * tstep;
    if constexpr (GATHER) { cA = (const char*)g.A;
#pragma unroll
        for (int h = 0; h < 2; ++h)
#pragma unroll
            for (int i = 0; i < 2; ++i) { gc[h][i] = (S.arow(cur, h * HALF + RA[i]) * (unsigned)K + (unsigned)CA[i]) * 2u; gn[h][i] = gc[h][i]; }
    } else { cA = (const char*)g.A + (size_t)cur.pm * tstep; }
    PG8_STAGE(PG8_SB(0, 0), cB, voffB); PG8_STAGE(PG8_SB(0, 1), cB + hstep, voffB); PG8_STAGE_A(PG8_SA(0, 0), cA, 0, gc); PG8_STAGE_A(PG8_SA(0, 1), cA, 1, gc);
    if (wr == 1) PG8_BAR;
    PG8_WAIT_V(2); PG8_BAR;
    PG8_STAGE(PG8_SB(1, 0), cB + kstep, voffB); PG8_STAGE_A(PG8_SA(1, 0), cA + kstep, 0, gc); PG8_STAGE(PG8_SB(1, 1), cB + hstep + kstep, voffB);
    PG8_WAIT_V(6); PG8_BAR;
    for (;;) {
        const bool has_next = S.next(ui + 1, nxt);
        const char* nA; const char* nB = has_next ? (const char*)g.Bt + (size_t)nxt.pn * tstep : cB;
        if constexpr (GATHER) { nA = cA;
            if (has_next) {
#pragma unroll
                for (int h = 0; h < 2; ++h)
#pragma unroll
                    for (int i = 0; i < 2; ++i) gn[h][i] = (S.arow(nxt, h * HALF + RA[i]) * (unsigned)K + (unsigned)CA[i]) * 2u; }
        } else { nA = has_next ? (const char*)g.A + (size_t)nxt.pm * tstep : cA; }
        for (int t = 0; t < nt; t += 2) {
            const bool last = (t == nt - 2);
            const char* a1 = cA + (size_t)(t + 1) * kstep;
            const char* a2 = last ? nA : cA + (size_t)(t + 2) * kstep; const char* b2 = last ? nB : cB + (size_t)(t + 2) * kstep;
            const char* a3 = a2 + kstep; const char* b3 = b2 + kstep;
            unsigned g2[2][2];
            if constexpr (GATHER) {
#pragma unroll
            for (int h = 0; h < 2; ++h)
#pragma unroll
                for (int i = 0; i < 2; ++i) g2[h][i] = last ? gn[h][i] : gc[h][i]; }
            PG8_LDB(B0, 0, 0); PG8_LDB(B1, 0, 1); PG8_SCHED; PG8_LDA(At, 0, 0); PG8_STAGE_A(PG8_SA(1, 1), a1, 1, gc);
            PG8_WAIT_V(8); PG8_WAIT_L(0); PG8_BAR; PG8_MMA(0, 0, At, B0); PG8_MMA(0, 1, At, B1); PG8_BAR; PG8_SCHED;
            PG8_LDA(At, 0, 1); PG8_STAGE(PG8_SB(0, 0), b2, voffB); PG8_STAGE(PG8_SB(0, 1), b2 + hstep, voffB); PG8_STAGE_A(PG8_SA(0, 0), a2, 0, g2);
            PG8_WAIT_V(8); PG8_WAIT_L(0); PG8_BAR; PG8_MMA(1, 0, At, B0); PG8_MMA(1, 1, At, B1); PG8_BAR; PG8_SCHED;
            PG8_LDB(B0, 1, 0); PG8_LDB(B1, 1, 1); PG8_SCHED; PG8_LDA(At, 1, 0); PG8_STAGE_A(PG8_SA(0, 1), a2, 1, g2);
            PG8_WAIT_V(8); PG8_WAIT_L(0); PG8_BAR; PG8_MMA(0, 0, At, B0); PG8_MMA(0, 1, At, B1); PG8_BAR; PG8_SCHED;
            PG8_LDA(At, 1, 1); PG8_STAGE(PG8_SB(1, 0), b3, voffB); PG8_STAGE(PG8_SB(1, 1), b3 + hstep, voffB); PG8_STAGE_A(PG8_SA(1, 0), a3, 0, g2);
            PG8_WAIT_V(8); PG8_WAIT_L(0); PG8_BAR; PG8_MMA(1, 0, At, B0); PG8_MMA(1, 1, At, B1); PG8_BAR; PG8_SCHED;
        }
        if constexpr (ALIGN_EPI) { if (wr == 0) PG8_BAR; }
        E(acc, cur, wr, wc, fr, fq);
        if (!has_next) break;
#pragma unroll
        for (int a = 0; a < 2; ++a)
#pragma unroll
            for (int b = 0; b < 2; ++b)
#pragma unroll
                for (int m = 0; m < 4; ++m)
#pragma unroll
                    for (int n = 0; n < 2; ++n) acc[a][b][m][n] = (f32x4){0.f, 0.f, 0.f, 0.f};
        cur = nxt; cA = nA; cB = nB; ++ui;
        if constexpr (GATHER) {
#pragma unroll
        for (int h = 0; h < 2; ++h)
#pragma unroll
            for (int i = 0; i < 2; ++i) gc[h][i] = gn[h][i]; }
        if constexpr (ALIGN_EPI) { if (wr == 1) PG8_BAR; }
    }
    PG8_WAIT_V(0);
    if constexpr (!ALIGN_EPI) { if (wr == 0) PG8_BAR; }
    PG8_BAR;
#undef PG8_SA
#undef PG8_SB
#undef PG8_STAGE
#undef PG8_STAGE_A
#undef PG8_LDA
#undef PG8_LDB
#undef PG8_MMA
#undef PG8_WAIT_V
#undef PG8_WAIT_L
#undef PG8_BAR
#undef PG8_SCHED
}
}
typedef __attribute__((address_space(3))) unsigned char lds_u8;

__device__ __forceinline__ u32x4 pack8(const f32x4& a, const f32x4& b) { return (u32x4){pg8::cvt_pk_bf16(a.x, a.y), pg8::cvt_pk_bf16(a.z, a.w), pg8::cvt_pk_bf16(b.x, b.y), pg8::cvt_pk_bf16(b.z, b.w)}; }
struct EpiInM {
  static constexpr bool PERM = true;
  unsigned char* ws;
  __device__ __forceinline__ void operator()(const f32x4 (&acc)[2][2][4][2], const pg8::Unit& u, int wr, int wc, int fr, int fq) const {
    const float* cs = (const float*)(ws + WS_ROPE); const float* sn = cs + SEQ * 32;
    const int pn = u.pn;
#pragma unroll
    for (int ai = 0; ai < 2; ++ai)
#pragma unroll
      for (int m = 0; m < 4; ++m) {
        const int row = u.pm * 256 + ai * 128 + wr * 64 + m * 16 + fr, pos = row & (SEQ - 1);
#pragma unroll
        for (int bj = 0; bj < 2; ++bj) {
          const int w = bj * 128 + wc * 32 + 8 * fq;
          f32x4 v0 = acc[ai][bj][m][0], v1 = acc[ai][bj][m][1];
          const bool do_rope = (pn == 0) || (pn == 1 && bj == 0) || (pn == 2) || (pn == 3 && bj == 0 && wc < 2);
          if (do_rope) { const int d = (w & 63) >> 1; const f32x4 c4 = *(const f32x4*)(cs + pos * 32 + d), s4 = *(const f32x4*)(sn + pos * 32 + d);
            const f32x4 o0 = {v0.x * c4.x - v0.y * s4.x, v0.y * c4.x + v0.x * s4.x, v0.z * c4.y - v0.w * s4.y, v0.w * c4.y + v0.z * s4.y};
            const f32x4 o1 = {v1.x * c4.z - v1.y * s4.z, v1.y * c4.z + v1.x * s4.z, v1.z * c4.w - v1.w * s4.w, v1.w * c4.w + v1.z * s4.w};
            v0 = o0; v1 = o1; }
          if (pn == 0) { *(u32x4*)((bf16_t*)(ws + WS_QA) + (size_t)row * 384 + w) = pack8(v0 * QSCALE, v1 * QSCALE); }
          else if (pn == 1) { if (bj == 0) *(u32x4*)((bf16_t*)(ws + WS_QA) + (size_t)row * 384 + 256 + w) = pack8(v0 * QSCALE, v1 * QSCALE);
                              else *(u32x4*)((bf16_t*)(ws + WS_CKV) + (size_t)row * 128 + (w - 128)) = pack8(v0, v1); }
          else if (pn == 2) { *(u32x4*)((bf16_t*)(ws + WS_IQ) + (size_t)row * 256 + w) = pack8(v0, v1); }
          else if (pn == 3) { if (bj == 0) { if (wc < 2) *(u32x4*)((bf16_t*)(ws + WS_IK) + (size_t)row * 64 + w) = pack8(v0, v1);
                                             else if (wc == 2 && fq < 2) { if (fq == 0) v0 = v0 * 0.0625f; float* o = (float*)(ws + WS_SM) + (size_t)row * 16 + 8 * fq; *(f32x4*)o = v0; *(f32x4*)(o + 4) = v1; } } }
          else if (pn == 4) { *(u32x4*)((bf16_t*)(ws + WS_QC) + (size_t)row * 256 + w) = pack8(v0 * QSCALE, v1 * QSCALE); }
          else { *(u32x4*)((bf16_t*)(ws + WS_GB) + (size_t)row * 1536 + (pn - 5) * 256 + w) = pack8(v0, v1); }
        }
      }
  }
};
struct EpiMemKVM {
  static constexpr bool PERM = true;
  unsigned char* ws;
  __device__ __forceinline__ void operator()(const f32x4 (&acc)[2][2][4][2], const pg8::Unit& u, int wr, int wc, int fr, int fq) const {
#pragma unroll
    for (int ai = 0; ai < 2; ++ai)
#pragma unroll
      for (int m = 0; m < 4; ++m) {
        const int row = u.pm * 256 + ai * 128 + wr * 64 + m * 16 + fr;
#pragma unroll
        for (int bj = 0; bj < 2; ++bj) {
          const int w = bj * 128 + wc * 32 + 8 * fq; const f32x4 v0 = acc[ai][bj][m][0], v1 = acc[ai][bj][m][1];
          if (u.pn == 0) *(u32x4*)((bf16_t*)(ws + WS_MK) + (size_t)row * 256 + w) = pack8(v0, v1);
          else { const int mem = row & 255, xx = mem & 31, mpos = (mem & ~31) + 8 * ((xx >> 2) & 3) + (xx & 3) + 4 * (xx >> 4);
            bf16_t* o = (bf16_t*)(ws + WS_MVT) + ((size_t)(row >> 8) * 256 + w) * 256 + mpos;
            o[0] = f2bf(v0.x); o[256] = f2bf(v0.y); o[512] = f2bf(v0.z); o[768] = f2bf(v0.w); o[1024] = f2bf(v1.x); o[1280] = f2bf(v1.y); o[1536] = f2bf(v1.z); o[1792] = f2bf(v1.w); }
        }
      }
  }
};
struct EpiOutM {
  static constexpr bool PERM = true;
  const float* x; bf16_t* y;
  __device__ __forceinline__ void operator()(const f32x4 (&acc)[2][2][4][2], const pg8::Unit& u, int wr, int wc, int fr, int fq) const {
#pragma unroll
    for (int ai = 0; ai < 2; ++ai)
#pragma unroll
      for (int m = 0; m < 4; ++m) {
        const size_t rb = (size_t)(u.pm * 256 + ai * 128 + wr * 64 + m * 16 + fr) * 1024 + u.pn * 256 + wc * 32 + 8 * fq;
#pragma unroll
        for (int bj = 0; bj < 2; ++bj) { const size_t o = rb + bj * 128; const f32x4 x0 = *(const f32x4*)(x + o), x1 = *(const f32x4*)(x + o + 4);
          *(u32x4*)(y + o) = pack8(x0 * ALPHA + acc[ai][bj][m][0], x1 * ALPHA + acc[ai][bj][m][1]); }
      }
  }
};
struct MoeOrder {
  const int* offs; const int* cnts; int npn, G, c; const unsigned* LIST;
  __device__ __forceinline__ bool next(int i, pg8::Unit& u) const {
    const int L = i * G + c; const int ntiles = __builtin_amdgcn_readfirstlane(offs[64]) >> 8;
    if (L >= ntiles * npn) return false;
    const int rt = L / npn, pl = L - rt * npn; int e = 0;
    while (__builtin_amdgcn_readfirstlane(offs[e + 1]) <= rt * 256) ++e;
    u.pm = rt; u.mt = rt - (__builtin_amdgcn_readfirstlane(offs[e]) >> 8); u.e = e; u.pn = e * npn + pl; u.aux = __builtin_amdgcn_readfirstlane(cnts[e]); return true;
  }
  __device__ __forceinline__ unsigned arow(const pg8::Unit& u, int r) const { const int rank = u.mt * 256 + r; return rank < u.aux ? LIST[(size_t)u.e * 32768 + rank] : 0u; }
};
struct EpiMoeUpM {
  static constexpr bool PERM = true;
  bf16_t* H;
  __device__ __forceinline__ void operator()(const f32x4 (&acc)[2][2][4][2], const pg8::Unit& u, int wr, int wc, int fr, int fq) const {
    const int pl = u.pn & 1;
#pragma unroll
    for (int ai = 0; ai < 2; ++ai)
#pragma unroll
      for (int m = 0; m < 4; ++m) {
        const int rl = ai * 128 + wr * 64 + m * 16 + fr;
        if (u.mt * 256 + rl < u.aux) {
          f32x4 h0, h1; const f32x4 g0 = acc[ai][0][m][0], g1 = acc[ai][0][m][1], u0 = acc[ai][1][m][0], u1 = acc[ai][1][m][1];
          h0.x = silu_f(g0.x) * u0.x; h0.y = silu_f(g0.y) * u0.y; h0.z = silu_f(g0.z) * u0.z; h0.w = silu_f(g0.w) * u0.w;
          h1.x = silu_f(g1.x) * u1.x; h1.y = silu_f(g1.y) * u1.y; h1.z = silu_f(g1.z) * u1.z; h1.w = silu_f(g1.w) * u1.w;
          *(u32x4*)(H + (size_t)(u.pm * 256 + rl) * 256 + pl * 128 + wc * 32 + 8 * fq) = pack8(h0, h1);
        }
      }
  }
};
struct EpiMoeDownM {
  static constexpr bool PERM = true;
  bf16_t* Y; const float* GATEL;
  __device__ __forceinline__ void operator()(const f32x4 (&acc)[2][2][4][2], const pg8::Unit& u, int wr, int wc, int fr, int fq) const {
    const int pl = u.pn & 3;
    const float* gp = GATEL + (size_t)u.e * 32768; const int rk0 = u.mt * 256 + wr * 64 + fr;
    bf16_t* yp = Y + (size_t)(u.pm * 256 + wr * 64 + fr) * 1024 + pl * 256 + wc * 32 + 8 * fq;
#pragma unroll
    for (int ai = 0; ai < 2; ++ai)
#pragma unroll
      for (int m = 0; m < 4; ++m) {
        const int rk = rk0 + ai * 128 + m * 16; const float gt = gp[rk < 32767 ? rk : 32767];
#pragma unroll
        for (int bj = 0; bj < 2; ++bj)
          *(u32x4*)(yp + (size_t)(ai * 128 + m * 16) * 1024 + bj * 128) = pack8(acc[ai][bj][m][0] * gt, acc[ai][bj][m][1] * gt);
      }
  }
};

__device__ __forceinline__ void phase_inproj_mfma(const Ctx& c, lds_u8* lds) {
  unsigned char* ws = c.ws; const int tid = phase_tid();
  { pg8::Gemm g{(const bf16_t*)(ws + WS_XB), (const bf16_t*)(ws + WS_WIN), 1024}; pg8::StaticOrder S; S.init(T, NIN, gridDim.x, blockIdx.x); EpiInM E{ws};
    pg8::gemm_phase<EpiInM, pg8::StaticOrder, true, false>(lds, g, S, E, tid); }
  { pg8::Gemm g{(const bf16_t*)(ws + WS_MEMB), (const bf16_t*)(ws + WS_WMKV), 1024}; pg8::StaticOrder S; S.init(TM, 512, gridDim.x, (int)blockIdx.x - 128); EpiMemKVM E{ws};
    pg8::gemm_phase<EpiMemKVM, pg8::StaticOrder, true, false>(lds, g, S, E, tid); }
}
__device__ __forceinline__ void phase_outproj_mfma(const Ctx& c, lds_u8* lds) {
  unsigned char* ws = c.ws; const int tid = phase_tid();
  pg8::Gemm g{(const bf16_t*)(ws + WS_CAT), (const bf16_t*)(ws + WS_WO), 1024}; pg8::StaticOrder S; S.init(T, 1024, gridDim.x, blockIdx.x); EpiOutM E{c.in[0], (bf16_t*)(ws + WS_X1B)};
  pg8::gemm_phase<EpiOutM, pg8::StaticOrder, true, false>(lds, g, S, E, tid);
}
__device__ __forceinline__ void phase_moe_up_mfma(const Ctx& c, lds_u8* lds) {
  unsigned char* ws = c.ws; const int tid = phase_tid();
  int* offs = (int*)((unsigned char*)lds + pg8::STAGE_BYTES); int* cnts = offs + 65;
  expert_offsets(c, offs, cnts, tid);
  pg8::Gemm g{(const bf16_t*)(ws + WS_X1B), (const bf16_t*)(ws + WS_WGU), 1024};
  MoeOrder S{offs, cnts, 2, (int)gridDim.x, (int)blockIdx.x, (const unsigned*)(ws + WS_LIST)}; EpiMoeUpM E{(bf16_t*)(ws + WS_H)};
  pg8::gemm_phase<EpiMoeUpM, MoeOrder, true, true>(lds, g, S, E, tid);
}
__device__ __forceinline__ void phase_moe_down_mfma(const Ctx& c, lds_u8* lds) {
  unsigned char* ws = c.ws; const int tid = phase_tid();
  int* offs = (int*)((unsigned char*)lds + pg8::STAGE_BYTES); int* cnts = offs + 65;
  expert_offsets(c, offs, cnts, tid);
  pg8::Gemm g{(const bf16_t*)(ws + WS_H), (const bf16_t*)(ws + WS_WD), 256};
  MoeOrder S{offs, cnts, 4, (int)gridDim.x, (int)blockIdx.x, nullptr}; EpiMoeDownM E{(bf16_t*)(ws + WS_Y), (const float*)(ws + WS_GATEL)};
  pg8::gemm_phase<EpiMoeDownM, MoeOrder, true, false>(lds, g, S, E, tid);
}

__device__ void phase_kvup(const Ctx& c, float* lds) {
  unsigned char* ws = c.ws;
  const int tid = phase_tid(), lane = tid & 63, wave = tid >> 6, fr = lane & 15, fq = lane >> 4;
  const bf16_t* W = (const bf16_t*)(ws + WS_WKV);
  const bf16_t* CKV = (const bf16_t*)(ws + WS_CKV); bf16_t* KVA = (bf16_t*)(ws + WS_KVA);
  const float* cs = (const float*)(ws + WS_ROPE); const float* sn = cs + SEQ * 32;
  for (int tile = blockIdx.x * NWAVES + wave; tile < T / 16; tile += gridDim.x * NWAVES) {
    const int t = tile * 16 + fr, pos = t & (SEQ - 1);
    pg8::bf16x8 bx[4]; float ss = 0.f;
#pragma unroll
    for (int ks = 0; ks < 4; ++ks) { const u32x4 v = *(const u32x4*)(CKV + (size_t)t * 128 + ks * 32 + fq * 8); bx[ks] = __builtin_bit_cast(pg8::bf16x8, v);
      const float f[8] = {__uint_as_float(v.x << 16), __uint_as_float(v.x & 0xffff0000u), __uint_as_float(v.y << 16), __uint_as_float(v.y & 0xffff0000u), __uint_as_float(v.z << 16), __uint_as_float(v.z & 0xffff0000u), __uint_as_float(v.w << 16), __uint_as_float(v.w & 0xffff0000u)};
#pragma unroll
      for (int e = 0; e < 8; ++e) ss += f[e] * f[e]; }
    ss += __shfl_xor(ss, 16); ss += __shfl_xor(ss, 32);
    const float rstd = rsqrtf(ss * (1.f / 128.f) + 1e-6f);
#pragma unroll
    for (int nt = 0; nt < 8; ++nt) { f32x4 d = {0.f, 0.f, 0.f, 0.f};
#pragma unroll
      for (int ks = 0; ks < 4; ++ks) d = __builtin_amdgcn_mfma_f32_16x16x32_bf16(*(const pg8::bf16x8*)(W + (size_t)(nt * 16 + fr) * 128 + ks * 32 + fq * 8), bx[ks], d, 0, 0, 0);
      d = d * rstd;
      const int p0 = nt * 16 + fq * 4;
      if (nt < 4) { const int dd = p0 >> 1; const float c0 = cs[pos * 32 + dd], s0 = sn[pos * 32 + dd], c1 = cs[pos * 32 + dd + 1], s1 = sn[pos * 32 + dd + 1];
        const f32x4 o = {d.x * c0 - d.y * s0, d.y * c0 + d.x * s0, d.z * c1 - d.w * s1, d.w * c1 + d.z * s1}; d = o; }
      *(u32x2*)(KVA + (size_t)t * 128 + p0) = (u32x2){pg8::cvt_pk_bf16(d.x, d.y), pg8::cvt_pk_bf16(d.z, d.w)}; }
  }
}


typedef _Float16 h16x2 __attribute__((ext_vector_type(2)));
constexpr int TK_KP = 4104;
constexpr int TK_KEYS = 0, TK_H1 = 16 * TK_KP * 2, TK_H2 = TK_H1 + 16 * 128 * 4, TK_MISC = TK_H2 + 8 * 128 * 4;
__device__ __forceinline__ unsigned mono16x2(unsigned u) { const unsigned m = ((u >> 15) & 0x00010001u) * 0xffffu; return u ^ (m | 0x80008000u); }
__device__ __forceinline__ int wave_incl_scan(int x) {
  x += __builtin_amdgcn_update_dpp(0, x, 0x111, 0xF, 0xF, true);
  x += __builtin_amdgcn_update_dpp(0, x, 0x112, 0xF, 0xF, true);
  x += __builtin_amdgcn_update_dpp(0, x, 0x114, 0xF, 0xF, true);
  x += __builtin_amdgcn_update_dpp(0, x, 0x118, 0xF, 0xF, true);
  x += __builtin_amdgcn_update_dpp(0, x, 0x142, 0xA, 0xF, false);
  x += __builtin_amdgcn_update_dpp(0, x, 0x143, 0xC, 0xF, false);
  return x;
}

__device__ __forceinline__ void hist_find(const unsigned* hw, int need, int lane, int& B, int& above) {
  const unsigned w0 = hw[127 - 2 * lane], w1 = hw[126 - 2 * lane];
  const int c0 = (int)(w0 >> 16), c1 = (int)(w0 & 0xffffu), c2 = (int)(w1 >> 16), c3 = (int)(w1 & 0xffffu);
  const int tl = c0 + c1 + c2 + c3;
  const int incl = wave_incl_scan(tl);
  const int excl = incl - tl;
  const bool hit = (excl < need) && (incl >= need);
  int b = 0, ab = 0;
  if (hit) { int a = excl; b = 255 - 4 * lane; ab = a;
    if (a + c0 < need) { a += c0; b = 254 - 4 * lane; ab = a; if (a + c1 < need) { a += c1; b = 253 - 4 * lane; ab = a; if (a + c2 < need) { a += c2; b = 252 - 4 * lane; ab = a; } } } }
  const unsigned long long m = __ballot(hit);
  const int src = __builtin_amdgcn_readfirstlane(m ? (__ffsll((long long)m) - 1) : 0);
  B = __builtin_amdgcn_readlane(b, src); above = __builtin_amdgcn_readlane(ab, src);
}
__device__ void phase_topk_mfma(const Ctx& c, unsigned char* ldsb, unsigned* qhead) {
  unsigned char* ws = c.ws;
  const int tid = phase_tid(), lane = tid & 63, wave = tid >> 6, fr = lane & 15, fq = lane >> 4;
  unsigned short* keys = (unsigned short*)(ldsb + TK_KEYS);
  unsigned* h1 = (unsigned*)(ldsb + TK_H1); unsigned* h2 = (unsigned*)(ldsb + TK_H2) + wave * 128; int* misc = (int*)(ldsb + TK_MISC);
  const bf16_t* IQ = (const bf16_t*)(ws + WS_IQ); const bf16_t* IK = (const bf16_t*)(ws + WS_IK); const float* SM = (const float*)(ws + WS_SM);
  unsigned short* SEL = (unsigned short*)(ws + WS_SEL);
  WorkQ wq; wq_init(wq, qhead, misc, tid);
  for (;;) {
    const int item = wq_next(wq, tid);
    if (item >= 240 * 8) break;
    const int b = item & 7, qb = 255 - (item >> 3), s0 = qb * 16;
    for (int i = tid; i < 16 * 128; i += NTHREADS) h1[i] = 0u;
    const size_t qrow = (size_t)b * SEQ + s0 + fr;
    pg8::bf16x8 bq[4][2];
#pragma unroll
    for (int hh = 0; hh < 4; ++hh)
#pragma unroll
      for (int ks = 0; ks < 2; ++ks) bq[hh][ks] = *(const pg8::bf16x8*)(IQ + qrow * 256 + hh * 64 + ks * 32 + fq * 8);
    const f32x4 iw = *(const f32x4*)(SM + qrow * 16);
    const int nkt = qb + 1, slim = s0 + fr;
    __syncthreads();
    pg8::bf16x8 a0n = {0, 0, 0, 0, 0, 0, 0, 0}, a1n = a0n;
    if (wave < nkt) { const bf16_t* kr = IK + ((size_t)b * SEQ + wave * 16 + fr) * 64 + fq * 8; a0n = *(const pg8::bf16x8*)kr; a1n = *(const pg8::bf16x8*)(kr + 32); }
    for (int kt = wave; kt < nkt; kt += NWAVES) {
      const pg8::bf16x8 a0 = a0n, a1 = a1n;
      if (kt + NWAVES < nkt) { const bf16_t* kr = IK + ((size_t)b * SEQ + (kt + NWAVES) * 16 + fr) * 64 + fq * 8; a0n = *(const pg8::bf16x8*)kr; a1n = *(const pg8::bf16x8*)(kr + 32); }
      f32x4 sc = {0.f, 0.f, 0.f, 0.f};
#pragma unroll
      for (int hh = 0; hh < 4; ++hh) { f32x4 d = {0.f, 0.f, 0.f, 0.f};
        d = __builtin_amdgcn_mfma_f32_16x16x32_bf16(a0, bq[hh][0], d, 0, 0, 0); d = __builtin_amdgcn_mfma_f32_16x16x32_bf16(a1, bq[hh][1], d, 0, 0, 0);
        const float w = hh == 0 ? iw.x : hh == 1 ? iw.y : hh == 2 ? iw.z : iw.w;
        sc.x = fmaf(w, fmaxf(d.x, 0.f), sc.x); sc.y = fmaf(w, fmaxf(d.y, 0.f), sc.y); sc.z = fmaf(w, fmaxf(d.z, 0.f), sc.z); sc.w = fmaf(w, fmaxf(d.w, 0.f), sc.w); }
      unsigned k01 = mono16x2(__builtin_bit_cast(unsigned, __builtin_amdgcn_cvt_pkrtz(sc.x, sc.y))), k23 = mono16x2(__builtin_bit_cast(unsigned, __builtin_amdgcn_cvt_pkrtz(sc.z, sc.w)));
      const int kbase = kt * 16 + fq * 4;
      unsigned* hq = h1 + fr * 128;
      if (kt + 1 < nkt) {
        *(u32x2*)(keys + fr * TK_KP + kbase) = (u32x2){k01, k23};
        { const unsigned kk = k01 & 0xffffu; atomicAdd(hq + (kk >> 9), 1u << ((kk >> 4) & 16)); }
        { const unsigned kk = k01 >> 16; atomicAdd(hq + (kk >> 9), 1u << ((kk >> 4) & 16)); }
        { const unsigned kk = k23 & 0xffffu; atomicAdd(hq + (kk >> 9), 1u << ((kk >> 4) & 16)); }
        { const unsigned kk = k23 >> 16; atomicAdd(hq + (kk >> 9), 1u << ((kk >> 4) & 16)); }
      } else {
        if (kbase + 0 > slim) k01 &= 0xffff0000u; if (kbase + 1 > slim) k01 &= 0x0000ffffu;
        if (kbase + 2 > slim) k23 &= 0xffff0000u; if (kbase + 3 > slim) k23 &= 0x0000ffffu;
        *(u32x2*)(keys + fr * TK_KP + kbase) = (u32x2){k01, k23};
        if (kbase + 0 <= slim) { const unsigned kk = k01 & 0xffffu; atomicAdd(hq + (kk >> 9), 1u << ((kk >> 4) & 16)); }
        if (kbase + 1 <= slim) { const unsigned kk = k01 >> 16; atomicAdd(hq + (kk >> 9), 1u << ((kk >> 4) & 16)); }
        if (kbase + 2 <= slim) { const unsigned kk = k23 & 0xffffu; atomicAdd(hq + (kk >> 9), 1u << ((kk >> 4) & 16)); }
        if (kbase + 3 <= slim) { const unsigned kk = k23 >> 16; atomicAdd(hq + (kk >> 9), 1u << ((kk >> 4) & 16)); }
      }
    }
    __syncthreads();
    for (int qi = 0; qi < 2; ++qi) {
      const int q = wave * 2 + qi, s = s0 + q, n = s + 1;
      int B1, above1; hist_find(h1 + q * 128, 256, lane, B1, above1);
      const int need1 = 256 - above1;
      h2[lane] = 0u; h2[64 + lane] = 0u;
      const unsigned short* kq = keys + q * TK_KP;
      const int niter = (n + 511) >> 9;
      for (int it = 0; it < niter; ++it) {
        const int i0 = (it * 64 + lane) * 8; const u32x4 kv = *(const u32x4*)(kq + i0);
        const unsigned k8[8] = {kv.x & 0xffffu, kv.x >> 16, kv.y & 0xffffu, kv.y >> 16, kv.z & 0xffffu, kv.z >> 16, kv.w & 0xffffu, kv.w >> 16};
#pragma unroll
        for (int e = 0; e < 8; ++e) if (i0 + e < n && (int)(k8[e] >> 8) == B1) atomicAdd(h2 + ((k8[e] & 255u) >> 1), 1u << ((k8[e] & 1u) * 16));
      }
      int B2, above2; hist_find(h2, need1, lane, B2, above2);
      const unsigned thr = (unsigned)((B1 << 8) | B2); const int need = need1 - above2;
      unsigned short* dummy = (unsigned short*)(misc + 8 + wave);
      unsigned short* sel = (unsigned short*)h2;
      asm volatile("s_waitcnt lgkmcnt(0)" ::: "memory");
      int tiebase = 0, outbase = 0;
      for (int it = 0; it < niter; ++it) {
        const int i0 = (it * 64 + lane) * 8; const u32x4 kv = *(const u32x4*)(kq + i0);
        const unsigned k8[8] = {kv.x & 0xffffu, kv.x >> 16, kv.y & 0xffffu, kv.y >> 16, kv.z & 0xffffu, kv.z >> 16, kv.w & 0xffffu, kv.w >> 16};
        int cg = 0, ce = 0;
#pragma unroll
        for (int e = 0; e < 8; ++e) { const bool v = i0 + e < n; cg += (v && k8[e] > thr) ? 1 : 0; ce += (v && k8[e] == thr) ? 1 : 0; }
        int tk = 0;
        if (__ballot(ce != 0)) {
          const int eincl = wave_incl_scan(ce); const int eg = tiebase + eincl - ce;
          tk = need - eg; tk = tk < 0 ? 0 : (tk > ce ? ce : tk);
          tiebase += __builtin_amdgcn_readlane(eincl, 63);
        }
        const int oc = cg + tk; const int oincl = wave_incl_scan(oc);
        int pos = outbase + oincl - oc; int tleft = tk;
#pragma unroll
        for (int e = 0; e < 8; ++e) { const bool v = i0 + e < n; const bool tie = v && k8[e] == thr && tleft > 0; const bool take = (v && k8[e] > thr) || tie;
          tleft -= tie ? 1 : 0;
          unsigned short* dst = (take && pos < 256) ? sel + pos : dummy;
          *dst = (unsigned short)(i0 + e); pos += take ? 1 : 0; }
        outbase += __builtin_amdgcn_readlane(oincl, 63);
      }
      asm volatile("s_waitcnt lgkmcnt(0)" ::: "memory");
      *(u32x2*)(SEL + ((size_t)b * SEQ + s) * 256 + lane * 4) = *(const u32x2*)(sel + lane * 4);
      asm volatile("s_waitcnt lgkmcnt(0)" ::: "memory");
    }
  }
}

typedef short s16x4 __attribute__((ext_vector_type(4)));
__device__ __forceinline__ s16x4 lds_tr16(const unsigned char* p) { return __builtin_bit_cast(s16x4, __builtin_amdgcn_ds_read_tr16_b64_v4i16((__attribute__((address_space(3))) s16x4*)(__attribute__((address_space(3))) unsigned char*)p)); }
typedef float f32x2_t __attribute__((ext_vector_type(2))); typedef __bf16 bf16x2_t __attribute__((ext_vector_type(2)));
__device__ __forceinline__ unsigned cvtpk_c(float lo, float hi) { const f32x2_t v = {lo, hi}; const bf16x2_t b = __builtin_convertvector(v, bf16x2_t); return __builtin_bit_cast(unsigned, b); }
__device__ __forceinline__ pg8::bf16x8 packp(const f32x4& a, const f32x4& b) {
  const u32x4 w = {cvtpk_c(a.x, a.y), cvtpk_c(a.z, a.w), cvtpk_c(b.x, b.y), cvtpk_c(b.z, b.w)}; return __builtin_bit_cast(pg8::bf16x8, w); }
constexpr int AT_WB = 9216 + 512;
__device__ void phase_attn_sparse(const Ctx& c, unsigned char* ldsb, unsigned* qhead) {
  unsigned char* ws = c.ws;
  const int tid = phase_tid(), lane = tid & 63, wave = tid >> 6, fr = lane & 15, fq = lane >> 4;
  unsigned char* vl = ldsb + wave * AT_WB; unsigned short* sl = (unsigned short*)(vl + 9216);
  const bf16_t* QA = (const bf16_t*)(ws + WS_QA); const bf16_t* KVA = (const bf16_t*)(ws + WS_KVA); const unsigned short* SEL = (const unsigned short*)(ws + WS_SEL);
  const bf16_t* QC = (const bf16_t*)(ws + WS_QC); const bf16_t* MK = (const bf16_t*)(ws + WS_MK); const bf16_t* MVT = (const bf16_t*)(ws + WS_MVT);
  bf16_t* CAT = (bf16_t*)(ws + WS_CAT);
  const float* gA = c.in[10]; const float* gC = c.in[11];
  const pg8::bf16x8 zero8 = {0, 0, 0, 0, 0, 0, 0, 0};
  __syncthreads();
  int* aq_slot = (int*)(ldsb + 8 * AT_WB);
  WorkQ wq; wq_init(wq, qhead, aq_slot, tid);
  for (;;) {
  const int item = wq_next(wq, tid);
  if (item >= 512) break;
  for (int tj = 0; tj < 8; ++tj) {
    const int t = item * 64 + wave * 8 + tj;
    const int b = t >> 12, s = t & (SEQ - 1), n = s + 1 < 256 ? s + 1 : 256;
    { u32x2 v;
      if (s >= 256) v = *(const u32x2*)(SEL + (size_t)t * 256 + lane * 4);
      else { const int i0 = lane * 4; const unsigned e0 = i0 < n ? i0 : 0, e1 = i0 + 1 < n ? i0 + 1 : 0, e2 = i0 + 2 < n ? i0 + 2 : 0, e3 = i0 + 3 < n ? i0 + 3 : 0; v = (u32x2){e0 | (e1 << 16), e2 | (e3 << 16)}; }
      *(u32x2*)(sl + lane * 4) = v; }
    asm volatile("s_waitcnt lgkmcnt(0)" ::: "memory");
    pg8::bf16x8 bq0 = zero8, bq1 = zero8;
    if (fr < 6) { const bf16_t* qp = QA + (size_t)t * 384 + fr * 64 + fq * 8; bq0 = *(const pg8::bf16x8*)qp; bq1 = *(const pg8::bf16x8*)(qp + 32); }
    const bf16_t* kvb = KVA + (size_t)b * SEQ * 128;
    f32x4 st[16];
#pragma unroll
    for (int kt = 0; kt < 16; ++kt) { const int key = sl[kt * 16 + fr]; const bf16_t* kr = kvb + (size_t)key * 128 + fq * 8;
      const pg8::bf16x8 a0 = *(const pg8::bf16x8*)kr, a1 = *(const pg8::bf16x8*)(kr + 32);
      f32x4 d = {0.f, 0.f, 0.f, 0.f};
      d = __builtin_amdgcn_mfma_f32_16x16x32_bf16(a0, bq0, d, 0, 0, 0); st[kt] = __builtin_amdgcn_mfma_f32_16x16x32_bf16(a1, bq1, d, 0, 0, 0); }
    float mx = -3.0e38f;
    if (n < 256) {
#pragma unroll
      for (int kt = 0; kt < 16; ++kt) { const int sb = kt * 16 + fq * 4;
        if (sb + 0 >= n) st[kt].x = -3.0e38f; if (sb + 1 >= n) st[kt].y = -3.0e38f; if (sb + 2 >= n) st[kt].z = -3.0e38f; if (sb + 3 >= n) st[kt].w = -3.0e38f; } }
#pragma unroll
    for (int kt = 0; kt < 16; ++kt) mx = fmaxf(fmaxf(fmaxf(mx, st[kt].x), fmaxf(st[kt].y, st[kt].z)), st[kt].w);
    mx = fmaxf(mx, __shfl_xor(mx, 16)); mx = fmaxf(mx, __shfl_xor(mx, 32));
    float l = 0.f;
#pragma unroll
    for (int kt = 0; kt < 16; ++kt) { st[kt].x = __builtin_amdgcn_exp2f(st[kt].x - mx); st[kt].y = __builtin_amdgcn_exp2f(st[kt].y - mx); st[kt].z = __builtin_amdgcn_exp2f(st[kt].z - mx); st[kt].w = __builtin_amdgcn_exp2f(st[kt].w - mx);
      l += (st[kt].x + st[kt].y) + (st[kt].z + st[kt].w); }
    l += __shfl_xor(l, 16); l += __shfl_xor(l, 32);
    f32x4 ot[4];
#pragma unroll
    for (int mt = 0; mt < 4; ++mt) ot[mt] = (f32x4){0.f, 0.f, 0.f, 0.f};
    u32x4 vv[8];
#pragma unroll
    for (int i = 0; i < 8; ++i) { const int key = sl[i * 8 + (lane >> 3)]; vv[i] = *(const u32x4*)(kvb + (size_t)key * 128 + 64 + (lane & 7) * 8); }
#pragma unroll
    for (int ch = 0; ch < 4; ++ch) {
#pragma unroll
      for (int i = 0; i < 8; ++i) *(u32x4*)(vl + (i * 8 + (lane >> 3)) * 144 + (lane & 7) * 16) = vv[i];
      if (ch < 3) {
#pragma unroll
        for (int i = 0; i < 8; ++i) { const int key = sl[(ch + 1) * 64 + i * 8 + (lane >> 3)]; vv[i] = *(const u32x4*)(kvb + (size_t)key * 128 + 64 + (lane & 7) * 8); } }
      asm volatile("s_waitcnt lgkmcnt(0)" ::: "memory");
#pragma unroll
      for (int k2 = 0; k2 < 2; ++k2) { const int kk = ch * 2 + k2; const pg8::bf16x8 pf = packp(st[2 * kk], st[2 * kk + 1]);
        const unsigned char* base = vl + (k2 * 32 + fq * 4 + (fr >> 2)) * 144 + (fr & 3) * 8;
#pragma unroll
        for (int mt = 0; mt < 4; ++mt) { const s16x4 lo = lds_tr16(base + mt * 32), hi = lds_tr16(base + 16 * 144 + mt * 32);
          const pg8::bf16x8 af = {lo[0], lo[1], lo[2], lo[3], hi[0], hi[1], hi[2], hi[3]};
          ot[mt] = __builtin_amdgcn_mfma_f32_16x16x32_bf16(af, pf, ot[mt], 0, 0, 0); } }
      asm volatile("s_waitcnt lgkmcnt(0)" ::: "memory");
    }
    const float il = __builtin_amdgcn_rcpf(l); float ss = 0.f;
#pragma unroll
    for (int mt = 0; mt < 4; ++mt) { ot[mt] = ot[mt] * il; ss += (ot[mt].x * ot[mt].x + ot[mt].y * ot[mt].y) + (ot[mt].z * ot[mt].z + ot[mt].w * ot[mt].w); }
    if (fr >= 6) ss = 0.f;
#pragma unroll
    for (int o = 1; o < 64; o <<= 1) ss += __shfl_xor(ss, o);
    const float rstd = rsqrtf(ss * (1.f / 384.f) + 1e-6f);
    if (fr < 6) {
#pragma unroll
      for (int mt = 0; mt < 4; ++mt) { const int col = fr * 64 + mt * 16 + fq * 4; const f32x4 g = *(const f32x4*)(gA + col); const f32x4 o = ot[mt] * rstd * g;
        *(u32x2*)(CAT + (size_t)t * 1024 + col) = (u32x2){pg8::cvt_pk_bf16(o.x, o.y), pg8::cvt_pk_bf16(o.z, o.w)}; } }
  }
  }
}

__device__ void phase_attn_mem(const Ctx& c, unsigned char* ldsb, unsigned* qhead) {
  unsigned char* ws = c.ws;
  const int tid = phase_tid(), lane = tid & 63, wave = tid >> 6, fr = lane & 15, fq = lane >> 4;
  unsigned char* vl = ldsb + wave * AT_WB; unsigned short* sl = (unsigned short*)(vl + 9216);
  const bf16_t* QA = (const bf16_t*)(ws + WS_QA); const bf16_t* KVA = (const bf16_t*)(ws + WS_KVA); const unsigned short* SEL = (const unsigned short*)(ws + WS_SEL);
  const bf16_t* QC = (const bf16_t*)(ws + WS_QC); const bf16_t* MK = (const bf16_t*)(ws + WS_MK); const bf16_t* MVT = (const bf16_t*)(ws + WS_MVT);
  bf16_t* CAT = (bf16_t*)(ws + WS_CAT);
  const float* gA = c.in[10]; const float* gC = c.in[11];
  const pg8::bf16x8 zero8 = {0, 0, 0, 0, 0, 0, 0, 0};
  int* aq_slot = (int*)(ldsb + 70656 + 8 * 8192);
  WorkQ wq; wq_init(wq, qhead, aq_slot, tid);
  for (;;) {
  const int item = wq_next(wq, tid) + 512;
  if (item >= 768) break;
  {
    const int t0 = (item - 512) * 128 + wave * 16, b = t0 >> 12;
    unsigned char* mkl = ldsb; unsigned char* mvl = ldsb + 36864; unsigned char* ocl = ldsb + 70656 + wave * 8192;
    float ss = 0.f;
#pragma unroll 1
    for (int h = 0; h < 4; ++h) {
      __syncthreads();
#pragma unroll
      for (int i = 0; i < 4; ++i) { const int p = tid + 512 * i, row = p >> 3, cc = p & 7;
        *(u32x4*)(mkl + row * 144 + cc * 16) = *(const u32x4*)(MK + ((size_t)(b * 256 + row)) * 256 + h * 64 + cc * 8); }
#pragma unroll
      for (int i = 0; i < 4; ++i) { const int p = tid + 512 * i, row = p >> 5, cc = p & 31;
        *(u32x4*)(mvl + row * 528 + cc * 16) = *(const u32x4*)(MVT + ((size_t)(b * 256 + h * 64 + row)) * 256 + cc * 8); }
      __syncthreads();
      f32x4 oc[4];
      const bf16_t* qp = QC + (size_t)(t0 + fr) * 256 + h * 64 + fq * 8;
      const pg8::bf16x8 bq0 = *(const pg8::bf16x8*)qp, bq1 = *(const pg8::bf16x8*)(qp + 32);
      f32x4 st[16];
#pragma unroll
      for (int kt = 0; kt < 16; ++kt) { const unsigned char* kr = mkl + (kt * 16 + fr) * 144 + fq * 16;
        const pg8::bf16x8 a0 = *(const pg8::bf16x8*)kr, a1 = *(const pg8::bf16x8*)(kr + 64);
        f32x4 d = {0.f, 0.f, 0.f, 0.f};
        d = __builtin_amdgcn_mfma_f32_16x16x32_bf16(a0, bq0, d, 0, 0, 0); st[kt] = __builtin_amdgcn_mfma_f32_16x16x32_bf16(a1, bq1, d, 0, 0, 0); }
      float mx = -3.0e38f;
#pragma unroll
      for (int kt = 0; kt < 16; ++kt) mx = fmaxf(fmaxf(fmaxf(mx, st[kt].x), fmaxf(st[kt].y, st[kt].z)), st[kt].w);
      mx = fmaxf(mx, __shfl_xor(mx, 16)); mx = fmaxf(mx, __shfl_xor(mx, 32));
      float l = 0.f;
#pragma unroll
      for (int kt = 0; kt < 16; ++kt) { st[kt].x = __builtin_amdgcn_exp2f(st[kt].x - mx); st[kt].y = __builtin_amdgcn_exp2f(st[kt].y - mx); st[kt].z = __builtin_amdgcn_exp2f(st[kt].z - mx); st[kt].w = __builtin_amdgcn_exp2f(st[kt].w - mx);
        l += (st[kt].x + st[kt].y) + (st[kt].z + st[kt].w); }
      l += __shfl_xor(l, 16); l += __shfl_xor(l, 32);
#pragma unroll
      for (int mt = 0; mt < 4; ++mt) oc[mt] = (f32x4){0.f, 0.f, 0.f, 0.f};
#pragma unroll
      for (int kk = 0; kk < 8; ++kk) { const pg8::bf16x8 pf = packp(st[2 * kk], st[2 * kk + 1]);
#pragma unroll
        for (int mt = 0; mt < 4; ++mt) { const pg8::bf16x8 af = *(const pg8::bf16x8*)(mvl + (mt * 16 + fr) * 528 + (kk * 4 + fq) * 16);
          oc[mt] = __builtin_amdgcn_mfma_f32_16x16x32_bf16(af, pf, oc[mt], 0, 0, 0); } }
      const float il = __builtin_amdgcn_rcpf(l);
#pragma unroll
      for (int mt = 0; mt < 4; ++mt) { const f32x4 o = oc[mt] * il; ss += (o.x * o.x + o.y * o.y) + (o.z * o.z + o.w * o.w); *(u32x2*)(ocl + ((h * 4 + mt) * 64 + lane) * 8) = (u32x2){pg8::cvt_pk_bf16(o.x, o.y), pg8::cvt_pk_bf16(o.z, o.w)}; }
    }
    ss += __shfl_xor(ss, 16); ss += __shfl_xor(ss, 32);
    const float rstd = rsqrtf(ss * (1.f / 256.f) + 1e-6f);
#pragma unroll 1
    for (int h = 0; h < 4; ++h)
#pragma unroll
      for (int mt = 0; mt < 4; ++mt) { const int col = h * 64 + mt * 16 + fq * 4; const f32x4 g = *(const f32x4*)(gC + col); const u32x2 pp = *(const u32x2*)(ocl + ((h * 4 + mt) * 64 + lane) * 8);
        const f32x4 ov = {__uint_as_float(pp.x << 16), __uint_as_float(pp.x & 0xffff0000u), __uint_as_float(pp.y << 16), __uint_as_float(pp.y & 0xffff0000u)}; const f32x4 o = ov * rstd * g;
        *(u32x2*)(CAT + (size_t)(t0 + fr) * 1024 + 768 + col) = (u32x2){pg8::cvt_pk_bf16(o.x, o.y), pg8::cvt_pk_bf16(o.z, o.w)}; }
  }
  }
}

constexpr int GD_ITEM = 41088;
__device__ __forceinline__ unsigned char* gd_item(unsigned char* ws, int it) { return it < 1536 ? ws + WS_XB + (size_t)it * GD_ITEM : ws + WS_X1B + (size_t)(it - 1536) * GD_ITEM; }
__device__ __forceinline__ int kperm(int x) { return (x & 32) | (((x >> 2) & 3) << 3) | (x & 3) | (((x >> 4) & 1) << 2); }
constexpr int GP_KB = 0, GP_KBB = 9216, GP_QB = 18432, GP_VBT = 27648, GP_KBET = 36864, GP_XR = 46080  , GP_PR = 82944  , GP_OUT = 101376, GP_SC = 142336;
__device__ __forceinline__ pg8::bf16x8 ldsfrag(const unsigned char* base, int row, int ks, int fq) { return *(const pg8::bf16x8*)(base + row * 144 + ks * 64 + fq * 16); }
constexpr int G2_KB = 0, G2_KBB = 9216, G2_QB = 18432, G2_XR0 = 27648, G2_XT0 = 36864, G2_PR0 = 46080, G2_VBT = 55296, G2_KBET = 64512, G2_SC = 73728, G2_CW = 75264, G2_HALF = 78336;
__device__ void phase_gdn_prep2(const Ctx& c, unsigned char* Lb) {
  unsigned char* ws = c.ws;
  const int tid = phase_tid(), lane = tid & 63, wave = tid >> 6, fr = lane & 15, fq = lane >> 4;
  const int hb = wave >> 2, w4 = wave & 3, htid = tid & 255;
  unsigned char* L = Lb + hb * G2_HALF;
  const bf16_t* GB = (const bf16_t*)(ws + WS_GB); const float* SM = (const float*)(ws + WS_SM);
  const float* convw = c.in[6];
  float* sc = (float*)(L + G2_SC);
  float* cw = (float*)(L + G2_CW);
  const int tt = htid >> 2, part = htid & 3;
  for (int it2 = blockIdx.x; it2 < 1536; it2 += gridDim.x) {
    const int it = it2 * 2 + hb;
    const int n = it & 63, bh = it >> 6, b = bh / 6, h = bh % 6;
    const int t = n * 64 + tt; const size_t r = (size_t)b * SEQ + t;
    unsigned char* gb = gd_item(ws, it);
    __syncthreads();
    for (int i = htid; i < 768; i += 256) { const int j = i / 192, rr = i % 192; cw[i] = convw[j * 1152 + (rr >> 6) * 384 + h * 64 + (rr & 63)]; }
    if (part == 0) { const float a = SM[r * 16 + 4 + h], bb = SM[r * 16 + 10 + h]; const float xs = a + c.in[8][h]; const float sp = xs > 20.f ? xs : log1pf(__expf(xs));
      sc[tt] = -__expf(c.in[7][h]) * sp; sc[192 + tt] = 1.f / (1.f + __expf(-bb)); }
    __syncthreads();
    if (w4 == 0) { float v = sc[lane];
#pragma unroll
      for (int o = 1; o < 64; o <<= 1) { const float u = __shfl_up(v, o); if (lane >= o) v += u; }
      const float last = __shfl(v, 63);
      sc[64 + lane] = v; sc[128 + lane] = __expf(v); sc[256 + lane] = __expf(last - v); if (lane == 0) { sc[320] = __expf(last); *(float*)(gb + 40960) = __expf(last); } }
    float qv[16], kv[16], vv[16];
#pragma unroll
    for (int role = 0; role < 3; ++role) {
      float acc[16];
#pragma unroll
      for (int e = 0; e < 16; ++e) acc[e] = 0.f;
      u32x4 xr[4][2];
#pragma unroll
      for (int j = 0; j < 4; ++j) { const bool ok = t - 3 + j >= 0; const bf16_t* xp = GB + (r - 3 + j) * 1536 + role * 384 + h * 64 + part * 16;
        xr[j][0] = ok ? *(const u32x4*)xp : (u32x4){0u, 0u, 0u, 0u}; xr[j][1] = ok ? *(const u32x4*)(xp + 8) : (u32x4){0u, 0u, 0u, 0u}; }
#pragma unroll
      for (int j = 0; j < 4; ++j)
#pragma unroll
        for (int hh = 0; hh < 2; ++hh) { const u32x4 xvv = xr[j][hh]; const float* wj = cw + j * 192 + role * 64 + part * 16 + hh * 8;
          const f32x4 w0 = *(const f32x4*)wj, w1 = *(const f32x4*)(wj + 4);
          acc[hh * 8 + 0] += w0.x * __uint_as_float(xvv.x << 16); acc[hh * 8 + 1] += w0.y * __uint_as_float(xvv.x & 0xffff0000u); acc[hh * 8 + 2] += w0.z * __uint_as_float(xvv.y << 16); acc[hh * 8 + 3] += w0.w * __uint_as_float(xvv.y & 0xffff0000u);
          acc[hh * 8 + 4] += w1.x * __uint_as_float(xvv.z << 16); acc[hh * 8 + 5] += w1.y * __uint_as_float(xvv.z & 0xffff0000u); acc[hh * 8 + 6] += w1.z * __uint_as_float(xvv.w << 16); acc[hh * 8 + 7] += w1.w * __uint_as_float(xvv.w & 0xffff0000u); }
      float ss = 0.f;
#pragma unroll
      for (int e = 0; e < 16; ++e) { acc[e] = silu_f(acc[e]); ss += acc[e] * acc[e]; }
      if (role < 2) { ss += __shfl_xor(ss, 1); ss += __shfl_xor(ss, 2); const float scl = rsqrtf(ss + 1e-6f) * (role == 0 ? 0.125f : 1.f);
#pragma unroll
        for (int e = 0; e < 16; ++e) acc[e] *= scl; }
#pragma unroll
      for (int e = 0; e < 16; ++e) { if (role == 0) qv[e] = acc[e]; else if (role == 1) kv[e] = acc[e]; else vv[e] = acc[e]; }
    }
    __syncthreads();
    { const float beta = sc[192 + tt], eg = sc[128 + tt], ekl = sc[256 + tt];
      float kb[16];
#pragma unroll
      for (int e = 0; e < 16; ++e) kb[e] = kv[e] * beta;
#pragma unroll
      for (int hh = 0; hh < 2; ++hh) { const int o8 = hh * 8;
        *(u32x4*)(L + G2_KB + tt * 144 + part * 32 + hh * 16) = (u32x4){pk2(kv[o8], kv[o8 + 1]), pk2(kv[o8 + 2], kv[o8 + 3]), pk2(kv[o8 + 4], kv[o8 + 5]), pk2(kv[o8 + 6], kv[o8 + 7])};
        *(u32x4*)(L + G2_KBB + tt * 144 + part * 32 + hh * 16) = (u32x4){pk2(kb[o8], kb[o8 + 1]), pk2(kb[o8 + 2], kb[o8 + 3]), pk2(kb[o8 + 4], kb[o8 + 5]), pk2(kb[o8 + 6], kb[o8 + 7])};
        *(u32x4*)(L + G2_QB + tt * 144 + part * 32 + hh * 16) = (u32x4){pk2(qv[o8], qv[o8 + 1]), pk2(qv[o8 + 2], qv[o8 + 3]), pk2(qv[o8 + 4], qv[o8 + 5]), pk2(qv[o8 + 6], qv[o8 + 7])}; }
      const int ptt = kperm(tt);
#pragma unroll
      for (int e = 0; e < 16; ++e) { const int d = part * 16 + e;
        *(bf16_t*)(L + G2_VBT + d * 144 + tt * 2) = f2bf(vv[e] * beta);
        *(bf16_t*)(L + G2_KBET + d * 144 + tt * 2) = f2bf(kb[e] * eg);
        *(bf16_t*)(gb + 8192 + tt * 128 + kperm(d) * 2) = f2bf(qv[e] * eg);
        *(bf16_t*)(gb + 3 * 8192 + d * 128 + ptt * 2) = f2bf(kv[e] * ekl); } }
    __syncthreads();
    const int rowb = (w4 * 16 + fq * 4) * 144 + fr * 2;
    const int colb = fr * 144 + (w4 * 16 + fq * 4) * 2;
    const int fa = (w4 * 16 + fr) * 144 + fq * 16;
    const int fb = fr * 144 + fq * 16;
    const int i0 = w4 * 16 + fq * 4;
#define G2F(buf, off) (*(const pg8::bf16x8*)(L + (buf) + (off)))
#define G2W16(buf, off, v) (*(bf16_t*)(L + (buf) + (off)) = f2bf(v))
    f32x4 Pt[4];
    { const float gi0 = sc[64 + i0], gi1 = sc[64 + i0 + 1], gi2 = sc[64 + i0 + 2], gi3 = sc[64 + i0 + 3];
#pragma unroll
    for (int u = 0; u < 4; ++u) {
      f32x4 dl = {0.f, 0.f, 0.f, 0.f}, da = {0.f, 0.f, 0.f, 0.f};
#pragma unroll
      for (int ks = 0; ks < 2; ++ks) { const pg8::bf16x8 bk = G2F(G2_KB, fb + u * 2304 + ks * 64);
        dl = __builtin_amdgcn_mfma_f32_16x16x32_bf16(G2F(G2_KBB, fa + ks * 64), bk, dl, 0, 0, 0);
        da = __builtin_amdgcn_mfma_f32_16x16x32_bf16(G2F(G2_QB, fa + ks * 64), bk, da, 0, 0, 0); }
      const int j = u * 16 + fr; const float gj = sc[64 + j]; const int pj = kperm(j);
      const float dec0 = __expf(fminf(gi0 - gj, 0.f)), dec1 = __expf(fminf(gi1 - gj, 0.f)), dec2 = __expf(fminf(gi2 - gj, 0.f)), dec3 = __expf(fminf(gi3 - gj, 0.f));
      const float l0 = i0 + 0 > j ? dl.x * dec0 : 0.f, l1 = i0 + 1 > j ? dl.y * dec1 : 0.f, l2 = i0 + 2 > j ? dl.z * dec2 : 0.f, l3 = i0 + 3 > j ? dl.w * dec3 : 0.f;
      const float a0 = i0 + 0 >= j ? da.x * dec0 : 0.f, a1 = i0 + 1 >= j ? da.y * dec1 : 0.f, a2 = i0 + 2 >= j ? da.z * dec2 : 0.f, a3 = i0 + 3 >= j ? da.w * dec3 : 0.f;
      const f32x4 pv = {(i0 + 0 == j ? 1.f : 0.f) - l0, (i0 + 1 == j ? 1.f : 0.f) - l1, (i0 + 2 == j ? 1.f : 0.f) - l2, (i0 + 3 == j ? 1.f : 0.f) - l3};
      G2W16(G2_XR0, rowb + u * 32, l0); G2W16(G2_XR0, rowb + 144 + u * 32, l1); G2W16(G2_XR0, rowb + 288 + u * 32, l2); G2W16(G2_XR0, rowb + 432 + u * 32, l3);
      G2W16(G2_PR0, rowb + u * 32, pv.x); G2W16(G2_PR0, rowb + 144 + u * 32, pv.y); G2W16(G2_PR0, rowb + 288 + u * 32, pv.z); G2W16(G2_PR0, rowb + 432 + u * 32, pv.w);
      *(u32x2*)(L + G2_XT0 + colb + u * 2304) = (u32x2){pk2(l0, l1), pk2(l2, l3)};
      bf16_t* am = (bf16_t*)(gb + 2 * 8192 + i0 * 128 + pj * 2);
      am[0] = f2bf(a0); am[64] = f2bf(a1); am[128] = f2bf(a2); am[192] = f2bf(a3);
      Pt[u] = pv; } }
    __syncthreads();
#pragma unroll
    for (int u = 0; u < 4; ++u) {
      f32x4 d = {0.f, 0.f, 0.f, 0.f};
#pragma unroll
      for (int ks = 0; ks < 2; ++ks) d = __builtin_amdgcn_mfma_f32_16x16x32_bf16(G2F(G2_XR0, fa + ks * 64), G2F(G2_XT0, fb + u * 2304 + ks * 64), d, 0, 0, 0);
      G2W16(G2_KB, rowb + u * 32, d.x); G2W16(G2_KB, rowb + 144 + u * 32, d.y); G2W16(G2_KB, rowb + 288 + u * 32, d.z); G2W16(G2_KB, rowb + 432 + u * 32, d.w);
      *(u32x2*)(L + G2_KBB + colb + u * 2304) = (u32x2){pk2(d.x, d.y), pk2(d.z, d.w)}; }
    __syncthreads();
#pragma unroll
    for (int itn = 0; itn < 4; ++itn) {
      const int XRc = (itn & 1) ? G2_XR0 : G2_KB, XTc = (itn & 1) ? G2_XT0 : G2_KBB, XRn = (itn & 1) ? G2_KB : G2_XR0, XTn = (itn & 1) ? G2_KBB : G2_XT0;
      const int PRc = (itn & 1) ? G2_QB : G2_PR0, PRn = (itn & 1) ? G2_PR0 : G2_QB;
#pragma unroll
      for (int u = 0; u < 4; ++u) {
        f32x4 d = {0.f, 0.f, 0.f, 0.f};
#pragma unroll
        for (int ks = 0; ks < 2; ++ks) { const pg8::bf16x8 bx = G2F(XTc, fb + u * 2304 + ks * 64);
          Pt[u] = __builtin_amdgcn_mfma_f32_16x16x32_bf16(G2F(PRc, fa + ks * 64), bx, Pt[u], 0, 0, 0);
          if (itn < 3) d = __builtin_amdgcn_mfma_f32_16x16x32_bf16(G2F(XRc, fa + ks * 64), bx, d, 0, 0, 0); }
        G2W16(PRn, rowb + u * 32, Pt[u].x); G2W16(PRn, rowb + 144 + u * 32, Pt[u].y); G2W16(PRn, rowb + 288 + u * 32, Pt[u].z); G2W16(PRn, rowb + 432 + u * 32, Pt[u].w);
        if (itn < 3) { G2W16(XRn, rowb + u * 32, d.x); G2W16(XRn, rowb + 144 + u * 32, d.y); G2W16(XRn, rowb + 288 + u * 32, d.z); G2W16(XRn, rowb + 432 + u * 32, d.w);
          *(u32x2*)(L + XTn + colb + u * 2304) = (u32x2){pk2(d.x, d.y), pk2(d.z, d.w)}; } }
      __syncthreads();
    }
#pragma unroll
    for (int u = 0; u < 4; ++u) {
      f32x4 du = {0.f, 0.f, 0.f, 0.f}, dw = {0.f, 0.f, 0.f, 0.f};
#pragma unroll
      for (int ks = 0; ks < 2; ++ks) { const pg8::bf16x8 a = G2F(G2_PR0, fa + ks * 64);
        du = __builtin_amdgcn_mfma_f32_16x16x32_bf16(a, G2F(G2_VBT, fb + u * 2304 + ks * 64), du, 0, 0, 0);
        dw = __builtin_amdgcn_mfma_f32_16x16x32_bf16(a, G2F(G2_KBET, fb + u * 2304 + ks * 64), dw, 0, 0, 0); }
      const int j = u * 16 + fr, pj = kperm(j);
      *(u32x2*)(gb + 4 * 8192 + j * 128 + i0 * 2) = (u32x2){pk2(du.x, du.y), pk2(du.z, du.w)};
      bf16_t* wn = (bf16_t*)(gb + i0 * 128 + pj * 2);
      wn[0] = f2bf(-dw.x); wn[64] = f2bf(-dw.y); wn[128] = f2bf(-dw.z); wn[192] = f2bf(-dw.w); }
#undef G2F
#undef G2W16
  }
}

constexpr int GS_SLOT = 46208, GS_OB = 2 * GS_SLOT;
__device__ void phase_gdn_scan(const Ctx& c, unsigned char* L, int item) {
  unsigned char* ws = c.ws;
  const int tid = phase_tid(), lane = tid & 63, wave = tid >> 6, fr = lane & 15, fq = lane >> 4;
  const int b = item / 6, h = item % 6;
  const bf16_t* GB = (const bf16_t*)(ws + WS_GB); bf16_t* CAT = (bf16_t*)(ws + WS_CAT); const float* gng = c.in[9];
  const int lt = tid - 256;
  u32x4 ra[10]; float gla = 0.f;
  f32x4 S[4];
#pragma unroll
  for (int i = 0; i < 4; ++i) S[i] = (f32x4){0.f, 0.f, 0.f, 0.f};
#define GS_LOAD(R, G, n) do { if ((n) < 64) { const unsigned char* gb_ = gd_item(ws, item * 64 + (n)); _Pragma("unroll") for (int i_ = 0; i_ < 10; ++i_) R[i_] = *(const u32x4*)(gb_ + (size_t)(lt + 256 * i_) * 16); if (lt == 0) G = *(const float*)(gb_ + 40960); } } while (0)
#define GS_STORE(R, G, slot) do { _Pragma("unroll") for (int i_ = 0; i_ < 10; ++i_) { const int p_ = lt + 256 * i_; *(u32x4*)(L + (slot) * GS_SLOT + (p_ >> 9) * 9216 + ((p_ >> 3) & 63) * 144 + (p_ & 7) * 16) = R[i_]; } if (lt == 0) *(float*)(L + (slot) * GS_SLOT + 46080) = G; } while (0)
  auto post = [&](int k) {
    const unsigned char* ob = L + GS_OB + (k & 1) * 9216; const int tk = lt >> 2, part = lt & 3; const size_t r = (size_t)b * SEQ + k * 64 + tk;
    const u32x4 o0 = *(const u32x4*)(ob + tk * 144 + part * 32), o1 = *(const u32x4*)(ob + tk * 144 + part * 32 + 16);
    float ov[16] = {__uint_as_float(o0.x << 16), __uint_as_float(o0.x & 0xffff0000u), __uint_as_float(o0.y << 16), __uint_as_float(o0.y & 0xffff0000u), __uint_as_float(o0.z << 16), __uint_as_float(o0.z & 0xffff0000u), __uint_as_float(o0.w << 16), __uint_as_float(o0.w & 0xffff0000u),
                    __uint_as_float(o1.x << 16), __uint_as_float(o1.x & 0xffff0000u), __uint_as_float(o1.y << 16), __uint_as_float(o1.y & 0xffff0000u), __uint_as_float(o1.z << 16), __uint_as_float(o1.z & 0xffff0000u), __uint_as_float(o1.w << 16), __uint_as_float(o1.w & 0xffff0000u)};
    float ss = 0.f;
#pragma unroll
    for (int e = 0; e < 16; ++e) ss += ov[e] * ov[e];
    ss += __shfl_xor(ss, 1); ss += __shfl_xor(ss, 2);
    const float rstd = rsqrtf(ss * (1.f / 64.f) + 1e-6f);
    const u32x4 z0 = *(const u32x4*)(GB + r * 1536 + 1152 + h * 64 + part * 16), z1 = *(const u32x4*)(GB + r * 1536 + 1152 + h * 64 + part * 16 + 8);
    const float zf[16] = {__uint_as_float(z0.x << 16), __uint_as_float(z0.x & 0xffff0000u), __uint_as_float(z0.y << 16), __uint_as_float(z0.y & 0xffff0000u), __uint_as_float(z0.z << 16), __uint_as_float(z0.z & 0xffff0000u), __uint_as_float(z0.w << 16), __uint_as_float(z0.w & 0xffff0000u),
                          __uint_as_float(z1.x << 16), __uint_as_float(z1.x & 0xffff0000u), __uint_as_float(z1.y << 16), __uint_as_float(z1.y & 0xffff0000u), __uint_as_float(z1.z << 16), __uint_as_float(z1.z & 0xffff0000u), __uint_as_float(z1.w << 16), __uint_as_float(z1.w & 0xffff0000u)};
#pragma unroll
    for (int e = 0; e < 16; ++e) ov[e] = ov[e] * rstd * gng[part * 16 + e] * silu_f(zf[e]);
    bf16_t* op = CAT + r * 1024 + 384 + h * 64 + part * 16;
    *(u32x4*)op = (u32x4){pk2(ov[0], ov[1]), pk2(ov[2], ov[3]), pk2(ov[4], ov[5]), pk2(ov[6], ov[7])};
    *(u32x4*)(op + 8) = (u32x4){pk2(ov[8], ov[9]), pk2(ov[10], ov[11]), pk2(ov[12], ov[13]), pk2(ov[14], ov[15])};
  };
  auto step = [&](int k) {
    const unsigned char* sb = L + (k & 1) * GS_SLOT; const float gl = *(const float*)(sb + 46080);
    const pg8::bf16x8 Sb0 = packp(S[0], S[1]), Sb1 = packp(S[2], S[3]);
    f32x4 vn[4], o[4];
#pragma unroll
    for (int mt = 0; mt < 4; ++mt) { const u32x2 uv = *(const u32x2*)(sb + 4 * 9216 + (wave * 16 + fr) * 144 + (mt * 16 + fq * 4) * 2);
      f32x4 a = {__uint_as_float(uv.x << 16), __uint_as_float(uv.x & 0xffff0000u), __uint_as_float(uv.y << 16), __uint_as_float(uv.y & 0xffff0000u)};
      a = __builtin_amdgcn_mfma_f32_16x16x32_bf16(ldsfrag(sb, mt * 16 + fr, 0, fq), Sb0, a, 0, 0, 0);
      vn[mt] = __builtin_amdgcn_mfma_f32_16x16x32_bf16(ldsfrag(sb, mt * 16 + fr, 1, fq), Sb1, a, 0, 0, 0);
      f32x4 q = {0.f, 0.f, 0.f, 0.f};
      q = __builtin_amdgcn_mfma_f32_16x16x32_bf16(ldsfrag(sb + 9216, mt * 16 + fr, 0, fq), Sb0, q, 0, 0, 0);
      o[mt] = __builtin_amdgcn_mfma_f32_16x16x32_bf16(ldsfrag(sb + 9216, mt * 16 + fr, 1, fq), Sb1, q, 0, 0, 0); }
    const pg8::bf16x8 Vb0 = packp(vn[0], vn[1]), Vb1 = packp(vn[2], vn[3]);
#pragma unroll
    for (int mt = 0; mt < 4; ++mt) { o[mt] = __builtin_amdgcn_mfma_f32_16x16x32_bf16(ldsfrag(sb + 2 * 9216, mt * 16 + fr, 0, fq), Vb0, o[mt], 0, 0, 0);
      o[mt] = __builtin_amdgcn_mfma_f32_16x16x32_bf16(ldsfrag(sb + 2 * 9216, mt * 16 + fr, 1, fq), Vb1, o[mt], 0, 0, 0); }
#pragma unroll
    for (int kt = 0; kt < 4; ++kt) { f32x4 sv = S[kt] * gl;
      sv = __builtin_amdgcn_mfma_f32_16x16x32_bf16(ldsfrag(sb + 3 * 9216, kt * 16 + fr, 0, fq), Vb0, sv, 0, 0, 0);
      S[kt] = __builtin_amdgcn_mfma_f32_16x16x32_bf16(ldsfrag(sb + 3 * 9216, kt * 16 + fr, 1, fq), Vb1, sv, 0, 0, 0); }
    unsigned char* ob = L + GS_OB + (k & 1) * 9216 + (wave * 16 + fr) * 2;
#pragma unroll
    for (int mt = 0; mt < 4; ++mt) { const int t0 = mt * 16 + fq * 4;
      *(bf16_t*)(ob + (t0 + 0) * 144) = f2bf(o[mt].x); *(bf16_t*)(ob + (t0 + 1) * 144) = f2bf(o[mt].y); *(bf16_t*)(ob + (t0 + 2) * 144) = f2bf(o[mt].z); *(bf16_t*)(ob + (t0 + 3) * 144) = f2bf(o[mt].w); }
  };
  __syncthreads();
  if (wave >= 4) { GS_LOAD(ra, gla, 0); GS_STORE(ra, gla, 0); GS_LOAD(ra, gla, 1); }
  __syncthreads();
#pragma unroll 1
  for (int k = 0; k < 64; ++k) {
    if (wave < 4) step(k); else { if (k + 1 < 64) GS_STORE(ra, gla, (k + 1) & 1); GS_LOAD(ra, gla, k + 2); if (k > 0) post(k - 1); }
    __syncthreads();
  }
  if (wave >= 4) post(63);
#undef GS_LOAD
#undef GS_STORE
}

__device__ __forceinline__ f32x4 bf4(u32x2 p) { return (f32x4){__uint_as_float(p.x << 16), __uint_as_float(p.x & 0xffff0000u), __uint_as_float(p.y << 16), __uint_as_float(p.y & 0xffff0000u)}; }
__device__ void phase_router(const Ctx& c, unsigned char* ldsb) {
  unsigned char* ws = c.ws;
  const int tid = phase_tid(), lane = tid & 63, wave = tid >> 6, fr = lane & 15, fq = lane >> 4;
  float* lg = (float*)(ldsb + wave * 5632);
  const float* bg = c.in[17]; const float* br = c.in[19]; const float* g1 = c.in[14]; const float* b1 = c.in[15];
  const bf16_t* WR = (const bf16_t*)(ws + WS_WR); bf16_t* X1B = (bf16_t*)(ws + WS_X1B);
  unsigned* ctl = (unsigned*)(ws + WS_CTL);
  unsigned* LIST = (unsigned*)(ws + WS_LIST); float* GATEL = (float*)(ws + WS_GATEL); unsigned* TSLOT = (unsigned*)(ws + WS_TSLOT);
  unsigned* cntl = (unsigned*)(ldsb + 46080); unsigned* basel = cntl + 64;
  __syncthreads();
  if (tid < 64) cntl[tid] = 0u;
  __syncthreads();
  for (int tile = blockIdx.x * NWAVES + wave; tile < T / 16; tile += gridDim.x * NWAVES) {
    const int t0 = tile * 16;
    float mean_t = 0.f, rstd_t = 0.f;
#pragma unroll 2
    for (int i = 0; i < 16; ++i) { const u32x2* row = (const u32x2*)(X1B + (size_t)(t0 + i) * 1024);
      f32x4 v[4]; float sm = 0.f;
#pragma unroll
      for (int j = 0; j < 4; ++j) { v[j] = bf4(row[lane + 64 * j]); sm += (v[j].x + v[j].y) + (v[j].z + v[j].w); }
      const float mean = wave_sum(sm) * (1.f / 1024.f); float s2 = 0.f;
#pragma unroll
      for (int j = 0; j < 4; ++j) { v[j] = v[j] - mean; s2 += (v[j].x * v[j].x + v[j].y * v[j].y) + (v[j].z * v[j].z + v[j].w * v[j].w); }
      const float rstd = rsqrtf(wave_sum(s2) * (1.f / 1024.f) + 1e-5f);
      if (fr == i) { mean_t = mean; rstd_t = rstd; } }
    f32x4 acc[5];
#pragma unroll
    for (int nt = 0; nt < 5; ++nt) acc[nt] = (f32x4){0.f, 0.f, 0.f, 0.f};
    bf16_t* xp = X1B + (size_t)(t0 + fr) * 1024 + fq * 8;
#pragma unroll 2
    for (int ks = 0; ks < 32; ++ks) {
      const u32x4 yv = *(const u32x4*)(xp + ks * 32);
      const f32x4 ga = *(const f32x4*)(g1 + ks * 32 + fq * 8), gb2 = *(const f32x4*)(g1 + ks * 32 + fq * 8 + 4), ba = *(const f32x4*)(b1 + ks * 32 + fq * 8), bb2 = *(const f32x4*)(b1 + ks * 32 + fq * 8 + 4);
      const f32x4 y0 = {__uint_as_float(yv.x << 16), __uint_as_float(yv.x & 0xffff0000u), __uint_as_float(yv.y << 16), __uint_as_float(yv.y & 0xffff0000u)};
      const f32x4 y1 = {__uint_as_float(yv.z << 16), __uint_as_float(yv.z & 0xffff0000u), __uint_as_float(yv.w << 16), __uint_as_float(yv.w & 0xffff0000u)};
      const f32x4 n0 = (y0 - mean_t) * rstd_t * ga + ba, n1 = (y1 - mean_t) * rstd_t * gb2 + bb2;
      const u32x4 xw = {cvtpk_c(n0.x, n0.y), cvtpk_c(n0.z, n0.w), cvtpk_c(n1.x, n1.y), cvtpk_c(n1.z, n1.w)};
      *(u32x4*)(xp + ks * 32) = xw;
      const pg8::bf16x8 bx = __builtin_bit_cast(pg8::bf16x8, xw);
#pragma unroll
      for (int nt = 0; nt < 5; ++nt) acc[nt] = __builtin_amdgcn_mfma_f32_16x16x32_bf16(*(const pg8::bf16x8*)(WR + (size_t)(nt * 16 + fr) * 1024 + ks * 32 + fq * 8), bx, acc[nt], 0, 0, 0); }
#pragma unroll
    for (int nt = 0; nt < 5; ++nt) { const int o = nt * 16 + fq * 4; *(f32x4*)(lg + fr * 88 + o) = acc[nt]; }
    asm volatile("s_waitcnt lgkmcnt(0)" ::: "memory");
    int ex1 = 0, ex2 = 0; float gt1 = 0.f, gt2 = 0.f; unsigned lr1 = 0u, lr2 = 0u;
    if (lane < 16) {
      const float* l = lg + lane * 88;
      int grp = 0; float gm = l[0] + bg[0];
      for (int i = 1; i < 8; ++i) { const float v = l[i] + bg[i]; if (v > gm) { gm = v; grp = i; } }
      float gs = 0.f; for (int i = 0; i < 8; ++i) gs += __expf(l[i] + bg[i] - gm);
      const float pgrp = 1.f / gs;
      const float* el = l + 8 + grp * 8; const float* eb = br + grp * 8;
      int i1 = 0; float m1 = el[0] + eb[0]; for (int i = 1; i < 8; ++i) { const float v = el[i] + eb[i]; if (v > m1) { m1 = v; i1 = i; } }
      int i2 = -1; float m2 = -3.0e38f; for (int i = 0; i < 8; ++i) { const float v = el[i] + eb[i]; if (i != i1 && v > m2) { m2 = v; i2 = i; } }
      const float e2 = __expf(m2 - m1), den = 1.f / (1.f + e2);
      gt1 = pgrp * den; gt2 = pgrp * e2 * den;
      ex1 = grp * 8 + i1; ex2 = grp * 8 + i2;
      lr1 = atomicAdd(&cntl[ex1], 1u); lr2 = atomicAdd(&cntl[ex2], 1u);
    }
    __syncthreads();
    if (wave == 0) { const unsigned nloc = cntl[lane]; basel[lane] = nloc ? atomicAdd(&ctl[CW_CNT + lane], nloc) : 0u; }
    __syncthreads();
    if (lane < 16) {
      const int t = t0 + lane; const unsigned r1 = basel[ex1] + lr1, r2 = basel[ex2] + lr2;
      LIST[(size_t)ex1 * 32768 + r1] = (unsigned)t; GATEL[(size_t)ex1 * 32768 + r1] = gt1;
      LIST[(size_t)ex2 * 32768 + r2] = (unsigned)t; GATEL[(size_t)ex2 * 32768 + r2] = gt2;
      TSLOT[(size_t)t * 2 + 0] = ((unsigned)ex1 << 16) | r1; TSLOT[(size_t)t * 2 + 1] = ((unsigned)ex2 << 16) | r2;
    }
    __syncthreads();
    if (tid < 64) cntl[tid] = 0u;
    __syncthreads();
  }
}

__device__ void phase_combine(const Ctx& c, float* lds) {
  unsigned char* ws = c.ws;
  const int tid = phase_tid(), lane = tid & 63, wave = tid >> 6;
  int* offs = (int*)lds; int* cnts = offs + 65;
  expert_offsets(c, offs, cnts, tid);
  const bf16_t* Y = (const bf16_t*)(ws + WS_Y); const unsigned* TSLOT = (const unsigned*)(ws + WS_TSLOT);
  const float* g2 = c.in[23]; const float* b2 = c.in[24];
  for (int t = blockIdx.x * NWAVES + wave; t < T; t += gridDim.x * NWAVES) {
    const unsigned s0 = TSLOT[(size_t)t * 2], s1 = TSLOT[(size_t)t * 2 + 1];
    const size_t r0 = (size_t)offs[s0 >> 16] + (s0 & 0xffffu), r1 = (size_t)offs[s1 >> 16] + (s1 & 0xffffu);
    f32x4* row = (f32x4*)(c.out + (size_t)t * 1024); const u32x2* xrow = (const u32x2*)((const bf16_t*)(ws + WS_X1B) + (size_t)t * 1024);
    f32x4 v[4]; float s = 0.f;
#pragma unroll
    for (int j = 0; j < 4; ++j) { const u32x2 ya = ((const u32x2*)(Y + r0 * 1024))[lane + 64 * j], yb = ((const u32x2*)(Y + r1 * 1024))[lane + 64 * j];
      f32x4 x = bf4(xrow[lane + 64 * j]) * ALPHA;
      x.x += __uint_as_float(ya.x << 16) + __uint_as_float(yb.x << 16); x.y += __uint_as_float(ya.x & 0xffff0000u) + __uint_as_float(yb.x & 0xffff0000u);
      x.z += __uint_as_float(ya.y << 16) + __uint_as_float(yb.y << 16); x.w += __uint_as_float(ya.y & 0xffff0000u) + __uint_as_float(yb.y & 0xffff0000u);
      v[j] = x; s += (x.x + x.y) + (x.z + x.w); }
    const float mean = wave_sum(s) * (1.f / 1024.f); float s2 = 0.f;
#pragma unroll
    for (int j = 0; j < 4; ++j) { v[j] = v[j] - mean; s2 += (v[j].x * v[j].x + v[j].y * v[j].y) + (v[j].z * v[j].z + v[j].w * v[j].w); }
    const float rstd = rsqrtf(wave_sum(s2) * (1.f / 1024.f) + 1e-5f);
#pragma unroll
    for (int j = 0; j < 4; ++j) { const f32x4 g = ((const f32x4*)g2)[lane + 64 * j], bb = ((const f32x4*)b2)[lane + 64 * j]; row[lane + 64 * j] = v[j] * rstd * g + bb; }
  }
}

constexpr int NPHASE = 11;
__global__ void __launch_bounds__(NTHREADS, 2) mega(Ctx c) {
  float* lds = (float*)lds_raw;
  unsigned* ctl = (unsigned*)(c.ws + WS_CTL);
  unsigned* bar = ctl + CW_BAR;
  if (threadIdx.x == 0) { *(volatile unsigned*)(lds_raw + LDS_WCTR) = 0u; *(volatile unsigned*)(lds_raw + LDS_XBST) = 0u; *(volatile unsigned*)(lds_raw + LDS_XBST + 4) = 0u;
    (void)xb_add(&bar[XB_XCNT(xb_xcc_id())], 1u); }
  __syncthreads();
  phase_prologue(c, lds);
  xcd_barrier(bar);
  phase_inproj_mfma(c, (lds_u8*)lds_raw);
  xcd_barrier(bar);
  phase_gdn_prep2(c, lds_raw);
  phase_kvup(c, lds);
  phase_topk_mfma(c, lds_raw, ctl + CW_Q);
  xcd_barrier(bar);
  if (blockIdx.x < 48) phase_gdn_scan(c, lds_raw, blockIdx.x);
  phase_attn_sparse(c, lds_raw, ctl + CW_Q + 16);
  phase_attn_mem(c, lds_raw, ctl + CW_Q + 32);
  xcd_barrier(bar);
  phase_outproj_mfma(c, (lds_u8*)lds_raw);
  xcd_barrier(bar);
  phase_router(c, lds_raw);
  xcd_barrier(bar);
  phase_moe_up_mfma(c, (lds_u8*)lds_raw);
  xcd_barrier(bar);
  phase_moe_down_mfma(c, (lds_u8*)lds_raw);
  xcd_barrier(bar);
  phase_combine(c, lds);
}

extern "C" void kernel_launch(void* const* d_in, const int* in_sizes, int n_in, void* d_out, int out_size, void* d_ws, size_t ws_size, hipStream_t stream) {
  static int grid = 0;
  if (grid == 0) {
    if (n_in != 25 || ws_size < WS_END) { fprintf(stderr, "kernel_launch: unexpected n_in %d / ws %zu\n", n_in, ws_size); grid = -1; return; }
    int dev = 0, cus = 0, per_cu = 0;
    hipGetDevice(&dev); hipDeviceGetAttribute(&cus, hipDeviceAttributeMultiprocessorCount, dev);
    hipFuncSetAttribute((const void*)mega, hipFuncAttributeMaxDynamicSharedMemorySize, LDS_BYTES);
    hipOccupancyMaxActiveBlocksPerMultiprocessor(&per_cu, (const void*)mega, NTHREADS, LDS_BYTES);
    if (per_cu < 1) { fprintf(stderr, "kernel_launch: occupancy query says %d blocks/CU\n", per_cu); per_cu = 1; }
    grid = cus * (per_cu < 1 ? 1 : 1);
    (void)hipGetLastError();
  }
  if (grid < 0) return;
  hipMemsetAsync((char*)d_ws + WS_CTL, 0, 32 * 1024, stream);
  Ctx c; memset(&c, 0, sizeof(c));
  for (int i = 0; i < 25; ++i) c.in[i] = (const float*)d_in[i];
  c.out = (float*)d_out; c.ws = (unsigned char*)d_ws;
  hipLaunchKernelGGL(mega, dim3(grid), dim3(NTHREADS), LDS_BYTES, stream, c);
}
```

```cpp
#include <hip/hip_runtime.h>
#include <cstdio>
#include <cstdint>
#include <cstring>

#ifndef ONE_LAUNCH
#define ONE_LAUNCH 1
#endif

typedef unsigned short bf16_t;
typedef float f32x4 __attribute__((ext_vector_type(4)));
typedef unsigned u32x4 __attribute__((ext_vector_type(4)));
typedef unsigned u32x2 __attribute__((ext_vector_type(2)));

constexpr int T = 32768, DM = 1024, SEQ = 4096, NBATCH = 8;
constexpr int NIN = 2816;
constexpr int NMEM = 256, TM = NBATCH * NMEM;
constexpr int NEXP = 64, DE = 256;
constexpr int NTHREADS = 512, NWAVES = 8;
constexpr float ALPHA = 1.189207115002721f;
constexpr float LOG2E = 1.4426950408889634f;
constexpr float QSCALE = 0.125f * LOG2E;

constexpr size_t MiB = 1ull << 20;
constexpr size_t WS_CTL = 0;
constexpr size_t WS_TSLOT = 512 * 1024;
constexpr size_t WS_ROPE = 1 * MiB;
constexpr size_t WS_WKV = 2 * MiB;
constexpr size_t WS_WR = 2 * MiB + 65536;
constexpr size_t WS_WIN = 3 * MiB;
constexpr size_t WS_WO = 9 * MiB;
constexpr size_t WS_WMKV = 11 * MiB;
constexpr size_t WS_MEMB = 12 * MiB;
constexpr size_t WS_WGU = 16 * MiB;
constexpr size_t WS_WD = 80 * MiB;
constexpr size_t WS_XB = 112 * MiB;
constexpr size_t WS_QA = 176 * MiB;
constexpr size_t WS_CKV = 200 * MiB;
constexpr size_t WS_IQ = 208 * MiB;
constexpr size_t WS_IK = 224 * MiB;
constexpr size_t WS_SM = 228 * MiB;
constexpr size_t WS_QC = 230 * MiB;
constexpr size_t WS_GB = 246 * MiB;
constexpr size_t WS_MK = 342 * MiB;
constexpr size_t WS_MVT = 343 * MiB;
constexpr size_t WS_KVA = 344 * MiB;
constexpr size_t WS_SEL = 352 * MiB;
constexpr size_t WS_CAT = 368 * MiB;
constexpr size_t WS_X1B = 432 * MiB;
constexpr size_t WS_LIST = 496 * MiB;
constexpr size_t WS_GATEL = 504 * MiB;
constexpr size_t WS_END = 512 * MiB;
constexpr size_t WS_H = 112 * MiB;
constexpr size_t WS_Y = 160 * MiB;

constexpr int CW_CNT = 0;
constexpr int CW_Q = 64;
constexpr int CW_BAR = 4096;

struct Ctx {
  const float* in[25];
  float* out;
  unsigned char* ws;
  int ph_lo, ph_hi;
};


extern __shared__ __attribute__((aligned(16))) unsigned char lds_raw[];
constexpr int LDS_BYTES = 157696;
constexpr int LDS_WCTR = LDS_BYTES - 64;
__device__ __forceinline__ int phase_tid() {
  __syncthreads();
  int l; asm volatile("v_mbcnt_lo_u32_b32 %0, -1, 0\n\tv_mbcnt_hi_u32_b32 %0, -1, %0" : "=v"(l));
  unsigned w = 0u;
  if (l == 0) w = __hip_atomic_fetch_add((__attribute__((address_space(3))) unsigned*)(__attribute__((address_space(3))) unsigned char*)(lds_raw + LDS_WCTR), 1u, __ATOMIC_RELAXED, __HIP_MEMORY_SCOPE_WORKGROUP);
  w = (unsigned)__builtin_amdgcn_readfirstlane((int)w) & 7u;
  return (int)(w * 64u) + l;
}


#define XB_TMO      128
#define XB_XCNT(j)  (256  + 64 * (j))
#define XB_XSUB(j)  (1280 + 64 * (j))
#define XB_XGEN(j)  (2304 + 64 * (j))
#define XB_TOP      3328
#define XB_TOPGEN   3392
#define XCD_BAR_WORDS 3456
#define XB_SPIN_CAP (1u << 18)
constexpr int LDS_XBST = LDS_BYTES - 32;
__device__ __forceinline__ unsigned xb_ld(unsigned* p)              { return __hip_atomic_load(p, __ATOMIC_RELAXED, __HIP_MEMORY_SCOPE_AGENT); }
__device__ __forceinline__ unsigned xb_add(unsigned* p, unsigned v) { return __hip_atomic_fetch_add(p, v, __ATOMIC_RELAXED, __HIP_MEMORY_SCOPE_AGENT); }
__device__ __forceinline__ unsigned xb_xcc_id() { return (unsigned)__builtin_amdgcn_s_getreg((3 << 11) | 20) & 0xFu; }
#define XB_SPIN(cond, bar) do { unsigned _sp = 0; while (cond) { __builtin_amdgcn_s_sleep(1); \
    if ((++_sp & 255u) == 0u) { if (xb_ld(&(bar)[XB_TMO])) break; if (_sp > XB_SPIN_CAP) { atomicAdd(&(bar)[XB_TMO], 1u); break; } } } } while (0)
__device__ __forceinline__ void xcd_barrier_complete(unsigned* bar, unsigned x, unsigned& nloc, unsigned& nx) {
    const unsigned G = gridDim.x;
    unsigned sum, cnt, mine, sp = 0u;
    for (;;) {
        sum = 0u; cnt = 0u; mine = 0u;
#pragma unroll
        for (unsigned j = 0; j < 16; ++j) { const unsigned cc = xb_ld(&bar[XB_XCNT(j)]); sum += cc; cnt += (cc > 0u) ? 1u : 0u; mine = (j == x) ? cc : mine; }
        if (sum == G) break;
        __builtin_amdgcn_s_sleep(1);
        if ((++sp & 255u) == 0u) { if (xb_ld(&bar[XB_TMO])) break; if (sp > XB_SPIN_CAP) { atomicAdd(&bar[XB_TMO], 1u); break; } }
    }
    nloc = mine > 0u ? mine : 1u; nx = cnt > 0u ? cnt : 1u;
}
__device__ __forceinline__ void xcd_barrier(unsigned* bar) {
    asm volatile("s_waitcnt vmcnt(0)" ::: "memory");
    __syncthreads();
    const int btid = phase_tid();
    if (btid == 0) {
        volatile __attribute__((address_space(3))) unsigned* st = (volatile __attribute__((address_space(3))) unsigned*)(__attribute__((address_space(3))) unsigned char*)(lds_raw + LDS_XBST);
        const unsigned x = xb_xcc_id();
        __builtin_amdgcn_s_waitcnt(0);
        unsigned nloc = st[0], nx = st[1];
        if (nloc == 0u) { xcd_barrier_complete(bar, x, nloc, nx); st[0] = nloc; st[1] = nx; }
        const unsigned old = xb_add(&bar[XB_XSUB(x)], 1u);
        const unsigned gen = old / nloc;
        if (old + 1u == (gen + 1u) * nloc) {
            __builtin_amdgcn_fence(__ATOMIC_RELEASE, "agent");
            asm volatile("s_waitcnt vmcnt(0)" ::: "memory");
            const unsigned og = xb_add(&bar[XB_TOP], 1u);
            const unsigned tg = og / nx;
            if (og + 1u == (tg + 1u) * nx) xb_add(&bar[XB_TOPGEN], 1u);
            else XB_SPIN(xb_ld(&bar[XB_TOPGEN]) == tg, bar);
            __builtin_amdgcn_fence(__ATOMIC_ACQUIRE, "agent");
            xb_add(&bar[XB_XGEN(x)], 1u);
            asm volatile("s_waitcnt vmcnt(0)" ::: "memory");
        } else {
            XB_SPIN(xb_ld(&bar[XB_XGEN(x)]) == gen, bar);
            __builtin_amdgcn_fence(__ATOMIC_ACQUIRE, "agent");
            asm volatile("s_waitcnt vmcnt(0)" ::: "memory");
        }
    }
    __syncthreads();
}

__device__ __forceinline__ float bf2f(bf16_t v) { return __uint_as_float(((unsigned)v) << 16); }
typedef float hw_f32x2 __attribute__((ext_vector_type(2))); typedef __bf16 hw_bf16x2 __attribute__((ext_vector_type(2)));
__device__ __forceinline__ unsigned pk2(float lo, float hi) { const hw_f32x2 v = {lo, hi}; const hw_bf16x2 b = __builtin_convertvector(v, hw_bf16x2); return __builtin_bit_cast(unsigned, b); }
__device__ __forceinline__ bf16_t f2bf(float f) { return (bf16_t)(pk2(f, f) & 0xffffu); }
__device__ __forceinline__ float wave_sum(float v) {
  int x = __float_as_int(v);
  x = __float_as_int(__int_as_float(x) + __int_as_float(__builtin_amdgcn_update_dpp(0, x, 0x111, 0xF, 0xF, true)));
  x = __float_as_int(__int_as_float(x) + __int_as_float(__builtin_amdgcn_update_dpp(0, x, 0x112, 0xF, 0xF, true)));
  x = __float_as_int(__int_as_float(x) + __int_as_float(__builtin_amdgcn_update_dpp(0, x, 0x114, 0xF, 0xF, true)));
  x = __float_as_int(__int_as_float(x) + __int_as_float(__builtin_amdgcn_update_dpp(0, x, 0x118, 0xF, 0xF, true)));
  x = __float_as_int(__int_as_float(x) + __int_as_float(__builtin_amdgcn_update_dpp(0, x, 0x142, 0xA, 0xF, false)));
  x = __float_as_int(__int_as_float(x) + __int_as_float(__builtin_amdgcn_update_dpp(0, x, 0x143, 0xC, 0xF, false)));
  return __int_as_float(__builtin_amdgcn_readlane(x, 63));
}
__device__ __forceinline__ float wave_max(float v) {
#pragma unroll
  for (int o = 32; o >= 1; o >>= 1) v = fmaxf(v, __shfl_xor(v, o));
  return v;
}
__device__ __forceinline__ float silu_f(float v) { return v * __builtin_amdgcn_rcpf(1.f + __expf(-v)); }

__device__ __forceinline__ int ropeperm(int p) { return (p >> 1) + 32 * (p & 1); }
__device__ __forceinline__ int colmap_in(int cp) {
  const int tile = cp >> 8, w = cp & 255;
  if (tile == 0) return (w >> 6) * 64 + ropeperm(w & 63);
  if (tile == 1) { if (w < 128) { const int c = 256 + w; return (c >> 6) * 64 + ropeperm(c & 63); } return 384 + (w - 128); }
  if (tile == 2) return 512 + (w >> 6) * 64 + ropeperm(w & 63);
  if (tile == 3) { if (w < 64) return 768 + ropeperm(w); if (w < 68) return 832 + (w - 64); if (w < 74) return 2372 + (w - 68); if (w < 80) return 2378 + (w - 74); return -1; }
  if (tile == 4) return 2384 + w;
  return 836 + (cp - 1280);
}

struct WorkQ { unsigned* head; volatile int* slot; int nxt; };
__device__ __forceinline__ void wq_init(WorkQ& q, unsigned* head, volatile int* slot, int tid) { q.head = head; q.slot = slot; q.nxt = 0; if (tid == 0) q.nxt = (int)atomicAdd(head, 1u); }
__device__ __forceinline__ int wq_next(WorkQ& q, int tid) {
  __syncthreads();
  if (tid == 0) { *q.slot = q.nxt; q.nxt = (int)atomicAdd(q.head, 1u); }
  __syncthreads();
  return *q.slot;
}

template <class CM>
__device__ __forceinline__ void tp_tile(const float* src, int ld, bf16_t* dst, int drow0, int K, int k0, CM cm, float* lds, int tid) {
  const int a = tid & 63, b = tid >> 6;
  const int sc = cm(a);
  __syncthreads();
#pragma unroll
  for (int i = 0; i < 8; ++i) { const int kk = b * 8 + i; lds[kk * 65 + a] = sc >= 0 ? src[(size_t)(k0 + kk) * ld + sc] : 0.f; }
  __syncthreads();
  { const int nn = tid >> 3, kc = (tid & 7) * 8;
    const float* p = lds + kc * 65 + nn;
    *(u32x4*)(dst + (size_t)(drow0 + nn) * K + k0 + kc) = (u32x4){pk2(p[0], p[65]), pk2(p[130], p[195]), pk2(p[260], p[325]), pk2(p[390], p[455])}; }
}

__device__ void phase_prologue(const Ctx& c, float* lds) {
  const int tid = phase_tid(), bid = blockIdx.x, G = gridDim.x;
  unsigned char* ws = c.ws;
  const size_t gtid = (size_t)bid * NTHREADS + tid, gstride = (size_t)G * NTHREADS;
  { const f32x4* x4 = (const f32x4*)c.in[0]; u32x2* o = (u32x2*)(ws + WS_XB);
    for (size_t i = gtid; i < (size_t)T * DM / 4; i += gstride) { const f32x4 v = x4[i]; o[i] = (u32x2){pk2(v.x, v.y), pk2(v.z, v.w)}; }
    const f32x4* m4 = (const f32x4*)c.in[1]; u32x2* om = (u32x2*)(ws + WS_MEMB);
    for (size_t i = gtid; i < (size_t)TM * DM / 4; i += gstride) { const f32x4 v = m4[i]; om[i] = (u32x2){pk2(v.x, v.y), pk2(v.z, v.w)}; } }
  { float* cs = (float*)(ws + WS_ROPE); float* sn = cs + SEQ * 32;
    for (size_t i = gtid; i < (size_t)SEQ * 32; i += gstride) { const int s = (int)(i >> 5), d = (int)(i & 31);
      const float inv = 1.0f / powf(10000.0f, (float)d / 32.0f); const float ang = (float)s * inv; float sv, cv; sincosf(ang, &sv, &cv); cs[i] = cv; sn[i] = sv; } }
  { bf16_t* wkv = (bf16_t*)(ws + WS_WKV); const float* g = c.in[3]; const float* wk = c.in[4]; const float* wv = c.in[5];
    for (size_t i = gtid; i < 128 * 128; i += gstride) { const int p = (int)(i >> 7), k = (int)(i & 127);
      const float w = p < 64 ? wk[k * 64 + ropeperm(p)] : wv[k * 64 + (p - 64)]; wkv[i] = f2bf(w * g[k]); }
    bf16_t* wr = (bf16_t*)(ws + WS_WR); const float* wg = c.in[16]; const float* wrt = c.in[18];
    for (size_t i = gtid; i < 80 * 1024; i += gstride) { const int o = (int)(i >> 10), k = (int)(i & 1023); wr[i] = f2bf(o < 8 ? wg[k * 8 + o] : o < 72 ? wrt[k * 64 + (o - 8)] : 0.f); } }
  const int n_win = (NIN / 64) * 16, n_wo = 16 * 16, n_wmkv = 8 * 16, n_wgu = 64 * 8 * 16, n_wd = 64 * 16 * 4;
  const int total = n_win + n_wo + n_wmkv + n_wgu + n_wd;
  for (int it = bid; it < total; it += G) {
    int r = it;
    if (r < n_win) { const int nt = r / 16, kt = r % 16; tp_tile(c.in[2], 2640, (bf16_t*)(ws + WS_WIN), nt * 64, 1024, kt * 64, [&](int a) { return colmap_in(nt * 64 + a); }, lds, tid); continue; } r -= n_win;
    if (r < n_wo) { const int nt = r / 16, kt = r % 16; tp_tile(c.in[13], 1024, (bf16_t*)(ws + WS_WO), nt * 64, 1024, kt * 64, [&](int a) { return nt * 64 + a; }, lds, tid); continue; } r -= n_wo;
    if (r < n_wmkv) { const int nt = r / 16, kt = r % 16; tp_tile(c.in[12], 512, (bf16_t*)(ws + WS_WMKV), nt * 64, 1024, kt * 64, [&](int a) { return nt * 64 + a; }, lds, tid); continue; } r -= n_wmkv;
    if (r < n_wgu) { const int e = r / 128, q = r % 128, nt = q / 16, kt = q % 16;
      const int pn = nt >> 2, sub = nt & 3, isup = sub >> 1, c0 = pn * 128 + (sub & 1) * 64;
      const float* src = (isup ? c.in[21] : c.in[20]) + (size_t)e * 1024 * 256;
      tp_tile(src, 256, (bf16_t*)(ws + WS_WGU), e * 512 + nt * 64, 1024, kt * 64, [&](int a) { return c0 + a; }, lds, tid); continue; } r -= n_wgu;
    { const int e = r / 64, q = r % 64, nt = q / 4, kt = q % 4;
      tp_tile(c.in[22] + (size_t)e * 256 * 1024, 1024, (bf16_t*)(ws + WS_WD), e * 1024 + nt * 64, 256, kt * 64, [&](int a) { return nt * 64 + a; }, lds, tid); }
  }
}

__device__ __forceinline__ void expert_offsets(const Ctx& c, int* offs  , int* cnts  , int tid) {
  const unsigned* ctl = (const unsigned*)(c.ws + WS_CTL);
  __syncthreads();
  if (tid == 0) { int o = 0; for (int e = 0; e < 64; ++e) { const int n = (int)ctl[CW_CNT + e]; cnts[e] = n; offs[e] = o; o += (n + 255) & ~255; } offs[64] = o; }
  __syncthreads();
}


namespace pg8 {
#define PG8_LAS __attribute__((address_space(3)))
typedef short bf16x8 __attribute__((ext_vector_type(8)));
constexpr int BM = 256, BK = 64, HALF = 128, HTB = HALF * BK * 2, STAGE_BYTES = 8 * HTB, NXCD = 8, WGM = 8;
__host__ __device__ __forceinline__ int lds_byte(int r, int c) { const int st = (r >> 4) * 2 + (c >> 5), rr = r & 15, cc = c & 31, ob = rr * 64 + cc * 2; return st * 1024 + (ob ^ (((ob >> 9) & 1) << 5)); }
__host__ __device__ __forceinline__ void stage_rc(int b, int& R, int& C) { const int st = b / 1024, sb = b % 1024, swz = sb ^ (((sb >> 9) & 1) << 5); R = (st >> 1) * 16 + swz / 64; C = (st & 1) * 32 + (swz % 64) / 2; }
__host__ __device__ __forceinline__ int perm32(int rho) { const int n = rho >> 4, i = rho & 15; return 8 * (i >> 2) + 4 * n + (i & 3); }
struct Unit { int pm, pn, e, mt, aux; };
struct Gemm { const bf16_t* A; const bf16_t* Bt; int K; };
struct StaticOrder {
    int nM, nN, nwg, G, c;
    __device__ void init(int M, int N, int G_, int c_) { nM = M / BM; nN = N / BM; nwg = nM * nN; G = G_; c = c_; }
    __device__ bool next(int i, Unit& u) const {
        const long L = (long)i * G + c; if (c < 0 || L >= nwg) return false;
        int wgid = (int)L; { const int q = nwg / NXCD, r = nwg % NXCD, xcd = wgid % NXCD, off = wgid / NXCD; wgid = (xcd < r ? xcd * (q + 1) : r * (q + 1) + (xcd - r) * q) + off; }
        const int nig = WGM * nN, gid = wgid / nig, fm = gid * WGM, gsz = (nM - fm) < WGM ? (nM - fm) : WGM;
        u.pm = fm + ((wgid % nig) % gsz); u.pn = (wgid % nig) / gsz; u.e = 0; u.mt = 0; u.aux = 0; return true;
    }
    __device__ __forceinline__ unsigned arow(const Unit&, int) const { return 0u; }
};
__device__ __forceinline__ unsigned cvt_pk_bf16(float lo, float hi) { unsigned r; asm volatile("v_cvt_pk_bf16_f32 %0, %1, %2" : "=v"(r) : "v"(lo), "v"(hi)); return r; }

template <class Epi, class Sched, bool ALIGN_EPI, bool GATHER>
__device__ __forceinline__ void gemm_phase(PG8_LAS unsigned char* lds, const Gemm g, const Sched& S, const Epi& E, const int tid) {
    const int wid = __builtin_amdgcn_readfirstlane(tid >> 6), lane = tid & 63, wr = wid >> 2, wc = wid & 3, fr = lane & 15, fq = lane >> 4;
    const int K = g.K, nt = K / BK;
    unsigned voffA[2], voffB[2]; int RA[2], CA[2];
#pragma unroll
    for (int i = 0; i < 2; ++i) { int R, C; stage_rc(tid * 16 + i * 8192, R, C); const int Rb = Epi::PERM ? ((R & ~31) + perm32(R & 31)) : R;
        RA[i] = R; CA[i] = C; voffA[i] = (unsigned)(R * K + C) * 2u; voffB[i] = (unsigned)(Rb * K + C) * 2u; }
    const size_t kstep = (size_t)(BK * 2);
    const size_t hstep = (size_t)HALF * K * 2;
    const size_t tstep = 2 * hstep;
    const unsigned ldsw = (unsigned)wid * 1024u;
    const int aoff = lds_byte(wr * 64 + fr, fq * 8), boff = lds_byte(wc * 32 + fr, fq * 8);
#define PG8_SA(b, h) (((b) * 2 + (h)) * HTB)
#define PG8_SB(b, h) ((4 + (b) * 2 + (h)) * HTB)
#define PG8_STAGE(bufoff, gbase, voff) do { _Pragma("unroll") for (int _i = 0; _i < 2; ++_i) \
        __builtin_amdgcn_global_load_lds((const unsigned*)((const char*)(gbase) + (voff)[_i]), (PG8_LAS unsigned*)(lds + (bufoff) + ldsw + _i * 8192), 16, 0, 0); } while (0)
#define PG8_STAGE_A(bufoff, gbase, h, goff) do { if constexpr (GATHER) { PG8_STAGE(bufoff, gbase, (goff)[h]); } else { PG8_STAGE(bufoff, (gbase) + (h) * hstep, voffA); } } while (0)
#define PG8_LDA(dst, b, h) do { _Pragma("unroll") for (int m = 0; m < 4; ++m) _Pragma("unroll") for (int k = 0; k < 2; ++k) dst[m][k] = *(const PG8_LAS bf16x8*)(lds + PG8_SA(b, h) + aoff + m * 2048 + k * 1024); } while (0)
#define PG8_LDB(dst, b, h) do { _Pragma("unroll") for (int n = 0; n < 2; ++n) _Pragma("unroll") for (int k = 0; k < 2; ++k) dst[n][k] = *(const PG8_LAS bf16x8*)(lds + PG8_SB(b, h) + boff + n * 2048 + k * 1024); } while (0)
#define PG8_MMA(ai, bj, At, Bt) do { __builtin_amdgcn_s_setprio(1); _Pragma("unroll") for (int m = 0; m < 4; ++m) _Pragma("unroll") for (int n = 0; n < 2; ++n) _Pragma("unroll") for (int k = 0; k < 2; ++k) \
        acc[ai][bj][m][n] = __builtin_amdgcn_mfma_f32_16x16x32_bf16(Bt[n][k], At[m][k], acc[ai][bj][m][n], 0, 0, 0); __builtin_amdgcn_s_setprio(0); } while (0)
#define PG8_WAIT_V(n) asm volatile("s_waitcnt vmcnt(" #n ")" ::: "memory")
#define PG8_WAIT_L(n) asm volatile("s_waitcnt lgkmcnt(" #n ")" ::: "memory")
#define PG8_BAR __builtin_amdgcn_s_barrier()
#define PG8_SCHED __builtin_amdgcn_sched_barrier(0)
    Unit cur, nxt; int ui = 0;
    if (!S.next(0, cur)) return;
    f32x4 acc[2][2][4][2];
#pragma unroll
    for (int a = 0; a < 2; ++a)
#pragma unroll
        for (int b = 0; b < 2; ++b)
#pragma unroll
            for (int m = 0; m < 4; ++m)
#pragma unroll
                for (int n = 0; n < 2; ++n) acc[a][b][m][n] = (f32x4){0.f, 0.f, 0.f, 0.f};
    bf16x8 At[4][2], B0[2][2], B1[2][2];
    unsigned gc[2][2], gn[2][2];
    const char* cA; const char* cB = (const char*)g.Bt + (size_t)cur.pn * tstep;
    if constexpr (GATHER) { cA = (const char*)g.A;
#pragma unroll
        for (int h = 0; h < 2; ++h)
#pragma unroll
            for (int i = 0; i < 2; ++i) { gc[h][i] = (S.arow(cur, h * HALF + RA[i]) * (unsigned)K + (unsigned)CA[i]) * 2u; gn[h][i] = gc[h][i]; }
    } else { cA = (const char*)g.A + (size_t)cur.pm * tstep; }
    PG8_STAGE(PG8_SB(0, 0), cB, voffB); PG8_STAGE(PG8_SB(0, 1), cB + hstep, voffB); PG8_STAGE_A(PG8_SA(0, 0), cA, 0, gc); PG8_STAGE_A(PG8_SA(0, 1), cA, 1, gc);
    if (wr == 1) PG8_BAR;
    PG8_WAIT_V(2); PG8_BAR;
    PG8_STAGE(PG8_SB(1, 0), cB + kstep, voffB); PG8_STAGE_A(PG8_SA(1, 0), cA + kstep, 0, gc); PG8_STAGE(PG8_SB(1, 1), cB + hstep + kstep, voffB);
    PG8_WAIT_V(6); PG8_BAR;
    for (;;) {
        const bool has_next = S.next(ui + 1, nxt);
        const char* nA; const char* nB = has_next ? (const char*)g.Bt + (size_t)nxt.pn * tstep : cB;
        if constexpr (GATHER) { nA = cA;
            if (has_next) {
#pragma unroll
                for (int h = 0; h < 2; ++h)
#pragma unroll
                    for (int i = 0; i < 2; ++i) gn[h][i] = (S.arow(nxt, h * HALF + RA[i]) * (unsigned)K + (unsigned)CA[i]) * 2u; }
        } else { nA = has_next ? (const char*)g.A + (size_t)nxt.pm * tstep : cA; }
        for (int t = 0; t < nt; t += 2) {
            const bool last = (t == nt - 2);
            const char* a1 = cA + (size_t)(t + 1) * kstep;
            const char* a2 = last ? nA : cA + (size_t)(t + 2) * kstep; const char* b2 = last ? nB : cB + (size_t)(t + 2) * kstep;
            const char* a3 = a2 + kstep; const char* b3 = b2 + kstep;
            unsigned g2[2][2];
            if constexpr (GATHER) {
#pragma unroll
            for (int h = 0; h < 2; ++h)
#pragma unroll
                for (int i = 0; i < 2; ++i) g2[h][i] = last ? gn[h][i] : gc[h][i]; }
            PG8_LDB(B0, 0, 0); PG8_LDB(B1, 0, 1); PG8_SCHED; PG8_LDA(At, 0, 0); PG8_STAGE_A(PG8_SA(1, 1), a1, 1, gc);
            PG8_WAIT_V(8); PG8_WAIT_L(0); PG8_BAR; PG8_MMA(0, 0, At, B0); PG8_MMA(0, 1, At, B1); PG8_BAR; PG8_SCHED;
            PG8_LDA(At, 0, 1); PG8_STAGE(PG8_SB(0, 0), b2, voffB); PG8_STAGE(PG8_SB(0, 1), b2 + hstep, voffB); PG8_STAGE_A(PG8_SA(0, 0), a2, 0, g2);
            PG8_WAIT_V(8); PG8_WAIT_L(0); PG8_BAR; PG8_MMA(1, 0, At, B0); PG8_MMA(1, 1, At, B1); PG8_BAR; PG8_SCHED;
            PG8_LDB(B0, 1, 0); PG8_LDB(B1, 1, 1); PG8_SCHED; PG8_LDA(At, 1, 0); PG8_STAGE_A(PG8_SA(0, 1), a2, 1, g2);
            PG8_WAIT_V(8); PG8_WAIT_L(0); PG8_BAR; PG8_MMA(0, 0, At, B0); PG8_MMA(0, 1, At, B1); PG8_BAR; PG8_SCHED;
            PG8_LDA(At, 1, 1); PG8_STAGE(PG8_SB(1, 0), b3, voffB); PG8_STAGE(PG8_SB(1, 1), b3 + hstep, voffB); PG8_STAGE_A(PG8_SA(1, 0), a3, 0, g2);
            PG8_WAIT_V(8); PG8_WAIT_L(0); PG8_BAR; PG8_MMA(1, 0, At, B0); PG8_MMA(1, 1, At, B1); PG8_BAR; PG8_SCHED;
        }
        if constexpr (ALIGN_EPI) { if (wr == 0) PG8_BAR; }
        E(acc, cur, wr, wc, fr, fq);
        if (!has_next) break;
#pragma unroll
        for (int a = 0; a < 2; ++a)
#pragma unroll
            for (int b = 0; b < 2; ++b)
#pragma unroll
                for (int m = 0; m < 4; ++m)
#pragma unroll
                    for (int n = 0; n < 2; ++n) acc[a][b][m][n] = (f32x4){0.f, 0.f, 0.f, 0.f};
        cur = nxt; cA = nA; cB = nB; ++ui;
        if constexpr (GATHER) {
#pragma unroll
        for (int h = 0; h < 2; ++h)
#pragma unroll
            for (int i = 0; i < 2; ++i) gc[h][i] = gn[h][i]; }
        if constexpr (ALIGN_EPI) { if (wr == 1) PG8_BAR; }
    }
    PG8_WAIT_V(0);
    if constexpr (!ALIGN_EPI) { if (wr == 0) PG8_BAR; }
    PG8_BAR;
#undef PG8_SA
#undef PG8_SB
#undef PG8_STAGE
#undef PG8_STAGE_A
#undef PG8_LDA
#undef PG8_LDB
#undef PG8_MMA
#undef PG8_WAIT_V
#undef PG8_WAIT_L
#undef PG8_BAR
#undef PG8_SCHED
}
}
typedef __attribute__((address_space(3))) unsigned char lds_u8;

__device__ __forceinline__ u32x4 pack8(const f32x4& a, const f32x4& b) { return (u32x4){pg8::cvt_pk_bf16(a.x, a.y), pg8::cvt_pk_bf16(a.z, a.w), pg8::cvt_pk_bf16(b.x, b.y), pg8::cvt_pk_bf16(b.z, b.w)}; }
struct EpiInM {
  static constexpr bool PERM = true;
  unsigned char* ws;
  __device__ __forceinline__ void operator()(const f32x4 (&acc)[2][2][4][2], const pg8::Unit& u, int wr, int wc, int fr, int fq) const {
    const float* cs = (const float*)(ws + WS_ROPE); const float* sn = cs + SEQ * 32;
    const int pn = u.pn;
#pragma unroll
    for (int ai = 0; ai < 2; ++ai)
#pragma unroll
      for (int m = 0; m < 4; ++m) {
        const int row = u.pm * 256 + ai * 128 + wr * 64 + m * 16 + fr, pos = row & (SEQ - 1);
#pragma unroll
        for (int bj = 0; bj < 2; ++bj) {
          const int w = bj * 128 + wc * 32 + 8 * fq;
          f32x4 v0 = acc[ai][bj][m][0], v1 = acc[ai][bj][m][1];
          const bool do_rope = (pn == 0) || (pn == 1 && bj == 0) || (pn == 2) || (pn == 3 && bj == 0 && wc < 2);
          if (do_rope) { const int d = (w & 63) >> 1; const f32x4 c4 = *(const f32x4*)(cs + pos * 32 + d), s4 = *(const f32x4*)(sn + pos * 32 + d);
            const f32x4 o0 = {v0.x * c4.x - v0.y * s4.x, v0.y * c4.x + v0.x * s4.x, v0.z * c4.y - v0.w * s4.y, v0.w * c4.y + v0.z * s4.y};
            const f32x4 o1 = {v1.x * c4.z - v1.y * s4.z, v1.y * c4.z + v1.x * s4.z, v1.z * c4.w - v1.w * s4.w, v1.w * c4.w + v1.z * s4.w};
            v0 = o0; v1 = o1; }
          if (pn == 0) { *(u32x4*)((bf16_t*)(ws + WS_QA) + (size_t)row * 384 + w) = pack8(v0 * QSCALE, v1 * QSCALE); }
          else if (pn == 1) { if (bj == 0) *(u32x4*)((bf16_t*)(ws + WS_QA) + (size_t)row * 384 + 256 + w) = pack8(v0 * QSCALE, v1 * QSCALE);
                              else *(u32x4*)((bf16_t*)(ws + WS_CKV) + (size_t)row * 128 + (w - 128)) = pack8(v0, v1); }
          else if (pn == 2) { *(u32x4*)((bf16_t*)(ws + WS_IQ) + (size_t)row * 256 + w) = pack8(v0, v1); }
          else if (pn == 3) { if (bj == 0) { if (wc < 2) *(u32x4*)((bf16_t*)(ws + WS_IK) + (size_t)row * 64 + w) = pack8(v0, v1);
                                             else if (wc == 2 && fq < 2) { if (fq == 0) v0 = v0 * 0.0625f; float* o = (float*)(ws + WS_SM) + (size_t)row * 16 + 8 * fq; *(f32x4*)o = v0; *(f32x4*)(o + 4) = v1; } } }
          else if (pn == 4) { *(u32x4*)((bf16_t*)(ws + WS_QC) + (size_t)row * 256 + w) = pack8(v0 * QSCALE, v1 * QSCALE); }
          else { *(u32x4*)((bf16_t*)(ws + WS_GB) + (size_t)row * 1536 + (pn - 5) * 256 + w) = pack8(v0, v1); }
        }
      }
  }
};
struct EpiMemKVM {
  static constexpr bool PERM = true;
  unsigned char* ws;
  __device__ __forceinline__ void operator()(const f32x4 (&acc)[2][2][4][2], const pg8::Unit& u, int wr, int wc, int fr, int fq) const {
#pragma unroll
    for (int ai = 0; ai < 2; ++ai)
#pragma unroll
      for (int m = 0; m < 4; ++m) {
        const int row = u.pm * 256 + ai * 128 + wr * 64 + m * 16 + fr;
#pragma unroll
        for (int bj = 0; bj < 2; ++bj) {
          const int w = bj * 128 + wc * 32 + 8 * fq; const f32x4 v0 = acc[ai][bj][m][0], v1 = acc[ai][bj][m][1];
          if (u.pn == 0) *(u32x4*)((bf16_t*)(ws + WS_MK) + (size_t)row * 256 + w) = pack8(v0, v1);
          else { const int mem = row & 255, xx = mem & 31, mpos = (mem & ~31) + 8 * ((xx >> 2) & 3) + (xx & 3) + 4 * (xx >> 4);
            bf16_t* o = (bf16_t*)(ws + WS_MVT) + ((size_t)(row >> 8) * 256 + w) * 256 + mpos;
            o[0] = f2bf(v0.x); o[256] = f2bf(v0.y); o[512] = f2bf(v0.z); o[768] = f2bf(v0.w); o[1024] = f2bf(v1.x); o[1280] = f2bf(v1.y); o[1536] = f2bf(v1.z); o[1792] = f2bf(v1.w); }
        }
      }
  }
};
struct EpiOutM {
  static constexpr bool PERM = true;
  const float* x; bf16_t* y;
  __device__ __forceinline__ void operator()(const f32x4 (&acc)[2][2][4][2], const pg8::Unit& u, int wr, int wc, int fr, int fq) const {
#pragma unroll
    for (int ai = 0; ai < 2; ++ai)
#pragma unroll
      for (int m = 0; m < 4; ++m) {
        const size_t rb = (size_t)(u.pm * 256 + ai * 128 + wr * 64 + m * 16 + fr) * 1024 + u.pn * 256 + wc * 32 + 8 * fq;
#pragma unroll
        for (int bj = 0; bj < 2; ++bj) { const size_t o = rb + bj * 128; const f32x4 x0 = *(const f32x4*)(x + o), x1 = *(const f32x4*)(x + o + 4);
          *(u32x4*)(y + o) = pack8(x0 * ALPHA + acc[ai][bj][m][0], x1 * ALPHA + acc[ai][bj][m][1]); }
      }
  }
};
struct MoeOrder {
  const int* offs; const int* cnts; int npn, G, c; const unsigned* LIST;
  __device__ __forceinline__ bool next(int i, pg8::Unit& u) const {
    const int L = i * G + c; const int ntiles = __builtin_amdgcn_readfirstlane(offs[64]) >> 8;
    if (L >= ntiles * npn) return false;
    const int rt = L / npn, pl = L - rt * npn; int e = 0;
    while (__builtin_amdgcn_readfirstlane(offs[e + 1]) <= rt * 256) ++e;
    u.pm = rt; u.mt = rt - (__builtin_amdgcn_readfirstlane(offs[e]) >> 8); u.e = e; u.pn = e * npn + pl; u.aux = __builtin_amdgcn_readfirstlane(cnts[e]); return true;
  }
  __device__ __forceinline__ unsigned arow(const pg8::Unit& u, int r) const { const int rank = u.mt * 256 + r; return rank < u.aux ? LIST[(size_t)u.e * 32768 + rank] : 0u; }
};
struct EpiMoeUpM {
  static constexpr bool PERM = true;
  bf16_t* H;
  __device__ __forceinline__ void operator()(const f32x4 (&acc)[2][2][4][2], const pg8::Unit& u, int wr, int wc, int fr, int fq) const {
    const int pl = u.pn & 1;
#pragma unroll
    for (int ai = 0; ai < 2; ++ai)
#pragma unroll
      for (int m = 0; m < 4; ++m) {
        const int rl = ai * 128 + wr * 64 + m * 16 + fr;
        if (u.mt * 256 + rl < u.aux) {
          f32x4 h0, h1; const f32x4 g0 = acc[ai][0][m][0], g1 = acc[ai][0][m][1], u0 = acc[ai][1][m][0], u1 = acc[ai][1][m][1];
          h0.x = silu_f(g0.x) * u0.x; h0.y = silu_f(g0.y) * u0.y; h0.z = silu_f(g0.z) * u0.z; h0.w = silu_f(g0.w) * u0.w;
          h1.x = silu_f(g1.x) * u1.x; h1.y = silu_f(g1.y) * u1.y; h1.z = silu_f(g1.z) * u1.z; h1.w = silu_f(g1.w) * u1.w;
          *(u32x4*)(H + (size_t)(u.pm * 256 + rl) * 256 + pl * 128 + wc * 32 + 8 * fq) = pack8(h0, h1);
        }
      }
  }
};
__device__ __forceinline__ unsigned pk4_fp8(const f32x4& v) { unsigned w = __builtin_amdgcn_cvt_pk_fp8_f32(v.x, v.y, 0u, false); return __builtin_amdgcn_cvt_pk_fp8_f32(v.z, v.w, w, true); }
struct EpiMoeDownM {
  static constexpr bool PERM = true;
  unsigned char* Y; const float* GATEL;
  __device__ __forceinline__ void operator()(const f32x4 (&acc)[2][2][4][2], const pg8::Unit& u, int wr, int wc, int fr, int fq) const {
    const int pl = u.pn & 3;
    const float* gp = GATEL + (size_t)u.e * 32768; const int rk0 = u.mt * 256 + wr * 64 + fr;
    unsigned char* yp = Y + (size_t)(u.pm * 256 + wr * 64 + fr) * 1024 + pl * 256 + wc * 32 + 8 * fq;
#pragma unroll
    for (int ai = 0; ai < 2; ++ai)
#pragma unroll
      for (int m = 0; m < 4; ++m) {
        const int rk = rk0 + ai * 128 + m * 16; const float gt = gp[rk < 32767 ? rk : 32767] * 64.0f;
#pragma unroll
        for (int bj = 0; bj < 2; ++bj)
          *(u32x2*)(yp + (size_t)(ai * 128 + m * 16) * 1024 + bj * 128) = (u32x2){pk4_fp8(acc[ai][bj][m][0] * gt), pk4_fp8(acc[ai][bj][m][1] * gt)};
      }
  }
};

__device__ __forceinline__ void phase_inproj_mfma(const Ctx& c, lds_u8* lds) {
  unsigned char* ws = c.ws; const int tid = phase_tid();
  { pg8::Gemm g{(const bf16_t*)(ws + WS_XB), (const bf16_t*)(ws + WS_WIN), 1024}; pg8::StaticOrder S; S.init(T, NIN, gridDim.x, blockIdx.x); EpiInM E{ws};
    pg8::gemm_phase<EpiInM, pg8::StaticOrder, true, false>(lds, g, S, E, tid); }
  { pg8::Gemm g{(const bf16_t*)(ws + WS_MEMB), (const bf16_t*)(ws + WS_WMKV), 1024}; pg8::StaticOrder S; S.init(TM, 512, gridDim.x, (int)blockIdx.x - 128); EpiMemKVM E{ws};
    pg8::gemm_phase<EpiMemKVM, pg8::StaticOrder, true, false>(lds, g, S, E, tid); }
}
__device__ __forceinline__ void phase_outproj_mfma(const Ctx& c, lds_u8* lds) {
  unsigned char* ws = c.ws; const int tid = phase_tid();
  pg8::Gemm g{(const bf16_t*)(ws + WS_CAT), (const bf16_t*)(ws + WS_WO), 1024}; pg8::StaticOrder S; S.init(T, 1024, gridDim.x, blockIdx.x); EpiOutM E{c.in[0], (bf16_t*)(ws + WS_X1B)};
  pg8::gemm_phase<EpiOutM, pg8::StaticOrder, true, false>(lds, g, S, E, tid);
}
__device__ __forceinline__ void phase_moe_up_mfma(const Ctx& c, lds_u8* lds) {
  unsigned char* ws = c.ws; const int tid = phase_tid();
  int* offs = (int*)((unsigned char*)lds + pg8::STAGE_BYTES); int* cnts = offs + 65;
  expert_offsets(c, offs, cnts, tid);
  pg8::Gemm g{(const bf16_t*)(ws + WS_X1B), (const bf16_t*)(ws + WS_WGU), 1024};
  MoeOrder S{offs, cnts, 2, (int)gridDim.x, (int)blockIdx.x, (const unsigned*)(ws + WS_LIST)}; EpiMoeUpM E{(bf16_t*)(ws + WS_H)};
  pg8::gemm_phase<EpiMoeUpM, MoeOrder, true, true>(lds, g, S, E, tid);
}
__device__ __forceinline__ void phase_moe_down_mfma(const Ctx& c, lds_u8* lds) {
  unsigned char* ws = c.ws; const int tid = phase_tid();
  int* offs = (int*)((unsigned char*)lds + pg8::STAGE_BYTES); int* cnts = offs + 65;
  expert_offsets(c, offs, cnts, tid);
  pg8::Gemm g{(const bf16_t*)(ws + WS_H), (const bf16_t*)(ws + WS_WD), 256};
  MoeOrder S{offs, cnts, 4, (int)gridDim.x, (int)blockIdx.x, nullptr}; EpiMoeDownM E{(unsigned char*)(ws + WS_Y), (const float*)(ws + WS_GATEL)};
  pg8::gemm_phase<EpiMoeDownM, MoeOrder, true, false>(lds, g, S, E, tid);
}

__device__ void phase_kvup(const Ctx& c, float* lds) {
  unsigned char* ws = c.ws;
  const int tid = phase_tid(), lane = tid & 63, wave = tid >> 6, fr = lane & 15, fq = lane >> 4;
  const bf16_t* W = (const bf16_t*)(ws + WS_WKV);
  const bf16_t* CKV = (const bf16_t*)(ws + WS_CKV); bf16_t* KVA = (bf16_t*)(ws + WS_KVA);
  const float* cs = (const float*)(ws + WS_ROPE); const float* sn = cs + SEQ * 32;
  for (int tile = blockIdx.x * NWAVES + wave; tile < T / 16; tile += gridDim.x * NWAVES) {
    const int t = tile * 16 + fr, pos = t & (SEQ - 1);
    pg8::bf16x8 bx[4]; float ss = 0.f;
#pragma unroll
    for (int ks = 0; ks < 4; ++ks) { const u32x4 v = *(const u32x4*)(CKV + (size_t)t * 128 + ks * 32 + fq * 8); bx[ks] = __builtin_bit_cast(pg8::bf16x8, v);
      const float f[8] = {__uint_as_float(v.x << 16), __uint_as_float(v.x & 0xffff0000u), __uint_as_float(v.y << 16), __uint_as_float(v.y & 0xffff0000u), __uint_as_float(v.z << 16), __uint_as_float(v.z & 0xffff0000u), __uint_as_float(v.w << 16), __uint_as_float(v.w & 0xffff0000u)};
#pragma unroll
      for (int e = 0; e < 8; ++e) ss += f[e] * f[e]; }
    ss += __shfl_xor(ss, 16); ss += __shfl_xor(ss, 32);
    const float rstd = rsqrtf(ss * (1.f / 128.f) + 1e-6f);
#pragma unroll
    for (int nt = 0; nt < 8; ++nt) { f32x4 d = {0.f, 0.f, 0.f, 0.f};
#pragma unroll
      for (int ks = 0; ks < 4; ++ks) d = __builtin_amdgcn_mfma_f32_16x16x32_bf16(*(const pg8::bf16x8*)(W + (size_t)(nt * 16 + fr) * 128 + ks * 32 + fq * 8), bx[ks], d, 0, 0, 0);
      d = d * rstd;
      const int p0 = nt * 16 + fq * 4;
      if (nt < 4) { const int dd = p0 >> 1; const float c0 = cs[pos * 32 + dd], s0 = sn[pos * 32 + dd], c1 = cs[pos * 32 + dd + 1], s1 = sn[pos * 32 + dd + 1];
        const f32x4 o = {d.x * c0 - d.y * s0, d.y * c0 + d.x * s0, d.z * c1 - d.w * s1, d.w * c1 + d.z * s1}; d = o; }
      *(u32x2*)(KVA + (size_t)t * 128 + p0) = (u32x2){pg8::cvt_pk_bf16(d.x, d.y), pg8::cvt_pk_bf16(d.z, d.w)}; }
  }
}


typedef _Float16 h16x2 __attribute__((ext_vector_type(2)));
constexpr int TK_KP = 4104;
constexpr int TK_KEYS = 0, TK_H1 = 16 * TK_KP * 2, TK_H2 = TK_H1 + 16 * 128 * 4, TK_MISC = TK_H2 + 8 * 128 * 4;
__device__ __forceinline__ unsigned mono16x2(unsigned u) { const unsigned m = ((u >> 15) & 0x00010001u) * 0xffffu; return u ^ (m | 0x80008000u); }
__device__ __forceinline__ int wave_incl_scan(int x) {
  x += __builtin_amdgcn_update_dpp(0, x, 0x111, 0xF, 0xF, true);
  x += __builtin_amdgcn_update_dpp(0, x, 0x112, 0xF, 0xF, true);
  x += __builtin_amdgcn_update_dpp(0, x, 0x114, 0xF, 0xF, true);
  x += __builtin_amdgcn_update_dpp(0, x, 0x118, 0xF, 0xF, true);
  x += __builtin_amdgcn_update_dpp(0, x, 0x142, 0xA, 0xF, false);
  x += __builtin_amdgcn_update_dpp(0, x, 0x143, 0xC, 0xF, false);
  return x;
}

__device__ __forceinline__ void hist_find(const unsigned* hw, int need, int lane, int& B, int& above) {
  const unsigned w0 = hw[127 - 2 * lane], w1 = hw[126 - 2 * lane];
  const int c0 = (int)(w0 >> 16), c1 = (int)(w0 & 0xffffu), c2 = (int)(w1 >> 16), c3 = (int)(w1 & 0xffffu);
  const int tl = c0 + c1 + c2 + c3;
  const int incl = wave_incl_scan(tl);
  const int excl = incl - tl;
  const bool hit = (excl < need) && (incl >= need);
  int b = 0, ab = 0;
  if (hit) { int a = excl; b = 255 - 4 * lane; ab = a;
    if (a + c0 < need) { a += c0; b = 254 - 4 * lane; ab = a; if (a + c1 < need) { a += c1; b = 253 - 4 * lane; ab = a; if (a + c2 < need) { a += c2; b = 252 - 4 * lane; ab = a; } } } }
  const unsigned long long m = __ballot(hit);
  const int src = __builtin_amdgcn_readfirstlane(m ? (__ffsll((long long)m) - 1) : 0);
  B = __builtin_amdgcn_readlane(b, src); above = __builtin_amdgcn_readlane(ab, src);
}
__device__ void phase_topk_mfma(const Ctx& c, unsigned char* ldsb, unsigned* qhead) {
  unsigned char* ws = c.ws;
  const int tid = phase_tid(), lane = tid & 63, wave = tid >> 6, fr = lane & 15, fq = lane >> 4;
  unsigned short* keys = (unsigned short*)(ldsb + TK_KEYS);
  unsigned* h1 = (unsigned*)(ldsb + TK_H1); unsigned* h2 = (unsigned*)(ldsb + TK_H2) + wave * 128; int* misc = (int*)(ldsb + TK_MISC);
  const bf16_t* IQ = (const bf16_t*)(ws + WS_IQ); const bf16_t* IK = (const bf16_t*)(ws + WS_IK); const float* SM = (const float*)(ws + WS_SM);
  unsigned short* SEL = (unsigned short*)(ws + WS_SEL);
  WorkQ wq; wq_init(wq, qhead, misc, tid);
  for (;;) {
    const int item = wq_next(wq, tid);
    if (item >= 240 * 8) break;
    const int b = item & 7, qb = 255 - (item >> 3), s0 = qb * 16;
    for (int i = tid; i < 16 * 128; i += NTHREADS) h1[i] = 0u;
    const size_t qrow = (size_t)b * SEQ + s0 + fr;
    pg8::bf16x8 bq[4][2];
#pragma unroll
    for (int hh = 0; hh < 4; ++hh)
#pragma unroll
      for (int ks = 0; ks < 2; ++ks) bq[hh][ks] = *(const pg8::bf16x8*)(IQ + qrow * 256 + hh * 64 + ks * 32 + fq * 8);
    const f32x4 iw = *(const f32x4*)(SM + qrow * 16);
    const int nkt = qb + 1, slim = s0 + fr;
    __syncthreads();
    pg8::bf16x8 a0n = {0, 0, 0, 0, 0, 0, 0, 0}, a1n = a0n;
    if (wave < nkt) { const bf16_t* kr = IK + ((size_t)b * SEQ + wave * 16 + fr) * 64 + fq * 8; a0n = *(const pg8::bf16x8*)kr; a1n = *(const pg8::bf16x8*)(kr + 32); }
    for (int kt = wave; kt < nkt; kt += NWAVES) {
      const pg8::bf16x8 a0 = a0n, a1 = a1n;
      if (kt + NWAVES < nkt) { const bf16_t* kr = IK + ((size_t)b * SEQ + (kt + NWAVES) * 16 + fr) * 64 + fq * 8; a0n = *(const pg8::bf16x8*)kr; a1n = *(const pg8::bf16x8*)(kr + 32); }
      f32x4 sc = {0.f, 0.f, 0.f, 0.f};
#pragma unroll
      for (int hh = 0; hh < 4; ++hh) { f32x4 d = {0.f, 0.f, 0.f, 0.f};
        d = __builtin_amdgcn_mfma_f32_16x16x32_bf16(a0, bq[hh][0], d, 0, 0, 0); d = __builtin_amdgcn_mfma_f32_16x16x32_bf16(a1, bq[hh][1], d, 0, 0, 0);
        const float w = hh == 0 ? iw.x : hh == 1 ? iw.y : hh == 2 ? iw.z : iw.w;
        sc.x = fmaf(w, fmaxf(d.x, 0.f), sc.x); sc.y = fmaf(w, fmaxf(d.y, 0.f), sc.y); sc.z = fmaf(w, fmaxf(d.z, 0.f), sc.z); sc.w = fmaf(w, fmaxf(d.w, 0.f), sc.w); }
      unsigned k01 = mono16x2(__builtin_bit_cast(unsigned, __builtin_amdgcn_cvt_pkrtz(sc.x, sc.y))), k23 = mono16x2(__builtin_bit_cast(unsigned, __builtin_amdgcn_cvt_pkrtz(sc.z, sc.w)));
      const int kbase = kt * 16 + fq * 4;
      unsigned* hq = h1 + fr * 128;
      if (kt + 1 < nkt) {
        *(u32x2*)(keys + fr * TK_KP + kbase) = (u32x2){k01, k23};
        { const unsigned kk = k01 & 0xffffu; atomicAdd(hq + (kk >> 9), 1u << ((kk >> 4) & 16)); }
        { const unsigned kk = k01 >> 16; atomicAdd(hq + (kk >> 9), 1u << ((kk >> 4) & 16)); }
        { const unsigned kk = k23 & 0xffffu; atomicAdd(hq + (kk >> 9), 1u << ((kk >> 4) & 16)); }
        { const unsigned kk = k23 >> 16; atomicAdd(hq + (kk >> 9), 1u << ((kk >> 4) & 16)); }
      } else {
        if (kbase + 0 > slim) k01 &= 0xffff0000u; if (kbase + 1 > slim) k01 &= 0x0000ffffu;
        if (kbase + 2 > slim) k23 &= 0xffff0000u; if (kbase + 3 > slim) k23 &= 0x0000ffffu;
        *(u32x2*)(keys + fr * TK_KP + kbase) = (u32x2){k01, k23};
        if (kbase + 0 <= slim) { const unsigned kk = k01 & 0xffffu; atomicAdd(hq + (kk >> 9), 1u << ((kk >> 4) & 16)); }
        if (kbase + 1 <= slim) { const unsigned kk = k01 >> 16; atomicAdd(hq + (kk >> 9), 1u << ((kk >> 4) & 16)); }
        if (kbase + 2 <= slim) { const unsigned kk = k23 & 0xffffu; atomicAdd(hq + (kk >> 9), 1u << ((kk >> 4) & 16)); }
        if (kbase + 3 <= slim) { const unsigned kk = k23 >> 16; atomicAdd(hq + (kk >> 9), 1u << ((kk >> 4) & 16)); }
      }
    }
    __syncthreads();
    for (int qi = 0; qi < 2; ++qi) {
      const int q = wave * 2 + qi, s = s0 + q, n = s + 1;
      int B1, above1; hist_find(h1 + q * 128, 256, lane, B1, above1);
      const int need1 = 256 - above1;
      h2[lane] = 0u; h2[64 + lane] = 0u;
      const unsigned short* kq = keys + q * TK_KP;
      const int niter = (n + 511) >> 9;
      for (int it = 0; it < niter; ++it) {
        const int i0 = (it * 64 + lane) * 8; const u32x4 kv = *(const u32x4*)(kq + i0);
        const unsigned k8[8] = {kv.x & 0xffffu, kv.x >> 16, kv.y & 0xffffu, kv.y >> 16, kv.z & 0xffffu, kv.z >> 16, kv.w & 0xffffu, kv.w >> 16};
#pragma unroll
        for (int e = 0; e < 8; ++e) if (i0 + e < n && (int)(k8[e] >> 8) == B1) atomicAdd(h2 + ((k8[e] & 255u) >> 1), 1u << ((k8[e] & 1u) * 16));
      }
      int B2, above2; hist_find(h2, need1, lane, B2, above2);
      const unsigned thr = (unsigned)((B1 << 8) | B2); const int need = need1 - above2;
      unsigned short* dummy = (unsigned short*)(misc + 8 + wave);
      unsigned short* sel = (unsigned short*)h2;
      asm volatile("s_waitcnt lgkmcnt(0)" ::: "memory");
      int tiebase = 0, outbase = 0;
      for (int it = 0; it < niter; ++it) {
        const int i0 = (it * 64 + lane) * 8; const u32x4 kv = *(const u32x4*)(kq + i0);
        const unsigned k8[8] = {kv.x & 0xffffu, kv.x >> 16, kv.y & 0xffffu, kv.y >> 16, kv.z & 0xffffu, kv.z >> 16, kv.w & 0xffffu, kv.w >> 16};
        int cg = 0, ce = 0;
#pragma unroll
        for (int e = 0; e < 8; ++e) { const bool v = i0 + e < n; cg += (v && k8[e] > thr) ? 1 : 0; ce += (v && k8[e] == thr) ? 1 : 0; }
        int tk = 0;
        if (__ballot(ce != 0)) {
          const int eincl = wave_incl_scan(ce); const int eg = tiebase + eincl - ce;
          tk = need - eg; tk = tk < 0 ? 0 : (tk > ce ? ce : tk);
          tiebase += __builtin_amdgcn_readlane(eincl, 63);
        }
        const int oc = cg + tk; const int oincl = wave_incl_scan(oc);
        int pos = outbase + oincl - oc; int tleft = tk;
#pragma unroll
        for (int e = 0; e < 8; ++e) { const bool v = i0 + e < n; const bool tie = v && k8[e] == thr && tleft > 0; const bool take = (v && k8[e] > thr) || tie;
          tleft -= tie ? 1 : 0;
          unsigned short* dst = (take && pos < 256) ? sel + pos : dummy;
          *dst = (unsigned short)(i0 + e); pos += take ? 1 : 0; }
        outbase += __builtin_amdgcn_readlane(oincl, 63);
      }
      asm volatile("s_waitcnt lgkmcnt(0)" ::: "memory");
      *(u32x2*)(SEL + ((size_t)b * SEQ + s) * 256 + lane * 4) = *(const u32x2*)(sel + lane * 4);
      asm volatile("s_waitcnt lgkmcnt(0)" ::: "memory");
    }
  }
}

typedef short s16x4 __attribute__((ext_vector_type(4)));
__device__ __forceinline__ s16x4 lds_tr16(const unsigned char* p) { return __builtin_bit_cast(s16x4, __builtin_amdgcn_ds_read_tr16_b64_v4i16((__attribute__((address_space(3))) s16x4*)(__attribute__((address_space(3))) unsigned char*)p)); }
typedef float f32x2_t __attribute__((ext_vector_type(2))); typedef __bf16 bf16x2_t __attribute__((ext_vector_type(2)));
__device__ __forceinline__ unsigned cvtpk_c(float lo, float hi) { const f32x2_t v = {lo, hi}; const bf16x2_t b = __builtin_convertvector(v, bf16x2_t); return __builtin_bit_cast(unsigned, b); }
__device__ __forceinline__ pg8::bf16x8 packp(const f32x4& a, const f32x4& b) {
  const u32x4 w = {cvtpk_c(a.x, a.y), cvtpk_c(a.z, a.w), cvtpk_c(b.x, b.y), cvtpk_c(b.z, b.w)}; return __builtin_bit_cast(pg8::bf16x8, w); }
constexpr int AT_WB = 9216 + 512;
__device__ void phase_attn_sparse(const Ctx& c, unsigned char* ldsb, unsigned* qhead) {
  unsigned char* ws = c.ws;
  const int tid = phase_tid(), lane = tid & 63, wave = tid >> 6, fr = lane & 15, fq = lane >> 4;
  unsigned char* vl = ldsb + wave * AT_WB; unsigned short* sl = (unsigned short*)(vl + 9216);
  const bf16_t* QA = (const bf16_t*)(ws + WS_QA); const bf16_t* KVA = (const bf16_t*)(ws + WS_KVA); const unsigned short* SEL = (const unsigned short*)(ws + WS_SEL);
  const bf16_t* QC = (const bf16_t*)(ws + WS_QC); const bf16_t* MK = (const bf16_t*)(ws + WS_MK); const bf16_t* MVT = (const bf16_t*)(ws + WS_MVT);
  bf16_t* CAT = (bf16_t*)(ws + WS_CAT);
  const float* gA = c.in[10]; const float* gC = c.in[11];
  const pg8::bf16x8 zero8 = {0, 0, 0, 0, 0, 0, 0, 0};
  __syncthreads();
  int* aq_slot = (int*)(ldsb + 8 * AT_WB);
  WorkQ wq; wq_init(wq, qhead, aq_slot, tid);
  for (;;) {
  const int item = wq_next(wq, tid);
  if (item >= 512) break;
  for (int tj = 0; tj < 8; ++tj) {
    const int t = item * 64 + wave * 8 + tj;
    const int b = t >> 12, s = t & (SEQ - 1), n = s + 1 < 256 ? s + 1 : 256;
    { u32x2 v;
      if (s >= 256) v = *(const u32x2*)(SEL + (size_t)t * 256 + lane * 4);
      else { const int i0 = lane * 4; const unsigned e0 = i0 < n ? i0 : 0, e1 = i0 + 1 < n ? i0 + 1 : 0, e2 = i0 + 2 < n ? i0 + 2 : 0, e3 = i0 + 3 < n ? i0 + 3 : 0; v = (u32x2){e0 | (e1 << 16), e2 | (e3 << 16)}; }
      *(u32x2*)(sl + lane * 4) = v; }
    asm volatile("s_waitcnt lgkmcnt(0)" ::: "memory");
    pg8::bf16x8 bq0 = zero8, bq1 = zero8;
    if (fr < 6) { const bf16_t* qp = QA + (size_t)t * 384 + fr * 64 + fq * 8; bq0 = *(const pg8::bf16x8*)qp; bq1 = *(const pg8::bf16x8*)(qp + 32); }
    const bf16_t* kvb = KVA + (size_t)b * SEQ * 128;
    f32x4 st[16];
#pragma unroll
    for (int kt = 0; kt < 16; ++kt) { const int key = sl[kt * 16 + fr]; const bf16_t* kr = kvb + (size_t)key * 128 + fq * 8;
      const pg8::bf16x8 a0 = *(const pg8::bf16x8*)kr, a1 = *(const pg8::bf16x8*)(kr + 32);
      f32x4 d = {0.f, 0.f, 0.f, 0.f};
      d = __builtin_amdgcn_mfma_f32_16x16x32_bf16(a0, bq0, d, 0, 0, 0); st[kt] = __builtin_amdgcn_mfma_f32_16x16x32_bf16(a1, bq1, d, 0, 0, 0); }
    float mx = -3.0e38f;
    if (n < 256) {
#pragma unroll
      for (int kt = 0; kt < 16; ++kt) { const int sb = kt * 16 + fq * 4;
        if (sb + 0 >= n) st[kt].x = -3.0e38f; if (sb + 1 >= n) st[kt].y = -3.0e38f; if (sb + 2 >= n) st[kt].z = -3.0e38f; if (sb + 3 >= n) st[kt].w = -3.0e38f; } }
#pragma unroll
    for (int kt = 0; kt < 16; ++kt) mx = fmaxf(fmaxf(fmaxf(mx, st[kt].x), fmaxf(st[kt].y, st[kt].z)), st[kt].w);
    mx = fmaxf(mx, __shfl_xor(mx, 16)); mx = fmaxf(mx, __shfl_xor(mx, 32));
    float l = 0.f;
#pragma unroll
    for (int kt = 0; kt < 16; ++kt) { st[kt].x = __builtin_amdgcn_exp2f(st[kt].x - mx); st[kt].y = __builtin_amdgcn_exp2f(st[kt].y - mx); st[kt].z = __builtin_amdgcn_exp2f(st[kt].z - mx); st[kt].w = __builtin_amdgcn_exp2f(st[kt].w - mx);
      l += (st[kt].x + st[kt].y) + (st[kt].z + st[kt].w); }
    l += __shfl_xor(l, 16); l += __shfl_xor(l, 32);
    f32x4 ot[4];
#pragma unroll
    for (int mt = 0; mt < 4; ++mt) ot[mt] = (f32x4){0.f, 0.f, 0.f, 0.f};
    u32x4 vv[8];
#pragma unroll
    for (int i = 0; i < 8; ++i) { const int key = sl[i * 8 + (lane >> 3)]; vv[i] = *(const u32x4*)(kvb + (size_t)key * 128 + 64 + (lane & 7) * 8); }
#pragma unroll
    for (int ch = 0; ch < 4; ++ch) {
#pragma unroll
      for (int i = 0; i < 8; ++i) *(u32x4*)(vl + (i * 8 + (lane >> 3)) * 144 + (lane & 7) * 16) = vv[i];
      if (ch < 3) {
#pragma unroll
        for (int i = 0; i < 8; ++i) { const int key = sl[(ch + 1) * 64 + i * 8 + (lane >> 3)]; vv[i] = *(const u32x4*)(kvb + (size_t)key * 128 + 64 + (lane & 7) * 8); } }
      asm volatile("s_waitcnt lgkmcnt(0)" ::: "memory");
#pragma unroll
      for (int k2 = 0; k2 < 2; ++k2) { const int kk = ch * 2 + k2; const pg8::bf16x8 pf = packp(st[2 * kk], st[2 * kk + 1]);
        const unsigned char* base = vl + (k2 * 32 + fq * 4 + (fr >> 2)) * 144 + (fr & 3) * 8;
#pragma unroll
        for (int mt = 0; mt < 4; ++mt) { const s16x4 lo = lds_tr16(base + mt * 32), hi = lds_tr16(base + 16 * 144 + mt * 32);
          const pg8::bf16x8 af = {lo[0], lo[1], lo[2], lo[3], hi[0], hi[1], hi[2], hi[3]};
          ot[mt] = __builtin_amdgcn_mfma_f32_16x16x32_bf16(af, pf, ot[mt], 0, 0, 0); } }
      asm volatile("s_waitcnt lgkmcnt(0)" ::: "memory");
    }
    const float il = __builtin_amdgcn_rcpf(l); float ss = 0.f;
#pragma unroll
    for (int mt = 0; mt < 4; ++mt) { ot[mt] = ot[mt] * il; ss += (ot[mt].x * ot[mt].x + ot[mt].y * ot[mt].y) + (ot[mt].z * ot[mt].z + ot[mt].w * ot[mt].w); }
    if (fr >= 6) ss = 0.f;
#pragma unroll
    for (int o = 1; o < 64; o <<= 1) ss += __shfl_xor(ss, o);
    const float rstd = rsqrtf(ss * (1.f / 384.f) + 1e-6f);
    if (fr < 6) {
#pragma unroll
      for (int mt = 0; mt < 4; ++mt) { const int col = fr * 64 + mt * 16 + fq * 4; const f32x4 g = *(const f32x4*)(gA + col); const f32x4 o = ot[mt] * rstd * g;
        *(u32x2*)(CAT + (size_t)t * 1024 + col) = (u32x2){pg8::cvt_pk_bf16(o.x, o.y), pg8::cvt_pk_bf16(o.z, o.w)}; } }
  }
  }
}

__device__ void phase_attn_mem(const Ctx& c, unsigned char* ldsb, unsigned* qhead) {
  unsigned char* ws = c.ws;
  const int tid = phase_tid(), lane = tid & 63, wave = tid >> 6, fr = lane & 15, fq = lane >> 4;
  unsigned char* vl = ldsb + wave * AT_WB; unsigned short* sl = (unsigned short*)(vl + 9216);
  const bf16_t* QA = (const bf16_t*)(ws + WS_QA); const bf16_t* KVA = (const bf16_t*)(ws + WS_KVA); const unsigned short* SEL = (const unsigned short*)(ws + WS_SEL);
  const bf16_t* QC = (const bf16_t*)(ws + WS_QC); const bf16_t* MK = (const bf16_t*)(ws + WS_MK); const bf16_t* MVT = (const bf16_t*)(ws + WS_MVT);
  bf16_t* CAT = (bf16_t*)(ws + WS_CAT);
  const float* gA = c.in[10]; const float* gC = c.in[11];
  const pg8::bf16x8 zero8 = {0, 0, 0, 0, 0, 0, 0, 0};
  int* aq_slot = (int*)(ldsb + 70656 + 8 * 8192);
  WorkQ wq; wq_init(wq, qhead, aq_slot, tid);
  for (;;) {
  const int item = wq_next(wq, tid) + 512;
  if (item >= 768) break;
  {
    const int t0 = (item - 512) * 128 + wave * 16, b = t0 >> 12;
    unsigned char* mkl = ldsb; unsigned char* mvl = ldsb + 36864; unsigned char* ocl = ldsb + 70656 + wave * 8192;
    float ss = 0.f;
#pragma unroll 1
    for (int h = 0; h < 4; ++h) {
      __syncthreads();
#pragma unroll
      for (int i = 0; i < 4; ++i) { const int p = tid + 512 * i, row = p >> 3, cc = p & 7;
        *(u32x4*)(mkl + row * 144 + cc * 16) = *(const u32x4*)(MK + ((size_t)(b * 256 + row)) * 256 + h * 64 + cc * 8); }
#pragma unroll
      for (int i = 0; i < 4; ++i) { const int p = tid + 512 * i, row = p >> 5, cc = p & 31;
        *(u32x4*)(mvl + row * 528 + cc * 16) = *(const u32x4*)(MVT + ((size_t)(b * 256 + h * 64 + row)) * 256 + cc * 8); }
      __syncthreads();
      f32x4 oc[4];
      const bf16_t* qp = QC + (size_t)(t0 + fr) * 256 + h * 64 + fq * 8;
      const pg8::bf16x8 bq0 = *(const pg8::bf16x8*)qp, bq1 = *(const pg8::bf16x8*)(qp + 32);
      f32x4 st[16];
#pragma unroll
      for (int kt = 0; kt < 16; ++kt) { const unsigned char* kr = mkl + (kt * 16 + fr) * 144 + fq * 16;
        const pg8::bf16x8 a0 = *(const pg8::bf16x8*)kr, a1 = *(const pg8::bf16x8*)(kr + 64);
        f32x4 d = {0.f, 0.f, 0.f, 0.f};
        d = __builtin_amdgcn_mfma_f32_16x16x32_bf16(a0, bq0, d, 0, 0, 0); st[kt] = __builtin_amdgcn_mfma_f32_16x16x32_bf16(a1, bq1, d, 0, 0, 0); }
      float mx = -3.0e38f;
#pragma unroll
      for (int kt = 0; kt < 16; ++kt) mx = fmaxf(fmaxf(fmaxf(mx, st[kt].x), fmaxf(st[kt].y, st[kt].z)), st[kt].w);
      mx = fmaxf(mx, __shfl_xor(mx, 16)); mx = fmaxf(mx, __shfl_xor(mx, 32));
      float l = 0.f;
#pragma unroll
      for (int kt = 0; kt < 16; ++kt) { st[kt].x = __builtin_amdgcn_exp2f(st[kt].x - mx); st[kt].y = __builtin_amdgcn_exp2f(st[kt].y - mx); st[kt].z = __builtin_amdgcn_exp2f(st[kt].z - mx); st[kt].w = __builtin_amdgcn_exp2f(st[kt].w - mx);
        l += (st[kt].x + st[kt].y) + (st[kt].z + st[kt].w); }
      l += __shfl_xor(l, 16); l += __shfl_xor(l, 32);
#pragma unroll
      for (int mt = 0; mt < 4; ++mt) oc[mt] = (f32x4){0.f, 0.f, 0.f, 0.f};
#pragma unroll
      for (int kk = 0; kk < 8; ++kk) { const pg8::bf16x8 pf = packp(st[2 * kk], st[2 * kk + 1]);
#pragma unroll
        for (int mt = 0; mt < 4; ++mt) { const pg8::bf16x8 af = *(const pg8::bf16x8*)(mvl + (mt * 16 + fr) * 528 + (kk * 4 + fq) * 16);
          oc[mt] = __builtin_amdgcn_mfma_f32_16x16x32_bf16(af, pf, oc[mt], 0, 0, 0); } }
      const float il = __builtin_amdgcn_rcpf(l);
#pragma unroll
      for (int mt = 0; mt < 4; ++mt) { const f32x4 o = oc[mt] * il; ss += (o.x * o.x + o.y * o.y) + (o.z * o.z + o.w * o.w); *(u32x2*)(ocl + ((h * 4 + mt) * 64 + lane) * 8) = (u32x2){pg8::cvt_pk_bf16(o.x, o.y), pg8::cvt_pk_bf16(o.z, o.w)}; }
    }
    ss += __shfl_xor(ss, 16); ss += __shfl_xor(ss, 32);
    const float rstd = rsqrtf(ss * (1.f / 256.f) + 1e-6f);
#pragma unroll 1
    for (int h = 0; h < 4; ++h)
#pragma unroll
      for (int mt = 0; mt < 4; ++mt) { const int col = h * 64 + mt * 16 + fq * 4; const f32x4 g = *(const f32x4*)(gC + col); const u32x2 pp = *(const u32x2*)(ocl + ((h * 4 + mt) * 64 + lane) * 8);
        const f32x4 ov = {__uint_as_float(pp.x << 16), __uint_as_float(pp.x & 0xffff0000u), __uint_as_float(pp.y << 16), __uint_as_float(pp.y & 0xffff0000u)}; const f32x4 o = ov * rstd * g;
        *(u32x2*)(CAT + (size_t)(t0 + fr) * 1024 + 768 + col) = (u32x2){pg8::cvt_pk_bf16(o.x, o.y), pg8::cvt_pk_bf16(o.z, o.w)}; }
  }
  }
}

constexpr int GD_ITEM = 41088;
__device__ __forceinline__ unsigned char* gd_item(unsigned char* ws, int it) { return it < 1536 ? ws + WS_XB + (size_t)it * GD_ITEM : ws + WS_X1B + (size_t)(it - 1536) * GD_ITEM; }
__device__ __forceinline__ int kperm(int x) { return (x & 32) | (((x >> 2) & 3) << 3) | (x & 3) | (((x >> 4) & 1) << 2); }
constexpr int GP_KB = 0, GP_KBB = 9216, GP_QB = 18432, GP_VBT = 27648, GP_KBET = 36864, GP_XR = 46080  , GP_PR = 82944  , GP_OUT = 101376, GP_SC = 142336;
__device__ __forceinline__ pg8::bf16x8 ldsfrag(const unsigned char* base, int row, int ks, int fq) { return *(const pg8::bf16x8*)(base + row * 144 + ks * 64 + fq * 16); }
constexpr int G2_KB = 0, G2_KBB = 9216, G2_QB = 18432, G2_XR0 = 27648, G2_XT0 = 36864, G2_PR0 = 46080, G2_VBT = 55296, G2_KBET = 64512, G2_SC = 73728, G2_CW = 75264, G2_HALF = 78336;
__device__ void phase_gdn_prep2(const Ctx& c, unsigned char* Lb) {
  unsigned char* ws = c.ws;
  const int tid = phase_tid(), lane = tid & 63, wave = tid >> 6, fr = lane & 15, fq = lane >> 4;
  const int hb = wave >> 2, w4 = wave & 3, htid = tid & 255;
  unsigned char* L = Lb + hb * G2_HALF;
  const bf16_t* GB = (const bf16_t*)(ws + WS_GB); const float* SM = (const float*)(ws + WS_SM);
  const float* convw = c.in[6];
  float* sc = (float*)(L + G2_SC);
  float* cw = (float*)(L + G2_CW);
  const int tt = htid >> 2, part = htid & 3;
  for (int it2 = blockIdx.x; it2 < 1536; it2 += gridDim.x) {
    const int it = it2 * 2 + hb;
    const int n = it & 63, bh = it >> 6, b = bh / 6, h = bh % 6;
    const int t = n * 64 + tt; const size_t r = (size_t)b * SEQ + t;
    unsigned char* gb = gd_item(ws, it);
    __syncthreads();
    for (int i = htid; i < 768; i += 256) { const int j = i / 192, rr = i % 192; cw[i] = convw[j * 1152 + (rr >> 6) * 384 + h * 64 + (rr & 63)]; }
    if (part == 0) { const float a = SM[r * 16 + 4 + h], bb = SM[r * 16 + 10 + h]; const float xs = a + c.in[8][h]; const float sp = xs > 20.f ? xs : log1pf(__expf(xs));
      sc[tt] = -__expf(c.in[7][h]) * sp; sc[192 + tt] = 1.f / (1.f + __expf(-bb)); }
    __syncthreads();
    if (w4 == 0) { float v = sc[lane];
#pragma unroll
      for (int o = 1; o < 64; o <<= 1) { const float u = __shfl_up(v, o); if (lane >= o) v += u; }
      const float last = __shfl(v, 63);
      sc[64 + lane] = v; sc[128 + lane] = __expf(v); sc[256 + lane] = __expf(last - v); if (lane == 0) { sc[320] = __expf(last); *(float*)(gb + 40960) = __expf(last); } }
    float qv[16], kv[16], vv[16];
#pragma unroll
    for (int role = 0; role < 3; ++role) {
      float acc[16];
#pragma unroll
      for (int e = 0; e < 16; ++e) acc[e] = 0.f;
      u32x4 xr[4][2];
#pragma unroll
      for (int j = 0; j < 4; ++j) { const bool ok = t - 3 + j >= 0; const bf16_t* xp = GB + (r - 3 + j) * 1536 + role * 384 + h * 64 + part * 16;
        xr[j][0] = ok ? *(const u32x4*)xp : (u32x4){0u, 0u, 0u, 0u}; xr[j][1] = ok ? *(const u32x4*)(xp + 8) : (u32x4){0u, 0u, 0u, 0u}; }
#pragma unroll
      for (int j = 0; j < 4; ++j)
#pragma unroll
        for (int hh = 0; hh < 2; ++hh) { const u32x4 xvv = xr[j][hh]; const float* wj = cw + j * 192 + role * 64 + part * 16 + hh * 8;
          const f32x4 w0 = *(const f32x4*)wj, w1 = *(const f32x4*)(wj + 4);
          acc[hh * 8 + 0] += w0.x * __uint_as_float(xvv.x << 16); acc[hh * 8 + 1] += w0.y * __uint_as_float(xvv.x & 0xffff0000u); acc[hh * 8 + 2] += w0.z * __uint_as_float(xvv.y << 16); acc[hh * 8 + 3] += w0.w * __uint_as_float(xvv.y & 0xffff0000u);
          acc[hh * 8 + 4] += w1.x * __uint_as_float(xvv.z << 16); acc[hh * 8 + 5] += w1.y * __uint_as_float(xvv.z & 0xffff0000u); acc[hh * 8 + 6] += w1.z * __uint_as_float(xvv.w << 16); acc[hh * 8 + 7] += w1.w * __uint_as_float(xvv.w & 0xffff0000u); }
      float ss = 0.f;
#pragma unroll
      for (int e = 0; e < 16; ++e) { acc[e] = silu_f(acc[e]); ss += acc[e] * acc[e]; }
      if (role < 2) { ss += __shfl_xor(ss, 1); ss += __shfl_xor(ss, 2); const float scl = rsqrtf(ss + 1e-6f) * (role == 0 ? 0.125f : 1.f);
#pragma unroll
        for (int e = 0; e < 16; ++e) acc[e] *= scl; }
#pragma unroll
      for (int e = 0; e < 16; ++e) { if (role == 0) qv[e] = acc[e]; else if (role == 1) kv[e] = acc[e]; else vv[e] = acc[e]; }
    }
    __syncthreads();
    { const float beta = sc[192 + tt], eg = sc[128 + tt], ekl = sc[256 + tt];
      float kb[16];
#pragma unroll
      for (int e = 0; e < 16; ++e) kb[e] = kv[e] * beta;
#pragma unroll
      for (int hh = 0; hh < 2; ++hh) { const int o8 = hh * 8;
        *(u32x4*)(L + G2_KB + tt * 144 + part * 32 + hh * 16) = (u32x4){pk2(kv[o8], kv[o8 + 1]), pk2(kv[o8 + 2], kv[o8 + 3]), pk2(kv[o8 + 4], kv[o8 + 5]), pk2(kv[o8 + 6], kv[o8 + 7])};
        *(u32x4*)(L + G2_KBB + tt * 144 + part * 32 + hh * 16) = (u32x4){pk2(kb[o8], kb[o8 + 1]), pk2(kb[o8 + 2], kb[o8 + 3]), pk2(kb[o8 + 4], kb[o8 + 5]), pk2(kb[o8 + 6], kb[o8 + 7])};
        *(u32x4*)(L + G2_QB + tt * 144 + part * 32 + hh * 16) = (u32x4){pk2(qv[o8], qv[o8 + 1]), pk2(qv[o8 + 2], qv[o8 + 3]), pk2(qv[o8 + 4], qv[o8 + 5]), pk2(qv[o8 + 6], qv[o8 + 7])}; }
      const int ptt = kperm(tt);
#pragma unroll
      for (int e = 0; e < 16; ++e) { const int d = part * 16 + e;
        *(bf16_t*)(L + G2_VBT + d * 144 + tt * 2) = f2bf(vv[e] * beta);
        *(bf16_t*)(L + G2_KBET + d * 144 + tt * 2) = f2bf(kb[e] * eg);
        *(bf16_t*)(gb + 8192 + tt * 128 + kperm(d) * 2) = f2bf(qv[e] * eg);
        *(bf16_t*)(gb + 3 * 8192 + d * 128 + ptt * 2) = f2bf(kv[e] * ekl); } }
    __syncthreads();
    const int rowb = (w4 * 16 + fq * 4) * 144 + fr * 2;
    const int colb = fr * 144 + (w4 * 16 + fq * 4) * 2;
    const int fa = (w4 * 16 + fr) * 144 + fq * 16;
    const int fb = fr * 144 + fq * 16;
    const int i0 = w4 * 16 + fq * 4;
#define G2F(buf, off) (*(const pg8::bf16x8*)(L + (buf) + (off)))
#define G2W16(buf, off, v) (*(bf16_t*)(L + (buf) + (off)) = f2bf(v))
    f32x4 Pt[4];
    { const float gi0 = sc[64 + i0], gi1 = sc[64 + i0 + 1], gi2 = sc[64 + i0 + 2], gi3 = sc[64 + i0 + 3];
#pragma unroll
    for (int u = 0; u < 4; ++u) {
      f32x4 dl = {0.f, 0.f, 0.f, 0.f}, da = {0.f, 0.f, 0.f, 0.f};
#pragma unroll
      for (int ks = 0; ks < 2; ++ks) { const pg8::bf16x8 bk = G2F(G2_KB, fb + u * 2304 + ks * 64);
        dl = __builtin_amdgcn_mfma_f32_16x16x32_bf16(G2F(G2_KBB, fa + ks * 64), bk, dl, 0, 0, 0);
        da = __builtin_amdgcn_mfma_f32_16x16x32_bf16(G2F(G2_QB, fa + ks * 64), bk, da, 0, 0, 0); }
      const int j = u * 16 + fr; const float gj = sc[64 + j]; const int pj = kperm(j);
      const float dec0 = __expf(fminf(gi0 - gj, 0.f)), dec1 = __expf(fminf(gi1 - gj, 0.f)), dec2 = __expf(fminf(gi2 - gj, 0.f)), dec3 = __expf(fminf(gi3 - gj, 0.f));
      const float l0 = i0 + 0 > j ? dl.x * dec0 : 0.f, l1 = i0 + 1 > j ? dl.y * dec1 : 0.f, l2 = i0 + 2 > j ? dl.z * dec2 : 0.f, l3 = i0 + 3 > j ? dl.w * dec3 : 0.f;
      const float a0 = i0 + 0 >= j ? da.x * dec0 : 0.f, a1 = i0 + 1 >= j ? da.y * dec1 : 0.f, a2 = i0 + 2 >= j ? da.z * dec2 : 0.f, a3 = i0 + 3 >= j ? da.w * dec3 : 0.f;
      const f32x4 pv = {(i0 + 0 == j ? 1.f : 0.f) - l0, (i0 + 1 == j ? 1.f : 0.f) - l1, (i0 + 2 == j ? 1.f : 0.f) - l2, (i0 + 3 == j ? 1.f : 0.f) - l3};
      G2W16(G2_XR0, rowb + u * 32, l0); G2W16(G2_XR0, rowb + 144 + u * 32, l1); G2W16(G2_XR0, rowb + 288 + u * 32, l2); G2W16(G2_XR0, rowb + 432 + u * 32, l3);
      G2W16(G2_PR0, rowb + u * 32, pv.x); G2W16(G2_PR0, rowb + 144 + u * 32, pv.y); G2W16(G2_PR0, rowb + 288 + u * 32, pv.z); G2W16(G2_PR0, rowb + 432 + u * 32, pv.w);
      *(u32x2*)(L + G2_XT0 + colb + u * 2304) = (u32x2){pk2(l0, l1), pk2(l2, l3)};
      bf16_t* am = (bf16_t*)(gb + 2 * 8192 + i0 * 128 + pj * 2);
      am[0] = f2bf(a0); am[64] = f2bf(a1); am[128] = f2bf(a2); am[192] = f2bf(a3);
      Pt[u] = pv; } }
    __syncthreads();
#pragma unroll
    for (int u = 0; u < 4; ++u) {
      f32x4 d = {0.f, 0.f, 0.f, 0.f};
#pragma unroll
      for (int ks = 0; ks < 2; ++ks) d = __builtin_amdgcn_mfma_f32_16x16x32_bf16(G2F(G2_XR0, fa + ks * 64), G2F(G2_XT0, fb + u * 2304 + ks * 64), d, 0, 0, 0);
      G2W16(G2_KB, rowb + u * 32, d.x); G2W16(G2_KB, rowb + 144 + u * 32, d.y); G2W16(G2_KB, rowb + 288 + u * 32, d.z); G2W16(G2_KB, rowb + 432 + u * 32, d.w);
      *(u32x2*)(L + G2_KBB + colb + u * 2304) = (u32x2){pk2(d.x, d.y), pk2(d.z, d.w)}; }
    __syncthreads();
#pragma unroll
    for (int itn = 0; itn < 4; ++itn) {
      const int XRc = (itn & 1) ? G2_XR0 : G2_KB, XTc = (itn & 1) ? G2_XT0 : G2_KBB, XRn = (itn & 1) ? G2_KB : G2_XR0, XTn = (itn & 1) ? G2_KBB : G2_XT0;
      const int PRc = (itn & 1) ? G2_QB : G2_PR0, PRn = (itn & 1) ? G2_PR0 : G2_QB;
#pragma unroll
      for (int u = 0; u < 4; ++u) {
        f32x4 d = {0.f, 0.f, 0.f, 0.f};
#pragma unroll
        for (int ks = 0; ks < 2; ++ks) { const pg8::bf16x8 bx = G2F(XTc, fb + u * 2304 + ks * 64);
          Pt[u] = __builtin_amdgcn_mfma_f32_16x16x32_bf16(G2F(PRc, fa + ks * 64), bx, Pt[u], 0, 0, 0);
          if (itn < 3) d = __builtin_amdgcn_mfma_f32_16x16x32_bf16(G2F(XRc, fa + ks * 64), bx, d, 0, 0, 0); }
        G2W16(PRn, rowb + u * 32, Pt[u].x); G2W16(PRn, rowb + 144 + u * 32, Pt[u].y); G2W16(PRn, rowb + 288 + u * 32, Pt[u].z); G2W16(PRn, rowb + 432 + u * 32, Pt[u].w);
        if (itn < 3) { G2W16(XRn, rowb + u * 32, d.x); G2W16(XRn, rowb + 144 + u * 32, d.y); G2W16(XRn, rowb + 288 + u * 32, d.z); G2W16(XRn, rowb + 432 + u * 32, d.w);
          *(u32x2*)(L + XTn + colb + u * 2304) = (u32x2){pk2(d.x, d.y), pk2(d.z, d.w)}; } }
      __syncthreads();
    }
#pragma unroll
    for (int u = 0; u < 4; ++u) {
      f32x4 du = {0.f, 0.f, 0.f, 0.f}, dw = {0.f, 0.f, 0.f, 0.f};
#pragma unroll
      for (int ks = 0; ks < 2; ++ks) { const pg8::bf16x8 a = G2F(G2_PR0, fa + ks * 64);
        du = __builtin_amdgcn_mfma_f32_16x16x32_bf16(a, G2F(G2_VBT, fb + u * 2304 + ks * 64), du, 0, 0, 0);
        dw = __builtin_amdgcn_mfma_f32_16x16x32_bf16(a, G2F(G2_KBET, fb + u * 2304 + ks * 64), dw, 0, 0, 0); }
      const int j = u * 16 + fr, pj = kperm(j);
      *(u32x2*)(gb + 4 * 8192 + j * 128 + i0 * 2) = (u32x2){pk2(du.x, du.y), pk2(du.z, du.w)};
      bf16_t* wn = (bf16_t*)(gb + i0 * 128 + pj * 2);
      wn[0] = f2bf(-dw.x); wn[64] = f2bf(-dw.y); wn[128] = f2bf(-dw.z); wn[192] = f2bf(-dw.w); }
#undef G2F
#undef G2W16
  }
}

constexpr int GS_SLOT = 46208, GS_OB = 2 * GS_SLOT;
__device__ void phase_gdn_scan(const Ctx& c, unsigned char* L, int item) {
  unsigned char* ws = c.ws;
  const int tid = phase_tid(), lane = tid & 63, wave = tid >> 6, fr = lane & 15, fq = lane >> 4;
  const int b = item / 6, h = item % 6;
  const bf16_t* GB = (const bf16_t*)(ws + WS_GB); bf16_t* CAT = (bf16_t*)(ws + WS_CAT); const float* gng = c.in[9];
  const int lt = tid - 256;
  u32x4 ra[10]; float gla = 0.f;
  f32x4 S[4];
#pragma unroll
  for (int i = 0; i < 4; ++i) S[i] = (f32x4){0.f, 0.f, 0.f, 0.f};
#define GS_LOAD(R, G, n) do { if ((n) < 64) { const unsigned char* gb_ = gd_item(ws, item * 64 + (n)); _Pragma("unroll") for (int i_ = 0; i_ < 10; ++i_) R[i_] = *(const u32x4*)(gb_ + (size_t)(lt + 256 * i_) * 16); if (lt == 0) G = *(const float*)(gb_ + 40960); } } while (0)
#define GS_STORE(R, G, slot) do { _Pragma("unroll") for (int i_ = 0; i_ < 10; ++i_) { const int p_ = lt + 256 * i_; *(u32x4*)(L + (slot) * GS_SLOT + (p_ >> 9) * 9216 + ((p_ >> 3) & 63) * 144 + (p_ & 7) * 16) = R[i_]; } if (lt == 0) *(float*)(L + (slot) * GS_SLOT + 46080) = G; } while (0)
  auto post = [&](int k) {
    const unsigned char* ob = L + GS_OB + (k & 1) * 9216; const int tk = lt >> 2, part = lt & 3; const size_t r = (size_t)b * SEQ + k * 64 + tk;
    const u32x4 o0 = *(const u32x4*)(ob + tk * 144 + part * 32), o1 = *(const u32x4*)(ob + tk * 144 + part * 32 + 16);
    float ov[16] = {__uint_as_float(o0.x << 16), __uint_as_float(o0.x & 0xffff0000u), __uint_as_float(o0.y << 16), __uint_as_float(o0.y & 0xffff0000u), __uint_as_float(o0.z << 16), __uint_as_float(o0.z & 0xffff0000u), __uint_as_float(o0.w << 16), __uint_as_float(o0.w & 0xffff0000u),
                    __uint_as_float(o1.x << 16), __uint_as_float(o1.x & 0xffff0000u), __uint_as_float(o1.y << 16), __uint_as_float(o1.y & 0xffff0000u), __uint_as_float(o1.z << 16), __uint_as_float(o1.z & 0xffff0000u), __uint_as_float(o1.w << 16), __uint_as_float(o1.w & 0xffff0000u)};
    float ss = 0.f;
#pragma unroll
    for (int e = 0; e < 16; ++e) ss += ov[e] * ov[e];
    ss += __shfl_xor(ss, 1); ss += __shfl_xor(ss, 2);
    const float rstd = rsqrtf(ss * (1.f / 64.f) + 1e-6f);
    const u32x4 z0 = *(const u32x4*)(GB + r * 1536 + 1152 + h * 64 + part * 16), z1 = *(const u32x4*)(GB + r * 1536 + 1152 + h * 64 + part * 16 + 8);
    const float zf[16] = {__uint_as_float(z0.x << 16), __uint_as_float(z0.x & 0xffff0000u), __uint_as_float(z0.y << 16), __uint_as_float(z0.y & 0xffff0000u), __uint_as_float(z0.z << 16), __uint_as_float(z0.z & 0xffff0000u), __uint_as_float(z0.w << 16), __uint_as_float(z0.w & 0xffff0000u),
                          __uint_as_float(z1.x << 16), __uint_as_float(z1.x & 0xffff0000u), __uint_as_float(z1.y << 16), __uint_as_float(z1.y & 0xffff0000u), __uint_as_float(z1.z << 16), __uint_as_float(z1.z & 0xffff0000u), __uint_as_float(z1.w << 16), __uint_as_float(z1.w & 0xffff0000u)};
#pragma unroll
    for (int e = 0; e < 16; ++e) ov[e] = ov[e] * rstd * gng[part * 16 + e] * silu_f(zf[e]);
    bf16_t* op = CAT + r * 1024 + 384 + h * 64 + part * 16;
    *(u32x4*)op = (u32x4){pk2(ov[0], ov[1]), pk2(ov[2], ov[3]), pk2(ov[4], ov[5]), pk2(ov[6], ov[7])};
    *(u32x4*)(op + 8) = (u32x4){pk2(ov[8], ov[9]), pk2(ov[10], ov[11]), pk2(ov[12], ov[13]), pk2(ov[14], ov[15])};
  };
  auto step = [&](int k) {
    const unsigned char* sb = L + (k & 1) * GS_SLOT; const float gl = *(const float*)(sb + 46080);
    const pg8::bf16x8 Sb0 = packp(S[0], S[1]), Sb1 = packp(S[2], S[3]);
    f32x4 vn[4], o[4];
#pragma unroll
    for (int mt = 0; mt < 4; ++mt) { const u32x2 uv = *(const u32x2*)(sb + 4 * 9216 + (wave * 16 + fr) * 144 + (mt * 16 + fq * 4) * 2);
      f32x4 a = {__uint_as_float(uv.x << 16), __uint_as_float(uv.x & 0xffff0000u), __uint_as_float(uv.y << 16), __uint_as_float(uv.y & 0xffff0000u)};
      a = __builtin_amdgcn_mfma_f32_16x16x32_bf16(ldsfrag(sb, mt * 16 + fr, 0, fq), Sb0, a, 0, 0, 0);
      vn[mt] = __builtin_amdgcn_mfma_f32_16x16x32_bf16(ldsfrag(sb, mt * 16 + fr, 1, fq), Sb1, a, 0, 0, 0);
      f32x4 q = {0.f, 0.f, 0.f, 0.f};
      q = __builtin_amdgcn_mfma_f32_16x16x32_bf16(ldsfrag(sb + 9216, mt * 16 + fr, 0, fq), Sb0, q, 0, 0, 0);
      o[mt] = __builtin_amdgcn_mfma_f32_16x16x32_bf16(ldsfrag(sb + 9216, mt * 16 + fr, 1, fq), Sb1, q, 0, 0, 0); }
    const pg8::bf16x8 Vb0 = packp(vn[0], vn[1]), Vb1 = packp(vn[2], vn[3]);
#pragma unroll
    for (int mt = 0; mt < 4; ++mt) { o[mt] = __builtin_amdgcn_mfma_f32_16x16x32_bf16(ldsfrag(sb + 2 * 9216, mt * 16 + fr, 0, fq), Vb0, o[mt], 0, 0, 0);
      o[mt] = __builtin_amdgcn_mfma_f32_16x16x32_bf16(ldsfrag(sb + 2 * 9216, mt * 16 + fr, 1, fq), Vb1, o[mt], 0, 0, 0); }
#pragma unroll
    for (int kt = 0; kt < 4; ++kt) { f32x4 sv = S[kt] * gl;
      sv = __builtin_amdgcn_mfma_f32_16x16x32_bf16(ldsfrag(sb + 3 * 9216, kt * 16 + fr, 0, fq), Vb0, sv, 0, 0, 0);
      S[kt] = __builtin_amdgcn_mfma_f32_16x16x32_bf16(ldsfrag(sb + 3 * 9216, kt * 16 + fr, 1, fq), Vb1, sv, 0, 0, 0); }
    unsigned char* ob = L + GS_OB + (k & 1) * 9216 + (wave * 16 + fr) * 2;
#pragma unroll
    for (int mt = 0; mt < 4; ++mt) { const int t0 = mt * 16 + fq * 4;
      *(bf16_t*)(ob + (t0 + 0) * 144) = f2bf(o[mt].x); *(bf16_t*)(ob + (t0 + 1) * 144) = f2bf(o[mt].y); *(bf16_t*)(ob + (t0 + 2) * 144) = f2bf(o[mt].z); *(bf16_t*)(ob + (t0 + 3) * 144) = f2bf(o[mt].w); }
  };
  __syncthreads();
  if (wave >= 4) { GS_LOAD(ra, gla, 0); GS_STORE(ra, gla, 0); GS_LOAD(ra, gla, 1); }
  __syncthreads();
#pragma unroll 1
  for (int k = 0; k < 64; ++k) {
    if (wave < 4) step(k); else { if (k + 1 < 64) GS_STORE(ra, gla, (k + 1) & 1); GS_LOAD(ra, gla, k + 2); if (k > 0) post(k - 1); }
    __syncthreads();
  }
  if (wave >= 4) post(63);
#undef GS_LOAD
#undef GS_STORE
}

__device__ __forceinline__ f32x4 bf4(u32x2 p) { return (f32x4){__uint_as_float(p.x << 16), __uint_as_float(p.x & 0xffff0000u), __uint_as_float(p.y << 16), __uint_as_float(p.y & 0xffff0000u)}; }
__device__ void phase_router(const Ctx& c, unsigned char* ldsb) {
  unsigned char* ws = c.ws;
  const int tid = phase_tid(), lane = tid & 63, wave = tid >> 6, fr = lane & 15, fq = lane >> 4;
  float* lg = (float*)(ldsb + wave * 5632);
  const float* bg = c.in[17]; const float* br = c.in[19]; const float* g1 = c.in[14]; const float* b1 = c.in[15];
  const bf16_t* WR = (const bf16_t*)(ws + WS_WR); bf16_t* X1B = (bf16_t*)(ws + WS_X1B);
  unsigned* ctl = (unsigned*)(ws + WS_CTL);
  unsigned* LIST = (unsigned*)(ws + WS_LIST); float* GATEL = (float*)(ws + WS_GATEL); unsigned* TSLOT = (unsigned*)(ws + WS_TSLOT);
  unsigned* cntl = (unsigned*)(ldsb + 46080); unsigned* basel = cntl + 64;
  __syncthreads();
  if (tid < 64) cntl[tid] = 0u;
  __syncthreads();
  for (int tile = blockIdx.x * NWAVES + wave; tile < T / 16; tile += gridDim.x * NWAVES) {
    const int t0 = tile * 16;
    float mean_t = 0.f, rstd_t = 0.f;
#pragma unroll 2
    for (int i = 0; i < 16; ++i) { const u32x2* row = (const u32x2*)(X1B + (size_t)(t0 + i) * 1024);
      f32x4 v[4]; float sm = 0.f;
#pragma unroll
      for (int j = 0; j < 4; ++j) { v[j] = bf4(row[lane + 64 * j]); sm += (v[j].x + v[j].y) + (v[j].z + v[j].w); }
      const float mean = wave_sum(sm) * (1.f / 1024.f); float s2 = 0.f;
#pragma unroll
      for (int j = 0; j < 4; ++j) { v[j] = v[j] - mean; s2 += (v[j].x * v[j].x + v[j].y * v[j].y) + (v[j].z * v[j].z + v[j].w * v[j].w); }
      const float rstd = rsqrtf(wave_sum(s2) * (1.f / 1024.f) + 1e-5f);
      if (fr == i) { mean_t = mean; rstd_t = rstd; } }
    f32x4 acc[5];
#pragma unroll
    for (int nt = 0; nt < 5; ++nt) acc[nt] = (f32x4){0.f, 0.f, 0.f, 0.f};
    bf16_t* xp = X1B + (size_t)(t0 + fr) * 1024 + fq * 8;
#pragma unroll 2
    for (int ks = 0; ks < 32; ++ks) {
      const u32x4 yv = *(const u32x4*)(xp + ks * 32);
      const f32x4 ga = *(const f32x4*)(g1 + ks * 32 + fq * 8), gb2 = *(const f32x4*)(g1 + ks * 32 + fq * 8 + 4), ba = *(const f32x4*)(b1 + ks * 32 + fq * 8), bb2 = *(const f32x4*)(b1 + ks * 32 + fq * 8 + 4);
      const f32x4 y0 = {__uint_as_float(yv.x << 16), __uint_as_float(yv.x & 0xffff0000u), __uint_as_float(yv.y << 16), __uint_as_float(yv.y & 0xffff0000u)};
      const f32x4 y1 = {__uint_as_float(yv.z << 16), __uint_as_float(yv.z & 0xffff0000u), __uint_as_float(yv.w << 16), __uint_as_float(yv.w & 0xffff0000u)};
      const f32x4 n0 = (y0 - mean_t) * rstd_t * ga + ba, n1 = (y1 - mean_t) * rstd_t * gb2 + bb2;
      const u32x4 xw = {cvtpk_c(n0.x, n0.y), cvtpk_c(n0.z, n0.w), cvtpk_c(n1.x, n1.y), cvtpk_c(n1.z, n1.w)};
      *(u32x4*)(xp + ks * 32) = xw;
      const pg8::bf16x8 bx = __builtin_bit_cast(pg8::bf16x8, xw);
#pragma unroll
      for (int nt = 0; nt < 5; ++nt) acc[nt] = __builtin_amdgcn_mfma_f32_16x16x32_bf16(*(const pg8::bf16x8*)(WR + (size_t)(nt * 16 + fr) * 1024 + ks * 32 + fq * 8), bx, acc[nt], 0, 0, 0); }
#pragma unroll
    for (int nt = 0; nt < 5; ++nt) { const int o = nt * 16 + fq * 4; *(f32x4*)(lg + fr * 88 + o) = acc[nt]; }
    asm volatile("s_waitcnt lgkmcnt(0)" ::: "memory");
    int ex1 = 0, ex2 = 0; float gt1 = 0.f, gt2 = 0.f; unsigned lr1 = 0u, lr2 = 0u;
    if (lane < 16) {
      const float* l = lg + lane * 88;
      int grp = 0; float gm = l[0] + bg[0];
      for (int i = 1; i < 8; ++i) { const float v = l[i] + bg[i]; if (v > gm) { gm = v; grp = i; } }
      float gs = 0.f; for (int i = 0; i < 8; ++i) gs += __expf(l[i] + bg[i] - gm);
      const float pgrp = 1.f / gs;
      const float* el = l + 8 + grp * 8; const float* eb = br + grp * 8;
      int i1 = 0; float m1 = el[0] + eb[0]; for (int i = 1; i < 8; ++i) { const float v = el[i] + eb[i]; if (v > m1) { m1 = v; i1 = i; } }
      int i2 = -1; float m2 = -3.0e38f; for (int i = 0; i < 8; ++i) { const float v = el[i] + eb[i]; if (i != i1 && v > m2) { m2 = v; i2 = i; } }
      const float e2 = __expf(m2 - m1), den = 1.f / (1.f + e2);
      gt1 = pgrp * den; gt2 = pgrp * e2 * den;
      ex1 = grp * 8 + i1; ex2 = grp * 8 + i2;
      lr1 = atomicAdd(&cntl[ex1], 1u); lr2 = atomicAdd(&cntl[ex2], 1u);
    }
    __syncthreads();
    if (wave == 0) { const unsigned nloc = cntl[lane]; basel[lane] = nloc ? atomicAdd(&ctl[CW_CNT + lane], nloc) : 0u; }
    __syncthreads();
    if (lane < 16) {
      const int t = t0 + lane; const unsigned r1 = basel[ex1] + lr1, r2 = basel[ex2] + lr2;
      LIST[(size_t)ex1 * 32768 + r1] = (unsigned)t; GATEL[(size_t)ex1 * 32768 + r1] = gt1;
      LIST[(size_t)ex2 * 32768 + r2] = (unsigned)t; GATEL[(size_t)ex2 * 32768 + r2] = gt2;
      TSLOT[(size_t)t * 2 + 0] = ((unsigned)ex1 << 16) | r1; TSLOT[(size_t)t * 2 + 1] = ((unsigned)ex2 << 16) | r2;
    }
    __syncthreads();
    if (tid < 64) cntl[tid] = 0u;
    __syncthreads();
  }
}

__device__ void phase_combine(const Ctx& c, float* lds) {
  unsigned char* ws = c.ws;
  const int tid = phase_tid(), lane = tid & 63, wave = tid >> 6;
  int* offs = (int*)lds; int* cnts = offs + 65;
  expert_offsets(c, offs, cnts, tid);
  const unsigned char* Y = (const unsigned char*)(ws + WS_Y); const unsigned* TSLOT = (const unsigned*)(ws + WS_TSLOT);
  const float* g2 = c.in[23]; const float* b2 = c.in[24];
  for (int t = blockIdx.x * NWAVES + wave; t < T; t += gridDim.x * NWAVES) {
    const unsigned s0 = TSLOT[(size_t)t * 2], s1 = TSLOT[(size_t)t * 2 + 1];
    const size_t r0 = (size_t)offs[s0 >> 16] + (s0 & 0xffffu), r1 = (size_t)offs[s1 >> 16] + (s1 & 0xffffu);
    f32x4* row = (f32x4*)(c.out + (size_t)t * 1024); const u32x2* xrow = (const u32x2*)((const bf16_t*)(ws + WS_X1B) + (size_t)t * 1024);
    f32x4 v[4]; float s = 0.f;
#pragma unroll
    for (int j = 0; j < 4; ++j) { const unsigned ya = ((const unsigned*)(Y + r0 * 1024))[lane + 64 * j], yb = ((const unsigned*)(Y + r1 * 1024))[lane + 64 * j];
      f32x4 x = bf4(xrow[lane + 64 * j]) * ALPHA;
      const hw_f32x2 a01 = __builtin_amdgcn_cvt_pk_f32_fp8(ya, false), a23 = __builtin_amdgcn_cvt_pk_f32_fp8(ya, true), b01 = __builtin_amdgcn_cvt_pk_f32_fp8(yb, false), b23 = __builtin_amdgcn_cvt_pk_f32_fp8(yb, true);
      x.x += (a01.x + b01.x) * 0.015625f; x.y += (a01.y + b01.y) * 0.015625f; x.z += (a23.x + b23.x) * 0.015625f; x.w += (a23.y + b23.y) * 0.015625f;
      v[j] = x; s += (x.x + x.y) + (x.z + x.w); }
    const float mean = wave_sum(s) * (1.f / 1024.f); float s2 = 0.f;
#pragma unroll
    for (int j = 0; j < 4; ++j) { v[j] = v[j] - mean; s2 += (v[j].x * v[j].x + v[j].y * v[j].y) + (v[j].z * v[j].z + v[j].w * v[j].w); }
    const float rstd = rsqrtf(wave_sum(s2) * (1.f / 1024.f) + 1e-5f);
#pragma unroll
    for (int j = 0; j < 4; ++j) { const f32x4 g = ((const f32x4*)g2)[lane + 64 * j], bb = ((const f32x4*)b2)[lane + 64 * j]; row[lane + 64 * j] = v[j] * rstd * g + bb; }
  }
}

constexpr int NPHASE = 11;
__global__ void __launch_bounds__(NTHREADS, 2) mega(Ctx c) {
  float* lds = (float*)lds_raw;
  unsigned* ctl = (unsigned*)(c.ws + WS_CTL);
  unsigned* bar = ctl + CW_BAR;
  if (threadIdx.x == 0) { *(volatile unsigned*)(lds_raw + LDS_WCTR) = 0u; *(volatile unsigned*)(lds_raw + LDS_XBST) = 0u; *(volatile unsigned*)(lds_raw + LDS_XBST + 4) = 0u;
    (void)xb_add(&bar[XB_XCNT(xb_xcc_id())], 1u); }
  __syncthreads();
  phase_prologue(c, lds);
  xcd_barrier(bar);
  phase_inproj_mfma(c, (lds_u8*)lds_raw);
  xcd_barrier(bar);
  phase_gdn_prep2(c, lds_raw);
  phase_kvup(c, lds);
  phase_topk_mfma(c, lds_raw, ctl + CW_Q);
  xcd_barrier(bar);
  if (blockIdx.x < 48) phase_gdn_scan(c, lds_raw, blockIdx.x);
  phase_attn_sparse(c, lds_raw, ctl + CW_Q + 16);
  phase_attn_mem(c, lds_raw, ctl + CW_Q + 32);
  xcd_barrier(bar);
  phase_outproj_mfma(c, (lds_u8*)lds_raw);
  xcd_barrier(bar);
  phase_router(c, lds_raw);
  xcd_barrier(bar);
  phase_moe_up_mfma(c, (lds_u8*)lds_raw);
  xcd_barrier(bar);
  phase_moe_down_mfma(c, (lds_u8*)lds_raw);
  xcd_barrier(bar);
  phase_combine(c, lds);
}

extern "C" void kernel_launch(void* const* d_in, const int* in_sizes, int n_in, void* d_out, int out_size, void* d_ws, size_t ws_size, hipStream_t stream) {
  static int grid = 0;
  if (grid == 0) {
    if (n_in != 25 || ws_size < WS_END) { fprintf(stderr, "kernel_launch: unexpected n_in %d / ws %zu\n", n_in, ws_size); grid = -1; return; }
    int dev = 0, cus = 0, per_cu = 0;
    hipGetDevice(&dev); hipDeviceGetAttribute(&cus, hipDeviceAttributeMultiprocessorCount, dev);
    hipFuncSetAttribute((const void*)mega, hipFuncAttributeMaxDynamicSharedMemorySize, LDS_BYTES);
    hipOccupancyMaxActiveBlocksPerMultiprocessor(&per_cu, (const void*)mega, NTHREADS, LDS_BYTES);
    if (per_cu < 1) { fprintf(stderr, "kernel_launch: occupancy query says %d blocks/CU\n", per_cu); per_cu = 1; }
    grid = cus * (per_cu < 1 ? 1 : 1);
    (void)hipGetLastError();
  }
  if (grid < 0) return;
  hipMemsetAsync((char*)d_ws + WS_CTL, 0, 32 * 1024, stream);
  Ctx c; memset(&c, 0, sizeof(c));
  for (int i = 0; i < 25; ++i) c.in[i] = (const float*)d_in[i];
  c.out = (float*)d_out; c.ws = (unsigned char*)d_ws;
  hipLaunchKernelGGL(mega, dim3(grid), dim3(NTHREADS), LDS_BYTES, stream, c);
}
```

```cpp
#include <hip/hip_runtime.h>
#include <cstdio>
#include <cstdint>
#include <cstring>

#ifndef ONE_LAUNCH
#define ONE_LAUNCH 1
#endif

typedef unsigned short bf16_t;
typedef float f32x4 __attribute__((ext_vector_type(4)));
typedef unsigned u32x4 __attribute__((ext_vector_type(4)));
typedef unsigned u32x2 __attribute__((ext_vector_type(2)));

constexpr int T = 32768, DM = 1024, SEQ = 4096, NBATCH = 8;
constexpr int NIN = 2816;
constexpr int NMEM = 256, TM = NBATCH * NMEM;
constexpr int NEXP = 64, DE = 256;
constexpr int NTHREADS = 512, NWAVES = 8;
constexpr float ALPHA = 1.189207115002721f;
constexpr float LOG2E = 1.4426950408889634f;
constexpr float QSCALE = 0.125f * LOG2E;

constexpr size_t MiB = 1ull << 20;
constexpr size_t WS_CTL = 0;
constexpr size_t WS_TSLOT = 512 * 1024;
constexpr size_t WS_ROPE = 1 * MiB;
constexpr size_t WS_WKV = 2 * MiB;
constexpr size_t WS_WR = 2 * MiB + 65536;
constexpr size_t WS_WIN = 3 * MiB;
constexpr size_t WS_WO = 9 * MiB;
constexpr size_t WS_WMKV = 11 * MiB;
constexpr size_t WS_MEMB = 12 * MiB;
constexpr size_t WS_WGU = 16 * MiB;
constexpr size_t WS_WD = 80 * MiB;
constexpr size_t WS_XB = 112 * MiB;
constexpr size_t WS_QA = 176 * MiB;
constexpr size_t WS_CKV = 200 * MiB;
constexpr size_t WS_IQ = 208 * MiB;
constexpr size_t WS_IK = 224 * MiB;
constexpr size_t WS_SM = 228 * MiB;
constexpr size_t WS_QC = 230 * MiB;
constexpr size_t WS_GB = 246 * MiB;
constexpr size_t WS_MK = 342 * MiB;
constexpr size_t WS_MVT = 343 * MiB;
constexpr size_t WS_KVA = 344 * MiB;
constexpr size_t WS_SEL = 352 * MiB;
constexpr size_t WS_CAT = 368 * MiB;
constexpr size_t WS_X1B = 432 * MiB;
constexpr size_t WS_LIST = 496 * MiB;
constexpr size_t WS_GATEL = 504 * MiB;
constexpr size_t WS_END = 512 * MiB;
constexpr size_t WS_H = 112 * MiB;
constexpr size_t WS_Y = 160 * MiB;

constexpr int CW_CNT = 0;
constexpr int CW_Q = 64;
constexpr int CW_BAR = 4096;

struct Ctx {
  const float* in[25];
  float* out;
  unsigned char* ws;
  int ph_lo, ph_hi;
};


extern __shared__ __attribute__((aligned(16))) unsigned char lds_raw[];
constexpr int LDS_BYTES = 157696;
constexpr int LDS_WCTR = LDS_BYTES - 64;
__device__ __forceinline__ int phase_tid() {
  __syncthreads();
  int l; asm volatile("v_mbcnt_lo_u32_b32 %0, -1, 0\n\tv_mbcnt_hi_u32_b32 %0, -1, %0" : "=v"(l));
  unsigned w = 0u;
  if (l == 0) w = __hip_atomic_fetch_add((__attribute__((address_space(3))) unsigned*)(__attribute__((address_space(3))) unsigned char*)(lds_raw + LDS_WCTR), 1u, __ATOMIC_RELAXED, __HIP_MEMORY_SCOPE_WORKGROUP);
  w = (unsigned)__builtin_amdgcn_readfirstlane((int)w) & 7u;
  return (int)(w * 64u) + l;
}


#define XB_TMO      128
#define XB_XCNT(j)  (256  + 64 * (j))
#define XB_XSUB(j)  (1280 + 64 * (j))
#define XB_XGEN(j)  (2304 + 64 * (j))
#define XB_TOP      3328
#define XB_TOPGEN   3392
#define XCD_BAR_WORDS 3456
#define XB_SPIN_CAP (1u << 18)
constexpr int LDS_XBST = LDS_BYTES - 32;
__device__ __forceinline__ unsigned xb_ld(unsigned* p)              { return __hip_atomic_load(p, __ATOMIC_RELAXED, __HIP_MEMORY_SCOPE_AGENT); }
__device__ __forceinline__ unsigned xb_add(unsigned* p, unsigned v) { return __hip_atomic_fetch_add(p, v, __ATOMIC_RELAXED, __HIP_MEMORY_SCOPE_AGENT); }
__device__ __forceinline__ unsigned xb_xcc_id() { return (unsigned)__builtin_amdgcn_s_getreg((3 << 11) | 20) & 0xFu; }
#define XB_SPIN(cond, bar) do { unsigned _sp = 0; while (cond) { __builtin_amdgcn_s_sleep(1); \
    if ((++_sp & 255u) == 0u) { if (xb_ld(&(bar)[XB_TMO])) break; if (_sp > XB_SPIN_CAP) { atomicAdd(&(bar)[XB_TMO], 1u); break; } } } } while (0)
__device__ __forceinline__ void xcd_barrier_complete(unsigned* bar, unsigned x, unsigned& nloc, unsigned& nx) {
    const unsigned G = gridDim.x;
    unsigned sum, cnt, mine, sp = 0u;
    for (;;) {
        sum = 0u; cnt = 0u; mine = 0u;
#pragma unroll
        for (unsigned j = 0; j < 16; ++j) { const unsigned cc = xb_ld(&bar[XB_XCNT(j)]); sum += cc; cnt += (cc > 0u) ? 1u : 0u; mine = (j == x) ? cc : mine; }
        if (sum == G) break;
        __builtin_amdgcn_s_sleep(1);
        if ((++sp & 255u) == 0u) { if (xb_ld(&bar[XB_TMO])) break; if (sp > XB_SPIN_CAP) { atomicAdd(&bar[XB_TMO], 1u); break; } }
    }
    nloc = mine > 0u ? mine : 1u; nx = cnt > 0u ? cnt : 1u;
}
__device__ __forceinline__ void xcd_barrier(unsigned* bar) {
    asm volatile("s_waitcnt vmcnt(0)" ::: "memory");
    __syncthreads();
    const int btid = phase_tid();
    if (btid == 0) {
        volatile __attribute__((address_space(3))) unsigned* st = (volatile __attribute__((address_space(3))) unsigned*)(__attribute__((address_space(3))) unsigned char*)(lds_raw + LDS_XBST);
        const unsigned x = xb_xcc_id();
        __builtin_amdgcn_s_waitcnt(0);
        unsigned nloc = st[0], nx = st[1];
        if (nloc == 0u) { xcd_barrier_complete(bar, x, nloc, nx); st[0] = nloc; st[1] = nx; }
        const unsigned old = xb_add(&bar[XB_XSUB(x)], 1u);
        const unsigned gen = old / nloc;
        if (old + 1u == (gen + 1u) * nloc) {
            __builtin_amdgcn_fence(__ATOMIC_RELEASE, "agent");
            asm volatile("s_waitcnt vmcnt(0)" ::: "memory");
            const unsigned og = xb_add(&bar[XB_TOP], 1u);
            const unsigned tg = og / nx;
            if (og + 1u == (tg + 1u) * nx) xb_add(&bar[XB_TOPGEN], 1u);
            else XB_SPIN(xb_ld(&bar[XB_TOPGEN]) == tg, bar);
            __builtin_amdgcn_fence(__ATOMIC_ACQUIRE, "agent");
            xb_add(&bar[XB_XGEN(x)], 1u);
            asm volatile("s_waitcnt vmcnt(0)" ::: "memory");
        } else {
            XB_SPIN(xb_ld(&bar[XB_XGEN(x)]) == gen, bar);
            __builtin_amdgcn_fence(__ATOMIC_ACQUIRE, "agent");
            asm volatile("s_waitcnt vmcnt(0)" ::: "memory");
        }
    }
    __syncthreads();
}

__device__ __forceinline__ float bf2f(bf16_t v) { return __uint_as_float(((unsigned)v) << 16); }
typedef float hw_f32x2 __attribute__((ext_vector_type(2))); typedef __bf16 hw_bf16x2 __attribute__((ext_vector_type(2)));
__device__ __forceinline__ unsigned pk2(float lo, float hi) { const hw_f32x2 v = {lo, hi}; const hw_bf16x2 b = __builtin_convertvector(v, hw_bf16x2); return __builtin_bit_cast(unsigned, b); }
__device__ __forceinline__ bf16_t f2bf(float f) { return (bf16_t)(pk2(f, f) & 0xffffu); }
__device__ __forceinline__ float wave_sum(float v) {
  int x = __float_as_int(v);
  x = __float_as_int(__int_as_float(x) + __int_as_float(__builtin_amdgcn_update_dpp(0, x, 0x111, 0xF, 0xF, true)));
  x = __float_as_int(__int_as_float(x) + __int_as_float(__builtin_amdgcn_update_dpp(0, x, 0x112, 0xF, 0xF, true)));
  x = __float_as_int(__int_as_float(x) + __int_as_float(__builtin_amdgcn_update_dpp(0, x, 0x114, 0xF, 0xF, true)));
  x = __float_as_int(__int_as_float(x) + __int_as_float(__builtin_amdgcn_update_dpp(0, x, 0x118, 0xF, 0xF, true)));
  x = __float_as_int(__int_as_float(x) + __int_as_float(__builtin_amdgcn_update_dpp(0, x, 0x142, 0xA, 0xF, false)));
  x = __float_as_int(__int_as_float(x) + __int_as_float(__builtin_amdgcn_update_dpp(0, x, 0x143, 0xC, 0xF, false)));
  return __int_as_float(__builtin_amdgcn_readlane(x, 63));
}
__device__ __forceinline__ float wave_max(float v) {
#pragma unroll
  for (int o = 32; o >= 1; o >>= 1) v = fmaxf(v, __shfl_xor(v, o));
  return v;
}
__device__ __forceinline__ float silu_f(float v) { return v * __builtin_amdgcn_rcpf(1.f + __expf(-v)); }

__device__ __forceinline__ int ropeperm(int p) { return (p >> 1) + 32 * (p & 1); }
__device__ __forceinline__ int colmap_in(int cp) {
  const int tile = cp >> 8, w = cp & 255;
  if (tile == 0) return (w >> 6) * 64 + ropeperm(w & 63);
  if (tile == 1) { if (w < 128) { const int c = 256 + w; return (c >> 6) * 64 + ropeperm(c & 63); } return 384 + (w - 128); }
  if (tile == 2) return 512 + (w >> 6) * 64 + ropeperm(w & 63);
  if (tile == 3) { if (w < 64) return 768 + ropeperm(w); if (w < 68) return 832 + (w - 64); if (w < 74) return 2372 + (w - 68); if (w < 80) return 2378 + (w - 74); return -1; }
  if (tile == 4) return 2384 + w;
  return 836 + (cp - 1280);
}

struct WorkQ { unsigned* head; volatile int* slot; int nxt; };
__device__ __forceinline__ void wq_init(WorkQ& q, unsigned* head, volatile int* slot, int tid) { q.head = head; q.slot = slot; q.nxt = 0; if (tid == 0) q.nxt = (int)atomicAdd(head, 1u); }
__device__ __forceinline__ int wq_next(WorkQ& q, int tid) {
  __syncthreads();
  if (tid == 0) { *q.slot = q.nxt; q.nxt = (int)atomicAdd(q.head, 1u); }
  __syncthreads();
  return *q.slot;
}

template <class CM>
__device__ __forceinline__ void tp_tile(const float* src, int ld, bf16_t* dst, int drow0, int K, int k0, CM cm, float* lds, int tid) {
  const int a = tid & 63, b = tid >> 6;
  const int sc = cm(a);
  __syncthreads();
#pragma unroll
  for (int i = 0; i < 8; ++i) { const int kk = b * 8 + i; lds[kk * 65 + a] = sc >= 0 ? src[(size_t)(k0 + kk) * ld + sc] : 0.f; }
  __syncthreads();
  { const int nn = tid >> 3, kc = (tid & 7) * 8;
    const float* p = lds + kc * 65 + nn;
    *(u32x4*)(dst + (size_t)(drow0 + nn) * K + k0 + kc) = (u32x4){pk2(p[0], p[65]), pk2(p[130], p[195]), pk2(p[260], p[325]), pk2(p[390], p[455])}; }
}

__device__ void phase_prologue(const Ctx& c, float* lds) {
  const int tid = phase_tid(), bid = blockIdx.x, G = gridDim.x;
  unsigned char* ws = c.ws;
  const size_t gtid = (size_t)bid * NTHREADS + tid, gstride = (size_t)G * NTHREADS;
  { const f32x4* x4 = (const f32x4*)c.in[0]; u32x2* o = (u32x2*)(ws + WS_XB);
    for (size_t i = gtid; i < (size_t)T * DM / 4; i += gstride) { const f32x4 v = x4[i]; o[i] = (u32x2){pk2(v.x, v.y), pk2(v.z, v.w)}; }
    const f32x4* m4 = (const f32x4*)c.in[1]; u32x2* om = (u32x2*)(ws + WS_MEMB);
    for (size_t i = gtid; i < (size_t)TM * DM / 4; i += gstride) { const f32x4 v = m4[i]; om[i] = (u32x2){pk2(v.x, v.y), pk2(v.z, v.w)}; } }
  { float* cs = (float*)(ws + WS_ROPE); float* sn = cs + SEQ * 32;
    for (size_t i = gtid; i < (size_t)SEQ * 32; i += gstride) { const int s = (int)(i >> 5), d = (int)(i & 31);
      const float inv = 1.0f / powf(10000.0f, (float)d / 32.0f); const float ang = (float)s * inv; float sv, cv; sincosf(ang, &sv, &cv); cs[i] = cv; sn[i] = sv; } }
  { bf16_t* wkv = (bf16_t*)(ws + WS_WKV); const float* g = c.in[3]; const float* wk = c.in[4]; const float* wv = c.in[5];
    for (size_t i = gtid; i < 128 * 128; i += gstride) { const int p = (int)(i >> 7), k = (int)(i & 127);
      const float w = p < 64 ? wk[k * 64 + ropeperm(p)] : wv[k * 64 + (p - 64)]; wkv[i] = f2bf(w * g[k]); }
    bf16_t* wr = (bf16_t*)(ws + WS_WR); const float* wg = c.in[16]; const float* wrt = c.in[18];
    for (size_t i = gtid; i < 80 * 1024; i += gstride) { const int o = (int)(i >> 10), k = (int)(i & 1023); wr[i] = f2bf(o < 8 ? wg[k * 8 + o] : o < 72 ? wrt[k * 64 + (o - 8)] : 0.f); } }
  const int n_win = (NIN / 64) * 16, n_wo = 16 * 16, n_wmkv = 8 * 16, n_wgu = 64 * 8 * 16, n_wd = 64 * 16 * 4;
  const int total = n_win + n_wo + n_wmkv + n_wgu + n_wd;
  for (int it = bid; it < total; it += G) {
    int r = it;
    if (r < n_win) { const int nt = r / 16, kt = r % 16; tp_tile(c.in[2], 2640, (bf16_t*)(ws + WS_WIN), nt * 64, 1024, kt * 64, [&](int a) { return colmap_in(nt * 64 + a); }, lds, tid); continue; } r -= n_win;
    if (r < n_wo) { const int nt = r / 16, kt = r % 16; tp_tile(c.in[13], 1024, (bf16_t*)(ws + WS_WO), nt * 64, 1024, kt * 64, [&](int a) { return nt * 64 + a; }, lds, tid); continue; } r -= n_wo;
    if (r < n_wmkv) { const int nt = r / 16, kt = r % 16; tp_tile(c.in[12], 512, (bf16_t*)(ws + WS_WMKV), nt * 64, 1024, kt * 64, [&](int a) { return nt * 64 + a; }, lds, tid); continue; } r -= n_wmkv;
    if (r < n_wgu) { const int e = r / 128, q = r % 128, nt = q / 16, kt = q % 16;
      const int pn = nt >> 2, sub = nt & 3, isup = sub >> 1, c0 = pn * 128 + (sub & 1) * 64;
      const float* src = (isup ? c.in[21] : c.in[20]) + (size_t)e * 1024 * 256;
      tp_tile(src, 256, (bf16_t*)(ws + WS_WGU), e * 512 + nt * 64, 1024, kt * 64, [&](int a) { return c0 + a; }, lds, tid); continue; } r -= n_wgu;
    { const int e = r / 64, q = r % 64, nt = q / 4, kt = q % 4;
      tp_tile(c.in[22] + (size_t)e * 256 * 1024, 1024, (bf16_t*)(ws + WS_WD), e * 1024 + nt * 64, 256, kt * 64, [&](int a) { return nt * 64 + a; }, lds, tid); }
  }
}

__device__ __forceinline__ void expert_offsets(const Ctx& c, int* offs  , int* cnts  , int tid) {
  const unsigned* ctl = (const unsigned*)(c.ws + WS_CTL);
  __syncthreads();
  if (tid == 0) { int o = 0; for (int e = 0; e < 64; ++e) { const int n = (int)ctl[CW_CNT + e]; cnts[e] = n; offs[e] = o; o += (n + 255) & ~255; } offs[64] = o; }
  __syncthreads();
}


namespace pg8 {
#define PG8_LAS __attribute__((address_space(3)))
typedef short bf16x8 __attribute__((ext_vector_type(8)));
constexpr int BM = 256, BK = 64, HALF = 128, HTB = HALF * BK * 2, STAGE_BYTES = 8 * HTB, NXCD = 8, WGM = 8;
__host__ __device__ __forceinline__ int lds_byte(int r, int c) { const int st = (r >> 4) * 2 + (c >> 5), rr = r & 15, cc = c & 31, ob = rr * 64 + cc * 2; return st * 1024 + (ob ^ (((ob >> 9) & 1) << 5)); }
__host__ __device__ __forceinline__ void stage_rc(int b, int& R, int& C) { const int st = b / 1024, sb = b % 1024, swz = sb ^ (((sb >> 9) & 1) << 5); R = (st >> 1) * 16 + swz / 64; C = (st & 1) * 32 + (swz % 64) / 2; }
__host__ __device__ __forceinline__ int perm32(int rho) { const int n = rho >> 4, i = rho & 15; return 8 * (i >> 2) + 4 * n + (i & 3); }
struct Unit { int pm, pn, e, mt, aux; };
struct Gemm { const bf16_t* A; const bf16_t* Bt; int K; };
struct StaticOrder {
    int nM, nN, nwg, G, c;
    __device__ void init(int M, int N, int G_, int c_) { nM = M / BM; nN = N / BM; nwg = nM * nN; G = G_; c = c_; }
    __device__ bool next(int i, Unit& u) const {
        const long L = (long)i * G + c; if (c < 0 || L >= nwg) return false;
        int wgid = (int)L; { const int q = nwg / NXCD, r = nwg % NXCD, xcd = wgid % NXCD, off = wgid / NXCD; wgid = (xcd < r ? xcd * (q + 1) : r * (q + 1) + (xcd - r) * q) + off; }
        const int nig = WGM * nN, gid = wgid / nig, fm = gid * WGM, gsz = (nM - fm) < WGM ? (nM - fm) : WGM;
        u.pm = fm + ((wgid % nig) % gsz); u.pn = (wgid % nig) / gsz; u.e = 0; u.mt = 0; u.aux = 0; return true;
    }
    __device__ __forceinline__ unsigned arow(const Unit&, int) const { return 0u; }
};
__device__ __forceinline__ unsigned cvt_pk_bf16(float lo, float hi) { unsigned r; asm volatile("v_cvt_pk_bf16_f32 %0, %1, %2" : "=v"(r) : "v"(lo), "v"(hi)); return r; }

template <class Epi, class Sched, bool ALIGN_EPI, bool GATHER>
__device__ __forceinline__ void gemm_phase(PG8_LAS unsigned char* lds, const Gemm g, const Sched& S, const Epi& E, const int tid) {
    const int wid = __builtin_amdgcn_readfirstlane(tid >> 6), lane = tid & 63, wr = wid >> 2, wc = wid & 3, fr = lane & 15, fq = lane >> 4;
    const int K = g.K, nt = K / BK;
    unsigned voffA[2], voffB[2]; int RA[2], CA[2];
#pragma unroll
    for (int i = 0; i < 2; ++i) { int R, C; stage_rc(tid * 16 + i * 8192, R, C); const int Rb = Epi::PERM ? ((R & ~31) + perm32(R & 31)) : R;
        RA[i] = R; CA[i] = C; voffA[i] = (unsigned)(R * K + C) * 2u; voffB[i] = (unsigned)(Rb * K + C) * 2u; }
    const size_t kstep = (size_t)(BK * 2);
    const size_t hstep = (size_t)HALF * K * 2;
    const size_t tstep = 2 * hstep;
    const unsigned ldsw = (unsigned)wid * 1024u;
    const int aoff = lds_byte(wr * 64 + fr, fq * 8), boff = lds_byte(wc * 32 + fr, fq * 8);
#define PG8_SA(b, h) (((b) * 2 + (h)) * HTB)
#define PG8_SB(b, h) ((4 + (b) * 2 + (h)) * HTB)
#define PG8_STAGE(bufoff, gbase, voff) do { _Pragma("unroll") for (int _i = 0; _i < 2; ++_i) \
        __builtin_amdgcn_global_load_lds((const unsigned*)((const char*)(gbase) + (voff)[_i]), (PG8_LAS unsigned*)(lds + (bufoff) + ldsw + _i * 8192), 16, 0, 0); } while (0)
#define PG8_STAGE_A(bufoff, gbase, h, goff) do { if constexpr (GATHER) { PG8_STAGE(bufoff, gbase, (goff)[h]); } else { PG8_STAGE(bufoff, (gbase) + (h) * hstep, voffA); } } while (0)
#define PG8_LDA(dst, b, h) do { _Pragma("unroll") for (int m = 0; m < 4; ++m) _Pragma("unroll") for (int k = 0; k < 2; ++k) dst[m][k] = *(const PG8_LAS bf16x8*)(lds + PG8_SA(b, h) + aoff + m * 2048 + k * 1024); } while (0)
#define PG8_LDB(dst, b, h) do { _Pragma("unroll") for (int n = 0; n < 2; ++n) _Pragma("unroll") for (int k = 0; k < 2; ++k) dst[n][k] = *(const PG8_LAS bf16x8*)(lds + PG8_SB(b, h) + boff + n * 2048 + k * 1024); } while (0)
#define PG8_MMA(ai, bj, At, Bt) do { __builtin_amdgcn_s_setprio(1); _Pragma("unroll") for (int m = 0; m < 4; ++m) _Pragma("unroll") for (int n = 0; n < 2; ++n) _Pragma("unroll") for (int k = 0; k < 2; ++k) \
        acc[ai][bj][m][n] = __builtin_amdgcn_mfma_f32_16x16x32_bf16(Bt[n][k], At[m][k], acc[ai][bj][m][n], 0, 0, 0); __builtin_amdgcn_s_setprio(0); } while (0)
#define PG8_WAIT_V(n) asm volatile("s_waitcnt vmcnt(" #n ")" ::: "memory")
#define PG8_WAIT_L(n) asm volatile("s_waitcnt lgkmcnt(" #n ")" ::: "memory")
#define PG8_BAR __builtin_amdgcn_s_barrier()
#define PG8_SCHED __builtin_amdgcn_sched_barrier(0)
    Unit cur, nxt; int ui = 0;
    if (!S.next(0, cur)) return;
    f32x4 acc[2][2][4][2];
#pragma unroll
    for (int a = 0; a < 2; ++a)
#pragma unroll
        for (int b = 0; b < 2; ++b)
#pragma unroll
            for (int m = 0; m < 4; ++m)
#pragma unroll
                for (int n = 0; n < 2; ++n) acc[a][b][m][n] = (f32x4){0.f, 0.f, 0.f, 0.f};
    bf16x8 At[4][2], B0[2][2], B1[2][2];
    unsigned gc[2][2], gn[2][2];
    const char* cA; const char* cB = (const char*)g.Bt + (size_t)cur.pn * tstep;
    if constexpr (GATHER) { cA = (const char*)g.A;
#pragma unroll
        for (int h = 0; h < 2; ++h)
#pragma unroll
            for (int i = 0; i < 2; ++i) { gc[h][i] = (S.arow(cur, h * HALF + RA[i]) * (unsigned)K + (unsigned)CA[i]) * 2u; gn[h][i] = gc[h][i]; }
    } else { cA = (const char*)g.A + (size_t)cur.pm * tstep; }
    PG8_STAGE(PG8_SB(0, 0), cB, voffB); PG8_STAGE(PG8_SB(0, 1), cB + hstep, voffB); PG8_STAGE_A(PG8_SA(0, 0), cA, 0, gc); PG8_STAGE_A(PG8_SA(0, 1), cA, 1, gc);
    if (wr == 1) PG8_BAR;
    PG8_WAIT_V(2); PG8_BAR;
    PG8_STAGE(PG8_SB(1, 0), cB + kstep, voffB); PG8_STAGE_A(PG8_SA(1, 0), cA + kstep, 0, gc); PG8_STAGE(PG8_SB(1, 1), cB + hstep + kstep, voffB);
    PG8_WAIT_V(6); PG8_BAR;
    for (;;) {
        const bool has_next = S.next(ui + 1, nxt);
        const char* nA; const char* nB = has_next ? (const char*)g.Bt + (size_t)nxt.pn * tstep : cB;
        if constexpr (GATHER) { nA = cA;
            if (has_next) {
#pragma unroll
                for (int h = 0; h < 2; ++h)
#pragma unroll
                    for (int i = 0; i < 2; ++i) gn[h][i] = (S.arow(nxt, h * HALF + RA[i]) * (unsigned)K + (unsigned)CA[i]) * 2u; }
        } else { nA = has_next ? (const char*)g.A + (size_t)nxt.pm * tstep : cA; }
        for (int t = 0; t < nt; t += 2) {
            const bool last = (t == nt - 2);
            const char* a1 = cA + (size_t)(t + 1) * kstep;
            const char* a2 = last ? nA : cA + (size_t)(t + 2) * kstep; const char* b2 = last ? nB : cB + (size_t)(t + 2) * kstep;
            const char* a3 = a2 + kstep; const char* b3 = b2 + kstep;
            unsigned g2[2][2];
            if constexpr (GATHER) {
#pragma unroll
            for (int h = 0; h < 2; ++h)
#pragma unroll
                for (int i = 0; i < 2; ++i) g2[h][i] = last ? gn[h][i] : gc[h][i]; }
            PG8_LDB(B0, 0, 0); PG8_LDB(B1, 0, 1); PG8_SCHED; PG8_LDA(At, 0, 0); PG8_STAGE_A(PG8_SA(1, 1), a1, 1, gc);
            PG8_WAIT_V(8); PG8_WAIT_L(0); PG8_BAR; PG8_MMA(0, 0, At, B0); PG8_MMA(0, 1, At, B1); PG8_BAR; PG8_SCHED;
            PG8_LDA(At, 0, 1); PG8_STAGE(PG8_SB(0, 0), b2, voffB); PG8_STAGE(PG8_SB(0, 1), b2 + hstep, voffB); PG8_STAGE_A(PG8_SA(0, 0), a2, 0, g2);
            PG8_WAIT_V(8); PG8_WAIT_L(0); PG8_BAR; PG8_MMA(1, 0, At, B0); PG8_MMA(1, 1, At, B1); PG8_BAR; PG8_SCHED;
            PG8_LDB(B0, 1, 0); PG8_LDB(B1, 1, 1); PG8_SCHED; PG8_LDA(At, 1, 0); PG8_STAGE_A(PG8_SA(0, 1), a2, 1, g2);
            PG8_WAIT_V(8); PG8_WAIT_L(0); PG8_BAR; PG8_MMA(0, 0, At, B0); PG8_MMA(0, 1, At, B1); PG8_BAR; PG8_SCHED;
            PG8_LDA(At, 1, 1); PG8_STAGE(PG8_SB(1, 0), b3, voffB); PG8_STAGE(PG8_SB(1, 1), b3 + hstep, voffB); PG8_STAGE_A(PG8_SA(1, 0), a3, 0, g2);
            PG8_WAIT_V(8); PG8_WAIT_L(0); PG8_BAR; PG8_MMA(1, 0, At, B0); PG8_MMA(1, 1, At, B1); PG8_BAR; PG8_SCHED;
        }
        if constexpr (ALIGN_EPI) { if (wr == 0) PG8_BAR; }
        E(acc, cur, wr, wc, fr, fq);
        if (!has_next) break;
#pragma unroll
        for (int a = 0; a < 2; ++a)
#pragma unroll
            for (int b = 0; b < 2; ++b)
#pragma unroll
                for (int m = 0; m < 4; ++m)
#pragma unroll
                    for (int n = 0; n < 2; ++n) acc[a][b][m][n] = (f32x4){0.f, 0.f, 0.f, 0.f};
        cur = nxt; cA = nA; cB = nB; ++ui;
        if constexpr (GATHER) {
#pragma unroll
        for (int h = 0; h < 2; ++h)
#pragma unroll
            for (int i = 0; i < 2; ++i) gc[h][i] = gn[h][i]; }
        if constexpr (ALIGN_EPI) { if (wr == 1) PG8_BAR; }
    }
    PG8_WAIT_V(0);
    if constexpr (!ALIGN_EPI) { if (wr == 0) PG8_BAR; }
    PG8_BAR;
#undef PG8_SA
#undef PG8_SB
#undef PG8_STAGE
#undef PG8_STAGE_A
#undef PG8_LDA
#undef PG8_LDB
#undef PG8_MMA
#undef PG8_WAIT_V
#undef PG8_WAIT_L
#undef PG8_BAR
#undef PG8_SCHED
}
}
typedef __attribute__((address_space(3))) unsigned char lds_u8;

__device__ __forceinline__ u32x4 pack8(const f32x4& a, const f32x4& b) { return (u32x4){pg8::cvt_pk_bf16(a.x, a.y), pg8::cvt_pk_bf16(a.z, a.w), pg8::cvt_pk_bf16(b.x, b.y), pg8::cvt_pk_bf16(b.z, b.w)}; }
struct EpiInM {
  static constexpr bool PERM = true;
  unsigned char* ws;
  __device__ __forceinline__ void operator()(const f32x4 (&acc)[2][2][4][2], const pg8::Unit& u, int wr, int wc, int fr, int fq) const {
    const float* cs = (const float*)(ws + WS_ROPE); const float* sn = cs + SEQ * 32;
    const int pn = u.pn;
#pragma unroll
    for (int ai = 0; ai < 2; ++ai)
#pragma unroll
      for (int m = 0; m < 4; ++m) {
        const int row = u.pm * 256 + ai * 128 + wr * 64 + m * 16 + fr, pos = row & (SEQ - 1);
#pragma unroll
        for (int bj = 0; bj < 2; ++bj) {
          const int w = bj * 128 + wc * 32 + 8 * fq;
          f32x4 v0 = acc[ai][bj][m][0], v1 = acc[ai][bj][m][1];
          const bool do_rope = (pn == 0) || (pn == 1 && bj == 0) || (pn == 2) || (pn == 3 && bj == 0 && wc < 2);
          if (do_rope) { const int d = (w & 63) >> 1; const f32x4 c4 = *(const f32x4*)(cs + pos * 32 + d), s4 = *(const f32x4*)(sn + pos * 32 + d);
            const f32x4 o0 = {v0.x * c4.x - v0.y * s4.x, v0.y * c4.x + v0.x * s4.x, v0.z * c4.y - v0.w * s4.y, v0.w * c4.y + v0.z * s4.y};
            const f32x4 o1 = {v1.x * c4.z - v1.y * s4.z, v1.y * c4.z + v1.x * s4.z, v1.z * c4.w - v1.w * s4.w, v1.w * c4.w + v1.z * s4.w};
            v0 = o0; v1 = o1; }
          if (pn == 0) { *(u32x4*)((bf16_t*)(ws + WS_QA) + (size_t)row * 384 + w) = pack8(v0 * QSCALE, v1 * QSCALE); }
          else if (pn == 1) { if (bj == 0) *(u32x4*)((bf16_t*)(ws + WS_QA) + (size_t)row * 384 + 256 + w) = pack8(v0 * QSCALE, v1 * QSCALE);
                              else *(u32x4*)((bf16_t*)(ws + WS_CKV) + (size_t)row * 128 + (w - 128)) = pack8(v0, v1); }
          else if (pn == 2) { *(u32x4*)((bf16_t*)(ws + WS_IQ) + (size_t)row * 256 + w) = pack8(v0, v1); }
          else if (pn == 3) { if (bj == 0) { if (wc < 2) *(u32x4*)((bf16_t*)(ws + WS_IK) + (size_t)row * 64 + w) = pack8(v0, v1);
                                             else if (wc == 2 && fq < 2) { if (fq == 0) v0 = v0 * 0.0625f; float* o = (float*)(ws + WS_SM) + (size_t)row * 16 + 8 * fq; *(f32x4*)o = v0; *(f32x4*)(o + 4) = v1; } } }
          else if (pn == 4) { *(u32x4*)((bf16_t*)(ws + WS_QC) + (size_t)row * 256 + w) = pack8(v0 * QSCALE, v1 * QSCALE); }
          else { *(u32x4*)((bf16_t*)(ws + WS_GB) + (size_t)row * 1536 + (pn - 5) * 256 + w) = pack8(v0, v1); }
        }
      }
  }
};
struct EpiMemKVM {
  static constexpr bool PERM = true;
  unsigned char* ws;
  __device__ __forceinline__ void operator()(const f32x4 (&acc)[2][2][4][2], const pg8::Unit& u, int wr, int wc, int fr, int fq) const {
#pragma unroll
    for (int ai = 0; ai < 2; ++ai)
#pragma unroll
      for (int m = 0; m < 4; ++m) {
        const int row = u.pm * 256 + ai * 128 + wr * 64 + m * 16 + fr;
#pragma unroll
        for (int bj = 0; bj < 2; ++bj) {
          const int w = bj * 128 + wc * 32 + 8 * fq; const f32x4 v0 = acc[ai][bj][m][0], v1 = acc[ai][bj][m][1];
          if (u.pn == 0) *(u32x4*)((bf16_t*)(ws + WS_MK) + (size_t)row * 256 + w) = pack8(v0, v1);
          else { const int mem = row & 255, xx = mem & 31, mpos = (mem & ~31) + 8 * ((xx >> 2) & 3) + (xx & 3) + 4 * (xx >> 4);
            bf16_t* o = (bf16_t*)(ws + WS_MVT) + ((size_t)(row >> 8) * 256 + w) * 256 + mpos;
            o[0] = f2bf(v0.x); o[256] = f2bf(v0.y); o[512] = f2bf(v0.z); o[768] = f2bf(v0.w); o[1024] = f2bf(v1.x); o[1280] = f2bf(v1.y); o[1536] = f2bf(v1.z); o[1792] = f2bf(v1.w); }
        }
      }
  }
};
struct EpiOutM {
  static constexpr bool PERM = true;
  const float* x; bf16_t* y;
  __device__ __forceinline__ void operator()(const f32x4 (&acc)[2][2][4][2], const pg8::Unit& u, int wr, int wc, int fr, int fq) const {
#pragma unroll
    for (int ai = 0; ai < 2; ++ai)
#pragma unroll
      for (int m = 0; m < 4; ++m) {
        const size_t rb = (size_t)(u.pm * 256 + ai * 128 + wr * 64 + m * 16 + fr) * 1024 + u.pn * 256 + wc * 32 + 8 * fq;
#pragma unroll
        for (int bj = 0; bj < 2; ++bj) { const size_t o = rb + bj * 128; const f32x4 x0 = *(const f32x4*)(x + o), x1 = *(const f32x4*)(x + o + 4);
          *(u32x4*)(y + o) = pack8(x0 * ALPHA + acc[ai][bj][m][0], x1 * ALPHA + acc[ai][bj][m][1]); }
      }
  }
};
struct MoeOrder {
  const int* offs; const int* cnts; int npn, G, c; const unsigned* LIST;
  __device__ __forceinline__ bool next(int i, pg8::Unit& u) const {
    const int L = i * G + c; const int ntiles = __builtin_amdgcn_readfirstlane(offs[64]) >> 8;
    if (L >= ntiles * npn) return false;
    const int rt = L / npn, pl = L - rt * npn; int e = 0;
    while (__builtin_amdgcn_readfirstlane(offs[e + 1]) <= rt * 256) ++e;
    u.pm = rt; u.mt = rt - (__builtin_amdgcn_readfirstlane(offs[e]) >> 8); u.e = e; u.pn = e * npn + pl; u.aux = __builtin_amdgcn_readfirstlane(cnts[e]); return true;
  }
  __device__ __forceinline__ unsigned arow(const pg8::Unit& u, int r) const { const int rank = u.mt * 256 + r; return rank < u.aux ? LIST[(size_t)u.e * 32768 + rank] : 0u; }
};
struct EpiMoeUpM {
  static constexpr bool PERM = true;
  bf16_t* H;
  __device__ __forceinline__ void operator()(const f32x4 (&acc)[2][2][4][2], const pg8::Unit& u, int wr, int wc, int fr, int fq) const {
    const int pl = u.pn & 1;
#pragma unroll
    for (int ai = 0; ai < 2; ++ai)
#pragma unroll
      for (int m = 0; m < 4; ++m) {
        const int rl = ai * 128 + wr * 64 + m * 16 + fr;
        if (u.mt * 256 + rl < u.aux) {
          f32x4 h0, h1; const f32x4 g0 = acc[ai][0][m][0], g1 = acc[ai][0][m][1], u0 = acc[ai][1][m][0], u1 = acc[ai][1][m][1];
          h0.x = silu_f(g0.x) * u0.x; h0.y = silu_f(g0.y) * u0.y; h0.z = silu_f(g0.z) * u0.z; h0.w = silu_f(g0.w) * u0.w;
          h1.x = silu_f(g1.x) * u1.x; h1.y = silu_f(g1.y) * u1.y; h1.z = silu_f(g1.z) * u1.z; h1.w = silu_f(g1.w) * u1.w;
          *(u32x4*)(H + (size_t)(u.pm * 256 + rl) * 256 + pl * 128 + wc * 32 + 8 * fq) = pack8(h0, h1);
        }
      }
  }
};
__device__ __forceinline__ unsigned pk4_fp8(const f32x4& v) { unsigned w = __builtin_amdgcn_cvt_pk_fp8_f32(v.x, v.y, 0u, false); return __builtin_amdgcn_cvt_pk_fp8_f32(v.z, v.w, w, true); }
struct EpiMoeDownM {
  static constexpr bool PERM = true;
  unsigned char* Y; const float* GATEL;
  __device__ __forceinline__ void operator()(const f32x4 (&acc)[2][2][4][2], const pg8::Unit& u, int wr, int wc, int fr, int fq) const {
    const int pl = u.pn & 3;
    const float* gp = GATEL + (size_t)u.e * 32768; const int rk0 = u.mt * 256 + wr * 64 + fr;
    unsigned char* yp = Y + (size_t)(u.pm * 256 + wr * 64 + fr) * 1024 + pl * 256 + wc * 32 + 8 * fq;
#pragma unroll
    for (int ai = 0; ai < 2; ++ai)
#pragma unroll
      for (int m = 0; m < 4; ++m) {
        const int rk = rk0 + ai * 128 + m * 16; const float gt = gp[rk < 32767 ? rk : 32767] * 64.0f;
#pragma unroll
        for (int bj = 0; bj < 2; ++bj)
          *(u32x2*)(yp + (size_t)(ai * 128 + m * 16) * 1024 + bj * 128) = (u32x2){pk4_fp8(acc[ai][bj][m][0] * gt), pk4_fp8(acc[ai][bj][m][1] * gt)};
      }
  }
};

__device__ __forceinline__ void phase_inproj_mfma(const Ctx& c, lds_u8* lds) {
  unsigned char* ws = c.ws; const int tid = phase_tid();
  { pg8::Gemm g{(const bf16_t*)(ws + WS_XB), (const bf16_t*)(ws + WS_WIN), 1024}; pg8::StaticOrder S; S.init(T, NIN, gridDim.x, blockIdx.x); EpiInM E{ws};
    pg8::gemm_phase<EpiInM, pg8::StaticOrder, true, false>(lds, g, S, E, tid); }
  { pg8::Gemm g{(const bf16_t*)(ws + WS_MEMB), (const bf16_t*)(ws + WS_WMKV), 1024}; pg8::StaticOrder S; S.init(TM, 512, gridDim.x, (int)blockIdx.x - 128); EpiMemKVM E{ws};
    pg8::gemm_phase<EpiMemKVM, pg8::StaticOrder, true, false>(lds, g, S, E, tid); }
}
__device__ __forceinline__ void phase_outproj_mfma(const Ctx& c, lds_u8* lds) {
  unsigned char* ws = c.ws; const int tid = phase_tid();
  pg8::Gemm g{(const bf16_t*)(ws + WS_CAT), (const bf16_t*)(ws + WS_WO), 1024}; pg8::StaticOrder S; S.init(T, 1024, gridDim.x, blockIdx.x); EpiOutM E{c.in[0], (bf16_t*)(ws + WS_X1B)};
  pg8::gemm_phase<EpiOutM, pg8::StaticOrder, true, false>(lds, g, S, E, tid);
}
__device__ __forceinline__ void phase_moe_up_mfma(const Ctx& c, lds_u8* lds) {
  unsigned char* ws = c.ws; const int tid = phase_tid();
  int* offs = (int*)((unsigned char*)lds + pg8::STAGE_BYTES); int* cnts = offs + 65;
  expert_offsets(c, offs, cnts, tid);
  pg8::Gemm g{(const bf16_t*)(ws + WS_X1B), (const bf16_t*)(ws + WS_WGU), 1024};
  MoeOrder S{offs, cnts, 2, (int)gridDim.x, (int)blockIdx.x, (const unsigned*)(ws + WS_LIST)}; EpiMoeUpM E{(bf16_t*)(ws + WS_H)};
  pg8::gemm_phase<EpiMoeUpM, MoeOrder, true, true>(lds, g, S, E, tid);
}
__device__ __forceinline__ void phase_moe_down_mfma(const Ctx& c, lds_u8* lds) {
  unsigned char* ws = c.ws; const int tid = phase_tid();
  int* offs = (int*)((unsigned char*)lds + pg8::STAGE_BYTES); int* cnts = offs + 65;
  expert_offsets(c, offs, cnts, tid);
  pg8::Gemm g{(const bf16_t*)(ws + WS_H), (const bf16_t*)(ws + WS_WD), 256};
  MoeOrder S{offs, cnts, 4, (int)gridDim.x, (int)blockIdx.x, nullptr}; EpiMoeDownM E{(unsigned char*)(ws + WS_Y), (const float*)(ws + WS_GATEL)};
  pg8::gemm_phase<EpiMoeDownM, MoeOrder, true, false>(lds, g, S, E, tid);
}

__device__ void phase_kvup(const Ctx& c, float* lds) {
  unsigned char* ws = c.ws;
  const int tid = phase_tid(), lane = tid & 63, wave = tid >> 6, fr = lane & 15, fq = lane >> 4;
  const bf16_t* W = (const bf16_t*)(ws + WS_WKV);
  const bf16_t* CKV = (const bf16_t*)(ws + WS_CKV); bf16_t* KVA = (bf16_t*)(ws + WS_KVA);
  const float* cs = (const float*)(ws + WS_ROPE); const float* sn = cs + SEQ * 32;
  for (int tile = blockIdx.x * NWAVES + wave; tile < T / 16; tile += gridDim.x * NWAVES) {
    const int t = tile * 16 + fr, pos = t & (SEQ - 1);
    pg8::bf16x8 bx[4]; float ss = 0.f;
#pragma unroll
    for (int ks = 0; ks < 4; ++ks) { const u32x4 v = *(const u32x4*)(CKV + (size_t)t * 128 + ks * 32 + fq * 8); bx[ks] = __builtin_bit_cast(pg8::bf16x8, v);
      const float f[8] = {__uint_as_float(v.x << 16), __uint_as_float(v.x & 0xffff0000u), __uint_as_float(v.y << 16), __uint_as_float(v.y & 0xffff0000u), __uint_as_float(v.z << 16), __uint_as_float(v.z & 0xffff0000u), __uint_as_float(v.w << 16), __uint_as_float(v.w & 0xffff0000u)};
#pragma unroll
      for (int e = 0; e < 8; ++e) ss += f[e] * f[e]; }
    ss += __shfl_xor(ss, 16); ss += __shfl_xor(ss, 32);
    const float rstd = rsqrtf(ss * (1.f / 128.f) + 1e-6f);
#pragma unroll
    for (int nt = 0; nt < 8; ++nt) { f32x4 d = {0.f, 0.f, 0.f, 0.f};
#pragma unroll
      for (int ks = 0; ks < 4; ++ks) d = __builtin_amdgcn_mfma_f32_16x16x32_bf16(*(const pg8::bf16x8*)(W + (size_t)(nt * 16 + fr) * 128 + ks * 32 + fq * 8), bx[ks], d, 0, 0, 0);
      d = d * rstd;
      const int p0 = nt * 16 + fq * 4;
      if (nt < 4) { const int dd = p0 >> 1; const float c0 = cs[pos * 32 + dd], s0 = sn[pos * 32 + dd], c1 = cs[pos * 32 + dd + 1], s1 = sn[pos * 32 + dd + 1];
        const f32x4 o = {d.x * c0 - d.y * s0, d.y * c0 + d.x * s0, d.z * c1 - d.w * s1, d.w * c1 + d.z * s1}; d = o; }
      *(u32x2*)(KVA + (size_t)t * 128 + p0) = (u32x2){pg8::cvt_pk_bf16(d.x, d.y), pg8::cvt_pk_bf16(d.z, d.w)}; }
  }
}


typedef _Float16 h16x2 __attribute__((ext_vector_type(2)));
constexpr int TK_KP = 4104;
constexpr int TK_KEYS = 0, TK_H1 = 16 * TK_KP * 2, TK_H2 = TK_H1 + 16 * 128 * 4, TK_MISC = TK_H2 + 8 * 128 * 4;
__device__ __forceinline__ unsigned mono16x2(unsigned u) { const unsigned m = ((u >> 15) & 0x00010001u) * 0xffffu; return u ^ (m | 0x80008000u); }
__device__ __forceinline__ int wave_incl_scan(int x) {
  x += __builtin_amdgcn_update_dpp(0, x, 0x111, 0xF, 0xF, true);
  x += __builtin_amdgcn_update_dpp(0, x, 0x112, 0xF, 0xF, true);
  x += __builtin_amdgcn_update_dpp(0, x, 0x114, 0xF, 0xF, true);
  x += __builtin_amdgcn_update_dpp(0, x, 0x118, 0xF, 0xF, true);
  x += __builtin_amdgcn_update_dpp(0, x, 0x142, 0xA, 0xF, false);
  x += __builtin_amdgcn_update_dpp(0, x, 0x143, 0xC, 0xF, false);
  return x;
}

__device__ __forceinline__ void hist_find(const unsigned* hw, int need, int lane, int& B, int& above) {
  const unsigned w0 = hw[127 - 2 * lane], w1 = hw[126 - 2 * lane];
  const int c0 = (int)(w0 >> 16), c1 = (int)(w0 & 0xffffu), c2 = (int)(w1 >> 16), c3 = (int)(w1 & 0xffffu);
  const int tl = c0 + c1 + c2 + c3;
  const int incl = wave_incl_scan(tl);
  const int excl = incl - tl;
  const bool hit = (excl < need) && (incl >= need);
  int b = 0, ab = 0;
  if (hit) { int a = excl; b = 255 - 4 * lane; ab = a;
    if (a + c0 < need) { a += c0; b = 254 - 4 * lane; ab = a; if (a + c1 < need) { a += c1; b = 253 - 4 * lane; ab = a; if (a + c2 < need) { a += c2; b = 252 - 4 * lane; ab = a; } } } }
  const unsigned long long m = __ballot(hit);
  const int src = __builtin_amdgcn_readfirstlane(m ? (__ffsll((long long)m) - 1) : 0);
  B = __builtin_amdgcn_readlane(b, src); above = __builtin_amdgcn_readlane(ab, src);
}
__device__ void phase_topk_mfma(const Ctx& c, unsigned char* ldsb, unsigned* qhead) {
  unsigned char* ws = c.ws;
  const int tid = phase_tid(), lane = tid & 63, wave = tid >> 6, fr = lane & 15, fq = lane >> 4;
  unsigned short* keys = (unsigned short*)(ldsb + TK_KEYS);
  unsigned* h1 = (unsigned*)(ldsb + TK_H1); unsigned* h2 = (unsigned*)(ldsb + TK_H2) + wave * 128; int* misc = (int*)(ldsb + TK_MISC);
  const bf16_t* IQ = (const bf16_t*)(ws + WS_IQ); const bf16_t* IK = (const bf16_t*)(ws + WS_IK); const float* SM = (const float*)(ws + WS_SM);
  unsigned short* SEL = (unsigned short*)(ws + WS_SEL);
  WorkQ wq; wq_init(wq, qhead, misc, tid);
  for (;;) {
    const int item = wq_next(wq, tid);
    if (item >= 240 * 8) break;
    const int b = item & 7, qb = 255 - (item >> 3), s0 = qb * 16;
    for (int i = tid; i < 16 * 128; i += NTHREADS) h1[i] = 0u;
    const size_t qrow = (size_t)b * SEQ + s0 + fr;
    pg8::bf16x8 bq[4][2];
#pragma unroll
    for (int hh = 0; hh < 4; ++hh)
#pragma unroll
      for (int ks = 0; ks < 2; ++ks) bq[hh][ks] = *(const pg8::bf16x8*)(IQ + qrow * 256 + hh * 64 + ks * 32 + fq * 8);
    const f32x4 iw = *(const f32x4*)(SM + qrow * 16);
    const int nkt = qb + 1, slim = s0 + fr;
    __syncthreads();
    pg8::bf16x8 a0n = {0, 0, 0, 0, 0, 0, 0, 0}, a1n = a0n;
    if (wave < nkt) { const bf16_t* kr = IK + ((size_t)b * SEQ + wave * 16 + fr) * 64 + fq * 8; a0n = *(const pg8::bf16x8*)kr; a1n = *(const pg8::bf16x8*)(kr + 32); }
    for (int kt = wave; kt < nkt; kt += NWAVES) {
      const pg8::bf16x8 a0 = a0n, a1 = a1n;
      if (kt + NWAVES < nkt) { const bf16_t* kr = IK + ((size_t)b * SEQ + (kt + NWAVES) * 16 + fr) * 64 + fq * 8; a0n = *(const pg8::bf16x8*)kr; a1n = *(const pg8::bf16x8*)(kr + 32); }
      f32x4 sc = {0.f, 0.f, 0.f, 0.f};
#pragma unroll
      for (int hh = 0; hh < 4; ++hh) { f32x4 d = {0.f, 0.f, 0.f, 0.f};
        d = __builtin_amdgcn_mfma_f32_16x16x32_bf16(a0, bq[hh][0], d, 0, 0, 0); d = __builtin_amdgcn_mfma_f32_16x16x32_bf16(a1, bq[hh][1], d, 0, 0, 0);
        const float w = hh == 0 ? iw.x : hh == 1 ? iw.y : hh == 2 ? iw.z : iw.w;
        sc.x = fmaf(w, fmaxf(d.x, 0.f), sc.x); sc.y = fmaf(w, fmaxf(d.y, 0.f), sc.y); sc.z = fmaf(w, fmaxf(d.z, 0.f), sc.z); sc.w = fmaf(w, fmaxf(d.w, 0.f), sc.w); }
      unsigned k01 = mono16x2(__builtin_bit_cast(unsigned, __builtin_amdgcn_cvt_pkrtz(sc.x, sc.y))), k23 = mono16x2(__builtin_bit_cast(unsigned, __builtin_amdgcn_cvt_pkrtz(sc.z, sc.w)));
      const int kbase = kt * 16 + fq * 4;
      unsigned* hq = h1 + fr * 128;
      if (kt + 1 < nkt) {
        *(u32x2*)(keys + fr * TK_KP + kbase) = (u32x2){k01, k23};
        { const unsigned kk = k01 & 0xffffu; atomicAdd(hq + (kk >> 9), 1u << ((kk >> 4) & 16)); }
        { const unsigned kk = k01 >> 16; atomicAdd(hq + (kk >> 9), 1u << ((kk >> 4) & 16)); }
        { const unsigned kk = k23 & 0xffffu; atomicAdd(hq + (kk >> 9), 1u << ((kk >> 4) & 16)); }
        { const unsigned kk = k23 >> 16; atomicAdd(hq + (kk >> 9), 1u << ((kk >> 4) & 16)); }
      } else {
        if (kbase + 0 > slim) k01 &= 0xffff0000u; if (kbase + 1 > slim) k01 &= 0x0000ffffu;
        if (kbase + 2 > slim) k23 &= 0xffff0000u; if (kbase + 3 > slim) k23 &= 0x0000ffffu;
        *(u32x2*)(keys + fr * TK_KP + kbase) = (u32x2){k01, k23};
        if (kbase + 0 <= slim) { const unsigned kk = k01 & 0xffffu; atomicAdd(hq + (kk >> 9), 1u << ((kk >> 4) & 16)); }
        if (kbase + 1 <= slim) { const unsigned kk = k01 >> 16; atomicAdd(hq + (kk >> 9), 1u << ((kk >> 4) & 16)); }
        if (kbase + 2 <= slim) { const unsigned kk = k23 & 0xffffu; atomicAdd(hq + (kk >> 9), 1u << ((kk >> 4) & 16)); }
        if (kbase + 3 <= slim) { const unsigned kk = k23 >> 16; atomicAdd(hq + (kk >> 9), 1u << ((kk >> 4) & 16)); }
      }
    }
    __syncthreads();
    for (int qi = 0; qi < 2; ++qi) {
      const int q = wave * 2 + qi, s = s0 + q, n = s + 1;
      int B1, above1; hist_find(h1 + q * 128, 256, lane, B1, above1);
      const int need1 = 256 - above1;
      h2[lane] = 0u; h2[64 + lane] = 0u;
      const unsigned short* kq = keys + q * TK_KP;
      const int niter = (n + 511) >> 9;
      for (int it = 0; it < niter; ++it) {
        const int i0 = (it * 64 + lane) * 8; const u32x4 kv = *(const u32x4*)(kq + i0);
        const unsigned k8[8] = {kv.x & 0xffffu, kv.x >> 16, kv.y & 0xffffu, kv.y >> 16, kv.z & 0xffffu, kv.z >> 16, kv.w & 0xffffu, kv.w >> 16};
#pragma unroll
        for (int e = 0; e < 8; ++e) if (i0 + e < n && (int)(k8[e] >> 8) == B1) atomicAdd(h2 + ((k8[e] & 255u) >> 1), 1u << ((k8[e] & 1u) * 16));
      }
      int B2, above2; hist_find(h2, need1, lane, B2, above2);
      const unsigned thr = (unsigned)((B1 << 8) | B2); const int need = need1 - above2;
      unsigned short* dummy = (unsigned short*)(misc + 8 + wave);
      unsigned short* sel = (unsigned short*)h2;
      asm volatile("s_waitcnt lgkmcnt(0)" ::: "memory");
      int tiebase = 0, outbase = 0;
      for (int it = 0; it < niter; ++it) {
        const int i0 = (it * 64 + lane) * 8; const u32x4 kv = *(const u32x4*)(kq + i0);
        const unsigned k8[8] = {kv.x & 0xffffu, kv.x >> 16, kv.y & 0xffffu, kv.y >> 16, kv.z & 0xffffu, kv.z >> 16, kv.w & 0xffffu, kv.w >> 16};
        int cg = 0, ce = 0;
#pragma unroll
        for (int e = 0; e < 8; ++e) { const bool v = i0 + e < n; cg += (v && k8[e] > thr) ? 1 : 0; ce += (v && k8[e] == thr) ? 1 : 0; }
        int tk = 0;
        if (__ballot(ce != 0)) {
          const int eincl = wave_incl_scan(ce); const int eg = tiebase + eincl - ce;
          tk = need - eg; tk = tk < 0 ? 0 : (tk > ce ? ce : tk);
          tiebase += __builtin_amdgcn_readlane(eincl, 63);
        }
        const int oc = cg + tk; const int oincl = wave_incl_scan(oc);
        int pos = outbase + oincl - oc; int tleft = tk;
#pragma unroll
        for (int e = 0; e < 8; ++e) { const bool v = i0 + e < n; const bool tie = v && k8[e] == thr && tleft > 0; const bool take = (v && k8[e] > thr) || tie;
          tleft -= tie ? 1 : 0;
          unsigned short* dst = (take && pos < 256) ? sel + pos : dummy;
          *dst = (unsigned short)(i0 + e); pos += take ? 1 : 0; }
        outbase += __builtin_amdgcn_readlane(oincl, 63);
      }
      asm volatile("s_waitcnt lgkmcnt(0)" ::: "memory");
      *(u32x2*)(SEL + ((size_t)b * SEQ + s) * 256 + lane * 4) = *(const u32x2*)(sel + lane * 4);
      asm volatile("s_waitcnt lgkmcnt(0)" ::: "memory");
    }
  }
}

typedef short s16x4 __attribute__((ext_vector_type(4)));
__device__ __forceinline__ s16x4 lds_tr16(const unsigned char* p) { return __builtin_bit_cast(s16x4, __builtin_amdgcn_ds_read_tr16_b64_v4i16((__attribute__((address_space(3))) s16x4*)(__attribute__((address_space(3))) unsigned char*)p)); }
typedef float f32x2_t __attribute__((ext_vector_type(2))); typedef __bf16 bf16x2_t __attribute__((ext_vector_type(2)));
__device__ __forceinline__ unsigned cvtpk_c(float lo, float hi) { const f32x2_t v = {lo, hi}; const bf16x2_t b = __builtin_convertvector(v, bf16x2_t); return __builtin_bit_cast(unsigned, b); }
__device__ __forceinline__ pg8::bf16x8 packp(const f32x4& a, const f32x4& b) {
  const u32x4 w = {cvtpk_c(a.x, a.y), cvtpk_c(a.z, a.w), cvtpk_c(b.x, b.y), cvtpk_c(b.z, b.w)}; return __builtin_bit_cast(pg8::bf16x8, w); }
constexpr int AT_WB = 9216 + 512;
__device__ void phase_attn_sparse(const Ctx& c, unsigned char* ldsb, unsigned* qhead) {
  unsigned char* ws = c.ws;
  const int tid = phase_tid(), lane = tid & 63, wave = tid >> 6, fr = lane & 15, fq = lane >> 4;
  unsigned char* vl = ldsb + wave * AT_WB; unsigned short* sl = (unsigned short*)(vl + 9216);
  const bf16_t* QA = (const bf16_t*)(ws + WS_QA); const bf16_t* KVA = (const bf16_t*)(ws + WS_KVA); const unsigned short* SEL = (const unsigned short*)(ws + WS_SEL);
  const bf16_t* QC = (const bf16_t*)(ws + WS_QC); const bf16_t* MK = (const bf16_t*)(ws + WS_MK); const bf16_t* MVT = (const bf16_t*)(ws + WS_MVT);
  bf16_t* CAT = (bf16_t*)(ws + WS_CAT);
  const float* gA = c.in[10]; const float* gC = c.in[11];
  const pg8::bf16x8 zero8 = {0, 0, 0, 0, 0, 0, 0, 0};
  __syncthreads();
  int* aq_slot = (int*)(ldsb + 8 * AT_WB);
  WorkQ wq; wq_init(wq, qhead, aq_slot, tid);
  for (;;) {
  const int item = wq_next(wq, tid);
  if (item >= 512) break;
  for (int tj = 0; tj < 8; ++tj) {
    const int t = item * 64 + wave * 8 + tj;
    const int b = t >> 12, s = t & (SEQ - 1), n = s + 1 < 256 ? s + 1 : 256;
    { u32x2 v;
      if (s >= 256) v = *(const u32x2*)(SEL + (size_t)t * 256 + lane * 4);
      else { const int i0 = lane * 4; const unsigned e0 = i0 < n ? i0 : 0, e1 = i0 + 1 < n ? i0 + 1 : 0, e2 = i0 + 2 < n ? i0 + 2 : 0, e3 = i0 + 3 < n ? i0 + 3 : 0; v = (u32x2){e0 | (e1 << 16), e2 | (e3 << 16)}; }
      *(u32x2*)(sl + lane * 4) = v; }
    asm volatile("s_waitcnt lgkmcnt(0)" ::: "memory");
    pg8::bf16x8 bq0 = zero8, bq1 = zero8;
    if (fr < 6) { const bf16_t* qp = QA + (size_t)t * 384 + fr * 64 + fq * 8; bq0 = *(const pg8::bf16x8*)qp; bq1 = *(const pg8::bf16x8*)(qp + 32); }
    const bf16_t* kvb = KVA + (size_t)b * SEQ * 128;
    f32x4 st[16];
#pragma unroll
    for (int kt = 0; kt < 16; ++kt) { const int key = sl[kt * 16 + fr]; const bf16_t* kr = kvb + (size_t)key * 128 + fq * 8;
      const pg8::bf16x8 a0 = *(const pg8::bf16x8*)kr, a1 = *(const pg8::bf16x8*)(kr + 32);
      f32x4 d = {0.f, 0.f, 0.f, 0.f};
      d = __builtin_amdgcn_mfma_f32_16x16x32_bf16(a0, bq0, d, 0, 0, 0); st[kt] = __builtin_amdgcn_mfma_f32_16x16x32_bf16(a1, bq1, d, 0, 0, 0); }
    u32x4 vva[8], vvb[8];
#pragma unroll
    for (int i = 0; i < 8; ++i) { const int key = sl[i * 8 + (lane >> 3)]; vva[i] = *(const u32x4*)(kvb + (size_t)key * 128 + 64 + (lane & 7) * 8); }
    float mx = -3.0e38f;
    if (n < 256) {
#pragma unroll
      for (int kt = 0; kt < 16; ++kt) { const int sb = kt * 16 + fq * 4;
        if (sb + 0 >= n) st[kt].x = -3.0e38f; if (sb + 1 >= n) st[kt].y = -3.0e38f; if (sb + 2 >= n) st[kt].z = -3.0e38f; if (sb + 3 >= n) st[kt].w = -3.0e38f; } }
#pragma unroll
    for (int kt = 0; kt < 16; ++kt) mx = fmaxf(fmaxf(fmaxf(mx, st[kt].x), fmaxf(st[kt].y, st[kt].z)), st[kt].w);
    mx = fmaxf(mx, __shfl_xor(mx, 16)); mx = fmaxf(mx, __shfl_xor(mx, 32));
    float l = 0.f;
#pragma unroll
    for (int kt = 0; kt < 16; ++kt) { st[kt].x = __builtin_amdgcn_exp2f(st[kt].x - mx); st[kt].y = __builtin_amdgcn_exp2f(st[kt].y - mx); st[kt].z = __builtin_amdgcn_exp2f(st[kt].z - mx); st[kt].w = __builtin_amdgcn_exp2f(st[kt].w - mx);
      l += (st[kt].x + st[kt].y) + (st[kt].z + st[kt].w); }
    l += __shfl_xor(l, 16); l += __shfl_xor(l, 32);
    f32x4 ot[4];
#pragma unroll
    for (int mt = 0; mt < 4; ++mt) ot[mt] = (f32x4){0.f, 0.f, 0.f, 0.f};
#define VLOAD(R, CH) do { _Pragma("unroll") for (int i_ = 0; i_ < 8; ++i_) { const int key_ = sl[(CH) * 64 + i_ * 8 + (lane >> 3)]; R[i_] = *(const u32x4*)(kvb + (size_t)key_ * 128 + 64 + (lane & 7) * 8); } } while (0)
#define VSTORE(R) do { _Pragma("unroll") for (int i_ = 0; i_ < 8; ++i_) *(u32x4*)(vl + (i_ * 8 + (lane >> 3)) * 144 + (lane & 7) * 16) = R[i_]; } while (0)
#define VPROC(CH) do { asm volatile("s_waitcnt lgkmcnt(0)" ::: "memory"); \
      _Pragma("unroll") for (int k2 = 0; k2 < 2; ++k2) { const int kk = (CH) * 2 + k2; const pg8::bf16x8 pf = pfr[kk]; \
        const unsigned char* base = vl + (k2 * 32 + fq * 4 + (fr >> 2)) * 144 + (fr & 3) * 8; \
        _Pragma("unroll") for (int mt = 0; mt < 4; ++mt) { const s16x4 lo = lds_tr16(base + mt * 32), hi = lds_tr16(base + 16 * 144 + mt * 32); \
          const pg8::bf16x8 af = {lo[0], lo[1], lo[2], lo[3], hi[0], hi[1], hi[2], hi[3]}; \
          ot[mt] = __builtin_amdgcn_mfma_f32_16x16x32_bf16(af, pf, ot[mt], 0, 0, 0); } } \
      asm volatile("s_waitcnt lgkmcnt(0)" ::: "memory"); } while (0)
    pg8::bf16x8 pfr[8];
#pragma unroll
    for (int kk = 0; kk < 8; ++kk) pfr[kk] = packp(st[2 * kk], st[2 * kk + 1]);
    asm volatile("" ::: "memory");
#pragma unroll
    for (int i = 0; i < 8; ++i) { const int key = sl[64 + i * 8 + (lane >> 3)]; vvb[i] = *(const u32x4*)(kvb + (size_t)key * 128 + 64 + (lane & 7) * 8); }
    VSTORE(vva); VLOAD(vva, 2); VPROC(0);
    VSTORE(vvb); VLOAD(vvb, 3); VPROC(1);
    VSTORE(vva); VPROC(2);
    VSTORE(vvb); VPROC(3);
#undef VLOAD
#undef VSTORE
#undef VPROC
    const float il = __builtin_amdgcn_rcpf(l); float ss = 0.f;
#pragma unroll
    for (int mt = 0; mt < 4; ++mt) { ot[mt] = ot[mt] * il; ss += (ot[mt].x * ot[mt].x + ot[mt].y * ot[mt].y) + (ot[mt].z * ot[mt].z + ot[mt].w * ot[mt].w); }
    if (fr >= 6) ss = 0.f;
#pragma unroll
    for (int o = 1; o < 64; o <<= 1) ss += __shfl_xor(ss, o);
    const float rstd = rsqrtf(ss * (1.f / 384.f) + 1e-6f);
    if (fr < 6) {
#pragma unroll
      for (int mt = 0; mt < 4; ++mt) { const int col = fr * 64 + mt * 16 + fq * 4; const f32x4 g = *(const f32x4*)(gA + col); const f32x4 o = ot[mt] * rstd * g;
        *(u32x2*)(CAT + (size_t)t * 1024 + col) = (u32x2){pg8::cvt_pk_bf16(o.x, o.y), pg8::cvt_pk_bf16(o.z, o.w)}; } }
  }
  }
}

__device__ void phase_attn_mem(const Ctx& c, unsigned char* ldsb, unsigned* qhead) {
  unsigned char* ws = c.ws;
  const int tid = phase_tid(), lane = tid & 63, wave = tid >> 6, fr = lane & 15, fq = lane >> 4;
  unsigned char* vl = ldsb + wave * AT_WB; unsigned short* sl = (unsigned short*)(vl + 9216);
  const bf16_t* QA = (const bf16_t*)(ws + WS_QA); const bf16_t* KVA = (const bf16_t*)(ws + WS_KVA); const unsigned short* SEL = (const unsigned short*)(ws + WS_SEL);
  const bf16_t* QC = (const bf16_t*)(ws + WS_QC); const bf16_t* MK = (const bf16_t*)(ws + WS_MK); const bf16_t* MVT = (const bf16_t*)(ws + WS_MVT);
  bf16_t* CAT = (bf16_t*)(ws + WS_CAT);
  const float* gA = c.in[10]; const float* gC = c.in[11];
  const pg8::bf16x8 zero8 = {0, 0, 0, 0, 0, 0, 0, 0};
  int* aq_slot = (int*)(ldsb + 70656 + 8 * 8192);
  WorkQ wq; wq_init(wq, qhead, aq_slot, tid);
  for (;;) {
  const int item = wq_next(wq, tid) + 512;
  if (item >= 768) break;
  {
    const int t0 = (item - 512) * 128 + wave * 16, b = t0 >> 12;
    unsigned char* mkl = ldsb; unsigned char* mvl = ldsb + 36864; unsigned char* ocl = ldsb + 70656 + wave * 8192;
    float ss = 0.f;
#pragma unroll 1
    for (int h = 0; h < 4; ++h) {
      __syncthreads();
#pragma unroll
      for (int i = 0; i < 4; ++i) { const int p = tid + 512 * i, row = p >> 3, cc = p & 7;
        *(u32x4*)(mkl + row * 144 + cc * 16) = *(const u32x4*)(MK + ((size_t)(b * 256 + row)) * 256 + h * 64 + cc * 8); }
#pragma unroll
      for (int i = 0; i < 4; ++i) { const int p = tid + 512 * i, row = p >> 5, cc = p & 31;
        *(u32x4*)(mvl + row * 528 + cc * 16) = *(const u32x4*)(MVT + ((size_t)(b * 256 + h * 64 + row)) * 256 + cc * 8); }
      __syncthreads();
      f32x4 oc[4];
      const bf16_t* qp = QC + (size_t)(t0 + fr) * 256 + h * 64 + fq * 8;
      const pg8::bf16x8 bq0 = *(const pg8::bf16x8*)qp, bq1 = *(const pg8::bf16x8*)(qp + 32);
      f32x4 st[16];
#pragma unroll
      for (int kt = 0; kt < 16; ++kt) { const unsigned char* kr = mkl + (kt * 16 + fr) * 144 + fq * 16;
        const pg8::bf16x8 a0 = *(const pg8::bf16x8*)kr, a1 = *(const pg8::bf16x8*)(kr + 64);
        f32x4 d = {0.f, 0.f, 0.f, 0.f};
        d = __builtin_amdgcn_mfma_f32_16x16x32_bf16(a0, bq0, d, 0, 0, 0); st[kt] = __builtin_amdgcn_mfma_f32_16x16x32_bf16(a1, bq1, d, 0, 0, 0); }
      float mx = -3.0e38f;
#pragma unroll
      for (int kt = 0; kt < 16; ++kt) mx = fmaxf(fmaxf(fmaxf(mx, st[kt].x), fmaxf(st[kt].y, st[kt].z)), st[kt].w);
      mx = fmaxf(mx, __shfl_xor(mx, 16)); mx = fmaxf(mx, __shfl_xor(mx, 32));
      float l = 0.f;
#pragma unroll
      for (int kt = 0; kt < 16; ++kt) { st[kt].x = __builtin_amdgcn_exp2f(st[kt].x - mx); st[kt].y = __builtin_amdgcn_exp2f(st[kt].y - mx); st[kt].z = __builtin_amdgcn_exp2f(st[kt].z - mx); st[kt].w = __builtin_amdgcn_exp2f(st[kt].w - mx);
        l += (st[kt].x + st[kt].y) + (st[kt].z + st[kt].w); }
      l += __shfl_xor(l, 16); l += __shfl_xor(l, 32);
#pragma unroll
      for (int mt = 0; mt < 4; ++mt) oc[mt] = (f32x4){0.f, 0.f, 0.f, 0.f};
#pragma unroll
      for (int kk = 0; kk < 8; ++kk) { const pg8::bf16x8 pf = packp(st[2 * kk], st[2 * kk + 1]);
#pragma unroll
        for (int mt = 0; mt < 4; ++mt) { const pg8::bf16x8 af = *(const pg8::bf16x8*)(mvl + (mt * 16 + fr) * 528 + (kk * 4 + fq) * 16);
          oc[mt] = __builtin_amdgcn_mfma_f32_16x16x32_bf16(af, pf, oc[mt], 0, 0, 0); } }
      const float il = __builtin_amdgcn_rcpf(l);
#pragma unroll
      for (int mt = 0; mt < 4; ++mt) { const f32x4 o = oc[mt] * il; ss += (o.x * o.x + o.y * o.y) + (o.z * o.z + o.w * o.w); *(u32x2*)(ocl + ((h * 4 + mt) * 64 + lane) * 8) = (u32x2){pg8::cvt_pk_bf16(o.x, o.y), pg8::cvt_pk_bf16(o.z, o.w)}; }
    }
    ss += __shfl_xor(ss, 16); ss += __shfl_xor(ss, 32);
    const float rstd = rsqrtf(ss * (1.f / 256.f) + 1e-6f);
#pragma unroll 1
    for (int h = 0; h < 4; ++h)
#pragma unroll
      for (int mt = 0; mt < 4; ++mt) { const int col = h * 64 + mt * 16 + fq * 4; const f32x4 g = *(const f32x4*)(gC + col); const u32x2 pp = *(const u32x2*)(ocl + ((h * 4 + mt) * 64 + lane) * 8);
        const f32x4 ov = {__uint_as_float(pp.x << 16), __uint_as_float(pp.x & 0xffff0000u), __uint_as_float(pp.y << 16), __uint_as_float(pp.y & 0xffff0000u)}; const f32x4 o = ov * rstd * g;
        *(u32x2*)(CAT + (size_t)(t0 + fr) * 1024 + 768 + col) = (u32x2){pg8::cvt_pk_bf16(o.x, o.y), pg8::cvt_pk_bf16(o.z, o.w)}; }
  }
  }
}

constexpr int GD_ITEM = 41088;
__device__ __forceinline__ unsigned char* gd_item(unsigned char* ws, int it) { return it < 1536 ? ws + WS_XB + (size_t)it * GD_ITEM : ws + WS_X1B + (size_t)(it - 1536) * GD_ITEM; }
__device__ __forceinline__ int kperm(int x) { return (x & 32) | (((x >> 2) & 3) << 3) | (x & 3) | (((x >> 4) & 1) << 2); }
constexpr int GP_KB = 0, GP_KBB = 9216, GP_QB = 18432, GP_VBT = 27648, GP_KBET = 36864, GP_XR = 46080  , GP_PR = 82944  , GP_OUT = 101376, GP_SC = 142336;
__device__ __forceinline__ pg8::bf16x8 ldsfrag(const unsigned char* base, int row, int ks, int fq) { return *(const pg8::bf16x8*)(base + row * 144 + ks * 64 + fq * 16); }
constexpr int G2_KB = 0, G2_KBB = 9216, G2_QB = 18432, G2_XR0 = 27648, G2_XT0 = 36864, G2_PR0 = 46080, G2_VBT = 55296, G2_KBET = 64512, G2_SC = 73728, G2_CW = 75264, G2_HALF = 78336;
__device__ void phase_gdn_prep2(const Ctx& c, unsigned char* Lb) {
  unsigned char* ws = c.ws;
  const int tid = phase_tid(), lane = tid & 63, wave = tid >> 6, fr = lane & 15, fq = lane >> 4;
  const int hb = wave >> 2, w4 = wave & 3, htid = tid & 255;
  unsigned char* L = Lb + hb * G2_HALF;
  const bf16_t* GB = (const bf16_t*)(ws + WS_GB); const float* SM = (const float*)(ws + WS_SM);
  const float* convw = c.in[6];
  float* sc = (float*)(L + G2_SC);
  float* cw = (float*)(L + G2_CW);
  const int tt = htid >> 2, part = htid & 3;
  for (int it2 = blockIdx.x; it2 < 1536; it2 += gridDim.x) {
    const int it = it2 * 2 + hb;
    const int n = it & 63, bh = it >> 6, b = bh / 6, h = bh % 6;
    const int t = n * 64 + tt; const size_t r = (size_t)b * SEQ + t;
    unsigned char* gb = gd_item(ws, it);
    __syncthreads();
    for (int i = htid; i < 768; i += 256) { const int j = i / 192, rr = i % 192; cw[i] = convw[j * 1152 + (rr >> 6) * 384 + h * 64 + (rr & 63)]; }
    if (part == 0) { const float a = SM[r * 16 + 4 + h], bb = SM[r * 16 + 10 + h]; const float xs = a + c.in[8][h]; const float sp = xs > 20.f ? xs : log1pf(__expf(xs));
      sc[tt] = -__expf(c.in[7][h]) * sp; sc[192 + tt] = 1.f / (1.f + __expf(-bb)); }
    __syncthreads();
    if (w4 == 0) { float v = sc[lane];
#pragma unroll
      for (int o = 1; o < 64; o <<= 1) { const float u = __shfl_up(v, o); if (lane >= o) v += u; }
      const float last = __shfl(v, 63);
      sc[64 + lane] = v; sc[128 + lane] = __expf(v); sc[256 + lane] = __expf(last - v); if (lane == 0) { sc[320] = __expf(last); *(float*)(gb + 40960) = __expf(last); } }
    float qv[16], kv[16], vv[16];
#pragma unroll
    for (int role = 0; role < 3; ++role) {
      float acc[16];
#pragma unroll
      for (int e = 0; e < 16; ++e) acc[e] = 0.f;
      u32x4 xr[4][2];
#pragma unroll
      for (int j = 0; j < 4; ++j) { const bool ok = t - 3 + j >= 0; const bf16_t* xp = GB + (r - 3 + j) * 1536 + role * 384 + h * 64 + part * 16;
        xr[j][0] = ok ? *(const u32x4*)xp : (u32x4){0u, 0u, 0u, 0u}; xr[j][1] = ok ? *(const u32x4*)(xp + 8) : (u32x4){0u, 0u, 0u, 0u}; }
#pragma unroll
      for (int j = 0; j < 4; ++j)
#pragma unroll
        for (int hh = 0; hh < 2; ++hh) { const u32x4 xvv = xr[j][hh]; const float* wj = cw + j * 192 + role * 64 + part * 16 + hh * 8;
          const f32x4 w0 = *(const f32x4*)wj, w1 = *(const f32x4*)(wj + 4);
          acc[hh * 8 + 0] += w0.x * __uint_as_float(xvv.x << 16); acc[hh * 8 + 1] += w0.y * __uint_as_float(xvv.x & 0xffff0000u); acc[hh * 8 + 2] += w0.z * __uint_as_float(xvv.y << 16); acc[hh * 8 + 3] += w0.w * __uint_as_float(xvv.y & 0xffff0000u);
          acc[hh * 8 + 4] += w1.x * __uint_as_float(xvv.z << 16); acc[hh * 8 + 5] += w1.y * __uint_as_float(xvv.z & 0xffff0000u); acc[hh * 8 + 6] += w1.z * __uint_as_float(xvv.w << 16); acc[hh * 8 + 7] += w1.w * __uint_as_float(xvv.w & 0xffff0000u); }
      float ss = 0.f;
#pragma unroll
      for (int e = 0; e < 16; ++e) { acc[e] = silu_f(acc[e]); ss += acc[e] * acc[e]; }
      if (role < 2) { ss += __shfl_xor(ss, 1); ss += __shfl_xor(ss, 2); const float scl = rsqrtf(ss + 1e-6f) * (role == 0 ? 0.125f : 1.f);
#pragma unroll
        for (int e = 0; e < 16; ++e) acc[e] *= scl; }
#pragma unroll
      for (int e = 0; e < 16; ++e) { if (role == 0) qv[e] = acc[e]; else if (role == 1) kv[e] = acc[e]; else vv[e] = acc[e]; }
    }
    __syncthreads();
    { const float beta = sc[192 + tt], eg = sc[128 + tt], ekl = sc[256 + tt];
      float kb[16];
#pragma unroll
      for (int e = 0; e < 16; ++e) kb[e] = kv[e] * beta;
#pragma unroll
      for (int hh = 0; hh < 2; ++hh) { const int o8 = hh * 8;
        *(u32x4*)(L + G2_KB + tt * 144 + part * 32 + hh * 16) = (u32x4){pk2(kv[o8], kv[o8 + 1]), pk2(kv[o8 + 2], kv[o8 + 3]), pk2(kv[o8 + 4], kv[o8 + 5]), pk2(kv[o8 + 6], kv[o8 + 7])};
        *(u32x4*)(L + G2_KBB + tt * 144 + part * 32 + hh * 16) = (u32x4){pk2(kb[o8], kb[o8 + 1]), pk2(kb[o8 + 2], kb[o8 + 3]), pk2(kb[o8 + 4], kb[o8 + 5]), pk2(kb[o8 + 6], kb[o8 + 7])};
        *(u32x4*)(L + G2_QB + tt * 144 + part * 32 + hh * 16) = (u32x4){pk2(qv[o8], qv[o8 + 1]), pk2(qv[o8 + 2], qv[o8 + 3]), pk2(qv[o8 + 4], qv[o8 + 5]), pk2(qv[o8 + 6], qv[o8 + 7])}; }
      const int ptt = kperm(tt);
#pragma unroll
      for (int e = 0; e < 16; ++e) { const int d = part * 16 + e;
        *(bf16_t*)(L + G2_VBT + d * 144 + tt * 2) = f2bf(vv[e] * beta);
        *(bf16_t*)(L + G2_KBET + d * 144 + tt * 2) = f2bf(kb[e] * eg);
        *(bf16_t*)(gb + 8192 + tt * 128 + kperm(d) * 2) = f2bf(qv[e] * eg);
        *(bf16_t*)(gb + 3 * 8192 + d * 128 + ptt * 2) = f2bf(kv[e] * ekl); } }
    __syncthreads();
    const int rowb = (w4 * 16 + fq * 4) * 144 + fr * 2;
    const int colb = fr * 144 + (w4 * 16 + fq * 4) * 2;
    const int fa = (w4 * 16 + fr) * 144 + fq * 16;
    const int fb = fr * 144 + fq * 16;
    const int i0 = w4 * 16 + fq * 4;
#define G2F(buf, off) (*(const pg8::bf16x8*)(L + (buf) + (off)))
#define G2W16(buf, off, v) (*(bf16_t*)(L + (buf) + (off)) = f2bf(v))
    f32x4 Pt[4];
    { const float gi0 = sc[64 + i0], gi1 = sc[64 + i0 + 1], gi2 = sc[64 + i0 + 2], gi3 = sc[64 + i0 + 3];
#pragma unroll
    for (int u = 0; u < 4; ++u) {
      f32x4 dl = {0.f, 0.f, 0.f, 0.f}, da = {0.f, 0.f, 0.f, 0.f};
#pragma unroll
      for (int ks = 0; ks < 2; ++ks) { const pg8::bf16x8 bk = G2F(G2_KB, fb + u * 2304 + ks * 64);
        dl = __builtin_amdgcn_mfma_f32_16x16x32_bf16(G2F(G2_KBB, fa + ks * 64), bk, dl, 0, 0, 0);
        da = __builtin_amdgcn_mfma_f32_16x16x32_bf16(G2F(G2_QB, fa + ks * 64), bk, da, 0, 0, 0); }
      const int j = u * 16 + fr; const float gj = sc[64 + j]; const int pj = kperm(j);
      const float dec0 = __expf(fminf(gi0 - gj, 0.f)), dec1 = __expf(fminf(gi1 - gj, 0.f)), dec2 = __expf(fminf(gi2 - gj, 0.f)), dec3 = __expf(fminf(gi3 - gj, 0.f));
      const float l0 = i0 + 0 > j ? dl.x * dec0 : 0.f, l1 = i0 + 1 > j ? dl.y * dec1 : 0.f, l2 = i0 + 2 > j ? dl.z * dec2 : 0.f, l3 = i0 + 3 > j ? dl.w * dec3 : 0.f;
      const float a0 = i0 + 0 >= j ? da.x * dec0 : 0.f, a1 = i0 + 1 >= j ? da.y * dec1 : 0.f, a2 = i0 + 2 >= j ? da.z * dec2 : 0.f, a3 = i0 + 3 >= j ? da.w * dec3 : 0.f;
      const f32x4 pv = {(i0 + 0 == j ? 1.f : 0.f) - l0, (i0 + 1 == j ? 1.f : 0.f) - l1, (i0 + 2 == j ? 1.f : 0.f) - l2, (i0 + 3 == j ? 1.f : 0.f) - l3};
      G2W16(G2_XR0, rowb + u * 32, l0); G2W16(G2_XR0, rowb + 144 + u * 32, l1); G2W16(G2_XR0, rowb + 288 + u * 32, l2); G2W16(G2_XR0, rowb + 432 + u * 32, l3);
      G2W16(G2_PR0, rowb + u * 32, pv.x); G2W16(G2_PR0, rowb + 144 + u * 32, pv.y); G2W16(G2_PR0, rowb + 288 + u * 32, pv.z); G2W16(G2_PR0, rowb + 432 + u * 32, pv.w);
      *(u32x2*)(L + G2_XT0 + colb + u * 2304) = (u32x2){pk2(l0, l1), pk2(l2, l3)};
      bf16_t* am = (bf16_t*)(gb + 2 * 8192 + i0 * 128 + pj * 2);
      am[0] = f2bf(a0); am[64] = f2bf(a1); am[128] = f2bf(a2); am[192] = f2bf(a3);
      Pt[u] = pv; } }
    __syncthreads();
#pragma unroll
    for (int u = 0; u < 4; ++u) {
      f32x4 d = {0.f, 0.f, 0.f, 0.f};
#pragma unroll
      for (int ks = 0; ks < 2; ++ks) d = __builtin_amdgcn_mfma_f32_16x16x32_bf16(G2F(G2_XR0, fa + ks * 64), G2F(G2_XT0, fb + u * 2304 + ks * 64), d, 0, 0, 0);
      G2W16(G2_KB, rowb + u * 32, d.x); G2W16(G2_KB, rowb + 144 + u * 32, d.y); G2W16(G2_KB, rowb + 288 + u * 32, d.z); G2W16(G2_KB, rowb + 432 + u * 32, d.w);
      *(u32x2*)(L + G2_KBB + colb + u * 2304) = (u32x2){pk2(d.x, d.y), pk2(d.z, d.w)}; }
    __syncthreads();
#pragma unroll
    for (int itn = 0; itn < 4; ++itn) {
      const int XRc = (itn & 1) ? G2_XR0 : G2_KB, XTc = (itn & 1) ? G2_XT0 : G2_KBB, XRn = (itn & 1) ? G2_KB : G2_XR0, XTn = (itn & 1) ? G2_KBB : G2_XT0;
      const int PRc = (itn & 1) ? G2_QB : G2_PR0, PRn = (itn & 1) ? G2_PR0 : G2_QB;
#pragma unroll
      for (int u = 0; u < 4; ++u) {
        f32x4 d = {0.f, 0.f, 0.f, 0.f};
#pragma unroll
        for (int ks = 0; ks < 2; ++ks) { const pg8::bf16x8 bx = G2F(XTc, fb + u * 2304 + ks * 64);
          Pt[u] = __builtin_amdgcn_mfma_f32_16x16x32_bf16(G2F(PRc, fa + ks * 64), bx, Pt[u], 0, 0, 0);
          if (itn < 3) d = __builtin_amdgcn_mfma_f32_16x16x32_bf16(G2F(XRc, fa + ks * 64), bx, d, 0, 0, 0); }
        G2W16(PRn, rowb + u * 32, Pt[u].x); G2W16(PRn, rowb + 144 + u * 32, Pt[u].y); G2W16(PRn, rowb + 288 + u * 32, Pt[u].z); G2W16(PRn, rowb + 432 + u * 32, Pt[u].w);
        if (itn < 3) { G2W16(XRn, rowb + u * 32, d.x); G2W16(XRn, rowb + 144 + u * 32, d.y); G2W16(XRn, rowb + 288 + u * 32, d.z); G2W16(XRn, rowb + 432 + u * 32, d.w);
          *(u32x2*)(L + XTn + colb + u * 2304) = (u32x2){pk2(d.x, d.y), pk2(d.z, d.w)}; } }
      __syncthreads();
    }
#pragma unroll
    for (int u = 0; u < 4; ++u) {
      f32x4 du = {0.f, 0.f, 0.f, 0.f}, dw = {0.f, 0.f, 0.f, 0.f};
#pragma unroll
      for (int ks = 0; ks < 2; ++ks) { const pg8::bf16x8 a = G2F(G2_PR0, fa + ks * 64);
        du = __builtin_amdgcn_mfma_f32_16x16x32_bf16(a, G2F(G2_VBT, fb + u * 2304 + ks * 64), du, 0, 0, 0);
        dw = __builtin_amdgcn_mfma_f32_16x16x32_bf16(a, G2F(G2_KBET, fb + u * 2304 + ks * 64), dw, 0, 0, 0); }
      const int j = u * 16 + fr, pj = kperm(j);
      *(u32x2*)(gb + 4 * 8192 + j * 128 + i0 * 2) = (u32x2){pk2(du.x, du.y), pk2(du.z, du.w)};
      bf16_t* wn = (bf16_t*)(gb + i0 * 128 + pj * 2);
      wn[0] = f2bf(-dw.x); wn[64] = f2bf(-dw.y); wn[128] = f2bf(-dw.z); wn[192] = f2bf(-dw.w); }
#undef G2F
#undef G2W16
  }
}

constexpr int GS_SLOT = 46208, GS_OB = 2 * GS_SLOT;
__device__ void phase_gdn_scan(const Ctx& c, unsigned char* L, int item) {
  unsigned char* ws = c.ws;
  const int tid = phase_tid(), lane = tid & 63, wave = tid >> 6, fr = lane & 15, fq = lane >> 4;
  const int b = item / 6, h = item % 6;
  const bf16_t* GB = (const bf16_t*)(ws + WS_GB); bf16_t* CAT = (bf16_t*)(ws + WS_CAT); const float* gng = c.in[9];
  const int lt = tid - 256;
  u32x4 ra[10]; float gla = 0.f;
  f32x4 S[4];
#pragma unroll
  for (int i = 0; i < 4; ++i) S[i] = (f32x4){0.f, 0.f, 0.f, 0.f};
#define GS_LOAD(R, G, n) do { if ((n) < 64) { const unsigned char* gb_ = gd_item(ws, item * 64 + (n)); _Pragma("unroll") for (int i_ = 0; i_ < 10; ++i_) R[i_] = *(const u32x4*)(gb_ + (size_t)(lt + 256 * i_) * 16); if (lt == 0) G = *(const float*)(gb_ + 40960); } } while (0)
#define GS_STORE(R, G, slot) do { _Pragma("unroll") for (int i_ = 0; i_ < 10; ++i_) { const int p_ = lt + 256 * i_; *(u32x4*)(L + (slot) * GS_SLOT + (p_ >> 9) * 9216 + ((p_ >> 3) & 63) * 144 + (p_ & 7) * 16) = R[i_]; } if (lt == 0) *(float*)(L + (slot) * GS_SLOT + 46080) = G; } while (0)
  auto post = [&](int k) {
    const unsigned char* ob = L + GS_OB + (k & 1) * 9216; const int tk = lt >> 2, part = lt & 3; const size_t r = (size_t)b * SEQ + k * 64 + tk;
    const u32x4 o0 = *(const u32x4*)(ob + tk * 144 + part * 32), o1 = *(const u32x4*)(ob + tk * 144 + part * 32 + 16);
    float ov[16] = {__uint_as_float(o0.x << 16), __uint_as_float(o0.x & 0xffff0000u), __uint_as_float(o0.y << 16), __uint_as_float(o0.y & 0xffff0000u), __uint_as_float(o0.z << 16), __uint_as_float(o0.z & 0xffff0000u), __uint_as_float(o0.w << 16), __uint_as_float(o0.w & 0xffff0000u),
                    __uint_as_float(o1.x << 16), __uint_as_float(o1.x & 0xffff0000u), __uint_as_float(o1.y << 16), __uint_as_float(o1.y & 0xffff0000u), __uint_as_float(o1.z << 16), __uint_as_float(o1.z & 0xffff0000u), __uint_as_float(o1.w << 16), __uint_as_float(o1.w & 0xffff0000u)};
    float ss = 0.f;
#pragma unroll
    for (int e = 0; e < 16; ++e) ss += ov[e] * ov[e];
    ss += __shfl_xor(ss, 1); ss += __shfl_xor(ss, 2);
    const float rstd = rsqrtf(ss * (1.f / 64.f) + 1e-6f);
    const u32x4 z0 = *(const u32x4*)(GB + r * 1536 + 1152 + h * 64 + part * 16), z1 = *(const u32x4*)(GB + r * 1536 + 1152 + h * 64 + part * 16 + 8);
    const float zf[16] = {__uint_as_float(z0.x << 16), __uint_as_float(z0.x & 0xffff0000u), __uint_as_float(z0.y << 16), __uint_as_float(z0.y & 0xffff0000u), __uint_as_float(z0.z << 16), __uint_as_float(z0.z & 0xffff0000u), __uint_as_float(z0.w << 16), __uint_as_float(z0.w & 0xffff0000u),
                          __uint_as_float(z1.x << 16), __uint_as_float(z1.x & 0xffff0000u), __uint_as_float(z1.y << 16), __uint_as_float(z1.y & 0xffff0000u), __uint_as_float(z1.z << 16), __uint_as_float(z1.z & 0xffff0000u), __uint_as_float(z1.w << 16), __uint_as_float(z1.w & 0xffff0000u)};
#pragma unroll
    for (int e = 0; e < 16; ++e) ov[e] = ov[e] * rstd * gng[part * 16 + e] * silu_f(zf[e]);
    bf16_t* op = CAT + r * 1024 + 384 + h * 64 + part * 16;
    *(u32x4*)op = (u32x4){pk2(ov[0], ov[1]), pk2(ov[2], ov[3]), pk2(ov[4], ov[5]), pk2(ov[6], ov[7])};
    *(u32x4*)(op + 8) = (u32x4){pk2(ov[8], ov[9]), pk2(ov[10], ov[11]), pk2(ov[12], ov[13]), pk2(ov[14], ov[15])};
  };
  auto step = [&](int k) {
    const unsigned char* sb = L + (k & 1) * GS_SLOT; const float gl = *(const float*)(sb + 46080);
    const pg8::bf16x8 Sb0 = packp(S[0], S[1]), Sb1 = packp(S[2], S[3]);
    f32x4 vn[4], o[4];
#pragma unroll
    for (int mt = 0; mt < 4; ++mt) { const u32x2 uv = *(const u32x2*)(sb + 4 * 9216 + (wave * 16 + fr) * 144 + (mt * 16 + fq * 4) * 2);
      f32x4 a = {__uint_as_float(uv.x << 16), __uint_as_float(uv.x & 0xffff0000u), __uint_as_float(uv.y << 16), __uint_as_float(uv.y & 0xffff0000u)};
      a = __builtin_amdgcn_mfma_f32_16x16x32_bf16(ldsfrag(sb, mt * 16 + fr, 0, fq), Sb0, a, 0, 0, 0);
      vn[mt] = __builtin_amdgcn_mfma_f32_16x16x32_bf16(ldsfrag(sb, mt * 16 + fr, 1, fq), Sb1, a, 0, 0, 0);
      f32x4 q = {0.f, 0.f, 0.f, 0.f};
      q = __builtin_amdgcn_mfma_f32_16x16x32_bf16(ldsfrag(sb + 9216, mt * 16 + fr, 0, fq), Sb0, q, 0, 0, 0);
      o[mt] = __builtin_amdgcn_mfma_f32_16x16x32_bf16(ldsfrag(sb + 9216, mt * 16 + fr, 1, fq), Sb1, q, 0, 0, 0); }
    const pg8::bf16x8 Vb0 = packp(vn[0], vn[1]), Vb1 = packp(vn[2], vn[3]);
#pragma unroll
    for (int mt = 0; mt < 4; ++mt) { o[mt] = __builtin_amdgcn_mfma_f32_16x16x32_bf16(ldsfrag(sb + 2 * 9216, mt * 16 + fr, 0, fq), Vb0, o[mt], 0, 0, 0);
      o[mt] = __builtin_amdgcn_mfma_f32_16x16x32_bf16(ldsfrag(sb + 2 * 9216, mt * 16 + fr, 1, fq), Vb1, o[mt], 0, 0, 0); }
#pragma unroll
    for (int kt = 0; kt < 4; ++kt) { f32x4 sv = S[kt] * gl;
      sv = __builtin_amdgcn_mfma_f32_16x16x32_bf16(ldsfrag(sb + 3 * 9216, kt * 16 + fr, 0, fq), Vb0, sv, 0, 0, 0);
      S[kt] = __builtin_amdgcn_mfma_f32_16x16x32_bf16(ldsfrag(sb + 3 * 9216, kt * 16 + fr, 1, fq), Vb1, sv, 0, 0, 0); }
    unsigned char* ob = L + GS_OB + (k & 1) * 9216 + (wave * 16 + fr) * 2;
#pragma unroll
    for (int mt = 0; mt < 4; ++mt) { const int t0 = mt * 16 + fq * 4;
      *(bf16_t*)(ob + (t0 + 0) * 144) = f2bf(o[mt].x); *(bf16_t*)(ob + (t0 + 1) * 144) = f2bf(o[mt].y); *(bf16_t*)(ob + (t0 + 2) * 144) = f2bf(o[mt].z); *(bf16_t*)(ob + (t0 + 3) * 144) = f2bf(o[mt].w); }
  };
  __syncthreads();
  if (wave >= 4) { GS_LOAD(ra, gla, 0); GS_STORE(ra, gla, 0); GS_LOAD(ra, gla, 1); }
  __syncthreads();
#pragma unroll 1
  for (int k = 0; k < 64; ++k) {
    if (wave < 4) step(k); else { if (k + 1 < 64) GS_STORE(ra, gla, (k + 1) & 1); GS_LOAD(ra, gla, k + 2); if (k > 0) post(k - 1); }
    __syncthreads();
  }
  if (wave >= 4) post(63);
#undef GS_LOAD
#undef GS_STORE
}

__device__ __forceinline__ f32x4 bf4(u32x2 p) { return (f32x4){__uint_as_float(p.x << 16), __uint_as_float(p.x & 0xffff0000u), __uint_as_float(p.y << 16), __uint_as_float(p.y & 0xffff0000u)}; }
__device__ void phase_router(const Ctx& c, unsigned char* ldsb) {
  unsigned char* ws = c.ws;
  const int tid = phase_tid(), lane = tid & 63, wave = tid >> 6, fr = lane & 15, fq = lane >> 4;
  float* lg = (float*)(ldsb + wave * 5632);
  const float* bg = c.in[17]; const float* br = c.in[19]; const float* g1 = c.in[14]; const float* b1 = c.in[15];
  const bf16_t* WR = (const bf16_t*)(ws + WS_WR); bf16_t* X1B = (bf16_t*)(ws + WS_X1B);
  unsigned* ctl = (unsigned*)(ws + WS_CTL);
  unsigned* LIST = (unsigned*)(ws + WS_LIST); float* GATEL = (float*)(ws + WS_GATEL); unsigned* TSLOT = (unsigned*)(ws + WS_TSLOT);
  unsigned* cntl = (unsigned*)(ldsb + 46080); unsigned* basel = cntl + 64;
  __syncthreads();
  if (tid < 64) cntl[tid] = 0u;
  __syncthreads();
  for (int tile = blockIdx.x * NWAVES + wave; tile < T / 16; tile += gridDim.x * NWAVES) {
    const int t0 = tile * 16;
    float mean_t = 0.f, rstd_t = 0.f;
#pragma unroll 2
    for (int i = 0; i < 16; ++i) { const u32x2* row = (const u32x2*)(X1B + (size_t)(t0 + i) * 1024);
      f32x4 v[4]; float sm = 0.f;
#pragma unroll
      for (int j = 0; j < 4; ++j) { v[j] = bf4(row[lane + 64 * j]); sm += (v[j].x + v[j].y) + (v[j].z + v[j].w); }
      const float mean = wave_sum(sm) * (1.f / 1024.f); float s2 = 0.f;
#pragma unroll
      for (int j = 0; j < 4; ++j) { v[j] = v[j] - mean; s2 += (v[j].x * v[j].x + v[j].y * v[j].y) + (v[j].z * v[j].z + v[j].w * v[j].w); }
      const float rstd = rsqrtf(wave_sum(s2) * (1.f / 1024.f) + 1e-5f);
      if (fr == i) { mean_t = mean; rstd_t = rstd; } }
    f32x4 acc[5];
#pragma unroll
    for (int nt = 0; nt < 5; ++nt) acc[nt] = (f32x4){0.f, 0.f, 0.f, 0.f};
    bf16_t* xp = X1B + (size_t)(t0 + fr) * 1024 + fq * 8;
#pragma unroll 2
    for (int ks = 0; ks < 32; ++ks) {
      const u32x4 yv = *(const u32x4*)(xp + ks * 32);
      const f32x4 ga = *(const f32x4*)(g1 + ks * 32 + fq * 8), gb2 = *(const f32x4*)(g1 + ks * 32 + fq * 8 + 4), ba = *(const f32x4*)(b1 + ks * 32 + fq * 8), bb2 = *(const f32x4*)(b1 + ks * 32 + fq * 8 + 4);
      const f32x4 y0 = {__uint_as_float(yv.x << 16), __uint_as_float(yv.x & 0xffff0000u), __uint_as_float(yv.y << 16), __uint_as_float(yv.y & 0xffff0000u)};
      const f32x4 y1 = {__uint_as_float(yv.z << 16), __uint_as_float(yv.z & 0xffff0000u), __uint_as_float(yv.w << 16), __uint_as_float(yv.w & 0xffff0000u)};
      const f32x4 n0 = (y0 - mean_t) * rstd_t * ga + ba, n1 = (y1 - mean_t) * rstd_t * gb2 + bb2;
      const u32x4 xw = {cvtpk_c(n0.x, n0.y), cvtpk_c(n0.z, n0.w), cvtpk_c(n1.x, n1.y), cvtpk_c(n1.z, n1.w)};
      *(u32x4*)(xp + ks * 32) = xw;
      const pg8::bf16x8 bx = __builtin_bit_cast(pg8::bf16x8, xw);
#pragma unroll
      for (int nt = 0; nt < 5; ++nt) acc[nt] = __builtin_amdgcn_mfma_f32_16x16x32_bf16(*(const pg8::bf16x8*)(WR + (size_t)(nt * 16 + fr) * 1024 + ks * 32 + fq * 8), bx, acc[nt], 0, 0, 0); }
#pragma unroll
    for (int nt = 0; nt < 5; ++nt) { const int o = nt * 16 + fq * 4; *(f32x4*)(lg + fr * 88 + o) = acc[nt]; }
    asm volatile("s_waitcnt lgkmcnt(0)" ::: "memory");
    int ex1 = 0, ex2 = 0; float gt1 = 0.f, gt2 = 0.f; unsigned lr1 = 0u, lr2 = 0u;
    if (lane < 16) {
      const float* l = lg + lane * 88;
      int grp = 0; float gm = l[0] + bg[0];
      for (int i = 1; i < 8; ++i) { const float v = l[i] + bg[i]; if (v > gm) { gm = v; grp = i; } }
      float gs = 0.f; for (int i = 0; i < 8; ++i) gs += __expf(l[i] + bg[i] - gm);
      const float pgrp = 1.f / gs;
      const float* el = l + 8 + grp * 8; const float* eb = br + grp * 8;
      int i1 = 0; float m1 = el[0] + eb[0]; for (int i = 1; i < 8; ++i) { const float v = el[i] + eb[i]; if (v > m1) { m1 = v; i1 = i; } }
      int i2 = -1; float m2 = -3.0e38f; for (int i = 0; i < 8; ++i) { const float v = el[i] + eb[i]; if (i != i1 && v > m2) { m2 = v; i2 = i; } }
      const float e2 = __expf(m2 - m1), den = 1.f / (1.f + e2);
      gt1 = pgrp * den; gt2 = pgrp * e2 * den;
      ex1 = grp * 8 + i1; ex2 = grp * 8 + i2;
      lr1 = atomicAdd(&cntl[ex1], 1u); lr2 = atomicAdd(&cntl[ex2], 1u);
    }
    __syncthreads();
    if (wave == 0) { const unsigned nloc = cntl[lane]; basel[lane] = nloc ? atomicAdd(&ctl[CW_CNT + lane], nloc) : 0u; }
    __syncthreads();
    if (lane < 16) {
      const int t = t0 + lane; const unsigned r1 = basel[ex1] + lr1, r2 = basel[ex2] + lr2;
      LIST[(size_t)ex1 * 32768 + r1] = (unsigned)t; GATEL[(size_t)ex1 * 32768 + r1] = gt1;
      LIST[(size_t)ex2 * 32768 + r2] = (unsigned)t; GATEL[(size_t)ex2 * 32768 + r2] = gt2;
      TSLOT[(size_t)t * 2 + 0] = ((unsigned)ex1 << 16) | r1; TSLOT[(size_t)t * 2 + 1] = ((unsigned)ex2 << 16) | r2;
    }
    __syncthreads();
    if (tid < 64) cntl[tid] = 0u;
    __syncthreads();
  }
}

__device__ void phase_combine(const Ctx& c, float* lds) {
  unsigned char* ws = c.ws;
  const int tid = phase_tid(), lane = tid & 63, wave = tid >> 6;
  int* offs = (int*)lds; int* cnts = offs + 65;
  expert_offsets(c, offs, cnts, tid);
  const unsigned char* Y = (const unsigned char*)(ws + WS_Y); const unsigned* TSLOT = (const unsigned*)(ws + WS_TSLOT);
  const float* g2 = c.in[23]; const float* b2 = c.in[24];
  for (int t = blockIdx.x * NWAVES + wave; t < T; t += gridDim.x * NWAVES) {
    const unsigned s0 = TSLOT[(size_t)t * 2], s1 = TSLOT[(size_t)t * 2 + 1];
    const size_t r0 = (size_t)offs[s0 >> 16] + (s0 & 0xffffu), r1 = (size_t)offs[s1 >> 16] + (s1 & 0xffffu);
    f32x4* row = (f32x4*)(c.out + (size_t)t * 1024); const u32x2* xrow = (const u32x2*)((const bf16_t*)(ws + WS_X1B) + (size_t)t * 1024);
    f32x4 v[4]; float s = 0.f;
#pragma unroll
    for (int j = 0; j < 4; ++j) { const unsigned ya = ((const unsigned*)(Y + r0 * 1024))[lane + 64 * j], yb = ((const unsigned*)(Y + r1 * 1024))[lane + 64 * j];
      f32x4 x = bf4(xrow[lane + 64 * j]) * ALPHA;
      const hw_f32x2 a01 = __builtin_amdgcn_cvt_pk_f32_fp8(ya, false), a23 = __builtin_amdgcn_cvt_pk_f32_fp8(ya, true), b01 = __builtin_amdgcn_cvt_pk_f32_fp8(yb, false), b23 = __builtin_amdgcn_cvt_pk_f32_fp8(yb, true);
      x.x += (a01.x + b01.x) * 0.015625f; x.y += (a01.y + b01.y) * 0.015625f; x.z += (a23.x + b23.x) * 0.015625f; x.w += (a23.y + b23.y) * 0.015625f;
      v[j] = x; s += (x.x + x.y) + (x.z + x.w); }
    const float mean = wave_sum(s) * (1.f / 1024.f); float s2 = 0.f;
#pragma unroll
    for (int j = 0; j < 4; ++j) { v[j] = v[j] - mean; s2 += (v[j].x * v[j].x + v[j].y * v[j].y) + (v[j].z * v[j].z + v[j].w * v[j].w); }
    const float rstd = rsqrtf(wave_sum(s2) * (1.f / 1024.f) + 1e-5f);
#pragma unroll
    for (int j = 0; j < 4; ++j) { const f32x4 g = ((const f32x4*)g2)[lane + 64 * j], bb = ((const f32x4*)b2)[lane + 64 * j]; row[lane + 64 * j] = v[j] * rstd * g + bb; }
  }
}

constexpr int NPHASE = 11;
__global__ void __launch_bounds__(NTHREADS, 2) mega(Ctx c) {
  float* lds = (float*)lds_raw;
  unsigned* ctl = (unsigned*)(c.ws + WS_CTL);
  unsigned* bar = ctl + CW_BAR;
  if (threadIdx.x == 0) { *(volatile unsigned*)(lds_raw + LDS_WCTR) = 0u; *(volatile unsigned*)(lds_raw + LDS_XBST) = 0u; *(volatile unsigned*)(lds_raw + LDS_XBST + 4) = 0u;
    (void)xb_add(&bar[XB_XCNT(xb_xcc_id())], 1u); }
  __syncthreads();
  phase_prologue(c, lds);
  xcd_barrier(bar);
  phase_inproj_mfma(c, (lds_u8*)lds_raw);
  xcd_barrier(bar);
  phase_gdn_prep2(c, lds_raw);
  phase_kvup(c, lds);
  phase_topk_mfma(c, lds_raw, ctl + CW_Q);
  xcd_barrier(bar);
  if (blockIdx.x < 48) phase_gdn_scan(c, lds_raw, blockIdx.x);
  phase_attn_sparse(c, lds_raw, ctl + CW_Q + 16);
  phase_attn_mem(c, lds_raw, ctl + CW_Q + 32);
  xcd_barrier(bar);
  phase_outproj_mfma(c, (lds_u8*)lds_raw);
  xcd_barrier(bar);
  phase_router(c, lds_raw);
  xcd_barrier(bar);
  phase_moe_up_mfma(c, (lds_u8*)lds_raw);
  xcd_barrier(bar);
  phase_moe_down_mfma(c, (lds_u8*)lds_raw);
  xcd_barrier(bar);
  phase_combine(c, lds);
}

extern "C" void kernel_launch(void* const* d_in, const int* in_sizes, int n_in, void* d_out, int out_size, void* d_ws, size_t ws_size, hipStream_t stream) {
  static int grid = 0;
  if (grid == 0) {
    if (n_in != 25 || ws_size < WS_END) { fprintf(stderr, "kernel_launch: unexpected n_in %d / ws %zu\n", n_in, ws_size); grid = -1; return; }
    int dev = 0, cus = 0, per_cu = 0;
    hipGetDevice(&dev); hipDeviceGetAttribute(&cus, hipDeviceAttributeMultiprocessorCount, dev);
    hipFuncSetAttribute((const void*)mega, hipFuncAttributeMaxDynamicSharedMemorySize, LDS_BYTES);
    hipOccupancyMaxActiveBlocksPerMultiprocessor(&per_cu, (const void*)mega, NTHREADS, LDS_BYTES);
    if (per_cu < 1) { fprintf(stderr, "kernel_launch: occupancy query says %d blocks/CU\n", per_cu); per_cu = 1; }
    grid = cus * (per_cu < 1 ? 1 : 1);
    (void)hipGetLastError();
  }
  if (grid < 0) return;
  hipMemsetAsync((char*)d_ws + WS_CTL, 0, 32 * 1024, stream);
  Ctx c; memset(&c, 0, sizeof(c));
  for (int i = 0; i < 25; ++i) c.in[i] = (const float*)d_in[i];
  c.out = (float*)d_out; c.ws = (unsigned char*)d_ws;
  hipLaunchKernelGGL(mega, dim3(grid), dim3(NTHREADS), LDS_BYTES, stream, c);
}
```

```cpp
#include <hip/hip_runtime.h>
#include <cstdio>
#include <cstdint>
#include <cstring>

#ifndef ONE_LAUNCH
#define ONE_LAUNCH 1
#endif

typedef unsigned short bf16_t;
typedef float f32x4 __attribute__((ext_vector_type(4)));
typedef unsigned u32x4 __attribute__((ext_vector_type(4)));
typedef unsigned u32x2 __attribute__((ext_vector_type(2)));

constexpr int T = 32768, DM = 1024, SEQ = 4096, NBATCH = 8;
constexpr int NIN = 2816;
constexpr int NMEM = 256, TM = NBATCH * NMEM;
constexpr int NEXP = 64, DE = 256;
constexpr int NTHREADS = 512, NWAVES = 8;
constexpr float ALPHA = 1.189207115002721f;
constexpr float LOG2E = 1.4426950408889634f;
constexpr float QSCALE = 0.125f * LOG2E;

constexpr size_t MiB = 1ull << 20;
constexpr size_t WS_CTL = 0;
constexpr size_t WS_TSLOT = 512 * 1024;
constexpr size_t WS_ROPE = 1 * MiB;
constexpr size_t WS_WKV = 2 * MiB;
constexpr size_t WS_WR = 2 * MiB + 65536;
constexpr size_t WS_WIN = 3 * MiB;
constexpr size_t WS_WO = 9 * MiB;
constexpr size_t WS_WMKV = 11 * MiB;
constexpr size_t WS_MEMB = 12 * MiB;
constexpr size_t WS_WGU = 16 * MiB;
constexpr size_t WS_WD = 80 * MiB;
constexpr size_t WS_XB = 112 * MiB;
constexpr size_t WS_QA = 176 * MiB;
constexpr size_t WS_CKV = 200 * MiB;
constexpr size_t WS_IQ = 208 * MiB;
constexpr size_t WS_IK = 224 * MiB;
constexpr size_t WS_SM = 228 * MiB;
constexpr size_t WS_QC = 230 * MiB;
constexpr size_t WS_GB = 246 * MiB;
constexpr size_t WS_MK = 342 * MiB;
constexpr size_t WS_MVT = 343 * MiB;
constexpr size_t WS_KVA = 344 * MiB;
constexpr size_t WS_SEL = 352 * MiB;
constexpr size_t WS_CAT = 368 * MiB;
constexpr size_t WS_X1B = 432 * MiB;
constexpr size_t WS_LIST = 496 * MiB;
constexpr size_t WS_GATEL = 504 * MiB;
constexpr size_t WS_END = 512 * MiB;
constexpr size_t WS_H = 112 * MiB;
constexpr size_t WS_Y = 160 * MiB;

constexpr int CW_CNT = 0;
constexpr int CW_Q = 64;
constexpr int CW_BAR = 4096;

struct Ctx {
  const float* in[25];
  float* out;
  unsigned char* ws;
  int ph_lo, ph_hi;
};


extern __shared__ __attribute__((aligned(16))) unsigned char lds_raw[];
constexpr int LDS_BYTES = 157696;
constexpr int LDS_WCTR = LDS_BYTES - 64;
__device__ __forceinline__ int phase_tid() {
  __syncthreads();
  int l; asm volatile("v_mbcnt_lo_u32_b32 %0, -1, 0\n\tv_mbcnt_hi_u32_b32 %0, -1, %0" : "=v"(l));
  unsigned w = 0u;
  if (l == 0) w = __hip_atomic_fetch_add((__attribute__((address_space(3))) unsigned*)(__attribute__((address_space(3))) unsigned char*)(lds_raw + LDS_WCTR), 1u, __ATOMIC_RELAXED, __HIP_MEMORY_SCOPE_WORKGROUP);
  w = (unsigned)__builtin_amdgcn_readfirstlane((int)w) & 7u;
  return (int)(w * 64u) + l;
}


#define XB_TMO      128
#define XB_XCNT(j)  (256  + 64 * (j))
#define XB_XSUB(j)  (1280 + 64 * (j))
#define XB_XGEN(j)  (2304 + 64 * (j))
#define XB_TOP      3328
#define XB_TOPGEN   3392
#define XCD_BAR_WORDS 3456
#define XB_SPIN_CAP (1u << 18)
constexpr int LDS_XBST = LDS_BYTES - 32;
__device__ __forceinline__ unsigned xb_ld(unsigned* p)              { return __hip_atomic_load(p, __ATOMIC_RELAXED, __HIP_MEMORY_SCOPE_AGENT); }
__device__ __forceinline__ unsigned xb_add(unsigned* p, unsigned v) { return __hip_atomic_fetch_add(p, v, __ATOMIC_RELAXED, __HIP_MEMORY_SCOPE_AGENT); }
__device__ __forceinline__ unsigned xb_xcc_id() { return (unsigned)__builtin_amdgcn_s_getreg((3 << 11) | 20) & 0xFu; }
#define XB_SPIN(cond, bar) do { unsigned _sp = 0; while (cond) { __builtin_amdgcn_s_sleep(1); \
    if ((++_sp & 255u) == 0u) { if (xb_ld(&(bar)[XB_TMO])) break; if (_sp > XB_SPIN_CAP) { atomicAdd(&(bar)[XB_TMO], 1u); break; } } } } while (0)
__device__ __forceinline__ void xcd_barrier_complete(unsigned* bar, unsigned x, unsigned& nloc, unsigned& nx) {
    const unsigned G = gridDim.x;
    unsigned sum, cnt, mine, sp = 0u;
    for (;;) {
        sum = 0u; cnt = 0u; mine = 0u;
#pragma unroll
        for (unsigned j = 0; j < 16; ++j) { const unsigned cc = xb_ld(&bar[XB_XCNT(j)]); sum += cc; cnt += (cc > 0u) ? 1u : 0u; mine = (j == x) ? cc : mine; }
        if (sum == G) break;
        __builtin_amdgcn_s_sleep(1);
        if ((++sp & 255u) == 0u) { if (xb_ld(&bar[XB_TMO])) break; if (sp > XB_SPIN_CAP) { atomicAdd(&bar[XB_TMO], 1u); break; } }
    }
    nloc = mine > 0u ? mine : 1u; nx = cnt > 0u ? cnt : 1u;
}
__device__ __forceinline__ void xcd_barrier(unsigned* bar) {
    asm volatile("s_waitcnt vmcnt(0)" ::: "memory");
    __syncthreads();
    const int btid = phase_tid();
    if (btid == 0) {
        volatile __attribute__((address_space(3))) unsigned* st = (volatile __attribute__((address_space(3))) unsigned*)(__attribute__((address_space(3))) unsigned char*)(lds_raw + LDS_XBST);
        const unsigned x = xb_xcc_id();
        __builtin_amdgcn_s_waitcnt(0);
        unsigned nloc = st[0], nx = st[1];
        if (nloc == 0u) { xcd_barrier_complete(bar, x, nloc, nx); st[0] = nloc; st[1] = nx; }
        const unsigned old = xb_add(&bar[XB_XSUB(x)], 1u);
        const unsigned gen = old / nloc;
        if (old + 1u == (gen + 1u) * nloc) {
            __builtin_amdgcn_fence(__ATOMIC_RELEASE, "agent");
            asm volatile("s_waitcnt vmcnt(0)" ::: "memory");
            const unsigned og = xb_add(&bar[XB_TOP], 1u);
            const unsigned tg = og / nx;
            if (og + 1u == (tg + 1u) * nx) xb_add(&bar[XB_TOPGEN], 1u);
            else XB_SPIN(xb_ld(&bar[XB_TOPGEN]) == tg, bar);
            __builtin_amdgcn_fence(__ATOMIC_ACQUIRE, "agent");
            xb_add(&bar[XB_XGEN(x)], 1u);
            asm volatile("s_waitcnt vmcnt(0)" ::: "memory");
        } else {
            XB_SPIN(xb_ld(&bar[XB_XGEN(x)]) == gen, bar);
            __builtin_amdgcn_fence(__ATOMIC_ACQUIRE, "agent");
            asm volatile("s_waitcnt vmcnt(0)" ::: "memory");
        }
    }
    __syncthreads();
}

__device__ __forceinline__ float bf2f(bf16_t v) { return __uint_as_float(((unsigned)v) << 16); }
typedef float hw_f32x2 __attribute__((ext_vector_type(2))); typedef __bf16 hw_bf16x2 __attribute__((ext_vector_type(2)));
__device__ __forceinline__ unsigned pk2(float lo, float hi) { const hw_f32x2 v = {lo, hi}; const hw_bf16x2 b = __builtin_convertvector(v, hw_bf16x2); return __builtin_bit_cast(unsigned, b); }
__device__ __forceinline__ bf16_t f2bf(float f) { return (bf16_t)(pk2(f, f) & 0xffffu); }
__device__ __forceinline__ float wave_sum(float v) {
  int x = __float_as_int(v);
  x = __float_as_int(__int_as_float(x) + __int_as_float(__builtin_amdgcn_update_dpp(0, x, 0x111, 0xF, 0xF, true)));
  x = __float_as_int(__int_as_float(x) + __int_as_float(__builtin_amdgcn_update_dpp(0, x, 0x112, 0xF, 0xF, true)));
  x = __float_as_int(__int_as_float(x) + __int_as_float(__builtin_amdgcn_update_dpp(0, x, 0x114, 0xF, 0xF, true)));
  x = __float_as_int(__int_as_float(x) + __int_as_float(__builtin_amdgcn_update_dpp(0, x, 0x118, 0xF, 0xF, true)));
  x = __float_as_int(__int_as_float(x) + __int_as_float(__builtin_amdgcn_update_dpp(0, x, 0x142, 0xA, 0xF, false)));
  x = __float_as_int(__int_as_float(x) + __int_as_float(__builtin_amdgcn_update_dpp(0, x, 0x143, 0xC, 0xF, false)));
  return __int_as_float(__builtin_amdgcn_readlane(x, 63));
}
__device__ __forceinline__ float wave_max(float v) {
#pragma unroll
  for (int o = 32; o >= 1; o >>= 1) v = fmaxf(v, __shfl_xor(v, o));
  return v;
}
__device__ __forceinline__ float silu_f(float v) { return v * __builtin_amdgcn_rcpf(1.f + __expf(-v)); }

__device__ __forceinline__ int ropeperm(int p) { return (p >> 1) + 32 * (p & 1); }
__device__ __forceinline__ int colmap_in(int cp) {
  const int tile = cp >> 8, w = cp & 255;
  if (tile == 0) return (w >> 6) * 64 + ropeperm(w & 63);
  if (tile == 1) { if (w < 128) { const int c = 256 + w; return (c >> 6) * 64 + ropeperm(c & 63); } return 384 + (w - 128); }
  if (tile == 2) return 512 + (w >> 6) * 64 + ropeperm(w & 63);
  if (tile == 3) { if (w < 64) return 768 + ropeperm(w); if (w < 68) return 832 + (w - 64); if (w < 74) return 2372 + (w - 68); if (w < 80) return 2378 + (w - 74); return -1; }
  if (tile == 4) return 2384 + w;
  return 836 + (cp - 1280);
}

struct WorkQ { unsigned* head; volatile int* slot; int nxt; };
__device__ __forceinline__ void wq_init(WorkQ& q, unsigned* head, volatile int* slot, int tid) { q.head = head; q.slot = slot; q.nxt = 0; if (tid == 0) q.nxt = (int)atomicAdd(head, 1u); }
__device__ __forceinline__ int wq_next(WorkQ& q, int tid) {
  __syncthreads();
  if (tid == 0) { *q.slot = q.nxt; q.nxt = (int)atomicAdd(q.head, 1u); }
  __syncthreads();
  return *q.slot;
}

template <class CM>
__device__ __forceinline__ void tp_tile(const float* src, int ld, bf16_t* dst, int drow0, int K, int k0, CM cm, float* lds, int tid) {
  const int a = tid & 63, b = tid >> 6;
  const int sc = cm(a);
  __syncthreads();
#pragma unroll
  for (int i = 0; i < 8; ++i) { const int kk = b * 8 + i; lds[kk * 65 + a] = sc >= 0 ? src[(size_t)(k0 + kk) * ld + sc] : 0.f; }
  __syncthreads();
  { const int nn = tid >> 3, kc = (tid & 7) * 8;
    const float* p = lds + kc * 65 + nn;
    *(u32x4*)(dst + (size_t)(drow0 + nn) * K + k0 + kc) = (u32x4){pk2(p[0], p[65]), pk2(p[130], p[195]), pk2(p[260], p[325]), pk2(p[390], p[455])}; }
}

constexpr int TP_TOTAL = (NIN / 64) * 16 + 16 * 16 + 8 * 16 + 64 * 8 * 16 + 64 * 16 * 4;
constexpr int TP_WD0 = TP_TOTAL - 64 * 16 * 4;
constexpr int TP_D1 = 5200;
__device__ __forceinline__ void prologue_tiles(const Ctx& c, float* lds, int tid, int lo, int hi, int b0, int nb) {
  unsigned char* ws = c.ws;
  const int n_win = (NIN / 64) * 16, n_wo = 16 * 16, n_wmkv = 8 * 16, n_wgu = 64 * 8 * 16, n_wd = 64 * 16 * 4;
  const int total = n_win + n_wo + n_wmkv + n_wgu + n_wd;
  for (int it = lo + b0; it < hi; it += nb) {
    int r = it;
    if (r < n_win) { const int nt = r / 16, kt = r % 16; tp_tile(c.in[2], 2640, (bf16_t*)(ws + WS_WIN), nt * 64, 1024, kt * 64, [&](int a) { return colmap_in(nt * 64 + a); }, lds, tid); continue; } r -= n_win;
    if (r < n_wo) { const int nt = r / 16, kt = r % 16; tp_tile(c.in[13], 1024, (bf16_t*)(ws + WS_WO), nt * 64, 1024, kt * 64, [&](int a) { return nt * 64 + a; }, lds, tid); continue; } r -= n_wo;
    if (r < n_wmkv) { const int nt = r / 16, kt = r % 16; tp_tile(c.in[12], 512, (bf16_t*)(ws + WS_WMKV), nt * 64, 1024, kt * 64, [&](int a) { return nt * 64 + a; }, lds, tid); continue; } r -= n_wmkv;
    if (r < n_wgu) { const int e = r / 128, q = r % 128, nt = q / 16, kt = q % 16;
      const int pn = nt >> 2, sub = nt & 3, isup = sub >> 1, c0 = pn * 128 + (sub & 1) * 64;
      const float* src = (isup ? c.in[21] : c.in[20]) + (size_t)e * 1024 * 256;
      tp_tile(src, 256, (bf16_t*)(ws + WS_WGU), e * 512 + nt * 64, 1024, kt * 64, [&](int a) { return c0 + a; }, lds, tid); continue; } r -= n_wgu;
    { const int e = r / 64, q = r % 64, nt = q / 4, kt = q % 4;
      tp_tile(c.in[22] + (size_t)e * 256 * 1024, 1024, (bf16_t*)(ws + WS_WD), e * 1024 + nt * 64, 256, kt * 64, [&](int a) { return nt * 64 + a; }, lds, tid); }
  }
}

__device__ void phase_tiles_queue(const Ctx& c, float* lds, unsigned* qhead, int lo, int hi) {
  const int tid = phase_tid();
  volatile int* slot = (volatile int*)(lds + 64 * 65 + 16);
  WorkQ wq; wq_init(wq, qhead, slot, tid);
  const int nitems = (hi - lo + 7) >> 3;
  for (;;) {
    const int item = wq_next(wq, tid);
    if (item >= nitems) break;
    const int t0 = lo + item * 8, t1 = t0 + 8 < hi ? t0 + 8 : hi;
    prologue_tiles(c, lds, tid, t0, t1, 0, 1);
  }
}

__device__ void phase_prologue(const Ctx& c, float* lds) {
  const int tid = phase_tid(), bid = blockIdx.x, G = gridDim.x;
  unsigned char* ws = c.ws;
  const size_t gtid = (size_t)bid * NTHREADS + tid, gstride = (size_t)G * NTHREADS;
  { const f32x4* x4 = (const f32x4*)c.in[0]; u32x2* o = (u32x2*)(ws + WS_XB);
    for (size_t i = gtid; i < (size_t)T * DM / 4; i += gstride) { const f32x4 v = x4[i]; o[i] = (u32x2){pk2(v.x, v.y), pk2(v.z, v.w)}; }
    const f32x4* m4 = (const f32x4*)c.in[1]; u32x2* om = (u32x2*)(ws + WS_MEMB);
    for (size_t i = gtid; i < (size_t)TM * DM / 4; i += gstride) { const f32x4 v = m4[i]; om[i] = (u32x2){pk2(v.x, v.y), pk2(v.z, v.w)}; } }
  { float* cs = (float*)(ws + WS_ROPE); float* sn = cs + SEQ * 32;
    for (size_t i = gtid; i < (size_t)SEQ * 32; i += gstride) { const int s = (int)(i >> 5), d = (int)(i & 31);
      const float inv = 1.0f / powf(10000.0f, (float)d / 32.0f); const float ang = (float)s * inv; float sv, cv; sincosf(ang, &sv, &cv); cs[i] = cv; sn[i] = sv; } }
  { bf16_t* wkv = (bf16_t*)(ws + WS_WKV); const float* g = c.in[3]; const float* wk = c.in[4]; const float* wv = c.in[5];
    for (size_t i = gtid; i < 128 * 128; i += gstride) { const int p = (int)(i >> 7), k = (int)(i & 127);
      const float w = p < 64 ? wk[k * 64 + ropeperm(p)] : wv[k * 64 + (p - 64)]; wkv[i] = f2bf(w * g[k]); }
    bf16_t* wr = (bf16_t*)(ws + WS_WR); const float* wg = c.in[16]; const float* wrt = c.in[18];
    for (size_t i = gtid; i < 80 * 1024; i += gstride) { const int o = (int)(i >> 10), k = (int)(i & 1023); wr[i] = f2bf(o < 8 ? wg[k * 8 + o] : o < 72 ? wrt[k * 64 + (o - 8)] : 0.f); } }
  prologue_tiles(c, lds, tid, 0, TP_WD0 - TP_D1, bid, G);
}

__device__ __forceinline__ void expert_offsets(const Ctx& c, int* offs  , int* cnts  , int tid) {
  const unsigned* ctl = (const unsigned*)(c.ws + WS_CTL);
  __syncthreads();
  if (tid == 0) { int o = 0; for (int e = 0; e < 64; ++e) { const int n = (int)ctl[CW_CNT + e]; cnts[e] = n; offs[e] = o; o += (n + 255) & ~255; } offs[64] = o; }
  __syncthreads();
}


namespace pg8 {
#define PG8_LAS __attribute__((address_space(3)))
typedef short bf16x8 __attribute__((ext_vector_type(8)));
constexpr int BM = 256, BK = 64, HALF = 128, HTB = HALF * BK * 2, STAGE_BYTES = 8 * HTB, NXCD = 8, WGM = 8;
__host__ __device__ __forceinline__ int lds_byte(int r, int c) { const int st = (r >> 4) * 2 + (c >> 5), rr = r & 15, cc = c & 31, ob = rr * 64 + cc * 2; return st * 1024 + (ob ^ (((ob >> 9) & 1) << 5)); }
__host__ __device__ __forceinline__ void stage_rc(int b, int& R, int& C) { const int st = b / 1024, sb = b % 1024, swz = sb ^ (((sb >> 9) & 1) << 5); R = (st >> 1) * 16 + swz / 64; C = (st & 1) * 32 + (swz % 64) / 2; }
__host__ __device__ __forceinline__ int perm32(int rho) { const int n = rho >> 4, i = rho & 15; return 8 * (i >> 2) + 4 * n + (i & 3); }
struct Unit { int pm, pn, e, mt, aux; };
struct Gemm { const bf16_t* A; const bf16_t* Bt; int K; };
struct StaticOrder {
    int nM, nN, nwg, G, c;
    __device__ void init(int M, int N, int G_, int c_) { nM = M / BM; nN = N / BM; nwg = nM * nN; G = G_; c = c_; }
    __device__ bool next(int i, Unit& u) const {
        const long L = (long)i * G + c; if (c < 0 || L >= nwg) return false;
        int wgid = (int)L; { const int q = nwg / NXCD, r = nwg % NXCD, xcd = wgid % NXCD, off = wgid / NXCD; wgid = (xcd < r ? xcd * (q + 1) : r * (q + 1) + (xcd - r) * q) + off; }
        const int nig = WGM * nN, gid = wgid / nig, fm = gid * WGM, gsz = (nM - fm) < WGM ? (nM - fm) : WGM;
        u.pm = fm + ((wgid % nig) % gsz); u.pn = (wgid % nig) / gsz; u.e = 0; u.mt = 0; u.aux = 0; return true;
    }
    __device__ __forceinline__ unsigned arow(const Unit&, int) const { return 0u; }
};
__device__ __forceinline__ unsigned cvt_pk_bf16(float lo, float hi) { unsigned r; asm volatile("v_cvt_pk_bf16_f32 %0, %1, %2" : "=v"(r) : "v"(lo), "v"(hi)); return r; }

template <class Epi, class Sched, bool ALIGN_EPI, bool GATHER>
__device__ __forceinline__ void gemm_phase(PG8_LAS unsigned char* lds, const Gemm g, const Sched& S, const Epi& E, const int tid) {
    const int wid = __builtin_amdgcn_readfirstlane(tid >> 6), lane = tid & 63, wr = wid >> 2, wc = wid & 3, fr = lane & 15, fq = lane >> 4;
    const int K = g.K, nt = K / BK;
    unsigned voffA[2], voffB[2]; int RA[2], CA[2];
#pragma unroll
    for (int i = 0; i < 2; ++i) { int R, C; stage_rc(tid * 16 + i * 8192, R, C); const int Rb = Epi::PERM ? ((R & ~31) + perm32(R & 31)) : R;
        RA[i] = R; CA[i] = C; voffA[i] = (unsigned)(R * K + C) * 2u; voffB[i] = (unsigned)(Rb * K + C) * 2u; }
    const size_t kstep = (size_t)(BK * 2);
    const size_t hstep = (size_t)HALF * K * 2;
    const size_t tstep = 2 * hstep;
    const unsigned ldsw = (unsigned)wid * 1024u;
    const int aoff = lds_byte(wr * 64 + fr, fq * 8), boff = lds_byte(wc * 32 + fr, fq * 8);
#define PG8_SA(b, h) (((b) * 2 + (h)) * HTB)
#define PG8_SB(b, h) ((4 + (b) * 2 + (h)) * HTB)
#define PG8_STAGE(bufoff, gbase, voff) do { _Pragma("unroll") for (int _i = 0; _i < 2; ++_i) \
        __builtin_amdgcn_global_load_lds((const unsigned*)((const char*)(gbase) + (voff)[_i]), (PG8_LAS unsigned*)(lds + (bufoff) + ldsw + _i * 8192), 16, 0, 0); } while (0)
#define PG8_STAGE_A(bufoff, gbase, h, goff) do { if constexpr (GATHER) { PG8_STAGE(bufoff, gbase, (goff)[h]); } else { PG8_STAGE(bufoff, (gbase) + (h) * hstep, voffA); } } while (0)
#define PG8_LDA(dst, b, h) do { _Pragma("unroll") for (int m = 0; m < 4; ++m) _Pragma("unroll") for (int k = 0; k < 2; ++k) dst[m][k] = *(const PG8_LAS bf16x8*)(lds + PG8_SA(b, h) + aoff + m * 2048 + k * 1024); } while (0)
#define PG8_LDB(dst, b, h) do { _Pragma("unroll") for (int n = 0; n < 2; ++n) _Pragma("unroll") for (int k = 0; k < 2; ++k) dst[n][k] = *(const PG8_LAS bf16x8*)(lds + PG8_SB(b, h) + boff + n * 2048 + k * 1024); } while (0)
#define PG8_MMA(ai, bj, At, Bt) do { __builtin_amdgcn_s_setprio(1); _Pragma("unroll") for (int m = 0; m < 4; ++m) _Pragma("unroll") for (int n = 0; n < 2; ++n) _Pragma("unroll") for (int k = 0; k < 2; ++k) \
        acc[ai][bj][m][n] = __builtin_amdgcn_mfma_f32_16x16x32_bf16(Bt[n][k], At[m][k], acc[ai][bj][m][n], 0, 0, 0); __builtin_amdgcn_s_setprio(0); } while (0)
#define PG8_WAIT_V(n) asm volatile("s_waitcnt vmcnt(" #n ")" ::: "memory")
#define PG8_WAIT_L(n) asm volatile("s_waitcnt lgkmcnt(" #n ")" ::: "memory")
#define PG8_BAR __builtin_amdgcn_s_barrier()
#define PG8_SCHED __builtin_amdgcn_sched_barrier(0)
    Unit cur, nxt; int ui = 0;
    if (!S.next(0, cur)) return;
    f32x4 acc[2][2][4][2];
#pragma unroll
    for (int a = 0; a < 2; ++a)
#pragma unroll
        for (int b = 0; b < 2; ++b)
#pragma unroll
            for (int m = 0; m < 4; ++m)
#pragma unroll
                for (int n = 0; n < 2; ++n) acc[a][b][m][n] = (f32x4){0.f, 0.f, 0.f, 0.f};
    bf16x8 At[4][2], B0[2][2], B1[2][2];
    unsigned gc[2][2], gn[2][2];
    const char* cA; const char* cB = (const char*)g.Bt + (size_t)cur.pn * tstep;
    if constexpr (GATHER) { cA = (const char*)g.A;
#pragma unroll
        for (int h = 0; h < 2; ++h)
#pragma unroll
            for (int i = 0; i < 2; ++i) { gc[h][i] = (S.arow(cur, h * HALF + RA[i]) * (unsigned)K + (unsigned)CA[i]) * 2u; gn[h][i] = gc[h][i]; }
    } else { cA = (const char*)g.A + (size_t)cur.pm * tstep; }
    PG8_STAGE(PG8_SB(0, 0), cB, voffB); PG8_STAGE(PG8_SB(0, 1), cB + hstep, voffB); PG8_STAGE_A(PG8_SA(0, 0), cA, 0, gc); PG8_STAGE_A(PG8_SA(0, 1), cA, 1, gc);
    if (wr == 1) PG8_BAR;
    PG8_WAIT_V(2); PG8_BAR;
    PG8_STAGE(PG8_SB(1, 0), cB + kstep, voffB); PG8_STAGE_A(PG8_SA(1, 0), cA + kstep, 0, gc); PG8_STAGE(PG8_SB(1, 1), cB + hstep + kstep, voffB);
    PG8_WAIT_V(6); PG8_BAR;
    for (;;) {
        const bool has_next = S.next(ui + 1, nxt);
        const char* nA; const char* nB = has_next ? (const char*)g.Bt + (size_t)nxt.pn * tstep : cB;
        if constexpr (GATHER) { nA = cA;
            if (has_next) {
#pragma unroll
                for (int h = 0; h < 2; ++h)
#pragma unroll
                    for (int i = 0; i < 2; ++i) gn[h][i] = (S.arow(nxt, h * HALF + RA[i]) * (unsigned)K + (unsigned)CA[i]) * 2u; }
        } else { nA = has_next ? (const char*)g.A + (size_t)nxt.pm * tstep : cA; }
        for (int t = 0; t < nt; t += 2) {
            const bool last = (t == nt - 2);
            const char* a1 = cA + (size_t)(t + 1) * kstep;
            const char* a2 = last ? nA : cA + (size_t)(t + 2) * kstep; const char* b2 = last ? nB : cB + (size_t)(t + 2) * kstep;
            const char* a3 = a2 + kstep; const char* b3 = b2 + kstep;
            unsigned g2[2][2];
            if constexpr (GATHER) {
#pragma unroll
            for (int h = 0; h < 2; ++h)
#pragma unroll
                for (int i = 0; i < 2; ++i) g2[h][i] = last ? gn[h][i] : gc[h][i]; }
            PG8_LDB(B0, 0, 0); PG8_LDB(B1, 0, 1); PG8_SCHED; PG8_LDA(At, 0, 0); PG8_STAGE_A(PG8_SA(1, 1), a1, 1, gc);
            PG8_WAIT_V(8); PG8_WAIT_L(0); PG8_BAR; PG8_MMA(0, 0, At, B0); PG8_MMA(0, 1, At, B1); PG8_BAR; PG8_SCHED;
            PG8_LDA(At, 0, 1); PG8_STAGE(PG8_SB(0, 0), b2, voffB); PG8_STAGE(PG8_SB(0, 1), b2 + hstep, voffB); PG8_STAGE_A(PG8_SA(0, 0), a2, 0, g2);
            PG8_WAIT_V(8); PG8_WAIT_L(0); PG8_BAR; PG8_MMA(1, 0, At, B0); PG8_MMA(1, 1, At, B1); PG8_BAR; PG8_SCHED;
            PG8_LDB(B0, 1, 0); PG8_LDB(B1, 1, 1); PG8_SCHED; PG8_LDA(At, 1, 0); PG8_STAGE_A(PG8_SA(0, 1), a2, 1, g2);
            PG8_WAIT_V(8); PG8_WAIT_L(0); PG8_BAR; PG8_MMA(0, 0, At, B0); PG8_MMA(0, 1, At, B1); PG8_BAR; PG8_SCHED;
            PG8_LDA(At, 1, 1); PG8_STAGE(PG8_SB(1, 0), b3, voffB); PG8_STAGE(PG8_SB(1, 1), b3 + hstep, voffB); PG8_STAGE_A(PG8_SA(1, 0), a3, 0, g2);
            PG8_WAIT_V(8); PG8_WAIT_L(0); PG8_BAR; PG8_MMA(1, 0, At, B0); PG8_MMA(1, 1, At, B1); PG8_BAR; PG8_SCHED;
        }
        if constexpr (ALIGN_EPI) { if (wr == 0) PG8_BAR; }
        E(acc, cur, wr, wc, fr, fq);
        if (!has_next) break;
#pragma unroll
        for (int a = 0; a < 2; ++a)
#pragma unroll
            for (int b = 0; b < 2; ++b)
#pragma unroll
                for (int m = 0; m < 4; ++m)
#pragma unroll
                    for (int n = 0; n < 2; ++n) acc[a][b][m][n] = (f32x4){0.f, 0.f, 0.f, 0.f};
        cur = nxt; cA = nA; cB = nB; ++ui;
        if constexpr (GATHER) {
#pragma unroll
        for (int h = 0; h < 2; ++h)
#pragma unroll
            for (int i = 0; i < 2; ++i) gc[h][i] = gn[h][i]; }
        if constexpr (ALIGN_EPI) { if (wr == 1) PG8_BAR; }
    }
    PG8_WAIT_V(0);
    if constexpr (!ALIGN_EPI) { if (wr == 0) PG8_BAR; }
    PG8_BAR;
#undef PG8_SA
#undef PG8_SB
#undef PG8_STAGE
#undef PG8_STAGE_A
#undef PG8_LDA
#undef PG8_LDB
#undef PG8_MMA
#undef PG8_WAIT_V
#undef PG8_WAIT_L
#undef PG8_BAR
#undef PG8_SCHED
}
}
typedef __attribute__((address_space(3))) unsigned char lds_u8;

__device__ __forceinline__ u32x4 pack8(const f32x4& a, const f32x4& b) { return (u32x4){pg8::cvt_pk_bf16(a.x, a.y), pg8::cvt_pk_bf16(a.z, a.w), pg8::cvt_pk_bf16(b.x, b.y), pg8::cvt_pk_bf16(b.z, b.w)}; }
struct EpiInM {
  static constexpr bool PERM = true;
  unsigned char* ws;
  __device__ __forceinline__ void operator()(const f32x4 (&acc)[2][2][4][2], const pg8::Unit& u, int wr, int wc, int fr, int fq) const {
    const float* cs = (const float*)(ws + WS_ROPE); const float* sn = cs + SEQ * 32;
    const int pn = u.pn;
#pragma unroll
    for (int ai = 0; ai < 2; ++ai)
#pragma unroll
      for (int m = 0; m < 4; ++m) {
        const int row = u.pm * 256 + ai * 128 + wr * 64 + m * 16 + fr, pos = row & (SEQ - 1);
#pragma unroll
        for (int bj = 0; bj < 2; ++bj) {
          const int w = bj * 128 + wc * 32 + 8 * fq;
          f32x4 v0 = acc[ai][bj][m][0], v1 = acc[ai][bj][m][1];
          const bool do_rope = (pn == 0) || (pn == 1 && bj == 0) || (pn == 2) || (pn == 3 && bj == 0 && wc < 2);
          if (do_rope) { const int d = (w & 63) >> 1; const f32x4 c4 = *(const f32x4*)(cs + pos * 32 + d), s4 = *(const f32x4*)(sn + pos * 32 + d);
            const f32x4 o0 = {v0.x * c4.x - v0.y * s4.x, v0.y * c4.x + v0.x * s4.x, v0.z * c4.y - v0.w * s4.y, v0.w * c4.y + v0.z * s4.y};
            const f32x4 o1 = {v1.x * c4.z - v1.y * s4.z, v1.y * c4.z + v1.x * s4.z, v1.z * c4.w - v1.w * s4.w, v1.w * c4.w + v1.z * s4.w};
            v0 = o0; v1 = o1; }
          if (pn == 0) { *(u32x4*)((bf16_t*)(ws + WS_QA) + (size_t)row * 384 + w) = pack8(v0 * QSCALE, v1 * QSCALE); }
          else if (pn == 1) { if (bj == 0) *(u32x4*)((bf16_t*)(ws + WS_QA) + (size_t)row * 384 + 256 + w) = pack8(v0 * QSCALE, v1 * QSCALE);
                              else *(u32x4*)((bf16_t*)(ws + WS_CKV) + (size_t)row * 128 + (w - 128)) = pack8(v0, v1); }
          else if (pn == 2) { *(u32x4*)((bf16_t*)(ws + WS_IQ) + (size_t)row * 256 + w) = pack8(v0, v1); }
          else if (pn == 3) { if (bj == 0) { if (wc < 2) *(u32x4*)((bf16_t*)(ws + WS_IK) + (size_t)row * 64 + w) = pack8(v0, v1);
                                             else if (wc == 2 && fq < 2) { if (fq == 0) v0 = v0 * 0.0625f; float* o = (float*)(ws + WS_SM) + (size_t)row * 16 + 8 * fq; *(f32x4*)o = v0; *(f32x4*)(o + 4) = v1; } } }
          else if (pn == 4) { *(u32x4*)((bf16_t*)(ws + WS_QC) + (size_t)row * 256 + w) = pack8(v0 * QSCALE, v1 * QSCALE); }
          else { *(u32x4*)((bf16_t*)(ws + WS_GB) + (size_t)row * 1536 + (pn - 5) * 256 + w) = pack8(v0, v1); }
        }
      }
  }
};
struct EpiMemKVM {
  static constexpr bool PERM = true;
  unsigned char* ws;
  __device__ __forceinline__ void operator()(const f32x4 (&acc)[2][2][4][2], const pg8::Unit& u, int wr, int wc, int fr, int fq) const {
#pragma unroll
    for (int ai = 0; ai < 2; ++ai)
#pragma unroll
      for (int m = 0; m < 4; ++m) {
        const int row = u.pm * 256 + ai * 128 + wr * 64 + m * 16 + fr;
#pragma unroll
        for (int bj = 0; bj < 2; ++bj) {
          const int w = bj * 128 + wc * 32 + 8 * fq; const f32x4 v0 = acc[ai][bj][m][0], v1 = acc[ai][bj][m][1];
          if (u.pn == 0) *(u32x4*)((bf16_t*)(ws + WS_MK) + (size_t)row * 256 + w) = pack8(v0, v1);
          else { const int mem = row & 255, xx = mem & 31, mpos = (mem & ~31) + 8 * ((xx >> 2) & 3) + (xx & 3) + 4 * (xx >> 4);
            bf16_t* o = (bf16_t*)(ws + WS_MVT) + ((size_t)(row >> 8) * 256 + w) * 256 + mpos;
            o[0] = f2bf(v0.x); o[256] = f2bf(v0.y); o[512] = f2bf(v0.z); o[768] = f2bf(v0.w); o[1024] = f2bf(v1.x); o[1280] = f2bf(v1.y); o[1536] = f2bf(v1.z); o[1792] = f2bf(v1.w); }
        }
      }
  }
};
struct EpiOutM {
  static constexpr bool PERM = true;
  const float* x; bf16_t* y;
  __device__ __forceinline__ void operator()(const f32x4 (&acc)[2][2][4][2], const pg8::Unit& u, int wr, int wc, int fr, int fq) const {
#pragma unroll
    for (int ai = 0; ai < 2; ++ai)
#pragma unroll
      for (int m = 0; m < 4; ++m) {
        const size_t rb = (size_t)(u.pm * 256 + ai * 128 + wr * 64 + m * 16 + fr) * 1024 + u.pn * 256 + wc * 32 + 8 * fq;
#pragma unroll
        for (int bj = 0; bj < 2; ++bj) { const size_t o = rb + bj * 128; const f32x4 x0 = *(const f32x4*)(x + o), x1 = *(const f32x4*)(x + o + 4);
          *(u32x4*)(y + o) = pack8(x0 * ALPHA + acc[ai][bj][m][0], x1 * ALPHA + acc[ai][bj][m][1]); }
      }
  }
};
struct MoeOrder {
  const int* offs; const int* cnts; int npn, G, c; const unsigned* LIST;
  __device__ __forceinline__ bool next(int i, pg8::Unit& u) const {
    const int L = i * G + c; const int ntiles = __builtin_amdgcn_readfirstlane(offs[64]) >> 8;
    if (L >= ntiles * npn) return false;
    const int rt = L / npn, pl = L - rt * npn; int e = 0;
    while (__builtin_amdgcn_readfirstlane(offs[e + 1]) <= rt * 256) ++e;
    u.pm = rt; u.mt = rt - (__builtin_amdgcn_readfirstlane(offs[e]) >> 8); u.e = e; u.pn = e * npn + pl; u.aux = __builtin_amdgcn_readfirstlane(cnts[e]); return true;
  }
  __device__ __forceinline__ unsigned arow(const pg8::Unit& u, int r) const { const int rank = u.mt * 256 + r; return rank < u.aux ? LIST[(size_t)u.e * 32768 + rank] : 0u; }
};
struct EpiMoeUpM {
  static constexpr bool PERM = true;
  bf16_t* H;
  __device__ __forceinline__ void operator()(const f32x4 (&acc)[2][2][4][2], const pg8::Unit& u, int wr, int wc, int fr, int fq) const {
    const int pl = u.pn & 1;
#pragma unroll
    for (int ai = 0; ai < 2; ++ai)
#pragma unroll
      for (int m = 0; m < 4; ++m) {
        const int rl = ai * 128 + wr * 64 + m * 16 + fr;
        if (u.mt * 256 + rl < u.aux) {
          f32x4 h0, h1; const f32x4 g0 = acc[ai][0][m][0], g1 = acc[ai][0][m][1], u0 = acc[ai][1][m][0], u1 = acc[ai][1][m][1];
          h0.x = silu_f(g0.x) * u0.x; h0.y = silu_f(g0.y) * u0.y; h0.z = silu_f(g0.z) * u0.z; h0.w = silu_f(g0.w) * u0.w;
          h1.x = silu_f(g1.x) * u1.x; h1.y = silu_f(g1.y) * u1.y; h1.z = silu_f(g1.z) * u1.z; h1.w = silu_f(g1.w) * u1.w;
          *(u32x4*)(H + (size_t)(u.pm * 256 + rl) * 256 + pl * 128 + wc * 32 + 8 * fq) = pack8(h0, h1);
        }
      }
  }
};
__device__ __forceinline__ unsigned pk4_fp8(const f32x4& v) { unsigned w = __builtin_amdgcn_cvt_pk_fp8_f32(v.x, v.y, 0u, false); return __builtin_amdgcn_cvt_pk_fp8_f32(v.z, v.w, w, true); }
struct EpiMoeDownM {
  static constexpr bool PERM = true;
  unsigned char* Y; const float* GATEL;
  __device__ __forceinline__ void operator()(const f32x4 (&acc)[2][2][4][2], const pg8::Unit& u, int wr, int wc, int fr, int fq) const {
    const int pl = u.pn & 3;
    const float* gp = GATEL + (size_t)u.e * 32768; const int rk0 = u.mt * 256 + wr * 64 + fr;
    unsigned char* yp = Y + (size_t)(u.pm * 256 + wr * 64 + fr) * 1024 + pl * 256 + wc * 32 + 8 * fq;
#pragma unroll
    for (int ai = 0; ai < 2; ++ai)
#pragma unroll
      for (int m = 0; m < 4; ++m) {
        const int rk = rk0 + ai * 128 + m * 16; const float gt = gp[rk < 32767 ? rk : 32767] * 64.0f;
#pragma unroll
        for (int bj = 0; bj < 2; ++bj)
          *(u32x2*)(yp + (size_t)(ai * 128 + m * 16) * 1024 + bj * 128) = (u32x2){pk4_fp8(acc[ai][bj][m][0] * gt), pk4_fp8(acc[ai][bj][m][1] * gt)};
      }
  }
};

__device__ __forceinline__ void phase_inproj_mfma(const Ctx& c, lds_u8* lds) {
  unsigned char* ws = c.ws; const int tid = phase_tid();
  { pg8::Gemm g{(const bf16_t*)(ws + WS_XB), (const bf16_t*)(ws + WS_WIN), 1024}; pg8::StaticOrder S; S.init(T, NIN, gridDim.x, blockIdx.x); EpiInM E{ws};
    pg8::gemm_phase<EpiInM, pg8::StaticOrder, true, false>(lds, g, S, E, tid); }
  { pg8::Gemm g{(const bf16_t*)(ws + WS_MEMB), (const bf16_t*)(ws + WS_WMKV), 1024}; pg8::StaticOrder S; S.init(TM, 512, gridDim.x, (int)blockIdx.x - 128); EpiMemKVM E{ws};
    pg8::gemm_phase<EpiMemKVM, pg8::StaticOrder, true, false>(lds, g, S, E, tid); }
}
__device__ __forceinline__ void phase_outproj_mfma(const Ctx& c, lds_u8* lds) {
  unsigned char* ws = c.ws; const int tid = phase_tid();
  pg8::Gemm g{(const bf16_t*)(ws + WS_CAT), (const bf16_t*)(ws + WS_WO), 1024}; pg8::StaticOrder S; S.init(T, 1024, gridDim.x, blockIdx.x); EpiOutM E{c.in[0], (bf16_t*)(ws + WS_X1B)};
  pg8::gemm_phase<EpiOutM, pg8::StaticOrder, true, false>(lds, g, S, E, tid);
}
__device__ __forceinline__ void phase_moe_up_mfma(const Ctx& c, lds_u8* lds) {
  unsigned char* ws = c.ws; const int tid = phase_tid();
  int* offs = (int*)((unsigned char*)lds + pg8::STAGE_BYTES); int* cnts = offs + 65;
  expert_offsets(c, offs, cnts, tid);
  pg8::Gemm g{(const bf16_t*)(ws + WS_X1B), (const bf16_t*)(ws + WS_WGU), 1024};
  MoeOrder S{offs, cnts, 2, (int)gridDim.x, (int)blockIdx.x, (const unsigned*)(ws + WS_LIST)}; EpiMoeUpM E{(bf16_t*)(ws + WS_H)};
  pg8::gemm_phase<EpiMoeUpM, MoeOrder, true, true>(lds, g, S, E, tid);
}
__device__ __forceinline__ void phase_moe_down_mfma(const Ctx& c, lds_u8* lds) {
  unsigned char* ws = c.ws; const int tid = phase_tid();
  int* offs = (int*)((unsigned char*)lds + pg8::STAGE_BYTES); int* cnts = offs + 65;
  expert_offsets(c, offs, cnts, tid);
  pg8::Gemm g{(const bf16_t*)(ws + WS_H), (const bf16_t*)(ws + WS_WD), 256};
  MoeOrder S{offs, cnts, 4, (int)gridDim.x, (int)blockIdx.x, nullptr}; EpiMoeDownM E{(unsigned char*)(ws + WS_Y), (const float*)(ws + WS_GATEL)};
  pg8::gemm_phase<EpiMoeDownM, MoeOrder, true, false>(lds, g, S, E, tid);
}

__device__ void phase_kvup(const Ctx& c, float* lds) {
  unsigned char* ws = c.ws;
  const int tid = phase_tid(), lane = tid & 63, wave = tid >> 6, fr = lane & 15, fq = lane >> 4;
  const bf16_t* W = (const bf16_t*)(ws + WS_WKV);
  const bf16_t* CKV = (const bf16_t*)(ws + WS_CKV); bf16_t* KVA = (bf16_t*)(ws + WS_KVA);
  const float* cs = (const float*)(ws + WS_ROPE); const float* sn = cs + SEQ * 32;
  for (int tile = blockIdx.x * NWAVES + wave; tile < T / 16; tile += gridDim.x * NWAVES) {
    const int t = tile * 16 + fr, pos = t & (SEQ - 1);
    pg8::bf16x8 bx[4]; float ss = 0.f;
#pragma unroll
    for (int ks = 0; ks < 4; ++ks) { const u32x4 v = *(const u32x4*)(CKV + (size_t)t * 128 + ks * 32 + fq * 8); bx[ks] = __builtin_bit_cast(pg8::bf16x8, v);
      const float f[8] = {__uint_as_float(v.x << 16), __uint_as_float(v.x & 0xffff0000u), __uint_as_float(v.y << 16), __uint_as_float(v.y & 0xffff0000u), __uint_as_float(v.z << 16), __uint_as_float(v.z & 0xffff0000u), __uint_as_float(v.w << 16), __uint_as_float(v.w & 0xffff0000u)};
#pragma unroll
      for (int e = 0; e < 8; ++e) ss += f[e] * f[e]; }
    ss += __shfl_xor(ss, 16); ss += __shfl_xor(ss, 32);
    const float rstd = rsqrtf(ss * (1.f / 128.f) + 1e-6f);
#pragma unroll
    for (int nt = 0; nt < 8; ++nt) { f32x4 d = {0.f, 0.f, 0.f, 0.f};
#pragma unroll
      for (int ks = 0; ks < 4; ++ks) d = __builtin_amdgcn_mfma_f32_16x16x32_bf16(*(const pg8::bf16x8*)(W + (size_t)(nt * 16 + fr) * 128 + ks * 32 + fq * 8), bx[ks], d, 0, 0, 0);
      d = d * rstd;
      const int p0 = nt * 16 + fq * 4;
      if (nt < 4) { const int dd = p0 >> 1; const float c0 = cs[pos * 32 + dd], s0 = sn[pos * 32 + dd], c1 = cs[pos * 32 + dd + 1], s1 = sn[pos * 32 + dd + 1];
        const f32x4 o = {d.x * c0 - d.y * s0, d.y * c0 + d.x * s0, d.z * c1 - d.w * s1, d.w * c1 + d.z * s1}; d = o; }
      *(u32x2*)(KVA + (size_t)t * 128 + p0) = (u32x2){pg8::cvt_pk_bf16(d.x, d.y), pg8::cvt_pk_bf16(d.z, d.w)}; }
  }
}


typedef _Float16 h16x2 __attribute__((ext_vector_type(2)));
constexpr int TK_KP = 4104;
constexpr int TK_KEYS = 0, TK_H1 = 16 * TK_KP * 2, TK_H2 = TK_H1 + 16 * 128 * 4, TK_MISC = TK_H2 + 8 * 128 * 4;
__device__ __forceinline__ unsigned mono16x2(unsigned u) { const unsigned m = ((u >> 15) & 0x00010001u) * 0xffffu; return u ^ (m | 0x80008000u); }
__device__ __forceinline__ int wave_incl_scan(int x) {
  x += __builtin_amdgcn_update_dpp(0, x, 0x111, 0xF, 0xF, true);
  x += __builtin_amdgcn_update_dpp(0, x, 0x112, 0xF, 0xF, true);
  x += __builtin_amdgcn_update_dpp(0, x, 0x114, 0xF, 0xF, true);
  x += __builtin_amdgcn_update_dpp(0, x, 0x118, 0xF, 0xF, true);
  x += __builtin_amdgcn_update_dpp(0, x, 0x142, 0xA, 0xF, false);
  x += __builtin_amdgcn_update_dpp(0, x, 0x143, 0xC, 0xF, false);
  return x;
}

__device__ __forceinline__ void hist_find(const unsigned* hw, int need, int lane, int& B, int& above) {
  const unsigned w0 = hw[127 - 2 * lane], w1 = hw[126 - 2 * lane];
  const int c0 = (int)(w0 >> 16), c1 = (int)(w0 & 0xffffu), c2 = (int)(w1 >> 16), c3 = (int)(w1 & 0xffffu);
  const int tl = c0 + c1 + c2 + c3;
  const int incl = wave_incl_scan(tl);
  const int excl = incl - tl;
  const bool hit = (excl < need) && (incl >= need);
  int b = 0, ab = 0;
  if (hit) { int a = excl; b = 255 - 4 * lane; ab = a;
    if (a + c0 < need) { a += c0; b = 254 - 4 * lane; ab = a; if (a + c1 < need) { a += c1; b = 253 - 4 * lane; ab = a; if (a + c2 < need) { a += c2; b = 252 - 4 * lane; ab = a; } } } }
  const unsigned long long m = __ballot(hit);
  const int src = __builtin_amdgcn_readfirstlane(m ? (__ffsll((long long)m) - 1) : 0);
  B = __builtin_amdgcn_readlane(b, src); above = __builtin_amdgcn_readlane(ab, src);
}
__device__ void phase_topk_mfma(const Ctx& c, unsigned char* ldsb, unsigned* qhead) {
  unsigned char* ws = c.ws;
  const int tid = phase_tid(), lane = tid & 63, wave = tid >> 6, fr = lane & 15, fq = lane >> 4;
  unsigned short* keys = (unsigned short*)(ldsb + TK_KEYS);
  unsigned* h1 = (unsigned*)(ldsb + TK_H1); unsigned* h2 = (unsigned*)(ldsb + TK_H2) + wave * 128; int* misc = (int*)(ldsb + TK_MISC);
  const bf16_t* IQ = (const bf16_t*)(ws + WS_IQ); const bf16_t* IK = (const bf16_t*)(ws + WS_IK); const float* SM = (const float*)(ws + WS_SM);
  unsigned short* SEL = (unsigned short*)(ws + WS_SEL);
  WorkQ wq; wq_init(wq, qhead, misc, tid);
  for (;;) {
    const int item = wq_next(wq, tid);
    if (item >= 240 * 8) break;
    const int b = item & 7, qb = 255 - (item >> 3), s0 = qb * 16;
    for (int i = tid; i < 16 * 128; i += NTHREADS) h1[i] = 0u;
    const size_t qrow = (size_t)b * SEQ + s0 + fr;
    pg8::bf16x8 bq[4][2];
#pragma unroll
    for (int hh = 0; hh < 4; ++hh)
#pragma unroll
      for (int ks = 0; ks < 2; ++ks) bq[hh][ks] = *(const pg8::bf16x8*)(IQ + qrow * 256 + hh * 64 + ks * 32 + fq * 8);
    const f32x4 iw = *(const f32x4*)(SM + qrow * 16);
    const int nkt = qb + 1, slim = s0 + fr;
    __syncthreads();
    pg8::bf16x8 a0n = {0, 0, 0, 0, 0, 0, 0, 0}, a1n = a0n;
    if (wave < nkt) { const bf16_t* kr = IK + ((size_t)b * SEQ + wave * 16 + fr) * 64 + fq * 8; a0n = *(const pg8::bf16x8*)kr; a1n = *(const pg8::bf16x8*)(kr + 32); }
    for (int kt = wave; kt < nkt; kt += NWAVES) {
      const pg8::bf16x8 a0 = a0n, a1 = a1n;
      if (kt + NWAVES < nkt) { const bf16_t* kr = IK + ((size_t)b * SEQ + (kt + NWAVES) * 16 + fr) * 64 + fq * 8; a0n = *(const pg8::bf16x8*)kr; a1n = *(const pg8::bf16x8*)(kr + 32); }
      f32x4 sc = {0.f, 0.f, 0.f, 0.f};
#pragma unroll
      for (int hh = 0; hh < 4; ++hh) { f32x4 d = {0.f, 0.f, 0.f, 0.f};
        d = __builtin_amdgcn_mfma_f32_16x16x32_bf16(a0, bq[hh][0], d, 0, 0, 0); d = __builtin_amdgcn_mfma_f32_16x16x32_bf16(a1, bq[hh][1], d, 0, 0, 0);
        const float w = hh == 0 ? iw.x : hh == 1 ? iw.y : hh == 2 ? iw.z : iw.w;
        sc.x = fmaf(w, fmaxf(d.x, 0.f), sc.x); sc.y = fmaf(w, fmaxf(d.y, 0.f), sc.y); sc.z = fmaf(w, fmaxf(d.z, 0.f), sc.z); sc.w = fmaf(w, fmaxf(d.w, 0.f), sc.w); }
      unsigned k01 = mono16x2(__builtin_bit_cast(unsigned, __builtin_amdgcn_cvt_pkrtz(sc.x, sc.y))), k23 = mono16x2(__builtin_bit_cast(unsigned, __builtin_amdgcn_cvt_pkrtz(sc.z, sc.w)));
      const int kbase = kt * 16 + fq * 4;
      unsigned* hq = h1 + fr * 128;
      if (kt + 1 < nkt) {
        *(u32x2*)(keys + fr * TK_KP + kbase) = (u32x2){k01, k23};
        { const unsigned kk = k01 & 0xffffu; atomicAdd(hq + (kk >> 9), 1u << ((kk >> 4) & 16)); }
        { const unsigned kk = k01 >> 16; atomicAdd(hq + (kk >> 9), 1u << ((kk >> 4) & 16)); }
        { const unsigned kk = k23 & 0xffffu; atomicAdd(hq + (kk >> 9), 1u << ((kk >> 4) & 16)); }
        { const unsigned kk = k23 >> 16; atomicAdd(hq + (kk >> 9), 1u << ((kk >> 4) & 16)); }
      } else {
        if (kbase + 0 > slim) k01 &= 0xffff0000u; if (kbase + 1 > slim) k01 &= 0x0000ffffu;
        if (kbase + 2 > slim) k23 &= 0xffff0000u; if (kbase + 3 > slim) k23 &= 0x0000ffffu;
        *(u32x2*)(keys + fr * TK_KP + kbase) = (u32x2){k01, k23};
        if (kbase + 0 <= slim) { const unsigned kk = k01 & 0xffffu; atomicAdd(hq + (kk >> 9), 1u << ((kk >> 4) & 16)); }
        if (kbase + 1 <= slim) { const unsigned kk = k01 >> 16; atomicAdd(hq + (kk >> 9), 1u << ((kk >> 4) & 16)); }
        if (kbase + 2 <= slim) { const unsigned kk = k23 & 0xffffu; atomicAdd(hq + (kk >> 9), 1u << ((kk >> 4) & 16)); }
        if (kbase + 3 <= slim) { const unsigned kk = k23 >> 16; atomicAdd(hq + (kk >> 9), 1u << ((kk >> 4) & 16)); }
      }
    }
    __syncthreads();
    for (int qi = 0; qi < 2; ++qi) {
      const int q = wave * 2 + qi, s = s0 + q, n = s + 1;
      int B1, above1; hist_find(h1 + q * 128, 256, lane, B1, above1);
      const int need1 = 256 - above1;
      h2[lane] = 0u; h2[64 + lane] = 0u;
      const unsigned short* kq = keys + q * TK_KP;
      const int niter = (n + 511) >> 9;
      for (int it = 0; it < niter; ++it) {
        const int i0 = (it * 64 + lane) * 8; const u32x4 kv = *(const u32x4*)(kq + i0);
        const unsigned k8[8] = {kv.x & 0xffffu, kv.x >> 16, kv.y & 0xffffu, kv.y >> 16, kv.z & 0xffffu, kv.z >> 16, kv.w & 0xffffu, kv.w >> 16};
#pragma unroll
        for (int e = 0; e < 8; ++e) if (i0 + e < n && (int)(k8[e] >> 8) == B1) atomicAdd(h2 + ((k8[e] & 255u) >> 1), 1u << ((k8[e] & 1u) * 16));
      }
      int B2, above2; hist_find(h2, need1, lane, B2, above2);
      const unsigned thr = (unsigned)((B1 << 8) | B2); const int need = need1 - above2;
      unsigned short* dummy = (unsigned short*)(misc + 8 + wave);
      unsigned short* sel = (unsigned short*)h2;
      asm volatile("s_waitcnt lgkmcnt(0)" ::: "memory");
      int tiebase = 0, outbase = 0;
      for (int it = 0; it < niter; ++it) {
        const int i0 = (it * 64 + lane) * 8; const u32x4 kv = *(const u32x4*)(kq + i0);
        const unsigned k8[8] = {kv.x & 0xffffu, kv.x >> 16, kv.y & 0xffffu, kv.y >> 16, kv.z & 0xffffu, kv.z >> 16, kv.w & 0xffffu, kv.w >> 16};
        int cg = 0, ce = 0;
#pragma unroll
        for (int e = 0; e < 8; ++e) { const bool v = i0 + e < n; cg += (v && k8[e] > thr) ? 1 : 0; ce += (v && k8[e] == thr) ? 1 : 0; }
        int tk = 0;
        if (__ballot(ce != 0)) {
          const int eincl = wave_incl_scan(ce); const int eg = tiebase + eincl - ce;
          tk = need - eg; tk = tk < 0 ? 0 : (tk > ce ? ce : tk);
          tiebase += __builtin_amdgcn_readlane(eincl, 63);
        }
        const int oc = cg + tk; const int oincl = wave_incl_scan(oc);
        int pos = outbase + oincl - oc; int tleft = tk;
#pragma unroll
        for (int e = 0; e < 8; ++e) { const bool v = i0 + e < n; const bool tie = v && k8[e] == thr && tleft > 0; const bool take = (v && k8[e] > thr) || tie;
          tleft -= tie ? 1 : 0;
          unsigned short* dst = (take && pos < 256) ? sel + pos : dummy;
          *dst = (unsigned short)(i0 + e); pos += take ? 1 : 0; }
        outbase += __builtin_amdgcn_readlane(oincl, 63);
      }
      asm volatile("s_waitcnt lgkmcnt(0)" ::: "memory");
      *(u32x2*)(SEL + ((size_t)b * SEQ + s) * 256 + lane * 4) = *(const u32x2*)(sel + lane * 4);
      asm volatile("s_waitcnt lgkmcnt(0)" ::: "memory");
    }
  }
}

typedef short s16x4 __attribute__((ext_vector_type(4)));
__device__ __forceinline__ s16x4 lds_tr16(const unsigned char* p) { return __builtin_bit_cast(s16x4, __builtin_amdgcn_ds_read_tr16_b64_v4i16((__attribute__((address_space(3))) s16x4*)(__attribute__((address_space(3))) unsigned char*)p)); }
typedef float f32x2_t __attribute__((ext_vector_type(2))); typedef __bf16 bf16x2_t __attribute__((ext_vector_type(2)));
__device__ __forceinline__ unsigned cvtpk_c(float lo, float hi) { const f32x2_t v = {lo, hi}; const bf16x2_t b = __builtin_convertvector(v, bf16x2_t); return __builtin_bit_cast(unsigned, b); }
__device__ __forceinline__ pg8::bf16x8 packp(const f32x4& a, const f32x4& b) {
  const u32x4 w = {cvtpk_c(a.x, a.y), cvtpk_c(a.z, a.w), cvtpk_c(b.x, b.y), cvtpk_c(b.z, b.w)}; return __builtin_bit_cast(pg8::bf16x8, w); }
constexpr int AT_WB = 9216 + 512;
__device__ void phase_attn_sparse(const Ctx& c, unsigned char* ldsb, unsigned* qhead) {
  unsigned char* ws = c.ws;
  const int tid = phase_tid(), lane = tid & 63, wave = tid >> 6, fr = lane & 15, fq = lane >> 4;
  unsigned char* vl = ldsb + wave * AT_WB; unsigned short* sl = (unsigned short*)(vl + 9216);
  const bf16_t* QA = (const bf16_t*)(ws + WS_QA); const bf16_t* KVA = (const bf16_t*)(ws + WS_KVA); const unsigned short* SEL = (const unsigned short*)(ws + WS_SEL);
  const bf16_t* QC = (const bf16_t*)(ws + WS_QC); const bf16_t* MK = (const bf16_t*)(ws + WS_MK); const bf16_t* MVT = (const bf16_t*)(ws + WS_MVT);
  bf16_t* CAT = (bf16_t*)(ws + WS_CAT);
  const float* gA = c.in[10]; const float* gC = c.in[11];
  const pg8::bf16x8 zero8 = {0, 0, 0, 0, 0, 0, 0, 0};
  __syncthreads();
  int* aq_slot = (int*)(ldsb + 8 * AT_WB);
  WorkQ wq; wq_init(wq, qhead, aq_slot, tid);
  for (;;) {
  const int item = wq_next(wq, tid);
  if (item >= 512) break;
  for (int tj = 0; tj < 8; ++tj) {
    const int t = item * 64 + wave * 8 + tj;
    const int b = t >> 12, s = t & (SEQ - 1), n = s + 1 < 256 ? s + 1 : 256;
    { u32x2 v;
      if (s >= 256) v = *(const u32x2*)(SEL + (size_t)t * 256 + lane * 4);
      else { const int i0 = lane * 4; const unsigned e0 = i0 < n ? i0 : 0, e1 = i0 + 1 < n ? i0 + 1 : 0, e2 = i0 + 2 < n ? i0 + 2 : 0, e3 = i0 + 3 < n ? i0 + 3 : 0; v = (u32x2){e0 | (e1 << 16), e2 | (e3 << 16)}; }
      *(u32x2*)(sl + lane * 4) = v; }
    asm volatile("s_waitcnt lgkmcnt(0)" ::: "memory");
    pg8::bf16x8 bq0 = zero8, bq1 = zero8;
    if (fr < 6) { const bf16_t* qp = QA + (size_t)t * 384 + fr * 64 + fq * 8; bq0 = *(const pg8::bf16x8*)qp; bq1 = *(const pg8::bf16x8*)(qp + 32); }
    const bf16_t* kvb = KVA + (size_t)b * SEQ * 128;
    f32x4 st[16];
#pragma unroll
    for (int kt = 0; kt < 16; ++kt) { const int key = sl[kt * 16 + fr]; const bf16_t* kr = kvb + (size_t)key * 128 + fq * 8;
      const pg8::bf16x8 a0 = *(const pg8::bf16x8*)kr, a1 = *(const pg8::bf16x8*)(kr + 32);
      f32x4 d = {0.f, 0.f, 0.f, 0.f};
      d = __builtin_amdgcn_mfma_f32_16x16x32_bf16(a0, bq0, d, 0, 0, 0); st[kt] = __builtin_amdgcn_mfma_f32_16x16x32_bf16(a1, bq1, d, 0, 0, 0); }
    u32x4 vva[8], vvb[8];
#pragma unroll
    for (int i = 0; i < 8; ++i) { const int key = sl[i * 8 + (lane >> 3)]; vva[i] = *(const u32x4*)(kvb + (size_t)key * 128 + 64 + (lane & 7) * 8); }
    float mx = -3.0e38f;
    if (n < 256) {
#pragma unroll
      for (int kt = 0; kt < 16; ++kt) { const int sb = kt * 16 + fq * 4;
        if (sb + 0 >= n) st[kt].x = -3.0e38f; if (sb + 1 >= n) st[kt].y = -3.0e38f; if (sb + 2 >= n) st[kt].z = -3.0e38f; if (sb + 3 >= n) st[kt].w = -3.0e38f; } }
#pragma unroll
    for (int kt = 0; kt < 16; ++kt) mx = fmaxf(fmaxf(fmaxf(mx, st[kt].x), fmaxf(st[kt].y, st[kt].z)), st[kt].w);
    mx = fmaxf(mx, __shfl_xor(mx, 16)); mx = fmaxf(mx, __shfl_xor(mx, 32));
    float l = 0.f;
#pragma unroll
    for (int kt = 0; kt < 16; ++kt) { st[kt].x = __builtin_amdgcn_exp2f(st[kt].x - mx); st[kt].y = __builtin_amdgcn_exp2f(st[kt].y - mx); st[kt].z = __builtin_amdgcn_exp2f(st[kt].z - mx); st[kt].w = __builtin_amdgcn_exp2f(st[kt].w - mx);
      l += (st[kt].x + st[kt].y) + (st[kt].z + st[kt].w); }
    l += __shfl_xor(l, 16); l += __shfl_xor(l, 32);
    f32x4 ot[4];
#pragma unroll
    for (int mt = 0; mt < 4; ++mt) ot[mt] = (f32x4){0.f, 0.f, 0.f, 0.f};
#define VLOAD(R, CH) do { _Pragma("unroll") for (int i_ = 0; i_ < 8; ++i_) { const int key_ = sl[(CH) * 64 + i_ * 8 + (lane >> 3)]; R[i_] = *(const u32x4*)(kvb + (size_t)key_ * 128 + 64 + (lane & 7) * 8); } } while (0)
#define VSTORE(R) do { _Pragma("unroll") for (int i_ = 0; i_ < 8; ++i_) *(u32x4*)(vl + (i_ * 8 + (lane >> 3)) * 144 + (lane & 7) * 16) = R[i_]; } while (0)
#define VPROC(CH) do { asm volatile("s_waitcnt lgkmcnt(0)" ::: "memory"); \
      _Pragma("unroll") for (int k2 = 0; k2 < 2; ++k2) { const int kk = (CH) * 2 + k2; const pg8::bf16x8 pf = pfr[kk]; \
        const unsigned char* base = vl + (k2 * 32 + fq * 4 + (fr >> 2)) * 144 + (fr & 3) * 8; \
        _Pragma("unroll") for (int mt = 0; mt < 4; ++mt) { const s16x4 lo = lds_tr16(base + mt * 32), hi = lds_tr16(base + 16 * 144 + mt * 32); \
          const pg8::bf16x8 af = {lo[0], lo[1], lo[2], lo[3], hi[0], hi[1], hi[2], hi[3]}; \
          ot[mt] = __builtin_amdgcn_mfma_f32_16x16x32_bf16(af, pf, ot[mt], 0, 0, 0); } } \
      asm volatile("s_waitcnt lgkmcnt(0)" ::: "memory"); } while (0)
    pg8::bf16x8 pfr[8];
#pragma unroll
    for (int kk = 0; kk < 8; ++kk) pfr[kk] = packp(st[2 * kk], st[2 * kk + 1]);
    asm volatile("" ::: "memory");
#pragma unroll
    for (int i = 0; i < 8; ++i) { const int key = sl[64 + i * 8 + (lane >> 3)]; vvb[i] = *(const u32x4*)(kvb + (size_t)key * 128 + 64 + (lane & 7) * 8); }
    VSTORE(vva); VLOAD(vva, 2); VPROC(0);
    VSTORE(vvb); VLOAD(vvb, 3); VPROC(1);
    VSTORE(vva); VPROC(2);
    VSTORE(vvb); VPROC(3);
#undef VLOAD
#undef VSTORE
#undef VPROC
    const float il = __builtin_amdgcn_rcpf(l); float ss = 0.f;
#pragma unroll
    for (int mt = 0; mt < 4; ++mt) { ot[mt] = ot[mt] * il; ss += (ot[mt].x * ot[mt].x + ot[mt].y * ot[mt].y) + (ot[mt].z * ot[mt].z + ot[mt].w * ot[mt].w); }
    if (fr >= 6) ss = 0.f;
#pragma unroll
    for (int o = 1; o < 64; o <<= 1) ss += __shfl_xor(ss, o);
    const float rstd = rsqrtf(ss * (1.f / 384.f) + 1e-6f);
    if (fr < 6) {
#pragma unroll
      for (int mt = 0; mt < 4; ++mt) { const int col = fr * 64 + mt * 16 + fq * 4; const f32x4 g = *(const f32x4*)(gA + col); const f32x4 o = ot[mt] * rstd * g;
        *(u32x2*)(CAT + (size_t)t * 1024 + col) = (u32x2){pg8::cvt_pk_bf16(o.x, o.y), pg8::cvt_pk_bf16(o.z, o.w)}; } }
  }
  }
}

__device__ void phase_attn_mem(const Ctx& c, unsigned char* ldsb, unsigned* qhead) {
  unsigned char* ws = c.ws;
  const int tid = phase_tid(), lane = tid & 63, wave = tid >> 6, fr = lane & 15, fq = lane >> 4;
  unsigned char* vl = ldsb + wave * AT_WB; unsigned short* sl = (unsigned short*)(vl + 9216);
  const bf16_t* QA = (const bf16_t*)(ws + WS_QA); const bf16_t* KVA = (const bf16_t*)(ws + WS_KVA); const unsigned short* SEL = (const unsigned short*)(ws + WS_SEL);
  const bf16_t* QC = (const bf16_t*)(ws + WS_QC); const bf16_t* MK = (const bf16_t*)(ws + WS_MK); const bf16_t* MVT = (const bf16_t*)(ws + WS_MVT);
  bf16_t* CAT = (bf16_t*)(ws + WS_CAT);
  const float* gA = c.in[10]; const float* gC = c.in[11];
  const pg8::bf16x8 zero8 = {0, 0, 0, 0, 0, 0, 0, 0};
  int* aq_slot = (int*)(ldsb + 70656 + 8 * 8192);
  WorkQ wq; wq_init(wq, qhead, aq_slot, tid);
  for (;;) {
  const int item = wq_next(wq, tid) + 512;
  if (item >= 768) break;
  {
    const int t0 = (item - 512) * 128 + wave * 16, b = t0 >> 12;
    unsigned char* mkl = ldsb; unsigned char* mvl = ldsb + 36864; unsigned char* ocl = ldsb + 70656 + wave * 8192;
    float ss = 0.f;
#pragma unroll 1
    for (int h = 0; h < 4; ++h) {
      __syncthreads();
#pragma unroll
      for (int i = 0; i < 4; ++i) { const int p = tid + 512 * i, row = p >> 3, cc = p & 7;
        *(u32x4*)(mkl + row * 144 + cc * 16) = *(const u32x4*)(MK + ((size_t)(b * 256 + row)) * 256 + h * 64 + cc * 8); }
#pragma unroll
      for (int i = 0; i < 4; ++i) { const int p = tid + 512 * i, row = p >> 5, cc = p & 31;
        *(u32x4*)(mvl + row * 528 + cc * 16) = *(const u32x4*)(MVT + ((size_t)(b * 256 + h * 64 + row)) * 256 + cc * 8); }
      __syncthreads();
      f32x4 oc[4];
      const bf16_t* qp = QC + (size_t)(t0 + fr) * 256 + h * 64 + fq * 8;
      const pg8::bf16x8 bq0 = *(const pg8::bf16x8*)qp, bq1 = *(const pg8::bf16x8*)(qp + 32);
      f32x4 st[16];
#pragma unroll
      for (int kt = 0; kt < 16; ++kt) { const unsigned char* kr = mkl + (kt * 16 + fr) * 144 + fq * 16;
        const pg8::bf16x8 a0 = *(const pg8::bf16x8*)kr, a1 = *(const pg8::bf16x8*)(kr + 64);
        f32x4 d = {0.f, 0.f, 0.f, 0.f};
        d = __builtin_amdgcn_mfma_f32_16x16x32_bf16(a0, bq0, d, 0, 0, 0); st[kt] = __builtin_amdgcn_mfma_f32_16x16x32_bf16(a1, bq1, d, 0, 0, 0); }
      float mx = -3.0e38f;
#pragma unroll
      for (int kt = 0; kt < 16; ++kt) mx = fmaxf(fmaxf(fmaxf(mx, st[kt].x), fmaxf(st[kt].y, st[kt].z)), st[kt].w);
      mx = fmaxf(mx, __shfl_xor(mx, 16)); mx = fmaxf(mx, __shfl_xor(mx, 32));
      float l = 0.f;
#pragma unroll
      for (int kt = 0; kt < 16; ++kt) { st[kt].x = __builtin_amdgcn_exp2f(st[kt].x - mx); st[kt].y = __builtin_amdgcn_exp2f(st[kt].y - mx); st[kt].z = __builtin_amdgcn_exp2f(st[kt].z - mx); st[kt].w = __builtin_amdgcn_exp2f(st[kt].w - mx);
        l += (st[kt].x + st[kt].y) + (st[kt].z + st[kt].w); }
      l += __shfl_xor(l, 16); l += __shfl_xor(l, 32);
#pragma unroll
      for (int mt = 0; mt < 4; ++mt) oc[mt] = (f32x4){0.f, 0.f, 0.f, 0.f};
#pragma unroll
      for (int kk = 0; kk < 8; ++kk) { const pg8::bf16x8 pf = packp(st[2 * kk], st[2 * kk + 1]);
#pragma unroll
        for (int mt = 0; mt < 4; ++mt) { const pg8::bf16x8 af = *(const pg8::bf16x8*)(mvl + (mt * 16 + fr) * 528 + (kk * 4 + fq) * 16);
          oc[mt] = __builtin_amdgcn_mfma_f32_16x16x32_bf16(af, pf, oc[mt], 0, 0, 0); } }
      const float il = __builtin_amdgcn_rcpf(l);
#pragma unroll
      for (int mt = 0; mt < 4; ++mt) { const f32x4 o = oc[mt] * il; ss += (o.x * o.x + o.y * o.y) + (o.z * o.z + o.w * o.w); *(u32x2*)(ocl + ((h * 4 + mt) * 64 + lane) * 8) = (u32x2){pg8::cvt_pk_bf16(o.x, o.y), pg8::cvt_pk_bf16(o.z, o.w)}; }
    }
    ss += __shfl_xor(ss, 16); ss += __shfl_xor(ss, 32);
    const float rstd = rsqrtf(ss * (1.f / 256.f) + 1e-6f);
#pragma unroll 1
    for (int h = 0; h < 4; ++h)
#pragma unroll
      for (int mt = 0; mt < 4; ++mt) { const int col = h * 64 + mt * 16 + fq * 4; const f32x4 g = *(const f32x4*)(gC + col); const u32x2 pp = *(const u32x2*)(ocl + ((h * 4 + mt) * 64 + lane) * 8);
        const f32x4 ov = {__uint_as_float(pp.x << 16), __uint_as_float(pp.x & 0xffff0000u), __uint_as_float(pp.y << 16), __uint_as_float(pp.y & 0xffff0000u)}; const f32x4 o = ov * rstd * g;
        *(u32x2*)(CAT + (size_t)(t0 + fr) * 1024 + 768 + col) = (u32x2){pg8::cvt_pk_bf16(o.x, o.y), pg8::cvt_pk_bf16(o.z, o.w)}; }
  }
  }
}

constexpr int GD_ITEM = 41088;
__device__ __forceinline__ unsigned char* gd_item(unsigned char* ws, int it) { return it < 1536 ? ws + WS_XB + (size_t)it * GD_ITEM : ws + WS_X1B + (size_t)(it - 1536) * GD_ITEM; }
__device__ __forceinline__ int kperm(int x) { return (x & 32) | (((x >> 2) & 3) << 3) | (x & 3) | (((x >> 4) & 1) << 2); }
constexpr int GP_KB = 0, GP_KBB = 9216, GP_QB = 18432, GP_VBT = 27648, GP_KBET = 36864, GP_XR = 46080  , GP_PR = 82944  , GP_OUT = 101376, GP_SC = 142336;
__device__ __forceinline__ pg8::bf16x8 ldsfrag(const unsigned char* base, int row, int ks, int fq) { return *(const pg8::bf16x8*)(base + row * 144 + ks * 64 + fq * 16); }
constexpr int G2_KB = 0, G2_KBB = 9216, G2_QB = 18432, G2_XR0 = 27648, G2_XT0 = 36864, G2_PR0 = 46080, G2_VBT = 55296, G2_KBET = 64512, G2_SC = 73728, G2_CW = 75264, G2_HALF = 78336;
__device__ void phase_gdn_prep2(const Ctx& c, unsigned char* Lb) {
  unsigned char* ws = c.ws;
  const int tid = phase_tid(), lane = tid & 63, wave = tid >> 6, fr = lane & 15, fq = lane >> 4;
  const int hb = wave >> 2, w4 = wave & 3, htid = tid & 255;
  unsigned char* L = Lb + hb * G2_HALF;
  const bf16_t* GB = (const bf16_t*)(ws + WS_GB); const float* SM = (const float*)(ws + WS_SM);
  const float* convw = c.in[6];
  float* sc = (float*)(L + G2_SC);
  float* cw = (float*)(L + G2_CW);
  const int tt = htid >> 2, part = htid & 3;
  for (int it2 = blockIdx.x; it2 < 1536; it2 += gridDim.x) {
    const int it = it2 * 2 + hb;
    const int n = it & 63, bh = it >> 6, b = bh / 6, h = bh % 6;
    const int t = n * 64 + tt; const size_t r = (size_t)b * SEQ + t;
    unsigned char* gb = gd_item(ws, it);
    __syncthreads();
    for (int i = htid; i < 768; i += 256) { const int j = i / 192, rr = i % 192; cw[i] = convw[j * 1152 + (rr >> 6) * 384 + h * 64 + (rr & 63)]; }
    if (part == 0) { const float a = SM[r * 16 + 4 + h], bb = SM[r * 16 + 10 + h]; const float xs = a + c.in[8][h]; const float sp = xs > 20.f ? xs : log1pf(__expf(xs));
      sc[tt] = -__expf(c.in[7][h]) * sp; sc[192 + tt] = 1.f / (1.f + __expf(-bb)); }
    __syncthreads();
    if (w4 == 0) { float v = sc[lane];
#pragma unroll
      for (int o = 1; o < 64; o <<= 1) { const float u = __shfl_up(v, o); if (lane >= o) v += u; }
      const float last = __shfl(v, 63);
      sc[64 + lane] = v; sc[128 + lane] = __expf(v); sc[256 + lane] = __expf(last - v); if (lane == 0) { sc[320] = __expf(last); *(float*)(gb + 40960) = __expf(last); } }
    float qv[16], kv[16], vv[16];
#pragma unroll
    for (int role = 0; role < 3; ++role) {
      float acc[16];
#pragma unroll
      for (int e = 0; e < 16; ++e) acc[e] = 0.f;
      u32x4 xr[4][2];
#pragma unroll
      for (int j = 0; j < 4; ++j) { const bool ok = t - 3 + j >= 0; const bf16_t* xp = GB + (r - 3 + j) * 1536 + role * 384 + h * 64 + part * 16;
        xr[j][0] = ok ? *(const u32x4*)xp : (u32x4){0u, 0u, 0u, 0u}; xr[j][1] = ok ? *(const u32x4*)(xp + 8) : (u32x4){0u, 0u, 0u, 0u}; }
#pragma unroll
      for (int j = 0; j < 4; ++j)
#pragma unroll
        for (int hh = 0; hh < 2; ++hh) { const u32x4 xvv = xr[j][hh]; const float* wj = cw + j * 192 + role * 64 + part * 16 + hh * 8;
          const f32x4 w0 = *(const f32x4*)wj, w1 = *(const f32x4*)(wj + 4);
          acc[hh * 8 + 0] += w0.x * __uint_as_float(xvv.x << 16); acc[hh * 8 + 1] += w0.y * __uint_as_float(xvv.x & 0xffff0000u); acc[hh * 8 + 2] += w0.z * __uint_as_float(xvv.y << 16); acc[hh * 8 + 3] += w0.w * __uint_as_float(xvv.y & 0xffff0000u);
          acc[hh * 8 + 4] += w1.x * __uint_as_float(xvv.z << 16); acc[hh * 8 + 5] += w1.y * __uint_as_float(xvv.z & 0xffff0000u); acc[hh * 8 + 6] += w1.z * __uint_as_float(xvv.w << 16); acc[hh * 8 + 7] += w1.w * __uint_as_float(xvv.w & 0xffff0000u); }
      float ss = 0.f;
#pragma unroll
      for (int e = 0; e < 16; ++e) { acc[e] = silu_f(acc[e]); ss += acc[e] * acc[e]; }
      if (role < 2) { ss += __shfl_xor(ss, 1); ss += __shfl_xor(ss, 2); const float scl = rsqrtf(ss + 1e-6f) * (role == 0 ? 0.125f : 1.f);
#pragma unroll
        for (int e = 0; e < 16; ++e) acc[e] *= scl; }
#pragma unroll
      for (int e = 0; e < 16; ++e) { if (role == 0) qv[e] = acc[e]; else if (role == 1) kv[e] = acc[e]; else vv[e] = acc[e]; }
    }
    __syncthreads();
    { const float beta = sc[192 + tt], eg = sc[128 + tt], ekl = sc[256 + tt];
      float kb[16];
#pragma unroll
      for (int e = 0; e < 16; ++e) kb[e] = kv[e] * beta;
#pragma unroll
      for (int hh = 0; hh < 2; ++hh) { const int o8 = hh * 8;
        *(u32x4*)(L + G2_KB + tt * 144 + part * 32 + hh * 16) = (u32x4){pk2(kv[o8], kv[o8 + 1]), pk2(kv[o8 + 2], kv[o8 + 3]), pk2(kv[o8 + 4], kv[o8 + 5]), pk2(kv[o8 + 6], kv[o8 + 7])};
        *(u32x4*)(L + G2_KBB + tt * 144 + part * 32 + hh * 16) = (u32x4){pk2(kb[o8], kb[o8 + 1]), pk2(kb[o8 + 2], kb[o8 + 3]), pk2(kb[o8 + 4], kb[o8 + 5]), pk2(kb[o8 + 6], kb[o8 + 7])};
        *(u32x4*)(L + G2_QB + tt * 144 + part * 32 + hh * 16) = (u32x4){pk2(qv[o8], qv[o8 + 1]), pk2(qv[o8 + 2], qv[o8 + 3]), pk2(qv[o8 + 4], qv[o8 + 5]), pk2(qv[o8 + 6], qv[o8 + 7])}; }
      const int ptt = kperm(tt);
#pragma unroll
      for (int e = 0; e < 16; ++e) { const int d = part * 16 + e;
        *(bf16_t*)(L + G2_VBT + d * 144 + tt * 2) = f2bf(vv[e] * beta);
        *(bf16_t*)(L + G2_KBET + d * 144 + tt * 2) = f2bf(kb[e] * eg);
        *(bf16_t*)(gb + 8192 + tt * 128 + kperm(d) * 2) = f2bf(qv[e] * eg);
        *(bf16_t*)(gb + 3 * 8192 + d * 128 + ptt * 2) = f2bf(kv[e] * ekl); } }
    __syncthreads();
    const int rowb = (w4 * 16 + fq * 4) * 144 + fr * 2;
    const int colb = fr * 144 + (w4 * 16 + fq * 4) * 2;
    const int fa = (w4 * 16 + fr) * 144 + fq * 16;
    const int fb = fr * 144 + fq * 16;
    const int i0 = w4 * 16 + fq * 4;
#define G2F(buf, off) (*(const pg8::bf16x8*)(L + (buf) + (off)))
#define G2W16(buf, off, v) (*(bf16_t*)(L + (buf) + (off)) = f2bf(v))
    f32x4 Pt[4];
    { const float gi0 = sc[64 + i0], gi1 = sc[64 + i0 + 1], gi2 = sc[64 + i0 + 2], gi3 = sc[64 + i0 + 3];
#pragma unroll
    for (int u = 0; u < 4; ++u) {
      f32x4 dl = {0.f, 0.f, 0.f, 0.f}, da = {0.f, 0.f, 0.f, 0.f};
#pragma unroll
      for (int ks = 0; ks < 2; ++ks) { const pg8::bf16x8 bk = G2F(G2_KB, fb + u * 2304 + ks * 64);
        dl = __builtin_amdgcn_mfma_f32_16x16x32_bf16(G2F(G2_KBB, fa + ks * 64), bk, dl, 0, 0, 0);
        da = __builtin_amdgcn_mfma_f32_16x16x32_bf16(G2F(G2_QB, fa + ks * 64), bk, da, 0, 0, 0); }
      const int j = u * 16 + fr; const float gj = sc[64 + j]; const int pj = kperm(j);
      const float dec0 = __expf(fminf(gi0 - gj, 0.f)), dec1 = __expf(fminf(gi1 - gj, 0.f)), dec2 = __expf(fminf(gi2 - gj, 0.f)), dec3 = __expf(fminf(gi3 - gj, 0.f));
      const float l0 = i0 + 0 > j ? dl.x * dec0 : 0.f, l1 = i0 + 1 > j ? dl.y * dec1 : 0.f, l2 = i0 + 2 > j ? dl.z * dec2 : 0.f, l3 = i0 + 3 > j ? dl.w * dec3 : 0.f;
      const float a0 = i0 + 0 >= j ? da.x * dec0 : 0.f, a1 = i0 + 1 >= j ? da.y * dec1 : 0.f, a2 = i0 + 2 >= j ? da.z * dec2 : 0.f, a3 = i0 + 3 >= j ? da.w * dec3 : 0.f;
      const f32x4 pv = {(i0 + 0 == j ? 1.f : 0.f) - l0, (i0 + 1 == j ? 1.f : 0.f) - l1, (i0 + 2 == j ? 1.f : 0.f) - l2, (i0 + 3 == j ? 1.f : 0.f) - l3};
      G2W16(G2_XR0, rowb + u * 32, l0); G2W16(G2_XR0, rowb + 144 + u * 32, l1); G2W16(G2_XR0, rowb + 288 + u * 32, l2); G2W16(G2_XR0, rowb + 432 + u * 32, l3);
      G2W16(G2_PR0, rowb + u * 32, pv.x); G2W16(G2_PR0, rowb + 144 + u * 32, pv.y); G2W16(G2_PR0, rowb + 288 + u * 32, pv.z); G2W16(G2_PR0, rowb + 432 + u * 32, pv.w);
      *(u32x2*)(L + G2_XT0 + colb + u * 2304) = (u32x2){pk2(l0, l1), pk2(l2, l3)};
      bf16_t* am = (bf16_t*)(gb + 2 * 8192 + i0 * 128 + pj * 2);
      am[0] = f2bf(a0); am[64] = f2bf(a1); am[128] = f2bf(a2); am[192] = f2bf(a3);
      Pt[u] = pv; } }
    __syncthreads();
#pragma unroll
    for (int u = 0; u < 4; ++u) {
      f32x4 d = {0.f, 0.f, 0.f, 0.f};
#pragma unroll
      for (int ks = 0; ks < 2; ++ks) d = __builtin_amdgcn_mfma_f32_16x16x32_bf16(G2F(G2_XR0, fa + ks * 64), G2F(G2_XT0, fb + u * 2304 + ks * 64), d, 0, 0, 0);
      G2W16(G2_KB, rowb + u * 32, d.x); G2W16(G2_KB, rowb + 144 + u * 32, d.y); G2W16(G2_KB, rowb + 288 + u * 32, d.z); G2W16(G2_KB, rowb + 432 + u * 32, d.w);
      *(u32x2*)(L + G2_KBB + colb + u * 2304) = (u32x2){pk2(d.x, d.y), pk2(d.z, d.w)}; }
    __syncthreads();
#pragma unroll
    for (int itn = 0; itn < 4; ++itn) {
      const int XRc = (itn & 1) ? G2_XR0 : G2_KB, XTc = (itn & 1) ? G2_XT0 : G2_KBB, XRn = (itn & 1) ? G2_KB : G2_XR0, XTn = (itn & 1) ? G2_KBB : G2_XT0;
      const int PRc = (itn & 1) ? G2_QB : G2_PR0, PRn = (itn & 1) ? G2_PR0 : G2_QB;
#pragma unroll
      for (int u = 0; u < 4; ++u) {
        f32x4 d = {0.f, 0.f, 0.f, 0.f};
#pragma unroll
        for (int ks = 0; ks < 2; ++ks) { const pg8::bf16x8 bx = G2F(XTc, fb + u * 2304 + ks * 64);
          Pt[u] = __builtin_amdgcn_mfma_f32_16x16x32_bf16(G2F(PRc, fa + ks * 64), bx, Pt[u], 0, 0, 0);
          if (itn < 3) d = __builtin_amdgcn_mfma_f32_16x16x32_bf16(G2F(XRc, fa + ks * 64), bx, d, 0, 0, 0); }
        G2W16(PRn, rowb + u * 32, Pt[u].x); G2W16(PRn, rowb + 144 + u * 32, Pt[u].y); G2W16(PRn, rowb + 288 + u * 32, Pt[u].z); G2W16(PRn, rowb + 432 + u * 32, Pt[u].w);
        if (itn < 3) { G2W16(XRn, rowb + u * 32, d.x); G2W16(XRn, rowb + 144 + u * 32, d.y); G2W16(XRn, rowb + 288 + u * 32, d.z); G2W16(XRn, rowb + 432 + u * 32, d.w);
          *(u32x2*)(L + XTn + colb + u * 2304) = (u32x2){pk2(d.x, d.y), pk2(d.z, d.w)}; } }
      __syncthreads();
    }
#pragma unroll
    for (int u = 0; u < 4; ++u) {
      f32x4 du = {0.f, 0.f, 0.f, 0.f}, dw = {0.f, 0.f, 0.f, 0.f};
#pragma unroll
      for (int ks = 0; ks < 2; ++ks) { const pg8::bf16x8 a = G2F(G2_PR0, fa + ks * 64);
        du = __builtin_amdgcn_mfma_f32_16x16x32_bf16(a, G2F(G2_VBT, fb + u * 2304 + ks * 64), du, 0, 0, 0);
        dw = __builtin_amdgcn_mfma_f32_16x16x32_bf16(a, G2F(G2_KBET, fb + u * 2304 + ks * 64), dw, 0, 0, 0); }
      const int j = u * 16 + fr, pj = kperm(j);
      *(u32x2*)(gb + 4 * 8192 + j * 128 + i0 * 2) = (u32x2){pk2(du.x, du.y), pk2(du.z, du.w)};
      bf16_t* wn = (bf16_t*)(gb + i0 * 128 + pj * 2);
      wn[0] = f2bf(-dw.x); wn[64] = f2bf(-dw.y); wn[128] = f2bf(-dw.z); wn[192] = f2bf(-dw.w); }
#undef G2F
#undef G2W16
  }
}

constexpr int GS_SLOT = 46208, GS_OB = 2 * GS_SLOT;
__device__ void phase_gdn_scan(const Ctx& c, unsigned char* L, int item) {
  unsigned char* ws = c.ws;
  const int tid = phase_tid(), lane = tid & 63, wave = tid >> 6, fr = lane & 15, fq = lane >> 4;
  const int b = item / 6, h = item % 6;
  const bf16_t* GB = (const bf16_t*)(ws + WS_GB); bf16_t* CAT = (bf16_t*)(ws + WS_CAT); const float* gng = c.in[9];
  const int lt = tid - 256;
  u32x4 ra[10]; float gla = 0.f;
  f32x4 S[4];
#pragma unroll
  for (int i = 0; i < 4; ++i) S[i] = (f32x4){0.f, 0.f, 0.f, 0.f};
#define GS_LOAD(R, G, n) do { if ((n) < 64) { const unsigned char* gb_ = gd_item(ws, item * 64 + (n)); _Pragma("unroll") for (int i_ = 0; i_ < 10; ++i_) R[i_] = *(const u32x4*)(gb_ + (size_t)(lt + 256 * i_) * 16); if (lt == 0) G = *(const float*)(gb_ + 40960); } } while (0)
#define GS_STORE(R, G, slot) do { _Pragma("unroll") for (int i_ = 0; i_ < 10; ++i_) { const int p_ = lt + 256 * i_; *(u32x4*)(L + (slot) * GS_SLOT + (p_ >> 9) * 9216 + ((p_ >> 3) & 63) * 144 + (p_ & 7) * 16) = R[i_]; } if (lt == 0) *(float*)(L + (slot) * GS_SLOT + 46080) = G; } while (0)
  auto post = [&](int k) {
    const unsigned char* ob = L + GS_OB + (k & 1) * 9216; const int tk = lt >> 2, part = lt & 3; const size_t r = (size_t)b * SEQ + k * 64 + tk;
    const u32x4 o0 = *(const u32x4*)(ob + tk * 144 + part * 32), o1 = *(const u32x4*)(ob + tk * 144 + part * 32 + 16);
    float ov[16] = {__uint_as_float(o0.x << 16), __uint_as_float(o0.x & 0xffff0000u), __uint_as_float(o0.y << 16), __uint_as_float(o0.y & 0xffff0000u), __uint_as_float(o0.z << 16), __uint_as_float(o0.z & 0xffff0000u), __uint_as_float(o0.w << 16), __uint_as_float(o0.w & 0xffff0000u),
                    __uint_as_float(o1.x << 16), __uint_as_float(o1.x & 0xffff0000u), __uint_as_float(o1.y << 16), __uint_as_float(o1.y & 0xffff0000u), __uint_as_float(o1.z << 16), __uint_as_float(o1.z & 0xffff0000u), __uint_as_float(o1.w << 16), __uint_as_float(o1.w & 0xffff0000u)};
    float ss = 0.f;
#pragma unroll
    for (int e = 0; e < 16; ++e) ss += ov[e] * ov[e];
    ss += __shfl_xor(ss, 1); ss += __shfl_xor(ss, 2);
    const float rstd = rsqrtf(ss * (1.f / 64.f) + 1e-6f);
    const u32x4 z0 = *(const u32x4*)(GB + r * 1536 + 1152 + h * 64 + part * 16), z1 = *(const u32x4*)(GB + r * 1536 + 1152 + h * 64 + part * 16 + 8);
    const float zf[16] = {__uint_as_float(z0.x << 16), __uint_as_float(z0.x & 0xffff0000u), __uint_as_float(z0.y << 16), __uint_as_float(z0.y & 0xffff0000u), __uint_as_float(z0.z << 16), __uint_as_float(z0.z & 0xffff0000u), __uint_as_float(z0.w << 16), __uint_as_float(z0.w & 0xffff0000u),
                          __uint_as_float(z1.x << 16), __uint_as_float(z1.x & 0xffff0000u), __uint_as_float(z1.y << 16), __uint_as_float(z1.y & 0xffff0000u), __uint_as_float(z1.z << 16), __uint_as_float(z1.z & 0xffff0000u), __uint_as_float(z1.w << 16), __uint_as_float(z1.w & 0xffff0000u)};
#pragma unroll
    for (int e = 0; e < 16; ++e) ov[e] = ov[e] * rstd * gng[part * 16 + e] * silu_f(zf[e]);
    bf16_t* op = CAT + r * 1024 + 384 + h * 64 + part * 16;
    *(u32x4*)op = (u32x4){pk2(ov[0], ov[1]), pk2(ov[2], ov[3]), pk2(ov[4], ov[5]), pk2(ov[6], ov[7])};
    *(u32x4*)(op + 8) = (u32x4){pk2(ov[8], ov[9]), pk2(ov[10], ov[11]), pk2(ov[12], ov[13]), pk2(ov[14], ov[15])};
  };
  auto step = [&](int k) {
    const unsigned char* sb = L + (k & 1) * GS_SLOT; const float gl = *(const float*)(sb + 46080);
    const pg8::bf16x8 Sb0 = packp(S[0], S[1]), Sb1 = packp(S[2], S[3]);
    f32x4 vn[4], o[4];
#pragma unroll
    for (int mt = 0; mt < 4; ++mt) { const u32x2 uv = *(const u32x2*)(sb + 4 * 9216 + (wave * 16 + fr) * 144 + (mt * 16 + fq * 4) * 2);
      f32x4 a = {__uint_as_float(uv.x << 16), __uint_as_float(uv.x & 0xffff0000u), __uint_as_float(uv.y << 16), __uint_as_float(uv.y & 0xffff0000u)};
      a = __builtin_amdgcn_mfma_f32_16x16x32_bf16(ldsfrag(sb, mt * 16 + fr, 0, fq), Sb0, a, 0, 0, 0);
      vn[mt] = __builtin_amdgcn_mfma_f32_16x16x32_bf16(ldsfrag(sb, mt * 16 + fr, 1, fq), Sb1, a, 0, 0, 0);
      f32x4 q = {0.f, 0.f, 0.f, 0.f};
      q = __builtin_amdgcn_mfma_f32_16x16x32_bf16(ldsfrag(sb + 9216, mt * 16 + fr, 0, fq), Sb0, q, 0, 0, 0);
      o[mt] = __builtin_amdgcn_mfma_f32_16x16x32_bf16(ldsfrag(sb + 9216, mt * 16 + fr, 1, fq), Sb1, q, 0, 0, 0); }
    const pg8::bf16x8 Vb0 = packp(vn[0], vn[1]), Vb1 = packp(vn[2], vn[3]);
#pragma unroll
    for (int mt = 0; mt < 4; ++mt) { o[mt] = __builtin_amdgcn_mfma_f32_16x16x32_bf16(ldsfrag(sb + 2 * 9216, mt * 16 + fr, 0, fq), Vb0, o[mt], 0, 0, 0);
      o[mt] = __builtin_amdgcn_mfma_f32_16x16x32_bf16(ldsfrag(sb + 2 * 9216, mt * 16 + fr, 1, fq), Vb1, o[mt], 0, 0, 0); }
#pragma unroll
    for (int kt = 0; kt < 4; ++kt) { f32x4 sv = S[kt] * gl;
      sv = __builtin_amdgcn_mfma_f32_16x16x32_bf16(ldsfrag(sb + 3 * 9216, kt * 16 + fr, 0, fq), Vb0, sv, 0, 0, 0);
      S[kt] = __builtin_amdgcn_mfma_f32_16x16x32_bf16(ldsfrag(sb + 3 * 9216, kt * 16 + fr, 1, fq), Vb1, sv, 0, 0, 0); }
    unsigned char* ob = L + GS_OB + (k & 1) * 9216 + (wave * 16 + fr) * 2;
#pragma unroll
    for (int mt = 0; mt < 4; ++mt) { const int t0 = mt * 16 + fq * 4;
      *(bf16_t*)(ob + (t0 + 0) * 144) = f2bf(o[mt].x); *(bf16_t*)(ob + (t0 + 1) * 144) = f2bf(o[mt].y); *(bf16_t*)(ob + (t0 + 2) * 144) = f2bf(o[mt].z); *(bf16_t*)(ob + (t0 + 3) * 144) = f2bf(o[mt].w); }
  };
  __syncthreads();
  if (wave >= 4) { GS_LOAD(ra, gla, 0); GS_STORE(ra, gla, 0); GS_LOAD(ra, gla, 1); }
  __syncthreads();
#pragma unroll 1
  for (int k = 0; k < 64; ++k) {
    if (wave < 4) step(k); else { if (k + 1 < 64) GS_STORE(ra, gla, (k + 1) & 1); GS_LOAD(ra, gla, k + 2); if (k > 0) post(k - 1); }
    __syncthreads();
  }
  if (wave >= 4) post(63);
#undef GS_LOAD
#undef GS_STORE
}

__device__ __forceinline__ f32x4 bf4(u32x2 p) { return (f32x4){__uint_as_float(p.x << 16), __uint_as_float(p.x & 0xffff0000u), __uint_as_float(p.y << 16), __uint_as_float(p.y & 0xffff0000u)}; }
__device__ void phase_router(const Ctx& c, unsigned char* ldsb) {
  unsigned char* ws = c.ws;
  const int tid = phase_tid(), lane = tid & 63, wave = tid >> 6, fr = lane & 15, fq = lane >> 4;
  float* lg = (float*)(ldsb + wave * 5632);
  const float* bg = c.in[17]; const float* br = c.in[19]; const float* g1 = c.in[14]; const float* b1 = c.in[15];
  const bf16_t* WR = (const bf16_t*)(ws + WS_WR); bf16_t* X1B = (bf16_t*)(ws + WS_X1B);
  unsigned* ctl = (unsigned*)(ws + WS_CTL);
  unsigned* LIST = (unsigned*)(ws + WS_LIST); float* GATEL = (float*)(ws + WS_GATEL); unsigned* TSLOT = (unsigned*)(ws + WS_TSLOT);
  unsigned* cntl = (unsigned*)(ldsb + 46080); unsigned* basel = cntl + 64;
  __syncthreads();
  if (tid < 64) cntl[tid] = 0u;
  __syncthreads();
  for (int tile = blockIdx.x * NWAVES + wave; tile < T / 16; tile += gridDim.x * NWAVES) {
    const int t0 = tile * 16;
    float mean_t = 0.f, rstd_t = 0.f;
#pragma unroll 2
    for (int i = 0; i < 16; ++i) { const u32x2* row = (const u32x2*)(X1B + (size_t)(t0 + i) * 1024);
      f32x4 v[4]; float sm = 0.f;
#pragma unroll
      for (int j = 0; j < 4; ++j) { v[j] = bf4(row[lane + 64 * j]); sm += (v[j].x + v[j].y) + (v[j].z + v[j].w); }
      const float mean = wave_sum(sm) * (1.f / 1024.f); float s2 = 0.f;
#pragma unroll
      for (int j = 0; j < 4; ++j) { v[j] = v[j] - mean; s2 += (v[j].x * v[j].x + v[j].y * v[j].y) + (v[j].z * v[j].z + v[j].w * v[j].w); }
      const float rstd = rsqrtf(wave_sum(s2) * (1.f / 1024.f) + 1e-5f);
      if (fr == i) { mean_t = mean; rstd_t = rstd; } }
    f32x4 acc[5];
#pragma unroll
    for (int nt = 0; nt < 5; ++nt) acc[nt] = (f32x4){0.f, 0.f, 0.f, 0.f};
    bf16_t* xp = X1B + (size_t)(t0 + fr) * 1024 + fq * 8;
#pragma unroll 2
    for (int ks = 0; ks < 32; ++ks) {
      const u32x4 yv = *(const u32x4*)(xp + ks * 32);
      const f32x4 ga = *(const f32x4*)(g1 + ks * 32 + fq * 8), gb2 = *(const f32x4*)(g1 + ks * 32 + fq * 8 + 4), ba = *(const f32x4*)(b1 + ks * 32 + fq * 8), bb2 = *(const f32x4*)(b1 + ks * 32 + fq * 8 + 4);
      const f32x4 y0 = {__uint_as_float(yv.x << 16), __uint_as_float(yv.x & 0xffff0000u), __uint_as_float(yv.y << 16), __uint_as_float(yv.y & 0xffff0000u)};
      const f32x4 y1 = {__uint_as_float(yv.z << 16), __uint_as_float(yv.z & 0xffff0000u), __uint_as_float(yv.w << 16), __uint_as_float(yv.w & 0xffff0000u)};
      const f32x4 n0 = (y0 - mean_t) * rstd_t * ga + ba, n1 = (y1 - mean_t) * rstd_t * gb2 + bb2;
      const u32x4 xw = {cvtpk_c(n0.x, n0.y), cvtpk_c(n0.z, n0.w), cvtpk_c(n1.x, n1.y), cvtpk_c(n1.z, n1.w)};
      *(u32x4*)(xp + ks * 32) = xw;
      const pg8::bf16x8 bx = __builtin_bit_cast(pg8::bf16x8, xw);
#pragma unroll
      for (int nt = 0; nt < 5; ++nt) acc[nt] = __builtin_amdgcn_mfma_f32_16x16x32_bf16(*(const pg8::bf16x8*)(WR + (size_t)(nt * 16 + fr) * 1024 + ks * 32 + fq * 8), bx, acc[nt], 0, 0, 0); }
#pragma unroll
    for (int nt = 0; nt < 5; ++nt) { const int o = nt * 16 + fq * 4; *(f32x4*)(lg + fr * 88 + o) = acc[nt]; }
    asm volatile("s_waitcnt lgkmcnt(0)" ::: "memory");
    int ex1 = 0, ex2 = 0; float gt1 = 0.f, gt2 = 0.f; unsigned lr1 = 0u, lr2 = 0u;
    if (lane < 16) {
      const float* l = lg + lane * 88;
      int grp = 0; float gm = l[0] + bg[0];
      for (int i = 1; i < 8; ++i) { const float v = l[i] + bg[i]; if (v > gm) { gm = v; grp = i; } }
      float gs = 0.f; for (int i = 0; i < 8; ++i) gs += __expf(l[i] + bg[i] - gm);
      const float pgrp = 1.f / gs;
      const float* el = l + 8 + grp * 8; const float* eb = br + grp * 8;
      int i1 = 0; float m1 = el[0] + eb[0]; for (int i = 1; i < 8; ++i) { const float v = el[i] + eb[i]; if (v > m1) { m1 = v; i1 = i; } }
      int i2 = -1; float m2 = -3.0e38f; for (int i = 0; i < 8; ++i) { const float v = el[i] + eb[i]; if (i != i1 && v > m2) { m2 = v; i2 = i; } }
      const float e2 = __expf(m2 - m1), den = 1.f / (1.f + e2);
      gt1 = pgrp * den; gt2 = pgrp * e2 * den;
      ex1 = grp * 8 + i1; ex2 = grp * 8 + i2;
      lr1 = atomicAdd(&cntl[ex1], 1u); lr2 = atomicAdd(&cntl[ex2], 1u);
    }
    __syncthreads();
    if (wave == 0) { const unsigned nloc = cntl[lane]; basel[lane] = nloc ? atomicAdd(&ctl[CW_CNT + lane], nloc) : 0u; }
    __syncthreads();
    if (lane < 16) {
      const int t = t0 + lane; const unsigned r1 = basel[ex1] + lr1, r2 = basel[ex2] + lr2;
      LIST[(size_t)ex1 * 32768 + r1] = (unsigned)t; GATEL[(size_t)ex1 * 32768 + r1] = gt1;
      LIST[(size_t)ex2 * 32768 + r2] = (unsigned)t; GATEL[(size_t)ex2 * 32768 + r2] = gt2;
      TSLOT[(size_t)t * 2 + 0] = ((unsigned)ex1 << 16) | r1; TSLOT[(size_t)t * 2 + 1] = ((unsigned)ex2 << 16) | r2;
    }
    __syncthreads();
    if (tid < 64) cntl[tid] = 0u;
    __syncthreads();
  }
}

__device__ void phase_combine(const Ctx& c, float* lds) {
  unsigned char* ws = c.ws;
  const int tid = phase_tid(), lane = tid & 63, wave = tid >> 6;
  int* offs = (int*)lds; int* cnts = offs + 65;
  expert_offsets(c, offs, cnts, tid);
  const unsigned char* Y = (const unsigned char*)(ws + WS_Y); const unsigned* TSLOT = (const unsigned*)(ws + WS_TSLOT);
  const float* g2 = c.in[23]; const float* b2 = c.in[24];
  for (int t = blockIdx.x * NWAVES + wave; t < T; t += gridDim.x * NWAVES) {
    const unsigned s0 = TSLOT[(size_t)t * 2], s1 = TSLOT[(size_t)t * 2 + 1];
    const size_t r0 = (size_t)offs[s0 >> 16] + (s0 & 0xffffu), r1 = (size_t)offs[s1 >> 16] + (s1 & 0xffffu);
    f32x4* row = (f32x4*)(c.out + (size_t)t * 1024); const u32x2* xrow = (const u32x2*)((const bf16_t*)(ws + WS_X1B) + (size_t)t * 1024);
    f32x4 v[4]; float s = 0.f;
#pragma unroll
    for (int j = 0; j < 4; ++j) { const unsigned ya = ((const unsigned*)(Y + r0 * 1024))[lane + 64 * j], yb = ((const unsigned*)(Y + r1 * 1024))[lane + 64 * j];
      f32x4 x = bf4(xrow[lane + 64 * j]) * ALPHA;
      const hw_f32x2 a01 = __builtin_amdgcn_cvt_pk_f32_fp8(ya, false), a23 = __builtin_amdgcn_cvt_pk_f32_fp8(ya, true), b01 = __builtin_amdgcn_cvt_pk_f32_fp8(yb, false), b23 = __builtin_amdgcn_cvt_pk_f32_fp8(yb, true);
      x.x += (a01.x + b01.x) * 0.015625f; x.y += (a01.y + b01.y) * 0.015625f; x.z += (a23.x + b23.x) * 0.015625f; x.w += (a23.y + b23.y) * 0.015625f;
      v[j] = x; s += (x.x + x.y) + (x.z + x.w); }
    const float mean = wave_sum(s) * (1.f / 1024.f); float s2 = 0.f;
#pragma unroll
    for (int j = 0; j < 4; ++j) { v[j] = v[j] - mean; s2 += (v[j].x * v[j].x + v[j].y * v[j].y) + (v[j].z * v[j].z + v[j].w * v[j].w); }
    const float rstd = rsqrtf(wave_sum(s2) * (1.f / 1024.f) + 1e-5f);
#pragma unroll
    for (int j = 0; j < 4; ++j) { const f32x4 g = ((const f32x4*)g2)[lane + 64 * j], bb = ((const f32x4*)b2)[lane + 64 * j]; row[lane + 64 * j] = v[j] * rstd * g + bb; }
  }
}

constexpr int NPHASE = 11;
__global__ void __launch_bounds__(NTHREADS, 2) mega(Ctx c) {
  float* lds = (float*)lds_raw;
  unsigned* ctl = (unsigned*)(c.ws + WS_CTL);
  unsigned* bar = ctl + CW_BAR;
  if (threadIdx.x == 0) { *(volatile unsigned*)(lds_raw + LDS_WCTR) = 0u; *(volatile unsigned*)(lds_raw + LDS_XBST) = 0u; *(volatile unsigned*)(lds_raw + LDS_XBST + 4) = 0u;
    (void)xb_add(&bar[XB_XCNT(xb_xcc_id())], 1u); }
  __syncthreads();
  phase_prologue(c, lds);
  xcd_barrier(bar);
  phase_inproj_mfma(c, (lds_u8*)lds_raw);
  phase_tiles_queue(c, lds, ctl + CW_Q + 48, TP_WD0 - TP_D1, TP_WD0);
  xcd_barrier(bar);
  phase_gdn_prep2(c, lds_raw);
  phase_kvup(c, lds);
  phase_topk_mfma(c, lds_raw, ctl + CW_Q);
  xcd_barrier(bar);
  if (blockIdx.x < 48) phase_gdn_scan(c, lds_raw, blockIdx.x);
  phase_attn_sparse(c, lds_raw, ctl + CW_Q + 16);
  phase_attn_mem(c, lds_raw, ctl + CW_Q + 32);
  xcd_barrier(bar);
  phase_outproj_mfma(c, (lds_u8*)lds_raw);
  xcd_barrier(bar);
  phase_router(c, lds_raw);
  xcd_barrier(bar);
  phase_moe_up_mfma(c, (lds_u8*)lds_raw);
  phase_tiles_queue(c, lds, ctl + CW_Q + 64, TP_WD0, TP_TOTAL);
  xcd_barrier(bar);
  phase_moe_down_mfma(c, (lds_u8*)lds_raw);
  xcd_barrier(bar);
  phase_combine(c, lds);
}

extern "C" void kernel_launch(void* const* d_in, const int* in_sizes, int n_in, void* d_out, int out_size, void* d_ws, size_t ws_size, hipStream_t stream) {
  static int grid = 0;
  if (grid == 0) {
    if (n_in != 25 || ws_size < WS_END) { fprintf(stderr, "kernel_launch: unexpected n_in %d / ws %zu\n", n_in, ws_size); grid = -1; return; }
    int dev = 0, cus = 0, per_cu = 0;
    hipGetDevice(&dev); hipDeviceGetAttribute(&cus, hipDeviceAttributeMultiprocessorCount, dev);
    hipFuncSetAttribute((const void*)mega, hipFuncAttributeMaxDynamicSharedMemorySize, LDS_BYTES);
    hipOccupancyMaxActiveBlocksPerMultiprocessor(&per_cu, (const void*)mega, NTHREADS, LDS_BYTES);
    if (per_cu < 1) { fprintf(stderr, "kernel_launch: occupancy query says %d blocks/CU\n", per_cu); per_cu = 1; }
    grid = cus * (per_cu < 1 ? 1 : 1);
    (void)hipGetLastError();
  }
  if (grid < 0) return;
  hipMemsetAsync((char*)d_ws + WS_CTL, 0, 32 * 1024, stream);
  Ctx c; memset(&c, 0, sizeof(c));
  for (int i = 0; i < 25; ++i) c.in[i] = (const float*)d_in[i];
  c.out = (float*)d_out; c.ws = (unsigned char*)d_ws;
  hipLaunchKernelGGL(mega, dim3(grid), dim3(NTHREADS), LDS_BYTES, stream, c);
}
```

```cpp
#include <hip/hip_runtime.h>
#include <cstdio>
#include <cstdint>
#include <cstring>

#ifndef ONE_LAUNCH
#define ONE_LAUNCH 1
#endif

typedef unsigned short bf16_t;
typedef float f32x4 __attribute__((ext_vector_type(4)));
typedef unsigned u32x4 __attribute__((ext_vector_type(4)));
typedef unsigned u32x2 __attribute__((ext_vector_type(2)));

constexpr int T = 32768, DM = 1024, SEQ = 4096, NBATCH = 8;
constexpr int NIN = 2816;
constexpr int NMEM = 256, TM = NBATCH * NMEM;
constexpr int NEXP = 64, DE = 256;
constexpr int NTHREADS = 512, NWAVES = 8;
constexpr float ALPHA = 1.189207115002721f;
constexpr float LOG2E = 1.4426950408889634f;
constexpr float QSCALE = 0.125f * LOG2E;

constexpr size_t MiB = 1ull << 20;
constexpr size_t WS_CTL = 0;
constexpr size_t WS_TSLOT = 512 * 1024;
constexpr size_t WS_ROPE = 1 * MiB;
constexpr size_t WS_WKV = 2 * MiB;
constexpr size_t WS_WR = 2 * MiB + 65536;
constexpr size_t WS_WIN = 3 * MiB;
constexpr size_t WS_WO = 9 * MiB;
constexpr size_t WS_WMKV = 11 * MiB;
constexpr size_t WS_MEMB = 12 * MiB;
constexpr size_t WS_WGU = 16 * MiB;
constexpr size_t WS_WD = 80 * MiB;
constexpr size_t WS_XB = 112 * MiB;
constexpr size_t WS_QA = 176 * MiB;
constexpr size_t WS_CKV = 200 * MiB;
constexpr size_t WS_IQ = 208 * MiB;
constexpr size_t WS_IK = 224 * MiB;
constexpr size_t WS_SM = 228 * MiB;
constexpr size_t WS_QC = 230 * MiB;
constexpr size_t WS_GB = 246 * MiB;
constexpr size_t WS_MK = 342 * MiB;
constexpr size_t WS_MVT = 343 * MiB;
constexpr size_t WS_KVA = 344 * MiB;
constexpr size_t WS_SEL = 352 * MiB;
constexpr size_t WS_CAT = 368 * MiB;
constexpr size_t WS_X1B = 432 * MiB;
constexpr size_t WS_LIST = 496 * MiB;
constexpr size_t WS_GATEL = 504 * MiB;
constexpr size_t WS_END = 512 * MiB;
constexpr size_t WS_H = 112 * MiB;
constexpr size_t WS_Y = 160 * MiB;

constexpr int CW_CNT = 0;
constexpr int CW_Q = 64;
constexpr int CW_BAR = 4096;

struct Ctx {
  const float* in[25];
  float* out;
  unsigned char* ws;
  int ph_lo, ph_hi;
};


extern __shared__ __attribute__((aligned(16))) unsigned char lds_raw[];
constexpr int LDS_BYTES = 157696;
constexpr int LDS_WCTR = LDS_BYTES - 64;
__device__ __forceinline__ int phase_tid() {
  __syncthreads();
  int l; asm volatile("v_mbcnt_lo_u32_b32 %0, -1, 0\n\tv_mbcnt_hi_u32_b32 %0, -1, %0" : "=v"(l));
  unsigned w = 0u;
  if (l == 0) w = __hip_atomic_fetch_add((__attribute__((address_space(3))) unsigned*)(__attribute__((address_space(3))) unsigned char*)(lds_raw + LDS_WCTR), 1u, __ATOMIC_RELAXED, __HIP_MEMORY_SCOPE_WORKGROUP);
  w = (unsigned)__builtin_amdgcn_readfirstlane((int)w) & 7u;
  return (int)(w * 64u) + l;
}


#define XB_TMO      128
#define XB_XCNT(j)  (256  + 64 * (j))
#define XB_XSUB(j)  (1280 + 64 * (j))
#define XB_XGEN(j)  (2304 + 64 * (j))
#define XB_TOP      3328
#define XB_TOPGEN   3392
#define XCD_BAR_WORDS 3456
#define XB_SPIN_CAP (1u << 18)
constexpr int LDS_XBST = LDS_BYTES - 32;
__device__ __forceinline__ unsigned xb_ld(unsigned* p)              { return __hip_atomic_load(p, __ATOMIC_RELAXED, __HIP_MEMORY_SCOPE_AGENT); }
__device__ __forceinline__ unsigned xb_add(unsigned* p, unsigned v) { return __hip_atomic_fetch_add(p, v, __ATOMIC_RELAXED, __HIP_MEMORY_SCOPE_AGENT); }
__device__ __forceinline__ unsigned xb_xcc_id() { return (unsigned)__builtin_amdgcn_s_getreg((3 << 11) | 20) & 0xFu; }
#define XB_SPIN(cond, bar) do { unsigned _sp = 0; while (cond) { __builtin_amdgcn_s_sleep(1); \
    if ((++_sp & 255u) == 0u) { if (xb_ld(&(bar)[XB_TMO])) break; if (_sp > XB_SPIN_CAP) { atomicAdd(&(bar)[XB_TMO], 1u); break; } } } } while (0)
__device__ __forceinline__ void xcd_barrier_complete(unsigned* bar, unsigned x, unsigned& nloc, unsigned& nx) {
    const unsigned G = gridDim.x;
    unsigned sum, cnt, mine, sp = 0u;
    for (;;) {
        sum = 0u; cnt = 0u; mine = 0u;
#pragma unroll
        for (unsigned j = 0; j < 16; ++j) { const unsigned cc = xb_ld(&bar[XB_XCNT(j)]); sum += cc; cnt += (cc > 0u) ? 1u : 0u; mine = (j == x) ? cc : mine; }
        if (sum == G) break;
        __builtin_amdgcn_s_sleep(1);
        if ((++sp & 255u) == 0u) { if (xb_ld(&bar[XB_TMO])) break; if (sp > XB_SPIN_CAP) { atomicAdd(&bar[XB_TMO], 1u); break; } }
    }
    nloc = mine > 0u ? mine : 1u; nx = cnt > 0u ? cnt : 1u;
}
__device__ __forceinline__ void xcd_barrier(unsigned* bar) {
    asm volatile("s_waitcnt vmcnt(0)" ::: "memory");
    __syncthreads();
    const int btid = phase_tid();
    if (btid == 0) {
        volatile __attribute__((address_space(3))) unsigned* st = (volatile __attribute__((address_space(3))) unsigned*)(__attribute__((address_space(3))) unsigned char*)(lds_raw + LDS_XBST);
        const unsigned x = xb_xcc_id();
        __builtin_amdgcn_s_waitcnt(0);
        unsigned nloc = st[0], nx = st[1];
        if (nloc == 0u) { xcd_barrier_complete(bar, x, nloc, nx); st[0] = nloc; st[1] = nx; }
        const unsigned old = xb_add(&bar[XB_XSUB(x)], 1u);
        const unsigned gen = old / nloc;
        if (old + 1u == (gen + 1u) * nloc) {
            __builtin_amdgcn_fence(__ATOMIC_RELEASE, "agent");
            asm volatile("s_waitcnt vmcnt(0)" ::: "memory");
            const unsigned og = xb_add(&bar[XB_TOP], 1u);
            const unsigned tg = og / nx;
            if (og + 1u == (tg + 1u) * nx) xb_add(&bar[XB_TOPGEN], 1u);
            else XB_SPIN(xb_ld(&bar[XB_TOPGEN]) == tg, bar);
            __builtin_amdgcn_fence(__ATOMIC_ACQUIRE, "agent");
            xb_add(&bar[XB_XGEN(x)], 1u);
            asm volatile("s_waitcnt vmcnt(0)" ::: "memory");
        } else {
            XB_SPIN(xb_ld(&bar[XB_XGEN(x)]) == gen, bar);
            __builtin_amdgcn_fence(__ATOMIC_ACQUIRE, "agent");
            asm volatile("s_waitcnt vmcnt(0)" ::: "memory");
        }
    }
    __syncthreads();
}

__device__ __forceinline__ float bf2f(bf16_t v) { return __uint_as_float(((unsigned)v) << 16); }
typedef float hw_f32x2 __attribute__((ext_vector_type(2))); typedef __bf16 hw_bf16x2 __attribute__((ext_vector_type(2)));
__device__ __forceinline__ unsigned pk2(float lo, float hi) { const hw_f32x2 v = {lo, hi}; const hw_bf16x2 b = __builtin_convertvector(v, hw_bf16x2); return __builtin_bit_cast(unsigned, b); }
__device__ __forceinline__ bf16_t f2bf(float f) { return (bf16_t)(pk2(f, f) & 0xffffu); }
__device__ __forceinline__ float wave_sum(float v) {
  int x = __float_as_int(v);
  x = __float_as_int(__int_as_float(x) + __int_as_float(__builtin_amdgcn_update_dpp(0, x, 0x111, 0xF, 0xF, true)));
  x = __float_as_int(__int_as_float(x) + __int_as_float(__builtin_amdgcn_update_dpp(0, x, 0x112, 0xF, 0xF, true)));
  x = __float_as_int(__int_as_float(x) + __int_as_float(__builtin_amdgcn_update_dpp(0, x, 0x114, 0xF, 0xF, true)));
  x = __float_as_int(__int_as_float(x) + __int_as_float(__builtin_amdgcn_update_dpp(0, x, 0x118, 0xF, 0xF, true)));
  x = __float_as_int(__int_as_float(x) + __int_as_float(__builtin_amdgcn_update_dpp(0, x, 0x142, 0xA, 0xF, false)));
  x = __float_as_int(__int_as_float(x) + __int_as_float(__builtin_amdgcn_update_dpp(0, x, 0x143, 0xC, 0xF, false)));
  return __int_as_float(__builtin_amdgcn_readlane(x, 63));
}
__device__ __forceinline__ float wave_max(float v) {
#pragma unroll
  for (int o = 32; o >= 1; o >>= 1) v = fmaxf(v, __shfl_xor(v, o));
  return v;
}
__device__ __forceinline__ float silu_f(float v) { return v * __builtin_amdgcn_rcpf(1.f + __expf(-v)); }

__device__ __forceinline__ int ropeperm(int p) { return (p >> 1) + 32 * (p & 1); }
__device__ __forceinline__ int colmap_in(int cp) {
  const int tile = cp >> 8, w = cp & 255;
  if (tile == 0) return (w >> 6) * 64 + ropeperm(w & 63);
  if (tile == 1) { if (w < 128) { const int c = 256 + w; return (c >> 6) * 64 + ropeperm(c & 63); } return 384 + (w - 128); }
  if (tile == 2) return 512 + (w >> 6) * 64 + ropeperm(w & 63);
  if (tile == 3) { if (w < 64) return 768 + ropeperm(w); if (w < 68) return 832 + (w - 64); if (w < 74) return 2372 + (w - 68); if (w < 80) return 2378 + (w - 74); return -1; }
  if (tile == 4) return 2384 + w;
  return 836 + (cp - 1280);
}

struct WorkQ { unsigned* head; volatile int* slot; int nxt; };
__device__ __forceinline__ void wq_init(WorkQ& q, unsigned* head, volatile int* slot, int tid) { q.head = head; q.slot = slot; q.nxt = 0; if (tid == 0) q.nxt = (int)atomicAdd(head, 1u); }
__device__ __forceinline__ int wq_next(WorkQ& q, int tid) {
  __syncthreads();
  if (tid == 0) { *q.slot = q.nxt; q.nxt = (int)atomicAdd(q.head, 1u); }
  __syncthreads();
  return *q.slot;
}

template <class CM>
__device__ __forceinline__ void tp_tile(const float* src, int ld, bf16_t* dst, int drow0, int K, int k0, CM cm, float* lds, int tid) {
  const int a = tid & 63, b = tid >> 6;
  const int sc = cm(a);
  __syncthreads();
#pragma unroll
  for (int i = 0; i < 8; ++i) { const int kk = b * 8 + i; lds[kk * 65 + a] = sc >= 0 ? src[(size_t)(k0 + kk) * ld + sc] : 0.f; }
  __syncthreads();
  { const int nn = tid >> 3, kc = (tid & 7) * 8;
    const float* p = lds + kc * 65 + nn;
    *(u32x4*)(dst + (size_t)(drow0 + nn) * K + k0 + kc) = (u32x4){pk2(p[0], p[65]), pk2(p[130], p[195]), pk2(p[260], p[325]), pk2(p[390], p[455])}; }
}

constexpr int TP_TOTAL = (NIN / 64) * 16 + 16 * 16 + 8 * 16 + 64 * 8 * 16 + 64 * 16 * 4;
constexpr int TP_WD0 = TP_TOTAL - 64 * 16 * 4;
constexpr int TP_D1 = 5200;
__device__ __forceinline__ void prologue_tiles(const Ctx& c, float* lds, int tid, int lo, int hi, int b0, int nb) {
  unsigned char* ws = c.ws;
  const int n_win = (NIN / 64) * 16, n_wo = 16 * 16, n_wmkv = 8 * 16, n_wgu = 64 * 8 * 16, n_wd = 64 * 16 * 4;
  const int total = n_win + n_wo + n_wmkv + n_wgu + n_wd;
  for (int it = lo + b0; it < hi; it += nb) {
    int r = it;
    if (r < n_win) { const int nt = r / 16, kt = r % 16; tp_tile(c.in[2], 2640, (bf16_t*)(ws + WS_WIN), nt * 64, 1024, kt * 64, [&](int a) { return colmap_in(nt * 64 + a); }, lds, tid); continue; } r -= n_win;
    if (r < n_wo) { const int nt = r / 16, kt = r % 16; tp_tile(c.in[13], 1024, (bf16_t*)(ws + WS_WO), nt * 64, 1024, kt * 64, [&](int a) { return nt * 64 + a; }, lds, tid); continue; } r -= n_wo;
    if (r < n_wmkv) { const int nt = r / 16, kt = r % 16; tp_tile(c.in[12], 512, (bf16_t*)(ws + WS_WMKV), nt * 64, 1024, kt * 64, [&](int a) { return nt * 64 + a; }, lds, tid); continue; } r -= n_wmkv;
    if (r < n_wgu) { const int e = r / 128, q = r % 128, nt = q / 16, kt = q % 16;
      const int pn = nt >> 2, sub = nt & 3, isup = sub >> 1, c0 = pn * 128 + (sub & 1) * 64;
      const float* src = (isup ? c.in[21] : c.in[20]) + (size_t)e * 1024 * 256;
      tp_tile(src, 256, (bf16_t*)(ws + WS_WGU), e * 512 + nt * 64, 1024, kt * 64, [&](int a) { return c0 + a; }, lds, tid); continue; } r -= n_wgu;
    { const int e = r / 64, q = r % 64, nt = q / 4, kt = q % 4;
      tp_tile(c.in[22] + (size_t)e * 256 * 1024, 1024, (bf16_t*)(ws + WS_WD), e * 1024 + nt * 64, 256, kt * 64, [&](int a) { return nt * 64 + a; }, lds, tid); }
  }
}

__device__ void phase_tiles_queue(const Ctx& c, float* lds, unsigned* qhead, int lo, int hi) {
  const int tid = phase_tid();
  volatile int* slot = (volatile int*)(lds + 64 * 65 + 16);
  WorkQ wq; wq_init(wq, qhead, slot, tid);
  const int nitems = (hi - lo + 7) >> 3;
  for (;;) {
    const int item = wq_next(wq, tid);
    if (item >= nitems) break;
    const int t0 = lo + item * 8, t1 = t0 + 8 < hi ? t0 + 8 : hi;
    prologue_tiles(c, lds, tid, t0, t1, 0, 1);
  }
}

__device__ void phase_prologue(const Ctx& c, float* lds) {
  const int tid = phase_tid(), bid = blockIdx.x, G = gridDim.x;
  unsigned char* ws = c.ws;
  const size_t gtid = (size_t)bid * NTHREADS + tid, gstride = (size_t)G * NTHREADS;
  { const f32x4* x4 = (const f32x4*)c.in[0]; u32x2* o = (u32x2*)c.out;
    for (size_t i = gtid; i < (size_t)T * DM / 4; i += gstride) { const f32x4 v = x4[i]; o[i] = (u32x2){pk2(v.x, v.y), pk2(v.z, v.w)}; }
    const f32x4* m4 = (const f32x4*)c.in[1]; u32x2* om = (u32x2*)(ws + WS_MEMB);
    for (size_t i = gtid; i < (size_t)TM * DM / 4; i += gstride) { const f32x4 v = m4[i]; om[i] = (u32x2){pk2(v.x, v.y), pk2(v.z, v.w)}; } }
  { float* cs = (float*)(ws + WS_ROPE); float* sn = cs + SEQ * 32;
    for (size_t i = gtid; i < (size_t)SEQ * 32; i += gstride) { const int s = (int)(i >> 5), d = (int)(i & 31);
      const float inv = 1.0f / powf(10000.0f, (float)d / 32.0f); const float ang = (float)s * inv; float sv, cv; sincosf(ang, &sv, &cv); cs[i] = cv; sn[i] = sv; } }
  { bf16_t* wkv = (bf16_t*)(ws + WS_WKV); const float* g = c.in[3]; const float* wk = c.in[4]; const float* wv = c.in[5];
    for (size_t i = gtid; i < 128 * 128; i += gstride) { const int p = (int)(i >> 7), k = (int)(i & 127);
      const float w = p < 64 ? wk[k * 64 + ropeperm(p)] : wv[k * 64 + (p - 64)]; wkv[i] = f2bf(w * g[k]); }
    bf16_t* wr = (bf16_t*)(ws + WS_WR); const float* wg = c.in[16]; const float* wrt = c.in[18];
    for (size_t i = gtid; i < 80 * 1024; i += gstride) { const int o = (int)(i >> 10), k = (int)(i & 1023); wr[i] = f2bf(o < 8 ? wg[k * 8 + o] : o < 72 ? wrt[k * 64 + (o - 8)] : 0.f); } }
  prologue_tiles(c, lds, tid, 0, TP_WD0 - TP_D1, bid, G);
}

__device__ __forceinline__ void expert_offsets(const Ctx& c, int* offs  , int* cnts  , int tid) {
  const unsigned* ctl = (const unsigned*)(c.ws + WS_CTL);
  __syncthreads();
  if (tid == 0) { int o = 0; for (int e = 0; e < 64; ++e) { const int n = (int)ctl[CW_CNT + e]; cnts[e] = n; offs[e] = o; o += (n + 255) & ~255; } offs[64] = o; }
  __syncthreads();
}


namespace pg8 {
#define PG8_LAS __attribute__((address_space(3)))
typedef short bf16x8 __attribute__((ext_vector_type(8)));
constexpr int BM = 256, BK = 64, HALF = 128, HTB = HALF * BK * 2, STAGE_BYTES = 8 * HTB, NXCD = 8, WGM = 8;
__host__ __device__ __forceinline__ int lds_byte(int r, int c) { const int st = (r >> 4) * 2 + (c >> 5), rr = r & 15, cc = c & 31, ob = rr * 64 + cc * 2; return st * 1024 + (ob ^ (((ob >> 9) & 1) << 5)); }
__host__ __device__ __forceinline__ void stage_rc(int b, int& R, int& C) { const int st = b / 1024, sb = b % 1024, swz = sb ^ (((sb >> 9) & 1) << 5); R = (st >> 1) * 16 + swz / 64; C = (st & 1) * 32 + (swz % 64) / 2; }
__host__ __device__ __forceinline__ int perm32(int rho) { const int n = rho >> 4, i = rho & 15; return 8 * (i >> 2) + 4 * n + (i & 3); }
struct Unit { int pm, pn, e, mt, aux; };
struct Gemm { const bf16_t* A; const bf16_t* Bt; int K; };
struct StaticOrder {
    int nM, nN, nwg, G, c;
    __device__ void init(int M, int N, int G_, int c_) { nM = M / BM; nN = N / BM; nwg = nM * nN; G = G_; c = c_; }
    __device__ bool next(int i, Unit& u) const {
        const long L = (long)i * G + c; if (c < 0 || L >= nwg) return false;
        int wgid = (int)L; { const int q = nwg / NXCD, r = nwg % NXCD, xcd = wgid % NXCD, off = wgid / NXCD; wgid = (xcd < r ? xcd * (q + 1) : r * (q + 1) + (xcd - r) * q) + off; }
        const int nig = WGM * nN, gid = wgid / nig, fm = gid * WGM, gsz = (nM - fm) < WGM ? (nM - fm) : WGM;
        u.pm = fm + ((wgid % nig) % gsz); u.pn = (wgid % nig) / gsz; u.e = 0; u.mt = 0; u.aux = 0; return true;
    }
    __device__ __forceinline__ unsigned arow(const Unit&, int) const { return 0u; }
};
__device__ __forceinline__ unsigned cvt_pk_bf16(float lo, float hi) { unsigned r; asm volatile("v_cvt_pk_bf16_f32 %0, %1, %2" : "=v"(r) : "v"(lo), "v"(hi)); return r; }

template <class Epi, class Sched, bool ALIGN_EPI, bool GATHER>
__device__ __forceinline__ void gemm_phase(PG8_LAS unsigned char* lds, const Gemm g, const Sched& S, const Epi& E, const int tid) {
    const int wid = __builtin_amdgcn_readfirstlane(tid >> 6), lane = tid & 63, wr = wid >> 2, wc = wid & 3, fr = lane & 15, fq = lane >> 4;
    const int K = g.K, nt = K / BK;
    unsigned voffA[2], voffB[2]; int RA[2], CA[2];
#pragma unroll
    for (int i = 0; i < 2; ++i) { int R, C; stage_rc(tid * 16 + i * 8192, R, C); const int Rb = Epi::PERM ? ((R & ~31) + perm32(R & 31)) : R;
        RA[i] = R; CA[i] = C; voffA[i] = (unsigned)(R * K + C) * 2u; voffB[i] = (unsigned)(Rb * K + C) * 2u; }
    const size_t kstep = (size_t)(BK * 2);
    const size_t hstep = (size_t)HALF * K * 2;
    const size_t tstep = 2 * hstep;
    const unsigned ldsw = (unsigned)wid * 1024u;
    const int aoff = lds_byte(wr * 64 + fr, fq * 8), boff = lds_byte(wc * 32 + fr, fq * 8);
#define PG8_SA(b, h) (((b) * 2 + (h)) * HTB)
#define PG8_SB(b, h) ((4 + (b) * 2 + (h)) * HTB)
#define PG8_STAGE(bufoff, gbase, voff) do { _Pragma("unroll") for (int _i = 0; _i < 2; ++_i) \
        __builtin_amdgcn_global_load_lds((const unsigned*)((const char*)(gbase) + (voff)[_i]), (PG8_LAS unsigned*)(lds + (bufoff) + ldsw + _i * 8192), 16, 0, 0); } while (0)
#define PG8_STAGE_A(bufoff, gbase, h, goff) do { if constexpr (GATHER) { PG8_STAGE(bufoff, gbase, (goff)[h]); } else { PG8_STAGE(bufoff, (gbase) + (h) * hstep, voffA); } } while (0)
#define PG8_LDA(dst, b, h) do { _Pragma("unroll") for (int m = 0; m < 4; ++m) _Pragma("unroll") for (int k = 0; k < 2; ++k) dst[m][k] = *(const PG8_LAS bf16x8*)(lds + PG8_SA(b, h) + aoff + m * 2048 + k * 1024); } while (0)
#define PG8_LDB(dst, b, h) do { _Pragma("unroll") for (int n = 0; n < 2; ++n) _Pragma("unroll") for (int k = 0; k < 2; ++k) dst[n][k] = *(const PG8_LAS bf16x8*)(lds + PG8_SB(b, h) + boff + n * 2048 + k * 1024); } while (0)
#define PG8_MMA(ai, bj, At, Bt) do { __builtin_amdgcn_s_setprio(1); _Pragma("unroll") for (int m = 0; m < 4; ++m) _Pragma("unroll") for (int n = 0; n < 2; ++n) _Pragma("unroll") for (int k = 0; k < 2; ++k) \
        acc[ai][bj][m][n] = __builtin_amdgcn_mfma_f32_16x16x32_bf16(Bt[n][k], At[m][k], acc[ai][bj][m][n], 0, 0, 0); __builtin_amdgcn_s_setprio(0); } while (0)
#define PG8_WAIT_V(n) asm volatile("s_waitcnt vmcnt(" #n ")" ::: "memory")
#define PG8_WAIT_L(n) asm volatile("s_waitcnt lgkmcnt(" #n ")" ::: "memory")
#define PG8_BAR __builtin_amdgcn_s_barrier()
#define PG8_SCHED __builtin_amdgcn_sched_barrier(0)
    Unit cur, nxt; int ui = 0;
    if (!S.next(0, cur)) return;
    f32x4 acc[2][2][4][2];
#pragma unroll
    for (int a = 0; a < 2; ++a)
#pragma unroll
        for (int b = 0; b < 2; ++b)
#pragma unroll
            for (int m = 0; m < 4; ++m)
#pragma unroll
                for (int n = 0; n < 2; ++n) acc[a][b][m][n] = (f32x4){0.f, 0.f, 0.f, 0.f};
    bf16x8 At[4][2], B0[2][2], B1[2][2];
    unsigned gc[2][2], gn[2][2];
    const char* cA; const char* cB = (const char*)g.Bt + (size_t)cur.pn * tstep;
    if constexpr (GATHER) { cA = (const char*)g.A;
#pragma unroll
        for (int h = 0; h < 2; ++h)
#pragma unroll
            for (int i = 0; i < 2; ++i) { gc[h][i] = (S.arow(cur, h * HALF + RA[i]) * (unsigned)K + (unsigned)CA[i]) * 2u; gn[h][i] = gc[h][i]; }
    } else { cA = (const char*)g.A + (size_t)cur.pm * tstep; }
    PG8_STAGE(PG8_SB(0, 0), cB, voffB); PG8_STAGE(PG8_SB(0, 1), cB + hstep, voffB); PG8_STAGE_A(PG8_SA(0, 0), cA, 0, gc); PG8_STAGE_A(PG8_SA(0, 1), cA, 1, gc);
    if (wr == 1) PG8_BAR;
    PG8_WAIT_V(2); PG8_BAR;
    PG8_STAGE(PG8_SB(1, 0), cB + kstep, voffB); PG8_STAGE_A(PG8_SA(1, 0), cA + kstep, 0, gc); PG8_STAGE(PG8_SB(1, 1), cB + hstep + kstep, voffB);
    PG8_WAIT_V(6); PG8_BAR;
    for (;;) {
        const bool has_next = S.next(ui + 1, nxt);
        const char* nA; const char* nB = has_next ? (const char*)g.Bt + (size_t)nxt.pn * tstep : cB;
        if constexpr (GATHER) { nA = cA;
            if (has_next) {
#pragma unroll
                for (int h = 0; h < 2; ++h)
#pragma unroll
                    for (int i = 0; i < 2; ++i) gn[h][i] = (S.arow(nxt, h * HALF + RA[i]) * (unsigned)K + (unsigned)CA[i]) * 2u; }
        } else { nA = has_next ? (const char*)g.A + (size_t)nxt.pm * tstep : cA; }
        for (int t = 0; t < nt; t += 2) {
            const bool last = (t == nt - 2);
            const char* a1 = cA + (size_t)(t + 1) * kstep;
            const char* a2 = last ? nA : cA + (size_t)(t + 2) * kstep; const char* b2 = last ? nB : cB + (size_t)(t + 2) * kstep;
            const char* a3 = a2 + kstep; const char* b3 = b2 + kstep;
            unsigned g2[2][2];
            if constexpr (GATHER) {
#pragma unroll
            for (int h = 0; h < 2; ++h)
#pragma unroll
                for (int i = 0; i < 2; ++i) g2[h][i] = last ? gn[h][i] : gc[h][i]; }
            PG8_LDB(B0, 0, 0); PG8_LDB(B1, 0, 1); PG8_SCHED; PG8_LDA(At, 0, 0); PG8_STAGE_A(PG8_SA(1, 1), a1, 1, gc);
            PG8_WAIT_V(8); PG8_WAIT_L(0); PG8_BAR; PG8_MMA(0, 0, At, B0); PG8_MMA(0, 1, At, B1); PG8_BAR; PG8_SCHED;
            PG8_LDA(At, 0, 1); PG8_STAGE(PG8_SB(0, 0), b2, voffB); PG8_STAGE(PG8_SB(0, 1), b2 + hstep, voffB); PG8_STAGE_A(PG8_SA(0, 0), a2, 0, g2);
            PG8_WAIT_V(8); PG8_WAIT_L(0); PG8_BAR; PG8_MMA(1, 0, At, B0); PG8_MMA(1, 1, At, B1); PG8_BAR; PG8_SCHED;
            PG8_LDB(B0, 1, 0); PG8_LDB(B1, 1, 1); PG8_SCHED; PG8_LDA(At, 1, 0); PG8_STAGE_A(PG8_SA(0, 1), a2, 1, g2);
            PG8_WAIT_V(8); PG8_WAIT_L(0); PG8_BAR; PG8_MMA(0, 0, At, B0); PG8_MMA(0, 1, At, B1); PG8_BAR; PG8_SCHED;
            PG8_LDA(At, 1, 1); PG8_STAGE(PG8_SB(1, 0), b3, voffB); PG8_STAGE(PG8_SB(1, 1), b3 + hstep, voffB); PG8_STAGE_A(PG8_SA(1, 0), a3, 0, g2);
            PG8_WAIT_V(8); PG8_WAIT_L(0); PG8_BAR; PG8_MMA(1, 0, At, B0); PG8_MMA(1, 1, At, B1); PG8_BAR; PG8_SCHED;
        }
        if constexpr (ALIGN_EPI) { if (wr == 0) PG8_BAR; }
        E(acc, cur, wr, wc, fr, fq);
        if (!has_next) break;
#pragma unroll
        for (int a = 0; a < 2; ++a)
#pragma unroll
            for (int b = 0; b < 2; ++b)
#pragma unroll
                for (int m = 0; m < 4; ++m)
#pragma unroll
                    for (int n = 0; n < 2; ++n) acc[a][b][m][n] = (f32x4){0.f, 0.f, 0.f, 0.f};
        cur = nxt; cA = nA; cB = nB; ++ui;
        if constexpr (GATHER) {
#pragma unroll
        for (int h = 0; h < 2; ++h)
#pragma unroll
            for (int i = 0; i < 2; ++i) gc[h][i] = gn[h][i]; }
        if constexpr (ALIGN_EPI) { if (wr == 1) PG8_BAR; }
    }
    PG8_WAIT_V(0);
    if constexpr (!ALIGN_EPI) { if (wr == 0) PG8_BAR; }
    PG8_BAR;
#undef PG8_SA
#undef PG8_SB
#undef PG8_STAGE
#undef PG8_STAGE_A
#undef PG8_LDA
#undef PG8_LDB
#undef PG8_MMA
#undef PG8_WAIT_V
#undef PG8_WAIT_L
#undef PG8_BAR
#undef PG8_SCHED
}
}
typedef __attribute__((address_space(3))) unsigned char lds_u8;

__device__ __forceinline__ u32x4 pack8(const f32x4& a, const f32x4& b) { return (u32x4){pg8::cvt_pk_bf16(a.x, a.y), pg8::cvt_pk_bf16(a.z, a.w), pg8::cvt_pk_bf16(b.x, b.y), pg8::cvt_pk_bf16(b.z, b.w)}; }
struct EpiInM {
  static constexpr bool PERM = true;
  unsigned char* ws;
  __device__ __forceinline__ void operator()(const f32x4 (&acc)[2][2][4][2], const pg8::Unit& u, int wr, int wc, int fr, int fq) const {
    const float* cs = (const float*)(ws + WS_ROPE); const float* sn = cs + SEQ * 32;
    const int pn = u.pn;
#pragma unroll
    for (int ai = 0; ai < 2; ++ai)
#pragma unroll
      for (int m = 0; m < 4; ++m) {
        const int row = u.pm * 256 + ai * 128 + wr * 64 + m * 16 + fr, pos = row & (SEQ - 1);
#pragma unroll
        for (int bj = 0; bj < 2; ++bj) {
          const int w = bj * 128 + wc * 32 + 8 * fq;
          f32x4 v0 = acc[ai][bj][m][0], v1 = acc[ai][bj][m][1];
          const bool do_rope = (pn == 0) || (pn == 1 && bj == 0) || (pn == 2) || (pn == 3 && bj == 0 && wc < 2);
          if (do_rope) { const int d = (w & 63) >> 1; const f32x4 c4 = *(const f32x4*)(cs + pos * 32 + d), s4 = *(const f32x4*)(sn + pos * 32 + d);
            const f32x4 o0 = {v0.x * c4.x - v0.y * s4.x, v0.y * c4.x + v0.x * s4.x, v0.z * c4.y - v0.w * s4.y, v0.w * c4.y + v0.z * s4.y};
            const f32x4 o1 = {v1.x * c4.z - v1.y * s4.z, v1.y * c4.z + v1.x * s4.z, v1.z * c4.w - v1.w * s4.w, v1.w * c4.w + v1.z * s4.w};
            v0 = o0; v1 = o1; }
          if (pn == 0) { *(u32x4*)((bf16_t*)(ws + WS_QA) + (size_t)row * 384 + w) = pack8(v0 * QSCALE, v1 * QSCALE); }
          else if (pn == 1) { if (bj == 0) *(u32x4*)((bf16_t*)(ws + WS_QA) + (size_t)row * 384 + 256 + w) = pack8(v0 * QSCALE, v1 * QSCALE);
                              else *(u32x4*)((bf16_t*)(ws + WS_CKV) + (size_t)row * 128 + (w - 128)) = pack8(v0, v1); }
          else if (pn == 2) { *(u32x4*)((bf16_t*)(ws + WS_IQ) + (size_t)row * 256 + w) = pack8(v0, v1); }
          else if (pn == 3) { if (bj == 0) { if (wc < 2) *(u32x4*)((bf16_t*)(ws + WS_IK) + (size_t)row * 64 + w) = pack8(v0, v1);
                                             else if (wc == 2 && fq < 2) { if (fq == 0) v0 = v0 * 0.0625f; float* o = (float*)(ws + WS_SM) + (size_t)row * 16 + 8 * fq; *(f32x4*)o = v0; *(f32x4*)(o + 4) = v1; } } }
          else if (pn == 4) { *(u32x4*)((bf16_t*)(ws + WS_QC) + (size_t)row * 256 + w) = pack8(v0 * QSCALE, v1 * QSCALE); }
          else { *(u32x4*)((bf16_t*)(ws + WS_GB) + (size_t)row * 1536 + (pn - 5) * 256 + w) = pack8(v0, v1); }
        }
      }
  }
};
struct EpiMemKVM {
  static constexpr bool PERM = true;
  unsigned char* ws;
  __device__ __forceinline__ void operator()(const f32x4 (&acc)[2][2][4][2], const pg8::Unit& u, int wr, int wc, int fr, int fq) const {
#pragma unroll
    for (int ai = 0; ai < 2; ++ai)
#pragma unroll
      for (int m = 0; m < 4; ++m) {
        const int row = u.pm * 256 + ai * 128 + wr * 64 + m * 16 + fr;
#pragma unroll
        for (int bj = 0; bj < 2; ++bj) {
          const int w = bj * 128 + wc * 32 + 8 * fq; const f32x4 v0 = acc[ai][bj][m][0], v1 = acc[ai][bj][m][1];
          if (u.pn == 0) *(u32x4*)((bf16_t*)(ws + WS_MK) + (size_t)row * 256 + w) = pack8(v0, v1);
          else { const int mem = row & 255, xx = mem & 31, mpos = (mem & ~31) + 8 * ((xx >> 2) & 3) + (xx & 3) + 4 * (xx >> 4);
            bf16_t* o = (bf16_t*)(ws + WS_MVT) + ((size_t)(row >> 8) * 256 + w) * 256 + mpos;
            o[0] = f2bf(v0.x); o[256] = f2bf(v0.y); o[512] = f2bf(v0.z); o[768] = f2bf(v0.w); o[1024] = f2bf(v1.x); o[1280] = f2bf(v1.y); o[1536] = f2bf(v1.z); o[1792] = f2bf(v1.w); }
        }
      }
  }
};
struct EpiOutM {
  static constexpr bool PERM = true;
  const bf16_t* x; bf16_t* y;
  __device__ __forceinline__ void operator()(const f32x4 (&acc)[2][2][4][2], const pg8::Unit& u, int wr, int wc, int fr, int fq) const {
#pragma unroll
    for (int ai = 0; ai < 2; ++ai)
#pragma unroll
      for (int m = 0; m < 4; ++m) {
        const size_t rb = (size_t)(u.pm * 256 + ai * 128 + wr * 64 + m * 16 + fr) * 1024 + u.pn * 256 + wc * 32 + 8 * fq;
#pragma unroll
        for (int bj = 0; bj < 2; ++bj) { const size_t o = rb + bj * 128; const u32x4 xv = *(const u32x4*)(x + o);
          const f32x4 x0 = {__uint_as_float(xv.x << 16), __uint_as_float(xv.x & 0xffff0000u), __uint_as_float(xv.y << 16), __uint_as_float(xv.y & 0xffff0000u)};
          const f32x4 x1 = {__uint_as_float(xv.z << 16), __uint_as_float(xv.z & 0xffff0000u), __uint_as_float(xv.w << 16), __uint_as_float(xv.w & 0xffff0000u)};
          *(u32x4*)(y + o) = pack8(x0 * ALPHA + acc[ai][bj][m][0], x1 * ALPHA + acc[ai][bj][m][1]); }
      }
  }
};
struct MoeOrder {
  const int* offs; const int* cnts; int npn, G, c; const unsigned* LIST;
  __device__ __forceinline__ bool next(int i, pg8::Unit& u) const {
    const int L = i * G + c; const int ntiles = __builtin_amdgcn_readfirstlane(offs[64]) >> 8;
    if (L >= ntiles * npn) return false;
    const int rt = L / npn, pl = L - rt * npn; int e = 0;
    while (__builtin_amdgcn_readfirstlane(offs[e + 1]) <= rt * 256) ++e;
    u.pm = rt; u.mt = rt - (__builtin_amdgcn_readfirstlane(offs[e]) >> 8); u.e = e; u.pn = e * npn + pl; u.aux = __builtin_amdgcn_readfirstlane(cnts[e]); return true;
  }
  __device__ __forceinline__ unsigned arow(const pg8::Unit& u, int r) const { const int rank = u.mt * 256 + r; return rank < u.aux ? LIST[(size_t)u.e * 32768 + rank] : 0u; }
};
struct EpiMoeUpM {
  static constexpr bool PERM = true;
  bf16_t* H;
  __device__ __forceinline__ void operator()(const f32x4 (&acc)[2][2][4][2], const pg8::Unit& u, int wr, int wc, int fr, int fq) const {
    const int pl = u.pn & 1;
#pragma unroll
    for (int ai = 0; ai < 2; ++ai)
#pragma unroll
      for (int m = 0; m < 4; ++m) {
        const int rl = ai * 128 + wr * 64 + m * 16 + fr;
        if (u.mt * 256 + rl < u.aux) {
          f32x4 h0, h1; const f32x4 g0 = acc[ai][0][m][0], g1 = acc[ai][0][m][1], u0 = acc[ai][1][m][0], u1 = acc[ai][1][m][1];
          h0.x = silu_f(g0.x) * u0.x; h0.y = silu_f(g0.y) * u0.y; h0.z = silu_f(g0.z) * u0.z; h0.w = silu_f(g0.w) * u0.w;
          h1.x = silu_f(g1.x) * u1.x; h1.y = silu_f(g1.y) * u1.y; h1.z = silu_f(g1.z) * u1.z; h1.w = silu_f(g1.w) * u1.w;
          *(u32x4*)(H + (size_t)(u.pm * 256 + rl) * 256 + pl * 128 + wc * 32 + 8 * fq) = pack8(h0, h1);
        }
      }
  }
};
__device__ __forceinline__ unsigned pk4_fp8(const f32x4& v) { unsigned w = __builtin_amdgcn_cvt_pk_fp8_f32(v.x, v.y, 0u, false); return __builtin_amdgcn_cvt_pk_fp8_f32(v.z, v.w, w, true); }
struct EpiMoeDownM {
  static constexpr bool PERM = true;
  unsigned char* Y; const float* GATEL;
  __device__ __forceinline__ void operator()(const f32x4 (&acc)[2][2][4][2], const pg8::Unit& u, int wr, int wc, int fr, int fq) const {
    const int pl = u.pn & 3;
    const float* gp = GATEL + (size_t)u.e * 32768; const int rk0 = u.mt * 256 + wr * 64 + fr;
    unsigned char* yp = Y + (size_t)(u.pm * 256 + wr * 64 + fr) * 1024 + pl * 256 + wc * 32 + 8 * fq;
#pragma unroll
    for (int ai = 0; ai < 2; ++ai)
#pragma unroll
      for (int m = 0; m < 4; ++m) {
        const int rk = rk0 + ai * 128 + m * 16; const float gt = gp[rk < 32767 ? rk : 32767] * 64.0f;
#pragma unroll
        for (int bj = 0; bj < 2; ++bj)
          *(u32x2*)(yp + (size_t)(ai * 128 + m * 16) * 1024 + bj * 128) = (u32x2){pk4_fp8(acc[ai][bj][m][0] * gt), pk4_fp8(acc[ai][bj][m][1] * gt)};
      }
  }
};

__device__ __forceinline__ void phase_inproj_mfma(const Ctx& c, lds_u8* lds) {
  unsigned char* ws = c.ws; const int tid = phase_tid();
  { pg8::Gemm g{(const bf16_t*)c.out, (const bf16_t*)(ws + WS_WIN), 1024}; pg8::StaticOrder S; S.init(T, NIN, gridDim.x, blockIdx.x); EpiInM E{ws};
    pg8::gemm_phase<EpiInM, pg8::StaticOrder, true, false>(lds, g, S, E, tid); }
  { pg8::Gemm g{(const bf16_t*)(ws + WS_MEMB), (const bf16_t*)(ws + WS_WMKV), 1024}; pg8::StaticOrder S; S.init(TM, 512, gridDim.x, (int)blockIdx.x - 128); EpiMemKVM E{ws};
    pg8::gemm_phase<EpiMemKVM, pg8::StaticOrder, true, false>(lds, g, S, E, tid); }
}
__device__ __forceinline__ void phase_outproj_mfma(const Ctx& c, lds_u8* lds) {
  unsigned char* ws = c.ws; const int tid = phase_tid();
  pg8::Gemm g{(const bf16_t*)(ws + WS_CAT), (const bf16_t*)(ws + WS_WO), 1024}; pg8::StaticOrder S; S.init(T, 1024, gridDim.x, blockIdx.x); EpiOutM E{(const bf16_t*)c.out, (bf16_t*)(ws + WS_X1B)};
  pg8::gemm_phase<EpiOutM, pg8::StaticOrder, true, false>(lds, g, S, E, tid);
}
__device__ __forceinline__ void phase_moe_up_mfma(const Ctx& c, lds_u8* lds) {
  unsigned char* ws = c.ws; const int tid = phase_tid();
  int* offs = (int*)((unsigned char*)lds + pg8::STAGE_BYTES); int* cnts = offs + 65;
  expert_offsets(c, offs, cnts, tid);
  pg8::Gemm g{(const bf16_t*)(ws + WS_X1B), (const bf16_t*)(ws + WS_WGU), 1024};
  MoeOrder S{offs, cnts, 2, (int)gridDim.x, (int)blockIdx.x, (const unsigned*)(ws + WS_LIST)}; EpiMoeUpM E{(bf16_t*)(ws + WS_H)};
  pg8::gemm_phase<EpiMoeUpM, MoeOrder, true, true>(lds, g, S, E, tid);
}
__device__ __forceinline__ void phase_moe_down_mfma(const Ctx& c, lds_u8* lds) {
  unsigned char* ws = c.ws; const int tid = phase_tid();
  int* offs = (int*)((unsigned char*)lds + pg8::STAGE_BYTES); int* cnts = offs + 65;
  expert_offsets(c, offs, cnts, tid);
  pg8::Gemm g{(const bf16_t*)(ws + WS_H), (const bf16_t*)(ws + WS_WD), 256};
  MoeOrder S{offs, cnts, 4, (int)gridDim.x, (int)blockIdx.x, nullptr}; EpiMoeDownM E{(unsigned char*)(ws + WS_Y), (const float*)(ws + WS_GATEL)};
  pg8::gemm_phase<EpiMoeDownM, MoeOrder, true, false>(lds, g, S, E, tid);
}

__device__ void phase_kvup(const Ctx& c, float* lds) {
  unsigned char* ws = c.ws;
  const int tid = phase_tid(), lane = tid & 63, wave = tid >> 6, fr = lane & 15, fq = lane >> 4;
  const bf16_t* W = (const bf16_t*)(ws + WS_WKV);
  const bf16_t* CKV = (const bf16_t*)(ws + WS_CKV); bf16_t* KVA = (bf16_t*)(ws + WS_KVA);
  const float* cs = (const float*)(ws + WS_ROPE); const float* sn = cs + SEQ * 32;
  for (int tile = blockIdx.x * NWAVES + wave; tile < T / 16; tile += gridDim.x * NWAVES) {
    const int t = tile * 16 + fr, pos = t & (SEQ - 1);
    pg8::bf16x8 bx[4]; float ss = 0.f;
#pragma unroll
    for (int ks = 0; ks < 4; ++ks) { const u32x4 v = *(const u32x4*)(CKV + (size_t)t * 128 + ks * 32 + fq * 8); bx[ks] = __builtin_bit_cast(pg8::bf16x8, v);
      const float f[8] = {__uint_as_float(v.x << 16), __uint_as_float(v.x & 0xffff0000u), __uint_as_float(v.y << 16), __uint_as_float(v.y & 0xffff0000u), __uint_as_float(v.z << 16), __uint_as_float(v.z & 0xffff0000u), __uint_as_float(v.w << 16), __uint_as_float(v.w & 0xffff0000u)};
#pragma unroll
      for (int e = 0; e < 8; ++e) ss += f[e] * f[e]; }
    ss += __shfl_xor(ss, 16); ss += __shfl_xor(ss, 32);
    const float rstd = rsqrtf(ss * (1.f / 128.f) + 1e-6f);
#pragma unroll
    for (int nt = 0; nt < 8; ++nt) { f32x4 d = {0.f, 0.f, 0.f, 0.f};
#pragma unroll
      for (int ks = 0; ks < 4; ++ks) d = __builtin_amdgcn_mfma_f32_16x16x32_bf16(*(const pg8::bf16x8*)(W + (size_t)(nt * 16 + fr) * 128 + ks * 32 + fq * 8), bx[ks], d, 0, 0, 0);
      d = d * rstd;
      const int p0 = nt * 16 + fq * 4;
      if (nt < 4) { const int dd = p0 >> 1; const float c0 = cs[pos * 32 + dd], s0 = sn[pos * 32 + dd], c1 = cs[pos * 32 + dd + 1], s1 = sn[pos * 32 + dd + 1];
        const f32x4 o = {d.x * c0 - d.y * s0, d.y * c0 + d.x * s0, d.z * c1 - d.w * s1, d.w * c1 + d.z * s1}; d = o; }
      *(u32x2*)(KVA + (size_t)t * 128 + p0) = (u32x2){pg8::cvt_pk_bf16(d.x, d.y), pg8::cvt_pk_bf16(d.z, d.w)}; }
  }
}


typedef _Float16 h16x2 __attribute__((ext_vector_type(2)));
constexpr int TK_KP = 4104;
constexpr int TK_KEYS = 0, TK_H1 = 16 * TK_KP * 2, TK_H2 = TK_H1 + 16 * 128 * 4, TK_MISC = TK_H2 + 8 * 128 * 4;
__device__ __forceinline__ unsigned mono16x2(unsigned u) { const unsigned m = ((u >> 15) & 0x00010001u) * 0xffffu; return u ^ (m | 0x80008000u); }
__device__ __forceinline__ int wave_incl_scan(int x) {
  x += __builtin_amdgcn_update_dpp(0, x, 0x111, 0xF, 0xF, true);
  x += __builtin_amdgcn_update_dpp(0, x, 0x112, 0xF, 0xF, true);
  x += __builtin_amdgcn_update_dpp(0, x, 0x114, 0xF, 0xF, true);
  x += __builtin_amdgcn_update_dpp(0, x, 0x118, 0xF, 0xF, true);
  x += __builtin_amdgcn_update_dpp(0, x, 0x142, 0xA, 0xF, false);
  x += __builtin_amdgcn_update_dpp(0, x, 0x143, 0xC, 0xF, false);
  return x;
}

__device__ __forceinline__ void hist_find(const unsigned* hw, int need, int lane, int& B, int& above) {
  const unsigned w0 = hw[127 - 2 * lane], w1 = hw[126 - 2 * lane];
  const int c0 = (int)(w0 >> 16), c1 = (int)(w0 & 0xffffu), c2 = (int)(w1 >> 16), c3 = (int)(w1 & 0xffffu);
  const int tl = c0 + c1 + c2 + c3;
  const int incl = wave_incl_scan(tl);
  const int excl = incl - tl;
  const bool hit = (excl < need) && (incl >= need);
  int b = 0, ab = 0;
  if (hit) { int a = excl; b = 255 - 4 * lane; ab = a;
    if (a + c0 < need) { a += c0; b = 254 - 4 * lane; ab = a; if (a + c1 < need) { a += c1; b = 253 - 4 * lane; ab = a; if (a + c2 < need) { a += c2; b = 252 - 4 * lane; ab = a; } } } }
  const unsigned long long m = __ballot(hit);
  const int src = __builtin_amdgcn_readfirstlane(m ? (__ffsll((long long)m) - 1) : 0);
  B = __builtin_amdgcn_readlane(b, src); above = __builtin_amdgcn_readlane(ab, src);
}
__device__ void phase_topk_mfma(const Ctx& c, unsigned char* ldsb, unsigned* qhead) {
  unsigned char* ws = c.ws;
  const int tid = phase_tid(), lane = tid & 63, wave = tid >> 6, fr = lane & 15, fq = lane >> 4;
  unsigned short* keys = (unsigned short*)(ldsb + TK_KEYS);
  unsigned* h1 = (unsigned*)(ldsb + TK_H1); unsigned* h2 = (unsigned*)(ldsb + TK_H2) + wave * 128; int* misc = (int*)(ldsb + TK_MISC);
  const bf16_t* IQ = (const bf16_t*)(ws + WS_IQ); const bf16_t* IK = (const bf16_t*)(ws + WS_IK); const float* SM = (const float*)(ws + WS_SM);
  unsigned short* SEL = (unsigned short*)(ws + WS_SEL);
  WorkQ wq; wq_init(wq, qhead, misc, tid);
  for (;;) {
    const int item = wq_next(wq, tid);
    if (item >= 240 * 8) break;
    const int b = item & 7, qb = 255 - (item >> 3), s0 = qb * 16;
    for (int i = tid; i < 16 * 128; i += NTHREADS) h1[i] = 0u;
    const size_t qrow = (size_t)b * SEQ + s0 + fr;
    pg8::bf16x8 bq[4][2];
#pragma unroll
    for (int hh = 0; hh < 4; ++hh)
#pragma unroll
      for (int ks = 0; ks < 2; ++ks) bq[hh][ks] = *(const pg8::bf16x8*)(IQ + qrow * 256 + hh * 64 + ks * 32 + fq * 8);
    const f32x4 iw = *(const f32x4*)(SM + qrow * 16);
    const int nkt = qb + 1, slim = s0 + fr;
    __syncthreads();
    pg8::bf16x8 a0n = {0, 0, 0, 0, 0, 0, 0, 0}, a1n = a0n;
    if (wave < nkt) { const bf16_t* kr = IK + ((size_t)b * SEQ + wave * 16 + fr) * 64 + fq * 8; a0n = *(const pg8::bf16x8*)kr; a1n = *(const pg8::bf16x8*)(kr + 32); }
    for (int kt = wave; kt < nkt; kt += NWAVES) {
      const pg8::bf16x8 a0 = a0n, a1 = a1n;
      if (kt + NWAVES < nkt) { const bf16_t* kr = IK + ((size_t)b * SEQ + (kt + NWAVES) * 16 + fr) * 64 + fq * 8; a0n = *(const pg8::bf16x8*)kr; a1n = *(const pg8::bf16x8*)(kr + 32); }
      f32x4 sc = {0.f, 0.f, 0.f, 0.f};
#pragma unroll
      for (int hh = 0; hh < 4; ++hh) { f32x4 d = {0.f, 0.f, 0.f, 0.f};
        d = __builtin_amdgcn_mfma_f32_16x16x32_bf16(a0, bq[hh][0], d, 0, 0, 0); d = __builtin_amdgcn_mfma_f32_16x16x32_bf16(a1, bq[hh][1], d, 0, 0, 0);
        const float w = hh == 0 ? iw.x : hh == 1 ? iw.y : hh == 2 ? iw.z : iw.w;
        sc.x = fmaf(w, fmaxf(d.x, 0.f), sc.x); sc.y = fmaf(w, fmaxf(d.y, 0.f), sc.y); sc.z = fmaf(w, fmaxf(d.z, 0.f), sc.z); sc.w = fmaf(w, fmaxf(d.w, 0.f), sc.w); }
      unsigned k01 = mono16x2(__builtin_bit_cast(unsigned, __builtin_amdgcn_cvt_pkrtz(sc.x, sc.y))), k23 = mono16x2(__builtin_bit_cast(unsigned, __builtin_amdgcn_cvt_pkrtz(sc.z, sc.w)));
      const int kbase = kt * 16 + fq * 4;
      unsigned* hq = h1 + fr * 128;
      if (kt + 1 < nkt) {
        *(u32x2*)(keys + fr * TK_KP + kbase) = (u32x2){k01, k23};
        { const unsigned kk = k01 & 0xffffu; atomicAdd(hq + (kk >> 9), 1u << ((kk >> 4) & 16)); }
        { const unsigned kk = k01 >> 16; atomicAdd(hq + (kk >> 9), 1u << ((kk >> 4) & 16)); }
        { const unsigned kk = k23 & 0xffffu; atomicAdd(hq + (kk >> 9), 1u << ((kk >> 4) & 16)); }
        { const unsigned kk = k23 >> 16; atomicAdd(hq + (kk >> 9), 1u << ((kk >> 4) & 16)); }
      } else {
        if (kbase + 0 > slim) k01 &= 0xffff0000u; if (kbase + 1 > slim) k01 &= 0x0000ffffu;
        if (kbase + 2 > slim) k23 &= 0xffff0000u; if (kbase + 3 > slim) k23 &= 0x0000ffffu;
        *(u32x2*)(keys + fr * TK_KP + kbase) = (u32x2){k01, k23};
        if (kbase + 0 <= slim) { const unsigned kk = k01 & 0xffffu; atomicAdd(hq + (kk >> 9), 1u << ((kk >> 4) & 16)); }
        if (kbase + 1 <= slim) { const unsigned kk = k01 >> 16; atomicAdd(hq + (kk >> 9), 1u << ((kk >> 4) & 16)); }
        if (kbase + 2 <= slim) { const unsigned kk = k23 & 0xffffu; atomicAdd(hq + (kk >> 9), 1u << ((kk >> 4) & 16)); }
        if (kbase + 3 <= slim) { const unsigned kk = k23 >> 16; atomicAdd(hq + (kk >> 9), 1u << ((kk >> 4) & 16)); }
      }
    }
    __syncthreads();
    for (int qi = 0; qi < 2; ++qi) {
      const int q = wave * 2 + qi, s = s0 + q, n = s + 1;
      int B1, above1; hist_find(h1 + q * 128, 256, lane, B1, above1);
      const int need1 = 256 - above1;
      h2[lane] = 0u; h2[64 + lane] = 0u;
      const unsigned short* kq = keys + q * TK_KP;
      const int niter = (n + 511) >> 9;
      for (int it = 0; it < niter; ++it) {
        const int i0 = (it * 64 + lane) * 8; const u32x4 kv = *(const u32x4*)(kq + i0);
        const unsigned k8[8] = {kv.x & 0xffffu, kv.x >> 16, kv.y & 0xffffu, kv.y >> 16, kv.z & 0xffffu, kv.z >> 16, kv.w & 0xffffu, kv.w >> 16};
#pragma unroll
        for (int e = 0; e < 8; ++e) if (i0 + e < n && (int)(k8[e] >> 8) == B1) atomicAdd(h2 + ((k8[e] & 255u) >> 1), 1u << ((k8[e] & 1u) * 16));
      }
      int B2, above2; hist_find(h2, need1, lane, B2, above2);
      const unsigned thr = (unsigned)((B1 << 8) | B2); const int need = need1 - above2;
      unsigned short* dummy = (unsigned short*)(misc + 8 + wave);
      unsigned short* sel = (unsigned short*)h2;
      asm volatile("s_waitcnt lgkmcnt(0)" ::: "memory");
      int tiebase = 0, outbase = 0;
      for (int it = 0; it < niter; ++it) {
        const int i0 = (it * 64 + lane) * 8; const u32x4 kv = *(const u32x4*)(kq + i0);
        const unsigned k8[8] = {kv.x & 0xffffu, kv.x >> 16, kv.y & 0xffffu, kv.y >> 16, kv.z & 0xffffu, kv.z >> 16, kv.w & 0xffffu, kv.w >> 16};
        int cg = 0, ce = 0;
#pragma unroll
        for (int e = 0; e < 8; ++e) { const bool v = i0 + e < n; cg += (v && k8[e] > thr) ? 1 : 0; ce += (v && k8[e] == thr) ? 1 : 0; }
        int tk = 0;
        if (__ballot(ce != 0)) {
          const int eincl = wave_incl_scan(ce); const int eg = tiebase + eincl - ce;
          tk = need - eg; tk = tk < 0 ? 0 : (tk > ce ? ce : tk);
          tiebase += __builtin_amdgcn_readlane(eincl, 63);
        }
        const int oc = cg + tk; const int oincl = wave_incl_scan(oc);
        int pos = outbase + oincl - oc; int tleft = tk;
#pragma unroll
        for (int e = 0; e < 8; ++e) { const bool v = i0 + e < n; const bool tie = v && k8[e] == thr && tleft > 0; const bool take = (v && k8[e] > thr) || tie;
          tleft -= tie ? 1 : 0;
          unsigned short* dst = (take && pos < 256) ? sel + pos : dummy;
          *dst = (unsigned short)(i0 + e); pos += take ? 1 : 0; }
        outbase += __builtin_amdgcn_readlane(oincl, 63);
      }
      asm volatile("s_waitcnt lgkmcnt(0)" ::: "memory");
      *(u32x2*)(SEL + ((size_t)b * SEQ + s) * 256 + lane * 4) = *(const u32x2*)(sel + lane * 4);
      asm volatile("s_waitcnt lgkmcnt(0)" ::: "memory");
    }
  }
}

typedef short s16x4 __attribute__((ext_vector_type(4)));
__device__ __forceinline__ s16x4 lds_tr16(const unsigned char* p) { return __builtin_bit_cast(s16x4, __builtin_amdgcn_ds_read_tr16_b64_v4i16((__attribute__((address_space(3))) s16x4*)(__attribute__((address_space(3))) unsigned char*)p)); }
typedef float f32x2_t __attribute__((ext_vector_type(2))); typedef __bf16 bf16x2_t __attribute__((ext_vector_type(2)));
__device__ __forceinline__ unsigned cvtpk_c(float lo, float hi) { const f32x2_t v = {lo, hi}; const bf16x2_t b = __builtin_convertvector(v, bf16x2_t); return __builtin_bit_cast(unsigned, b); }
__device__ __forceinline__ pg8::bf16x8 packp(const f32x4& a, const f32x4& b) {
  const u32x4 w = {cvtpk_c(a.x, a.y), cvtpk_c(a.z, a.w), cvtpk_c(b.x, b.y), cvtpk_c(b.z, b.w)}; return __builtin_bit_cast(pg8::bf16x8, w); }
constexpr int AT_WB = 9216 + 512;
__device__ void phase_attn_sparse(const Ctx& c, unsigned char* ldsb, unsigned* qhead) {
  unsigned char* ws = c.ws;
  const int tid = phase_tid(), lane = tid & 63, wave = tid >> 6, fr = lane & 15, fq = lane >> 4;
  unsigned char* vl = ldsb + wave * AT_WB; unsigned short* sl = (unsigned short*)(vl + 9216);
  const bf16_t* QA = (const bf16_t*)(ws + WS_QA); const bf16_t* KVA = (const bf16_t*)(ws + WS_KVA); const unsigned short* SEL = (const unsigned short*)(ws + WS_SEL);
  const bf16_t* QC = (const bf16_t*)(ws + WS_QC); const bf16_t* MK = (const bf16_t*)(ws + WS_MK); const bf16_t* MVT = (const bf16_t*)(ws + WS_MVT);
  bf16_t* CAT = (bf16_t*)(ws + WS_CAT);
  const float* gA = c.in[10]; const float* gC = c.in[11];
  const pg8::bf16x8 zero8 = {0, 0, 0, 0, 0, 0, 0, 0};
  __syncthreads();
  int* aq_slot = (int*)(ldsb + 8 * AT_WB);
  WorkQ wq; wq_init(wq, qhead, aq_slot, tid);
  for (;;) {
  const int item = wq_next(wq, tid);
  if (item >= 512) break;
  for (int tj = 0; tj < 8; ++tj) {
    const int t = item * 64 + wave * 8 + tj;
    const int b = t >> 12, s = t & (SEQ - 1), n = s + 1 < 256 ? s + 1 : 256;
    { u32x2 v;
      if (s >= 256) v = *(const u32x2*)(SEL + (size_t)t * 256 + lane * 4);
      else { const int i0 = lane * 4; const unsigned e0 = i0 < n ? i0 : 0, e1 = i0 + 1 < n ? i0 + 1 : 0, e2 = i0 + 2 < n ? i0 + 2 : 0, e3 = i0 + 3 < n ? i0 + 3 : 0; v = (u32x2){e0 | (e1 << 16), e2 | (e3 << 16)}; }
      *(u32x2*)(sl + lane * 4) = v; }
    asm volatile("s_waitcnt lgkmcnt(0)" ::: "memory");
    pg8::bf16x8 bq0 = zero8, bq1 = zero8;
    if (fr < 6) { const bf16_t* qp = QA + (size_t)t * 384 + fr * 64 + fq * 8; bq0 = *(const pg8::bf16x8*)qp; bq1 = *(const pg8::bf16x8*)(qp + 32); }
    const bf16_t* kvb = KVA + (size_t)b * SEQ * 128;
    f32x4 st[16];
#pragma unroll
    for (int kt = 0; kt < 16; ++kt) { const int key = sl[kt * 16 + fr]; const bf16_t* kr = kvb + (size_t)key * 128 + fq * 8;
      const pg8::bf16x8 a0 = *(const pg8::bf16x8*)kr, a1 = *(const pg8::bf16x8*)(kr + 32);
      f32x4 d = {0.f, 0.f, 0.f, 0.f};
      d = __builtin_amdgcn_mfma_f32_16x16x32_bf16(a0, bq0, d, 0, 0, 0); st[kt] = __builtin_amdgcn_mfma_f32_16x16x32_bf16(a1, bq1, d, 0, 0, 0); }
    u32x4 vva[8], vvb[8];
#pragma unroll
    for (int i = 0; i < 8; ++i) { const int key = sl[i * 8 + (lane >> 3)]; vva[i] = *(const u32x4*)(kvb + (size_t)key * 128 + 64 + (lane & 7) * 8); }
    float mx = -3.0e38f;
    if (n < 256) {
#pragma unroll
      for (int kt = 0; kt < 16; ++kt) { const int sb = kt * 16 + fq * 4;
        if (sb + 0 >= n) st[kt].x = -3.0e38f; if (sb + 1 >= n) st[kt].y = -3.0e38f; if (sb + 2 >= n) st[kt].z = -3.0e38f; if (sb + 3 >= n) st[kt].w = -3.0e38f; } }
#pragma unroll
    for (int kt = 0; kt < 16; ++kt) mx = fmaxf(fmaxf(fmaxf(mx, st[kt].x), fmaxf(st[kt].y, st[kt].z)), st[kt].w);
    mx = fmaxf(mx, __shfl_xor(mx, 16)); mx = fmaxf(mx, __shfl_xor(mx, 32));
    float l = 0.f;
#pragma unroll
    for (int kt = 0; kt < 16; ++kt) { st[kt].x = __builtin_amdgcn_exp2f(st[kt].x - mx); st[kt].y = __builtin_amdgcn_exp2f(st[kt].y - mx); st[kt].z = __builtin_amdgcn_exp2f(st[kt].z - mx); st[kt].w = __builtin_amdgcn_exp2f(st[kt].w - mx);
      l += (st[kt].x + st[kt].y) + (st[kt].z + st[kt].w); }
    l += __shfl_xor(l, 16); l += __shfl_xor(l, 32);
    f32x4 ot[4];
#pragma unroll
    for (int mt = 0; mt < 4; ++mt) ot[mt] = (f32x4){0.f, 0.f, 0.f, 0.f};
#define VLOAD(R, CH) do { _Pragma("unroll") for (int i_ = 0; i_ < 8; ++i_) { const int key_ = sl[(CH) * 64 + i_ * 8 + (lane >> 3)]; R[i_] = *(const u32x4*)(kvb + (size_t)key_ * 128 + 64 + (lane & 7) * 8); } } while (0)
#define VSTORE(R) do { _Pragma("unroll") for (int i_ = 0; i_ < 8; ++i_) *(u32x4*)(vl + (i_ * 8 + (lane >> 3)) * 144 + (lane & 7) * 16) = R[i_]; } while (0)
#define VPROC(CH) do { asm volatile("s_waitcnt lgkmcnt(0)" ::: "memory"); \
      _Pragma("unroll") for (int k2 = 0; k2 < 2; ++k2) { const int kk = (CH) * 2 + k2; const pg8::bf16x8 pf = pfr[kk]; \
        const unsigned char* base = vl + (k2 * 32 + fq * 4 + (fr >> 2)) * 144 + (fr & 3) * 8; \
        _Pragma("unroll") for (int mt = 0; mt < 4; ++mt) { const s16x4 lo = lds_tr16(base + mt * 32), hi = lds_tr16(base + 16 * 144 + mt * 32); \
          const pg8::bf16x8 af = {lo[0], lo[1], lo[2], lo[3], hi[0], hi[1], hi[2], hi[3]}; \
          ot[mt] = __builtin_amdgcn_mfma_f32_16x16x32_bf16(af, pf, ot[mt], 0, 0, 0); } } \
      asm volatile("s_waitcnt lgkmcnt(0)" ::: "memory"); } while (0)
    pg8::bf16x8 pfr[8];
#pragma unroll
    for (int kk = 0; kk < 8; ++kk) pfr[kk] = packp(st[2 * kk], st[2 * kk + 1]);
    asm volatile("" ::: "memory");
#pragma unroll
    for (int i = 0; i < 8; ++i) { const int key = sl[64 + i * 8 + (lane >> 3)]; vvb[i] = *(const u32x4*)(kvb + (size_t)key * 128 + 64 + (lane & 7) * 8); }
    VSTORE(vva); VLOAD(vva, 2); VPROC(0);
    VSTORE(vvb); VLOAD(vvb, 3); VPROC(1);
    VSTORE(vva); VPROC(2);
    VSTORE(vvb); VPROC(3);
#undef VLOAD
#undef VSTORE
#undef VPROC
    const float il = __builtin_amdgcn_rcpf(l); float ss = 0.f;
#pragma unroll
    for (int mt = 0; mt < 4; ++mt) { ot[mt] = ot[mt] * il; ss += (ot[mt].x * ot[mt].x + ot[mt].y * ot[mt].y) + (ot[mt].z * ot[mt].z + ot[mt].w * ot[mt].w); }
    if (fr >= 6) ss = 0.f;
#pragma unroll
    for (int o = 1; o < 64; o <<= 1) ss += __shfl_xor(ss, o);
    const float rstd = rsqrtf(ss * (1.f / 384.f) + 1e-6f);
    if (fr < 6) {
#pragma unroll
      for (int mt = 0; mt < 4; ++mt) { const int col = fr * 64 + mt * 16 + fq * 4; const f32x4 g = *(const f32x4*)(gA + col); const f32x4 o = ot[mt] * rstd * g;
        *(u32x2*)(CAT + (size_t)t * 1024 + col) = (u32x2){pg8::cvt_pk_bf16(o.x, o.y), pg8::cvt_pk_bf16(o.z, o.w)}; } }
  }
  }
}

__device__ void phase_attn_mem(const Ctx& c, unsigned char* ldsb, unsigned* qhead) {
  unsigned char* ws = c.ws;
  const int tid = phase_tid(), lane = tid & 63, wave = tid >> 6, fr = lane & 15, fq = lane >> 4;
  unsigned char* vl = ldsb + wave * AT_WB; unsigned short* sl = (unsigned short*)(vl + 9216);
  const bf16_t* QA = (const bf16_t*)(ws + WS_QA); const bf16_t* KVA = (const bf16_t*)(ws + WS_KVA); const unsigned short* SEL = (const unsigned short*)(ws + WS_SEL);
  const bf16_t* QC = (const bf16_t*)(ws + WS_QC); const bf16_t* MK = (const bf16_t*)(ws + WS_MK); const bf16_t* MVT = (const bf16_t*)(ws + WS_MVT);
  bf16_t* CAT = (bf16_t*)(ws + WS_CAT);
  const float* gA = c.in[10]; const float* gC = c.in[11];
  const pg8::bf16x8 zero8 = {0, 0, 0, 0, 0, 0, 0, 0};
  int* aq_slot = (int*)(ldsb + 70656 + 8 * 8192);
  WorkQ wq; wq_init(wq, qhead, aq_slot, tid);
  for (;;) {
  const int item = wq_next(wq, tid) + 512;
  if (item >= 768) break;
  {
    const int t0 = (item - 512) * 128 + wave * 16, b = t0 >> 12;
    unsigned char* mkl = ldsb; unsigned char* mvl = ldsb + 36864; unsigned char* ocl = ldsb + 70656 + wave * 8192;
    float ss = 0.f;
#pragma unroll 1
    for (int h = 0; h < 4; ++h) {
      __syncthreads();
#pragma unroll
      for (int i = 0; i < 4; ++i) { const int p = tid + 512 * i, row = p >> 3, cc = p & 7;
        *(u32x4*)(mkl + row * 144 + cc * 16) = *(const u32x4*)(MK + ((size_t)(b * 256 + row)) * 256 + h * 64 + cc * 8); }
#pragma unroll
      for (int i = 0; i < 4; ++i) { const int p = tid + 512 * i, row = p >> 5, cc = p & 31;
        *(u32x4*)(mvl + row * 528 + cc * 16) = *(const u32x4*)(MVT + ((size_t)(b * 256 + h * 64 + row)) * 256 + cc * 8); }
      __syncthreads();
      f32x4 oc[4];
      const bf16_t* qp = QC + (size_t)(t0 + fr) * 256 + h * 64 + fq * 8;
      const pg8::bf16x8 bq0 = *(const pg8::bf16x8*)qp, bq1 = *(const pg8::bf16x8*)(qp + 32);
      f32x4 st[16];
#pragma unroll
      for (int kt = 0; kt < 16; ++kt) { const unsigned char* kr = mkl + (kt * 16 + fr) * 144 + fq * 16;
        const pg8::bf16x8 a0 = *(const pg8::bf16x8*)kr, a1 = *(const pg8::bf16x8*)(kr + 64);
        f32x4 d = {0.f, 0.f, 0.f, 0.f};
        d = __builtin_amdgcn_mfma_f32_16x16x32_bf16(a0, bq0, d, 0, 0, 0); st[kt] = __builtin_amdgcn_mfma_f32_16x16x32_bf16(a1, bq1, d, 0, 0, 0); }
      float mx = -3.0e38f;
#pragma unroll
      for (int kt = 0; kt < 16; ++kt) mx = fmaxf(fmaxf(fmaxf(mx, st[kt].x), fmaxf(st[kt].y, st[kt].z)), st[kt].w);
      mx = fmaxf(mx, __shfl_xor(mx, 16)); mx = fmaxf(mx, __shfl_xor(mx, 32));
      float l = 0.f;
#pragma unroll
      for (int kt = 0; kt < 16; ++kt) { st[kt].x = __builtin_amdgcn_exp2f(st[kt].x - mx); st[kt].y = __builtin_amdgcn_exp2f(st[kt].y - mx); st[kt].z = __builtin_amdgcn_exp2f(st[kt].z - mx); st[kt].w = __builtin_amdgcn_exp2f(st[kt].w - mx);
        l += (st[kt].x + st[kt].y) + (st[kt].z + st[kt].w); }
      l += __shfl_xor(l, 16); l += __shfl_xor(l, 32);
#pragma unroll
      for (int mt = 0; mt < 4; ++mt) oc[mt] = (f32x4){0.f, 0.f, 0.f, 0.f};
#pragma unroll
      for (int kk = 0; kk < 8; ++kk) { const pg8::bf16x8 pf = packp(st[2 * kk], st[2 * kk + 1]);
#pragma unroll
        for (int mt = 0; mt < 4; ++mt) { const pg8::bf16x8 af = *(const pg8::bf16x8*)(mvl + (mt * 16 + fr) * 528 + (kk * 4 + fq) * 16);
          oc[mt] = __builtin_amdgcn_mfma_f32_16x16x32_bf16(af, pf, oc[mt], 0, 0, 0); } }
      const float il = __builtin_amdgcn_rcpf(l);
#pragma unroll
      for (int mt = 0; mt < 4; ++mt) { const f32x4 o = oc[mt] * il; ss += (o.x * o.x + o.y * o.y) + (o.z * o.z + o.w * o.w); *(u32x2*)(ocl + ((h * 4 + mt) * 64 + lane) * 8) = (u32x2){pg8::cvt_pk_bf16(o.x, o.y), pg8::cvt_pk_bf16(o.z, o.w)}; }
    }
    ss += __shfl_xor(ss, 16); ss += __shfl_xor(ss, 32);
    const float rstd = rsqrtf(ss * (1.f / 256.f) + 1e-6f);
#pragma unroll 1
    for (int h = 0; h < 4; ++h)
#pragma unroll
      for (int mt = 0; mt < 4; ++mt) { const int col = h * 64 + mt * 16 + fq * 4; const f32x4 g = *(const f32x4*)(gC + col); const u32x2 pp = *(const u32x2*)(ocl + ((h * 4 + mt) * 64 + lane) * 8);
        const f32x4 ov = {__uint_as_float(pp.x << 16), __uint_as_float(pp.x & 0xffff0000u), __uint_as_float(pp.y << 16), __uint_as_float(pp.y & 0xffff0000u)}; const f32x4 o = ov * rstd * g;
        *(u32x2*)(CAT + (size_t)(t0 + fr) * 1024 + 768 + col) = (u32x2){pg8::cvt_pk_bf16(o.x, o.y), pg8::cvt_pk_bf16(o.z, o.w)}; }
  }
  }
}

constexpr int GD_ITEM = 41088;
__device__ __forceinline__ unsigned char* gd_item(unsigned char* ws, int it) { return it < 1536 ? ws + WS_XB + (size_t)it * GD_ITEM : ws + WS_X1B + (size_t)(it - 1536) * GD_ITEM; }
__device__ __forceinline__ int kperm(int x) { return (x & 32) | (((x >> 2) & 3) << 3) | (x & 3) | (((x >> 4) & 1) << 2); }
constexpr int GP_KB = 0, GP_KBB = 9216, GP_QB = 18432, GP_VBT = 27648, GP_KBET = 36864, GP_XR = 46080  , GP_PR = 82944  , GP_OUT = 101376, GP_SC = 142336;
__device__ __forceinline__ pg8::bf16x8 ldsfrag(const unsigned char* base, int row, int ks, int fq) { return *(const pg8::bf16x8*)(base + row * 144 + ks * 64 + fq * 16); }
constexpr int G2_KB = 0, G2_KBB = 9216, G2_QB = 18432, G2_XR0 = 27648, G2_XT0 = 36864, G2_PR0 = 46080, G2_VBT = 55296, G2_KBET = 64512, G2_SC = 73728, G2_CW = 75264, G2_HALF = 78336;
__device__ void phase_gdn_prep2(const Ctx& c, unsigned char* Lb) {
  unsigned char* ws = c.ws;
  const int tid = phase_tid(), lane = tid & 63, wave = tid >> 6, fr = lane & 15, fq = lane >> 4;
  const int hb = wave >> 2, w4 = wave & 3, htid = tid & 255;
  unsigned char* L = Lb + hb * G2_HALF;
  const bf16_t* GB = (const bf16_t*)(ws + WS_GB); const float* SM = (const float*)(ws + WS_SM);
  const float* convw = c.in[6];
  float* sc = (float*)(L + G2_SC);
  float* cw = (float*)(L + G2_CW);
  const int tt = htid >> 2, part = htid & 3;
  for (int it2 = blockIdx.x; it2 < 1536; it2 += gridDim.x) {
    const int it = it2 * 2 + hb;
    const int n = it & 63, bh = it >> 6, b = bh / 6, h = bh % 6;
    const int t = n * 64 + tt; const size_t r = (size_t)b * SEQ + t;
    unsigned char* gb = gd_item(ws, it);
    __syncthreads();
    for (int i = htid; i < 768; i += 256) { const int j = i / 192, rr = i % 192; cw[i] = convw[j * 1152 + (rr >> 6) * 384 + h * 64 + (rr & 63)]; }
    if (part == 0) { const float a = SM[r * 16 + 4 + h], bb = SM[r * 16 + 10 + h]; const float xs = a + c.in[8][h]; const float sp = xs > 20.f ? xs : log1pf(__expf(xs));
      sc[tt] = -__expf(c.in[7][h]) * sp; sc[192 + tt] = 1.f / (1.f + __expf(-bb)); }
    __syncthreads();
    if (w4 == 0) { float v = sc[lane];
#pragma unroll
      for (int o = 1; o < 64; o <<= 1) { const float u = __shfl_up(v, o); if (lane >= o) v += u; }
      const float last = __shfl(v, 63);
      sc[64 + lane] = v; sc[128 + lane] = __expf(v); sc[256 + lane] = __expf(last - v); if (lane == 0) { sc[320] = __expf(last); *(float*)(gb + 40960) = __expf(last); } }
    float qv[16], kv[16], vv[16];
#pragma unroll
    for (int role = 0; role < 3; ++role) {
      float acc[16];
#pragma unroll
      for (int e = 0; e < 16; ++e) acc[e] = 0.f;
      u32x4 xr[4][2];
#pragma unroll
      for (int j = 0; j < 4; ++j) { const bool ok = t - 3 + j >= 0; const bf16_t* xp = GB + (r - 3 + j) * 1536 + role * 384 + h * 64 + part * 16;
        xr[j][0] = ok ? *(const u32x4*)xp : (u32x4){0u, 0u, 0u, 0u}; xr[j][1] = ok ? *(const u32x4*)(xp + 8) : (u32x4){0u, 0u, 0u, 0u}; }
#pragma unroll
      for (int j = 0; j < 4; ++j)
#pragma unroll
        for (int hh = 0; hh < 2; ++hh) { const u32x4 xvv = xr[j][hh]; const float* wj = cw + j * 192 + role * 64 + part * 16 + hh * 8;
          const f32x4 w0 = *(const f32x4*)wj, w1 = *(const f32x4*)(wj + 4);
          acc[hh * 8 + 0] += w0.x * __uint_as_float(xvv.x << 16); acc[hh * 8 + 1] += w0.y * __uint_as_float(xvv.x & 0xffff0000u); acc[hh * 8 + 2] += w0.z * __uint_as_float(xvv.y << 16); acc[hh * 8 + 3] += w0.w * __uint_as_float(xvv.y & 0xffff0000u);
          acc[hh * 8 + 4] += w1.x * __uint_as_float(xvv.z << 16); acc[hh * 8 + 5] += w1.y * __uint_as_float(xvv.z & 0xffff0000u); acc[hh * 8 + 6] += w1.z * __uint_as_float(xvv.w << 16); acc[hh * 8 + 7] += w1.w * __uint_as_float(xvv.w & 0xffff0000u); }
      float ss = 0.f;
#pragma unroll
      for (int e = 0; e < 16; ++e) { acc[e] = silu_f(acc[e]); ss += acc[e] * acc[e]; }
      if (role < 2) { ss += __shfl_xor(ss, 1); ss += __shfl_xor(ss, 2); const float scl = rsqrtf(ss + 1e-6f) * (role == 0 ? 0.125f : 1.f);
#pragma unroll
        for (int e = 0; e < 16; ++e) acc[e] *= scl; }
#pragma unroll
      for (int e = 0; e < 16; ++e) { if (role == 0) qv[e] = acc[e]; else if (role == 1) kv[e] = acc[e]; else vv[e] = acc[e]; }
    }
    __syncthreads();
    { const float beta = sc[192 + tt], eg = sc[128 + tt], ekl = sc[256 + tt];
      float kb[16];
#pragma unroll
      for (int e = 0; e < 16; ++e) kb[e] = kv[e] * beta;
#pragma unroll
      for (int hh = 0; hh < 2; ++hh) { const int o8 = hh * 8;
        *(u32x4*)(L + G2_KB + tt * 144 + part * 32 + hh * 16) = (u32x4){pk2(kv[o8], kv[o8 + 1]), pk2(kv[o8 + 2], kv[o8 + 3]), pk2(kv[o8 + 4], kv[o8 + 5]), pk2(kv[o8 + 6], kv[o8 + 7])};
        *(u32x4*)(L + G2_KBB + tt * 144 + part * 32 + hh * 16) = (u32x4){pk2(kb[o8], kb[o8 + 1]), pk2(kb[o8 + 2], kb[o8 + 3]), pk2(kb[o8 + 4], kb[o8 + 5]), pk2(kb[o8 + 6], kb[o8 + 7])};
        *(u32x4*)(L + G2_QB + tt * 144 + part * 32 + hh * 16) = (u32x4){pk2(qv[o8], qv[o8 + 1]), pk2(qv[o8 + 2], qv[o8 + 3]), pk2(qv[o8 + 4], qv[o8 + 5]), pk2(qv[o8 + 6], qv[o8 + 7])}; }
      const int ptt = kperm(tt);
#pragma unroll
      for (int e = 0; e < 16; ++e) { const int d = part * 16 + e;
        *(bf16_t*)(L + G2_VBT + d * 144 + tt * 2) = f2bf(vv[e] * beta);
        *(bf16_t*)(L + G2_KBET + d * 144 + tt * 2) = f2bf(kb[e] * eg);
        *(bf16_t*)(gb + 8192 + tt * 128 + kperm(d) * 2) = f2bf(qv[e] * eg);
        *(bf16_t*)(gb + 3 * 8192 + d * 128 + ptt * 2) = f2bf(kv[e] * ekl); } }
    __syncthreads();
    const int rowb = (w4 * 16 + fq * 4) * 144 + fr * 2;
    const int colb = fr * 144 + (w4 * 16 + fq * 4) * 2;
    const int fa = (w4 * 16 + fr) * 144 + fq * 16;
    const int fb = fr * 144 + fq * 16;
    const int i0 = w4 * 16 + fq * 4;
#define G2F(buf, off) (*(const pg8::bf16x8*)(L + (buf) + (off)))
#define G2W16(buf, off, v) (*(bf16_t*)(L + (buf) + (off)) = f2bf(v))
    f32x4 Pt[4];
    { const float gi0 = sc[64 + i0], gi1 = sc[64 + i0 + 1], gi2 = sc[64 + i0 + 2], gi3 = sc[64 + i0 + 3];
#pragma unroll
    for (int u = 0; u < 4; ++u) {
      f32x4 dl = {0.f, 0.f, 0.f, 0.f}, da = {0.f, 0.f, 0.f, 0.f};
#pragma unroll
      for (int ks = 0; ks < 2; ++ks) { const pg8::bf16x8 bk = G2F(G2_KB, fb + u * 2304 + ks * 64);
        dl = __builtin_amdgcn_mfma_f32_16x16x32_bf16(G2F(G2_KBB, fa + ks * 64), bk, dl, 0, 0, 0);
        da = __builtin_amdgcn_mfma_f32_16x16x32_bf16(G2F(G2_QB, fa + ks * 64), bk, da, 0, 0, 0); }
      const int j = u * 16 + fr; const float gj = sc[64 + j]; const int pj = kperm(j);
      const float dec0 = __expf(fminf(gi0 - gj, 0.f)), dec1 = __expf(fminf(gi1 - gj, 0.f)), dec2 = __expf(fminf(gi2 - gj, 0.f)), dec3 = __expf(fminf(gi3 - gj, 0.f));
      const float l0 = i0 + 0 > j ? dl.x * dec0 : 0.f, l1 = i0 + 1 > j ? dl.y * dec1 : 0.f, l2 = i0 + 2 > j ? dl.z * dec2 : 0.f, l3 = i0 + 3 > j ? dl.w * dec3 : 0.f;
      const float a0 = i0 + 0 >= j ? da.x * dec0 : 0.f, a1 = i0 + 1 >= j ? da.y * dec1 : 0.f, a2 = i0 + 2 >= j ? da.z * dec2 : 0.f, a3 = i0 + 3 >= j ? da.w * dec3 : 0.f;
      const f32x4 pv = {(i0 + 0 == j ? 1.f : 0.f) - l0, (i0 + 1 == j ? 1.f : 0.f) - l1, (i0 + 2 == j ? 1.f : 0.f) - l2, (i0 + 3 == j ? 1.f : 0.f) - l3};
      G2W16(G2_XR0, rowb + u * 32, l0); G2W16(G2_XR0, rowb + 144 + u * 32, l1); G2W16(G2_XR0, rowb + 288 + u * 32, l2); G2W16(G2_XR0, rowb + 432 + u * 32, l3);
      G2W16(G2_PR0, rowb + u * 32, pv.x); G2W16(G2_PR0, rowb + 144 + u * 32, pv.y); G2W16(G2_PR0, rowb + 288 + u * 32, pv.z); G2W16(G2_PR0, rowb + 432 + u * 32, pv.w);
      *(u32x2*)(L + G2_XT0 + colb + u * 2304) = (u32x2){pk2(l0, l1), pk2(l2, l3)};
      bf16_t* am = (bf16_t*)(gb + 2 * 8192 + i0 * 128 + pj * 2);
      am[0] = f2bf(a0); am[64] = f2bf(a1); am[128] = f2bf(a2); am[192] = f2bf(a3);
      Pt[u] = pv; } }
    __syncthreads();
#pragma unroll
    for (int u = 0; u < 4; ++u) {
      f32x4 d = {0.f, 0.f, 0.f, 0.f};
#pragma unroll
      for (int ks = 0; ks < 2; ++ks) d = __builtin_amdgcn_mfma_f32_16x16x32_bf16(G2F(G2_XR0, fa + ks * 64), G2F(G2_XT0, fb + u * 2304 + ks * 64), d, 0, 0, 0);
      G2W16(G2_KB, rowb + u * 32, d.x); G2W16(G2_KB, rowb + 144 + u * 32, d.y); G2W16(G2_KB, rowb + 288 + u * 32, d.z); G2W16(G2_KB, rowb + 432 + u * 32, d.w);
      *(u32x2*)(L + G2_KBB + colb + u * 2304) = (u32x2){pk2(d.x, d.y), pk2(d.z, d.w)}; }
    __syncthreads();
#pragma unroll
    for (int itn = 0; itn < 4; ++itn) {
      const int XRc = (itn & 1) ? G2_XR0 : G2_KB, XTc = (itn & 1) ? G2_XT0 : G2_KBB, XRn = (itn & 1) ? G2_KB : G2_XR0, XTn = (itn & 1) ? G2_KBB : G2_XT0;
      const int PRc = (itn & 1) ? G2_QB : G2_PR0, PRn = (itn & 1) ? G2_PR0 : G2_QB;
#pragma unroll
      for (int u = 0; u < 4; ++u) {
        f32x4 d = {0.f, 0.f, 0.f, 0.f};
#pragma unroll
        for (int ks = 0; ks < 2; ++ks) { const pg8::bf16x8 bx = G2F(XTc, fb + u * 2304 + ks * 64);
          Pt[u] = __builtin_amdgcn_mfma_f32_16x16x32_bf16(G2F(PRc, fa + ks * 64), bx, Pt[u], 0, 0, 0);
          if (itn < 3) d = __builtin_amdgcn_mfma_f32_16x16x32_bf16(G2F(XRc, fa + ks * 64), bx, d, 0, 0, 0); }
        G2W16(PRn, rowb + u * 32, Pt[u].x); G2W16(PRn, rowb + 144 + u * 32, Pt[u].y); G2W16(PRn, rowb + 288 + u * 32, Pt[u].z); G2W16(PRn, rowb + 432 + u * 32, Pt[u].w);
        if (itn < 3) { G2W16(XRn, rowb + u * 32, d.x); G2W16(XRn, rowb + 144 + u * 32, d.y); G2W16(XRn, rowb + 288 + u * 32, d.z); G2W16(XRn, rowb + 432 + u * 32, d.w);
          *(u32x2*)(L + XTn + colb + u * 2304) = (u32x2){pk2(d.x, d.y), pk2(d.z, d.w)}; } }
      __syncthreads();
    }
#pragma unroll
    for (int u = 0; u < 4; ++u) {
      f32x4 du = {0.f, 0.f, 0.f, 0.f}, dw = {0.f, 0.f, 0.f, 0.f};
#pragma unroll
      for (int ks = 0; ks < 2; ++ks) { const pg8::bf16x8 a = G2F(G2_PR0, fa + ks * 64);
        du = __builtin_amdgcn_mfma_f32_16x16x32_bf16(a, G2F(G2_VBT, fb + u * 2304 + ks * 64), du, 0, 0, 0);
        dw = __builtin_amdgcn_mfma_f32_16x16x32_bf16(a, G2F(G2_KBET, fb + u * 2304 + ks * 64), dw, 0, 0, 0); }
      const int j = u * 16 + fr, pj = kperm(j);
      *(u32x2*)(gb + 4 * 8192 + j * 128 + i0 * 2) = (u32x2){pk2(du.x, du.y), pk2(du.z, du.w)};
      bf16_t* wn = (bf16_t*)(gb + i0 * 128 + pj * 2);
      wn[0] = f2bf(-dw.x); wn[64] = f2bf(-dw.y); wn[128] = f2bf(-dw.z); wn[192] = f2bf(-dw.w); }
#undef G2F
#undef G2W16
  }
}

constexpr int GS_SLOT = 46208, GS_OB = 2 * GS_SLOT;
__device__ void phase_gdn_scan(const Ctx& c, unsigned char* L, int item) {
  unsigned char* ws = c.ws;
  const int tid = phase_tid(), lane = tid & 63, wave = tid >> 6, fr = lane & 15, fq = lane >> 4;
  const int b = item / 6, h = item % 6;
  const bf16_t* GB = (const bf16_t*)(ws + WS_GB); bf16_t* CAT = (bf16_t*)(ws + WS_CAT); const float* gng = c.in[9];
  const int lt = tid - 256;
  u32x4 ra[10]; float gla = 0.f;
  f32x4 S[4];
#pragma unroll
  for (int i = 0; i < 4; ++i) S[i] = (f32x4){0.f, 0.f, 0.f, 0.f};
#define GS_LOAD(R, G, n) do { if ((n) < 64) { const unsigned char* gb_ = gd_item(ws, item * 64 + (n)); _Pragma("unroll") for (int i_ = 0; i_ < 10; ++i_) R[i_] = *(const u32x4*)(gb_ + (size_t)(lt + 256 * i_) * 16); if (lt == 0) G = *(const float*)(gb_ + 40960); } } while (0)
#define GS_STORE(R, G, slot) do { _Pragma("unroll") for (int i_ = 0; i_ < 10; ++i_) { const int p_ = lt + 256 * i_; *(u32x4*)(L + (slot) * GS_SLOT + (p_ >> 9) * 9216 + ((p_ >> 3) & 63) * 144 + (p_ & 7) * 16) = R[i_]; } if (lt == 0) *(float*)(L + (slot) * GS_SLOT + 46080) = G; } while (0)
  auto post = [&](int k) {
    const unsigned char* ob = L + GS_OB + (k & 1) * 9216; const int tk = lt >> 2, part = lt & 3; const size_t r = (size_t)b * SEQ + k * 64 + tk;
    const u32x4 o0 = *(const u32x4*)(ob + tk * 144 + part * 32), o1 = *(const u32x4*)(ob + tk * 144 + part * 32 + 16);
    float ov[16] = {__uint_as_float(o0.x << 16), __uint_as_float(o0.x & 0xffff0000u), __uint_as_float(o0.y << 16), __uint_as_float(o0.y & 0xffff0000u), __uint_as_float(o0.z << 16), __uint_as_float(o0.z & 0xffff0000u), __uint_as_float(o0.w << 16), __uint_as_float(o0.w & 0xffff0000u),
                    __uint_as_float(o1.x << 16), __uint_as_float(o1.x & 0xffff0000u), __uint_as_float(o1.y << 16), __uint_as_float(o1.y & 0xffff0000u), __uint_as_float(o1.z << 16), __uint_as_float(o1.z & 0xffff0000u), __uint_as_float(o1.w << 16), __uint_as_float(o1.w & 0xffff0000u)};
    float ss = 0.f;
#pragma unroll
    for (int e = 0; e < 16; ++e) ss += ov[e] * ov[e];
    ss += __shfl_xor(ss, 1); ss += __shfl_xor(ss, 2);
    const float rstd = rsqrtf(ss * (1.f / 64.f) + 1e-6f);
    const u32x4 z0 = *(const u32x4*)(GB + r * 1536 + 1152 + h * 64 + part * 16), z1 = *(const u32x4*)(GB + r * 1536 + 1152 + h * 64 + part * 16 + 8);
    const float zf[16] = {__uint_as_float(z0.x << 16), __uint_as_float(z0.x & 0xffff0000u), __uint_as_float(z0.y << 16), __uint_as_float(z0.y & 0xffff0000u), __uint_as_float(z0.z << 16), __uint_as_float(z0.z & 0xffff0000u), __uint_as_float(z0.w << 16), __uint_as_float(z0.w & 0xffff0000u),
                          __uint_as_float(z1.x << 16), __uint_as_float(z1.x & 0xffff0000u), __uint_as_float(z1.y << 16), __uint_as_float(z1.y & 0xffff0000u), __uint_as_float(z1.z << 16), __uint_as_float(z1.z & 0xffff0000u), __uint_as_float(z1.w << 16), __uint_as_float(z1.w & 0xffff0000u)};
#pragma unroll
    for (int e = 0; e < 16; ++e) ov[e] = ov[e] * rstd * gng[part * 16 + e] * silu_f(zf[e]);
    bf16_t* op = CAT + r * 1024 + 384 + h * 64 + part * 16;
    *(u32x4*)op = (u32x4){pk2(ov[0], ov[1]), pk2(ov[2], ov[3]), pk2(ov[4], ov[5]), pk2(ov[6], ov[7])};
    *(u32x4*)(op + 8) = (u32x4){pk2(ov[8], ov[9]), pk2(ov[10], ov[11]), pk2(ov[12], ov[13]), pk2(ov[14], ov[15])};
  };
  auto step = [&](int k) {
    const unsigned char* sb = L + (k & 1) * GS_SLOT; const float gl = *(const float*)(sb + 46080);
    const pg8::bf16x8 Sb0 = packp(S[0], S[1]), Sb1 = packp(S[2], S[3]);
    f32x4 vn[4], o[4];
#pragma unroll
    for (int mt = 0; mt < 4; ++mt) { const u32x2 uv = *(const u32x2*)(sb + 4 * 9216 + (wave * 16 + fr) * 144 + (mt * 16 + fq * 4) * 2);
      f32x4 a = {__uint_as_float(uv.x << 16), __uint_as_float(uv.x & 0xffff0000u), __uint_as_float(uv.y << 16), __uint_as_float(uv.y & 0xffff0000u)};
      a = __builtin_amdgcn_mfma_f32_16x16x32_bf16(ldsfrag(sb, mt * 16 + fr, 0, fq), Sb0, a, 0, 0, 0);
      vn[mt] = __builtin_amdgcn_mfma_f32_16x16x32_bf16(ldsfrag(sb, mt * 16 + fr, 1, fq), Sb1, a, 0, 0, 0);
      f32x4 q = {0.f, 0.f, 0.f, 0.f};
      q = __builtin_amdgcn_mfma_f32_16x16x32_bf16(ldsfrag(sb + 9216, mt * 16 + fr, 0, fq), Sb0, q, 0, 0, 0);
      o[mt] = __builtin_amdgcn_mfma_f32_16x16x32_bf16(ldsfrag(sb + 9216, mt * 16 + fr, 1, fq), Sb1, q, 0, 0, 0); }
    const pg8::bf16x8 Vb0 = packp(vn[0], vn[1]), Vb1 = packp(vn[2], vn[3]);
#pragma unroll
    for (int mt = 0; mt < 4; ++mt) { o[mt] = __builtin_amdgcn_mfma_f32_16x16x32_bf16(ldsfrag(sb + 2 * 9216, mt * 16 + fr, 0, fq), Vb0, o[mt], 0, 0, 0);
      o[mt] = __builtin_amdgcn_mfma_f32_16x16x32_bf16(ldsfrag(sb + 2 * 9216, mt * 16 + fr, 1, fq), Vb1, o[mt], 0, 0, 0); }
#pragma unroll
    for (int kt = 0; kt < 4; ++kt) { f32x4 sv = S[kt] * gl;
      sv = __builtin_amdgcn_mfma_f32_16x16x32_bf16(ldsfrag(sb + 3 * 9216, kt * 16 + fr, 0, fq), Vb0, sv, 0, 0, 0);
      S[kt] = __builtin_amdgcn_mfma_f32_16x16x32_bf16(ldsfrag(sb + 3 * 9216, kt * 16 + fr, 1, fq), Vb1, sv, 0, 0, 0); }
    unsigned char* ob = L + GS_OB + (k & 1) * 9216 + (wave * 16 + fr) * 2;
#pragma unroll
    for (int mt = 0; mt < 4; ++mt) { const int t0 = mt * 16 + fq * 4;
      *(bf16_t*)(ob + (t0 + 0) * 144) = f2bf(o[mt].x); *(bf16_t*)(ob + (t0 + 1) * 144) = f2bf(o[mt].y); *(bf16_t*)(ob + (t0 + 2) * 144) = f2bf(o[mt].z); *(bf16_t*)(ob + (t0 + 3) * 144) = f2bf(o[mt].w); }
  };
  __syncthreads();
  if (wave >= 4) { GS_LOAD(ra, gla, 0); GS_STORE(ra, gla, 0); GS_LOAD(ra, gla, 1); }
  __syncthreads();
#pragma unroll 1
  for (int k = 0; k < 64; ++k) {
    if (wave < 4) step(k); else { if (k + 1 < 64) GS_STORE(ra, gla, (k + 1) & 1); GS_LOAD(ra, gla, k + 2); if (k > 0) post(k - 1); }
    __syncthreads();
  }
  if (wave >= 4) post(63);
#undef GS_LOAD
#undef GS_STORE
}

__device__ __forceinline__ f32x4 bf4(u32x2 p) { return (f32x4){__uint_as_float(p.x << 16), __uint_as_float(p.x & 0xffff0000u), __uint_as_float(p.y << 16), __uint_as_float(p.y & 0xffff0000u)}; }
__device__ void phase_router(const Ctx& c, unsigned char* ldsb) {
  unsigned char* ws = c.ws;
  const int tid = phase_tid(), lane = tid & 63, wave = tid >> 6, fr = lane & 15, fq = lane >> 4;
  float* lg = (float*)(ldsb + wave * 5632);
  const float* bg = c.in[17]; const float* br = c.in[19]; const float* g1 = c.in[14]; const float* b1 = c.in[15];
  const bf16_t* WR = (const bf16_t*)(ws + WS_WR); bf16_t* X1B = (bf16_t*)(ws + WS_X1B);
  unsigned* ctl = (unsigned*)(ws + WS_CTL);
  unsigned* LIST = (unsigned*)(ws + WS_LIST); float* GATEL = (float*)(ws + WS_GATEL); unsigned* TSLOT = (unsigned*)(ws + WS_TSLOT);
  unsigned* cntl = (unsigned*)(ldsb + 46080); unsigned* basel = cntl + 64;
  __syncthreads();
  if (tid < 64) cntl[tid] = 0u;
  __syncthreads();
  for (int tile = blockIdx.x * NWAVES + wave; tile < T / 16; tile += gridDim.x * NWAVES) {
    const int t0 = tile * 16;
    float mean_t = 0.f, rstd_t = 0.f;
#pragma unroll 2
    for (int i = 0; i < 16; ++i) { const u32x2* row = (const u32x2*)(X1B + (size_t)(t0 + i) * 1024);
      f32x4 v[4]; float sm = 0.f;
#pragma unroll
      for (int j = 0; j < 4; ++j) { v[j] = bf4(row[lane + 64 * j]); sm += (v[j].x + v[j].y) + (v[j].z + v[j].w); }
      const float mean = wave_sum(sm) * (1.f / 1024.f); float s2 = 0.f;
#pragma unroll
      for (int j = 0; j < 4; ++j) { v[j] = v[j] - mean; s2 += (v[j].x * v[j].x + v[j].y * v[j].y) + (v[j].z * v[j].z + v[j].w * v[j].w); }
      const float rstd = rsqrtf(wave_sum(s2) * (1.f / 1024.f) + 1e-5f);
      if (fr == i) { mean_t = mean; rstd_t = rstd; } }
    f32x4 acc[5];
#pragma unroll
    for (int nt = 0; nt < 5; ++nt) acc[nt] = (f32x4){0.f, 0.f, 0.f, 0.f};
    bf16_t* xp = X1B + (size_t)(t0 + fr) * 1024 + fq * 8;
#pragma unroll 2
    for (int ks = 0; ks < 32; ++ks) {
      const u32x4 yv = *(const u32x4*)(xp + ks * 32);
      const f32x4 ga = *(const f32x4*)(g1 + ks * 32 + fq * 8), gb2 = *(const f32x4*)(g1 + ks * 32 + fq * 8 + 4), ba = *(const f32x4*)(b1 + ks * 32 + fq * 8), bb2 = *(const f32x4*)(b1 + ks * 32 + fq * 8 + 4);
      const f32x4 y0 = {__uint_as_float(yv.x << 16), __uint_as_float(yv.x & 0xffff0000u), __uint_as_float(yv.y << 16), __uint_as_float(yv.y & 0xffff0000u)};
      const f32x4 y1 = {__uint_as_float(yv.z << 16), __uint_as_float(yv.z & 0xffff0000u), __uint_as_float(yv.w << 16), __uint_as_float(yv.w & 0xffff0000u)};
      const f32x4 n0 = (y0 - mean_t) * rstd_t * ga + ba, n1 = (y1 - mean_t) * rstd_t * gb2 + bb2;
      const u32x4 xw = {cvtpk_c(n0.x, n0.y), cvtpk_c(n0.z, n0.w), cvtpk_c(n1.x, n1.y), cvtpk_c(n1.z, n1.w)};
      *(u32x4*)(xp + ks * 32) = xw;
      const pg8::bf16x8 bx = __builtin_bit_cast(pg8::bf16x8, xw);
#pragma unroll
      for (int nt = 0; nt < 5; ++nt) acc[nt] = __builtin_amdgcn_mfma_f32_16x16x32_bf16(*(const pg8::bf16x8*)(WR + (size_t)(nt * 16 + fr) * 1024 + ks * 32 + fq * 8), bx, acc[nt], 0, 0, 0); }
#pragma unroll
    for (int nt = 0; nt < 5; ++nt) { const int o = nt * 16 + fq * 4; *(f32x4*)(lg + fr * 88 + o) = acc[nt]; }
    asm volatile("s_waitcnt lgkmcnt(0)" ::: "memory");
    int ex1 = 0, ex2 = 0; float gt1 = 0.f, gt2 = 0.f; unsigned lr1 = 0u, lr2 = 0u;
    if (lane < 16) {
      const float* l = lg + lane * 88;
      int grp = 0; float gm = l[0] + bg[0];
      for (int i = 1; i < 8; ++i) { const float v = l[i] + bg[i]; if (v > gm) { gm = v; grp = i; } }
      float gs = 0.f; for (int i = 0; i < 8; ++i) gs += __expf(l[i] + bg[i] - gm);
      const float pgrp = 1.f / gs;
      const float* el = l + 8 + grp * 8; const float* eb = br + grp * 8;
      int i1 = 0; float m1 = el[0] + eb[0]; for (int i = 1; i < 8; ++i) { const float v = el[i] + eb[i]; if (v > m1) { m1 = v; i1 = i; } }
      int i2 = -1; float m2 = -3.0e38f; for (int i = 0; i < 8; ++i) { const float v = el[i] + eb[i]; if (i != i1 && v > m2) { m2 = v; i2 = i; } }
      const float e2 = __expf(m2 - m1), den = 1.f / (1.f + e2);
      gt1 = pgrp * den; gt2 = pgrp * e2 * den;
      ex1 = grp * 8 + i1; ex2 = grp * 8 + i2;
      lr1 = atomicAdd(&cntl[ex1], 1u); lr2 = atomicAdd(&cntl[ex2], 1u);
    }
    __syncthreads();
    if (wave == 0) { const unsigned nloc = cntl[lane]; basel[lane] = nloc ? atomicAdd(&ctl[CW_CNT + lane], nloc) : 0u; }
    __syncthreads();
    if (lane < 16) {
      const int t = t0 + lane; const unsigned r1 = basel[ex1] + lr1, r2 = basel[ex2] + lr2;
      LIST[(size_t)ex1 * 32768 + r1] = (unsigned)t; GATEL[(size_t)ex1 * 32768 + r1] = gt1;
      LIST[(size_t)ex2 * 32768 + r2] = (unsigned)t; GATEL[(size_t)ex2 * 32768 + r2] = gt2;
      TSLOT[(size_t)t * 2 + 0] = ((unsigned)ex1 << 16) | r1; TSLOT[(size_t)t * 2 + 1] = ((unsigned)ex2 << 16) | r2;
    }
    __syncthreads();
    if (tid < 64) cntl[tid] = 0u;
    __syncthreads();
  }
}

__device__ void phase_combine(const Ctx& c, float* lds) {
  unsigned char* ws = c.ws;
  const int tid = phase_tid(), lane = tid & 63, wave = tid >> 6;
  int* offs = (int*)lds; int* cnts = offs + 65;
  expert_offsets(c, offs, cnts, tid);
  const unsigned char* Y = (const unsigned char*)(ws + WS_Y); const unsigned* TSLOT = (const unsigned*)(ws + WS_TSLOT);
  const float* g2 = c.in[23]; const float* b2 = c.in[24];
  for (int t = blockIdx.x * NWAVES + wave; t < T; t += gridDim.x * NWAVES) {
    const unsigned s0 = TSLOT[(size_t)t * 2], s1 = TSLOT[(size_t)t * 2 + 1];
    const size_t r0 = (size_t)offs[s0 >> 16] + (s0 & 0xffffu), r1 = (size_t)offs[s1 >> 16] + (s1 & 0xffffu);
    f32x4* row = (f32x4*)(c.out + (size_t)t * 1024); const u32x2* xrow = (const u32x2*)((const bf16_t*)(ws + WS_X1B) + (size_t)t * 1024);
    f32x4 v[4]; float s = 0.f;
#pragma unroll
    for (int j = 0; j < 4; ++j) { const unsigned ya = ((const unsigned*)(Y + r0 * 1024))[lane + 64 * j], yb = ((const unsigned*)(Y + r1 * 1024))[lane + 64 * j];
      f32x4 x = bf4(xrow[lane + 64 * j]) * ALPHA;
      const hw_f32x2 a01 = __builtin_amdgcn_cvt_pk_f32_fp8(ya, false), a23 = __builtin_amdgcn_cvt_pk_f32_fp8(ya, true), b01 = __builtin_amdgcn_cvt_pk_f32_fp8(yb, false), b23 = __builtin_amdgcn_cvt_pk_f32_fp8(yb, true);
      x.x += (a01.x + b01.x) * 0.015625f; x.y += (a01.y + b01.y) * 0.015625f; x.z += (a23.x + b23.x) * 0.015625f; x.w += (a23.y + b23.y) * 0.015625f;
      v[j] = x; s += (x.x + x.y) + (x.z + x.w); }
    const float mean = wave_sum(s) * (1.f / 1024.f); float s2 = 0.f;
#pragma unroll
    for (int j = 0; j < 4; ++j) { v[j] = v[j] - mean; s2 += (v[j].x * v[j].x + v[j].y * v[j].y) + (v[j].z * v[j].z + v[j].w * v[j].w); }
    const float rstd = rsqrtf(wave_sum(s2) * (1.f / 1024.f) + 1e-5f);
#pragma unroll
    for (int j = 0; j < 4; ++j) { const f32x4 g = ((const f32x4*)g2)[lane + 64 * j], bb = ((const f32x4*)b2)[lane + 64 * j]; row[lane + 64 * j] = v[j] * rstd * g + bb; }
  }
}

constexpr int NPHASE = 11;
__global__ void __launch_bounds__(NTHREADS, 2) mega(Ctx c) {
  float* lds = (float*)lds_raw;
  unsigned* ctl = (unsigned*)(c.ws + WS_CTL);
  unsigned* bar = ctl + CW_BAR;
  if (threadIdx.x == 0) { *(volatile unsigned*)(lds_raw + LDS_WCTR) = 0u; *(volatile unsigned*)(lds_raw + LDS_XBST) = 0u; *(volatile unsigned*)(lds_raw + LDS_XBST + 4) = 0u;
    (void)xb_add(&bar[XB_XCNT(xb_xcc_id())], 1u); }
  __syncthreads();
  phase_prologue(c, lds);
  xcd_barrier(bar);
  phase_inproj_mfma(c, (lds_u8*)lds_raw);
  phase_tiles_queue(c, lds, ctl + CW_Q + 48, TP_WD0 - TP_D1, TP_WD0);
  xcd_barrier(bar);
  phase_gdn_prep2(c, lds_raw);
  phase_kvup(c, lds);
  phase_topk_mfma(c, lds_raw, ctl + CW_Q);
  xcd_barrier(bar);
  if (blockIdx.x < 48) phase_gdn_scan(c, lds_raw, blockIdx.x);
  phase_attn_sparse(c, lds_raw, ctl + CW_Q + 16);
  phase_attn_mem(c, lds_raw, ctl + CW_Q + 32);
  xcd_barrier(bar);
  phase_outproj_mfma(c, (lds_u8*)lds_raw);
  xcd_barrier(bar);
  phase_router(c, lds_raw);
  xcd_barrier(bar);
  phase_moe_up_mfma(c, (lds_u8*)lds_raw);
  phase_tiles_queue(c, lds, ctl + CW_Q + 64, TP_WD0, TP_TOTAL);
  xcd_barrier(bar);
  phase_moe_down_mfma(c, (lds_u8*)lds_raw);
  xcd_barrier(bar);
  phase_combine(c, lds);
}

extern "C" void kernel_launch(void* const* d_in, const int* in_sizes, int n_in, void* d_out, int out_size, void* d_ws, size_t ws_size, hipStream_t stream) {
  static int grid = 0;
  if (grid == 0) {
    if (n_in != 25 || ws_size < WS_END) { fprintf(stderr, "kernel_launch: unexpected n_in %d / ws %zu\n", n_in, ws_size); grid = -1; return; }
    int dev = 0, cus = 0, per_cu = 0;
    hipGetDevice(&dev); hipDeviceGetAttribute(&cus, hipDeviceAttributeMultiprocessorCount, dev);
    hipFuncSetAttribute((const void*)mega, hipFuncAttributeMaxDynamicSharedMemorySize, LDS_BYTES);
    hipOccupancyMaxActiveBlocksPerMultiprocessor(&per_cu, (const void*)mega, NTHREADS, LDS_BYTES);
    if (per_cu < 1) { fprintf(stderr, "kernel_launch: occupancy query says %d blocks/CU\n", per_cu); per_cu = 1; }
    grid = cus * (per_cu < 1 ? 1 : 1);
    (void)hipGetLastError();
  }
  if (grid < 0) return;
  hipMemsetAsync((char*)d_ws + WS_CTL, 0, 32 * 1024, stream);
  Ctx c; memset(&c, 0, sizeof(c));
  for (int i = 0; i < 25; ++i) c.in[i] = (const float*)d_in[i];
  c.out = (float*)d_out; c.ws = (unsigned char*)d_ws;
  hipLaunchKernelGGL(mega, dim3(grid), dim3(NTHREADS), LDS_BYTES, stream, c);
}
```

```cpp
#include <hip/hip_runtime.h>
#include <cstdio>
#include <cstdint>
#include <cstring>

#ifndef ONE_LAUNCH
#define ONE_LAUNCH 1
#endif

typedef unsigned short bf16_t;
typedef float f32x4 __attribute__((ext_vector_type(4)));
typedef unsigned u32x4 __attribute__((ext_vector_type(4)));
typedef unsigned u32x2 __attribute__((ext_vector_type(2)));

constexpr int T = 32768, DM = 1024, SEQ = 4096, NBATCH = 8;
constexpr int NIN = 2816;
constexpr int NMEM = 256, TM = NBATCH * NMEM;
constexpr int NEXP = 64, DE = 256;
constexpr int NTHREADS = 512, NWAVES = 8;
constexpr float ALPHA = 1.189207115002721f;
constexpr float LOG2E = 1.4426950408889634f;
constexpr float QSCALE = 0.125f * LOG2E;

constexpr size_t MiB = 1ull << 20;
constexpr size_t WS_CTL = 0;
constexpr size_t WS_TSLOT = 512 * 1024;
constexpr size_t WS_ROPE = 1 * MiB;
constexpr size_t WS_WKV = 2 * MiB;
constexpr size_t WS_WR = 2 * MiB + 65536;
constexpr size_t WS_WIN = 3 * MiB;
constexpr size_t WS_WO = 9 * MiB;
constexpr size_t WS_WMKV = 11 * MiB;
constexpr size_t WS_MEMB = 12 * MiB;
constexpr size_t WS_WGU = 16 * MiB;
constexpr size_t WS_WD = 80 * MiB;
constexpr size_t WS_XB = 112 * MiB;
constexpr size_t WS_QA = 176 * MiB;
constexpr size_t WS_CKV = 200 * MiB;
constexpr size_t WS_IQ = 208 * MiB;
constexpr size_t WS_IK = 224 * MiB;
constexpr size_t WS_SM = 228 * MiB;
constexpr size_t WS_QC = 230 * MiB;
constexpr size_t WS_GB = 246 * MiB;
constexpr size_t WS_MK = 342 * MiB;
constexpr size_t WS_MVT = 343 * MiB;
constexpr size_t WS_KVA = 344 * MiB;
constexpr size_t WS_SEL = 352 * MiB;
constexpr size_t WS_CAT = 368 * MiB;
constexpr size_t WS_X1B = 432 * MiB;
constexpr size_t WS_LIST = 496 * MiB;
constexpr size_t WS_GATEL = 504 * MiB;
constexpr size_t WS_END = 512 * MiB;
constexpr size_t WS_H = 112 * MiB;
constexpr size_t WS_Y = 160 * MiB;

constexpr int CW_CNT = 0;
constexpr int CW_Q = 64;
constexpr int CW_BAR = 4096;

struct Ctx {
  const float* in[25];
  float* out;
  unsigned char* ws;
  int ph_lo, ph_hi;
};


extern __shared__ __attribute__((aligned(16))) unsigned char lds_raw[];
constexpr int LDS_BYTES = 157696;
constexpr int LDS_WCTR = LDS_BYTES - 64;
__device__ __forceinline__ int phase_tid() {
  __syncthreads();
  int l; asm volatile("v_mbcnt_lo_u32_b32 %0, -1, 0\n\tv_mbcnt_hi_u32_b32 %0, -1, %0" : "=v"(l));
  unsigned w = 0u;
  if (l == 0) w = __hip_atomic_fetch_add((__attribute__((address_space(3))) unsigned*)(__attribute__((address_space(3))) unsigned char*)(lds_raw + LDS_WCTR), 1u, __ATOMIC_RELAXED, __HIP_MEMORY_SCOPE_WORKGROUP);
  w = (unsigned)__builtin_amdgcn_readfirstlane((int)w) & 7u;
  return (int)(w * 64u) + l;
}


#define XB_TMO      128
#define XB_XCNT(j)  (256  + 64 * (j))
#define XB_XSUB(j)  (1280 + 64 * (j))
#define XB_XGEN(j)  (2304 + 64 * (j))
#define XB_TOP      3328
#define XB_TOPGEN   3392
#define XCD_BAR_WORDS 3456
#define XB_SPIN_CAP (1u << 18)
constexpr int LDS_XBST = LDS_BYTES - 32;
__device__ __forceinline__ unsigned xb_ld(unsigned* p)              { return __hip_atomic_load(p, __ATOMIC_RELAXED, __HIP_MEMORY_SCOPE_AGENT); }
__device__ __forceinline__ unsigned xb_add(unsigned* p, unsigned v) { return __hip_atomic_fetch_add(p, v, __ATOMIC_RELAXED, __HIP_MEMORY_SCOPE_AGENT); }
__device__ __forceinline__ unsigned xb_xcc_id() { return (unsigned)__builtin_amdgcn_s_getreg((3 << 11) | 20) & 0xFu; }
#define XB_SPIN(cond, bar) do { unsigned _sp = 0; while (cond) { __builtin_amdgcn_s_sleep(1); \
    if ((++_sp & 255u) == 0u) { if (xb_ld(&(bar)[XB_TMO])) break; if (_sp > XB_SPIN_CAP) { atomicAdd(&(bar)[XB_TMO], 1u); break; } } } } while (0)
__device__ __forceinline__ void xcd_barrier_complete(unsigned* bar, unsigned x, unsigned& nloc, unsigned& nx) {
    const unsigned G = gridDim.x;
    unsigned sum, cnt, mine, sp = 0u;
    for (;;) {
        sum = 0u; cnt = 0u; mine = 0u;
#pragma unroll
        for (unsigned j = 0; j < 16; ++j) { const unsigned cc = xb_ld(&bar[XB_XCNT(j)]); sum += cc; cnt += (cc > 0u) ? 1u : 0u; mine = (j == x) ? cc : mine; }
        if (sum == G) break;
        __builtin_amdgcn_s_sleep(1);
        if ((++sp & 255u) == 0u) { if (xb_ld(&bar[XB_TMO])) break; if (sp > XB_SPIN_CAP) { atomicAdd(&bar[XB_TMO], 1u); break; } }
    }
    nloc = mine > 0u ? mine : 1u; nx = cnt > 0u ? cnt : 1u;
}
__device__ __forceinline__ void xcd_barrier(unsigned* bar) {
    asm volatile("s_waitcnt vmcnt(0)" ::: "memory");
    __syncthreads();
    const int btid = phase_tid();
    if (btid == 0) {
        volatile __attribute__((address_space(3))) unsigned* st = (volatile __attribute__((address_space(3))) unsigned*)(__attribute__((address_space(3))) unsigned char*)(lds_raw + LDS_XBST);
        const unsigned x = xb_xcc_id();
        __builtin_amdgcn_s_waitcnt(0);
        unsigned nloc = st[0], nx = st[1];
        if (nloc == 0u) { xcd_barrier_complete(bar, x, nloc, nx); st[0] = nloc; st[1] = nx; }
        const unsigned old = xb_add(&bar[XB_XSUB(x)], 1u);
        const unsigned gen = old / nloc;
        if (old + 1u == (gen + 1u) * nloc) {
            __builtin_amdgcn_fence(__ATOMIC_RELEASE, "agent");
            asm volatile("s_waitcnt vmcnt(0)" ::: "memory");
            const unsigned og = xb_add(&bar[XB_TOP], 1u);
            const unsigned tg = og / nx;
            if (og + 1u == (tg + 1u) * nx) xb_add(&bar[XB_TOPGEN], 1u);
            else XB_SPIN(xb_ld(&bar[XB_TOPGEN]) == tg, bar);
            __builtin_amdgcn_fence(__ATOMIC_ACQUIRE, "agent");
            xb_add(&bar[XB_XGEN(x)], 1u);
            asm volatile("s_waitcnt vmcnt(0)" ::: "memory");
        } else {
            XB_SPIN(xb_ld(&bar[XB_XGEN(x)]) == gen, bar);
            __builtin_amdgcn_fence(__ATOMIC_ACQUIRE, "agent");
            asm volatile("s_waitcnt vmcnt(0)" ::: "memory");
        }
    }
    __syncthreads();
}

__device__ __forceinline__ float bf2f(bf16_t v) { return __uint_as_float(((unsigned)v) << 16); }
typedef float hw_f32x2 __attribute__((ext_vector_type(2))); typedef __bf16 hw_bf16x2 __attribute__((ext_vector_type(2)));
__device__ __forceinline__ unsigned pk2(float lo, float hi) { const hw_f32x2 v = {lo, hi}; const hw_bf16x2 b = __builtin_convertvector(v, hw_bf16x2); return __builtin_bit_cast(unsigned, b); }
__device__ __forceinline__ bf16_t f2bf(float f) { return (bf16_t)(pk2(f, f) & 0xffffu); }
__device__ __forceinline__ float wave_sum(float v) {
  int x = __float_as_int(v);
  x = __float_as_int(__int_as_float(x) + __int_as_float(__builtin_amdgcn_update_dpp(0, x, 0x111, 0xF, 0xF, true)));
  x = __float_as_int(__int_as_float(x) + __int_as_float(__builtin_amdgcn_update_dpp(0, x, 0x112, 0xF, 0xF, true)));
  x = __float_as_int(__int_as_float(x) + __int_as_float(__builtin_amdgcn_update_dpp(0, x, 0x114, 0xF, 0xF, true)));
  x = __float_as_int(__int_as_float(x) + __int_as_float(__builtin_amdgcn_update_dpp(0, x, 0x118, 0xF, 0xF, true)));
  x = __float_as_int(__int_as_float(x) + __int_as_float(__builtin_amdgcn_update_dpp(0, x, 0x142, 0xA, 0xF, false)));
  x = __float_as_int(__int_as_float(x) + __int_as_float(__builtin_amdgcn_update_dpp(0, x, 0x143, 0xC, 0xF, false)));
  return __int_as_float(__builtin_amdgcn_readlane(x, 63));
}
__device__ __forceinline__ float wave_max(float v) {
#pragma unroll
  for (int o = 32; o >= 1; o >>= 1) v = fmaxf(v, __shfl_xor(v, o));
  return v;
}
__device__ __forceinline__ float silu_f(float v) { return v * __builtin_amdgcn_rcpf(1.f + __expf(-v)); }

__device__ __forceinline__ int ropeperm(int p) { return (p >> 1) + 32 * (p & 1); }
__device__ __forceinline__ int colmap_in(int cp) {
  const int tile = cp >> 8, w = cp & 255;
  if (tile == 0) return (w >> 6) * 64 + ropeperm(w & 63);
  if (tile == 1) { if (w < 128) { const int c = 256 + w; return (c >> 6) * 64 + ropeperm(c & 63); } return 384 + (w - 128); }
  if (tile == 2) return 512 + (w >> 6) * 64 + ropeperm(w & 63);
  if (tile == 3) { if (w < 64) return 768 + ropeperm(w); if (w < 68) return 832 + (w - 64); if (w < 74) return 2372 + (w - 68); if (w < 80) return 2378 + (w - 74); return -1; }
  if (tile == 4) return 2384 + w;
  return 836 + (cp - 1280);
}

struct WorkQ { unsigned* head; volatile int* slot; int nxt; };
__device__ __forceinline__ void wq_init(WorkQ& q, unsigned* head, volatile int* slot, int tid) { q.head = head; q.slot = slot; q.nxt = 0; if (tid == 0) q.nxt = (int)atomicAdd(head, 1u); }
__device__ __forceinline__ int wq_next(WorkQ& q, int tid) {
  __syncthreads();
  if (tid == 0) { *q.slot = q.nxt; q.nxt = (int)atomicAdd(q.head, 1u); }
  __syncthreads();
  return *q.slot;
}

template <class CM>
__device__ __forceinline__ void tp_tile(const float* src, int ld, bf16_t* dst, int drow0, int K, int k0, CM cm, float* lds, int tid) {
  const int a = tid & 63, b = tid >> 6;
  const int sc = cm(a);
  __syncthreads();
#pragma unroll
  for (int i = 0; i < 8; ++i) { const int kk = b * 8 + i; lds[kk * 65 + a] = sc >= 0 ? src[(size_t)(k0 + kk) * ld + sc] : 0.f; }
  __syncthreads();
  { const int nn = tid >> 3, kc = (tid & 7) * 8;
    const float* p = lds + kc * 65 + nn;
    *(u32x4*)(dst + (size_t)(drow0 + nn) * K + k0 + kc) = (u32x4){pk2(p[0], p[65]), pk2(p[130], p[195]), pk2(p[260], p[325]), pk2(p[390], p[455])}; }
}

constexpr int TP_TOTAL = (NIN / 64) * 16 + 16 * 16 + 8 * 16 + 64 * 8 * 16 + 64 * 16 * 4;
constexpr int TP_WD0 = TP_TOTAL - 64 * 16 * 4;
constexpr int TP_D1 = 5200;
__device__ __forceinline__ void prologue_tiles(const Ctx& c, float* lds, int tid, int lo, int hi, int b0, int nb) {
  unsigned char* ws = c.ws;
  const int n_win = (NIN / 64) * 16, n_wo = 16 * 16, n_wmkv = 8 * 16, n_wgu = 64 * 8 * 16, n_wd = 64 * 16 * 4;
  const int total = n_win + n_wo + n_wmkv + n_wgu + n_wd;
  for (int it = lo + b0; it < hi; it += nb) {
    int r = it;
    if (r < n_win) { const int nt = r / 16, kt = r % 16; tp_tile(c.in[2], 2640, (bf16_t*)(ws + WS_WIN), nt * 64, 1024, kt * 64, [&](int a) { return colmap_in(nt * 64 + a); }, lds, tid); continue; } r -= n_win;
    if (r < n_wo) { const int nt = r / 16, kt = r % 16; tp_tile(c.in[13], 1024, (bf16_t*)(ws + WS_WO), nt * 64, 1024, kt * 64, [&](int a) { return nt * 64 + a; }, lds, tid); continue; } r -= n_wo;
    if (r < n_wmkv) { const int nt = r / 16, kt = r % 16; tp_tile(c.in[12], 512, (bf16_t*)(ws + WS_WMKV), nt * 64, 1024, kt * 64, [&](int a) { return nt * 64 + a; }, lds, tid); continue; } r -= n_wmkv;
    if (r < n_wgu) { const int e = r / 128, q = r % 128, nt = q / 16, kt = q % 16;
      const int pn = nt >> 2, sub = nt & 3, isup = sub >> 1, c0 = pn * 128 + (sub & 1) * 64;
      const float* src = (isup ? c.in[21] : c.in[20]) + (size_t)e * 1024 * 256;
      tp_tile(src, 256, (bf16_t*)(ws + WS_WGU), e * 512 + nt * 64, 1024, kt * 64, [&](int a) { return c0 + a; }, lds, tid); continue; } r -= n_wgu;
    { const int e = r / 64, q = r % 64, nt = q / 4, kt = q % 4;
      tp_tile(c.in[22] + (size_t)e * 256 * 1024, 1024, (bf16_t*)(ws + WS_WD), e * 1024 + nt * 64, 256, kt * 64, [&](int a) { return nt * 64 + a; }, lds, tid); }
  }
}

__device__ void phase_tiles_queue(const Ctx& c, float* lds, unsigned* qhead, int lo, int hi) {
  const int tid = phase_tid();
  volatile int* slot = (volatile int*)(lds + 64 * 65 + 16);
  WorkQ wq; wq_init(wq, qhead, slot, tid);
  const int nitems = (hi - lo + 7) >> 3;
  for (;;) {
    const int item = wq_next(wq, tid);
    if (item >= nitems) break;
    const int t0 = lo + item * 8, t1 = t0 + 8 < hi ? t0 + 8 : hi;
    prologue_tiles(c, lds, tid, t0, t1, 0, 1);
  }
}

__device__ void phase_prologue(const Ctx& c, float* lds) {
  const int tid = phase_tid(), bid = blockIdx.x, G = gridDim.x;
  unsigned char* ws = c.ws;
  const size_t gtid = (size_t)bid * NTHREADS + tid, gstride = (size_t)G * NTHREADS;
  { const f32x4* x4 = (const f32x4*)c.in[0]; u32x2* o = (u32x2*)c.out;
    for (size_t i = gtid; i < (size_t)T * DM / 4; i += gstride) { const f32x4 v = x4[i]; o[i] = (u32x2){pk2(v.x, v.y), pk2(v.z, v.w)}; }
    const f32x4* m4 = (const f32x4*)c.in[1]; u32x2* om = (u32x2*)(ws + WS_MEMB);
    for (size_t i = gtid; i < (size_t)TM * DM / 4; i += gstride) { const f32x4 v = m4[i]; om[i] = (u32x2){pk2(v.x, v.y), pk2(v.z, v.w)}; } }
  { float* cs = (float*)(ws + WS_ROPE); float* sn = cs + SEQ * 32;
    for (size_t i = gtid; i < (size_t)SEQ * 32; i += gstride) { const int s = (int)(i >> 5), d = (int)(i & 31);
      const float inv = 1.0f / powf(10000.0f, (float)d / 32.0f); const float ang = (float)s * inv; float sv, cv; sincosf(ang, &sv, &cv); cs[i] = cv; sn[i] = sv; } }
  { bf16_t* wkv = (bf16_t*)(ws + WS_WKV); const float* g = c.in[3]; const float* wk = c.in[4]; const float* wv = c.in[5];
    for (size_t i = gtid; i < 128 * 128; i += gstride) { const int p = (int)(i >> 7), k = (int)(i & 127);
      const float w = p < 64 ? wk[k * 64 + ropeperm(p)] : wv[k * 64 + (p - 64)]; wkv[i] = f2bf(w * g[k]); }
    bf16_t* wr = (bf16_t*)(ws + WS_WR); const float* wg = c.in[16]; const float* wrt = c.in[18];
    for (size_t i = gtid; i < 80 * 1024; i += gstride) { const int o = (int)(i >> 10), k = (int)(i & 1023); wr[i] = f2bf(o < 8 ? wg[k * 8 + o] : o < 72 ? wrt[k * 64 + (o - 8)] : 0.f); } }
  prologue_tiles(c, lds, tid, 0, TP_WD0 - TP_D1, bid, G);
}

__device__ __forceinline__ void expert_offsets(const Ctx& c, int* offs  , int* cnts  , int tid) {
  const unsigned* ctl = (const unsigned*)(c.ws + WS_CTL);
  __syncthreads();
  if (tid == 0) { int o = 0; for (int e = 0; e < 64; ++e) { const int n = (int)ctl[CW_CNT + e]; cnts[e] = n; offs[e] = o; o += (n + 255) & ~255; } offs[64] = o; }
  __syncthreads();
}


namespace pg8 {
#define PG8_LAS __attribute__((address_space(3)))
typedef short bf16x8 __attribute__((ext_vector_type(8)));
constexpr int BM = 256, BK = 64, HALF = 128, HTB = HALF * BK * 2, STAGE_BYTES = 8 * HTB, NXCD = 8, WGM = 8;
__host__ __device__ __forceinline__ int lds_byte(int r, int c) { const int st = (r >> 4) * 2 + (c >> 5), rr = r & 15, cc = c & 31, ob = rr * 64 + cc * 2; return st * 1024 + (ob ^ (((ob >> 9) & 1) << 5)); }
__host__ __device__ __forceinline__ void stage_rc(int b, int& R, int& C) { const int st = b / 1024, sb = b % 1024, swz = sb ^ (((sb >> 9) & 1) << 5); R = (st >> 1) * 16 + swz / 64; C = (st & 1) * 32 + (swz % 64) / 2; }
__host__ __device__ __forceinline__ int perm32(int rho) { const int n = rho >> 4, i = rho & 15; return 8 * (i >> 2) + 4 * n + (i & 3); }
struct Unit { int pm, pn, e, mt, aux; };
struct Gemm { const bf16_t* A; const bf16_t* Bt; int K; };
struct StaticOrder {
    int nM, nN, nwg, G, c;
    __device__ void init(int M, int N, int G_, int c_) { nM = M / BM; nN = N / BM; nwg = nM * nN; G = G_; c = c_; }
    __device__ bool next(int i, Unit& u) const {
        const long L = (long)i * G + c; if (c < 0 || L >= nwg) return false;
        int wgid = (int)L; { const int q = nwg / NXCD, r = nwg % NXCD, xcd = wgid % NXCD, off = wgid / NXCD; wgid = (xcd < r ? xcd * (q + 1) : r * (q + 1) + (xcd - r) * q) + off; }
        const int nig = WGM * nN, gid = wgid / nig, fm = gid * WGM, gsz = (nM - fm) < WGM ? (nM - fm) : WGM;
        u.pm = fm + ((wgid % nig) % gsz); u.pn = (wgid % nig) / gsz; u.e = 0; u.mt = 0; u.aux = 0; return true;
    }
    __device__ __forceinline__ unsigned arow(const Unit&, int) const { return 0u; }
};
__device__ __forceinline__ unsigned cvt_pk_bf16(float lo, float hi) { unsigned r; asm volatile("v_cvt_pk_bf16_f32 %0, %1, %2" : "=v"(r) : "v"(lo), "v"(hi)); return r; }

template <class Epi, class Sched, bool ALIGN_EPI, bool GATHER>
__device__ __forceinline__ void gemm_phase(PG8_LAS unsigned char* lds, const Gemm g, const Sched& S, const Epi& E, const int tid) {
    const int wid = __builtin_amdgcn_readfirstlane(tid >> 6), lane = tid & 63, wr = wid >> 2, wc = wid & 3, fr = lane & 15, fq = lane >> 4;
    const int K = g.K, nt = K / BK;
    unsigned voffA[2], voffB[2]; int RA[2], CA[2];
#pragma unroll
    for (int i = 0; i < 2; ++i) { int R, C; stage_rc(tid * 16 + i * 8192, R, C); const int Rb = Epi::PERM ? ((R & ~31) + perm32(R & 31)) : R;
        RA[i] = R; CA[i] = C; voffA[i] = (unsigned)(R * K + C) * 2u; voffB[i] = (unsigned)(Rb * K + C) * 2u; }
    const size_t kstep = (size_t)(BK * 2);
    const size_t hstep = (size_t)HALF * K * 2;
    const size_t tstep = 2 * hstep;
    const unsigned ldsw = (unsigned)wid * 1024u;
    const int aoff = lds_byte(wr * 64 + fr, fq * 8), boff = lds_byte(wc * 32 + fr, fq * 8);
#define PG8_SA(b, h) (((b) * 2 + (h)) * HTB)
#define PG8_SB(b, h) ((4 + (b) * 2 + (h)) * HTB)
#define PG8_STAGE(bufoff, gbase, voff) do { _Pragma("unroll") for (int _i = 0; _i < 2; ++_i) \
        __builtin_amdgcn_global_load_lds((const unsigned*)((const char*)(gbase) + (voff)[_i]), (PG8_LAS unsigned*)(lds + (bufoff) + ldsw + _i * 8192), 16, 0, 0); } while (0)
#define PG8_STAGE_A(bufoff, gbase, h, goff) do { if constexpr (GATHER) { PG8_STAGE(bufoff, gbase, (goff)[h]); } else { PG8_STAGE(bufoff, (gbase) + (h) * hstep, voffA); } } while (0)
#define PG8_LDA(dst, b, h) do { _Pragma("unroll") for (int m = 0; m < 4; ++m) _Pragma("unroll") for (int k = 0; k < 2; ++k) dst[m][k] = *(const PG8_LAS bf16x8*)(lds + PG8_SA(b, h) + aoff + m * 2048 + k * 1024); } while (0)
#define PG8_LDB(dst, b, h) do { _Pragma("unroll") for (int n = 0; n < 2; ++n) _Pragma("unroll") for (int k = 0; k < 2; ++k) dst[n][k] = *(const PG8_LAS bf16x8*)(lds + PG8_SB(b, h) + boff + n * 2048 + k * 1024); } while (0)
#define PG8_MMA(ai, bj, At, Bt) do { __builtin_amdgcn_s_setprio(1); _Pragma("unroll") for (int m = 0; m < 4; ++m) _Pragma("unroll") for (int n = 0; n < 2; ++n) _Pragma("unroll") for (int k = 0; k < 2; ++k) \
        acc[ai][bj][m][n] = __builtin_amdgcn_mfma_f32_16x16x32_bf16(Bt[n][k], At[m][k], acc[ai][bj][m][n], 0, 0, 0); __builtin_amdgcn_s_setprio(0); } while (0)
#define PG8_WAIT_V(n) asm volatile("s_waitcnt vmcnt(" #n ")" ::: "memory")
#define PG8_WAIT_L(n) asm volatile("s_waitcnt lgkmcnt(" #n ")" ::: "memory")
#define PG8_BAR __builtin_amdgcn_s_barrier()
#define PG8_SCHED __builtin_amdgcn_sched_barrier(0)
    Unit cur, nxt; int ui = 0;
    if (!S.next(0, cur)) return;
    f32x4 acc[2][2][4][2];
#pragma unroll
    for (int a = 0; a < 2; ++a)
#pragma unroll
        for (int b = 0; b < 2; ++b)
#pragma unroll
            for (int m = 0; m < 4; ++m)
#pragma unroll
                for (int n = 0; n < 2; ++n) acc[a][b][m][n] = (f32x4){0.f, 0.f, 0.f, 0.f};
    bf16x8 At[4][2], B0[2][2], B1[2][2];
    unsigned gc[2][2], gn[2][2];
    const char* cA; const char* cB = (const char*)g.Bt + (size_t)cur.pn * tstep;
    if constexpr (GATHER) { cA = (const char*)g.A;
#pragma unroll
        for (int h = 0; h < 2; ++h)
#pragma unroll
            for (int i = 0; i < 2; ++i) { gc[h][i] = (S.arow(cur, h * HALF + RA[i]) * (unsigned)K + (unsigned)CA[i]) * 2u; gn[h][i] = gc[h][i]; }
    } else { cA = (const char*)g.A + (size_t)cur.pm * tstep; }
    PG8_STAGE(PG8_SB(0, 0), cB, voffB); PG8_STAGE(PG8_SB(0, 1), cB + hstep, voffB); PG8_STAGE_A(PG8_SA(0, 0), cA, 0, gc); PG8_STAGE_A(PG8_SA(0, 1), cA, 1, gc);
    if (wr == 1) PG8_BAR;
    PG8_WAIT_V(2); PG8_BAR;
    PG8_STAGE(PG8_SB(1, 0), cB + kstep, voffB); PG8_STAGE_A(PG8_SA(1, 0), cA + kstep, 0, gc); PG8_STAGE(PG8_SB(1, 1), cB + hstep + kstep, voffB);
    PG8_WAIT_V(6); PG8_BAR;
    for (;;) {
        const bool has_next = S.next(ui + 1, nxt);
        const char* nA; const char* nB = has_next ? (const char*)g.Bt + (size_t)nxt.pn * tstep : cB;
        if constexpr (GATHER) { nA = cA;
            if (has_next) {
#pragma unroll
                for (int h = 0; h < 2; ++h)
#pragma unroll
                    for (int i = 0; i < 2; ++i) gn[h][i] = (S.arow(nxt, h * HALF + RA[i]) * (unsigned)K + (unsigned)CA[i]) * 2u; }
        } else { nA = has_next ? (const char*)g.A + (size_t)nxt.pm * tstep : cA; }
        for (int t = 0; t < nt; t += 2) {
            const bool last = (t == nt - 2);
            const char* a1 = cA + (size_t)(t + 1) * kstep;
            const char* a2 = last ? nA : cA + (size_t)(t + 2) * kstep; const char* b2 = last ? nB : cB + (size_t)(t + 2) * kstep;
            const char* a3 = a2 + kstep; const char* b3 = b2 + kstep;
            unsigned g2[2][2];
            if constexpr (GATHER) {
#pragma unroll
            for (int h = 0; h < 2; ++h)
#pragma unroll
                for (int i = 0; i < 2; ++i) g2[h][i] = last ? gn[h][i] : gc[h][i]; }
            PG8_LDB(B0, 0, 0); PG8_LDB(B1, 0, 1); PG8_SCHED; PG8_LDA(At, 0, 0); PG8_STAGE_A(PG8_SA(1, 1), a1, 1, gc);
            PG8_WAIT_V(8); PG8_WAIT_L(0); PG8_BAR; PG8_MMA(0, 0, At, B0); PG8_MMA(0, 1, At, B1); PG8_BAR; PG8_SCHED;
            PG8_LDA(At, 0, 1); PG8_STAGE(PG8_SB(0, 0), b2, voffB); PG8_STAGE(PG8_SB(0, 1), b2 + hstep, voffB); PG8_STAGE_A(PG8_SA(0, 0), a2, 0, g2);
            PG8_WAIT_V(8); PG8_WAIT_L(0); PG8_BAR; PG8_MMA(1, 0, At, B0); PG8_MMA(1, 1, At, B1); PG8_BAR; PG8_SCHED;
            PG8_LDB(B0, 1, 0); PG8_LDB(B1, 1, 1); PG8_SCHED; PG8_LDA(At, 1, 0); PG8_STAGE_A(PG8_SA(0, 1), a2, 1, g2);
            PG8_WAIT_V(8); PG8_WAIT_L(0); PG8_BAR; PG8_MMA(0, 0, At, B0); PG8_MMA(0, 1, At, B1); PG8_BAR; PG8_SCHED;
            PG8_LDA(At, 1, 1); PG8_STAGE(PG8_SB(1, 0), b3, voffB); PG8_STAGE(PG8_SB(1, 1), b3 + hstep, voffB); PG8_STAGE_A(PG8_SA(1, 0), a3, 0, g2);
            PG8_WAIT_V(8); PG8_WAIT_L(0); PG8_BAR; PG8_MMA(1, 0, At, B0); PG8_MMA(1, 1, At, B1); PG8_BAR; PG8_SCHED;
        }
        if constexpr (ALIGN_EPI) { if (wr == 0) PG8_BAR; }
        E(acc, cur, wr, wc, fr, fq);
        if (!has_next) break;
#pragma unroll
        for (int a = 0; a < 2; ++a)
#pragma unroll
            for (int b = 0; b < 2; ++b)
#pragma unroll
                for (int m = 0; m < 4; ++m)
#pragma unroll
                    for (int n = 0; n < 2; ++n) acc[a][b][m][n] = (f32x4){0.f, 0.f, 0.f, 0.f};
        cur = nxt; cA = nA; cB = nB; ++ui;
        if constexpr (GATHER) {
#pragma unroll
        for (int h = 0; h < 2; ++h)
#pragma unroll
            for (int i = 0; i < 2; ++i) gc[h][i] = gn[h][i]; }
        if constexpr (ALIGN_EPI) { if (wr == 1) PG8_BAR; }
    }
    PG8_WAIT_V(0);
    if constexpr (!ALIGN_EPI) { if (wr == 0) PG8_BAR; }
    PG8_BAR;
#undef PG8_SA
#undef PG8_SB
#undef PG8_STAGE
#undef PG8_STAGE_A
#undef PG8_LDA
#undef PG8_LDB
#undef PG8_MMA
#undef PG8_WAIT_V
#undef PG8_WAIT_L
#undef PG8_BAR
#undef PG8_SCHED
}
}
typedef __attribute__((address_space(3))) unsigned char lds_u8;

__device__ __forceinline__ u32x4 pack8(const f32x4& a, const f32x4& b) { return (u32x4){pg8::cvt_pk_bf16(a.x, a.y), pg8::cvt_pk_bf16(a.z, a.w), pg8::cvt_pk_bf16(b.x, b.y), pg8::cvt_pk_bf16(b.z, b.w)}; }
struct EpiInM {
  static constexpr bool PERM = true;
  unsigned char* ws;
  __device__ __forceinline__ void operator()(const f32x4 (&acc)[2][2][4][2], const pg8::Unit& u, int wr, int wc, int fr, int fq) const {
    const float* cs = (const float*)(ws + WS_ROPE); const float* sn = cs + SEQ * 32;
    const int pn = u.pn;
#pragma unroll
    for (int ai = 0; ai < 2; ++ai)
#pragma unroll
      for (int m = 0; m < 4; ++m) {
        const int row = u.pm * 256 + ai * 128 + wr * 64 + m * 16 + fr, pos = row & (SEQ - 1);
#pragma unroll
        for (int bj = 0; bj < 2; ++bj) {
          const int w = bj * 128 + wc * 32 + 8 * fq;
          f32x4 v0 = acc[ai][bj][m][0], v1 = acc[ai][bj][m][1];
          const bool do_rope = (pn == 0) || (pn == 1 && bj == 0) || (pn == 2) || (pn == 3 && bj == 0 && wc < 2);
          if (do_rope) { const int d = (w & 63) >> 1; const f32x4 c4 = *(const f32x4*)(cs + pos * 32 + d), s4 = *(const f32x4*)(sn + pos * 32 + d);
            const f32x4 o0 = {v0.x * c4.x - v0.y * s4.x, v0.y * c4.x + v0.x * s4.x, v0.z * c4.y - v0.w * s4.y, v0.w * c4.y + v0.z * s4.y};
            const f32x4 o1 = {v1.x * c4.z - v1.y * s4.z, v1.y * c4.z + v1.x * s4.z, v1.z * c4.w - v1.w * s4.w, v1.w * c4.w + v1.z * s4.w};
            v0 = o0; v1 = o1; }
          if (pn == 0) { *(u32x4*)((bf16_t*)(ws + WS_QA) + (size_t)row * 384 + w) = pack8(v0 * QSCALE, v1 * QSCALE); }
          else if (pn == 1) { if (bj == 0) *(u32x4*)((bf16_t*)(ws + WS_QA) + (size_t)row * 384 + 256 + w) = pack8(v0 * QSCALE, v1 * QSCALE);
                              else *(u32x4*)((bf16_t*)(ws + WS_CKV) + (size_t)row * 128 + (w - 128)) = pack8(v0, v1); }
          else if (pn == 2) { *(u32x4*)((bf16_t*)(ws + WS_IQ) + (size_t)row * 256 + w) = pack8(v0, v1); }
          else if (pn == 3) { if (bj == 0) { if (wc < 2) *(u32x4*)((bf16_t*)(ws + WS_IK) + (size_t)row * 64 + w) = pack8(v0, v1);
                                             else if (wc == 2 && fq < 2) { if (fq == 0) v0 = v0 * 0.0625f; float* o = (float*)(ws + WS_SM) + (size_t)row * 16 + 8 * fq; *(f32x4*)o = v0; *(f32x4*)(o + 4) = v1; } } }
          else if (pn == 4) { *(u32x4*)((bf16_t*)(ws + WS_QC) + (size_t)row * 256 + w) = pack8(v0 * QSCALE, v1 * QSCALE); }
          else { *(u32x4*)((bf16_t*)(ws + WS_GB) + (size_t)row * 1536 + (pn - 5) * 256 + w) = pack8(v0, v1); }
        }
      }
  }
};
struct EpiMemKVM {
  static constexpr bool PERM = true;
  unsigned char* ws;
  __device__ __forceinline__ void operator()(const f32x4 (&acc)[2][2][4][2], const pg8::Unit& u, int wr, int wc, int fr, int fq) const {
#pragma unroll
    for (int ai = 0; ai < 2; ++ai)
#pragma unroll
      for (int m = 0; m < 4; ++m) {
        const int row = u.pm * 256 + ai * 128 + wr * 64 + m * 16 + fr;
#pragma unroll
        for (int bj = 0; bj < 2; ++bj) {
          const int w = bj * 128 + wc * 32 + 8 * fq; const f32x4 v0 = acc[ai][bj][m][0], v1 = acc[ai][bj][m][1];
          if (u.pn == 0) *(u32x4*)((bf16_t*)(ws + WS_MK) + (size_t)row * 256 + w) = pack8(v0, v1);
          else { const int mem = row & 255, xx = mem & 31, mpos = (mem & ~31) + 8 * ((xx >> 2) & 3) + (xx & 3) + 4 * (xx >> 4);
            bf16_t* o = (bf16_t*)(ws + WS_MVT) + ((size_t)(row >> 8) * 256 + w) * 256 + mpos;
            o[0] = f2bf(v0.x); o[256] = f2bf(v0.y); o[512] = f2bf(v0.z); o[768] = f2bf(v0.w); o[1024] = f2bf(v1.x); o[1280] = f2bf(v1.y); o[1536] = f2bf(v1.z); o[1792] = f2bf(v1.w); }
        }
      }
  }
};
struct EpiOutM {
  static constexpr bool PERM = true;
  const bf16_t* x; bf16_t* y;
  __device__ __forceinline__ void operator()(const f32x4 (&acc)[2][2][4][2], const pg8::Unit& u, int wr, int wc, int fr, int fq) const {
#pragma unroll
    for (int ai = 0; ai < 2; ++ai)
#pragma unroll
      for (int m = 0; m < 4; ++m) {
        const size_t rb = (size_t)(u.pm * 256 + ai * 128 + wr * 64 + m * 16 + fr) * 1024 + u.pn * 256 + wc * 32 + 8 * fq;
#pragma unroll
        for (int bj = 0; bj < 2; ++bj) { const size_t o = rb + bj * 128; const u32x4 xv = *(const u32x4*)(x + o);
          const f32x4 x0 = {__uint_as_float(xv.x << 16), __uint_as_float(xv.x & 0xffff0000u), __uint_as_float(xv.y << 16), __uint_as_float(xv.y & 0xffff0000u)};
          const f32x4 x1 = {__uint_as_float(xv.z << 16), __uint_as_float(xv.z & 0xffff0000u), __uint_as_float(xv.w << 16), __uint_as_float(xv.w & 0xffff0000u)};
          *(u32x4*)(y + o) = pack8(x0 * ALPHA + acc[ai][bj][m][0], x1 * ALPHA + acc[ai][bj][m][1]); }
      }
  }
};
struct MoeOrder {
  const int* offs; const int* cnts; int npn, G, c; const unsigned* LIST;
  __device__ __forceinline__ bool next(int i, pg8::Unit& u) const {
    const int L = i * G + c; const int ntiles = __builtin_amdgcn_readfirstlane(offs[64]) >> 8;
    if (L >= ntiles * npn) return false;
    const int rt = L / npn, pl = L - rt * npn; int e = 0;
    while (__builtin_amdgcn_readfirstlane(offs[e + 1]) <= rt * 256) ++e;
    u.pm = rt; u.mt = rt - (__builtin_amdgcn_readfirstlane(offs[e]) >> 8); u.e = e; u.pn = e * npn + pl; u.aux = __builtin_amdgcn_readfirstlane(cnts[e]); return true;
  }
  __device__ __forceinline__ unsigned arow(const pg8::Unit& u, int r) const { const int rank = u.mt * 256 + r; return rank < u.aux ? LIST[(size_t)u.e * 32768 + rank] : 0u; }
};
struct EpiMoeUpM {
  static constexpr bool PERM = true;
  bf16_t* H;
  __device__ __forceinline__ void operator()(const f32x4 (&acc)[2][2][4][2], const pg8::Unit& u, int wr, int wc, int fr, int fq) const {
    const int pl = u.pn & 1;
#pragma unroll
    for (int ai = 0; ai < 2; ++ai)
#pragma unroll
      for (int m = 0; m < 4; ++m) {
        const int rl = ai * 128 + wr * 64 + m * 16 + fr;
        if (u.mt * 256 + rl < u.aux) {
          f32x4 h0, h1; const f32x4 g0 = acc[ai][0][m][0], g1 = acc[ai][0][m][1], u0 = acc[ai][1][m][0], u1 = acc[ai][1][m][1];
          h0.x = silu_f(g0.x) * u0.x; h0.y = silu_f(g0.y) * u0.y; h0.z = silu_f(g0.z) * u0.z; h0.w = silu_f(g0.w) * u0.w;
          h1.x = silu_f(g1.x) * u1.x; h1.y = silu_f(g1.y) * u1.y; h1.z = silu_f(g1.z) * u1.z; h1.w = silu_f(g1.w) * u1.w;
          *(u32x4*)(H + (size_t)(u.pm * 256 + rl) * 256 + pl * 128 + wc * 32 + 8 * fq) = pack8(h0, h1);
        }
      }
  }
};
__device__ __forceinline__ unsigned pk4_fp8(const f32x4& v) { unsigned w = __builtin_amdgcn_cvt_pk_fp8_f32(v.x, v.y, 0u, false); return __builtin_amdgcn_cvt_pk_fp8_f32(v.z, v.w, w, true); }
struct EpiMoeDownM {
  static constexpr bool PERM = true;
  unsigned char* Y; const float* GATEL;
  __device__ __forceinline__ void operator()(const f32x4 (&acc)[2][2][4][2], const pg8::Unit& u, int wr, int wc, int fr, int fq) const {
    const int pl = u.pn & 3;
    const float* gp = GATEL + (size_t)u.e * 32768; const int rk0 = u.mt * 256 + wr * 64 + fr;
    unsigned char* yp = Y + (size_t)(u.pm * 256 + wr * 64 + fr) * 1024 + pl * 256 + wc * 32 + 8 * fq;
#pragma unroll
    for (int ai = 0; ai < 2; ++ai)
#pragma unroll
      for (int m = 0; m < 4; ++m) {
        const int rk = rk0 + ai * 128 + m * 16; const float gt = gp[rk < 32767 ? rk : 32767] * 64.0f;
#pragma unroll
        for (int bj = 0; bj < 2; ++bj)
          *(u32x2*)(yp + (size_t)(ai * 128 + m * 16) * 1024 + bj * 128) = (u32x2){pk4_fp8(acc[ai][bj][m][0] * gt), pk4_fp8(acc[ai][bj][m][1] * gt)};
      }
  }
};

__device__ __forceinline__ void phase_inproj_mfma(const Ctx& c, lds_u8* lds) {
  unsigned char* ws = c.ws; const int tid = phase_tid();
  { pg8::Gemm g{(const bf16_t*)c.out, (const bf16_t*)(ws + WS_WIN), 1024}; pg8::StaticOrder S; S.init(T, NIN, gridDim.x, blockIdx.x); EpiInM E{ws};
    pg8::gemm_phase<EpiInM, pg8::StaticOrder, true, false>(lds, g, S, E, tid); }
  { pg8::Gemm g{(const bf16_t*)(ws + WS_MEMB), (const bf16_t*)(ws + WS_WMKV), 1024}; pg8::StaticOrder S; S.init(TM, 512, gridDim.x, (int)blockIdx.x - 128); EpiMemKVM E{ws};
    pg8::gemm_phase<EpiMemKVM, pg8::StaticOrder, true, false>(lds, g, S, E, tid); }
}
__device__ __forceinline__ void phase_outproj_mfma(const Ctx& c, lds_u8* lds) {
  unsigned char* ws = c.ws; const int tid = phase_tid();
  pg8::Gemm g{(const bf16_t*)(ws + WS_CAT), (const bf16_t*)(ws + WS_WO), 1024}; pg8::StaticOrder S; S.init(T, 1024, gridDim.x, blockIdx.x); EpiOutM E{(const bf16_t*)c.out, (bf16_t*)(ws + WS_X1B)};
  pg8::gemm_phase<EpiOutM, pg8::StaticOrder, true, false>(lds, g, S, E, tid);
}
__device__ __forceinline__ void phase_moe_up_mfma(const Ctx& c, lds_u8* lds) {
  unsigned char* ws = c.ws; const int tid = phase_tid();
  int* offs = (int*)((unsigned char*)lds + pg8::STAGE_BYTES); int* cnts = offs + 65;
  expert_offsets(c, offs, cnts, tid);
  pg8::Gemm g{(const bf16_t*)(ws + WS_X1B), (const bf16_t*)(ws + WS_WGU), 1024};
  MoeOrder S{offs, cnts, 2, (int)gridDim.x, (int)blockIdx.x, (const unsigned*)(ws + WS_LIST)}; EpiMoeUpM E{(bf16_t*)(ws + WS_H)};
  pg8::gemm_phase<EpiMoeUpM, MoeOrder, true, true>(lds, g, S, E, tid);
}
__device__ __forceinline__ void phase_moe_down_mfma(const Ctx& c, lds_u8* lds) {
  unsigned char* ws = c.ws; const int tid = phase_tid();
  int* offs = (int*)((unsigned char*)lds + pg8::STAGE_BYTES); int* cnts = offs + 65;
  expert_offsets(c, offs, cnts, tid);
  pg8::Gemm g{(const bf16_t*)(ws + WS_H), (const bf16_t*)(ws + WS_WD), 256};
  MoeOrder S{offs, cnts, 4, (int)gridDim.x, (int)blockIdx.x, nullptr}; EpiMoeDownM E{(unsigned char*)(ws + WS_Y), (const float*)(ws + WS_GATEL)};
  pg8::gemm_phase<EpiMoeDownM, MoeOrder, true, false>(lds, g, S, E, tid);
}

__device__ void phase_kvup(const Ctx& c, float* lds) {
  unsigned char* ws = c.ws;
  const int tid = phase_tid(), lane = tid & 63, wave = tid >> 6, fr = lane & 15, fq = lane >> 4;
  const bf16_t* W = (const bf16_t*)(ws + WS_WKV);
  const bf16_t* CKV = (const bf16_t*)(ws + WS_CKV); bf16_t* KVA = (bf16_t*)(ws + WS_KVA);
  const float* cs = (const float*)(ws + WS_ROPE); const float* sn = cs + SEQ * 32;
  for (int tile = blockIdx.x * NWAVES + wave; tile < T / 16; tile += gridDim.x * NWAVES) {
    const int t = tile * 16 + fr, pos = t & (SEQ - 1);
    pg8::bf16x8 bx[4]; float ss = 0.f;
#pragma unroll
    for (int ks = 0; ks < 4; ++ks) { const u32x4 v = *(const u32x4*)(CKV + (size_t)t * 128 + ks * 32 + fq * 8); bx[ks] = __builtin_bit_cast(pg8::bf16x8, v);
      const float f[8] = {__uint_as_float(v.x << 16), __uint_as_float(v.x & 0xffff0000u), __uint_as_float(v.y << 16), __uint_as_float(v.y & 0xffff0000u), __uint_as_float(v.z << 16), __uint_as_float(v.z & 0xffff0000u), __uint_as_float(v.w << 16), __uint_as_float(v.w & 0xffff0000u)};
#pragma unroll
      for (int e = 0; e < 8; ++e) ss += f[e] * f[e]; }
    ss += __shfl_xor(ss, 16); ss += __shfl_xor(ss, 32);
    const float rstd = rsqrtf(ss * (1.f / 128.f) + 1e-6f);
#pragma unroll
    for (int nt = 0; nt < 8; ++nt) { f32x4 d = {0.f, 0.f, 0.f, 0.f};
#pragma unroll
      for (int ks = 0; ks < 4; ++ks) d = __builtin_amdgcn_mfma_f32_16x16x32_bf16(*(const pg8::bf16x8*)(W + (size_t)(nt * 16 + fr) * 128 + ks * 32 + fq * 8), bx[ks], d, 0, 0, 0);
      d = d * rstd;
      const int p0 = nt * 16 + fq * 4;
      if (nt < 4) { const int dd = p0 >> 1; const float c0 = cs[pos * 32 + dd], s0 = sn[pos * 32 + dd], c1 = cs[pos * 32 + dd + 1], s1 = sn[pos * 32 + dd + 1];
        const f32x4 o = {d.x * c0 - d.y * s0, d.y * c0 + d.x * s0, d.z * c1 - d.w * s1, d.w * c1 + d.z * s1}; d = o; }
      { int w8 = __builtin_amdgcn_cvt_pk_fp8_f32(d.x, d.y, 0, false); w8 = __builtin_amdgcn_cvt_pk_fp8_f32(d.z, d.w, w8, true);
        *(unsigned*)((unsigned char*)KVA + (size_t)t * 128 + p0) = (unsigned)w8; } }
  }
}


typedef _Float16 h16x2 __attribute__((ext_vector_type(2)));
constexpr int TK_KP = 4104;
constexpr int TK_KEYS = 0, TK_H1 = 16 * TK_KP * 2, TK_H2 = TK_H1 + 16 * 128 * 4, TK_MISC = TK_H2 + 8 * 128 * 4;
__device__ __forceinline__ unsigned mono16x2(unsigned u) { const unsigned m = ((u >> 15) & 0x00010001u) * 0xffffu; return u ^ (m | 0x80008000u); }
__device__ __forceinline__ int wave_incl_scan(int x) {
  x += __builtin_amdgcn_update_dpp(0, x, 0x111, 0xF, 0xF, true);
  x += __builtin_amdgcn_update_dpp(0, x, 0x112, 0xF, 0xF, true);
  x += __builtin_amdgcn_update_dpp(0, x, 0x114, 0xF, 0xF, true);
  x += __builtin_amdgcn_update_dpp(0, x, 0x118, 0xF, 0xF, true);
  x += __builtin_amdgcn_update_dpp(0, x, 0x142, 0xA, 0xF, false);
  x += __builtin_amdgcn_update_dpp(0, x, 0x143, 0xC, 0xF, false);
  return x;
}

__device__ __forceinline__ void hist_find(const unsigned* hw, int need, int lane, int& B, int& above) {
  const unsigned w0 = hw[127 - 2 * lane], w1 = hw[126 - 2 * lane];
  const int c0 = (int)(w0 >> 16), c1 = (int)(w0 & 0xffffu), c2 = (int)(w1 >> 16), c3 = (int)(w1 & 0xffffu);
  const int tl = c0 + c1 + c2 + c3;
  const int incl = wave_incl_scan(tl);
  const int excl = incl - tl;
  const bool hit = (excl < need) && (incl >= need);
  int b = 0, ab = 0;
  if (hit) { int a = excl; b = 255 - 4 * lane; ab = a;
    if (a + c0 < need) { a += c0; b = 254 - 4 * lane; ab = a; if (a + c1 < need) { a += c1; b = 253 - 4 * lane; ab = a; if (a + c2 < need) { a += c2; b = 252 - 4 * lane; ab = a; } } } }
  const unsigned long long m = __ballot(hit);
  const int src = __builtin_amdgcn_readfirstlane(m ? (__ffsll((long long)m) - 1) : 0);
  B = __builtin_amdgcn_readlane(b, src); above = __builtin_amdgcn_readlane(ab, src);
}
__device__ void phase_topk_mfma(const Ctx& c, unsigned char* ldsb, unsigned* qhead) {
  unsigned char* ws = c.ws;
  const int tid = phase_tid(), lane = tid & 63, wave = tid >> 6, fr = lane & 15, fq = lane >> 4;
  unsigned short* keys = (unsigned short*)(ldsb + TK_KEYS);
  unsigned* h1 = (unsigned*)(ldsb + TK_H1); unsigned* h2 = (unsigned*)(ldsb + TK_H2) + wave * 128; int* misc = (int*)(ldsb + TK_MISC);
  const bf16_t* IQ = (const bf16_t*)(ws + WS_IQ); const bf16_t* IK = (const bf16_t*)(ws + WS_IK); const float* SM = (const float*)(ws + WS_SM);
  unsigned short* SEL = (unsigned short*)(ws + WS_SEL);
  WorkQ wq; wq_init(wq, qhead, misc, tid);
  for (;;) {
    const int item = wq_next(wq, tid);
    if (item >= 240 * 8) break;
    const int b = item & 7, qb = 255 - (item >> 3), s0 = qb * 16;
    for (int i = tid; i < 16 * 128; i += NTHREADS) h1[i] = 0u;
    const size_t qrow = (size_t)b * SEQ + s0 + fr;
    pg8::bf16x8 bq[4][2];
#pragma unroll
    for (int hh = 0; hh < 4; ++hh)
#pragma unroll
      for (int ks = 0; ks < 2; ++ks) bq[hh][ks] = *(const pg8::bf16x8*)(IQ + qrow * 256 + hh * 64 + ks * 32 + fq * 8);
    const f32x4 iw = *(const f32x4*)(SM + qrow * 16);
    const int nkt = qb + 1, slim = s0 + fr;
    __syncthreads();
    pg8::bf16x8 a0n = {0, 0, 0, 0, 0, 0, 0, 0}, a1n = a0n;
    if (wave < nkt) { const bf16_t* kr = IK + ((size_t)b * SEQ + wave * 16 + fr) * 64 + fq * 8; a0n = *(const pg8::bf16x8*)kr; a1n = *(const pg8::bf16x8*)(kr + 32); }
    for (int kt = wave; kt < nkt; kt += NWAVES) {
      const pg8::bf16x8 a0 = a0n, a1 = a1n;
      if (kt + NWAVES < nkt) { const bf16_t* kr = IK + ((size_t)b * SEQ + (kt + NWAVES) * 16 + fr) * 64 + fq * 8; a0n = *(const pg8::bf16x8*)kr; a1n = *(const pg8::bf16x8*)(kr + 32); }
      f32x4 sc = {0.f, 0.f, 0.f, 0.f};
#pragma unroll
      for (int hh = 0; hh < 4; ++hh) { f32x4 d = {0.f, 0.f, 0.f, 0.f};
        d = __builtin_amdgcn_mfma_f32_16x16x32_bf16(a0, bq[hh][0], d, 0, 0, 0); d = __builtin_amdgcn_mfma_f32_16x16x32_bf16(a1, bq[hh][1], d, 0, 0, 0);
        const float w = hh == 0 ? iw.x : hh == 1 ? iw.y : hh == 2 ? iw.z : iw.w;
        sc.x = fmaf(w, fmaxf(d.x, 0.f), sc.x); sc.y = fmaf(w, fmaxf(d.y, 0.f), sc.y); sc.z = fmaf(w, fmaxf(d.z, 0.f), sc.z); sc.w = fmaf(w, fmaxf(d.w, 0.f), sc.w); }
      unsigned k01 = mono16x2(__builtin_bit_cast(unsigned, __builtin_amdgcn_cvt_pkrtz(sc.x, sc.y))), k23 = mono16x2(__builtin_bit_cast(unsigned, __builtin_amdgcn_cvt_pkrtz(sc.z, sc.w)));
      const int kbase = kt * 16 + fq * 4;
      unsigned* hq = h1 + fr * 128;
      if (kt + 1 < nkt) {
        *(u32x2*)(keys + fr * TK_KP + kbase) = (u32x2){k01, k23};
        { const unsigned kk = k01 & 0xffffu; atomicAdd(hq + (kk >> 9), 1u << ((kk >> 4) & 16)); }
        { const unsigned kk = k01 >> 16; atomicAdd(hq + (kk >> 9), 1u << ((kk >> 4) & 16)); }
        { const unsigned kk = k23 & 0xffffu; atomicAdd(hq + (kk >> 9), 1u << ((kk >> 4) & 16)); }
        { const unsigned kk = k23 >> 16; atomicAdd(hq + (kk >> 9), 1u << ((kk >> 4) & 16)); }
      } else {
        if (kbase + 0 > slim) k01 &= 0xffff0000u; if (kbase + 1 > slim) k01 &= 0x0000ffffu;
        if (kbase + 2 > slim) k23 &= 0xffff0000u; if (kbase + 3 > slim) k23 &= 0x0000ffffu;
        *(u32x2*)(keys + fr * TK_KP + kbase) = (u32x2){k01, k23};
        if (kbase + 0 <= slim) { const unsigned kk = k01 & 0xffffu; atomicAdd(hq + (kk >> 9), 1u << ((kk >> 4) & 16)); }
        if (kbase + 1 <= slim) { const unsigned kk = k01 >> 16; atomicAdd(hq + (kk >> 9), 1u << ((kk >> 4) & 16)); }
        if (kbase + 2 <= slim) { const unsigned kk = k23 & 0xffffu; atomicAdd(hq + (kk >> 9), 1u << ((kk >> 4) & 16)); }
        if (kbase + 3 <= slim) { const unsigned kk = k23 >> 16; atomicAdd(hq + (kk >> 9), 1u << ((kk >> 4) & 16)); }
      }
    }
    __syncthreads();
    for (int qi = 0; qi < 2; ++qi) {
      const int q = wave * 2 + qi, s = s0 + q, n = s + 1;
      int B1, above1; hist_find(h1 + q * 128, 256, lane, B1, above1);
      const int need1 = 256 - above1;
      h2[lane] = 0u; h2[64 + lane] = 0u;
      const unsigned short* kq = keys + q * TK_KP;
      const int niter = (n + 511) >> 9;
      for (int it = 0; it < niter; ++it) {
        const int i0 = (it * 64 + lane) * 8; const u32x4 kv = *(const u32x4*)(kq + i0);
        const unsigned k8[8] = {kv.x & 0xffffu, kv.x >> 16, kv.y & 0xffffu, kv.y >> 16, kv.z & 0xffffu, kv.z >> 16, kv.w & 0xffffu, kv.w >> 16};
#pragma unroll
        for (int e = 0; e < 8; ++e) if (i0 + e < n && (int)(k8[e] >> 8) == B1) atomicAdd(h2 + ((k8[e] & 255u) >> 1), 1u << ((k8[e] & 1u) * 16));
      }
      int B2, above2; hist_find(h2, need1, lane, B2, above2);
      const unsigned thr = (unsigned)((B1 << 8) | B2); const int need = need1 - above2;
      unsigned short* dummy = (unsigned short*)(misc + 8 + wave);
      unsigned short* sel = (unsigned short*)h2;
      asm volatile("s_waitcnt lgkmcnt(0)" ::: "memory");
      int tiebase = 0, outbase = 0;
      for (int it = 0; it < niter; ++it) {
        const int i0 = (it * 64 + lane) * 8; const u32x4 kv = *(const u32x4*)(kq + i0);
        const unsigned k8[8] = {kv.x & 0xffffu, kv.x >> 16, kv.y & 0xffffu, kv.y >> 16, kv.z & 0xffffu, kv.z >> 16, kv.w & 0xffffu, kv.w >> 16};
        int cg = 0, ce = 0;
#pragma unroll
        for (int e = 0; e < 8; ++e) { const bool v = i0 + e < n; cg += (v && k8[e] > thr) ? 1 : 0; ce += (v && k8[e] == thr) ? 1 : 0; }
        int tk = 0;
        if (__ballot(ce != 0)) {
          const int eincl = wave_incl_scan(ce); const int eg = tiebase + eincl - ce;
          tk = need - eg; tk = tk < 0 ? 0 : (tk > ce ? ce : tk);
          tiebase += __builtin_amdgcn_readlane(eincl, 63);
        }
        const int oc = cg + tk; const int oincl = wave_incl_scan(oc);
        int pos = outbase + oincl - oc; int tleft = tk;
#pragma unroll
        for (int e = 0; e < 8; ++e) { const bool v = i0 + e < n; const bool tie = v && k8[e] == thr && tleft > 0; const bool take = (v && k8[e] > thr) || tie;
          tleft -= tie ? 1 : 0;
          unsigned short* dst = (take && pos < 256) ? sel + pos : dummy;
          *dst = (unsigned short)(i0 + e); pos += take ? 1 : 0; }
        outbase += __builtin_amdgcn_readlane(oincl, 63);
      }
      asm volatile("s_waitcnt lgkmcnt(0)" ::: "memory");
      *(u32x2*)(SEL + ((size_t)b * SEQ + s) * 256 + lane * 4) = *(const u32x2*)(sel + lane * 4);
      asm volatile("s_waitcnt lgkmcnt(0)" ::: "memory");
    }
  }
}

typedef short s16x4 __attribute__((ext_vector_type(4)));
__device__ __forceinline__ s16x4 lds_tr16(const unsigned char* p) { return __builtin_bit_cast(s16x4, __builtin_amdgcn_ds_read_tr16_b64_v4i16((__attribute__((address_space(3))) s16x4*)(__attribute__((address_space(3))) unsigned char*)p)); }
typedef float f32x2_t __attribute__((ext_vector_type(2))); typedef __bf16 bf16x2_t __attribute__((ext_vector_type(2)));
__device__ __forceinline__ unsigned cvtpk_c(float lo, float hi) { const f32x2_t v = {lo, hi}; const bf16x2_t b = __builtin_convertvector(v, bf16x2_t); return __builtin_bit_cast(unsigned, b); }
__device__ __forceinline__ pg8::bf16x8 packp(const f32x4& a, const f32x4& b) {
  const u32x4 w = {cvtpk_c(a.x, a.y), cvtpk_c(a.z, a.w), cvtpk_c(b.x, b.y), cvtpk_c(b.z, b.w)}; return __builtin_bit_cast(pg8::bf16x8, w); }
constexpr int AT_WB = 9216 + 512;
typedef int v2i_t __attribute__((ext_vector_type(2)));
__device__ __forceinline__ long lds_tr8(const unsigned char* p) { const v2i_t r = __builtin_amdgcn_ds_read_tr8_b64_v2i32((__attribute__((address_space(3))) v2i_t*)(__attribute__((address_space(3))) unsigned char*)p); return (long)(((unsigned long)(unsigned)r.y << 32) | (unsigned long)(unsigned)r.x); }
__device__ __forceinline__ unsigned cvt4_fp8(float a, float b, float c2, float d) { int w = __builtin_amdgcn_cvt_pk_fp8_f32(a, b, 0, false); w = __builtin_amdgcn_cvt_pk_fp8_f32(c2, d, w, true); return (unsigned)w; }
__device__ __forceinline__ long mk64(unsigned lo, unsigned hi) { return (long)(((unsigned long)hi << 32) | (unsigned long)lo); }
__device__ void phase_attn_sparse(const Ctx& c, unsigned char* ldsb, unsigned* qhead) {
  unsigned char* ws = c.ws;
  const int tid = phase_tid(), lane = tid & 63, wave = tid >> 6, fr = lane & 15, fq = lane >> 4;
  unsigned char* vl = ldsb + wave * AT_WB; unsigned short* sl = (unsigned short*)(vl + 9216);
  const bf16_t* QA = (const bf16_t*)(ws + WS_QA); const unsigned char* KVA = (const unsigned char*)(ws + WS_KVA); const unsigned short* SEL = (const unsigned short*)(ws + WS_SEL);
  bf16_t* CAT = (bf16_t*)(ws + WS_CAT);
  const float* gA = c.in[10];
  __syncthreads();
  int* aq_slot = (int*)(ldsb + 8 * AT_WB);
  WorkQ wq; wq_init(wq, qhead, aq_slot, tid);
  const int st_off = (lane >> 3) * 144 + (lane & 7) * 16;
  const int kr_off = fr * 144 + fq * 16;
  const int tr_off = (fq * 4 + ((fr >> 1) & 3) + (fr >> 3) * 16) * 144 + 64 + (fr & 1) * 8;
  for (;;) {
  const int item = wq_next(wq, tid);
  if (item >= 512) break;
  for (int tj = 0; tj < 8; ++tj) {
    const int t = item * 64 + wave * 8 + tj;
    const int b = t >> 12, s = t & (SEQ - 1), n = s + 1 < 256 ? s + 1 : 256;
    { u32x2 v;
      if (s >= 256) v = *(const u32x2*)(SEL + (size_t)t * 256 + lane * 4);
      else { const int i0 = lane * 4; const unsigned e0 = i0 < n ? i0 : 0, e1 = i0 + 1 < n ? i0 + 1 : 0, e2 = i0 + 2 < n ? i0 + 2 : 0, e3 = i0 + 3 < n ? i0 + 3 : 0; v = (u32x2){e0 | (e1 << 16), e2 | (e3 << 16)}; }
      *(u32x2*)(sl + lane * 4) = v; }
    asm volatile("s_waitcnt lgkmcnt(0)" ::: "memory");
    const unsigned char* kvb = KVA + (size_t)b * SEQ * 128;
    u32x4 ra[8], rb[8];
#define KLOAD(R, CH) do { _Pragma("unroll") for (int i_ = 0; i_ < 8; ++i_) { const int key_ = sl[(CH) * 64 + i_ * 8 + (lane >> 3)]; R[i_] = *(const u32x4*)(kvb + (size_t)key_ * 128 + (lane & 7) * 16); } } while (0)
#define KSTORE(R) do { _Pragma("unroll") for (int i_ = 0; i_ < 8; ++i_) *(u32x4*)(vl + i_ * 8 * 144 + st_off) = R[i_]; } while (0)
    KLOAD(ra, 0); KLOAD(rb, 1);
    long q0 = 0, q1 = 0;
    if (fr < 6) { const bf16_t* qp = QA + (size_t)t * 384 + fr * 64 + fq * 16; const u32x4 a = *(const u32x4*)qp, bb = *(const u32x4*)(qp + 8);
      q0 = mk64(cvt4_fp8(__uint_as_float(a.x << 16), __uint_as_float(a.x & 0xffff0000u), __uint_as_float(a.y << 16), __uint_as_float(a.y & 0xffff0000u)),
                cvt4_fp8(__uint_as_float(a.z << 16), __uint_as_float(a.z & 0xffff0000u), __uint_as_float(a.w << 16), __uint_as_float(a.w & 0xffff0000u)));
      q1 = mk64(cvt4_fp8(__uint_as_float(bb.x << 16), __uint_as_float(bb.x & 0xffff0000u), __uint_as_float(bb.y << 16), __uint_as_float(bb.y & 0xffff0000u)),
                cvt4_fp8(__uint_as_float(bb.z << 16), __uint_as_float(bb.z & 0xffff0000u), __uint_as_float(bb.w << 16), __uint_as_float(bb.w & 0xffff0000u))); }
    float m = -3.0e38f, l = 0.f;
    f32x4 ot[4];
#pragma unroll
    for (int mt = 0; mt < 4; ++mt) ot[mt] = (f32x4){0.f, 0.f, 0.f, 0.f};
#define KCHUNK(R, CH) do { \
      KSTORE(R); if ((CH) + 2 < 4) KLOAD(R, (CH) + 2); \
      asm volatile("s_waitcnt lgkmcnt(0)" ::: "memory"); \
      f32x4 st[4]; \
      _Pragma("unroll") for (int kt = 0; kt < 4; ++kt) { const u32x4 a_ = *(const u32x4*)(vl + kt * 16 * 144 + kr_off); f32x4 d_ = {0.f, 0.f, 0.f, 0.f}; \
        d_ = __builtin_amdgcn_mfma_f32_16x16x32_fp8_fp8(mk64(a_.x, a_.y), q0, d_, 0, 0, 0); st[kt] = __builtin_amdgcn_mfma_f32_16x16x32_fp8_fp8(mk64(a_.z, a_.w), q1, d_, 0, 0, 0); } \
      if (n < 256) { _Pragma("unroll") for (int kt = 0; kt < 4; ++kt) { const int sb = (CH) * 64 + kt * 16 + fq * 4; \
        if (sb + 0 >= n) st[kt].x = -3.0e38f; if (sb + 1 >= n) st[kt].y = -3.0e38f; if (sb + 2 >= n) st[kt].z = -3.0e38f; if (sb + 3 >= n) st[kt].w = -3.0e38f; } } \
      float cm = -3.0e38f; \
      _Pragma("unroll") for (int kt = 0; kt < 4; ++kt) cm = fmaxf(fmaxf(fmaxf(cm, st[kt].x), fmaxf(st[kt].y, st[kt].z)), st[kt].w); \
      cm = fmaxf(cm, __shfl_xor(cm, 16)); cm = fmaxf(cm, __shfl_xor(cm, 32)); \
      const float mn = fmaxf(m, cm), al = __builtin_amdgcn_exp2f(m - mn), mb = mn - 8.f; m = mn; \
      float ls = 0.f; \
      _Pragma("unroll") for (int kt = 0; kt < 4; ++kt) { st[kt].x = __builtin_amdgcn_exp2f(st[kt].x - mb); st[kt].y = __builtin_amdgcn_exp2f(st[kt].y - mb); st[kt].z = __builtin_amdgcn_exp2f(st[kt].z - mb); st[kt].w = __builtin_amdgcn_exp2f(st[kt].w - mb); \
        ls += (st[kt].x + st[kt].y) + (st[kt].z + st[kt].w); } \
      l = l * al + ls; \
      _Pragma("unroll") for (int mt = 0; mt < 4; ++mt) ot[mt] = ot[mt] * al; \
      _Pragma("unroll") for (int k2 = 0; k2 < 2; ++k2) { \
        const long pf = mk64(cvt4_fp8(st[2 * k2].x, st[2 * k2].y, st[2 * k2].z, st[2 * k2].w), cvt4_fp8(st[2 * k2 + 1].x, st[2 * k2 + 1].y, st[2 * k2 + 1].z, st[2 * k2 + 1].w)); \
        _Pragma("unroll") for (int mt = 0; mt < 4; ++mt) { const long af = lds_tr8(vl + k2 * 32 * 144 + tr_off + mt * 16); \
          ot[mt] = __builtin_amdgcn_mfma_f32_16x16x32_fp8_fp8(af, pf, ot[mt], 0, 0, 0); } } \
      asm volatile("s_waitcnt lgkmcnt(0)" ::: "memory"); } while (0)
    KCHUNK(ra, 0); KCHUNK(rb, 1); KCHUNK(ra, 2); KCHUNK(rb, 3);
#undef KLOAD
#undef KSTORE
#undef KCHUNK
    l += __shfl_xor(l, 16); l += __shfl_xor(l, 32);
    const float il = __builtin_amdgcn_rcpf(l); float ss = 0.f;
#pragma unroll
    for (int mt = 0; mt < 4; ++mt) { ot[mt] = ot[mt] * il; ss += (ot[mt].x * ot[mt].x + ot[mt].y * ot[mt].y) + (ot[mt].z * ot[mt].z + ot[mt].w * ot[mt].w); }
    if (fr >= 6) ss = 0.f;
#pragma unroll
    for (int o = 1; o < 64; o <<= 1) ss += __shfl_xor(ss, o);
    const float rstd = rsqrtf(ss * (1.f / 384.f) + 1e-6f);
    if (fr < 6) {
#pragma unroll
      for (int mt = 0; mt < 4; ++mt) { const int col = fr * 64 + mt * 16 + fq * 4; const f32x4 g = *(const f32x4*)(gA + col); const f32x4 o = ot[mt] * rstd * g;
        *(u32x2*)(CAT + (size_t)t * 1024 + col) = (u32x2){pg8::cvt_pk_bf16(o.x, o.y), pg8::cvt_pk_bf16(o.z, o.w)}; } }
  }
  }
}

__device__ void phase_attn_mem(const Ctx& c, unsigned char* ldsb, unsigned* qhead) {
  unsigned char* ws = c.ws;
  const int tid = phase_tid(), lane = tid & 63, wave = tid >> 6, fr = lane & 15, fq = lane >> 4;
  unsigned char* vl = ldsb + wave * AT_WB; unsigned short* sl = (unsigned short*)(vl + 9216);
  const bf16_t* QA = (const bf16_t*)(ws + WS_QA); const bf16_t* KVA = (const bf16_t*)(ws + WS_KVA); const unsigned short* SEL = (const unsigned short*)(ws + WS_SEL);
  const bf16_t* QC = (const bf16_t*)(ws + WS_QC); const bf16_t* MK = (const bf16_t*)(ws + WS_MK); const bf16_t* MVT = (const bf16_t*)(ws + WS_MVT);
  bf16_t* CAT = (bf16_t*)(ws + WS_CAT);
  const float* gA = c.in[10]; const float* gC = c.in[11];
  const pg8::bf16x8 zero8 = {0, 0, 0, 0, 0, 0, 0, 0};
  int* aq_slot = (int*)(ldsb + 70656 + 8 * 8192);
  WorkQ wq; wq_init(wq, qhead, aq_slot, tid);
  for (;;) {
  const int item = wq_next(wq, tid) + 512;
  if (item >= 768) break;
  {
    const int t0 = (item - 512) * 128 + wave * 16, b = t0 >> 12;
    unsigned char* mkl = ldsb; unsigned char* mvl = ldsb + 36864; unsigned char* ocl = ldsb + 70656 + wave * 8192;
    float ss = 0.f;
#pragma unroll 1
    for (int h = 0; h < 4; ++h) {
      __syncthreads();
#pragma unroll
      for (int i = 0; i < 4; ++i) { const int p = tid + 512 * i, row = p >> 3, cc = p & 7;
        *(u32x4*)(mkl + row * 144 + cc * 16) = *(const u32x4*)(MK + ((size_t)(b * 256 + row)) * 256 + h * 64 + cc * 8); }
#pragma unroll
      for (int i = 0; i < 4; ++i) { const int p = tid + 512 * i, row = p >> 5, cc = p & 31;
        *(u32x4*)(mvl + row * 528 + cc * 16) = *(const u32x4*)(MVT + ((size_t)(b * 256 + h * 64 + row)) * 256 + cc * 8); }
      __syncthreads();
      f32x4 oc[4];
      const bf16_t* qp = QC + (size_t)(t0 + fr) * 256 + h * 64 + fq * 8;
      const pg8::bf16x8 bq0 = *(const pg8::bf16x8*)qp, bq1 = *(const pg8::bf16x8*)(qp + 32);
      f32x4 st[16];
#pragma unroll
      for (int kt = 0; kt < 16; ++kt) { const unsigned char* kr = mkl + (kt * 16 + fr) * 144 + fq * 16;
        const pg8::bf16x8 a0 = *(const pg8::bf16x8*)kr, a1 = *(const pg8::bf16x8*)(kr + 64);
        f32x4 d = {0.f, 0.f, 0.f, 0.f};
        d = __builtin_amdgcn_mfma_f32_16x16x32_bf16(a0, bq0, d, 0, 0, 0); st[kt] = __builtin_amdgcn_mfma_f32_16x16x32_bf16(a1, bq1, d, 0, 0, 0); }
      float mx = -3.0e38f;
#pragma unroll
      for (int kt = 0; kt < 16; ++kt) mx = fmaxf(fmaxf(fmaxf(mx, st[kt].x), fmaxf(st[kt].y, st[kt].z)), st[kt].w);
      mx = fmaxf(mx, __shfl_xor(mx, 16)); mx = fmaxf(mx, __shfl_xor(mx, 32));
      float l = 0.f;
#pragma unroll
      for (int kt = 0; kt < 16; ++kt) { st[kt].x = __builtin_amdgcn_exp2f(st[kt].x - mx); st[kt].y = __builtin_amdgcn_exp2f(st[kt].y - mx); st[kt].z = __builtin_amdgcn_exp2f(st[kt].z - mx); st[kt].w = __builtin_amdgcn_exp2f(st[kt].w - mx);
        l += (st[kt].x + st[kt].y) + (st[kt].z + st[kt].w); }
      l += __shfl_xor(l, 16); l += __shfl_xor(l, 32);
#pragma unroll
      for (int mt = 0; mt < 4; ++mt) oc[mt] = (f32x4){0.f, 0.f, 0.f, 0.f};
#pragma unroll
      for (int kk = 0; kk < 8; ++kk) { const pg8::bf16x8 pf = packp(st[2 * kk], st[2 * kk + 1]);
#pragma unroll
        for (int mt = 0; mt < 4; ++mt) { const pg8::bf16x8 af = *(const pg8::bf16x8*)(mvl + (mt * 16 + fr) * 528 + (kk * 4 + fq) * 16);
          oc[mt] = __builtin_amdgcn_mfma_f32_16x16x32_bf16(af, pf, oc[mt], 0, 0, 0); } }
      const float il = __builtin_amdgcn_rcpf(l);
#pragma unroll
      for (int mt = 0; mt < 4; ++mt) { const f32x4 o = oc[mt] * il; ss += (o.x * o.x + o.y * o.y) + (o.z * o.z + o.w * o.w); *(u32x2*)(ocl + ((h * 4 + mt) * 64 + lane) * 8) = (u32x2){pg8::cvt_pk_bf16(o.x, o.y), pg8::cvt_pk_bf16(o.z, o.w)}; }
    }
    ss += __shfl_xor(ss, 16); ss += __shfl_xor(ss, 32);
    const float rstd = rsqrtf(ss * (1.f / 256.f) + 1e-6f);
#pragma unroll 1
    for (int h = 0; h < 4; ++h)
#pragma unroll
      for (int mt = 0; mt < 4; ++mt) { const int col = h * 64 + mt * 16 + fq * 4; const f32x4 g = *(const f32x4*)(gC + col); const u32x2 pp = *(const u32x2*)(ocl + ((h * 4 + mt) * 64 + lane) * 8);
        const f32x4 ov = {__uint_as_float(pp.x << 16), __uint_as_float(pp.x & 0xffff0000u), __uint_as_float(pp.y << 16), __uint_as_float(pp.y & 0xffff0000u)}; const f32x4 o = ov * rstd * g;
        *(u32x2*)(CAT + (size_t)(t0 + fr) * 1024 + 768 + col) = (u32x2){pg8::cvt_pk_bf16(o.x, o.y), pg8::cvt_pk_bf16(o.z, o.w)}; }
  }
  }
}

constexpr int GD_ITEM = 41088;
__device__ __forceinline__ unsigned char* gd_item(unsigned char* ws, int it) { return it < 1536 ? ws + WS_XB + (size_t)it * GD_ITEM : ws + WS_X1B + (size_t)(it - 1536) * GD_ITEM; }
__device__ __forceinline__ int kperm(int x) { return (x & 32) | (((x >> 2) & 3) << 3) | (x & 3) | (((x >> 4) & 1) << 2); }
constexpr int GP_KB = 0, GP_KBB = 9216, GP_QB = 18432, GP_VBT = 27648, GP_KBET = 36864, GP_XR = 46080  , GP_PR = 82944  , GP_OUT = 101376, GP_SC = 142336;
__device__ __forceinline__ pg8::bf16x8 ldsfrag(const unsigned char* base, int row, int ks, int fq) { return *(const pg8::bf16x8*)(base + row * 144 + ks * 64 + fq * 16); }
constexpr int G2_KB = 0, G2_KBB = 9216, G2_QB = 18432, G2_XR0 = 27648, G2_XT0 = 36864, G2_PR0 = 46080, G2_VBT = 55296, G2_KBET = 64512, G2_SC = 73728, G2_CW = 75264, G2_HALF = 78336;
__device__ void phase_gdn_prep2(const Ctx& c, unsigned char* Lb) {
  unsigned char* ws = c.ws;
  const int tid = phase_tid(), lane = tid & 63, wave = tid >> 6, fr = lane & 15, fq = lane >> 4;
  const int hb = wave >> 2, w4 = wave & 3, htid = tid & 255;
  unsigned char* L = Lb + hb * G2_HALF;
  const bf16_t* GB = (const bf16_t*)(ws + WS_GB); const float* SM = (const float*)(ws + WS_SM);
  const float* convw = c.in[6];
  float* sc = (float*)(L + G2_SC);
  float* cw = (float*)(L + G2_CW);
  const int tt = htid >> 2, part = htid & 3;
  for (int it2 = blockIdx.x; it2 < 1536; it2 += gridDim.x) {
    const int it = it2 * 2 + hb;
    const int n = it & 63, bh = it >> 6, b = bh / 6, h = bh % 6;
    const int t = n * 64 + tt; const size_t r = (size_t)b * SEQ + t;
    unsigned char* gb = gd_item(ws, it);
    __syncthreads();
    for (int i = htid; i < 768; i += 256) { const int j = i / 192, rr = i % 192; cw[i] = convw[j * 1152 + (rr >> 6) * 384 + h * 64 + (rr & 63)]; }
    if (part == 0) { const float a = SM[r * 16 + 4 + h], bb = SM[r * 16 + 10 + h]; const float xs = a + c.in[8][h]; const float sp = xs > 20.f ? xs : log1pf(__expf(xs));
      sc[tt] = -__expf(c.in[7][h]) * sp; sc[192 + tt] = 1.f / (1.f + __expf(-bb)); }
    __syncthreads();
    if (w4 == 0) { float v = sc[lane];
#pragma unroll
      for (int o = 1; o < 64; o <<= 1) { const float u = __shfl_up(v, o); if (lane >= o) v += u; }
      const float last = __shfl(v, 63);
      sc[64 + lane] = v; sc[128 + lane] = __expf(v); sc[256 + lane] = __expf(last - v); if (lane == 0) { sc[320] = __expf(last); *(float*)(gb + 40960) = __expf(last); } }
    float qv[16], kv[16], vv[16];
#pragma unroll
    for (int role = 0; role < 3; ++role) {
      float acc[16];
#pragma unroll
      for (int e = 0; e < 16; ++e) acc[e] = 0.f;
      u32x4 xr[4][2];
#pragma unroll
      for (int j = 0; j < 4; ++j) { const bool ok = t - 3 + j >= 0; const bf16_t* xp = GB + (r - 3 + j) * 1536 + role * 384 + h * 64 + part * 16;
        xr[j][0] = ok ? *(const u32x4*)xp : (u32x4){0u, 0u, 0u, 0u}; xr[j][1] = ok ? *(const u32x4*)(xp + 8) : (u32x4){0u, 0u, 0u, 0u}; }
#pragma unroll
      for (int j = 0; j < 4; ++j)
#pragma unroll
        for (int hh = 0; hh < 2; ++hh) { const u32x4 xvv = xr[j][hh]; const float* wj = cw + j * 192 + role * 64 + part * 16 + hh * 8;
          const f32x4 w0 = *(const f32x4*)wj, w1 = *(const f32x4*)(wj + 4);
          acc[hh * 8 + 0] += w0.x * __uint_as_float(xvv.x << 16); acc[hh * 8 + 1] += w0.y * __uint_as_float(xvv.x & 0xffff0000u); acc[hh * 8 + 2] += w0.z * __uint_as_float(xvv.y << 16); acc[hh * 8 + 3] += w0.w * __uint_as_float(xvv.y & 0xffff0000u);
          acc[hh * 8 + 4] += w1.x * __uint_as_float(xvv.z << 16); acc[hh * 8 + 5] += w1.y * __uint_as_float(xvv.z & 0xffff0000u); acc[hh * 8 + 6] += w1.z * __uint_as_float(xvv.w << 16); acc[hh * 8 + 7] += w1.w * __uint_as_float(xvv.w & 0xffff0000u); }
      float ss = 0.f;
#pragma unroll
      for (int e = 0; e < 16; ++e) { acc[e] = silu_f(acc[e]); ss += acc[e] * acc[e]; }
      if (role < 2) { ss += __shfl_xor(ss, 1); ss += __shfl_xor(ss, 2); const float scl = rsqrtf(ss + 1e-6f) * (role == 0 ? 0.125f : 1.f);
#pragma unroll
        for (int e = 0; e < 16; ++e) acc[e] *= scl; }
#pragma unroll
      for (int e = 0; e < 16; ++e) { if (role == 0) qv[e] = acc[e]; else if (role == 1) kv[e] = acc[e]; else vv[e] = acc[e]; }
    }
    __syncthreads();
    { const float beta = sc[192 + tt], eg = sc[128 + tt], ekl = sc[256 + tt];
      float kb[16];
#pragma unroll
      for (int e = 0; e < 16; ++e) kb[e] = kv[e] * beta;
#pragma unroll
      for (int hh = 0; hh < 2; ++hh) { const int o8 = hh * 8;
        *(u32x4*)(L + G2_KB + tt * 144 + part * 32 + hh * 16) = (u32x4){pk2(kv[o8], kv[o8 + 1]), pk2(kv[o8 + 2], kv[o8 + 3]), pk2(kv[o8 + 4], kv[o8 + 5]), pk2(kv[o8 + 6], kv[o8 + 7])};
        *(u32x4*)(L + G2_KBB + tt * 144 + part * 32 + hh * 16) = (u32x4){pk2(kb[o8], kb[o8 + 1]), pk2(kb[o8 + 2], kb[o8 + 3]), pk2(kb[o8 + 4], kb[o8 + 5]), pk2(kb[o8 + 6], kb[o8 + 7])};
        *(u32x4*)(L + G2_QB + tt * 144 + part * 32 + hh * 16) = (u32x4){pk2(qv[o8], qv[o8 + 1]), pk2(qv[o8 + 2], qv[o8 + 3]), pk2(qv[o8 + 4], qv[o8 + 5]), pk2(qv[o8 + 6], qv[o8 + 7])}; }
      const int ptt = kperm(tt);
#pragma unroll
      for (int e = 0; e < 16; ++e) { const int d = part * 16 + e;
        *(bf16_t*)(L + G2_VBT + d * 144 + tt * 2) = f2bf(vv[e] * beta);
        *(bf16_t*)(L + G2_KBET + d * 144 + tt * 2) = f2bf(kb[e] * eg);
        *(bf16_t*)(gb + 8192 + tt * 128 + kperm(d) * 2) = f2bf(qv[e] * eg);
        *(bf16_t*)(gb + 3 * 8192 + d * 128 + ptt * 2) = f2bf(kv[e] * ekl); } }
    __syncthreads();
    const int rowb = (w4 * 16 + fq * 4) * 144 + fr * 2;
    const int colb = fr * 144 + (w4 * 16 + fq * 4) * 2;
    const int fa = (w4 * 16 + fr) * 144 + fq * 16;
    const int fb = fr * 144 + fq * 16;
    const int i0 = w4 * 16 + fq * 4;
#define G2F(buf, off) (*(const pg8::bf16x8*)(L + (buf) + (off)))
#define G2W16(buf, off, v) (*(bf16_t*)(L + (buf) + (off)) = f2bf(v))
    f32x4 Pt[4];
    { const float gi0 = sc[64 + i0], gi1 = sc[64 + i0 + 1], gi2 = sc[64 + i0 + 2], gi3 = sc[64 + i0 + 3];
#pragma unroll
    for (int u = 0; u < 4; ++u) {
      f32x4 dl = {0.f, 0.f, 0.f, 0.f}, da = {0.f, 0.f, 0.f, 0.f};
#pragma unroll
      for (int ks = 0; ks < 2; ++ks) { const pg8::bf16x8 bk = G2F(G2_KB, fb + u * 2304 + ks * 64);
        dl = __builtin_amdgcn_mfma_f32_16x16x32_bf16(G2F(G2_KBB, fa + ks * 64), bk, dl, 0, 0, 0);
        da = __builtin_amdgcn_mfma_f32_16x16x32_bf16(G2F(G2_QB, fa + ks * 64), bk, da, 0, 0, 0); }
      const int j = u * 16 + fr; const float gj = sc[64 + j]; const int pj = kperm(j);
      const float dec0 = __expf(fminf(gi0 - gj, 0.f)), dec1 = __expf(fminf(gi1 - gj, 0.f)), dec2 = __expf(fminf(gi2 - gj, 0.f)), dec3 = __expf(fminf(gi3 - gj, 0.f));
      const float l0 = i0 + 0 > j ? dl.x * dec0 : 0.f, l1 = i0 + 1 > j ? dl.y * dec1 : 0.f, l2 = i0 + 2 > j ? dl.z * dec2 : 0.f, l3 = i0 + 3 > j ? dl.w * dec3 : 0.f;
      const float a0 = i0 + 0 >= j ? da.x * dec0 : 0.f, a1 = i0 + 1 >= j ? da.y * dec1 : 0.f, a2 = i0 + 2 >= j ? da.z * dec2 : 0.f, a3 = i0 + 3 >= j ? da.w * dec3 : 0.f;
      const f32x4 pv = {(i0 + 0 == j ? 1.f : 0.f) - l0, (i0 + 1 == j ? 1.f : 0.f) - l1, (i0 + 2 == j ? 1.f : 0.f) - l2, (i0 + 3 == j ? 1.f : 0.f) - l3};
      G2W16(G2_XR0, rowb + u * 32, l0); G2W16(G2_XR0, rowb + 144 + u * 32, l1); G2W16(G2_XR0, rowb + 288 + u * 32, l2); G2W16(G2_XR0, rowb + 432 + u * 32, l3);
      G2W16(G2_PR0, rowb + u * 32, pv.x); G2W16(G2_PR0, rowb + 144 + u * 32, pv.y); G2W16(G2_PR0, rowb + 288 + u * 32, pv.z); G2W16(G2_PR0, rowb + 432 + u * 32, pv.w);
      *(u32x2*)(L + G2_XT0 + colb + u * 2304) = (u32x2){pk2(l0, l1), pk2(l2, l3)};
      bf16_t* am = (bf16_t*)(gb + 2 * 8192 + i0 * 128 + pj * 2);
      am[0] = f2bf(a0); am[64] = f2bf(a1); am[128] = f2bf(a2); am[192] = f2bf(a3);
      Pt[u] = pv; } }
    __syncthreads();
#pragma unroll
    for (int u = 0; u < 4; ++u) {
      f32x4 d = {0.f, 0.f, 0.f, 0.f};
#pragma unroll
      for (int ks = 0; ks < 2; ++ks) d = __builtin_amdgcn_mfma_f32_16x16x32_bf16(G2F(G2_XR0, fa + ks * 64), G2F(G2_XT0, fb + u * 2304 + ks * 64), d, 0, 0, 0);
      G2W16(G2_KB, rowb + u * 32, d.x); G2W16(G2_KB, rowb + 144 + u * 32, d.y); G2W16(G2_KB, rowb + 288 + u * 32, d.z); G2W16(G2_KB, rowb + 432 + u * 32, d.w);
      *(u32x2*)(L + G2_KBB + colb + u * 2304) = (u32x2){pk2(d.x, d.y), pk2(d.z, d.w)}; }
    __syncthreads();
#pragma unroll
    for (int itn = 0; itn < 4; ++itn) {
      const int XRc = (itn & 1) ? G2_XR0 : G2_KB, XTc = (itn & 1) ? G2_XT0 : G2_KBB, XRn = (itn & 1) ? G2_KB : G2_XR0, XTn = (itn & 1) ? G2_KBB : G2_XT0;
      const int PRc = (itn & 1) ? G2_QB : G2_PR0, PRn = (itn & 1) ? G2_PR0 : G2_QB;
#pragma unroll
      for (int u = 0; u < 4; ++u) {
        f32x4 d = {0.f, 0.f, 0.f, 0.f};
#pragma unroll
        for (int ks = 0; ks < 2; ++ks) { const pg8::bf16x8 bx = G2F(XTc, fb + u * 2304 + ks * 64);
          Pt[u] = __builtin_amdgcn_mfma_f32_16x16x32_bf16(G2F(PRc, fa + ks * 64), bx, Pt[u], 0, 0, 0);
          if (itn < 3) d = __builtin_amdgcn_mfma_f32_16x16x32_bf16(G2F(XRc, fa + ks * 64), bx, d, 0, 0, 0); }
        G2W16(PRn, rowb + u * 32, Pt[u].x); G2W16(PRn, rowb + 144 + u * 32, Pt[u].y); G2W16(PRn, rowb + 288 + u * 32, Pt[u].z); G2W16(PRn, rowb + 432 + u * 32, Pt[u].w);
        if (itn < 3) { G2W16(XRn, rowb + u * 32, d.x); G2W16(XRn, rowb + 144 + u * 32, d.y); G2W16(XRn, rowb + 288 + u * 32, d.z); G2W16(XRn, rowb + 432 + u * 32, d.w);
          *(u32x2*)(L + XTn + colb + u * 2304) = (u32x2){pk2(d.x, d.y), pk2(d.z, d.w)}; } }
      __syncthreads();
    }
#pragma unroll
    for (int u = 0; u < 4; ++u) {
      f32x4 du = {0.f, 0.f, 0.f, 0.f}, dw = {0.f, 0.f, 0.f, 0.f};
#pragma unroll
      for (int ks = 0; ks < 2; ++ks) { const pg8::bf16x8 a = G2F(G2_PR0, fa + ks * 64);
        du = __builtin_amdgcn_mfma_f32_16x16x32_bf16(a, G2F(G2_VBT, fb + u * 2304 + ks * 64), du, 0, 0, 0);
        dw = __builtin_amdgcn_mfma_f32_16x16x32_bf16(a, G2F(G2_KBET, fb + u * 2304 + ks * 64), dw, 0, 0, 0); }
      const int j = u * 16 + fr, pj = kperm(j);
      *(u32x2*)(gb + 4 * 8192 + j * 128 + i0 * 2) = (u32x2){pk2(du.x, du.y), pk2(du.z, du.w)};
      bf16_t* wn = (bf16_t*)(gb + i0 * 128 + pj * 2);
      wn[0] = f2bf(-dw.x); wn[64] = f2bf(-dw.y); wn[128] = f2bf(-dw.z); wn[192] = f2bf(-dw.w); }
#undef G2F
#undef G2W16
  }
}

constexpr int GS_SLOT = 46208, GS_OB = 2 * GS_SLOT;
__device__ void phase_gdn_scan(const Ctx& c, unsigned char* L, int item) {
  unsigned char* ws = c.ws;
  const int tid = phase_tid(), lane = tid & 63, wave = tid >> 6, fr = lane & 15, fq = lane >> 4;
  const int b = item / 6, h = item % 6;
  const bf16_t* GB = (const bf16_t*)(ws + WS_GB); bf16_t* CAT = (bf16_t*)(ws + WS_CAT); const float* gng = c.in[9];
  const int lt = tid - 256;
  u32x4 ra[10]; float gla = 0.f;
  f32x4 S[4];
#pragma unroll
  for (int i = 0; i < 4; ++i) S[i] = (f32x4){0.f, 0.f, 0.f, 0.f};
#define GS_LOAD(R, G, n) do { if ((n) < 64) { const unsigned char* gb_ = gd_item(ws, item * 64 + (n)); _Pragma("unroll") for (int i_ = 0; i_ < 10; ++i_) R[i_] = *(const u32x4*)(gb_ + (size_t)(lt + 256 * i_) * 16); if (lt == 0) G = *(const float*)(gb_ + 40960); } } while (0)
#define GS_STORE(R, G, slot) do { _Pragma("unroll") for (int i_ = 0; i_ < 10; ++i_) { const int p_ = lt + 256 * i_; *(u32x4*)(L + (slot) * GS_SLOT + (p_ >> 9) * 9216 + ((p_ >> 3) & 63) * 144 + (p_ & 7) * 16) = R[i_]; } if (lt == 0) *(float*)(L + (slot) * GS_SLOT + 46080) = G; } while (0)
  auto post = [&](int k) {
    const unsigned char* ob = L + GS_OB + (k & 1) * 9216; const int tk = lt >> 2, part = lt & 3; const size_t r = (size_t)b * SEQ + k * 64 + tk;
    const u32x4 o0 = *(const u32x4*)(ob + tk * 144 + part * 32), o1 = *(const u32x4*)(ob + tk * 144 + part * 32 + 16);
    float ov[16] = {__uint_as_float(o0.x << 16), __uint_as_float(o0.x & 0xffff0000u), __uint_as_float(o0.y << 16), __uint_as_float(o0.y & 0xffff0000u), __uint_as_float(o0.z << 16), __uint_as_float(o0.z & 0xffff0000u), __uint_as_float(o0.w << 16), __uint_as_float(o0.w & 0xffff0000u),
                    __uint_as_float(o1.x << 16), __uint_as_float(o1.x & 0xffff0000u), __uint_as_float(o1.y << 16), __uint_as_float(o1.y & 0xffff0000u), __uint_as_float(o1.z << 16), __uint_as_float(o1.z & 0xffff0000u), __uint_as_float(o1.w << 16), __uint_as_float(o1.w & 0xffff0000u)};
    float ss = 0.f;
#pragma unroll
    for (int e = 0; e < 16; ++e) ss += ov[e] * ov[e];
    ss += __shfl_xor(ss, 1); ss += __shfl_xor(ss, 2);
    const float rstd = rsqrtf(ss * (1.f / 64.f) + 1e-6f);
    const u32x4 z0 = *(const u32x4*)(GB + r * 1536 + 1152 + h * 64 + part * 16), z1 = *(const u32x4*)(GB + r * 1536 + 1152 + h * 64 + part * 16 + 8);
    const float zf[16] = {__uint_as_float(z0.x << 16), __uint_as_float(z0.x & 0xffff0000u), __uint_as_float(z0.y << 16), __uint_as_float(z0.y & 0xffff0000u), __uint_as_float(z0.z << 16), __uint_as_float(z0.z & 0xffff0000u), __uint_as_float(z0.w << 16), __uint_as_float(z0.w & 0xffff0000u),
                          __uint_as_float(z1.x << 16), __uint_as_float(z1.x & 0xffff0000u), __uint_as_float(z1.y << 16), __uint_as_float(z1.y & 0xffff0000u), __uint_as_float(z1.z << 16), __uint_as_float(z1.z & 0xffff0000u), __uint_as_float(z1.w << 16), __uint_as_float(z1.w & 0xffff0000u)};
#pragma unroll
    for (int e = 0; e < 16; ++e) ov[e] = ov[e] * rstd * gng[part * 16 + e] * silu_f(zf[e]);
    bf16_t* op = CAT + r * 1024 + 384 + h * 64 + part * 16;
    *(u32x4*)op = (u32x4){pk2(ov[0], ov[1]), pk2(ov[2], ov[3]), pk2(ov[4], ov[5]), pk2(ov[6], ov[7])};
    *(u32x4*)(op + 8) = (u32x4){pk2(ov[8], ov[9]), pk2(ov[10], ov[11]), pk2(ov[12], ov[13]), pk2(ov[14], ov[15])};
  };
  auto step = [&](int k) {
    const unsigned char* sb = L + (k & 1) * GS_SLOT; const float gl = *(const float*)(sb + 46080);
    const pg8::bf16x8 Sb0 = packp(S[0], S[1]), Sb1 = packp(S[2], S[3]);
    f32x4 vn[4], o[4];
#pragma unroll
    for (int mt = 0; mt < 4; ++mt) { const u32x2 uv = *(const u32x2*)(sb + 4 * 9216 + (wave * 16 + fr) * 144 + (mt * 16 + fq * 4) * 2);
      f32x4 a = {__uint_as_float(uv.x << 16), __uint_as_float(uv.x & 0xffff0000u), __uint_as_float(uv.y << 16), __uint_as_float(uv.y & 0xffff0000u)};
      a = __builtin_amdgcn_mfma_f32_16x16x32_bf16(ldsfrag(sb, mt * 16 + fr, 0, fq), Sb0, a, 0, 0, 0);
      vn[mt] = __builtin_amdgcn_mfma_f32_16x16x32_bf16(ldsfrag(sb, mt * 16 + fr, 1, fq), Sb1, a, 0, 0, 0);
      f32x4 q = {0.f, 0.f, 0.f, 0.f};
      q = __builtin_amdgcn_mfma_f32_16x16x32_bf16(ldsfrag(sb + 9216, mt * 16 + fr, 0, fq), Sb0, q, 0, 0, 0);
      o[mt] = __builtin_amdgcn_mfma_f32_16x16x32_bf16(ldsfrag(sb + 9216, mt * 16 + fr, 1, fq), Sb1, q, 0, 0, 0); }
    const pg8::bf16x8 Vb0 = packp(vn[0], vn[1]), Vb1 = packp(vn[2], vn[3]);
#pragma unroll
    for (int mt = 0; mt < 4; ++mt) { o[mt] = __builtin_amdgcn_mfma_f32_16x16x32_bf16(ldsfrag(sb + 2 * 9216, mt * 16 + fr, 0, fq), Vb0, o[mt], 0, 0, 0);
      o[mt] = __builtin_amdgcn_mfma_f32_16x16x32_bf16(ldsfrag(sb + 2 * 9216, mt * 16 + fr, 1, fq), Vb1, o[mt], 0, 0, 0); }
#pragma unroll
    for (int kt = 0; kt < 4; ++kt) { f32x4 sv = S[kt] * gl;
      sv = __builtin_amdgcn_mfma_f32_16x16x32_bf16(ldsfrag(sb + 3 * 9216, kt * 16 + fr, 0, fq), Vb0, sv, 0, 0, 0);
      S[kt] = __builtin_amdgcn_mfma_f32_16x16x32_bf16(ldsfrag(sb + 3 * 9216, kt * 16 + fr, 1, fq), Vb1, sv, 0, 0, 0); }
    unsigned char* ob = L + GS_OB + (k & 1) * 9216 + (wave * 16 + fr) * 2;
#pragma unroll
    for (int mt = 0; mt < 4; ++mt) { const int t0 = mt * 16 + fq * 4;
      *(bf16_t*)(ob + (t0 + 0) * 144) = f2bf(o[mt].x); *(bf16_t*)(ob + (t0 + 1) * 144) = f2bf(o[mt].y); *(bf16_t*)(ob + (t0 + 2) * 144) = f2bf(o[mt].z); *(bf16_t*)(ob + (t0 + 3) * 144) = f2bf(o[mt].w); }
  };
  __syncthreads();
  if (wave >= 4) { GS_LOAD(ra, gla, 0); GS_STORE(ra, gla, 0); GS_LOAD(ra, gla, 1); }
  __syncthreads();
#pragma unroll 1
  for (int k = 0; k < 64; ++k) {
    if (wave < 4) step(k); else { if (k + 1 < 64) GS_STORE(ra, gla, (k + 1) & 1); GS_LOAD(ra, gla, k + 2); if (k > 0) post(k - 1); }
    __syncthreads();
  }
  if (wave >= 4) post(63);
#undef GS_LOAD
#undef GS_STORE
}

__device__ __forceinline__ f32x4 bf4(u32x2 p) { return (f32x4){__uint_as_float(p.x << 16), __uint_as_float(p.x & 0xffff0000u), __uint_as_float(p.y << 16), __uint_as_float(p.y & 0xffff0000u)}; }
__device__ void phase_router(const Ctx& c, unsigned char* ldsb) {
  unsigned char* ws = c.ws;
  const int tid = phase_tid(), lane = tid & 63, wave = tid >> 6, fr = lane & 15, fq = lane >> 4;
  float* lg = (float*)(ldsb + wave * 5632);
  const float* bg = c.in[17]; const float* br = c.in[19]; const float* g1 = c.in[14]; const float* b1 = c.in[15];
  const bf16_t* WR = (const bf16_t*)(ws + WS_WR); bf16_t* X1B = (bf16_t*)(ws + WS_X1B);
  unsigned* ctl = (unsigned*)(ws + WS_CTL);
  unsigned* LIST = (unsigned*)(ws + WS_LIST); float* GATEL = (float*)(ws + WS_GATEL); unsigned* TSLOT = (unsigned*)(ws + WS_TSLOT);
  unsigned* cntl = (unsigned*)(ldsb + 46080); unsigned* basel = cntl + 64;
  __syncthreads();
  if (tid < 64) cntl[tid] = 0u;
  __syncthreads();
  for (int tile = blockIdx.x * NWAVES + wave; tile < T / 16; tile += gridDim.x * NWAVES) {
    const int t0 = tile * 16;
    float mean_t = 0.f, rstd_t = 0.f;
#pragma unroll 2
    for (int i = 0; i < 16; ++i) { const u32x2* row = (const u32x2*)(X1B + (size_t)(t0 + i) * 1024);
      f32x4 v[4]; float sm = 0.f;
#pragma unroll
      for (int j = 0; j < 4; ++j) { v[j] = bf4(row[lane + 64 * j]); sm += (v[j].x + v[j].y) + (v[j].z + v[j].w); }
      const float mean = wave_sum(sm) * (1.f / 1024.f); float s2 = 0.f;
#pragma unroll
      for (int j = 0; j < 4; ++j) { v[j] = v[j] - mean; s2 += (v[j].x * v[j].x + v[j].y * v[j].y) + (v[j].z * v[j].z + v[j].w * v[j].w); }
      const float rstd = rsqrtf(wave_sum(s2) * (1.f / 1024.f) + 1e-5f);
      if (fr == i) { mean_t = mean; rstd_t = rstd; } }
    f32x4 acc[5];
#pragma unroll
    for (int nt = 0; nt < 5; ++nt) acc[nt] = (f32x4){0.f, 0.f, 0.f, 0.f};
    bf16_t* xp = X1B + (size_t)(t0 + fr) * 1024 + fq * 8;
#pragma unroll 2
    for (int ks = 0; ks < 32; ++ks) {
      const u32x4 yv = *(const u32x4*)(xp + ks * 32);
      const f32x4 ga = *(const f32x4*)(g1 + ks * 32 + fq * 8), gb2 = *(const f32x4*)(g1 + ks * 32 + fq * 8 + 4), ba = *(const f32x4*)(b1 + ks * 32 + fq * 8), bb2 = *(const f32x4*)(b1 + ks * 32 + fq * 8 + 4);
      const f32x4 y0 = {__uint_as_float(yv.x << 16), __uint_as_float(yv.x & 0xffff0000u), __uint_as_float(yv.y << 16), __uint_as_float(yv.y & 0xffff0000u)};
      const f32x4 y1 = {__uint_as_float(yv.z << 16), __uint_as_float(yv.z & 0xffff0000u), __uint_as_float(yv.w << 16), __uint_as_float(yv.w & 0xffff0000u)};
      const f32x4 n0 = (y0 - mean_t) * rstd_t * ga + ba, n1 = (y1 - mean_t) * rstd_t * gb2 + bb2;
      const u32x4 xw = {cvtpk_c(n0.x, n0.y), cvtpk_c(n0.z, n0.w), cvtpk_c(n1.x, n1.y), cvtpk_c(n1.z, n1.w)};
      *(u32x4*)(xp + ks * 32) = xw;
      const pg8::bf16x8 bx = __builtin_bit_cast(pg8::bf16x8, xw);
#pragma unroll
      for (int nt = 0; nt < 5; ++nt) acc[nt] = __builtin_amdgcn_mfma_f32_16x16x32_bf16(*(const pg8::bf16x8*)(WR + (size_t)(nt * 16 + fr) * 1024 + ks * 32 + fq * 8), bx, acc[nt], 0, 0, 0); }
#pragma unroll
    for (int nt = 0; nt < 5; ++nt) { const int o = nt * 16 + fq * 4; *(f32x4*)(lg + fr * 88 + o) = acc[nt]; }
    asm volatile("s_waitcnt lgkmcnt(0)" ::: "memory");
    int ex1 = 0, ex2 = 0; float gt1 = 0.f, gt2 = 0.f; unsigned lr1 = 0u, lr2 = 0u;
    if (lane < 16) {
      const float* l = lg + lane * 88;
      int grp = 0; float gm = l[0] + bg[0];
      for (int i = 1; i < 8; ++i) { const float v = l[i] + bg[i]; if (v > gm) { gm = v; grp = i; } }
      float gs = 0.f; for (int i = 0; i < 8; ++i) gs += __expf(l[i] + bg[i] - gm);
      const float pgrp = 1.f / gs;
      const float* el = l + 8 + grp * 8; const float* eb = br + grp * 8;
      int i1 = 0; float m1 = el[0] + eb[0]; for (int i = 1; i < 8; ++i) { const float v = el[i] + eb[i]; if (v > m1) { m1 = v; i1 = i; } }
      int i2 = -1; float m2 = -3.0e38f; for (int i = 0; i < 8; ++i) { const float v = el[i] + eb[i]; if (i != i1 && v > m2) { m2 = v; i2 = i; } }
      const float e2 = __expf(m2 - m1), den = 1.f / (1.f + e2);
      gt1 = pgrp * den; gt2 = pgrp * e2 * den;
      ex1 = grp * 8 + i1; ex2 = grp * 8 + i2;
      lr1 = atomicAdd(&cntl[ex1], 1u); lr2 = atomicAdd(&cntl[ex2], 1u);
    }
    __syncthreads();
    if (wave == 0) { const unsigned nloc = cntl[lane]; basel[lane] = nloc ? atomicAdd(&ctl[CW_CNT + lane], nloc) : 0u; }
    __syncthreads();
    if (lane < 16) {
      const int t = t0 + lane; const unsigned r1 = basel[ex1] + lr1, r2 = basel[ex2] + lr2;
      LIST[(size_t)ex1 * 32768 + r1] = (unsigned)t; GATEL[(size_t)ex1 * 32768 + r1] = gt1;
      LIST[(size_t)ex2 * 32768 + r2] = (unsigned)t; GATEL[(size_t)ex2 * 32768 + r2] = gt2;
      TSLOT[(size_t)t * 2 + 0] = ((unsigned)ex1 << 16) | r1; TSLOT[(size_t)t * 2 + 1] = ((unsigned)ex2 << 16) | r2;
    }
    __syncthreads();
    if (tid < 64) cntl[tid] = 0u;
    __syncthreads();
  }
}

__device__ void phase_combine(const Ctx& c, float* lds) {
  unsigned char* ws = c.ws;
  const int tid = phase_tid(), lane = tid & 63, wave = tid >> 6;
  int* offs = (int*)lds; int* cnts = offs + 65;
  expert_offsets(c, offs, cnts, tid);
  const unsigned char* Y = (const unsigned char*)(ws + WS_Y); const unsigned* TSLOT = (const unsigned*)(ws + WS_TSLOT);
  const float* g2 = c.in[23]; const float* b2 = c.in[24];
  for (int t = blockIdx.x * NWAVES + wave; t < T; t += gridDim.x * NWAVES) {
    const unsigned s0 = TSLOT[(size_t)t * 2], s1 = TSLOT[(size_t)t * 2 + 1];
    const size_t r0 = (size_t)offs[s0 >> 16] + (s0 & 0xffffu), r1 = (size_t)offs[s1 >> 16] + (s1 & 0xffffu);
    f32x4* row = (f32x4*)(c.out + (size_t)t * 1024); const u32x2* xrow = (const u32x2*)((const bf16_t*)(ws + WS_X1B) + (size_t)t * 1024);
    f32x4 v[4]; float s = 0.f;
#pragma unroll
    for (int j = 0; j < 4; ++j) { const unsigned ya = ((const unsigned*)(Y + r0 * 1024))[lane + 64 * j], yb = ((const unsigned*)(Y + r1 * 1024))[lane + 64 * j];
      f32x4 x = bf4(xrow[lane + 64 * j]) * ALPHA;
      const hw_f32x2 a01 = __builtin_amdgcn_cvt_pk_f32_fp8(ya, false), a23 = __builtin_amdgcn_cvt_pk_f32_fp8(ya, true), b01 = __builtin_amdgcn_cvt_pk_f32_fp8(yb, false), b23 = __builtin_amdgcn_cvt_pk_f32_fp8(yb, true);
      x.x += (a01.x + b01.x) * 0.015625f; x.y += (a01.y + b01.y) * 0.015625f; x.z += (a23.x + b23.x) * 0.015625f; x.w += (a23.y + b23.y) * 0.015625f;
      v[j] = x; s += (x.x + x.y) + (x.z + x.w); }
    const float mean = wave_sum(s) * (1.f / 1024.f); float s2 = 0.f;
#pragma unroll
    for (int j = 0; j < 4; ++j) { v[j] = v[j] - mean; s2 += (v[j].x * v[j].x + v[j].y * v[j].y) + (v[j].z * v[j].z + v[j].w * v[j].w); }
    const float rstd = rsqrtf(wave_sum(s2) * (1.f / 1024.f) + 1e-5f);
#pragma unroll
    for (int j = 0; j < 4; ++j) { const f32x4 g = ((const f32x4*)g2)[lane + 64 * j], bb = ((const f32x4*)b2)[lane + 64 * j]; row[lane + 64 * j] = v[j] * rstd * g + bb; }
  }
}

constexpr int NPHASE = 11;
__global__ void __launch_bounds__(NTHREADS, 2) mega(Ctx c) {
  float* lds = (float*)lds_raw;
  unsigned* ctl = (unsigned*)(c.ws + WS_CTL);
  unsigned* bar = ctl + CW_BAR;
  if (threadIdx.x == 0) { *(volatile unsigned*)(lds_raw + LDS_WCTR) = 0u; *(volatile unsigned*)(lds_raw + LDS_XBST) = 0u; *(volatile unsigned*)(lds_raw + LDS_XBST + 4) = 0u;
    (void)xb_add(&bar[XB_XCNT(xb_xcc_id())], 1u); }
  __syncthreads();
  phase_prologue(c, lds);
  xcd_barrier(bar);
  phase_inproj_mfma(c, (lds_u8*)lds_raw);
  phase_tiles_queue(c, lds, ctl + CW_Q + 48, TP_WD0 - TP_D1, TP_WD0);
  xcd_barrier(bar);
  phase_gdn_prep2(c, lds_raw);
  phase_kvup(c, lds);
  phase_topk_mfma(c, lds_raw, ctl + CW_Q);
  xcd_barrier(bar);
  if (blockIdx.x < 48) phase_gdn_scan(c, lds_raw, blockIdx.x);
  phase_attn_sparse(c, lds_raw, ctl + CW_Q + 16);
  phase_attn_mem(c, lds_raw, ctl + CW_Q + 32);
  xcd_barrier(bar);
  phase_outproj_mfma(c, (lds_u8*)lds_raw);
  xcd_barrier(bar);
  phase_router(c, lds_raw);
  xcd_barrier(bar);
  phase_moe_up_mfma(c, (lds_u8*)lds_raw);
  phase_tiles_queue(c, lds, ctl + CW_Q + 64, TP_WD0, TP_TOTAL);
  xcd_barrier(bar);
  phase_moe_down_mfma(c, (lds_u8*)lds_raw);
  xcd_barrier(bar);
  phase_combine(c, lds);
}

extern "C" void kernel_launch(void* const* d_in, const int* in_sizes, int n_in, void* d_out, int out_size, void* d_ws, size_t ws_size, hipStream_t stream) {
  static int grid = 0;
  if (grid == 0) {
    if (n_in != 25 || ws_size < WS_END) { fprintf(stderr, "kernel_launch: unexpected n_in %d / ws %zu\n", n_in, ws_size); grid = -1; return; }
    int dev = 0, cus = 0, per_cu = 0;
    hipGetDevice(&dev); hipDeviceGetAttribute(&cus, hipDeviceAttributeMultiprocessorCount, dev);
    hipFuncSetAttribute((const void*)mega, hipFuncAttributeMaxDynamicSharedMemorySize, LDS_BYTES);
    hipOccupancyMaxActiveBlocksPerMultiprocessor(&per_cu, (const void*)mega, NTHREADS, LDS_BYTES);
    if (per_cu < 1) { fprintf(stderr, "kernel_launch: occupancy query says %d blocks/CU\n", per_cu); per_cu = 1; }
    grid = cus * (per_cu < 1 ? 1 : 1);
    (void)hipGetLastError();
  }
  if (grid < 0) return;
  hipMemsetAsync((char*)d_ws + WS_CTL, 0, 32 * 1024, stream);
  Ctx c; memset(&c, 0, sizeof(c));
  for (int i = 0; i < 25; ++i) c.in[i] = (const float*)d_in[i];
  c.out = (float*)d_out; c.ws = (unsigned char*)d_ws;
  hipLaunchKernelGGL(mega, dim3(grid), dim3(NTHREADS), LDS_BYTES, stream, c);
}
```

```cpp
#include <hip/hip_runtime.h>
#include <cstdio>
#include <cstdint>
#include <cstring>

#ifndef ONE_LAUNCH
#define ONE_LAUNCH 1
#endif

typedef unsigned short bf16_t;
typedef float f32x4 __attribute__((ext_vector_type(4)));
typedef unsigned u32x4 __attribute__((ext_vector_type(4)));
typedef unsigned u32x2 __attribute__((ext_vector_type(2)));

constexpr int T = 32768, DM = 1024, SEQ = 4096, NBATCH = 8;
constexpr int NIN = 2816;
constexpr int NMEM = 256, TM = NBATCH * NMEM;
constexpr int NEXP = 64, DE = 256;
constexpr int NTHREADS = 512, NWAVES = 8;
constexpr float ALPHA = 1.189207115002721f;
constexpr float LOG2E = 1.4426950408889634f;
constexpr float QSCALE = 0.125f * LOG2E;

constexpr size_t MiB = 1ull << 20;
constexpr size_t WS_CTL = 0;
constexpr size_t WS_TSLOT = 512 * 1024;
constexpr size_t WS_ROPE = 1 * MiB;
constexpr size_t WS_WKV = 2 * MiB;
constexpr size_t WS_WR = 2 * MiB + 65536;
constexpr size_t WS_WIN = 3 * MiB;
constexpr size_t WS_WO = 9 * MiB;
constexpr size_t WS_WMKV = 11 * MiB;
constexpr size_t WS_MEMB = 12 * MiB;
constexpr size_t WS_WGU = 16 * MiB;
constexpr size_t WS_WD = 80 * MiB;
constexpr size_t WS_XB = 112 * MiB;
constexpr size_t WS_QA = 176 * MiB;
constexpr size_t WS_CKV = 200 * MiB;
constexpr size_t WS_IQ = 208 * MiB;
constexpr size_t WS_IK = 224 * MiB;
constexpr size_t WS_SM = 228 * MiB;
constexpr size_t WS_QC = 230 * MiB;
constexpr size_t WS_GB = 246 * MiB;
constexpr size_t WS_MK = 342 * MiB;
constexpr size_t WS_MVT = 343 * MiB;
constexpr size_t WS_KVA = 344 * MiB;
constexpr size_t WS_SEL = 352 * MiB;
constexpr size_t WS_CAT = 368 * MiB;
constexpr size_t WS_X1B = 432 * MiB;
constexpr size_t WS_LIST = 496 * MiB;
constexpr size_t WS_GATEL = 504 * MiB;
constexpr size_t WS_END = 512 * MiB;
constexpr size_t WS_H = 112 * MiB;
constexpr size_t WS_Y = 160 * MiB;

constexpr int CW_CNT = 0;
constexpr int CW_Q = 64;
constexpr int CW_BAR = 4096;

struct Ctx {
  const float* in[25];
  float* out;
  unsigned char* ws;
  int ph_lo, ph_hi;
};


extern __shared__ __attribute__((aligned(16))) unsigned char lds_raw[];
constexpr int LDS_BYTES = 157696;
constexpr int LDS_WCTR = LDS_BYTES - 64;
__device__ __forceinline__ int phase_tid() {
  __syncthreads();
  int l; asm volatile("v_mbcnt_lo_u32_b32 %0, -1, 0\n\tv_mbcnt_hi_u32_b32 %0, -1, %0" : "=v"(l));
  unsigned w = 0u;
  if (l == 0) w = __hip_atomic_fetch_add((__attribute__((address_space(3))) unsigned*)(__attribute__((address_space(3))) unsigned char*)(lds_raw + LDS_WCTR), 1u, __ATOMIC_RELAXED, __HIP_MEMORY_SCOPE_WORKGROUP);
  w = (unsigned)__builtin_amdgcn_readfirstlane((int)w) & 7u;
  return (int)(w * 64u) + l;
}


#define XB_TMO      128
#define XB_XCNT(j)  (256  + 64 * (j))
#define XB_XSUB(j)  (1280 + 64 * (j))
#define XB_XGEN(j)  (2304 + 64 * (j))
#define XB_TOP      3328
#define XB_TOPGEN   3392
#define XCD_BAR_WORDS 3456
#define XB_SPIN_CAP (1u << 18)
constexpr int LDS_XBST = LDS_BYTES - 32;
__device__ __forceinline__ unsigned xb_ld(unsigned* p)              { return __hip_atomic_load(p, __ATOMIC_RELAXED, __HIP_MEMORY_SCOPE_AGENT); }
__device__ __forceinline__ unsigned xb_add(unsigned* p, unsigned v) { return __hip_atomic_fetch_add(p, v, __ATOMIC_RELAXED, __HIP_MEMORY_SCOPE_AGENT); }
__device__ __forceinline__ unsigned xb_xcc_id() { return (unsigned)__builtin_amdgcn_s_getreg((3 << 11) | 20) & 0xFu; }
#define XB_SPIN(cond, bar) do { unsigned _sp = 0; while (cond) { __builtin_amdgcn_s_sleep(1); \
    if ((++_sp & 255u) == 0u) { if (xb_ld(&(bar)[XB_TMO])) break; if (_sp > XB_SPIN_CAP) { atomicAdd(&(bar)[XB_TMO], 1u); break; } } } } while (0)
__device__ __forceinline__ void xcd_barrier_complete(unsigned* bar, unsigned x, unsigned& nloc, unsigned& nx) {
    const unsigned G = gridDim.x;
    unsigned sum, cnt, mine, sp = 0u;
    for (;;) {
        sum = 0u; cnt = 0u; mine = 0u;
#pragma unroll
        for (unsigned j = 0; j < 16; ++j) { const unsigned cc = xb_ld(&bar[XB_XCNT(j)]); sum += cc; cnt += (cc > 0u) ? 1u : 0u; mine = (j == x) ? cc : mine; }
        if (sum == G) break;
        __builtin_amdgcn_s_sleep(1);
        if ((++sp & 255u) == 0u) { if (xb_ld(&bar[XB_TMO])) break; if (sp > XB_SPIN_CAP) { atomicAdd(&bar[XB_TMO], 1u); break; } }
    }
    nloc = mine > 0u ? mine : 1u; nx = cnt > 0u ? cnt : 1u;
}
__device__ __forceinline__ void xcd_barrier(unsigned* bar) {
    asm volatile("s_waitcnt vmcnt(0)" ::: "memory");
    __syncthreads();
    const int btid = phase_tid();
    if (btid == 0) {
        volatile __attribute__((address_space(3))) unsigned* st = (volatile __attribute__((address_space(3))) unsigned*)(__attribute__((address_space(3))) unsigned char*)(lds_raw + LDS_XBST);
        const unsigned x = xb_xcc_id();
        __builtin_amdgcn_s_waitcnt(0);
        unsigned nloc = st[0], nx = st[1];
        if (nloc == 0u) { xcd_barrier_complete(bar, x, nloc, nx); st[0] = nloc; st[1] = nx; }
        const unsigned old = xb_add(&bar[XB_XSUB(x)], 1u);
        const unsigned gen = old / nloc;
        if (old + 1u == (gen + 1u) * nloc) {
            __builtin_amdgcn_fence(__ATOMIC_RELEASE, "agent");
            asm volatile("s_waitcnt vmcnt(0)" ::: "memory");
            const unsigned og = xb_add(&bar[XB_TOP], 1u);
            const unsigned tg = og / nx;
            if (og + 1u == (tg + 1u) * nx) xb_add(&bar[XB_TOPGEN], 1u);
            else XB_SPIN(xb_ld(&bar[XB_TOPGEN]) == tg, bar);
            __builtin_amdgcn_fence(__ATOMIC_ACQUIRE, "agent");
            xb_add(&bar[XB_XGEN(x)], 1u);
            asm volatile("s_waitcnt vmcnt(0)" ::: "memory");
        } else {
            XB_SPIN(xb_ld(&bar[XB_XGEN(x)]) == gen, bar);
            __builtin_amdgcn_fence(__ATOMIC_ACQUIRE, "agent");
            asm volatile("s_waitcnt vmcnt(0)" ::: "memory");
        }
    }
    __syncthreads();
}

__device__ __forceinline__ float bf2f(bf16_t v) { return __uint_as_float(((unsigned)v) << 16); }
typedef float hw_f32x2 __attribute__((ext_vector_type(2))); typedef __bf16 hw_bf16x2 __attribute__((ext_vector_type(2)));
__device__ __forceinline__ unsigned pk2(float lo, float hi) { const hw_f32x2 v = {lo, hi}; const hw_bf16x2 b = __builtin_convertvector(v, hw_bf16x2); return __builtin_bit_cast(unsigned, b); }
__device__ __forceinline__ bf16_t f2bf(float f) { return (bf16_t)(pk2(f, f) & 0xffffu); }
__device__ __forceinline__ float wave_sum(float v) {
  int x = __float_as_int(v);
  x = __float_as_int(__int_as_float(x) + __int_as_float(__builtin_amdgcn_update_dpp(0, x, 0x111, 0xF, 0xF, true)));
  x = __float_as_int(__int_as_float(x) + __int_as_float(__builtin_amdgcn_update_dpp(0, x, 0x112, 0xF, 0xF, true)));
  x = __float_as_int(__int_as_float(x) + __int_as_float(__builtin_amdgcn_update_dpp(0, x, 0x114, 0xF, 0xF, true)));
  x = __float_as_int(__int_as_float(x) + __int_as_float(__builtin_amdgcn_update_dpp(0, x, 0x118, 0xF, 0xF, true)));
  x = __float_as_int(__int_as_float(x) + __int_as_float(__builtin_amdgcn_update_dpp(0, x, 0x142, 0xA, 0xF, false)));
  x = __float_as_int(__int_as_float(x) + __int_as_float(__builtin_amdgcn_update_dpp(0, x, 0x143, 0xC, 0xF, false)));
  return __int_as_float(__builtin_amdgcn_readlane(x, 63));
}
__device__ __forceinline__ float wave_max(float v) {
#pragma unroll
  for (int o = 32; o >= 1; o >>= 1) v = fmaxf(v, __shfl_xor(v, o));
  return v;
}
__device__ __forceinline__ float silu_f(float v) { return v * __builtin_amdgcn_rcpf(1.f + __expf(-v)); }

__device__ __forceinline__ int ropeperm(int p) { return (p >> 1) + 32 * (p & 1); }
__device__ __forceinline__ int colmap_in(int cp) {
  const int tile = cp >> 8, w = cp & 255;
  if (tile == 0) return (w >> 6) * 64 + ropeperm(w & 63);
  if (tile == 1) { if (w < 128) { const int c = 256 + w; return (c >> 6) * 64 + ropeperm(c & 63); } return 384 + (w - 128); }
  if (tile == 2) return 512 + (w >> 6) * 64 + ropeperm(w & 63);
  if (tile == 3) { if (w < 64) return 768 + ropeperm(w); if (w < 68) return 832 + (w - 64); if (w < 74) return 2372 + (w - 68); if (w < 80) return 2378 + (w - 74); return -1; }
  if (tile == 4) return 2384 + w;
  return 836 + (cp - 1280);
}

struct WorkQ { unsigned* head; volatile int* slot; int nxt; };
__device__ __forceinline__ void wq_init(WorkQ& q, unsigned* head, volatile int* slot, int tid) { q.head = head; q.slot = slot; q.nxt = 0; if (tid == 0) q.nxt = (int)atomicAdd(head, 1u); }
__device__ __forceinline__ int wq_next(WorkQ& q, int tid) {
  __syncthreads();
  if (tid == 0) { *q.slot = q.nxt; q.nxt = (int)atomicAdd(q.head, 1u); }
  __syncthreads();
  return *q.slot;
}

template <class CM>
__device__ __forceinline__ void tp_tile(const float* src, int ld, bf16_t* dst, int drow0, int K, int k0, CM cm, float* lds, int tid) {
  const int a = tid & 63, b = tid >> 6;
  const int sc = cm(a);
  __syncthreads();
#pragma unroll
  for (int i = 0; i < 8; ++i) { const int kk = b * 8 + i; lds[kk * 65 + a] = sc >= 0 ? src[(size_t)(k0 + kk) * ld + sc] : 0.f; }
  __syncthreads();
  { const int nn = tid >> 3, kc = (tid & 7) * 8;
    const float* p = lds + kc * 65 + nn;
    *(u32x4*)(dst + (size_t)(drow0 + nn) * K + k0 + kc) = (u32x4){pk2(p[0], p[65]), pk2(p[130], p[195]), pk2(p[260], p[325]), pk2(p[390], p[455])}; }
}

constexpr int TP_TOTAL = (NIN / 64) * 16 + 16 * 16 + 8 * 16 + 64 * 8 * 16 + 64 * 16 * 4;
constexpr int TP_WD0 = TP_TOTAL - 64 * 16 * 4;
constexpr int TP_D1 = 5200;
__device__ __forceinline__ void prologue_tiles(const Ctx& c, float* lds, int tid, int lo, int hi, int b0, int nb) {
  unsigned char* ws = c.ws;
  const int n_win = (NIN / 64) * 16, n_wo = 16 * 16, n_wmkv = 8 * 16, n_wgu = 64 * 8 * 16, n_wd = 64 * 16 * 4;
  const int total = n_win + n_wo + n_wmkv + n_wgu + n_wd;
  for (int it = lo + b0; it < hi; it += nb) {
    int r = it;
    if (r < n_win) { const int nt = r / 16, kt = r % 16; tp_tile(c.in[2], 2640, (bf16_t*)(ws + WS_WIN), nt * 64, 1024, kt * 64, [&](int a) { return colmap_in(nt * 64 + a); }, lds, tid); continue; } r -= n_win;
    if (r < n_wo) { const int nt = r / 16, kt = r % 16; tp_tile(c.in[13], 1024, (bf16_t*)(ws + WS_WO), nt * 64, 1024, kt * 64, [&](int a) { return nt * 64 + a; }, lds, tid); continue; } r -= n_wo;
    if (r < n_wmkv) { const int nt = r / 16, kt = r % 16; tp_tile(c.in[12], 512, (bf16_t*)(ws + WS_WMKV), nt * 64, 1024, kt * 64, [&](int a) { return nt * 64 + a; }, lds, tid); continue; } r -= n_wmkv;
    if (r < n_wgu) { const int e = r / 128, q = r % 128, nt = q / 16, kt = q % 16;
      const int pn = nt >> 2, sub = nt & 3, isup = sub >> 1, c0 = pn * 128 + (sub & 1) * 64;
      const float* src = (isup ? c.in[21] : c.in[20]) + (size_t)e * 1024 * 256;
      tp_tile(src, 256, (bf16_t*)(ws + WS_WGU), e * 512 + nt * 64, 1024, kt * 64, [&](int a) { return c0 + a; }, lds, tid); continue; } r -= n_wgu;
    { const int e = r / 64, q = r % 64, nt = q / 4, kt = q % 4;
      tp_tile(c.in[22] + (size_t)e * 256 * 1024, 1024, (bf16_t*)(ws + WS_WD), e * 1024 + nt * 64, 256, kt * 64, [&](int a) { return nt * 64 + a; }, lds, tid); }
  }
}

__device__ void phase_tiles_queue(const Ctx& c, float* lds, unsigned* qhead, int lo, int hi) {
  const int tid = phase_tid();
  volatile int* slot = (volatile int*)(lds + 64 * 65 + 16);
  WorkQ wq; wq_init(wq, qhead, slot, tid);
  const int nitems = (hi - lo + 7) >> 3;
  for (;;) {
    const int item = wq_next(wq, tid);
    if (item >= nitems) break;
    const int t0 = lo + item * 8, t1 = t0 + 8 < hi ? t0 + 8 : hi;
    prologue_tiles(c, lds, tid, t0, t1, 0, 1);
  }
}

__device__ void phase_prologue(const Ctx& c, float* lds) {
  const int tid = phase_tid(), bid = blockIdx.x, G = gridDim.x;
  unsigned char* ws = c.ws;
  const size_t gtid = (size_t)bid * NTHREADS + tid, gstride = (size_t)G * NTHREADS;
  { const f32x4* x4 = (const f32x4*)c.in[0]; u32x2* o = (u32x2*)c.out;
    for (size_t i = gtid; i < (size_t)T * DM / 4; i += gstride) { const f32x4 v = x4[i]; o[i] = (u32x2){pk2(v.x, v.y), pk2(v.z, v.w)}; }
    const f32x4* m4 = (const f32x4*)c.in[1]; u32x2* om = (u32x2*)(ws + WS_MEMB);
    for (size_t i = gtid; i < (size_t)TM * DM / 4; i += gstride) { const f32x4 v = m4[i]; om[i] = (u32x2){pk2(v.x, v.y), pk2(v.z, v.w)}; } }
  { float* cs = (float*)(ws + WS_ROPE); float* sn = cs + SEQ * 32;
    for (size_t i = gtid; i < (size_t)SEQ * 32; i += gstride) { const int s = (int)(i >> 5), d = (int)(i & 31);
      const float inv = 1.0f / powf(10000.0f, (float)d / 32.0f); const float ang = (float)s * inv; float sv, cv; sincosf(ang, &sv, &cv); cs[i] = cv; sn[i] = sv; } }
  { bf16_t* wkv = (bf16_t*)(ws + WS_WKV); const float* g = c.in[3]; const float* wk = c.in[4]; const float* wv = c.in[5];
    for (size_t i = gtid; i < 128 * 128; i += gstride) { const int p = (int)(i >> 7), k = (int)(i & 127);
      const float w = p < 64 ? wk[k * 64 + ropeperm(p)] : wv[k * 64 + (p - 64)]; wkv[i] = f2bf(w * g[k]); }
    bf16_t* wr = (bf16_t*)(ws + WS_WR); const float* wg = c.in[16]; const float* wrt = c.in[18];
    for (size_t i = gtid; i < 80 * 1024; i += gstride) { const int o = (int)(i >> 10), k = (int)(i & 1023); wr[i] = f2bf(o < 8 ? wg[k * 8 + o] : o < 72 ? wrt[k * 64 + (o - 8)] : 0.f); } }
  prologue_tiles(c, lds, tid, 0, TP_WD0 - TP_D1, bid, G);
}

__device__ __forceinline__ void expert_offsets(const Ctx& c, int* offs  , int* cnts  , int tid) {
  const unsigned* ctl = (const unsigned*)(c.ws + WS_CTL);
  __syncthreads();
  if (tid == 0) { int o = 0; for (int e = 0; e < 64; ++e) { const int n = (int)ctl[CW_CNT + e]; cnts[e] = n; offs[e] = o; o += (n + 255) & ~255; } offs[64] = o; }
  __syncthreads();
}


namespace pg8 {
#define PG8_LAS __attribute__((address_space(3)))
typedef short bf16x8 __attribute__((ext_vector_type(8)));
constexpr int BM = 256, BK = 64, HALF = 128, HTB = HALF * BK * 2, STAGE_BYTES = 8 * HTB, NXCD = 8, WGM = 8;
__host__ __device__ __forceinline__ int lds_byte(int r, int c) { const int st = (r >> 4) * 2 + (c >> 5), rr = r & 15, cc = c & 31, ob = rr * 64 + cc * 2; return st * 1024 + (ob ^ (((ob >> 9) & 1) << 5)); }
__host__ __device__ __forceinline__ void stage_rc(int b, int& R, int& C) { const int st = b / 1024, sb = b % 1024, swz = sb ^ (((sb >> 9) & 1) << 5); R = (st >> 1) * 16 + swz / 64; C = (st & 1) * 32 + (swz % 64) / 2; }
__host__ __device__ __forceinline__ int perm32(int rho) { const int n = rho >> 4, i = rho & 15; return 8 * (i >> 2) + 4 * n + (i & 3); }
struct Unit { int pm, pn, e, mt, aux; };
struct Gemm { const bf16_t* A; const bf16_t* Bt; int K; };
struct StaticOrder {
    int nM, nN, nwg, G, c;
    __device__ void init(int M, int N, int G_, int c_) { nM = M / BM; nN = N / BM; nwg = nM * nN; G = G_; c = c_; }
    __device__ bool next(int i, Unit& u) const {
        const long L = (long)i * G + c; if (c < 0 || L >= nwg) return false;
        int wgid = (int)L; { const int q = nwg / NXCD, r = nwg % NXCD, xcd = wgid % NXCD, off = wgid / NXCD; wgid = (xcd < r ? xcd * (q + 1) : r * (q + 1) + (xcd - r) * q) + off; }
        const int nig = WGM * nN, gid = wgid / nig, fm = gid * WGM, gsz = (nM - fm) < WGM ? (nM - fm) : WGM;
        u.pm = fm + ((wgid % nig) % gsz); u.pn = (wgid % nig) / gsz; u.e = 0; u.mt = 0; u.aux = 0; return true;
    }
    __device__ __forceinline__ unsigned arow(const Unit&, int) const { return 0u; }
};
__device__ __forceinline__ unsigned cvt_pk_bf16(float lo, float hi) { unsigned r; asm volatile("v_cvt_pk_bf16_f32 %0, %1, %2" : "=v"(r) : "v"(lo), "v"(hi)); return r; }

template <class Epi, class Sched, bool ALIGN_EPI, bool GATHER>
__device__ __forceinline__ void gemm_phase(PG8_LAS unsigned char* lds, const Gemm g, const Sched& S, const Epi& E, const int tid) {
    const int wid = __builtin_amdgcn_readfirstlane(tid >> 6), lane = tid & 63, wr = wid >> 2, wc = wid & 3, fr = lane & 15, fq = lane >> 4;
    const int K = g.K, nt = K / BK;
    unsigned voffA[2], voffB[2]; int RA[2], CA[2];
#pragma unroll
    for (int i = 0; i < 2; ++i) { int R, C; stage_rc(tid * 16 + i * 8192, R, C); const int Rb = Epi::PERM ? ((R & ~31) + perm32(R & 31)) : R;
        RA[i] = R; CA[i] = C; voffA[i] = (unsigned)(R * K + C) * 2u; voffB[i] = (unsigned)(Rb * K + C) * 2u; }
    const size_t kstep = (size_t)(BK * 2);
    const size_t hstep = (size_t)HALF * K * 2;
    const size_t tstep = 2 * hstep;
    const unsigned ldsw = (unsigned)wid * 1024u;
    const int aoff = lds_byte(wr * 64 + fr, fq * 8), boff = lds_byte(wc * 32 + fr, fq * 8);
#define PG8_SA(b, h) (((b) * 2 + (h)) * HTB)
#define PG8_SB(b, h) ((4 + (b) * 2 + (h)) * HTB)
#define PG8_STAGE(bufoff, gbase, voff) do { _Pragma("unroll") for (int _i = 0; _i < 2; ++_i) \
        __builtin_amdgcn_global_load_lds((const unsigned*)((const char*)(gbase) + (voff)[_i]), (PG8_LAS unsigned*)(lds + (bufoff) + ldsw + _i * 8192), 16, 0, 0); } while (0)
#define PG8_STAGE_A(bufoff, gbase, h, goff) do { if constexpr (GATHER) { PG8_STAGE(bufoff, gbase, (goff)[h]); } else { PG8_STAGE(bufoff, (gbase) + (h) * hstep, voffA); } } while (0)
#define PG8_LDA(dst, b, h) do { _Pragma("unroll") for (int m = 0; m < 4; ++m) _Pragma("unroll") for (int k = 0; k < 2; ++k) dst[m][k] = *(const PG8_LAS bf16x8*)(lds + PG8_SA(b, h) + aoff + m * 2048 + k * 1024); } while (0)
#define PG8_LDB(dst, b, h) do { _Pragma("unroll") for (int n = 0; n < 2; ++n) _Pragma("unroll") for (int k = 0; k < 2; ++k) dst[n][k] = *(const PG8_LAS bf16x8*)(lds + PG8_SB(b, h) + boff + n * 2048 + k * 1024); } while (0)
#define PG8_MMA(ai, bj, At, Bt) do { __builtin_amdgcn_s_setprio(1); _Pragma("unroll") for (int m = 0; m < 4; ++m) _Pragma("unroll") for (int n = 0; n < 2; ++n) _Pragma("unroll") for (int k = 0; k < 2; ++k) \
        acc[ai][bj][m][n] = __builtin_amdgcn_mfma_f32_16x16x32_bf16(Bt[n][k], At[m][k], acc[ai][bj][m][n], 0, 0, 0); __builtin_amdgcn_s_setprio(0); } while (0)
#define PG8_WAIT_V(n) asm volatile("s_waitcnt vmcnt(" #n ")" ::: "memory")
#define PG8_WAIT_L(n) asm volatile("s_waitcnt lgkmcnt(" #n ")" ::: "memory")
#define PG8_BAR __builtin_amdgcn_s_barrier()
#define PG8_SCHED __builtin_amdgcn_sched_barrier(0)
    Unit cur, nxt; int ui = 0;
    if (!S.next(0, cur)) return;
    f32x4 acc[2][2][4][2];
#pragma unroll
    for (int a = 0; a < 2; ++a)
#pragma unroll
        for (int b = 0; b < 2; ++b)
#pragma unroll
            for (int m = 0; m < 4; ++m)
#pragma unroll
                for (int n = 0; n < 2; ++n) acc[a][b][m][n] = (f32x4){0.f, 0.f, 0.f, 0.f};
    bf16x8 At[4][2], B0[2][2], B1[2][2];
    unsigned gc[2][2], gn[2][2];
    const char* cA; const char* cB = (const char*)g.Bt + (size_t)cur.pn * tstep;
    if constexpr (GATHER) { cA = (const char*)g.A;
#pragma unroll
        for (int h = 0; h < 2; ++h)
#pragma unroll
            for (int i = 0; i < 2; ++i) { gc[h][i] = (S.arow(cur, h * HALF + RA[i]) * (unsigned)K + (unsigned)CA[i]) * 2u; gn[h][i] = gc[h][i]; }
    } else { cA = (const char*)g.A + (size_t)cur.pm * tstep; }
    PG8_STAGE(PG8_SB(0, 0), cB, voffB); PG8_STAGE(PG8_SB(0, 1), cB + hstep, voffB); PG8_STAGE_A(PG8_SA(0, 0), cA, 0, gc); PG8_STAGE_A(PG8_SA(0, 1), cA, 1, gc);
    if (wr == 1) PG8_BAR;
    PG8_WAIT_V(2); PG8_BAR;
    PG8_STAGE(PG8_SB(1, 0), cB + kstep, voffB); PG8_STAGE_A(PG8_SA(1, 0), cA + kstep, 0, gc); PG8_STAGE(PG8_SB(1, 1), cB + hstep + kstep, voffB);
    PG8_WAIT_V(6); PG8_BAR;
    for (;;) {
        const bool has_next = S.next(ui + 1, nxt);
        const char* nA; const char* nB = has_next ? (const char*)g.Bt + (size_t)nxt.pn * tstep : cB;
        if constexpr (GATHER) { nA = cA;
            if (has_next) {
#pragma unroll
                for (int h = 0; h < 2; ++h)
#pragma unroll
                    for (int i = 0; i < 2; ++i) gn[h][i] = (S.arow(nxt, h * HALF + RA[i]) * (unsigned)K + (unsigned)CA[i]) * 2u; }
        } else { nA = has_next ? (const char*)g.A + (size_t)nxt.pm * tstep : cA; }
        for (int t = 0; t < nt; t += 2) {
            const bool last = (t == nt - 2);
            const char* a1 = cA + (size_t)(t + 1) * kstep;
            const char* a2 = last ? nA : cA + (size_t)(t + 2) * kstep; const char* b2 = last ? nB : cB + (size_t)(t + 2) * kstep;
            const char* a3 = a2 + kstep; const char* b3 = b2 + kstep;
            unsigned g2[2][2];
            if constexpr (GATHER) {
#pragma unroll
            for (int h = 0; h < 2; ++h)
#pragma unroll
                for (int i = 0; i < 2; ++i) g2[h][i] = last ? gn[h][i] : gc[h][i]; }
            PG8_LDB(B0, 0, 0); PG8_LDB(B1, 0, 1); PG8_SCHED; PG8_LDA(At, 0, 0); PG8_STAGE_A(PG8_SA(1, 1), a1, 1, gc);
            PG8_WAIT_V(8); PG8_WAIT_L(0); PG8_BAR; PG8_MMA(0, 0, At, B0); PG8_MMA(0, 1, At, B1); PG8_BAR; PG8_SCHED;
            PG8_LDA(At, 0, 1); PG8_STAGE(PG8_SB(0, 0), b2, voffB); PG8_STAGE(PG8_SB(0, 1), b2 + hstep, voffB); PG8_STAGE_A(PG8_SA(0, 0), a2, 0, g2);
            PG8_WAIT_V(8); PG8_WAIT_L(0); PG8_BAR; PG8_MMA(1, 0, At, B0); PG8_MMA(1, 1, At, B1); PG8_BAR; PG8_SCHED;
            PG8_LDB(B0, 1, 0); PG8_LDB(B1, 1, 1); PG8_SCHED; PG8_LDA(At, 1, 0); PG8_STAGE_A(PG8_SA(0, 1), a2, 1, g2);
            PG8_WAIT_V(8); PG8_WAIT_L(0); PG8_BAR; PG8_MMA(0, 0, At, B0); PG8_MMA(0, 1, At, B1); PG8_BAR; PG8_SCHED;
            PG8_LDA(At, 1, 1); PG8_STAGE(PG8_SB(1, 0), b3, voffB); PG8_STAGE(PG8_SB(1, 1), b3 + hstep, voffB); PG8_STAGE_A(PG8_SA(1, 0), a3, 0, g2);
            PG8_WAIT_V(8); PG8_WAIT_L(0); PG8_BAR; PG8_MMA(1, 0, At, B0); PG8_MMA(1, 1, At, B1); PG8_BAR; PG8_SCHED;
        }
        if constexpr (ALIGN_EPI) { if (wr == 0) PG8_BAR; }
        E(acc, cur, wr, wc, fr, fq);
        if (!has_next) break;
#pragma unroll
        for (int a = 0; a < 2; ++a)
#pragma unroll
            for (int b = 0; b < 2; ++b)
#pragma unroll
                for (int m = 0; m < 4; ++m)
#pragma unroll
                    for (int n = 0; n < 2; ++n) acc[a][b][m][n] = (f32x4){0.f, 0.f, 0.f, 0.f};
        cur = nxt; cA = nA; cB = nB; ++ui;
        if constexpr (GATHER) {
#pragma unroll
        for (int h = 0; h < 2; ++h)
#pragma unroll
            for (int i = 0; i < 2; ++i) gc[h][i] = gn[h][i]; }
        if constexpr (ALIGN_EPI) { if (wr == 1) PG8_BAR; }
    }
    PG8_WAIT_V(0);
    if constexpr (!ALIGN_EPI) { if (wr == 0) PG8_BAR; }
    PG8_BAR;
#undef PG8_SA
#undef PG8_SB
#undef PG8_STAGE
#undef PG8_STAGE_A
#undef PG8_LDA
#undef PG8_LDB
#undef PG8_MMA
#undef PG8_WAIT_V
#undef PG8_WAIT_L
#undef PG8_BAR
#undef PG8_SCHED
}
}
typedef __attribute__((address_space(3))) unsigned char lds_u8;

__device__ __forceinline__ u32x4 pack8(const f32x4& a, const f32x4& b) { return (u32x4){pg8::cvt_pk_bf16(a.x, a.y), pg8::cvt_pk_bf16(a.z, a.w), pg8::cvt_pk_bf16(b.x, b.y), pg8::cvt_pk_bf16(b.z, b.w)}; }
struct EpiInM {
  static constexpr bool PERM = true;
  unsigned char* ws;
  __device__ __forceinline__ void operator()(const f32x4 (&acc)[2][2][4][2], const pg8::Unit& u, int wr, int wc, int fr, int fq) const {
    const float* cs = (const float*)(ws + WS_ROPE); const float* sn = cs + SEQ * 32;
    const int pn = u.pn;
#pragma unroll
    for (int ai = 0; ai < 2; ++ai)
#pragma unroll
      for (int m = 0; m < 4; ++m) {
        const int row = u.pm * 256 + ai * 128 + wr * 64 + m * 16 + fr, pos = row & (SEQ - 1);
#pragma unroll
        for (int bj = 0; bj < 2; ++bj) {
          const int w = bj * 128 + wc * 32 + 8 * fq;
          f32x4 v0 = acc[ai][bj][m][0], v1 = acc[ai][bj][m][1];
          const bool do_rope = (pn == 0) || (pn == 1 && bj == 0) || (pn == 2) || (pn == 3 && bj == 0 && wc < 2);
          if (do_rope) { const int d = (w & 63) >> 1; const f32x4 c4 = *(const f32x4*)(cs + pos * 32 + d), s4 = *(const f32x4*)(sn + pos * 32 + d);
            const f32x4 o0 = {v0.x * c4.x - v0.y * s4.x, v0.y * c4.x + v0.x * s4.x, v0.z * c4.y - v0.w * s4.y, v0.w * c4.y + v0.z * s4.y};
            const f32x4 o1 = {v1.x * c4.z - v1.y * s4.z, v1.y * c4.z + v1.x * s4.z, v1.z * c4.w - v1.w * s4.w, v1.w * c4.w + v1.z * s4.w};
            v0 = o0; v1 = o1; }
          if (pn == 0) { *(u32x4*)((bf16_t*)(ws + WS_QA) + (size_t)row * 384 + w) = pack8(v0 * QSCALE, v1 * QSCALE); }
          else if (pn == 1) { if (bj == 0) *(u32x4*)((bf16_t*)(ws + WS_QA) + (size_t)row * 384 + 256 + w) = pack8(v0 * QSCALE, v1 * QSCALE);
                              else *(u32x4*)((bf16_t*)(ws + WS_CKV) + (size_t)row * 128 + (w - 128)) = pack8(v0, v1); }
          else if (pn == 2) { *(u32x4*)((bf16_t*)(ws + WS_IQ) + (size_t)row * 256 + w) = pack8(v0, v1); }
          else if (pn == 3) { if (bj == 0) { if (wc < 2) *(u32x4*)((bf16_t*)(ws + WS_IK) + (size_t)row * 64 + w) = pack8(v0, v1);
                                             else if (wc == 2 && fq < 2) { if (fq == 0) v0 = v0 * 0.0625f; float* o = (float*)(ws + WS_SM) + (size_t)row * 16 + 8 * fq; *(f32x4*)o = v0; *(f32x4*)(o + 4) = v1; } } }
          else if (pn == 4) { *(u32x4*)((bf16_t*)(ws + WS_QC) + (size_t)row * 256 + w) = pack8(v0 * QSCALE, v1 * QSCALE); }
          else { *(u32x4*)((bf16_t*)(ws + WS_GB) + (size_t)row * 1536 + (pn - 5) * 256 + w) = pack8(v0, v1); }
        }
      }
  }
};
struct EpiMemKVM {
  static constexpr bool PERM = true;
  unsigned char* ws;
  __device__ __forceinline__ void operator()(const f32x4 (&acc)[2][2][4][2], const pg8::Unit& u, int wr, int wc, int fr, int fq) const {
#pragma unroll
    for (int ai = 0; ai < 2; ++ai)
#pragma unroll
      for (int m = 0; m < 4; ++m) {
        const int row = u.pm * 256 + ai * 128 + wr * 64 + m * 16 + fr;
#pragma unroll
        for (int bj = 0; bj < 2; ++bj) {
          const int w = bj * 128 + wc * 32 + 8 * fq; const f32x4 v0 = acc[ai][bj][m][0], v1 = acc[ai][bj][m][1];
          if (u.pn == 0) *(u32x4*)((bf16_t*)(ws + WS_MK) + (size_t)row * 256 + w) = pack8(v0, v1);
          else { const int mem = row & 255, xx = mem & 31, mpos = (mem & ~31) + 8 * ((xx >> 2) & 3) + (xx & 3) + 4 * (xx >> 4);
            bf16_t* o = (bf16_t*)(ws + WS_MVT) + ((size_t)(row >> 8) * 256 + w) * 256 + mpos;
            o[0] = f2bf(v0.x); o[256] = f2bf(v0.y); o[512] = f2bf(v0.z); o[768] = f2bf(v0.w); o[1024] = f2bf(v1.x); o[1280] = f2bf(v1.y); o[1536] = f2bf(v1.z); o[1792] = f2bf(v1.w); }
        }
      }
  }
};
struct EpiOutM {
  static constexpr bool PERM = true;
  const bf16_t* x; bf16_t* y;
  __device__ __forceinline__ void operator()(const f32x4 (&acc)[2][2][4][2], const pg8::Unit& u, int wr, int wc, int fr, int fq) const {
#pragma unroll
    for (int ai = 0; ai < 2; ++ai)
#pragma unroll
      for (int m = 0; m < 4; ++m) {
        const size_t rb = (size_t)(u.pm * 256 + ai * 128 + wr * 64 + m * 16 + fr) * 1024 + u.pn * 256 + wc * 32 + 8 * fq;
#pragma unroll
        for (int bj = 0; bj < 2; ++bj) { const size_t o = rb + bj * 128; const u32x4 xv = *(const u32x4*)(x + o);
          const f32x4 x0 = {__uint_as_float(xv.x << 16), __uint_as_float(xv.x & 0xffff0000u), __uint_as_float(xv.y << 16), __uint_as_float(xv.y & 0xffff0000u)};
          const f32x4 x1 = {__uint_as_float(xv.z << 16), __uint_as_float(xv.z & 0xffff0000u), __uint_as_float(xv.w << 16), __uint_as_float(xv.w & 0xffff0000u)};
          *(u32x4*)(y + o) = pack8(x0 * ALPHA + acc[ai][bj][m][0], x1 * ALPHA + acc[ai][bj][m][1]); }
      }
  }
};
struct MoeOrder {
  const int* offs; const int* cnts; int npn, G, c; const unsigned* LIST;
  __device__ __forceinline__ bool next(int i, pg8::Unit& u) const {
    const int L = i * G + c; const int ntiles = __builtin_amdgcn_readfirstlane(offs[64]) >> 8;
    if (L >= ntiles * npn) return false;
    const int rt = L / npn, pl = L - rt * npn; int e = 0;
    while (__builtin_amdgcn_readfirstlane(offs[e + 1]) <= rt * 256) ++e;
    u.pm = rt; u.mt = rt - (__builtin_amdgcn_readfirstlane(offs[e]) >> 8); u.e = e; u.pn = e * npn + pl; u.aux = __builtin_amdgcn_readfirstlane(cnts[e]); return true;
  }
  __device__ __forceinline__ unsigned arow(const pg8::Unit& u, int r) const { const int rank = u.mt * 256 + r; return rank < u.aux ? LIST[(size_t)u.e * 32768 + rank] : 0u; }
};
struct EpiMoeUpM {
  static constexpr bool PERM = true;
  bf16_t* H;
  __device__ __forceinline__ void operator()(const f32x4 (&acc)[2][2][4][2], const pg8::Unit& u, int wr, int wc, int fr, int fq) const {
    const int pl = u.pn & 1;
#pragma unroll
    for (int ai = 0; ai < 2; ++ai)
#pragma unroll
      for (int m = 0; m < 4; ++m) {
        const int rl = ai * 128 + wr * 64 + m * 16 + fr;
        if (u.mt * 256 + rl < u.aux) {
          f32x4 h0, h1; const f32x4 g0 = acc[ai][0][m][0], g1 = acc[ai][0][m][1], u0 = acc[ai][1][m][0], u1 = acc[ai][1][m][1];
          h0.x = silu_f(g0.x) * u0.x; h0.y = silu_f(g0.y) * u0.y; h0.z = silu_f(g0.z) * u0.z; h0.w = silu_f(g0.w) * u0.w;
          h1.x = silu_f(g1.x) * u1.x; h1.y = silu_f(g1.y) * u1.y; h1.z = silu_f(g1.z) * u1.z; h1.w = silu_f(g1.w) * u1.w;
          *(u32x4*)(H + (size_t)(u.pm * 256 + rl) * 256 + pl * 128 + wc * 32 + 8 * fq) = pack8(h0, h1);
        }
      }
  }
};
__device__ __forceinline__ unsigned pk4_fp8(const f32x4& v) { unsigned w = __builtin_amdgcn_cvt_pk_fp8_f32(v.x, v.y, 0u, false); return __builtin_amdgcn_cvt_pk_fp8_f32(v.z, v.w, w, true); }
struct EpiMoeDownM {
  static constexpr bool PERM = true;
  unsigned char* Y; const float* GATEL;
  __device__ __forceinline__ void operator()(const f32x4 (&acc)[2][2][4][2], const pg8::Unit& u, int wr, int wc, int fr, int fq) const {
    const int pl = u.pn & 3;
    const float* gp = GATEL + (size_t)u.e * 32768; const int rk0 = u.mt * 256 + wr * 64 + fr;
    unsigned char* yp = Y + (size_t)(u.pm * 256 + wr * 64 + fr) * 1024 + pl * 256 + wc * 32 + 8 * fq;
#pragma unroll
    for (int ai = 0; ai < 2; ++ai)
#pragma unroll
      for (int m = 0; m < 4; ++m) {
        const int rk = rk0 + ai * 128 + m * 16; const float gt = gp[rk < 32767 ? rk : 32767] * 64.0f;
#pragma unroll
        for (int bj = 0; bj < 2; ++bj)
          *(u32x2*)(yp + (size_t)(ai * 128 + m * 16) * 1024 + bj * 128) = (u32x2){pk4_fp8(acc[ai][bj][m][0] * gt), pk4_fp8(acc[ai][bj][m][1] * gt)};
      }
  }
};

__device__ __forceinline__ void phase_inproj_mfma(const Ctx& c, lds_u8* lds) {
  unsigned char* ws = c.ws; const int tid = phase_tid();
  { pg8::Gemm g{(const bf16_t*)c.out, (const bf16_t*)(ws + WS_WIN), 1024}; pg8::StaticOrder S; S.init(T, NIN, gridDim.x, blockIdx.x); EpiInM E{ws};
    pg8::gemm_phase<EpiInM, pg8::StaticOrder, true, false>(lds, g, S, E, tid); }
  { pg8::Gemm g{(const bf16_t*)(ws + WS_MEMB), (const bf16_t*)(ws + WS_WMKV), 1024}; pg8::StaticOrder S; S.init(TM, 512, gridDim.x, (int)blockIdx.x - 128); EpiMemKVM E{ws};
    pg8::gemm_phase<EpiMemKVM, pg8::StaticOrder, true, false>(lds, g, S, E, tid); }
}
__device__ __forceinline__ void phase_outproj_mfma(const Ctx& c, lds_u8* lds) {
  unsigned char* ws = c.ws; const int tid = phase_tid();
  pg8::Gemm g{(const bf16_t*)(ws + WS_CAT), (const bf16_t*)(ws + WS_WO), 1024}; pg8::StaticOrder S; S.init(T, 1024, gridDim.x, blockIdx.x); EpiOutM E{(const bf16_t*)c.out, (bf16_t*)(ws + WS_X1B)};
  pg8::gemm_phase<EpiOutM, pg8::StaticOrder, true, false>(lds, g, S, E, tid);
}
__device__ __forceinline__ void phase_moe_up_mfma(const Ctx& c, lds_u8* lds) {
  unsigned char* ws = c.ws; const int tid = phase_tid();
  int* offs = (int*)((unsigned char*)lds + pg8::STAGE_BYTES); int* cnts = offs + 65;
  expert_offsets(c, offs, cnts, tid);
  pg8::Gemm g{(const bf16_t*)(ws + WS_X1B), (const bf16_t*)(ws + WS_WGU), 1024};
  MoeOrder S{offs, cnts, 2, (int)gridDim.x, (int)blockIdx.x, (const unsigned*)(ws + WS_LIST)}; EpiMoeUpM E{(bf16_t*)(ws + WS_H)};
  pg8::gemm_phase<EpiMoeUpM, MoeOrder, true, true>(lds, g, S, E, tid);
}
__device__ __forceinline__ void phase_moe_down_mfma(const Ctx& c, lds_u8* lds) {
  unsigned char* ws = c.ws; const int tid = phase_tid();
  int* offs = (int*)((unsigned char*)lds + pg8::STAGE_BYTES); int* cnts = offs + 65;
  expert_offsets(c, offs, cnts, tid);
  pg8::Gemm g{(const bf16_t*)(ws + WS_H), (const bf16_t*)(ws + WS_WD), 256};
  MoeOrder S{offs, cnts, 4, (int)gridDim.x, (int)blockIdx.x, nullptr}; EpiMoeDownM E{(unsigned char*)(ws + WS_Y), (const float*)(ws + WS_GATEL)};
  pg8::gemm_phase<EpiMoeDownM, MoeOrder, true, false>(lds, g, S, E, tid);
}

__device__ void phase_kvup(const Ctx& c, float* lds) {
  unsigned char* ws = c.ws;
  const int tid = phase_tid(), lane = tid & 63, wave = tid >> 6, fr = lane & 15, fq = lane >> 4;
  const bf16_t* W = (const bf16_t*)(ws + WS_WKV);
  const bf16_t* CKV = (const bf16_t*)(ws + WS_CKV); bf16_t* KVA = (bf16_t*)(ws + WS_KVA);
  const float* cs = (const float*)(ws + WS_ROPE); const float* sn = cs + SEQ * 32;
  for (int tile = blockIdx.x * NWAVES + wave; tile < T / 16; tile += gridDim.x * NWAVES) {
    const int t = tile * 16 + fr, pos = t & (SEQ - 1);
    pg8::bf16x8 bx[4]; float ss = 0.f;
#pragma unroll
    for (int ks = 0; ks < 4; ++ks) { const u32x4 v = *(const u32x4*)(CKV + (size_t)t * 128 + ks * 32 + fq * 8); bx[ks] = __builtin_bit_cast(pg8::bf16x8, v);
      const float f[8] = {__uint_as_float(v.x << 16), __uint_as_float(v.x & 0xffff0000u), __uint_as_float(v.y << 16), __uint_as_float(v.y & 0xffff0000u), __uint_as_float(v.z << 16), __uint_as_float(v.z & 0xffff0000u), __uint_as_float(v.w << 16), __uint_as_float(v.w & 0xffff0000u)};
#pragma unroll
      for (int e = 0; e < 8; ++e) ss += f[e] * f[e]; }
    ss += __shfl_xor(ss, 16); ss += __shfl_xor(ss, 32);
    const float rstd = rsqrtf(ss * (1.f / 128.f) + 1e-6f);
#pragma unroll
    for (int nt = 0; nt < 8; ++nt) { f32x4 d = {0.f, 0.f, 0.f, 0.f};
#pragma unroll
      for (int ks = 0; ks < 4; ++ks) d = __builtin_amdgcn_mfma_f32_16x16x32_bf16(*(const pg8::bf16x8*)(W + (size_t)(nt * 16 + fr) * 128 + ks * 32 + fq * 8), bx[ks], d, 0, 0, 0);
      d = d * rstd;
      const int p0 = nt * 16 + fq * 4;
      if (nt < 4) { const int dd = p0 >> 1; const float c0 = cs[pos * 32 + dd], s0 = sn[pos * 32 + dd], c1 = cs[pos * 32 + dd + 1], s1 = sn[pos * 32 + dd + 1];
        const f32x4 o = {d.x * c0 - d.y * s0, d.y * c0 + d.x * s0, d.z * c1 - d.w * s1, d.w * c1 + d.z * s1}; d = o; }
      { int w8 = __builtin_amdgcn_cvt_pk_fp8_f32(d.x, d.y, 0, false); w8 = __builtin_amdgcn_cvt_pk_fp8_f32(d.z, d.w, w8, true);
        *(unsigned*)((unsigned char*)KVA + (size_t)t * 128 + p0) = (unsigned)w8; } }
  }
}


typedef _Float16 h16x2 __attribute__((ext_vector_type(2)));
constexpr int TK_KP = 4104;
constexpr int TK_KEYS = 0, TK_H1 = 16 * TK_KP * 2, TK_H2 = TK_H1 + 16 * 128 * 4, TK_MISC = TK_H2 + 8 * 128 * 4;
__device__ __forceinline__ unsigned mono16x2(unsigned u) { const unsigned m = ((u >> 15) & 0x00010001u) * 0xffffu; return u ^ (m | 0x80008000u); }
__device__ __forceinline__ int wave_incl_scan(int x) {
  x += __builtin_amdgcn_update_dpp(0, x, 0x111, 0xF, 0xF, true);
  x += __builtin_amdgcn_update_dpp(0, x, 0x112, 0xF, 0xF, true);
  x += __builtin_amdgcn_update_dpp(0, x, 0x114, 0xF, 0xF, true);
  x += __builtin_amdgcn_update_dpp(0, x, 0x118, 0xF, 0xF, true);
  x += __builtin_amdgcn_update_dpp(0, x, 0x142, 0xA, 0xF, false);
  x += __builtin_amdgcn_update_dpp(0, x, 0x143, 0xC, 0xF, false);
  return x;
}

__device__ __forceinline__ void hist_find(const unsigned* hw, int need, int lane, int& B, int& above) {
  const unsigned w0 = hw[127 - 2 * lane], w1 = hw[126 - 2 * lane];
  const int c0 = (int)(w0 >> 16), c1 = (int)(w0 & 0xffffu), c2 = (int)(w1 >> 16), c3 = (int)(w1 & 0xffffu);
  const int tl = c0 + c1 + c2 + c3;
  const int incl = wave_incl_scan(tl);
  const int excl = incl - tl;
  const bool hit = (excl < need) && (incl >= need);
  int b = 0, ab = 0;
  if (hit) { int a = excl; b = 255 - 4 * lane; ab = a;
    if (a + c0 < need) { a += c0; b = 254 - 4 * lane; ab = a; if (a + c1 < need) { a += c1; b = 253 - 4 * lane; ab = a; if (a + c2 < need) { a += c2; b = 252 - 4 * lane; ab = a; } } } }
  const unsigned long long m = __ballot(hit);
  const int src = __builtin_amdgcn_readfirstlane(m ? (__ffsll((long long)m) - 1) : 0);
  B = __builtin_amdgcn_readlane(b, src); above = __builtin_amdgcn_readlane(ab, src);
}
__device__ void phase_topk_mfma(const Ctx& c, unsigned char* ldsb, unsigned* qhead) {
  unsigned char* ws = c.ws;
  const int tid = phase_tid(), lane = tid & 63, wave = tid >> 6, fr = lane & 15, fq = lane >> 4;
  unsigned short* keys = (unsigned short*)(ldsb + TK_KEYS);
  unsigned* h1 = (unsigned*)(ldsb + TK_H1); unsigned* h2 = (unsigned*)(ldsb + TK_H2) + wave * 128; int* misc = (int*)(ldsb + TK_MISC);
  const bf16_t* IQ = (const bf16_t*)(ws + WS_IQ); const bf16_t* IK = (const bf16_t*)(ws + WS_IK); const float* SM = (const float*)(ws + WS_SM);
  unsigned short* SEL = (unsigned short*)(ws + WS_SEL);
  WorkQ wq; wq_init(wq, qhead, misc, tid);
  for (;;) {
    const int item = wq_next(wq, tid);
    if (item >= 240 * 8) break;
    const int b = item & 7, qb = 255 - (item >> 3), s0 = qb * 16;
    for (int i = tid; i < 16 * 128; i += NTHREADS) h1[i] = 0u;
    const size_t qrow = (size_t)b * SEQ + s0 + fr;
    pg8::bf16x8 bq[4][2];
#pragma unroll
    for (int hh = 0; hh < 4; ++hh)
#pragma unroll
      for (int ks = 0; ks < 2; ++ks) bq[hh][ks] = *(const pg8::bf16x8*)(IQ + qrow * 256 + hh * 64 + ks * 32 + fq * 8);
    const f32x4 iw = *(const f32x4*)(SM + qrow * 16);
    const int nkt = qb + 1, slim = s0 + fr;
    __syncthreads();
    pg8::bf16x8 a0n = {0, 0, 0, 0, 0, 0, 0, 0}, a1n = a0n;
    if (wave < nkt) { const bf16_t* kr = IK + ((size_t)b * SEQ + wave * 16 + fr) * 64 + fq * 8; a0n = *(const pg8::bf16x8*)kr; a1n = *(const pg8::bf16x8*)(kr + 32); }
    for (int kt = wave; kt < nkt; kt += NWAVES) {
      const pg8::bf16x8 a0 = a0n, a1 = a1n;
      if (kt + NWAVES < nkt) { const bf16_t* kr = IK + ((size_t)b * SEQ + (kt + NWAVES) * 16 + fr) * 64 + fq * 8; a0n = *(const pg8::bf16x8*)kr; a1n = *(const pg8::bf16x8*)(kr + 32); }
      f32x4 sc = {0.f, 0.f, 0.f, 0.f};
#pragma unroll
      for (int hh = 0; hh < 4; ++hh) { f32x4 d = {0.f, 0.f, 0.f, 0.f};
        d = __builtin_amdgcn_mfma_f32_16x16x32_bf16(a0, bq[hh][0], d, 0, 0, 0); d = __builtin_amdgcn_mfma_f32_16x16x32_bf16(a1, bq[hh][1], d, 0, 0, 0);
        const float w = hh == 0 ? iw.x : hh == 1 ? iw.y : hh == 2 ? iw.z : iw.w;
        sc.x = fmaf(w, fmaxf(d.x, 0.f), sc.x); sc.y = fmaf(w, fmaxf(d.y, 0.f), sc.y); sc.z = fmaf(w, fmaxf(d.z, 0.f), sc.z); sc.w = fmaf(w, fmaxf(d.w, 0.f), sc.w); }
      unsigned k01 = mono16x2(__builtin_bit_cast(unsigned, __builtin_amdgcn_cvt_pkrtz(sc.x, sc.y))), k23 = mono16x2(__builtin_bit_cast(unsigned, __builtin_amdgcn_cvt_pkrtz(sc.z, sc.w)));
      const int kbase = kt * 16 + fq * 4;
      unsigned* hq = h1 + fr * 128;
      if (kt + 1 < nkt) {
        *(u32x2*)(keys + fr * TK_KP + kbase) = (u32x2){k01, k23};
        { const unsigned kk = k01 & 0xffffu; atomicAdd(hq + (kk >> 9), 1u << ((kk >> 4) & 16)); }
        { const unsigned kk = k01 >> 16; atomicAdd(hq + (kk >> 9), 1u << ((kk >> 4) & 16)); }
        { const unsigned kk = k23 & 0xffffu; atomicAdd(hq + (kk >> 9), 1u << ((kk >> 4) & 16)); }
        { const unsigned kk = k23 >> 16; atomicAdd(hq + (kk >> 9), 1u << ((kk >> 4) & 16)); }
      } else {
        if (kbase + 0 > slim) k01 &= 0xffff0000u; if (kbase + 1 > slim) k01 &= 0x0000ffffu;
        if (kbase + 2 > slim) k23 &= 0xffff0000u; if (kbase + 3 > slim) k23 &= 0x0000ffffu;
        *(u32x2*)(keys + fr * TK_KP + kbase) = (u32x2){k01, k23};
        if (kbase + 0 <= slim) { const unsigned kk = k01 & 0xffffu; atomicAdd(hq + (kk >> 9), 1u << ((kk >> 4) & 16)); }
        if (kbase + 1 <= slim) { const unsigned kk = k01 >> 16; atomicAdd(hq + (kk >> 9), 1u << ((kk >> 4) & 16)); }
        if (kbase + 2 <= slim) { const unsigned kk = k23 & 0xffffu; atomicAdd(hq + (kk >> 9), 1u << ((kk >> 4) & 16)); }
        if (kbase + 3 <= slim) { const unsigned kk = k23 >> 16; atomicAdd(hq + (kk >> 9), 1u << ((kk >> 4) & 16)); }
      }
    }
    __syncthreads();
    for (int qi = 0; qi < 2; ++qi) {
      const int q = wave * 2 + qi, s = s0 + q, n = s + 1;
      int B1, above1; hist_find(h1 + q * 128, 256, lane, B1, above1);
      const int need1 = 256 - above1;
      h2[lane] = 0u; h2[64 + lane] = 0u;
      const unsigned short* kq = keys + q * TK_KP;
      const int niter = (n + 511) >> 9;
      for (int it = 0; it < niter; ++it) {
        const int i0 = (it * 64 + lane) * 8; const u32x4 kv = *(const u32x4*)(kq + i0);
        const unsigned k8[8] = {kv.x & 0xffffu, kv.x >> 16, kv.y & 0xffffu, kv.y >> 16, kv.z & 0xffffu, kv.z >> 16, kv.w & 0xffffu, kv.w >> 16};
#pragma unroll
        for (int e = 0; e < 8; ++e) if (i0 + e < n && (int)(k8[e] >> 8) == B1) atomicAdd(h2 + ((k8[e] & 255u) >> 1), 1u << ((k8[e] & 1u) * 16));
      }
      int B2, above2; hist_find(h2, need1, lane, B2, above2);
      const unsigned thr = (unsigned)((B1 << 8) | B2); const int need = need1 - above2;
      unsigned short* dummy = (unsigned short*)(misc + 8 + wave);
      unsigned short* sel = (unsigned short*)h2;
      asm volatile("s_waitcnt lgkmcnt(0)" ::: "memory");
      int tiebase = 0, outbase = 0;
      for (int it = 0; it < niter; ++it) {
        const int i0 = (it * 64 + lane) * 8; const u32x4 kv = *(const u32x4*)(kq + i0);
        const unsigned k8[8] = {kv.x & 0xffffu, kv.x >> 16, kv.y & 0xffffu, kv.y >> 16, kv.z & 0xffffu, kv.z >> 16, kv.w & 0xffffu, kv.w >> 16};
        int cg = 0, ce = 0;
#pragma unroll
        for (int e = 0; e < 8; ++e) { const bool v = i0 + e < n; cg += (v && k8[e] > thr) ? 1 : 0; ce += (v && k8[e] == thr) ? 1 : 0; }
        int tk = 0;
        if (__ballot(ce != 0)) {
          const int eincl = wave_incl_scan(ce); const int eg = tiebase + eincl - ce;
          tk = need - eg; tk = tk < 0 ? 0 : (tk > ce ? ce : tk);
          tiebase += __builtin_amdgcn_readlane(eincl, 63);
        }
        const int oc = cg + tk; const int oincl = wave_incl_scan(oc);
        int pos = outbase + oincl - oc; int tleft = tk;
#pragma unroll
        for (int e = 0; e < 8; ++e) { const bool v = i0 + e < n; const bool tie = v && k8[e] == thr && tleft > 0; const bool take = (v && k8[e] > thr) || tie;
          tleft -= tie ? 1 : 0;
          unsigned short* dst = (take && pos < 256) ? sel + pos : dummy;
          *dst = (unsigned short)(i0 + e); pos += take ? 1 : 0; }
        outbase += __builtin_amdgcn_readlane(oincl, 63);
      }
      asm volatile("s_waitcnt lgkmcnt(0)" ::: "memory");
      *(u32x2*)(SEL + ((size_t)b * SEQ + s) * 256 + lane * 4) = *(const u32x2*)(sel + lane * 4);
      asm volatile("s_waitcnt lgkmcnt(0)" ::: "memory");
    }
  }
}

typedef short s16x4 __attribute__((ext_vector_type(4)));
__device__ __forceinline__ s16x4 lds_tr16(const unsigned char* p) { return __builtin_bit_cast(s16x4, __builtin_amdgcn_ds_read_tr16_b64_v4i16((__attribute__((address_space(3))) s16x4*)(__attribute__((address_space(3))) unsigned char*)p)); }
typedef float f32x2_t __attribute__((ext_vector_type(2))); typedef __bf16 bf16x2_t __attribute__((ext_vector_type(2)));
__device__ __forceinline__ unsigned cvtpk_c(float lo, float hi) { const f32x2_t v = {lo, hi}; const bf16x2_t b = __builtin_convertvector(v, bf16x2_t); return __builtin_bit_cast(unsigned, b); }
__device__ __forceinline__ pg8::bf16x8 packp(const f32x4& a, const f32x4& b) {
  const u32x4 w = {cvtpk_c(a.x, a.y), cvtpk_c(a.z, a.w), cvtpk_c(b.x, b.y), cvtpk_c(b.z, b.w)}; return __builtin_bit_cast(pg8::bf16x8, w); }
constexpr int AT_WB = 9216 + 512;
typedef int v2i_t __attribute__((ext_vector_type(2)));
__device__ __forceinline__ long lds_tr8(const unsigned char* p) { const v2i_t r = __builtin_amdgcn_ds_read_tr8_b64_v2i32((__attribute__((address_space(3))) v2i_t*)(__attribute__((address_space(3))) unsigned char*)p); return (long)(((unsigned long)(unsigned)r.y << 32) | (unsigned long)(unsigned)r.x); }
__device__ __forceinline__ unsigned cvt4_fp8(float a, float b, float c2, float d) { int w = __builtin_amdgcn_cvt_pk_fp8_f32(a, b, 0, false); w = __builtin_amdgcn_cvt_pk_fp8_f32(c2, d, w, true); return (unsigned)w; }
__device__ __forceinline__ long mk64(unsigned lo, unsigned hi) { return (long)(((unsigned long)hi << 32) | (unsigned long)lo); }
__device__ void phase_attn_sparse(const Ctx& c, unsigned char* ldsb, unsigned* qhead) {
  unsigned char* ws = c.ws;
  const int tid = phase_tid(), lane = tid & 63, wave = tid >> 6, fr = lane & 15, fq = lane >> 4;
  unsigned char* vl = ldsb + wave * AT_WB; unsigned short* sl = (unsigned short*)(vl + 9216);
  const bf16_t* QA = (const bf16_t*)(ws + WS_QA); const unsigned char* KVA = (const unsigned char*)(ws + WS_KVA); const unsigned short* SEL = (const unsigned short*)(ws + WS_SEL);
  bf16_t* CAT = (bf16_t*)(ws + WS_CAT);
  const float* gA = c.in[10];
  __syncthreads();
  int* aq_slot = (int*)(ldsb + 8 * AT_WB);
  WorkQ wq; wq_init(wq, qhead, aq_slot, tid);
  const int st_off = (lane >> 3) * 144 + (lane & 7) * 16;
  const int kr_off = fr * 144 + fq * 16;
  const int tr_off = (fq * 4 + ((fr >> 1) & 3) + (fr >> 3) * 16) * 144 + 64 + (fr & 1) * 8;
  for (;;) {
  const int item = wq_next(wq, tid);
  if (item >= 512) break;
  for (int tj = 0; tj < 8; ++tj) {
    const int t = item * 64 + wave * 8 + tj;
    const int b = t >> 12, s = t & (SEQ - 1), n = s + 1 < 256 ? s + 1 : 256;
    { u32x2 v;
      if (s >= 256) v = *(const u32x2*)(SEL + (size_t)t * 256 + lane * 4);
      else { const int i0 = lane * 4; const unsigned e0 = i0 < n ? i0 : 0, e1 = i0 + 1 < n ? i0 + 1 : 0, e2 = i0 + 2 < n ? i0 + 2 : 0, e3 = i0 + 3 < n ? i0 + 3 : 0; v = (u32x2){e0 | (e1 << 16), e2 | (e3 << 16)}; }
      *(u32x2*)(sl + lane * 4) = v; }
    asm volatile("s_waitcnt lgkmcnt(0)" ::: "memory");
    const unsigned char* kvb = KVA + (size_t)b * SEQ * 128;
    u32x4 ra[8], rb[8];
#define KLOAD(R, CH) do { _Pragma("unroll") for (int i_ = 0; i_ < 8; ++i_) { const int key_ = sl[(CH) * 64 + i_ * 8 + (lane >> 3)]; R[i_] = *(const u32x4*)(kvb + (size_t)key_ * 128 + (lane & 7) * 16); } } while (0)
#define KSTORE(R) do { _Pragma("unroll") for (int i_ = 0; i_ < 8; ++i_) *(u32x4*)(vl + i_ * 8 * 144 + st_off) = R[i_]; } while (0)
    KLOAD(ra, 0); KLOAD(rb, 1);
    long q0 = 0, q1 = 0;
    if (fr < 6) { const bf16_t* qp = QA + (size_t)t * 384 + fr * 64 + fq * 16; const u32x4 a = *(const u32x4*)qp, bb = *(const u32x4*)(qp + 8);
      q0 = mk64(cvt4_fp8(__uint_as_float(a.x << 16), __uint_as_float(a.x & 0xffff0000u), __uint_as_float(a.y << 16), __uint_as_float(a.y & 0xffff0000u)),
                cvt4_fp8(__uint_as_float(a.z << 16), __uint_as_float(a.z & 0xffff0000u), __uint_as_float(a.w << 16), __uint_as_float(a.w & 0xffff0000u)));
      q1 = mk64(cvt4_fp8(__uint_as_float(bb.x << 16), __uint_as_float(bb.x & 0xffff0000u), __uint_as_float(bb.y << 16), __uint_as_float(bb.y & 0xffff0000u)),
                cvt4_fp8(__uint_as_float(bb.z << 16), __uint_as_float(bb.z & 0xffff0000u), __uint_as_float(bb.w << 16), __uint_as_float(bb.w & 0xffff0000u))); }
    float m = -3.0e38f, l = 0.f;
    f32x4 ot[4];
#pragma unroll
    for (int mt = 0; mt < 4; ++mt) ot[mt] = (f32x4){0.f, 0.f, 0.f, 0.f};
#define KCHUNK(R, CH) do { \
      KSTORE(R); if ((CH) + 2 < 4) KLOAD(R, (CH) + 2); \
      asm volatile("s_waitcnt lgkmcnt(0)" ::: "memory"); \
      f32x4 st[4]; \
      _Pragma("unroll") for (int kt = 0; kt < 4; ++kt) { const u32x4 a_ = *(const u32x4*)(vl + kt * 16 * 144 + kr_off); f32x4 d_ = {0.f, 0.f, 0.f, 0.f}; \
        d_ = __builtin_amdgcn_mfma_f32_16x16x32_fp8_fp8(mk64(a_.x, a_.y), q0, d_, 0, 0, 0); st[kt] = __builtin_amdgcn_mfma_f32_16x16x32_fp8_fp8(mk64(a_.z, a_.w), q1, d_, 0, 0, 0); } \
      if (n < 256) { _Pragma("unroll") for (int kt = 0; kt < 4; ++kt) { const int sb = (CH) * 64 + kt * 16 + fq * 4; \
        if (sb + 0 >= n) st[kt].x = -3.0e38f; if (sb + 1 >= n) st[kt].y = -3.0e38f; if (sb + 2 >= n) st[kt].z = -3.0e38f; if (sb + 3 >= n) st[kt].w = -3.0e38f; } } \
      float cm = -3.0e38f; \
      _Pragma("unroll") for (int kt = 0; kt < 4; ++kt) cm = fmaxf(fmaxf(fmaxf(cm, st[kt].x), fmaxf(st[kt].y, st[kt].z)), st[kt].w); \
      cm = fmaxf(cm, __shfl_xor(cm, 16)); cm = fmaxf(cm, __shfl_xor(cm, 32)); \
      const float mn = fmaxf(m, cm), al = __builtin_amdgcn_exp2f(m - mn), mb = mn - 8.f; m = mn; \
      float ls = 0.f; \
      _Pragma("unroll") for (int kt = 0; kt < 4; ++kt) { st[kt].x = __builtin_amdgcn_exp2f(st[kt].x - mb); st[kt].y = __builtin_amdgcn_exp2f(st[kt].y - mb); st[kt].z = __builtin_amdgcn_exp2f(st[kt].z - mb); st[kt].w = __builtin_amdgcn_exp2f(st[kt].w - mb); \
        ls += (st[kt].x + st[kt].y) + (st[kt].z + st[kt].w); } \
      l = l * al + ls; \
      _Pragma("unroll") for (int mt = 0; mt < 4; ++mt) ot[mt] = ot[mt] * al; \
      _Pragma("unroll") for (int k2 = 0; k2 < 2; ++k2) { \
        const long pf = mk64(cvt4_fp8(st[2 * k2].x, st[2 * k2].y, st[2 * k2].z, st[2 * k2].w), cvt4_fp8(st[2 * k2 + 1].x, st[2 * k2 + 1].y, st[2 * k2 + 1].z, st[2 * k2 + 1].w)); \
        _Pragma("unroll") for (int mt = 0; mt < 4; ++mt) { const long af = lds_tr8(vl + k2 * 32 * 144 + tr_off + mt * 16); \
          ot[mt] = __builtin_amdgcn_mfma_f32_16x16x32_fp8_fp8(af, pf, ot[mt], 0, 0, 0); } } \
      asm volatile("s_waitcnt lgkmcnt(0)" ::: "memory"); } while (0)
    KCHUNK(ra, 0); KCHUNK(rb, 1); KCHUNK(ra, 2); KCHUNK(rb, 3);
#undef KLOAD
#undef KSTORE
#undef KCHUNK
    l += __shfl_xor(l, 16); l += __shfl_xor(l, 32);
    const float il = __builtin_amdgcn_rcpf(l); float ss = 0.f;
#pragma unroll
    for (int mt = 0; mt < 4; ++mt) { ot[mt] = ot[mt] * il; ss += (ot[mt].x * ot[mt].x + ot[mt].y * ot[mt].y) + (ot[mt].z * ot[mt].z + ot[mt].w * ot[mt].w); }
    if (fr >= 6) ss = 0.f;
#pragma unroll
    for (int o = 1; o < 64; o <<= 1) ss += __shfl_xor(ss, o);
    const float rstd = rsqrtf(ss * (1.f / 384.f) + 1e-6f);
    if (fr < 6) {
#pragma unroll
      for (int mt = 0; mt < 4; ++mt) { const int col = fr * 64 + mt * 16 + fq * 4; const f32x4 g = *(const f32x4*)(gA + col); const f32x4 o = ot[mt] * rstd * g;
        *(u32x2*)(CAT + (size_t)t * 1024 + col) = (u32x2){pg8::cvt_pk_bf16(o.x, o.y), pg8::cvt_pk_bf16(o.z, o.w)}; } }
  }
  }
}

__device__ void phase_attn_mem(const Ctx& c, unsigned char* ldsb, unsigned* qhead) {
  unsigned char* ws = c.ws;
  const int tid = phase_tid(), lane = tid & 63, wave = tid >> 6, fr = lane & 15, fq = lane >> 4;
  unsigned char* vl = ldsb + wave * AT_WB; unsigned short* sl = (unsigned short*)(vl + 9216);
  const bf16_t* QA = (const bf16_t*)(ws + WS_QA); const bf16_t* KVA = (const bf16_t*)(ws + WS_KVA); const unsigned short* SEL = (const unsigned short*)(ws + WS_SEL);
  const bf16_t* QC = (const bf16_t*)(ws + WS_QC); const bf16_t* MK = (const bf16_t*)(ws + WS_MK); const bf16_t* MVT = (const bf16_t*)(ws + WS_MVT);
  bf16_t* CAT = (bf16_t*)(ws + WS_CAT);
  const float* gA = c.in[10]; const float* gC = c.in[11];
  const pg8::bf16x8 zero8 = {0, 0, 0, 0, 0, 0, 0, 0};
  int* aq_slot = (int*)(ldsb + 70656 + 8 * 8192);
  WorkQ wq; wq_init(wq, qhead, aq_slot, tid);
  for (;;) {
  const int item = wq_next(wq, tid) + 512;
  if (item >= 768) break;
  {
    const int t0 = (item - 512) * 128 + wave * 16, b = t0 >> 12;
    unsigned char* mkl = ldsb; unsigned char* mvl = ldsb + 36864; unsigned char* ocl = ldsb + 70656 + wave * 8192;
    float ss = 0.f;
#pragma unroll 1
    for (int h = 0; h < 4; ++h) {
      __syncthreads();
#pragma unroll
      for (int i = 0; i < 4; ++i) { const int p = tid + 512 * i, row = p >> 3, cc = p & 7;
        *(u32x4*)(mkl + row * 144 + cc * 16) = *(const u32x4*)(MK + ((size_t)(b * 256 + row)) * 256 + h * 64 + cc * 8); }
#pragma unroll
      for (int i = 0; i < 4; ++i) { const int p = tid + 512 * i, row = p >> 5, cc = p & 31;
        *(u32x4*)(mvl + row * 528 + cc * 16) = *(const u32x4*)(MVT + ((size_t)(b * 256 + h * 64 + row)) * 256 + cc * 8); }
      __syncthreads();
      f32x4 oc[4];
      const bf16_t* qp = QC + (size_t)(t0 + fr) * 256 + h * 64 + fq * 8;
      const pg8::bf16x8 bq0 = *(const pg8::bf16x8*)qp, bq1 = *(const pg8::bf16x8*)(qp + 32);
      f32x4 st[16];
#pragma unroll
      for (int kt = 0; kt < 16; ++kt) { const unsigned char* kr = mkl + (kt * 16 + fr) * 144 + fq * 16;
        const pg8::bf16x8 a0 = *(const pg8::bf16x8*)kr, a1 = *(const pg8::bf16x8*)(kr + 64);
        f32x4 d = {0.f, 0.f, 0.f, 0.f};
        d = __builtin_amdgcn_mfma_f32_16x16x32_bf16(a0, bq0, d, 0, 0, 0); st[kt] = __builtin_amdgcn_mfma_f32_16x16x32_bf16(a1, bq1, d, 0, 0, 0); }
      float mx = -3.0e38f;
#pragma unroll
      for (int kt = 0; kt < 16; ++kt) mx = fmaxf(fmaxf(fmaxf(mx, st[kt].x), fmaxf(st[kt].y, st[kt].z)), st[kt].w);
      mx = fmaxf(mx, __shfl_xor(mx, 16)); mx = fmaxf(mx, __shfl_xor(mx, 32));
      float l = 0.f;
#pragma unroll
      for (int kt = 0; kt < 16; ++kt) { st[kt].x = __builtin_amdgcn_exp2f(st[kt].x - mx); st[kt].y = __builtin_amdgcn_exp2f(st[kt].y - mx); st[kt].z = __builtin_amdgcn_exp2f(st[kt].z - mx); st[kt].w = __builtin_amdgcn_exp2f(st[kt].w - mx);
        l += (st[kt].x + st[kt].y) + (st[kt].z + st[kt].w); }
      l += __shfl_xor(l, 16); l += __shfl_xor(l, 32);
#pragma unroll
      for (int mt = 0; mt < 4; ++mt) oc[mt] = (f32x4){0.f, 0.f, 0.f, 0.f};
#pragma unroll
      for (int kk = 0; kk < 8; ++kk) { const pg8::bf16x8 pf = packp(st[2 * kk], st[2 * kk + 1]);
#pragma unroll
        for (int mt = 0; mt < 4; ++mt) { const pg8::bf16x8 af = *(const pg8::bf16x8*)(mvl + (mt * 16 + fr) * 528 + (kk * 4 + fq) * 16);
          oc[mt] = __builtin_amdgcn_mfma_f32_16x16x32_bf16(af, pf, oc[mt], 0, 0, 0); } }
      const float il = __builtin_amdgcn_rcpf(l);
#pragma unroll
      for (int mt = 0; mt < 4; ++mt) { const f32x4 o = oc[mt] * il; ss += (o.x * o.x + o.y * o.y) + (o.z * o.z + o.w * o.w); *(u32x2*)(ocl + ((h * 4 + mt) * 64 + lane) * 8) = (u32x2){pg8::cvt_pk_bf16(o.x, o.y), pg8::cvt_pk_bf16(o.z, o.w)}; }
    }
    ss += __shfl_xor(ss, 16); ss += __shfl_xor(ss, 32);
    const float rstd = rsqrtf(ss * (1.f / 256.f) + 1e-6f);
#pragma unroll 1
    for (int h = 0; h < 4; ++h)
#pragma unroll
      for (int mt = 0; mt < 4; ++mt) { const int col = h * 64 + mt * 16 + fq * 4; const f32x4 g = *(const f32x4*)(gC + col); const u32x2 pp = *(const u32x2*)(ocl + ((h * 4 + mt) * 64 + lane) * 8);
        const f32x4 ov = {__uint_as_float(pp.x << 16), __uint_as_float(pp.x & 0xffff0000u), __uint_as_float(pp.y << 16), __uint_as_float(pp.y & 0xffff0000u)}; const f32x4 o = ov * rstd * g;
        *(u32x2*)(CAT + (size_t)(t0 + fr) * 1024 + 768 + col) = (u32x2){pg8::cvt_pk_bf16(o.x, o.y), pg8::cvt_pk_bf16(o.z, o.w)}; }
  }
  }
}

constexpr int GD_ITEM = 41088;
__device__ __forceinline__ unsigned char* gd_item(unsigned char* ws, int it) { return it < 1536 ? ws + WS_XB + (size_t)it * GD_ITEM : ws + WS_X1B + (size_t)(it - 1536) * GD_ITEM; }
__device__ __forceinline__ int kperm(int x) { return (x & 32) | (((x >> 2) & 3) << 3) | (x & 3) | (((x >> 4) & 1) << 2); }
constexpr int GP_KB = 0, GP_KBB = 9216, GP_QB = 18432, GP_VBT = 27648, GP_KBET = 36864, GP_XR = 46080  , GP_PR = 82944  , GP_OUT = 101376, GP_SC = 142336;
__device__ __forceinline__ pg8::bf16x8 ldsfrag(const unsigned char* base, int row, int ks, int fq) { return *(const pg8::bf16x8*)(base + row * 144 + ks * 64 + fq * 16); }
constexpr int G2_KB = 0, G2_KBB = 9216, G2_QB = 18432, G2_XR0 = 27648, G2_XT0 = 36864, G2_PR0 = 46080, G2_VBT = 55296, G2_KBET = 64512, G2_SC = 73728, G2_CW = 75264, G2_HALF = 78336;
__device__ void phase_gdn_prep2(const Ctx& c, unsigned char* Lb) {
  unsigned char* ws = c.ws;
  const int tid = phase_tid(), lane = tid & 63, wave = tid >> 6, fr = lane & 15, fq = lane >> 4;
  const int hb = wave >> 2, w4 = wave & 3, htid = tid & 255;
  unsigned char* L = Lb + hb * G2_HALF;
  const bf16_t* GB = (const bf16_t*)(ws + WS_GB); const float* SM = (const float*)(ws + WS_SM);
  const float* convw = c.in[6];
  float* sc = (float*)(L + G2_SC);
  float* cw = (float*)(L + G2_CW);
  const int tt = htid >> 2, part = htid & 3;
  for (int it2 = blockIdx.x; it2 < 1536; it2 += gridDim.x) {
    const int it = it2 * 2 + hb;
    const int n = it & 63, bh = it >> 6, b = bh / 6, h = bh % 6;
    const int t = n * 64 + tt; const size_t r = (size_t)b * SEQ + t;
    unsigned char* gb = gd_item(ws, it);
    __syncthreads();
    for (int i = htid; i < 768; i += 256) { const int j = i / 192, rr = i % 192; cw[i] = convw[j * 1152 + (rr >> 6) * 384 + h * 64 + (rr & 63)]; }
    if (part == 0) { const float a = SM[r * 16 + 4 + h], bb = SM[r * 16 + 10 + h]; const float xs = a + c.in[8][h]; const float sp = xs > 20.f ? xs : log1pf(__expf(xs));
      sc[tt] = -__expf(c.in[7][h]) * sp; sc[192 + tt] = 1.f / (1.f + __expf(-bb)); }
    __syncthreads();
    if (w4 == 0) { float v = sc[lane];
#pragma unroll
      for (int o = 1; o < 64; o <<= 1) { const float u = __shfl_up(v, o); if (lane >= o) v += u; }
      const float last = __shfl(v, 63);
      sc[64 + lane] = v; sc[128 + lane] = __expf(v); sc[256 + lane] = __expf(last - v); if (lane == 0) { sc[320] = __expf(last); *(float*)(gb + 40960) = __expf(last); } }
    float qv[16], kv[16], vv[16];
#pragma unroll
    for (int role = 0; role < 3; ++role) {
      float acc[16];
#pragma unroll
      for (int e = 0; e < 16; ++e) acc[e] = 0.f;
      u32x4 xr[4][2];
#pragma unroll
      for (int j = 0; j < 4; ++j) { const bool ok = t - 3 + j >= 0; const bf16_t* xp = GB + (r - 3 + j) * 1536 + role * 384 + h * 64 + part * 16;
        xr[j][0] = ok ? *(const u32x4*)xp : (u32x4){0u, 0u, 0u, 0u}; xr[j][1] = ok ? *(const u32x4*)(xp + 8) : (u32x4){0u, 0u, 0u, 0u}; }
#pragma unroll
      for (int j = 0; j < 4; ++j)
#pragma unroll
        for (int hh = 0; hh < 2; ++hh) { const u32x4 xvv = xr[j][hh]; const float* wj = cw + j * 192 + role * 64 + part * 16 + hh * 8;
          const f32x4 w0 = *(const f32x4*)wj, w1 = *(const f32x4*)(wj + 4);
          acc[hh * 8 + 0] += w0.x * __uint_as_float(xvv.x << 16); acc[hh * 8 + 1] += w0.y * __uint_as_float(xvv.x & 0xffff0000u); acc[hh * 8 + 2] += w0.z * __uint_as_float(xvv.y << 16); acc[hh * 8 + 3] += w0.w * __uint_as_float(xvv.y & 0xffff0000u);
          acc[hh * 8 + 4] += w1.x * __uint_as_float(xvv.z << 16); acc[hh * 8 + 5] += w1.y * __uint_as_float(xvv.z & 0xffff0000u); acc[hh * 8 + 6] += w1.z * __uint_as_float(xvv.w << 16); acc[hh * 8 + 7] += w1.w * __uint_as_float(xvv.w & 0xffff0000u); }
      float ss = 0.f;
#pragma unroll
      for (int e = 0; e < 16; ++e) { acc[e] = silu_f(acc[e]); ss += acc[e] * acc[e]; }
      if (role < 2) { ss += __shfl_xor(ss, 1); ss += __shfl_xor(ss, 2); const float scl = rsqrtf(ss + 1e-6f) * (role == 0 ? 0.125f : 1.f);
#pragma unroll
        for (int e = 0; e < 16; ++e) acc[e] *= scl; }
#pragma unroll
      for (int e = 0; e < 16; ++e) { if (role == 0) qv[e] = acc[e]; else if (role == 1) kv[e] = acc[e]; else vv[e] = acc[e]; }
    }
    __syncthreads();
    { const float beta = sc[192 + tt], eg = sc[128 + tt], ekl = sc[256 + tt];
      float kb[16];
#pragma unroll
      for (int e = 0; e < 16; ++e) kb[e] = kv[e] * beta;
#pragma unroll
      for (int hh = 0; hh < 2; ++hh) { const int o8 = hh * 8;
        *(u32x4*)(L + G2_KB + tt * 144 + part * 32 + hh * 16) = (u32x4){pk2(kv[o8], kv[o8 + 1]), pk2(kv[o8 + 2], kv[o8 + 3]), pk2(kv[o8 + 4], kv[o8 + 5]), pk2(kv[o8 + 6], kv[o8 + 7])};
        *(u32x4*)(L + G2_KBB + tt * 144 + part * 32 + hh * 16) = (u32x4){pk2(kb[o8], kb[o8 + 1]), pk2(kb[o8 + 2], kb[o8 + 3]), pk2(kb[o8 + 4], kb[o8 + 5]), pk2(kb[o8 + 6], kb[o8 + 7])};
        *(u32x4*)(L + G2_QB + tt * 144 + part * 32 + hh * 16) = (u32x4){pk2(qv[o8], qv[o8 + 1]), pk2(qv[o8 + 2], qv[o8 + 3]), pk2(qv[o8 + 4], qv[o8 + 5]), pk2(qv[o8 + 6], qv[o8 + 7])}; }
      const int ptt = kperm(tt);
#pragma unroll
      for (int e = 0; e < 16; ++e) { const int d = part * 16 + e;
        *(bf16_t*)(L + G2_VBT + d * 144 + tt * 2) = f2bf(vv[e] * beta);
        *(bf16_t*)(L + G2_KBET + d * 144 + tt * 2) = f2bf(kb[e] * eg);
        *(bf16_t*)(gb + 8192 + tt * 128 + kperm(d) * 2) = f2bf(qv[e] * eg);
        *(bf16_t*)(gb + 3 * 8192 + d * 128 + ptt * 2) = f2bf(kv[e] * ekl); } }
    __syncthreads();
    const int rowb = (w4 * 16 + fq * 4) * 144 + fr * 2;
    const int colb = fr * 144 + (w4 * 16 + fq * 4) * 2;
    const int fa = (w4 * 16 + fr) * 144 + fq * 16;
    const int fb = fr * 144 + fq * 16;
    const int i0 = w4 * 16 + fq * 4;
#define G2F(buf, off) (*(const pg8::bf16x8*)(L + (buf) + (off)))
#define G2W16(buf, off, v) (*(bf16_t*)(L + (buf) + (off)) = f2bf(v))
    f32x4 Pt[4];
    { const float gi0 = sc[64 + i0], gi1 = sc[64 + i0 + 1], gi2 = sc[64 + i0 + 2], gi3 = sc[64 + i0 + 3];
#pragma unroll
    for (int u = 0; u < 4; ++u) {
      f32x4 dl = {0.f, 0.f, 0.f, 0.f}, da = {0.f, 0.f, 0.f, 0.f};
#pragma unroll
      for (int ks = 0; ks < 2; ++ks) { const pg8::bf16x8 bk = G2F(G2_KB, fb + u * 2304 + ks * 64);
        dl = __builtin_amdgcn_mfma_f32_16x16x32_bf16(G2F(G2_KBB, fa + ks * 64), bk, dl, 0, 0, 0);
        da = __builtin_amdgcn_mfma_f32_16x16x32_bf16(G2F(G2_QB, fa + ks * 64), bk, da, 0, 0, 0); }
      const int j = u * 16 + fr; const float gj = sc[64 + j]; const int pj = kperm(j);
      const float dec0 = __expf(fminf(gi0 - gj, 0.f)), dec1 = __expf(fminf(gi1 - gj, 0.f)), dec2 = __expf(fminf(gi2 - gj, 0.f)), dec3 = __expf(fminf(gi3 - gj, 0.f));
      const float l0 = i0 + 0 > j ? dl.x * dec0 : 0.f, l1 = i0 + 1 > j ? dl.y * dec1 : 0.f, l2 = i0 + 2 > j ? dl.z * dec2 : 0.f, l3 = i0 + 3 > j ? dl.w * dec3 : 0.f;
      const float a0 = i0 + 0 >= j ? da.x * dec0 : 0.f, a1 = i0 + 1 >= j ? da.y * dec1 : 0.f, a2 = i0 + 2 >= j ? da.z * dec2 : 0.f, a3 = i0 + 3 >= j ? da.w * dec3 : 0.f;
      const f32x4 pv = {(i0 + 0 == j ? 1.f : 0.f) - l0, (i0 + 1 == j ? 1.f : 0.f) - l1, (i0 + 2 == j ? 1.f : 0.f) - l2, (i0 + 3 == j ? 1.f : 0.f) - l3};
      G2W16(G2_XR0, rowb + u * 32, l0); G2W16(G2_XR0, rowb + 144 + u * 32, l1); G2W16(G2_XR0, rowb + 288 + u * 32, l2); G2W16(G2_XR0, rowb + 432 + u * 32, l3);
      G2W16(G2_PR0, rowb + u * 32, pv.x); G2W16(G2_PR0, rowb + 144 + u * 32, pv.y); G2W16(G2_PR0, rowb + 288 + u * 32, pv.z); G2W16(G2_PR0, rowb + 432 + u * 32, pv.w);
      *(u32x2*)(L + G2_XT0 + colb + u * 2304) = (u32x2){pk2(l0, l1), pk2(l2, l3)};
      bf16_t* am = (bf16_t*)(gb + 2 * 8192 + i0 * 128 + pj * 2);
      am[0] = f2bf(a0); am[64] = f2bf(a1); am[128] = f2bf(a2); am[192] = f2bf(a3);
      Pt[u] = pv; } }
    __syncthreads();
#pragma unroll
    for (int u = 0; u < 4; ++u) {
      f32x4 d = {0.f, 0.f, 0.f, 0.f};
#pragma unroll
      for (int ks = 0; ks < 2; ++ks) d = __builtin_amdgcn_mfma_f32_16x16x32_bf16(G2F(G2_XR0, fa + ks * 64), G2F(G2_XT0, fb + u * 2304 + ks * 64), d, 0, 0, 0);
      G2W16(G2_KB, rowb + u * 32, d.x); G2W16(G2_KB, rowb + 144 + u * 32, d.y); G2W16(G2_KB, rowb + 288 + u * 32, d.z); G2W16(G2_KB, rowb + 432 + u * 32, d.w);
      *(u32x2*)(L + G2_KBB + colb + u * 2304) = (u32x2){pk2(d.x, d.y), pk2(d.z, d.w)}; }
    __syncthreads();
#pragma unroll
    for (int itn = 0; itn < 4; ++itn) {
      const int XRc = (itn & 1) ? G2_XR0 : G2_KB, XTc = (itn & 1) ? G2_XT0 : G2_KBB, XRn = (itn & 1) ? G2_KB : G2_XR0, XTn = (itn & 1) ? G2_KBB : G2_XT0;
      const int PRc = (itn & 1) ? G2_QB : G2_PR0, PRn = (itn & 1) ? G2_PR0 : G2_QB;
#pragma unroll
      for (int u = 0; u < 4; ++u) {
        f32x4 d = {0.f, 0.f, 0.f, 0.f};
#pragma unroll
        for (int ks = 0; ks < 2; ++ks) { const pg8::bf16x8 bx = G2F(XTc, fb + u * 2304 + ks * 64);
          Pt[u] = __builtin_amdgcn_mfma_f32_16x16x32_bf16(G2F(PRc, fa + ks * 64), bx, Pt[u], 0, 0, 0);
          if (itn < 3) d = __builtin_amdgcn_mfma_f32_16x16x32_bf16(G2F(XRc, fa + ks * 64), bx, d, 0, 0, 0); }
        G2W16(PRn, rowb + u * 32, Pt[u].x); G2W16(PRn, rowb + 144 + u * 32, Pt[u].y); G2W16(PRn, rowb + 288 + u * 32, Pt[u].z); G2W16(PRn, rowb + 432 + u * 32, Pt[u].w);
        if (itn < 3) { G2W16(XRn, rowb + u * 32, d.x); G2W16(XRn, rowb + 144 + u * 32, d.y); G2W16(XRn, rowb + 288 + u * 32, d.z); G2W16(XRn, rowb + 432 + u * 32, d.w);
          *(u32x2*)(L + XTn + colb + u * 2304) = (u32x2){pk2(d.x, d.y), pk2(d.z, d.w)}; } }
      __syncthreads();
    }
#pragma unroll
    for (int u = 0; u < 4; ++u) {
      f32x4 du = {0.f, 0.f, 0.f, 0.f}, dw = {0.f, 0.f, 0.f, 0.f};
#pragma unroll
      for (int ks = 0; ks < 2; ++ks) { const pg8::bf16x8 a = G2F(G2_PR0, fa + ks * 64);
        du = __builtin_amdgcn_mfma_f32_16x16x32_bf16(a, G2F(G2_VBT, fb + u * 2304 + ks * 64), du, 0, 0, 0);
        dw = __builtin_amdgcn_mfma_f32_16x16x32_bf16(a, G2F(G2_KBET, fb + u * 2304 + ks * 64), dw, 0, 0, 0); }
      const int j = u * 16 + fr, pj = kperm(j);
      *(u32x2*)(gb + 4 * 8192 + j * 128 + i0 * 2) = (u32x2){pk2(du.x, du.y), pk2(du.z, du.w)};
      bf16_t* wn = (bf16_t*)(gb + i0 * 128 + pj * 2);
      wn[0] = f2bf(-dw.x); wn[64] = f2bf(-dw.y); wn[128] = f2bf(-dw.z); wn[192] = f2bf(-dw.w); }
#undef G2F
#undef G2W16
  }
}

constexpr int GS_SLOT = 46208, GS_OB = 2 * GS_SLOT;
__device__ void phase_gdn_scan(const Ctx& c, unsigned char* L, int item) {
  unsigned char* ws = c.ws;
  const int tid = phase_tid(), lane = tid & 63, wave = tid >> 6, fr = lane & 15, fq = lane >> 4;
  const int b = item / 6, h = item % 6;
  const bf16_t* GB = (const bf16_t*)(ws + WS_GB); bf16_t* CAT = (bf16_t*)(ws + WS_CAT); const float* gng = c.in[9];
  const int lt = tid - 256;
  u32x4 ra[10], rb[10]; float gla = 0.f, glb = 0.f;
  f32x4 S[4];
#pragma unroll
  for (int i = 0; i < 4; ++i) S[i] = (f32x4){0.f, 0.f, 0.f, 0.f};
#define GS_LOAD(R, G, n) do { if ((n) < 64) { const unsigned char* gb_ = gd_item(ws, item * 64 + (n)); _Pragma("unroll") for (int i_ = 0; i_ < 10; ++i_) R[i_] = *(const u32x4*)(gb_ + (size_t)(lt + 256 * i_) * 16); if (lt == 0) G = *(const float*)(gb_ + 40960); } } while (0)
#define GS_STORE(R, G, slot) do { _Pragma("unroll") for (int i_ = 0; i_ < 10; ++i_) { const int p_ = lt + 256 * i_; *(u32x4*)(L + (slot) * GS_SLOT + (p_ >> 9) * 9216 + ((p_ >> 3) & 63) * 144 + (p_ & 7) * 16) = R[i_]; } if (lt == 0) *(float*)(L + (slot) * GS_SLOT + 46080) = G; } while (0)
  float gnr[16];
#pragma unroll
  for (int e = 0; e < 16; ++e) gnr[e] = gng[((tid - 256) & 3) * 16 + e];
  auto zload = [&](int k, u32x4& z0, u32x4& z1) {
    const size_t r = (size_t)b * SEQ + k * 64 + (lt >> 2); const bf16_t* zp = GB + r * 1536 + 1152 + h * 64 + (lt & 3) * 16; z0 = *(const u32x4*)zp; z1 = *(const u32x4*)(zp + 8); };
  auto post = [&](int k, const u32x4 z0, const u32x4 z1) {
    const unsigned char* ob = L + GS_OB + (k & 1) * 9216; const int tk = lt >> 2, part = lt & 3; const size_t r = (size_t)b * SEQ + k * 64 + tk;
    const u32x4 o0 = *(const u32x4*)(ob + tk * 144 + part * 32), o1 = *(const u32x4*)(ob + tk * 144 + part * 32 + 16);
    float ov[16] = {__uint_as_float(o0.x << 16), __uint_as_float(o0.x & 0xffff0000u), __uint_as_float(o0.y << 16), __uint_as_float(o0.y & 0xffff0000u), __uint_as_float(o0.z << 16), __uint_as_float(o0.z & 0xffff0000u), __uint_as_float(o0.w << 16), __uint_as_float(o0.w & 0xffff0000u),
                    __uint_as_float(o1.x << 16), __uint_as_float(o1.x & 0xffff0000u), __uint_as_float(o1.y << 16), __uint_as_float(o1.y & 0xffff0000u), __uint_as_float(o1.z << 16), __uint_as_float(o1.z & 0xffff0000u), __uint_as_float(o1.w << 16), __uint_as_float(o1.w & 0xffff0000u)};
    float ss = 0.f;
#pragma unroll
    for (int e = 0; e < 16; ++e) ss += ov[e] * ov[e];
    ss += __shfl_xor(ss, 1); ss += __shfl_xor(ss, 2);
    const float rstd = rsqrtf(ss * (1.f / 64.f) + 1e-6f);
    const float zf[16] = {__uint_as_float(z0.x << 16), __uint_as_float(z0.x & 0xffff0000u), __uint_as_float(z0.y << 16), __uint_as_float(z0.y & 0xffff0000u), __uint_as_float(z0.z << 16), __uint_as_float(z0.z & 0xffff0000u), __uint_as_float(z0.w << 16), __uint_as_float(z0.w & 0xffff0000u),
                          __uint_as_float(z1.x << 16), __uint_as_float(z1.x & 0xffff0000u), __uint_as_float(z1.y << 16), __uint_as_float(z1.y & 0xffff0000u), __uint_as_float(z1.z << 16), __uint_as_float(z1.z & 0xffff0000u), __uint_as_float(z1.w << 16), __uint_as_float(z1.w & 0xffff0000u)};
#pragma unroll
    for (int e = 0; e < 16; ++e) ov[e] = ov[e] * rstd * gnr[e] * silu_f(zf[e]);
    bf16_t* op = CAT + r * 1024 + 384 + h * 64 + part * 16;
    *(u32x4*)op = (u32x4){pk2(ov[0], ov[1]), pk2(ov[2], ov[3]), pk2(ov[4], ov[5]), pk2(ov[6], ov[7])};
    *(u32x4*)(op + 8) = (u32x4){pk2(ov[8], ov[9]), pk2(ov[10], ov[11]), pk2(ov[12], ov[13]), pk2(ov[14], ov[15])};
  };
  auto step = [&](int k) {
    const unsigned char* sb = L + (k & 1) * GS_SLOT; const float gl = *(const float*)(sb + 46080);
    const pg8::bf16x8 Sb0 = packp(S[0], S[1]), Sb1 = packp(S[2], S[3]);
    f32x4 vn[4], o[4];
#pragma unroll
    for (int mt = 0; mt < 4; ++mt) { const u32x2 uv = *(const u32x2*)(sb + 4 * 9216 + (wave * 16 + fr) * 144 + (mt * 16 + fq * 4) * 2);
      f32x4 a = {__uint_as_float(uv.x << 16), __uint_as_float(uv.x & 0xffff0000u), __uint_as_float(uv.y << 16), __uint_as_float(uv.y & 0xffff0000u)};
      a = __builtin_amdgcn_mfma_f32_16x16x32_bf16(ldsfrag(sb, mt * 16 + fr, 0, fq), Sb0, a, 0, 0, 0);
      vn[mt] = __builtin_amdgcn_mfma_f32_16x16x32_bf16(ldsfrag(sb, mt * 16 + fr, 1, fq), Sb1, a, 0, 0, 0);
      f32x4 q = {0.f, 0.f, 0.f, 0.f};
      q = __builtin_amdgcn_mfma_f32_16x16x32_bf16(ldsfrag(sb + 9216, mt * 16 + fr, 0, fq), Sb0, q, 0, 0, 0);
      o[mt] = __builtin_amdgcn_mfma_f32_16x16x32_bf16(ldsfrag(sb + 9216, mt * 16 + fr, 1, fq), Sb1, q, 0, 0, 0); }
    const pg8::bf16x8 Vb0 = packp(vn[0], vn[1]), Vb1 = packp(vn[2], vn[3]);
#pragma unroll
    for (int mt = 0; mt < 4; ++mt) { o[mt] = __builtin_amdgcn_mfma_f32_16x16x32_bf16(ldsfrag(sb + 2 * 9216, mt * 16 + fr, 0, fq), Vb0, o[mt], 0, 0, 0);
      o[mt] = __builtin_amdgcn_mfma_f32_16x16x32_bf16(ldsfrag(sb + 2 * 9216, mt * 16 + fr, 1, fq), Vb1, o[mt], 0, 0, 0); }
#pragma unroll
    for (int kt = 0; kt < 4; ++kt) { f32x4 sv = S[kt] * gl;
      sv = __builtin_amdgcn_mfma_f32_16x16x32_bf16(ldsfrag(sb + 3 * 9216, kt * 16 + fr, 0, fq), Vb0, sv, 0, 0, 0);
      S[kt] = __builtin_amdgcn_mfma_f32_16x16x32_bf16(ldsfrag(sb + 3 * 9216, kt * 16 + fr, 1, fq), Vb1, sv, 0, 0, 0); }
    unsigned char* ob = L + GS_OB + (k & 1) * 9216 + (wave * 16 + fr) * 2;
#pragma unroll
    for (int mt = 0; mt < 4; ++mt) { const int t0 = mt * 16 + fq * 4;
      *(bf16_t*)(ob + (t0 + 0) * 144) = f2bf(o[mt].x); *(bf16_t*)(ob + (t0 + 1) * 144) = f2bf(o[mt].y); *(bf16_t*)(ob + (t0 + 2) * 144) = f2bf(o[mt].z); *(bf16_t*)(ob + (t0 + 3) * 144) = f2bf(o[mt].w); }
  };
  __syncthreads();
  u32x4 z0a = {0u, 0u, 0u, 0u}, z0b = z0a, z1a = z0a, z1b = z0a;
  if (wave >= 4) { GS_LOAD(ra, gla, 0); GS_STORE(ra, gla, 0); GS_LOAD(ra, gla, 1); GS_LOAD(rb, glb, 2); zload(0, z0a, z0b); }
  __syncthreads();
#define SCAN_BAR() do { asm volatile("s_waitcnt lgkmcnt(0)" ::: "memory"); __builtin_amdgcn_s_barrier(); asm volatile("" ::: "memory"); } while (0)
  if (wave < 4) {
#pragma unroll 1
    for (int k = 0; k < 64; ++k) { step(k); SCAN_BAR(); }
  } else {
#define GS_LSTEP(R, G, ZA, ZB, kk) do { if ((kk) + 1 < 64) GS_STORE(R, G, ((kk) + 1) & 1); GS_LOAD(R, G, (kk) + 3); if ((kk) > 0) post((kk) - 1, ZA, ZB); if ((kk) + 1 < 64) zload((kk) + 1, ZA, ZB); SCAN_BAR(); } while (0)
#pragma unroll 1
    for (int k = 0; k < 64; k += 2) { GS_LSTEP(ra, gla, z1a, z1b, k); GS_LSTEP(rb, glb, z0a, z0b, k + 1); }
    post(63, z1a, z1b);
#undef GS_LSTEP
  }
#undef SCAN_BAR
#undef GS_LOAD
#undef GS_STORE
}

__device__ __forceinline__ f32x4 bf4(u32x2 p) { return (f32x4){__uint_as_float(p.x << 16), __uint_as_float(p.x & 0xffff0000u), __uint_as_float(p.y << 16), __uint_as_float(p.y & 0xffff0000u)}; }
__device__ void phase_router(const Ctx& c, unsigned char* ldsb) {
  unsigned char* ws = c.ws;
  const int tid = phase_tid(), lane = tid & 63, wave = tid >> 6, fr = lane & 15, fq = lane >> 4;
  float* lg = (float*)(ldsb + wave * 5632);
  const float* bg = c.in[17]; const float* br = c.in[19]; const float* g1 = c.in[14]; const float* b1 = c.in[15];
  const bf16_t* WR = (const bf16_t*)(ws + WS_WR); bf16_t* X1B = (bf16_t*)(ws + WS_X1B);
  unsigned* ctl = (unsigned*)(ws + WS_CTL);
  unsigned* LIST = (unsigned*)(ws + WS_LIST); float* GATEL = (float*)(ws + WS_GATEL); unsigned* TSLOT = (unsigned*)(ws + WS_TSLOT);
  unsigned* cntl = (unsigned*)(ldsb + 46080); unsigned* basel = cntl + 64;
  __syncthreads();
  if (tid < 64) cntl[tid] = 0u;
  __syncthreads();
  for (int tile = blockIdx.x * NWAVES + wave; tile < T / 16; tile += gridDim.x * NWAVES) {
    const int t0 = tile * 16;
    float mean_t = 0.f, rstd_t = 0.f;
#pragma unroll 2
    for (int i = 0; i < 16; ++i) { const u32x2* row = (const u32x2*)(X1B + (size_t)(t0 + i) * 1024);
      f32x4 v[4]; float sm = 0.f;
#pragma unroll
      for (int j = 0; j < 4; ++j) { v[j] = bf4(row[lane + 64 * j]); sm += (v[j].x + v[j].y) + (v[j].z + v[j].w); }
      const float mean = wave_sum(sm) * (1.f / 1024.f); float s2 = 0.f;
#pragma unroll
      for (int j = 0; j < 4; ++j) { v[j] = v[j] - mean; s2 += (v[j].x * v[j].x + v[j].y * v[j].y) + (v[j].z * v[j].z + v[j].w * v[j].w); }
      const float rstd = rsqrtf(wave_sum(s2) * (1.f / 1024.f) + 1e-5f);
      if (fr == i) { mean_t = mean; rstd_t = rstd; } }
    f32x4 acc[5];
#pragma unroll
    for (int nt = 0; nt < 5; ++nt) acc[nt] = (f32x4){0.f, 0.f, 0.f, 0.f};
    bf16_t* xp = X1B + (size_t)(t0 + fr) * 1024 + fq * 8;
#pragma unroll 2
    for (int ks = 0; ks < 32; ++ks) {
      const u32x4 yv = *(const u32x4*)(xp + ks * 32);
      const f32x4 ga = *(const f32x4*)(g1 + ks * 32 + fq * 8), gb2 = *(const f32x4*)(g1 + ks * 32 + fq * 8 + 4), ba = *(const f32x4*)(b1 + ks * 32 + fq * 8), bb2 = *(const f32x4*)(b1 + ks * 32 + fq * 8 + 4);
      const f32x4 y0 = {__uint_as_float(yv.x << 16), __uint_as_float(yv.x & 0xffff0000u), __uint_as_float(yv.y << 16), __uint_as_float(yv.y & 0xffff0000u)};
      const f32x4 y1 = {__uint_as_float(yv.z << 16), __uint_as_float(yv.z & 0xffff0000u), __uint_as_float(yv.w << 16), __uint_as_float(yv.w & 0xffff0000u)};
      const f32x4 n0 = (y0 - mean_t) * rstd_t * ga + ba, n1 = (y1 - mean_t) * rstd_t * gb2 + bb2;
      const u32x4 xw = {cvtpk_c(n0.x, n0.y), cvtpk_c(n0.z, n0.w), cvtpk_c(n1.x, n1.y), cvtpk_c(n1.z, n1.w)};
      *(u32x4*)(xp + ks * 32) = xw;
      const pg8::bf16x8 bx = __builtin_bit_cast(pg8::bf16x8, xw);
#pragma unroll
      for (int nt = 0; nt < 5; ++nt) acc[nt] = __builtin_amdgcn_mfma_f32_16x16x32_bf16(*(const pg8::bf16x8*)(WR + (size_t)(nt * 16 + fr) * 1024 + ks * 32 + fq * 8), bx, acc[nt], 0, 0, 0); }
#pragma unroll
    for (int nt = 0; nt < 5; ++nt) { const int o = nt * 16 + fq * 4; *(f32x4*)(lg + fr * 88 + o) = acc[nt]; }
    asm volatile("s_waitcnt lgkmcnt(0)" ::: "memory");
    int ex1 = 0, ex2 = 0; float gt1 = 0.f, gt2 = 0.f; unsigned lr1 = 0u, lr2 = 0u;
    if (lane < 16) {
      const float* l = lg + lane * 88;
      int grp = 0; float gm = l[0] + bg[0];
      for (int i = 1; i < 8; ++i) { const float v = l[i] + bg[i]; if (v > gm) { gm = v; grp = i; } }
      float gs = 0.f; for (int i = 0; i < 8; ++i) gs += __expf(l[i] + bg[i] - gm);
      const float pgrp = 1.f / gs;
      const float* el = l + 8 + grp * 8; const float* eb = br + grp * 8;
      int i1 = 0; float m1 = el[0] + eb[0]; for (int i = 1; i < 8; ++i) { const float v = el[i] + eb[i]; if (v > m1) { m1 = v; i1 = i; } }
      int i2 = -1; float m2 = -3.0e38f; for (int i = 0; i < 8; ++i) { const float v = el[i] + eb[i]; if (i != i1 && v > m2) { m2 = v; i2 = i; } }
      const float e2 = __expf(m2 - m1), den = 1.f / (1.f + e2);
      gt1 = pgrp * den; gt2 = pgrp * e2 * den;
      ex1 = grp * 8 + i1; ex2 = grp * 8 + i2;
      lr1 = atomicAdd(&cntl[ex1], 1u); lr2 = atomicAdd(&cntl[ex2], 1u);
    }
    __syncthreads();
    if (wave == 0) { const unsigned nloc = cntl[lane]; basel[lane] = nloc ? atomicAdd(&ctl[CW_CNT + lane], nloc) : 0u; }
    __syncthreads();
    if (lane < 16) {
      const int t = t0 + lane; const unsigned r1 = basel[ex1] + lr1, r2 = basel[ex2] + lr2;
      LIST[(size_t)ex1 * 32768 + r1] = (unsigned)t; GATEL[(size_t)ex1 * 32768 + r1] = gt1;
      LIST[(size_t)ex2 * 32768 + r2] = (unsigned)t; GATEL[(size_t)ex2 * 32768 + r2] = gt2;
      TSLOT[(size_t)t * 2 + 0] = ((unsigned)ex1 << 16) | r1; TSLOT[(size_t)t * 2 + 1] = ((unsigned)ex2 << 16) | r2;
    }
    __syncthreads();
    if (tid < 64) cntl[tid] = 0u;
    __syncthreads();
  }
}

__device__ void phase_combine(const Ctx& c, float* lds) {
  unsigned char* ws = c.ws;
  const int tid = phase_tid(), lane = tid & 63, wave = tid >> 6;
  int* offs = (int*)lds; int* cnts = offs + 65;
  expert_offsets(c, offs, cnts, tid);
  const unsigned char* Y = (const unsigned char*)(ws + WS_Y); const unsigned* TSLOT = (const unsigned*)(ws + WS_TSLOT);
  const float* g2 = c.in[23]; const float* b2 = c.in[24];
  for (int t = blockIdx.x * NWAVES + wave; t < T; t += gridDim.x * NWAVES) {
    const unsigned s0 = TSLOT[(size_t)t * 2], s1 = TSLOT[(size_t)t * 2 + 1];
    const size_t r0 = (size_t)offs[s0 >> 16] + (s0 & 0xffffu), r1 = (size_t)offs[s1 >> 16] + (s1 & 0xffffu);
    f32x4* row = (f32x4*)(c.out + (size_t)t * 1024); const u32x2* xrow = (const u32x2*)((const bf16_t*)(ws + WS_X1B) + (size_t)t * 1024);
    f32x4 v[4]; float s = 0.f;
#pragma unroll
    for (int j = 0; j < 4; ++j) { const unsigned ya = ((const unsigned*)(Y + r0 * 1024))[lane + 64 * j], yb = ((const unsigned*)(Y + r1 * 1024))[lane + 64 * j];
      f32x4 x = bf4(xrow[lane + 64 * j]) * ALPHA;
      const hw_f32x2 a01 = __builtin_amdgcn_cvt_pk_f32_fp8(ya, false), a23 = __builtin_amdgcn_cvt_pk_f32_fp8(ya, true), b01 = __builtin_amdgcn_cvt_pk_f32_fp8(yb, false), b23 = __builtin_amdgcn_cvt_pk_f32_fp8(yb, true);
      x.x += (a01.x + b01.x) * 0.015625f; x.y += (a01.y + b01.y) * 0.015625f; x.z += (a23.x + b23.x) * 0.015625f; x.w += (a23.y + b23.y) * 0.015625f;
      v[j] = x; s += (x.x + x.y) + (x.z + x.w); }
    const float mean = wave_sum(s) * (1.f / 1024.f); float s2 = 0.f;
#pragma unroll
    for (int j = 0; j < 4; ++j) { v[j] = v[j] - mean; s2 += (v[j].x * v[j].x + v[j].y * v[j].y) + (v[j].z * v[j].z + v[j].w * v[j].w); }
    const float rstd = rsqrtf(wave_sum(s2) * (1.f / 1024.f) + 1e-5f);
#pragma unroll
    for (int j = 0; j < 4; ++j) { const f32x4 g = ((const f32x4*)g2)[lane + 64 * j], bb = ((const f32x4*)b2)[lane + 64 * j]; row[lane + 64 * j] = v[j] * rstd * g + bb; }
  }
}

constexpr int NPHASE = 11;
__global__ void __launch_bounds__(NTHREADS, 2) mega(Ctx c) {
  float* lds = (float*)lds_raw;
  unsigned* ctl = (unsigned*)(c.ws + WS_CTL);
  unsigned* bar = ctl + CW_BAR;
  if (threadIdx.x == 0) { *(volatile unsigned*)(lds_raw + LDS_WCTR) = 0u; *(volatile unsigned*)(lds_raw + LDS_XBST) = 0u; *(volatile unsigned*)(lds_raw + LDS_XBST + 4) = 0u;
    (void)xb_add(&bar[XB_XCNT(xb_xcc_id())], 1u); }
  __syncthreads();
  phase_prologue(c, lds);
  xcd_barrier(bar);
  phase_inproj_mfma(c, (lds_u8*)lds_raw);
  phase_tiles_queue(c, lds, ctl + CW_Q + 48, TP_WD0 - TP_D1, TP_WD0);
  xcd_barrier(bar);
  phase_gdn_prep2(c, lds_raw);
  phase_kvup(c, lds);
  phase_topk_mfma(c, lds_raw, ctl + CW_Q);
  xcd_barrier(bar);
  if (blockIdx.x < 48) phase_gdn_scan(c, lds_raw, blockIdx.x);
  phase_attn_sparse(c, lds_raw, ctl + CW_Q + 16);
  phase_attn_mem(c, lds_raw, ctl + CW_Q + 32);
  xcd_barrier(bar);
  phase_outproj_mfma(c, (lds_u8*)lds_raw);
  xcd_barrier(bar);
  phase_router(c, lds_raw);
  xcd_barrier(bar);
  phase_moe_up_mfma(c, (lds_u8*)lds_raw);
  phase_tiles_queue(c, lds, ctl + CW_Q + 64, TP_WD0, TP_TOTAL);
  xcd_barrier(bar);
  phase_moe_down_mfma(c, (lds_u8*)lds_raw);
  xcd_barrier(bar);
  phase_combine(c, lds);
}

extern "C" void kernel_launch(void* const* d_in, const int* in_sizes, int n_in, void* d_out, int out_size, void* d_ws, size_t ws_size, hipStream_t stream) {
  static int grid = 0;
  if (grid == 0) {
    if (n_in != 25 || ws_size < WS_END) { fprintf(stderr, "kernel_launch: unexpected n_in %d / ws %zu\n", n_in, ws_size); grid = -1; return; }
    int dev = 0, cus = 0, per_cu = 0;
    hipGetDevice(&dev); hipDeviceGetAttribute(&cus, hipDeviceAttributeMultiprocessorCount, dev);
    hipFuncSetAttribute((const void*)mega, hipFuncAttributeMaxDynamicSharedMemorySize, LDS_BYTES);
    hipOccupancyMaxActiveBlocksPerMultiprocessor(&per_cu, (const void*)mega, NTHREADS, LDS_BYTES);
    if (per_cu < 1) { fprintf(stderr, "kernel_launch: occupancy query says %d blocks/CU\n", per_cu); per_cu = 1; }
    grid = cus * (per_cu < 1 ? 1 : 1);
    (void)hipGetLastError();
  }
  if (grid < 0) return;
  hipMemsetAsync((char*)d_ws + WS_CTL, 0, 32 * 1024, stream);
  Ctx c; memset(&c, 0, sizeof(c));
  for (int i = 0; i < 25; ++i) c.in[i] = (const float*)d_in[i];
  c.out = (float*)d_out; c.ws = (unsigned char*)d_ws;
  hipLaunchKernelGGL(mega, dim3(grid), dim3(NTHREADS), LDS_BYTES, stream, c);
}
```

```cpp
#include <hip/hip_runtime.h>
#include <cstdio>
#include <cstdint>
#include <cstring>

#ifndef ONE_LAUNCH
#define ONE_LAUNCH 1
#endif

typedef unsigned short bf16_t;
typedef float f32x4 __attribute__((ext_vector_type(4)));
typedef unsigned u32x4 __attribute__((ext_vector_type(4)));
typedef unsigned u32x2 __attribute__((ext_vector_type(2)));

constexpr int T = 32768, DM = 1024, SEQ = 4096, NBATCH = 8;
constexpr int NIN = 2816;
constexpr int NMEM = 256, TM = NBATCH * NMEM;
constexpr int NEXP = 64, DE = 256;
constexpr int NTHREADS = 512, NWAVES = 8;
constexpr float ALPHA = 1.189207115002721f;
constexpr float LOG2E = 1.4426950408889634f;
constexpr float QSCALE = 0.125f * LOG2E;

constexpr size_t MiB = 1ull << 20;
constexpr size_t WS_CTL = 0;
constexpr size_t WS_TSLOT = 512 * 1024;
constexpr size_t WS_ROPE = 1 * MiB;
constexpr size_t WS_WKV = 2 * MiB;
constexpr size_t WS_WR = 2 * MiB + 65536;
constexpr size_t WS_WIN = 3 * MiB;
constexpr size_t WS_WO = 9 * MiB;
constexpr size_t WS_WMKV = 11 * MiB;
constexpr size_t WS_MEMB = 12 * MiB;
constexpr size_t WS_WGU = 16 * MiB;
constexpr size_t WS_WD = 80 * MiB;
constexpr size_t WS_XB = 112 * MiB;
constexpr size_t WS_QA = 176 * MiB;
constexpr size_t WS_CKV = 200 * MiB;
constexpr size_t WS_IQ = 208 * MiB;
constexpr size_t WS_IK = 224 * MiB;
constexpr size_t WS_SM = 228 * MiB;
constexpr size_t WS_QC = 230 * MiB;
constexpr size_t WS_GB = 246 * MiB;
constexpr size_t WS_MK = 342 * MiB;
constexpr size_t WS_MVT = 343 * MiB;
constexpr size_t WS_KVA = 344 * MiB;
constexpr size_t WS_SEL = 352 * MiB;
constexpr size_t WS_CAT = 368 * MiB;
constexpr size_t WS_X1B = 432 * MiB;
constexpr size_t WS_LIST = 496 * MiB;
constexpr size_t WS_GATEL = 504 * MiB;
constexpr size_t WS_END = 512 * MiB;
constexpr size_t WS_H = 112 * MiB;
constexpr size_t WS_Y = 160 * MiB;

constexpr int CW_CNT = 0;
constexpr int CW_Q = 64;
constexpr int CW_BAR = 4096;

struct Ctx {
  const float* in[25];
  float* out;
  unsigned char* ws;
  int ph_lo, ph_hi;
};


extern __shared__ __attribute__((aligned(16))) unsigned char lds_raw[];
constexpr int LDS_BYTES = 157696;
constexpr int LDS_WCTR = LDS_BYTES - 64;
__device__ __forceinline__ int phase_tid() {
  __syncthreads();
  int l; asm volatile("v_mbcnt_lo_u32_b32 %0, -1, 0\n\tv_mbcnt_hi_u32_b32 %0, -1, %0" : "=v"(l));
  unsigned w = 0u;
  if (l == 0) w = __hip_atomic_fetch_add((__attribute__((address_space(3))) unsigned*)(__attribute__((address_space(3))) unsigned char*)(lds_raw + LDS_WCTR), 1u, __ATOMIC_RELAXED, __HIP_MEMORY_SCOPE_WORKGROUP);
  w = (unsigned)__builtin_amdgcn_readfirstlane((int)w) & 7u;
  return (int)(w * 64u) + l;
}


#define XB_TMO      128
#define XB_XCNT(j)  (256  + 64 * (j))
#define XB_XSUB(j)  (1280 + 64 * (j))
#define XB_XGEN(j)  (2304 + 64 * (j))
#define XB_TOP      3328
#define XB_TOPGEN   3392
#define XCD_BAR_WORDS 3456
#define XB_SPIN_CAP (1u << 18)
constexpr int LDS_XBST = LDS_BYTES - 32;
__device__ __forceinline__ unsigned xb_ld(unsigned* p)              { return __hip_atomic_load(p, __ATOMIC_RELAXED, __HIP_MEMORY_SCOPE_AGENT); }
__device__ __forceinline__ unsigned xb_add(unsigned* p, unsigned v) { return __hip_atomic_fetch_add(p, v, __ATOMIC_RELAXED, __HIP_MEMORY_SCOPE_AGENT); }
__device__ __forceinline__ unsigned xb_xcc_id() { return (unsigned)__builtin_amdgcn_s_getreg((3 << 11) | 20) & 0xFu; }
#define XB_SPIN(cond, bar) do { unsigned _sp = 0; while (cond) { __builtin_amdgcn_s_sleep(1); \
    if ((++_sp & 255u) == 0u) { if (xb_ld(&(bar)[XB_TMO])) break; if (_sp > XB_SPIN_CAP) { atomicAdd(&(bar)[XB_TMO], 1u); break; } } } } while (0)
__device__ __forceinline__ void xcd_barrier_complete(unsigned* bar, unsigned x, unsigned& nloc, unsigned& nx) {
    const unsigned G = gridDim.x;
    unsigned sum, cnt, mine, sp = 0u;
    for (;;) {
        sum = 0u; cnt = 0u; mine = 0u;
#pragma unroll
        for (unsigned j = 0; j < 16; ++j) { const unsigned cc = xb_ld(&bar[XB_XCNT(j)]); sum += cc; cnt += (cc > 0u) ? 1u : 0u; mine = (j == x) ? cc : mine; }
        if (sum == G) break;
        __builtin_amdgcn_s_sleep(1);
        if ((++sp & 255u) == 0u) { if (xb_ld(&bar[XB_TMO])) break; if (sp > XB_SPIN_CAP) { atomicAdd(&bar[XB_TMO], 1u); break; } }
    }
    nloc = mine > 0u ? mine : 1u; nx = cnt > 0u ? cnt : 1u;
}
__device__ __forceinline__ void xcd_barrier(unsigned* bar) {
    asm volatile("s_waitcnt vmcnt(0)" ::: "memory");
    __syncthreads();
    const int btid = phase_tid();
    if (btid == 0) {
        volatile __attribute__((address_space(3))) unsigned* st = (volatile __attribute__((address_space(3))) unsigned*)(__attribute__((address_space(3))) unsigned char*)(lds_raw + LDS_XBST);
        const unsigned x = xb_xcc_id();
        __builtin_amdgcn_s_waitcnt(0);
        unsigned nloc = st[0], nx = st[1];
        if (nloc == 0u) { xcd_barrier_complete(bar, x, nloc, nx); st[0] = nloc; st[1] = nx; }
        const unsigned old = xb_add(&bar[XB_XSUB(x)], 1u);
        const unsigned gen = old / nloc;
        if (old + 1u == (gen + 1u) * nloc) {
            __builtin_amdgcn_fence(__ATOMIC_RELEASE, "agent");
            asm volatile("s_waitcnt vmcnt(0)" ::: "memory");
            const unsigned og = xb_add(&bar[XB_TOP], 1u);
            const unsigned tg = og / nx;
            if (og + 1u == (tg + 1u) * nx) xb_add(&bar[XB_TOPGEN], 1u);
            else XB_SPIN(xb_ld(&bar[XB_TOPGEN]) == tg, bar);
            __builtin_amdgcn_fence(__ATOMIC_ACQUIRE, "agent");
            xb_add(&bar[XB_XGEN(x)], 1u);
            asm volatile("s_waitcnt vmcnt(0)" ::: "memory");
        } else {
            XB_SPIN(xb_ld(&bar[XB_XGEN(x)]) == gen, bar);
            __builtin_amdgcn_fence(__ATOMIC_ACQUIRE, "agent");
            asm volatile("s_waitcnt vmcnt(0)" ::: "memory");
        }
    }
    __syncthreads();
}

__device__ __forceinline__ float bf2f(bf16_t v) { return __uint_as_float(((unsigned)v) << 16); }
typedef float hw_f32x2 __attribute__((ext_vector_type(2))); typedef __bf16 hw_bf16x2 __attribute__((ext_vector_type(2)));
__device__ __forceinline__ unsigned pk2(float lo, float hi) { const hw_f32x2 v = {lo, hi}; const hw_bf16x2 b = __builtin_convertvector(v, hw_bf16x2); return __builtin_bit_cast(unsigned, b); }
__device__ __forceinline__ bf16_t f2bf(float f) { return (bf16_t)(pk2(f, f) & 0xffffu); }
__device__ __forceinline__ float wave_sum(float v) {
  int x = __float_as_int(v);
  x = __float_as_int(__int_as_float(x) + __int_as_float(__builtin_amdgcn_update_dpp(0, x, 0x111, 0xF, 0xF, true)));
  x = __float_as_int(__int_as_float(x) + __int_as_float(__builtin_amdgcn_update_dpp(0, x, 0x112, 0xF, 0xF, true)));
  x = __float_as_int(__int_as_float(x) + __int_as_float(__builtin_amdgcn_update_dpp(0, x, 0x114, 0xF, 0xF, true)));
  x = __float_as_int(__int_as_float(x) + __int_as_float(__builtin_amdgcn_update_dpp(0, x, 0x118, 0xF, 0xF, true)));
  x = __float_as_int(__int_as_float(x) + __int_as_float(__builtin_amdgcn_update_dpp(0, x, 0x142, 0xA, 0xF, false)));
  x = __float_as_int(__int_as_float(x) + __int_as_float(__builtin_amdgcn_update_dpp(0, x, 0x143, 0xC, 0xF, false)));
  return __int_as_float(__builtin_amdgcn_readlane(x, 63));
}
__device__ __forceinline__ float wave_max(float v) {
#pragma unroll
  for (int o = 32; o >= 1; o >>= 1) v = fmaxf(v, __shfl_xor(v, o));
  return v;
}
__device__ __forceinline__ float silu_f(float v) { return v * __builtin_amdgcn_rcpf(1.f + __expf(-v)); }

__device__ __forceinline__ int ropeperm(int p) { return (p >> 1) + 32 * (p & 1); }
__device__ __forceinline__ int colmap_in(int cp) {
  const int tile = cp >> 8, w = cp & 255;
  if (tile == 0) return (w >> 6) * 64 + ropeperm(w & 63);
  if (tile == 1) { if (w < 128) { const int c = 256 + w; return (c >> 6) * 64 + ropeperm(c & 63); } return 384 + (w - 128); }
  if (tile == 2) return 512 + (w >> 6) * 64 + ropeperm(w & 63);
  if (tile == 3) { if (w < 64) return 768 + ropeperm(w); if (w < 68) return 832 + (w - 64); if (w < 74) return 2372 + (w - 68); if (w < 80) return 2378 + (w - 74); return -1; }
  if (tile == 4) return 2384 + w;
  return 836 + (cp - 1280);
}

struct WorkQ { unsigned* head; volatile int* slot; int nxt; };
__device__ __forceinline__ void wq_init(WorkQ& q, unsigned* head, volatile int* slot, int tid) { q.head = head; q.slot = slot; q.nxt = 0; if (tid == 0) q.nxt = (int)atomicAdd(head, 1u); }
__device__ __forceinline__ int wq_next(WorkQ& q, int tid) {
  __syncthreads();
  if (tid == 0) { *q.slot = q.nxt; q.nxt = (int)atomicAdd(q.head, 1u); }
  __syncthreads();
  return *q.slot;
}

template <class CM>
__device__ __forceinline__ void tp_tile(const float* src, int ld, bf16_t* dst, int drow0, int K, int k0, CM cm, float* lds, int tid) {
  const int a = tid & 63, b = tid >> 6;
  const int sc = cm(a);
  __syncthreads();
#pragma unroll
  for (int i = 0; i < 8; ++i) { const int kk = b * 8 + i; lds[kk * 65 + a] = sc >= 0 ? src[(size_t)(k0 + kk) * ld + sc] : 0.f; }
  __syncthreads();
  { const int nn = tid >> 3, kc = (tid & 7) * 8;
    const float* p = lds + kc * 65 + nn;
    *(u32x4*)(dst + (size_t)(drow0 + nn) * K + k0 + kc) = (u32x4){pk2(p[0], p[65]), pk2(p[130], p[195]), pk2(p[260], p[325]), pk2(p[390], p[455])}; }
}

constexpr int TP_TOTAL = (NIN / 64) * 16 + 16 * 16 + 8 * 16 + 64 * 8 * 16 + 64 * 16 * 4;
constexpr int TP_WD0 = TP_TOTAL - 64 * 16 * 4;
constexpr int TP_D1 = 5200;
__device__ __forceinline__ void prologue_tiles(const Ctx& c, float* lds, int tid, int lo, int hi, int b0, int nb) {
  unsigned char* ws = c.ws;
  const int n_win = (NIN / 64) * 16, n_wo = 16 * 16, n_wmkv = 8 * 16, n_wgu = 64 * 8 * 16, n_wd = 64 * 16 * 4;
  const int total = n_win + n_wo + n_wmkv + n_wgu + n_wd;
  for (int it = lo + b0; it < hi; it += nb) {
    int r = it;
    if (r < n_win) { const int nt = r / 16, kt = r % 16; tp_tile(c.in[2], 2640, (bf16_t*)(ws + WS_WIN), nt * 64, 1024, kt * 64, [&](int a) { return colmap_in(nt * 64 + a); }, lds, tid); continue; } r -= n_win;
    if (r < n_wo) { const int nt = r / 16, kt = r % 16; tp_tile(c.in[13], 1024, (bf16_t*)(ws + WS_WO), nt * 64, 1024, kt * 64, [&](int a) { return nt * 64 + a; }, lds, tid); continue; } r -= n_wo;
    if (r < n_wmkv) { const int nt = r / 16, kt = r % 16; tp_tile(c.in[12], 512, (bf16_t*)(ws + WS_WMKV), nt * 64, 1024, kt * 64, [&](int a) { return nt * 64 + a; }, lds, tid); continue; } r -= n_wmkv;
    if (r < n_wgu) { const int e = r / 128, q = r % 128, nt = q / 16, kt = q % 16;
      const int pn = nt >> 2, sub = nt & 3, isup = sub >> 1, c0 = pn * 128 + (sub & 1) * 64;
      const float* src = (isup ? c.in[21] : c.in[20]) + (size_t)e * 1024 * 256;
      tp_tile(src, 256, (bf16_t*)(ws + WS_WGU), e * 512 + nt * 64, 1024, kt * 64, [&](int a) { return c0 + a; }, lds, tid); continue; } r -= n_wgu;
    { const int e = r / 64, q = r % 64, nt = q / 4, kt = q % 4;
      tp_tile(c.in[22] + (size_t)e * 256 * 1024, 1024, (bf16_t*)(ws + WS_WD), e * 1024 + nt * 64, 256, kt * 64, [&](int a) { return nt * 64 + a; }, lds, tid); }
  }
}

__device__ void phase_tiles_queue(const Ctx& c, float* lds, unsigned* qhead, int lo, int hi) {
  const int tid = phase_tid();
  volatile int* slot = (volatile int*)(lds + 64 * 65 + 16);
  WorkQ wq; wq_init(wq, qhead, slot, tid);
  const int nitems = (hi - lo + 7) >> 3;
  for (;;) {
    const int item = wq_next(wq, tid);
    if (item >= nitems) break;
    const int t0 = lo + item * 8, t1 = t0 + 8 < hi ? t0 + 8 : hi;
    prologue_tiles(c, lds, tid, t0, t1, 0, 1);
  }
}

__device__ void phase_prologue(const Ctx& c, float* lds) {
  const int tid = phase_tid(), bid = blockIdx.x, G = gridDim.x;
  unsigned char* ws = c.ws;
  const size_t gtid = (size_t)bid * NTHREADS + tid, gstride = (size_t)G * NTHREADS;
  { const f32x4* x4 = (const f32x4*)c.in[0]; u32x2* o = (u32x2*)c.out;
    for (size_t i = gtid; i < (size_t)T * DM / 4; i += gstride) { const f32x4 v = x4[i]; o[i] = (u32x2){pk2(v.x, v.y), pk2(v.z, v.w)}; }
    const f32x4* m4 = (const f32x4*)c.in[1]; u32x2* om = (u32x2*)(ws + WS_MEMB);
    for (size_t i = gtid; i < (size_t)TM * DM / 4; i += gstride) { const f32x4 v = m4[i]; om[i] = (u32x2){pk2(v.x, v.y), pk2(v.z, v.w)}; } }
  { float* cs = (float*)(ws + WS_ROPE); float* sn = cs + SEQ * 32;
    for (size_t i = gtid; i < (size_t)SEQ * 32; i += gstride) { const int s = (int)(i >> 5), d = (int)(i & 31);
      const float inv = 1.0f / powf(10000.0f, (float)d / 32.0f); const float ang = (float)s * inv; float sv, cv; sincosf(ang, &sv, &cv); cs[i] = cv; sn[i] = sv; } }
  { bf16_t* wkv = (bf16_t*)(ws + WS_WKV); const float* g = c.in[3]; const float* wk = c.in[4]; const float* wv = c.in[5];
    for (size_t i = gtid; i < 128 * 128; i += gstride) { const int p = (int)(i >> 7), k = (int)(i & 127);
      const float w = p < 64 ? wk[k * 64 + ropeperm(p)] : wv[k * 64 + (p - 64)]; wkv[i] = f2bf(w * g[k]); }
    bf16_t* wr = (bf16_t*)(ws + WS_WR); const float* wg = c.in[16]; const float* wrt = c.in[18];
    for (size_t i = gtid; i < 80 * 1024; i += gstride) { const int o = (int)(i >> 10), k = (int)(i & 1023); wr[i] = f2bf(o < 8 ? wg[k * 8 + o] : o < 72 ? wrt[k * 64 + (o - 8)] : 0.f); } }
  prologue_tiles(c, lds, tid, 0, TP_WD0 - TP_D1, bid, G);
}

__device__ __forceinline__ void expert_offsets(const Ctx& c, int* offs  , int* cnts  , int tid) {
  const unsigned* ctl = (const unsigned*)(c.ws + WS_CTL);
  __syncthreads();
  if (tid == 0) { int o = 0; for (int e = 0; e < 64; ++e) { const int n = (int)ctl[CW_CNT + e]; cnts[e] = n; offs[e] = o; o += (n + 255) & ~255; } offs[64] = o; }
  __syncthreads();
}


namespace pg8 {
#define PG8_LAS __attribute__((address_space(3)))
typedef short bf16x8 __attribute__((ext_vector_type(8)));
constexpr int BM = 256, BK = 64, HALF = 128, HTB = HALF * BK * 2, STAGE_BYTES = 8 * HTB, NXCD = 8, WGM = 8;
__host__ __device__ __forceinline__ int lds_byte(int r, int c) { const int st = (r >> 4) * 2 + (c >> 5), rr = r & 15, cc = c & 31, ob = rr * 64 + cc * 2; return st * 1024 + (ob ^ (((ob >> 9) & 1) << 5)); }
__host__ __device__ __forceinline__ void stage_rc(int b, int& R, int& C) { const int st = b / 1024, sb = b % 1024, swz = sb ^ (((sb >> 9) & 1) << 5); R = (st >> 1) * 16 + swz / 64; C = (st & 1) * 32 + (swz % 64) / 2; }
__host__ __device__ __forceinline__ int perm32(int rho) { const int n = rho >> 4, i = rho & 15; return 8 * (i >> 2) + 4 * n + (i & 3); }
struct Unit { int pm, pn, e, mt, aux; };
struct Gemm { const bf16_t* A; const bf16_t* Bt; int K; };
struct StaticOrder {
    int nM, nN, nwg, G, c;
    __device__ void init(int M, int N, int G_, int c_) { nM = M / BM; nN = N / BM; nwg = nM * nN; G = G_; c = c_; }
    __device__ bool next(int i, Unit& u) const {
        const long L = (long)i * G + c; if (c < 0 || L >= nwg) return false;
        int wgid = (int)L; { const int q = nwg / NXCD, r = nwg % NXCD, xcd = wgid % NXCD, off = wgid / NXCD; wgid = (xcd < r ? xcd * (q + 1) : r * (q + 1) + (xcd - r) * q) + off; }
        const int nig = WGM * nN, gid = wgid / nig, fm = gid * WGM, gsz = (nM - fm) < WGM ? (nM - fm) : WGM;
        u.pm = fm + ((wgid % nig) % gsz); u.pn = (wgid % nig) / gsz; u.e = 0; u.mt = 0; u.aux = 0; return true;
    }
    __device__ __forceinline__ unsigned arow(const Unit&, int) const { return 0u; }
};
__device__ __forceinline__ unsigned cvt_pk_bf16(float lo, float hi) { unsigned r; asm volatile("v_cvt_pk_bf16_f32 %0, %1, %2" : "=v"(r) : "v"(lo), "v"(hi)); return r; }

template <class Epi, class Sched, bool ALIGN_EPI, bool GATHER>
__device__ __forceinline__ void gemm_phase(PG8_LAS unsigned char* lds, const Gemm g, const Sched& S, const Epi& E, const int tid) {
    const int wid = __builtin_amdgcn_readfirstlane(tid >> 6), lane = tid & 63, wr = wid >> 2, wc = wid & 3, fr = lane & 15, fq = lane >> 4;
    const int K = g.K, nt = K / BK;
    unsigned voffA[2], voffB[2]; int RA[2], CA[2];
#pragma unroll
    for (int i = 0; i < 2; ++i) { int R, C; stage_rc(tid * 16 + i * 8192, R, C); const int Rb = Epi::PERM ? ((R & ~31) + perm32(R & 31)) : R;
        RA[i] = R; CA[i] = C; voffA[i] = (unsigned)(R * K + C) * 2u; voffB[i] = (unsigned)(Rb * K + C) * 2u; }
    const size_t kstep = (size_t)(BK * 2);
    const size_t hstep = (size_t)HALF * K * 2;
    const size_t tstep = 2 * hstep;
    const unsigned ldsw = (unsigned)wid * 1024u;
    const int aoff = lds_byte(wr * 64 + fr, fq * 8), boff = lds_byte(wc * 32 + fr, fq * 8);
#define PG8_SA(b, h) (((b) * 2 + (h)) * HTB)
#define PG8_SB(b, h) ((4 + (b) * 2 + (h)) * HTB)
#define PG8_STAGE(bufoff, gbase, voff) do { _Pragma("unroll") for (int _i = 0; _i < 2; ++_i) \
        __builtin_amdgcn_global_load_lds((const unsigned*)((const char*)(gbase) + (voff)[_i]), (PG8_LAS unsigned*)(lds + (bufoff) + ldsw + _i * 8192), 16, 0, 0); } while (0)
#define PG8_STAGE_A(bufoff, gbase, h, goff) do { if constexpr (GATHER) { PG8_STAGE(bufoff, gbase, (goff)[h]); } else { PG8_STAGE(bufoff, (gbase) + (h) * hstep, voffA); } } while (0)
#define PG8_LDA(dst, b, h) do { _Pragma("unroll") for (int m = 0; m < 4; ++m) _Pragma("unroll") for (int k = 0; k < 2; ++k) dst[m][k] = *(const PG8_LAS bf16x8*)(lds + PG8_SA(b, h) + aoff + m * 2048 + k * 1024); } while (0)
#define PG8_LDB(dst, b, h) do { _Pragma("unroll") for (int n = 0; n < 2; ++n) _Pragma("unroll") for (int k = 0; k < 2; ++k) dst[n][k] = *(const PG8_LAS bf16x8*)(lds + PG8_SB(b, h) + boff + n * 2048 + k * 1024); } while (0)
#define PG8_MMA(ai, bj, At, Bt) do { __builtin_amdgcn_s_setprio(1); _Pragma("unroll") for (int m = 0; m < 4; ++m) _Pragma("unroll") for (int n = 0; n < 2; ++n) _Pragma("unroll") for (int k = 0; k < 2; ++k) \
        acc[ai][bj][m][n] = __builtin_amdgcn_mfma_f32_16x16x32_bf16(Bt[n][k], At[m][k], acc[ai][bj][m][n], 0, 0, 0); __builtin_amdgcn_s_setprio(0); } while (0)
#define PG8_WAIT_V(n) asm volatile("s_waitcnt vmcnt(" #n ")" ::: "memory")
#define PG8_WAIT_L(n) asm volatile("s_waitcnt lgkmcnt(" #n ")" ::: "memory")
#define PG8_BAR __builtin_amdgcn_s_barrier()
#define PG8_SCHED __builtin_amdgcn_sched_barrier(0)
    Unit cur, nxt; int ui = 0;
    if (!S.next(0, cur)) return;
    f32x4 acc[2][2][4][2];
#pragma unroll
    for (int a = 0; a < 2; ++a)
#pragma unroll
        for (int b = 0; b < 2; ++b)
#pragma unroll
            for (int m = 0; m < 4; ++m)
#pragma unroll
                for (int n = 0; n < 2; ++n) acc[a][b][m][n] = (f32x4){0.f, 0.f, 0.f, 0.f};
    bf16x8 At[4][2], B0[2][2], B1[2][2];
    unsigned gc[2][2], gn[2][2];
    const char* cA; const char* cB = (const char*)g.Bt + (size_t)cur.pn * tstep;
    if constexpr (GATHER) { cA = (const char*)g.A;
#pragma unroll
        for (int h = 0; h < 2; ++h)
#pragma unroll
            for (int i = 0; i < 2; ++i) { gc[h][i] = (S.arow(cur, h * HALF + RA[i]) * (unsigned)K + (unsigned)CA[i]) * 2u; gn[h][i] = gc[h][i]; }
    } else { cA = (const char*)g.A + (size_t)cur.pm * tstep; }
    PG8_STAGE(PG8_SB(0, 0), cB, voffB); PG8_STAGE(PG8_SB(0, 1), cB + hstep, voffB); PG8_STAGE_A(PG8_SA(0, 0), cA, 0, gc); PG8_STAGE_A(PG8_SA(0, 1), cA, 1, gc);
    if (wr == 1) PG8_BAR;
    PG8_WAIT_V(2); PG8_BAR;
    PG8_STAGE(PG8_SB(1, 0), cB + kstep, voffB); PG8_STAGE_A(PG8_SA(1, 0), cA + kstep, 0, gc); PG8_STAGE(PG8_SB(1, 1), cB + hstep + kstep, voffB);
    PG8_WAIT_V(6); PG8_BAR;
    for (;;) {
        const bool has_next = S.next(ui + 1, nxt);
        const char* nA; const char* nB = has_next ? (const char*)g.Bt + (size_t)nxt.pn * tstep : cB;
        if constexpr (GATHER) { nA = cA;
            if (has_next) {
#pragma unroll
                for (int h = 0; h < 2; ++h)
#pragma unroll
                    for (int i = 0; i < 2; ++i) gn[h][i] = (S.arow(nxt, h * HALF + RA[i]) * (unsigned)K + (unsigned)CA[i]) * 2u; }
        } else { nA = has_next ? (const char*)g.A + (size_t)nxt.pm * tstep : cA; }
        for (int t = 0; t < nt; t += 2) {
            const bool last = (t == nt - 2);
            const char* a1 = cA + (size_t)(t + 1) * kstep;
            const char* a2 = last ? nA : cA + (size_t)(t + 2) * kstep; const char* b2 = last ? nB : cB + (size_t)(t + 2) * kstep;
            const char* a3 = a2 + kstep; const char* b3 = b2 + kstep;
            unsigned g2[2][2];
            if constexpr (GATHER) {
#pragma unroll
            for (int h = 0; h < 2; ++h)
#pragma unroll
                for (int i = 0; i < 2; ++i) g2[h][i] = last ? gn[h][i] : gc[h][i]; }
            PG8_LDB(B0, 0, 0); PG8_LDB(B1, 0, 1); PG8_SCHED; PG8_LDA(At, 0, 0); PG8_STAGE_A(PG8_SA(1, 1), a1, 1, gc);
            PG8_WAIT_V(8); PG8_WAIT_L(0); PG8_BAR; PG8_MMA(0, 0, At, B0); PG8_MMA(0, 1, At, B1); PG8_BAR; PG8_SCHED;
            PG8_LDA(At, 0, 1); PG8_STAGE(PG8_SB(0, 0), b2, voffB); PG8_STAGE(PG8_SB(0, 1), b2 + hstep, voffB); PG8_STAGE_A(PG8_SA(0, 0), a2, 0, g2);
            PG8_WAIT_V(8); PG8_WAIT_L(0); PG8_BAR; PG8_MMA(1, 0, At, B0); PG8_MMA(1, 1, At, B1); PG8_BAR; PG8_SCHED;
            PG8_LDB(B0, 1, 0); PG8_LDB(B1, 1, 1); PG8_SCHED; PG8_LDA(At, 1, 0); PG8_STAGE_A(PG8_SA(0, 1), a2, 1, g2);
            PG8_WAIT_V(8); PG8_WAIT_L(0); PG8_BAR; PG8_MMA(0, 0, At, B0); PG8_MMA(0, 1, At, B1); PG8_BAR; PG8_SCHED;
            PG8_LDA(At, 1, 1); PG8_STAGE(PG8_SB(1, 0), b3, voffB); PG8_STAGE(PG8_SB(1, 1), b3 + hstep, voffB); PG8_STAGE_A(PG8_SA(1, 0), a3, 0, g2);
            PG8_WAIT_V(8); PG8_WAIT_L(0); PG8_BAR; PG8_MMA(1, 0, At, B0); PG8_MMA(1, 1, At, B1); PG8_BAR; PG8_SCHED;
        }
        if constexpr (ALIGN_EPI) { if (wr == 0) PG8_BAR; }
        E(acc, cur, wr, wc, fr, fq);
        if (!has_next) break;
#pragma unroll
        for (int a = 0; a < 2; ++a)
#pragma unroll
            for (int b = 0; b < 2; ++b)
#pragma unroll
                for (int m = 0; m < 4; ++m)
#pragma unroll
                    for (int n = 0; n < 2; ++n) acc[a][b][m][n] = (f32x4){0.f, 0.f, 0.f, 0.f};
        cur = nxt; cA = nA; cB = nB; ++ui;
        if constexpr (GATHER) {
#pragma unroll
        for (int h = 0; h < 2; ++h)
#pragma unroll
            for (int i = 0; i < 2; ++i) gc[h][i] = gn[h][i]; }
        if constexpr (ALIGN_EPI) { if (wr == 1) PG8_BAR; }
    }
    PG8_WAIT_V(0);
    if constexpr (!ALIGN_EPI) { if (wr == 0) PG8_BAR; }
    PG8_BAR;
#undef PG8_SA
#undef PG8_SB
#undef PG8_STAGE
#undef PG8_STAGE_A
#undef PG8_LDA
#undef PG8_LDB
#undef PG8_MMA
#undef PG8_WAIT_V
#undef PG8_WAIT_L
#undef PG8_BAR
#undef PG8_SCHED
}
}
typedef __attribute__((address_space(3))) unsigned char lds_u8;

__device__ __forceinline__ u32x4 pack8(const f32x4& a, const f32x4& b) { return (u32x4){pg8::cvt_pk_bf16(a.x, a.y), pg8::cvt_pk_bf16(a.z, a.w), pg8::cvt_pk_bf16(b.x, b.y), pg8::cvt_pk_bf16(b.z, b.w)}; }
struct EpiInM {
  static constexpr bool PERM = true;
  unsigned char* ws;
  __device__ __forceinline__ void operator()(const f32x4 (&acc)[2][2][4][2], const pg8::Unit& u, int wr, int wc, int fr, int fq) const {
    const float* cs = (const float*)(ws + WS_ROPE); const float* sn = cs + SEQ * 32;
    const int pn = u.pn;
#pragma unroll
    for (int ai = 0; ai < 2; ++ai)
#pragma unroll
      for (int m = 0; m < 4; ++m) {
        const int row = u.pm * 256 + ai * 128 + wr * 64 + m * 16 + fr, pos = row & (SEQ - 1);
#pragma unroll
        for (int bj = 0; bj < 2; ++bj) {
          const int w = bj * 128 + wc * 32 + 8 * fq;
          f32x4 v0 = acc[ai][bj][m][0], v1 = acc[ai][bj][m][1];
          const bool do_rope = (pn == 0) || (pn == 1 && bj == 0) || (pn == 2) || (pn == 3 && bj == 0 && wc < 2);
          if (do_rope) { const int d = (w & 63) >> 1; const f32x4 c4 = *(const f32x4*)(cs + pos * 32 + d), s4 = *(const f32x4*)(sn + pos * 32 + d);
            const f32x4 o0 = {v0.x * c4.x - v0.y * s4.x, v0.y * c4.x + v0.x * s4.x, v0.z * c4.y - v0.w * s4.y, v0.w * c4.y + v0.z * s4.y};
            const f32x4 o1 = {v1.x * c4.z - v1.y * s4.z, v1.y * c4.z + v1.x * s4.z, v1.z * c4.w - v1.w * s4.w, v1.w * c4.w + v1.z * s4.w};
            v0 = o0; v1 = o1; }
          if (pn == 0) { *(u32x4*)((bf16_t*)(ws + WS_QA) + (size_t)row * 384 + w) = pack8(v0 * QSCALE, v1 * QSCALE); }
          else if (pn == 1) { if (bj == 0) *(u32x4*)((bf16_t*)(ws + WS_QA) + (size_t)row * 384 + 256 + w) = pack8(v0 * QSCALE, v1 * QSCALE);
                              else *(u32x4*)((bf16_t*)(ws + WS_CKV) + (size_t)row * 128 + (w - 128)) = pack8(v0, v1); }
          else if (pn == 2) { *(u32x4*)((bf16_t*)(ws + WS_IQ) + (size_t)row * 256 + w) = pack8(v0, v1); }
          else if (pn == 3) { if (bj == 0) { if (wc < 2) *(u32x4*)((bf16_t*)(ws + WS_IK) + (size_t)row * 64 + w) = pack8(v0, v1);
                                             else if (wc == 2 && fq < 2) { if (fq == 0) v0 = v0 * 0.0625f; float* o = (float*)(ws + WS_SM) + (size_t)row * 16 + 8 * fq; *(f32x4*)o = v0; *(f32x4*)(o + 4) = v1; } } }
          else if (pn == 4) { *(u32x4*)((bf16_t*)(ws + WS_QC) + (size_t)row * 256 + w) = pack8(v0 * QSCALE, v1 * QSCALE); }
          else { *(u32x4*)((bf16_t*)(ws + WS_GB) + (size_t)row * 1536 + (pn - 5) * 256 + w) = pack8(v0, v1); }
        }
      }
  }
};
__device__ __forceinline__ unsigned pk4_fp8(const f32x4& v) { unsigned w = __builtin_amdgcn_cvt_pk_fp8_f32(v.x, v.y, 0u, false); return __builtin_amdgcn_cvt_pk_fp8_f32(v.z, v.w, w, true); }
struct EpiMemKVM {
  static constexpr bool PERM = true;
  unsigned char* ws;
  __device__ __forceinline__ void operator()(const f32x4 (&acc)[2][2][4][2], const pg8::Unit& u, int wr, int wc, int fr, int fq) const {
#pragma unroll
    for (int ai = 0; ai < 2; ++ai)
#pragma unroll
      for (int m = 0; m < 4; ++m) {
        const int row = u.pm * 256 + ai * 128 + wr * 64 + m * 16 + fr;
#pragma unroll
        for (int bj = 0; bj < 2; ++bj) {
          const int w = bj * 128 + wc * 32 + 8 * fq; const f32x4 v0 = acc[ai][bj][m][0], v1 = acc[ai][bj][m][1];
          const unsigned w0 = pk4_fp8(v0), w1 = pk4_fp8(v1);
          if (u.pn == 0) *(u32x2*)(ws + WS_MK + (size_t)row * 256 + w) = (u32x2){w0, w1};
          else { const int mem = row & 255, xx = mem & 31, mpos = (mem & ~31) + 8 * ((xx >> 2) & 3) + (xx & 3) + 4 * (xx >> 4);
            unsigned char* o = ws + WS_MVT + ((size_t)(row >> 8) * 256 + w) * 256 + mpos;
            o[0] = (unsigned char)w0; o[256] = (unsigned char)(w0 >> 8); o[512] = (unsigned char)(w0 >> 16); o[768] = (unsigned char)(w0 >> 24); o[1024] = (unsigned char)w1; o[1280] = (unsigned char)(w1 >> 8); o[1536] = (unsigned char)(w1 >> 16); o[1792] = (unsigned char)(w1 >> 24); }
        }
      }
  }
};
struct EpiOutM {
  static constexpr bool PERM = true;
  const bf16_t* x; bf16_t* y;
  __device__ __forceinline__ void operator()(const f32x4 (&acc)[2][2][4][2], const pg8::Unit& u, int wr, int wc, int fr, int fq) const {
#pragma unroll
    for (int ai = 0; ai < 2; ++ai)
#pragma unroll
      for (int m = 0; m < 4; ++m) {
        const size_t rb = (size_t)(u.pm * 256 + ai * 128 + wr * 64 + m * 16 + fr) * 1024 + u.pn * 256 + wc * 32 + 8 * fq;
#pragma unroll
        for (int bj = 0; bj < 2; ++bj) { const size_t o = rb + bj * 128; const u32x4 xv = *(const u32x4*)(x + o);
          const f32x4 x0 = {__uint_as_float(xv.x << 16), __uint_as_float(xv.x & 0xffff0000u), __uint_as_float(xv.y << 16), __uint_as_float(xv.y & 0xffff0000u)};
          const f32x4 x1 = {__uint_as_float(xv.z << 16), __uint_as_float(xv.z & 0xffff0000u), __uint_as_float(xv.w << 16), __uint_as_float(xv.w & 0xffff0000u)};
          *(u32x4*)(y + o) = pack8(x0 * ALPHA + acc[ai][bj][m][0], x1 * ALPHA + acc[ai][bj][m][1]); }
      }
  }
};
struct MoeOrder {
  const int* offs; const int* cnts; int npn, G, c; const unsigned* LIST;
  __device__ __forceinline__ bool next(int i, pg8::Unit& u) const {
    const int L = i * G + c; const int ntiles = __builtin_amdgcn_readfirstlane(offs[64]) >> 8;
    if (L >= ntiles * npn) return false;
    const int rt = L / npn, pl = L - rt * npn; int e = 0;
    while (__builtin_amdgcn_readfirstlane(offs[e + 1]) <= rt * 256) ++e;
    u.pm = rt; u.mt = rt - (__builtin_amdgcn_readfirstlane(offs[e]) >> 8); u.e = e; u.pn = e * npn + pl; u.aux = __builtin_amdgcn_readfirstlane(cnts[e]); return true;
  }
  __device__ __forceinline__ unsigned arow(const pg8::Unit& u, int r) const { const int rank = u.mt * 256 + r; return rank < u.aux ? LIST[(size_t)u.e * 32768 + rank] : 0u; }
};
struct EpiMoeUpM {
  static constexpr bool PERM = true;
  bf16_t* H;
  __device__ __forceinline__ void operator()(const f32x4 (&acc)[2][2][4][2], const pg8::Unit& u, int wr, int wc, int fr, int fq) const {
    const int pl = u.pn & 1;
#pragma unroll
    for (int ai = 0; ai < 2; ++ai)
#pragma unroll
      for (int m = 0; m < 4; ++m) {
        const int rl = ai * 128 + wr * 64 + m * 16 + fr;
        if (u.mt * 256 + rl < u.aux) {
          f32x4 h0, h1; const f32x4 g0 = acc[ai][0][m][0], g1 = acc[ai][0][m][1], u0 = acc[ai][1][m][0], u1 = acc[ai][1][m][1];
          h0.x = silu_f(g0.x) * u0.x; h0.y = silu_f(g0.y) * u0.y; h0.z = silu_f(g0.z) * u0.z; h0.w = silu_f(g0.w) * u0.w;
          h1.x = silu_f(g1.x) * u1.x; h1.y = silu_f(g1.y) * u1.y; h1.z = silu_f(g1.z) * u1.z; h1.w = silu_f(g1.w) * u1.w;
          *(u32x4*)(H + (size_t)(u.pm * 256 + rl) * 256 + pl * 128 + wc * 32 + 8 * fq) = pack8(h0, h1);
        }
      }
  }
};
struct EpiMoeDownM {
  static constexpr bool PERM = true;
  unsigned char* Y; const float* GATEL;
  __device__ __forceinline__ void operator()(const f32x4 (&acc)[2][2][4][2], const pg8::Unit& u, int wr, int wc, int fr, int fq) const {
    const int pl = u.pn & 3;
    const float* gp = GATEL + (size_t)u.e * 32768; const int rk0 = u.mt * 256 + wr * 64 + fr;
    unsigned char* yp = Y + (size_t)(u.pm * 256 + wr * 64 + fr) * 1024 + pl * 256 + wc * 32 + 8 * fq;
#pragma unroll
    for (int ai = 0; ai < 2; ++ai)
#pragma unroll
      for (int m = 0; m < 4; ++m) {
        const int rk = rk0 + ai * 128 + m * 16; const float gt = gp[rk < 32767 ? rk : 32767] * 64.0f;
#pragma unroll
        for (int bj = 0; bj < 2; ++bj)
          *(u32x2*)(yp + (size_t)(ai * 128 + m * 16) * 1024 + bj * 128) = (u32x2){pk4_fp8(acc[ai][bj][m][0] * gt), pk4_fp8(acc[ai][bj][m][1] * gt)};
      }
  }
};

__device__ __forceinline__ void phase_inproj_mfma(const Ctx& c, lds_u8* lds) {
  unsigned char* ws = c.ws; const int tid = phase_tid();
  { pg8::Gemm g{(const bf16_t*)c.out, (const bf16_t*)(ws + WS_WIN), 1024}; pg8::StaticOrder S; S.init(T, NIN, gridDim.x, blockIdx.x); EpiInM E{ws};
    pg8::gemm_phase<EpiInM, pg8::StaticOrder, true, false>(lds, g, S, E, tid); }
  { pg8::Gemm g{(const bf16_t*)(ws + WS_MEMB), (const bf16_t*)(ws + WS_WMKV), 1024}; pg8::StaticOrder S; S.init(TM, 512, gridDim.x, (int)blockIdx.x - 128); EpiMemKVM E{ws};
    pg8::gemm_phase<EpiMemKVM, pg8::StaticOrder, true, false>(lds, g, S, E, tid); }
}
__device__ __forceinline__ void phase_outproj_mfma(const Ctx& c, lds_u8* lds) {
  unsigned char* ws = c.ws; const int tid = phase_tid();
  pg8::Gemm g{(const bf16_t*)(ws + WS_CAT), (const bf16_t*)(ws + WS_WO), 1024}; pg8::StaticOrder S; S.init(T, 1024, gridDim.x, blockIdx.x); EpiOutM E{(const bf16_t*)c.out, (bf16_t*)(ws + WS_X1B)};
  pg8::gemm_phase<EpiOutM, pg8::StaticOrder, true, false>(lds, g, S, E, tid);
}
__device__ __forceinline__ void phase_moe_up_mfma(const Ctx& c, lds_u8* lds) {
  unsigned char* ws = c.ws; const int tid = phase_tid();
  int* offs = (int*)((unsigned char*)lds + pg8::STAGE_BYTES); int* cnts = offs + 65;
  expert_offsets(c, offs, cnts, tid);
  pg8::Gemm g{(const bf16_t*)(ws + WS_X1B), (const bf16_t*)(ws + WS_WGU), 1024};
  MoeOrder S{offs, cnts, 2, (int)gridDim.x, (int)blockIdx.x, (const unsigned*)(ws + WS_LIST)}; EpiMoeUpM E{(bf16_t*)(ws + WS_H)};
  pg8::gemm_phase<EpiMoeUpM, MoeOrder, true, true>(lds, g, S, E, tid);
}
__device__ __forceinline__ void phase_moe_down_mfma(const Ctx& c, lds_u8* lds) {
  unsigned char* ws = c.ws; const int tid = phase_tid();
  int* offs = (int*)((unsigned char*)lds + pg8::STAGE_BYTES); int* cnts = offs + 65;
  expert_offsets(c, offs, cnts, tid);
  pg8::Gemm g{(const bf16_t*)(ws + WS_H), (const bf16_t*)(ws + WS_WD), 256};
  MoeOrder S{offs, cnts, 4, (int)gridDim.x, (int)blockIdx.x, nullptr}; EpiMoeDownM E{(unsigned char*)(ws + WS_Y), (const float*)(ws + WS_GATEL)};
  pg8::gemm_phase<EpiMoeDownM, MoeOrder, true, false>(lds, g, S, E, tid);
}

__device__ void phase_kvup(const Ctx& c, float* lds) {
  unsigned char* ws = c.ws;
  const int tid = phase_tid(), lane = tid & 63, wave = tid >> 6, fr = lane & 15, fq = lane >> 4;
  const bf16_t* W = (const bf16_t*)(ws + WS_WKV);
  const bf16_t* CKV = (const bf16_t*)(ws + WS_CKV); bf16_t* KVA = (bf16_t*)(ws + WS_KVA);
  const float* cs = (const float*)(ws + WS_ROPE); const float* sn = cs + SEQ * 32;
  for (int tile = blockIdx.x * NWAVES + wave; tile < T / 16; tile += gridDim.x * NWAVES) {
    const int t = tile * 16 + fr, pos = t & (SEQ - 1);
    pg8::bf16x8 bx[4]; float ss = 0.f;
#pragma unroll
    for (int ks = 0; ks < 4; ++ks) { const u32x4 v = *(const u32x4*)(CKV + (size_t)t * 128 + ks * 32 + fq * 8); bx[ks] = __builtin_bit_cast(pg8::bf16x8, v);
      const float f[8] = {__uint_as_float(v.x << 16), __uint_as_float(v.x & 0xffff0000u), __uint_as_float(v.y << 16), __uint_as_float(v.y & 0xffff0000u), __uint_as_float(v.z << 16), __uint_as_float(v.z & 0xffff0000u), __uint_as_float(v.w << 16), __uint_as_float(v.w & 0xffff0000u)};
#pragma unroll
      for (int e = 0; e < 8; ++e) ss += f[e] * f[e]; }
    ss += __shfl_xor(ss, 16); ss += __shfl_xor(ss, 32);
    const float rstd = rsqrtf(ss * (1.f / 128.f) + 1e-6f);
#pragma unroll
    for (int nt = 0; nt < 8; ++nt) { f32x4 d = {0.f, 0.f, 0.f, 0.f};
#pragma unroll
      for (int ks = 0; ks < 4; ++ks) d = __builtin_amdgcn_mfma_f32_16x16x32_bf16(*(const pg8::bf16x8*)(W + (size_t)(nt * 16 + fr) * 128 + ks * 32 + fq * 8), bx[ks], d, 0, 0, 0);
      d = d * rstd;
      const int p0 = nt * 16 + fq * 4;
      if (nt < 4) { const int dd = p0 >> 1; const float c0 = cs[pos * 32 + dd], s0 = sn[pos * 32 + dd], c1 = cs[pos * 32 + dd + 1], s1 = sn[pos * 32 + dd + 1];
        const f32x4 o = {d.x * c0 - d.y * s0, d.y * c0 + d.x * s0, d.z * c1 - d.w * s1, d.w * c1 + d.z * s1}; d = o; }
      { int w8 = __builtin_amdgcn_cvt_pk_fp8_f32(d.x, d.y, 0, false); w8 = __builtin_amdgcn_cvt_pk_fp8_f32(d.z, d.w, w8, true);
        *(unsigned*)((unsigned char*)KVA + (size_t)t * 128 + p0) = (unsigned)w8; } }
  }
}


typedef _Float16 h16x2 __attribute__((ext_vector_type(2)));
constexpr int TK_KP = 4104;
constexpr int TK_KEYS = 0, TK_H1 = 16 * TK_KP * 2, TK_H2 = TK_H1 + 16 * 128 * 4, TK_MISC = TK_H2 + 8 * 128 * 4;
__device__ __forceinline__ unsigned mono16x2(unsigned u) { const unsigned m = ((u >> 15) & 0x00010001u) * 0xffffu; return u ^ (m | 0x80008000u); }
__device__ __forceinline__ int wave_incl_scan(int x) {
  x += __builtin_amdgcn_update_dpp(0, x, 0x111, 0xF, 0xF, true);
  x += __builtin_amdgcn_update_dpp(0, x, 0x112, 0xF, 0xF, true);
  x += __builtin_amdgcn_update_dpp(0, x, 0x114, 0xF, 0xF, true);
  x += __builtin_amdgcn_update_dpp(0, x, 0x118, 0xF, 0xF, true);
  x += __builtin_amdgcn_update_dpp(0, x, 0x142, 0xA, 0xF, false);
  x += __builtin_amdgcn_update_dpp(0, x, 0x143, 0xC, 0xF, false);
  return x;
}

__device__ __forceinline__ void hist_find(const unsigned* hw, int need, int lane, int& B, int& above) {
  const unsigned w0 = hw[127 - 2 * lane], w1 = hw[126 - 2 * lane];
  const int c0 = (int)(w0 >> 16), c1 = (int)(w0 & 0xffffu), c2 = (int)(w1 >> 16), c3 = (int)(w1 & 0xffffu);
  const int tl = c0 + c1 + c2 + c3;
  const int incl = wave_incl_scan(tl);
  const int excl = incl - tl;
  const bool hit = (excl < need) && (incl >= need);
  int b = 0, ab = 0;
  if (hit) { int a = excl; b = 255 - 4 * lane; ab = a;
    if (a + c0 < need) { a += c0; b = 254 - 4 * lane; ab = a; if (a + c1 < need) { a += c1; b = 253 - 4 * lane; ab = a; if (a + c2 < need) { a += c2; b = 252 - 4 * lane; ab = a; } } } }
  const unsigned long long m = __ballot(hit);
  const int src = __builtin_amdgcn_readfirstlane(m ? (__ffsll((long long)m) - 1) : 0);
  B = __builtin_amdgcn_readlane(b, src); above = __builtin_amdgcn_readlane(ab, src);
}
__device__ void phase_topk_mfma(const Ctx& c, unsigned char* ldsb, unsigned* qhead) {
  unsigned char* ws = c.ws;
  const int tid = phase_tid(), lane = tid & 63, wave = tid >> 6, fr = lane & 15, fq = lane >> 4;
  unsigned short* keys = (unsigned short*)(ldsb + TK_KEYS);
  unsigned* h1 = (unsigned*)(ldsb + TK_H1); unsigned* h2 = (unsigned*)(ldsb + TK_H2) + wave * 128; int* misc = (int*)(ldsb + TK_MISC);
  const bf16_t* IQ = (const bf16_t*)(ws + WS_IQ); const bf16_t* IK = (const bf16_t*)(ws + WS_IK); const float* SM = (const float*)(ws + WS_SM);
  unsigned short* SEL = (unsigned short*)(ws + WS_SEL);
  WorkQ wq; wq_init(wq, qhead, misc, tid);
  for (;;) {
    const int item = wq_next(wq, tid);
    if (item >= 240 * 8) break;
    const int b = item & 7, qb = 255 - (item >> 3), s0 = qb * 16;
    for (int i = tid; i < 16 * 128; i += NTHREADS) h1[i] = 0u;
    const size_t qrow = (size_t)b * SEQ + s0 + fr;
    pg8::bf16x8 bq[4][2];
#pragma unroll
    for (int hh = 0; hh < 4; ++hh)
#pragma unroll
      for (int ks = 0; ks < 2; ++ks) bq[hh][ks] = *(const pg8::bf16x8*)(IQ + qrow * 256 + hh * 64 + ks * 32 + fq * 8);
    const f32x4 iw = *(const f32x4*)(SM + qrow * 16);
    const int nkt = qb + 1, slim = s0 + fr;
    __syncthreads();
    pg8::bf16x8 a0n = {0, 0, 0, 0, 0, 0, 0, 0}, a1n = a0n;
    if (wave < nkt) { const bf16_t* kr = IK + ((size_t)b * SEQ + wave * 16 + fr) * 64 + fq * 8; a0n = *(const pg8::bf16x8*)kr; a1n = *(const pg8::bf16x8*)(kr + 32); }
    for (int kt = wave; kt < nkt; kt += NWAVES) {
      const pg8::bf16x8 a0 = a0n, a1 = a1n;
      if (kt + NWAVES < nkt) { const bf16_t* kr = IK + ((size_t)b * SEQ + (kt + NWAVES) * 16 + fr) * 64 + fq * 8; a0n = *(const pg8::bf16x8*)kr; a1n = *(const pg8::bf16x8*)(kr + 32); }
      f32x4 sc = {0.f, 0.f, 0.f, 0.f};
#pragma unroll
      for (int hh = 0; hh < 4; ++hh) { f32x4 d = {0.f, 0.f, 0.f, 0.f};
        d = __builtin_amdgcn_mfma_f32_16x16x32_bf16(a0, bq[hh][0], d, 0, 0, 0); d = __builtin_amdgcn_mfma_f32_16x16x32_bf16(a1, bq[hh][1], d, 0, 0, 0);
        const float w = hh == 0 ? iw.x : hh == 1 ? iw.y : hh == 2 ? iw.z : iw.w;
        sc.x = fmaf(w, fmaxf(d.x, 0.f), sc.x); sc.y = fmaf(w, fmaxf(d.y, 0.f), sc.y); sc.z = fmaf(w, fmaxf(d.z, 0.f), sc.z); sc.w = fmaf(w, fmaxf(d.w, 0.f), sc.w); }
      unsigned k01 = mono16x2(__builtin_bit_cast(unsigned, __builtin_amdgcn_cvt_pkrtz(sc.x, sc.y))), k23 = mono16x2(__builtin_bit_cast(unsigned, __builtin_amdgcn_cvt_pkrtz(sc.z, sc.w)));
      const int kbase = kt * 16 + fq * 4;
      unsigned* hq = h1 + fr * 128;
      if (kt + 1 < nkt) {
        *(u32x2*)(keys + fr * TK_KP + kbase) = (u32x2){k01, k23};
        { const unsigned kk = k01 & 0xffffu; atomicAdd(hq + (kk >> 9), 1u << ((kk >> 4) & 16)); }
        { const unsigned kk = k01 >> 16; atomicAdd(hq + (kk >> 9), 1u << ((kk >> 4) & 16)); }
        { const unsigned kk = k23 & 0xffffu; atomicAdd(hq + (kk >> 9), 1u << ((kk >> 4) & 16)); }
        { const unsigned kk = k23 >> 16; atomicAdd(hq + (kk >> 9), 1u << ((kk >> 4) & 16)); }
      } else {
        if (kbase + 0 > slim) k01 &= 0xffff0000u; if (kbase + 1 > slim) k01 &= 0x0000ffffu;
        if (kbase + 2 > slim) k23 &= 0xffff0000u; if (kbase + 3 > slim) k23 &= 0x0000ffffu;
        *(u32x2*)(keys + fr * TK_KP + kbase) = (u32x2){k01, k23};
        if (kbase + 0 <= slim) { const unsigned kk = k01 & 0xffffu; atomicAdd(hq + (kk >> 9), 1u << ((kk >> 4) & 16)); }
        if (kbase + 1 <= slim) { const unsigned kk = k01 >> 16; atomicAdd(hq + (kk >> 9), 1u << ((kk >> 4) & 16)); }
        if (kbase + 2 <= slim) { const unsigned kk = k23 & 0xffffu; atomicAdd(hq + (kk >> 9), 1u << ((kk >> 4) & 16)); }
        if (kbase + 3 <= slim) { const unsigned kk = k23 >> 16; atomicAdd(hq + (kk >> 9), 1u << ((kk >> 4) & 16)); }
      }
    }
    __syncthreads();
    for (int qi = 0; qi < 2; ++qi) {
      const int q = wave * 2 + qi, s = s0 + q, n = s + 1;
      int B1, above1; hist_find(h1 + q * 128, 256, lane, B1, above1);
      const int need1 = 256 - above1;
      h2[lane] = 0u; h2[64 + lane] = 0u;
      const unsigned short* kq = keys + q * TK_KP;
      const int niter = (n + 511) >> 9;
      for (int it = 0; it < niter; ++it) {
        const int i0 = (it * 64 + lane) * 8; const u32x4 kv = *(const u32x4*)(kq + i0);
        const unsigned k8[8] = {kv.x & 0xffffu, kv.x >> 16, kv.y & 0xffffu, kv.y >> 16, kv.z & 0xffffu, kv.z >> 16, kv.w & 0xffffu, kv.w >> 16};
#pragma unroll
        for (int e = 0; e < 8; ++e) if (i0 + e < n && (int)(k8[e] >> 8) == B1) atomicAdd(h2 + ((k8[e] & 255u) >> 1), 1u << ((k8[e] & 1u) * 16));
      }
      int B2, above2; hist_find(h2, need1, lane, B2, above2);
      const unsigned thr = (unsigned)((B1 << 8) | B2); const int need = need1 - above2;
      unsigned short* dummy = (unsigned short*)(misc + 8 + wave);
      unsigned short* sel = (unsigned short*)h2;
      asm volatile("s_waitcnt lgkmcnt(0)" ::: "memory");
      int tiebase = 0, outbase = 0;
      for (int it = 0; it < niter; ++it) {
        const int i0 = (it * 64 + lane) * 8; const u32x4 kv = *(const u32x4*)(kq + i0);
        const unsigned k8[8] = {kv.x & 0xffffu, kv.x >> 16, kv.y & 0xffffu, kv.y >> 16, kv.z & 0xffffu, kv.z >> 16, kv.w & 0xffffu, kv.w >> 16};
        int cg = 0, ce = 0;
#pragma unroll
        for (int e = 0; e < 8; ++e) { const bool v = i0 + e < n; cg += (v && k8[e] > thr) ? 1 : 0; ce += (v && k8[e] == thr) ? 1 : 0; }
        int tk = 0;
        if (__ballot(ce != 0)) {
          const int eincl = wave_incl_scan(ce); const int eg = tiebase + eincl - ce;
          tk = need - eg; tk = tk < 0 ? 0 : (tk > ce ? ce : tk);
          tiebase += __builtin_amdgcn_readlane(eincl, 63);
        }
        const int oc = cg + tk; const int oincl = wave_incl_scan(oc);
        int pos = outbase + oincl - oc; int tleft = tk;
#pragma unroll
        for (int e = 0; e < 8; ++e) { const bool v = i0 + e < n; const bool tie = v && k8[e] == thr && tleft > 0; const bool take = (v && k8[e] > thr) || tie;
          tleft -= tie ? 1 : 0;
          unsigned short* dst = (take && pos < 256) ? sel + pos : dummy;
          *dst = (unsigned short)(i0 + e); pos += take ? 1 : 0; }
        outbase += __builtin_amdgcn_readlane(oincl, 63);
      }
      asm volatile("s_waitcnt lgkmcnt(0)" ::: "memory");
      *(u32x2*)(SEL + ((size_t)b * SEQ + s) * 256 + lane * 4) = *(const u32x2*)(sel + lane * 4);
      asm volatile("s_waitcnt lgkmcnt(0)" ::: "memory");
    }
  }
}

typedef short s16x4 __attribute__((ext_vector_type(4)));
__device__ __forceinline__ s16x4 lds_tr16(const unsigned char* p) { return __builtin_bit_cast(s16x4, __builtin_amdgcn_ds_read_tr16_b64_v4i16((__attribute__((address_space(3))) s16x4*)(__attribute__((address_space(3))) unsigned char*)p)); }
typedef float f32x2_t __attribute__((ext_vector_type(2))); typedef __bf16 bf16x2_t __attribute__((ext_vector_type(2)));
__device__ __forceinline__ unsigned cvtpk_c(float lo, float hi) { const f32x2_t v = {lo, hi}; const bf16x2_t b = __builtin_convertvector(v, bf16x2_t); return __builtin_bit_cast(unsigned, b); }
__device__ __forceinline__ pg8::bf16x8 packp(const f32x4& a, const f32x4& b) {
  const u32x4 w = {cvtpk_c(a.x, a.y), cvtpk_c(a.z, a.w), cvtpk_c(b.x, b.y), cvtpk_c(b.z, b.w)}; return __builtin_bit_cast(pg8::bf16x8, w); }
constexpr int AT_WB = 9216 + 512;
typedef int v2i_t __attribute__((ext_vector_type(2)));
__device__ __forceinline__ long lds_tr8(const unsigned char* p) { const v2i_t r = __builtin_amdgcn_ds_read_tr8_b64_v2i32((__attribute__((address_space(3))) v2i_t*)(__attribute__((address_space(3))) unsigned char*)p); return (long)(((unsigned long)(unsigned)r.y << 32) | (unsigned long)(unsigned)r.x); }
__device__ __forceinline__ unsigned cvt4_fp8(float a, float b, float c2, float d) { int w = __builtin_amdgcn_cvt_pk_fp8_f32(a, b, 0, false); w = __builtin_amdgcn_cvt_pk_fp8_f32(c2, d, w, true); return (unsigned)w; }
__device__ __forceinline__ long mk64(unsigned lo, unsigned hi) { return (long)(((unsigned long)hi << 32) | (unsigned long)lo); }
__device__ void phase_attn_sparse(const Ctx& c, unsigned char* ldsb, unsigned* qhead) {
  unsigned char* ws = c.ws;
  const int tid = phase_tid(), lane = tid & 63, wave = tid >> 6, fr = lane & 15, fq = lane >> 4;
  unsigned char* vl = ldsb + wave * AT_WB; unsigned short* sl = (unsigned short*)(vl + 9216);
  const bf16_t* QA = (const bf16_t*)(ws + WS_QA); const unsigned char* KVA = (const unsigned char*)(ws + WS_KVA); const unsigned short* SEL = (const unsigned short*)(ws + WS_SEL);
  bf16_t* CAT = (bf16_t*)(ws + WS_CAT);
  const float* gA = c.in[10];
  __syncthreads();
  int* aq_slot = (int*)(ldsb + 8 * AT_WB);
  WorkQ wq; wq_init(wq, qhead, aq_slot, tid);
  const int st_off = (lane >> 3) * 144 + (lane & 7) * 16;
  const int kr_off = fr * 144 + fq * 16;
  const int tr_off = (fq * 4 + ((fr >> 1) & 3) + (fr >> 3) * 16) * 144 + 64 + (fr & 1) * 8;
  for (;;) {
  const int item = wq_next(wq, tid);
  if (item >= 512) break;
  for (int tj = 0; tj < 8; ++tj) {
    const int t = item * 64 + wave * 8 + tj;
    const int b = t >> 12, s = t & (SEQ - 1), n = s + 1 < 256 ? s + 1 : 256;
    { u32x2 v;
      if (s >= 256) v = *(const u32x2*)(SEL + (size_t)t * 256 + lane * 4);
      else { const int i0 = lane * 4; const unsigned e0 = i0 < n ? i0 : 0, e1 = i0 + 1 < n ? i0 + 1 : 0, e2 = i0 + 2 < n ? i0 + 2 : 0, e3 = i0 + 3 < n ? i0 + 3 : 0; v = (u32x2){e0 | (e1 << 16), e2 | (e3 << 16)}; }
      *(u32x2*)(sl + lane * 4) = v; }
    asm volatile("s_waitcnt lgkmcnt(0)" ::: "memory");
    const unsigned char* kvb = KVA + (size_t)b * SEQ * 128;
    u32x4 ra[8], rb[8];
#define KLOAD(R, CH) do { _Pragma("unroll") for (int i_ = 0; i_ < 8; ++i_) { const int key_ = sl[(CH) * 64 + i_ * 8 + (lane >> 3)]; R[i_] = *(const u32x4*)(kvb + (size_t)key_ * 128 + (lane & 7) * 16); } } while (0)
#define KSTORE(R) do { _Pragma("unroll") for (int i_ = 0; i_ < 8; ++i_) *(u32x4*)(vl + i_ * 8 * 144 + st_off) = R[i_]; } while (0)
    KLOAD(ra, 0); KLOAD(rb, 1);
    long q0 = 0, q1 = 0;
    if (fr < 6) { const bf16_t* qp = QA + (size_t)t * 384 + fr * 64 + fq * 16; const u32x4 a = *(const u32x4*)qp, bb = *(const u32x4*)(qp + 8);
      q0 = mk64(cvt4_fp8(__uint_as_float(a.x << 16), __uint_as_float(a.x & 0xffff0000u), __uint_as_float(a.y << 16), __uint_as_float(a.y & 0xffff0000u)),
                cvt4_fp8(__uint_as_float(a.z << 16), __uint_as_float(a.z & 0xffff0000u), __uint_as_float(a.w << 16), __uint_as_float(a.w & 0xffff0000u)));
      q1 = mk64(cvt4_fp8(__uint_as_float(bb.x << 16), __uint_as_float(bb.x & 0xffff0000u), __uint_as_float(bb.y << 16), __uint_as_float(bb.y & 0xffff0000u)),
                cvt4_fp8(__uint_as_float(bb.z << 16), __uint_as_float(bb.z & 0xffff0000u), __uint_as_float(bb.w << 16), __uint_as_float(bb.w & 0xffff0000u))); }
    float m = -3.0e38f, l = 0.f;
    f32x4 ot[4];
#pragma unroll
    for (int mt = 0; mt < 4; ++mt) ot[mt] = (f32x4){0.f, 0.f, 0.f, 0.f};
#define KCHUNK(R, CH) do { \
      KSTORE(R); if ((CH) + 2 < 4) KLOAD(R, (CH) + 2); \
      asm volatile("s_waitcnt lgkmcnt(0)" ::: "memory"); \
      f32x4 st[4]; \
      _Pragma("unroll") for (int kt = 0; kt < 4; ++kt) { const u32x4 a_ = *(const u32x4*)(vl + kt * 16 * 144 + kr_off); f32x4 d_ = {0.f, 0.f, 0.f, 0.f}; \
        d_ = __builtin_amdgcn_mfma_f32_16x16x32_fp8_fp8(mk64(a_.x, a_.y), q0, d_, 0, 0, 0); st[kt] = __builtin_amdgcn_mfma_f32_16x16x32_fp8_fp8(mk64(a_.z, a_.w), q1, d_, 0, 0, 0); } \
      if (n < 256) { _Pragma("unroll") for (int kt = 0; kt < 4; ++kt) { const int sb = (CH) * 64 + kt * 16 + fq * 4; \
        if (sb + 0 >= n) st[kt].x = -3.0e38f; if (sb + 1 >= n) st[kt].y = -3.0e38f; if (sb + 2 >= n) st[kt].z = -3.0e38f; if (sb + 3 >= n) st[kt].w = -3.0e38f; } } \
      float cm = -3.0e38f; \
      _Pragma("unroll") for (int kt = 0; kt < 4; ++kt) cm = fmaxf(fmaxf(fmaxf(cm, st[kt].x), fmaxf(st[kt].y, st[kt].z)), st[kt].w); \
      cm = fmaxf(cm, __shfl_xor(cm, 16)); cm = fmaxf(cm, __shfl_xor(cm, 32)); \
      const float mn = fmaxf(m, cm), al = __builtin_amdgcn_exp2f(m - mn), mb = mn - 8.f; m = mn; \
      float ls = 0.f; \
      _Pragma("unroll") for (int kt = 0; kt < 4; ++kt) { st[kt].x = __builtin_amdgcn_exp2f(st[kt].x - mb); st[kt].y = __builtin_amdgcn_exp2f(st[kt].y - mb); st[kt].z = __builtin_amdgcn_exp2f(st[kt].z - mb); st[kt].w = __builtin_amdgcn_exp2f(st[kt].w - mb); \
        ls += (st[kt].x + st[kt].y) + (st[kt].z + st[kt].w); } \
      l = l * al + ls; \
      _Pragma("unroll") for (int mt = 0; mt < 4; ++mt) ot[mt] = ot[mt] * al; \
      _Pragma("unroll") for (int k2 = 0; k2 < 2; ++k2) { \
        const long pf = mk64(cvt4_fp8(st[2 * k2].x, st[2 * k2].y, st[2 * k2].z, st[2 * k2].w), cvt4_fp8(st[2 * k2 + 1].x, st[2 * k2 + 1].y, st[2 * k2 + 1].z, st[2 * k2 + 1].w)); \
        _Pragma("unroll") for (int mt = 0; mt < 4; ++mt) { const long af = lds_tr8(vl + k2 * 32 * 144 + tr_off + mt * 16); \
          ot[mt] = __builtin_amdgcn_mfma_f32_16x16x32_fp8_fp8(af, pf, ot[mt], 0, 0, 0); } } \
      asm volatile("s_waitcnt lgkmcnt(0)" ::: "memory"); } while (0)
    KCHUNK(ra, 0); KCHUNK(rb, 1); KCHUNK(ra, 2); KCHUNK(rb, 3);
#undef KLOAD
#undef KSTORE
#undef KCHUNK
    l += __shfl_xor(l, 16); l += __shfl_xor(l, 32);
    const float il = __builtin_amdgcn_rcpf(l); float ss = 0.f;
#pragma unroll
    for (int mt = 0; mt < 4; ++mt) { ot[mt] = ot[mt] * il; ss += (ot[mt].x * ot[mt].x + ot[mt].y * ot[mt].y) + (ot[mt].z * ot[mt].z + ot[mt].w * ot[mt].w); }
    if (fr >= 6) ss = 0.f;
#pragma unroll
    for (int o = 1; o < 64; o <<= 1) ss += __shfl_xor(ss, o);
    const float rstd = rsqrtf(ss * (1.f / 384.f) + 1e-6f);
    if (fr < 6) {
#pragma unroll
      for (int mt = 0; mt < 4; ++mt) { const int col = fr * 64 + mt * 16 + fq * 4; const f32x4 g = *(const f32x4*)(gA + col); const f32x4 o = ot[mt] * rstd * g;
        *(u32x2*)(CAT + (size_t)t * 1024 + col) = (u32x2){pg8::cvt_pk_bf16(o.x, o.y), pg8::cvt_pk_bf16(o.z, o.w)}; } }
  }
  }
}

__device__ void phase_attn_mem(const Ctx& c, unsigned char* ldsb, unsigned* qhead) {
  unsigned char* ws = c.ws;
  const int tid = phase_tid(), lane = tid & 63, wave = tid >> 6, fr = lane & 15, fq = lane >> 4;
  const bf16_t* QC = (const bf16_t*)(ws + WS_QC); const unsigned char* MK = ws + WS_MK; const unsigned char* MVT = ws + WS_MVT;
  bf16_t* CAT = (bf16_t*)(ws + WS_CAT);
  const float* gC = c.in[11];
  int* aq_slot = (int*)(ldsb + 70656 + 8 * 8192);
  WorkQ wq; wq_init(wq, qhead, aq_slot, tid);
  for (;;) {
  const int item = wq_next(wq, tid) + 512;
  if (item >= 768) break;
  {
    const int t0 = (item - 512) * 128 + wave * 16, b = t0 >> 12;
    unsigned char* mkl = ldsb; unsigned char* mvl = ldsb + 36864; unsigned char* ocl = ldsb + 70656 + wave * 8192;
    float ss = 0.f;
#pragma unroll 1
    for (int h = 0; h < 4; ++h) {
      const bf16_t* qp = QC + (size_t)(t0 + fr) * 256 + h * 64 + fq * 16;
      const u32x4 qa = *(const u32x4*)qp, qb = *(const u32x4*)(qp + 8);
      __syncthreads();
#pragma unroll
      for (int i = 0; i < 2; ++i) { const int p = tid + 512 * i, row = p >> 2, cc = p & 3;
        *(u32x4*)(mkl + row * 80 + cc * 16) = *(const u32x4*)(MK + ((size_t)(b * 256 + row)) * 256 + h * 64 + cc * 16); }
#pragma unroll
      for (int i = 0; i < 2; ++i) { const int p = tid + 512 * i, row = p >> 4, cc = p & 15;
        *(u32x4*)(mvl + row * 272 + cc * 16) = *(const u32x4*)(MVT + ((size_t)(b * 256 + h * 64 + row)) * 256 + cc * 16); }
      const long q0 = mk64(cvt4_fp8(__uint_as_float(qa.x << 16), __uint_as_float(qa.x & 0xffff0000u), __uint_as_float(qa.y << 16), __uint_as_float(qa.y & 0xffff0000u)),
                           cvt4_fp8(__uint_as_float(qa.z << 16), __uint_as_float(qa.z & 0xffff0000u), __uint_as_float(qa.w << 16), __uint_as_float(qa.w & 0xffff0000u)));
      const long q1 = mk64(cvt4_fp8(__uint_as_float(qb.x << 16), __uint_as_float(qb.x & 0xffff0000u), __uint_as_float(qb.y << 16), __uint_as_float(qb.y & 0xffff0000u)),
                           cvt4_fp8(__uint_as_float(qb.z << 16), __uint_as_float(qb.z & 0xffff0000u), __uint_as_float(qb.w << 16), __uint_as_float(qb.w & 0xffff0000u)));
      __syncthreads();
      f32x4 oc[4];
      f32x4 st[16];
#pragma unroll
      for (int kt = 0; kt < 16; ++kt) { const u32x4 a_ = *(const u32x4*)(mkl + (kt * 16 + fr) * 80 + fq * 16);
        f32x4 d = {0.f, 0.f, 0.f, 0.f};
        d = __builtin_amdgcn_mfma_f32_16x16x32_fp8_fp8(mk64(a_.x, a_.y), q0, d, 0, 0, 0); st[kt] = __builtin_amdgcn_mfma_f32_16x16x32_fp8_fp8(mk64(a_.z, a_.w), q1, d, 0, 0, 0); }
      float mx = -3.0e38f;
#pragma unroll
      for (int kt = 0; kt < 16; ++kt) mx = fmaxf(fmaxf(fmaxf(mx, st[kt].x), fmaxf(st[kt].y, st[kt].z)), st[kt].w);
      mx = fmaxf(mx, __shfl_xor(mx, 16)); mx = fmaxf(mx, __shfl_xor(mx, 32));
      mx -= 8.f;
      float l = 0.f;
#pragma unroll
      for (int kt = 0; kt < 16; ++kt) { st[kt].x = __builtin_amdgcn_exp2f(st[kt].x - mx); st[kt].y = __builtin_amdgcn_exp2f(st[kt].y - mx); st[kt].z = __builtin_amdgcn_exp2f(st[kt].z - mx); st[kt].w = __builtin_amdgcn_exp2f(st[kt].w - mx);
        l += (st[kt].x + st[kt].y) + (st[kt].z + st[kt].w); }
      l += __shfl_xor(l, 16); l += __shfl_xor(l, 32);
#pragma unroll
      for (int mt = 0; mt < 4; ++mt) oc[mt] = (f32x4){0.f, 0.f, 0.f, 0.f};
#pragma unroll
      for (int kk = 0; kk < 8; ++kk) { const long pf = mk64(cvt4_fp8(st[2 * kk].x, st[2 * kk].y, st[2 * kk].z, st[2 * kk].w), cvt4_fp8(st[2 * kk + 1].x, st[2 * kk + 1].y, st[2 * kk + 1].z, st[2 * kk + 1].w));
#pragma unroll
        for (int mt = 0; mt < 4; ++mt) { const u32x2 a_ = *(const u32x2*)(mvl + (mt * 16 + fr) * 272 + (kk * 4 + fq) * 8);
          oc[mt] = __builtin_amdgcn_mfma_f32_16x16x32_fp8_fp8(mk64(a_.x, a_.y), pf, oc[mt], 0, 0, 0); } }
      const float il = __builtin_amdgcn_rcpf(l);
#pragma unroll
      for (int mt = 0; mt < 4; ++mt) { const f32x4 o = oc[mt] * il; ss += (o.x * o.x + o.y * o.y) + (o.z * o.z + o.w * o.w); *(u32x2*)(ocl + ((h * 4 + mt) * 64 + lane) * 8) = (u32x2){pg8::cvt_pk_bf16(o.x, o.y), pg8::cvt_pk_bf16(o.z, o.w)}; }
    }
    ss += __shfl_xor(ss, 16); ss += __shfl_xor(ss, 32);
    const float rstd = rsqrtf(ss * (1.f / 256.f) + 1e-6f);
#pragma unroll 1
    for (int h = 0; h < 4; ++h)
#pragma unroll
      for (int mt = 0; mt < 4; ++mt) { const int col = h * 64 + mt * 16 + fq * 4; const f32x4 g = *(const f32x4*)(gC + col); const u32x2 pp = *(const u32x2*)(ocl + ((h * 4 + mt) * 64 + lane) * 8);
        const f32x4 ov = {__uint_as_float(pp.x << 16), __uint_as_float(pp.x & 0xffff0000u), __uint_as_float(pp.y << 16), __uint_as_float(pp.y & 0xffff0000u)}; const f32x4 o = ov * rstd * g;
        *(u32x2*)(CAT + (size_t)(t0 + fr) * 1024 + 768 + col) = (u32x2){pg8::cvt_pk_bf16(o.x, o.y), pg8::cvt_pk_bf16(o.z, o.w)}; }
  }
  }
}

constexpr int GD_ITEM = 41088;
__device__ __forceinline__ unsigned char* gd_item(unsigned char* ws, int it) { return it < 1536 ? ws + WS_XB + (size_t)it * GD_ITEM : ws + WS_X1B + (size_t)(it - 1536) * GD_ITEM; }
__device__ __forceinline__ int kperm(int x) { return (x & 32) | (((x >> 2) & 3) << 3) | (x & 3) | (((x >> 4) & 1) << 2); }
constexpr int GP_KB = 0, GP_KBB = 9216, GP_QB = 18432, GP_VBT = 27648, GP_KBET = 36864, GP_XR = 46080  , GP_PR = 82944  , GP_OUT = 101376, GP_SC = 142336;
__device__ __forceinline__ pg8::bf16x8 ldsfrag(const unsigned char* base, int row, int ks, int fq) { return *(const pg8::bf16x8*)(base + row * 144 + ks * 64 + fq * 16); }
constexpr int G2_KB = 0, G2_KBB = 9216, G2_QB = 18432, G2_XR0 = 27648, G2_XT0 = 36864, G2_PR0 = 46080, G2_VBT = 55296, G2_KBET = 64512, G2_SC = 73728, G2_CW = 75264, G2_HALF = 78336;
__device__ void phase_gdn_prep2(const Ctx& c, unsigned char* Lb) {
  unsigned char* ws = c.ws;
  const int tid = phase_tid(), lane = tid & 63, wave = tid >> 6, fr = lane & 15, fq = lane >> 4;
  const int hb = wave >> 2, w4 = wave & 3, htid = tid & 255;
  unsigned char* L = Lb + hb * G2_HALF;
  const bf16_t* GB = (const bf16_t*)(ws + WS_GB); const float* SM = (const float*)(ws + WS_SM);
  const float* convw = c.in[6];
  float* sc = (float*)(L + G2_SC);
  float* cw = (float*)(L + G2_CW);
  const int tt = htid >> 2, part = htid & 3;
  for (int it2 = blockIdx.x; it2 < 1536; it2 += gridDim.x) {
    const int it = it2 * 2 + hb;
    const int n = it & 63, bh = it >> 6, b = bh / 6, h = bh % 6;
    const int t = n * 64 + tt; const size_t r = (size_t)b * SEQ + t;
    unsigned char* gb = gd_item(ws, it);
    __syncthreads();
    for (int i = htid; i < 768; i += 256) { const int j = i / 192, rr = i % 192; cw[i] = convw[j * 1152 + (rr >> 6) * 384 + h * 64 + (rr & 63)]; }
    if (part == 0) { const float a = SM[r * 16 + 4 + h], bb = SM[r * 16 + 10 + h]; const float xs = a + c.in[8][h]; const float sp = xs > 20.f ? xs : log1pf(__expf(xs));
      sc[tt] = -__expf(c.in[7][h]) * sp; sc[192 + tt] = 1.f / (1.f + __expf(-bb)); }
    __syncthreads();
    if (w4 == 0) { float v = sc[lane];
#pragma unroll
      for (int o = 1; o < 64; o <<= 1) { const float u = __shfl_up(v, o); if (lane >= o) v += u; }
      const float last = __shfl(v, 63);
      sc[64 + lane] = v; sc[128 + lane] = __expf(v); sc[256 + lane] = __expf(last - v); if (lane == 0) { sc[320] = __expf(last); *(float*)(gb + 40960) = __expf(last); } }
    float qv[16], kv[16], vv[16];
#pragma unroll
    for (int role = 0; role < 3; ++role) {
      float acc[16];
#pragma unroll
      for (int e = 0; e < 16; ++e) acc[e] = 0.f;
      u32x4 xr[4][2];
#pragma unroll
      for (int j = 0; j < 4; ++j) { const bool ok = t - 3 + j >= 0; const bf16_t* xp = GB + (r - 3 + j) * 1536 + role * 384 + h * 64 + part * 16;
        xr[j][0] = ok ? *(const u32x4*)xp : (u32x4){0u, 0u, 0u, 0u}; xr[j][1] = ok ? *(const u32x4*)(xp + 8) : (u32x4){0u, 0u, 0u, 0u}; }
#pragma unroll
      for (int j = 0; j < 4; ++j)
#pragma unroll
        for (int hh = 0; hh < 2; ++hh) { const u32x4 xvv = xr[j][hh]; const float* wj = cw + j * 192 + role * 64 + part * 16 + hh * 8;
          const f32x4 w0 = *(const f32x4*)wj, w1 = *(const f32x4*)(wj + 4);
          acc[hh * 8 + 0] += w0.x * __uint_as_float(xvv.x << 16); acc[hh * 8 + 1] += w0.y * __uint_as_float(xvv.x & 0xffff0000u); acc[hh * 8 + 2] += w0.z * __uint_as_float(xvv.y << 16); acc[hh * 8 + 3] += w0.w * __uint_as_float(xvv.y & 0xffff0000u);
          acc[hh * 8 + 4] += w1.x * __uint_as_float(xvv.z << 16); acc[hh * 8 + 5] += w1.y * __uint_as_float(xvv.z & 0xffff0000u); acc[hh * 8 + 6] += w1.z * __uint_as_float(xvv.w << 16); acc[hh * 8 + 7] += w1.w * __uint_as_float(xvv.w & 0xffff0000u); }
      float ss = 0.f;
#pragma unroll
      for (int e = 0; e < 16; ++e) { acc[e] = silu_f(acc[e]); ss += acc[e] * acc[e]; }
      if (role < 2) { ss += __shfl_xor(ss, 1); ss += __shfl_xor(ss, 2); const float scl = rsqrtf(ss + 1e-6f) * (role == 0 ? 0.125f : 1.f);
#pragma unroll
        for (int e = 0; e < 16; ++e) acc[e] *= scl; }
#pragma unroll
      for (int e = 0; e < 16; ++e) { if (role == 0) qv[e] = acc[e]; else if (role == 1) kv[e] = acc[e]; else vv[e] = acc[e]; }
    }
    __syncthreads();
    { const float beta = sc[192 + tt], eg = sc[128 + tt], ekl = sc[256 + tt];
      float kb[16];
#pragma unroll
      for (int e = 0; e < 16; ++e) kb[e] = kv[e] * beta;
#pragma unroll
      for (int hh = 0; hh < 2; ++hh) { const int o8 = hh * 8;
        *(u32x4*)(L + G2_KB + tt * 144 + part * 32 + hh * 16) = (u32x4){pk2(kv[o8], kv[o8 + 1]), pk2(kv[o8 + 2], kv[o8 + 3]), pk2(kv[o8 + 4], kv[o8 + 5]), pk2(kv[o8 + 6], kv[o8 + 7])};
        *(u32x4*)(L + G2_KBB + tt * 144 + part * 32 + hh * 16) = (u32x4){pk2(kb[o8], kb[o8 + 1]), pk2(kb[o8 + 2], kb[o8 + 3]), pk2(kb[o8 + 4], kb[o8 + 5]), pk2(kb[o8 + 6], kb[o8 + 7])};
        *(u32x4*)(L + G2_QB + tt * 144 + part * 32 + hh * 16) = (u32x4){pk2(qv[o8], qv[o8 + 1]), pk2(qv[o8 + 2], qv[o8 + 3]), pk2(qv[o8 + 4], qv[o8 + 5]), pk2(qv[o8 + 6], qv[o8 + 7])}; }
      const int ptt = kperm(tt);
#pragma unroll
      for (int e = 0; e < 16; ++e) { const int d = part * 16 + e;
        *(bf16_t*)(L + G2_VBT + d * 144 + tt * 2) = f2bf(vv[e] * beta);
        *(bf16_t*)(L + G2_KBET + d * 144 + tt * 2) = f2bf(kb[e] * eg);
        *(bf16_t*)(gb + 8192 + tt * 128 + kperm(d) * 2) = f2bf(qv[e] * eg);
        *(bf16_t*)(gb + 3 * 8192 + d * 128 + ptt * 2) = f2bf(kv[e] * ekl); } }
    __syncthreads();
    const int rowb = (w4 * 16 + fq * 4) * 144 + fr * 2;
    const int colb = fr * 144 + (w4 * 16 + fq * 4) * 2;
    const int fa = (w4 * 16 + fr) * 144 + fq * 16;
    const int fb = fr * 144 + fq * 16;
    const int i0 = w4 * 16 + fq * 4;
#define G2F(buf, off) (*(const pg8::bf16x8*)(L + (buf) + (off)))
#define G2W16(buf, off, v) (*(bf16_t*)(L + (buf) + (off)) = f2bf(v))
    f32x4 Pt[4];
    { const float gi0 = sc[64 + i0], gi1 = sc[64 + i0 + 1], gi2 = sc[64 + i0 + 2], gi3 = sc[64 + i0 + 3];
#pragma unroll
    for (int u = 0; u < 4; ++u) {
      f32x4 dl = {0.f, 0.f, 0.f, 0.f}, da = {0.f, 0.f, 0.f, 0.f};
#pragma unroll
      for (int ks = 0; ks < 2; ++ks) { const pg8::bf16x8 bk = G2F(G2_KB, fb + u * 2304 + ks * 64);
        dl = __builtin_amdgcn_mfma_f32_16x16x32_bf16(G2F(G2_KBB, fa + ks * 64), bk, dl, 0, 0, 0);
        da = __builtin_amdgcn_mfma_f32_16x16x32_bf16(G2F(G2_QB, fa + ks * 64), bk, da, 0, 0, 0); }
      const int j = u * 16 + fr; const float gj = sc[64 + j]; const int pj = kperm(j);
      const float dec0 = __expf(fminf(gi0 - gj, 0.f)), dec1 = __expf(fminf(gi1 - gj, 0.f)), dec2 = __expf(fminf(gi2 - gj, 0.f)), dec3 = __expf(fminf(gi3 - gj, 0.f));
      const float l0 = i0 + 0 > j ? dl.x * dec0 : 0.f, l1 = i0 + 1 > j ? dl.y * dec1 : 0.f, l2 = i0 + 2 > j ? dl.z * dec2 : 0.f, l3 = i0 + 3 > j ? dl.w * dec3 : 0.f;
      const float a0 = i0 + 0 >= j ? da.x * dec0 : 0.f, a1 = i0 + 1 >= j ? da.y * dec1 : 0.f, a2 = i0 + 2 >= j ? da.z * dec2 : 0.f, a3 = i0 + 3 >= j ? da.w * dec3 : 0.f;
      const f32x4 pv = {(i0 + 0 == j ? 1.f : 0.f) - l0, (i0 + 1 == j ? 1.f : 0.f) - l1, (i0 + 2 == j ? 1.f : 0.f) - l2, (i0 + 3 == j ? 1.f : 0.f) - l3};
      G2W16(G2_XR0, rowb + u * 32, l0); G2W16(G2_XR0, rowb + 144 + u * 32, l1); G2W16(G2_XR0, rowb + 288 + u * 32, l2); G2W16(G2_XR0, rowb + 432 + u * 32, l3);
      G2W16(G2_PR0, rowb + u * 32, pv.x); G2W16(G2_PR0, rowb + 144 + u * 32, pv.y); G2W16(G2_PR0, rowb + 288 + u * 32, pv.z); G2W16(G2_PR0, rowb + 432 + u * 32, pv.w);
      *(u32x2*)(L + G2_XT0 + colb + u * 2304) = (u32x2){pk2(l0, l1), pk2(l2, l3)};
      bf16_t* am = (bf16_t*)(gb + 2 * 8192 + i0 * 128 + pj * 2);
      am[0] = f2bf(a0); am[64] = f2bf(a1); am[128] = f2bf(a2); am[192] = f2bf(a3);
      Pt[u] = pv; } }
    __syncthreads();
#pragma unroll
    for (int u = 0; u < 4; ++u) {
      f32x4 d = {0.f, 0.f, 0.f, 0.f};
#pragma unroll
      for (int ks = 0; ks < 2; ++ks) d = __builtin_amdgcn_mfma_f32_16x16x32_bf16(G2F(G2_XR0, fa + ks * 64), G2F(G2_XT0, fb + u * 2304 + ks * 64), d, 0, 0, 0);
      G2W16(G2_KB, rowb + u * 32, d.x); G2W16(G2_KB, rowb + 144 + u * 32, d.y); G2W16(G2_KB, rowb + 288 + u * 32, d.z); G2W16(G2_KB, rowb + 432 + u * 32, d.w);
      *(u32x2*)(L + G2_KBB + colb + u * 2304) = (u32x2){pk2(d.x, d.y), pk2(d.z, d.w)}; }
    __syncthreads();
#pragma unroll
    for (int itn = 0; itn < 4; ++itn) {
      const int XRc = (itn & 1) ? G2_XR0 : G2_KB, XTc = (itn & 1) ? G2_XT0 : G2_KBB, XRn = (itn & 1) ? G2_KB : G2_XR0, XTn = (itn & 1) ? G2_KBB : G2_XT0;
      const int PRc = (itn & 1) ? G2_QB : G2_PR0, PRn = (itn & 1) ? G2_PR0 : G2_QB;
#pragma unroll
      for (int u = 0; u < 4; ++u) {
        f32x4 d = {0.f, 0.f, 0.f, 0.f};
#pragma unroll
        for (int ks = 0; ks < 2; ++ks) { const pg8::bf16x8 bx = G2F(XTc, fb + u * 2304 + ks * 64);
          Pt[u] = __builtin_amdgcn_mfma_f32_16x16x32_bf16(G2F(PRc, fa + ks * 64), bx, Pt[u], 0, 0, 0);
          if (itn < 3) d = __builtin_amdgcn_mfma_f32_16x16x32_bf16(G2F(XRc, fa + ks * 64), bx, d, 0, 0, 0); }
        G2W16(PRn, rowb + u * 32, Pt[u].x); G2W16(PRn, rowb + 144 + u * 32, Pt[u].y); G2W16(PRn, rowb + 288 + u * 32, Pt[u].z); G2W16(PRn, rowb + 432 + u * 32, Pt[u].w);
        if (itn < 3) { G2W16(XRn, rowb + u * 32, d.x); G2W16(XRn, rowb + 144 + u * 32, d.y); G2W16(XRn, rowb + 288 + u * 32, d.z); G2W16(XRn, rowb + 432 + u * 32, d.w);
          *(u32x2*)(L + XTn + colb + u * 2304) = (u32x2){pk2(d.x, d.y), pk2(d.z, d.w)}; } }
      __syncthreads();
    }
#pragma unroll
    for (int u = 0; u < 4; ++u) {
      f32x4 du = {0.f, 0.f, 0.f, 0.f}, dw = {0.f, 0.f, 0.f, 0.f};
#pragma unroll
      for (int ks = 0; ks < 2; ++ks) { const pg8::bf16x8 a = G2F(G2_PR0, fa + ks * 64);
        du = __builtin_amdgcn_mfma_f32_16x16x32_bf16(a, G2F(G2_VBT, fb + u * 2304 + ks * 64), du, 0, 0, 0);
        dw = __builtin_amdgcn_mfma_f32_16x16x32_bf16(a, G2F(G2_KBET, fb + u * 2304 + ks * 64), dw, 0, 0, 0); }
      const int j = u * 16 + fr, pj = kperm(j);
      *(u32x2*)(gb + 4 * 8192 + j * 128 + i0 * 2) = (u32x2){pk2(du.x, du.y), pk2(du.z, du.w)};
      bf16_t* wn = (bf16_t*)(gb + i0 * 128 + pj * 2);
      wn[0] = f2bf(-dw.x); wn[64] = f2bf(-dw.y); wn[128] = f2bf(-dw.z); wn[192] = f2bf(-dw.w); }
#undef G2F
#undef G2W16
  }
}

constexpr int GS_SLOT = 46208, GS_OB = 2 * GS_SLOT;
__device__ void phase_gdn_scan(const Ctx& c, unsigned char* L, int item) {
  unsigned char* ws = c.ws;
  const int tid = phase_tid(), lane = tid & 63, wave = tid >> 6, fr = lane & 15, fq = lane >> 4;
  const int b = item / 6, h = item % 6;
  const bf16_t* GB = (const bf16_t*)(ws + WS_GB); bf16_t* CAT = (bf16_t*)(ws + WS_CAT); const float* gng = c.in[9];
  const int lt = tid - 256;
  u32x4 ra[10], rb[10]; float gla = 0.f, glb = 0.f;
  f32x4 S[4];
#pragma unroll
  for (int i = 0; i < 4; ++i) S[i] = (f32x4){0.f, 0.f, 0.f, 0.f};
#define GS_LOAD(R, G, n) do { if ((n) < 64) { const unsigned char* gb_ = gd_item(ws, item * 64 + (n)); _Pragma("unroll") for (int i_ = 0; i_ < 10; ++i_) R[i_] = *(const u32x4*)(gb_ + (size_t)(lt + 256 * i_) * 16); if (lt == 0) G = *(const float*)(gb_ + 40960); } } while (0)
#define GS_STORE(R, G, slot) do { _Pragma("unroll") for (int i_ = 0; i_ < 10; ++i_) { const int p_ = lt + 256 * i_; *(u32x4*)(L + (slot) * GS_SLOT + (p_ >> 9) * 9216 + ((p_ >> 3) & 63) * 144 + (p_ & 7) * 16) = R[i_]; } if (lt == 0) *(float*)(L + (slot) * GS_SLOT + 46080) = G; } while (0)
  float gnr[16];
#pragma unroll
  for (int e = 0; e < 16; ++e) gnr[e] = gng[((tid - 256) & 3) * 16 + e];
  auto zload = [&](int k, u32x4& z0, u32x4& z1) {
    const size_t r = (size_t)b * SEQ + k * 64 + (lt >> 2); const bf16_t* zp = GB + r * 1536 + 1152 + h * 64 + (lt & 3) * 16; z0 = *(const u32x4*)zp; z1 = *(const u32x4*)(zp + 8); };
  auto post = [&](int k, const u32x4 z0, const u32x4 z1) {
    const unsigned char* ob = L + GS_OB + (k & 1) * 9216; const int tk = lt >> 2, part = lt & 3; const size_t r = (size_t)b * SEQ + k * 64 + tk;
    const u32x4 o0 = *(const u32x4*)(ob + tk * 144 + part * 32), o1 = *(const u32x4*)(ob + tk * 144 + part * 32 + 16);
    float ov[16] = {__uint_as_float(o0.x << 16), __uint_as_float(o0.x & 0xffff0000u), __uint_as_float(o0.y << 16), __uint_as_float(o0.y & 0xffff0000u), __uint_as_float(o0.z << 16), __uint_as_float(o0.z & 0xffff0000u), __uint_as_float(o0.w << 16), __uint_as_float(o0.w & 0xffff0000u),
                    __uint_as_float(o1.x << 16), __uint_as_float(o1.x & 0xffff0000u), __uint_as_float(o1.y << 16), __uint_as_float(o1.y & 0xffff0000u), __uint_as_float(o1.z << 16), __uint_as_float(o1.z & 0xffff0000u), __uint_as_float(o1.w << 16), __uint_as_float(o1.w & 0xffff0000u)};
    float ss = 0.f;
#pragma unroll
    for (int e = 0; e < 16; ++e) ss += ov[e] * ov[e];
    ss += __shfl_xor(ss, 1); ss += __shfl_xor(ss, 2);
    const float rstd = rsqrtf(ss * (1.f / 64.f) + 1e-6f);
    const float zf[16] = {__uint_as_float(z0.x << 16), __uint_as_float(z0.x & 0xffff0000u), __uint_as_float(z0.y << 16), __uint_as_float(z0.y & 0xffff0000u), __uint_as_float(z0.z << 16), __uint_as_float(z0.z & 0xffff0000u), __uint_as_float(z0.w << 16), __uint_as_float(z0.w & 0xffff0000u),
                          __uint_as_float(z1.x << 16), __uint_as_float(z1.x & 0xffff0000u), __uint_as_float(z1.y << 16), __uint_as_float(z1.y & 0xffff0000u), __uint_as_float(z1.z << 16), __uint_as_float(z1.z & 0xffff0000u), __uint_as_float(z1.w << 16), __uint_as_float(z1.w & 0xffff0000u)};
#pragma unroll
    for (int e = 0; e < 16; ++e) ov[e] = ov[e] * rstd * gnr[e] * silu_f(zf[e]);
    bf16_t* op = CAT + r * 1024 + 384 + h * 64 + part * 16;
    *(u32x4*)op = (u32x4){pk2(ov[0], ov[1]), pk2(ov[2], ov[3]), pk2(ov[4], ov[5]), pk2(ov[6], ov[7])};
    *(u32x4*)(op + 8) = (u32x4){pk2(ov[8], ov[9]), pk2(ov[10], ov[11]), pk2(ov[12], ov[13]), pk2(ov[14], ov[15])};
  };
  auto step = [&](int k) {
    const unsigned char* sb = L + (k & 1) * GS_SLOT; const float gl = *(const float*)(sb + 46080);
    const pg8::bf16x8 Sb0 = packp(S[0], S[1]), Sb1 = packp(S[2], S[3]);
    f32x4 vn[4], o[4];
#pragma unroll
    for (int mt = 0; mt < 4; ++mt) { const u32x2 uv = *(const u32x2*)(sb + 4 * 9216 + (wave * 16 + fr) * 144 + (mt * 16 + fq * 4) * 2);
      f32x4 a = {__uint_as_float(uv.x << 16), __uint_as_float(uv.x & 0xffff0000u), __uint_as_float(uv.y << 16), __uint_as_float(uv.y & 0xffff0000u)};
      a = __builtin_amdgcn_mfma_f32_16x16x32_bf16(ldsfrag(sb, mt * 16 + fr, 0, fq), Sb0, a, 0, 0, 0);
      vn[mt] = __builtin_amdgcn_mfma_f32_16x16x32_bf16(ldsfrag(sb, mt * 16 + fr, 1, fq), Sb1, a, 0, 0, 0);
      f32x4 q = {0.f, 0.f, 0.f, 0.f};
      q = __builtin_amdgcn_mfma_f32_16x16x32_bf16(ldsfrag(sb + 9216, mt * 16 + fr, 0, fq), Sb0, q, 0, 0, 0);
      o[mt] = __builtin_amdgcn_mfma_f32_16x16x32_bf16(ldsfrag(sb + 9216, mt * 16 + fr, 1, fq), Sb1, q, 0, 0, 0); }
    const pg8::bf16x8 Vb0 = packp(vn[0], vn[1]), Vb1 = packp(vn[2], vn[3]);
#pragma unroll
    for (int mt = 0; mt < 4; ++mt) { o[mt] = __builtin_amdgcn_mfma_f32_16x16x32_bf16(ldsfrag(sb + 2 * 9216, mt * 16 + fr, 0, fq), Vb0, o[mt], 0, 0, 0);
      o[mt] = __builtin_amdgcn_mfma_f32_16x16x32_bf16(ldsfrag(sb + 2 * 9216, mt * 16 + fr, 1, fq), Vb1, o[mt], 0, 0, 0); }
#pragma unroll
    for (int kt = 0; kt < 4; ++kt) { f32x4 sv = S[kt] * gl;
      sv = __builtin_amdgcn_mfma_f32_16x16x32_bf16(ldsfrag(sb + 3 * 9216, kt * 16 + fr, 0, fq), Vb0, sv, 0, 0, 0);
      S[kt] = __builtin_amdgcn_mfma_f32_16x16x32_bf16(ldsfrag(sb + 3 * 9216, kt * 16 + fr, 1, fq), Vb1, sv, 0, 0, 0); }
    unsigned char* ob = L + GS_OB + (k & 1) * 9216 + (wave * 16 + fr) * 2;
#pragma unroll
    for (int mt = 0; mt < 4; ++mt) { const int t0 = mt * 16 + fq * 4;
      *(bf16_t*)(ob + (t0 + 0) * 144) = f2bf(o[mt].x); *(bf16_t*)(ob + (t0 + 1) * 144) = f2bf(o[mt].y); *(bf16_t*)(ob + (t0 + 2) * 144) = f2bf(o[mt].z); *(bf16_t*)(ob + (t0 + 3) * 144) = f2bf(o[mt].w); }
  };
  __syncthreads();
  u32x4 z0a = {0u, 0u, 0u, 0u}, z0b = z0a, z1a = z0a, z1b = z0a;
  if (wave >= 4) { GS_LOAD(ra, gla, 0); GS_STORE(ra, gla, 0); GS_LOAD(ra, gla, 1); GS_LOAD(rb, glb, 2); zload(0, z0a, z0b); }
  __syncthreads();
#define SCAN_BAR() do { asm volatile("s_waitcnt lgkmcnt(0)" ::: "memory"); __builtin_amdgcn_s_barrier(); asm volatile("" ::: "memory"); } while (0)
  if (wave < 4) {
#pragma unroll 1
    for (int k = 0; k < 64; ++k) { step(k); SCAN_BAR(); }
  } else {
#define GS_LSTEP(R, G, ZA, ZB, kk) do { if ((kk) + 1 < 64) GS_STORE(R, G, ((kk) + 1) & 1); GS_LOAD(R, G, (kk) + 3); if ((kk) > 0) post((kk) - 1, ZA, ZB); if ((kk) + 1 < 64) zload((kk) + 1, ZA, ZB); SCAN_BAR(); } while (0)
#pragma unroll 1
    for (int k = 0; k < 64; k += 2) { GS_LSTEP(ra, gla, z1a, z1b, k); GS_LSTEP(rb, glb, z0a, z0b, k + 1); }
    post(63, z1a, z1b);
#undef GS_LSTEP
  }
#undef SCAN_BAR
#undef GS_LOAD
#undef GS_STORE
}

__device__ __forceinline__ f32x4 bf4(u32x2 p) { return (f32x4){__uint_as_float(p.x << 16), __uint_as_float(p.x & 0xffff0000u), __uint_as_float(p.y << 16), __uint_as_float(p.y & 0xffff0000u)}; }
__device__ void phase_router(const Ctx& c, unsigned char* ldsb) {
  unsigned char* ws = c.ws;
  const int tid = phase_tid(), lane = tid & 63, wave = tid >> 6, fr = lane & 15, fq = lane >> 4;
  float* lg = (float*)(ldsb + wave * 5632);
  const float* bg = c.in[17]; const float* br = c.in[19]; const float* g1 = c.in[14]; const float* b1 = c.in[15];
  const bf16_t* WR = (const bf16_t*)(ws + WS_WR); bf16_t* X1B = (bf16_t*)(ws + WS_X1B);
  unsigned* ctl = (unsigned*)(ws + WS_CTL);
  unsigned* LIST = (unsigned*)(ws + WS_LIST); float* GATEL = (float*)(ws + WS_GATEL); unsigned* TSLOT = (unsigned*)(ws + WS_TSLOT);
  unsigned* cntl = (unsigned*)(ldsb + 46080); unsigned* basel = cntl + 64;
  __syncthreads();
  if (tid < 64) cntl[tid] = 0u;
  __syncthreads();
  for (int tile = blockIdx.x * NWAVES + wave; tile < T / 16; tile += gridDim.x * NWAVES) {
    const int t0 = tile * 16;
    float mean_t = 0.f, rstd_t = 0.f;
#pragma unroll 2
    for (int i = 0; i < 16; ++i) { const u32x2* row = (const u32x2*)(X1B + (size_t)(t0 + i) * 1024);
      f32x4 v[4]; float sm = 0.f;
#pragma unroll
      for (int j = 0; j < 4; ++j) { v[j] = bf4(row[lane + 64 * j]); sm += (v[j].x + v[j].y) + (v[j].z + v[j].w); }
      const float mean = wave_sum(sm) * (1.f / 1024.f); float s2 = 0.f;
#pragma unroll
      for (int j = 0; j < 4; ++j) { v[j] = v[j] - mean; s2 += (v[j].x * v[j].x + v[j].y * v[j].y) + (v[j].z * v[j].z + v[j].w * v[j].w); }
      const float rstd = rsqrtf(wave_sum(s2) * (1.f / 1024.f) + 1e-5f);
      if (fr == i) { mean_t = mean; rstd_t = rstd; } }
    f32x4 acc[5];
#pragma unroll
    for (int nt = 0; nt < 5; ++nt) acc[nt] = (f32x4){0.f, 0.f, 0.f, 0.f};
    bf16_t* xp = X1B + (size_t)(t0 + fr) * 1024 + fq * 8;
#pragma unroll 2
    for (int ks = 0; ks < 32; ++ks) {
      const u32x4 yv = *(const u32x4*)(xp + ks * 32);
      const f32x4 ga = *(const f32x4*)(g1 + ks * 32 + fq * 8), gb2 = *(const f32x4*)(g1 + ks * 32 + fq * 8 + 4), ba = *(const f32x4*)(b1 + ks * 32 + fq * 8), bb2 = *(const f32x4*)(b1 + ks * 32 + fq * 8 + 4);
      const f32x4 y0 = {__uint_as_float(yv.x << 16), __uint_as_float(yv.x & 0xffff0000u), __uint_as_float(yv.y << 16), __uint_as_float(yv.y & 0xffff0000u)};
      const f32x4 y1 = {__uint_as_float(yv.z << 16), __uint_as_float(yv.z & 0xffff0000u), __uint_as_float(yv.w << 16), __uint_as_float(yv.w & 0xffff0000u)};
      const f32x4 n0 = (y0 - mean_t) * rstd_t * ga + ba, n1 = (y1 - mean_t) * rstd_t * gb2 + bb2;
      const u32x4 xw = {cvtpk_c(n0.x, n0.y), cvtpk_c(n0.z, n0.w), cvtpk_c(n1.x, n1.y), cvtpk_c(n1.z, n1.w)};
      *(u32x4*)(xp + ks * 32) = xw;
      const pg8::bf16x8 bx = __builtin_bit_cast(pg8::bf16x8, xw);
#pragma unroll
      for (int nt = 0; nt < 5; ++nt) acc[nt] = __builtin_amdgcn_mfma_f32_16x16x32_bf16(*(const pg8::bf16x8*)(WR + (size_t)(nt * 16 + fr) * 1024 + ks * 32 + fq * 8), bx, acc[nt], 0, 0, 0); }
#pragma unroll
    for (int nt = 0; nt < 5; ++nt) { const int o = nt * 16 + fq * 4; *(f32x4*)(lg + fr * 88 + o) = acc[nt]; }
    asm volatile("s_waitcnt lgkmcnt(0)" ::: "memory");
    int ex1 = 0, ex2 = 0; float gt1 = 0.f, gt2 = 0.f; unsigned lr1 = 0u, lr2 = 0u;
    if (lane < 16) {
      const float* l = lg + lane * 88;
      int grp = 0; float gm = l[0] + bg[0];
      for (int i = 1; i < 8; ++i) { const float v = l[i] + bg[i]; if (v > gm) { gm = v; grp = i; } }
      float gs = 0.f; for (int i = 0; i < 8; ++i) gs += __expf(l[i] + bg[i] - gm);
      const float pgrp = 1.f / gs;
      const float* el = l + 8 + grp * 8; const float* eb = br + grp * 8;
      int i1 = 0; float m1 = el[0] + eb[0]; for (int i = 1; i < 8; ++i) { const float v = el[i] + eb[i]; if (v > m1) { m1 = v; i1 = i; } }
      int i2 = -1; float m2 = -3.0e38f; for (int i = 0; i < 8; ++i) { const float v = el[i] + eb[i]; if (i != i1 && v > m2) { m2 = v; i2 = i; } }
      const float e2 = __expf(m2 - m1), den = 1.f / (1.f + e2);
      gt1 = pgrp * den; gt2 = pgrp * e2 * den;
      ex1 = grp * 8 + i1; ex2 = grp * 8 + i2;
      lr1 = atomicAdd(&cntl[ex1], 1u); lr2 = atomicAdd(&cntl[ex2], 1u);
    }
    __syncthreads();
    if (wave == 0) { const unsigned nloc = cntl[lane]; basel[lane] = nloc ? atomicAdd(&ctl[CW_CNT + lane], nloc) : 0u; }
    __syncthreads();
    if (lane < 16) {
      const int t = t0 + lane; const unsigned r1 = basel[ex1] + lr1, r2 = basel[ex2] + lr2;
      LIST[(size_t)ex1 * 32768 + r1] = (unsigned)t; GATEL[(size_t)ex1 * 32768 + r1] = gt1;
      LIST[(size_t)ex2 * 32768 + r2] = (unsigned)t; GATEL[(size_t)ex2 * 32768 + r2] = gt2;
      TSLOT[(size_t)t * 2 + 0] = ((unsigned)ex1 << 16) | r1; TSLOT[(size_t)t * 2 + 1] = ((unsigned)ex2 << 16) | r2;
    }
    __syncthreads();
    if (tid < 64) cntl[tid] = 0u;
    __syncthreads();
  }
}

__device__ void phase_combine(const Ctx& c, float* lds) {
  unsigned char* ws = c.ws;
  const int tid = phase_tid(), lane = tid & 63, wave = tid >> 6;
  int* offs = (int*)lds; int* cnts = offs + 65;
  expert_offsets(c, offs, cnts, tid);
  const unsigned char* Y = (const unsigned char*)(ws + WS_Y); const unsigned* TSLOT = (const unsigned*)(ws + WS_TSLOT);
  const float* g2 = c.in[23]; const float* b2 = c.in[24];
  for (int t = blockIdx.x * NWAVES + wave; t < T; t += gridDim.x * NWAVES) {
    const unsigned s0 = TSLOT[(size_t)t * 2], s1 = TSLOT[(size_t)t * 2 + 1];
    const size_t r0 = (size_t)offs[s0 >> 16] + (s0 & 0xffffu), r1 = (size_t)offs[s1 >> 16] + (s1 & 0xffffu);
    f32x4* row = (f32x4*)(c.out + (size_t)t * 1024); const u32x2* xrow = (const u32x2*)((const bf16_t*)(ws + WS_X1B) + (size_t)t * 1024);
    f32x4 v[4]; float s = 0.f;
#pragma unroll
    for (int j = 0; j < 4; ++j) { const unsigned ya = ((const unsigned*)(Y + r0 * 1024))[lane + 64 * j], yb = ((const unsigned*)(Y + r1 * 1024))[lane + 64 * j];
      f32x4 x = bf4(xrow[lane + 64 * j]) * ALPHA;
      const hw_f32x2 a01 = __builtin_amdgcn_cvt_pk_f32_fp8(ya, false), a23 = __builtin_amdgcn_cvt_pk_f32_fp8(ya, true), b01 = __builtin_amdgcn_cvt_pk_f32_fp8(yb, false), b23 = __builtin_amdgcn_cvt_pk_f32_fp8(yb, true);
      x.x += (a01.x + b01.x) * 0.015625f; x.y += (a01.y + b01.y) * 0.015625f; x.z += (a23.x + b23.x) * 0.015625f; x.w += (a23.y + b23.y) * 0.015625f;
      v[j] = x; s += (x.x + x.y) + (x.z + x.w); }
    const float mean = wave_sum(s) * (1.f / 1024.f); float s2 = 0.f;
#pragma unroll
    for (int j = 0; j < 4; ++j) { v[j] = v[j] - mean; s2 += (v[j].x * v[j].x + v[j].y * v[j].y) + (v[j].z * v[j].z + v[j].w * v[j].w); }
    const float rstd = rsqrtf(wave_sum(s2) * (1.f / 1024.f) + 1e-5f);
#pragma unroll
    for (int j = 0; j < 4; ++j) { const f32x4 g = ((const f32x4*)g2)[lane + 64 * j], bb = ((const f32x4*)b2)[lane + 64 * j]; row[lane + 64 * j] = v[j] * rstd * g + bb; }
  }
}

constexpr int NPHASE = 11;
__global__ void __launch_bounds__(NTHREADS, 2) mega(Ctx c) {
  float* lds = (float*)lds_raw;
  unsigned* ctl = (unsigned*)(c.ws + WS_CTL);
  unsigned* bar = ctl + CW_BAR;
  if (threadIdx.x == 0) { *(volatile unsigned*)(lds_raw + LDS_WCTR) = 0u; *(volatile unsigned*)(lds_raw + LDS_XBST) = 0u; *(volatile unsigned*)(lds_raw + LDS_XBST + 4) = 0u;
    (void)xb_add(&bar[XB_XCNT(xb_xcc_id())], 1u); }
  __syncthreads();
  phase_prologue(c, lds);
  xcd_barrier(bar);
  phase_inproj_mfma(c, (lds_u8*)lds_raw);
  phase_tiles_queue(c, lds, ctl + CW_Q + 48, TP_WD0 - TP_D1, TP_WD0);
  xcd_barrier(bar);
  phase_gdn_prep2(c, lds_raw);
  phase_kvup(c, lds);
  phase_topk_mfma(c, lds_raw, ctl + CW_Q);
  xcd_barrier(bar);
  if (blockIdx.x < 48) phase_gdn_scan(c, lds_raw, blockIdx.x);
  phase_attn_sparse(c, lds_raw, ctl + CW_Q + 16);
  phase_attn_mem(c, lds_raw, ctl + CW_Q + 32);
  xcd_barrier(bar);
  phase_outproj_mfma(c, (lds_u8*)lds_raw);
  xcd_barrier(bar);
  phase_router(c, lds_raw);
  xcd_barrier(bar);
  phase_moe_up_mfma(c, (lds_u8*)lds_raw);
  phase_tiles_queue(c, lds, ctl + CW_Q + 64, TP_WD0, TP_TOTAL);
  xcd_barrier(bar);
  phase_moe_down_mfma(c, (lds_u8*)lds_raw);
  xcd_barrier(bar);
  phase_combine(c, lds);
}

extern "C" void kernel_launch(void* const* d_in, const int* in_sizes, int n_in, void* d_out, int out_size, void* d_ws, size_t ws_size, hipStream_t stream) {
  static int grid = 0;
  if (grid == 0) {
    if (n_in != 25 || ws_size < WS_END) { fprintf(stderr, "kernel_launch: unexpected n_in %d / ws %zu\n", n_in, ws_size); grid = -1; return; }
    int dev = 0, cus = 0, per_cu = 0;
    hipGetDevice(&dev); hipDeviceGetAttribute(&cus, hipDeviceAttributeMultiprocessorCount, dev);
    hipFuncSetAttribute((const void*)mega, hipFuncAttributeMaxDynamicSharedMemorySize, LDS_BYTES);
    hipOccupancyMaxActiveBlocksPerMultiprocessor(&per_cu, (const void*)mega, NTHREADS, LDS_BYTES);
    if (per_cu < 1) { fprintf(stderr, "kernel_launch: occupancy query says %d blocks/CU\n", per_cu); per_cu = 1; }
    grid = cus * (per_cu < 1 ? 1 : 1);
    (void)hipGetLastError();
  }
  if (grid < 0) return;
  hipMemsetAsync((char*)d_ws + WS_CTL, 0, 32 * 1024, stream);
  Ctx c; memset(&c, 0, sizeof(c));
  for (int i = 0; i < 25; ++i) c.in[i] = (const float*)d_in[i];
  c.out = (float*)d_out; c.ws = (unsigned char*)d_ws;
  hipLaunchKernelGGL(mega, dim3(grid), dim3(NTHREADS), LDS_BYTES, stream, c);
}
```

```cpp
#include <hip/hip_runtime.h>
#include <cstdio>
#include <cstdint>
#include <cstring>

#ifndef ONE_LAUNCH
#define ONE_LAUNCH 1
#endif

typedef unsigned short bf16_t;
typedef float f32x4 __attribute__((ext_vector_type(4)));
typedef unsigned u32x4 __attribute__((ext_vector_type(4)));
typedef unsigned u32x2 __attribute__((ext_vector_type(2)));

constexpr int T = 32768, DM = 1024, SEQ = 4096, NBATCH = 8;
constexpr int NIN = 2816;
constexpr int NMEM = 256, TM = NBATCH * NMEM;
constexpr int NEXP = 64, DE = 256;
constexpr int NTHREADS = 512, NWAVES = 8;
constexpr float ALPHA = 1.189207115002721f;
constexpr float LOG2E = 1.4426950408889634f;
constexpr float QSCALE = 0.125f * LOG2E;

constexpr size_t MiB = 1ull << 20;
constexpr size_t WS_CTL = 0;
constexpr size_t WS_TSLOT = 512 * 1024;
constexpr size_t WS_ROPE = 1 * MiB;
constexpr size_t WS_WKV = 2 * MiB;
constexpr size_t WS_WR = 2 * MiB + 65536;
constexpr size_t WS_WIN = 3 * MiB;
constexpr size_t WS_WO = 9 * MiB;
constexpr size_t WS_WMKV = 11 * MiB;
constexpr size_t WS_MEMB = 12 * MiB;
constexpr size_t WS_WGU = 16 * MiB;
constexpr size_t WS_WD = 80 * MiB;
constexpr size_t WS_XB = 112 * MiB;
constexpr size_t WS_QA = 176 * MiB;
constexpr size_t WS_CKV = 200 * MiB;
constexpr size_t WS_IQ = 208 * MiB;
constexpr size_t WS_IK = 224 * MiB;
constexpr size_t WS_SM = 228 * MiB;
constexpr size_t WS_QC = 230 * MiB;
constexpr size_t WS_GB = 246 * MiB;
constexpr size_t WS_X1F = WS_GB;
constexpr float W8SCALE = 32.f, H8SCALE = 8.f;
constexpr size_t WS_MK = 342 * MiB;
constexpr size_t WS_MVT = 343 * MiB;
constexpr size_t WS_KVA = 344 * MiB;
constexpr size_t WS_SEL = 352 * MiB;
constexpr size_t WS_CAT = 368 * MiB;
constexpr size_t WS_X1B = 432 * MiB;
constexpr size_t WS_LIST = 496 * MiB;
constexpr size_t WS_GATEL = 504 * MiB;
constexpr size_t WS_END = 512 * MiB;
constexpr size_t WS_H = 112 * MiB;
constexpr size_t WS_Y = 160 * MiB;

constexpr int CW_CNT = 0;
constexpr int CW_Q = 64;
constexpr int CW_BAR = 4096;

struct Ctx {
  const float* in[25];
  float* out;
  unsigned char* ws;
  int ph_lo, ph_hi;
};


extern __shared__ __attribute__((aligned(16))) unsigned char lds_raw[];
constexpr int LDS_BYTES = 157696;
constexpr int LDS_WCTR = LDS_BYTES - 64;
__device__ __forceinline__ int phase_tid() {
  __syncthreads();
  int l; asm volatile("v_mbcnt_lo_u32_b32 %0, -1, 0\n\tv_mbcnt_hi_u32_b32 %0, -1, %0" : "=v"(l));
  unsigned w = 0u;
  if (l == 0) w = __hip_atomic_fetch_add((__attribute__((address_space(3))) unsigned*)(__attribute__((address_space(3))) unsigned char*)(lds_raw + LDS_WCTR), 1u, __ATOMIC_RELAXED, __HIP_MEMORY_SCOPE_WORKGROUP);
  w = (unsigned)__builtin_amdgcn_readfirstlane((int)w) & 7u;
  return (int)(w * 64u) + l;
}


#define XB_TMO      128
#define XB_XCNT(j)  (256  + 64 * (j))
#define XB_XSUB(j)  (1280 + 64 * (j))
#define XB_XGEN(j)  (2304 + 64 * (j))
#define XB_TOP      3328
#define XB_TOPGEN   3392
#define XCD_BAR_WORDS 3456
#define XB_SPIN_CAP (1u << 18)
constexpr int LDS_XBST = LDS_BYTES - 32;
__device__ __forceinline__ unsigned xb_ld(unsigned* p)              { return __hip_atomic_load(p, __ATOMIC_RELAXED, __HIP_MEMORY_SCOPE_AGENT); }
__device__ __forceinline__ unsigned xb_add(unsigned* p, unsigned v) { return __hip_atomic_fetch_add(p, v, __ATOMIC_RELAXED, __HIP_MEMORY_SCOPE_AGENT); }
__device__ __forceinline__ unsigned xb_xcc_id() { return (unsigned)__builtin_amdgcn_s_getreg((3 << 11) | 20) & 0xFu; }
#define XB_SPIN(cond, bar) do { unsigned _sp = 0; while (cond) { __builtin_amdgcn_s_sleep(1); \
    if ((++_sp & 255u) == 0u) { if (xb_ld(&(bar)[XB_TMO])) break; if (_sp > XB_SPIN_CAP) { atomicAdd(&(bar)[XB_TMO], 1u); break; } } } } while (0)
__device__ __forceinline__ void xcd_barrier_complete(unsigned* bar, unsigned x, unsigned& nloc, unsigned& nx) {
    const unsigned G = gridDim.x;
    unsigned sum, cnt, mine, sp = 0u;
    for (;;) {
        sum = 0u; cnt = 0u; mine = 0u;
#pragma unroll
        for (unsigned j = 0; j < 16; ++j) { const unsigned cc = xb_ld(&bar[XB_XCNT(j)]); sum += cc; cnt += (cc > 0u) ? 1u : 0u; mine = (j == x) ? cc : mine; }
        if (sum == G) break;
        __builtin_amdgcn_s_sleep(1);
        if ((++sp & 255u) == 0u) { if (xb_ld(&bar[XB_TMO])) break; if (sp > XB_SPIN_CAP) { atomicAdd(&bar[XB_TMO], 1u); break; } }
    }
    nloc = mine > 0u ? mine : 1u; nx = cnt > 0u ? cnt : 1u;
}
__device__ __forceinline__ void xcd_barrier(unsigned* bar) {
    asm volatile("s_waitcnt vmcnt(0)" ::: "memory");
    __syncthreads();
    const int btid = phase_tid();
    if (btid == 0) {
        volatile __attribute__((address_space(3))) unsigned* st = (volatile __attribute__((address_space(3))) unsigned*)(__attribute__((address_space(3))) unsigned char*)(lds_raw + LDS_XBST);
        const unsigned x = xb_xcc_id();
        __builtin_amdgcn_s_waitcnt(0);
        unsigned nloc = st[0], nx = st[1];
        if (nloc == 0u) { xcd_barrier_complete(bar, x, nloc, nx); st[0] = nloc; st[1] = nx; }
        const unsigned old = xb_add(&bar[XB_XSUB(x)], 1u);
        const unsigned gen = old / nloc;
        if (old + 1u == (gen + 1u) * nloc) {
            __builtin_amdgcn_fence(__ATOMIC_RELEASE, "agent");
            asm volatile("s_waitcnt vmcnt(0)" ::: "memory");
            const unsigned og = xb_add(&bar[XB_TOP], 1u);
            const unsigned tg = og / nx;
            if (og + 1u == (tg + 1u) * nx) xb_add(&bar[XB_TOPGEN], 1u);
            else XB_SPIN(xb_ld(&bar[XB_TOPGEN]) == tg, bar);
            __builtin_amdgcn_fence(__ATOMIC_ACQUIRE, "agent");
            xb_add(&bar[XB_XGEN(x)], 1u);
            asm volatile("s_waitcnt vmcnt(0)" ::: "memory");
        } else {
            XB_SPIN(xb_ld(&bar[XB_XGEN(x)]) == gen, bar);
            __builtin_amdgcn_fence(__ATOMIC_ACQUIRE, "agent");
            asm volatile("s_waitcnt vmcnt(0)" ::: "memory");
        }
    }
    __syncthreads();
}

__device__ __forceinline__ float bf2f(bf16_t v) { return __uint_as_float(((unsigned)v) << 16); }
typedef float hw_f32x2 __attribute__((ext_vector_type(2))); typedef __bf16 hw_bf16x2 __attribute__((ext_vector_type(2)));
__device__ __forceinline__ unsigned pk2(float lo, float hi) { const hw_f32x2 v = {lo, hi}; const hw_bf16x2 b = __builtin_convertvector(v, hw_bf16x2); return __builtin_bit_cast(unsigned, b); }
__device__ __forceinline__ unsigned cvt4_fp8(float a, float b, float c2, float d) { int w = __builtin_amdgcn_cvt_pk_fp8_f32(a, b, 0, false); w = __builtin_amdgcn_cvt_pk_fp8_f32(c2, d, w, true); return (unsigned)w; }
__device__ __forceinline__ long mk64(unsigned lo, unsigned hi) { return (long)(((unsigned long)hi << 32) | (unsigned long)lo); }
__device__ __forceinline__ bf16_t f2bf(float f) { return (bf16_t)(pk2(f, f) & 0xffffu); }
__device__ __forceinline__ float wave_sum(float v) {
  int x = __float_as_int(v);
  x = __float_as_int(__int_as_float(x) + __int_as_float(__builtin_amdgcn_update_dpp(0, x, 0x111, 0xF, 0xF, true)));
  x = __float_as_int(__int_as_float(x) + __int_as_float(__builtin_amdgcn_update_dpp(0, x, 0x112, 0xF, 0xF, true)));
  x = __float_as_int(__int_as_float(x) + __int_as_float(__builtin_amdgcn_update_dpp(0, x, 0x114, 0xF, 0xF, true)));
  x = __float_as_int(__int_as_float(x) + __int_as_float(__builtin_amdgcn_update_dpp(0, x, 0x118, 0xF, 0xF, true)));
  x = __float_as_int(__int_as_float(x) + __int_as_float(__builtin_amdgcn_update_dpp(0, x, 0x142, 0xA, 0xF, false)));
  x = __float_as_int(__int_as_float(x) + __int_as_float(__builtin_amdgcn_update_dpp(0, x, 0x143, 0xC, 0xF, false)));
  return __int_as_float(__builtin_amdgcn_readlane(x, 63));
}
__device__ __forceinline__ float wave_max(float v) {
#pragma unroll
  for (int o = 32; o >= 1; o >>= 1) v = fmaxf(v, __shfl_xor(v, o));
  return v;
}
__device__ __forceinline__ float silu_f(float v) { return v * __builtin_amdgcn_rcpf(1.f + __expf(-v)); }

__device__ __forceinline__ int ropeperm(int p) { return (p >> 1) + 32 * (p & 1); }
__device__ __forceinline__ int colmap_in(int cp) {
  const int tile = cp >> 8, w = cp & 255;
  if (tile == 0) return (w >> 6) * 64 + ropeperm(w & 63);
  if (tile == 1) { if (w < 128) { const int c = 256 + w; return (c >> 6) * 64 + ropeperm(c & 63); } return 384 + (w - 128); }
  if (tile == 2) return 512 + (w >> 6) * 64 + ropeperm(w & 63);
  if (tile == 3) { if (w < 64) return 768 + ropeperm(w); if (w < 68) return 832 + (w - 64); if (w < 74) return 2372 + (w - 68); if (w < 80) return 2378 + (w - 74); return -1; }
  if (tile == 4) return 2384 + w;
  return 836 + (cp - 1280);
}

struct WorkQ { unsigned* head; volatile int* slot; int nxt; };
__device__ __forceinline__ void wq_init(WorkQ& q, unsigned* head, volatile int* slot, int tid) { q.head = head; q.slot = slot; q.nxt = 0; if (tid == 0) q.nxt = (int)atomicAdd(head, 1u); }
__device__ __forceinline__ int wq_next(WorkQ& q, int tid) {
  __syncthreads();
  if (tid == 0) { *q.slot = q.nxt; q.nxt = (int)atomicAdd(q.head, 1u); }
  __syncthreads();
  return *q.slot;
}

template <bool F8 = false, class CM>
__device__ __forceinline__ void tp_tile(const float* src, int ld, bf16_t* dst, int drow0, int K, int k0, CM cm, float* lds, int tid, float sc8 = 1.f) {
  const int a = tid & 63, b = tid >> 6;
  const int sc = cm(a);
  __syncthreads();
#pragma unroll
  for (int i = 0; i < 8; ++i) { const int kk = b * 8 + i; lds[kk * 65 + a] = sc >= 0 ? src[(size_t)(k0 + kk) * ld + sc] : 0.f; }
  __syncthreads();
  { const int nn = tid >> 3, kc = (tid & 7) * 8;
    const float* p = lds + kc * 65 + nn;
    if constexpr (F8) *(u32x2*)((unsigned char*)dst + (size_t)(drow0 + nn) * K + k0 + kc) = (u32x2){cvt4_fp8(p[0] * sc8, p[65] * sc8, p[130] * sc8, p[195] * sc8), cvt4_fp8(p[260] * sc8, p[325] * sc8, p[390] * sc8, p[455] * sc8)};
    else *(u32x4*)(dst + (size_t)(drow0 + nn) * K + k0 + kc) = (u32x4){pk2(p[0], p[65]), pk2(p[130], p[195]), pk2(p[260], p[325]), pk2(p[390], p[455])}; }
}

constexpr int TP_TOTAL = (NIN / 64) * 16 + 16 * 16 + 8 * 16 + 64 * 8 * 16 + 64 * 16 * 4;
constexpr int TP_WD0 = TP_TOTAL - 64 * 16 * 4;
constexpr int TP_D1 = 5200;
__device__ __forceinline__ void prologue_tiles(const Ctx& c, float* lds, int tid, int lo, int hi, int b0, int nb) {
  unsigned char* ws = c.ws;
  const int n_win = (NIN / 64) * 16, n_wo = 16 * 16, n_wmkv = 8 * 16, n_wgu = 64 * 8 * 16, n_wd = 64 * 16 * 4;
  const int total = n_win + n_wo + n_wmkv + n_wgu + n_wd;
  for (int it = lo + b0; it < hi; it += nb) {
    int r = it;
    if (r < n_win) { const int nt = r / 16, kt = r % 16; tp_tile(c.in[2], 2640, (bf16_t*)(ws + WS_WIN), nt * 64, 1024, kt * 64, [&](int a) { return colmap_in(nt * 64 + a); }, lds, tid); continue; } r -= n_win;
    if (r < n_wo) { const int nt = r / 16, kt = r % 16; tp_tile(c.in[13], 1024, (bf16_t*)(ws + WS_WO), nt * 64, 1024, kt * 64, [&](int a) { return nt * 64 + a; }, lds, tid); continue; } r -= n_wo;
    if (r < n_wmkv) { const int nt = r / 16, kt = r % 16; tp_tile(c.in[12], 512, (bf16_t*)(ws + WS_WMKV), nt * 64, 1024, kt * 64, [&](int a) { return nt * 64 + a; }, lds, tid); continue; } r -= n_wmkv;
    if (r < n_wgu) { const int e = r / 128, q = r % 128, nt = q / 16, kt = q % 16;
      const int pn = nt >> 2, sub = nt & 3, isup = sub >> 1, c0 = pn * 128 + (sub & 1) * 64;
      const float* src = (isup ? c.in[21] : c.in[20]) + (size_t)e * 1024 * 256;
      tp_tile<true>(src, 256, (bf16_t*)(ws + WS_WGU), e * 512 + nt * 64, 1024, kt * 64, [&](int a) { return c0 + a; }, lds, tid, W8SCALE); continue; } r -= n_wgu;
    { const int e = r / 64, q = r % 64, nt = q / 4, kt = q % 4;
      tp_tile<true>(c.in[22] + (size_t)e * 256 * 1024, 1024, (bf16_t*)(ws + WS_WD), e * 1024 + nt * 64, 256, kt * 64, [&](int a) { return nt * 64 + a; }, lds, tid, W8SCALE); }
  }
}

__device__ void phase_tiles_queue(const Ctx& c, float* lds, unsigned* qhead, int lo, int hi) {
  const int tid = phase_tid();
  volatile int* slot = (volatile int*)(lds + 64 * 65 + 16);
  WorkQ wq; wq_init(wq, qhead, slot, tid);
  const int nitems = (hi - lo + 7) >> 3;
  for (;;) {
    const int item = wq_next(wq, tid);
    if (item >= nitems) break;
    const int t0 = lo + item * 8, t1 = t0 + 8 < hi ? t0 + 8 : hi;
    prologue_tiles(c, lds, tid, t0, t1, 0, 1);
  }
}

__device__ void phase_prologue(const Ctx& c, float* lds) {
  const int tid = phase_tid(), bid = blockIdx.x, G = gridDim.x;
  unsigned char* ws = c.ws;
  const size_t gtid = (size_t)bid * NTHREADS + tid, gstride = (size_t)G * NTHREADS;
  { const f32x4* x4 = (const f32x4*)c.in[0]; u32x2* o = (u32x2*)c.out;
    for (size_t i = gtid; i < (size_t)T * DM / 4; i += gstride) { const f32x4 v = x4[i]; o[i] = (u32x2){pk2(v.x, v.y), pk2(v.z, v.w)}; }
    const f32x4* m4 = (const f32x4*)c.in[1]; u32x2* om = (u32x2*)(ws + WS_MEMB);
    for (size_t i = gtid; i < (size_t)TM * DM / 4; i += gstride) { const f32x4 v = m4[i]; om[i] = (u32x2){pk2(v.x, v.y), pk2(v.z, v.w)}; } }
  { float* cs = (float*)(ws + WS_ROPE); float* sn = cs + SEQ * 32;
    for (size_t i = gtid; i < (size_t)SEQ * 32; i += gstride) { const int s = (int)(i >> 5), d = (int)(i & 31);
      const float inv = 1.0f / powf(10000.0f, (float)d / 32.0f); const float ang = (float)s * inv; float sv, cv; sincosf(ang, &sv, &cv); cs[i] = cv; sn[i] = sv; } }
  { bf16_t* wkv = (bf16_t*)(ws + WS_WKV); const float* g = c.in[3]; const float* wk = c.in[4]; const float* wv = c.in[5];
    for (size_t i = gtid; i < 128 * 128; i += gstride) { const int p = (int)(i >> 7), k = (int)(i & 127);
      const float w = p < 64 ? wk[k * 64 + ropeperm(p)] : wv[k * 64 + (p - 64)]; wkv[i] = f2bf(w * g[k]); }
    bf16_t* wr = (bf16_t*)(ws + WS_WR); const float* wg = c.in[16]; const float* wrt = c.in[18];
    for (size_t i = gtid; i < 80 * 1024; i += gstride) { const int o = (int)(i >> 10), k = (int)(i & 1023); wr[i] = f2bf(o < 8 ? wg[k * 8 + o] : o < 72 ? wrt[k * 64 + (o - 8)] : 0.f); } }
  prologue_tiles(c, lds, tid, 0, TP_WD0 - TP_D1, bid, G);
}

__device__ __forceinline__ void expert_offsets(const Ctx& c, int* offs  , int* cnts  , int tid) {
  const unsigned* ctl = (const unsigned*)(c.ws + WS_CTL);
  __syncthreads();
  if (tid == 0) { int o = 0; for (int e = 0; e < 64; ++e) { const int n = (int)ctl[CW_CNT + e]; cnts[e] = n; offs[e] = o; o += (n + 255) & ~255; } offs[64] = o; }
  __syncthreads();
}


namespace pg8 {
#define PG8_LAS __attribute__((address_space(3)))
typedef short bf16x8 __attribute__((ext_vector_type(8)));
constexpr int BM = 256, BK = 64, HALF = 128, HTB = HALF * BK * 2, STAGE_BYTES = 8 * HTB, NXCD = 8, WGM = 8;
__host__ __device__ __forceinline__ int lds_byte(int r, int c) { const int st = (r >> 4) * 2 + (c >> 5), rr = r & 15, cc = c & 31, ob = rr * 64 + cc * 2; return st * 1024 + (ob ^ (((ob >> 9) & 1) << 5)); }
__host__ __device__ __forceinline__ void stage_rc(int b, int& R, int& C) { const int st = b / 1024, sb = b % 1024, swz = sb ^ (((sb >> 9) & 1) << 5); R = (st >> 1) * 16 + swz / 64; C = (st & 1) * 32 + (swz % 64) / 2; }
__host__ __device__ __forceinline__ int perm32(int rho) { const int n = rho >> 4, i = rho & 15; return 8 * (i >> 2) + 4 * n + (i & 3); }
typedef int i32x4v __attribute__((ext_vector_type(4))); typedef int i32x8 __attribute__((ext_vector_type(8))); typedef long i64x2 __attribute__((ext_vector_type(2)));
struct Unit { int pm, pn, e, mt, aux; };
struct Gemm { const bf16_t* A; const bf16_t* Bt; int K; };
struct StaticOrder {
    int nM, nN, nwg, G, c;
    __device__ void init(int M, int N, int G_, int c_) { nM = M / BM; nN = N / BM; nwg = nM * nN; G = G_; c = c_; }
    __device__ bool next(int i, Unit& u) const {
        const long L = (long)i * G + c; if (c < 0 || L >= nwg) return false;
        int wgid = (int)L; { const int q = nwg / NXCD, r = nwg % NXCD, xcd = wgid % NXCD, off = wgid / NXCD; wgid = (xcd < r ? xcd * (q + 1) : r * (q + 1) + (xcd - r) * q) + off; }
        const int nig = WGM * nN, gid = wgid / nig, fm = gid * WGM, gsz = (nM - fm) < WGM ? (nM - fm) : WGM;
        u.pm = fm + ((wgid % nig) % gsz); u.pn = (wgid % nig) / gsz; u.e = 0; u.mt = 0; u.aux = 0; return true;
    }
    __device__ __forceinline__ unsigned arow(const Unit&, int) const { return 0u; }
};
__device__ __forceinline__ unsigned cvt_pk_bf16(float lo, float hi) { unsigned r; asm volatile("v_cvt_pk_bf16_f32 %0, %1, %2" : "=v"(r) : "v"(lo), "v"(hi)); return r; }

template <class Epi, class Sched, bool ALIGN_EPI, bool GATHER, int FP8 = 0>
__device__ __forceinline__ void gemm_phase(PG8_LAS unsigned char* lds, const Gemm g, const Sched& S, const Epi& E, const int tid) {
    const int wid = __builtin_amdgcn_readfirstlane(tid >> 6), lane = tid & 63, wr = wid >> 2, wc = wid & 3, fr = lane & 15, fq = lane >> 4;
    const int K = g.K, nt = K / BK;
    unsigned voffA[2], voffB[2]; int RA[2], CA[2];
#pragma unroll
    for (int i = 0; i < 2; ++i) { int R, C; stage_rc(tid * 16 + i * 8192, R, C); const int Rb = Epi::PERM ? ((R & ~31) + perm32(R & 31)) : R;
        RA[i] = R; CA[i] = C; voffA[i] = (unsigned)(R * K + C) * 2u; voffB[i] = (unsigned)(Rb * K + C) * 2u; }
    const size_t kstep = (size_t)(BK * 2);
    const size_t hstep = (size_t)HALF * K * 2;
    const size_t tstep = 2 * hstep;
    const unsigned ldsw = (unsigned)wid * 1024u;
    const int aoff = lds_byte(wr * 64 + fr, fq * 8), boff = lds_byte(wc * 32 + fr, fq * 8);
#define PG8_SA(b, h) (((b) * 2 + (h)) * HTB)
#define PG8_SB(b, h) ((4 + (b) * 2 + (h)) * HTB)
#define PG8_STAGE(bufoff, gbase, voff) do { _Pragma("unroll") for (int _i = 0; _i < 2; ++_i) \
        __builtin_amdgcn_global_load_lds((const unsigned*)((const char*)(gbase) + (voff)[_i]), (PG8_LAS unsigned*)(lds + (bufoff) + ldsw + _i * 8192), 16, 0, 0); } while (0)
#define PG8_STAGE_A(bufoff, gbase, h, goff) do { if constexpr (GATHER) { PG8_STAGE(bufoff, gbase, (goff)[h]); } else { PG8_STAGE(bufoff, (gbase) + (h) * hstep, voffA); } } while (0)
#define PG8_LDA(dst, b, h) do { _Pragma("unroll") for (int m = 0; m < 4; ++m) _Pragma("unroll") for (int k = 0; k < 2; ++k) dst[m][k] = *(const PG8_LAS bf16x8*)(lds + PG8_SA(b, h) + aoff + m * 2048 + k * 1024); } while (0)
#define PG8_LDB(dst, b, h) do { _Pragma("unroll") for (int n = 0; n < 2; ++n) _Pragma("unroll") for (int k = 0; k < 2; ++k) dst[n][k] = *(const PG8_LAS bf16x8*)(lds + PG8_SB(b, h) + boff + n * 2048 + k * 1024); } while (0)
#define PG8_MMA(ai, bj, At, Bt) do { __builtin_amdgcn_s_setprio(1); \
        if constexpr (FP8 == 2) { _Pragma("unroll") for (int m = 0; m < 4; ++m) _Pragma("unroll") for (int n = 0; n < 2; ++n) { \
            const i32x8 b_ = __builtin_shufflevector(__builtin_bit_cast(i32x4v, Bt[n][0]), __builtin_bit_cast(i32x4v, Bt[n][1]), 0, 1, 2, 3, 4, 5, 6, 7), a_ = __builtin_shufflevector(__builtin_bit_cast(i32x4v, At[m][0]), __builtin_bit_cast(i32x4v, At[m][1]), 0, 1, 2, 3, 4, 5, 6, 7); \
            acc[ai][bj][m][n] = __builtin_amdgcn_mfma_scale_f32_16x16x128_f8f6f4(b_, a_, acc[ai][bj][m][n], 0, 0, 0, 0, 0, 0); } } \
        else if constexpr (FP8 == 1) { _Pragma("unroll") for (int k = 0; k < 2; ++k) _Pragma("unroll") for (int hf = 0; hf < 2; ++hf) _Pragma("unroll") for (int m = 0; m < 4; ++m) _Pragma("unroll") for (int n = 0; n < 2; ++n) { \
            const i64x2 b_ = __builtin_bit_cast(i64x2, Bt[n][k]), a_ = __builtin_bit_cast(i64x2, At[m][k]); \
            acc[ai][bj][m][n] = __builtin_amdgcn_mfma_f32_16x16x32_fp8_fp8(b_[hf], a_[hf], acc[ai][bj][m][n], 0, 0, 0); } } \
        else { _Pragma("unroll") for (int m = 0; m < 4; ++m) _Pragma("unroll") for (int n = 0; n < 2; ++n) _Pragma("unroll") for (int k = 0; k < 2; ++k) \
            acc[ai][bj][m][n] = __builtin_amdgcn_mfma_f32_16x16x32_bf16(Bt[n][k], At[m][k], acc[ai][bj][m][n], 0, 0, 0); } \
        __builtin_amdgcn_s_setprio(0); } while (0)
#define PG8_WAIT_V(n) asm volatile("s_waitcnt vmcnt(" #n ")" ::: "memory")
#define PG8_WAIT_L(n) asm volatile("s_waitcnt lgkmcnt(" #n ")" ::: "memory")
#define PG8_BAR __builtin_amdgcn_s_barrier()
#define PG8_SCHED __builtin_amdgcn_sched_barrier(0)
    Unit cur, nxt; int ui = 0;
    if (!S.next(0, cur)) return;
    f32x4 acc[2][2][4][2];
#pragma unroll
    for (int a = 0; a < 2; ++a)
#pragma unroll
        for (int b = 0; b < 2; ++b)
#pragma unroll
            for (int m = 0; m < 4; ++m)
#pragma unroll
                for (int n = 0; n < 2; ++n) acc[a][b][m][n] = (f32x4){0.f, 0.f, 0.f, 0.f};
    bf16x8 At[4][2], B0[2][2], B1[2][2];
    unsigned gc[2][2], gn[2][2];
    const char* cA; const char* cB = (const char*)g.Bt + (size_t)cur.pn * tstep;
    if constexpr (GATHER) { cA = (const char*)g.A;
#pragma unroll
        for (int h = 0; h < 2; ++h)
#pragma unroll
            for (int i = 0; i < 2; ++i) { gc[h][i] = (S.arow(cur, h * HALF + RA[i]) * (unsigned)K + (unsigned)CA[i]) * 2u; gn[h][i] = gc[h][i]; }
    } else { cA = (const char*)g.A + (size_t)cur.pm * tstep; }
    PG8_STAGE(PG8_SB(0, 0), cB, voffB); PG8_STAGE(PG8_SB(0, 1), cB + hstep, voffB); PG8_STAGE_A(PG8_SA(0, 0), cA, 0, gc); PG8_STAGE_A(PG8_SA(0, 1), cA, 1, gc);
    if (wr == 1) PG8_BAR;
    PG8_WAIT_V(2); PG8_BAR;
    PG8_STAGE(PG8_SB(1, 0), cB + kstep, voffB); PG8_STAGE_A(PG8_SA(1, 0), cA + kstep, 0, gc); PG8_STAGE(PG8_SB(1, 1), cB + hstep + kstep, voffB);
    PG8_WAIT_V(6); PG8_BAR;
    for (;;) {
        const bool has_next = S.next(ui + 1, nxt);
        const char* nA; const char* nB = has_next ? (const char*)g.Bt + (size_t)nxt.pn * tstep : cB;
        if constexpr (GATHER) { nA = cA;
            if (has_next) {
#pragma unroll
                for (int h = 0; h < 2; ++h)
#pragma unroll
                    for (int i = 0; i < 2; ++i) gn[h][i] = (S.arow(nxt, h * HALF + RA[i]) * (unsigned)K + (unsigned)CA[i]) * 2u; }
        } else { nA = has_next ? (const char*)g.A + (size_t)nxt.pm * tstep : cA; }
#pragma unroll 1
        for (int t = 0; t < nt; t += 2) {
            const bool last = (t == nt - 2);
            const char* a1 = cA + (size_t)(t + 1) * kstep;
            const char* a2 = last ? nA : cA + (size_t)(t + 2) * kstep; const char* b2 = last ? nB : cB + (size_t)(t + 2) * kstep;
            const char* a3 = a2 + kstep; const char* b3 = b2 + kstep;
            unsigned g2[2][2];
            if constexpr (GATHER) {
#pragma unroll
            for (int h = 0; h < 2; ++h)
#pragma unroll
                for (int i = 0; i < 2; ++i) g2[h][i] = last ? gn[h][i] : gc[h][i]; }
            PG8_LDB(B0, 0, 0); PG8_LDB(B1, 0, 1); PG8_SCHED; PG8_LDA(At, 0, 0); PG8_STAGE_A(PG8_SA(1, 1), a1, 1, gc);
            PG8_WAIT_V(8); PG8_WAIT_L(0); PG8_BAR; PG8_MMA(0, 0, At, B0); PG8_MMA(0, 1, At, B1); PG8_BAR; PG8_SCHED;
            PG8_LDA(At, 0, 1); PG8_STAGE(PG8_SB(0, 0), b2, voffB); PG8_STAGE(PG8_SB(0, 1), b2 + hstep, voffB); PG8_STAGE_A(PG8_SA(0, 0), a2, 0, g2);
            PG8_WAIT_V(8); PG8_WAIT_L(0); PG8_BAR; PG8_MMA(1, 0, At, B0); PG8_MMA(1, 1, At, B1); PG8_BAR; PG8_SCHED;
            PG8_LDB(B0, 1, 0); PG8_LDB(B1, 1, 1); PG8_SCHED; PG8_LDA(At, 1, 0); PG8_STAGE_A(PG8_SA(0, 1), a2, 1, g2);
            PG8_WAIT_V(8); PG8_WAIT_L(0); PG8_BAR; PG8_MMA(0, 0, At, B0); PG8_MMA(0, 1, At, B1); PG8_BAR; PG8_SCHED;
            PG8_LDA(At, 1, 1); PG8_STAGE(PG8_SB(1, 0), b3, voffB); PG8_STAGE(PG8_SB(1, 1), b3 + hstep, voffB); PG8_STAGE_A(PG8_SA(1, 0), a3, 0, g2);
            PG8_WAIT_V(8); PG8_WAIT_L(0); PG8_BAR; PG8_MMA(1, 0, At, B0); PG8_MMA(1, 1, At, B1); PG8_BAR; PG8_SCHED;
        }
        if constexpr (ALIGN_EPI) { if (wr == 0) PG8_BAR; }
        E(acc, cur, wr, wc, fr, fq);
        if (!has_next) break;
#pragma unroll
        for (int a = 0; a < 2; ++a)
#pragma unroll
            for (int b = 0; b < 2; ++b)
#pragma unroll
                for (int m = 0; m < 4; ++m)
#pragma unroll
                    for (int n = 0; n < 2; ++n) acc[a][b][m][n] = (f32x4){0.f, 0.f, 0.f, 0.f};
        cur = nxt; cA = nA; cB = nB; ++ui;
        if constexpr (GATHER) {
#pragma unroll
        for (int h = 0; h < 2; ++h)
#pragma unroll
            for (int i = 0; i < 2; ++i) gc[h][i] = gn[h][i]; }
        if constexpr (ALIGN_EPI) { if (wr == 1) PG8_BAR; }
    }
    PG8_WAIT_V(0);
    if constexpr (!ALIGN_EPI) { if (wr == 0) PG8_BAR; }
    PG8_BAR;
#undef PG8_SA
#undef PG8_SB
#undef PG8_STAGE
#undef PG8_STAGE_A
#undef PG8_LDA
#undef PG8_LDB
#undef PG8_MMA
#undef PG8_WAIT_V
#undef PG8_WAIT_L
#undef PG8_BAR
#undef PG8_SCHED
}
}
typedef __attribute__((address_space(3))) unsigned char lds_u8;

__device__ __forceinline__ u32x4 pack8(const f32x4& a, const f32x4& b) { return (u32x4){pg8::cvt_pk_bf16(a.x, a.y), pg8::cvt_pk_bf16(a.z, a.w), pg8::cvt_pk_bf16(b.x, b.y), pg8::cvt_pk_bf16(b.z, b.w)}; }
struct EpiInM {
  static constexpr bool PERM = true;
  unsigned char* ws;
  __device__ __forceinline__ void operator()(const f32x4 (&acc)[2][2][4][2], const pg8::Unit& u, int wr, int wc, int fr, int fq) const {
    const float* cs = (const float*)(ws + WS_ROPE); const float* sn = cs + SEQ * 32;
    const int pn = u.pn;
#pragma unroll
    for (int ai = 0; ai < 2; ++ai)
#pragma unroll
      for (int m = 0; m < 4; ++m) {
        const int row = u.pm * 256 + ai * 128 + wr * 64 + m * 16 + fr, pos = row & (SEQ - 1);
#pragma unroll
        for (int bj = 0; bj < 2; ++bj) {
          const int w = bj * 128 + wc * 32 + 8 * fq;
          f32x4 v0 = acc[ai][bj][m][0], v1 = acc[ai][bj][m][1];
          const bool do_rope = (pn == 0) || (pn == 1 && bj == 0) || (pn == 2) || (pn == 3 && bj == 0 && wc < 2);
          if (do_rope) { const int d = (w & 63) >> 1; const f32x4 c4 = *(const f32x4*)(cs + pos * 32 + d), s4 = *(const f32x4*)(sn + pos * 32 + d);
            const f32x4 o0 = {v0.x * c4.x - v0.y * s4.x, v0.y * c4.x + v0.x * s4.x, v0.z * c4.y - v0.w * s4.y, v0.w * c4.y + v0.z * s4.y};
            const f32x4 o1 = {v1.x * c4.z - v1.y * s4.z, v1.y * c4.z + v1.x * s4.z, v1.z * c4.w - v1.w * s4.w, v1.w * c4.w + v1.z * s4.w};
            v0 = o0; v1 = o1; }
          if (pn == 0) { *(u32x4*)((bf16_t*)(ws + WS_QA) + (size_t)row * 384 + w) = pack8(v0 * QSCALE, v1 * QSCALE); }
          else if (pn == 1) { if (bj == 0) *(u32x4*)((bf16_t*)(ws + WS_QA) + (size_t)row * 384 + 256 + w) = pack8(v0 * QSCALE, v1 * QSCALE);
                              else *(u32x4*)((bf16_t*)(ws + WS_CKV) + (size_t)row * 128 + (w - 128)) = pack8(v0, v1); }
          else if (pn == 2) { *(u32x4*)((bf16_t*)(ws + WS_IQ) + (size_t)row * 256 + w) = pack8(v0, v1); }
          else if (pn == 3) { if (bj == 0) { if (wc < 2) *(u32x4*)((bf16_t*)(ws + WS_IK) + (size_t)row * 64 + w) = pack8(v0, v1);
                                             else if (wc == 2 && fq < 2) { if (fq == 0) v0 = v0 * 0.0625f; float* o = (float*)(ws + WS_SM) + (size_t)row * 16 + 8 * fq; *(f32x4*)o = v0; *(f32x4*)(o + 4) = v1; } } }
          else if (pn == 4) { *(u32x4*)((bf16_t*)(ws + WS_QC) + (size_t)row * 256 + w) = pack8(v0 * QSCALE, v1 * QSCALE); }
          else { *(u32x4*)((bf16_t*)(ws + WS_GB) + (size_t)row * 1536 + (pn - 5) * 256 + w) = pack8(v0, v1); }
        }
      }
  }
};
__device__ __forceinline__ unsigned pk4_fp8(const f32x4& v) { unsigned w = __builtin_amdgcn_cvt_pk_fp8_f32(v.x, v.y, 0u, false); return __builtin_amdgcn_cvt_pk_fp8_f32(v.z, v.w, w, true); }
struct EpiMemKVM {
  static constexpr bool PERM = true;
  unsigned char* ws;
  __device__ __forceinline__ void operator()(const f32x4 (&acc)[2][2][4][2], const pg8::Unit& u, int wr, int wc, int fr, int fq) const {
#pragma unroll
    for (int ai = 0; ai < 2; ++ai)
#pragma unroll
      for (int m = 0; m < 4; ++m) {
        const int row = u.pm * 256 + ai * 128 + wr * 64 + m * 16 + fr;
#pragma unroll
        for (int bj = 0; bj < 2; ++bj) {
          const int w = bj * 128 + wc * 32 + 8 * fq; const f32x4 v0 = acc[ai][bj][m][0], v1 = acc[ai][bj][m][1];
          const unsigned w0 = pk4_fp8(v0), w1 = pk4_fp8(v1);
          if (u.pn == 0) *(u32x2*)(ws + WS_MK + (size_t)row * 256 + w) = (u32x2){w0, w1};
          else { const int mem = row & 255, xx = mem & 31, mpos = (mem & ~31) + 8 * ((xx >> 2) & 3) + (xx & 3) + 4 * (xx >> 4);
            unsigned char* o = ws + WS_MVT + ((size_t)(row >> 8) * 256 + w) * 256 + mpos;
            o[0] = (unsigned char)w0; o[256] = (unsigned char)(w0 >> 8); o[512] = (unsigned char)(w0 >> 16); o[768] = (unsigned char)(w0 >> 24); o[1024] = (unsigned char)w1; o[1280] = (unsigned char)(w1 >> 8); o[1536] = (unsigned char)(w1 >> 16); o[1792] = (unsigned char)(w1 >> 24); }
        }
      }
  }
};
struct EpiOutM {
  static constexpr bool PERM = true;
  const bf16_t* x; bf16_t* y;
  __device__ __forceinline__ void operator()(const f32x4 (&acc)[2][2][4][2], const pg8::Unit& u, int wr, int wc, int fr, int fq) const {
#pragma unroll
    for (int ai = 0; ai < 2; ++ai)
#pragma unroll
      for (int m = 0; m < 4; ++m) {
        const size_t rb = (size_t)(u.pm * 256 + ai * 128 + wr * 64 + m * 16 + fr) * 1024 + u.pn * 256 + wc * 32 + 8 * fq;
#pragma unroll
        for (int bj = 0; bj < 2; ++bj) { const size_t o = rb + bj * 128; const u32x4 xv = *(const u32x4*)(x + o);
          const f32x4 x0 = {__uint_as_float(xv.x << 16), __uint_as_float(xv.x & 0xffff0000u), __uint_as_float(xv.y << 16), __uint_as_float(xv.y & 0xffff0000u)};
          const f32x4 x1 = {__uint_as_float(xv.z << 16), __uint_as_float(xv.z & 0xffff0000u), __uint_as_float(xv.w << 16), __uint_as_float(xv.w & 0xffff0000u)};
          *(u32x4*)(y + o) = pack8(x0 * ALPHA + acc[ai][bj][m][0], x1 * ALPHA + acc[ai][bj][m][1]); }
      }
  }
};
struct MoeOrder {
  const int* offs; const int* cnts; int npn, G, c; const unsigned* LIST;
  __device__ __forceinline__ bool next(int i, pg8::Unit& u) const {
    const int* offs = this->offs; asm volatile("" : "+s"(offs));
    const int L = i * G + c; const int ntiles = __builtin_amdgcn_readfirstlane(offs[64]) >> 8;
    if (L >= ntiles * npn) return false;
    const int rt = L / npn, pl = L - rt * npn; int e = 0;
    while (__builtin_amdgcn_readfirstlane(offs[e + 1]) <= rt * 256) ++e;
    u.pm = rt; u.mt = rt - (__builtin_amdgcn_readfirstlane(offs[e]) >> 8); u.e = e; u.pn = e * npn + pl; u.aux = __builtin_amdgcn_readfirstlane(cnts[e]); return true;
  }
  __device__ __forceinline__ unsigned arow(const pg8::Unit& u, int r) const { const int rank = u.mt * 256 + r; return rank < u.aux ? LIST[(size_t)u.e * 32768 + rank] : 0u; }
};
struct EpiMoeUpM {
  static constexpr bool PERM = true;
  unsigned char* H;
  __device__ __forceinline__ void operator()(const f32x4 (&acc)[2][2][4][2], const pg8::Unit& u, int wr, int wc, int fr, int fq) const {
    const int pl = u.pn & 1;
#pragma unroll
    for (int ai = 0; ai < 2; ++ai)
#pragma unroll
      for (int m = 0; m < 4; ++m) {
        const int rl = ai * 128 + wr * 64 + m * 16 + fr;
        if (u.mt * 256 + rl < u.aux) {
          f32x4 h0, h1; const float is = 1.f / W8SCALE, us = H8SCALE / W8SCALE; const f32x4 g0 = acc[ai][0][m][0] * is, g1 = acc[ai][0][m][1] * is, u0 = acc[ai][1][m][0] * us, u1 = acc[ai][1][m][1] * us;
          h0.x = silu_f(g0.x) * u0.x; h0.y = silu_f(g0.y) * u0.y; h0.z = silu_f(g0.z) * u0.z; h0.w = silu_f(g0.w) * u0.w;
          h1.x = silu_f(g1.x) * u1.x; h1.y = silu_f(g1.y) * u1.y; h1.z = silu_f(g1.z) * u1.z; h1.w = silu_f(g1.w) * u1.w;
          *(u32x2*)(H + (size_t)(u.pm * 256 + rl) * 256 + pl * 128 + wc * 32 + 8 * fq) = (u32x2){pk4_fp8(h0), pk4_fp8(h1)};
        }
      }
  }
};
struct EpiMoeDownM {
  static constexpr bool PERM = true;
  unsigned char* Y; const float* GATEL;
  __device__ __forceinline__ void operator()(const f32x4 (&acc)[2][2][4][2], const pg8::Unit& u, int wr, int wc, int fr, int fq) const {
    const int pl = u.pn & 3;
    int fr_ = fr, fq_ = fq; asm volatile("" : "+v"(fr_), "+v"(fq_));
    const float* gp = GATEL + (size_t)u.e * 32768; const int rk0 = u.mt * 256 + wr * 64 + fr_;
    unsigned char* yp = Y + (size_t)(u.pm * 256 + wr * 64 + fr_) * 1024 + pl * 256 + wc * 32 + 8 * fq_;
#pragma unroll
    for (int ai = 0; ai < 2; ++ai)
#pragma unroll
      for (int m = 0; m < 4; ++m) {
        const int rk = rk0 + ai * 128 + m * 16; const float gt = gp[rk < 32767 ? rk : 32767] * (64.0f / (W8SCALE * H8SCALE));
#pragma unroll
        for (int bj = 0; bj < 2; ++bj)
          *(u32x2*)(yp + (size_t)(ai * 128 + m * 16) * 1024 + bj * 128) = (u32x2){pk4_fp8(acc[ai][bj][m][0] * gt), pk4_fp8(acc[ai][bj][m][1] * gt)};
      }
  }
};

__device__ __forceinline__ void phase_inproj_mfma(const Ctx& c, lds_u8* lds) {
  unsigned char* ws = c.ws; const int tid = phase_tid();
  { pg8::Gemm g{(const bf16_t*)c.out, (const bf16_t*)(ws + WS_WIN), 1024}; pg8::StaticOrder S; S.init(T, NIN, gridDim.x, blockIdx.x); EpiInM E{ws};
    pg8::gemm_phase<EpiInM, pg8::StaticOrder, true, false>(lds, g, S, E, tid); }
  { pg8::Gemm g{(const bf16_t*)(ws + WS_MEMB), (const bf16_t*)(ws + WS_WMKV), 1024}; pg8::StaticOrder S; S.init(TM, 512, gridDim.x, (int)blockIdx.x - 128); EpiMemKVM E{ws};
    pg8::gemm_phase<EpiMemKVM, pg8::StaticOrder, true, false>(lds, g, S, E, tid); }
}
__device__ __forceinline__ void phase_outproj_mfma(const Ctx& c, lds_u8* lds) {
  unsigned char* ws = c.ws; const int tid = phase_tid();
  pg8::Gemm g{(const bf16_t*)(ws + WS_CAT), (const bf16_t*)(ws + WS_WO), 1024}; pg8::StaticOrder S; S.init(T, 1024, gridDim.x, blockIdx.x); EpiOutM E{(const bf16_t*)c.out, (bf16_t*)(ws + WS_X1B)};
  pg8::gemm_phase<EpiOutM, pg8::StaticOrder, true, false>(lds, g, S, E, tid);
}
__device__ __forceinline__ void phase_moe_up_mfma(const Ctx& c, lds_u8* lds) {
  unsigned char* ws = c.ws; const int tid = phase_tid();
  int* offs = (int*)((unsigned char*)lds + pg8::STAGE_BYTES); int* cnts = offs + 65;
  expert_offsets(c, offs, cnts, tid);
  pg8::Gemm g{(const bf16_t*)(ws + WS_X1F), (const bf16_t*)(ws + WS_WGU), 512};
  MoeOrder S{offs, cnts, 2, (int)gridDim.x, (int)blockIdx.x, (const unsigned*)(ws + WS_LIST)}; EpiMoeUpM E{ws + WS_H};
  pg8::gemm_phase<EpiMoeUpM, MoeOrder, true, true, 1>(lds, g, S, E, tid);
}
__device__ __forceinline__ void phase_moe_down_mfma(const Ctx& c, lds_u8* lds) {
  unsigned char* ws = c.ws; const int tid = phase_tid();
  int* offs = (int*)((unsigned char*)lds + pg8::STAGE_BYTES); int* cnts = offs + 65;
  expert_offsets(c, offs, cnts, tid);
  pg8::Gemm g{(const bf16_t*)(ws + WS_H), (const bf16_t*)(ws + WS_WD), 128};
  MoeOrder S{offs, cnts, 4, (int)gridDim.x, (int)blockIdx.x, nullptr}; EpiMoeDownM E{(unsigned char*)(ws + WS_Y), (const float*)(ws + WS_GATEL)};
  pg8::gemm_phase<EpiMoeDownM, MoeOrder, true, false, 2>(lds, g, S, E, tid);
}

__device__ void phase_kvup(const Ctx& c, float* lds) {
  unsigned char* ws = c.ws;
  const int tid = phase_tid(), lane = tid & 63, wave = tid >> 6, fr = lane & 15, fq = lane >> 4;
  const bf16_t* W = (const bf16_t*)(ws + WS_WKV);
  const bf16_t* CKV = (const bf16_t*)(ws + WS_CKV); bf16_t* KVA = (bf16_t*)(ws + WS_KVA);
  const float* cs = (const float*)(ws + WS_ROPE); const float* sn = cs + SEQ * 32;
  for (int tile = blockIdx.x * NWAVES + wave; tile < T / 16; tile += gridDim.x * NWAVES) {
    const int t = tile * 16 + fr, pos = t & (SEQ - 1);
    pg8::bf16x8 bx[4]; float ss = 0.f;
#pragma unroll
    for (int ks = 0; ks < 4; ++ks) { const u32x4 v = *(const u32x4*)(CKV + (size_t)t * 128 + ks * 32 + fq * 8); bx[ks] = __builtin_bit_cast(pg8::bf16x8, v);
      const float f[8] = {__uint_as_float(v.x << 16), __uint_as_float(v.x & 0xffff0000u), __uint_as_float(v.y << 16), __uint_as_float(v.y & 0xffff0000u), __uint_as_float(v.z << 16), __uint_as_float(v.z & 0xffff0000u), __uint_as_float(v.w << 16), __uint_as_float(v.w & 0xffff0000u)};
#pragma unroll
      for (int e = 0; e < 8; ++e) ss += f[e] * f[e]; }
    ss += __shfl_xor(ss, 16); ss += __shfl_xor(ss, 32);
    const float rstd = rsqrtf(ss * (1.f / 128.f) + 1e-6f);
#pragma unroll
    for (int nt = 0; nt < 8; ++nt) { f32x4 d = {0.f, 0.f, 0.f, 0.f};
#pragma unroll
      for (int ks = 0; ks < 4; ++ks) d = __builtin_amdgcn_mfma_f32_16x16x32_bf16(*(const pg8::bf16x8*)(W + (size_t)(nt * 16 + fr) * 128 + ks * 32 + fq * 8), bx[ks], d, 0, 0, 0);
      d = d * rstd;
      const int p0 = nt * 16 + fq * 4;
      if (nt < 4) { const int dd = p0 >> 1; const float c0 = cs[pos * 32 + dd], s0 = sn[pos * 32 + dd], c1 = cs[pos * 32 + dd + 1], s1 = sn[pos * 32 + dd + 1];
        const f32x4 o = {d.x * c0 - d.y * s0, d.y * c0 + d.x * s0, d.z * c1 - d.w * s1, d.w * c1 + d.z * s1}; d = o; }
      { int w8 = __builtin_amdgcn_cvt_pk_fp8_f32(d.x, d.y, 0, false); w8 = __builtin_amdgcn_cvt_pk_fp8_f32(d.z, d.w, w8, true);
        *(unsigned*)((unsigned char*)KVA + (size_t)t * 128 + p0) = (unsigned)w8; } }
  }
}


typedef _Float16 h16x2 __attribute__((ext_vector_type(2)));
constexpr int TK_KP = 4104;
constexpr int TK_KEYS = 0, TK_H1 = 16 * TK_KP * 2, TK_H2 = TK_H1 + 16 * 128 * 4, TK_MISC = TK_H2 + 8 * 128 * 4;
__device__ __forceinline__ unsigned mono16x2(unsigned u) { const unsigned m = ((u >> 15) & 0x00010001u) * 0xffffu; return u ^ (m | 0x80008000u); }
__device__ __forceinline__ int wave_incl_scan(int x) {
  x += __builtin_amdgcn_update_dpp(0, x, 0x111, 0xF, 0xF, true);
  x += __builtin_amdgcn_update_dpp(0, x, 0x112, 0xF, 0xF, true);
  x += __builtin_amdgcn_update_dpp(0, x, 0x114, 0xF, 0xF, true);
  x += __builtin_amdgcn_update_dpp(0, x, 0x118, 0xF, 0xF, true);
  x += __builtin_amdgcn_update_dpp(0, x, 0x142, 0xA, 0xF, false);
  x += __builtin_amdgcn_update_dpp(0, x, 0x143, 0xC, 0xF, false);
  return x;
}

__device__ __forceinline__ void hist_find(const unsigned* hw, int need, int lane, int& B, int& above) {
  const unsigned w0 = hw[127 - 2 * lane], w1 = hw[126 - 2 * lane];
  const int c0 = (int)(w0 >> 16), c1 = (int)(w0 & 0xffffu), c2 = (int)(w1 >> 16), c3 = (int)(w1 & 0xffffu);
  const int tl = c0 + c1 + c2 + c3;
  const int incl = wave_incl_scan(tl);
  const int excl = incl - tl;
  const bool hit = (excl < need) && (incl >= need);
  int b = 0, ab = 0;
  if (hit) { int a = excl; b = 255 - 4 * lane; ab = a;
    if (a + c0 < need) { a += c0; b = 254 - 4 * lane; ab = a; if (a + c1 < need) { a += c1; b = 253 - 4 * lane; ab = a; if (a + c2 < need) { a += c2; b = 252 - 4 * lane; ab = a; } } } }
  const unsigned long long m = __ballot(hit);
  const int src = __builtin_amdgcn_readfirstlane(m ? (__ffsll((long long)m) - 1) : 0);
  B = __builtin_amdgcn_readlane(b, src); above = __builtin_amdgcn_readlane(ab, src);
}
__device__ void phase_topk_mfma(const Ctx& c, unsigned char* ldsb, unsigned* qhead) {
  unsigned char* ws = c.ws;
  const int tid = phase_tid(), lane = tid & 63, wave = tid >> 6, fr = lane & 15, fq = lane >> 4;
  unsigned short* keys = (unsigned short*)(ldsb + TK_KEYS);
  unsigned* h1 = (unsigned*)(ldsb + TK_H1); unsigned* h2 = (unsigned*)(ldsb + TK_H2) + wave * 128; int* misc = (int*)(ldsb + TK_MISC);
  const bf16_t* IQ = (const bf16_t*)(ws + WS_IQ); const bf16_t* IK = (const bf16_t*)(ws + WS_IK); const float* SM = (const float*)(ws + WS_SM);
  unsigned short* SEL = (unsigned short*)(ws + WS_SEL);
  WorkQ wq; wq_init(wq, qhead, misc, tid);
  for (;;) {
    const int item = wq_next(wq, tid);
    if (item >= 240 * 8) break;
    const int b = item & 7, qb = 255 - (item >> 3), s0 = qb * 16;
    for (int i = tid; i < 16 * 128; i += NTHREADS) h1[i] = 0u;
    const size_t qrow = (size_t)b * SEQ + s0 + fr;
    pg8::bf16x8 bq[4][2];
#pragma unroll
    for (int hh = 0; hh < 4; ++hh)
#pragma unroll
      for (int ks = 0; ks < 2; ++ks) bq[hh][ks] = *(const pg8::bf16x8*)(IQ + qrow * 256 + hh * 64 + ks * 32 + fq * 8);
    const f32x4 iw = *(const f32x4*)(SM + qrow * 16);
    const int nkt = qb + 1, slim = s0 + fr;
    __syncthreads();
    pg8::bf16x8 a0n = {0, 0, 0, 0, 0, 0, 0, 0}, a1n = a0n;
    if (wave < nkt) { const bf16_t* kr = IK + ((size_t)b * SEQ + wave * 16 + fr) * 64 + fq * 8; a0n = *(const pg8::bf16x8*)kr; a1n = *(const pg8::bf16x8*)(kr + 32); }
    for (int kt = wave; kt < nkt; kt += NWAVES) {
      const pg8::bf16x8 a0 = a0n, a1 = a1n;
      if (kt + NWAVES < nkt) { const bf16_t* kr = IK + ((size_t)b * SEQ + (kt + NWAVES) * 16 + fr) * 64 + fq * 8; a0n = *(const pg8::bf16x8*)kr; a1n = *(const pg8::bf16x8*)(kr + 32); }
      f32x4 sc = {0.f, 0.f, 0.f, 0.f};
#pragma unroll
      for (int hh = 0; hh < 4; ++hh) { f32x4 d = {0.f, 0.f, 0.f, 0.f};
        d = __builtin_amdgcn_mfma_f32_16x16x32_bf16(a0, bq[hh][0], d, 0, 0, 0); d = __builtin_amdgcn_mfma_f32_16x16x32_bf16(a1, bq[hh][1], d, 0, 0, 0);
        const float w = hh == 0 ? iw.x : hh == 1 ? iw.y : hh == 2 ? iw.z : iw.w;
        sc.x = fmaf(w, fmaxf(d.x, 0.f), sc.x); sc.y = fmaf(w, fmaxf(d.y, 0.f), sc.y); sc.z = fmaf(w, fmaxf(d.z, 0.f), sc.z); sc.w = fmaf(w, fmaxf(d.w, 0.f), sc.w); }
      unsigned k01 = mono16x2(__builtin_bit_cast(unsigned, __builtin_amdgcn_cvt_pkrtz(sc.x, sc.y))), k23 = mono16x2(__builtin_bit_cast(unsigned, __builtin_amdgcn_cvt_pkrtz(sc.z, sc.w)));
      const int kbase = kt * 16 + fq * 4;
      unsigned* hq = h1 + fr * 128;
      if (kt + 1 < nkt) {
        *(u32x2*)(keys + fr * TK_KP + kbase) = (u32x2){k01, k23};
        { const unsigned kk = k01 & 0xffffu; atomicAdd(hq + (kk >> 9), 1u << ((kk >> 4) & 16)); }
        { const unsigned kk = k01 >> 16; atomicAdd(hq + (kk >> 9), 1u << ((kk >> 4) & 16)); }
        { const unsigned kk = k23 & 0xffffu; atomicAdd(hq + (kk >> 9), 1u << ((kk >> 4) & 16)); }
        { const unsigned kk = k23 >> 16; atomicAdd(hq + (kk >> 9), 1u << ((kk >> 4) & 16)); }
      } else {
        if (kbase + 0 > slim) k01 &= 0xffff0000u; if (kbase + 1 > slim) k01 &= 0x0000ffffu;
        if (kbase + 2 > slim) k23 &= 0xffff0000u; if (kbase + 3 > slim) k23 &= 0x0000ffffu;
        *(u32x2*)(keys + fr * TK_KP + kbase) = (u32x2){k01, k23};
        if (kbase + 0 <= slim) { const unsigned kk = k01 & 0xffffu; atomicAdd(hq + (kk >> 9), 1u << ((kk >> 4) & 16)); }
        if (kbase + 1 <= slim) { const unsigned kk = k01 >> 16; atomicAdd(hq + (kk >> 9), 1u << ((kk >> 4) & 16)); }
        if (kbase + 2 <= slim) { const unsigned kk = k23 & 0xffffu; atomicAdd(hq + (kk >> 9), 1u << ((kk >> 4) & 16)); }
        if (kbase + 3 <= slim) { const unsigned kk = k23 >> 16; atomicAdd(hq + (kk >> 9), 1u << ((kk >> 4) & 16)); }
      }
    }
    __syncthreads();
    for (int qi = 0; qi < 2; ++qi) {
      const int q = wave * 2 + qi, s = s0 + q, n = s + 1;
      int B1, above1; hist_find(h1 + q * 128, 256, lane, B1, above1);
      const int need1 = 256 - above1;
      h2[lane] = 0u; h2[64 + lane] = 0u;
      const unsigned short* kq = keys + q * TK_KP;
      const int niter = (n + 511) >> 9;
      for (int it = 0; it < niter; ++it) {
        const int i0 = (it * 64 + lane) * 8; const u32x4 kv = *(const u32x4*)(kq + i0);
        const unsigned k8[8] = {kv.x & 0xffffu, kv.x >> 16, kv.y & 0xffffu, kv.y >> 16, kv.z & 0xffffu, kv.z >> 16, kv.w & 0xffffu, kv.w >> 16};
#pragma unroll
        for (int e = 0; e < 8; ++e) if (i0 + e < n && (int)(k8[e] >> 8) == B1) atomicAdd(h2 + ((k8[e] & 255u) >> 1), 1u << ((k8[e] & 1u) * 16));
      }
      int B2, above2; hist_find(h2, need1, lane, B2, above2);
      const unsigned thr = (unsigned)((B1 << 8) | B2); const int need = need1 - above2;
      unsigned short* dummy = (unsigned short*)(misc + 8 + wave);
      unsigned short* sel = (unsigned short*)h2;
      asm volatile("s_waitcnt lgkmcnt(0)" ::: "memory");
      int tiebase = 0, outbase = 0;
      for (int it = 0; it < niter; ++it) {
        const int i0 = (it * 64 + lane) * 8; const u32x4 kv = *(const u32x4*)(kq + i0);
        const unsigned k8[8] = {kv.x & 0xffffu, kv.x >> 16, kv.y & 0xffffu, kv.y >> 16, kv.z & 0xffffu, kv.z >> 16, kv.w & 0xffffu, kv.w >> 16};
        int cg = 0, ce = 0;
#pragma unroll
        for (int e = 0; e < 8; ++e) { const bool v = i0 + e < n; cg += (v && k8[e] > thr) ? 1 : 0; ce += (v && k8[e] == thr) ? 1 : 0; }
        int tk = 0;
        if (__ballot(ce != 0)) {
          const int eincl = wave_incl_scan(ce); const int eg = tiebase + eincl - ce;
          tk = need - eg; tk = tk < 0 ? 0 : (tk > ce ? ce : tk);
          tiebase += __builtin_amdgcn_readlane(eincl, 63);
        }
        const int oc = cg + tk; const int oincl = wave_incl_scan(oc);
        int pos = outbase + oincl - oc; int tleft = tk;
#pragma unroll
        for (int e = 0; e < 8; ++e) { const bool v = i0 + e < n; const bool tie = v && k8[e] == thr && tleft > 0; const bool take = (v && k8[e] > thr) || tie;
          tleft -= tie ? 1 : 0;
          unsigned short* dst = (take && pos < 256) ? sel + pos : dummy;
          *dst = (unsigned short)(i0 + e); pos += take ? 1 : 0; }
        outbase += __builtin_amdgcn_readlane(oincl, 63);
      }
      asm volatile("s_waitcnt lgkmcnt(0)" ::: "memory");
      *(u32x2*)(SEL + ((size_t)b * SEQ + s) * 256 + lane * 4) = *(const u32x2*)(sel + lane * 4);
      asm volatile("s_waitcnt lgkmcnt(0)" ::: "memory");
    }
  }
}

typedef short s16x4 __attribute__((ext_vector_type(4)));
__device__ __forceinline__ s16x4 lds_tr16(const unsigned char* p) { return __builtin_bit_cast(s16x4, __builtin_amdgcn_ds_read_tr16_b64_v4i16((__attribute__((address_space(3))) s16x4*)(__attribute__((address_space(3))) unsigned char*)p)); }
typedef float f32x2_t __attribute__((ext_vector_type(2))); typedef __bf16 bf16x2_t __attribute__((ext_vector_type(2)));
__device__ __forceinline__ unsigned cvtpk_c(float lo, float hi) { const f32x2_t v = {lo, hi}; const bf16x2_t b = __builtin_convertvector(v, bf16x2_t); return __builtin_bit_cast(unsigned, b); }
__device__ __forceinline__ pg8::bf16x8 packp(const f32x4& a, const f32x4& b) {
  const u32x4 w = {cvtpk_c(a.x, a.y), cvtpk_c(a.z, a.w), cvtpk_c(b.x, b.y), cvtpk_c(b.z, b.w)}; return __builtin_bit_cast(pg8::bf16x8, w); }
constexpr int AT_WB = 9216 + 512;
typedef int v2i_t __attribute__((ext_vector_type(2)));
__device__ __forceinline__ long lds_tr8(const unsigned char* p) { const v2i_t r = __builtin_amdgcn_ds_read_tr8_b64_v2i32((__attribute__((address_space(3))) v2i_t*)(__attribute__((address_space(3))) unsigned char*)p); return (long)(((unsigned long)(unsigned)r.y << 32) | (unsigned long)(unsigned)r.x); }
__device__ void phase_attn_sparse(const Ctx& c, unsigned char* ldsb, unsigned* qhead) {
  unsigned char* ws = c.ws;
  const int tid = phase_tid(), lane = tid & 63, wave = tid >> 6, fr = lane & 15, fq = lane >> 4;
  unsigned char* vl = ldsb + wave * AT_WB; unsigned short* sl = (unsigned short*)(vl + 9216);
  const bf16_t* QA = (const bf16_t*)(ws + WS_QA); const unsigned char* KVA = (const unsigned char*)(ws + WS_KVA); const unsigned short* SEL = (const unsigned short*)(ws + WS_SEL);
  bf16_t* CAT = (bf16_t*)(ws + WS_CAT);
  const float* gA = c.in[10];
  __syncthreads();
  int* aq_slot = (int*)(ldsb + 8 * AT_WB);
  WorkQ wq; wq_init(wq, qhead, aq_slot, tid);
  const int st_off = (lane >> 3) * 144 + (lane & 7) * 16;
  const int kr_off = fr * 144 + fq * 16;
  const int tr_off = (fq * 4 + ((fr >> 1) & 3) + (fr >> 3) * 16) * 144 + 64 + (fr & 1) * 8;
  for (;;) {
  const int item = wq_next(wq, tid);
  if (item >= 512) break;
  for (int tj = 0; tj < 8; ++tj) {
    const int t = item * 64 + wave * 8 + tj;
    const int b = t >> 12, s = t & (SEQ - 1), n = s + 1 < 256 ? s + 1 : 256;
    { u32x2 v;
      if (s >= 256) v = *(const u32x2*)(SEL + (size_t)t * 256 + lane * 4);
      else { const int i0 = lane * 4; const unsigned e0 = i0 < n ? i0 : 0, e1 = i0 + 1 < n ? i0 + 1 : 0, e2 = i0 + 2 < n ? i0 + 2 : 0, e3 = i0 + 3 < n ? i0 + 3 : 0; v = (u32x2){e0 | (e1 << 16), e2 | (e3 << 16)}; }
      *(u32x2*)(sl + lane * 4) = v; }
    asm volatile("s_waitcnt lgkmcnt(0)" ::: "memory");
    const unsigned char* kvb = KVA + (size_t)b * SEQ * 128;
    u32x4 ra[8], rb[8];
#define KLOAD(R, CH) do { _Pragma("unroll") for (int i_ = 0; i_ < 8; ++i_) { const int key_ = sl[(CH) * 64 + i_ * 8 + (lane >> 3)]; R[i_] = *(const u32x4*)(kvb + (size_t)key_ * 128 + (lane & 7) * 16); } } while (0)
#define KSTORE(R) do { _Pragma("unroll") for (int i_ = 0; i_ < 8; ++i_) *(u32x4*)(vl + i_ * 8 * 144 + st_off) = R[i_]; } while (0)
    KLOAD(ra, 0); KLOAD(rb, 1);
    long q0 = 0, q1 = 0;
    if (fr < 6) { const bf16_t* qp = QA + (size_t)t * 384 + fr * 64 + fq * 16; const u32x4 a = *(const u32x4*)qp, bb = *(const u32x4*)(qp + 8);
      q0 = mk64(cvt4_fp8(__uint_as_float(a.x << 16), __uint_as_float(a.x & 0xffff0000u), __uint_as_float(a.y << 16), __uint_as_float(a.y & 0xffff0000u)),
                cvt4_fp8(__uint_as_float(a.z << 16), __uint_as_float(a.z & 0xffff0000u), __uint_as_float(a.w << 16), __uint_as_float(a.w & 0xffff0000u)));
      q1 = mk64(cvt4_fp8(__uint_as_float(bb.x << 16), __uint_as_float(bb.x & 0xffff0000u), __uint_as_float(bb.y << 16), __uint_as_float(bb.y & 0xffff0000u)),
                cvt4_fp8(__uint_as_float(bb.z << 16), __uint_as_float(bb.z & 0xffff0000u), __uint_as_float(bb.w << 16), __uint_as_float(bb.w & 0xffff0000u))); }
    float m = -3.0e38f, l = 0.f;
    f32x4 ot[4];
#pragma unroll
    for (int mt = 0; mt < 4; ++mt) ot[mt] = (f32x4){0.f, 0.f, 0.f, 0.f};
#define KCHUNK(R, CH) do { \
      KSTORE(R); if ((CH) + 2 < 4) KLOAD(R, (CH) + 2); \
      asm volatile("s_waitcnt lgkmcnt(0)" ::: "memory"); \
      f32x4 st[4]; \
      _Pragma("unroll") for (int kt = 0; kt < 4; ++kt) { const u32x4 a_ = *(const u32x4*)(vl + kt * 16 * 144 + kr_off); f32x4 d_ = {0.f, 0.f, 0.f, 0.f}; \
        d_ = __builtin_amdgcn_mfma_f32_16x16x32_fp8_fp8(mk64(a_.x, a_.y), q0, d_, 0, 0, 0); st[kt] = __builtin_amdgcn_mfma_f32_16x16x32_fp8_fp8(mk64(a_.z, a_.w), q1, d_, 0, 0, 0); } \
      if (n < 256) { _Pragma("unroll") for (int kt = 0; kt < 4; ++kt) { const int sb = (CH) * 64 + kt * 16 + fq * 4; \
        if (sb + 0 >= n) st[kt].x = -3.0e38f; if (sb + 1 >= n) st[kt].y = -3.0e38f; if (sb + 2 >= n) st[kt].z = -3.0e38f; if (sb + 3 >= n) st[kt].w = -3.0e38f; } } \
      float cm = -3.0e38f; \
      _Pragma("unroll") for (int kt = 0; kt < 4; ++kt) cm = fmaxf(fmaxf(fmaxf(cm, st[kt].x), fmaxf(st[kt].y, st[kt].z)), st[kt].w); \
      cm = fmaxf(cm, __shfl_xor(cm, 16)); cm = fmaxf(cm, __shfl_xor(cm, 32)); \
      const float mn = fmaxf(m, cm), al = __builtin_amdgcn_exp2f(m - mn), mb = mn - 8.f; m = mn; \
      float ls = 0.f; \
      _Pragma("unroll") for (int kt = 0; kt < 4; ++kt) { st[kt].x = __builtin_amdgcn_exp2f(st[kt].x - mb); st[kt].y = __builtin_amdgcn_exp2f(st[kt].y - mb); st[kt].z = __builtin_amdgcn_exp2f(st[kt].z - mb); st[kt].w = __builtin_amdgcn_exp2f(st[kt].w - mb); \
        ls += (st[kt].x + st[kt].y) + (st[kt].z + st[kt].w); } \
      l = l * al + ls; \
      _Pragma("unroll") for (int mt = 0; mt < 4; ++mt) ot[mt] = ot[mt] * al; \
      _Pragma("unroll") for (int k2 = 0; k2 < 2; ++k2) { \
        const long pf = mk64(cvt4_fp8(st[2 * k2].x, st[2 * k2].y, st[2 * k2].z, st[2 * k2].w), cvt4_fp8(st[2 * k2 + 1].x, st[2 * k2 + 1].y, st[2 * k2 + 1].z, st[2 * k2 + 1].w)); \
        _Pragma("unroll") for (int mt = 0; mt < 4; ++mt) { const long af = lds_tr8(vl + k2 * 32 * 144 + tr_off + mt * 16); \
          ot[mt] = __builtin_amdgcn_mfma_f32_16x16x32_fp8_fp8(af, pf, ot[mt], 0, 0, 0); } } \
      asm volatile("s_waitcnt lgkmcnt(0)" ::: "memory"); } while (0)
    KCHUNK(ra, 0); KCHUNK(rb, 1); KCHUNK(ra, 2); KCHUNK(rb, 3);
#undef KLOAD
#undef KSTORE
#undef KCHUNK
    l += __shfl_xor(l, 16); l += __shfl_xor(l, 32);
    const float il = __builtin_amdgcn_rcpf(l); float ss = 0.f;
#pragma unroll
    for (int mt = 0; mt < 4; ++mt) { ot[mt] = ot[mt] * il; ss += (ot[mt].x * ot[mt].x + ot[mt].y * ot[mt].y) + (ot[mt].z * ot[mt].z + ot[mt].w * ot[mt].w); }
    if (fr >= 6) ss = 0.f;
#pragma unroll
    for (int o = 1; o < 64; o <<= 1) ss += __shfl_xor(ss, o);
    const float rstd = rsqrtf(ss * (1.f / 384.f) + 1e-6f);
    if (fr < 6) {
#pragma unroll
      for (int mt = 0; mt < 4; ++mt) { const int col = fr * 64 + mt * 16 + fq * 4; const f32x4 g = *(const f32x4*)(gA + col); const f32x4 o = ot[mt] * rstd * g;
        *(u32x2*)(CAT + (size_t)t * 1024 + col) = (u32x2){pg8::cvt_pk_bf16(o.x, o.y), pg8::cvt_pk_bf16(o.z, o.w)}; } }
  }
  }
}

__device__ void phase_attn_mem(const Ctx& c, unsigned char* ldsb, unsigned* qhead) {
  unsigned char* ws = c.ws;
  const int tid = phase_tid(), lane = tid & 63, wave = tid >> 6, fr = lane & 15, fq = lane >> 4;
  const bf16_t* QC = (const bf16_t*)(ws + WS_QC); const unsigned char* MK = ws + WS_MK; const unsigned char* MVT = ws + WS_MVT;
  bf16_t* CAT = (bf16_t*)(ws + WS_CAT);
  const float* gC = c.in[11];
  int* aq_slot = (int*)(ldsb + 70656 + 8 * 8192);
  WorkQ wq; wq_init(wq, qhead, aq_slot, tid);
  for (;;) {
  const int item = wq_next(wq, tid) + 512;
  if (item >= 768) break;
  {
    const int t0 = (item - 512) * 128 + wave * 16, b = t0 >> 12;
    unsigned char* mkl = ldsb; unsigned char* mvl = ldsb + 36864; unsigned char* ocl = ldsb + 70656 + wave * 8192;
    float ss = 0.f;
#pragma unroll 1
    for (int h = 0; h < 4; ++h) {
      const bf16_t* qp = QC + (size_t)(t0 + fr) * 256 + h * 64 + fq * 16;
      const u32x4 qa = *(const u32x4*)qp, qb = *(const u32x4*)(qp + 8);
      __syncthreads();
#pragma unroll
      for (int i = 0; i < 2; ++i) { const int p = tid + 512 * i, row = p >> 2, cc = p & 3;
        *(u32x4*)(mkl + row * 80 + cc * 16) = *(const u32x4*)(MK + ((size_t)(b * 256 + row)) * 256 + h * 64 + cc * 16); }
#pragma unroll
      for (int i = 0; i < 2; ++i) { const int p = tid + 512 * i, row = p >> 4, cc = p & 15;
        *(u32x4*)(mvl + row * 272 + cc * 16) = *(const u32x4*)(MVT + ((size_t)(b * 256 + h * 64 + row)) * 256 + cc * 16); }
      const long q0 = mk64(cvt4_fp8(__uint_as_float(qa.x << 16), __uint_as_float(qa.x & 0xffff0000u), __uint_as_float(qa.y << 16), __uint_as_float(qa.y & 0xffff0000u)),
                           cvt4_fp8(__uint_as_float(qa.z << 16), __uint_as_float(qa.z & 0xffff0000u), __uint_as_float(qa.w << 16), __uint_as_float(qa.w & 0xffff0000u)));
      const long q1 = mk64(cvt4_fp8(__uint_as_float(qb.x << 16), __uint_as_float(qb.x & 0xffff0000u), __uint_as_float(qb.y << 16), __uint_as_float(qb.y & 0xffff0000u)),
                           cvt4_fp8(__uint_as_float(qb.z << 16), __uint_as_float(qb.z & 0xffff0000u), __uint_as_float(qb.w << 16), __uint_as_float(qb.w & 0xffff0000u)));
      __syncthreads();
      f32x4 oc[4];
      f32x4 st[16];
#pragma unroll
      for (int kt = 0; kt < 16; ++kt) { const u32x4 a_ = *(const u32x4*)(mkl + (kt * 16 + fr) * 80 + fq * 16);
        f32x4 d = {0.f, 0.f, 0.f, 0.f};
        d = __builtin_amdgcn_mfma_f32_16x16x32_fp8_fp8(mk64(a_.x, a_.y), q0, d, 0, 0, 0); st[kt] = __builtin_amdgcn_mfma_f32_16x16x32_fp8_fp8(mk64(a_.z, a_.w), q1, d, 0, 0, 0); }
      float mx = -3.0e38f;
#pragma unroll
      for (int kt = 0; kt < 16; ++kt) mx = fmaxf(fmaxf(fmaxf(mx, st[kt].x), fmaxf(st[kt].y, st[kt].z)), st[kt].w);
      mx = fmaxf(mx, __shfl_xor(mx, 16)); mx = fmaxf(mx, __shfl_xor(mx, 32));
      mx -= 8.f;
      float l = 0.f;
#pragma unroll
      for (int kt = 0; kt < 16; ++kt) { st[kt].x = __builtin_amdgcn_exp2f(st[kt].x - mx); st[kt].y = __builtin_amdgcn_exp2f(st[kt].y - mx); st[kt].z = __builtin_amdgcn_exp2f(st[kt].z - mx); st[kt].w = __builtin_amdgcn_exp2f(st[kt].w - mx);
        l += (st[kt].x + st[kt].y) + (st[kt].z + st[kt].w); }
      l += __shfl_xor(l, 16); l += __shfl_xor(l, 32);
#pragma unroll
      for (int mt = 0; mt < 4; ++mt) oc[mt] = (f32x4){0.f, 0.f, 0.f, 0.f};
#pragma unroll
      for (int kk = 0; kk < 8; ++kk) { const long pf = mk64(cvt4_fp8(st[2 * kk].x, st[2 * kk].y, st[2 * kk].z, st[2 * kk].w), cvt4_fp8(st[2 * kk + 1].x, st[2 * kk + 1].y, st[2 * kk + 1].z, st[2 * kk + 1].w));
#pragma unroll
        for (int mt = 0; mt < 4; ++mt) { const u32x2 a_ = *(const u32x2*)(mvl + (mt * 16 + fr) * 272 + (kk * 4 + fq) * 8);
          oc[mt] = __builtin_amdgcn_mfma_f32_16x16x32_fp8_fp8(mk64(a_.x, a_.y), pf, oc[mt], 0, 0, 0); } }
      const float il = __builtin_amdgcn_rcpf(l);
#pragma unroll
      for (int mt = 0; mt < 4; ++mt) { const f32x4 o = oc[mt] * il; ss += (o.x * o.x + o.y * o.y) + (o.z * o.z + o.w * o.w); *(u32x2*)(ocl + ((h * 4 + mt) * 64 + lane) * 8) = (u32x2){pg8::cvt_pk_bf16(o.x, o.y), pg8::cvt_pk_bf16(o.z, o.w)}; }
    }
    ss += __shfl_xor(ss, 16); ss += __shfl_xor(ss, 32);
    const float rstd = rsqrtf(ss * (1.f / 256.f) + 1e-6f);
#pragma unroll 1
    for (int h = 0; h < 4; ++h)
#pragma unroll
      for (int mt = 0; mt < 4; ++mt) { const int col = h * 64 + mt * 16 + fq * 4; const f32x4 g = *(const f32x4*)(gC + col); const u32x2 pp = *(const u32x2*)(ocl + ((h * 4 + mt) * 64 + lane) * 8);
        const f32x4 ov = {__uint_as_float(pp.x << 16), __uint_as_float(pp.x & 0xffff0000u), __uint_as_float(pp.y << 16), __uint_as_float(pp.y & 0xffff0000u)}; const f32x4 o = ov * rstd * g;
        *(u32x2*)(CAT + (size_t)(t0 + fr) * 1024 + 768 + col) = (u32x2){pg8::cvt_pk_bf16(o.x, o.y), pg8::cvt_pk_bf16(o.z, o.w)}; }
  }
  }
}

constexpr int GD_ITEM = 41088;
__device__ __forceinline__ unsigned char* gd_item(unsigned char* ws, int it) { return it < 1536 ? ws + WS_XB + (size_t)it * GD_ITEM : ws + WS_X1B + (size_t)(it - 1536) * GD_ITEM; }
__device__ __forceinline__ int kperm(int x) { return (x & 32) | (((x >> 2) & 3) << 3) | (x & 3) | (((x >> 4) & 1) << 2); }
constexpr int GP_KB = 0, GP_KBB = 9216, GP_QB = 18432, GP_VBT = 27648, GP_KBET = 36864, GP_XR = 46080  , GP_PR = 82944  , GP_OUT = 101376, GP_SC = 142336;
__device__ __forceinline__ pg8::bf16x8 ldsfrag(const unsigned char* base, int row, int ks, int fq) { return *(const pg8::bf16x8*)(base + row * 144 + ks * 64 + fq * 16); }
constexpr int G2_KB = 0, G2_KBB = 9216, G2_QB = 18432, G2_XR0 = 27648, G2_XT0 = 36864, G2_PR0 = 46080, G2_VBT = 55296, G2_KBET = 64512, G2_SC = 73728, G2_CW = 75264, G2_HALF = 78336;
__device__ void phase_gdn_prep2(const Ctx& c, unsigned char* Lb) {
  unsigned char* ws = c.ws;
  const int tid = phase_tid(), lane = tid & 63, wave = tid >> 6, fr = lane & 15, fq = lane >> 4;
  const int hb = wave >> 2, w4 = wave & 3, htid = tid & 255;
  unsigned char* L = Lb + hb * G2_HALF;
  const bf16_t* GB = (const bf16_t*)(ws + WS_GB); const float* SM = (const float*)(ws + WS_SM);
  const float* convw = c.in[6];
  float* sc = (float*)(L + G2_SC);
  float* cw = (float*)(L + G2_CW);
  const int tt = htid >> 2, part = htid & 3;
  for (int it2 = blockIdx.x; it2 < 1536; it2 += gridDim.x) {
    const int it = it2 * 2 + hb;
    const int n = it & 63, bh = it >> 6, b = bh / 6, h = bh % 6;
    const int t = n * 64 + tt; const size_t r = (size_t)b * SEQ + t;
    unsigned char* gb = gd_item(ws, it);
    __syncthreads();
    for (int i = htid; i < 768; i += 256) { const int j = i / 192, rr = i % 192; cw[i] = convw[j * 1152 + (rr >> 6) * 384 + h * 64 + (rr & 63)]; }
    if (part == 0) { const float a = SM[r * 16 + 4 + h], bb = SM[r * 16 + 10 + h]; const float xs = a + c.in[8][h]; const float sp = xs > 20.f ? xs : log1pf(__expf(xs));
      sc[tt] = -__expf(c.in[7][h]) * sp; sc[192 + tt] = 1.f / (1.f + __expf(-bb)); }
    __syncthreads();
    if (w4 == 0) { float v = sc[lane];
#pragma unroll
      for (int o = 1; o < 64; o <<= 1) { const float u = __shfl_up(v, o); if (lane >= o) v += u; }
      const float last = __shfl(v, 63);
      sc[64 + lane] = v; sc[128 + lane] = __expf(v); sc[256 + lane] = __expf(last - v); if (lane == 0) { sc[320] = __expf(last); *(float*)(gb + 40960) = __expf(last); } }
    float qv[16], kv[16], vv[16];
#pragma unroll
    for (int role = 0; role < 3; ++role) {
      float acc[16];
#pragma unroll
      for (int e = 0; e < 16; ++e) acc[e] = 0.f;
      u32x4 xr[4][2];
#pragma unroll
      for (int j = 0; j < 4; ++j) { const bool ok = t - 3 + j >= 0; const bf16_t* xp = GB + (r - 3 + j) * 1536 + role * 384 + h * 64 + part * 16;
        xr[j][0] = ok ? *(const u32x4*)xp : (u32x4){0u, 0u, 0u, 0u}; xr[j][1] = ok ? *(const u32x4*)(xp + 8) : (u32x4){0u, 0u, 0u, 0u}; }
#pragma unroll
      for (int j = 0; j < 4; ++j)
#pragma unroll
        for (int hh = 0; hh < 2; ++hh) { const u32x4 xvv = xr[j][hh]; const float* wj = cw + j * 192 + role * 64 + part * 16 + hh * 8;
          const f32x4 w0 = *(const f32x4*)wj, w1 = *(const f32x4*)(wj + 4);
          acc[hh * 8 + 0] += w0.x * __uint_as_float(xvv.x << 16); acc[hh * 8 + 1] += w0.y * __uint_as_float(xvv.x & 0xffff0000u); acc[hh * 8 + 2] += w0.z * __uint_as_float(xvv.y << 16); acc[hh * 8 + 3] += w0.w * __uint_as_float(xvv.y & 0xffff0000u);
          acc[hh * 8 + 4] += w1.x * __uint_as_float(xvv.z << 16); acc[hh * 8 + 5] += w1.y * __uint_as_float(xvv.z & 0xffff0000u); acc[hh * 8 + 6] += w1.z * __uint_as_float(xvv.w << 16); acc[hh * 8 + 7] += w1.w * __uint_as_float(xvv.w & 0xffff0000u); }
      float ss = 0.f;
#pragma unroll
      for (int e = 0; e < 16; ++e) { acc[e] = silu_f(acc[e]); ss += acc[e] * acc[e]; }
      if (role < 2) { ss += __shfl_xor(ss, 1); ss += __shfl_xor(ss, 2); const float scl = rsqrtf(ss + 1e-6f) * (role == 0 ? 0.125f : 1.f);
#pragma unroll
        for (int e = 0; e < 16; ++e) acc[e] *= scl; }
#pragma unroll
      for (int e = 0; e < 16; ++e) { if (role == 0) qv[e] = acc[e]; else if (role == 1) kv[e] = acc[e]; else vv[e] = acc[e]; }
    }
    __syncthreads();
    { const float beta = sc[192 + tt], eg = sc[128 + tt], ekl = sc[256 + tt];
      float kb[16];
#pragma unroll
      for (int e = 0; e < 16; ++e) kb[e] = kv[e] * beta;
#pragma unroll
      for (int hh = 0; hh < 2; ++hh) { const int o8 = hh * 8;
        *(u32x4*)(L + G2_KB + tt * 144 + part * 32 + hh * 16) = (u32x4){pk2(kv[o8], kv[o8 + 1]), pk2(kv[o8 + 2], kv[o8 + 3]), pk2(kv[o8 + 4], kv[o8 + 5]), pk2(kv[o8 + 6], kv[o8 + 7])};
        *(u32x4*)(L + G2_KBB + tt * 144 + part * 32 + hh * 16) = (u32x4){pk2(kb[o8], kb[o8 + 1]), pk2(kb[o8 + 2], kb[o8 + 3]), pk2(kb[o8 + 4], kb[o8 + 5]), pk2(kb[o8 + 6], kb[o8 + 7])};
        *(u32x4*)(L + G2_QB + tt * 144 + part * 32 + hh * 16) = (u32x4){pk2(qv[o8], qv[o8 + 1]), pk2(qv[o8 + 2], qv[o8 + 3]), pk2(qv[o8 + 4], qv[o8 + 5]), pk2(qv[o8 + 6], qv[o8 + 7])}; }
      const int ptt = kperm(tt);
#pragma unroll
      for (int e = 0; e < 16; ++e) { const int d = part * 16 + e;
        *(bf16_t*)(L + G2_VBT + d * 144 + tt * 2) = f2bf(vv[e] * beta);
        *(bf16_t*)(L + G2_KBET + d * 144 + tt * 2) = f2bf(kb[e] * eg);
        *(bf16_t*)(gb + 8192 + tt * 128 + kperm(d) * 2) = f2bf(qv[e] * eg);
        *(bf16_t*)(gb + 3 * 8192 + d * 128 + ptt * 2) = f2bf(kv[e] * ekl); } }
    __syncthreads();
    const int rowb = (w4 * 16 + fq * 4) * 144 + fr * 2;
    const int colb = fr * 144 + (w4 * 16 + fq * 4) * 2;
    const int fa = (w4 * 16 + fr) * 144 + fq * 16;
    const int fb = fr * 144 + fq * 16;
    const int i0 = w4 * 16 + fq * 4;
#define G2F(buf, off) (*(const pg8::bf16x8*)(L + (buf) + (off)))
#define G2W16(buf, off, v) (*(bf16_t*)(L + (buf) + (off)) = f2bf(v))
    f32x4 Pt[4];
    { const float gi0 = sc[64 + i0], gi1 = sc[64 + i0 + 1], gi2 = sc[64 + i0 + 2], gi3 = sc[64 + i0 + 3];
#pragma unroll
    for (int u = 0; u < 4; ++u) {
      f32x4 dl = {0.f, 0.f, 0.f, 0.f}, da = {0.f, 0.f, 0.f, 0.f};
#pragma unroll
      for (int ks = 0; ks < 2; ++ks) { const pg8::bf16x8 bk = G2F(G2_KB, fb + u * 2304 + ks * 64);
        dl = __builtin_amdgcn_mfma_f32_16x16x32_bf16(G2F(G2_KBB, fa + ks * 64), bk, dl, 0, 0, 0);
        da = __builtin_amdgcn_mfma_f32_16x16x32_bf16(G2F(G2_QB, fa + ks * 64), bk, da, 0, 0, 0); }
      const int j = u * 16 + fr; const float gj = sc[64 + j]; const int pj = kperm(j);
      const float dec0 = __expf(fminf(gi0 - gj, 0.f)), dec1 = __expf(fminf(gi1 - gj, 0.f)), dec2 = __expf(fminf(gi2 - gj, 0.f)), dec3 = __expf(fminf(gi3 - gj, 0.f));
      const float l0 = i0 + 0 > j ? dl.x * dec0 : 0.f, l1 = i0 + 1 > j ? dl.y * dec1 : 0.f, l2 = i0 + 2 > j ? dl.z * dec2 : 0.f, l3 = i0 + 3 > j ? dl.w * dec3 : 0.f;
      const float a0 = i0 + 0 >= j ? da.x * dec0 : 0.f, a1 = i0 + 1 >= j ? da.y * dec1 : 0.f, a2 = i0 + 2 >= j ? da.z * dec2 : 0.f, a3 = i0 + 3 >= j ? da.w * dec3 : 0.f;
      const f32x4 pv = {(i0 + 0 == j ? 1.f : 0.f) - l0, (i0 + 1 == j ? 1.f : 0.f) - l1, (i0 + 2 == j ? 1.f : 0.f) - l2, (i0 + 3 == j ? 1.f : 0.f) - l3};
      G2W16(G2_XR0, rowb + u * 32, l0); G2W16(G2_XR0, rowb + 144 + u * 32, l1); G2W16(G2_XR0, rowb + 288 + u * 32, l2); G2W16(G2_XR0, rowb + 432 + u * 32, l3);
      G2W16(G2_PR0, rowb + u * 32, pv.x); G2W16(G2_PR0, rowb + 144 + u * 32, pv.y); G2W16(G2_PR0, rowb + 288 + u * 32, pv.z); G2W16(G2_PR0, rowb + 432 + u * 32, pv.w);
      *(u32x2*)(L + G2_XT0 + colb + u * 2304) = (u32x2){pk2(l0, l1), pk2(l2, l3)};
      bf16_t* am = (bf16_t*)(gb + 2 * 8192 + i0 * 128 + pj * 2);
      am[0] = f2bf(a0); am[64] = f2bf(a1); am[128] = f2bf(a2); am[192] = f2bf(a3);
      Pt[u] = pv; } }
    __syncthreads();
#pragma unroll
    for (int u = 0; u < 4; ++u) {
      f32x4 d = {0.f, 0.f, 0.f, 0.f};
#pragma unroll
      for (int ks = 0; ks < 2; ++ks) d = __builtin_amdgcn_mfma_f32_16x16x32_bf16(G2F(G2_XR0, fa + ks * 64), G2F(G2_XT0, fb + u * 2304 + ks * 64), d, 0, 0, 0);
      G2W16(G2_KB, rowb + u * 32, d.x); G2W16(G2_KB, rowb + 144 + u * 32, d.y); G2W16(G2_KB, rowb + 288 + u * 32, d.z); G2W16(G2_KB, rowb + 432 + u * 32, d.w);
      *(u32x2*)(L + G2_KBB + colb + u * 2304) = (u32x2){pk2(d.x, d.y), pk2(d.z, d.w)}; }
    __syncthreads();
#pragma unroll
    for (int itn = 0; itn < 4; ++itn) {
      const int XRc = (itn & 1) ? G2_XR0 : G2_KB, XTc = (itn & 1) ? G2_XT0 : G2_KBB, XRn = (itn & 1) ? G2_KB : G2_XR0, XTn = (itn & 1) ? G2_KBB : G2_XT0;
      const int PRc = (itn & 1) ? G2_QB : G2_PR0, PRn = (itn & 1) ? G2_PR0 : G2_QB;
#pragma unroll
      for (int u = 0; u < 4; ++u) {
        f32x4 d = {0.f, 0.f, 0.f, 0.f};
#pragma unroll
        for (int ks = 0; ks < 2; ++ks) { const pg8::bf16x8 bx = G2F(XTc, fb + u * 2304 + ks * 64);
          Pt[u] = __builtin_amdgcn_mfma_f32_16x16x32_bf16(G2F(PRc, fa + ks * 64), bx, Pt[u], 0, 0, 0);
          if (itn < 3) d = __builtin_amdgcn_mfma_f32_16x16x32_bf16(G2F(XRc, fa + ks * 64), bx, d, 0, 0, 0); }
        G2W16(PRn, rowb + u * 32, Pt[u].x); G2W16(PRn, rowb + 144 + u * 32, Pt[u].y); G2W16(PRn, rowb + 288 + u * 32, Pt[u].z); G2W16(PRn, rowb + 432 + u * 32, Pt[u].w);
        if (itn < 3) { G2W16(XRn, rowb + u * 32, d.x); G2W16(XRn, rowb + 144 + u * 32, d.y); G2W16(XRn, rowb + 288 + u * 32, d.z); G2W16(XRn, rowb + 432 + u * 32, d.w);
          *(u32x2*)(L + XTn + colb + u * 2304) = (u32x2){pk2(d.x, d.y), pk2(d.z, d.w)}; } }
      __syncthreads();
    }
#pragma unroll
    for (int u = 0; u < 4; ++u) {
      f32x4 du = {0.f, 0.f, 0.f, 0.f}, dw = {0.f, 0.f, 0.f, 0.f};
#pragma unroll
      for (int ks = 0; ks < 2; ++ks) { const pg8::bf16x8 a = G2F(G2_PR0, fa + ks * 64);
        du = __builtin_amdgcn_mfma_f32_16x16x32_bf16(a, G2F(G2_VBT, fb + u * 2304 + ks * 64), du, 0, 0, 0);
        dw = __builtin_amdgcn_mfma_f32_16x16x32_bf16(a, G2F(G2_KBET, fb + u * 2304 + ks * 64), dw, 0, 0, 0); }
      const int j = u * 16 + fr, pj = kperm(j);
      *(u32x2*)(gb + 4 * 8192 + j * 128 + i0 * 2) = (u32x2){pk2(du.x, du.y), pk2(du.z, du.w)};
      bf16_t* wn = (bf16_t*)(gb + i0 * 128 + pj * 2);
      wn[0] = f2bf(-dw.x); wn[64] = f2bf(-dw.y); wn[128] = f2bf(-dw.z); wn[192] = f2bf(-dw.w); }
#undef G2F
#undef G2W16
  }
}

constexpr int GS_SLOT = 46208, GS_OB = 2 * GS_SLOT;
__device__ void phase_gdn_scan(const Ctx& c, unsigned char* L, int item) {
  unsigned char* ws = c.ws;
  const int tid = phase_tid(), lane = tid & 63, wave = tid >> 6, fr = lane & 15, fq = lane >> 4;
  const int b = item / 6, h = item % 6;
  const bf16_t* GB = (const bf16_t*)(ws + WS_GB); bf16_t* CAT = (bf16_t*)(ws + WS_CAT); const float* gng = c.in[9];
  const int lt = tid - 256;
  u32x4 ra[10], rb[10]; float gla = 0.f, glb = 0.f;
  f32x4 S[4];
#pragma unroll
  for (int i = 0; i < 4; ++i) S[i] = (f32x4){0.f, 0.f, 0.f, 0.f};
#define GS_LOAD(R, G, n) do { if ((n) < 64) { const unsigned char* gb_ = gd_item(ws, item * 64 + (n)); _Pragma("unroll") for (int i_ = 0; i_ < 10; ++i_) R[i_] = *(const u32x4*)(gb_ + (size_t)(lt + 256 * i_) * 16); if (lt == 0) G = *(const float*)(gb_ + 40960); } } while (0)
#define GS_STORE(R, G, slot) do { _Pragma("unroll") for (int i_ = 0; i_ < 10; ++i_) { const int p_ = lt + 256 * i_; *(u32x4*)(L + (slot) * GS_SLOT + (p_ >> 9) * 9216 + ((p_ >> 3) & 63) * 144 + (p_ & 7) * 16) = R[i_]; } if (lt == 0) *(float*)(L + (slot) * GS_SLOT + 46080) = G; } while (0)
  float gnr[16];
#pragma unroll
  for (int e = 0; e < 16; ++e) gnr[e] = gng[((tid - 256) & 3) * 16 + e];
  auto zload = [&](int k, u32x4& z0, u32x4& z1) {
    const size_t r = (size_t)b * SEQ + k * 64 + (lt >> 2); const bf16_t* zp = GB + r * 1536 + 1152 + h * 64 + (lt & 3) * 16; z0 = *(const u32x4*)zp; z1 = *(const u32x4*)(zp + 8); };
  auto post = [&](int k, const u32x4 z0, const u32x4 z1) {
    const unsigned char* ob = L + GS_OB + (k & 1) * 9216; const int tk = lt >> 2, part = lt & 3; const size_t r = (size_t)b * SEQ + k * 64 + tk;
    const u32x4 o0 = *(const u32x4*)(ob + tk * 144 + part * 32), o1 = *(const u32x4*)(ob + tk * 144 + part * 32 + 16);
    float ov[16] = {__uint_as_float(o0.x << 16), __uint_as_float(o0.x & 0xffff0000u), __uint_as_float(o0.y << 16), __uint_as_float(o0.y & 0xffff0000u), __uint_as_float(o0.z << 16), __uint_as_float(o0.z & 0xffff0000u), __uint_as_float(o0.w << 16), __uint_as_float(o0.w & 0xffff0000u),
                    __uint_as_float(o1.x << 16), __uint_as_float(o1.x & 0xffff0000u), __uint_as_float(o1.y << 16), __uint_as_float(o1.y & 0xffff0000u), __uint_as_float(o1.z << 16), __uint_as_float(o1.z & 0xffff0000u), __uint_as_float(o1.w << 16), __uint_as_float(o1.w & 0xffff0000u)};
    float ss = 0.f;
#pragma unroll
    for (int e = 0; e < 16; ++e) ss += ov[e] * ov[e];
    ss += __shfl_xor(ss, 1); ss += __shfl_xor(ss, 2);
    const float rstd = rsqrtf(ss * (1.f / 64.f) + 1e-6f);
    const float zf[16] = {__uint_as_float(z0.x << 16), __uint_as_float(z0.x & 0xffff0000u), __uint_as_float(z0.y << 16), __uint_as_float(z0.y & 0xffff0000u), __uint_as_float(z0.z << 16), __uint_as_float(z0.z & 0xffff0000u), __uint_as_float(z0.w << 16), __uint_as_float(z0.w & 0xffff0000u),
                          __uint_as_float(z1.x << 16), __uint_as_float(z1.x & 0xffff0000u), __uint_as_float(z1.y << 16), __uint_as_float(z1.y & 0xffff0000u), __uint_as_float(z1.z << 16), __uint_as_float(z1.z & 0xffff0000u), __uint_as_float(z1.w << 16), __uint_as_float(z1.w & 0xffff0000u)};
#pragma unroll
    for (int e = 0; e < 16; ++e) ov[e] = ov[e] * rstd * gnr[e] * silu_f(zf[e]);
    bf16_t* op = CAT + r * 1024 + 384 + h * 64 + part * 16;
    *(u32x4*)op = (u32x4){pk2(ov[0], ov[1]), pk2(ov[2], ov[3]), pk2(ov[4], ov[5]), pk2(ov[6], ov[7])};
    *(u32x4*)(op + 8) = (u32x4){pk2(ov[8], ov[9]), pk2(ov[10], ov[11]), pk2(ov[12], ov[13]), pk2(ov[14], ov[15])};
  };
  auto step = [&](int k) {
    const unsigned char* sb = L + (k & 1) * GS_SLOT; const float gl = *(const float*)(sb + 46080);
    const pg8::bf16x8 Sb0 = packp(S[0], S[1]), Sb1 = packp(S[2], S[3]);
    f32x4 vn[4], o[4];
#pragma unroll
    for (int mt = 0; mt < 4; ++mt) { const u32x2 uv = *(const u32x2*)(sb + 4 * 9216 + (wave * 16 + fr) * 144 + (mt * 16 + fq * 4) * 2);
      f32x4 a = {__uint_as_float(uv.x << 16), __uint_as_float(uv.x & 0xffff0000u), __uint_as_float(uv.y << 16), __uint_as_float(uv.y & 0xffff0000u)};
      a = __builtin_amdgcn_mfma_f32_16x16x32_bf16(ldsfrag(sb, mt * 16 + fr, 0, fq), Sb0, a, 0, 0, 0);
      vn[mt] = __builtin_amdgcn_mfma_f32_16x16x32_bf16(ldsfrag(sb, mt * 16 + fr, 1, fq), Sb1, a, 0, 0, 0);
      f32x4 q = {0.f, 0.f, 0.f, 0.f};
      q = __builtin_amdgcn_mfma_f32_16x16x32_bf16(ldsfrag(sb + 9216, mt * 16 + fr, 0, fq), Sb0, q, 0, 0, 0);
      o[mt] = __builtin_amdgcn_mfma_f32_16x16x32_bf16(ldsfrag(sb + 9216, mt * 16 + fr, 1, fq), Sb1, q, 0, 0, 0); }
    const pg8::bf16x8 Vb0 = packp(vn[0], vn[1]), Vb1 = packp(vn[2], vn[3]);
#pragma unroll
    for (int mt = 0; mt < 4; ++mt) { o[mt] = __builtin_amdgcn_mfma_f32_16x16x32_bf16(ldsfrag(sb + 2 * 9216, mt * 16 + fr, 0, fq), Vb0, o[mt], 0, 0, 0);
      o[mt] = __builtin_amdgcn_mfma_f32_16x16x32_bf16(ldsfrag(sb + 2 * 9216, mt * 16 + fr, 1, fq), Vb1, o[mt], 0, 0, 0); }
#pragma unroll
    for (int kt = 0; kt < 4; ++kt) { f32x4 sv = S[kt] * gl;
      sv = __builtin_amdgcn_mfma_f32_16x16x32_bf16(ldsfrag(sb + 3 * 9216, kt * 16 + fr, 0, fq), Vb0, sv, 0, 0, 0);
      S[kt] = __builtin_amdgcn_mfma_f32_16x16x32_bf16(ldsfrag(sb + 3 * 9216, kt * 16 + fr, 1, fq), Vb1, sv, 0, 0, 0); }
    unsigned char* ob = L + GS_OB + (k & 1) * 9216 + (wave * 16 + fr) * 2;
#pragma unroll
    for (int mt = 0; mt < 4; ++mt) { const int t0 = mt * 16 + fq * 4;
      *(bf16_t*)(ob + (t0 + 0) * 144) = f2bf(o[mt].x); *(bf16_t*)(ob + (t0 + 1) * 144) = f2bf(o[mt].y); *(bf16_t*)(ob + (t0 + 2) * 144) = f2bf(o[mt].z); *(bf16_t*)(ob + (t0 + 3) * 144) = f2bf(o[mt].w); }
  };
  __syncthreads();
  u32x4 z0a = {0u, 0u, 0u, 0u}, z0b = z0a, z1a = z0a, z1b = z0a;
  if (wave >= 4) { GS_LOAD(ra, gla, 0); GS_STORE(ra, gla, 0); GS_LOAD(ra, gla, 1); GS_LOAD(rb, glb, 2); zload(0, z0a, z0b); }
  __syncthreads();
#define SCAN_BAR() do { asm volatile("s_waitcnt lgkmcnt(0)" ::: "memory"); __builtin_amdgcn_s_barrier(); asm volatile("" ::: "memory"); } while (0)
  if (wave < 4) {
#pragma unroll 1
    for (int k = 0; k < 64; ++k) { step(k); SCAN_BAR(); }
  } else {
#define GS_LSTEP(R, G, ZA, ZB, kk) do { if ((kk) + 1 < 64) GS_STORE(R, G, ((kk) + 1) & 1); GS_LOAD(R, G, (kk) + 3); if ((kk) > 0) post((kk) - 1, ZA, ZB); if ((kk) + 1 < 64) zload((kk) + 1, ZA, ZB); SCAN_BAR(); } while (0)
#pragma unroll 1
    for (int k = 0; k < 64; k += 2) { GS_LSTEP(ra, gla, z1a, z1b, k); GS_LSTEP(rb, glb, z0a, z0b, k + 1); }
    post(63, z1a, z1b);
#undef GS_LSTEP
  }
#undef SCAN_BAR
#undef GS_LOAD
#undef GS_STORE
}

__device__ __forceinline__ f32x4 bf4(u32x2 p) { return (f32x4){__uint_as_float(p.x << 16), __uint_as_float(p.x & 0xffff0000u), __uint_as_float(p.y << 16), __uint_as_float(p.y & 0xffff0000u)}; }
__device__ void phase_router(const Ctx& c, unsigned char* ldsb) {
  unsigned char* ws = c.ws;
  const int tid = phase_tid(), lane = tid & 63, wave = tid >> 6, fr = lane & 15, fq = lane >> 4;
  float* lg = (float*)(ldsb + wave * 5632);
  const float* bg = c.in[17]; const float* br = c.in[19]; const float* g1 = c.in[14]; const float* b1 = c.in[15];
  const bf16_t* WR = (const bf16_t*)(ws + WS_WR); bf16_t* X1B = (bf16_t*)(ws + WS_X1B);
  unsigned* ctl = (unsigned*)(ws + WS_CTL);
  unsigned* LIST = (unsigned*)(ws + WS_LIST); float* GATEL = (float*)(ws + WS_GATEL); unsigned* TSLOT = (unsigned*)(ws + WS_TSLOT);
  unsigned* cntl = (unsigned*)(ldsb + 46080); unsigned* basel = cntl + 64;
  __syncthreads();
  if (tid < 64) cntl[tid] = 0u;
  __syncthreads();
  for (int tile = blockIdx.x * NWAVES + wave; tile < T / 16; tile += gridDim.x * NWAVES) {
    const int t0 = tile * 16;
    float mean_t = 0.f, rstd_t = 0.f;
#pragma unroll 2
    for (int i = 0; i < 16; ++i) { const u32x2* row = (const u32x2*)(X1B + (size_t)(t0 + i) * 1024);
      f32x4 v[4]; float sm = 0.f;
#pragma unroll
      for (int j = 0; j < 4; ++j) { v[j] = bf4(row[lane + 64 * j]); sm += (v[j].x + v[j].y) + (v[j].z + v[j].w); }
      const float mean = wave_sum(sm) * (1.f / 1024.f); float s2 = 0.f;
#pragma unroll
      for (int j = 0; j < 4; ++j) { v[j] = v[j] - mean; s2 += (v[j].x * v[j].x + v[j].y * v[j].y) + (v[j].z * v[j].z + v[j].w * v[j].w); }
      const float rstd = rsqrtf(wave_sum(s2) * (1.f / 1024.f) + 1e-5f);
      if (fr == i) { mean_t = mean; rstd_t = rstd; } }
    f32x4 acc[5];
#pragma unroll
    for (int nt = 0; nt < 5; ++nt) acc[nt] = (f32x4){0.f, 0.f, 0.f, 0.f};
    bf16_t* xp = X1B + (size_t)(t0 + fr) * 1024 + fq * 8; unsigned char* x8 = ws + WS_X1F + (size_t)(t0 + fr) * 1024 + fq * 8;
#pragma unroll 2
    for (int ks = 0; ks < 32; ++ks) {
      const u32x4 yv = *(const u32x4*)(xp + ks * 32);
      const f32x4 ga = *(const f32x4*)(g1 + ks * 32 + fq * 8), gb2 = *(const f32x4*)(g1 + ks * 32 + fq * 8 + 4), ba = *(const f32x4*)(b1 + ks * 32 + fq * 8), bb2 = *(const f32x4*)(b1 + ks * 32 + fq * 8 + 4);
      const f32x4 y0 = {__uint_as_float(yv.x << 16), __uint_as_float(yv.x & 0xffff0000u), __uint_as_float(yv.y << 16), __uint_as_float(yv.y & 0xffff0000u)};
      const f32x4 y1 = {__uint_as_float(yv.z << 16), __uint_as_float(yv.z & 0xffff0000u), __uint_as_float(yv.w << 16), __uint_as_float(yv.w & 0xffff0000u)};
      const f32x4 n0 = (y0 - mean_t) * rstd_t * ga + ba, n1 = (y1 - mean_t) * rstd_t * gb2 + bb2;
      const u32x4 xw = {cvtpk_c(n0.x, n0.y), cvtpk_c(n0.z, n0.w), cvtpk_c(n1.x, n1.y), cvtpk_c(n1.z, n1.w)};
      *(u32x4*)(xp + ks * 32) = xw;
      *(u32x2*)(x8 + ks * 32) = (u32x2){cvt4_fp8(n0.x, n0.y, n0.z, n0.w), cvt4_fp8(n1.x, n1.y, n1.z, n1.w)};
      const pg8::bf16x8 bx = __builtin_bit_cast(pg8::bf16x8, xw);
#pragma unroll
      for (int nt = 0; nt < 5; ++nt) acc[nt] = __builtin_amdgcn_mfma_f32_16x16x32_bf16(*(const pg8::bf16x8*)(WR + (size_t)(nt * 16 + fr) * 1024 + ks * 32 + fq * 8), bx, acc[nt], 0, 0, 0); }
#pragma unroll
    for (int nt = 0; nt < 5; ++nt) { const int o = nt * 16 + fq * 4; *(f32x4*)(lg + fr * 88 + o) = acc[nt]; }
    asm volatile("s_waitcnt lgkmcnt(0)" ::: "memory");
    int ex1 = 0, ex2 = 0; float gt1 = 0.f, gt2 = 0.f; unsigned lr1 = 0u, lr2 = 0u;
    if (lane < 16) {
      const float* l = lg + lane * 88;
      int grp = 0; float gm = l[0] + bg[0];
      for (int i = 1; i < 8; ++i) { const float v = l[i] + bg[i]; if (v > gm) { gm = v; grp = i; } }
      float gs = 0.f; for (int i = 0; i < 8; ++i) gs += __expf(l[i] + bg[i] - gm);
      const float pgrp = 1.f / gs;
      const float* el = l + 8 + grp * 8; const float* eb = br + grp * 8;
      int i1 = 0; float m1 = el[0] + eb[0]; for (int i = 1; i < 8; ++i) { const float v = el[i] + eb[i]; if (v > m1) { m1 = v; i1 = i; } }
      int i2 = -1; float m2 = -3.0e38f; for (int i = 0; i < 8; ++i) { const float v = el[i] + eb[i]; if (i != i1 && v > m2) { m2 = v; i2 = i; } }
      const float e2 = __expf(m2 - m1), den = 1.f / (1.f + e2);
      gt1 = pgrp * den; gt2 = pgrp * e2 * den;
      ex1 = grp * 8 + i1; ex2 = grp * 8 + i2;
      lr1 = atomicAdd(&cntl[ex1], 1u); lr2 = atomicAdd(&cntl[ex2], 1u);
    }
    __syncthreads();
    if (wave == 0) { const unsigned nloc = cntl[lane]; basel[lane] = nloc ? atomicAdd(&ctl[CW_CNT + lane], nloc) : 0u; }
    __syncthreads();
    if (lane < 16) {
      const int t = t0 + lane; const unsigned r1 = basel[ex1] + lr1, r2 = basel[ex2] + lr2;
      LIST[(size_t)ex1 * 32768 + r1] = (unsigned)t; GATEL[(size_t)ex1 * 32768 + r1] = gt1;
      LIST[(size_t)ex2 * 32768 + r2] = (unsigned)t; GATEL[(size_t)ex2 * 32768 + r2] = gt2;
      TSLOT[(size_t)t * 2 + 0] = ((unsigned)ex1 << 16) | r1; TSLOT[(size_t)t * 2 + 1] = ((unsigned)ex2 << 16) | r2;
    }
    __syncthreads();
    if (tid < 64) cntl[tid] = 0u;
    __syncthreads();
  }
}

__device__ void phase_combine(const Ctx& c, float* lds) {
  unsigned char* ws = c.ws;
  const int tid = phase_tid(), lane = tid & 63, wave = tid >> 6;
  int* offs = (int*)lds; int* cnts = offs + 65;
  expert_offsets(c, offs, cnts, tid);
  const unsigned char* Y = (const unsigned char*)(ws + WS_Y); const unsigned* TSLOT = (const unsigned*)(ws + WS_TSLOT);
  const float* g2 = c.in[23]; const float* b2 = c.in[24];
  for (int t = blockIdx.x * NWAVES + wave; t < T; t += gridDim.x * NWAVES) {
    const unsigned s0 = TSLOT[(size_t)t * 2], s1 = TSLOT[(size_t)t * 2 + 1];
    const size_t r0 = (size_t)offs[s0 >> 16] + (s0 & 0xffffu), r1 = (size_t)offs[s1 >> 16] + (s1 & 0xffffu);
    f32x4* row = (f32x4*)(c.out + (size_t)t * 1024); const u32x2* xrow = (const u32x2*)((const bf16_t*)(ws + WS_X1B) + (size_t)t * 1024);
    f32x4 v[4]; float s = 0.f;
#pragma unroll
    for (int j = 0; j < 4; ++j) { const unsigned ya = ((const unsigned*)(Y + r0 * 1024))[lane + 64 * j], yb = ((const unsigned*)(Y + r1 * 1024))[lane + 64 * j];
      f32x4 x = bf4(xrow[lane + 64 * j]) * ALPHA;
      const hw_f32x2 a01 = __builtin_amdgcn_cvt_pk_f32_fp8(ya, false), a23 = __builtin_amdgcn_cvt_pk_f32_fp8(ya, true), b01 = __builtin_amdgcn_cvt_pk_f32_fp8(yb, false), b23 = __builtin_amdgcn_cvt_pk_f32_fp8(yb, true);
      x.x += (a01.x + b01.x) * 0.015625f; x.y += (a01.y + b01.y) * 0.015625f; x.z += (a23.x + b23.x) * 0.015625f; x.w += (a23.y + b23.y) * 0.015625f;
      v[j] = x; s += (x.x + x.y) + (x.z + x.w); }
    const float mean = wave_sum(s) * (1.f / 1024.f); float s2 = 0.f;
#pragma unroll
    for (int j = 0; j < 4; ++j) { v[j] = v[j] - mean; s2 += (v[j].x * v[j].x + v[j].y * v[j].y) + (v[j].z * v[j].z + v[j].w * v[j].w); }
    const float rstd = rsqrtf(wave_sum(s2) * (1.f / 1024.f) + 1e-5f);
#pragma unroll
    for (int j = 0; j < 4; ++j) { const f32x4 g = ((const f32x4*)g2)[lane + 64 * j], bb = ((const f32x4*)b2)[lane + 64 * j]; row[lane + 64 * j] = v[j] * rstd * g + bb; }
  }
}

constexpr int NPHASE = 11;
__global__ void __launch_bounds__(NTHREADS, 2) mega(Ctx c) {
  float* lds = (float*)lds_raw;
  unsigned* ctl = (unsigned*)(c.ws + WS_CTL);
  unsigned* bar = ctl + CW_BAR;
  if (threadIdx.x == 0) { *(volatile unsigned*)(lds_raw + LDS_WCTR) = 0u; *(volatile unsigned*)(lds_raw + LDS_XBST) = 0u; *(volatile unsigned*)(lds_raw + LDS_XBST + 4) = 0u;
    (void)xb_add(&bar[XB_XCNT(xb_xcc_id())], 1u); }
  __syncthreads();
  phase_prologue(c, lds);
  xcd_barrier(bar);
  phase_inproj_mfma(c, (lds_u8*)lds_raw);
  phase_tiles_queue(c, lds, ctl + CW_Q + 48, TP_WD0 - TP_D1, TP_WD0);
  xcd_barrier(bar);
  phase_gdn_prep2(c, lds_raw);
  phase_kvup(c, lds);
  phase_topk_mfma(c, lds_raw, ctl + CW_Q);
  xcd_barrier(bar);
  if (blockIdx.x < 48) phase_gdn_scan(c, lds_raw, blockIdx.x);
  phase_attn_sparse(c, lds_raw, ctl + CW_Q + 16);
  phase_attn_mem(c, lds_raw, ctl + CW_Q + 32);
  xcd_barrier(bar);
  phase_outproj_mfma(c, (lds_u8*)lds_raw);
  xcd_barrier(bar);
  phase_router(c, lds_raw);
  xcd_barrier(bar);
  phase_moe_up_mfma(c, (lds_u8*)lds_raw);
  phase_tiles_queue(c, lds, ctl + CW_Q + 64, TP_WD0, TP_TOTAL);
  xcd_barrier(bar);
  phase_moe_down_mfma(c, (lds_u8*)lds_raw);
  xcd_barrier(bar);
  phase_combine(c, lds);
}

extern "C" void kernel_launch(void* const* d_in, const int* in_sizes, int n_in, void* d_out, int out_size, void* d_ws, size_t ws_size, hipStream_t stream) {
  static int grid = 0;
  if (grid == 0) {
    if (n_in != 25 || ws_size < WS_END) { fprintf(stderr, "kernel_launch: unexpected n_in %d / ws %zu\n", n_in, ws_size); grid = -1; return; }
    int dev = 0, cus = 0, per_cu = 0;
    hipGetDevice(&dev); hipDeviceGetAttribute(&cus, hipDeviceAttributeMultiprocessorCount, dev);
    hipFuncSetAttribute((const void*)mega, hipFuncAttributeMaxDynamicSharedMemorySize, LDS_BYTES);
    hipOccupancyMaxActiveBlocksPerMultiprocessor(&per_cu, (const void*)mega, NTHREADS, LDS_BYTES);
    if (per_cu < 1) { fprintf(stderr, "kernel_launch: occupancy query says %d blocks/CU\n", per_cu); per_cu = 1; }
    grid = cus * (per_cu < 1 ? 1 : 1);
    (void)hipGetLastError();
  }
  if (grid < 0) return;
  hipMemsetAsync((char*)d_ws + WS_CTL, 0, 32 * 1024, stream);
  Ctx c; memset(&c, 0, sizeof(c));
  for (int i = 0; i < 25; ++i) c.in[i] = (const float*)d_in[i];
  c.out = (float*)d_out; c.ws = (unsigned char*)d_ws;
  hipLaunchKernelGGL(mega, dim3(grid), dim3(NTHREADS), LDS_BYTES, stream, c);
}
```

```cpp
#include <hip/hip_runtime.h>
#include <cstdio>
#include <cstdint>
#include <cstring>

#ifndef ONE_LAUNCH
#define ONE_LAUNCH 1
#endif

typedef unsigned short bf16_t;
typedef float f32x4 __attribute__((ext_vector_type(4)));
typedef unsigned u32x4 __attribute__((ext_vector_type(4)));
typedef unsigned u32x2 __attribute__((ext_vector_type(2)));

constexpr int T = 32768, DM = 1024, SEQ = 4096, NBATCH = 8;
constexpr int NIN = 2816;
constexpr int NMEM = 256, TM = NBATCH * NMEM;
constexpr int NEXP = 64, DE = 256;
constexpr int NTHREADS = 512, NWAVES = 8;
constexpr float ALPHA = 1.189207115002721f;
constexpr float LOG2E = 1.4426950408889634f;
constexpr float QSCALE = 0.125f * LOG2E;

constexpr size_t MiB = 1ull << 20;
constexpr size_t WS_CTL = 0;
constexpr size_t WS_TSLOT = 512 * 1024;
constexpr size_t WS_ROPE = 1 * MiB;
constexpr size_t WS_WKV = 2 * MiB;
constexpr size_t WS_WR = 2 * MiB + 65536;
constexpr size_t WS_WIN = 3 * MiB;
constexpr size_t WS_WO = 9 * MiB;
constexpr size_t WS_WMKV = 11 * MiB;
constexpr size_t WS_MEMB = 12 * MiB;
constexpr size_t WS_WGU = 16 * MiB;
constexpr size_t WS_WD = 80 * MiB;
constexpr size_t WS_XB = 112 * MiB;
constexpr size_t WS_QA = 176 * MiB;
constexpr size_t WS_CKV = 200 * MiB;
constexpr size_t WS_IQ = 208 * MiB;
constexpr size_t WS_IK = 224 * MiB;
constexpr size_t WS_SM = 228 * MiB;
constexpr size_t WS_QC = 230 * MiB;
constexpr size_t WS_GB = 246 * MiB;
constexpr size_t WS_X1F = WS_GB;
constexpr float W8SCALE = 32.f, H8SCALE = 8.f;
constexpr size_t WS_MK = 342 * MiB;
constexpr size_t WS_MVT = 343 * MiB;
constexpr size_t WS_KVA = 344 * MiB;
constexpr size_t WS_SEL = 352 * MiB;
constexpr size_t WS_CAT = 368 * MiB;
constexpr size_t WS_X1B = 432 * MiB;
constexpr size_t WS_LIST = 496 * MiB;
constexpr size_t WS_GATEL = 504 * MiB;
constexpr size_t WS_END = 512 * MiB;
constexpr size_t WS_H = 112 * MiB;
constexpr size_t WS_Y = 160 * MiB;

constexpr int CW_CNT = 0;
constexpr int CW_Q = 64;
constexpr int CW_BAR = 4096;

struct Ctx {
  const float* in[25];
  float* out;
  unsigned char* ws;
  int ph_lo, ph_hi;
};


extern __shared__ __attribute__((aligned(16))) unsigned char lds_raw[];
constexpr int LDS_BYTES = 157696;
constexpr int LDS_WCTR = LDS_BYTES - 64;
__device__ __forceinline__ int phase_tid() {
  __syncthreads();
  int l; asm volatile("v_mbcnt_lo_u32_b32 %0, -1, 0\n\tv_mbcnt_hi_u32_b32 %0, -1, %0" : "=v"(l));
  unsigned w = 0u;
  if (l == 0) w = __hip_atomic_fetch_add((__attribute__((address_space(3))) unsigned*)(__attribute__((address_space(3))) unsigned char*)(lds_raw + LDS_WCTR), 1u, __ATOMIC_RELAXED, __HIP_MEMORY_SCOPE_WORKGROUP);
  w = (unsigned)__builtin_amdgcn_readfirstlane((int)w) & 7u;
  return (int)(w * 64u) + l;
}


#define XB_TMO      128
#define XB_XCNT(j)  (256  + 64 * (j))
#define XB_XSUB(j)  (1280 + 64 * (j))
#define XB_XGEN(j)  (2304 + 64 * (j))
#define XB_TOP      3328
#define XB_TOPGEN   3392
#define XCD_BAR_WORDS 3456
#define XB_SPIN_CAP (1u << 18)
constexpr int LDS_XBST = LDS_BYTES - 32;
__device__ __forceinline__ unsigned xb_ld(unsigned* p)              { return __hip_atomic_load(p, __ATOMIC_RELAXED, __HIP_MEMORY_SCOPE_AGENT); }
__device__ __forceinline__ unsigned xb_add(unsigned* p, unsigned v) { return __hip_atomic_fetch_add(p, v, __ATOMIC_RELAXED, __HIP_MEMORY_SCOPE_AGENT); }
__device__ __forceinline__ unsigned xb_xcc_id() { return (unsigned)__builtin_amdgcn_s_getreg((3 << 11) | 20) & 0xFu; }
#define XB_SPIN(cond, bar) do { unsigned _sp = 0; while (cond) { __builtin_amdgcn_s_sleep(1); \
    if ((++_sp & 255u) == 0u) { if (xb_ld(&(bar)[XB_TMO])) break; if (_sp > XB_SPIN_CAP) { atomicAdd(&(bar)[XB_TMO], 1u); break; } } } } while (0)
__device__ __forceinline__ void xcd_barrier_complete(unsigned* bar, unsigned x, unsigned& nloc, unsigned& nx) {
    const unsigned G = gridDim.x;
    unsigned sum, cnt, mine, sp = 0u;
    for (;;) {
        sum = 0u; cnt = 0u; mine = 0u;
#pragma unroll
        for (unsigned j = 0; j < 16; ++j) { const unsigned cc = xb_ld(&bar[XB_XCNT(j)]); sum += cc; cnt += (cc > 0u) ? 1u : 0u; mine = (j == x) ? cc : mine; }
        if (sum == G) break;
        __builtin_amdgcn_s_sleep(1);
        if ((++sp & 255u) == 0u) { if (xb_ld(&bar[XB_TMO])) break; if (sp > XB_SPIN_CAP) { atomicAdd(&bar[XB_TMO], 1u); break; } }
    }
    nloc = mine > 0u ? mine : 1u; nx = cnt > 0u ? cnt : 1u;
}
__device__ __forceinline__ void xcd_barrier(unsigned* bar) {
    asm volatile("s_waitcnt vmcnt(0)" ::: "memory");
    __syncthreads();
    const int btid = phase_tid();
    if (btid == 0) {
        volatile __attribute__((address_space(3))) unsigned* st = (volatile __attribute__((address_space(3))) unsigned*)(__attribute__((address_space(3))) unsigned char*)(lds_raw + LDS_XBST);
        const unsigned x = xb_xcc_id();
        __builtin_amdgcn_s_waitcnt(0);
        unsigned nloc = st[0], nx = st[1];
        if (nloc == 0u) { xcd_barrier_complete(bar, x, nloc, nx); st[0] = nloc; st[1] = nx; }
        const unsigned old = xb_add(&bar[XB_XSUB(x)], 1u);
        const unsigned gen = old / nloc;
        if (old + 1u == (gen + 1u) * nloc) {
            __builtin_amdgcn_fence(__ATOMIC_RELEASE, "agent");
            asm volatile("s_waitcnt vmcnt(0)" ::: "memory");
            const unsigned og = xb_add(&bar[XB_TOP], 1u);
            const unsigned tg = og / nx;
            if (og + 1u == (tg + 1u) * nx) xb_add(&bar[XB_TOPGEN], 1u);
            else XB_SPIN(xb_ld(&bar[XB_TOPGEN]) == tg, bar);
            __builtin_amdgcn_fence(__ATOMIC_ACQUIRE, "agent");
            xb_add(&bar[XB_XGEN(x)], 1u);
            asm volatile("s_waitcnt vmcnt(0)" ::: "memory");
        } else {
            XB_SPIN(xb_ld(&bar[XB_XGEN(x)]) == gen, bar);
            __builtin_amdgcn_fence(__ATOMIC_ACQUIRE, "agent");
            asm volatile("s_waitcnt vmcnt(0)" ::: "memory");
        }
    }
    __syncthreads();
}

__device__ __forceinline__ float bf2f(bf16_t v) { return __uint_as_float(((unsigned)v) << 16); }
typedef float hw_f32x2 __attribute__((ext_vector_type(2))); typedef __bf16 hw_bf16x2 __attribute__((ext_vector_type(2)));
__device__ __forceinline__ unsigned pk2(float lo, float hi) { const hw_f32x2 v = {lo, hi}; const hw_bf16x2 b = __builtin_convertvector(v, hw_bf16x2); return __builtin_bit_cast(unsigned, b); }
__device__ __forceinline__ unsigned cvt4_fp8(float a, float b, float c2, float d) { int w = __builtin_amdgcn_cvt_pk_fp8_f32(a, b, 0, false); w = __builtin_amdgcn_cvt_pk_fp8_f32(c2, d, w, true); return (unsigned)w; }
__device__ __forceinline__ long mk64(unsigned lo, unsigned hi) { return (long)(((unsigned long)hi << 32) | (unsigned long)lo); }
__device__ __forceinline__ bf16_t f2bf(float f) { return (bf16_t)(pk2(f, f) & 0xffffu); }
__device__ __forceinline__ float wave_sum(float v) {
  int x = __float_as_int(v);
  x = __float_as_int(__int_as_float(x) + __int_as_float(__builtin_amdgcn_update_dpp(0, x, 0x111, 0xF, 0xF, true)));
  x = __float_as_int(__int_as_float(x) + __int_as_float(__builtin_amdgcn_update_dpp(0, x, 0x112, 0xF, 0xF, true)));
  x = __float_as_int(__int_as_float(x) + __int_as_float(__builtin_amdgcn_update_dpp(0, x, 0x114, 0xF, 0xF, true)));
  x = __float_as_int(__int_as_float(x) + __int_as_float(__builtin_amdgcn_update_dpp(0, x, 0x118, 0xF, 0xF, true)));
  x = __float_as_int(__int_as_float(x) + __int_as_float(__builtin_amdgcn_update_dpp(0, x, 0x142, 0xA, 0xF, false)));
  x = __float_as_int(__int_as_float(x) + __int_as_float(__builtin_amdgcn_update_dpp(0, x, 0x143, 0xC, 0xF, false)));
  return __int_as_float(__builtin_amdgcn_readlane(x, 63));
}
__device__ __forceinline__ float wave_max(float v) {
#pragma unroll
  for (int o = 32; o >= 1; o >>= 1) v = fmaxf(v, __shfl_xor(v, o));
  return v;
}
__device__ __forceinline__ float silu_f(float v) { return v * __builtin_amdgcn_rcpf(1.f + __expf(-v)); }

__device__ __forceinline__ int ropeperm(int p) { return (p >> 1) + 32 * (p & 1); }
__device__ __forceinline__ int colmap_in(int cp) {
  const int tile = cp >> 8, w = cp & 255;
  if (tile == 0) return (w >> 6) * 64 + ropeperm(w & 63);
  if (tile == 1) { if (w < 128) { const int c = 256 + w; return (c >> 6) * 64 + ropeperm(c & 63); } return 384 + (w - 128); }
  if (tile == 2) return 512 + (w >> 6) * 64 + ropeperm(w & 63);
  if (tile == 3) { if (w < 64) return 768 + ropeperm(w); if (w < 68) return 832 + (w - 64); if (w < 74) return 2372 + (w - 68); if (w < 80) return 2378 + (w - 74); return -1; }
  if (tile == 4) return 2384 + w;
  return 836 + (cp - 1280);
}

struct WorkQ { unsigned* head; volatile int* slot; int nxt; };
__device__ __forceinline__ void wq_init(WorkQ& q, unsigned* head, volatile int* slot, int tid) { q.head = head; q.slot = slot; q.nxt = 0; if (tid == 0) q.nxt = (int)atomicAdd(head, 1u); }
__device__ __forceinline__ int wq_next(WorkQ& q, int tid) {
  __syncthreads();
  if (tid == 0) { *q.slot = q.nxt; q.nxt = (int)atomicAdd(q.head, 1u); }
  __syncthreads();
  return *q.slot;
}

template <bool F8 = false, class CM>
__device__ __forceinline__ void tp_tile(const float* src, int ld, bf16_t* dst, int drow0, int K, int k0, CM cm, float* lds, int tid, float sc8 = 1.f) {
  const int a = tid & 63, b = tid >> 6;
  const int sc = cm(a);
  __syncthreads();
#pragma unroll
  for (int i = 0; i < 8; ++i) { const int kk = b * 8 + i; lds[kk * 65 + a] = sc >= 0 ? src[(size_t)(k0 + kk) * ld + sc] : 0.f; }
  __syncthreads();
  { const int nn = tid >> 3, kc = (tid & 7) * 8;
    const float* p = lds + kc * 65 + nn;
    if constexpr (F8) *(u32x2*)((unsigned char*)dst + (size_t)(drow0 + nn) * K + k0 + kc) = (u32x2){cvt4_fp8(p[0] * sc8, p[65] * sc8, p[130] * sc8, p[195] * sc8), cvt4_fp8(p[260] * sc8, p[325] * sc8, p[390] * sc8, p[455] * sc8)};
    else *(u32x4*)(dst + (size_t)(drow0 + nn) * K + k0 + kc) = (u32x4){pk2(p[0], p[65]), pk2(p[130], p[195]), pk2(p[260], p[325]), pk2(p[390], p[455])}; }
}

constexpr int TP_TOTAL = (NIN / 64) * 16 + 16 * 16 + 8 * 16 + 64 * 8 * 16 + 64 * 16 * 4;
constexpr int TP_WD0 = TP_TOTAL - 64 * 16 * 4;
constexpr int TP_D1 = 5200;
__device__ __forceinline__ void prologue_tiles(const Ctx& c, float* lds, int tid, int lo, int hi, int b0, int nb) {
  unsigned char* ws = c.ws;
  const int n_win = (NIN / 64) * 16, n_wo = 16 * 16, n_wmkv = 8 * 16, n_wgu = 64 * 8 * 16, n_wd = 64 * 16 * 4;
  const int total = n_win + n_wo + n_wmkv + n_wgu + n_wd;
  for (int it = lo + b0; it < hi; it += nb) {
    int r = it;
    if (r < n_win) { const int nt = r / 16, kt = r % 16; tp_tile(c.in[2], 2640, (bf16_t*)(ws + WS_WIN), nt * 64, 1024, kt * 64, [&](int a) { return colmap_in(nt * 64 + a); }, lds, tid); continue; } r -= n_win;
    if (r < n_wo) { const int nt = r / 16, kt = r % 16; tp_tile(c.in[13], 1024, (bf16_t*)(ws + WS_WO), nt * 64, 1024, kt * 64, [&](int a) { return nt * 64 + a; }, lds, tid); continue; } r -= n_wo;
    if (r < n_wmkv) { const int nt = r / 16, kt = r % 16; tp_tile(c.in[12], 512, (bf16_t*)(ws + WS_WMKV), nt * 64, 1024, kt * 64, [&](int a) { return nt * 64 + a; }, lds, tid); continue; } r -= n_wmkv;
    if (r < n_wgu) { const int e = r / 128, q = r % 128, nt = q / 16, kt = q % 16;
      const int pn = nt >> 2, sub = nt & 3, isup = sub >> 1, c0 = pn * 128 + (sub & 1) * 64;
      const float* src = (isup ? c.in[21] : c.in[20]) + (size_t)e * 1024 * 256;
      tp_tile<true>(src, 256, (bf16_t*)(ws + WS_WGU), e * 512 + nt * 64, 1024, kt * 64, [&](int a) { return c0 + a; }, lds, tid, W8SCALE); continue; } r -= n_wgu;
    { const int e = r / 64, q = r % 64, nt = q / 4, kt = q % 4;
      tp_tile<true>(c.in[22] + (size_t)e * 256 * 1024, 1024, (bf16_t*)(ws + WS_WD), e * 1024 + nt * 64, 256, kt * 64, [&](int a) { return nt * 64 + a; }, lds, tid, W8SCALE); }
  }
}

__device__ void phase_tiles_queue(const Ctx& c, float* lds, unsigned* qhead, int lo, int hi) {
  const int tid = phase_tid();
  volatile int* slot = (volatile int*)(lds + 64 * 65 + 16);
  WorkQ wq; wq_init(wq, qhead, slot, tid);
  const int nitems = (hi - lo + 7) >> 3;
  for (;;) {
    const int item = wq_next(wq, tid);
    if (item >= nitems) break;
    const int t0 = lo + item * 8, t1 = t0 + 8 < hi ? t0 + 8 : hi;
    prologue_tiles(c, lds, tid, t0, t1, 0, 1);
  }
}

__device__ void phase_prologue(const Ctx& c, float* lds) {
  const int tid = phase_tid(), bid = blockIdx.x, G = gridDim.x;
  unsigned char* ws = c.ws;
  const size_t gtid = (size_t)bid * NTHREADS + tid, gstride = (size_t)G * NTHREADS;
  { const f32x4* x4 = (const f32x4*)c.in[0]; u32x2* o = (u32x2*)c.out;
    for (size_t i = gtid; i < (size_t)T * DM / 4; i += gstride) { const f32x4 v = x4[i]; o[i] = (u32x2){pk2(v.x, v.y), pk2(v.z, v.w)}; }
    const f32x4* m4 = (const f32x4*)c.in[1]; u32x2* om = (u32x2*)(ws + WS_MEMB);
    for (size_t i = gtid; i < (size_t)TM * DM / 4; i += gstride) { const f32x4 v = m4[i]; om[i] = (u32x2){pk2(v.x, v.y), pk2(v.z, v.w)}; } }
  { float* cs = (float*)(ws + WS_ROPE); float* sn = cs + SEQ * 32;
    for (size_t i = gtid; i < (size_t)SEQ * 32; i += gstride) { const int s = (int)(i >> 5), d = (int)(i & 31);
      const float inv = 1.0f / powf(10000.0f, (float)d / 32.0f); const float ang = (float)s * inv; float sv, cv; sincosf(ang, &sv, &cv); cs[i] = cv; sn[i] = sv; } }
  { bf16_t* wkv = (bf16_t*)(ws + WS_WKV); const float* g = c.in[3]; const float* wk = c.in[4]; const float* wv = c.in[5];
    for (size_t i = gtid; i < 128 * 128; i += gstride) { const int p = (int)(i >> 7), k = (int)(i & 127);
      const float w = p < 64 ? wk[k * 64 + ropeperm(p)] : wv[k * 64 + (p - 64)]; wkv[i] = f2bf(w * g[k]); }
    bf16_t* wr = (bf16_t*)(ws + WS_WR); const float* wg = c.in[16]; const float* wrt = c.in[18];
    for (size_t i = gtid; i < 80 * 1024; i += gstride) { const int o = (int)(i >> 10), k = (int)(i & 1023); wr[i] = f2bf(o < 8 ? wg[k * 8 + o] : o < 72 ? wrt[k * 64 + (o - 8)] : 0.f); } }
  prologue_tiles(c, lds, tid, 0, TP_WD0 - TP_D1, bid, G);
}

__device__ __forceinline__ void expert_offsets(const Ctx& c, int* offs  , int* cnts  , int tid) {
  const unsigned* ctl = (const unsigned*)(c.ws + WS_CTL);
  __syncthreads();
  if (tid == 0) { int o = 0; for (int e = 0; e < 64; ++e) { const int n = (int)ctl[CW_CNT + e]; cnts[e] = n; offs[e] = o; o += (n + 255) & ~255; } offs[64] = o; }
  __syncthreads();
}


namespace pg8 {
#define PG8_LAS __attribute__((address_space(3)))
typedef short bf16x8 __attribute__((ext_vector_type(8)));
constexpr int BM = 256, BK = 64, HALF = 128, HTB = HALF * BK * 2, STAGE_BYTES = 8 * HTB, NXCD = 8, WGM = 8, GN_STASH = STAGE_BYTES + 2048;
typedef unsigned u32x4s __attribute__((ext_vector_type(4)));
__host__ __device__ __forceinline__ int lds_byte(int r, int c) { const int st = (r >> 4) * 2 + (c >> 5), rr = r & 15, cc = c & 31, ob = rr * 64 + cc * 2; return st * 1024 + (ob ^ (((ob >> 9) & 1) << 5)); }
__host__ __device__ __forceinline__ void stage_rc(int b, int& R, int& C) { const int st = b / 1024, sb = b % 1024, swz = sb ^ (((sb >> 9) & 1) << 5); R = (st >> 1) * 16 + swz / 64; C = (st & 1) * 32 + (swz % 64) / 2; }
__host__ __device__ __forceinline__ int perm32(int rho) { const int n = rho >> 4, i = rho & 15; return 8 * (i >> 2) + 4 * n + (i & 3); }
typedef int i32x4v __attribute__((ext_vector_type(4))); typedef int i32x8 __attribute__((ext_vector_type(8))); typedef long i64x2 __attribute__((ext_vector_type(2)));
struct Unit { int pm, pn, e, mt, aux; };
struct Gemm { const bf16_t* A; const bf16_t* Bt; int K; };
struct StaticOrder {
    int nM, nN, nwg, G, c;
    __device__ void init(int M, int N, int G_, int c_) { nM = M / BM; nN = N / BM; nwg = nM * nN; G = G_; c = c_; }
    __device__ bool next(int i, Unit& u) const {
        const long L = (long)i * G + c; if (c < 0 || L >= nwg) return false;
        int wgid = (int)L; { const int q = nwg / NXCD, r = nwg % NXCD, xcd = wgid % NXCD, off = wgid / NXCD; wgid = (xcd < r ? xcd * (q + 1) : r * (q + 1) + (xcd - r) * q) + off; }
        const int nig = WGM * nN, gid = wgid / nig, fm = gid * WGM, gsz = (nM - fm) < WGM ? (nM - fm) : WGM;
        u.pm = fm + ((wgid % nig) % gsz); u.pn = (wgid % nig) / gsz; u.e = 0; u.mt = 0; u.aux = 0; return true;
    }
    __device__ __forceinline__ unsigned arow(const Unit&, int) const { return 0u; }
};
__device__ __forceinline__ unsigned cvt_pk_bf16(float lo, float hi) { unsigned r; asm volatile("v_cvt_pk_bf16_f32 %0, %1, %2" : "=v"(r) : "v"(lo), "v"(hi)); return r; }

template <class Epi, class Sched, bool ALIGN_EPI, bool GATHER, int FP8 = 0, bool BUF = false>
__device__ __forceinline__ void gemm_phase(PG8_LAS unsigned char* lds, const Gemm g, const Sched& S, const Epi& E, const int tid) {
    const int wid = __builtin_amdgcn_readfirstlane(tid >> 6), lane = tid & 63, wr = wid >> 2, wc = wid & 3, fr = lane & 15, fq = lane >> 4;
    const int K = g.K, nt = K / BK;
    unsigned voffA[2], voffB[2]; int RA[2], CA[2];
#pragma unroll
    for (int i = 0; i < 2; ++i) { int R, C; stage_rc(tid * 16 + i * 8192, R, C); const int Rb = Epi::PERM ? ((R & ~31) + perm32(R & 31)) : R;
        RA[i] = R; CA[i] = C; voffA[i] = (unsigned)(R * K + C) * 2u; voffB[i] = (unsigned)(Rb * K + C) * 2u; }
    const size_t kstep = (size_t)(BK * 2);
    const size_t hstep = (size_t)HALF * K * 2;
    const size_t tstep = 2 * hstep;
    const unsigned ldsw = (unsigned)wid * 1024u;
    const int aoff = lds_byte(wr * 64 + fr, fq * 8), boff = lds_byte(wc * 32 + fr, fq * 8);
#define PG8_FRESH_TID() ([&]() { int l_; asm volatile("v_mbcnt_lo_u32_b32 %0, -1, 0\n\tv_mbcnt_hi_u32_b32 %0, -1, %0" : "=v"(l_)); return wid * 64 + l_; }())
#define PG8_SA(b, h) (((b) * 2 + (h)) * HTB)
#define PG8_SB(b, h) ((4 + (b) * 2 + (h)) * HTB)
    const __amdgpu_buffer_rsrc_t rsA = __builtin_amdgcn_make_buffer_rsrc((void*)g.A, 0, -1, 0x00020000), rsB = __builtin_amdgcn_make_buffer_rsrc((void*)g.Bt, 0, -1, 0x00020000);
#define PG8_STAGE_X(rs, base0, bufoff, gbase, voff) do { _Pragma("unroll") for (int _i = 0; _i < 2; ++_i) { \
        if constexpr (BUF) __builtin_amdgcn_raw_ptr_buffer_load_lds(rs, (PG8_LAS void*)(lds + (bufoff) + ldsw + _i * 8192), 16, (int)(voff)[_i], (int)(unsigned)((const char*)(gbase) - (const char*)(base0)), 0, 0); \
        else __builtin_amdgcn_global_load_lds((const unsigned*)((const char*)(gbase) + (voff)[_i]), (PG8_LAS unsigned*)(lds + (bufoff) + ldsw + _i * 8192), 16, 0, 0); } } while (0)
#define PG8_STAGE(bufoff, gbase, voff) PG8_STAGE_X(rsB, g.Bt, bufoff, gbase, voff)
#define PG8_STAGE_A(bufoff, gbase, h, goff) do { if constexpr (GATHER) { PG8_STAGE_X(rsA, g.A, bufoff, gbase, (goff)[h]); } else { PG8_STAGE_X(rsA, g.A, bufoff, (gbase) + (h) * hstep, voffA); } } while (0)
#define PG8_LDA(dst, b, h) do { _Pragma("unroll") for (int m = 0; m < 4; ++m) _Pragma("unroll") for (int k = 0; k < 2; ++k) dst[m][k] = *(const PG8_LAS bf16x8*)(lds + PG8_SA(b, h) + aoff + m * 2048 + k * 1024); } while (0)
#define PG8_LDB(dst, b, h) do { _Pragma("unroll") for (int n = 0; n < 2; ++n) _Pragma("unroll") for (int k = 0; k < 2; ++k) dst[n][k] = *(const PG8_LAS bf16x8*)(lds + PG8_SB(b, h) + boff + n * 2048 + k * 1024); } while (0)
#define PG8_MMA(ai, bj, At, Bt) do { __builtin_amdgcn_s_setprio(1); \
        if constexpr (FP8 == 2) { _Pragma("unroll") for (int m = 0; m < 4; ++m) _Pragma("unroll") for (int n = 0; n < 2; ++n) { \
            const i32x8 b_ = __builtin_shufflevector(__builtin_bit_cast(i32x4v, Bt[n][0]), __builtin_bit_cast(i32x4v, Bt[n][1]), 0, 1, 2, 3, 4, 5, 6, 7), a_ = __builtin_shufflevector(__builtin_bit_cast(i32x4v, At[m][0]), __builtin_bit_cast(i32x4v, At[m][1]), 0, 1, 2, 3, 4, 5, 6, 7); \
            acc[ai][bj][m][n] = __builtin_amdgcn_mfma_scale_f32_16x16x128_f8f6f4(b_, a_, acc[ai][bj][m][n], 0, 0, 0, 0, 0, 0); } } \
        else if constexpr (FP8 == 1) { _Pragma("unroll") for (int k = 0; k < 2; ++k) _Pragma("unroll") for (int hf = 0; hf < 2; ++hf) _Pragma("unroll") for (int m = 0; m < 4; ++m) _Pragma("unroll") for (int n = 0; n < 2; ++n) { \
            const i64x2 b_ = __builtin_bit_cast(i64x2, Bt[n][k]), a_ = __builtin_bit_cast(i64x2, At[m][k]); \
            acc[ai][bj][m][n] = __builtin_amdgcn_mfma_f32_16x16x32_fp8_fp8(b_[hf], a_[hf], acc[ai][bj][m][n], 0, 0, 0); } } \
        else { _Pragma("unroll") for (int m = 0; m < 4; ++m) _Pragma("unroll") for (int n = 0; n < 2; ++n) _Pragma("unroll") for (int k = 0; k < 2; ++k) \
            acc[ai][bj][m][n] = __builtin_amdgcn_mfma_f32_16x16x32_bf16(Bt[n][k], At[m][k], acc[ai][bj][m][n], 0, 0, 0); } \
        __builtin_amdgcn_s_setprio(0); } while (0)
#define PG8_WAIT_V(n) asm volatile("s_waitcnt vmcnt(" #n ")" ::: "memory")
#define PG8_WAIT_L(n) asm volatile("s_waitcnt lgkmcnt(" #n ")" ::: "memory")
#define PG8_BAR __builtin_amdgcn_s_barrier()
#define PG8_SCHED __builtin_amdgcn_sched_barrier(0)
    Unit cur, nxt; int ui = 0;
    if (!S.next(0, cur)) return;
    f32x4 acc[2][2][4][2];
#pragma unroll
    for (int a = 0; a < 2; ++a)
#pragma unroll
        for (int b = 0; b < 2; ++b)
#pragma unroll
            for (int m = 0; m < 4; ++m)
#pragma unroll
                for (int n = 0; n < 2; ++n) acc[a][b][m][n] = (f32x4){0.f, 0.f, 0.f, 0.f};
    bf16x8 At[4][2], B0[2][2], B1[2][2];
    unsigned gc[2][2], gn[2][2];
    const char* cA; const char* cB = (const char*)g.Bt + (size_t)cur.pn * tstep;
    if constexpr (GATHER) { cA = (const char*)g.A;
#pragma unroll
        for (int h = 0; h < 2; ++h)
#pragma unroll
            for (int i = 0; i < 2; ++i) { gc[h][i] = (S.arow(cur, h * HALF + RA[i]) * (unsigned)K + (unsigned)CA[i]) * 2u; gn[h][i] = gc[h][i]; }
    } else { cA = (const char*)g.A + (size_t)cur.pm * tstep; }
    PG8_STAGE(PG8_SB(0, 0), cB, voffB); PG8_STAGE(PG8_SB(0, 1), cB + hstep, voffB); PG8_STAGE_A(PG8_SA(0, 0), cA, 0, gc); PG8_STAGE_A(PG8_SA(0, 1), cA, 1, gc);
    if (wr == 1) PG8_BAR;
    PG8_WAIT_V(2); PG8_BAR;
    PG8_STAGE(PG8_SB(1, 0), cB + kstep, voffB); PG8_STAGE_A(PG8_SA(1, 0), cA + kstep, 0, gc); PG8_STAGE(PG8_SB(1, 1), cB + hstep + kstep, voffB);
    PG8_WAIT_V(6); PG8_BAR;
    for (;;) {
        const bool has_next = S.next(ui + 1, nxt);
        const char* nA; const char* nB = has_next ? (const char*)g.Bt + (size_t)nxt.pn * tstep : cB;
        if constexpr (GATHER) { nA = cA;
            if (has_next) {
#pragma unroll
                for (int h = 0; h < 2; ++h)
#pragma unroll
                    for (int i = 0; i < 2; ++i) { int R_ = RA[i], C_ = CA[i]; if constexpr (BUF) { const int t2 = PG8_FRESH_TID(); stage_rc(t2 * 16 + i * 8192, R_, C_); }
                        gn[h][i] = (S.arow(nxt, h * HALF + R_) * (unsigned)K + (unsigned)C_) * 2u; }
                if constexpr (BUF) { *(PG8_LAS u32x4s*)(lds + GN_STASH + PG8_FRESH_TID() * 16) = (u32x4s){gn[0][0], gn[0][1], gn[1][0], gn[1][1]}; } }
        } else { nA = has_next ? (const char*)g.A + (size_t)nxt.pm * tstep : cA; }
        unsigned g2[2][2];
#pragma unroll 1
        for (int t = 0; t < nt; t += 2) {
            const bool last = (t == nt - 2);
            const char* a1 = cA + (size_t)(t + 1) * kstep;
            const char* a2 = last ? nA : cA + (size_t)(t + 2) * kstep; const char* b2 = last ? nB : cB + (size_t)(t + 2) * kstep;
            const char* a3 = a2 + kstep; const char* b3 = b2 + kstep;
            if constexpr (GATHER) {
              if constexpr (BUF) {
                if (last && has_next) { const u32x4s v_ = *(const PG8_LAS u32x4s*)(lds + GN_STASH + PG8_FRESH_TID() * 16); g2[0][0] = v_.x; g2[0][1] = v_.y; g2[1][0] = v_.z; g2[1][1] = v_.w; }
                else { g2[0][0] = gc[0][0]; g2[0][1] = gc[0][1]; g2[1][0] = gc[1][0]; g2[1][1] = gc[1][1]; }
              } else {
#pragma unroll
            for (int h = 0; h < 2; ++h)
#pragma unroll
                for (int i = 0; i < 2; ++i) g2[h][i] = last ? gn[h][i] : gc[h][i]; } }
            PG8_LDB(B0, 0, 0); PG8_LDB(B1, 0, 1); PG8_SCHED; PG8_LDA(At, 0, 0); PG8_STAGE_A(PG8_SA(1, 1), a1, 1, gc);
            PG8_WAIT_V(8); PG8_WAIT_L(0); PG8_BAR; PG8_MMA(0, 0, At, B0); PG8_MMA(0, 1, At, B1); PG8_BAR; PG8_SCHED;
            PG8_LDA(At, 0, 1); PG8_STAGE(PG8_SB(0, 0), b2, voffB); PG8_STAGE(PG8_SB(0, 1), b2 + hstep, voffB); PG8_STAGE_A(PG8_SA(0, 0), a2, 0, g2);
            PG8_WAIT_V(8); PG8_WAIT_L(0); PG8_BAR; PG8_MMA(1, 0, At, B0); PG8_MMA(1, 1, At, B1); PG8_BAR; PG8_SCHED;
            PG8_LDB(B0, 1, 0); PG8_LDB(B1, 1, 1); PG8_SCHED; PG8_LDA(At, 1, 0); PG8_STAGE_A(PG8_SA(0, 1), a2, 1, g2);
            PG8_WAIT_V(8); PG8_WAIT_L(0); PG8_BAR; PG8_MMA(0, 0, At, B0); PG8_MMA(0, 1, At, B1); PG8_BAR; PG8_SCHED;
            PG8_LDA(At, 1, 1); PG8_STAGE(PG8_SB(1, 0), b3, voffB); PG8_STAGE(PG8_SB(1, 1), b3 + hstep, voffB); PG8_STAGE_A(PG8_SA(1, 0), a3, 0, g2);
            PG8_WAIT_V(8); PG8_WAIT_L(0); PG8_BAR; PG8_MMA(1, 0, At, B0); PG8_MMA(1, 1, At, B1); PG8_BAR; PG8_SCHED;
        }
        if constexpr (ALIGN_EPI) { if (wr == 0) PG8_BAR; }
        if constexpr (BUF) { const int l2 = PG8_FRESH_TID(); E(acc, cur, wr, wc, l2 & 15, (l2 >> 4) & 3); }
        else E(acc, cur, wr, wc, fr, fq);
        if (!has_next) break;
#pragma unroll
        for (int a = 0; a < 2; ++a)
#pragma unroll
            for (int b = 0; b < 2; ++b)
#pragma unroll
                for (int m = 0; m < 4; ++m)
#pragma unroll
                    for (int n = 0; n < 2; ++n) acc[a][b][m][n] = (f32x4){0.f, 0.f, 0.f, 0.f};
        cur = nxt; cA = nA; cB = nB; ++ui;
        if constexpr (GATHER) {
#pragma unroll
        for (int h = 0; h < 2; ++h)
#pragma unroll
            for (int i = 0; i < 2; ++i) gc[h][i] = BUF ? g2[h][i] : gn[h][i]; }
        if constexpr (ALIGN_EPI) { if (wr == 1) PG8_BAR; }
    }
    PG8_WAIT_V(0);
    if constexpr (!ALIGN_EPI) { if (wr == 0) PG8_BAR; }
    PG8_BAR;
#undef PG8_SA
#undef PG8_FRESH_TID
#undef PG8_SB
#undef PG8_STAGE
#undef PG8_STAGE_X
#undef PG8_STAGE_A
#undef PG8_LDA
#undef PG8_LDB
#undef PG8_MMA
#undef PG8_WAIT_V
#undef PG8_WAIT_L
#undef PG8_BAR
#undef PG8_SCHED
}
}
typedef __attribute__((address_space(3))) unsigned char lds_u8;

__device__ __forceinline__ u32x4 pack8(const f32x4& a, const f32x4& b) { return (u32x4){pg8::cvt_pk_bf16(a.x, a.y), pg8::cvt_pk_bf16(a.z, a.w), pg8::cvt_pk_bf16(b.x, b.y), pg8::cvt_pk_bf16(b.z, b.w)}; }
struct EpiInM {
  static constexpr bool PERM = true;
  unsigned char* ws;
  __device__ __forceinline__ void operator()(const f32x4 (&acc)[2][2][4][2], const pg8::Unit& u, int wr, int wc, int fr, int fq) const {
    const float* cs = (const float*)(ws + WS_ROPE); const float* sn = cs + SEQ * 32;
    const int pn = u.pn;
#pragma unroll
    for (int ai = 0; ai < 2; ++ai)
#pragma unroll
      for (int m = 0; m < 4; ++m) {
        const int row = u.pm * 256 + ai * 128 + wr * 64 + m * 16 + fr, pos = row & (SEQ - 1);
#pragma unroll
        for (int bj = 0; bj < 2; ++bj) {
          const int w = bj * 128 + wc * 32 + 8 * fq;
          f32x4 v0 = acc[ai][bj][m][0], v1 = acc[ai][bj][m][1];
          const bool do_rope = (pn == 0) || (pn == 1 && bj == 0) || (pn == 2) || (pn == 3 && bj == 0 && wc < 2);
          if (do_rope) { const int d = (w & 63) >> 1; const f32x4 c4 = *(const f32x4*)(cs + pos * 32 + d), s4 = *(const f32x4*)(sn + pos * 32 + d);
            const f32x4 o0 = {v0.x * c4.x - v0.y * s4.x, v0.y * c4.x + v0.x * s4.x, v0.z * c4.y - v0.w * s4.y, v0.w * c4.y + v0.z * s4.y};
            const f32x4 o1 = {v1.x * c4.z - v1.y * s4.z, v1.y * c4.z + v1.x * s4.z, v1.z * c4.w - v1.w * s4.w, v1.w * c4.w + v1.z * s4.w};
            v0 = o0; v1 = o1; }
          if (pn == 0) { *(u32x4*)((bf16_t*)(ws + WS_QA) + (size_t)row * 384 + w) = pack8(v0 * QSCALE, v1 * QSCALE); }
          else if (pn == 1) { if (bj == 0) *(u32x4*)((bf16_t*)(ws + WS_QA) + (size_t)row * 384 + 256 + w) = pack8(v0 * QSCALE, v1 * QSCALE);
                              else *(u32x4*)((bf16_t*)(ws + WS_CKV) + (size_t)row * 128 + (w - 128)) = pack8(v0, v1); }
          else if (pn == 2) { *(u32x4*)((bf16_t*)(ws + WS_IQ) + (size_t)row * 256 + w) = pack8(v0, v1); }
          else if (pn == 3) { if (bj == 0) { if (wc < 2) *(u32x4*)((bf16_t*)(ws + WS_IK) + (size_t)row * 64 + w) = pack8(v0, v1);
                                             else if (wc == 2 && fq < 2) { if (fq == 0) v0 = v0 * 0.0625f; float* o = (float*)(ws + WS_SM) + (size_t)row * 16 + 8 * fq; *(f32x4*)o = v0; *(f32x4*)(o + 4) = v1; } } }
          else if (pn == 4) { *(u32x4*)((bf16_t*)(ws + WS_QC) + (size_t)row * 256 + w) = pack8(v0 * QSCALE, v1 * QSCALE); }
          else { *(u32x4*)((bf16_t*)(ws + WS_GB) + (size_t)row * 1536 + (pn - 5) * 256 + w) = pack8(v0, v1); }
        }
      }
  }
};
__device__ __forceinline__ unsigned pk4_fp8(const f32x4& v) { unsigned w = __builtin_amdgcn_cvt_pk_fp8_f32(v.x, v.y, 0u, false); return __builtin_amdgcn_cvt_pk_fp8_f32(v.z, v.w, w, true); }
struct EpiMemKVM {
  static constexpr bool PERM = true;
  unsigned char* ws;
  __device__ __forceinline__ void operator()(const f32x4 (&acc)[2][2][4][2], const pg8::Unit& u, int wr, int wc, int fr, int fq) const {
#pragma unroll
    for (int ai = 0; ai < 2; ++ai)
#pragma unroll
      for (int m = 0; m < 4; ++m) {
        const int row = u.pm * 256 + ai * 128 + wr * 64 + m * 16 + fr;
#pragma unroll
        for (int bj = 0; bj < 2; ++bj) {
          const int w = bj * 128 + wc * 32 + 8 * fq; const f32x4 v0 = acc[ai][bj][m][0], v1 = acc[ai][bj][m][1];
          const unsigned w0 = pk4_fp8(v0), w1 = pk4_fp8(v1);
          if (u.pn == 0) *(u32x2*)(ws + WS_MK + (size_t)row * 256 + w) = (u32x2){w0, w1};
          else { const int mem = row & 255, xx = mem & 31, mpos = (mem & ~31) + 8 * ((xx >> 2) & 3) + (xx & 3) + 4 * (xx >> 4);
            unsigned char* o = ws + WS_MVT + ((size_t)(row >> 8) * 256 + w) * 256 + mpos;
            o[0] = (unsigned char)w0; o[256] = (unsigned char)(w0 >> 8); o[512] = (unsigned char)(w0 >> 16); o[768] = (unsigned char)(w0 >> 24); o[1024] = (unsigned char)w1; o[1280] = (unsigned char)(w1 >> 8); o[1536] = (unsigned char)(w1 >> 16); o[1792] = (unsigned char)(w1 >> 24); }
        }
      }
  }
};
struct EpiOutM {
  static constexpr bool PERM = true;
  const bf16_t* x; bf16_t* y;
  __device__ __forceinline__ void operator()(const f32x4 (&acc)[2][2][4][2], const pg8::Unit& u, int wr, int wc, int fr, int fq) const {
#pragma unroll
    for (int ai = 0; ai < 2; ++ai)
#pragma unroll
      for (int m = 0; m < 4; ++m) {
        const size_t rb = (size_t)(u.pm * 256 + ai * 128 + wr * 64 + m * 16 + fr) * 1024 + u.pn * 256 + wc * 32 + 8 * fq;
#pragma unroll
        for (int bj = 0; bj < 2; ++bj) { const size_t o = rb + bj * 128; const u32x4 xv = *(const u32x4*)(x + o);
          const f32x4 x0 = {__uint_as_float(xv.x << 16), __uint_as_float(xv.x & 0xffff0000u), __uint_as_float(xv.y << 16), __uint_as_float(xv.y & 0xffff0000u)};
          const f32x4 x1 = {__uint_as_float(xv.z << 16), __uint_as_float(xv.z & 0xffff0000u), __uint_as_float(xv.w << 16), __uint_as_float(xv.w & 0xffff0000u)};
          *(u32x4*)(y + o) = pack8(x0 * ALPHA + acc[ai][bj][m][0], x1 * ALPHA + acc[ai][bj][m][1]); }
      }
  }
};
struct MoeOrder {
  const int* offs; const int* cnts; int npn, G, c; const unsigned* LIST;
  __device__ __forceinline__ bool next(int i, pg8::Unit& u) const {
    const int* offs = this->offs; asm volatile("" : "+s"(offs));
    const int L = i * G + c; const int ntiles = __builtin_amdgcn_readfirstlane(offs[64]) >> 8;
    if (L >= ntiles * npn) return false;
    const int rt = L / npn, pl = L - rt * npn; int e = 0;
    while (__builtin_amdgcn_readfirstlane(offs[e + 1]) <= rt * 256) ++e;
    u.pm = rt; u.mt = rt - (__builtin_amdgcn_readfirstlane(offs[e]) >> 8); u.e = e; u.pn = e * npn + pl; u.aux = __builtin_amdgcn_readfirstlane(cnts[e]); return true;
  }
  __device__ __forceinline__ unsigned arow(const pg8::Unit& u, int r) const { const int rank = u.mt * 256 + r; return rank < u.aux ? LIST[(size_t)u.e * 32768 + rank] : 0u; }
};
struct EpiMoeUpM {
  static constexpr bool PERM = true;
  unsigned char* H;
  __device__ __forceinline__ void operator()(const f32x4 (&acc)[2][2][4][2], const pg8::Unit& u, int wr, int wc, int fr, int fq) const {
    const int pl = u.pn & 1;
    int fr_ = fr, fq_ = fq; asm volatile("" : "+v"(fr_), "+v"(fq_));
#pragma unroll
    for (int ai = 0; ai < 2; ++ai)
#pragma unroll
      for (int m = 0; m < 4; ++m) {
        const int rl = ai * 128 + wr * 64 + m * 16 + fr_;
        if (u.mt * 256 + rl < u.aux) {
          f32x4 h0, h1; const float is = 1.f / W8SCALE, us = H8SCALE / W8SCALE; const f32x4 g0 = acc[ai][0][m][0] * is, g1 = acc[ai][0][m][1] * is, u0 = acc[ai][1][m][0] * us, u1 = acc[ai][1][m][1] * us;
          h0.x = silu_f(g0.x) * u0.x; h0.y = silu_f(g0.y) * u0.y; h0.z = silu_f(g0.z) * u0.z; h0.w = silu_f(g0.w) * u0.w;
          h1.x = silu_f(g1.x) * u1.x; h1.y = silu_f(g1.y) * u1.y; h1.z = silu_f(g1.z) * u1.z; h1.w = silu_f(g1.w) * u1.w;
          *(u32x2*)(H + (size_t)(u.pm * 256 + rl) * 256 + pl * 128 + wc * 32 + 8 * fq_) = (u32x2){pk4_fp8(h0), pk4_fp8(h1)};
        }
      }
  }
};
struct EpiMoeDownM {
  static constexpr bool PERM = true;
  unsigned char* Y; const float* GATEL;
  __device__ __forceinline__ void operator()(const f32x4 (&acc)[2][2][4][2], const pg8::Unit& u, int wr, int wc, int fr, int fq) const {
    const int pl = u.pn & 3;
    int fr_ = fr, fq_ = fq; asm volatile("" : "+v"(fr_), "+v"(fq_));
    const float* gp = GATEL + (size_t)u.e * 32768; const int rk0 = u.mt * 256 + wr * 64 + fr_;
    unsigned char* yp = Y + (size_t)(u.pm * 256 + wr * 64 + fr_) * 1024 + pl * 256 + wc * 32 + 8 * fq_;
#pragma unroll
    for (int ai = 0; ai < 2; ++ai)
#pragma unroll
      for (int m = 0; m < 4; ++m) {
        const int rk = rk0 + ai * 128 + m * 16; const float gt = gp[rk < 32767 ? rk : 32767] * (64.0f / (W8SCALE * H8SCALE));
#pragma unroll
        for (int bj = 0; bj < 2; ++bj)
          *(u32x2*)(yp + (size_t)(ai * 128 + m * 16) * 1024 + bj * 128) = (u32x2){pk4_fp8(acc[ai][bj][m][0] * gt), pk4_fp8(acc[ai][bj][m][1] * gt)};
      }
  }
};

__device__ __forceinline__ void phase_inproj_mfma(const Ctx& c, lds_u8* lds) {
  unsigned char* ws = c.ws; const int tid = phase_tid();
  { pg8::Gemm g{(const bf16_t*)c.out, (const bf16_t*)(ws + WS_WIN), 1024}; pg8::StaticOrder S; S.init(T, NIN, gridDim.x, blockIdx.x); EpiInM E{ws};
    pg8::gemm_phase<EpiInM, pg8::StaticOrder, true, false>(lds, g, S, E, tid); }
  { pg8::Gemm g{(const bf16_t*)(ws + WS_MEMB), (const bf16_t*)(ws + WS_WMKV), 1024}; pg8::StaticOrder S; S.init(TM, 512, gridDim.x, (int)blockIdx.x - 128); EpiMemKVM E{ws};
    pg8::gemm_phase<EpiMemKVM, pg8::StaticOrder, true, false>(lds, g, S, E, tid); }
}
__device__ __forceinline__ void phase_outproj_mfma(const Ctx& c, lds_u8* lds) {
  unsigned char* ws = c.ws; const int tid = phase_tid();
  pg8::Gemm g{(const bf16_t*)(ws + WS_CAT), (const bf16_t*)(ws + WS_WO), 1024}; pg8::StaticOrder S; S.init(T, 1024, gridDim.x, blockIdx.x); EpiOutM E{(const bf16_t*)c.out, (bf16_t*)(ws + WS_X1B)};
  pg8::gemm_phase<EpiOutM, pg8::StaticOrder, true, false>(lds, g, S, E, tid);
}
__device__ __forceinline__ void phase_moe_up_mfma(const Ctx& c, lds_u8* lds) {
  unsigned char* ws = c.ws; const int tid = phase_tid();
  int* offs = (int*)((unsigned char*)lds + pg8::STAGE_BYTES); int* cnts = offs + 65;
  expert_offsets(c, offs, cnts, tid);
  pg8::Gemm g{(const bf16_t*)(ws + WS_X1F), (const bf16_t*)(ws + WS_WGU), 512};
  MoeOrder S{offs, cnts, 2, (int)gridDim.x, (int)blockIdx.x, (const unsigned*)(ws + WS_LIST)}; EpiMoeUpM E{ws + WS_H};
  pg8::gemm_phase<EpiMoeUpM, MoeOrder, true, true, 2, true>(lds, g, S, E, tid);
}
__device__ __forceinline__ void phase_moe_down_mfma(const Ctx& c, lds_u8* lds) {
  unsigned char* ws = c.ws; const int tid = phase_tid();
  int* offs = (int*)((unsigned char*)lds + pg8::STAGE_BYTES); int* cnts = offs + 65;
  expert_offsets(c, offs, cnts, tid);
  pg8::Gemm g{(const bf16_t*)(ws + WS_H), (const bf16_t*)(ws + WS_WD), 128};
  MoeOrder S{offs, cnts, 4, (int)gridDim.x, (int)blockIdx.x, nullptr}; EpiMoeDownM E{(unsigned char*)(ws + WS_Y), (const float*)(ws + WS_GATEL)};
  pg8::gemm_phase<EpiMoeDownM, MoeOrder, true, false, 2>(lds, g, S, E, tid);
}

__device__ void phase_kvup(const Ctx& c, float* lds) {
  unsigned char* ws = c.ws;
  const int tid = phase_tid(), lane = tid & 63, wave = tid >> 6, fr = lane & 15, fq = lane >> 4;
  const bf16_t* W = (const bf16_t*)(ws + WS_WKV);
  const bf16_t* CKV = (const bf16_t*)(ws + WS_CKV); bf16_t* KVA = (bf16_t*)(ws + WS_KVA);
  const float* cs = (const float*)(ws + WS_ROPE); const float* sn = cs + SEQ * 32;
  for (int tile = blockIdx.x * NWAVES + wave; tile < T / 16; tile += gridDim.x * NWAVES) {
    const int t = tile * 16 + fr, pos = t & (SEQ - 1);
    pg8::bf16x8 bx[4]; float ss = 0.f;
#pragma unroll
    for (int ks = 0; ks < 4; ++ks) { const u32x4 v = *(const u32x4*)(CKV + (size_t)t * 128 + ks * 32 + fq * 8); bx[ks] = __builtin_bit_cast(pg8::bf16x8, v);
      const float f[8] = {__uint_as_float(v.x << 16), __uint_as_float(v.x & 0xffff0000u), __uint_as_float(v.y << 16), __uint_as_float(v.y & 0xffff0000u), __uint_as_float(v.z << 16), __uint_as_float(v.z & 0xffff0000u), __uint_as_float(v.w << 16), __uint_as_float(v.w & 0xffff0000u)};
#pragma unroll
      for (int e = 0; e < 8; ++e) ss += f[e] * f[e]; }
    ss += __shfl_xor(ss, 16); ss += __shfl_xor(ss, 32);
    const float rstd = rsqrtf(ss * (1.f / 128.f) + 1e-6f);
#pragma unroll
    for (int nt = 0; nt < 8; ++nt) { f32x4 d = {0.f, 0.f, 0.f, 0.f};
#pragma unroll
      for (int ks = 0; ks < 4; ++ks) d = __builtin_amdgcn_mfma_f32_16x16x32_bf16(*(const pg8::bf16x8*)(W + (size_t)(nt * 16 + fr) * 128 + ks * 32 + fq * 8), bx[ks], d, 0, 0, 0);
      d = d * rstd;
      const int p0 = nt * 16 + fq * 4;
      if (nt < 4) { const int dd = p0 >> 1; const float c0 = cs[pos * 32 + dd], s0 = sn[pos * 32 + dd], c1 = cs[pos * 32 + dd + 1], s1 = sn[pos * 32 + dd + 1];
        const f32x4 o = {d.x * c0 - d.y * s0, d.y * c0 + d.x * s0, d.z * c1 - d.w * s1, d.w * c1 + d.z * s1}; d = o; }
      { int w8 = __builtin_amdgcn_cvt_pk_fp8_f32(d.x, d.y, 0, false); w8 = __builtin_amdgcn_cvt_pk_fp8_f32(d.z, d.w, w8, true);
        *(unsigned*)((unsigned char*)KVA + (size_t)t * 128 + p0) = (unsigned)w8; } }
  }
}


typedef _Float16 h16x2 __attribute__((ext_vector_type(2)));
constexpr int TK_KP = 4104;
constexpr int TK_KEYS = 0, TK_H1 = 16 * TK_KP * 2, TK_H2 = TK_H1 + 16 * 128 * 4, TK_MISC = TK_H2 + 8 * 128 * 4;
__device__ __forceinline__ unsigned mono16x2(unsigned u) { const unsigned m = ((u >> 15) & 0x00010001u) * 0xffffu; return u ^ (m | 0x80008000u); }
__device__ __forceinline__ int wave_incl_scan(int x) {
  x += __builtin_amdgcn_update_dpp(0, x, 0x111, 0xF, 0xF, true);
  x += __builtin_amdgcn_update_dpp(0, x, 0x112, 0xF, 0xF, true);
  x += __builtin_amdgcn_update_dpp(0, x, 0x114, 0xF, 0xF, true);
  x += __builtin_amdgcn_update_dpp(0, x, 0x118, 0xF, 0xF, true);
  x += __builtin_amdgcn_update_dpp(0, x, 0x142, 0xA, 0xF, false);
  x += __builtin_amdgcn_update_dpp(0, x, 0x143, 0xC, 0xF, false);
  return x;
}

__device__ __forceinline__ void hist_find(const unsigned* hw, int need, int lane, int& B, int& above) {
  const unsigned w0 = hw[127 - 2 * lane], w1 = hw[126 - 2 * lane];
  const int c0 = (int)(w0 >> 16), c1 = (int)(w0 & 0xffffu), c2 = (int)(w1 >> 16), c3 = (int)(w1 & 0xffffu);
  const int tl = c0 + c1 + c2 + c3;
  const int incl = wave_incl_scan(tl);
  const int excl = incl - tl;
  const bool hit = (excl < need) && (incl >= need);
  int b = 0, ab = 0;
  if (hit) { int a = excl; b = 255 - 4 * lane; ab = a;
    if (a + c0 < need) { a += c0; b = 254 - 4 * lane; ab = a; if (a + c1 < need) { a += c1; b = 253 - 4 * lane; ab = a; if (a + c2 < need) { a += c2; b = 252 - 4 * lane; ab = a; } } } }
  const unsigned long long m = __ballot(hit);
  const int src = __builtin_amdgcn_readfirstlane(m ? (__ffsll((long long)m) - 1) : 0);
  B = __builtin_amdgcn_readlane(b, src); above = __builtin_amdgcn_readlane(ab, src);
}
__device__ void phase_topk_mfma(const Ctx& c, unsigned char* ldsb, unsigned* qhead) {
  unsigned char* ws = c.ws;
  const int tid = phase_tid(), lane = tid & 63, wave = tid >> 6, fr = lane & 15, fq = lane >> 4;
  unsigned short* keys = (unsigned short*)(ldsb + TK_KEYS);
  unsigned* h1 = (unsigned*)(ldsb + TK_H1); unsigned* h2 = (unsigned*)(ldsb + TK_H2) + wave * 128; int* misc = (int*)(ldsb + TK_MISC);
  const bf16_t* IQ = (const bf16_t*)(ws + WS_IQ); const bf16_t* IK = (const bf16_t*)(ws + WS_IK); const float* SM = (const float*)(ws + WS_SM);
  unsigned short* SEL = (unsigned short*)(ws + WS_SEL);
  WorkQ wq; wq_init(wq, qhead, misc, tid);
  for (;;) {
    const int item = wq_next(wq, tid);
    if (item >= 240 * 8) break;
    const int b = item & 7, qb = 255 - (item >> 3), s0 = qb * 16;
    for (int i = tid; i < 16 * 128; i += NTHREADS) h1[i] = 0u;
    const size_t qrow = (size_t)b * SEQ + s0 + fr;
    pg8::bf16x8 bq[4][2];
#pragma unroll
    for (int hh = 0; hh < 4; ++hh)
#pragma unroll
      for (int ks = 0; ks < 2; ++ks) bq[hh][ks] = *(const pg8::bf16x8*)(IQ + qrow * 256 + hh * 64 + ks * 32 + fq * 8);
    const f32x4 iw = *(const f32x4*)(SM + qrow * 16);
    const int nkt = qb + 1, slim = s0 + fr;
    __syncthreads();
    pg8::bf16x8 a0n = {0, 0, 0, 0, 0, 0, 0, 0}, a1n = a0n;
    if (wave < nkt) { const bf16_t* kr = IK + ((size_t)b * SEQ + wave * 16 + fr) * 64 + fq * 8; a0n = *(const pg8::bf16x8*)kr; a1n = *(const pg8::bf16x8*)(kr + 32); }
    for (int kt = wave; kt < nkt; kt += NWAVES) {
      const pg8::bf16x8 a0 = a0n, a1 = a1n;
      if (kt + NWAVES < nkt) { const bf16_t* kr = IK + ((size_t)b * SEQ + (kt + NWAVES) * 16 + fr) * 64 + fq * 8; a0n = *(const pg8::bf16x8*)kr; a1n = *(const pg8::bf16x8*)(kr + 32); }
      f32x4 sc = {0.f, 0.f, 0.f, 0.f};
#pragma unroll
      for (int hh = 0; hh < 4; ++hh) { f32x4 d = {0.f, 0.f, 0.f, 0.f};
        d = __builtin_amdgcn_mfma_f32_16x16x32_bf16(a0, bq[hh][0], d, 0, 0, 0); d = __builtin_amdgcn_mfma_f32_16x16x32_bf16(a1, bq[hh][1], d, 0, 0, 0);
        const float w = hh == 0 ? iw.x : hh == 1 ? iw.y : hh == 2 ? iw.z : iw.w;
        sc.x = fmaf(w, fmaxf(d.x, 0.f), sc.x); sc.y = fmaf(w, fmaxf(d.y, 0.f), sc.y); sc.z = fmaf(w, fmaxf(d.z, 0.f), sc.z); sc.w = fmaf(w, fmaxf(d.w, 0.f), sc.w); }
      unsigned k01 = mono16x2(__builtin_bit_cast(unsigned, __builtin_amdgcn_cvt_pkrtz(sc.x, sc.y))), k23 = mono16x2(__builtin_bit_cast(unsigned, __builtin_amdgcn_cvt_pkrtz(sc.z, sc.w)));
      const int kbase = kt * 16 + fq * 4;
      unsigned* hq = h1 + fr * 128;
      if (kt + 1 < nkt) {
        *(u32x2*)(keys + fr * TK_KP + kbase) = (u32x2){k01, k23};
        { const unsigned kk = k01 & 0xffffu; atomicAdd(hq + (kk >> 9), 1u << ((kk >> 4) & 16)); }
        { const unsigned kk = k01 >> 16; atomicAdd(hq + (kk >> 9), 1u << ((kk >> 4) & 16)); }
        { const unsigned kk = k23 & 0xffffu; atomicAdd(hq + (kk >> 9), 1u << ((kk >> 4) & 16)); }
        { const unsigned kk = k23 >> 16; atomicAdd(hq + (kk >> 9), 1u << ((kk >> 4) & 16)); }
      } else {
        if (kbase + 0 > slim) k01 &= 0xffff0000u; if (kbase + 1 > slim) k01 &= 0x0000ffffu;
        if (kbase + 2 > slim) k23 &= 0xffff0000u; if (kbase + 3 > slim) k23 &= 0x0000ffffu;
        *(u32x2*)(keys + fr * TK_KP + kbase) = (u32x2){k01, k23};
        if (kbase + 0 <= slim) { const unsigned kk = k01 & 0xffffu; atomicAdd(hq + (kk >> 9), 1u << ((kk >> 4) & 16)); }
        if (kbase + 1 <= slim) { const unsigned kk = k01 >> 16; atomicAdd(hq + (kk >> 9), 1u << ((kk >> 4) & 16)); }
        if (kbase + 2 <= slim) { const unsigned kk = k23 & 0xffffu; atomicAdd(hq + (kk >> 9), 1u << ((kk >> 4) & 16)); }
        if (kbase + 3 <= slim) { const unsigned kk = k23 >> 16; atomicAdd(hq + (kk >> 9), 1u << ((kk >> 4) & 16)); }
      }
    }
    __syncthreads();
    for (int qi = 0; qi < 2; ++qi) {
      const int q = wave * 2 + qi, s = s0 + q, n = s + 1;
      int B1, above1; hist_find(h1 + q * 128, 256, lane, B1, above1);
      const int need1 = 256 - above1;
      h2[lane] = 0u; h2[64 + lane] = 0u;
      const unsigned short* kq = keys + q * TK_KP;
      const int niter = (n + 511) >> 9;
      for (int it = 0; it < niter; ++it) {
        const int i0 = (it * 64 + lane) * 8; const u32x4 kv = *(const u32x4*)(kq + i0);
        const unsigned k8[8] = {kv.x & 0xffffu, kv.x >> 16, kv.y & 0xffffu, kv.y >> 16, kv.z & 0xffffu, kv.z >> 16, kv.w & 0xffffu, kv.w >> 16};
#pragma unroll
        for (int e = 0; e < 8; ++e) if (i0 + e < n && (int)(k8[e] >> 8) == B1) atomicAdd(h2 + ((k8[e] & 255u) >> 1), 1u << ((k8[e] & 1u) * 16));
      }
      int B2, above2; hist_find(h2, need1, lane, B2, above2);
      const unsigned thr = (unsigned)((B1 << 8) | B2); const int need = need1 - above2;
      unsigned short* dummy = (unsigned short*)(misc + 8 + wave);
      unsigned short* sel = (unsigned short*)h2;
      asm volatile("s_waitcnt lgkmcnt(0)" ::: "memory");
      int tiebase = 0, outbase = 0;
      for (int it = 0; it < niter; ++it) {
        const int i0 = (it * 64 + lane) * 8; const u32x4 kv = *(const u32x4*)(kq + i0);
        const unsigned k8[8] = {kv.x & 0xffffu, kv.x >> 16, kv.y & 0xffffu, kv.y >> 16, kv.z & 0xffffu, kv.z >> 16, kv.w & 0xffffu, kv.w >> 16};
        int cg = 0, ce = 0;
#pragma unroll
        for (int e = 0; e < 8; ++e) { const bool v = i0 + e < n; cg += (v && k8[e] > thr) ? 1 : 0; ce += (v && k8[e] == thr) ? 1 : 0; }
        int tk = 0;
        if (__ballot(ce != 0)) {
          const int eincl = wave_incl_scan(ce); const int eg = tiebase + eincl - ce;
          tk = need - eg; tk = tk < 0 ? 0 : (tk > ce ? ce : tk);
          tiebase += __builtin_amdgcn_readlane(eincl, 63);
        }
        const int oc = cg + tk; const int oincl = wave_incl_scan(oc);
        int pos = outbase + oincl - oc; int tleft = tk;
#pragma unroll
        for (int e = 0; e < 8; ++e) { const bool v = i0 + e < n; const bool tie = v && k8[e] == thr && tleft > 0; const bool take = (v && k8[e] > thr) || tie;
          tleft -= tie ? 1 : 0;
          unsigned short* dst = (take && pos < 256) ? sel + pos : dummy;
          *dst = (unsigned short)(i0 + e); pos += take ? 1 : 0; }
        outbase += __builtin_amdgcn_readlane(oincl, 63);
      }
      asm volatile("s_waitcnt lgkmcnt(0)" ::: "memory");
      *(u32x2*)(SEL + ((size_t)b * SEQ + s) * 256 + lane * 4) = *(const u32x2*)(sel + lane * 4);
      asm volatile("s_waitcnt lgkmcnt(0)" ::: "memory");
    }
  }
}

typedef short s16x4 __attribute__((ext_vector_type(4)));
__device__ __forceinline__ s16x4 lds_tr16(const unsigned char* p) { return __builtin_bit_cast(s16x4, __builtin_amdgcn_ds_read_tr16_b64_v4i16((__attribute__((address_space(3))) s16x4*)(__attribute__((address_space(3))) unsigned char*)p)); }
typedef float f32x2_t __attribute__((ext_vector_type(2))); typedef __bf16 bf16x2_t __attribute__((ext_vector_type(2)));
__device__ __forceinline__ unsigned cvtpk_c(float lo, float hi) { const f32x2_t v = {lo, hi}; const bf16x2_t b = __builtin_convertvector(v, bf16x2_t); return __builtin_bit_cast(unsigned, b); }
__device__ __forceinline__ pg8::bf16x8 packp(const f32x4& a, const f32x4& b) {
  const u32x4 w = {cvtpk_c(a.x, a.y), cvtpk_c(a.z, a.w), cvtpk_c(b.x, b.y), cvtpk_c(b.z, b.w)}; return __builtin_bit_cast(pg8::bf16x8, w); }
constexpr int AT_WB = 9216 + 512;
typedef int v2i_t __attribute__((ext_vector_type(2)));
__device__ __forceinline__ long lds_tr8(const unsigned char* p) { const v2i_t r = __builtin_amdgcn_ds_read_tr8_b64_v2i32((__attribute__((address_space(3))) v2i_t*)(__attribute__((address_space(3))) unsigned char*)p); return (long)(((unsigned long)(unsigned)r.y << 32) | (unsigned long)(unsigned)r.x); }
__device__ void phase_attn_sparse(const Ctx& c, unsigned char* ldsb, unsigned* qhead) {
  unsigned char* ws = c.ws;
  const int tid = phase_tid(), lane = tid & 63, wave = tid >> 6, fr = lane & 15, fq = lane >> 4;
  unsigned char* vl = ldsb + wave * AT_WB; unsigned short* sl = (unsigned short*)(vl + 9216);
  const bf16_t* QA = (const bf16_t*)(ws + WS_QA); const unsigned char* KVA = (const unsigned char*)(ws + WS_KVA); const unsigned short* SEL = (const unsigned short*)(ws + WS_SEL);
  bf16_t* CAT = (bf16_t*)(ws + WS_CAT);
  const float* gA = c.in[10];
  __syncthreads();
  int* aq_slot = (int*)(ldsb + 8 * AT_WB);
  WorkQ wq; wq_init(wq, qhead, aq_slot, tid);
  const int st_off = (lane >> 3) * 144 + (lane & 7) * 16;
  const int kr_off = fr * 144 + fq * 16;
  const int tr_off = (fq * 4 + ((fr >> 1) & 3) + (fr >> 3) * 16) * 144 + 64 + (fr & 1) * 8;
  for (;;) {
  const int item = wq_next(wq, tid);
  if (item >= 512) break;
  for (int tj = 0; tj < 8; ++tj) {
    const int t = item * 64 + wave * 8 + tj;
    const int b = t >> 12, s = t & (SEQ - 1), n = s + 1 < 256 ? s + 1 : 256;
    { u32x2 v;
      if (s >= 256) v = *(const u32x2*)(SEL + (size_t)t * 256 + lane * 4);
      else { const int i0 = lane * 4; const unsigned e0 = i0 < n ? i0 : 0, e1 = i0 + 1 < n ? i0 + 1 : 0, e2 = i0 + 2 < n ? i0 + 2 : 0, e3 = i0 + 3 < n ? i0 + 3 : 0; v = (u32x2){e0 | (e1 << 16), e2 | (e3 << 16)}; }
      *(u32x2*)(sl + lane * 4) = v; }
    asm volatile("s_waitcnt lgkmcnt(0)" ::: "memory");
    const unsigned char* kvb = KVA + (size_t)b * SEQ * 128;
    u32x4 ra[8], rb[8];
#define KLOAD(R, CH) do { _Pragma("unroll") for (int i_ = 0; i_ < 8; ++i_) { const int key_ = sl[(CH) * 64 + i_ * 8 + (lane >> 3)]; R[i_] = *(const u32x4*)(kvb + (size_t)key_ * 128 + (lane & 7) * 16); } } while (0)
#define KSTORE(R) do { _Pragma("unroll") for (int i_ = 0; i_ < 8; ++i_) *(u32x4*)(vl + i_ * 8 * 144 + st_off) = R[i_]; } while (0)
    KLOAD(ra, 0); KLOAD(rb, 1);
    long q0 = 0, q1 = 0;
    if (fr < 6) { const bf16_t* qp = QA + (size_t)t * 384 + fr * 64 + fq * 16; const u32x4 a = *(const u32x4*)qp, bb = *(const u32x4*)(qp + 8);
      q0 = mk64(cvt4_fp8(__uint_as_float(a.x << 16), __uint_as_float(a.x & 0xffff0000u), __uint_as_float(a.y << 16), __uint_as_float(a.y & 0xffff0000u)),
                cvt4_fp8(__uint_as_float(a.z << 16), __uint_as_float(a.z & 0xffff0000u), __uint_as_float(a.w << 16), __uint_as_float(a.w & 0xffff0000u)));
      q1 = mk64(cvt4_fp8(__uint_as_float(bb.x << 16), __uint_as_float(bb.x & 0xffff0000u), __uint_as_float(bb.y << 16), __uint_as_float(bb.y & 0xffff0000u)),
                cvt4_fp8(__uint_as_float(bb.z << 16), __uint_as_float(bb.z & 0xffff0000u), __uint_as_float(bb.w << 16), __uint_as_float(bb.w & 0xffff0000u))); }
    float m = -3.0e38f, l = 0.f;
    f32x4 ot[4];
#pragma unroll
    for (int mt = 0; mt < 4; ++mt) ot[mt] = (f32x4){0.f, 0.f, 0.f, 0.f};
#define KCHUNK(R, CH) do { \
      KSTORE(R); if ((CH) + 2 < 4) KLOAD(R, (CH) + 2); \
      asm volatile("s_waitcnt lgkmcnt(0)" ::: "memory"); \
      f32x4 st[4]; \
      _Pragma("unroll") for (int kt = 0; kt < 4; ++kt) { const u32x4 a_ = *(const u32x4*)(vl + kt * 16 * 144 + kr_off); f32x4 d_ = {0.f, 0.f, 0.f, 0.f}; \
        d_ = __builtin_amdgcn_mfma_f32_16x16x32_fp8_fp8(mk64(a_.x, a_.y), q0, d_, 0, 0, 0); st[kt] = __builtin_amdgcn_mfma_f32_16x16x32_fp8_fp8(mk64(a_.z, a_.w), q1, d_, 0, 0, 0); } \
      if (n < 256) { _Pragma("unroll") for (int kt = 0; kt < 4; ++kt) { const int sb = (CH) * 64 + kt * 16 + fq * 4; \
        if (sb + 0 >= n) st[kt].x = -3.0e38f; if (sb + 1 >= n) st[kt].y = -3.0e38f; if (sb + 2 >= n) st[kt].z = -3.0e38f; if (sb + 3 >= n) st[kt].w = -3.0e38f; } } \
      float cm = -3.0e38f; \
      _Pragma("unroll") for (int kt = 0; kt < 4; ++kt) cm = fmaxf(fmaxf(fmaxf(cm, st[kt].x), fmaxf(st[kt].y, st[kt].z)), st[kt].w); \
      cm = fmaxf(cm, __shfl_xor(cm, 16)); cm = fmaxf(cm, __shfl_xor(cm, 32)); \
      const float mn = fmaxf(m, cm), al = __builtin_amdgcn_exp2f(m - mn), mb = mn - 8.f; m = mn; \
      float ls = 0.f; \
      _Pragma("unroll") for (int kt = 0; kt < 4; ++kt) { st[kt].x = __builtin_amdgcn_exp2f(st[kt].x - mb); st[kt].y = __builtin_amdgcn_exp2f(st[kt].y - mb); st[kt].z = __builtin_amdgcn_exp2f(st[kt].z - mb); st[kt].w = __builtin_amdgcn_exp2f(st[kt].w - mb); \
        ls += (st[kt].x + st[kt].y) + (st[kt].z + st[kt].w); } \
      l = l * al + ls; \
      _Pragma("unroll") for (int mt = 0; mt < 4; ++mt) ot[mt] = ot[mt] * al; \
      _Pragma("unroll") for (int k2 = 0; k2 < 2; ++k2) { \
        const long pf = mk64(cvt4_fp8(st[2 * k2].x, st[2 * k2].y, st[2 * k2].z, st[2 * k2].w), cvt4_fp8(st[2 * k2 + 1].x, st[2 * k2 + 1].y, st[2 * k2 + 1].z, st[2 * k2 + 1].w)); \
        _Pragma("unroll") for (int mt = 0; mt < 4; ++mt) { const long af = lds_tr8(vl + k2 * 32 * 144 + tr_off + mt * 16); \
          ot[mt] = __builtin_amdgcn_mfma_f32_16x16x32_fp8_fp8(af, pf, ot[mt], 0, 0, 0); } } \
      asm volatile("s_waitcnt lgkmcnt(0)" ::: "memory"); } while (0)
    KCHUNK(ra, 0); KCHUNK(rb, 1); KCHUNK(ra, 2); KCHUNK(rb, 3);
#undef KLOAD
#undef KSTORE
#undef KCHUNK
    l += __shfl_xor(l, 16); l += __shfl_xor(l, 32);
    const float il = __builtin_amdgcn_rcpf(l); float ss = 0.f;
#pragma unroll
    for (int mt = 0; mt < 4; ++mt) { ot[mt] = ot[mt] * il; ss += (ot[mt].x * ot[mt].x + ot[mt].y * ot[mt].y) + (ot[mt].z * ot[mt].z + ot[mt].w * ot[mt].w); }
    if (fr >= 6) ss = 0.f;
#pragma unroll
    for (int o = 1; o < 64; o <<= 1) ss += __shfl_xor(ss, o);
    const float rstd = rsqrtf(ss * (1.f / 384.f) + 1e-6f);
    if (fr < 6) {
#pragma unroll
      for (int mt = 0; mt < 4; ++mt) { const int col = fr * 64 + mt * 16 + fq * 4; const f32x4 g = *(const f32x4*)(gA + col); const f32x4 o = ot[mt] * rstd * g;
        *(u32x2*)(CAT + (size_t)t * 1024 + col) = (u32x2){pg8::cvt_pk_bf16(o.x, o.y), pg8::cvt_pk_bf16(o.z, o.w)}; } }
  }
  }
}

__device__ void phase_attn_mem(const Ctx& c, unsigned char* ldsb, unsigned* qhead) {
  unsigned char* ws = c.ws;
  const int tid = phase_tid(), lane = tid & 63, wave = tid >> 6, fr = lane & 15, fq = lane >> 4;
  const bf16_t* QC = (const bf16_t*)(ws + WS_QC); const unsigned char* MK = ws + WS_MK; const unsigned char* MVT = ws + WS_MVT;
  bf16_t* CAT = (bf16_t*)(ws + WS_CAT);
  const float* gC = c.in[11];
  int* aq_slot = (int*)(ldsb + 70656 + 8 * 8192);
  WorkQ wq; wq_init(wq, qhead, aq_slot, tid);
  for (;;) {
  const int item = wq_next(wq, tid) + 512;
  if (item >= 768) break;
  {
    const int t0 = (item - 512) * 128 + wave * 16, b = t0 >> 12;
    unsigned char* mkl = ldsb; unsigned char* mvl = ldsb + 36864; unsigned char* ocl = ldsb + 70656 + wave * 8192;
    float ss = 0.f;
#pragma unroll 1
    for (int h = 0; h < 4; ++h) {
      const bf16_t* qp = QC + (size_t)(t0 + fr) * 256 + h * 64 + fq * 16;
      const u32x4 qa = *(const u32x4*)qp, qb = *(const u32x4*)(qp + 8);
      __syncthreads();
#pragma unroll
      for (int i = 0; i < 2; ++i) { const int p = tid + 512 * i, row = p >> 2, cc = p & 3;
        *(u32x4*)(mkl + row * 80 + cc * 16) = *(const u32x4*)(MK + ((size_t)(b * 256 + row)) * 256 + h * 64 + cc * 16); }
#pragma unroll
      for (int i = 0; i < 2; ++i) { const int p = tid + 512 * i, row = p >> 4, cc = p & 15;
        *(u32x4*)(mvl + row * 272 + cc * 16) = *(const u32x4*)(MVT + ((size_t)(b * 256 + h * 64 + row)) * 256 + cc * 16); }
      const long q0 = mk64(cvt4_fp8(__uint_as_float(qa.x << 16), __uint_as_float(qa.x & 0xffff0000u), __uint_as_float(qa.y << 16), __uint_as_float(qa.y & 0xffff0000u)),
                           cvt4_fp8(__uint_as_float(qa.z << 16), __uint_as_float(qa.z & 0xffff0000u), __uint_as_float(qa.w << 16), __uint_as_float(qa.w & 0xffff0000u)));
      const long q1 = mk64(cvt4_fp8(__uint_as_float(qb.x << 16), __uint_as_float(qb.x & 0xffff0000u), __uint_as_float(qb.y << 16), __uint_as_float(qb.y & 0xffff0000u)),
                           cvt4_fp8(__uint_as_float(qb.z << 16), __uint_as_float(qb.z & 0xffff0000u), __uint_as_float(qb.w << 16), __uint_as_float(qb.w & 0xffff0000u)));
      __syncthreads();
      f32x4 oc[4];
      f32x4 st[16];
#pragma unroll
      for (int kt = 0; kt < 16; ++kt) { const u32x4 a_ = *(const u32x4*)(mkl + (kt * 16 + fr) * 80 + fq * 16);
        f32x4 d = {0.f, 0.f, 0.f, 0.f};
        d = __builtin_amdgcn_mfma_f32_16x16x32_fp8_fp8(mk64(a_.x, a_.y), q0, d, 0, 0, 0); st[kt] = __builtin_amdgcn_mfma_f32_16x16x32_fp8_fp8(mk64(a_.z, a_.w), q1, d, 0, 0, 0); }
      float mx = -3.0e38f;
#pragma unroll
      for (int kt = 0; kt < 16; ++kt) mx = fmaxf(fmaxf(fmaxf(mx, st[kt].x), fmaxf(st[kt].y, st[kt].z)), st[kt].w);
      mx = fmaxf(mx, __shfl_xor(mx, 16)); mx = fmaxf(mx, __shfl_xor(mx, 32));
      mx -= 8.f;
      float l = 0.f;
#pragma unroll
      for (int kt = 0; kt < 16; ++kt) { st[kt].x = __builtin_amdgcn_exp2f(st[kt].x - mx); st[kt].y = __builtin_amdgcn_exp2f(st[kt].y - mx); st[kt].z = __builtin_amdgcn_exp2f(st[kt].z - mx); st[kt].w = __builtin_amdgcn_exp2f(st[kt].w - mx);
        l += (st[kt].x + st[kt].y) + (st[kt].z + st[kt].w); }
      l += __shfl_xor(l, 16); l += __shfl_xor(l, 32);
#pragma unroll
      for (int mt = 0; mt < 4; ++mt) oc[mt] = (f32x4){0.f, 0.f, 0.f, 0.f};
#pragma unroll
      for (int kk = 0; kk < 8; ++kk) { const long pf = mk64(cvt4_fp8(st[2 * kk].x, st[2 * kk].y, st[2 * kk].z, st[2 * kk].w), cvt4_fp8(st[2 * kk + 1].x, st[2 * kk + 1].y, st[2 * kk + 1].z, st[2 * kk + 1].w));
#pragma unroll
        for (int mt = 0; mt < 4; ++mt) { const u32x2 a_ = *(const u32x2*)(mvl + (mt * 16 + fr) * 272 + (kk * 4 + fq) * 8);
          oc[mt] = __builtin_amdgcn_mfma_f32_16x16x32_fp8_fp8(mk64(a_.x, a_.y), pf, oc[mt], 0, 0, 0); } }
      const float il = __builtin_amdgcn_rcpf(l);
#pragma unroll
      for (int mt = 0; mt < 4; ++mt) { const f32x4 o = oc[mt] * il; ss += (o.x * o.x + o.y * o.y) + (o.z * o.z + o.w * o.w); *(u32x2*)(ocl + ((h * 4 + mt) * 64 + lane) * 8) = (u32x2){pg8::cvt_pk_bf16(o.x, o.y), pg8::cvt_pk_bf16(o.z, o.w)}; }
    }
    ss += __shfl_xor(ss, 16); ss += __shfl_xor(ss, 32);
    const float rstd = rsqrtf(ss * (1.f / 256.f) + 1e-6f);
#pragma unroll 1
    for (int h = 0; h < 4; ++h)
#pragma unroll
      for (int mt = 0; mt < 4; ++mt) { const int col = h * 64 + mt * 16 + fq * 4; const f32x4 g = *(const f32x4*)(gC + col); const u32x2 pp = *(const u32x2*)(ocl + ((h * 4 + mt) * 64 + lane) * 8);
        const f32x4 ov = {__uint_as_float(pp.x << 16), __uint_as_float(pp.x & 0xffff0000u), __uint_as_float(pp.y << 16), __uint_as_float(pp.y & 0xffff0000u)}; const f32x4 o = ov * rstd * g;
        *(u32x2*)(CAT + (size_t)(t0 + fr) * 1024 + 768 + col) = (u32x2){pg8::cvt_pk_bf16(o.x, o.y), pg8::cvt_pk_bf16(o.z, o.w)}; }
  }
  }
}

constexpr int GD_ITEM = 41088;
__device__ __forceinline__ unsigned char* gd_item(unsigned char* ws, int it) { return it < 1536 ? ws + WS_XB + (size_t)it * GD_ITEM : ws + WS_X1B + (size_t)(it - 1536) * GD_ITEM; }
__device__ __forceinline__ int kperm(int x) { return (x & 32) | (((x >> 2) & 3) << 3) | (x & 3) | (((x >> 4) & 1) << 2); }
constexpr int GP_KB = 0, GP_KBB = 9216, GP_QB = 18432, GP_VBT = 27648, GP_KBET = 36864, GP_XR = 46080  , GP_PR = 82944  , GP_OUT = 101376, GP_SC = 142336;
__device__ __forceinline__ pg8::bf16x8 ldsfrag(const unsigned char* base, int row, int ks, int fq) { return *(const pg8::bf16x8*)(base + row * 144 + ks * 64 + fq * 16); }
constexpr int G2_KB = 0, G2_KBB = 9216, G2_QB = 18432, G2_XR0 = 27648, G2_XT0 = 36864, G2_PR0 = 46080, G2_VBT = 55296, G2_KBET = 64512, G2_SC = 73728, G2_CW = 75264, G2_HALF = 78336;
__device__ void phase_gdn_prep2(const Ctx& c, unsigned char* Lb) {
  unsigned char* ws = c.ws;
  const int tid = phase_tid(), lane = tid & 63, wave = tid >> 6, fr = lane & 15, fq = lane >> 4;
  const int hb = wave >> 2, w4 = wave & 3, htid = tid & 255;
  unsigned char* L = Lb + hb * G2_HALF;
  const bf16_t* GB = (const bf16_t*)(ws + WS_GB); const float* SM = (const float*)(ws + WS_SM);
  const float* convw = c.in[6];
  float* sc = (float*)(L + G2_SC);
  float* cw = (float*)(L + G2_CW);
  const int tt = htid >> 2, part = htid & 3;
  for (int it2 = blockIdx.x; it2 < 1536; it2 += gridDim.x) {
    const int it = it2 * 2 + hb;
    const int n = it & 63, bh = it >> 6, b = bh / 6, h = bh % 6;
    const int t = n * 64 + tt; const size_t r = (size_t)b * SEQ + t;
    unsigned char* gb = gd_item(ws, it);
    __syncthreads();
    for (int i = htid; i < 768; i += 256) { const int j = i / 192, rr = i % 192; cw[i] = convw[j * 1152 + (rr >> 6) * 384 + h * 64 + (rr & 63)]; }
    if (part == 0) { const float a = SM[r * 16 + 4 + h], bb = SM[r * 16 + 10 + h]; const float xs = a + c.in[8][h]; const float sp = xs > 20.f ? xs : log1pf(__expf(xs));
      sc[tt] = -__expf(c.in[7][h]) * sp; sc[192 + tt] = 1.f / (1.f + __expf(-bb)); }
    __syncthreads();
    if (w4 == 0) { float v = sc[lane];
#pragma unroll
      for (int o = 1; o < 64; o <<= 1) { const float u = __shfl_up(v, o); if (lane >= o) v += u; }
      const float last = __shfl(v, 63);
      sc[64 + lane] = v; sc[128 + lane] = __expf(v); sc[256 + lane] = __expf(last - v); if (lane == 0) { sc[320] = __expf(last); *(float*)(gb + 40960) = __expf(last); } }
    float qv[16], kv[16], vv[16];
#pragma unroll
    for (int role = 0; role < 3; ++role) {
      float acc[16];
#pragma unroll
      for (int e = 0; e < 16; ++e) acc[e] = 0.f;
      u32x4 xr[4][2];
#pragma unroll
      for (int j = 0; j < 4; ++j) { const bool ok = t - 3 + j >= 0; const bf16_t* xp = GB + (r - 3 + j) * 1536 + role * 384 + h * 64 + part * 16;
        xr[j][0] = ok ? *(const u32x4*)xp : (u32x4){0u, 0u, 0u, 0u}; xr[j][1] = ok ? *(const u32x4*)(xp + 8) : (u32x4){0u, 0u, 0u, 0u}; }
#pragma unroll
      for (int j = 0; j < 4; ++j)
#pragma unroll
        for (int hh = 0; hh < 2; ++hh) { const u32x4 xvv = xr[j][hh]; const float* wj = cw + j * 192 + role * 64 + part * 16 + hh * 8;
          const f32x4 w0 = *(const f32x4*)wj, w1 = *(const f32x4*)(wj + 4);
          acc[hh * 8 + 0] += w0.x * __uint_as_float(xvv.x << 16); acc[hh * 8 + 1] += w0.y * __uint_as_float(xvv.x & 0xffff0000u); acc[hh * 8 + 2] += w0.z * __uint_as_float(xvv.y << 16); acc[hh * 8 + 3] += w0.w * __uint_as_float(xvv.y & 0xffff0000u);
          acc[hh * 8 + 4] += w1.x * __uint_as_float(xvv.z << 16); acc[hh * 8 + 5] += w1.y * __uint_as_float(xvv.z & 0xffff0000u); acc[hh * 8 + 6] += w1.z * __uint_as_float(xvv.w << 16); acc[hh * 8 + 7] += w1.w * __uint_as_float(xvv.w & 0xffff0000u); }
      float ss = 0.f;
#pragma unroll
      for (int e = 0; e < 16; ++e) { acc[e] = silu_f(acc[e]); ss += acc[e] * acc[e]; }
      if (role < 2) { ss += __shfl_xor(ss, 1); ss += __shfl_xor(ss, 2); const float scl = rsqrtf(ss + 1e-6f) * (role == 0 ? 0.125f : 1.f);
#pragma unroll
        for (int e = 0; e < 16; ++e) acc[e] *= scl; }
#pragma unroll
      for (int e = 0; e < 16; ++e) { if (role == 0) qv[e] = acc[e]; else if (role == 1) kv[e] = acc[e]; else vv[e] = acc[e]; }
    }
    __syncthreads();
    { const float beta = sc[192 + tt], eg = sc[128 + tt], ekl = sc[256 + tt];
      float kb[16];
#pragma unroll
      for (int e = 0; e < 16; ++e) kb[e] = kv[e] * beta;
#pragma unroll
      for (int hh = 0; hh < 2; ++hh) { const int o8 = hh * 8;
        *(u32x4*)(L + G2_KB + tt * 144 + part * 32 + hh * 16) = (u32x4){pk2(kv[o8], kv[o8 + 1]), pk2(kv[o8 + 2], kv[o8 + 3]), pk2(kv[o8 + 4], kv[o8 + 5]), pk2(kv[o8 + 6], kv[o8 + 7])};
        *(u32x4*)(L + G2_KBB + tt * 144 + part * 32 + hh * 16) = (u32x4){pk2(kb[o8], kb[o8 + 1]), pk2(kb[o8 + 2], kb[o8 + 3]), pk2(kb[o8 + 4], kb[o8 + 5]), pk2(kb[o8 + 6], kb[o8 + 7])};
        *(u32x4*)(L + G2_QB + tt * 144 + part * 32 + hh * 16) = (u32x4){pk2(qv[o8], qv[o8 + 1]), pk2(qv[o8 + 2], qv[o8 + 3]), pk2(qv[o8 + 4], qv[o8 + 5]), pk2(qv[o8 + 6], qv[o8 + 7])}; }
      const int ptt = kperm(tt);
#pragma unroll
      for (int e = 0; e < 16; ++e) { const int d = part * 16 + e;
        *(bf16_t*)(L + G2_VBT + d * 144 + tt * 2) = f2bf(vv[e] * beta);
        *(bf16_t*)(L + G2_KBET + d * 144 + tt * 2) = f2bf(kb[e] * eg);
        *(bf16_t*)(gb + 8192 + tt * 128 + kperm(d) * 2) = f2bf(qv[e] * eg);
        *(bf16_t*)(gb + 3 * 8192 + d * 128 + ptt * 2) = f2bf(kv[e] * ekl); } }
    __syncthreads();
    const int rowb = (w4 * 16 + fq * 4) * 144 + fr * 2;
    const int colb = fr * 144 + (w4 * 16 + fq * 4) * 2;
    const int fa = (w4 * 16 + fr) * 144 + fq * 16;
    const int fb = fr * 144 + fq * 16;
    const int i0 = w4 * 16 + fq * 4;
#define G2F(buf, off) (*(const pg8::bf16x8*)(L + (buf) + (off)))
#define G2W16(buf, off, v) (*(bf16_t*)(L + (buf) + (off)) = f2bf(v))
    f32x4 Pt[4];
    { const float gi0 = sc[64 + i0], gi1 = sc[64 + i0 + 1], gi2 = sc[64 + i0 + 2], gi3 = sc[64 + i0 + 3];
#pragma unroll
    for (int u = 0; u < 4; ++u) {
      f32x4 dl = {0.f, 0.f, 0.f, 0.f}, da = {0.f, 0.f, 0.f, 0.f};
#pragma unroll
      for (int ks = 0; ks < 2; ++ks) { const pg8::bf16x8 bk = G2F(G2_KB, fb + u * 2304 + ks * 64);
        dl = __builtin_amdgcn_mfma_f32_16x16x32_bf16(G2F(G2_KBB, fa + ks * 64), bk, dl, 0, 0, 0);
        da = __builtin_amdgcn_mfma_f32_16x16x32_bf16(G2F(G2_QB, fa + ks * 64), bk, da, 0, 0, 0); }
      const int j = u * 16 + fr; const float gj = sc[64 + j]; const int pj = kperm(j);
      const float dec0 = __expf(fminf(gi0 - gj, 0.f)), dec1 = __expf(fminf(gi1 - gj, 0.f)), dec2 = __expf(fminf(gi2 - gj, 0.f)), dec3 = __expf(fminf(gi3 - gj, 0.f));
      const float l0 = i0 + 0 > j ? dl.x * dec0 : 0.f, l1 = i0 + 1 > j ? dl.y * dec1 : 0.f, l2 = i0 + 2 > j ? dl.z * dec2 : 0.f, l3 = i0 + 3 > j ? dl.w * dec3 : 0.f;
      const float a0 = i0 + 0 >= j ? da.x * dec0 : 0.f, a1 = i0 + 1 >= j ? da.y * dec1 : 0.f, a2 = i0 + 2 >= j ? da.z * dec2 : 0.f, a3 = i0 + 3 >= j ? da.w * dec3 : 0.f;
      const f32x4 pv = {(i0 + 0 == j ? 1.f : 0.f) - l0, (i0 + 1 == j ? 1.f : 0.f) - l1, (i0 + 2 == j ? 1.f : 0.f) - l2, (i0 + 3 == j ? 1.f : 0.f) - l3};
      G2W16(G2_XR0, rowb + u * 32, l0); G2W16(G2_XR0, rowb + 144 + u * 32, l1); G2W16(G2_XR0, rowb + 288 + u * 32, l2); G2W16(G2_XR0, rowb + 432 + u * 32, l3);
      G2W16(G2_PR0, rowb + u * 32, pv.x); G2W16(G2_PR0, rowb + 144 + u * 32, pv.y); G2W16(G2_PR0, rowb + 288 + u * 32, pv.z); G2W16(G2_PR0, rowb + 432 + u * 32, pv.w);
      *(u32x2*)(L + G2_XT0 + colb + u * 2304) = (u32x2){pk2(l0, l1), pk2(l2, l3)};
      bf16_t* am = (bf16_t*)(gb + 2 * 8192 + i0 * 128 + pj * 2);
      am[0] = f2bf(a0); am[64] = f2bf(a1); am[128] = f2bf(a2); am[192] = f2bf(a3);
      Pt[u] = pv; } }
    __syncthreads();
#pragma unroll
    for (int u = 0; u < 4; ++u) {
      f32x4 d = {0.f, 0.f, 0.f, 0.f};
#pragma unroll
      for (int ks = 0; ks < 2; ++ks) d = __builtin_amdgcn_mfma_f32_16x16x32_bf16(G2F(G2_XR0, fa + ks * 64), G2F(G2_XT0, fb + u * 2304 + ks * 64), d, 0, 0, 0);
      G2W16(G2_KB, rowb + u * 32, d.x); G2W16(G2_KB, rowb + 144 + u * 32, d.y); G2W16(G2_KB, rowb + 288 + u * 32, d.z); G2W16(G2_KB, rowb + 432 + u * 32, d.w);
      *(u32x2*)(L + G2_KBB + colb + u * 2304) = (u32x2){pk2(d.x, d.y), pk2(d.z, d.w)}; }
    __syncthreads();
#pragma unroll
    for (int itn = 0; itn < 4; ++itn) {
      const int XRc = (itn & 1) ? G2_XR0 : G2_KB, XTc = (itn & 1) ? G2_XT0 : G2_KBB, XRn = (itn & 1) ? G2_KB : G2_XR0, XTn = (itn & 1) ? G2_KBB : G2_XT0;
      const int PRc = (itn & 1) ? G2_QB : G2_PR0, PRn = (itn & 1) ? G2_PR0 : G2_QB;
#pragma unroll
      for (int u = 0; u < 4; ++u) {
        f32x4 d = {0.f, 0.f, 0.f, 0.f};
#pragma unroll
        for (int ks = 0; ks < 2; ++ks) { const pg8::bf16x8 bx = G2F(XTc, fb + u * 2304 + ks * 64);
          Pt[u] = __builtin_amdgcn_mfma_f32_16x16x32_bf16(G2F(PRc, fa + ks * 64), bx, Pt[u], 0, 0, 0);
          if (itn < 3) d = __builtin_amdgcn_mfma_f32_16x16x32_bf16(G2F(XRc, fa + ks * 64), bx, d, 0, 0, 0); }
        G2W16(PRn, rowb + u * 32, Pt[u].x); G2W16(PRn, rowb + 144 + u * 32, Pt[u].y); G2W16(PRn, rowb + 288 + u * 32, Pt[u].z); G2W16(PRn, rowb + 432 + u * 32, Pt[u].w);
        if (itn < 3) { G2W16(XRn, rowb + u * 32, d.x); G2W16(XRn, rowb + 144 + u * 32, d.y); G2W16(XRn, rowb + 288 + u * 32, d.z); G2W16(XRn, rowb + 432 + u * 32, d.w);
          *(u32x2*)(L + XTn + colb + u * 2304) = (u32x2){pk2(d.x, d.y), pk2(d.z, d.w)}; } }
      __syncthreads();
    }
#pragma unroll
    for (int u = 0; u < 4; ++u) {
      f32x4 du = {0.f, 0.f, 0.f, 0.f}, dw = {0.f, 0.f, 0.f, 0.f};
#pragma unroll
      for (int ks = 0; ks < 2; ++ks) { const pg8::bf16x8 a = G2F(G2_PR0, fa + ks * 64);
        du = __builtin_amdgcn_mfma_f32_16x16x32_bf16(a, G2F(G2_VBT, fb + u * 2304 + ks * 64), du, 0, 0, 0);
        dw = __builtin_amdgcn_mfma_f32_16x16x32_bf16(a, G2F(G2_KBET, fb + u * 2304 + ks * 64), dw, 0, 0, 0); }
      const int j = u * 16 + fr, pj = kperm(j);
      *(u32x2*)(gb + 4 * 8192 + j * 128 + i0 * 2) = (u32x2){pk2(du.x, du.y), pk2(du.z, du.w)};
      bf16_t* wn = (bf16_t*)(gb + i0 * 128 + pj * 2);
      wn[0] = f2bf(-dw.x); wn[64] = f2bf(-dw.y); wn[128] = f2bf(-dw.z); wn[192] = f2bf(-dw.w); }
#undef G2F
#undef G2W16
  }
}

constexpr int GS_SLOT = 46208, GS_OB = 2 * GS_SLOT;
__device__ void phase_gdn_scan(const Ctx& c, unsigned char* L, int item) {
  unsigned char* ws = c.ws;
  const int tid = phase_tid(), lane = tid & 63, wave = tid >> 6, fr = lane & 15, fq = lane >> 4;
  const int b = item / 6, h = item % 6;
  const bf16_t* GB = (const bf16_t*)(ws + WS_GB); bf16_t* CAT = (bf16_t*)(ws + WS_CAT); const float* gng = c.in[9];
  const int lt = tid - 256;
  u32x4 ra[10], rb[10]; float gla = 0.f, glb = 0.f;
  f32x4 S[4];
#pragma unroll
  for (int i = 0; i < 4; ++i) S[i] = (f32x4){0.f, 0.f, 0.f, 0.f};
#define GS_LOAD(R, G, n) do { if ((n) < 64) { const unsigned char* gb_ = gd_item(ws, item * 64 + (n)); _Pragma("unroll") for (int i_ = 0; i_ < 10; ++i_) R[i_] = *(const u32x4*)(gb_ + (size_t)(lt + 256 * i_) * 16); if (lt == 0) G = *(const float*)(gb_ + 40960); } } while (0)
#define GS_STORE(R, G, slot) do { _Pragma("unroll") for (int i_ = 0; i_ < 10; ++i_) { const int p_ = lt + 256 * i_; *(u32x4*)(L + (slot) * GS_SLOT + (p_ >> 9) * 9216 + ((p_ >> 3) & 63) * 144 + (p_ & 7) * 16) = R[i_]; } if (lt == 0) *(float*)(L + (slot) * GS_SLOT + 46080) = G; } while (0)
  float gnr[16];
#pragma unroll
  for (int e = 0; e < 16; ++e) gnr[e] = gng[((tid - 256) & 3) * 16 + e];
  auto zload = [&](int k, u32x4& z0, u32x4& z1) {
    const size_t r = (size_t)b * SEQ + k * 64 + (lt >> 2); const bf16_t* zp = GB + r * 1536 + 1152 + h * 64 + (lt & 3) * 16; z0 = *(const u32x4*)zp; z1 = *(const u32x4*)(zp + 8); };
  auto post = [&](int k, const u32x4 z0, const u32x4 z1) {
    const unsigned char* ob = L + GS_OB + (k & 1) * 9216; const int tk = lt >> 2, part = lt & 3; const size_t r = (size_t)b * SEQ + k * 64 + tk;
    const u32x4 o0 = *(const u32x4*)(ob + tk * 144 + part * 32), o1 = *(const u32x4*)(ob + tk * 144 + part * 32 + 16);
    float ov[16] = {__uint_as_float(o0.x << 16), __uint_as_float(o0.x & 0xffff0000u), __uint_as_float(o0.y << 16), __uint_as_float(o0.y & 0xffff0000u), __uint_as_float(o0.z << 16), __uint_as_float(o0.z & 0xffff0000u), __uint_as_float(o0.w << 16), __uint_as_float(o0.w & 0xffff0000u),
                    __uint_as_float(o1.x << 16), __uint_as_float(o1.x & 0xffff0000u), __uint_as_float(o1.y << 16), __uint_as_float(o1.y & 0xffff0000u), __uint_as_float(o1.z << 16), __uint_as_float(o1.z & 0xffff0000u), __uint_as_float(o1.w << 16), __uint_as_float(o1.w & 0xffff0000u)};
    float ss = 0.f;
#pragma unroll
    for (int e = 0; e < 16; ++e) ss += ov[e] * ov[e];
    ss += __shfl_xor(ss, 1); ss += __shfl_xor(ss, 2);
    const float rstd = rsqrtf(ss * (1.f / 64.f) + 1e-6f);
    const float zf[16] = {__uint_as_float(z0.x << 16), __uint_as_float(z0.x & 0xffff0000u), __uint_as_float(z0.y << 16), __uint_as_float(z0.y & 0xffff0000u), __uint_as_float(z0.z << 16), __uint_as_float(z0.z & 0xffff0000u), __uint_as_float(z0.w << 16), __uint_as_float(z0.w & 0xffff0000u),
                          __uint_as_float(z1.x << 16), __uint_as_float(z1.x & 0xffff0000u), __uint_as_float(z1.y << 16), __uint_as_float(z1.y & 0xffff0000u), __uint_as_float(z1.z << 16), __uint_as_float(z1.z & 0xffff0000u), __uint_as_float(z1.w << 16), __uint_as_float(z1.w & 0xffff0000u)};
#pragma unroll
    for (int e = 0; e < 16; ++e) ov[e] = ov[e] * rstd * gnr[e] * silu_f(zf[e]);
    bf16_t* op = CAT + r * 1024 + 384 + h * 64 + part * 16;
    *(u32x4*)op = (u32x4){pk2(ov[0], ov[1]), pk2(ov[2], ov[3]), pk2(ov[4], ov[5]), pk2(ov[6], ov[7])};
    *(u32x4*)(op + 8) = (u32x4){pk2(ov[8], ov[9]), pk2(ov[10], ov[11]), pk2(ov[12], ov[13]), pk2(ov[14], ov[15])};
  };
  auto step = [&](int k) {
    const unsigned char* sb = L + (k & 1) * GS_SLOT; const float gl = *(const float*)(sb + 46080);
    const pg8::bf16x8 Sb0 = packp(S[0], S[1]), Sb1 = packp(S[2], S[3]);
    f32x4 vn[4], o[4];
#pragma unroll
    for (int mt = 0; mt < 4; ++mt) { const u32x2 uv = *(const u32x2*)(sb + 4 * 9216 + (wave * 16 + fr) * 144 + (mt * 16 + fq * 4) * 2);
      f32x4 a = {__uint_as_float(uv.x << 16), __uint_as_float(uv.x & 0xffff0000u), __uint_as_float(uv.y << 16), __uint_as_float(uv.y & 0xffff0000u)};
      a = __builtin_amdgcn_mfma_f32_16x16x32_bf16(ldsfrag(sb, mt * 16 + fr, 0, fq), Sb0, a, 0, 0, 0);
      vn[mt] = __builtin_amdgcn_mfma_f32_16x16x32_bf16(ldsfrag(sb, mt * 16 + fr, 1, fq), Sb1, a, 0, 0, 0);
      f32x4 q = {0.f, 0.f, 0.f, 0.f};
      q = __builtin_amdgcn_mfma_f32_16x16x32_bf16(ldsfrag(sb + 9216, mt * 16 + fr, 0, fq), Sb0, q, 0, 0, 0);
      o[mt] = __builtin_amdgcn_mfma_f32_16x16x32_bf16(ldsfrag(sb + 9216, mt * 16 + fr, 1, fq), Sb1, q, 0, 0, 0); }
    const pg8::bf16x8 Vb0 = packp(vn[0], vn[1]), Vb1 = packp(vn[2], vn[3]);
#pragma unroll
    for (int mt = 0; mt < 4; ++mt) { o[mt] = __builtin_amdgcn_mfma_f32_16x16x32_bf16(ldsfrag(sb + 2 * 9216, mt * 16 + fr, 0, fq), Vb0, o[mt], 0, 0, 0);
      o[mt] = __builtin_amdgcn_mfma_f32_16x16x32_bf16(ldsfrag(sb + 2 * 9216, mt * 16 + fr, 1, fq), Vb1, o[mt], 0, 0, 0); }
#pragma unroll
    for (int kt = 0; kt < 4; ++kt) { f32x4 sv = S[kt] * gl;
      sv = __builtin_amdgcn_mfma_f32_16x16x32_bf16(ldsfrag(sb + 3 * 9216, kt * 16 + fr, 0, fq), Vb0, sv, 0, 0, 0);
      S[kt] = __builtin_amdgcn_mfma_f32_16x16x32_bf16(ldsfrag(sb + 3 * 9216, kt * 16 + fr, 1, fq), Vb1, sv, 0, 0, 0); }
    unsigned char* ob = L + GS_OB + (k & 1) * 9216 + (wave * 16 + fr) * 2;
#pragma unroll
    for (int mt = 0; mt < 4; ++mt) { const int t0 = mt * 16 + fq * 4;
      *(bf16_t*)(ob + (t0 + 0) * 144) = f2bf(o[mt].x); *(bf16_t*)(ob + (t0 + 1) * 144) = f2bf(o[mt].y); *(bf16_t*)(ob + (t0 + 2) * 144) = f2bf(o[mt].z); *(bf16_t*)(ob + (t0 + 3) * 144) = f2bf(o[mt].w); }
  };
  __syncthreads();
  u32x4 z0a = {0u, 0u, 0u, 0u}, z0b = z0a, z1a = z0a, z1b = z0a;
  if (wave >= 4) { GS_LOAD(ra, gla, 0); GS_STORE(ra, gla, 0); GS_LOAD(ra, gla, 1); GS_LOAD(rb, glb, 2); zload(0, z0a, z0b); }
  __syncthreads();
#define SCAN_BAR() do { asm volatile("s_waitcnt lgkmcnt(0)" ::: "memory"); __builtin_amdgcn_s_barrier(); asm volatile("" ::: "memory"); } while (0)
  if (wave < 4) {
#pragma unroll 1
    for (int k = 0; k < 64; ++k) { step(k); SCAN_BAR(); }
  } else {
#define GS_LSTEP(R, G, ZA, ZB, kk) do { if ((kk) + 1 < 64) GS_STORE(R, G, ((kk) + 1) & 1); GS_LOAD(R, G, (kk) + 3); if ((kk) > 0) post((kk) - 1, ZA, ZB); if ((kk) + 1 < 64) zload((kk) + 1, ZA, ZB); SCAN_BAR(); } while (0)
#pragma unroll 1
    for (int k = 0; k < 64; k += 2) { GS_LSTEP(ra, gla, z1a, z1b, k); GS_LSTEP(rb, glb, z0a, z0b, k + 1); }
    post(63, z1a, z1b);
#undef GS_LSTEP
  }
#undef SCAN_BAR
#undef GS_LOAD
#undef GS_STORE
}

__device__ __forceinline__ f32x4 bf4(u32x2 p) { return (f32x4){__uint_as_float(p.x << 16), __uint_as_float(p.x & 0xffff0000u), __uint_as_float(p.y << 16), __uint_as_float(p.y & 0xffff0000u)}; }
__device__ void phase_router(const Ctx& c, unsigned char* ldsb) {
  unsigned char* ws = c.ws;
  const int tid = phase_tid(), lane = tid & 63, wave = tid >> 6, fr = lane & 15, fq = lane >> 4;
  float* lg = (float*)(ldsb + wave * 5632);
  const float* bg = c.in[17]; const float* br = c.in[19]; const float* g1 = c.in[14]; const float* b1 = c.in[15];
  const bf16_t* WR = (const bf16_t*)(ws + WS_WR); bf16_t* X1B = (bf16_t*)(ws + WS_X1B);
  unsigned* ctl = (unsigned*)(ws + WS_CTL);
  unsigned* LIST = (unsigned*)(ws + WS_LIST); float* GATEL = (float*)(ws + WS_GATEL); unsigned* TSLOT = (unsigned*)(ws + WS_TSLOT);
  unsigned* cntl = (unsigned*)(ldsb + 46080); unsigned* basel = cntl + 64;
  __syncthreads();
  if (tid < 64) cntl[tid] = 0u;
  __syncthreads();
  for (int tile = blockIdx.x * NWAVES + wave; tile < T / 16; tile += gridDim.x * NWAVES) {
    const int t0 = tile * 16;
    float mean_t = 0.f, rstd_t = 0.f;
#pragma unroll 2
    for (int i = 0; i < 16; ++i) { const u32x2* row = (const u32x2*)(X1B + (size_t)(t0 + i) * 1024);
      f32x4 v[4]; float sm = 0.f;
#pragma unroll
      for (int j = 0; j < 4; ++j) { v[j] = bf4(row[lane + 64 * j]); sm += (v[j].x + v[j].y) + (v[j].z + v[j].w); }
      const float mean = wave_sum(sm) * (1.f / 1024.f); float s2 = 0.f;
#pragma unroll
      for (int j = 0; j < 4; ++j) { v[j] = v[j] - mean; s2 += (v[j].x * v[j].x + v[j].y * v[j].y) + (v[j].z * v[j].z + v[j].w * v[j].w); }
      const float rstd = rsqrtf(wave_sum(s2) * (1.f / 1024.f) + 1e-5f);
      if (fr == i) { mean_t = mean; rstd_t = rstd; } }
    f32x4 acc[5];
#pragma unroll
    for (int nt = 0; nt < 5; ++nt) acc[nt] = (f32x4){0.f, 0.f, 0.f, 0.f};
    bf16_t* xp = X1B + (size_t)(t0 + fr) * 1024 + fq * 8; unsigned char* x8 = ws + WS_X1F + (size_t)(t0 + fr) * 1024 + fq * 8;
#pragma unroll 2
    for (int ks = 0; ks < 32; ++ks) {
      const u32x4 yv = *(const u32x4*)(xp + ks * 32);
      const f32x4 ga = *(const f32x4*)(g1 + ks * 32 + fq * 8), gb2 = *(const f32x4*)(g1 + ks * 32 + fq * 8 + 4), ba = *(const f32x4*)(b1 + ks * 32 + fq * 8), bb2 = *(const f32x4*)(b1 + ks * 32 + fq * 8 + 4);
      const f32x4 y0 = {__uint_as_float(yv.x << 16), __uint_as_float(yv.x & 0xffff0000u), __uint_as_float(yv.y << 16), __uint_as_float(yv.y & 0xffff0000u)};
      const f32x4 y1 = {__uint_as_float(yv.z << 16), __uint_as_float(yv.z & 0xffff0000u), __uint_as_float(yv.w << 16), __uint_as_float(yv.w & 0xffff0000u)};
      const f32x4 n0 = (y0 - mean_t) * rstd_t * ga + ba, n1 = (y1 - mean_t) * rstd_t * gb2 + bb2;
      const u32x4 xw = {cvtpk_c(n0.x, n0.y), cvtpk_c(n0.z, n0.w), cvtpk_c(n1.x, n1.y), cvtpk_c(n1.z, n1.w)};
      *(u32x4*)(xp + ks * 32) = xw;
      *(u32x2*)(x8 + ks * 32) = (u32x2){cvt4_fp8(n0.x, n0.y, n0.z, n0.w), cvt4_fp8(n1.x, n1.y, n1.z, n1.w)};
      const pg8::bf16x8 bx = __builtin_bit_cast(pg8::bf16x8, xw);
#pragma unroll
      for (int nt = 0; nt < 5; ++nt) acc[nt] = __builtin_amdgcn_mfma_f32_16x16x32_bf16(*(const pg8::bf16x8*)(WR + (size_t)(nt * 16 + fr) * 1024 + ks * 32 + fq * 8), bx, acc[nt], 0, 0, 0); }
#pragma unroll
    for (int nt = 0; nt < 5; ++nt) { const int o = nt * 16 + fq * 4; *(f32x4*)(lg + fr * 88 + o) = acc[nt]; }
    asm volatile("s_waitcnt lgkmcnt(0)" ::: "memory");
    int ex1 = 0, ex2 = 0; float gt1 = 0.f, gt2 = 0.f; unsigned lr1 = 0u, lr2 = 0u;
    if (lane < 16) {
      const float* l = lg + lane * 88;
      int grp = 0; float gm = l[0] + bg[0];
      for (int i = 1; i < 8; ++i) { const float v = l[i] + bg[i]; if (v > gm) { gm = v; grp = i; } }
      float gs = 0.f; for (int i = 0; i < 8; ++i) gs += __expf(l[i] + bg[i] - gm);
      const float pgrp = 1.f / gs;
      const float* el = l + 8 + grp * 8; const float* eb = br + grp * 8;
      int i1 = 0; float m1 = el[0] + eb[0]; for (int i = 1; i < 8; ++i) { const float v = el[i] + eb[i]; if (v > m1) { m1 = v; i1 = i; } }
      int i2 = -1; float m2 = -3.0e38f; for (int i = 0; i < 8; ++i) { const float v = el[i] + eb[i]; if (i != i1 && v > m2) { m2 = v; i2 = i; } }
      const float e2 = __expf(m2 - m1), den = 1.f / (1.f + e2);
      gt1 = pgrp * den; gt2 = pgrp * e2 * den;
      ex1 = grp * 8 + i1; ex2 = grp * 8 + i2;
      lr1 = atomicAdd(&cntl[ex1], 1u); lr2 = atomicAdd(&cntl[ex2], 1u);
    }
    __syncthreads();
    if (wave == 0) { const unsigned nloc = cntl[lane]; basel[lane] = nloc ? atomicAdd(&ctl[CW_CNT + lane], nloc) : 0u; }
    __syncthreads();
    if (lane < 16) {
      const int t = t0 + lane; const unsigned r1 = basel[ex1] + lr1, r2 = basel[ex2] + lr2;
      LIST[(size_t)ex1 * 32768 + r1] = (unsigned)t; GATEL[(size_t)ex1 * 32768 + r1] = gt1;
      LIST[(size_t)ex2 * 32768 + r2] = (unsigned)t; GATEL[(size_t)ex2 * 32768 + r2] = gt2;
      TSLOT[(size_t)t * 2 + 0] = ((unsigned)ex1 << 16) | r1; TSLOT[(size_t)t * 2 + 1] = ((unsigned)ex2 << 16) | r2;
    }
    __syncthreads();
    if (tid < 64) cntl[tid] = 0u;
    __syncthreads();
  }
}

__device__ void phase_combine(const Ctx& c, float* lds) {
  unsigned char* ws = c.ws;
  const int tid = phase_tid(), lane = tid & 63, wave = tid >> 6;
  int* offs = (int*)lds; int* cnts = offs + 65;
  expert_offsets(c, offs, cnts, tid);
  const unsigned char* Y = (const unsigned char*)(ws + WS_Y); const unsigned* TSLOT = (const unsigned*)(ws + WS_TSLOT);
  const float* g2 = c.in[23]; const float* b2 = c.in[24];
  for (int t = blockIdx.x * NWAVES + wave; t < T; t += gridDim.x * NWAVES) {
    const unsigned s0 = TSLOT[(size_t)t * 2], s1 = TSLOT[(size_t)t * 2 + 1];
    const size_t r0 = (size_t)offs[s0 >> 16] + (s0 & 0xffffu), r1 = (size_t)offs[s1 >> 16] + (s1 & 0xffffu);
    f32x4* row = (f32x4*)(c.out + (size_t)t * 1024); const u32x2* xrow = (const u32x2*)((const bf16_t*)(ws + WS_X1B) + (size_t)t * 1024);
    f32x4 v[4]; float s = 0.f;
#pragma unroll
    for (int j = 0; j < 4; ++j) { const unsigned ya = ((const unsigned*)(Y + r0 * 1024))[lane + 64 * j], yb = ((const unsigned*)(Y + r1 * 1024))[lane + 64 * j];
      f32x4 x = bf4(xrow[lane + 64 * j]) * ALPHA;
      const hw_f32x2 a01 = __builtin_amdgcn_cvt_pk_f32_fp8(ya, false), a23 = __builtin_amdgcn_cvt_pk_f32_fp8(ya, true), b01 = __builtin_amdgcn_cvt_pk_f32_fp8(yb, false), b23 = __builtin_amdgcn_cvt_pk_f32_fp8(yb, true);
      x.x += (a01.x + b01.x) * 0.015625f; x.y += (a01.y + b01.y) * 0.015625f; x.z += (a23.x + b23.x) * 0.015625f; x.w += (a23.y + b23.y) * 0.015625f;
      v[j] = x; s += (x.x + x.y) + (x.z + x.w); }
    const float mean = wave_sum(s) * (1.f / 1024.f); float s2 = 0.f;
#pragma unroll
    for (int j = 0; j < 4; ++j) { v[j] = v[j] - mean; s2 += (v[j].x * v[j].x + v[j].y * v[j].y) + (v[j].z * v[j].z + v[j].w * v[j].w); }
    const float rstd = rsqrtf(wave_sum(s2) * (1.f / 1024.f) + 1e-5f);
#pragma unroll
    for (int j = 0; j < 4; ++j) { const f32x4 g = ((const f32x4*)g2)[lane + 64 * j], bb = ((const f32x4*)b2)[lane + 64 * j]; row[lane + 64 * j] = v[j] * rstd * g + bb; }
  }
}

constexpr int NPHASE = 11;
__global__ void __launch_bounds__(NTHREADS, 2) mega(Ctx c) {
  float* lds = (float*)lds_raw;
  unsigned* ctl = (unsigned*)(c.ws + WS_CTL);
  unsigned* bar = ctl + CW_BAR;
  if (threadIdx.x == 0) { *(volatile unsigned*)(lds_raw + LDS_WCTR) = 0u; *(volatile unsigned*)(lds_raw + LDS_XBST) = 0u; *(volatile unsigned*)(lds_raw + LDS_XBST + 4) = 0u;
    (void)xb_add(&bar[XB_XCNT(xb_xcc_id())], 1u); }
  __syncthreads();
  phase_prologue(c, lds);
  xcd_barrier(bar);
  phase_inproj_mfma(c, (lds_u8*)lds_raw);
  phase_tiles_queue(c, lds, ctl + CW_Q + 48, TP_WD0 - TP_D1, TP_WD0);
  xcd_barrier(bar);
  phase_gdn_prep2(c, lds_raw);
  phase_kvup(c, lds);
  phase_topk_mfma(c, lds_raw, ctl + CW_Q);
  xcd_barrier(bar);
  if (blockIdx.x < 48) phase_gdn_scan(c, lds_raw, blockIdx.x);
  phase_attn_sparse(c, lds_raw, ctl + CW_Q + 16);
  phase_attn_mem(c, lds_raw, ctl + CW_Q + 32);
  xcd_barrier(bar);
  phase_outproj_mfma(c, (lds_u8*)lds_raw);
  xcd_barrier(bar);
  phase_router(c, lds_raw);
  xcd_barrier(bar);
  phase_moe_up_mfma(c, (lds_u8*)lds_raw);
  phase_tiles_queue(c, lds, ctl + CW_Q + 64, TP_WD0, TP_TOTAL);
  xcd_barrier(bar);
  phase_moe_down_mfma(c, (lds_u8*)lds_raw);
  xcd_barrier(bar);
  phase_combine(c, lds);
}

extern "C" void kernel_launch(void* const* d_in, const int* in_sizes, int n_in, void* d_out, int out_size, void* d_ws, size_t ws_size, hipStream_t stream) {
  static int grid = 0;
  if (grid == 0) {
    if (n_in != 25 || ws_size < WS_END) { fprintf(stderr, "kernel_launch: unexpected n_in %d / ws %zu\n", n_in, ws_size); grid = -1; return; }
    int dev = 0, cus = 0, per_cu = 0;
    hipGetDevice(&dev); hipDeviceGetAttribute(&cus, hipDeviceAttributeMultiprocessorCount, dev);
    hipFuncSetAttribute((const void*)mega, hipFuncAttributeMaxDynamicSharedMemorySize, LDS_BYTES);
    hipOccupancyMaxActiveBlocksPerMultiprocessor(&per_cu, (const void*)mega, NTHREADS, LDS_BYTES);
    if (per_cu < 1) { fprintf(stderr, "kernel_launch: occupancy query says %d blocks/CU\n", per_cu); per_cu = 1; }
    grid = cus * (per_cu < 1 ? 1 : 1);
    (void)hipGetLastError();
  }
  if (grid < 0) return;
  hipMemsetAsync((char*)d_ws + WS_CTL, 0, 32 * 1024, stream);
  Ctx c; memset(&c, 0, sizeof(c));
  for (int i = 0; i < 25; ++i) c.in[i] = (const float*)d_in[i];
  c.out = (float*)d_out; c.ws = (unsigned char*)d_ws;
  hipLaunchKernelGGL(mega, dim3(grid), dim3(NTHREADS), LDS_BYTES, stream, c);
}
```

```cpp
#include <hip/hip_runtime.h>
#include <cstdio>
#include <cstdint>
#include <cstring>

#ifndef ONE_LAUNCH
#define ONE_LAUNCH 1
#endif

typedef unsigned short bf16_t;
typedef float f32x4 __attribute__((ext_vector_type(4)));
typedef unsigned u32x4 __attribute__((ext_vector_type(4)));
typedef unsigned u32x2 __attribute__((ext_vector_type(2)));

constexpr int T = 32768, DM = 1024, SEQ = 4096, NBATCH = 8;
constexpr int NIN = 2816;
constexpr int NMEM = 256, TM = NBATCH * NMEM;
constexpr int NEXP = 64, DE = 256;
constexpr int NTHREADS = 512, NWAVES = 8;
constexpr float ALPHA = 1.189207115002721f;
constexpr float LOG2E = 1.4426950408889634f;
constexpr float QSCALE = 0.125f * LOG2E;

constexpr size_t MiB = 1ull << 20;
constexpr size_t WS_CTL = 0;
constexpr size_t WS_TSLOT = 512 * 1024;
constexpr size_t WS_ROPE = 1 * MiB;
constexpr size_t WS_WKV = 2 * MiB;
constexpr size_t WS_WR = 2 * MiB + 65536;
constexpr size_t WS_WIN = 3 * MiB;
constexpr size_t WS_WO = 9 * MiB;
constexpr size_t WS_WMKV = 11 * MiB;
constexpr size_t WS_MEMB = 12 * MiB;
constexpr size_t WS_WGU = 16 * MiB;
constexpr size_t WS_WD = 80 * MiB;
constexpr size_t WS_XB = 112 * MiB;
constexpr size_t WS_QA = 176 * MiB;
constexpr size_t WS_CKV = 200 * MiB;
constexpr size_t WS_IQ = 208 * MiB;
constexpr size_t WS_IK = 224 * MiB;
constexpr size_t WS_SM = 228 * MiB;
constexpr size_t WS_QC = 230 * MiB;
constexpr size_t WS_GB = 246 * MiB;
constexpr size_t WS_X1F = WS_GB;
constexpr float W8SCALE = 32.f, H8SCALE = 8.f;
constexpr size_t WS_MK = 342 * MiB;
constexpr size_t WS_MVT = 343 * MiB;
constexpr size_t WS_KVA = 344 * MiB;
constexpr size_t WS_SEL = 352 * MiB;
constexpr size_t WS_CAT = 368 * MiB;
constexpr size_t WS_X1B = 432 * MiB;
constexpr size_t WS_LIST = 496 * MiB;
constexpr size_t WS_GATEL = 504 * MiB;
constexpr size_t WS_END = 512 * MiB;
constexpr size_t WS_H = 112 * MiB;
constexpr size_t WS_Y = 160 * MiB;

constexpr int CW_CNT = 0;
constexpr int CW_Q = 64;
constexpr int CW_BAR = 4096;

struct Ctx {
  const float* in[25];
  float* out;
  unsigned char* ws;
  int ph_lo, ph_hi;
};


extern __shared__ __attribute__((aligned(16))) unsigned char lds_raw[];
constexpr int LDS_BYTES = 157696;
constexpr int LDS_WCTR = LDS_BYTES - 64;
__device__ __forceinline__ int phase_tid() {
  __syncthreads();
  int l; asm volatile("v_mbcnt_lo_u32_b32 %0, -1, 0\n\tv_mbcnt_hi_u32_b32 %0, -1, %0" : "=v"(l));
  unsigned w = 0u;
  if (l == 0) w = __hip_atomic_fetch_add((__attribute__((address_space(3))) unsigned*)(__attribute__((address_space(3))) unsigned char*)(lds_raw + LDS_WCTR), 1u, __ATOMIC_RELAXED, __HIP_MEMORY_SCOPE_WORKGROUP);
  w = (unsigned)__builtin_amdgcn_readfirstlane((int)w) & 7u;
  return (int)(w * 64u) + l;
}


#define XB_TMO      128
#define XB_XCNT(j)  (256  + 64 * (j))
#define XB_XSUB(j)  (1280 + 64 * (j))
#define XB_XGEN(j)  (2304 + 64 * (j))
#define XB_TOP      3328
#define XB_TOPGEN   3392
#define XCD_BAR_WORDS 3456
#define XB_SPIN_CAP (1u << 18)
constexpr int LDS_XBST = LDS_BYTES - 32;
__device__ __forceinline__ unsigned xb_ld(unsigned* p)              { return __hip_atomic_load(p, __ATOMIC_RELAXED, __HIP_MEMORY_SCOPE_AGENT); }
__device__ __forceinline__ unsigned xb_add(unsigned* p, unsigned v) { return __hip_atomic_fetch_add(p, v, __ATOMIC_RELAXED, __HIP_MEMORY_SCOPE_AGENT); }
__device__ __forceinline__ unsigned xb_xcc_id() { return (unsigned)__builtin_amdgcn_s_getreg((3 << 11) | 20) & 0xFu; }
#define XB_SPIN(cond, bar) do { unsigned _sp = 0; while (cond) { __builtin_amdgcn_s_sleep(1); \
    if ((++_sp & 255u) == 0u) { if (xb_ld(&(bar)[XB_TMO])) break; if (_sp > XB_SPIN_CAP) { atomicAdd(&(bar)[XB_TMO], 1u); break; } } } } while (0)
__device__ __forceinline__ void xcd_barrier_complete(unsigned* bar, unsigned x, unsigned& nloc, unsigned& nx) {
    const unsigned G = gridDim.x;
    unsigned sum, cnt, mine, sp = 0u;
    for (;;) {
        sum = 0u; cnt = 0u; mine = 0u;
#pragma unroll
        for (unsigned j = 0; j < 16; ++j) { const unsigned cc = xb_ld(&bar[XB_XCNT(j)]); sum += cc; cnt += (cc > 0u) ? 1u : 0u; mine = (j == x) ? cc : mine; }
        if (sum == G) break;
        __builtin_amdgcn_s_sleep(1);
        if ((++sp & 255u) == 0u) { if (xb_ld(&bar[XB_TMO])) break; if (sp > XB_SPIN_CAP) { atomicAdd(&bar[XB_TMO], 1u); break; } }
    }
    nloc = mine > 0u ? mine : 1u; nx = cnt > 0u ? cnt : 1u;
}
__device__ __forceinline__ void xcd_barrier(unsigned* bar) {
    asm volatile("s_waitcnt vmcnt(0)" ::: "memory");
    __syncthreads();
    const int btid = phase_tid();
    if (btid == 0) {
        volatile __attribute__((address_space(3))) unsigned* st = (volatile __attribute__((address_space(3))) unsigned*)(__attribute__((address_space(3))) unsigned char*)(lds_raw + LDS_XBST);
        const unsigned x = xb_xcc_id();
        __builtin_amdgcn_s_waitcnt(0);
        unsigned nloc = st[0], nx = st[1];
        if (nloc == 0u) { xcd_barrier_complete(bar, x, nloc, nx); st[0] = nloc; st[1] = nx; }
        const unsigned old = xb_add(&bar[XB_XSUB(x)], 1u);
        const unsigned gen = old / nloc;
        if (old + 1u == (gen + 1u) * nloc) {
            __builtin_amdgcn_fence(__ATOMIC_RELEASE, "agent");
            asm volatile("s_waitcnt vmcnt(0)" ::: "memory");
            const unsigned og = xb_add(&bar[XB_TOP], 1u);
            const unsigned tg = og / nx;
            if (og + 1u == (tg + 1u) * nx) xb_add(&bar[XB_TOPGEN], 1u);
            else XB_SPIN(xb_ld(&bar[XB_TOPGEN]) == tg, bar);
            __builtin_amdgcn_fence(__ATOMIC_ACQUIRE, "agent");
            xb_add(&bar[XB_XGEN(x)], 1u);
            asm volatile("s_waitcnt vmcnt(0)" ::: "memory");
        } else {
            XB_SPIN(xb_ld(&bar[XB_XGEN(x)]) == gen, bar);
            __builtin_amdgcn_fence(__ATOMIC_ACQUIRE, "agent");
            asm volatile("s_waitcnt vmcnt(0)" ::: "memory");
        }
    }
    __syncthreads();
}

__device__ __forceinline__ float bf2f(bf16_t v) { return __uint_as_float(((unsigned)v) << 16); }
typedef float hw_f32x2 __attribute__((ext_vector_type(2))); typedef __bf16 hw_bf16x2 __attribute__((ext_vector_type(2)));
__device__ __forceinline__ unsigned pk2(float lo, float hi) { const hw_f32x2 v = {lo, hi}; const hw_bf16x2 b = __builtin_convertvector(v, hw_bf16x2); return __builtin_bit_cast(unsigned, b); }
__device__ __forceinline__ unsigned cvt4_fp8(float a, float b, float c2, float d) { int w = __builtin_amdgcn_cvt_pk_fp8_f32(a, b, 0, false); w = __builtin_amdgcn_cvt_pk_fp8_f32(c2, d, w, true); return (unsigned)w; }
__device__ __forceinline__ long mk64(unsigned lo, unsigned hi) { return (long)(((unsigned long)hi << 32) | (unsigned long)lo); }
__device__ __forceinline__ bf16_t f2bf(float f) { return (bf16_t)(pk2(f, f) & 0xffffu); }
__device__ __forceinline__ float wave_sum(float v) {
  int x = __float_as_int(v);
  x = __float_as_int(__int_as_float(x) + __int_as_float(__builtin_amdgcn_update_dpp(0, x, 0x111, 0xF, 0xF, true)));
  x = __float_as_int(__int_as_float(x) + __int_as_float(__builtin_amdgcn_update_dpp(0, x, 0x112, 0xF, 0xF, true)));
  x = __float_as_int(__int_as_float(x) + __int_as_float(__builtin_amdgcn_update_dpp(0, x, 0x114, 0xF, 0xF, true)));
  x = __float_as_int(__int_as_float(x) + __int_as_float(__builtin_amdgcn_update_dpp(0, x, 0x118, 0xF, 0xF, true)));
  x = __float_as_int(__int_as_float(x) + __int_as_float(__builtin_amdgcn_update_dpp(0, x, 0x142, 0xA, 0xF, false)));
  x = __float_as_int(__int_as_float(x) + __int_as_float(__builtin_amdgcn_update_dpp(0, x, 0x143, 0xC, 0xF, false)));
  return __int_as_float(__builtin_amdgcn_readlane(x, 63));
}
__device__ __forceinline__ float wave_max(float v) {
#pragma unroll
  for (int o = 32; o >= 1; o >>= 1) v = fmaxf(v, __shfl_xor(v, o));
  return v;
}
__device__ __forceinline__ float silu_f(float v) { return v * __builtin_amdgcn_rcpf(1.f + __expf(-v)); }

__device__ __forceinline__ int ropeperm(int p) { return (p >> 1) + 32 * (p & 1); }
__device__ __forceinline__ int colmap_in(int cp) {
  const int tile = cp >> 8, w = cp & 255;
  if (tile == 0) return (w >> 6) * 64 + ropeperm(w & 63);
  if (tile == 1) { if (w < 128) { const int c = 256 + w; return (c >> 6) * 64 + ropeperm(c & 63); } return 384 + (w - 128); }
  if (tile == 2) return 512 + (w >> 6) * 64 + ropeperm(w & 63);
  if (tile == 3) { if (w < 64) return 768 + ropeperm(w); if (w < 68) return 832 + (w - 64); if (w < 74) return 2372 + (w - 68); if (w < 80) return 2378 + (w - 74); return -1; }
  if (tile == 4) return 2384 + w;
  return 836 + (cp - 1280);
}

struct WorkQ { unsigned* head; volatile int* slot; int nxt; };
__device__ __forceinline__ void wq_init(WorkQ& q, unsigned* head, volatile int* slot, int tid) { q.head = head; q.slot = slot; q.nxt = 0; if (tid == 0) q.nxt = (int)atomicAdd(head, 1u); }
__device__ __forceinline__ int wq_next(WorkQ& q, int tid) {
  __syncthreads();
  if (tid == 0) { *q.slot = q.nxt; q.nxt = (int)atomicAdd(q.head, 1u); }
  __syncthreads();
  return *q.slot;
}

template <bool F8 = false, class CM>
__device__ __forceinline__ void tp_tile(const float* src, int ld, bf16_t* dst, int drow0, int K, int k0, CM cm, float* lds, int tid, float sc8 = 1.f) {
  const int a = tid & 63, b = tid >> 6;
  const int sc = cm(a);
  __syncthreads();
#pragma unroll
  for (int i = 0; i < 8; ++i) { const int kk = b * 8 + i; lds[kk * 65 + a] = sc >= 0 ? src[(size_t)(k0 + kk) * ld + sc] : 0.f; }
  __syncthreads();
  { const int nn = tid >> 3, kc = (tid & 7) * 8;
    const float* p = lds + kc * 65 + nn;
    if constexpr (F8) *(u32x2*)((unsigned char*)dst + (size_t)(drow0 + nn) * K + k0 + kc) = (u32x2){cvt4_fp8(p[0] * sc8, p[65] * sc8, p[130] * sc8, p[195] * sc8), cvt4_fp8(p[260] * sc8, p[325] * sc8, p[390] * sc8, p[455] * sc8)};
    else *(u32x4*)(dst + (size_t)(drow0 + nn) * K + k0 + kc) = (u32x4){pk2(p[0], p[65]), pk2(p[130], p[195]), pk2(p[260], p[325]), pk2(p[390], p[455])}; }
}

constexpr int TP_TOTAL = (NIN / 64) * 16 + 16 * 16 + 8 * 16 + 64 * 8 * 16 + 64 * 16 * 4;
constexpr int TP_WD0 = TP_TOTAL - 64 * 16 * 4;
constexpr int TP_D1 = 5200;
__device__ __forceinline__ void prologue_tiles(const Ctx& c, float* lds, int tid, int lo, int hi, int b0, int nb) {
  unsigned char* ws = c.ws;
  const int n_win = (NIN / 64) * 16, n_wo = 16 * 16, n_wmkv = 8 * 16, n_wgu = 64 * 8 * 16, n_wd = 64 * 16 * 4;
  const int total = n_win + n_wo + n_wmkv + n_wgu + n_wd;
  for (int it = lo + b0; it < hi; it += nb) {
    int r = it;
    if (r < n_win) { const int nt = r / 16, kt = r % 16; tp_tile(c.in[2], 2640, (bf16_t*)(ws + WS_WIN), nt * 64, 1024, kt * 64, [&](int a) { return colmap_in(nt * 64 + a); }, lds, tid); continue; } r -= n_win;
    if (r < n_wo) { const int nt = r / 16, kt = r % 16; tp_tile<true>(c.in[13], 1024, (bf16_t*)(ws + WS_WO), nt * 64, 1024, kt * 64, [&](int a) { return nt * 64 + a; }, lds, tid, W8SCALE); continue; } r -= n_wo;
    if (r < n_wmkv) { const int nt = r / 16, kt = r % 16; tp_tile(c.in[12], 512, (bf16_t*)(ws + WS_WMKV), nt * 64, 1024, kt * 64, [&](int a) { return nt * 64 + a; }, lds, tid); continue; } r -= n_wmkv;
    if (r < n_wgu) { const int e = r / 128, q = r % 128, nt = q / 16, kt = q % 16;
      const int pn = nt >> 2, sub = nt & 3, isup = sub >> 1, c0 = pn * 128 + (sub & 1) * 64;
      const float* src = (isup ? c.in[21] : c.in[20]) + (size_t)e * 1024 * 256;
      tp_tile<true>(src, 256, (bf16_t*)(ws + WS_WGU), e * 512 + nt * 64, 1024, kt * 64, [&](int a) { return c0 + a; }, lds, tid, W8SCALE); continue; } r -= n_wgu;
    { const int e = r / 64, q = r % 64, nt = q / 4, kt = q % 4;
      tp_tile<true>(c.in[22] + (size_t)e * 256 * 1024, 1024, (bf16_t*)(ws + WS_WD), e * 1024 + nt * 64, 256, kt * 64, [&](int a) { return nt * 64 + a; }, lds, tid, W8SCALE); }
  }
}

__device__ void phase_tiles_queue(const Ctx& c, float* lds, unsigned* qhead, int lo, int hi) {
  const int tid = phase_tid();
  volatile int* slot = (volatile int*)(lds + 64 * 65 + 16);
  WorkQ wq; wq_init(wq, qhead, slot, tid);
  const int nitems = (hi - lo + 7) >> 3;
  for (;;) {
    const int item = wq_next(wq, tid);
    if (item >= nitems) break;
    const int t0 = lo + item * 8, t1 = t0 + 8 < hi ? t0 + 8 : hi;
    prologue_tiles(c, lds, tid, t0, t1, 0, 1);
  }
}

__device__ void phase_prologue(const Ctx& c, float* lds) {
  const int tid = phase_tid(), bid = blockIdx.x, G = gridDim.x;
  unsigned char* ws = c.ws;
  const size_t gtid = (size_t)bid * NTHREADS + tid, gstride = (size_t)G * NTHREADS;
  { const f32x4* x4 = (const f32x4*)c.in[0]; u32x2* o = (u32x2*)c.out;
    for (size_t i = gtid; i < (size_t)T * DM / 4; i += gstride) { const f32x4 v = x4[i]; o[i] = (u32x2){pk2(v.x, v.y), pk2(v.z, v.w)}; }
    const f32x4* m4 = (const f32x4*)c.in[1]; u32x2* om = (u32x2*)(ws + WS_MEMB);
    for (size_t i = gtid; i < (size_t)TM * DM / 4; i += gstride) { const f32x4 v = m4[i]; om[i] = (u32x2){pk2(v.x, v.y), pk2(v.z, v.w)}; } }
  { float* cs = (float*)(ws + WS_ROPE); float* sn = cs + SEQ * 32;
    for (size_t i = gtid; i < (size_t)SEQ * 32; i += gstride) { const int s = (int)(i >> 5), d = (int)(i & 31);
      const float inv = 1.0f / powf(10000.0f, (float)d / 32.0f); const float ang = (float)s * inv; float sv, cv; sincosf(ang, &sv, &cv); cs[i] = cv; sn[i] = sv; } }
  { bf16_t* wkv = (bf16_t*)(ws + WS_WKV); const float* g = c.in[3]; const float* wk = c.in[4]; const float* wv = c.in[5];
    for (size_t i = gtid; i < 128 * 128; i += gstride) { const int p = (int)(i >> 7), k = (int)(i & 127);
      const float w = p < 64 ? wk[k * 64 + ropeperm(p)] : wv[k * 64 + (p - 64)]; wkv[i] = f2bf(w * g[k]); }
    bf16_t* wr = (bf16_t*)(ws + WS_WR); const float* wg = c.in[16]; const float* wrt = c.in[18];
    for (size_t i = gtid; i < 80 * 1024; i += gstride) { const int o = (int)(i >> 10), k = (int)(i & 1023); wr[i] = f2bf(o < 8 ? wg[k * 8 + o] : o < 72 ? wrt[k * 64 + (o - 8)] : 0.f); } }
  prologue_tiles(c, lds, tid, 0, TP_WD0 - TP_D1, bid, G);
}

__device__ __forceinline__ void expert_offsets(const Ctx& c, int* offs  , int* cnts  , int tid) {
  const unsigned* ctl = (const unsigned*)(c.ws + WS_CTL);
  __syncthreads();
  if (tid == 0) { int o = 0; for (int e = 0; e < 64; ++e) { const int n = (int)ctl[CW_CNT + e]; cnts[e] = n; offs[e] = o; o += (n + 255) & ~255; } offs[64] = o; }
  __syncthreads();
}


namespace pg8 {
#define PG8_LAS __attribute__((address_space(3)))
typedef short bf16x8 __attribute__((ext_vector_type(8)));
constexpr int BM = 256, BK = 64, HALF = 128, HTB = HALF * BK * 2, STAGE_BYTES = 8 * HTB, NXCD = 8, WGM = 8, GN_STASH = STAGE_BYTES + 2048;
typedef unsigned u32x4s __attribute__((ext_vector_type(4)));
__host__ __device__ __forceinline__ int lds_byte(int r, int c) { const int st = (r >> 4) * 2 + (c >> 5), rr = r & 15, cc = c & 31, ob = rr * 64 + cc * 2; return st * 1024 + (ob ^ (((ob >> 9) & 1) << 5)); }
__host__ __device__ __forceinline__ void stage_rc(int b, int& R, int& C) { const int st = b / 1024, sb = b % 1024, swz = sb ^ (((sb >> 9) & 1) << 5); R = (st >> 1) * 16 + swz / 64; C = (st & 1) * 32 + (swz % 64) / 2; }
__host__ __device__ __forceinline__ int perm32(int rho) { const int n = rho >> 4, i = rho & 15; return 8 * (i >> 2) + 4 * n + (i & 3); }
typedef int i32x4v __attribute__((ext_vector_type(4))); typedef int i32x8 __attribute__((ext_vector_type(8))); typedef long i64x2 __attribute__((ext_vector_type(2)));
struct Unit { int pm, pn, e, mt, aux; };
struct Gemm { const bf16_t* A; const bf16_t* Bt; int K; };
struct StaticOrder {
    int nM, nN, nwg, G, c;
    __device__ void init(int M, int N, int G_, int c_) { nM = M / BM; nN = N / BM; nwg = nM * nN; G = G_; c = c_; }
    __device__ bool next(int i, Unit& u) const {
        const long L = (long)i * G + c; if (c < 0 || L >= nwg) return false;
        int wgid = (int)L; { const int q = nwg / NXCD, r = nwg % NXCD, xcd = wgid % NXCD, off = wgid / NXCD; wgid = (xcd < r ? xcd * (q + 1) : r * (q + 1) + (xcd - r) * q) + off; }
        const int nig = WGM * nN, gid = wgid / nig, fm = gid * WGM, gsz = (nM - fm) < WGM ? (nM - fm) : WGM;
        u.pm = fm + ((wgid % nig) % gsz); u.pn = (wgid % nig) / gsz; u.e = 0; u.mt = 0; u.aux = 0; return true;
    }
    __device__ __forceinline__ unsigned arow(const Unit&, int) const { return 0u; }
};
__device__ __forceinline__ unsigned cvt_pk_bf16(float lo, float hi) { unsigned r; asm volatile("v_cvt_pk_bf16_f32 %0, %1, %2" : "=v"(r) : "v"(lo), "v"(hi)); return r; }

template <class Epi, class Sched, bool ALIGN_EPI, bool GATHER, int FP8 = 0, bool BUF = false>
__device__ __forceinline__ void gemm_phase(PG8_LAS unsigned char* lds, const Gemm g, const Sched& S, const Epi& E, const int tid) {
    const int wid = __builtin_amdgcn_readfirstlane(tid >> 6), lane = tid & 63, wr = wid >> 2, wc = wid & 3, fr = lane & 15, fq = lane >> 4;
    const int K = g.K, nt = K / BK;
    unsigned voffA[2], voffB[2]; int RA[2], CA[2];
#pragma unroll
    for (int i = 0; i < 2; ++i) { int R, C; stage_rc(tid * 16 + i * 8192, R, C); const int Rb = Epi::PERM ? ((R & ~31) + perm32(R & 31)) : R;
        RA[i] = R; CA[i] = C; voffA[i] = (unsigned)(R * K + C) * 2u; voffB[i] = (unsigned)(Rb * K + C) * 2u; }
    const size_t kstep = (size_t)(BK * 2);
    const size_t hstep = (size_t)HALF * K * 2;
    const size_t tstep = 2 * hstep;
    const unsigned ldsw = (unsigned)wid * 1024u;
    const int aoff = lds_byte(wr * 64 + fr, fq * 8), boff = lds_byte(wc * 32 + fr, fq * 8);
#define PG8_FRESH_TID() ([&]() { int l_; asm volatile("v_mbcnt_lo_u32_b32 %0, -1, 0\n\tv_mbcnt_hi_u32_b32 %0, -1, %0" : "=v"(l_)); return wid * 64 + l_; }())
#define PG8_SA(b, h) (((b) * 2 + (h)) * HTB)
#define PG8_SB(b, h) ((4 + (b) * 2 + (h)) * HTB)
    const __amdgpu_buffer_rsrc_t rsA = __builtin_amdgcn_make_buffer_rsrc((void*)g.A, 0, -1, 0x00020000), rsB = __builtin_amdgcn_make_buffer_rsrc((void*)g.Bt, 0, -1, 0x00020000);
#define PG8_STAGE_X(rs, base0, bufoff, gbase, voff) do { _Pragma("unroll") for (int _i = 0; _i < 2; ++_i) { \
        if constexpr (BUF) __builtin_amdgcn_raw_ptr_buffer_load_lds(rs, (PG8_LAS void*)(lds + (bufoff) + ldsw + _i * 8192), 16, (int)(voff)[_i], (int)(unsigned)((const char*)(gbase) - (const char*)(base0)), 0, 0); \
        else __builtin_amdgcn_global_load_lds((const unsigned*)((const char*)(gbase) + (voff)[_i]), (PG8_LAS unsigned*)(lds + (bufoff) + ldsw + _i * 8192), 16, 0, 0); } } while (0)
#define PG8_STAGE(bufoff, gbase, voff) PG8_STAGE_X(rsB, g.Bt, bufoff, gbase, voff)
#define PG8_STAGE_A(bufoff, gbase, h, goff) do { if constexpr (GATHER) { PG8_STAGE_X(rsA, g.A, bufoff, gbase, (goff)[h]); } else { PG8_STAGE_X(rsA, g.A, bufoff, (gbase) + (h) * hstep, voffA); } } while (0)
#define PG8_LDA(dst, b, h) do { _Pragma("unroll") for (int m = 0; m < 4; ++m) _Pragma("unroll") for (int k = 0; k < 2; ++k) dst[m][k] = *(const PG8_LAS bf16x8*)(lds + PG8_SA(b, h) + aoff + m * 2048 + k * 1024); } while (0)
#define PG8_LDB(dst, b, h) do { _Pragma("unroll") for (int n = 0; n < 2; ++n) _Pragma("unroll") for (int k = 0; k < 2; ++k) dst[n][k] = *(const PG8_LAS bf16x8*)(lds + PG8_SB(b, h) + boff + n * 2048 + k * 1024); } while (0)
#define PG8_MMA(ai, bj, At, Bt) do { __builtin_amdgcn_s_setprio(1); \
        if constexpr (FP8 == 2) { _Pragma("unroll") for (int m = 0; m < 4; ++m) _Pragma("unroll") for (int n = 0; n < 2; ++n) { \
            const i32x8 b_ = __builtin_shufflevector(__builtin_bit_cast(i32x4v, Bt[n][0]), __builtin_bit_cast(i32x4v, Bt[n][1]), 0, 1, 2, 3, 4, 5, 6, 7), a_ = __builtin_shufflevector(__builtin_bit_cast(i32x4v, At[m][0]), __builtin_bit_cast(i32x4v, At[m][1]), 0, 1, 2, 3, 4, 5, 6, 7); \
            acc[ai][bj][m][n] = __builtin_amdgcn_mfma_scale_f32_16x16x128_f8f6f4(b_, a_, acc[ai][bj][m][n], 0, 0, 0, 0, 0, 0); } } \
        else if constexpr (FP8 == 1) { _Pragma("unroll") for (int k = 0; k < 2; ++k) _Pragma("unroll") for (int hf = 0; hf < 2; ++hf) _Pragma("unroll") for (int m = 0; m < 4; ++m) _Pragma("unroll") for (int n = 0; n < 2; ++n) { \
            const i64x2 b_ = __builtin_bit_cast(i64x2, Bt[n][k]), a_ = __builtin_bit_cast(i64x2, At[m][k]); \
            acc[ai][bj][m][n] = __builtin_amdgcn_mfma_f32_16x16x32_fp8_fp8(b_[hf], a_[hf], acc[ai][bj][m][n], 0, 0, 0); } } \
        else { _Pragma("unroll") for (int m = 0; m < 4; ++m) _Pragma("unroll") for (int n = 0; n < 2; ++n) _Pragma("unroll") for (int k = 0; k < 2; ++k) \
            acc[ai][bj][m][n] = __builtin_amdgcn_mfma_f32_16x16x32_bf16(Bt[n][k], At[m][k], acc[ai][bj][m][n], 0, 0, 0); } \
        __builtin_amdgcn_s_setprio(0); } while (0)
#define PG8_WAIT_V(n) asm volatile("s_waitcnt vmcnt(" #n ")" ::: "memory")
#define PG8_WAIT_L(n) asm volatile("s_waitcnt lgkmcnt(" #n ")" ::: "memory")
#define PG8_BAR __builtin_amdgcn_s_barrier()
#define PG8_SCHED __builtin_amdgcn_sched_barrier(0)
    Unit cur, nxt; int ui = 0;
    if (!S.next(0, cur)) return;
    f32x4 acc[2][2][4][2];
#pragma unroll
    for (int a = 0; a < 2; ++a)
#pragma unroll
        for (int b = 0; b < 2; ++b)
#pragma unroll
            for (int m = 0; m < 4; ++m)
#pragma unroll
                for (int n = 0; n < 2; ++n) acc[a][b][m][n] = (f32x4){0.f, 0.f, 0.f, 0.f};
    bf16x8 At[4][2], B0[2][2], B1[2][2];
    unsigned gc[2][2], gn[2][2];
    const char* cA; const char* cB = (const char*)g.Bt + (size_t)cur.pn * tstep;
    if constexpr (GATHER) { cA = (const char*)g.A;
#pragma unroll
        for (int h = 0; h < 2; ++h)
#pragma unroll
            for (int i = 0; i < 2; ++i) { gc[h][i] = (S.arow(cur, h * HALF + RA[i]) * (unsigned)K + (unsigned)CA[i]) * 2u; gn[h][i] = gc[h][i]; }
    } else { cA = (const char*)g.A + (size_t)cur.pm * tstep; }
    PG8_STAGE(PG8_SB(0, 0), cB, voffB); PG8_STAGE(PG8_SB(0, 1), cB + hstep, voffB); PG8_STAGE_A(PG8_SA(0, 0), cA, 0, gc); PG8_STAGE_A(PG8_SA(0, 1), cA, 1, gc);
    if (wr == 1) PG8_BAR;
    PG8_WAIT_V(2); PG8_BAR;
    PG8_STAGE(PG8_SB(1, 0), cB + kstep, voffB); PG8_STAGE_A(PG8_SA(1, 0), cA + kstep, 0, gc); PG8_STAGE(PG8_SB(1, 1), cB + hstep + kstep, voffB);
    PG8_WAIT_V(6); PG8_BAR;
    for (;;) {
        const bool has_next = S.next(ui + 1, nxt);
        const char* nA; const char* nB = has_next ? (const char*)g.Bt + (size_t)nxt.pn * tstep : cB;
        if constexpr (GATHER) { nA = cA;
            if (has_next) {
#pragma unroll
                for (int h = 0; h < 2; ++h)
#pragma unroll
                    for (int i = 0; i < 2; ++i) { int R_ = RA[i], C_ = CA[i]; if constexpr (BUF) { const int t2 = PG8_FRESH_TID(); stage_rc(t2 * 16 + i * 8192, R_, C_); }
                        gn[h][i] = (S.arow(nxt, h * HALF + R_) * (unsigned)K + (unsigned)C_) * 2u; }
                if constexpr (BUF) { *(PG8_LAS u32x4s*)(lds + GN_STASH + PG8_FRESH_TID() * 16) = (u32x4s){gn[0][0], gn[0][1], gn[1][0], gn[1][1]}; } }
        } else { nA = has_next ? (const char*)g.A + (size_t)nxt.pm * tstep : cA; }
        unsigned g2[2][2];
#pragma unroll 1
        for (int t = 0; t < nt; t += 2) {
            const bool last = (t == nt - 2);
            const char* a1 = cA + (size_t)(t + 1) * kstep;
            const char* a2 = last ? nA : cA + (size_t)(t + 2) * kstep; const char* b2 = last ? nB : cB + (size_t)(t + 2) * kstep;
            const char* a3 = a2 + kstep; const char* b3 = b2 + kstep;
            if constexpr (GATHER) {
              if constexpr (BUF) {
                if (last && has_next) { const u32x4s v_ = *(const PG8_LAS u32x4s*)(lds + GN_STASH + PG8_FRESH_TID() * 16); g2[0][0] = v_.x; g2[0][1] = v_.y; g2[1][0] = v_.z; g2[1][1] = v_.w; }
                else { g2[0][0] = gc[0][0]; g2[0][1] = gc[0][1]; g2[1][0] = gc[1][0]; g2[1][1] = gc[1][1]; }
              } else {
#pragma unroll
            for (int h = 0; h < 2; ++h)
#pragma unroll
                for (int i = 0; i < 2; ++i) g2[h][i] = last ? gn[h][i] : gc[h][i]; } }
            PG8_LDB(B0, 0, 0); PG8_LDB(B1, 0, 1); PG8_SCHED; PG8_LDA(At, 0, 0); PG8_STAGE_A(PG8_SA(1, 1), a1, 1, gc);
            PG8_WAIT_V(8); PG8_WAIT_L(0); PG8_BAR; PG8_MMA(0, 0, At, B0); PG8_MMA(0, 1, At, B1); PG8_BAR; PG8_SCHED;
            PG8_LDA(At, 0, 1); PG8_STAGE(PG8_SB(0, 0), b2, voffB); PG8_STAGE(PG8_SB(0, 1), b2 + hstep, voffB); PG8_STAGE_A(PG8_SA(0, 0), a2, 0, g2);
            PG8_WAIT_V(8); PG8_WAIT_L(0); PG8_BAR; PG8_MMA(1, 0, At, B0); PG8_MMA(1, 1, At, B1); PG8_BAR; PG8_SCHED;
            PG8_LDB(B0, 1, 0); PG8_LDB(B1, 1, 1); PG8_SCHED; PG8_LDA(At, 1, 0); PG8_STAGE_A(PG8_SA(0, 1), a2, 1, g2);
            PG8_WAIT_V(8); PG8_WAIT_L(0); PG8_BAR; PG8_MMA(0, 0, At, B0); PG8_MMA(0, 1, At, B1); PG8_BAR; PG8_SCHED;
            PG8_LDA(At, 1, 1); PG8_STAGE(PG8_SB(1, 0), b3, voffB); PG8_STAGE(PG8_SB(1, 1), b3 + hstep, voffB); PG8_STAGE_A(PG8_SA(1, 0), a3, 0, g2);
            PG8_WAIT_V(8); PG8_WAIT_L(0); PG8_BAR; PG8_MMA(1, 0, At, B0); PG8_MMA(1, 1, At, B1); PG8_BAR; PG8_SCHED;
        }
        if constexpr (ALIGN_EPI) { if (wr == 0) PG8_BAR; }
        if constexpr (BUF) { const int l2 = PG8_FRESH_TID(); E(acc, cur, wr, wc, l2 & 15, (l2 >> 4) & 3); }
        else E(acc, cur, wr, wc, fr, fq);
        if (!has_next) break;
#pragma unroll
        for (int a = 0; a < 2; ++a)
#pragma unroll
            for (int b = 0; b < 2; ++b)
#pragma unroll
                for (int m = 0; m < 4; ++m)
#pragma unroll
                    for (int n = 0; n < 2; ++n) acc[a][b][m][n] = (f32x4){0.f, 0.f, 0.f, 0.f};
        cur = nxt; cA = nA; cB = nB; ++ui;
        if constexpr (GATHER) {
#pragma unroll
        for (int h = 0; h < 2; ++h)
#pragma unroll
            for (int i = 0; i < 2; ++i) gc[h][i] = BUF ? g2[h][i] : gn[h][i]; }
        if constexpr (ALIGN_EPI) { if (wr == 1) PG8_BAR; }
    }
    PG8_WAIT_V(0);
    if constexpr (!ALIGN_EPI) { if (wr == 0) PG8_BAR; }
    PG8_BAR;
#undef PG8_SA
#undef PG8_FRESH_TID
#undef PG8_SB
#undef PG8_STAGE
#undef PG8_STAGE_X
#undef PG8_STAGE_A
#undef PG8_LDA
#undef PG8_LDB
#undef PG8_MMA
#undef PG8_WAIT_V
#undef PG8_WAIT_L
#undef PG8_BAR
#undef PG8_SCHED
}
}
typedef __attribute__((address_space(3))) unsigned char lds_u8;

__device__ __forceinline__ u32x4 pack8(const f32x4& a, const f32x4& b) { return (u32x4){pg8::cvt_pk_bf16(a.x, a.y), pg8::cvt_pk_bf16(a.z, a.w), pg8::cvt_pk_bf16(b.x, b.y), pg8::cvt_pk_bf16(b.z, b.w)}; }
struct EpiInM {
  static constexpr bool PERM = true;
  unsigned char* ws;
  __device__ __forceinline__ void operator()(const f32x4 (&acc)[2][2][4][2], const pg8::Unit& u, int wr, int wc, int fr, int fq) const {
    const float* cs = (const float*)(ws + WS_ROPE); const float* sn = cs + SEQ * 32;
    const int pn = u.pn;
#pragma unroll
    for (int ai = 0; ai < 2; ++ai)
#pragma unroll
      for (int m = 0; m < 4; ++m) {
        const int row = u.pm * 256 + ai * 128 + wr * 64 + m * 16 + fr, pos = row & (SEQ - 1);
#pragma unroll
        for (int bj = 0; bj < 2; ++bj) {
          const int w = bj * 128 + wc * 32 + 8 * fq;
          f32x4 v0 = acc[ai][bj][m][0], v1 = acc[ai][bj][m][1];
          const bool do_rope = (pn == 0) || (pn == 1 && bj == 0) || (pn == 2) || (pn == 3 && bj == 0 && wc < 2);
          if (do_rope) { const int d = (w & 63) >> 1; const f32x4 c4 = *(const f32x4*)(cs + pos * 32 + d), s4 = *(const f32x4*)(sn + pos * 32 + d);
            const f32x4 o0 = {v0.x * c4.x - v0.y * s4.x, v0.y * c4.x + v0.x * s4.x, v0.z * c4.y - v0.w * s4.y, v0.w * c4.y + v0.z * s4.y};
            const f32x4 o1 = {v1.x * c4.z - v1.y * s4.z, v1.y * c4.z + v1.x * s4.z, v1.z * c4.w - v1.w * s4.w, v1.w * c4.w + v1.z * s4.w};
            v0 = o0; v1 = o1; }
          if (pn == 0) { *(u32x4*)((bf16_t*)(ws + WS_QA) + (size_t)row * 384 + w) = pack8(v0 * QSCALE, v1 * QSCALE); }
          else if (pn == 1) { if (bj == 0) *(u32x4*)((bf16_t*)(ws + WS_QA) + (size_t)row * 384 + 256 + w) = pack8(v0 * QSCALE, v1 * QSCALE);
                              else *(u32x4*)((bf16_t*)(ws + WS_CKV) + (size_t)row * 128 + (w - 128)) = pack8(v0, v1); }
          else if (pn == 2) { *(u32x4*)((bf16_t*)(ws + WS_IQ) + (size_t)row * 256 + w) = pack8(v0, v1); }
          else if (pn == 3) { if (bj == 0) { if (wc < 2) *(u32x4*)((bf16_t*)(ws + WS_IK) + (size_t)row * 64 + w) = pack8(v0, v1);
                                             else if (wc == 2 && fq < 2) { if (fq == 0) v0 = v0 * 0.0625f; float* o = (float*)(ws + WS_SM) + (size_t)row * 16 + 8 * fq; *(f32x4*)o = v0; *(f32x4*)(o + 4) = v1; } } }
          else if (pn == 4) { *(u32x4*)((bf16_t*)(ws + WS_QC) + (size_t)row * 256 + w) = pack8(v0 * QSCALE, v1 * QSCALE); }
          else { *(u32x4*)((bf16_t*)(ws + WS_GB) + (size_t)row * 1536 + (pn - 5) * 256 + w) = pack8(v0, v1); }
        }
      }
  }
};
__device__ __forceinline__ unsigned pk4_fp8(const f32x4& v) { unsigned w = __builtin_amdgcn_cvt_pk_fp8_f32(v.x, v.y, 0u, false); return __builtin_amdgcn_cvt_pk_fp8_f32(v.z, v.w, w, true); }
struct EpiMemKVM {
  static constexpr bool PERM = true;
  unsigned char* ws;
  __device__ __forceinline__ void operator()(const f32x4 (&acc)[2][2][4][2], const pg8::Unit& u, int wr, int wc, int fr, int fq) const {
#pragma unroll
    for (int ai = 0; ai < 2; ++ai)
#pragma unroll
      for (int m = 0; m < 4; ++m) {
        const int row = u.pm * 256 + ai * 128 + wr * 64 + m * 16 + fr;
#pragma unroll
        for (int bj = 0; bj < 2; ++bj) {
          const int w = bj * 128 + wc * 32 + 8 * fq; const f32x4 v0 = acc[ai][bj][m][0], v1 = acc[ai][bj][m][1];
          const unsigned w0 = pk4_fp8(v0), w1 = pk4_fp8(v1);
          if (u.pn == 0) *(u32x2*)(ws + WS_MK + (size_t)row * 256 + w) = (u32x2){w0, w1};
          else { const int mem = row & 255, xx = mem & 31, mpos = (mem & ~31) + 8 * ((xx >> 2) & 3) + (xx & 3) + 4 * (xx >> 4);
            unsigned char* o = ws + WS_MVT + ((size_t)(row >> 8) * 256 + w) * 256 + mpos;
            o[0] = (unsigned char)w0; o[256] = (unsigned char)(w0 >> 8); o[512] = (unsigned char)(w0 >> 16); o[768] = (unsigned char)(w0 >> 24); o[1024] = (unsigned char)w1; o[1280] = (unsigned char)(w1 >> 8); o[1536] = (unsigned char)(w1 >> 16); o[1792] = (unsigned char)(w1 >> 24); }
        }
      }
  }
};
struct EpiOutM {
  static constexpr bool PERM = true;
  const bf16_t* x; bf16_t* y;
  __device__ __forceinline__ void operator()(const f32x4 (&acc)[2][2][4][2], const pg8::Unit& u, int wr, int wc, int fr, int fq) const {
#pragma unroll
    for (int ai = 0; ai < 2; ++ai)
#pragma unroll
      for (int m = 0; m < 4; ++m) {
        const size_t rb = (size_t)(u.pm * 256 + ai * 128 + wr * 64 + m * 16 + fr) * 1024 + u.pn * 256 + wc * 32 + 8 * fq;
#pragma unroll
        for (int bj = 0; bj < 2; ++bj) { const size_t o = rb + bj * 128; const u32x4 xv = *(const u32x4*)(x + o);
          const f32x4 x0 = {__uint_as_float(xv.x << 16), __uint_as_float(xv.x & 0xffff0000u), __uint_as_float(xv.y << 16), __uint_as_float(xv.y & 0xffff0000u)};
          const f32x4 x1 = {__uint_as_float(xv.z << 16), __uint_as_float(xv.z & 0xffff0000u), __uint_as_float(xv.w << 16), __uint_as_float(xv.w & 0xffff0000u)};
          *(u32x4*)(y + o) = pack8(x0 * ALPHA + acc[ai][bj][m][0] * (1.f / W8SCALE), x1 * ALPHA + acc[ai][bj][m][1] * (1.f / W8SCALE)); }
      }
  }
};
struct MoeOrder {
  const int* offs; const int* cnts; int npn, G, c; const unsigned* LIST;
  __device__ __forceinline__ bool next(int i, pg8::Unit& u) const {
    const int* offs = this->offs; asm volatile("" : "+s"(offs));
    const int L = i * G + c; const int ntiles = __builtin_amdgcn_readfirstlane(offs[64]) >> 8;
    if (L >= ntiles * npn) return false;
    const int rt = L / npn, pl = L - rt * npn; int e = 0;
    while (__builtin_amdgcn_readfirstlane(offs[e + 1]) <= rt * 256) ++e;
    u.pm = rt; u.mt = rt - (__builtin_amdgcn_readfirstlane(offs[e]) >> 8); u.e = e; u.pn = e * npn + pl; u.aux = __builtin_amdgcn_readfirstlane(cnts[e]); return true;
  }
  __device__ __forceinline__ unsigned arow(const pg8::Unit& u, int r) const { const int rank = u.mt * 256 + r; return rank < u.aux ? LIST[(size_t)u.e * 32768 + rank] : 0u; }
};
struct EpiMoeUpM {
  static constexpr bool PERM = true;
  unsigned char* H;
  __device__ __forceinline__ void operator()(const f32x4 (&acc)[2][2][4][2], const pg8::Unit& u, int wr, int wc, int fr, int fq) const {
    const int pl = u.pn & 1;
    int fr_ = fr, fq_ = fq; asm volatile("" : "+v"(fr_), "+v"(fq_));
#pragma unroll
    for (int ai = 0; ai < 2; ++ai)
#pragma unroll
      for (int m = 0; m < 4; ++m) {
        const int rl = ai * 128 + wr * 64 + m * 16 + fr_;
        if (u.mt * 256 + rl < u.aux) {
          f32x4 h0, h1; const float is = 1.f / W8SCALE, us = H8SCALE / W8SCALE; const f32x4 g0 = acc[ai][0][m][0] * is, g1 = acc[ai][0][m][1] * is, u0 = acc[ai][1][m][0] * us, u1 = acc[ai][1][m][1] * us;
          h0.x = silu_f(g0.x) * u0.x; h0.y = silu_f(g0.y) * u0.y; h0.z = silu_f(g0.z) * u0.z; h0.w = silu_f(g0.w) * u0.w;
          h1.x = silu_f(g1.x) * u1.x; h1.y = silu_f(g1.y) * u1.y; h1.z = silu_f(g1.z) * u1.z; h1.w = silu_f(g1.w) * u1.w;
          *(u32x2*)(H + (size_t)(u.pm * 256 + rl) * 256 + pl * 128 + wc * 32 + 8 * fq_) = (u32x2){pk4_fp8(h0), pk4_fp8(h1)};
        }
      }
  }
};
struct EpiMoeDownM {
  static constexpr bool PERM = true;
  unsigned char* Y; const float* GATEL;
  __device__ __forceinline__ void operator()(const f32x4 (&acc)[2][2][4][2], const pg8::Unit& u, int wr, int wc, int fr, int fq) const {
    const int pl = u.pn & 3;
    int fr_ = fr, fq_ = fq; asm volatile("" : "+v"(fr_), "+v"(fq_));
    const float* gp = GATEL + (size_t)u.e * 32768; const int rk0 = u.mt * 256 + wr * 64 + fr_;
    unsigned char* yp = Y + (size_t)(u.pm * 256 + wr * 64 + fr_) * 1024 + pl * 256 + wc * 32 + 8 * fq_;
#pragma unroll
    for (int ai = 0; ai < 2; ++ai)
#pragma unroll
      for (int m = 0; m < 4; ++m) {
        const int rk = rk0 + ai * 128 + m * 16; const float gt = gp[rk < 32767 ? rk : 32767] * (64.0f / (W8SCALE * H8SCALE));
#pragma unroll
        for (int bj = 0; bj < 2; ++bj)
          *(u32x2*)(yp + (size_t)(ai * 128 + m * 16) * 1024 + bj * 128) = (u32x2){pk4_fp8(acc[ai][bj][m][0] * gt), pk4_fp8(acc[ai][bj][m][1] * gt)};
      }
  }
};

__device__ __forceinline__ void phase_inproj_mfma(const Ctx& c, lds_u8* lds) {
  unsigned char* ws = c.ws; const int tid = phase_tid();
  { pg8::Gemm g{(const bf16_t*)c.out, (const bf16_t*)(ws + WS_WIN), 1024}; pg8::StaticOrder S; S.init(T, NIN, gridDim.x, blockIdx.x); EpiInM E{ws};
    pg8::gemm_phase<EpiInM, pg8::StaticOrder, true, false>(lds, g, S, E, tid); }
  { pg8::Gemm g{(const bf16_t*)(ws + WS_MEMB), (const bf16_t*)(ws + WS_WMKV), 1024}; pg8::StaticOrder S; S.init(TM, 512, gridDim.x, (int)blockIdx.x - 128); EpiMemKVM E{ws};
    pg8::gemm_phase<EpiMemKVM, pg8::StaticOrder, true, false>(lds, g, S, E, tid); }
}
__device__ __forceinline__ void phase_outproj_mfma(const Ctx& c, lds_u8* lds) {
  unsigned char* ws = c.ws; const int tid = phase_tid();
  pg8::Gemm g{(const bf16_t*)(ws + WS_CAT), (const bf16_t*)(ws + WS_WO), 512}; pg8::StaticOrder S; S.init(T, 1024, gridDim.x, blockIdx.x); EpiOutM E{(const bf16_t*)c.out, (bf16_t*)(ws + WS_X1B)};
  pg8::gemm_phase<EpiOutM, pg8::StaticOrder, true, false, 2, true>(lds, g, S, E, tid);
}
__device__ __forceinline__ void phase_moe_up_mfma(const Ctx& c, lds_u8* lds) {
  unsigned char* ws = c.ws; const int tid = phase_tid();
  int* offs = (int*)((unsigned char*)lds + pg8::STAGE_BYTES); int* cnts = offs + 65;
  expert_offsets(c, offs, cnts, tid);
  pg8::Gemm g{(const bf16_t*)(ws + WS_X1F), (const bf16_t*)(ws + WS_WGU), 512};
  MoeOrder S{offs, cnts, 2, (int)gridDim.x, (int)blockIdx.x, (const unsigned*)(ws + WS_LIST)}; EpiMoeUpM E{ws + WS_H};
  pg8::gemm_phase<EpiMoeUpM, MoeOrder, true, true, 2, true>(lds, g, S, E, tid);
}
__device__ __forceinline__ void phase_moe_down_mfma(const Ctx& c, lds_u8* lds) {
  unsigned char* ws = c.ws; const int tid = phase_tid();
  int* offs = (int*)((unsigned char*)lds + pg8::STAGE_BYTES); int* cnts = offs + 65;
  expert_offsets(c, offs, cnts, tid);
  pg8::Gemm g{(const bf16_t*)(ws + WS_H), (const bf16_t*)(ws + WS_WD), 128};
  MoeOrder S{offs, cnts, 4, (int)gridDim.x, (int)blockIdx.x, nullptr}; EpiMoeDownM E{(unsigned char*)(ws + WS_Y), (const float*)(ws + WS_GATEL)};
  pg8::gemm_phase<EpiMoeDownM, MoeOrder, true, false, 2>(lds, g, S, E, tid);
}

__device__ void phase_kvup(const Ctx& c, float* lds) {
  unsigned char* ws = c.ws;
  const int tid = phase_tid(), lane = tid & 63, wave = tid >> 6, fr = lane & 15, fq = lane >> 4;
  const bf16_t* W = (const bf16_t*)(ws + WS_WKV);
  const bf16_t* CKV = (const bf16_t*)(ws + WS_CKV); bf16_t* KVA = (bf16_t*)(ws + WS_KVA);
  const float* cs = (const float*)(ws + WS_ROPE); const float* sn = cs + SEQ * 32;
  for (int tile = blockIdx.x * NWAVES + wave; tile < T / 16; tile += gridDim.x * NWAVES) {
    const int t = tile * 16 + fr, pos = t & (SEQ - 1);
    pg8::bf16x8 bx[4]; float ss = 0.f;
#pragma unroll
    for (int ks = 0; ks < 4; ++ks) { const u32x4 v = *(const u32x4*)(CKV + (size_t)t * 128 + ks * 32 + fq * 8); bx[ks] = __builtin_bit_cast(pg8::bf16x8, v);
      const float f[8] = {__uint_as_float(v.x << 16), __uint_as_float(v.x & 0xffff0000u), __uint_as_float(v.y << 16), __uint_as_float(v.y & 0xffff0000u), __uint_as_float(v.z << 16), __uint_as_float(v.z & 0xffff0000u), __uint_as_float(v.w << 16), __uint_as_float(v.w & 0xffff0000u)};
#pragma unroll
      for (int e = 0; e < 8; ++e) ss += f[e] * f[e]; }
    ss += __shfl_xor(ss, 16); ss += __shfl_xor(ss, 32);
    const float rstd = rsqrtf(ss * (1.f / 128.f) + 1e-6f);
#pragma unroll
    for (int nt = 0; nt < 8; ++nt) { f32x4 d = {0.f, 0.f, 0.f, 0.f};
#pragma unroll
      for (int ks = 0; ks < 4; ++ks) d = __builtin_amdgcn_mfma_f32_16x16x32_bf16(*(const pg8::bf16x8*)(W + (size_t)(nt * 16 + fr) * 128 + ks * 32 + fq * 8), bx[ks], d, 0, 0, 0);
      d = d * rstd;
      const int p0 = nt * 16 + fq * 4;
      if (nt < 4) { const int dd = p0 >> 1; const float c0 = cs[pos * 32 + dd], s0 = sn[pos * 32 + dd], c1 = cs[pos * 32 + dd + 1], s1 = sn[pos * 32 + dd + 1];
        const f32x4 o = {d.x * c0 - d.y * s0, d.y * c0 + d.x * s0, d.z * c1 - d.w * s1, d.w * c1 + d.z * s1}; d = o; }
      { int w8 = __builtin_amdgcn_cvt_pk_fp8_f32(d.x, d.y, 0, false); w8 = __builtin_amdgcn_cvt_pk_fp8_f32(d.z, d.w, w8, true);
        *(unsigned*)((unsigned char*)KVA + (size_t)t * 128 + p0) = (unsigned)w8; } }
  }
}


typedef _Float16 h16x2 __attribute__((ext_vector_type(2)));
constexpr int TK_KP = 4104;
constexpr int TK_KEYS = 0, TK_H1 = 16 * TK_KP * 2, TK_H2 = TK_H1 + 16 * 128 * 4, TK_MISC = TK_H2 + 8 * 128 * 4;
__device__ __forceinline__ unsigned mono16x2(unsigned u) { const unsigned m = ((u >> 15) & 0x00010001u) * 0xffffu; return u ^ (m | 0x80008000u); }
__device__ __forceinline__ int wave_incl_scan(int x) {
  x += __builtin_amdgcn_update_dpp(0, x, 0x111, 0xF, 0xF, true);
  x += __builtin_amdgcn_update_dpp(0, x, 0x112, 0xF, 0xF, true);
  x += __builtin_amdgcn_update_dpp(0, x, 0x114, 0xF, 0xF, true);
  x += __builtin_amdgcn_update_dpp(0, x, 0x118, 0xF, 0xF, true);
  x += __builtin_amdgcn_update_dpp(0, x, 0x142, 0xA, 0xF, false);
  x += __builtin_amdgcn_update_dpp(0, x, 0x143, 0xC, 0xF, false);
  return x;
}

__device__ __forceinline__ void hist_find(const unsigned* hw, int need, int lane, int& B, int& above) {
  const unsigned w0 = hw[127 - 2 * lane], w1 = hw[126 - 2 * lane];
  const int c0 = (int)(w0 >> 16), c1 = (int)(w0 & 0xffffu), c2 = (int)(w1 >> 16), c3 = (int)(w1 & 0xffffu);
  const int tl = c0 + c1 + c2 + c3;
  const int incl = wave_incl_scan(tl);
  const int excl = incl - tl;
  const bool hit = (excl < need) && (incl >= need);
  int b = 0, ab = 0;
  if (hit) { int a = excl; b = 255 - 4 * lane; ab = a;
    if (a + c0 < need) { a += c0; b = 254 - 4 * lane; ab = a; if (a + c1 < need) { a += c1; b = 253 - 4 * lane; ab = a; if (a + c2 < need) { a += c2; b = 252 - 4 * lane; ab = a; } } } }
  const unsigned long long m = __ballot(hit);
  const int src = __builtin_amdgcn_readfirstlane(m ? (__ffsll((long long)m) - 1) : 0);
  B = __builtin_amdgcn_readlane(b, src); above = __builtin_amdgcn_readlane(ab, src);
}
__device__ void phase_topk_mfma(const Ctx& c, unsigned char* ldsb, unsigned* qhead) {
  unsigned char* ws = c.ws;
  const int tid = phase_tid(), lane = tid & 63, wave = tid >> 6, fr = lane & 15, fq = lane >> 4;
  unsigned short* keys = (unsigned short*)(ldsb + TK_KEYS);
  unsigned* h1 = (unsigned*)(ldsb + TK_H1); unsigned* h2 = (unsigned*)(ldsb + TK_H2) + wave * 128; int* misc = (int*)(ldsb + TK_MISC);
  const bf16_t* IQ = (const bf16_t*)(ws + WS_IQ); const bf16_t* IK = (const bf16_t*)(ws + WS_IK); const float* SM = (const float*)(ws + WS_SM);
  unsigned short* SEL = (unsigned short*)(ws + WS_SEL);
  WorkQ wq; wq_init(wq, qhead, misc, tid);
  for (;;) {
    const int item = wq_next(wq, tid);
    if (item >= 240 * 8) break;
    const int b = item & 7, qb = 255 - (item >> 3), s0 = qb * 16;
    for (int i = tid; i < 16 * 128; i += NTHREADS) h1[i] = 0u;
    const size_t qrow = (size_t)b * SEQ + s0 + fr;
    pg8::bf16x8 bq[4][2];
#pragma unroll
    for (int hh = 0; hh < 4; ++hh)
#pragma unroll
      for (int ks = 0; ks < 2; ++ks) bq[hh][ks] = *(const pg8::bf16x8*)(IQ + qrow * 256 + hh * 64 + ks * 32 + fq * 8);
    const f32x4 iw = *(const f32x4*)(SM + qrow * 16);
    const int nkt = qb + 1, slim = s0 + fr;
    __syncthreads();
    pg8::bf16x8 a0n = {0, 0, 0, 0, 0, 0, 0, 0}, a1n = a0n;
    if (wave < nkt) { const bf16_t* kr = IK + ((size_t)b * SEQ + wave * 16 + fr) * 64 + fq * 8; a0n = *(const pg8::bf16x8*)kr; a1n = *(const pg8::bf16x8*)(kr + 32); }
    for (int kt = wave; kt < nkt; kt += NWAVES) {
      const pg8::bf16x8 a0 = a0n, a1 = a1n;
      if (kt + NWAVES < nkt) { const bf16_t* kr = IK + ((size_t)b * SEQ + (kt + NWAVES) * 16 + fr) * 64 + fq * 8; a0n = *(const pg8::bf16x8*)kr; a1n = *(const pg8::bf16x8*)(kr + 32); }
      f32x4 sc = {0.f, 0.f, 0.f, 0.f};
#pragma unroll
      for (int hh = 0; hh < 4; ++hh) { f32x4 d = {0.f, 0.f, 0.f, 0.f};
        d = __builtin_amdgcn_mfma_f32_16x16x32_bf16(a0, bq[hh][0], d, 0, 0, 0); d = __builtin_amdgcn_mfma_f32_16x16x32_bf16(a1, bq[hh][1], d, 0, 0, 0);
        const float w = hh == 0 ? iw.x : hh == 1 ? iw.y : hh == 2 ? iw.z : iw.w;
        sc.x = fmaf(w, fmaxf(d.x, 0.f), sc.x); sc.y = fmaf(w, fmaxf(d.y, 0.f), sc.y); sc.z = fmaf(w, fmaxf(d.z, 0.f), sc.z); sc.w = fmaf(w, fmaxf(d.w, 0.f), sc.w); }
      unsigned k01 = mono16x2(__builtin_bit_cast(unsigned, __builtin_amdgcn_cvt_pkrtz(sc.x, sc.y))), k23 = mono16x2(__builtin_bit_cast(unsigned, __builtin_amdgcn_cvt_pkrtz(sc.z, sc.w)));
      const int kbase = kt * 16 + fq * 4;
      unsigned* hq = h1 + fr * 128;
      if (kt + 1 < nkt) {
        *(u32x2*)(keys + fr * TK_KP + kbase) = (u32x2){k01, k23};
        { const unsigned kk = k01 & 0xffffu; atomicAdd(hq + (kk >> 9), 1u << ((kk >> 4) & 16)); }
        { const unsigned kk = k01 >> 16; atomicAdd(hq + (kk >> 9), 1u << ((kk >> 4) & 16)); }
        { const unsigned kk = k23 & 0xffffu; atomicAdd(hq + (kk >> 9), 1u << ((kk >> 4) & 16)); }
        { const unsigned kk = k23 >> 16; atomicAdd(hq + (kk >> 9), 1u << ((kk >> 4) & 16)); }
      } else {
        if (kbase + 0 > slim) k01 &= 0xffff0000u; if (kbase + 1 > slim) k01 &= 0x0000ffffu;
        if (kbase + 2 > slim) k23 &= 0xffff0000u; if (kbase + 3 > slim) k23 &= 0x0000ffffu;
        *(u32x2*)(keys + fr * TK_KP + kbase) = (u32x2){k01, k23};
        if (kbase + 0 <= slim) { const unsigned kk = k01 & 0xffffu; atomicAdd(hq + (kk >> 9), 1u << ((kk >> 4) & 16)); }
        if (kbase + 1 <= slim) { const unsigned kk = k01 >> 16; atomicAdd(hq + (kk >> 9), 1u << ((kk >> 4) & 16)); }
        if (kbase + 2 <= slim) { const unsigned kk = k23 & 0xffffu; atomicAdd(hq + (kk >> 9), 1u << ((kk >> 4) & 16)); }
        if (kbase + 3 <= slim) { const unsigned kk = k23 >> 16; atomicAdd(hq + (kk >> 9), 1u << ((kk >> 4) & 16)); }
      }
    }
    __syncthreads();
    for (int qi = 0; qi < 2; ++qi) {
      const int q = wave * 2 + qi, s = s0 + q, n = s + 1;
      int B1, above1; hist_find(h1 + q * 128, 256, lane, B1, above1);
      const int need1 = 256 - above1;
      h2[lane] = 0u; h2[64 + lane] = 0u;
      const unsigned short* kq = keys + q * TK_KP;
      const int niter = (n + 511) >> 9;
      for (int it = 0; it < niter; ++it) {
        const int i0 = (it * 64 + lane) * 8; const u32x4 kv = *(const u32x4*)(kq + i0);
        const unsigned k8[8] = {kv.x & 0xffffu, kv.x >> 16, kv.y & 0xffffu, kv.y >> 16, kv.z & 0xffffu, kv.z >> 16, kv.w & 0xffffu, kv.w >> 16};
#pragma unroll
        for (int e = 0; e < 8; ++e) if (i0 + e < n && (int)(k8[e] >> 8) == B1) atomicAdd(h2 + ((k8[e] & 255u) >> 1), 1u << ((k8[e] & 1u) * 16));
      }
      int B2, above2; hist_find(h2, need1, lane, B2, above2);
      const unsigned thr = (unsigned)((B1 << 8) | B2); const int need = need1 - above2;
      unsigned short* dummy = (unsigned short*)(misc + 8 + wave);
      unsigned short* sel = (unsigned short*)h2;
      asm volatile("s_waitcnt lgkmcnt(0)" ::: "memory");
      int tiebase = 0, outbase = 0;
      for (int it = 0; it < niter; ++it) {
        const int i0 = (it * 64 + lane) * 8; const u32x4 kv = *(const u32x4*)(kq + i0);
        const unsigned k8[8] = {kv.x & 0xffffu, kv.x >> 16, kv.y & 0xffffu, kv.y >> 16, kv.z & 0xffffu, kv.z >> 16, kv.w & 0xffffu, kv.w >> 16};
        int cg = 0, ce = 0;
#pragma unroll
        for (int e = 0; e < 8; ++e) { const bool v = i0 + e < n; cg += (v && k8[e] > thr) ? 1 : 0; ce += (v && k8[e] == thr) ? 1 : 0; }
        int tk = 0;
        if (__ballot(ce != 0)) {
          const int eincl = wave_incl_scan(ce); const int eg = tiebase + eincl - ce;
          tk = need - eg; tk = tk < 0 ? 0 : (tk > ce ? ce : tk);
          tiebase += __builtin_amdgcn_readlane(eincl, 63);
        }
        const int oc = cg + tk; const int oincl = wave_incl_scan(oc);
        int pos = outbase + oincl - oc; int tleft = tk;
#pragma unroll
        for (int e = 0; e < 8; ++e) { const bool v = i0 + e < n; const bool tie = v && k8[e] == thr && tleft > 0; const bool take = (v && k8[e] > thr) || tie;
          tleft -= tie ? 1 : 0;
          unsigned short* dst = (take && pos < 256) ? sel + pos : dummy;
          *dst = (unsigned short)(i0 + e); pos += take ? 1 : 0; }
        outbase += __builtin_amdgcn_readlane(oincl, 63);
      }
      asm volatile("s_waitcnt lgkmcnt(0)" ::: "memory");
      *(u32x2*)(SEL + ((size_t)b * SEQ + s) * 256 + lane * 4) = *(const u32x2*)(sel + lane * 4);
      asm volatile("s_waitcnt lgkmcnt(0)" ::: "memory");
    }
  }
}

typedef short s16x4 __attribute__((ext_vector_type(4)));
__device__ __forceinline__ s16x4 lds_tr16(const unsigned char* p) { return __builtin_bit_cast(s16x4, __builtin_amdgcn_ds_read_tr16_b64_v4i16((__attribute__((address_space(3))) s16x4*)(__attribute__((address_space(3))) unsigned char*)p)); }
typedef float f32x2_t __attribute__((ext_vector_type(2))); typedef __bf16 bf16x2_t __attribute__((ext_vector_type(2)));
__device__ __forceinline__ unsigned cvtpk_c(float lo, float hi) { const f32x2_t v = {lo, hi}; const bf16x2_t b = __builtin_convertvector(v, bf16x2_t); return __builtin_bit_cast(unsigned, b); }
__device__ __forceinline__ pg8::bf16x8 packp(const f32x4& a, const f32x4& b) {
  const u32x4 w = {cvtpk_c(a.x, a.y), cvtpk_c(a.z, a.w), cvtpk_c(b.x, b.y), cvtpk_c(b.z, b.w)}; return __builtin_bit_cast(pg8::bf16x8, w); }
constexpr int AT_WB = 9216 + 512;
typedef int v2i_t __attribute__((ext_vector_type(2)));
__device__ __forceinline__ long lds_tr8(const unsigned char* p) { const v2i_t r = __builtin_amdgcn_ds_read_tr8_b64_v2i32((__attribute__((address_space(3))) v2i_t*)(__attribute__((address_space(3))) unsigned char*)p); return (long)(((unsigned long)(unsigned)r.y << 32) | (unsigned long)(unsigned)r.x); }
__device__ void phase_attn_sparse(const Ctx& c, unsigned char* ldsb, unsigned* qhead) {
  unsigned char* ws = c.ws;
  const int tid = phase_tid(), lane = tid & 63, wave = tid >> 6, fr = lane & 15, fq = lane >> 4;
  unsigned char* vl = ldsb + wave * AT_WB; unsigned short* sl = (unsigned short*)(vl + 9216);
  const bf16_t* QA = (const bf16_t*)(ws + WS_QA); const unsigned char* KVA = (const unsigned char*)(ws + WS_KVA); const unsigned short* SEL = (const unsigned short*)(ws + WS_SEL);
  unsigned char* CAT = ws + WS_CAT;
  const float* gA = c.in[10];
  __syncthreads();
  int* aq_slot = (int*)(ldsb + 8 * AT_WB);
  WorkQ wq; wq_init(wq, qhead, aq_slot, tid);
  const int st_off = (lane >> 3) * 144 + (lane & 7) * 16;
  const int kr_off = fr * 144 + fq * 16;
  const int tr_off = (fq * 4 + ((fr >> 1) & 3) + (fr >> 3) * 16) * 144 + 64 + (fr & 1) * 8;
  for (;;) {
  const int item = wq_next(wq, tid);
  if (item >= 512) break;
  for (int tj = 0; tj < 8; ++tj) {
    const int t = item * 64 + wave * 8 + tj;
    const int b = t >> 12, s = t & (SEQ - 1), n = s + 1 < 256 ? s + 1 : 256;
    { u32x2 v;
      if (s >= 256) v = *(const u32x2*)(SEL + (size_t)t * 256 + lane * 4);
      else { const int i0 = lane * 4; const unsigned e0 = i0 < n ? i0 : 0, e1 = i0 + 1 < n ? i0 + 1 : 0, e2 = i0 + 2 < n ? i0 + 2 : 0, e3 = i0 + 3 < n ? i0 + 3 : 0; v = (u32x2){e0 | (e1 << 16), e2 | (e3 << 16)}; }
      *(u32x2*)(sl + lane * 4) = v; }
    asm volatile("s_waitcnt lgkmcnt(0)" ::: "memory");
    const unsigned char* kvb = KVA + (size_t)b * SEQ * 128;
    u32x4 ra[8], rb[8];
#define KLOAD(R, CH) do { _Pragma("unroll") for (int i_ = 0; i_ < 8; ++i_) { const int key_ = sl[(CH) * 64 + i_ * 8 + (lane >> 3)]; R[i_] = *(const u32x4*)(kvb + (size_t)key_ * 128 + (lane & 7) * 16); } } while (0)
#define KSTORE(R) do { _Pragma("unroll") for (int i_ = 0; i_ < 8; ++i_) *(u32x4*)(vl + i_ * 8 * 144 + st_off) = R[i_]; } while (0)
    KLOAD(ra, 0); KLOAD(rb, 1);
    long q0 = 0, q1 = 0;
    if (fr < 6) { const bf16_t* qp = QA + (size_t)t * 384 + fr * 64 + fq * 16; const u32x4 a = *(const u32x4*)qp, bb = *(const u32x4*)(qp + 8);
      q0 = mk64(cvt4_fp8(__uint_as_float(a.x << 16), __uint_as_float(a.x & 0xffff0000u), __uint_as_float(a.y << 16), __uint_as_float(a.y & 0xffff0000u)),
                cvt4_fp8(__uint_as_float(a.z << 16), __uint_as_float(a.z & 0xffff0000u), __uint_as_float(a.w << 16), __uint_as_float(a.w & 0xffff0000u)));
      q1 = mk64(cvt4_fp8(__uint_as_float(bb.x << 16), __uint_as_float(bb.x & 0xffff0000u), __uint_as_float(bb.y << 16), __uint_as_float(bb.y & 0xffff0000u)),
                cvt4_fp8(__uint_as_float(bb.z << 16), __uint_as_float(bb.z & 0xffff0000u), __uint_as_float(bb.w << 16), __uint_as_float(bb.w & 0xffff0000u))); }
    float m = -3.0e38f, l = 0.f;
    f32x4 ot[4];
#pragma unroll
    for (int mt = 0; mt < 4; ++mt) ot[mt] = (f32x4){0.f, 0.f, 0.f, 0.f};
#define KCHUNK(R, CH) do { \
      KSTORE(R); if ((CH) + 2 < 4) KLOAD(R, (CH) + 2); \
      asm volatile("s_waitcnt lgkmcnt(0)" ::: "memory"); \
      f32x4 st[4]; \
      _Pragma("unroll") for (int kt = 0; kt < 4; ++kt) { const u32x4 a_ = *(const u32x4*)(vl + kt * 16 * 144 + kr_off); f32x4 d_ = {0.f, 0.f, 0.f, 0.f}; \
        d_ = __builtin_amdgcn_mfma_f32_16x16x32_fp8_fp8(mk64(a_.x, a_.y), q0, d_, 0, 0, 0); st[kt] = __builtin_amdgcn_mfma_f32_16x16x32_fp8_fp8(mk64(a_.z, a_.w), q1, d_, 0, 0, 0); } \
      if (n < 256) { _Pragma("unroll") for (int kt = 0; kt < 4; ++kt) { const int sb = (CH) * 64 + kt * 16 + fq * 4; \
        if (sb + 0 >= n) st[kt].x = -3.0e38f; if (sb + 1 >= n) st[kt].y = -3.0e38f; if (sb + 2 >= n) st[kt].z = -3.0e38f; if (sb + 3 >= n) st[kt].w = -3.0e38f; } } \
      float cm = -3.0e38f; \
      _Pragma("unroll") for (int kt = 0; kt < 4; ++kt) cm = fmaxf(fmaxf(fmaxf(cm, st[kt].x), fmaxf(st[kt].y, st[kt].z)), st[kt].w); \
      cm = fmaxf(cm, __shfl_xor(cm, 16)); cm = fmaxf(cm, __shfl_xor(cm, 32)); \
      const float mn = fmaxf(m, cm), al = __builtin_amdgcn_exp2f(m - mn), mb = mn - 8.f; m = mn; \
      float ls = 0.f; \
      _Pragma("unroll") for (int kt = 0; kt < 4; ++kt) { st[kt].x = __builtin_amdgcn_exp2f(st[kt].x - mb); st[kt].y = __builtin_amdgcn_exp2f(st[kt].y - mb); st[kt].z = __builtin_amdgcn_exp2f(st[kt].z - mb); st[kt].w = __builtin_amdgcn_exp2f(st[kt].w - mb); \
        ls += (st[kt].x + st[kt].y) + (st[kt].z + st[kt].w); } \
      l = l * al + ls; \
      _Pragma("unroll") for (int mt = 0; mt < 4; ++mt) ot[mt] = ot[mt] * al; \
      _Pragma("unroll") for (int k2 = 0; k2 < 2; ++k2) { \
        const long pf = mk64(cvt4_fp8(st[2 * k2].x, st[2 * k2].y, st[2 * k2].z, st[2 * k2].w), cvt4_fp8(st[2 * k2 + 1].x, st[2 * k2 + 1].y, st[2 * k2 + 1].z, st[2 * k2 + 1].w)); \
        _Pragma("unroll") for (int mt = 0; mt < 4; ++mt) { const long af = lds_tr8(vl + k2 * 32 * 144 + tr_off + mt * 16); \
          ot[mt] = __builtin_amdgcn_mfma_f32_16x16x32_fp8_fp8(af, pf, ot[mt], 0, 0, 0); } } \
      asm volatile("s_waitcnt lgkmcnt(0)" ::: "memory"); } while (0)
    KCHUNK(ra, 0); KCHUNK(rb, 1); KCHUNK(ra, 2); KCHUNK(rb, 3);
#undef KLOAD
#undef KSTORE
#undef KCHUNK
    l += __shfl_xor(l, 16); l += __shfl_xor(l, 32);
    const float il = __builtin_amdgcn_rcpf(l); float ss = 0.f;
#pragma unroll
    for (int mt = 0; mt < 4; ++mt) { ot[mt] = ot[mt] * il; ss += (ot[mt].x * ot[mt].x + ot[mt].y * ot[mt].y) + (ot[mt].z * ot[mt].z + ot[mt].w * ot[mt].w); }
    if (fr >= 6) ss = 0.f;
#pragma unroll
    for (int o = 1; o < 64; o <<= 1) ss += __shfl_xor(ss, o);
    const float rstd = rsqrtf(ss * (1.f / 384.f) + 1e-6f);
    if (fr < 6) {
#pragma unroll
      for (int mt = 0; mt < 4; ++mt) { const int col = fr * 64 + mt * 16 + fq * 4; const f32x4 g = *(const f32x4*)(gA + col); const f32x4 o = ot[mt] * rstd * g;
        *(unsigned*)(CAT + (size_t)t * 1024 + col) = pk4_fp8(o); } }
  }
  }
}

__device__ void phase_attn_mem(const Ctx& c, unsigned char* ldsb, unsigned* qhead) {
  unsigned char* ws = c.ws;
  const int tid = phase_tid(), lane = tid & 63, wave = tid >> 6, fr = lane & 15, fq = lane >> 4;
  const bf16_t* QC = (const bf16_t*)(ws + WS_QC); const unsigned char* MK = ws + WS_MK; const unsigned char* MVT = ws + WS_MVT;
  unsigned char* CAT = ws + WS_CAT;
  const float* gC = c.in[11];
  int* aq_slot = (int*)(ldsb + 70656 + 8 * 8192);
  WorkQ wq; wq_init(wq, qhead, aq_slot, tid);
  for (;;) {
  const int item = wq_next(wq, tid) + 512;
  if (item >= 768) break;
  {
    const int t0 = (item - 512) * 128 + wave * 16, b = t0 >> 12;
    unsigned char* mkl = ldsb; unsigned char* mvl = ldsb + 36864; unsigned char* ocl = ldsb + 70656 + wave * 8192;
    float ss = 0.f;
#pragma unroll 1
    for (int h = 0; h < 4; ++h) {
      const bf16_t* qp = QC + (size_t)(t0 + fr) * 256 + h * 64 + fq * 16;
      const u32x4 qa = *(const u32x4*)qp, qb = *(const u32x4*)(qp + 8);
      __syncthreads();
#pragma unroll
      for (int i = 0; i < 2; ++i) { const int p = tid + 512 * i, row = p >> 2, cc = p & 3;
        *(u32x4*)(mkl + row * 80 + cc * 16) = *(const u32x4*)(MK + ((size_t)(b * 256 + row)) * 256 + h * 64 + cc * 16); }
#pragma unroll
      for (int i = 0; i < 2; ++i) { const int p = tid + 512 * i, row = p >> 4, cc = p & 15;
        *(u32x4*)(mvl + row * 272 + cc * 16) = *(const u32x4*)(MVT + ((size_t)(b * 256 + h * 64 + row)) * 256 + cc * 16); }
      const long q0 = mk64(cvt4_fp8(__uint_as_float(qa.x << 16), __uint_as_float(qa.x & 0xffff0000u), __uint_as_float(qa.y << 16), __uint_as_float(qa.y & 0xffff0000u)),
                           cvt4_fp8(__uint_as_float(qa.z << 16), __uint_as_float(qa.z & 0xffff0000u), __uint_as_float(qa.w << 16), __uint_as_float(qa.w & 0xffff0000u)));
      const long q1 = mk64(cvt4_fp8(__uint_as_float(qb.x << 16), __uint_as_float(qb.x & 0xffff0000u), __uint_as_float(qb.y << 16), __uint_as_float(qb.y & 0xffff0000u)),
                           cvt4_fp8(__uint_as_float(qb.z << 16), __uint_as_float(qb.z & 0xffff0000u), __uint_as_float(qb.w << 16), __uint_as_float(qb.w & 0xffff0000u)));
      __syncthreads();
      f32x4 oc[4];
      f32x4 st[16];
#pragma unroll
      for (int kt = 0; kt < 16; ++kt) { const u32x4 a_ = *(const u32x4*)(mkl + (kt * 16 + fr) * 80 + fq * 16);
        f32x4 d = {0.f, 0.f, 0.f, 0.f};
        d = __builtin_amdgcn_mfma_f32_16x16x32_fp8_fp8(mk64(a_.x, a_.y), q0, d, 0, 0, 0); st[kt] = __builtin_amdgcn_mfma_f32_16x16x32_fp8_fp8(mk64(a_.z, a_.w), q1, d, 0, 0, 0); }
      float mx = -3.0e38f;
#pragma unroll
      for (int kt = 0; kt < 16; ++kt) mx = fmaxf(fmaxf(fmaxf(mx, st[kt].x), fmaxf(st[kt].y, st[kt].z)), st[kt].w);
      mx = fmaxf(mx, __shfl_xor(mx, 16)); mx = fmaxf(mx, __shfl_xor(mx, 32));
      mx -= 8.f;
      float l = 0.f;
#pragma unroll
      for (int kt = 0; kt < 16; ++kt) { st[kt].x = __builtin_amdgcn_exp2f(st[kt].x - mx); st[kt].y = __builtin_amdgcn_exp2f(st[kt].y - mx); st[kt].z = __builtin_amdgcn_exp2f(st[kt].z - mx); st[kt].w = __builtin_amdgcn_exp2f(st[kt].w - mx);
        l += (st[kt].x + st[kt].y) + (st[kt].z + st[kt].w); }
      l += __shfl_xor(l, 16); l += __shfl_xor(l, 32);
#pragma unroll
      for (int mt = 0; mt < 4; ++mt) oc[mt] = (f32x4){0.f, 0.f, 0.f, 0.f};
#pragma unroll
      for (int kk = 0; kk < 8; ++kk) { const long pf = mk64(cvt4_fp8(st[2 * kk].x, st[2 * kk].y, st[2 * kk].z, st[2 * kk].w), cvt4_fp8(st[2 * kk + 1].x, st[2 * kk + 1].y, st[2 * kk + 1].z, st[2 * kk + 1].w));
#pragma unroll
        for (int mt = 0; mt < 4; ++mt) { const u32x2 a_ = *(const u32x2*)(mvl + (mt * 16 + fr) * 272 + (kk * 4 + fq) * 8);
          oc[mt] = __builtin_amdgcn_mfma_f32_16x16x32_fp8_fp8(mk64(a_.x, a_.y), pf, oc[mt], 0, 0, 0); } }
      const float il = __builtin_amdgcn_rcpf(l);
#pragma unroll
      for (int mt = 0; mt < 4; ++mt) { const f32x4 o = oc[mt] * il; ss += (o.x * o.x + o.y * o.y) + (o.z * o.z + o.w * o.w); *(u32x2*)(ocl + ((h * 4 + mt) * 64 + lane) * 8) = (u32x2){pg8::cvt_pk_bf16(o.x, o.y), pg8::cvt_pk_bf16(o.z, o.w)}; }
    }
    ss += __shfl_xor(ss, 16); ss += __shfl_xor(ss, 32);
    const float rstd = rsqrtf(ss * (1.f / 256.f) + 1e-6f);
#pragma unroll 1
    for (int h = 0; h < 4; ++h)
#pragma unroll
      for (int mt = 0; mt < 4; ++mt) { const int col = h * 64 + mt * 16 + fq * 4; const f32x4 g = *(const f32x4*)(gC + col); const u32x2 pp = *(const u32x2*)(ocl + ((h * 4 + mt) * 64 + lane) * 8);
        const f32x4 ov = {__uint_as_float(pp.x << 16), __uint_as_float(pp.x & 0xffff0000u), __uint_as_float(pp.y << 16), __uint_as_float(pp.y & 0xffff0000u)}; const f32x4 o = ov * rstd * g;
        *(unsigned*)(CAT + (size_t)(t0 + fr) * 1024 + 768 + col) = pk4_fp8(o); }
  }
  }
}

constexpr int GD_ITEM = 41088;
__device__ __forceinline__ unsigned char* gd_item(unsigned char* ws, int it) { return it < 1536 ? ws + WS_XB + (size_t)it * GD_ITEM : ws + WS_X1B + (size_t)(it - 1536) * GD_ITEM; }
__device__ __forceinline__ int kperm(int x) { return (x & 32) | (((x >> 2) & 3) << 3) | (x & 3) | (((x >> 4) & 1) << 2); }
constexpr int GP_KB = 0, GP_KBB = 9216, GP_QB = 18432, GP_VBT = 27648, GP_KBET = 36864, GP_XR = 46080  , GP_PR = 82944  , GP_OUT = 101376, GP_SC = 142336;
__device__ __forceinline__ pg8::bf16x8 ldsfrag(const unsigned char* base, int row, int ks, int fq) { return *(const pg8::bf16x8*)(base + row * 144 + ks * 64 + fq * 16); }
constexpr int G2_KB = 0, G2_KBB = 9216, G2_QB = 18432, G2_XR0 = 27648, G2_XT0 = 36864, G2_PR0 = 46080, G2_VBT = 55296, G2_KBET = 64512, G2_SC = 73728, G2_CW = 75264, G2_HALF = 78336;
__device__ void phase_gdn_prep2(const Ctx& c, unsigned char* Lb) {
  unsigned char* ws = c.ws;
  const int tid = phase_tid(), lane = tid & 63, wave = tid >> 6, fr = lane & 15, fq = lane >> 4;
  const int hb = wave >> 2, w4 = wave & 3, htid = tid & 255;
  unsigned char* L = Lb + hb * G2_HALF;
  const bf16_t* GB = (const bf16_t*)(ws + WS_GB); const float* SM = (const float*)(ws + WS_SM);
  const float* convw = c.in[6];
  float* sc = (float*)(L + G2_SC);
  float* cw = (float*)(L + G2_CW);
  const int tt = htid >> 2, part = htid & 3;
  for (int it2 = blockIdx.x; it2 < 1536; it2 += gridDim.x) {
    const int it = it2 * 2 + hb;
    const int n = it & 63, bh = it >> 6, b = bh / 6, h = bh % 6;
    const int t = n * 64 + tt; const size_t r = (size_t)b * SEQ + t;
    unsigned char* gb = gd_item(ws, it);
    __syncthreads();
    for (int i = htid; i < 768; i += 256) { const int j = i / 192, rr = i % 192; cw[i] = convw[j * 1152 + (rr >> 6) * 384 + h * 64 + (rr & 63)]; }
    if (part == 0) { const float a = SM[r * 16 + 4 + h], bb = SM[r * 16 + 10 + h]; const float xs = a + c.in[8][h]; const float sp = xs > 20.f ? xs : log1pf(__expf(xs));
      sc[tt] = -__expf(c.in[7][h]) * sp; sc[192 + tt] = 1.f / (1.f + __expf(-bb)); }
    __syncthreads();
    if (w4 == 0) { float v = sc[lane];
#pragma unroll
      for (int o = 1; o < 64; o <<= 1) { const float u = __shfl_up(v, o); if (lane >= o) v += u; }
      const float last = __shfl(v, 63);
      sc[64 + lane] = v; sc[128 + lane] = __expf(v); sc[256 + lane] = __expf(last - v); if (lane == 0) { sc[320] = __expf(last); *(float*)(gb + 40960) = __expf(last); } }
    float qv[16], kv[16], vv[16];
#pragma unroll
    for (int role = 0; role < 3; ++role) {
      float acc[16];
#pragma unroll
      for (int e = 0; e < 16; ++e) acc[e] = 0.f;
      u32x4 xr[4][2];
#pragma unroll
      for (int j = 0; j < 4; ++j) { const bool ok = t - 3 + j >= 0; const bf16_t* xp = GB + (r - 3 + j) * 1536 + role * 384 + h * 64 + part * 16;
        xr[j][0] = ok ? *(const u32x4*)xp : (u32x4){0u, 0u, 0u, 0u}; xr[j][1] = ok ? *(const u32x4*)(xp + 8) : (u32x4){0u, 0u, 0u, 0u}; }
#pragma unroll
      for (int j = 0; j < 4; ++j)
#pragma unroll
        for (int hh = 0; hh < 2; ++hh) { const u32x4 xvv = xr[j][hh]; const float* wj = cw + j * 192 + role * 64 + part * 16 + hh * 8;
          const f32x4 w0 = *(const f32x4*)wj, w1 = *(const f32x4*)(wj + 4);
          acc[hh * 8 + 0] += w0.x * __uint_as_float(xvv.x << 16); acc[hh * 8 + 1] += w0.y * __uint_as_float(xvv.x & 0xffff0000u); acc[hh * 8 + 2] += w0.z * __uint_as_float(xvv.y << 16); acc[hh * 8 + 3] += w0.w * __uint_as_float(xvv.y & 0xffff0000u);
          acc[hh * 8 + 4] += w1.x * __uint_as_float(xvv.z << 16); acc[hh * 8 + 5] += w1.y * __uint_as_float(xvv.z & 0xffff0000u); acc[hh * 8 + 6] += w1.z * __uint_as_float(xvv.w << 16); acc[hh * 8 + 7] += w1.w * __uint_as_float(xvv.w & 0xffff0000u); }
      float ss = 0.f;
#pragma unroll
      for (int e = 0; e < 16; ++e) { acc[e] = silu_f(acc[e]); ss += acc[e] * acc[e]; }
      if (role < 2) { ss += __shfl_xor(ss, 1); ss += __shfl_xor(ss, 2); const float scl = rsqrtf(ss + 1e-6f) * (role == 0 ? 0.125f : 1.f);
#pragma unroll
        for (int e = 0; e < 16; ++e) acc[e] *= scl; }
#pragma unroll
      for (int e = 0; e < 16; ++e) { if (role == 0) qv[e] = acc[e]; else if (role == 1) kv[e] = acc[e]; else vv[e] = acc[e]; }
    }
    __syncthreads();
    { const float beta = sc[192 + tt], eg = sc[128 + tt], ekl = sc[256 + tt];
      float kb[16];
#pragma unroll
      for (int e = 0; e < 16; ++e) kb[e] = kv[e] * beta;
#pragma unroll
      for (int hh = 0; hh < 2; ++hh) { const int o8 = hh * 8;
        *(u32x4*)(L + G2_KB + tt * 144 + part * 32 + hh * 16) = (u32x4){pk2(kv[o8], kv[o8 + 1]), pk2(kv[o8 + 2], kv[o8 + 3]), pk2(kv[o8 + 4], kv[o8 + 5]), pk2(kv[o8 + 6], kv[o8 + 7])};
        *(u32x4*)(L + G2_KBB + tt * 144 + part * 32 + hh * 16) = (u32x4){pk2(kb[o8], kb[o8 + 1]), pk2(kb[o8 + 2], kb[o8 + 3]), pk2(kb[o8 + 4], kb[o8 + 5]), pk2(kb[o8 + 6], kb[o8 + 7])};
        *(u32x4*)(L + G2_QB + tt * 144 + part * 32 + hh * 16) = (u32x4){pk2(qv[o8], qv[o8 + 1]), pk2(qv[o8 + 2], qv[o8 + 3]), pk2(qv[o8 + 4], qv[o8 + 5]), pk2(qv[o8 + 6], qv[o8 + 7])}; }
      const int ptt = kperm(tt);
#pragma unroll
      for (int e = 0; e < 16; ++e) { const int d = part * 16 + e;
        *(bf16_t*)(L + G2_VBT + d * 144 + tt * 2) = f2bf(vv[e] * beta);
        *(bf16_t*)(L + G2_KBET + d * 144 + tt * 2) = f2bf(kb[e] * eg);
        *(bf16_t*)(gb + 8192 + tt * 128 + kperm(d) * 2) = f2bf(qv[e] * eg);
        *(bf16_t*)(gb + 3 * 8192 + d * 128 + ptt * 2) = f2bf(kv[e] * ekl); } }
    __syncthreads();
    const int rowb = (w4 * 16 + fq * 4) * 144 + fr * 2;
    const int colb = fr * 144 + (w4 * 16 + fq * 4) * 2;
    const int fa = (w4 * 16 + fr) * 144 + fq * 16;
    const int fb = fr * 144 + fq * 16;
    const int i0 = w4 * 16 + fq * 4;
#define G2F(buf, off) (*(const pg8::bf16x8*)(L + (buf) + (off)))
#define G2W16(buf, off, v) (*(bf16_t*)(L + (buf) + (off)) = f2bf(v))
    f32x4 Pt[4];
    { const float gi0 = sc[64 + i0], gi1 = sc[64 + i0 + 1], gi2 = sc[64 + i0 + 2], gi3 = sc[64 + i0 + 3];
#pragma unroll
    for (int u = 0; u < 4; ++u) {
      f32x4 dl = {0.f, 0.f, 0.f, 0.f}, da = {0.f, 0.f, 0.f, 0.f};
#pragma unroll
      for (int ks = 0; ks < 2; ++ks) { const pg8::bf16x8 bk = G2F(G2_KB, fb + u * 2304 + ks * 64);
        dl = __builtin_amdgcn_mfma_f32_16x16x32_bf16(G2F(G2_KBB, fa + ks * 64), bk, dl, 0, 0, 0);
        da = __builtin_amdgcn_mfma_f32_16x16x32_bf16(G2F(G2_QB, fa + ks * 64), bk, da, 0, 0, 0); }
      const int j = u * 16 + fr; const float gj = sc[64 + j]; const int pj = kperm(j);
      const float dec0 = __expf(fminf(gi0 - gj, 0.f)), dec1 = __expf(fminf(gi1 - gj, 0.f)), dec2 = __expf(fminf(gi2 - gj, 0.f)), dec3 = __expf(fminf(gi3 - gj, 0.f));
      const float l0 = i0 + 0 > j ? dl.x * dec0 : 0.f, l1 = i0 + 1 > j ? dl.y * dec1 : 0.f, l2 = i0 + 2 > j ? dl.z * dec2 : 0.f, l3 = i0 + 3 > j ? dl.w * dec3 : 0.f;
      const float a0 = i0 + 0 >= j ? da.x * dec0 : 0.f, a1 = i0 + 1 >= j ? da.y * dec1 : 0.f, a2 = i0 + 2 >= j ? da.z * dec2 : 0.f, a3 = i0 + 3 >= j ? da.w * dec3 : 0.f;
      const f32x4 pv = {(i0 + 0 == j ? 1.f : 0.f) - l0, (i0 + 1 == j ? 1.f : 0.f) - l1, (i0 + 2 == j ? 1.f : 0.f) - l2, (i0 + 3 == j ? 1.f : 0.f) - l3};
      G2W16(G2_XR0, rowb + u * 32, l0); G2W16(G2_XR0, rowb + 144 + u * 32, l1); G2W16(G2_XR0, rowb + 288 + u * 32, l2); G2W16(G2_XR0, rowb + 432 + u * 32, l3);
      G2W16(G2_PR0, rowb + u * 32, pv.x); G2W16(G2_PR0, rowb + 144 + u * 32, pv.y); G2W16(G2_PR0, rowb + 288 + u * 32, pv.z); G2W16(G2_PR0, rowb + 432 + u * 32, pv.w);
      *(u32x2*)(L + G2_XT0 + colb + u * 2304) = (u32x2){pk2(l0, l1), pk2(l2, l3)};
      bf16_t* am = (bf16_t*)(gb + 2 * 8192 + i0 * 128 + pj * 2);
      am[0] = f2bf(a0); am[64] = f2bf(a1); am[128] = f2bf(a2); am[192] = f2bf(a3);
      Pt[u] = pv; } }
    __syncthreads();
#pragma unroll
    for (int u = 0; u < 4; ++u) {
      f32x4 d = {0.f, 0.f, 0.f, 0.f};
#pragma unroll
      for (int ks = 0; ks < 2; ++ks) d = __builtin_amdgcn_mfma_f32_16x16x32_bf16(G2F(G2_XR0, fa + ks * 64), G2F(G2_XT0, fb + u * 2304 + ks * 64), d, 0, 0, 0);
      G2W16(G2_KB, rowb + u * 32, d.x); G2W16(G2_KB, rowb + 144 + u * 32, d.y); G2W16(G2_KB, rowb + 288 + u * 32, d.z); G2W16(G2_KB, rowb + 432 + u * 32, d.w);
      *(u32x2*)(L + G2_KBB + colb + u * 2304) = (u32x2){pk2(d.x, d.y), pk2(d.z, d.w)}; }
    __syncthreads();
#pragma unroll
    for (int itn = 0; itn < 4; ++itn) {
      const int XRc = (itn & 1) ? G2_XR0 : G2_KB, XTc = (itn & 1) ? G2_XT0 : G2_KBB, XRn = (itn & 1) ? G2_KB : G2_XR0, XTn = (itn & 1) ? G2_KBB : G2_XT0;
      const int PRc = (itn & 1) ? G2_QB : G2_PR0, PRn = (itn & 1) ? G2_PR0 : G2_QB;
#pragma unroll
      for (int u = 0; u < 4; ++u) {
        f32x4 d = {0.f, 0.f, 0.f, 0.f};
#pragma unroll
        for (int ks = 0; ks < 2; ++ks) { const pg8::bf16x8 bx = G2F(XTc, fb + u * 2304 + ks * 64);
          Pt[u] = __builtin_amdgcn_mfma_f32_16x16x32_bf16(G2F(PRc, fa + ks * 64), bx, Pt[u], 0, 0, 0);
          if (itn < 3) d = __builtin_amdgcn_mfma_f32_16x16x32_bf16(G2F(XRc, fa + ks * 64), bx, d, 0, 0, 0); }
        G2W16(PRn, rowb + u * 32, Pt[u].x); G2W16(PRn, rowb + 144 + u * 32, Pt[u].y); G2W16(PRn, rowb + 288 + u * 32, Pt[u].z); G2W16(PRn, rowb + 432 + u * 32, Pt[u].w);
        if (itn < 3) { G2W16(XRn, rowb + u * 32, d.x); G2W16(XRn, rowb + 144 + u * 32, d.y); G2W16(XRn, rowb + 288 + u * 32, d.z); G2W16(XRn, rowb + 432 + u * 32, d.w);
          *(u32x2*)(L + XTn + colb + u * 2304) = (u32x2){pk2(d.x, d.y), pk2(d.z, d.w)}; } }
      __syncthreads();
    }
#pragma unroll
    for (int u = 0; u < 4; ++u) {
      f32x4 du = {0.f, 0.f, 0.f, 0.f}, dw = {0.f, 0.f, 0.f, 0.f};
#pragma unroll
      for (int ks = 0; ks < 2; ++ks) { const pg8::bf16x8 a = G2F(G2_PR0, fa + ks * 64);
        du = __builtin_amdgcn_mfma_f32_16x16x32_bf16(a, G2F(G2_VBT, fb + u * 2304 + ks * 64), du, 0, 0, 0);
        dw = __builtin_amdgcn_mfma_f32_16x16x32_bf16(a, G2F(G2_KBET, fb + u * 2304 + ks * 64), dw, 0, 0, 0); }
      const int j = u * 16 + fr, pj = kperm(j);
      *(u32x2*)(gb + 4 * 8192 + j * 128 + i0 * 2) = (u32x2){pk2(du.x, du.y), pk2(du.z, du.w)};
      bf16_t* wn = (bf16_t*)(gb + i0 * 128 + pj * 2);
      wn[0] = f2bf(-dw.x); wn[64] = f2bf(-dw.y); wn[128] = f2bf(-dw.z); wn[192] = f2bf(-dw.w); }
#undef G2F
#undef G2W16
  }
}

constexpr int GS_SLOT = 46208, GS_OB = 2 * GS_SLOT;
__device__ void phase_gdn_scan(const Ctx& c, unsigned char* L, int item) {
  unsigned char* ws = c.ws;
  const int tid = phase_tid(), lane = tid & 63, wave = tid >> 6, fr = lane & 15, fq = lane >> 4;
  const int b = item / 6, h = item % 6;
  const bf16_t* GB = (const bf16_t*)(ws + WS_GB); unsigned char* CAT = ws + WS_CAT; const float* gng = c.in[9];
  const int lt = tid - 256;
  u32x4 ra[10], rb[10]; float gla = 0.f, glb = 0.f;
  f32x4 S[4];
#pragma unroll
  for (int i = 0; i < 4; ++i) S[i] = (f32x4){0.f, 0.f, 0.f, 0.f};
#define GS_LOAD(R, G, n) do { if ((n) < 64) { const unsigned char* gb_ = gd_item(ws, item * 64 + (n)); _Pragma("unroll") for (int i_ = 0; i_ < 10; ++i_) R[i_] = *(const u32x4*)(gb_ + (size_t)(lt + 256 * i_) * 16); if (lt == 0) G = *(const float*)(gb_ + 40960); } } while (0)
#define GS_STORE(R, G, slot) do { _Pragma("unroll") for (int i_ = 0; i_ < 10; ++i_) { const int p_ = lt + 256 * i_; *(u32x4*)(L + (slot) * GS_SLOT + (p_ >> 9) * 9216 + ((p_ >> 3) & 63) * 144 + (p_ & 7) * 16) = R[i_]; } if (lt == 0) *(float*)(L + (slot) * GS_SLOT + 46080) = G; } while (0)
  float gnr[16];
#pragma unroll
  for (int e = 0; e < 16; ++e) gnr[e] = gng[((tid - 256) & 3) * 16 + e];
  auto zload = [&](int k, u32x4& z0, u32x4& z1) {
    const size_t r = (size_t)b * SEQ + k * 64 + (lt >> 2); const bf16_t* zp = GB + r * 1536 + 1152 + h * 64 + (lt & 3) * 16; z0 = *(const u32x4*)zp; z1 = *(const u32x4*)(zp + 8); };
  auto post = [&](int k, const u32x4 z0, const u32x4 z1) {
    const unsigned char* ob = L + GS_OB + (k & 1) * 9216; const int tk = lt >> 2, part = lt & 3; const size_t r = (size_t)b * SEQ + k * 64 + tk;
    const u32x4 o0 = *(const u32x4*)(ob + tk * 144 + part * 32), o1 = *(const u32x4*)(ob + tk * 144 + part * 32 + 16);
    float ov[16] = {__uint_as_float(o0.x << 16), __uint_as_float(o0.x & 0xffff0000u), __uint_as_float(o0.y << 16), __uint_as_float(o0.y & 0xffff0000u), __uint_as_float(o0.z << 16), __uint_as_float(o0.z & 0xffff0000u), __uint_as_float(o0.w << 16), __uint_as_float(o0.w & 0xffff0000u),
                    __uint_as_float(o1.x << 16), __uint_as_float(o1.x & 0xffff0000u), __uint_as_float(o1.y << 16), __uint_as_float(o1.y & 0xffff0000u), __uint_as_float(o1.z << 16), __uint_as_float(o1.z & 0xffff0000u), __uint_as_float(o1.w << 16), __uint_as_float(o1.w & 0xffff0000u)};
    float ss = 0.f;
#pragma unroll
    for (int e = 0; e < 16; ++e) ss += ov[e] * ov[e];
    ss += __shfl_xor(ss, 1); ss += __shfl_xor(ss, 2);
    const float rstd = rsqrtf(ss * (1.f / 64.f) + 1e-6f);
    const float zf[16] = {__uint_as_float(z0.x << 16), __uint_as_float(z0.x & 0xffff0000u), __uint_as_float(z0.y << 16), __uint_as_float(z0.y & 0xffff0000u), __uint_as_float(z0.z << 16), __uint_as_float(z0.z & 0xffff0000u), __uint_as_float(z0.w << 16), __uint_as_float(z0.w & 0xffff0000u),
                          __uint_as_float(z1.x << 16), __uint_as_float(z1.x & 0xffff0000u), __uint_as_float(z1.y << 16), __uint_as_float(z1.y & 0xffff0000u), __uint_as_float(z1.z << 16), __uint_as_float(z1.z & 0xffff0000u), __uint_as_float(z1.w << 16), __uint_as_float(z1.w & 0xffff0000u)};
#pragma unroll
    for (int e = 0; e < 16; ++e) ov[e] = ov[e] * rstd * gnr[e] * silu_f(zf[e]);
    unsigned char* op = CAT + r * 1024 + 384 + h * 64 + part * 16;
    *(u32x4*)op = (u32x4){cvt4_fp8(ov[0], ov[1], ov[2], ov[3]), cvt4_fp8(ov[4], ov[5], ov[6], ov[7]), cvt4_fp8(ov[8], ov[9], ov[10], ov[11]), cvt4_fp8(ov[12], ov[13], ov[14], ov[15])};
  };
  auto step = [&](int k) {
    const unsigned char* sb = L + (k & 1) * GS_SLOT; const float gl = *(const float*)(sb + 46080);
    const pg8::bf16x8 Sb0 = packp(S[0], S[1]), Sb1 = packp(S[2], S[3]);
    f32x4 vn[4], o[4];
#pragma unroll
    for (int mt = 0; mt < 4; ++mt) { const u32x2 uv = *(const u32x2*)(sb + 4 * 9216 + (wave * 16 + fr) * 144 + (mt * 16 + fq * 4) * 2);
      f32x4 a = {__uint_as_float(uv.x << 16), __uint_as_float(uv.x & 0xffff0000u), __uint_as_float(uv.y << 16), __uint_as_float(uv.y & 0xffff0000u)};
      a = __builtin_amdgcn_mfma_f32_16x16x32_bf16(ldsfrag(sb, mt * 16 + fr, 0, fq), Sb0, a, 0, 0, 0);
      vn[mt] = __builtin_amdgcn_mfma_f32_16x16x32_bf16(ldsfrag(sb, mt * 16 + fr, 1, fq), Sb1, a, 0, 0, 0);
      f32x4 q = {0.f, 0.f, 0.f, 0.f};
      q = __builtin_amdgcn_mfma_f32_16x16x32_bf16(ldsfrag(sb + 9216, mt * 16 + fr, 0, fq), Sb0, q, 0, 0, 0);
      o[mt] = __builtin_amdgcn_mfma_f32_16x16x32_bf16(ldsfrag(sb + 9216, mt * 16 + fr, 1, fq), Sb1, q, 0, 0, 0); }
    const pg8::bf16x8 Vb0 = packp(vn[0], vn[1]), Vb1 = packp(vn[2], vn[3]);
#pragma unroll
    for (int mt = 0; mt < 4; ++mt) { o[mt] = __builtin_amdgcn_mfma_f32_16x16x32_bf16(ldsfrag(sb + 2 * 9216, mt * 16 + fr, 0, fq), Vb0, o[mt], 0, 0, 0);
      o[mt] = __builtin_amdgcn_mfma_f32_16x16x32_bf16(ldsfrag(sb + 2 * 9216, mt * 16 + fr, 1, fq), Vb1, o[mt], 0, 0, 0); }
#pragma unroll
    for (int kt = 0; kt < 4; ++kt) { f32x4 sv = S[kt] * gl;
      sv = __builtin_amdgcn_mfma_f32_16x16x32_bf16(ldsfrag(sb + 3 * 9216, kt * 16 + fr, 0, fq), Vb0, sv, 0, 0, 0);
      S[kt] = __builtin_amdgcn_mfma_f32_16x16x32_bf16(ldsfrag(sb + 3 * 9216, kt * 16 + fr, 1, fq), Vb1, sv, 0, 0, 0); }
    unsigned char* ob = L + GS_OB + (k & 1) * 9216 + (wave * 16 + fr) * 2;
#pragma unroll
    for (int mt = 0; mt < 4; ++mt) { const int t0 = mt * 16 + fq * 4;
      *(bf16_t*)(ob + (t0 + 0) * 144) = f2bf(o[mt].x); *(bf16_t*)(ob + (t0 + 1) * 144) = f2bf(o[mt].y); *(bf16_t*)(ob + (t0 + 2) * 144) = f2bf(o[mt].z); *(bf16_t*)(ob + (t0 + 3) * 144) = f2bf(o[mt].w); }
  };
  __syncthreads();
  u32x4 z0a = {0u, 0u, 0u, 0u}, z0b = z0a, z1a = z0a, z1b = z0a;
  if (wave >= 4) { GS_LOAD(ra, gla, 0); GS_STORE(ra, gla, 0); GS_LOAD(ra, gla, 1); GS_LOAD(rb, glb, 2); zload(0, z0a, z0b); }
  __syncthreads();
#define SCAN_BAR() do { asm volatile("s_waitcnt lgkmcnt(0)" ::: "memory"); __builtin_amdgcn_s_barrier(); asm volatile("" ::: "memory"); } while (0)
  if (wave < 4) {
#pragma unroll 1
    for (int k = 0; k < 64; ++k) { step(k); SCAN_BAR(); }
  } else {
#define GS_LSTEP(R, G, ZA, ZB, kk) do { if ((kk) + 1 < 64) GS_STORE(R, G, ((kk) + 1) & 1); GS_LOAD(R, G, (kk) + 3); if ((kk) > 0) post((kk) - 1, ZA, ZB); if ((kk) + 1 < 64) zload((kk) + 1, ZA, ZB); SCAN_BAR(); } while (0)
#pragma unroll 1
    for (int k = 0; k < 64; k += 2) { GS_LSTEP(ra, gla, z1a, z1b, k); GS_LSTEP(rb, glb, z0a, z0b, k + 1); }
    post(63, z1a, z1b);
#undef GS_LSTEP
  }
#undef SCAN_BAR
#undef GS_LOAD
#undef GS_STORE
}

__device__ __forceinline__ f32x4 bf4(u32x2 p) { return (f32x4){__uint_as_float(p.x << 16), __uint_as_float(p.x & 0xffff0000u), __uint_as_float(p.y << 16), __uint_as_float(p.y & 0xffff0000u)}; }
__device__ void phase_router(const Ctx& c, unsigned char* ldsb) {
  unsigned char* ws = c.ws;
  const int tid = phase_tid(), lane = tid & 63, wave = tid >> 6, fr = lane & 15, fq = lane >> 4;
  float* lg = (float*)(ldsb + wave * 5632);
  const float* bg = c.in[17]; const float* br = c.in[19]; const float* g1 = c.in[14]; const float* b1 = c.in[15];
  const bf16_t* WR = (const bf16_t*)(ws + WS_WR); bf16_t* X1B = (bf16_t*)(ws + WS_X1B);
  unsigned* ctl = (unsigned*)(ws + WS_CTL);
  unsigned* LIST = (unsigned*)(ws + WS_LIST); float* GATEL = (float*)(ws + WS_GATEL); unsigned* TSLOT = (unsigned*)(ws + WS_TSLOT);
  unsigned* cntl = (unsigned*)(ldsb + 46080); unsigned* basel = cntl + 64;
  __syncthreads();
  if (tid < 64) cntl[tid] = 0u;
  __syncthreads();
  for (int tile = blockIdx.x * NWAVES + wave; tile < T / 16; tile += gridDim.x * NWAVES) {
    const int t0 = tile * 16;
    float mean_t = 0.f, rstd_t = 0.f;
#pragma unroll 2
    for (int i = 0; i < 16; ++i) { const u32x2* row = (const u32x2*)(X1B + (size_t)(t0 + i) * 1024);
      f32x4 v[4]; float sm = 0.f;
#pragma unroll
      for (int j = 0; j < 4; ++j) { v[j] = bf4(row[lane + 64 * j]); sm += (v[j].x + v[j].y) + (v[j].z + v[j].w); }
      const float mean = wave_sum(sm) * (1.f / 1024.f); float s2 = 0.f;
#pragma unroll
      for (int j = 0; j < 4; ++j) { v[j] = v[j] - mean; s2 += (v[j].x * v[j].x + v[j].y * v[j].y) + (v[j].z * v[j].z + v[j].w * v[j].w); }
      const float rstd = rsqrtf(wave_sum(s2) * (1.f / 1024.f) + 1e-5f);
      if (fr == i) { mean_t = mean; rstd_t = rstd; } }
    f32x4 acc[5];
#pragma unroll
    for (int nt = 0; nt < 5; ++nt) acc[nt] = (f32x4){0.f, 0.f, 0.f, 0.f};
    bf16_t* xp = X1B + (size_t)(t0 + fr) * 1024 + fq * 8; unsigned char* x8 = ws + WS_X1F + (size_t)(t0 + fr) * 1024 + fq * 8;
#pragma unroll 2
    for (int ks = 0; ks < 32; ++ks) {
      const u32x4 yv = *(const u32x4*)(xp + ks * 32);
      const f32x4 ga = *(const f32x4*)(g1 + ks * 32 + fq * 8), gb2 = *(const f32x4*)(g1 + ks * 32 + fq * 8 + 4), ba = *(const f32x4*)(b1 + ks * 32 + fq * 8), bb2 = *(const f32x4*)(b1 + ks * 32 + fq * 8 + 4);
      const f32x4 y0 = {__uint_as_float(yv.x << 16), __uint_as_float(yv.x & 0xffff0000u), __uint_as_float(yv.y << 16), __uint_as_float(yv.y & 0xffff0000u)};
      const f32x4 y1 = {__uint_as_float(yv.z << 16), __uint_as_float(yv.z & 0xffff0000u), __uint_as_float(yv.w << 16), __uint_as_float(yv.w & 0xffff0000u)};
      const f32x4 n0 = (y0 - mean_t) * rstd_t * ga + ba, n1 = (y1 - mean_t) * rstd_t * gb2 + bb2;
      const u32x4 xw = {cvtpk_c(n0.x, n0.y), cvtpk_c(n0.z, n0.w), cvtpk_c(n1.x, n1.y), cvtpk_c(n1.z, n1.w)};
      *(u32x4*)(xp + ks * 32) = xw;
      *(u32x2*)(x8 + ks * 32) = (u32x2){cvt4_fp8(n0.x, n0.y, n0.z, n0.w), cvt4_fp8(n1.x, n1.y, n1.z, n1.w)};
      const pg8::bf16x8 bx = __builtin_bit_cast(pg8::bf16x8, xw);
#pragma unroll
      for (int nt = 0; nt < 5; ++nt) acc[nt] = __builtin_amdgcn_mfma_f32_16x16x32_bf16(*(const pg8::bf16x8*)(WR + (size_t)(nt * 16 + fr) * 1024 + ks * 32 + fq * 8), bx, acc[nt], 0, 0, 0); }
#pragma unroll
    for (int nt = 0; nt < 5; ++nt) { const int o = nt * 16 + fq * 4; *(f32x4*)(lg + fr * 88 + o) = acc[nt]; }
    asm volatile("s_waitcnt lgkmcnt(0)" ::: "memory");
    int ex1 = 0, ex2 = 0; float gt1 = 0.f, gt2 = 0.f; unsigned lr1 = 0u, lr2 = 0u;
    if (lane < 16) {
      const float* l = lg + lane * 88;
      int grp = 0; float gm = l[0] + bg[0];
      for (int i = 1; i < 8; ++i) { const float v = l[i] + bg[i]; if (v > gm) { gm = v; grp = i; } }
      float gs = 0.f; for (int i = 0; i < 8; ++i) gs += __expf(l[i] + bg[i] - gm);
      const float pgrp = 1.f / gs;
      const float* el = l + 8 + grp * 8; const float* eb = br + grp * 8;
      int i1 = 0; float m1 = el[0] + eb[0]; for (int i = 1; i < 8; ++i) { const float v = el[i] + eb[i]; if (v > m1) { m1 = v; i1 = i; } }
      int i2 = -1; float m2 = -3.0e38f; for (int i = 0; i < 8; ++i) { const float v = el[i] + eb[i]; if (i != i1 && v > m2) { m2 = v; i2 = i; } }
      const float e2 = __expf(m2 - m1), den = 1.f / (1.f + e2);
      gt1 = pgrp * den; gt2 = pgrp * e2 * den;
      ex1 = grp * 8 + i1; ex2 = grp * 8 + i2;
      lr1 = atomicAdd(&cntl[ex1], 1u); lr2 = atomicAdd(&cntl[ex2], 1u);
    }
    __syncthreads();
    if (wave == 0) { const unsigned nloc = cntl[lane]; basel[lane] = nloc ? atomicAdd(&ctl[CW_CNT + lane], nloc) : 0u; }
    __syncthreads();
    if (lane < 16) {
      const int t = t0 + lane; const unsigned r1 = basel[ex1] + lr1, r2 = basel[ex2] + lr2;
      LIST[(size_t)ex1 * 32768 + r1] = (unsigned)t; GATEL[(size_t)ex1 * 32768 + r1] = gt1;
      LIST[(size_t)ex2 * 32768 + r2] = (unsigned)t; GATEL[(size_t)ex2 * 32768 + r2] = gt2;
      TSLOT[(size_t)t * 2 + 0] = ((unsigned)ex1 << 16) | r1; TSLOT[(size_t)t * 2 + 1] = ((unsigned)ex2 << 16) | r2;
    }
    __syncthreads();
    if (tid < 64) cntl[tid] = 0u;
    __syncthreads();
  }
}

__device__ void phase_combine(const Ctx& c, float* lds) {
  unsigned char* ws = c.ws;
  const int tid = phase_tid(), lane = tid & 63, wave = tid >> 6;
  int* offs = (int*)lds; int* cnts = offs + 65;
  expert_offsets(c, offs, cnts, tid);
  const unsigned char* Y = (const unsigned char*)(ws + WS_Y); const unsigned* TSLOT = (const unsigned*)(ws + WS_TSLOT);
  const float* g2 = c.in[23]; const float* b2 = c.in[24];
  for (int t = blockIdx.x * NWAVES + wave; t < T; t += gridDim.x * NWAVES) {
    const unsigned s0 = TSLOT[(size_t)t * 2], s1 = TSLOT[(size_t)t * 2 + 1];
    const size_t r0 = (size_t)offs[s0 >> 16] + (s0 & 0xffffu), r1 = (size_t)offs[s1 >> 16] + (s1 & 0xffffu);
    f32x4* row = (f32x4*)(c.out + (size_t)t * 1024); const u32x2* xrow = (const u32x2*)((const bf16_t*)(ws + WS_X1B) + (size_t)t * 1024);
    f32x4 v[4]; float s = 0.f;
#pragma unroll
    for (int j = 0; j < 4; ++j) { const unsigned ya = ((const unsigned*)(Y + r0 * 1024))[lane + 64 * j], yb = ((const unsigned*)(Y + r1 * 1024))[lane + 64 * j];
      f32x4 x = bf4(xrow[lane + 64 * j]) * ALPHA;
      const hw_f32x2 a01 = __builtin_amdgcn_cvt_pk_f32_fp8(ya, false), a23 = __builtin_amdgcn_cvt_pk_f32_fp8(ya, true), b01 = __builtin_amdgcn_cvt_pk_f32_fp8(yb, false), b23 = __builtin_amdgcn_cvt_pk_f32_fp8(yb, true);
      x.x += (a01.x + b01.x) * 0.015625f; x.y += (a01.y + b01.y) * 0.015625f; x.z += (a23.x + b23.x) * 0.015625f; x.w += (a23.y + b23.y) * 0.015625f;
      v[j] = x; s += (x.x + x.y) + (x.z + x.w); }
    const float mean = wave_sum(s) * (1.f / 1024.f); float s2 = 0.f;
#pragma unroll
    for (int j = 0; j < 4; ++j) { v[j] = v[j] - mean; s2 += (v[j].x * v[j].x + v[j].y * v[j].y) + (v[j].z * v[j].z + v[j].w * v[j].w); }
    const float rstd = rsqrtf(wave_sum(s2) * (1.f / 1024.f) + 1e-5f);
#pragma unroll
    for (int j = 0; j < 4; ++j) { const f32x4 g = ((const f32x4*)g2)[lane + 64 * j], bb = ((const f32x4*)b2)[lane + 64 * j]; row[lane + 64 * j] = v[j] * rstd * g + bb; }
  }
}

constexpr int NPHASE = 11;
__global__ void __launch_bounds__(NTHREADS, 2) mega(Ctx c) {
  float* lds = (float*)lds_raw;
  unsigned* ctl = (unsigned*)(c.ws + WS_CTL);
  unsigned* bar = ctl + CW_BAR;
  if (threadIdx.x == 0) { *(volatile unsigned*)(lds_raw + LDS_WCTR) = 0u; *(volatile unsigned*)(lds_raw + LDS_XBST) = 0u; *(volatile unsigned*)(lds_raw + LDS_XBST + 4) = 0u;
    (void)xb_add(&bar[XB_XCNT(xb_xcc_id())], 1u); }
  __syncthreads();
  phase_prologue(c, lds);
  xcd_barrier(bar);
  phase_inproj_mfma(c, (lds_u8*)lds_raw);
  phase_tiles_queue(c, lds, ctl + CW_Q + 48, TP_WD0 - TP_D1, TP_WD0);
  xcd_barrier(bar);
  phase_gdn_prep2(c, lds_raw);
  phase_kvup(c, lds);
  phase_topk_mfma(c, lds_raw, ctl + CW_Q);
  xcd_barrier(bar);
  if (blockIdx.x < 48) phase_gdn_scan(c, lds_raw, blockIdx.x);
  phase_attn_sparse(c, lds_raw, ctl + CW_Q + 16);
  phase_attn_mem(c, lds_raw, ctl + CW_Q + 32);
  xcd_barrier(bar);
  phase_outproj_mfma(c, (lds_u8*)lds_raw);
  xcd_barrier(bar);
  phase_router(c, lds_raw);
  xcd_barrier(bar);
  phase_moe_up_mfma(c, (lds_u8*)lds_raw);
  phase_tiles_queue(c, lds, ctl + CW_Q + 64, TP_WD0, TP_TOTAL);
  xcd_barrier(bar);
  phase_moe_down_mfma(c, (lds_u8*)lds_raw);
  xcd_barrier(bar);
  phase_combine(c, lds);
}

extern "C" void kernel_launch(void* const* d_in, const int* in_sizes, int n_in, void* d_out, int out_size, void* d_ws, size_t ws_size, hipStream_t stream) {
  static int grid = 0;
  if (grid == 0) {
    if (n_in != 25 || ws_size < WS_END) { fprintf(stderr, "kernel_launch: unexpected n_in %d / ws %zu\n", n_in, ws_size); grid = -1; return; }
    int dev = 0, cus = 0, per_cu = 0;
    hipGetDevice(&dev); hipDeviceGetAttribute(&cus, hipDeviceAttributeMultiprocessorCount, dev);
    hipFuncSetAttribute((const void*)mega, hipFuncAttributeMaxDynamicSharedMemorySize, LDS_BYTES);
    hipOccupancyMaxActiveBlocksPerMultiprocessor(&per_cu, (const void*)mega, NTHREADS, LDS_BYTES);
    if (per_cu < 1) { fprintf(stderr, "kernel_launch: occupancy query says %d blocks/CU\n", per_cu); per_cu = 1; }
    grid = cus * (per_cu < 1 ? 1 : 1);
    (void)hipGetLastError();
  }
  if (grid < 0) return;
  hipMemsetAsync((char*)d_ws + WS_CTL, 0, 32 * 1024, stream);
  Ctx c; memset(&c, 0, sizeof(c));
  for (int i = 0; i < 25; ++i) c.in[i] = (const float*)d_in[i];
  c.out = (float*)d_out; c.ws = (unsigned char*)d_ws;
  hipLaunchKernelGGL(mega, dim3(grid), dim3(NTHREADS), LDS_BYTES, stream, c);
}
```

```cpp
#include <hip/hip_runtime.h>
#include <cstdio>
#include <cstdint>
#include <cstring>

#ifndef ONE_LAUNCH
#define ONE_LAUNCH 1
#endif

typedef unsigned short bf16_t;
typedef float f32x4 __attribute__((ext_vector_type(4)));
typedef unsigned u32x4 __attribute__((ext_vector_type(4)));
typedef unsigned u32x2 __attribute__((ext_vector_type(2)));

constexpr int T = 32768, DM = 1024, SEQ = 4096, NBATCH = 8;
constexpr int NIN = 2816;
constexpr int NMEM = 256, TM = NBATCH * NMEM;
constexpr int NEXP = 64, DE = 256;
constexpr int NTHREADS = 512, NWAVES = 8;
constexpr float ALPHA = 1.189207115002721f;
constexpr float LOG2E = 1.4426950408889634f;
constexpr float QSCALE = 0.125f * LOG2E;

constexpr size_t MiB = 1ull << 20;
constexpr size_t WS_CTL = 0;
constexpr size_t WS_TSLOT = 512 * 1024;
constexpr size_t WS_ROPE = 1 * MiB;
constexpr size_t WS_WKV = 2 * MiB;
constexpr size_t WS_WR = 2 * MiB + 65536;
constexpr size_t WS_WIN = 3 * MiB;
constexpr size_t WS_WO = 9 * MiB;
constexpr size_t WS_WMKV = 11 * MiB;
constexpr size_t WS_MEMB = 12 * MiB;
constexpr size_t WS_WGU = 16 * MiB;
constexpr size_t WS_WD = 80 * MiB;
constexpr size_t WS_XB = 112 * MiB;
constexpr size_t WS_QA = 176 * MiB;
constexpr size_t WS_CKV = 200 * MiB;
constexpr size_t WS_IQ = 208 * MiB;
constexpr size_t WS_IK = 224 * MiB;
constexpr size_t WS_SM = 228 * MiB;
constexpr size_t WS_QC = 230 * MiB;
constexpr size_t WS_GB = 246 * MiB;
constexpr size_t WS_X1F = WS_GB;
constexpr float W8SCALE = 32.f, H8SCALE = 8.f;
constexpr size_t WS_MK = 342 * MiB;
constexpr size_t WS_MVT = 343 * MiB;
constexpr size_t WS_KVA = 344 * MiB;
constexpr size_t WS_SEL = 352 * MiB;
constexpr size_t WS_CAT = 368 * MiB;
constexpr size_t WS_X1B = 432 * MiB;
constexpr size_t WS_LIST = 496 * MiB;
constexpr size_t WS_GATEL = 504 * MiB;
constexpr size_t WS_END = 512 * MiB;
constexpr size_t WS_H = 112 * MiB;
constexpr size_t WS_Y = 160 * MiB;

constexpr int CW_CNT = 0;
constexpr int CW_Q = 64;
constexpr int CW_BAR = 4096;

struct Ctx {
  const float* in[25];
  float* out;
  unsigned char* ws;
  int ph_lo, ph_hi;
};


extern __shared__ __attribute__((aligned(16))) unsigned char lds_raw[];
constexpr int LDS_BYTES = 157696;
constexpr int LDS_WCTR = LDS_BYTES - 64;
__device__ __forceinline__ int phase_tid() {
  __syncthreads();
  int l; asm volatile("v_mbcnt_lo_u32_b32 %0, -1, 0\n\tv_mbcnt_hi_u32_b32 %0, -1, %0" : "=v"(l));
  unsigned w = 0u;
  if (l == 0) w = __hip_atomic_fetch_add((__attribute__((address_space(3))) unsigned*)(__attribute__((address_space(3))) unsigned char*)(lds_raw + LDS_WCTR), 1u, __ATOMIC_RELAXED, __HIP_MEMORY_SCOPE_WORKGROUP);
  w = (unsigned)__builtin_amdgcn_readfirstlane((int)w) & 7u;
  return (int)(w * 64u) + l;
}


#define XB_TMO      128
#define XB_XCNT(j)  (256  + 64 * (j))
#define XB_XSUB(j)  (1280 + 64 * (j))
#define XB_XGEN(j)  (2304 + 64 * (j))
#define XB_TOP      3328
#define XB_TOPGEN   3392
#define XCD_BAR_WORDS 3456
#define XB_SPIN_CAP (1u << 18)
constexpr int LDS_XBST = LDS_BYTES - 32;
__device__ __forceinline__ unsigned xb_ld(unsigned* p)              { return __hip_atomic_load(p, __ATOMIC_RELAXED, __HIP_MEMORY_SCOPE_AGENT); }
__device__ __forceinline__ unsigned xb_add(unsigned* p, unsigned v) { return __hip_atomic_fetch_add(p, v, __ATOMIC_RELAXED, __HIP_MEMORY_SCOPE_AGENT); }
__device__ __forceinline__ unsigned xb_xcc_id() { return (unsigned)__builtin_amdgcn_s_getreg((3 << 11) | 20) & 0xFu; }
#define XB_SPIN(cond, bar) do { unsigned _sp = 0; while (cond) { __builtin_amdgcn_s_sleep(1); \
    if ((++_sp & 255u) == 0u) { if (xb_ld(&(bar)[XB_TMO])) break; if (_sp > XB_SPIN_CAP) { atomicAdd(&(bar)[XB_TMO], 1u); break; } } } } while (0)
__device__ __forceinline__ void xcd_barrier_complete(unsigned* bar, unsigned x, unsigned& nloc, unsigned& nx) {
    const unsigned G = gridDim.x;
    unsigned sum, cnt, mine, sp = 0u;
    for (;;) {
        sum = 0u; cnt = 0u; mine = 0u;
#pragma unroll
        for (unsigned j = 0; j < 16; ++j) { const unsigned cc = xb_ld(&bar[XB_XCNT(j)]); sum += cc; cnt += (cc > 0u) ? 1u : 0u; mine = (j == x) ? cc : mine; }
        if (sum == G) break;
        __builtin_amdgcn_s_sleep(1);
        if ((++sp & 255u) == 0u) { if (xb_ld(&bar[XB_TMO])) break; if (sp > XB_SPIN_CAP) { atomicAdd(&bar[XB_TMO], 1u); break; } }
    }
    nloc = mine > 0u ? mine : 1u; nx = cnt > 0u ? cnt : 1u;
}
__device__ __forceinline__ void xcd_barrier(unsigned* bar) {
    asm volatile("s_waitcnt vmcnt(0)" ::: "memory");
    __syncthreads();
    const int btid = phase_tid();
    if (btid == 0) {
        volatile __attribute__((address_space(3))) unsigned* st = (volatile __attribute__((address_space(3))) unsigned*)(__attribute__((address_space(3))) unsigned char*)(lds_raw + LDS_XBST);
        const unsigned x = xb_xcc_id();
        __builtin_amdgcn_s_waitcnt(0);
        unsigned nloc = st[0], nx = st[1];
        if (nloc == 0u) { xcd_barrier_complete(bar, x, nloc, nx); st[0] = nloc; st[1] = nx; }
        const unsigned old = xb_add(&bar[XB_XSUB(x)], 1u);
        const unsigned gen = old / nloc;
        if (old + 1u == (gen + 1u) * nloc) {
            __builtin_amdgcn_fence(__ATOMIC_RELEASE, "agent");
            asm volatile("s_waitcnt vmcnt(0)" ::: "memory");
            const unsigned og = xb_add(&bar[XB_TOP], 1u);
            const unsigned tg = og / nx;
            if (og + 1u == (tg + 1u) * nx) xb_add(&bar[XB_TOPGEN], 1u);
            else XB_SPIN(xb_ld(&bar[XB_TOPGEN]) == tg, bar);
            __builtin_amdgcn_fence(__ATOMIC_ACQUIRE, "agent");
            xb_add(&bar[XB_XGEN(x)], 1u);
            asm volatile("s_waitcnt vmcnt(0)" ::: "memory");
        } else {
            XB_SPIN(xb_ld(&bar[XB_XGEN(x)]) == gen, bar);
            __builtin_amdgcn_fence(__ATOMIC_ACQUIRE, "agent");
            asm volatile("s_waitcnt vmcnt(0)" ::: "memory");
        }
    }
    __syncthreads();
}

__device__ __forceinline__ float bf2f(bf16_t v) { return __uint_as_float(((unsigned)v) << 16); }
typedef float hw_f32x2 __attribute__((ext_vector_type(2))); typedef __bf16 hw_bf16x2 __attribute__((ext_vector_type(2)));
__device__ __forceinline__ unsigned pk2(float lo, float hi) { const hw_f32x2 v = {lo, hi}; const hw_bf16x2 b = __builtin_convertvector(v, hw_bf16x2); return __builtin_bit_cast(unsigned, b); }
__device__ __forceinline__ unsigned cvt4_fp8(float a, float b, float c2, float d) { int w = __builtin_amdgcn_cvt_pk_fp8_f32(a, b, 0, false); w = __builtin_amdgcn_cvt_pk_fp8_f32(c2, d, w, true); return (unsigned)w; }
__device__ __forceinline__ long mk64(unsigned lo, unsigned hi) { return (long)(((unsigned long)hi << 32) | (unsigned long)lo); }
__device__ __forceinline__ bf16_t f2bf(float f) { return (bf16_t)(pk2(f, f) & 0xffffu); }
__device__ __forceinline__ float wave_sum(float v) {
  int x = __float_as_int(v);
  x = __float_as_int(__int_as_float(x) + __int_as_float(__builtin_amdgcn_update_dpp(0, x, 0x111, 0xF, 0xF, true)));
  x = __float_as_int(__int_as_float(x) + __int_as_float(__builtin_amdgcn_update_dpp(0, x, 0x112, 0xF, 0xF, true)));
  x = __float_as_int(__int_as_float(x) + __int_as_float(__builtin_amdgcn_update_dpp(0, x, 0x114, 0xF, 0xF, true)));
  x = __float_as_int(__int_as_float(x) + __int_as_float(__builtin_amdgcn_update_dpp(0, x, 0x118, 0xF, 0xF, true)));
  x = __float_as_int(__int_as_float(x) + __int_as_float(__builtin_amdgcn_update_dpp(0, x, 0x142, 0xA, 0xF, false)));
  x = __float_as_int(__int_as_float(x) + __int_as_float(__builtin_amdgcn_update_dpp(0, x, 0x143, 0xC, 0xF, false)));
  return __int_as_float(__builtin_amdgcn_readlane(x, 63));
}
__device__ __forceinline__ float wave_max(float v) {
#pragma unroll
  for (int o = 32; o >= 1; o >>= 1) v = fmaxf(v, __shfl_xor(v, o));
  return v;
}
__device__ __forceinline__ float silu_f(float v) { return v * __builtin_amdgcn_rcpf(1.f + __expf(-v)); }

__device__ __forceinline__ int ropeperm(int p) { return (p >> 1) + 32 * (p & 1); }
__device__ __forceinline__ int colmap_in(int cp) {
  const int tile = cp >> 8, w = cp & 255;
  if (tile == 0) return (w >> 6) * 64 + ropeperm(w & 63);
  if (tile == 1) { if (w < 128) { const int c = 256 + w; return (c >> 6) * 64 + ropeperm(c & 63); } return 384 + (w - 128); }
  if (tile == 2) return 512 + (w >> 6) * 64 + ropeperm(w & 63);
  if (tile == 3) { if (w < 64) return 768 + ropeperm(w); if (w < 68) return 832 + (w - 64); if (w < 74) return 2372 + (w - 68); if (w < 80) return 2378 + (w - 74); return -1; }
  if (tile == 4) return 2384 + w;
  return 836 + (cp - 1280);
}

struct WorkQ { unsigned* head; volatile int* slot; int nxt; };
__device__ __forceinline__ void wq_init(WorkQ& q, unsigned* head, volatile int* slot, int tid) { q.head = head; q.slot = slot; q.nxt = 0; if (tid == 0) q.nxt = (int)atomicAdd(head, 1u); }
__device__ __forceinline__ int wq_next(WorkQ& q, int tid) {
  __syncthreads();
  if (tid == 0) { *q.slot = q.nxt; q.nxt = (int)atomicAdd(q.head, 1u); }
  __syncthreads();
  return *q.slot;
}

template <bool F8 = false, class CM>
__device__ __forceinline__ void tp_tile(const float* src, int ld, bf16_t* dst, int drow0, int K, int k0, CM cm, float* lds, int tid, float sc8 = 1.f) {
  const int a = tid & 63, b = tid >> 6;
  const int sc = cm(a);
  __syncthreads();
#pragma unroll
  for (int i = 0; i < 8; ++i) { const int kk = b * 8 + i; lds[kk * 65 + a] = sc >= 0 ? src[(size_t)(k0 + kk) * ld + sc] : 0.f; }
  __syncthreads();
  { const int nn = tid >> 3, kc = (tid & 7) * 8;
    const float* p = lds + kc * 65 + nn;
    if constexpr (F8) *(u32x2*)((unsigned char*)dst + (size_t)(drow0 + nn) * K + k0 + kc) = (u32x2){cvt4_fp8(p[0] * sc8, p[65] * sc8, p[130] * sc8, p[195] * sc8), cvt4_fp8(p[260] * sc8, p[325] * sc8, p[390] * sc8, p[455] * sc8)};
    else *(u32x4*)(dst + (size_t)(drow0 + nn) * K + k0 + kc) = (u32x4){pk2(p[0], p[65]), pk2(p[130], p[195]), pk2(p[260], p[325]), pk2(p[390], p[455])}; }
}

constexpr int TP_TOTAL = (NIN / 64) * 16 + 16 * 16 + 8 * 16 + 64 * 8 * 16 + 64 * 16 * 4;
constexpr int TP_WD0 = TP_TOTAL - 64 * 16 * 4;
constexpr int TP_D1 = 5200;
__device__ __forceinline__ void prologue_tiles(const Ctx& c, float* lds, int tid, int lo, int hi, int b0, int nb) {
  unsigned char* ws = c.ws;
  const int n_win = (NIN / 64) * 16, n_wo = 16 * 16, n_wmkv = 8 * 16, n_wgu = 64 * 8 * 16, n_wd = 64 * 16 * 4;
  const int total = n_win + n_wo + n_wmkv + n_wgu + n_wd;
  for (int it = lo + b0; it < hi; it += nb) {
    int r = it;
    if (r < n_win) { const int nt = r / 16, kt = r % 16; tp_tile(c.in[2], 2640, (bf16_t*)(ws + WS_WIN), nt * 64, 1024, kt * 64, [&](int a) { return colmap_in(nt * 64 + a); }, lds, tid); continue; } r -= n_win;
    if (r < n_wo) { const int nt = r / 16, kt = r % 16; tp_tile<true>(c.in[13], 1024, (bf16_t*)(ws + WS_WO), nt * 64, 1024, kt * 64, [&](int a) { return nt * 64 + a; }, lds, tid, W8SCALE); continue; } r -= n_wo;
    if (r < n_wmkv) { const int nt = r / 16, kt = r % 16; tp_tile(c.in[12], 512, (bf16_t*)(ws + WS_WMKV), nt * 64, 1024, kt * 64, [&](int a) { return nt * 64 + a; }, lds, tid); continue; } r -= n_wmkv;
    if (r < n_wgu) { const int e = r / 128, q = r % 128, nt = q / 16, kt = q % 16;
      const int pn = nt >> 2, sub = nt & 3, isup = sub >> 1, c0 = pn * 128 + (sub & 1) * 64;
      const float* src = (isup ? c.in[21] : c.in[20]) + (size_t)e * 1024 * 256;
      tp_tile<true>(src, 256, (bf16_t*)(ws + WS_WGU), e * 512 + nt * 64, 1024, kt * 64, [&](int a) { return c0 + a; }, lds, tid, W8SCALE); continue; } r -= n_wgu;
    { const int e = r / 64, q = r % 64, nt = q / 4, kt = q % 4;
      tp_tile<true>(c.in[22] + (size_t)e * 256 * 1024, 1024, (bf16_t*)(ws + WS_WD), e * 1024 + nt * 64, 256, kt * 64, [&](int a) { return nt * 64 + a; }, lds, tid, W8SCALE); }
  }
}

__device__ void phase_tiles_queue(const Ctx& c, float* lds, unsigned* qhead, int lo, int hi) {
  const int tid = phase_tid();
  volatile int* slot = (volatile int*)(lds + 64 * 65 + 16);
  WorkQ wq; wq_init(wq, qhead, slot, tid);
  const int nitems = (hi - lo + 7) >> 3;
  for (;;) {
    const int item = wq_next(wq, tid);
    if (item >= nitems) break;
    const int t0 = lo + item * 8, t1 = t0 + 8 < hi ? t0 + 8 : hi;
    prologue_tiles(c, lds, tid, t0, t1, 0, 1);
  }
}

__device__ void phase_prologue(const Ctx& c, float* lds) {
  const int tid = phase_tid(), bid = blockIdx.x, G = gridDim.x;
  unsigned char* ws = c.ws;
  const size_t gtid = (size_t)bid * NTHREADS + tid, gstride = (size_t)G * NTHREADS;
  { const f32x4* x4 = (const f32x4*)c.in[0]; u32x2* o = (u32x2*)c.out;
    for (size_t i = gtid; i < (size_t)T * DM / 4; i += gstride) { const f32x4 v = x4[i]; o[i] = (u32x2){pk2(v.x, v.y), pk2(v.z, v.w)}; }
    const f32x4* m4 = (const f32x4*)c.in[1]; u32x2* om = (u32x2*)(ws + WS_MEMB);
    for (size_t i = gtid; i < (size_t)TM * DM / 4; i += gstride) { const f32x4 v = m4[i]; om[i] = (u32x2){pk2(v.x, v.y), pk2(v.z, v.w)}; } }
  { float* cs = (float*)(ws + WS_ROPE); float* sn = cs + SEQ * 32;
    for (size_t i = gtid; i < (size_t)SEQ * 32; i += gstride) { const int s = (int)(i >> 5), d = (int)(i & 31);
      const float inv = 1.0f / powf(10000.0f, (float)d / 32.0f); const float ang = (float)s * inv; float sv, cv; sincosf(ang, &sv, &cv); cs[i] = cv; sn[i] = sv; } }
  { bf16_t* wkv = (bf16_t*)(ws + WS_WKV); const float* g = c.in[3]; const float* wk = c.in[4]; const float* wv = c.in[5];
    for (size_t i = gtid; i < 128 * 128; i += gstride) { const int p = (int)(i >> 7), k = (int)(i & 127);
      const float w = p < 64 ? wk[k * 64 + ropeperm(p)] : wv[k * 64 + (p - 64)]; wkv[i] = f2bf(w * g[k]); }
    bf16_t* wr = (bf16_t*)(ws + WS_WR); const float* wg = c.in[16]; const float* wrt = c.in[18];
    for (size_t i = gtid; i < 80 * 1024; i += gstride) { const int o = (int)(i >> 10), k = (int)(i & 1023); wr[i] = f2bf(o < 8 ? wg[k * 8 + o] : o < 72 ? wrt[k * 64 + (o - 8)] : 0.f); } }
  prologue_tiles(c, lds, tid, 0, TP_WD0 - TP_D1, bid, G);
}

__device__ __forceinline__ void expert_offsets(const Ctx& c, int* offs  , int* cnts  , int tid) {
  const unsigned* ctl = (const unsigned*)(c.ws + WS_CTL);
  __syncthreads();
  if (tid == 0) { int o = 0; for (int e = 0; e < 64; ++e) { const int n = (int)ctl[CW_CNT + e]; cnts[e] = n; offs[e] = o; o += (n + 255) & ~255; } offs[64] = o; }
  __syncthreads();
}


namespace pg8 {
#define PG8_LAS __attribute__((address_space(3)))
typedef short bf16x8 __attribute__((ext_vector_type(8)));
constexpr int BM = 256, BK = 64, HALF = 128, HTB = HALF * BK * 2, STAGE_BYTES = 8 * HTB, NXCD = 8, WGM = 8, GN_STASH = STAGE_BYTES + 2048;
typedef unsigned u32x4s __attribute__((ext_vector_type(4)));
__host__ __device__ __forceinline__ int lds_byte(int r, int c) { const int st = (r >> 4) * 2 + (c >> 5), rr = r & 15, cc = c & 31, ob = rr * 64 + cc * 2; return st * 1024 + (ob ^ (((ob >> 9) & 1) << 5)); }
__host__ __device__ __forceinline__ void stage_rc(int b, int& R, int& C) { const int st = b / 1024, sb = b % 1024, swz = sb ^ (((sb >> 9) & 1) << 5); R = (st >> 1) * 16 + swz / 64; C = (st & 1) * 32 + (swz % 64) / 2; }
__host__ __device__ __forceinline__ int perm32(int rho) { const int n = rho >> 4, i = rho & 15; return 8 * (i >> 2) + 4 * n + (i & 3); }
typedef int i32x4v __attribute__((ext_vector_type(4))); typedef int i32x8 __attribute__((ext_vector_type(8))); typedef long i64x2 __attribute__((ext_vector_type(2)));
struct Unit { int pm, pn, e, mt, aux; };
struct Gemm { const bf16_t* A; const bf16_t* Bt; int K; };
struct StaticOrder {
    int nM, nN, nwg, G, c;
    __device__ void init(int M, int N, int G_, int c_) { nM = M / BM; nN = N / BM; nwg = nM * nN; G = G_; c = c_; }
    __device__ bool next(int i, Unit& u) const {
        const long L = (long)i * G + c; if (c < 0 || L >= nwg) return false;
        int wgid = (int)L; { const int q = nwg / NXCD, r = nwg % NXCD, xcd = wgid % NXCD, off = wgid / NXCD; wgid = (xcd < r ? xcd * (q + 1) : r * (q + 1) + (xcd - r) * q) + off; }
        const int nig = WGM * nN, gid = wgid / nig, fm = gid * WGM, gsz = (nM - fm) < WGM ? (nM - fm) : WGM;
        u.pm = fm + ((wgid % nig) % gsz); u.pn = (wgid % nig) / gsz; u.e = 0; u.mt = 0; u.aux = 0; return true;
    }
    __device__ __forceinline__ unsigned arow(const Unit&, int) const { return 0u; }
};
__device__ __forceinline__ unsigned cvt_pk_bf16(float lo, float hi) { unsigned r; asm volatile("v_cvt_pk_bf16_f32 %0, %1, %2" : "=v"(r) : "v"(lo), "v"(hi)); return r; }

template <class Epi, class Sched, bool ALIGN_EPI, bool GATHER, int FP8 = 0, bool BUF = false>
__device__ __forceinline__ void gemm_phase(PG8_LAS unsigned char* lds, const Gemm g, const Sched& S, const Epi& E, const int tid) {
    const int wid = __builtin_amdgcn_readfirstlane(tid >> 6), lane = tid & 63, wr = wid >> 2, wc = wid & 3, fr = lane & 15, fq = lane >> 4;
    const int K = g.K, nt = K / BK;
    unsigned voffA[2], voffB[2]; int RA[2], CA[2];
#pragma unroll
    for (int i = 0; i < 2; ++i) { int R, C; stage_rc(tid * 16 + i * 8192, R, C); const int Rb = Epi::PERM ? ((R & ~31) + perm32(R & 31)) : R;
        RA[i] = R; CA[i] = C; voffA[i] = (unsigned)(R * K + C) * 2u; voffB[i] = (unsigned)(Rb * K + C) * 2u; }
    const size_t kstep = (size_t)(BK * 2);
    const size_t hstep = (size_t)HALF * K * 2;
    const size_t tstep = 2 * hstep;
    const unsigned ldsw = (unsigned)wid * 1024u;
    const int aoff = lds_byte(wr * 64 + fr, fq * 8), boff = lds_byte(wc * 32 + fr, fq * 8);
#define PG8_FRESH_TID() ([&]() { int l_; asm volatile("v_mbcnt_lo_u32_b32 %0, -1, 0\n\tv_mbcnt_hi_u32_b32 %0, -1, %0" : "=v"(l_)); return wid * 64 + l_; }())
#define PG8_SA(b, h) (((b) * 2 + (h)) * HTB)
#define PG8_SB(b, h) ((4 + (b) * 2 + (h)) * HTB)
    const __amdgpu_buffer_rsrc_t rsA = __builtin_amdgcn_make_buffer_rsrc((void*)g.A, 0, -1, 0x00020000), rsB = __builtin_amdgcn_make_buffer_rsrc((void*)g.Bt, 0, -1, 0x00020000);
#define PG8_STAGE_X(rs, base0, bufoff, gbase, voff) do { _Pragma("unroll") for (int _i = 0; _i < 2; ++_i) { \
        if constexpr (BUF) __builtin_amdgcn_raw_ptr_buffer_load_lds(rs, (PG8_LAS void*)(lds + (bufoff) + ldsw + _i * 8192), 16, (int)(voff)[_i], (int)(unsigned)((const char*)(gbase) - (const char*)(base0)), 0, 0); \
        else __builtin_amdgcn_global_load_lds((const unsigned*)((const char*)(gbase) + (voff)[_i]), (PG8_LAS unsigned*)(lds + (bufoff) + ldsw + _i * 8192), 16, 0, 0); } } while (0)
#define PG8_STAGE(bufoff, gbase, voff) PG8_STAGE_X(rsB, g.Bt, bufoff, gbase, voff)
#define PG8_STAGE_A(bufoff, gbase, h, goff) do { if constexpr (GATHER) { PG8_STAGE_X(rsA, g.A, bufoff, gbase, (goff)[h]); } else { PG8_STAGE_X(rsA, g.A, bufoff, (gbase) + (h) * hstep, voffA); } } while (0)
#define PG8_LDA(dst, b, h) do { _Pragma("unroll") for (int m = 0; m < 4; ++m) _Pragma("unroll") for (int k = 0; k < 2; ++k) dst[m][k] = *(const PG8_LAS bf16x8*)(lds + PG8_SA(b, h) + aoff + m * 2048 + k * 1024); } while (0)
#define PG8_LDB(dst, b, h) do { _Pragma("unroll") for (int n = 0; n < 2; ++n) _Pragma("unroll") for (int k = 0; k < 2; ++k) dst[n][k] = *(const PG8_LAS bf16x8*)(lds + PG8_SB(b, h) + boff + n * 2048 + k * 1024); } while (0)
#define PG8_MMA(ai, bj, At, Bt) do { __builtin_amdgcn_s_setprio(1); \
        if constexpr (FP8 == 2) { _Pragma("unroll") for (int m = 0; m < 4; ++m) _Pragma("unroll") for (int n = 0; n < 2; ++n) { \
            const i32x8 b_ = __builtin_shufflevector(__builtin_bit_cast(i32x4v, Bt[n][0]), __builtin_bit_cast(i32x4v, Bt[n][1]), 0, 1, 2, 3, 4, 5, 6, 7), a_ = __builtin_shufflevector(__builtin_bit_cast(i32x4v, At[m][0]), __builtin_bit_cast(i32x4v, At[m][1]), 0, 1, 2, 3, 4, 5, 6, 7); \
            acc[ai][bj][m][n] = __builtin_amdgcn_mfma_scale_f32_16x16x128_f8f6f4(b_, a_, acc[ai][bj][m][n], 0, 0, 0, 0, 0, 0); } } \
        else if constexpr (FP8 == 1) { _Pragma("unroll") for (int k = 0; k < 2; ++k) _Pragma("unroll") for (int hf = 0; hf < 2; ++hf) _Pragma("unroll") for (int m = 0; m < 4; ++m) _Pragma("unroll") for (int n = 0; n < 2; ++n) { \
            const i64x2 b_ = __builtin_bit_cast(i64x2, Bt[n][k]), a_ = __builtin_bit_cast(i64x2, At[m][k]); \
            acc[ai][bj][m][n] = __builtin_amdgcn_mfma_f32_16x16x32_fp8_fp8(b_[hf], a_[hf], acc[ai][bj][m][n], 0, 0, 0); } } \
        else { _Pragma("unroll") for (int m = 0; m < 4; ++m) _Pragma("unroll") for (int n = 0; n < 2; ++n) _Pragma("unroll") for (int k = 0; k < 2; ++k) \
            acc[ai][bj][m][n] = __builtin_amdgcn_mfma_f32_16x16x32_bf16(Bt[n][k], At[m][k], acc[ai][bj][m][n], 0, 0, 0); } \
        __builtin_amdgcn_s_setprio(0); } while (0)
#define PG8_WAIT_V(n) asm volatile("s_waitcnt vmcnt(" #n ")" ::: "memory")
#define PG8_WAIT_L(n) asm volatile("s_waitcnt lgkmcnt(" #n ")" ::: "memory")
#define PG8_BAR __builtin_amdgcn_s_barrier()
#define PG8_SCHED __builtin_amdgcn_sched_barrier(0)
    Unit cur, nxt; int ui = 0;
    if (!S.next(0, cur)) return;
    f32x4 acc[2][2][4][2];
#pragma unroll
    for (int a = 0; a < 2; ++a)
#pragma unroll
        for (int b = 0; b < 2; ++b)
#pragma unroll
            for (int m = 0; m < 4; ++m)
#pragma unroll
                for (int n = 0; n < 2; ++n) acc[a][b][m][n] = (f32x4){0.f, 0.f, 0.f, 0.f};
    bf16x8 At[4][2], B0[2][2], B1[2][2];
    unsigned gc[2][2], gn[2][2];
    const char* cA; const char* cB = (const char*)g.Bt + (size_t)cur.pn * tstep;
    if constexpr (GATHER) { cA = (const char*)g.A;
#pragma unroll
        for (int h = 0; h < 2; ++h)
#pragma unroll
            for (int i = 0; i < 2; ++i) { gc[h][i] = (S.arow(cur, h * HALF + RA[i]) * (unsigned)K + (unsigned)CA[i]) * 2u; gn[h][i] = gc[h][i]; }
    } else { cA = (const char*)g.A + (size_t)cur.pm * tstep; }
    PG8_STAGE(PG8_SB(0, 0), cB, voffB); PG8_STAGE(PG8_SB(0, 1), cB + hstep, voffB); PG8_STAGE_A(PG8_SA(0, 0), cA, 0, gc); PG8_STAGE_A(PG8_SA(0, 1), cA, 1, gc);
    if (wr == 1) PG8_BAR;
    PG8_WAIT_V(2); PG8_BAR;
    PG8_STAGE(PG8_SB(1, 0), cB + kstep, voffB); PG8_STAGE_A(PG8_SA(1, 0), cA + kstep, 0, gc); PG8_STAGE(PG8_SB(1, 1), cB + hstep + kstep, voffB);
    PG8_WAIT_V(6); PG8_BAR;
    for (;;) {
        const bool has_next = S.next(ui + 1, nxt);
        const char* nA; const char* nB = has_next ? (const char*)g.Bt + (size_t)nxt.pn * tstep : cB;
        if constexpr (GATHER) { nA = cA;
            if (has_next) {
#pragma unroll
                for (int h = 0; h < 2; ++h)
#pragma unroll
                    for (int i = 0; i < 2; ++i) { int R_ = RA[i], C_ = CA[i]; if constexpr (BUF) { const int t2 = PG8_FRESH_TID(); stage_rc(t2 * 16 + i * 8192, R_, C_); }
                        gn[h][i] = (S.arow(nxt, h * HALF + R_) * (unsigned)K + (unsigned)C_) * 2u; }
                if constexpr (BUF) { *(PG8_LAS u32x4s*)(lds + GN_STASH + PG8_FRESH_TID() * 16) = (u32x4s){gn[0][0], gn[0][1], gn[1][0], gn[1][1]}; } }
        } else { nA = has_next ? (const char*)g.A + (size_t)nxt.pm * tstep : cA; }
        unsigned g2[2][2];
#pragma unroll 1
        for (int t = 0; t < nt; t += 2) {
            const bool last = (t == nt - 2);
            const char* a1 = cA + (size_t)(t + 1) * kstep;
            const char* a2 = last ? nA : cA + (size_t)(t + 2) * kstep; const char* b2 = last ? nB : cB + (size_t)(t + 2) * kstep;
            const char* a3 = a2 + kstep; const char* b3 = b2 + kstep;
            if constexpr (GATHER) {
              if constexpr (BUF) {
                if (last && has_next) { const u32x4s v_ = *(const PG8_LAS u32x4s*)(lds + GN_STASH + PG8_FRESH_TID() * 16); g2[0][0] = v_.x; g2[0][1] = v_.y; g2[1][0] = v_.z; g2[1][1] = v_.w; }
                else { g2[0][0] = gc[0][0]; g2[0][1] = gc[0][1]; g2[1][0] = gc[1][0]; g2[1][1] = gc[1][1]; }
              } else {
#pragma unroll
            for (int h = 0; h < 2; ++h)
#pragma unroll
                for (int i = 0; i < 2; ++i) g2[h][i] = last ? gn[h][i] : gc[h][i]; } }
            PG8_LDB(B0, 0, 0); PG8_LDB(B1, 0, 1); PG8_SCHED; PG8_LDA(At, 0, 0); PG8_STAGE_A(PG8_SA(1, 1), a1, 1, gc);
            PG8_WAIT_V(8); PG8_WAIT_L(0); PG8_BAR; PG8_MMA(0, 0, At, B0); PG8_MMA(0, 1, At, B1); PG8_BAR; PG8_SCHED;
            PG8_LDA(At, 0, 1); PG8_STAGE(PG8_SB(0, 0), b2, voffB); PG8_STAGE(PG8_SB(0, 1), b2 + hstep, voffB); PG8_STAGE_A(PG8_SA(0, 0), a2, 0, g2);
            PG8_WAIT_V(8); PG8_WAIT_L(0); PG8_BAR; PG8_MMA(1, 0, At, B0); PG8_MMA(1, 1, At, B1); PG8_BAR; PG8_SCHED;
            PG8_LDB(B0, 1, 0); PG8_LDB(B1, 1, 1); PG8_SCHED; PG8_LDA(At, 1, 0); PG8_STAGE_A(PG8_SA(0, 1), a2, 1, g2);
            PG8_WAIT_V(8); PG8_WAIT_L(0); PG8_BAR; PG8_MMA(0, 0, At, B0); PG8_MMA(0, 1, At, B1); PG8_BAR; PG8_SCHED;
            PG8_LDA(At, 1, 1); PG8_STAGE(PG8_SB(1, 0), b3, voffB); PG8_STAGE(PG8_SB(1, 1), b3 + hstep, voffB); PG8_STAGE_A(PG8_SA(1, 0), a3, 0, g2);
            PG8_WAIT_V(8); PG8_WAIT_L(0); PG8_BAR; PG8_MMA(1, 0, At, B0); PG8_MMA(1, 1, At, B1); PG8_BAR; PG8_SCHED;
        }
        if constexpr (ALIGN_EPI) { if (wr == 0) PG8_BAR; }
        if constexpr (BUF) { const int l2 = PG8_FRESH_TID(); E(acc, cur, wr, wc, l2 & 15, (l2 >> 4) & 3); }
        else E(acc, cur, wr, wc, fr, fq);
        if (!has_next) break;
#pragma unroll
        for (int a = 0; a < 2; ++a)
#pragma unroll
            for (int b = 0; b < 2; ++b)
#pragma unroll
                for (int m = 0; m < 4; ++m)
#pragma unroll
                    for (int n = 0; n < 2; ++n) acc[a][b][m][n] = (f32x4){0.f, 0.f, 0.f, 0.f};
        cur = nxt; cA = nA; cB = nB; ++ui;
        if constexpr (GATHER) {
#pragma unroll
        for (int h = 0; h < 2; ++h)
#pragma unroll
            for (int i = 0; i < 2; ++i) gc[h][i] = BUF ? g2[h][i] : gn[h][i]; }
        if constexpr (ALIGN_EPI) { if (wr == 1) PG8_BAR; }
    }
    PG8_WAIT_V(0);
    if constexpr (!ALIGN_EPI) { if (wr == 0) PG8_BAR; }
    PG8_BAR;
#undef PG8_SA
#undef PG8_FRESH_TID
#undef PG8_SB
#undef PG8_STAGE
#undef PG8_STAGE_X
#undef PG8_STAGE_A
#undef PG8_LDA
#undef PG8_LDB
#undef PG8_MMA
#undef PG8_WAIT_V
#undef PG8_WAIT_L
#undef PG8_BAR
#undef PG8_SCHED
}
}
typedef __attribute__((address_space(3))) unsigned char lds_u8;

__device__ __forceinline__ u32x4 pack8(const f32x4& a, const f32x4& b) { return (u32x4){pg8::cvt_pk_bf16(a.x, a.y), pg8::cvt_pk_bf16(a.z, a.w), pg8::cvt_pk_bf16(b.x, b.y), pg8::cvt_pk_bf16(b.z, b.w)}; }
struct EpiInM {
  static constexpr bool PERM = true;
  unsigned char* ws;
  __device__ __forceinline__ void operator()(const f32x4 (&acc)[2][2][4][2], const pg8::Unit& u, int wr, int wc, int fr, int fq) const {
    const float* cs = (const float*)(ws + WS_ROPE); const float* sn = cs + SEQ * 32;
    const int pn = u.pn;
#pragma unroll
    for (int ai = 0; ai < 2; ++ai)
#pragma unroll
      for (int m = 0; m < 4; ++m) {
        const int row = u.pm * 256 + ai * 128 + wr * 64 + m * 16 + fr, pos = row & (SEQ - 1);
#pragma unroll
        for (int bj = 0; bj < 2; ++bj) {
          const int w = bj * 128 + wc * 32 + 8 * fq;
          f32x4 v0 = acc[ai][bj][m][0], v1 = acc[ai][bj][m][1];
          const bool do_rope = (pn == 0) || (pn == 1 && bj == 0) || (pn == 2) || (pn == 3 && bj == 0 && wc < 2);
          if (do_rope) { const int d = (w & 63) >> 1; const f32x4 c4 = *(const f32x4*)(cs + pos * 32 + d), s4 = *(const f32x4*)(sn + pos * 32 + d);
            const f32x4 o0 = {v0.x * c4.x - v0.y * s4.x, v0.y * c4.x + v0.x * s4.x, v0.z * c4.y - v0.w * s4.y, v0.w * c4.y + v0.z * s4.y};
            const f32x4 o1 = {v1.x * c4.z - v1.y * s4.z, v1.y * c4.z + v1.x * s4.z, v1.z * c4.w - v1.w * s4.w, v1.w * c4.w + v1.z * s4.w};
            v0 = o0; v1 = o1; }
          if (pn == 0) { *(u32x4*)((bf16_t*)(ws + WS_QA) + (size_t)row * 384 + w) = pack8(v0 * QSCALE, v1 * QSCALE); }
          else if (pn == 1) { if (bj == 0) *(u32x4*)((bf16_t*)(ws + WS_QA) + (size_t)row * 384 + 256 + w) = pack8(v0 * QSCALE, v1 * QSCALE);
                              else *(u32x4*)((bf16_t*)(ws + WS_CKV) + (size_t)row * 128 + (w - 128)) = pack8(v0, v1); }
          else if (pn == 2) { *(u32x4*)((bf16_t*)(ws + WS_IQ) + (size_t)row * 256 + w) = pack8(v0, v1); }
          else if (pn == 3) { if (bj == 0) { if (wc < 2) *(u32x4*)((bf16_t*)(ws + WS_IK) + (size_t)row * 64 + w) = pack8(v0, v1);
                                             else if (wc == 2 && fq < 2) { if (fq == 0) v0 = v0 * 0.0625f; float* o = (float*)(ws + WS_SM) + (size_t)row * 16 + 8 * fq; *(f32x4*)o = v0; *(f32x4*)(o + 4) = v1; } } }
          else if (pn == 4) { *(u32x4*)((bf16_t*)(ws + WS_QC) + (size_t)row * 256 + w) = pack8(v0 * QSCALE, v1 * QSCALE); }
          else { *(u32x4*)((bf16_t*)(ws + WS_GB) + (size_t)row * 1536 + (pn - 5) * 256 + w) = pack8(v0, v1); }
        }
      }
  }
};
__device__ __forceinline__ unsigned pk4_fp8(const f32x4& v) { unsigned w = __builtin_amdgcn_cvt_pk_fp8_f32(v.x, v.y, 0u, false); return __builtin_amdgcn_cvt_pk_fp8_f32(v.z, v.w, w, true); }
struct EpiMemKVM {
  static constexpr bool PERM = true;
  unsigned char* ws;
  __device__ __forceinline__ void operator()(const f32x4 (&acc)[2][2][4][2], const pg8::Unit& u, int wr, int wc, int fr, int fq) const {
#pragma unroll
    for (int ai = 0; ai < 2; ++ai)
#pragma unroll
      for (int m = 0; m < 4; ++m) {
        const int row = u.pm * 256 + ai * 128 + wr * 64 + m * 16 + fr;
#pragma unroll
        for (int bj = 0; bj < 2; ++bj) {
          const int w = bj * 128 + wc * 32 + 8 * fq; const f32x4 v0 = acc[ai][bj][m][0], v1 = acc[ai][bj][m][1];
          const unsigned w0 = pk4_fp8(v0), w1 = pk4_fp8(v1);
          if (u.pn == 0) *(u32x2*)(ws + WS_MK + (size_t)row * 256 + w) = (u32x2){w0, w1};
          else { const int mem = row & 255, xx = mem & 31, mpos = (mem & ~31) + 8 * ((xx >> 2) & 3) + (xx & 3) + 4 * (xx >> 4);
            unsigned char* o = ws + WS_MVT + ((size_t)(row >> 8) * 256 + w) * 256 + mpos;
            o[0] = (unsigned char)w0; o[256] = (unsigned char)(w0 >> 8); o[512] = (unsigned char)(w0 >> 16); o[768] = (unsigned char)(w0 >> 24); o[1024] = (unsigned char)w1; o[1280] = (unsigned char)(w1 >> 8); o[1536] = (unsigned char)(w1 >> 16); o[1792] = (unsigned char)(w1 >> 24); }
        }
      }
  }
};
struct EpiOutM {
  static constexpr bool PERM = true;
  const bf16_t* x; bf16_t* y;
  __device__ __forceinline__ void operator()(const f32x4 (&acc)[2][2][4][2], const pg8::Unit& u, int wr, int wc, int fr, int fq) const {
#pragma unroll
    for (int ai = 0; ai < 2; ++ai)
#pragma unroll
      for (int m = 0; m < 4; ++m) {
        const size_t rb = (size_t)(u.pm * 256 + ai * 128 + wr * 64 + m * 16 + fr) * 1024 + u.pn * 256 + wc * 32 + 8 * fq;
#pragma unroll
        for (int bj = 0; bj < 2; ++bj) { const size_t o = rb + bj * 128; const u32x4 xv = *(const u32x4*)(x + o);
          const f32x4 x0 = {__uint_as_float(xv.x << 16), __uint_as_float(xv.x & 0xffff0000u), __uint_as_float(xv.y << 16), __uint_as_float(xv.y & 0xffff0000u)};
          const f32x4 x1 = {__uint_as_float(xv.z << 16), __uint_as_float(xv.z & 0xffff0000u), __uint_as_float(xv.w << 16), __uint_as_float(xv.w & 0xffff0000u)};
          *(u32x4*)(y + o) = pack8(x0 * ALPHA + acc[ai][bj][m][0] * (1.f / W8SCALE), x1 * ALPHA + acc[ai][bj][m][1] * (1.f / W8SCALE)); }
      }
  }
};
struct MoeOrder {
  const int* offs; const int* cnts; int npn, G, c; const unsigned* LIST;
  __device__ __forceinline__ bool next(int i, pg8::Unit& u) const {
    const int* offs = this->offs; asm volatile("" : "+s"(offs));
    const int L = i * G + c; const int ntiles = __builtin_amdgcn_readfirstlane(offs[64]) >> 8;
    if (L >= ntiles * npn) return false;
    const int rt = L / npn, pl = L - rt * npn; int e = 0;
    while (__builtin_amdgcn_readfirstlane(offs[e + 1]) <= rt * 256) ++e;
    u.pm = rt; u.mt = rt - (__builtin_amdgcn_readfirstlane(offs[e]) >> 8); u.e = e; u.pn = e * npn + pl; u.aux = __builtin_amdgcn_readfirstlane(cnts[e]); return true;
  }
  __device__ __forceinline__ unsigned arow(const pg8::Unit& u, int r) const { const int rank = u.mt * 256 + r; return rank < u.aux ? LIST[(size_t)u.e * 32768 + rank] : 0u; }
};
struct EpiMoeUpM {
  static constexpr bool PERM = true;
  unsigned char* H;
  __device__ __forceinline__ void operator()(const f32x4 (&acc)[2][2][4][2], const pg8::Unit& u, int wr, int wc, int fr, int fq) const {
    const int pl = u.pn & 1;
    int fr_ = fr, fq_ = fq; asm volatile("" : "+v"(fr_), "+v"(fq_));
#pragma unroll
    for (int ai = 0; ai < 2; ++ai)
#pragma unroll
      for (int m = 0; m < 4; ++m) {
        const int rl = ai * 128 + wr * 64 + m * 16 + fr_;
        if (u.mt * 256 + rl < u.aux) {
          f32x4 h0, h1; const float is = 1.f / W8SCALE, us = H8SCALE / W8SCALE; const f32x4 g0 = acc[ai][0][m][0] * is, g1 = acc[ai][0][m][1] * is, u0 = acc[ai][1][m][0] * us, u1 = acc[ai][1][m][1] * us;
          h0.x = silu_f(g0.x) * u0.x; h0.y = silu_f(g0.y) * u0.y; h0.z = silu_f(g0.z) * u0.z; h0.w = silu_f(g0.w) * u0.w;
          h1.x = silu_f(g1.x) * u1.x; h1.y = silu_f(g1.y) * u1.y; h1.z = silu_f(g1.z) * u1.z; h1.w = silu_f(g1.w) * u1.w;
          *(u32x2*)(H + (size_t)(u.pm * 256 + rl) * 256 + pl * 128 + wc * 32 + 8 * fq_) = (u32x2){pk4_fp8(h0), pk4_fp8(h1)};
        }
      }
  }
};
struct EpiMoeDownM {
  static constexpr bool PERM = true;
  unsigned char* Y; const float* GATEL;
  __device__ __forceinline__ void operator()(const f32x4 (&acc)[2][2][4][2], const pg8::Unit& u, int wr, int wc, int fr, int fq) const {
    const int pl = u.pn & 3;
    int fr_ = fr, fq_ = fq; asm volatile("" : "+v"(fr_), "+v"(fq_));
    const float* gp = GATEL + (size_t)u.e * 32768; const int rk0 = u.mt * 256 + wr * 64 + fr_;
    unsigned char* yp = Y + (size_t)(u.pm * 256 + wr * 64 + fr_) * 1024 + pl * 256 + wc * 32 + 8 * fq_;
#pragma unroll
    for (int ai = 0; ai < 2; ++ai)
#pragma unroll
      for (int m = 0; m < 4; ++m) {
        const int rk = rk0 + ai * 128 + m * 16; const float gt = gp[rk < 32767 ? rk : 32767] * (64.0f / (W8SCALE * H8SCALE));
#pragma unroll
        for (int bj = 0; bj < 2; ++bj)
          *(u32x2*)(yp + (size_t)(ai * 128 + m * 16) * 1024 + bj * 128) = (u32x2){pk4_fp8(acc[ai][bj][m][0] * gt), pk4_fp8(acc[ai][bj][m][1] * gt)};
      }
  }
};

__device__ __forceinline__ void phase_inproj_mfma(const Ctx& c, lds_u8* lds) {
  unsigned char* ws = c.ws; const int tid = phase_tid();
  { pg8::Gemm g{(const bf16_t*)c.out, (const bf16_t*)(ws + WS_WIN), 1024}; pg8::StaticOrder S; S.init(T, NIN, gridDim.x, blockIdx.x); EpiInM E{ws};
    pg8::gemm_phase<EpiInM, pg8::StaticOrder, true, false>(lds, g, S, E, tid); }
  { pg8::Gemm g{(const bf16_t*)(ws + WS_MEMB), (const bf16_t*)(ws + WS_WMKV), 1024}; pg8::StaticOrder S; S.init(TM, 512, gridDim.x, (int)blockIdx.x - 128); EpiMemKVM E{ws};
    pg8::gemm_phase<EpiMemKVM, pg8::StaticOrder, true, false>(lds, g, S, E, tid); }
}
__device__ __forceinline__ void phase_outproj_mfma(const Ctx& c, lds_u8* lds) {
  unsigned char* ws = c.ws; const int tid = phase_tid();
  pg8::Gemm g{(const bf16_t*)(ws + WS_CAT), (const bf16_t*)(ws + WS_WO), 512}; pg8::StaticOrder S; S.init(T, 1024, gridDim.x, blockIdx.x); EpiOutM E{(const bf16_t*)c.out, (bf16_t*)(ws + WS_X1B)};
  pg8::gemm_phase<EpiOutM, pg8::StaticOrder, true, false, 2, true>(lds, g, S, E, tid);
}
__device__ __forceinline__ void phase_moe_up_mfma(const Ctx& c, lds_u8* lds) {
  unsigned char* ws = c.ws; const int tid = phase_tid();
  int* offs = (int*)((unsigned char*)lds + pg8::STAGE_BYTES); int* cnts = offs + 65;
  expert_offsets(c, offs, cnts, tid);
  pg8::Gemm g{(const bf16_t*)(ws + WS_X1F), (const bf16_t*)(ws + WS_WGU), 512};
  MoeOrder S{offs, cnts, 2, (int)gridDim.x, (int)blockIdx.x, (const unsigned*)(ws + WS_LIST)}; EpiMoeUpM E{ws + WS_H};
  pg8::gemm_phase<EpiMoeUpM, MoeOrder, true, true, 2, true>(lds, g, S, E, tid);
}
__device__ __forceinline__ void phase_moe_down_mfma(const Ctx& c, lds_u8* lds) {
  unsigned char* ws = c.ws; const int tid = phase_tid();
  int* offs = (int*)((unsigned char*)lds + pg8::STAGE_BYTES); int* cnts = offs + 65;
  expert_offsets(c, offs, cnts, tid);
  pg8::Gemm g{(const bf16_t*)(ws + WS_H), (const bf16_t*)(ws + WS_WD), 128};
  MoeOrder S{offs, cnts, 4, (int)gridDim.x, (int)blockIdx.x, nullptr}; EpiMoeDownM E{(unsigned char*)(ws + WS_Y), (const float*)(ws + WS_GATEL)};
  pg8::gemm_phase<EpiMoeDownM, MoeOrder, true, false, 2>(lds, g, S, E, tid);
}

__device__ void phase_kvup(const Ctx& c, float* lds) {
  unsigned char* ws = c.ws;
  const int tid = phase_tid(), lane = tid & 63, wave = tid >> 6, fr = lane & 15, fq = lane >> 4;
  const bf16_t* W = (const bf16_t*)(ws + WS_WKV);
  const bf16_t* CKV = (const bf16_t*)(ws + WS_CKV); bf16_t* KVA = (bf16_t*)(ws + WS_KVA);
  const float* cs = (const float*)(ws + WS_ROPE); const float* sn = cs + SEQ * 32;
  for (int tile = blockIdx.x * NWAVES + wave; tile < T / 16; tile += gridDim.x * NWAVES) {
    const int t = tile * 16 + fr, pos = t & (SEQ - 1);
    pg8::bf16x8 bx[4]; float ss = 0.f;
#pragma unroll
    for (int ks = 0; ks < 4; ++ks) { const u32x4 v = *(const u32x4*)(CKV + (size_t)t * 128 + ks * 32 + fq * 8); bx[ks] = __builtin_bit_cast(pg8::bf16x8, v);
      const float f[8] = {__uint_as_float(v.x << 16), __uint_as_float(v.x & 0xffff0000u), __uint_as_float(v.y << 16), __uint_as_float(v.y & 0xffff0000u), __uint_as_float(v.z << 16), __uint_as_float(v.z & 0xffff0000u), __uint_as_float(v.w << 16), __uint_as_float(v.w & 0xffff0000u)};
#pragma unroll
      for (int e = 0; e < 8; ++e) ss += f[e] * f[e]; }
    ss += __shfl_xor(ss, 16); ss += __shfl_xor(ss, 32);
    const float rstd = rsqrtf(ss * (1.f / 128.f) + 1e-6f);
#pragma unroll
    for (int nt = 0; nt < 8; ++nt) { f32x4 d = {0.f, 0.f, 0.f, 0.f};
#pragma unroll
      for (int ks = 0; ks < 4; ++ks) d = __builtin_amdgcn_mfma_f32_16x16x32_bf16(*(const pg8::bf16x8*)(W + (size_t)(nt * 16 + fr) * 128 + ks * 32 + fq * 8), bx[ks], d, 0, 0, 0);
      d = d * rstd;
      const int p0 = nt * 16 + fq * 4;
      if (nt < 4) { const int dd = p0 >> 1; const float c0 = cs[pos * 32 + dd], s0 = sn[pos * 32 + dd], c1 = cs[pos * 32 + dd + 1], s1 = sn[pos * 32 + dd + 1];
        const f32x4 o = {d.x * c0 - d.y * s0, d.y * c0 + d.x * s0, d.z * c1 - d.w * s1, d.w * c1 + d.z * s1}; d = o; }
      { int w8 = __builtin_amdgcn_cvt_pk_fp8_f32(d.x, d.y, 0, false); w8 = __builtin_amdgcn_cvt_pk_fp8_f32(d.z, d.w, w8, true);
        *(unsigned*)((unsigned char*)KVA + (size_t)t * 128 + p0) = (unsigned)w8; } }
  }
}


typedef _Float16 h16x2 __attribute__((ext_vector_type(2)));
constexpr int TK_KP = 4104;
constexpr int TK_KEYS = 0, TK_H1 = 16 * TK_KP * 2, TK_H2 = TK_H1 + 16 * 128 * 4, TK_MISC = TK_H2 + 8 * 128 * 4;
__device__ __forceinline__ unsigned mono16x2(unsigned u) { const unsigned m = ((u >> 15) & 0x00010001u) * 0xffffu; return u ^ (m | 0x80008000u); }
__device__ __forceinline__ int wave_incl_scan(int x) {
  x += __builtin_amdgcn_update_dpp(0, x, 0x111, 0xF, 0xF, true);
  x += __builtin_amdgcn_update_dpp(0, x, 0x112, 0xF, 0xF, true);
  x += __builtin_amdgcn_update_dpp(0, x, 0x114, 0xF, 0xF, true);
  x += __builtin_amdgcn_update_dpp(0, x, 0x118, 0xF, 0xF, true);
  x += __builtin_amdgcn_update_dpp(0, x, 0x142, 0xA, 0xF, false);
  x += __builtin_amdgcn_update_dpp(0, x, 0x143, 0xC, 0xF, false);
  return x;
}

__device__ __forceinline__ void hist_find(const unsigned* hw, int need, int lane, int& B, int& above) {
  const unsigned w0 = hw[127 - 2 * lane], w1 = hw[126 - 2 * lane];
  const int c0 = (int)(w0 >> 16), c1 = (int)(w0 & 0xffffu), c2 = (int)(w1 >> 16), c3 = (int)(w1 & 0xffffu);
  const int tl = c0 + c1 + c2 + c3;
  const int incl = wave_incl_scan(tl);
  const int excl = incl - tl;
  const bool hit = (excl < need) && (incl >= need);
  int b = 0, ab = 0;
  if (hit) { int a = excl; b = 255 - 4 * lane; ab = a;
    if (a + c0 < need) { a += c0; b = 254 - 4 * lane; ab = a; if (a + c1 < need) { a += c1; b = 253 - 4 * lane; ab = a; if (a + c2 < need) { a += c2; b = 252 - 4 * lane; ab = a; } } } }
  const unsigned long long m = __ballot(hit);
  const int src = __builtin_amdgcn_readfirstlane(m ? (__ffsll((long long)m) - 1) : 0);
  B = __builtin_amdgcn_readlane(b, src); above = __builtin_amdgcn_readlane(ab, src);
}
__device__ void phase_topk_mfma(const Ctx& c, unsigned char* ldsb, unsigned* qhead) {
  unsigned char* ws = c.ws;
  const int tid = phase_tid(), lane = tid & 63, wave = tid >> 6, fr = lane & 15, fq = lane >> 4;
  unsigned short* keys = (unsigned short*)(ldsb + TK_KEYS);
  unsigned* h1 = (unsigned*)(ldsb + TK_H1); unsigned* h2 = (unsigned*)(ldsb + TK_H2) + wave * 128; int* misc = (int*)(ldsb + TK_MISC);
  const bf16_t* IQ = (const bf16_t*)(ws + WS_IQ); const bf16_t* IK = (const bf16_t*)(ws + WS_IK); const float* SM = (const float*)(ws + WS_SM);
  unsigned short* SEL = (unsigned short*)(ws + WS_SEL);
  WorkQ wq; wq_init(wq, qhead, misc, tid);
  for (;;) {
    const int item = wq_next(wq, tid);
    if (item >= 240 * 8) break;
    const int b = item & 7, qb = 255 - (item >> 3), s0 = qb * 16;
    for (int i = tid; i < 16 * 128; i += NTHREADS) h1[i] = 0u;
    const size_t qrow = (size_t)b * SEQ + s0 + fr;
    pg8::bf16x8 bq[4][2];
#pragma unroll
    for (int hh = 0; hh < 4; ++hh)
#pragma unroll
      for (int ks = 0; ks < 2; ++ks) bq[hh][ks] = *(const pg8::bf16x8*)(IQ + qrow * 256 + hh * 64 + ks * 32 + fq * 8);
    const f32x4 iw = *(const f32x4*)(SM + qrow * 16);
    const int nkt = qb + 1, slim = s0 + fr;
    __syncthreads();
    pg8::bf16x8 a0n = {0, 0, 0, 0, 0, 0, 0, 0}, a1n = a0n;
    if (wave < nkt) { const bf16_t* kr = IK + ((size_t)b * SEQ + wave * 16 + fr) * 64 + fq * 8; a0n = *(const pg8::bf16x8*)kr; a1n = *(const pg8::bf16x8*)(kr + 32); }
    for (int kt = wave; kt < nkt; kt += NWAVES) {
      const pg8::bf16x8 a0 = a0n, a1 = a1n;
      if (kt + NWAVES < nkt) { const bf16_t* kr = IK + ((size_t)b * SEQ + (kt + NWAVES) * 16 + fr) * 64 + fq * 8; a0n = *(const pg8::bf16x8*)kr; a1n = *(const pg8::bf16x8*)(kr + 32); }
      f32x4 sc = {0.f, 0.f, 0.f, 0.f};
#pragma unroll
      for (int hh = 0; hh < 4; ++hh) { f32x4 d = {0.f, 0.f, 0.f, 0.f};
        d = __builtin_amdgcn_mfma_f32_16x16x32_bf16(a0, bq[hh][0], d, 0, 0, 0); d = __builtin_amdgcn_mfma_f32_16x16x32_bf16(a1, bq[hh][1], d, 0, 0, 0);
        const float w = hh == 0 ? iw.x : hh == 1 ? iw.y : hh == 2 ? iw.z : iw.w;
        sc.x = fmaf(w, fmaxf(d.x, 0.f), sc.x); sc.y = fmaf(w, fmaxf(d.y, 0.f), sc.y); sc.z = fmaf(w, fmaxf(d.z, 0.f), sc.z); sc.w = fmaf(w, fmaxf(d.w, 0.f), sc.w); }
      unsigned k01 = mono16x2(__builtin_bit_cast(unsigned, __builtin_amdgcn_cvt_pkrtz(sc.x, sc.y))), k23 = mono16x2(__builtin_bit_cast(unsigned, __builtin_amdgcn_cvt_pkrtz(sc.z, sc.w)));
      const int kbase = kt * 16 + fq * 4;
      unsigned* hq = h1 + fr * 128;
      if (kt + 1 < nkt) {
        *(u32x2*)(keys + fr * TK_KP + kbase) = (u32x2){k01, k23};
        { const unsigned kk = k01 & 0xffffu; atomicAdd(hq + (kk >> 9), 1u << ((kk >> 4) & 16)); }
        { const unsigned kk = k01 >> 16; atomicAdd(hq + (kk >> 9), 1u << ((kk >> 4) & 16)); }
        { const unsigned kk = k23 & 0xffffu; atomicAdd(hq + (kk >> 9), 1u << ((kk >> 4) & 16)); }
        { const unsigned kk = k23 >> 16; atomicAdd(hq + (kk >> 9), 1u << ((kk >> 4) & 16)); }
      } else {
        if (kbase + 0 > slim) k01 &= 0xffff0000u; if (kbase + 1 > slim) k01 &= 0x0000ffffu;
        if (kbase + 2 > slim) k23 &= 0xffff0000u; if (kbase + 3 > slim) k23 &= 0x0000ffffu;
        *(u32x2*)(keys + fr * TK_KP + kbase) = (u32x2){k01, k23};
        if (kbase + 0 <= slim) { const unsigned kk = k01 & 0xffffu; atomicAdd(hq + (kk >> 9), 1u << ((kk >> 4) & 16)); }
        if (kbase + 1 <= slim) { const unsigned kk = k01 >> 16; atomicAdd(hq + (kk >> 9), 1u << ((kk >> 4) & 16)); }
        if (kbase + 2 <= slim) { const unsigned kk = k23 & 0xffffu; atomicAdd(hq + (kk >> 9), 1u << ((kk >> 4) & 16)); }
        if (kbase + 3 <= slim) { const unsigned kk = k23 >> 16; atomicAdd(hq + (kk >> 9), 1u << ((kk >> 4) & 16)); }
      }
    }
    __syncthreads();
    for (int qi = 0; qi < 2; ++qi) {
      const int q = wave * 2 + qi, s = s0 + q, n = s + 1;
      int B1, above1; hist_find(h1 + q * 128, 256, lane, B1, above1);
      const int need1 = 256 - above1;
      h2[lane] = 0u; h2[64 + lane] = 0u;
      const unsigned short* kq = keys + q * TK_KP;
      const int niter = (n + 511) >> 9;
      for (int it = 0; it < niter; ++it) {
        const int i0 = (it * 64 + lane) * 8; const u32x4 kv = *(const u32x4*)(kq + i0);
        const unsigned k8[8] = {kv.x & 0xffffu, kv.x >> 16, kv.y & 0xffffu, kv.y >> 16, kv.z & 0xffffu, kv.z >> 16, kv.w & 0xffffu, kv.w >> 16};
#pragma unroll
        for (int e = 0; e < 8; ++e) if (i0 + e < n && (int)(k8[e] >> 8) == B1) atomicAdd(h2 + ((k8[e] & 255u) >> 1), 1u << ((k8[e] & 1u) * 16));
      }
      int B2, above2; hist_find(h2, need1, lane, B2, above2);
      const unsigned thr = (unsigned)((B1 << 8) | B2); const int need = need1 - above2;
      unsigned short* dummy = (unsigned short*)(misc + 8 + wave);
      unsigned short* sel = (unsigned short*)h2;
      asm volatile("s_waitcnt lgkmcnt(0)" ::: "memory");
      int tiebase = 0, outbase = 0;
      for (int it = 0; it < niter; ++it) {
        const int i0 = (it * 64 + lane) * 8; const u32x4 kv = *(const u32x4*)(kq + i0);
        const unsigned k8[8] = {kv.x & 0xffffu, kv.x >> 16, kv.y & 0xffffu, kv.y >> 16, kv.z & 0xffffu, kv.z >> 16, kv.w & 0xffffu, kv.w >> 16};
        int cg = 0, ce = 0;
#pragma unroll
        for (int e = 0; e < 8; ++e) { const bool v = i0 + e < n; cg += (v && k8[e] > thr) ? 1 : 0; ce += (v && k8[e] == thr) ? 1 : 0; }
        int tk = 0;
        if (__ballot(ce != 0)) {
          const int eincl = wave_incl_scan(ce); const int eg = tiebase + eincl - ce;
          tk = need - eg; tk = tk < 0 ? 0 : (tk > ce ? ce : tk);
          tiebase += __builtin_amdgcn_readlane(eincl, 63);
        }
        const int oc = cg + tk; const int oincl = wave_incl_scan(oc);
        int pos = outbase + oincl - oc; int tleft = tk;
#pragma unroll
        for (int e = 0; e < 8; ++e) { const bool v = i0 + e < n; const bool tie = v && k8[e] == thr && tleft > 0; const bool take = (v && k8[e] > thr) || tie;
          tleft -= tie ? 1 : 0;
          unsigned short* dst = (take && pos < 256) ? sel + pos : dummy;
          *dst = (unsigned short)(i0 + e); pos += take ? 1 : 0; }
        outbase += __builtin_amdgcn_readlane(oincl, 63);
      }
      asm volatile("s_waitcnt lgkmcnt(0)" ::: "memory");
      *(u32x2*)(SEL + ((size_t)b * SEQ + s) * 256 + lane * 4) = *(const u32x2*)(sel + lane * 4);
      asm volatile("s_waitcnt lgkmcnt(0)" ::: "memory");
    }
  }
}

typedef short s16x4 __attribute__((ext_vector_type(4)));
__device__ __forceinline__ s16x4 lds_tr16(const unsigned char* p) { return __builtin_bit_cast(s16x4, __builtin_amdgcn_ds_read_tr16_b64_v4i16((__attribute__((address_space(3))) s16x4*)(__attribute__((address_space(3))) unsigned char*)p)); }
typedef float f32x2_t __attribute__((ext_vector_type(2))); typedef __bf16 bf16x2_t __attribute__((ext_vector_type(2)));
__device__ __forceinline__ unsigned cvtpk_c(float lo, float hi) { const f32x2_t v = {lo, hi}; const bf16x2_t b = __builtin_convertvector(v, bf16x2_t); return __builtin_bit_cast(unsigned, b); }
__device__ __forceinline__ pg8::bf16x8 packp(const f32x4& a, const f32x4& b) {
  const u32x4 w = {cvtpk_c(a.x, a.y), cvtpk_c(a.z, a.w), cvtpk_c(b.x, b.y), cvtpk_c(b.z, b.w)}; return __builtin_bit_cast(pg8::bf16x8, w); }
constexpr int AT_WB = 9216 + 512;
typedef int v2i_t __attribute__((ext_vector_type(2)));
__device__ __forceinline__ long lds_tr8(const unsigned char* p) { const v2i_t r = __builtin_amdgcn_ds_read_tr8_b64_v2i32((__attribute__((address_space(3))) v2i_t*)(__attribute__((address_space(3))) unsigned char*)p); return (long)(((unsigned long)(unsigned)r.y << 32) | (unsigned long)(unsigned)r.x); }
__device__ void phase_attn_sparse(const Ctx& c, unsigned char* ldsb, unsigned* qhead) {
  unsigned char* ws = c.ws;
  const int tid = phase_tid(), lane = tid & 63, wave = tid >> 6, fr = lane & 15, fq = lane >> 4;
  unsigned char* vl = ldsb + wave * AT_WB; unsigned short* sl = (unsigned short*)(vl + 9216);
  const bf16_t* QA = (const bf16_t*)(ws + WS_QA); const unsigned char* KVA = (const unsigned char*)(ws + WS_KVA); const unsigned short* SEL = (const unsigned short*)(ws + WS_SEL);
  unsigned char* CAT = ws + WS_CAT;
  const float* gA = c.in[10];
  __syncthreads();
  int* aq_slot = (int*)(ldsb + 8 * AT_WB);
  WorkQ wq; wq_init(wq, qhead, aq_slot, tid);
  const int st_off = (lane >> 3) * 144 + (lane & 7) * 16;
  const int kr_off = fr * 144 + fq * 16;
  const int tr_off = (fq * 4 + ((fr >> 1) & 3) + (fr >> 3) * 16) * 144 + 64 + (fr & 1) * 8;
  for (;;) {
  const int item = wq_next(wq, tid);
  if (item >= 512) break;
  for (int tj = 0; tj < 8; ++tj) {
    const int t = item * 64 + wave * 8 + tj;
    const int b = t >> 12, s = t & (SEQ - 1), n = s + 1 < 256 ? s + 1 : 256;
    { u32x2 v;
      if (s >= 256) v = *(const u32x2*)(SEL + (size_t)t * 256 + lane * 4);
      else { const int i0 = lane * 4; const unsigned e0 = i0 < n ? i0 : 0, e1 = i0 + 1 < n ? i0 + 1 : 0, e2 = i0 + 2 < n ? i0 + 2 : 0, e3 = i0 + 3 < n ? i0 + 3 : 0; v = (u32x2){e0 | (e1 << 16), e2 | (e3 << 16)}; }
      *(u32x2*)(sl + lane * 4) = v; }
    asm volatile("s_waitcnt lgkmcnt(0)" ::: "memory");
    const unsigned char* kvb = KVA + (size_t)b * SEQ * 128;
    u32x4 ra[8], rb[8];
#define KLOAD(R, CH) do { _Pragma("unroll") for (int i_ = 0; i_ < 8; ++i_) { const int key_ = sl[(CH) * 64 + i_ * 8 + (lane >> 3)]; R[i_] = *(const u32x4*)(kvb + (size_t)key_ * 128 + (lane & 7) * 16); } } while (0)
#define KSTORE(R) do { _Pragma("unroll") for (int i_ = 0; i_ < 8; ++i_) *(u32x4*)(vl + i_ * 8 * 144 + st_off) = R[i_]; } while (0)
    KLOAD(ra, 0); KLOAD(rb, 1);
    long q0 = 0, q1 = 0;
    if (fr < 6) { const bf16_t* qp = QA + (size_t)t * 384 + fr * 64 + fq * 16; const u32x4 a = *(const u32x4*)qp, bb = *(const u32x4*)(qp + 8);
      q0 = mk64(cvt4_fp8(__uint_as_float(a.x << 16), __uint_as_float(a.x & 0xffff0000u), __uint_as_float(a.y << 16), __uint_as_float(a.y & 0xffff0000u)),
                cvt4_fp8(__uint_as_float(a.z << 16), __uint_as_float(a.z & 0xffff0000u), __uint_as_float(a.w << 16), __uint_as_float(a.w & 0xffff0000u)));
      q1 = mk64(cvt4_fp8(__uint_as_float(bb.x << 16), __uint_as_float(bb.x & 0xffff0000u), __uint_as_float(bb.y << 16), __uint_as_float(bb.y & 0xffff0000u)),
                cvt4_fp8(__uint_as_float(bb.z << 16), __uint_as_float(bb.z & 0xffff0000u), __uint_as_float(bb.w << 16), __uint_as_float(bb.w & 0xffff0000u))); }
    float m = -3.0e38f, l = 0.f;
    f32x4 ot[4];
#pragma unroll
    for (int mt = 0; mt < 4; ++mt) ot[mt] = (f32x4){0.f, 0.f, 0.f, 0.f};
#define KCHUNK(R, CH) do { \
      KSTORE(R); if ((CH) + 2 < 4) KLOAD(R, (CH) + 2); \
      asm volatile("s_waitcnt lgkmcnt(0)" ::: "memory"); \
      f32x4 st[4]; \
      _Pragma("unroll") for (int kt = 0; kt < 4; ++kt) { const u32x4 a_ = *(const u32x4*)(vl + kt * 16 * 144 + kr_off); f32x4 d_ = {0.f, 0.f, 0.f, 0.f}; \
        d_ = __builtin_amdgcn_mfma_f32_16x16x32_fp8_fp8(mk64(a_.x, a_.y), q0, d_, 0, 0, 0); st[kt] = __builtin_amdgcn_mfma_f32_16x16x32_fp8_fp8(mk64(a_.z, a_.w), q1, d_, 0, 0, 0); } \
      if (n < 256) { _Pragma("unroll") for (int kt = 0; kt < 4; ++kt) { const int sb = (CH) * 64 + kt * 16 + fq * 4; \
        if (sb + 0 >= n) st[kt].x = -3.0e38f; if (sb + 1 >= n) st[kt].y = -3.0e38f; if (sb + 2 >= n) st[kt].z = -3.0e38f; if (sb + 3 >= n) st[kt].w = -3.0e38f; } } \
      float cm = -3.0e38f; \
      _Pragma("unroll") for (int kt = 0; kt < 4; ++kt) cm = fmaxf(fmaxf(fmaxf(cm, st[kt].x), fmaxf(st[kt].y, st[kt].z)), st[kt].w); \
      cm = fmaxf(cm, __shfl_xor(cm, 16)); cm = fmaxf(cm, __shfl_xor(cm, 32)); \
      const float mn = fmaxf(m, cm), al = __builtin_amdgcn_exp2f(m - mn), mb = mn - 8.f; m = mn; \
      float ls = 0.f; \
      _Pragma("unroll") for (int kt = 0; kt < 4; ++kt) { st[kt].x = __builtin_amdgcn_exp2f(st[kt].x - mb); st[kt].y = __builtin_amdgcn_exp2f(st[kt].y - mb); st[kt].z = __builtin_amdgcn_exp2f(st[kt].z - mb); st[kt].w = __builtin_amdgcn_exp2f(st[kt].w - mb); \
        ls += (st[kt].x + st[kt].y) + (st[kt].z + st[kt].w); } \
      l = l * al + ls; \
      _Pragma("unroll") for (int mt = 0; mt < 4; ++mt) ot[mt] = ot[mt] * al; \
      _Pragma("unroll") for (int k2 = 0; k2 < 2; ++k2) { \
        const long pf = mk64(cvt4_fp8(st[2 * k2].x, st[2 * k2].y, st[2 * k2].z, st[2 * k2].w), cvt4_fp8(st[2 * k2 + 1].x, st[2 * k2 + 1].y, st[2 * k2 + 1].z, st[2 * k2 + 1].w)); \
        _Pragma("unroll") for (int mt = 0; mt < 4; ++mt) { const long af = lds_tr8(vl + k2 * 32 * 144 + tr_off + mt * 16); \
          ot[mt] = __builtin_amdgcn_mfma_f32_16x16x32_fp8_fp8(af, pf, ot[mt], 0, 0, 0); } } \
      asm volatile("s_waitcnt lgkmcnt(0)" ::: "memory"); } while (0)
    KCHUNK(ra, 0); KCHUNK(rb, 1); KCHUNK(ra, 2); KCHUNK(rb, 3);
#undef KLOAD
#undef KSTORE
#undef KCHUNK
    l += __shfl_xor(l, 16); l += __shfl_xor(l, 32);
    const float il = __builtin_amdgcn_rcpf(l); float ss = 0.f;
#pragma unroll
    for (int mt = 0; mt < 4; ++mt) { ot[mt] = ot[mt] * il; ss += (ot[mt].x * ot[mt].x + ot[mt].y * ot[mt].y) + (ot[mt].z * ot[mt].z + ot[mt].w * ot[mt].w); }
    if (fr >= 6) ss = 0.f;
#pragma unroll
    for (int o = 1; o < 64; o <<= 1) ss += __shfl_xor(ss, o);
    const float rstd = rsqrtf(ss * (1.f / 384.f) + 1e-6f);
    if (fr < 6) {
#pragma unroll
      for (int mt = 0; mt < 4; ++mt) { const int col = fr * 64 + mt * 16 + fq * 4; const f32x4 g = *(const f32x4*)(gA + col); const f32x4 o = ot[mt] * rstd * g;
        *(unsigned*)(CAT + (size_t)t * 1024 + col) = pk4_fp8(o); } }
  }
  }
}

__device__ void phase_attn_mem(const Ctx& c, unsigned char* ldsb, unsigned* qhead) {
  unsigned char* ws = c.ws;
  const int tid = phase_tid(), lane = tid & 63, wave = tid >> 6, fr = lane & 15, fq = lane >> 4;
  const bf16_t* QC = (const bf16_t*)(ws + WS_QC); const unsigned char* MK = ws + WS_MK; const unsigned char* MVT = ws + WS_MVT;
  unsigned char* CAT = ws + WS_CAT;
  const float* gC = c.in[11];
  int* aq_slot = (int*)(ldsb + 70656 + 8 * 8192);
  WorkQ wq; wq_init(wq, qhead, aq_slot, tid);
  for (;;) {
  const int item = wq_next(wq, tid) + 512;
  if (item >= 768) break;
  {
    const int t0 = (item - 512) * 128 + wave * 16, b = t0 >> 12;
    unsigned char* mkl = ldsb; unsigned char* mvl = ldsb + 36864; unsigned char* ocl = ldsb + 70656 + wave * 8192;
    float ss = 0.f;
#pragma unroll 1
    for (int h = 0; h < 4; ++h) {
      const bf16_t* qp = QC + (size_t)(t0 + fr) * 256 + h * 64 + fq * 16;
      const u32x4 qa = *(const u32x4*)qp, qb = *(const u32x4*)(qp + 8);
      __syncthreads();
#pragma unroll
      for (int i = 0; i < 2; ++i) { const int p = tid + 512 * i, row = p >> 2, cc = p & 3;
        *(u32x4*)(mkl + row * 80 + cc * 16) = *(const u32x4*)(MK + ((size_t)(b * 256 + row)) * 256 + h * 64 + cc * 16); }
#pragma unroll
      for (int i = 0; i < 2; ++i) { const int p = tid + 512 * i, row = p >> 4, cc = p & 15;
        *(u32x4*)(mvl + row * 272 + cc * 16) = *(const u32x4*)(MVT + ((size_t)(b * 256 + h * 64 + row)) * 256 + cc * 16); }
      const long q0 = mk64(cvt4_fp8(__uint_as_float(qa.x << 16), __uint_as_float(qa.x & 0xffff0000u), __uint_as_float(qa.y << 16), __uint_as_float(qa.y & 0xffff0000u)),
                           cvt4_fp8(__uint_as_float(qa.z << 16), __uint_as_float(qa.z & 0xffff0000u), __uint_as_float(qa.w << 16), __uint_as_float(qa.w & 0xffff0000u)));
      const long q1 = mk64(cvt4_fp8(__uint_as_float(qb.x << 16), __uint_as_float(qb.x & 0xffff0000u), __uint_as_float(qb.y << 16), __uint_as_float(qb.y & 0xffff0000u)),
                           cvt4_fp8(__uint_as_float(qb.z << 16), __uint_as_float(qb.z & 0xffff0000u), __uint_as_float(qb.w << 16), __uint_as_float(qb.w & 0xffff0000u)));
      __syncthreads();
      f32x4 oc[4];
      f32x4 st[16];
#pragma unroll
      for (int kt = 0; kt < 16; ++kt) { const u32x4 a_ = *(const u32x4*)(mkl + (kt * 16 + fr) * 80 + fq * 16);
        f32x4 d = {0.f, 0.f, 0.f, 0.f};
        d = __builtin_amdgcn_mfma_f32_16x16x32_fp8_fp8(mk64(a_.x, a_.y), q0, d, 0, 0, 0); st[kt] = __builtin_amdgcn_mfma_f32_16x16x32_fp8_fp8(mk64(a_.z, a_.w), q1, d, 0, 0, 0); }
      float mx = -3.0e38f;
#pragma unroll
      for (int kt = 0; kt < 16; ++kt) mx = fmaxf(fmaxf(fmaxf(mx, st[kt].x), fmaxf(st[kt].y, st[kt].z)), st[kt].w);
      mx = fmaxf(mx, __shfl_xor(mx, 16)); mx = fmaxf(mx, __shfl_xor(mx, 32));
      mx -= 8.f;
      float l = 0.f;
#pragma unroll
      for (int kt = 0; kt < 16; ++kt) { st[kt].x = __builtin_amdgcn_exp2f(st[kt].x - mx); st[kt].y = __builtin_amdgcn_exp2f(st[kt].y - mx); st[kt].z = __builtin_amdgcn_exp2f(st[kt].z - mx); st[kt].w = __builtin_amdgcn_exp2f(st[kt].w - mx);
        l += (st[kt].x + st[kt].y) + (st[kt].z + st[kt].w); }
      l += __shfl_xor(l, 16); l += __shfl_xor(l, 32);
#pragma unroll
      for (int mt = 0; mt < 4; ++mt) oc[mt] = (f32x4){0.f, 0.f, 0.f, 0.f};
#pragma unroll
      for (int kk = 0; kk < 8; ++kk) { const long pf = mk64(cvt4_fp8(st[2 * kk].x, st[2 * kk].y, st[2 * kk].z, st[2 * kk].w), cvt4_fp8(st[2 * kk + 1].x, st[2 * kk + 1].y, st[2 * kk + 1].z, st[2 * kk + 1].w));
#pragma unroll
        for (int mt = 0; mt < 4; ++mt) { const u32x2 a_ = *(const u32x2*)(mvl + (mt * 16 + fr) * 272 + (kk * 4 + fq) * 8);
          oc[mt] = __builtin_amdgcn_mfma_f32_16x16x32_fp8_fp8(mk64(a_.x, a_.y), pf, oc[mt], 0, 0, 0); } }
      const float il = __builtin_amdgcn_rcpf(l);
#pragma unroll
      for (int mt = 0; mt < 4; ++mt) { const f32x4 o = oc[mt] * il; ss += (o.x * o.x + o.y * o.y) + (o.z * o.z + o.w * o.w); *(u32x2*)(ocl + ((h * 4 + mt) * 64 + lane) * 8) = (u32x2){pg8::cvt_pk_bf16(o.x, o.y), pg8::cvt_pk_bf16(o.z, o.w)}; }
    }
    ss += __shfl_xor(ss, 16); ss += __shfl_xor(ss, 32);
    const float rstd = rsqrtf(ss * (1.f / 256.f) + 1e-6f);
#pragma unroll 1
    for (int h = 0; h < 4; ++h)
#pragma unroll
      for (int mt = 0; mt < 4; ++mt) { const int col = h * 64 + mt * 16 + fq * 4; const f32x4 g = *(const f32x4*)(gC + col); const u32x2 pp = *(const u32x2*)(ocl + ((h * 4 + mt) * 64 + lane) * 8);
        const f32x4 ov = {__uint_as_float(pp.x << 16), __uint_as_float(pp.x & 0xffff0000u), __uint_as_float(pp.y << 16), __uint_as_float(pp.y & 0xffff0000u)}; const f32x4 o = ov * rstd * g;
        *(unsigned*)(CAT + (size_t)(t0 + fr) * 1024 + 768 + col) = pk4_fp8(o); }
  }
  }
}

constexpr int GD_ITEM = 41088;
__device__ __forceinline__ unsigned char* gd_item(unsigned char* ws, int it) { return it < 1536 ? ws + WS_XB + (size_t)it * GD_ITEM : ws + WS_X1B + (size_t)(it - 1536) * GD_ITEM; }
__device__ __forceinline__ int kperm(int x) { return (x & 32) | (((x >> 2) & 3) << 3) | (x & 3) | (((x >> 4) & 1) << 2); }
constexpr int GP_KB = 0, GP_KBB = 9216, GP_QB = 18432, GP_VBT = 27648, GP_KBET = 36864, GP_XR = 46080  , GP_PR = 82944  , GP_OUT = 101376, GP_SC = 142336;
__device__ __forceinline__ pg8::bf16x8 ldsfrag(const unsigned char* base, int row, int ks, int fq) { return *(const pg8::bf16x8*)(base + row * 144 + ks * 64 + fq * 16); }
constexpr int G2_KB = 0, G2_KBB = 9216, G2_QB = 18432, G2_XR0 = 27648, G2_XT0 = 36864, G2_PR0 = 46080, G2_VBT = 55296, G2_KBET = 64512, G2_SC = 73728, G2_CW = 75264, G2_HALF = 78336;
__device__ void phase_gdn_prep2(const Ctx& c, unsigned char* Lb) {
  unsigned char* ws = c.ws;
  const int tid = phase_tid(), lane = tid & 63, wave = tid >> 6, fr = lane & 15, fq = lane >> 4;
  const int hb = wave >> 2, w4 = wave & 3, htid = tid & 255;
  unsigned char* L = Lb + hb * G2_HALF;
  const bf16_t* GB = (const bf16_t*)(ws + WS_GB); const float* SM = (const float*)(ws + WS_SM);
  const float* convw = c.in[6];
  float* sc = (float*)(L + G2_SC);
  float* cw = (float*)(L + G2_CW);
  const int tt = htid >> 2, part = htid & 3;
  for (int it2 = blockIdx.x; it2 < 1536; it2 += gridDim.x) {
    const int it = it2 * 2 + hb;
    const int n = it & 63, bh = it >> 6, b = bh / 6, h = bh % 6;
    const int t = n * 64 + tt; const size_t r = (size_t)b * SEQ + t;
    unsigned char* gb = gd_item(ws, it);
    __syncthreads();
    for (int i = htid; i < 768; i += 256) { const int j = i / 192, rr = i % 192; cw[i] = convw[j * 1152 + (rr >> 6) * 384 + h * 64 + (rr & 63)]; }
    if (part == 0) { const float a = SM[r * 16 + 4 + h], bb = SM[r * 16 + 10 + h]; const float xs = a + c.in[8][h]; const float sp = xs > 20.f ? xs : log1pf(__expf(xs));
      sc[tt] = -__expf(c.in[7][h]) * sp; sc[192 + tt] = 1.f / (1.f + __expf(-bb)); }
    __syncthreads();
    if (w4 == 0) { float v = sc[lane];
#pragma unroll
      for (int o = 1; o < 64; o <<= 1) { const float u = __shfl_up(v, o); if (lane >= o) v += u; }
      const float last = __shfl(v, 63);
      sc[64 + lane] = v; sc[128 + lane] = __expf(v); sc[256 + lane] = __expf(last - v); if (lane == 0) { sc[320] = __expf(last); *(float*)(gb + 40960) = __expf(last); } }
    float qv[16], kv[16], vv[16];
#pragma unroll
    for (int role = 0; role < 3; ++role) {
      float acc[16];
#pragma unroll
      for (int e = 0; e < 16; ++e) acc[e] = 0.f;
      u32x4 xr[4][2];
#pragma unroll
      for (int j = 0; j < 4; ++j) { const bool ok = t - 3 + j >= 0; const bf16_t* xp = GB + (r - 3 + j) * 1536 + role * 384 + h * 64 + part * 16;
        xr[j][0] = ok ? *(const u32x4*)xp : (u32x4){0u, 0u, 0u, 0u}; xr[j][1] = ok ? *(const u32x4*)(xp + 8) : (u32x4){0u, 0u, 0u, 0u}; }
#pragma unroll
      for (int j = 0; j < 4; ++j)
#pragma unroll
        for (int hh = 0; hh < 2; ++hh) { const u32x4 xvv = xr[j][hh]; const float* wj = cw + j * 192 + role * 64 + part * 16 + hh * 8;
          const f32x4 w0 = *(const f32x4*)wj, w1 = *(const f32x4*)(wj + 4);
          acc[hh * 8 + 0] += w0.x * __uint_as_float(xvv.x << 16); acc[hh * 8 + 1] += w0.y * __uint_as_float(xvv.x & 0xffff0000u); acc[hh * 8 + 2] += w0.z * __uint_as_float(xvv.y << 16); acc[hh * 8 + 3] += w0.w * __uint_as_float(xvv.y & 0xffff0000u);
          acc[hh * 8 + 4] += w1.x * __uint_as_float(xvv.z << 16); acc[hh * 8 + 5] += w1.y * __uint_as_float(xvv.z & 0xffff0000u); acc[hh * 8 + 6] += w1.z * __uint_as_float(xvv.w << 16); acc[hh * 8 + 7] += w1.w * __uint_as_float(xvv.w & 0xffff0000u); }
      float ss = 0.f;
#pragma unroll
      for (int e = 0; e < 16; ++e) { acc[e] = silu_f(acc[e]); ss += acc[e] * acc[e]; }
      if (role < 2) { ss += __shfl_xor(ss, 1); ss += __shfl_xor(ss, 2); const float scl = rsqrtf(ss + 1e-6f) * (role == 0 ? 0.125f : 1.f);
#pragma unroll
        for (int e = 0; e < 16; ++e) acc[e] *= scl; }
#pragma unroll
      for (int e = 0; e < 16; ++e) { if (role == 0) qv[e] = acc[e]; else if (role == 1) kv[e] = acc[e]; else vv[e] = acc[e]; }
    }
    __syncthreads();
    { const float beta = sc[192 + tt], eg = sc[128 + tt], ekl = sc[256 + tt];
      float kb[16];
#pragma unroll
      for (int e = 0; e < 16; ++e) kb[e] = kv[e] * beta;
#pragma unroll
      for (int hh = 0; hh < 2; ++hh) { const int o8 = hh * 8;
        *(u32x4*)(L + G2_KB + tt * 144 + part * 32 + hh * 16) = (u32x4){pk2(kv[o8], kv[o8 + 1]), pk2(kv[o8 + 2], kv[o8 + 3]), pk2(kv[o8 + 4], kv[o8 + 5]), pk2(kv[o8 + 6], kv[o8 + 7])};
        *(u32x4*)(L + G2_KBB + tt * 144 + part * 32 + hh * 16) = (u32x4){pk2(kb[o8], kb[o8 + 1]), pk2(kb[o8 + 2], kb[o8 + 3]), pk2(kb[o8 + 4], kb[o8 + 5]), pk2(kb[o8 + 6], kb[o8 + 7])};
        *(u32x4*)(L + G2_QB + tt * 144 + part * 32 + hh * 16) = (u32x4){pk2(qv[o8], qv[o8 + 1]), pk2(qv[o8 + 2], qv[o8 + 3]), pk2(qv[o8 + 4], qv[o8 + 5]), pk2(qv[o8 + 6], qv[o8 + 7])}; }
      const int ptt = kperm(tt);
#pragma unroll
      for (int e = 0; e < 16; ++e) { const int d = part * 16 + e;
        *(bf16_t*)(L + G2_VBT + d * 144 + tt * 2) = f2bf(vv[e] * beta);
        *(bf16_t*)(L + G2_KBET + d * 144 + tt * 2) = f2bf(kb[e] * eg);
        *(bf16_t*)(gb + 8192 + tt * 128 + kperm(d) * 2) = f2bf(qv[e] * eg);
        *(bf16_t*)(gb + 3 * 8192 + d * 128 + ptt * 2) = f2bf(kv[e] * ekl); } }
    __syncthreads();
    const int rowb = (w4 * 16 + fq * 4) * 144 + fr * 2;
    const int colb = fr * 144 + (w4 * 16 + fq * 4) * 2;
    const int fa = (w4 * 16 + fr) * 144 + fq * 16;
    const int fb = fr * 144 + fq * 16;
    const int i0 = w4 * 16 + fq * 4;
#define G2F(buf, off) (*(const pg8::bf16x8*)(L + (buf) + (off)))
#define G2W16(buf, off, v) (*(bf16_t*)(L + (buf) + (off)) = f2bf(v))
    f32x4 Pt[4];
    { const float gi0 = sc[64 + i0], gi1 = sc[64 + i0 + 1], gi2 = sc[64 + i0 + 2], gi3 = sc[64 + i0 + 3];
#pragma unroll
    for (int u = 0; u < 4; ++u) {
      f32x4 dl = {0.f, 0.f, 0.f, 0.f}, da = {0.f, 0.f, 0.f, 0.f};
#pragma unroll
      for (int ks = 0; ks < 2; ++ks) { const pg8::bf16x8 bk = G2F(G2_KB, fb + u * 2304 + ks * 64);
        dl = __builtin_amdgcn_mfma_f32_16x16x32_bf16(G2F(G2_KBB, fa + ks * 64), bk, dl, 0, 0, 0);
        da = __builtin_amdgcn_mfma_f32_16x16x32_bf16(G2F(G2_QB, fa + ks * 64), bk, da, 0, 0, 0); }
      const int j = u * 16 + fr; const float gj = sc[64 + j]; const int pj = kperm(j);
      const float dec0 = __expf(fminf(gi0 - gj, 0.f)), dec1 = __expf(fminf(gi1 - gj, 0.f)), dec2 = __expf(fminf(gi2 - gj, 0.f)), dec3 = __expf(fminf(gi3 - gj, 0.f));
      const float l0 = i0 + 0 > j ? dl.x * dec0 : 0.f, l1 = i0 + 1 > j ? dl.y * dec1 : 0.f, l2 = i0 + 2 > j ? dl.z * dec2 : 0.f, l3 = i0 + 3 > j ? dl.w * dec3 : 0.f;
      const float a0 = i0 + 0 >= j ? da.x * dec0 : 0.f, a1 = i0 + 1 >= j ? da.y * dec1 : 0.f, a2 = i0 + 2 >= j ? da.z * dec2 : 0.f, a3 = i0 + 3 >= j ? da.w * dec3 : 0.f;
      const f32x4 pv = {(i0 + 0 == j ? 1.f : 0.f) - l0, (i0 + 1 == j ? 1.f : 0.f) - l1, (i0 + 2 == j ? 1.f : 0.f) - l2, (i0 + 3 == j ? 1.f : 0.f) - l3};
      G2W16(G2_XR0, rowb + u * 32, l0); G2W16(G2_XR0, rowb + 144 + u * 32, l1); G2W16(G2_XR0, rowb + 288 + u * 32, l2); G2W16(G2_XR0, rowb + 432 + u * 32, l3);
      G2W16(G2_PR0, rowb + u * 32, pv.x); G2W16(G2_PR0, rowb + 144 + u * 32, pv.y); G2W16(G2_PR0, rowb + 288 + u * 32, pv.z); G2W16(G2_PR0, rowb + 432 + u * 32, pv.w);
      *(u32x2*)(L + G2_XT0 + colb + u * 2304) = (u32x2){pk2(l0, l1), pk2(l2, l3)};
      bf16_t* am = (bf16_t*)(gb + 2 * 8192 + i0 * 128 + pj * 2);
      am[0] = f2bf(a0); am[64] = f2bf(a1); am[128] = f2bf(a2); am[192] = f2bf(a3);
      Pt[u] = pv; } }
    __syncthreads();
#pragma unroll
    for (int u = 0; u < 4; ++u) {
      f32x4 d = {0.f, 0.f, 0.f, 0.f};
#pragma unroll
      for (int ks = 0; ks < 2; ++ks) d = __builtin_amdgcn_mfma_f32_16x16x32_bf16(G2F(G2_XR0, fa + ks * 64), G2F(G2_XT0, fb + u * 2304 + ks * 64), d, 0, 0, 0);
      G2W16(G2_KB, rowb + u * 32, d.x); G2W16(G2_KB, rowb + 144 + u * 32, d.y); G2W16(G2_KB, rowb + 288 + u * 32, d.z); G2W16(G2_KB, rowb + 432 + u * 32, d.w);
      *(u32x2*)(L + G2_KBB + colb + u * 2304) = (u32x2){pk2(d.x, d.y), pk2(d.z, d.w)}; }
    __syncthreads();
#pragma unroll
    for (int itn = 0; itn < 4; ++itn) {
      const int XRc = (itn & 1) ? G2_XR0 : G2_KB, XTc = (itn & 1) ? G2_XT0 : G2_KBB, XRn = (itn & 1) ? G2_KB : G2_XR0, XTn = (itn & 1) ? G2_KBB : G2_XT0;
      const int PRc = (itn & 1) ? G2_QB : G2_PR0, PRn = (itn & 1) ? G2_PR0 : G2_QB;
#pragma unroll
      for (int u = 0; u < 4; ++u) {
        f32x4 d = {0.f, 0.f, 0.f, 0.f};
#pragma unroll
        for (int ks = 0; ks < 2; ++ks) { const pg8::bf16x8 bx = G2F(XTc, fb + u * 2304 + ks * 64);
          Pt[u] = __builtin_amdgcn_mfma_f32_16x16x32_bf16(G2F(PRc, fa + ks * 64), bx, Pt[u], 0, 0, 0);
          if (itn < 3) d = __builtin_amdgcn_mfma_f32_16x16x32_bf16(G2F(XRc, fa + ks * 64), bx, d, 0, 0, 0); }
        G2W16(PRn, rowb + u * 32, Pt[u].x); G2W16(PRn, rowb + 144 + u * 32, Pt[u].y); G2W16(PRn, rowb + 288 + u * 32, Pt[u].z); G2W16(PRn, rowb + 432 + u * 32, Pt[u].w);
        if (itn < 3) { G2W16(XRn, rowb + u * 32, d.x); G2W16(XRn, rowb + 144 + u * 32, d.y); G2W16(XRn, rowb + 288 + u * 32, d.z); G2W16(XRn, rowb + 432 + u * 32, d.w);
          *(u32x2*)(L + XTn + colb + u * 2304) = (u32x2){pk2(d.x, d.y), pk2(d.z, d.w)}; } }
      __syncthreads();
    }
#pragma unroll
    for (int u = 0; u < 4; ++u) {
      f32x4 du = {0.f, 0.f, 0.f, 0.f}, dw = {0.f, 0.f, 0.f, 0.f};
#pragma unroll
      for (int ks = 0; ks < 2; ++ks) { const pg8::bf16x8 a = G2F(G2_PR0, fa + ks * 64);
        du = __builtin_amdgcn_mfma_f32_16x16x32_bf16(a, G2F(G2_VBT, fb + u * 2304 + ks * 64), du, 0, 0, 0);
        dw = __builtin_amdgcn_mfma_f32_16x16x32_bf16(a, G2F(G2_KBET, fb + u * 2304 + ks * 64), dw, 0, 0, 0); }
      const int j = u * 16 + fr, pj = kperm(j);
      *(u32x2*)(gb + 4 * 8192 + j * 128 + i0 * 2) = (u32x2){pk2(du.x, du.y), pk2(du.z, du.w)};
      bf16_t* wn = (bf16_t*)(gb + i0 * 128 + pj * 2);
      wn[0] = f2bf(-dw.x); wn[64] = f2bf(-dw.y); wn[128] = f2bf(-dw.z); wn[192] = f2bf(-dw.w); }
#undef G2F
#undef G2W16
  }
}

constexpr int GS_SLOT = 46208, GS_OB = 2 * GS_SLOT;
__device__ void phase_gdn_scan(const Ctx& c, unsigned char* L, int item) {
  unsigned char* ws = c.ws;
  const int tid = phase_tid(), lane = tid & 63, wave = tid >> 6, fr = lane & 15, fq = lane >> 4;
  const int b = item / 6, h = item % 6;
  const bf16_t* GB = (const bf16_t*)(ws + WS_GB); unsigned char* CAT = ws + WS_CAT; const float* gng = c.in[9];
  const int lt = tid - 256;
  u32x4 ra[10], rb[10]; float gla = 0.f, glb = 0.f;
  f32x4 S[4];
#pragma unroll
  for (int i = 0; i < 4; ++i) S[i] = (f32x4){0.f, 0.f, 0.f, 0.f};
#define GS_LOAD(R, G, n) do { if ((n) < 64) { const unsigned char* gb_ = gd_item(ws, item * 64 + (n)); _Pragma("unroll") for (int i_ = 0; i_ < 10; ++i_) R[i_] = *(const u32x4*)(gb_ + (size_t)(lt + 256 * i_) * 16); if (lt == 0) G = *(const float*)(gb_ + 40960); } } while (0)
#define GS_STORE(R, G, slot) do { _Pragma("unroll") for (int i_ = 0; i_ < 10; ++i_) { const int p_ = lt + 256 * i_; *(u32x4*)(L + (slot) * GS_SLOT + (p_ >> 9) * 9216 + ((p_ >> 3) & 63) * 144 + (p_ & 7) * 16) = R[i_]; } if (lt == 0) *(float*)(L + (slot) * GS_SLOT + 46080) = G; } while (0)
  float gnr[16];
#pragma unroll
  for (int e = 0; e < 16; ++e) gnr[e] = gng[((tid - 256) & 3) * 16 + e];
  auto zload = [&](int k, u32x4& z0, u32x4& z1) {
    const size_t r = (size_t)b * SEQ + k * 64 + (lt >> 2); const bf16_t* zp = GB + r * 1536 + 1152 + h * 64 + (lt & 3) * 16; z0 = *(const u32x4*)zp; z1 = *(const u32x4*)(zp + 8); };
  auto post = [&](int k, const u32x4 z0, const u32x4 z1) {
    const unsigned char* ob = L + GS_OB + (k & 1) * 9216; const int tk = lt >> 2, part = lt & 3; const size_t r = (size_t)b * SEQ + k * 64 + tk;
    const u32x4 o0 = *(const u32x4*)(ob + tk * 144 + part * 32), o1 = *(const u32x4*)(ob + tk * 144 + part * 32 + 16);
    float ov[16] = {__uint_as_float(o0.x << 16), __uint_as_float(o0.x & 0xffff0000u), __uint_as_float(o0.y << 16), __uint_as_float(o0.y & 0xffff0000u), __uint_as_float(o0.z << 16), __uint_as_float(o0.z & 0xffff0000u), __uint_as_float(o0.w << 16), __uint_as_float(o0.w & 0xffff0000u),
                    __uint_as_float(o1.x << 16), __uint_as_float(o1.x & 0xffff0000u), __uint_as_float(o1.y << 16), __uint_as_float(o1.y & 0xffff0000u), __uint_as_float(o1.z << 16), __uint_as_float(o1.z & 0xffff0000u), __uint_as_float(o1.w << 16), __uint_as_float(o1.w & 0xffff0000u)};
    float ss = 0.f;
#pragma unroll
    for (int e = 0; e < 16; ++e) ss += ov[e] * ov[e];
    ss += __shfl_xor(ss, 1); ss += __shfl_xor(ss, 2);
    const float rstd = rsqrtf(ss * (1.f / 64.f) + 1e-6f);
    const float zf[16] = {__uint_as_float(z0.x << 16), __uint_as_float(z0.x & 0xffff0000u), __uint_as_float(z0.y << 16), __uint_as_float(z0.y & 0xffff0000u), __uint_as_float(z0.z << 16), __uint_as_float(z0.z & 0xffff0000u), __uint_as_float(z0.w << 16), __uint_as_float(z0.w & 0xffff0000u),
                          __uint_as_float(z1.x << 16), __uint_as_float(z1.x & 0xffff0000u), __uint_as_float(z1.y << 16), __uint_as_float(z1.y & 0xffff0000u), __uint_as_float(z1.z << 16), __uint_as_float(z1.z & 0xffff0000u), __uint_as_float(z1.w << 16), __uint_as_float(z1.w & 0xffff0000u)};
#pragma unroll
    for (int e = 0; e < 16; ++e) ov[e] = ov[e] * rstd * gnr[e] * silu_f(zf[e]);
    unsigned char* op = CAT + r * 1024 + 384 + h * 64 + part * 16;
    *(u32x4*)op = (u32x4){cvt4_fp8(ov[0], ov[1], ov[2], ov[3]), cvt4_fp8(ov[4], ov[5], ov[6], ov[7]), cvt4_fp8(ov[8], ov[9], ov[10], ov[11]), cvt4_fp8(ov[12], ov[13], ov[14], ov[15])};
  };
  auto step = [&](int k) {
    const unsigned char* sb = L + (k & 1) * GS_SLOT; const float gl = *(const float*)(sb + 46080);
    const pg8::bf16x8 Sb0 = packp(S[0], S[1]), Sb1 = packp(S[2], S[3]);
    f32x4 vn[4], o[4];
#pragma unroll
    for (int mt = 0; mt < 4; ++mt) { const u32x2 uv = *(const u32x2*)(sb + 4 * 9216 + (wave * 16 + fr) * 144 + (mt * 16 + fq * 4) * 2);
      f32x4 a = {__uint_as_float(uv.x << 16), __uint_as_float(uv.x & 0xffff0000u), __uint_as_float(uv.y << 16), __uint_as_float(uv.y & 0xffff0000u)};
      a = __builtin_amdgcn_mfma_f32_16x16x32_bf16(ldsfrag(sb, mt * 16 + fr, 0, fq), Sb0, a, 0, 0, 0);
      vn[mt] = __builtin_amdgcn_mfma_f32_16x16x32_bf16(ldsfrag(sb, mt * 16 + fr, 1, fq), Sb1, a, 0, 0, 0);
      f32x4 q = {0.f, 0.f, 0.f, 0.f};
      q = __builtin_amdgcn_mfma_f32_16x16x32_bf16(ldsfrag(sb + 9216, mt * 16 + fr, 0, fq), Sb0, q, 0, 0, 0);
      o[mt] = __builtin_amdgcn_mfma_f32_16x16x32_bf16(ldsfrag(sb + 9216, mt * 16 + fr, 1, fq), Sb1, q, 0, 0, 0); }
    const pg8::bf16x8 Vb0 = packp(vn[0], vn[1]), Vb1 = packp(vn[2], vn[3]);
#pragma unroll
    for (int mt = 0; mt < 4; ++mt) { o[mt] = __builtin_amdgcn_mfma_f32_16x16x32_bf16(ldsfrag(sb + 2 * 9216, mt * 16 + fr, 0, fq), Vb0, o[mt], 0, 0, 0);
      o[mt] = __builtin_amdgcn_mfma_f32_16x16x32_bf16(ldsfrag(sb + 2 * 9216, mt * 16 + fr, 1, fq), Vb1, o[mt], 0, 0, 0); }
#pragma unroll
    for (int kt = 0; kt < 4; ++kt) { f32x4 sv = S[kt] * gl;
      sv = __builtin_amdgcn_mfma_f32_16x16x32_bf16(ldsfrag(sb + 3 * 9216, kt * 16 + fr, 0, fq), Vb0, sv, 0, 0, 0);
      S[kt] = __builtin_amdgcn_mfma_f32_16x16x32_bf16(ldsfrag(sb + 3 * 9216, kt * 16 + fr, 1, fq), Vb1, sv, 0, 0, 0); }
    unsigned char* ob = L + GS_OB + (k & 1) * 9216 + (wave * 16 + fr) * 2;
#pragma unroll
    for (int mt = 0; mt < 4; ++mt) { const int t0 = mt * 16 + fq * 4;
      *(bf16_t*)(ob + (t0 + 0) * 144) = f2bf(o[mt].x); *(bf16_t*)(ob + (t0 + 1) * 144) = f2bf(o[mt].y); *(bf16_t*)(ob + (t0 + 2) * 144) = f2bf(o[mt].z); *(bf16_t*)(ob + (t0 + 3) * 144) = f2bf(o[mt].w); }
  };
  __syncthreads();
  u32x4 z0a = {0u, 0u, 0u, 0u}, z0b = z0a, z1a = z0a, z1b = z0a;
  if (wave >= 4) { GS_LOAD(ra, gla, 0); GS_STORE(ra, gla, 0); GS_LOAD(ra, gla, 1); GS_LOAD(rb, glb, 2); zload(0, z0a, z0b); }
  __syncthreads();
#define SCAN_BAR() do { asm volatile("s_waitcnt lgkmcnt(0)" ::: "memory"); __builtin_amdgcn_s_barrier(); asm volatile("" ::: "memory"); } while (0)
  if (wave < 4) {
#pragma unroll 1
    for (int k = 0; k < 64; ++k) { step(k); SCAN_BAR(); }
  } else {
#define GS_LSTEP(R, G, ZA, ZB, kk) do { if ((kk) + 1 < 64) GS_STORE(R, G, ((kk) + 1) & 1); GS_LOAD(R, G, (kk) + 3); if ((kk) > 0) post((kk) - 1, ZA, ZB); if ((kk) + 1 < 64) zload((kk) + 1, ZA, ZB); SCAN_BAR(); } while (0)
#pragma unroll 1
    for (int k = 0; k < 64; k += 2) { GS_LSTEP(ra, gla, z1a, z1b, k); GS_LSTEP(rb, glb, z0a, z0b, k + 1); }
    post(63, z1a, z1b);
#undef GS_LSTEP
  }
#undef SCAN_BAR
#undef GS_LOAD
#undef GS_STORE
}

__device__ __forceinline__ f32x4 bf4(u32x2 p) { return (f32x4){__uint_as_float(p.x << 16), __uint_as_float(p.x & 0xffff0000u), __uint_as_float(p.y << 16), __uint_as_float(p.y & 0xffff0000u)}; }
__device__ void phase_router(const Ctx& c, unsigned char* ldsb) {
  unsigned char* ws = c.ws;
  const int tid = phase_tid(), lane = tid & 63, wave = tid >> 6, fr = lane & 15, fq = lane >> 4;
  float* lg = (float*)(ldsb + wave * 5632);
  const float* bg = c.in[17]; const float* br = c.in[19]; const float* g1 = c.in[14]; const float* b1 = c.in[15];
  const bf16_t* WR = (const bf16_t*)(ws + WS_WR); bf16_t* X1B = (bf16_t*)(ws + WS_X1B);
  unsigned* ctl = (unsigned*)(ws + WS_CTL);
  unsigned* LIST = (unsigned*)(ws + WS_LIST); float* GATEL = (float*)(ws + WS_GATEL); unsigned* TSLOT = (unsigned*)(ws + WS_TSLOT);
  unsigned* cntl = (unsigned*)(ldsb + 46080); unsigned* basel = cntl + 64;
  __syncthreads();
  if (tid < 64) cntl[tid] = 0u;
  __syncthreads();
  for (int tile = blockIdx.x * NWAVES + wave; tile < T / 16; tile += gridDim.x * NWAVES) {
    const int t0 = tile * 16;
    float mean_t = 0.f, rstd_t = 0.f;
#pragma unroll 2
    for (int i = 0; i < 16; ++i) { const u32x2* row = (const u32x2*)(X1B + (size_t)(t0 + i) * 1024);
      f32x4 v[4]; float sm = 0.f;
#pragma unroll
      for (int j = 0; j < 4; ++j) { v[j] = bf4(row[lane + 64 * j]); sm += (v[j].x + v[j].y) + (v[j].z + v[j].w); }
      const float mean = wave_sum(sm) * (1.f / 1024.f); float s2 = 0.f;
#pragma unroll
      for (int j = 0; j < 4; ++j) { v[j] = v[j] - mean; s2 += (v[j].x * v[j].x + v[j].y * v[j].y) + (v[j].z * v[j].z + v[j].w * v[j].w); }
      const float rstd = rsqrtf(wave_sum(s2) * (1.f / 1024.f) + 1e-5f);
      if (fr == i) { mean_t = mean; rstd_t = rstd; } }
    f32x4 acc[5];
#pragma unroll
    for (int nt = 0; nt < 5; ++nt) acc[nt] = (f32x4){0.f, 0.f, 0.f, 0.f};
    bf16_t* xp = X1B + (size_t)(t0 + fr) * 1024 + fq * 8; unsigned char* x8 = ws + WS_X1F + (size_t)(t0 + fr) * 1024 + fq * 8;
    unsigned char* wrl = ldsb + 47104;
    u32x4 wst[5];
#define WR_LOAD(CH) do { _Pragma("unroll") for (int i_ = 0; i_ < 5; ++i_) { const int p_ = tid + 512 * i_; wst[i_] = *(const u32x4*)(WR + (size_t)(p_ >> 5) * 1024 + (CH) * 256 + (p_ & 31) * 8); } } while (0)
#define WR_STORE(BUF) do { _Pragma("unroll") for (int i_ = 0; i_ < 5; ++i_) { const int p_ = tid + 512 * i_; *(u32x4*)(wrl + (BUF) * 42240 + (p_ >> 5) * 528 + (p_ & 31) * 16) = wst[i_]; } } while (0)
    WR_LOAD(0); WR_STORE(0);
    __syncthreads();
#pragma unroll 1
    for (int ch = 0; ch < 4; ++ch) {
      if (ch < 3) WR_LOAD(ch + 1);
      const unsigned char* wb = wrl + (ch & 1) * 42240 + fr * 528 + fq * 16;
#pragma unroll 2
      for (int k8 = 0; k8 < 8; ++k8) { const int ks = ch * 8 + k8;
        const u32x4 yv = *(const u32x4*)(xp + ks * 32);
        const f32x4 ga = *(const f32x4*)(g1 + ks * 32 + fq * 8), gb2 = *(const f32x4*)(g1 + ks * 32 + fq * 8 + 4), ba = *(const f32x4*)(b1 + ks * 32 + fq * 8), bb2 = *(const f32x4*)(b1 + ks * 32 + fq * 8 + 4);
        const f32x4 y0 = {__uint_as_float(yv.x << 16), __uint_as_float(yv.x & 0xffff0000u), __uint_as_float(yv.y << 16), __uint_as_float(yv.y & 0xffff0000u)};
        const f32x4 y1 = {__uint_as_float(yv.z << 16), __uint_as_float(yv.z & 0xffff0000u), __uint_as_float(yv.w << 16), __uint_as_float(yv.w & 0xffff0000u)};
        const f32x4 n0 = (y0 - mean_t) * rstd_t * ga + ba, n1 = (y1 - mean_t) * rstd_t * gb2 + bb2;
        const u32x4 xw = {cvtpk_c(n0.x, n0.y), cvtpk_c(n0.z, n0.w), cvtpk_c(n1.x, n1.y), cvtpk_c(n1.z, n1.w)};
        *(u32x4*)(xp + ks * 32) = xw;
        *(u32x2*)(x8 + ks * 32) = (u32x2){cvt4_fp8(n0.x, n0.y, n0.z, n0.w), cvt4_fp8(n1.x, n1.y, n1.z, n1.w)};
        const pg8::bf16x8 bx = __builtin_bit_cast(pg8::bf16x8, xw);
#pragma unroll
        for (int nt = 0; nt < 5; ++nt) acc[nt] = __builtin_amdgcn_mfma_f32_16x16x32_bf16(*(const pg8::bf16x8*)(wb + nt * 16 * 528 + k8 * 64), bx, acc[nt], 0, 0, 0); }
      if (ch < 3) WR_STORE((ch + 1) & 1);
      __syncthreads();
    }
#undef WR_LOAD
#undef WR_STORE
#pragma unroll
    for (int nt = 0; nt < 5; ++nt) { const int o = nt * 16 + fq * 4; *(f32x4*)(lg + fr * 88 + o) = acc[nt]; }
    asm volatile("s_waitcnt lgkmcnt(0)" ::: "memory");
    int ex1 = 0, ex2 = 0; float gt1 = 0.f, gt2 = 0.f; unsigned lr1 = 0u, lr2 = 0u;
    if (lane < 16) {
      const float* l = lg + lane * 88;
      int grp = 0; float gm = l[0] + bg[0];
      for (int i = 1; i < 8; ++i) { const float v = l[i] + bg[i]; if (v > gm) { gm = v; grp = i; } }
      float gs = 0.f; for (int i = 0; i < 8; ++i) gs += __expf(l[i] + bg[i] - gm);
      const float pgrp = 1.f / gs;
      const float* el = l + 8 + grp * 8; const float* eb = br + grp * 8;
      int i1 = 0; float m1 = el[0] + eb[0]; for (int i = 1; i < 8; ++i) { const float v = el[i] + eb[i]; if (v > m1) { m1 = v; i1 = i; } }
      int i2 = -1; float m2 = -3.0e38f; for (int i = 0; i < 8; ++i) { const float v = el[i] + eb[i]; if (i != i1 && v > m2) { m2 = v; i2 = i; } }
      const float e2 = __expf(m2 - m1), den = 1.f / (1.f + e2);
      gt1 = pgrp * den; gt2 = pgrp * e2 * den;
      ex1 = grp * 8 + i1; ex2 = grp * 8 + i2;
      lr1 = atomicAdd(&cntl[ex1], 1u); lr2 = atomicAdd(&cntl[ex2], 1u);
    }
    __syncthreads();
    if (wave == 0) { const unsigned nloc = cntl[lane]; basel[lane] = nloc ? atomicAdd(&ctl[CW_CNT + lane], nloc) : 0u; }
    __syncthreads();
    if (lane < 16) {
      const int t = t0 + lane; const unsigned r1 = basel[ex1] + lr1, r2 = basel[ex2] + lr2;
      LIST[(size_t)ex1 * 32768 + r1] = (unsigned)t; GATEL[(size_t)ex1 * 32768 + r1] = gt1;
      LIST[(size_t)ex2 * 32768 + r2] = (unsigned)t; GATEL[(size_t)ex2 * 32768 + r2] = gt2;
      TSLOT[(size_t)t * 2 + 0] = ((unsigned)ex1 << 16) | r1; TSLOT[(size_t)t * 2 + 1] = ((unsigned)ex2 << 16) | r2;
    }
    __syncthreads();
    if (tid < 64) cntl[tid] = 0u;
    __syncthreads();
  }
}

__device__ void phase_combine(const Ctx& c, float* lds) {
  unsigned char* ws = c.ws;
  const int tid = phase_tid(), lane = tid & 63, wave = tid >> 6;
  int* offs = (int*)lds; int* cnts = offs + 65;
  expert_offsets(c, offs, cnts, tid);
  const unsigned char* Y = (const unsigned char*)(ws + WS_Y); const unsigned* TSLOT = (const unsigned*)(ws + WS_TSLOT);
  const float* g2 = c.in[23]; const float* b2 = c.in[24];
  for (int t = blockIdx.x * NWAVES + wave; t < T; t += gridDim.x * NWAVES) {
    const unsigned s0 = TSLOT[(size_t)t * 2], s1 = TSLOT[(size_t)t * 2 + 1];
    const size_t r0 = (size_t)offs[s0 >> 16] + (s0 & 0xffffu), r1 = (size_t)offs[s1 >> 16] + (s1 & 0xffffu);
    f32x4* row = (f32x4*)(c.out + (size_t)t * 1024); const u32x2* xrow = (const u32x2*)((const bf16_t*)(ws + WS_X1B) + (size_t)t * 1024);
    f32x4 v[4]; float s = 0.f;
#pragma unroll
    for (int j = 0; j < 4; ++j) { const unsigned ya = ((const unsigned*)(Y + r0 * 1024))[lane + 64 * j], yb = ((const unsigned*)(Y + r1 * 1024))[lane + 64 * j];
      f32x4 x = bf4(xrow[lane + 64 * j]) * ALPHA;
      const hw_f32x2 a01 = __builtin_amdgcn_cvt_pk_f32_fp8(ya, false), a23 = __builtin_amdgcn_cvt_pk_f32_fp8(ya, true), b01 = __builtin_amdgcn_cvt_pk_f32_fp8(yb, false), b23 = __builtin_amdgcn_cvt_pk_f32_fp8(yb, true);
      x.x += (a01.x + b01.x) * 0.015625f; x.y += (a01.y + b01.y) * 0.015625f; x.z += (a23.x + b23.x) * 0.015625f; x.w += (a23.y + b23.y) * 0.015625f;
      v[j] = x; s += (x.x + x.y) + (x.z + x.w); }
    const float mean = wave_sum(s) * (1.f / 1024.f); float s2 = 0.f;
#pragma unroll
    for (int j = 0; j < 4; ++j) { v[j] = v[j] - mean; s2 += (v[j].x * v[j].x + v[j].y * v[j].y) + (v[j].z * v[j].z + v[j].w * v[j].w); }
    const float rstd = rsqrtf(wave_sum(s2) * (1.f / 1024.f) + 1e-5f);
#pragma unroll
    for (int j = 0; j < 4; ++j) { const f32x4 g = ((const f32x4*)g2)[lane + 64 * j], bb = ((const f32x4*)b2)[lane + 64 * j]; row[lane + 64 * j] = v[j] * rstd * g + bb; }
  }
}

constexpr int NPHASE = 11;
__global__ void __launch_bounds__(NTHREADS, 2) mega(Ctx c) {
  float* lds = (float*)lds_raw;
  unsigned* ctl = (unsigned*)(c.ws + WS_CTL);
  unsigned* bar = ctl + CW_BAR;
  if (threadIdx.x == 0) { *(volatile unsigned*)(lds_raw + LDS_WCTR) = 0u; *(volatile unsigned*)(lds_raw + LDS_XBST) = 0u; *(volatile unsigned*)(lds_raw + LDS_XBST + 4) = 0u;
    (void)xb_add(&bar[XB_XCNT(xb_xcc_id())], 1u); }
  __syncthreads();
  phase_prologue(c, lds);
  xcd_barrier(bar);
  phase_inproj_mfma(c, (lds_u8*)lds_raw);
  phase_tiles_queue(c, lds, ctl + CW_Q + 48, TP_WD0 - TP_D1, TP_WD0);
  xcd_barrier(bar);
  phase_gdn_prep2(c, lds_raw);
  phase_kvup(c, lds);
  phase_topk_mfma(c, lds_raw, ctl + CW_Q);
  xcd_barrier(bar);
  if (blockIdx.x < 48) phase_gdn_scan(c, lds_raw, blockIdx.x);
  phase_attn_sparse(c, lds_raw, ctl + CW_Q + 16);
  phase_attn_mem(c, lds_raw, ctl + CW_Q + 32);
  xcd_barrier(bar);
  phase_outproj_mfma(c, (lds_u8*)lds_raw);
  xcd_barrier(bar);
  phase_router(c, lds_raw);
  xcd_barrier(bar);
  phase_moe_up_mfma(c, (lds_u8*)lds_raw);
  phase_tiles_queue(c, lds, ctl + CW_Q + 64, TP_WD0, TP_TOTAL);
  xcd_barrier(bar);
  phase_moe_down_mfma(c, (lds_u8*)lds_raw);
  xcd_barrier(bar);
  phase_combine(c, lds);
}

extern "C" void kernel_launch(void* const* d_in, const int* in_sizes, int n_in, void* d_out, int out_size, void* d_ws, size_t ws_size, hipStream_t stream) {
  static int grid = 0;
  if (grid == 0) {
    if (n_in != 25 || ws_size < WS_END) { fprintf(stderr, "kernel_launch: unexpected n_in %d / ws %zu\n", n_in, ws_size); grid = -1; return; }
    int dev = 0, cus = 0, per_cu = 0;
    hipGetDevice(&dev); hipDeviceGetAttribute(&cus, hipDeviceAttributeMultiprocessorCount, dev);
    hipFuncSetAttribute((const void*)mega, hipFuncAttributeMaxDynamicSharedMemorySize, LDS_BYTES);
    hipOccupancyMaxActiveBlocksPerMultiprocessor(&per_cu, (const void*)mega, NTHREADS, LDS_BYTES);
    if (per_cu < 1) { fprintf(stderr, "kernel_launch: occupancy query says %d blocks/CU\n", per_cu); per_cu = 1; }
    grid = cus * (per_cu < 1 ? 1 : 1);
    (void)hipGetLastError();
  }
  if (grid < 0) return;
  hipMemsetAsync((char*)d_ws + WS_CTL, 0, 32 * 1024, stream);
  Ctx c; memset(&c, 0, sizeof(c));
  for (int i = 0; i < 25; ++i) c.in[i] = (const float*)d_in[i];
  c.out = (float*)d_out; c.ws = (unsigned char*)d_ws;
  hipLaunchKernelGGL(mega, dim3(grid), dim3(NTHREADS), LDS_BYTES, stream, c);
}
```

```cpp
#include <hip/hip_runtime.h>
#include <cstdio>
#include <cstdint>
#include <cstring>

#ifndef ONE_LAUNCH
#define ONE_LAUNCH 1
#endif

typedef unsigned short bf16_t;
typedef float f32x4 __attribute__((ext_vector_type(4)));
typedef unsigned u32x4 __attribute__((ext_vector_type(4)));
typedef unsigned u32x2 __attribute__((ext_vector_type(2)));

constexpr int T = 32768, DM = 1024, SEQ = 4096, NBATCH = 8;
constexpr int NIN = 2816;
constexpr int NMEM = 256, TM = NBATCH * NMEM;
constexpr int NEXP = 64, DE = 256;
constexpr int NTHREADS = 512, NWAVES = 8;
constexpr float ALPHA = 1.189207115002721f;
constexpr float LOG2E = 1.4426950408889634f;
constexpr float QSCALE = 0.125f * LOG2E;

constexpr size_t MiB = 1ull << 20;
constexpr size_t WS_CTL = 0;
constexpr size_t WS_TSLOT = 512 * 1024;
constexpr size_t WS_ROPE = 1 * MiB;
constexpr size_t WS_WKV = 2 * MiB;
constexpr size_t WS_WR = 2 * MiB + 65536;
constexpr size_t WS_WIN = 3 * MiB;
constexpr size_t WS_WO = 9 * MiB;
constexpr size_t WS_WMKV = 11 * MiB;
constexpr size_t WS_MEMB = 12 * MiB;
constexpr size_t WS_WGU = 16 * MiB;
constexpr size_t WS_WD = 80 * MiB;
constexpr size_t WS_XB = 112 * MiB;
constexpr size_t WS_QA = 176 * MiB;
constexpr size_t WS_CKV = 200 * MiB;
constexpr size_t WS_IQ = 208 * MiB;
constexpr size_t WS_IK = 224 * MiB;
constexpr size_t WS_SM = 228 * MiB;
constexpr size_t WS_QC = 230 * MiB;
constexpr size_t WS_GB = 246 * MiB;
constexpr size_t WS_X1F = WS_GB;
constexpr size_t XF_OFF = (size_t)64 * MiB;
constexpr size_t WS_WIN8 = 48 * MiB;
constexpr int IN_F8 = 5;
constexpr float W8SCALE = 32.f, H8SCALE = 8.f;
constexpr size_t WS_MK = 342 * MiB;
constexpr size_t WS_MVT = 343 * MiB;
constexpr size_t WS_KVA = 344 * MiB;
constexpr size_t WS_SEL = 352 * MiB;
constexpr size_t WS_CAT = 368 * MiB;
constexpr size_t WS_X1B = 432 * MiB;
constexpr size_t WS_LIST = 496 * MiB;
constexpr size_t WS_GATEL = 504 * MiB;
constexpr size_t WS_END = 512 * MiB;
constexpr size_t WS_H = 112 * MiB;
constexpr size_t WS_Y = 160 * MiB;

constexpr int CW_CNT = 0;
constexpr int CW_Q = 64;
constexpr int CW_BAR = 4096;

struct Ctx {
  const float* in[25];
  float* out;
  unsigned char* ws;
  int ph_lo, ph_hi;
};


extern __shared__ __attribute__((aligned(16))) unsigned char lds_raw[];
constexpr int LDS_BYTES = 157696;
constexpr int LDS_WCTR = LDS_BYTES - 64;
__device__ __forceinline__ int phase_tid() {
  __syncthreads();
  int l; asm volatile("v_mbcnt_lo_u32_b32 %0, -1, 0\n\tv_mbcnt_hi_u32_b32 %0, -1, %0" : "=v"(l));
  unsigned w = 0u;
  if (l == 0) w = __hip_atomic_fetch_add((__attribute__((address_space(3))) unsigned*)(__attribute__((address_space(3))) unsigned char*)(lds_raw + LDS_WCTR), 1u, __ATOMIC_RELAXED, __HIP_MEMORY_SCOPE_WORKGROUP);
  w = (unsigned)__builtin_amdgcn_readfirstlane((int)w) & 7u;
  return (int)(w * 64u) + l;
}


#define XB_TMO      128
#define XB_XCNT(j)  (256  + 64 * (j))
#define XB_XSUB(j)  (1280 + 64 * (j))
#define XB_XGEN(j)  (2304 + 64 * (j))
#define XB_TOP      3328
#define XB_TOPGEN   3392
#define XCD_BAR_WORDS 3456
#define XB_SPIN_CAP (1u << 18)
constexpr int LDS_XBST = LDS_BYTES - 32;
__device__ __forceinline__ unsigned xb_ld(unsigned* p)              { return __hip_atomic_load(p, __ATOMIC_RELAXED, __HIP_MEMORY_SCOPE_AGENT); }
__device__ __forceinline__ unsigned xb_add(unsigned* p, unsigned v) { return __hip_atomic_fetch_add(p, v, __ATOMIC_RELAXED, __HIP_MEMORY_SCOPE_AGENT); }
__device__ __forceinline__ unsigned xb_xcc_id() { return (unsigned)__builtin_amdgcn_s_getreg((3 << 11) | 20) & 0xFu; }
#define XB_SPIN(cond, bar) do { unsigned _sp = 0; while (cond) { __builtin_amdgcn_s_sleep(1); \
    if ((++_sp & 255u) == 0u) { if (xb_ld(&(bar)[XB_TMO])) break; if (_sp > XB_SPIN_CAP) { atomicAdd(&(bar)[XB_TMO], 1u); break; } } } } while (0)
__device__ __forceinline__ void xcd_barrier_complete(unsigned* bar, unsigned x, unsigned& nloc, unsigned& nx) {
    const unsigned G = gridDim.x;
    unsigned sum, cnt, mine, sp = 0u;
    for (;;) {
        sum = 0u; cnt = 0u; mine = 0u;
#pragma unroll
        for (unsigned j = 0; j < 16; ++j) { const unsigned cc = xb_ld(&bar[XB_XCNT(j)]); sum += cc; cnt += (cc > 0u) ? 1u : 0u; mine = (j == x) ? cc : mine; }
        if (sum == G) break;
        __builtin_amdgcn_s_sleep(1);
        if ((++sp & 255u) == 0u) { if (xb_ld(&bar[XB_TMO])) break; if (sp > XB_SPIN_CAP) { atomicAdd(&bar[XB_TMO], 1u); break; } }
    }
    nloc = mine > 0u ? mine : 1u; nx = cnt > 0u ? cnt : 1u;
}
__device__ __forceinline__ void xcd_barrier(unsigned* bar) {
    asm volatile("s_waitcnt vmcnt(0)" ::: "memory");
    __syncthreads();
    const int btid = phase_tid();
    if (btid == 0) {
        volatile __attribute__((address_space(3))) unsigned* st = (volatile __attribute__((address_space(3))) unsigned*)(__attribute__((address_space(3))) unsigned char*)(lds_raw + LDS_XBST);
        const unsigned x = xb_xcc_id();
        __builtin_amdgcn_s_waitcnt(0);
        unsigned nloc = st[0], nx = st[1];
        if (nloc == 0u) { xcd_barrier_complete(bar, x, nloc, nx); st[0] = nloc; st[1] = nx; }
        const unsigned old = xb_add(&bar[XB_XSUB(x)], 1u);
        const unsigned gen = old / nloc;
        if (old + 1u == (gen + 1u) * nloc) {
            __builtin_amdgcn_fence(__ATOMIC_RELEASE, "agent");
            asm volatile("s_waitcnt vmcnt(0)" ::: "memory");
            const unsigned og = xb_add(&bar[XB_TOP], 1u);
            const unsigned tg = og / nx;
            if (og + 1u == (tg + 1u) * nx) xb_add(&bar[XB_TOPGEN], 1u);
            else XB_SPIN(xb_ld(&bar[XB_TOPGEN]) == tg, bar);
            __builtin_amdgcn_fence(__ATOMIC_ACQUIRE, "agent");
            xb_add(&bar[XB_XGEN(x)], 1u);
            asm volatile("s_waitcnt vmcnt(0)" ::: "memory");
        } else {
            XB_SPIN(xb_ld(&bar[XB_XGEN(x)]) == gen, bar);
            __builtin_amdgcn_fence(__ATOMIC_ACQUIRE, "agent");
            asm volatile("s_waitcnt vmcnt(0)" ::: "memory");
        }
    }
    __syncthreads();
}

__device__ __forceinline__ float bf2f(bf16_t v) { return __uint_as_float(((unsigned)v) << 16); }
typedef float hw_f32x2 __attribute__((ext_vector_type(2))); typedef __bf16 hw_bf16x2 __attribute__((ext_vector_type(2)));
__device__ __forceinline__ unsigned pk2(float lo, float hi) { const hw_f32x2 v = {lo, hi}; const hw_bf16x2 b = __builtin_convertvector(v, hw_bf16x2); return __builtin_bit_cast(unsigned, b); }
__device__ __forceinline__ unsigned cvt4_fp8(float a, float b, float c2, float d) { int w = __builtin_amdgcn_cvt_pk_fp8_f32(a, b, 0, false); w = __builtin_amdgcn_cvt_pk_fp8_f32(c2, d, w, true); return (unsigned)w; }
__device__ __forceinline__ long mk64(unsigned lo, unsigned hi) { return (long)(((unsigned long)hi << 32) | (unsigned long)lo); }
__device__ __forceinline__ bf16_t f2bf(float f) { return (bf16_t)(pk2(f, f) & 0xffffu); }
__device__ __forceinline__ float wave_sum(float v) {
  int x = __float_as_int(v);
  x = __float_as_int(__int_as_float(x) + __int_as_float(__builtin_amdgcn_update_dpp(0, x, 0x111, 0xF, 0xF, true)));
  x = __float_as_int(__int_as_float(x) + __int_as_float(__builtin_amdgcn_update_dpp(0, x, 0x112, 0xF, 0xF, true)));
  x = __float_as_int(__int_as_float(x) + __int_as_float(__builtin_amdgcn_update_dpp(0, x, 0x114, 0xF, 0xF, true)));
  x = __float_as_int(__int_as_float(x) + __int_as_float(__builtin_amdgcn_update_dpp(0, x, 0x118, 0xF, 0xF, true)));
  x = __float_as_int(__int_as_float(x) + __int_as_float(__builtin_amdgcn_update_dpp(0, x, 0x142, 0xA, 0xF, false)));
  x = __float_as_int(__int_as_float(x) + __int_as_float(__builtin_amdgcn_update_dpp(0, x, 0x143, 0xC, 0xF, false)));
  return __int_as_float(__builtin_amdgcn_readlane(x, 63));
}
__device__ __forceinline__ float wave_max(float v) {
#pragma unroll
  for (int o = 32; o >= 1; o >>= 1) v = fmaxf(v, __shfl_xor(v, o));
  return v;
}
__device__ __forceinline__ float silu_f(float v) { return v * __builtin_amdgcn_rcpf(1.f + __expf(-v)); }

__device__ __forceinline__ int ropeperm(int p) { return (p >> 1) + 32 * (p & 1); }
__device__ __forceinline__ int colmap_in(int cp) {
  const int tile = cp >> 8, w = cp & 255;
  if (tile == 0) return (w >> 6) * 64 + ropeperm(w & 63);
  if (tile == 1) { if (w < 128) { const int c = 256 + w; return (c >> 6) * 64 + ropeperm(c & 63); } return 384 + (w - 128); }
  if (tile == 2) return 512 + (w >> 6) * 64 + ropeperm(w & 63);
  if (tile == 3) { if (w < 64) return 768 + ropeperm(w); if (w < 68) return 832 + (w - 64); if (w < 74) return 2372 + (w - 68); if (w < 80) return 2378 + (w - 74); return -1; }
  if (tile == 4) return 2384 + w;
  return 836 + (cp - 1280);
}

struct WorkQ { unsigned* head; volatile int* slot; int nxt; };
__device__ __forceinline__ void wq_init(WorkQ& q, unsigned* head, volatile int* slot, int tid) { q.head = head; q.slot = slot; q.nxt = 0; if (tid == 0) q.nxt = (int)atomicAdd(head, 1u); }
__device__ __forceinline__ int wq_next(WorkQ& q, int tid) {
  __syncthreads();
  if (tid == 0) { *q.slot = q.nxt; q.nxt = (int)atomicAdd(q.head, 1u); }
  __syncthreads();
  return *q.slot;
}

template <bool F8 = false, class CM>
__device__ __forceinline__ void tp_tile(const float* src, int ld, bf16_t* dst, int drow0, int K, int k0, CM cm, float* lds, int tid, float sc8 = 1.f) {
  const int a = tid & 63, b = tid >> 6;
  const int sc = cm(a);
  __syncthreads();
#pragma unroll
  for (int i = 0; i < 8; ++i) { const int kk = b * 8 + i; lds[kk * 65 + a] = sc >= 0 ? src[(size_t)(k0 + kk) * ld + sc] : 0.f; }
  __syncthreads();
  { const int nn = tid >> 3, kc = (tid & 7) * 8;
    const float* p = lds + kc * 65 + nn;
    if constexpr (F8) *(u32x2*)((unsigned char*)dst + (size_t)(drow0 + nn) * K + k0 + kc) = (u32x2){cvt4_fp8(p[0] * sc8, p[65] * sc8, p[130] * sc8, p[195] * sc8), cvt4_fp8(p[260] * sc8, p[325] * sc8, p[390] * sc8, p[455] * sc8)};
    else *(u32x4*)(dst + (size_t)(drow0 + nn) * K + k0 + kc) = (u32x4){pk2(p[0], p[65]), pk2(p[130], p[195]), pk2(p[260], p[325]), pk2(p[390], p[455])}; }
}

constexpr int TP_TOTAL = (NIN / 64) * 16 + 16 * 16 + 8 * 16 + 64 * 8 * 16 + 64 * 16 * 4;
constexpr int TP_WD0 = TP_TOTAL - 64 * 16 * 4;
constexpr int TP_D1 = 5200;
__device__ __forceinline__ void prologue_tiles(const Ctx& c, float* lds, int tid, int lo, int hi, int b0, int nb) {
  unsigned char* ws = c.ws;
  const int n_win = (NIN / 64) * 16, n_wo = 16 * 16, n_wmkv = 8 * 16, n_wgu = 64 * 8 * 16, n_wd = 64 * 16 * 4;
  const int total = n_win + n_wo + n_wmkv + n_wgu + n_wd;
  for (int it = lo + b0; it < hi; it += nb) {
    int r = it;
    if (r < n_win) { const int nt = r / 16, kt = r % 16;
      if (nt >= IN_F8 * 4) tp_tile<true>(c.in[2], 2640, (bf16_t*)(ws + WS_WIN8), nt * 64, 1024, kt * 64, [&](int a) { return colmap_in(nt * 64 + a); }, lds, tid, W8SCALE);
      else tp_tile(c.in[2], 2640, (bf16_t*)(ws + WS_WIN), nt * 64, 1024, kt * 64, [&](int a) { return colmap_in(nt * 64 + a); }, lds, tid);
      continue; } r -= n_win;
    if (r < n_wo) { const int nt = r / 16, kt = r % 16; tp_tile<true>(c.in[13], 1024, (bf16_t*)(ws + WS_WO), nt * 64, 1024, kt * 64, [&](int a) { return nt * 64 + a; }, lds, tid, W8SCALE); continue; } r -= n_wo;
    if (r < n_wmkv) { const int nt = r / 16, kt = r % 16; tp_tile(c.in[12], 512, (bf16_t*)(ws + WS_WMKV), nt * 64, 1024, kt * 64, [&](int a) { return nt * 64 + a; }, lds, tid); continue; } r -= n_wmkv;
    if (r < n_wgu) { const int e = r / 128, q = r % 128, nt = q / 16, kt = q % 16;
      const int pn = nt >> 2, sub = nt & 3, isup = sub >> 1, c0 = pn * 128 + (sub & 1) * 64;
      const float* src = (isup ? c.in[21] : c.in[20]) + (size_t)e * 1024 * 256;
      tp_tile<true>(src, 256, (bf16_t*)(ws + WS_WGU), e * 512 + nt * 64, 1024, kt * 64, [&](int a) { return c0 + a; }, lds, tid, W8SCALE); continue; } r -= n_wgu;
    { const int e = r / 64, q = r % 64, nt = q / 4, kt = q % 4;
      tp_tile<true>(c.in[22] + (size_t)e * 256 * 1024, 1024, (bf16_t*)(ws + WS_WD), e * 1024 + nt * 64, 256, kt * 64, [&](int a) { return nt * 64 + a; }, lds, tid, W8SCALE); }
  }
}

__device__ __forceinline__ void phase_tiles_queue(const Ctx& c, float* lds, unsigned* qhead, int lo, int hi) {
  const int tid = phase_tid();
  volatile int* slot = (volatile int*)(lds + 64 * 65 + 16);
  WorkQ wq; wq_init(wq, qhead, slot, tid);
  const int nitems = (hi - lo + 7) >> 3;
  for (;;) {
    const int item = wq_next(wq, tid);
    if (item >= nitems) break;
    const int t0 = lo + item * 8, t1 = t0 + 8 < hi ? t0 + 8 : hi;
    prologue_tiles(c, lds, tid, t0, t1, 0, 1);
  }
}

__device__ __forceinline__ void phase_prologue(const Ctx& c, float* lds) {
  const int tid = phase_tid(), bid = blockIdx.x, G = gridDim.x;
  unsigned char* ws = c.ws;
  const size_t gtid = (size_t)bid * NTHREADS + tid, gstride = (size_t)G * NTHREADS;
  { const f32x4* x4 = (const f32x4*)c.in[0]; u32x2* o = (u32x2*)c.out;
    unsigned* o8 = (unsigned*)((unsigned char*)c.out + XF_OFF);
    for (size_t i = gtid; i < (size_t)T * DM / 4; i += gstride) { const f32x4 v = x4[i]; o[i] = (u32x2){pk2(v.x, v.y), pk2(v.z, v.w)}; o8[i] = cvt4_fp8(v.x, v.y, v.z, v.w); }
    const f32x4* m4 = (const f32x4*)c.in[1]; u32x2* om = (u32x2*)(ws + WS_MEMB);
    for (size_t i = gtid; i < (size_t)TM * DM / 4; i += gstride) { const f32x4 v = m4[i]; om[i] = (u32x2){pk2(v.x, v.y), pk2(v.z, v.w)}; } }
  { float* cs = (float*)(ws + WS_ROPE); float* sn = cs + SEQ * 32;
    for (size_t i = gtid; i < (size_t)SEQ * 32; i += gstride) { const int s = (int)(i >> 5), d = (int)(i & 31);
      const float inv = 1.0f / powf(10000.0f, (float)d / 32.0f); const float ang = (float)s * inv; float sv, cv; sincosf(ang, &sv, &cv); cs[i] = cv; sn[i] = sv; } }
  { bf16_t* wkv = (bf16_t*)(ws + WS_WKV); const float* g = c.in[3]; const float* wk = c.in[4]; const float* wv = c.in[5];
    for (size_t i = gtid; i < 128 * 128; i += gstride) { const int p = (int)(i >> 7), k = (int)(i & 127);
      const float w = p < 64 ? wk[k * 64 + ropeperm(p)] : wv[k * 64 + (p - 64)]; wkv[i] = f2bf(w * g[k]); }
    bf16_t* wr = (bf16_t*)(ws + WS_WR); const float* wg = c.in[16]; const float* wrt = c.in[18];
    for (size_t i = gtid; i < 80 * 1024; i += gstride) { const int o = (int)(i >> 10), k = (int)(i & 1023); wr[i] = f2bf(o < 8 ? wg[k * 8 + o] : o < 72 ? wrt[k * 64 + (o - 8)] : 0.f); } }
  prologue_tiles(c, lds, tid, 0, TP_WD0 - TP_D1, bid, G);
}

__device__ __forceinline__ void expert_offsets(const Ctx& c, int* offs  , int* cnts  , int tid) {
  const unsigned* ctl = (const unsigned*)(c.ws + WS_CTL);
  __syncthreads();
  if (tid == 0) { int o = 0; for (int e = 0; e < 64; ++e) { const int n = (int)ctl[CW_CNT + e]; cnts[e] = n; offs[e] = o; o += (n + 255) & ~255; } offs[64] = o; }
  __syncthreads();
}


namespace pg8 {
#define PG8_LAS __attribute__((address_space(3)))
typedef short bf16x8 __attribute__((ext_vector_type(8)));
constexpr int BM = 256, BK = 64, HALF = 128, HTB = HALF * BK * 2, STAGE_BYTES = 8 * HTB, NXCD = 8, WGM = 8, GN_STASH = STAGE_BYTES + 2048;
typedef unsigned u32x4s __attribute__((ext_vector_type(4)));
__host__ __device__ __forceinline__ int lds_byte(int r, int c) { const int st = (r >> 4) * 2 + (c >> 5), rr = r & 15, cc = c & 31, ob = rr * 64 + cc * 2; return st * 1024 + (ob ^ (((ob >> 9) & 1) << 5)); }
__host__ __device__ __forceinline__ void stage_rc(int b, int& R, int& C) { const int st = b / 1024, sb = b % 1024, swz = sb ^ (((sb >> 9) & 1) << 5); R = (st >> 1) * 16 + swz / 64; C = (st & 1) * 32 + (swz % 64) / 2; }
__host__ __device__ __forceinline__ int perm32(int rho) { const int n = rho >> 4, i = rho & 15; return 8 * (i >> 2) + 4 * n + (i & 3); }
typedef int i32x4v __attribute__((ext_vector_type(4))); typedef int i32x8 __attribute__((ext_vector_type(8))); typedef long i64x2 __attribute__((ext_vector_type(2)));
struct Unit { int pm, pn, e, mt, aux; };
struct Gemm { const bf16_t* A; const bf16_t* Bt; int K; };
struct StaticOrder {
    int nM, nN, nwg, G, c;
    __device__ void init(int M, int N, int G_, int c_) { nM = M / BM; nN = N / BM; nwg = nM * nN; G = G_; c = c_; }
    __device__ bool next(int i, Unit& u) const {
        const long L = (long)i * G + c; if (c < 0 || L >= nwg) return false;
        int wgid = (int)L; { const int q = nwg / NXCD, r = nwg % NXCD, xcd = wgid % NXCD, off = wgid / NXCD; wgid = (xcd < r ? xcd * (q + 1) : r * (q + 1) + (xcd - r) * q) + off; }
        const int nig = WGM * nN, gid = wgid / nig, fm = gid * WGM, gsz = (nM - fm) < WGM ? (nM - fm) : WGM;
        u.pm = fm + ((wgid % nig) % gsz); u.pn = (wgid % nig) / gsz; u.e = 0; u.mt = 0; u.aux = 0; return true;
    }
    __device__ __forceinline__ unsigned arow(const Unit&, int) const { return 0u; }
};
__device__ __forceinline__ unsigned cvt_pk_bf16(float lo, float hi) { unsigned r; asm volatile("v_cvt_pk_bf16_f32 %0, %1, %2" : "=v"(r) : "v"(lo), "v"(hi)); return r; }

template <class Epi, class Sched, bool ALIGN_EPI, bool GATHER, int FP8 = 0, bool BUF = false>
__device__ __forceinline__ void gemm_phase(PG8_LAS unsigned char* lds, const Gemm g, const Sched& S, const Epi& E, const int tid) {
    const int wid = __builtin_amdgcn_readfirstlane(tid >> 6), lane = tid & 63, wr = wid >> 2, wc = wid & 3, fr = lane & 15, fq = lane >> 4;
    const int K = g.K, nt = K / BK;
    unsigned voffA[2], voffB[2]; int RA[2], CA[2];
#pragma unroll
    for (int i = 0; i < 2; ++i) { int R, C; stage_rc(tid * 16 + i * 8192, R, C); const int Rb = Epi::PERM ? ((R & ~31) + perm32(R & 31)) : R;
        RA[i] = R; CA[i] = C; voffA[i] = (unsigned)(R * K + C) * 2u; voffB[i] = (unsigned)(Rb * K + C) * 2u; }
    const size_t kstep = (size_t)(BK * 2);
    const size_t hstep = (size_t)HALF * K * 2;
    const size_t tstep = 2 * hstep;
    const unsigned ldsw = (unsigned)wid * 1024u;
    const int aoff = lds_byte(wr * 64 + fr, fq * 8), boff = lds_byte(wc * 32 + fr, fq * 8);
#define PG8_FRESH_TID() ([&]() { int l_; asm volatile("v_mbcnt_lo_u32_b32 %0, -1, 0\n\tv_mbcnt_hi_u32_b32 %0, -1, %0" : "=v"(l_)); return wid * 64 + l_; }())
#define PG8_SA(b, h) (((b) * 2 + (h)) * HTB)
#define PG8_SB(b, h) ((4 + (b) * 2 + (h)) * HTB)
    const __amdgpu_buffer_rsrc_t rsA = __builtin_amdgcn_make_buffer_rsrc((void*)g.A, 0, -1, 0x00020000), rsB = __builtin_amdgcn_make_buffer_rsrc((void*)g.Bt, 0, -1, 0x00020000);
#define PG8_STAGE_X(rs, base0, bufoff, gbase, voff) do { _Pragma("unroll") for (int _i = 0; _i < 2; ++_i) { \
        if constexpr (BUF) __builtin_amdgcn_raw_ptr_buffer_load_lds(rs, (PG8_LAS void*)(lds + (bufoff) + ldsw + _i * 8192), 16, (int)(voff)[_i], (int)(unsigned)((const char*)(gbase) - (const char*)(base0)), 0, 0); \
        else __builtin_amdgcn_global_load_lds((const unsigned*)((const char*)(gbase) + (voff)[_i]), (PG8_LAS unsigned*)(lds + (bufoff) + ldsw + _i * 8192), 16, 0, 0); } } while (0)
#define PG8_STAGE(bufoff, gbase, voff) PG8_STAGE_X(rsB, g.Bt, bufoff, gbase, voff)
#define PG8_STAGE_A(bufoff, gbase, h, goff) do { if constexpr (GATHER) { PG8_STAGE_X(rsA, g.A, bufoff, gbase, (goff)[h]); } else { PG8_STAGE_X(rsA, g.A, bufoff, (gbase) + (h) * hstep, voffA); } } while (0)
#define PG8_LDA(dst, b, h) do { _Pragma("unroll") for (int m = 0; m < 4; ++m) _Pragma("unroll") for (int k = 0; k < 2; ++k) dst[m][k] = *(const PG8_LAS bf16x8*)(lds + PG8_SA(b, h) + aoff + m * 2048 + k * 1024); } while (0)
#define PG8_LDB(dst, b, h) do { _Pragma("unroll") for (int n = 0; n < 2; ++n) _Pragma("unroll") for (int k = 0; k < 2; ++k) dst[n][k] = *(const PG8_LAS bf16x8*)(lds + PG8_SB(b, h) + boff + n * 2048 + k * 1024); } while (0)
#define PG8_MMA(ai, bj, At, Bt) do { __builtin_amdgcn_s_setprio(1); \
        if constexpr (FP8 == 2) { _Pragma("unroll") for (int m = 0; m < 4; ++m) _Pragma("unroll") for (int n = 0; n < 2; ++n) { \
            const i32x8 b_ = __builtin_shufflevector(__builtin_bit_cast(i32x4v, Bt[n][0]), __builtin_bit_cast(i32x4v, Bt[n][1]), 0, 1, 2, 3, 4, 5, 6, 7), a_ = __builtin_shufflevector(__builtin_bit_cast(i32x4v, At[m][0]), __builtin_bit_cast(i32x4v, At[m][1]), 0, 1, 2, 3, 4, 5, 6, 7); \
            acc[ai][bj][m][n] = __builtin_amdgcn_mfma_scale_f32_16x16x128_f8f6f4(b_, a_, acc[ai][bj][m][n], 0, 0, 0, 0, 0, 0); } } \
        else if constexpr (FP8 == 1) { _Pragma("unroll") for (int k = 0; k < 2; ++k) _Pragma("unroll") for (int hf = 0; hf < 2; ++hf) _Pragma("unroll") for (int m = 0; m < 4; ++m) _Pragma("unroll") for (int n = 0; n < 2; ++n) { \
            const i64x2 b_ = __builtin_bit_cast(i64x2, Bt[n][k]), a_ = __builtin_bit_cast(i64x2, At[m][k]); \
            acc[ai][bj][m][n] = __builtin_amdgcn_mfma_f32_16x16x32_fp8_fp8(b_[hf], a_[hf], acc[ai][bj][m][n], 0, 0, 0); } } \
        else { _Pragma("unroll") for (int m = 0; m < 4; ++m) _Pragma("unroll") for (int n = 0; n < 2; ++n) _Pragma("unroll") for (int k = 0; k < 2; ++k) \
            acc[ai][bj][m][n] = __builtin_amdgcn_mfma_f32_16x16x32_bf16(Bt[n][k], At[m][k], acc[ai][bj][m][n], 0, 0, 0); } \
        __builtin_amdgcn_s_setprio(0); } while (0)
#define PG8_WAIT_V(n) asm volatile("s_waitcnt vmcnt(" #n ")" ::: "memory")
#define PG8_WAIT_L(n) asm volatile("s_waitcnt lgkmcnt(" #n ")" ::: "memory")
#define PG8_BAR __builtin_amdgcn_s_barrier()
#define PG8_SCHED __builtin_amdgcn_sched_barrier(0)
    Unit cur, nxt; int ui = 0;
    if (!S.next(0, cur)) return;
    f32x4 acc[2][2][4][2];
#pragma unroll
    for (int a = 0; a < 2; ++a)
#pragma unroll
        for (int b = 0; b < 2; ++b)
#pragma unroll
            for (int m = 0; m < 4; ++m)
#pragma unroll
                for (int n = 0; n < 2; ++n) acc[a][b][m][n] = (f32x4){0.f, 0.f, 0.f, 0.f};
    bf16x8 At[4][2], B0[2][2], B1[2][2];
    unsigned gc[2][2], gn[2][2];
    const char* cA; const char* cB = (const char*)g.Bt + (size_t)cur.pn * tstep;
    if constexpr (GATHER) { cA = (const char*)g.A;
#pragma unroll
        for (int h = 0; h < 2; ++h)
#pragma unroll
            for (int i = 0; i < 2; ++i) { gc[h][i] = (S.arow(cur, h * HALF + RA[i]) * (unsigned)K + (unsigned)CA[i]) * 2u; gn[h][i] = gc[h][i]; }
    } else { cA = (const char*)g.A + (size_t)cur.pm * tstep; }
    PG8_STAGE(PG8_SB(0, 0), cB, voffB); PG8_STAGE(PG8_SB(0, 1), cB + hstep, voffB); PG8_STAGE_A(PG8_SA(0, 0), cA, 0, gc); PG8_STAGE_A(PG8_SA(0, 1), cA, 1, gc);
    if (wr == 1) PG8_BAR;
    PG8_WAIT_V(2); PG8_BAR;
    PG8_STAGE(PG8_SB(1, 0), cB + kstep, voffB); PG8_STAGE_A(PG8_SA(1, 0), cA + kstep, 0, gc); PG8_STAGE(PG8_SB(1, 1), cB + hstep + kstep, voffB);
    PG8_WAIT_V(6); PG8_BAR;
    for (;;) {
        const bool has_next = S.next(ui + 1, nxt);
        const char* nA; const char* nB = has_next ? (const char*)g.Bt + (size_t)nxt.pn * tstep : cB;
        if constexpr (GATHER) { nA = cA;
            if (has_next) {
#pragma unroll
                for (int h = 0; h < 2; ++h)
#pragma unroll
                    for (int i = 0; i < 2; ++i) { int R_ = RA[i], C_ = CA[i]; if constexpr (BUF) { const int t2 = PG8_FRESH_TID(); stage_rc(t2 * 16 + i * 8192, R_, C_); }
                        gn[h][i] = (S.arow(nxt, h * HALF + R_) * (unsigned)K + (unsigned)C_) * 2u; }
                if constexpr (BUF) { *(PG8_LAS u32x4s*)(lds + GN_STASH + PG8_FRESH_TID() * 16) = (u32x4s){gn[0][0], gn[0][1], gn[1][0], gn[1][1]}; } }
        } else { nA = has_next ? (const char*)g.A + (size_t)nxt.pm * tstep : cA; }
        unsigned g2[2][2];
#pragma unroll 1
        for (int t = 0; t < nt; t += 2) {
            const bool last = (t == nt - 2);
            const char* a1 = cA + (size_t)(t + 1) * kstep;
            const char* a2 = last ? nA : cA + (size_t)(t + 2) * kstep; const char* b2 = last ? nB : cB + (size_t)(t + 2) * kstep;
            const char* a3 = a2 + kstep; const char* b3 = b2 + kstep;
            if constexpr (GATHER) {
              if constexpr (BUF) {
                if (last && has_next) { const u32x4s v_ = *(const PG8_LAS u32x4s*)(lds + GN_STASH + PG8_FRESH_TID() * 16); g2[0][0] = v_.x; g2[0][1] = v_.y; g2[1][0] = v_.z; g2[1][1] = v_.w; }
                else { g2[0][0] = gc[0][0]; g2[0][1] = gc[0][1]; g2[1][0] = gc[1][0]; g2[1][1] = gc[1][1]; }
              } else {
#pragma unroll
            for (int h = 0; h < 2; ++h)
#pragma unroll
                for (int i = 0; i < 2; ++i) g2[h][i] = last ? gn[h][i] : gc[h][i]; } }
            PG8_LDB(B0, 0, 0); PG8_LDB(B1, 0, 1); PG8_SCHED; PG8_LDA(At, 0, 0); PG8_STAGE_A(PG8_SA(1, 1), a1, 1, gc);
            PG8_WAIT_V(8); PG8_WAIT_L(0); PG8_BAR; PG8_MMA(0, 0, At, B0); PG8_MMA(0, 1, At, B1); PG8_BAR; PG8_SCHED;
            PG8_LDA(At, 0, 1); PG8_STAGE(PG8_SB(0, 0), b2, voffB); PG8_STAGE(PG8_SB(0, 1), b2 + hstep, voffB); PG8_STAGE_A(PG8_SA(0, 0), a2, 0, g2);
            PG8_WAIT_V(8); PG8_WAIT_L(0); PG8_BAR; PG8_MMA(1, 0, At, B0); PG8_MMA(1, 1, At, B1); PG8_BAR; PG8_SCHED;
            PG8_LDB(B0, 1, 0); PG8_LDB(B1, 1, 1); PG8_SCHED; PG8_LDA(At, 1, 0); PG8_STAGE_A(PG8_SA(0, 1), a2, 1, g2);
            PG8_WAIT_V(8); PG8_WAIT_L(0); PG8_BAR; PG8_MMA(0, 0, At, B0); PG8_MMA(0, 1, At, B1); PG8_BAR; PG8_SCHED;
            PG8_LDA(At, 1, 1); PG8_STAGE(PG8_SB(1, 0), b3, voffB); PG8_STAGE(PG8_SB(1, 1), b3 + hstep, voffB); PG8_STAGE_A(PG8_SA(1, 0), a3, 0, g2);
            PG8_WAIT_V(8); PG8_WAIT_L(0); PG8_BAR; PG8_MMA(1, 0, At, B0); PG8_MMA(1, 1, At, B1); PG8_BAR; PG8_SCHED;
        }
        if constexpr (ALIGN_EPI) { if (wr == 0) PG8_BAR; }
        if constexpr (BUF) { const int l2 = PG8_FRESH_TID(); E(acc, cur, wr, wc, l2 & 15, (l2 >> 4) & 3); }
        else E(acc, cur, wr, wc, fr, fq);
        if (!has_next) break;
#pragma unroll
        for (int a = 0; a < 2; ++a)
#pragma unroll
            for (int b = 0; b < 2; ++b)
#pragma unroll
                for (int m = 0; m < 4; ++m)
#pragma unroll
                    for (int n = 0; n < 2; ++n) acc[a][b][m][n] = (f32x4){0.f, 0.f, 0.f, 0.f};
        cur = nxt; cA = nA; cB = nB; ++ui;
        if constexpr (GATHER) {
#pragma unroll
        for (int h = 0; h < 2; ++h)
#pragma unroll
            for (int i = 0; i < 2; ++i) gc[h][i] = BUF ? g2[h][i] : gn[h][i]; }
        if constexpr (ALIGN_EPI) { if (wr == 1) PG8_BAR; }
    }
    PG8_WAIT_V(0);
    if constexpr (!ALIGN_EPI) { if (wr == 0) PG8_BAR; }
    PG8_BAR;
#undef PG8_SA
#undef PG8_FRESH_TID
#undef PG8_SB
#undef PG8_STAGE
#undef PG8_STAGE_X
#undef PG8_STAGE_A
#undef PG8_LDA
#undef PG8_LDB
#undef PG8_MMA
#undef PG8_WAIT_V
#undef PG8_WAIT_L
#undef PG8_BAR
#undef PG8_SCHED
}
}
typedef __attribute__((address_space(3))) unsigned char lds_u8;

__device__ __forceinline__ u32x4 pack8(const f32x4& a, const f32x4& b) { return (u32x4){pg8::cvt_pk_bf16(a.x, a.y), pg8::cvt_pk_bf16(a.z, a.w), pg8::cvt_pk_bf16(b.x, b.y), pg8::cvt_pk_bf16(b.z, b.w)}; }
struct EpiInM {
  static constexpr bool PERM = true;
  unsigned char* ws;
  __device__ __forceinline__ void operator()(const f32x4 (&acc)[2][2][4][2], const pg8::Unit& u, int wr, int wc, int fr, int fq) const {
    const float* cs = (const float*)(ws + WS_ROPE); const float* sn = cs + SEQ * 32;
    const int pn = u.pn;
#pragma unroll
    for (int ai = 0; ai < 2; ++ai)
#pragma unroll
      for (int m = 0; m < 4; ++m) {
        const int row = u.pm * 256 + ai * 128 + wr * 64 + m * 16 + fr, pos = row & (SEQ - 1);
#pragma unroll
        for (int bj = 0; bj < 2; ++bj) {
          const int w = bj * 128 + wc * 32 + 8 * fq;
          f32x4 v0 = acc[ai][bj][m][0], v1 = acc[ai][bj][m][1];
          const bool do_rope = (pn == 0) || (pn == 1 && bj == 0) || (pn == 2) || (pn == 3 && bj == 0 && wc < 2);
          if (do_rope) { const int d = (w & 63) >> 1; const f32x4 c4 = *(const f32x4*)(cs + pos * 32 + d), s4 = *(const f32x4*)(sn + pos * 32 + d);
            const f32x4 o0 = {v0.x * c4.x - v0.y * s4.x, v0.y * c4.x + v0.x * s4.x, v0.z * c4.y - v0.w * s4.y, v0.w * c4.y + v0.z * s4.y};
            const f32x4 o1 = {v1.x * c4.z - v1.y * s4.z, v1.y * c4.z + v1.x * s4.z, v1.z * c4.w - v1.w * s4.w, v1.w * c4.w + v1.z * s4.w};
            v0 = o0; v1 = o1; }
          if (pn == 0) { *(u32x4*)((bf16_t*)(ws + WS_QA) + (size_t)row * 384 + w) = pack8(v0 * QSCALE, v1 * QSCALE); }
          else if (pn == 1) { if (bj == 0) *(u32x4*)((bf16_t*)(ws + WS_QA) + (size_t)row * 384 + 256 + w) = pack8(v0 * QSCALE, v1 * QSCALE);
                              else *(u32x4*)((bf16_t*)(ws + WS_CKV) + (size_t)row * 128 + (w - 128)) = pack8(v0, v1); }
          else if (pn == 2) { *(u32x4*)((bf16_t*)(ws + WS_IQ) + (size_t)row * 256 + w) = pack8(v0, v1); }
          else if (pn == 3) { if (bj == 0) { if (wc < 2) *(u32x4*)((bf16_t*)(ws + WS_IK) + (size_t)row * 64 + w) = pack8(v0, v1);
                                             else if (wc == 2 && fq < 2) { if (fq == 0) v0 = v0 * 0.0625f; float* o = (float*)(ws + WS_SM) + (size_t)row * 16 + 8 * fq; *(f32x4*)o = v0; *(f32x4*)(o + 4) = v1; } } }
          else if (pn == 4) { *(u32x4*)((bf16_t*)(ws + WS_QC) + (size_t)row * 256 + w) = pack8(v0 * QSCALE, v1 * QSCALE); }
          else { *(u32x4*)((bf16_t*)(ws + WS_GB) + (size_t)row * 1536 + (pn - 5) * 256 + w) = pack8(v0, v1); }
        }
      }
  }
};
struct EpiInGB {
  static constexpr bool PERM = true;
  bf16_t* GB;
  __device__ __forceinline__ void operator()(const f32x4 (&acc)[2][2][4][2], const pg8::Unit& u, int wr, int wc, int fr, int fq) const {
#pragma unroll
    for (int ai = 0; ai < 2; ++ai)
#pragma unroll
      for (int m = 0; m < 4; ++m) {
        bf16_t* rp = GB + (size_t)(u.pm * 256 + ai * 128 + wr * 64 + m * 16 + fr) * 1536 + (u.pn + IN_F8 - 5) * 256 + wc * 32 + 8 * fq;
#pragma unroll
        for (int bj = 0; bj < 2; ++bj) *(u32x4*)(rp + bj * 128) = pack8(acc[ai][bj][m][0] * (1.f / W8SCALE), acc[ai][bj][m][1] * (1.f / W8SCALE));
      }
  }
};
__device__ __forceinline__ unsigned pk4_fp8(const f32x4& v) { unsigned w = __builtin_amdgcn_cvt_pk_fp8_f32(v.x, v.y, 0u, false); return __builtin_amdgcn_cvt_pk_fp8_f32(v.z, v.w, w, true); }
struct EpiMemKVM {
  static constexpr bool PERM = true;
  unsigned char* ws;
  __device__ __forceinline__ void operator()(const f32x4 (&acc)[2][2][4][2], const pg8::Unit& u, int wr, int wc, int fr, int fq) const {
#pragma unroll
    for (int ai = 0; ai < 2; ++ai)
#pragma unroll
      for (int m = 0; m < 4; ++m) {
        const int row = u.pm * 256 + ai * 128 + wr * 64 + m * 16 + fr;
#pragma unroll
        for (int bj = 0; bj < 2; ++bj) {
          const int w = bj * 128 + wc * 32 + 8 * fq; const f32x4 v0 = acc[ai][bj][m][0], v1 = acc[ai][bj][m][1];
          const unsigned w0 = pk4_fp8(v0), w1 = pk4_fp8(v1);
          if (u.pn == 0) *(u32x2*)(ws + WS_MK + (size_t)row * 256 + w) = (u32x2){w0, w1};
          else { const int mem = row & 255, xx = mem & 31, mpos = (mem & ~31) + 8 * ((xx >> 2) & 3) + (xx & 3) + 4 * (xx >> 4);
            unsigned char* o = ws + WS_MVT + ((size_t)(row >> 8) * 256 + w) * 256 + mpos;
            o[0] = (unsigned char)w0; o[256] = (unsigned char)(w0 >> 8); o[512] = (unsigned char)(w0 >> 16); o[768] = (unsigned char)(w0 >> 24); o[1024] = (unsigned char)w1; o[1280] = (unsigned char)(w1 >> 8); o[1536] = (unsigned char)(w1 >> 16); o[1792] = (unsigned char)(w1 >> 24); }
        }
      }
  }
};
struct EpiOutM {
  static constexpr bool PERM = true;
  const bf16_t* x; bf16_t* y;
  __device__ __forceinline__ void operator()(const f32x4 (&acc)[2][2][4][2], const pg8::Unit& u, int wr, int wc, int fr, int fq) const {
#pragma unroll
    for (int ai = 0; ai < 2; ++ai)
#pragma unroll
      for (int m = 0; m < 4; ++m) {
        const size_t rb = (size_t)(u.pm * 256 + ai * 128 + wr * 64 + m * 16 + fr) * 1024 + u.pn * 256 + wc * 32 + 8 * fq;
#pragma unroll
        for (int bj = 0; bj < 2; ++bj) { const size_t o = rb + bj * 128; const u32x4 xv = *(const u32x4*)(x + o);
          const f32x4 x0 = {__uint_as_float(xv.x << 16), __uint_as_float(xv.x & 0xffff0000u), __uint_as_float(xv.y << 16), __uint_as_float(xv.y & 0xffff0000u)};
          const f32x4 x1 = {__uint_as_float(xv.z << 16), __uint_as_float(xv.z & 0xffff0000u), __uint_as_float(xv.w << 16), __uint_as_float(xv.w & 0xffff0000u)};
          *(u32x4*)(y + o) = pack8(x0 * ALPHA + acc[ai][bj][m][0] * (1.f / W8SCALE), x1 * ALPHA + acc[ai][bj][m][1] * (1.f / W8SCALE)); }
      }
  }
};
struct MoeOrder {
  const int* offs; const int* cnts; int npn, G, c; const unsigned* LIST;
  __device__ __forceinline__ bool next(int i, pg8::Unit& u) const {
    const int* offs = this->offs; asm volatile("" : "+s"(offs));
    const int L = i * G + c; const int ntiles = __builtin_amdgcn_readfirstlane(offs[64]) >> 8;
    if (L >= ntiles * npn) return false;
    const int rt = L / npn, pl = L - rt * npn; int e = 0;
    while (__builtin_amdgcn_readfirstlane(offs[e + 1]) <= rt * 256) ++e;
    u.pm = rt; u.mt = rt - (__builtin_amdgcn_readfirstlane(offs[e]) >> 8); u.e = e; u.pn = e * npn + pl; u.aux = __builtin_amdgcn_readfirstlane(cnts[e]); return true;
  }
  __device__ __forceinline__ unsigned arow(const pg8::Unit& u, int r) const { const int rank = u.mt * 256 + r; return rank < u.aux ? LIST[(size_t)u.e * 32768 + rank] : 0u; }
};
struct EpiMoeUpM {
  static constexpr bool PERM = true;
  unsigned char* H;
  __device__ __forceinline__ void operator()(const f32x4 (&acc)[2][2][4][2], const pg8::Unit& u, int wr, int wc, int fr, int fq) const {
    const int pl = u.pn & 1;
    int fr_ = fr, fq_ = fq; asm volatile("" : "+v"(fr_), "+v"(fq_));
#pragma unroll
    for (int ai = 0; ai < 2; ++ai)
#pragma unroll
      for (int m = 0; m < 4; ++m) {
        const int rl = ai * 128 + wr * 64 + m * 16 + fr_;
        if (u.mt * 256 + rl < u.aux) {
          f32x4 h0, h1; const float is = 1.f / W8SCALE, us = H8SCALE / W8SCALE; const f32x4 g0 = acc[ai][0][m][0] * is, g1 = acc[ai][0][m][1] * is, u0 = acc[ai][1][m][0] * us, u1 = acc[ai][1][m][1] * us;
          h0.x = silu_f(g0.x) * u0.x; h0.y = silu_f(g0.y) * u0.y; h0.z = silu_f(g0.z) * u0.z; h0.w = silu_f(g0.w) * u0.w;
          h1.x = silu_f(g1.x) * u1.x; h1.y = silu_f(g1.y) * u1.y; h1.z = silu_f(g1.z) * u1.z; h1.w = silu_f(g1.w) * u1.w;
          *(u32x2*)(H + (size_t)(u.pm * 256 + rl) * 256 + pl * 128 + wc * 32 + 8 * fq_) = (u32x2){pk4_fp8(h0), pk4_fp8(h1)};
        }
      }
  }
};
struct EpiMoeDownM {
  static constexpr bool PERM = true;
  unsigned char* Y; const float* GATEL;
  __device__ __forceinline__ void operator()(const f32x4 (&acc)[2][2][4][2], const pg8::Unit& u, int wr, int wc, int fr, int fq) const {
    const int pl = u.pn & 3;
    int fr_ = fr, fq_ = fq; asm volatile("" : "+v"(fr_), "+v"(fq_));
    const float* gp = GATEL + (size_t)u.e * 32768; const int rk0 = u.mt * 256 + wr * 64 + fr_;
    unsigned char* yp = Y + (size_t)(u.pm * 256 + wr * 64 + fr_) * 1024 + pl * 256 + wc * 32 + 8 * fq_;
#pragma unroll
    for (int ai = 0; ai < 2; ++ai)
#pragma unroll
      for (int m = 0; m < 4; ++m) {
        const int rk = rk0 + ai * 128 + m * 16; const float gt = gp[rk < 32767 ? rk : 32767] * (64.0f / (W8SCALE * H8SCALE));
#pragma unroll
        for (int bj = 0; bj < 2; ++bj)
          *(u32x2*)(yp + (size_t)(ai * 128 + m * 16) * 1024 + bj * 128) = (u32x2){pk4_fp8(acc[ai][bj][m][0] * gt), pk4_fp8(acc[ai][bj][m][1] * gt)};
      }
  }
};

__device__ __forceinline__ void phase_inproj_mfma(const Ctx& c, lds_u8* lds) {
  unsigned char* ws = c.ws; const int tid = phase_tid();
  { pg8::Gemm g{(const bf16_t*)c.out, (const bf16_t*)(ws + WS_WIN), 1024}; pg8::StaticOrder S; S.init(T, IN_F8 * 256, gridDim.x, blockIdx.x); EpiInM E{ws};
    pg8::gemm_phase<EpiInM, pg8::StaticOrder, true, false>(lds, g, S, E, tid); }
  { pg8::Gemm g{(const bf16_t*)(ws + WS_MEMB), (const bf16_t*)(ws + WS_WMKV), 1024}; pg8::StaticOrder S; S.init(TM, 512, gridDim.x, (int)blockIdx.x - 128); EpiMemKVM E{ws};
    pg8::gemm_phase<EpiMemKVM, pg8::StaticOrder, true, false>(lds, g, S, E, tid); }
}
__device__ __forceinline__ void phase_inproj_f8(const Ctx& c, lds_u8* lds) {
  unsigned char* ws = c.ws; const int tid = phase_tid();
  pg8::Gemm g{(const bf16_t*)((const unsigned char*)c.out + XF_OFF), (const bf16_t*)(ws + WS_WIN8 + (size_t)IN_F8 * 256 * 1024), 512}; pg8::StaticOrder S; S.init(T, NIN - IN_F8 * 256, gridDim.x, blockIdx.x); EpiInGB E{(bf16_t*)(ws + WS_GB)};
  pg8::gemm_phase<EpiInGB, pg8::StaticOrder, true, false, 2, true>(lds, g, S, E, tid);
}
__device__ __forceinline__ void phase_outproj_mfma(const Ctx& c, lds_u8* lds) {
  unsigned char* ws = c.ws; const int tid = phase_tid();
  pg8::Gemm g{(const bf16_t*)(ws + WS_CAT), (const bf16_t*)(ws + WS_WO), 512}; pg8::StaticOrder S; S.init(T, 1024, gridDim.x, blockIdx.x); EpiOutM E{(const bf16_t*)c.out, (bf16_t*)(ws + WS_X1B)};
  pg8::gemm_phase<EpiOutM, pg8::StaticOrder, true, false, 2, true>(lds, g, S, E, tid);
}
__device__ __forceinline__ void phase_moe_up_mfma(const Ctx& c, lds_u8* lds) {
  unsigned char* ws = c.ws; const int tid = phase_tid();
  int* offs = (int*)((unsigned char*)lds + pg8::STAGE_BYTES); int* cnts = offs + 65;
  expert_offsets(c, offs, cnts, tid);
  pg8::Gemm g{(const bf16_t*)(ws + WS_X1F), (const bf16_t*)(ws + WS_WGU), 512};
  MoeOrder S{offs, cnts, 2, (int)gridDim.x, (int)blockIdx.x, (const unsigned*)(ws + WS_LIST)}; EpiMoeUpM E{ws + WS_H};
  pg8::gemm_phase<EpiMoeUpM, MoeOrder, true, true, 2, true>(lds, g, S, E, tid);
}
__device__ __forceinline__ void phase_moe_down_mfma(const Ctx& c, lds_u8* lds) {
  unsigned char* ws = c.ws; const int tid = phase_tid();
  int* offs = (int*)((unsigned char*)lds + pg8::STAGE_BYTES); int* cnts = offs + 65;
  expert_offsets(c, offs, cnts, tid);
  pg8::Gemm g{(const bf16_t*)(ws + WS_H), (const bf16_t*)(ws + WS_WD), 128};
  MoeOrder S{offs, cnts, 4, (int)gridDim.x, (int)blockIdx.x, nullptr}; EpiMoeDownM E{(unsigned char*)(ws + WS_Y), (const float*)(ws + WS_GATEL)};
  pg8::gemm_phase<EpiMoeDownM, MoeOrder, true, false, 2>(lds, g, S, E, tid);
}

__device__ __forceinline__ void phase_kvup(const Ctx& c, float* lds) {
  unsigned char* ws = c.ws;
  const int tid = phase_tid(), lane = tid & 63, wave = tid >> 6, fr = lane & 15, fq = lane >> 4;
  const bf16_t* W = (const bf16_t*)(ws + WS_WKV);
  const bf16_t* CKV = (const bf16_t*)(ws + WS_CKV); bf16_t* KVA = (bf16_t*)(ws + WS_KVA);
  const float* cs = (const float*)(ws + WS_ROPE); const float* sn = cs + SEQ * 32;
  for (int tile = blockIdx.x * NWAVES + wave; tile < T / 16; tile += gridDim.x * NWAVES) {
    const int t = tile * 16 + fr, pos = t & (SEQ - 1);
    pg8::bf16x8 bx[4]; float ss = 0.f;
#pragma unroll
    for (int ks = 0; ks < 4; ++ks) { const u32x4 v = *(const u32x4*)(CKV + (size_t)t * 128 + ks * 32 + fq * 8); bx[ks] = __builtin_bit_cast(pg8::bf16x8, v);
      const float f[8] = {__uint_as_float(v.x << 16), __uint_as_float(v.x & 0xffff0000u), __uint_as_float(v.y << 16), __uint_as_float(v.y & 0xffff0000u), __uint_as_float(v.z << 16), __uint_as_float(v.z & 0xffff0000u), __uint_as_float(v.w << 16), __uint_as_float(v.w & 0xffff0000u)};
#pragma unroll
      for (int e = 0; e < 8; ++e) ss += f[e] * f[e]; }
    ss += __shfl_xor(ss, 16); ss += __shfl_xor(ss, 32);
    const float rstd = rsqrtf(ss * (1.f / 128.f) + 1e-6f);
#pragma unroll
    for (int nt = 0; nt < 8; ++nt) { f32x4 d = {0.f, 0.f, 0.f, 0.f};
#pragma unroll
      for (int ks = 0; ks < 4; ++ks) d = __builtin_amdgcn_mfma_f32_16x16x32_bf16(*(const pg8::bf16x8*)(W + (size_t)(nt * 16 + fr) * 128 + ks * 32 + fq * 8), bx[ks], d, 0, 0, 0);
      d = d * rstd;
      const int p0 = nt * 16 + fq * 4;
      if (nt < 4) { const int dd = p0 >> 1; const float c0 = cs[pos * 32 + dd], s0 = sn[pos * 32 + dd], c1 = cs[pos * 32 + dd + 1], s1 = sn[pos * 32 + dd + 1];
        const f32x4 o = {d.x * c0 - d.y * s0, d.y * c0 + d.x * s0, d.z * c1 - d.w * s1, d.w * c1 + d.z * s1}; d = o; }
      { int w8 = __builtin_amdgcn_cvt_pk_fp8_f32(d.x, d.y, 0, false); w8 = __builtin_amdgcn_cvt_pk_fp8_f32(d.z, d.w, w8, true);
        *(unsigned*)((unsigned char*)KVA + (size_t)t * 128 + p0) = (unsigned)w8; } }
  }
}


typedef _Float16 h16x2 __attribute__((ext_vector_type(2)));
constexpr int TK_KP = 4104;
constexpr int TK_KEYS = 0, TK_H1 = 16 * TK_KP * 2, TK_H2 = TK_H1 + 16 * 128 * 4, TK_MISC = TK_H2 + 8 * 128 * 4;
__device__ __forceinline__ unsigned mono16x2(unsigned u) { const unsigned m = ((u >> 15) & 0x00010001u) * 0xffffu; return u ^ (m | 0x80008000u); }
__device__ __forceinline__ int wave_incl_scan(int x) {
  x += __builtin_amdgcn_update_dpp(0, x, 0x111, 0xF, 0xF, true);
  x += __builtin_amdgcn_update_dpp(0, x, 0x112, 0xF, 0xF, true);
  x += __builtin_amdgcn_update_dpp(0, x, 0x114, 0xF, 0xF, true);
  x += __builtin_amdgcn_update_dpp(0, x, 0x118, 0xF, 0xF, true);
  x += __builtin_amdgcn_update_dpp(0, x, 0x142, 0xA, 0xF, false);
  x += __builtin_amdgcn_update_dpp(0, x, 0x143, 0xC, 0xF, false);
  return x;
}

__device__ __forceinline__ void hist_find(const unsigned* hw, int need, int lane, int& B, int& above) {
  const unsigned w0 = hw[127 - 2 * lane], w1 = hw[126 - 2 * lane];
  const int c0 = (int)(w0 >> 16), c1 = (int)(w0 & 0xffffu), c2 = (int)(w1 >> 16), c3 = (int)(w1 & 0xffffu);
  const int tl = c0 + c1 + c2 + c3;
  const int incl = wave_incl_scan(tl);
  const int excl = incl - tl;
  const bool hit = (excl < need) && (incl >= need);
  int b = 0, ab = 0;
  if (hit) { int a = excl; b = 255 - 4 * lane; ab = a;
    if (a + c0 < need) { a += c0; b = 254 - 4 * lane; ab = a; if (a + c1 < need) { a += c1; b = 253 - 4 * lane; ab = a; if (a + c2 < need) { a += c2; b = 252 - 4 * lane; ab = a; } } } }
  const unsigned long long m = __ballot(hit);
  const int src = __builtin_amdgcn_readfirstlane(m ? (__ffsll((long long)m) - 1) : 0);
  B = __builtin_amdgcn_readlane(b, src); above = __builtin_amdgcn_readlane(ab, src);
}
__device__ __forceinline__ void phase_topk_mfma(const Ctx& c, unsigned char* ldsb, unsigned* qhead) {
  unsigned char* ws = c.ws;
  const int tid = phase_tid(), lane = tid & 63, wave = tid >> 6, fr = lane & 15, fq = lane >> 4;
  unsigned short* keys = (unsigned short*)(ldsb + TK_KEYS);
  unsigned* h1 = (unsigned*)(ldsb + TK_H1); unsigned* h2 = (unsigned*)(ldsb + TK_H2) + wave * 128; int* misc = (int*)(ldsb + TK_MISC);
  const bf16_t* IQ = (const bf16_t*)(ws + WS_IQ); const bf16_t* IK = (const bf16_t*)(ws + WS_IK); const float* SM = (const float*)(ws + WS_SM);
  unsigned short* SEL = (unsigned short*)(ws + WS_SEL);
  WorkQ wq; wq_init(wq, qhead, misc, tid);
  for (;;) {
    const int item = wq_next(wq, tid);
    if (item >= 240 * 8) break;
    const int b = item & 7, qb = 255 - (item >> 3), s0 = qb * 16;
    for (int i = tid; i < 16 * 128; i += NTHREADS) h1[i] = 0u;
    const size_t qrow = (size_t)b * SEQ + s0 + fr;
    pg8::bf16x8 bq[4][2];
#pragma unroll
    for (int hh = 0; hh < 4; ++hh)
#pragma unroll
      for (int ks = 0; ks < 2; ++ks) bq[hh][ks] = *(const pg8::bf16x8*)(IQ + qrow * 256 + hh * 64 + ks * 32 + fq * 8);
    const f32x4 iw = *(const f32x4*)(SM + qrow * 16);
    const int nkt = qb + 1, slim = s0 + fr;
    __syncthreads();
    pg8::bf16x8 a0n = {0, 0, 0, 0, 0, 0, 0, 0}, a1n = a0n;
    if (wave < nkt) { const bf16_t* kr = IK + ((size_t)b * SEQ + wave * 16 + fr) * 64 + fq * 8; a0n = *(const pg8::bf16x8*)kr; a1n = *(const pg8::bf16x8*)(kr + 32); }
    for (int kt = wave; kt < nkt; kt += NWAVES) {
      const pg8::bf16x8 a0 = a0n, a1 = a1n;
      if (kt + NWAVES < nkt) { const bf16_t* kr = IK + ((size_t)b * SEQ + (kt + NWAVES) * 16 + fr) * 64 + fq * 8; a0n = *(const pg8::bf16x8*)kr; a1n = *(const pg8::bf16x8*)(kr + 32); }
      f32x4 sc = {0.f, 0.f, 0.f, 0.f};
#pragma unroll
      for (int hh = 0; hh < 4; ++hh) { f32x4 d = {0.f, 0.f, 0.f, 0.f};
        d = __builtin_amdgcn_mfma_f32_16x16x32_bf16(a0, bq[hh][0], d, 0, 0, 0); d = __builtin_amdgcn_mfma_f32_16x16x32_bf16(a1, bq[hh][1], d, 0, 0, 0);
        const float w = hh == 0 ? iw.x : hh == 1 ? iw.y : hh == 2 ? iw.z : iw.w;
        sc.x = fmaf(w, fmaxf(d.x, 0.f), sc.x); sc.y = fmaf(w, fmaxf(d.y, 0.f), sc.y); sc.z = fmaf(w, fmaxf(d.z, 0.f), sc.z); sc.w = fmaf(w, fmaxf(d.w, 0.f), sc.w); }
      unsigned k01 = mono16x2(__builtin_bit_cast(unsigned, __builtin_amdgcn_cvt_pkrtz(sc.x, sc.y))), k23 = mono16x2(__builtin_bit_cast(unsigned, __builtin_amdgcn_cvt_pkrtz(sc.z, sc.w)));
      const int kbase = kt * 16 + fq * 4;
      unsigned* hq = h1 + fr * 128;
      if (kt + 1 < nkt) {
        *(u32x2*)(keys + fr * TK_KP + kbase) = (u32x2){k01, k23};
        { const unsigned kk = k01 & 0xffffu; atomicAdd(hq + (kk >> 9), 1u << ((kk >> 4) & 16)); }
        { const unsigned kk = k01 >> 16; atomicAdd(hq + (kk >> 9), 1u << ((kk >> 4) & 16)); }
        { const unsigned kk = k23 & 0xffffu; atomicAdd(hq + (kk >> 9), 1u << ((kk >> 4) & 16)); }
        { const unsigned kk = k23 >> 16; atomicAdd(hq + (kk >> 9), 1u << ((kk >> 4) & 16)); }
      } else {
        if (kbase + 0 > slim) k01 &= 0xffff0000u; if (kbase + 1 > slim) k01 &= 0x0000ffffu;
        if (kbase + 2 > slim) k23 &= 0xffff0000u; if (kbase + 3 > slim) k23 &= 0x0000ffffu;
        *(u32x2*)(keys + fr * TK_KP + kbase) = (u32x2){k01, k23};
        if (kbase + 0 <= slim) { const unsigned kk = k01 & 0xffffu; atomicAdd(hq + (kk >> 9), 1u << ((kk >> 4) & 16)); }
        if (kbase + 1 <= slim) { const unsigned kk = k01 >> 16; atomicAdd(hq + (kk >> 9), 1u << ((kk >> 4) & 16)); }
        if (kbase + 2 <= slim) { const unsigned kk = k23 & 0xffffu; atomicAdd(hq + (kk >> 9), 1u << ((kk >> 4) & 16)); }
        if (kbase + 3 <= slim) { const unsigned kk = k23 >> 16; atomicAdd(hq + (kk >> 9), 1u << ((kk >> 4) & 16)); }
      }
    }
    __syncthreads();
    for (int qi = 0; qi < 2; ++qi) {
      const int q = wave * 2 + qi, s = s0 + q, n = s + 1;
      int B1, above1; hist_find(h1 + q * 128, 256, lane, B1, above1);
      const int need1 = 256 - above1;
      h2[lane] = 0u; h2[64 + lane] = 0u;
      const unsigned short* kq = keys + q * TK_KP;
      const int niter = (n + 511) >> 9;
      for (int it = 0; it < niter; ++it) {
        const int i0 = (it * 64 + lane) * 8; const u32x4 kv = *(const u32x4*)(kq + i0);
        const unsigned k8[8] = {kv.x & 0xffffu, kv.x >> 16, kv.y & 0xffffu, kv.y >> 16, kv.z & 0xffffu, kv.z >> 16, kv.w & 0xffffu, kv.w >> 16};
#pragma unroll
        for (int e = 0; e < 8; ++e) if (i0 + e < n && (int)(k8[e] >> 8) == B1) atomicAdd(h2 + ((k8[e] & 255u) >> 1), 1u << ((k8[e] & 1u) * 16));
      }
      int B2, above2; hist_find(h2, need1, lane, B2, above2);
      const unsigned thr = (unsigned)((B1 << 8) | B2); const int need = need1 - above2;
      unsigned short* dummy = (unsigned short*)(misc + 8 + wave);
      unsigned short* sel = (unsigned short*)h2;
      asm volatile("s_waitcnt lgkmcnt(0)" ::: "memory");
      int tiebase = 0, outbase = 0;
      for (int it = 0; it < niter; ++it) {
        const int i0 = (it * 64 + lane) * 8; const u32x4 kv = *(const u32x4*)(kq + i0);
        const unsigned k8[8] = {kv.x & 0xffffu, kv.x >> 16, kv.y & 0xffffu, kv.y >> 16, kv.z & 0xffffu, kv.z >> 16, kv.w & 0xffffu, kv.w >> 16};
        int cg = 0, ce = 0;
#pragma unroll
        for (int e = 0; e < 8; ++e) { const bool v = i0 + e < n; cg += (v && k8[e] > thr) ? 1 : 0; ce += (v && k8[e] == thr) ? 1 : 0; }
        int tk = 0;
        if (__ballot(ce != 0)) {
          const int eincl = wave_incl_scan(ce); const int eg = tiebase + eincl - ce;
          tk = need - eg; tk = tk < 0 ? 0 : (tk > ce ? ce : tk);
          tiebase += __builtin_amdgcn_readlane(eincl, 63);
        }
        const int oc = cg + tk; const int oincl = wave_incl_scan(oc);
        int pos = outbase + oincl - oc; int tleft = tk;
#pragma unroll
        for (int e = 0; e < 8; ++e) { const bool v = i0 + e < n; const bool tie = v && k8[e] == thr && tleft > 0; const bool take = (v && k8[e] > thr) || tie;
          tleft -= tie ? 1 : 0;
          unsigned short* dst = (take && pos < 256) ? sel + pos : dummy;
          *dst = (unsigned short)(i0 + e); pos += take ? 1 : 0; }
        outbase += __builtin_amdgcn_readlane(oincl, 63);
      }
      asm volatile("s_waitcnt lgkmcnt(0)" ::: "memory");
      *(u32x2*)(SEL + ((size_t)b * SEQ + s) * 256 + lane * 4) = *(const u32x2*)(sel + lane * 4);
      asm volatile("s_waitcnt lgkmcnt(0)" ::: "memory");
    }
  }
}

typedef short s16x4 __attribute__((ext_vector_type(4)));
__device__ __forceinline__ s16x4 lds_tr16(const unsigned char* p) { return __builtin_bit_cast(s16x4, __builtin_amdgcn_ds_read_tr16_b64_v4i16((__attribute__((address_space(3))) s16x4*)(__attribute__((address_space(3))) unsigned char*)p)); }
typedef float f32x2_t __attribute__((ext_vector_type(2))); typedef __bf16 bf16x2_t __attribute__((ext_vector_type(2)));
__device__ __forceinline__ unsigned cvtpk_c(float lo, float hi) { const f32x2_t v = {lo, hi}; const bf16x2_t b = __builtin_convertvector(v, bf16x2_t); return __builtin_bit_cast(unsigned, b); }
__device__ __forceinline__ pg8::bf16x8 packp(const f32x4& a, const f32x4& b) {
  const u32x4 w = {cvtpk_c(a.x, a.y), cvtpk_c(a.z, a.w), cvtpk_c(b.x, b.y), cvtpk_c(b.z, b.w)}; return __builtin_bit_cast(pg8::bf16x8, w); }
constexpr int AT_WB = 9216 + 512;
typedef int v2i_t __attribute__((ext_vector_type(2)));
__device__ __forceinline__ long lds_tr8(const unsigned char* p) { const v2i_t r = __builtin_amdgcn_ds_read_tr8_b64_v2i32((__attribute__((address_space(3))) v2i_t*)(__attribute__((address_space(3))) unsigned char*)p); return (long)(((unsigned long)(unsigned)r.y << 32) | (unsigned long)(unsigned)r.x); }
__device__ __forceinline__ void phase_attn_sparse(const Ctx& c, unsigned char* ldsb, unsigned* qhead) {
  unsigned char* ws = c.ws;
  const int tid = phase_tid(), lane = tid & 63, wave = tid >> 6, fr = lane & 15, fq = lane >> 4;
  unsigned char* vl = ldsb + wave * AT_WB; unsigned short* sl = (unsigned short*)(vl + 9216);
  const bf16_t* QA = (const bf16_t*)(ws + WS_QA); const unsigned char* KVA = (const unsigned char*)(ws + WS_KVA); const unsigned short* SEL = (const unsigned short*)(ws + WS_SEL);
  unsigned char* CAT = ws + WS_CAT;
  const float* gA = c.in[10];
  __syncthreads();
  int* aq_slot = (int*)(ldsb + 8 * AT_WB);
  WorkQ wq; wq_init(wq, qhead, aq_slot, tid);
  const int st_off = (lane >> 3) * 144 + (lane & 7) * 16;
  const int kr_off = fr * 144 + fq * 16;
  const int tr_off = (fq * 4 + ((fr >> 1) & 3) + (fr >> 3) * 16) * 144 + 64 + (fr & 1) * 8;
  for (;;) {
  const int item = wq_next(wq, tid);
  if (item >= 512) break;
  for (int tj = 0; tj < 8; ++tj) {
    const int t = item * 64 + wave * 8 + tj;
    const int b = t >> 12, s = t & (SEQ - 1), n = s + 1 < 256 ? s + 1 : 256;
    { u32x2 v;
      if (s >= 256) v = *(const u32x2*)(SEL + (size_t)t * 256 + lane * 4);
      else { const int i0 = lane * 4; const unsigned e0 = i0 < n ? i0 : 0, e1 = i0 + 1 < n ? i0 + 1 : 0, e2 = i0 + 2 < n ? i0 + 2 : 0, e3 = i0 + 3 < n ? i0 + 3 : 0; v = (u32x2){e0 | (e1 << 16), e2 | (e3 << 16)}; }
      *(u32x2*)(sl + lane * 4) = v; }
    asm volatile("s_waitcnt lgkmcnt(0)" ::: "memory");
    const unsigned char* kvb = KVA + (size_t)b * SEQ * 128;
    u32x4 ra[8], rb[8];
#define KLOAD(R, CH) do { _Pragma("unroll") for (int i_ = 0; i_ < 8; ++i_) { const int key_ = sl[(CH) * 64 + i_ * 8 + (lane >> 3)]; R[i_] = *(const u32x4*)(kvb + (size_t)key_ * 128 + (lane & 7) * 16); } } while (0)
#define KSTORE(R) do { _Pragma("unroll") for (int i_ = 0; i_ < 8; ++i_) *(u32x4*)(vl + i_ * 8 * 144 + st_off) = R[i_]; } while (0)
    KLOAD(ra, 0); KLOAD(rb, 1);
    long q0 = 0, q1 = 0;
    if (fr < 6) { const bf16_t* qp = QA + (size_t)t * 384 + fr * 64 + fq * 16; const u32x4 a = *(const u32x4*)qp, bb = *(const u32x4*)(qp + 8);
      q0 = mk64(cvt4_fp8(__uint_as_float(a.x << 16), __uint_as_float(a.x & 0xffff0000u), __uint_as_float(a.y << 16), __uint_as_float(a.y & 0xffff0000u)),
                cvt4_fp8(__uint_as_float(a.z << 16), __uint_as_float(a.z & 0xffff0000u), __uint_as_float(a.w << 16), __uint_as_float(a.w & 0xffff0000u)));
      q1 = mk64(cvt4_fp8(__uint_as_float(bb.x << 16), __uint_as_float(bb.x & 0xffff0000u), __uint_as_float(bb.y << 16), __uint_as_float(bb.y & 0xffff0000u)),
                cvt4_fp8(__uint_as_float(bb.z << 16), __uint_as_float(bb.z & 0xffff0000u), __uint_as_float(bb.w << 16), __uint_as_float(bb.w & 0xffff0000u))); }
    float m = -3.0e38f, l = 0.f;
    f32x4 ot[4];
#pragma unroll
    for (int mt = 0; mt < 4; ++mt) ot[mt] = (f32x4){0.f, 0.f, 0.f, 0.f};
#define KCHUNK(R, CH) do { \
      KSTORE(R); if ((CH) + 2 < 4) KLOAD(R, (CH) + 2); \
      asm volatile("s_waitcnt lgkmcnt(0)" ::: "memory"); \
      f32x4 st[4]; \
      _Pragma("unroll") for (int kt = 0; kt < 4; ++kt) { const u32x4 a_ = *(const u32x4*)(vl + kt * 16 * 144 + kr_off); f32x4 d_ = {0.f, 0.f, 0.f, 0.f}; \
        d_ = __builtin_amdgcn_mfma_f32_16x16x32_fp8_fp8(mk64(a_.x, a_.y), q0, d_, 0, 0, 0); st[kt] = __builtin_amdgcn_mfma_f32_16x16x32_fp8_fp8(mk64(a_.z, a_.w), q1, d_, 0, 0, 0); } \
      if (n < 256) { _Pragma("unroll") for (int kt = 0; kt < 4; ++kt) { const int sb = (CH) * 64 + kt * 16 + fq * 4; \
        if (sb + 0 >= n) st[kt].x = -3.0e38f; if (sb + 1 >= n) st[kt].y = -3.0e38f; if (sb + 2 >= n) st[kt].z = -3.0e38f; if (sb + 3 >= n) st[kt].w = -3.0e38f; } } \
      float cm = -3.0e38f; \
      _Pragma("unroll") for (int kt = 0; kt < 4; ++kt) cm = fmaxf(fmaxf(fmaxf(cm, st[kt].x), fmaxf(st[kt].y, st[kt].z)), st[kt].w); \
      cm = fmaxf(cm, __shfl_xor(cm, 16)); cm = fmaxf(cm, __shfl_xor(cm, 32)); \
      const float mn = fmaxf(m, cm), al = __builtin_amdgcn_exp2f(m - mn), mb = mn - 8.f; m = mn; \
      float ls = 0.f; \
      _Pragma("unroll") for (int kt = 0; kt < 4; ++kt) { st[kt].x = __builtin_amdgcn_exp2f(st[kt].x - mb); st[kt].y = __builtin_amdgcn_exp2f(st[kt].y - mb); st[kt].z = __builtin_amdgcn_exp2f(st[kt].z - mb); st[kt].w = __builtin_amdgcn_exp2f(st[kt].w - mb); \
        ls += (st[kt].x + st[kt].y) + (st[kt].z + st[kt].w); } \
      l = l * al + ls; \
      _Pragma("unroll") for (int mt = 0; mt < 4; ++mt) ot[mt] = ot[mt] * al; \
      _Pragma("unroll") for (int k2 = 0; k2 < 2; ++k2) { \
        const long pf = mk64(cvt4_fp8(st[2 * k2].x, st[2 * k2].y, st[2 * k2].z, st[2 * k2].w), cvt4_fp8(st[2 * k2 + 1].x, st[2 * k2 + 1].y, st[2 * k2 + 1].z, st[2 * k2 + 1].w)); \
        _Pragma("unroll") for (int mt = 0; mt < 4; ++mt) { const long af = lds_tr8(vl + k2 * 32 * 144 + tr_off + mt * 16); \
          ot[mt] = __builtin_amdgcn_mfma_f32_16x16x32_fp8_fp8(af, pf, ot[mt], 0, 0, 0); } } \
      asm volatile("s_waitcnt lgkmcnt(0)" ::: "memory"); } while (0)
    KCHUNK(ra, 0); KCHUNK(rb, 1); KCHUNK(ra, 2); KCHUNK(rb, 3);
#undef KLOAD
#undef KSTORE
#undef KCHUNK
    l += __shfl_xor(l, 16); l += __shfl_xor(l, 32);
    const float il = __builtin_amdgcn_rcpf(l); float ss = 0.f;
#pragma unroll
    for (int mt = 0; mt < 4; ++mt) { ot[mt] = ot[mt] * il; ss += (ot[mt].x * ot[mt].x + ot[mt].y * ot[mt].y) + (ot[mt].z * ot[mt].z + ot[mt].w * ot[mt].w); }
    if (fr >= 6) ss = 0.f;
#pragma unroll
    for (int o = 1; o < 64; o <<= 1) ss += __shfl_xor(ss, o);
    const float rstd = rsqrtf(ss * (1.f / 384.f) + 1e-6f);
    if (fr < 6) {
#pragma unroll
      for (int mt = 0; mt < 4; ++mt) { const int col = fr * 64 + mt * 16 + fq * 4; const f32x4 g = *(const f32x4*)(gA + col); const f32x4 o = ot[mt] * rstd * g;
        *(unsigned*)(CAT + (size_t)t * 1024 + col) = pk4_fp8(o); } }
  }
  }
}

__device__ __forceinline__ void phase_attn_mem(const Ctx& c, unsigned char* ldsb, unsigned* qhead) {
  unsigned char* ws = c.ws;
  const int tid = phase_tid(), lane = tid & 63, wave = tid >> 6, fr = lane & 15, fq = lane >> 4;
  const bf16_t* QC = (const bf16_t*)(ws + WS_QC); const unsigned char* MK = ws + WS_MK; const unsigned char* MVT = ws + WS_MVT;
  unsigned char* CAT = ws + WS_CAT;
  const float* gC = c.in[11];
  int* aq_slot = (int*)(ldsb + 70656 + 8 * 8192);
  WorkQ wq; wq_init(wq, qhead, aq_slot, tid);
  for (;;) {
  const int item = wq_next(wq, tid) + 512;
  if (item >= 768) break;
  {
    const int t0 = (item - 512) * 128 + wave * 16, b = t0 >> 12;
    unsigned char* mkl = ldsb; unsigned char* mvl = ldsb + 36864; unsigned char* ocl = ldsb + 70656 + wave * 8192;
    float ss = 0.f;
#pragma unroll 1
    for (int h = 0; h < 4; ++h) {
      const bf16_t* qp = QC + (size_t)(t0 + fr) * 256 + h * 64 + fq * 16;
      const u32x4 qa = *(const u32x4*)qp, qb = *(const u32x4*)(qp + 8);
      __syncthreads();
#pragma unroll
      for (int i = 0; i < 2; ++i) { const int p = tid + 512 * i, row = p >> 2, cc = p & 3;
        *(u32x4*)(mkl + row * 80 + cc * 16) = *(const u32x4*)(MK + ((size_t)(b * 256 + row)) * 256 + h * 64 + cc * 16); }
#pragma unroll
      for (int i = 0; i < 2; ++i) { const int p = tid + 512 * i, row = p >> 4, cc = p & 15;
        *(u32x4*)(mvl + row * 272 + cc * 16) = *(const u32x4*)(MVT + ((size_t)(b * 256 + h * 64 + row)) * 256 + cc * 16); }
      const long q0 = mk64(cvt4_fp8(__uint_as_float(qa.x << 16), __uint_as_float(qa.x & 0xffff0000u), __uint_as_float(qa.y << 16), __uint_as_float(qa.y & 0xffff0000u)),
                           cvt4_fp8(__uint_as_float(qa.z << 16), __uint_as_float(qa.z & 0xffff0000u), __uint_as_float(qa.w << 16), __uint_as_float(qa.w & 0xffff0000u)));
      const long q1 = mk64(cvt4_fp8(__uint_as_float(qb.x << 16), __uint_as_float(qb.x & 0xffff0000u), __uint_as_float(qb.y << 16), __uint_as_float(qb.y & 0xffff0000u)),
                           cvt4_fp8(__uint_as_float(qb.z << 16), __uint_as_float(qb.z & 0xffff0000u), __uint_as_float(qb.w << 16), __uint_as_float(qb.w & 0xffff0000u)));
      __syncthreads();
      f32x4 oc[4];
      f32x4 st[16];
#pragma unroll
      for (int kt = 0; kt < 16; ++kt) { const u32x4 a_ = *(const u32x4*)(mkl + (kt * 16 + fr) * 80 + fq * 16);
        f32x4 d = {0.f, 0.f, 0.f, 0.f};
        d = __builtin_amdgcn_mfma_f32_16x16x32_fp8_fp8(mk64(a_.x, a_.y), q0, d, 0, 0, 0); st[kt] = __builtin_amdgcn_mfma_f32_16x16x32_fp8_fp8(mk64(a_.z, a_.w), q1, d, 0, 0, 0); }
      float mx = -3.0e38f;
#pragma unroll
      for (int kt = 0; kt < 16; ++kt) mx = fmaxf(fmaxf(fmaxf(mx, st[kt].x), fmaxf(st[kt].y, st[kt].z)), st[kt].w);
      mx = fmaxf(mx, __shfl_xor(mx, 16)); mx = fmaxf(mx, __shfl_xor(mx, 32));
      mx -= 8.f;
      float l = 0.f;
#pragma unroll
      for (int kt = 0; kt < 16; ++kt) { st[kt].x = __builtin_amdgcn_exp2f(st[kt].x - mx); st[kt].y = __builtin_amdgcn_exp2f(st[kt].y - mx); st[kt].z = __builtin_amdgcn_exp2f(st[kt].z - mx); st[kt].w = __builtin_amdgcn_exp2f(st[kt].w - mx);
        l += (st[kt].x + st[kt].y) + (st[kt].z + st[kt].w); }
      l += __shfl_xor(l, 16); l += __shfl_xor(l, 32);
#pragma unroll
      for (int mt = 0; mt < 4; ++mt) oc[mt] = (f32x4){0.f, 0.f, 0.f, 0.f};
#pragma unroll
      for (int kk = 0; kk < 8; ++kk) { const long pf = mk64(cvt4_fp8(st[2 * kk].x, st[2 * kk].y, st[2 * kk].z, st[2 * kk].w), cvt4_fp8(st[2 * kk + 1].x, st[2 * kk + 1].y, st[2 * kk + 1].z, st[2 * kk + 1].w));
#pragma unroll
        for (int mt = 0; mt < 4; ++mt) { const u32x2 a_ = *(const u32x2*)(mvl + (mt * 16 + fr) * 272 + (kk * 4 + fq) * 8);
          oc[mt] = __builtin_amdgcn_mfma_f32_16x16x32_fp8_fp8(mk64(a_.x, a_.y), pf, oc[mt], 0, 0, 0); } }
      const float il = __builtin_amdgcn_rcpf(l);
#pragma unroll
      for (int mt = 0; mt < 4; ++mt) { const f32x4 o = oc[mt] * il; ss += (o.x * o.x + o.y * o.y) + (o.z * o.z + o.w * o.w); *(u32x2*)(ocl + ((h * 4 + mt) * 64 + lane) * 8) = (u32x2){pg8::cvt_pk_bf16(o.x, o.y), pg8::cvt_pk_bf16(o.z, o.w)}; }
    }
    ss += __shfl_xor(ss, 16); ss += __shfl_xor(ss, 32);
    const float rstd = rsqrtf(ss * (1.f / 256.f) + 1e-6f);
#pragma unroll 1
    for (int h = 0; h < 4; ++h)
#pragma unroll
      for (int mt = 0; mt < 4; ++mt) { const int col = h * 64 + mt * 16 + fq * 4; const f32x4 g = *(const f32x4*)(gC + col); const u32x2 pp = *(const u32x2*)(ocl + ((h * 4 + mt) * 64 + lane) * 8);
        const f32x4 ov = {__uint_as_float(pp.x << 16), __uint_as_float(pp.x & 0xffff0000u), __uint_as_float(pp.y << 16), __uint_as_float(pp.y & 0xffff0000u)}; const f32x4 o = ov * rstd * g;
        *(unsigned*)(CAT + (size_t)(t0 + fr) * 1024 + 768 + col) = pk4_fp8(o); }
  }
  }
}

constexpr int GD_ITEM = 41088;
__device__ __forceinline__ unsigned char* gd_item(unsigned char* ws, int it) { return it < 1536 ? ws + WS_XB + (size_t)it * GD_ITEM : ws + WS_X1B + (size_t)(it - 1536) * GD_ITEM; }
__device__ __forceinline__ int kperm(int x) { return (x & 32) | (((x >> 2) & 3) << 3) | (x & 3) | (((x >> 4) & 1) << 2); }
constexpr int GP_KB = 0, GP_KBB = 9216, GP_QB = 18432, GP_VBT = 27648, GP_KBET = 36864, GP_XR = 46080  , GP_PR = 82944  , GP_OUT = 101376, GP_SC = 142336;
__device__ __forceinline__ pg8::bf16x8 ldsfrag(const unsigned char* base, int row, int ks, int fq) { return *(const pg8::bf16x8*)(base + row * 144 + ks * 64 + fq * 16); }
constexpr int G2_KB = 0, G2_KBB = 9216, G2_QB = 18432, G2_XR0 = 27648, G2_XT0 = 36864, G2_PR0 = 46080, G2_VBT = 55296, G2_KBET = 64512, G2_SC = 73728, G2_CW = 75264, G2_HALF = 78336;
__device__ __forceinline__ void phase_gdn_prep2(const Ctx& c, unsigned char* Lb) {
  unsigned char* ws = c.ws;
  const int tid = phase_tid(), lane = tid & 63, wave = tid >> 6, fr = lane & 15, fq = lane >> 4;
  const int hb = wave >> 2, w4 = wave & 3, htid = tid & 255;
  unsigned char* L = Lb + hb * G2_HALF;
  const bf16_t* GB = (const bf16_t*)(ws + WS_GB); const float* SM = (const float*)(ws + WS_SM);
  const float* convw = c.in[6];
  float* sc = (float*)(L + G2_SC);
  float* cw = (float*)(L + G2_CW);
  const int tt = htid >> 2, part = htid & 3;
  for (int it2 = blockIdx.x; it2 < 1536; it2 += gridDim.x) {
    const int it = it2 * 2 + hb;
    const int n = it & 63, bh = it >> 6, b = bh / 6, h = bh % 6;
    const int t = n * 64 + tt; const size_t r = (size_t)b * SEQ + t;
    unsigned char* gb = gd_item(ws, it);
    __syncthreads();
    for (int i = htid; i < 768; i += 256) { const int j = i / 192, rr = i % 192; cw[i] = convw[j * 1152 + (rr >> 6) * 384 + h * 64 + (rr & 63)]; }
    if (part == 0) { const float a = SM[r * 16 + 4 + h], bb = SM[r * 16 + 10 + h]; const float xs = a + c.in[8][h]; const float sp = xs > 20.f ? xs : log1pf(__expf(xs));
      sc[tt] = -__expf(c.in[7][h]) * sp; sc[192 + tt] = 1.f / (1.f + __expf(-bb)); }
    __syncthreads();
    if (w4 == 0) { float v = sc[lane];
#pragma unroll
      for (int o = 1; o < 64; o <<= 1) { const float u = __shfl_up(v, o); if (lane >= o) v += u; }
      const float last = __shfl(v, 63);
      sc[64 + lane] = v; sc[128 + lane] = __expf(v); sc[256 + lane] = __expf(last - v); if (lane == 0) { sc[320] = __expf(last); *(float*)(gb + 40960) = __expf(last); } }
    float qv[16], kv[16], vv[16];
#pragma unroll
    for (int role = 0; role < 3; ++role) {
      float acc[16];
#pragma unroll
      for (int e = 0; e < 16; ++e) acc[e] = 0.f;
      u32x4 xr[4][2];
#pragma unroll
      for (int j = 0; j < 4; ++j) { const bool ok = t - 3 + j >= 0; const bf16_t* xp = GB + (r - 3 + j) * 1536 + role * 384 + h * 64 + part * 16;
        xr[j][0] = ok ? *(const u32x4*)xp : (u32x4){0u, 0u, 0u, 0u}; xr[j][1] = ok ? *(const u32x4*)(xp + 8) : (u32x4){0u, 0u, 0u, 0u}; }
#pragma unroll
      for (int j = 0; j < 4; ++j)
#pragma unroll
        for (int hh = 0; hh < 2; ++hh) { const u32x4 xvv = xr[j][hh]; const float* wj = cw + j * 192 + role * 64 + part * 16 + hh * 8;
          const f32x4 w0 = *(const f32x4*)wj, w1 = *(const f32x4*)(wj + 4);
          acc[hh * 8 + 0] += w0.x * __uint_as_float(xvv.x << 16); acc[hh * 8 + 1] += w0.y * __uint_as_float(xvv.x & 0xffff0000u); acc[hh * 8 + 2] += w0.z * __uint_as_float(xvv.y << 16); acc[hh * 8 + 3] += w0.w * __uint_as_float(xvv.y & 0xffff0000u);
          acc[hh * 8 + 4] += w1.x * __uint_as_float(xvv.z << 16); acc[hh * 8 + 5] += w1.y * __uint_as_float(xvv.z & 0xffff0000u); acc[hh * 8 + 6] += w1.z * __uint_as_float(xvv.w << 16); acc[hh * 8 + 7] += w1.w * __uint_as_float(xvv.w & 0xffff0000u); }
      float ss = 0.f;
#pragma unroll
      for (int e = 0; e < 16; ++e) { acc[e] = silu_f(acc[e]); ss += acc[e] * acc[e]; }
      if (role < 2) { ss += __shfl_xor(ss, 1); ss += __shfl_xor(ss, 2); const float scl = rsqrtf(ss + 1e-6f) * (role == 0 ? 0.125f : 1.f);
#pragma unroll
        for (int e = 0; e < 16; ++e) acc[e] *= scl; }
#pragma unroll
      for (int e = 0; e < 16; ++e) { if (role == 0) qv[e] = acc[e]; else if (role == 1) kv[e] = acc[e]; else vv[e] = acc[e]; }
    }
    __syncthreads();
    { const float beta = sc[192 + tt], eg = sc[128 + tt], ekl = sc[256 + tt];
      float kb[16];
#pragma unroll
      for (int e = 0; e < 16; ++e) kb[e] = kv[e] * beta;
#pragma unroll
      for (int hh = 0; hh < 2; ++hh) { const int o8 = hh * 8;
        *(u32x4*)(L + G2_KB + tt * 144 + part * 32 + hh * 16) = (u32x4){pk2(kv[o8], kv[o8 + 1]), pk2(kv[o8 + 2], kv[o8 + 3]), pk2(kv[o8 + 4], kv[o8 + 5]), pk2(kv[o8 + 6], kv[o8 + 7])};
        *(u32x4*)(L + G2_KBB + tt * 144 + part * 32 + hh * 16) = (u32x4){pk2(kb[o8], kb[o8 + 1]), pk2(kb[o8 + 2], kb[o8 + 3]), pk2(kb[o8 + 4], kb[o8 + 5]), pk2(kb[o8 + 6], kb[o8 + 7])};
        *(u32x4*)(L + G2_QB + tt * 144 + part * 32 + hh * 16) = (u32x4){pk2(qv[o8], qv[o8 + 1]), pk2(qv[o8 + 2], qv[o8 + 3]), pk2(qv[o8 + 4], qv[o8 + 5]), pk2(qv[o8 + 6], qv[o8 + 7])}; }
      const int ptt = kperm(tt);
#pragma unroll
      for (int e = 0; e < 16; ++e) { const int d = part * 16 + e;
        *(bf16_t*)(L + G2_VBT + d * 144 + tt * 2) = f2bf(vv[e] * beta);
        *(bf16_t*)(L + G2_KBET + d * 144 + tt * 2) = f2bf(kb[e] * eg);
        *(bf16_t*)(gb + 8192 + tt * 128 + kperm(d) * 2) = f2bf(qv[e] * eg);
        *(bf16_t*)(gb + 3 * 8192 + d * 128 + ptt * 2) = f2bf(kv[e] * ekl); } }
    __syncthreads();
    const int rowb = (w4 * 16 + fq * 4) * 144 + fr * 2;
    const int colb = fr * 144 + (w4 * 16 + fq * 4) * 2;
    const int fa = (w4 * 16 + fr) * 144 + fq * 16;
    const int fb = fr * 144 + fq * 16;
    const int i0 = w4 * 16 + fq * 4;
#define G2F(buf, off) (*(const pg8::bf16x8*)(L + (buf) + (off)))
#define G2W16(buf, off, v) (*(bf16_t*)(L + (buf) + (off)) = f2bf(v))
    f32x4 Pt[4];
    { const float gi0 = sc[64 + i0], gi1 = sc[64 + i0 + 1], gi2 = sc[64 + i0 + 2], gi3 = sc[64 + i0 + 3];
#pragma unroll
    for (int u = 0; u < 4; ++u) {
      f32x4 dl = {0.f, 0.f, 0.f, 0.f}, da = {0.f, 0.f, 0.f, 0.f};
#pragma unroll
      for (int ks = 0; ks < 2; ++ks) { const pg8::bf16x8 bk = G2F(G2_KB, fb + u * 2304 + ks * 64);
        dl = __builtin_amdgcn_mfma_f32_16x16x32_bf16(G2F(G2_KBB, fa + ks * 64), bk, dl, 0, 0, 0);
        da = __builtin_amdgcn_mfma_f32_16x16x32_bf16(G2F(G2_QB, fa + ks * 64), bk, da, 0, 0, 0); }
      const int j = u * 16 + fr; const float gj = sc[64 + j]; const int pj = kperm(j);
      const float dec0 = __expf(fminf(gi0 - gj, 0.f)), dec1 = __expf(fminf(gi1 - gj, 0.f)), dec2 = __expf(fminf(gi2 - gj, 0.f)), dec3 = __expf(fminf(gi3 - gj, 0.f));
      const float l0 = i0 + 0 > j ? dl.x * dec0 : 0.f, l1 = i0 + 1 > j ? dl.y * dec1 : 0.f, l2 = i0 + 2 > j ? dl.z * dec2 : 0.f, l3 = i0 + 3 > j ? dl.w * dec3 : 0.f;
      const float a0 = i0 + 0 >= j ? da.x * dec0 : 0.f, a1 = i0 + 1 >= j ? da.y * dec1 : 0.f, a2 = i0 + 2 >= j ? da.z * dec2 : 0.f, a3 = i0 + 3 >= j ? da.w * dec3 : 0.f;
      const f32x4 pv = {(i0 + 0 == j ? 1.f : 0.f) - l0, (i0 + 1 == j ? 1.f : 0.f) - l1, (i0 + 2 == j ? 1.f : 0.f) - l2, (i0 + 3 == j ? 1.f : 0.f) - l3};
      G2W16(G2_XR0, rowb + u * 32, l0); G2W16(G2_XR0, rowb + 144 + u * 32, l1); G2W16(G2_XR0, rowb + 288 + u * 32, l2); G2W16(G2_XR0, rowb + 432 + u * 32, l3);
      G2W16(G2_PR0, rowb + u * 32, pv.x); G2W16(G2_PR0, rowb + 144 + u * 32, pv.y); G2W16(G2_PR0, rowb + 288 + u * 32, pv.z); G2W16(G2_PR0, rowb + 432 + u * 32, pv.w);
      *(u32x2*)(L + G2_XT0 + colb + u * 2304) = (u32x2){pk2(l0, l1), pk2(l2, l3)};
      bf16_t* am = (bf16_t*)(gb + 2 * 8192 + i0 * 128 + pj * 2);
      am[0] = f2bf(a0); am[64] = f2bf(a1); am[128] = f2bf(a2); am[192] = f2bf(a3);
      Pt[u] = pv; } }
    __syncthreads();
#pragma unroll
    for (int u = 0; u < 4; ++u) {
      f32x4 d = {0.f, 0.f, 0.f, 0.f};
#pragma unroll
      for (int ks = 0; ks < 2; ++ks) d = __builtin_amdgcn_mfma_f32_16x16x32_bf16(G2F(G2_XR0, fa + ks * 64), G2F(G2_XT0, fb + u * 2304 + ks * 64), d, 0, 0, 0);
      G2W16(G2_KB, rowb + u * 32, d.x); G2W16(G2_KB, rowb + 144 + u * 32, d.y); G2W16(G2_KB, rowb + 288 + u * 32, d.z); G2W16(G2_KB, rowb + 432 + u * 32, d.w);
      *(u32x2*)(L + G2_KBB + colb + u * 2304) = (u32x2){pk2(d.x, d.y), pk2(d.z, d.w)}; }
    __syncthreads();
#pragma unroll
    for (int itn = 0; itn < 4; ++itn) {
      const int XRc = (itn & 1) ? G2_XR0 : G2_KB, XTc = (itn & 1) ? G2_XT0 : G2_KBB, XRn = (itn & 1) ? G2_KB : G2_XR0, XTn = (itn & 1) ? G2_KBB : G2_XT0;
      const int PRc = (itn & 1) ? G2_QB : G2_PR0, PRn = (itn & 1) ? G2_PR0 : G2_QB;
#pragma unroll
      for (int u = 0; u < 4; ++u) {
        f32x4 d = {0.f, 0.f, 0.f, 0.f};
#pragma unroll
        for (int ks = 0; ks < 2; ++ks) { const pg8::bf16x8 bx = G2F(XTc, fb + u * 2304 + ks * 64);
          Pt[u] = __builtin_amdgcn_mfma_f32_16x16x32_bf16(G2F(PRc, fa + ks * 64), bx, Pt[u], 0, 0, 0);
          if (itn < 3) d = __builtin_amdgcn_mfma_f32_16x16x32_bf16(G2F(XRc, fa + ks * 64), bx, d, 0, 0, 0); }
        G2W16(PRn, rowb + u * 32, Pt[u].x); G2W16(PRn, rowb + 144 + u * 32, Pt[u].y); G2W16(PRn, rowb + 288 + u * 32, Pt[u].z); G2W16(PRn, rowb + 432 + u * 32, Pt[u].w);
        if (itn < 3) { G2W16(XRn, rowb + u * 32, d.x); G2W16(XRn, rowb + 144 + u * 32, d.y); G2W16(XRn, rowb + 288 + u * 32, d.z); G2W16(XRn, rowb + 432 + u * 32, d.w);
          *(u32x2*)(L + XTn + colb + u * 2304) = (u32x2){pk2(d.x, d.y), pk2(d.z, d.w)}; } }
      __syncthreads();
    }
#pragma unroll
    for (int u = 0; u < 4; ++u) {
      f32x4 du = {0.f, 0.f, 0.f, 0.f}, dw = {0.f, 0.f, 0.f, 0.f};
#pragma unroll
      for (int ks = 0; ks < 2; ++ks) { const pg8::bf16x8 a = G2F(G2_PR0, fa + ks * 64);
        du = __builtin_amdgcn_mfma_f32_16x16x32_bf16(a, G2F(G2_VBT, fb + u * 2304 + ks * 64), du, 0, 0, 0);
        dw = __builtin_amdgcn_mfma_f32_16x16x32_bf16(a, G2F(G2_KBET, fb + u * 2304 + ks * 64), dw, 0, 0, 0); }
      const int j = u * 16 + fr, pj = kperm(j);
      *(u32x2*)(gb + 4 * 8192 + j * 128 + i0 * 2) = (u32x2){pk2(du.x, du.y), pk2(du.z, du.w)};
      bf16_t* wn = (bf16_t*)(gb + i0 * 128 + pj * 2);
      wn[0] = f2bf(-dw.x); wn[64] = f2bf(-dw.y); wn[128] = f2bf(-dw.z); wn[192] = f2bf(-dw.w); }
#undef G2F
#undef G2W16
  }
}

constexpr int GS_SLOT = 46208, GS_OB = 2 * GS_SLOT;
__device__ __forceinline__ void phase_gdn_scan(const Ctx& c, unsigned char* L, int item) {
  unsigned char* ws = c.ws;
  const int tid = phase_tid(), lane = tid & 63, wave = tid >> 6, fr = lane & 15, fq = lane >> 4;
  const int b = item / 6, h = item % 6;
  const bf16_t* GB = (const bf16_t*)(ws + WS_GB); unsigned char* CAT = ws + WS_CAT; const float* gng = c.in[9];
  const int lt = tid - 256;
  u32x4 ra[10], rb[10]; float gla = 0.f, glb = 0.f;
  f32x4 S[4];
#pragma unroll
  for (int i = 0; i < 4; ++i) S[i] = (f32x4){0.f, 0.f, 0.f, 0.f};
#define GS_LOAD(R, G, n) do { if ((n) < 64) { const unsigned char* gb_ = gd_item(ws, item * 64 + (n)); _Pragma("unroll") for (int i_ = 0; i_ < 10; ++i_) R[i_] = *(const u32x4*)(gb_ + (size_t)(lt + 256 * i_) * 16); if (lt == 0) G = *(const float*)(gb_ + 40960); } } while (0)
#define GS_STORE(R, G, slot) do { _Pragma("unroll") for (int i_ = 0; i_ < 10; ++i_) { const int p_ = lt + 256 * i_; *(u32x4*)(L + (slot) * GS_SLOT + (p_ >> 9) * 9216 + ((p_ >> 3) & 63) * 144 + (p_ & 7) * 16) = R[i_]; } if (lt == 0) *(float*)(L + (slot) * GS_SLOT + 46080) = G; } while (0)
  float gnr[16];
#pragma unroll
  for (int e = 0; e < 16; ++e) gnr[e] = gng[((tid - 256) & 3) * 16 + e];
  auto zload = [&](int k, u32x4& z0, u32x4& z1) {
    const size_t r = (size_t)b * SEQ + k * 64 + (lt >> 2); const bf16_t* zp = GB + r * 1536 + 1152 + h * 64 + (lt & 3) * 16; z0 = *(const u32x4*)zp; z1 = *(const u32x4*)(zp + 8); };
  auto post = [&](int k, const u32x4 z0, const u32x4 z1) {
    const unsigned char* ob = L + GS_OB + (k & 1) * 9216; const int tk = lt >> 2, part = lt & 3; const size_t r = (size_t)b * SEQ + k * 64 + tk;
    const u32x4 o0 = *(const u32x4*)(ob + tk * 144 + part * 32), o1 = *(const u32x4*)(ob + tk * 144 + part * 32 + 16);
    float ov[16] = {__uint_as_float(o0.x << 16), __uint_as_float(o0.x & 0xffff0000u), __uint_as_float(o0.y << 16), __uint_as_float(o0.y & 0xffff0000u), __uint_as_float(o0.z << 16), __uint_as_float(o0.z & 0xffff0000u), __uint_as_float(o0.w << 16), __uint_as_float(o0.w & 0xffff0000u),
                    __uint_as_float(o1.x << 16), __uint_as_float(o1.x & 0xffff0000u), __uint_as_float(o1.y << 16), __uint_as_float(o1.y & 0xffff0000u), __uint_as_float(o1.z << 16), __uint_as_float(o1.z & 0xffff0000u), __uint_as_float(o1.w << 16), __uint_as_float(o1.w & 0xffff0000u)};
    float ss = 0.f;
#pragma unroll
    for (int e = 0; e < 16; ++e) ss += ov[e] * ov[e];
    ss += __shfl_xor(ss, 1); ss += __shfl_xor(ss, 2);
    const float rstd = rsqrtf(ss * (1.f / 64.f) + 1e-6f);
    const float zf[16] = {__uint_as_float(z0.x << 16), __uint_as_float(z0.x & 0xffff0000u), __uint_as_float(z0.y << 16), __uint_as_float(z0.y & 0xffff0000u), __uint_as_float(z0.z << 16), __uint_as_float(z0.z & 0xffff0000u), __uint_as_float(z0.w << 16), __uint_as_float(z0.w & 0xffff0000u),
                          __uint_as_float(z1.x << 16), __uint_as_float(z1.x & 0xffff0000u), __uint_as_float(z1.y << 16), __uint_as_float(z1.y & 0xffff0000u), __uint_as_float(z1.z << 16), __uint_as_float(z1.z & 0xffff0000u), __uint_as_float(z1.w << 16), __uint_as_float(z1.w & 0xffff0000u)};
#pragma unroll
    for (int e = 0; e < 16; ++e) ov[e] = ov[e] * rstd * gnr[e] * silu_f(zf[e]);
    unsigned char* op = CAT + r * 1024 + 384 + h * 64 + part * 16;
    *(u32x4*)op = (u32x4){cvt4_fp8(ov[0], ov[1], ov[2], ov[3]), cvt4_fp8(ov[4], ov[5], ov[6], ov[7]), cvt4_fp8(ov[8], ov[9], ov[10], ov[11]), cvt4_fp8(ov[12], ov[13], ov[14], ov[15])};
  };
  auto step = [&](int k) {
    const unsigned char* sb = L + (k & 1) * GS_SLOT; const float gl = *(const float*)(sb + 46080);
    const pg8::bf16x8 Sb0 = packp(S[0], S[1]), Sb1 = packp(S[2], S[3]);
    f32x4 vn[4], o[4];
#pragma unroll
    for (int mt = 0; mt < 4; ++mt) { const u32x2 uv = *(const u32x2*)(sb + 4 * 9216 + (wave * 16 + fr) * 144 + (mt * 16 + fq * 4) * 2);
      f32x4 a = {__uint_as_float(uv.x << 16), __uint_as_float(uv.x & 0xffff0000u), __uint_as_float(uv.y << 16), __uint_as_float(uv.y & 0xffff0000u)};
      a = __builtin_amdgcn_mfma_f32_16x16x32_bf16(ldsfrag(sb, mt * 16 + fr, 0, fq), Sb0, a, 0, 0, 0);
      vn[mt] = __builtin_amdgcn_mfma_f32_16x16x32_bf16(ldsfrag(sb, mt * 16 + fr, 1, fq), Sb1, a, 0, 0, 0);
      f32x4 q = {0.f, 0.f, 0.f, 0.f};
      q = __builtin_amdgcn_mfma_f32_16x16x32_bf16(ldsfrag(sb + 9216, mt * 16 + fr, 0, fq), Sb0, q, 0, 0, 0);
      o[mt] = __builtin_amdgcn_mfma_f32_16x16x32_bf16(ldsfrag(sb + 9216, mt * 16 + fr, 1, fq), Sb1, q, 0, 0, 0); }
    const pg8::bf16x8 Vb0 = packp(vn[0], vn[1]), Vb1 = packp(vn[2], vn[3]);
#pragma unroll
    for (int mt = 0; mt < 4; ++mt) { o[mt] = __builtin_amdgcn_mfma_f32_16x16x32_bf16(ldsfrag(sb + 2 * 9216, mt * 16 + fr, 0, fq), Vb0, o[mt], 0, 0, 0);
      o[mt] = __builtin_amdgcn_mfma_f32_16x16x32_bf16(ldsfrag(sb + 2 * 9216, mt * 16 + fr, 1, fq), Vb1, o[mt], 0, 0, 0); }
#pragma unroll
    for (int kt = 0; kt < 4; ++kt) { f32x4 sv = S[kt] * gl;
      sv = __builtin_amdgcn_mfma_f32_16x16x32_bf16(ldsfrag(sb + 3 * 9216, kt * 16 + fr, 0, fq), Vb0, sv, 0, 0, 0);
      S[kt] = __builtin_amdgcn_mfma_f32_16x16x32_bf16(ldsfrag(sb + 3 * 9216, kt * 16 + fr, 1, fq), Vb1, sv, 0, 0, 0); }
    unsigned char* ob = L + GS_OB + (k & 1) * 9216 + (wave * 16 + fr) * 2;
#pragma unroll
    for (int mt = 0; mt < 4; ++mt) { const int t0 = mt * 16 + fq * 4;
      *(bf16_t*)(ob + (t0 + 0) * 144) = f2bf(o[mt].x); *(bf16_t*)(ob + (t0 + 1) * 144) = f2bf(o[mt].y); *(bf16_t*)(ob + (t0 + 2) * 144) = f2bf(o[mt].z); *(bf16_t*)(ob + (t0 + 3) * 144) = f2bf(o[mt].w); }
  };
  __syncthreads();
  u32x4 z0a = {0u, 0u, 0u, 0u}, z0b = z0a, z1a = z0a, z1b = z0a;
  if (wave >= 4) { GS_LOAD(ra, gla, 0); GS_STORE(ra, gla, 0); GS_LOAD(ra, gla, 1); GS_LOAD(rb, glb, 2); zload(0, z0a, z0b); }
  __syncthreads();
#define SCAN_BAR() do { asm volatile("s_waitcnt lgkmcnt(0)" ::: "memory"); __builtin_amdgcn_s_barrier(); asm volatile("" ::: "memory"); } while (0)
  if (wave < 4) {
#pragma unroll 1
    for (int k = 0; k < 64; ++k) { step(k); SCAN_BAR(); }
  } else {
#define GS_LSTEP(R, G, ZA, ZB, kk) do { if ((kk) + 1 < 64) GS_STORE(R, G, ((kk) + 1) & 1); GS_LOAD(R, G, (kk) + 3); if ((kk) > 0) post((kk) - 1, ZA, ZB); if ((kk) + 1 < 64) zload((kk) + 1, ZA, ZB); SCAN_BAR(); } while (0)
#pragma unroll 1
    for (int k = 0; k < 64; k += 2) { GS_LSTEP(ra, gla, z1a, z1b, k); GS_LSTEP(rb, glb, z0a, z0b, k + 1); }
    post(63, z1a, z1b);
#undef GS_LSTEP
  }
#undef SCAN_BAR
#undef GS_LOAD
#undef GS_STORE
}

__device__ __forceinline__ f32x4 bf4(u32x2 p) { return (f32x4){__uint_as_float(p.x << 16), __uint_as_float(p.x & 0xffff0000u), __uint_as_float(p.y << 16), __uint_as_float(p.y & 0xffff0000u)}; }
__device__ __forceinline__ void phase_router(const Ctx& c, unsigned char* ldsb) {
  unsigned char* ws = c.ws;
  const int tid = phase_tid(), lane = tid & 63, wave = tid >> 6, fr = lane & 15, fq = lane >> 4;
  float* lg = (float*)(ldsb + wave * 5632);
  const float* bg = c.in[17]; const float* br = c.in[19]; const float* g1 = c.in[14]; const float* b1 = c.in[15];
  const bf16_t* WR = (const bf16_t*)(ws + WS_WR); bf16_t* X1B = (bf16_t*)(ws + WS_X1B);
  unsigned* ctl = (unsigned*)(ws + WS_CTL);
  unsigned* LIST = (unsigned*)(ws + WS_LIST); float* GATEL = (float*)(ws + WS_GATEL); unsigned* TSLOT = (unsigned*)(ws + WS_TSLOT);
  unsigned* cntl = (unsigned*)(ldsb + 46080); unsigned* basel = cntl + 64;
  __syncthreads();
  if (tid < 64) cntl[tid] = 0u;
  __syncthreads();
  for (int tile = blockIdx.x * NWAVES + wave; tile < T / 16; tile += gridDim.x * NWAVES) {
    const int t0 = tile * 16;
    float mean_t = 0.f, rstd_t = 0.f;
#pragma unroll 2
    for (int i = 0; i < 16; ++i) { const u32x2* row = (const u32x2*)(X1B + (size_t)(t0 + i) * 1024);
      f32x4 v[4]; float sm = 0.f;
#pragma unroll
      for (int j = 0; j < 4; ++j) { v[j] = bf4(row[lane + 64 * j]); sm += (v[j].x + v[j].y) + (v[j].z + v[j].w); }
      const float mean = wave_sum(sm) * (1.f / 1024.f); float s2 = 0.f;
#pragma unroll
      for (int j = 0; j < 4; ++j) { v[j] = v[j] - mean; s2 += (v[j].x * v[j].x + v[j].y * v[j].y) + (v[j].z * v[j].z + v[j].w * v[j].w); }
      const float rstd = rsqrtf(wave_sum(s2) * (1.f / 1024.f) + 1e-5f);
      if (fr == i) { mean_t = mean; rstd_t = rstd; } }
    f32x4 acc[5];
#pragma unroll
    for (int nt = 0; nt < 5; ++nt) acc[nt] = (f32x4){0.f, 0.f, 0.f, 0.f};
    bf16_t* xp = X1B + (size_t)(t0 + fr) * 1024 + fq * 8; unsigned char* x8 = ws + WS_X1F + (size_t)(t0 + fr) * 1024 + fq * 8;
    unsigned char* wrl = ldsb + 47104;
    u32x4 wst[5];
#define WR_LOAD(CH) do { _Pragma("unroll") for (int i_ = 0; i_ < 5; ++i_) { const int p_ = tid + 512 * i_; wst[i_] = *(const u32x4*)(WR + (size_t)(p_ >> 5) * 1024 + (CH) * 256 + (p_ & 31) * 8); } } while (0)
#define WR_STORE(BUF) do { _Pragma("unroll") for (int i_ = 0; i_ < 5; ++i_) { const int p_ = tid + 512 * i_; *(u32x4*)(wrl + (BUF) * 42240 + (p_ >> 5) * 528 + (p_ & 31) * 16) = wst[i_]; } } while (0)
    WR_LOAD(0); WR_STORE(0);
    __syncthreads();
#pragma unroll 1
    for (int ch = 0; ch < 4; ++ch) {
      if (ch < 3) WR_LOAD(ch + 1);
      const unsigned char* wb = wrl + (ch & 1) * 42240 + fr * 528 + fq * 16;
#pragma unroll 2
      for (int k8 = 0; k8 < 8; ++k8) { const int ks = ch * 8 + k8;
        const u32x4 yv = *(const u32x4*)(xp + ks * 32);
        const f32x4 ga = *(const f32x4*)(g1 + ks * 32 + fq * 8), gb2 = *(const f32x4*)(g1 + ks * 32 + fq * 8 + 4), ba = *(const f32x4*)(b1 + ks * 32 + fq * 8), bb2 = *(const f32x4*)(b1 + ks * 32 + fq * 8 + 4);
        const f32x4 y0 = {__uint_as_float(yv.x << 16), __uint_as_float(yv.x & 0xffff0000u), __uint_as_float(yv.y << 16), __uint_as_float(yv.y & 0xffff0000u)};
        const f32x4 y1 = {__uint_as_float(yv.z << 16), __uint_as_float(yv.z & 0xffff0000u), __uint_as_float(yv.w << 16), __uint_as_float(yv.w & 0xffff0000u)};
        const f32x4 n0 = (y0 - mean_t) * rstd_t * ga + ba, n1 = (y1 - mean_t) * rstd_t * gb2 + bb2;
        const u32x4 xw = {cvtpk_c(n0.x, n0.y), cvtpk_c(n0.z, n0.w), cvtpk_c(n1.x, n1.y), cvtpk_c(n1.z, n1.w)};
        *(u32x4*)(xp + ks * 32) = xw;
        *(u32x2*)(x8 + ks * 32) = (u32x2){cvt4_fp8(n0.x, n0.y, n0.z, n0.w), cvt4_fp8(n1.x, n1.y, n1.z, n1.w)};
        const pg8::bf16x8 bx = __builtin_bit_cast(pg8::bf16x8, xw);
#pragma unroll
        for (int nt = 0; nt < 5; ++nt) acc[nt] = __builtin_amdgcn_mfma_f32_16x16x32_bf16(*(const pg8::bf16x8*)(wb + nt * 16 * 528 + k8 * 64), bx, acc[nt], 0, 0, 0); }
      if (ch < 3) WR_STORE((ch + 1) & 1);
      __syncthreads();
    }
#undef WR_LOAD
#undef WR_STORE
#pragma unroll
    for (int nt = 0; nt < 5; ++nt) { const int o = nt * 16 + fq * 4; *(f32x4*)(lg + fr * 88 + o) = acc[nt]; }
    asm volatile("s_waitcnt lgkmcnt(0)" ::: "memory");
    int ex1 = 0, ex2 = 0; float gt1 = 0.f, gt2 = 0.f; unsigned lr1 = 0u, lr2 = 0u;
    if (lane < 16) {
      const float* l = lg + lane * 88;
      int grp = 0; float gm = l[0] + bg[0];
      for (int i = 1; i < 8; ++i) { const float v = l[i] + bg[i]; if (v > gm) { gm = v; grp = i; } }
      float gs = 0.f; for (int i = 0; i < 8; ++i) gs += __expf(l[i] + bg[i] - gm);
      const float pgrp = 1.f / gs;
      const float* el = l + 8 + grp * 8; const float* eb = br + grp * 8;
      int i1 = 0; float m1 = el[0] + eb[0]; for (int i = 1; i < 8; ++i) { const float v = el[i] + eb[i]; if (v > m1) { m1 = v; i1 = i; } }
      int i2 = -1; float m2 = -3.0e38f; for (int i = 0; i < 8; ++i) { const float v = el[i] + eb[i]; if (i != i1 && v > m2) { m2 = v; i2 = i; } }
      const float e2 = __expf(m2 - m1), den = 1.f / (1.f + e2);
      gt1 = pgrp * den; gt2 = pgrp * e2 * den;
      ex1 = grp * 8 + i1; ex2 = grp * 8 + i2;
      lr1 = atomicAdd(&cntl[ex1], 1u); lr2 = atomicAdd(&cntl[ex2], 1u);
    }
    __syncthreads();
    if (wave == 0) { const unsigned nloc = cntl[lane]; basel[lane] = nloc ? atomicAdd(&ctl[CW_CNT + lane], nloc) : 0u; }
    __syncthreads();
    if (lane < 16) {
      const int t = t0 + lane; const unsigned r1 = basel[ex1] + lr1, r2 = basel[ex2] + lr2;
      LIST[(size_t)ex1 * 32768 + r1] = (unsigned)t; GATEL[(size_t)ex1 * 32768 + r1] = gt1;
      LIST[(size_t)ex2 * 32768 + r2] = (unsigned)t; GATEL[(size_t)ex2 * 32768 + r2] = gt2;
      TSLOT[(size_t)t * 2 + 0] = ((unsigned)ex1 << 16) | r1; TSLOT[(size_t)t * 2 + 1] = ((unsigned)ex2 << 16) | r2;
    }
    __syncthreads();
    if (tid < 64) cntl[tid] = 0u;
    __syncthreads();
  }
}

__device__ __forceinline__ void phase_combine(const Ctx& c, float* lds) {
  unsigned char* ws = c.ws;
  const int tid = phase_tid(), lane = tid & 63, wave = tid >> 6;
  int* offs = (int*)lds; int* cnts = offs + 65;
  expert_offsets(c, offs, cnts, tid);
  const unsigned char* Y = (const unsigned char*)(ws + WS_Y); const unsigned* TSLOT = (const unsigned*)(ws + WS_TSLOT);
  const float* g2 = c.in[23]; const float* b2 = c.in[24];
  for (int t = blockIdx.x * NWAVES + wave; t < T; t += gridDim.x * NWAVES) {
    const unsigned s0 = TSLOT[(size_t)t * 2], s1 = TSLOT[(size_t)t * 2 + 1];
    const size_t r0 = (size_t)offs[s0 >> 16] + (s0 & 0xffffu), r1 = (size_t)offs[s1 >> 16] + (s1 & 0xffffu);
    f32x4* row = (f32x4*)(c.out + (size_t)t * 1024); const u32x2* xrow = (const u32x2*)((const bf16_t*)(ws + WS_X1B) + (size_t)t * 1024);
    f32x4 v[4]; float s = 0.f;
#pragma unroll
    for (int j = 0; j < 4; ++j) { const unsigned ya = ((const unsigned*)(Y + r0 * 1024))[lane + 64 * j], yb = ((const unsigned*)(Y + r1 * 1024))[lane + 64 * j];
      f32x4 x = bf4(xrow[lane + 64 * j]) * ALPHA;
      const hw_f32x2 a01 = __builtin_amdgcn_cvt_pk_f32_fp8(ya, false), a23 = __builtin_amdgcn_cvt_pk_f32_fp8(ya, true), b01 = __builtin_amdgcn_cvt_pk_f32_fp8(yb, false), b23 = __builtin_amdgcn_cvt_pk_f32_fp8(yb, true);
      x.x += (a01.x + b01.x) * 0.015625f; x.y += (a01.y + b01.y) * 0.015625f; x.z += (a23.x + b23.x) * 0.015625f; x.w += (a23.y + b23.y) * 0.015625f;
      v[j] = x; s += (x.x + x.y) + (x.z + x.w); }
    const float mean = wave_sum(s) * (1.f / 1024.f); float s2 = 0.f;
#pragma unroll
    for (int j = 0; j < 4; ++j) { v[j] = v[j] - mean; s2 += (v[j].x * v[j].x + v[j].y * v[j].y) + (v[j].z * v[j].z + v[j].w * v[j].w); }
    const float rstd = rsqrtf(wave_sum(s2) * (1.f / 1024.f) + 1e-5f);
#pragma unroll
    for (int j = 0; j < 4; ++j) { const f32x4 g = ((const f32x4*)g2)[lane + 64 * j], bb = ((const f32x4*)b2)[lane + 64 * j]; row[lane + 64 * j] = v[j] * rstd * g + bb; }
  }
}

constexpr int NPHASE = 11;
__global__ void __launch_bounds__(NTHREADS, 2) mega(Ctx c) {
  float* lds = (float*)lds_raw;
  unsigned* ctl = (unsigned*)(c.ws + WS_CTL);
  unsigned* bar = ctl + CW_BAR;
  if (threadIdx.x == 0) { *(volatile unsigned*)(lds_raw + LDS_WCTR) = 0u; *(volatile unsigned*)(lds_raw + LDS_XBST) = 0u; *(volatile unsigned*)(lds_raw + LDS_XBST + 4) = 0u;
    (void)xb_add(&bar[XB_XCNT(xb_xcc_id())], 1u); }
  __syncthreads();
  phase_prologue(c, lds);
  xcd_barrier(bar);
  phase_inproj_mfma(c, (lds_u8*)lds_raw);
  phase_inproj_f8(c, (lds_u8*)lds_raw);
  phase_tiles_queue(c, lds, ctl + CW_Q + 48, TP_WD0 - TP_D1, TP_WD0);
  xcd_barrier(bar);
  phase_gdn_prep2(c, lds_raw);
  phase_kvup(c, lds);
  phase_topk_mfma(c, lds_raw, ctl + CW_Q);
  xcd_barrier(bar);
  if (blockIdx.x < 48) phase_gdn_scan(c, lds_raw, blockIdx.x);
  phase_attn_sparse(c, lds_raw, ctl + CW_Q + 16);
  phase_attn_mem(c, lds_raw, ctl + CW_Q + 32);
  xcd_barrier(bar);
  phase_outproj_mfma(c, (lds_u8*)lds_raw);
  xcd_barrier(bar);
  phase_router(c, lds_raw);
  xcd_barrier(bar);
  phase_moe_up_mfma(c, (lds_u8*)lds_raw);
  phase_tiles_queue(c, lds, ctl + CW_Q + 64, TP_WD0, TP_TOTAL);
  xcd_barrier(bar);
  phase_moe_down_mfma(c, (lds_u8*)lds_raw);
  xcd_barrier(bar);
  phase_combine(c, lds);
}

extern "C" void kernel_launch(void* const* d_in, const int* in_sizes, int n_in, void* d_out, int out_size, void* d_ws, size_t ws_size, hipStream_t stream) {
  static int grid = 0;
  if (grid == 0) {
    if (n_in != 25 || ws_size < WS_END) { fprintf(stderr, "kernel_launch: unexpected n_in %d / ws %zu\n", n_in, ws_size); grid = -1; return; }
    int dev = 0, cus = 0, per_cu = 0;
    hipGetDevice(&dev); hipDeviceGetAttribute(&cus, hipDeviceAttributeMultiprocessorCount, dev);
    hipFuncSetAttribute((const void*)mega, hipFuncAttributeMaxDynamicSharedMemorySize, LDS_BYTES);
    hipOccupancyMaxActiveBlocksPerMultiprocessor(&per_cu, (const void*)mega, NTHREADS, LDS_BYTES);
    if (per_cu < 1) { fprintf(stderr, "kernel_launch: occupancy query says %d blocks/CU\n", per_cu); per_cu = 1; }
    grid = cus * (per_cu < 1 ? 1 : 1);
    (void)hipGetLastError();
  }
  if (grid < 0) return;
  hipMemsetAsync((char*)d_ws + WS_CTL, 0, 32 * 1024, stream);
  Ctx c; memset(&c, 0, sizeof(c));
  for (int i = 0; i < 25; ++i) c.in[i] = (const float*)d_in[i];
  c.out = (float*)d_out; c.ws = (unsigned char*)d_ws;
  hipLaunchKernelGGL(mega, dim3(grid), dim3(NTHREADS), LDS_BYTES, stream, c);
}
```

```cpp
#include <hip/hip_runtime.h>
#include <cstdio>
#include <cstdint>
#include <cstring>

#ifndef ONE_LAUNCH
#define ONE_LAUNCH 1
#endif

typedef unsigned short bf16_t;
typedef float f32x4 __attribute__((ext_vector_type(4)));
typedef unsigned u32x4 __attribute__((ext_vector_type(4)));
typedef unsigned u32x2 __attribute__((ext_vector_type(2)));

constexpr int T = 32768, DM = 1024, SEQ = 4096, NBATCH = 8;
constexpr int NIN = 2816;
constexpr int NMEM = 256, TM = NBATCH * NMEM;
constexpr int NEXP = 64, DE = 256;
constexpr int NTHREADS = 512, NWAVES = 8;
constexpr float ALPHA = 1.189207115002721f;
constexpr float LOG2E = 1.4426950408889634f;
constexpr float QSCALE = 0.125f * LOG2E;

constexpr size_t MiB = 1ull << 20;
constexpr size_t WS_CTL = 0;
constexpr size_t WS_TSLOT = 512 * 1024;
constexpr size_t WS_ROPE = 1 * MiB;
constexpr size_t WS_WKV = 2 * MiB;
constexpr size_t WS_WR = 2 * MiB + 65536;
constexpr size_t WS_WIN = 3 * MiB;
constexpr size_t WS_WO = 9 * MiB;
constexpr size_t WS_WMKV = 11 * MiB;
constexpr size_t WS_MEMB = 12 * MiB;
constexpr size_t WS_WGU = 16 * MiB;
constexpr size_t WS_WD = 80 * MiB;
constexpr size_t WS_XB = 112 * MiB;
constexpr size_t WS_QA = 176 * MiB;
constexpr size_t WS_CKV = 200 * MiB;
constexpr size_t WS_IQ = 208 * MiB;
constexpr size_t WS_IK = 224 * MiB;
constexpr size_t WS_SM = 228 * MiB;
constexpr size_t WS_QC = 230 * MiB;
constexpr size_t WS_GB = 246 * MiB;
constexpr size_t WS_X1F = WS_GB;
constexpr size_t XF_OFF = (size_t)64 * MiB;
constexpr size_t WS_WIN8 = 48 * MiB;
constexpr int IN_F8 = 2;
constexpr float W8SCALE = 32.f, H8SCALE = 8.f, Y8SCALE = 16.f;
constexpr size_t WS_MK = 342 * MiB;
constexpr size_t WS_MVT = 343 * MiB;
constexpr size_t WS_KVA = 344 * MiB;
constexpr size_t WS_SEL = 352 * MiB;
constexpr size_t WS_CAT = 368 * MiB;
constexpr size_t WS_X1B = 432 * MiB;
constexpr size_t WS_LIST = 496 * MiB;
constexpr size_t WS_LNSUM = 506 * MiB;
constexpr size_t WS_LNST = 505 * MiB;
constexpr size_t WS_GATEL = 504 * MiB;
constexpr size_t WS_END = 512 * MiB;
constexpr size_t WS_H = 112 * MiB;
constexpr size_t WS_Y = 160 * MiB;

constexpr int CW_CNT = 0;
constexpr int CW_Q = 64;
constexpr int CW_BAR = 4096;

struct Ctx {
  const float* in[25];
  float* out;
  unsigned char* ws;
  int ph_lo, ph_hi;
};


extern __shared__ __attribute__((aligned(16))) unsigned char lds_raw[];
constexpr int LDS_BYTES = 157696;
constexpr int LDS_WCTR = LDS_BYTES - 64;
__device__ __forceinline__ int phase_tid() {
  __syncthreads();
  int l; asm volatile("v_mbcnt_lo_u32_b32 %0, -1, 0\n\tv_mbcnt_hi_u32_b32 %0, -1, %0" : "=v"(l));
  unsigned w = 0u;
  if (l == 0) w = __hip_atomic_fetch_add((__attribute__((address_space(3))) unsigned*)(__attribute__((address_space(3))) unsigned char*)(lds_raw + LDS_WCTR), 1u, __ATOMIC_RELAXED, __HIP_MEMORY_SCOPE_WORKGROUP);
  w = (unsigned)__builtin_amdgcn_readfirstlane((int)w) & 7u;
  return (int)(w * 64u) + l;
}


#define XB_TMO      128
#define XB_XCNT(j)  (256  + 64 * (j))
#define XB_XSUB(j)  (1280 + 64 * (j))
#define XB_XGEN(j)  (2304 + 64 * (j))
#define XB_TOP      3328
#define XB_TOPGEN   3392
#define XCD_BAR_WORDS 3456
#define XB_SPIN_CAP (1u << 18)
constexpr int LDS_XBST = LDS_BYTES - 32;
__device__ __forceinline__ unsigned xb_ld(unsigned* p)              { return __hip_atomic_load(p, __ATOMIC_RELAXED, __HIP_MEMORY_SCOPE_AGENT); }
__device__ __forceinline__ unsigned xb_add(unsigned* p, unsigned v) { return __hip_atomic_fetch_add(p, v, __ATOMIC_RELAXED, __HIP_MEMORY_SCOPE_AGENT); }
__device__ __forceinline__ unsigned xb_xcc_id() { return (unsigned)__builtin_amdgcn_s_getreg((3 << 11) | 20) & 0xFu; }
#define XB_SPIN(cond, bar) do { unsigned _sp = 0; while (cond) { __builtin_amdgcn_s_sleep(1); \
    if ((++_sp & 255u) == 0u) { if (xb_ld(&(bar)[XB_TMO])) break; if (_sp > XB_SPIN_CAP) { atomicAdd(&(bar)[XB_TMO], 1u); break; } } } } while (0)
__device__ __forceinline__ void xcd_barrier_complete(unsigned* bar, unsigned x, unsigned& nloc, unsigned& nx) {
    const unsigned G = gridDim.x;
    unsigned sum, cnt, mine, sp = 0u;
    for (;;) {
        sum = 0u; cnt = 0u; mine = 0u;
#pragma unroll
        for (unsigned j = 0; j < 16; ++j) { const unsigned cc = xb_ld(&bar[XB_XCNT(j)]); sum += cc; cnt += (cc > 0u) ? 1u : 0u; mine = (j == x) ? cc : mine; }
        if (sum == G) break;
        __builtin_amdgcn_s_sleep(1);
        if ((++sp & 255u) == 0u) { if (xb_ld(&bar[XB_TMO])) break; if (sp > XB_SPIN_CAP) { atomicAdd(&bar[XB_TMO], 1u); break; } }
    }
    nloc = mine > 0u ? mine : 1u; nx = cnt > 0u ? cnt : 1u;
}
__device__ __forceinline__ void xcd_barrier(unsigned* bar) {
    asm volatile("s_waitcnt vmcnt(0)" ::: "memory");
    __syncthreads();
    const int btid = phase_tid();
    if (btid == 0) {
        volatile __attribute__((address_space(3))) unsigned* st = (volatile __attribute__((address_space(3))) unsigned*)(__attribute__((address_space(3))) unsigned char*)(lds_raw + LDS_XBST);
        const unsigned x = xb_xcc_id();
        __builtin_amdgcn_s_waitcnt(0);
        unsigned nloc = st[0], nx = st[1];
        if (nloc == 0u) { xcd_barrier_complete(bar, x, nloc, nx); st[0] = nloc; st[1] = nx; }
        const unsigned old = xb_add(&bar[XB_XSUB(x)], 1u);
        const unsigned gen = old / nloc;
        if (old + 1u == (gen + 1u) * nloc) {
            __builtin_amdgcn_fence(__ATOMIC_RELEASE, "agent");
            asm volatile("s_waitcnt vmcnt(0)" ::: "memory");
            const unsigned og = xb_add(&bar[XB_TOP], 1u);
            const unsigned tg = og / nx;
            if (og + 1u == (tg + 1u) * nx) xb_add(&bar[XB_TOPGEN], 1u);
            else XB_SPIN(xb_ld(&bar[XB_TOPGEN]) == tg, bar);
            __builtin_amdgcn_fence(__ATOMIC_ACQUIRE, "agent");
            xb_add(&bar[XB_XGEN(x)], 1u);
            asm volatile("s_waitcnt vmcnt(0)" ::: "memory");
        } else {
            XB_SPIN(xb_ld(&bar[XB_XGEN(x)]) == gen, bar);
            __builtin_amdgcn_fence(__ATOMIC_ACQUIRE, "agent");
            asm volatile("s_waitcnt vmcnt(0)" ::: "memory");
        }
    }
    __syncthreads();
}

__device__ __forceinline__ float bf2f(bf16_t v) { return __uint_as_float(((unsigned)v) << 16); }
typedef float hw_f32x2 __attribute__((ext_vector_type(2))); typedef __bf16 hw_bf16x2 __attribute__((ext_vector_type(2)));
__device__ __forceinline__ unsigned pk2(float lo, float hi) { const hw_f32x2 v = {lo, hi}; const hw_bf16x2 b = __builtin_convertvector(v, hw_bf16x2); return __builtin_bit_cast(unsigned, b); }
__device__ __forceinline__ unsigned cvt4_fp8(float a, float b, float c2, float d) { int w = __builtin_amdgcn_cvt_pk_fp8_f32(a, b, 0, false); w = __builtin_amdgcn_cvt_pk_fp8_f32(c2, d, w, true); return (unsigned)w; }
__device__ __forceinline__ long mk64(unsigned lo, unsigned hi) { return (long)(((unsigned long)hi << 32) | (unsigned long)lo); }
__device__ __forceinline__ bf16_t f2bf(float f) { return (bf16_t)(pk2(f, f) & 0xffffu); }
__device__ __forceinline__ float wave_sum(float v) {
  int x = __float_as_int(v);
  x = __float_as_int(__int_as_float(x) + __int_as_float(__builtin_amdgcn_update_dpp(0, x, 0x111, 0xF, 0xF, true)));
  x = __float_as_int(__int_as_float(x) + __int_as_float(__builtin_amdgcn_update_dpp(0, x, 0x112, 0xF, 0xF, true)));
  x = __float_as_int(__int_as_float(x) + __int_as_float(__builtin_amdgcn_update_dpp(0, x, 0x114, 0xF, 0xF, true)));
  x = __float_as_int(__int_as_float(x) + __int_as_float(__builtin_amdgcn_update_dpp(0, x, 0x118, 0xF, 0xF, true)));
  x = __float_as_int(__int_as_float(x) + __int_as_float(__builtin_amdgcn_update_dpp(0, x, 0x142, 0xA, 0xF, false)));
  x = __float_as_int(__int_as_float(x) + __int_as_float(__builtin_amdgcn_update_dpp(0, x, 0x143, 0xC, 0xF, false)));
  return __int_as_float(__builtin_amdgcn_readlane(x, 63));
}
__device__ __forceinline__ float wave_max(float v) {
#pragma unroll
  for (int o = 32; o >= 1; o >>= 1) v = fmaxf(v, __shfl_xor(v, o));
  return v;
}
__device__ __forceinline__ float silu_f(float v) { return v * __builtin_amdgcn_rcpf(1.f + __expf(-v)); }

__device__ __forceinline__ int ropeperm(int p) { return (p >> 1) + 32 * (p & 1); }
__host__ __device__ __forceinline__ int tperm(int pt) { return pt == 0 ? 2 : pt == 1 ? 3 : pt == 2 ? 0 : pt == 3 ? 1 : pt; }
__device__ __forceinline__ int colmap_in(int cpp) {
  const int cp = tperm(cpp >> 8) * 256 + (cpp & 255);
  const int tile = cp >> 8, w = cp & 255;
  if (tile == 0) return (w >> 6) * 64 + ropeperm(w & 63);
  if (tile == 1) { if (w < 128) { const int c = 256 + w; return (c >> 6) * 64 + ropeperm(c & 63); } return 384 + (w - 128); }
  if (tile == 2) return 512 + (w >> 6) * 64 + ropeperm(w & 63);
  if (tile == 3) { if (w < 64) return 768 + ropeperm(w); if (w < 68) return 832 + (w - 64); if (w < 74) return 2372 + (w - 68); if (w < 80) return 2378 + (w - 74); return -1; }
  if (tile == 4) return 2384 + w;
  return 836 + (cp - 1280);
}

struct WorkQ { unsigned* head; volatile int* slot; int nxt; };
__device__ __forceinline__ void wq_init(WorkQ& q, unsigned* head, volatile int* slot, int tid) { q.head = head; q.slot = slot; q.nxt = 0; if (tid == 0) q.nxt = (int)atomicAdd(head, 1u); }
__device__ __forceinline__ int wq_next(WorkQ& q, int tid) {
  __syncthreads();
  if (tid == 0) { *q.slot = q.nxt; q.nxt = (int)atomicAdd(q.head, 1u); }
  __syncthreads();
  return *q.slot;
}

struct WorkQ2 { unsigned* head; volatile int* slot; int n1, n2; };
__device__ __forceinline__ void wq2_init(WorkQ2& q, unsigned* head, volatile int* slot, int tid) { q.head = head; q.slot = slot; q.n1 = 0; q.n2 = 0; if (tid == 0) { q.n1 = (int)atomicAdd(head, 1u); q.n2 = (int)atomicAdd(head, 1u); } }
__device__ __forceinline__ void wq2_next(WorkQ2& q, int tid, int& cur, int& nxt) {
  __syncthreads();
  if (tid == 0) { q.slot[0] = q.n1; q.slot[1] = q.n2; q.n1 = q.n2; q.n2 = (int)atomicAdd(q.head, 1u); }
  __syncthreads();
  cur = q.slot[0]; nxt = q.slot[1];
}

struct TpDesc { const float* lp; int ld; unsigned char* sp; int f8; float sc8; float keep; };
constexpr int TP_TOTAL = (NIN / 64) * 16 + 16 * 16 + 8 * 16 + 64 * 8 * 16 + 64 * 16 * 4;
constexpr int TP_WD0 = TP_TOTAL - 64 * 16 * 4;
constexpr int TP_D1 = 5200;
__device__ __forceinline__ TpDesc tp_desc(const Ctx& c, int r, int tid) {
  unsigned char* ws = c.ws;
  const int n_win = (NIN / 64) * 16, n_wo = 16 * 16, n_wmkv = 8 * 16, n_wgu = 64 * 8 * 16;
  const int a = tid & 63, b = tid >> 6, nn = tid >> 3, kc = (tid & 7) * 8;
  const float* src; int ld, sc, drow0, K, k0, f8; unsigned char* dst; float sc8 = 1.f;
  if (r < n_win) { const int nt = r / 16, kt = r % 16; src = c.in[2]; ld = 2640; sc = colmap_in(nt * 64 + a); drow0 = nt * 64; K = 1024; k0 = kt * 64;
    if (nt >= IN_F8 * 4) { dst = ws + WS_WIN8; f8 = 1; sc8 = W8SCALE; } else { dst = ws + WS_WIN; f8 = 0; } }
  else if ((r -= n_win) < n_wo) { const int nt = r / 16, kt = r % 16; src = c.in[13]; ld = 1024; sc = nt * 64 + a; drow0 = nt * 64; K = 1024; k0 = kt * 64; dst = ws + WS_WO; f8 = 1; sc8 = W8SCALE; }
  else if ((r -= n_wo) < n_wmkv) { const int nt = r / 16, kt = r % 16; src = c.in[12]; ld = 512; sc = nt * 64 + a; drow0 = nt * 64; K = 1024; k0 = kt * 64; dst = ws + WS_WMKV; f8 = 0; }
  else if ((r -= n_wmkv) < n_wgu) { const int e = r / 128, q = r % 128, nt = q / 16, kt = q % 16;
    const int pn = nt >> 2, sub = nt & 3, isup = sub >> 1, c0 = pn * 128 + (sub & 1) * 64;
    src = (isup ? c.in[21] : c.in[20]) + (size_t)e * 1024 * 256; ld = 256; sc = c0 + a; drow0 = e * 512 + nt * 64; K = 1024; k0 = kt * 64; dst = ws + WS_WGU; f8 = 1; sc8 = W8SCALE; }
  else { r -= n_wgu; const int e = r / 64, q = r % 64, nt = q / 4, kt = q % 4;
    src = c.in[22] + (size_t)e * 256 * 1024; ld = 1024; sc = nt * 64 + a; drow0 = e * 1024 + nt * 64; K = 256; k0 = kt * 64; dst = ws + WS_WD; f8 = 1; sc8 = W8SCALE; }
  TpDesc d; d.ld = ld; d.keep = sc >= 0 ? 1.f : 0.f; d.lp = src + (size_t)(k0 + b * 8) * ld + (sc >= 0 ? sc : 0); d.f8 = f8; d.sc8 = sc8;
  d.sp = dst + ((size_t)(drow0 + nn) * K + k0 + kc) * (f8 ? 1 : 2);
  return d;
}
__device__ __forceinline__ void tp_load(const TpDesc& d, float (&v)[8]) {
#pragma unroll
  for (int i = 0; i < 8; ++i) v[i] = d.lp[(size_t)i * d.ld];
}
__device__ __forceinline__ void tp_finish(const TpDesc& d, const float (&v)[8], float* lds, int tid) {
  const int a = tid & 63, b = tid >> 6;
  asm volatile("s_waitcnt lgkmcnt(0)" ::: "memory"); __builtin_amdgcn_s_barrier();
#pragma unroll
  for (int i = 0; i < 8; ++i) lds[(b * 8 + i) * 65 + a] = v[i] * d.keep;
  asm volatile("s_waitcnt lgkmcnt(0)" ::: "memory"); __builtin_amdgcn_s_barrier();
  { const int nn = tid >> 3, kc = (tid & 7) * 8;
    const float* p = lds + kc * 65 + nn; const float s8 = d.sc8;
    if (d.f8) *(u32x2*)d.sp = (u32x2){cvt4_fp8(p[0] * s8, p[65] * s8, p[130] * s8, p[195] * s8), cvt4_fp8(p[260] * s8, p[325] * s8, p[390] * s8, p[455] * s8)};
    else *(u32x4*)d.sp = (u32x4){pk2(p[0], p[65]), pk2(p[130], p[195]), pk2(p[260], p[325]), pk2(p[390], p[455])}; }
}
__device__ __forceinline__ void prologue_tiles(const Ctx& c, float* lds, int tid, int lo, int hi, int b0, int nb) {
  const int first = lo + b0;
  __syncthreads();
  if (first >= hi) return;
  const int n = (hi - first + nb - 1) / nb;
  TpDesc dA = tp_desc(c, first, tid), dB = dA; float vA[8], vB[8]; tp_load(dA, vA);
  int k = 0;
#pragma unroll 1
  for (; k + 1 < n; k += 2) {
    dB = tp_desc(c, first + (k + 1) * nb, tid); tp_load(dB, vB);
    tp_finish(dA, vA, lds, tid);
    const int k2 = k + 2 < n ? k + 2 : n - 1;
    dA = tp_desc(c, first + k2 * nb, tid); tp_load(dA, vA);
    tp_finish(dB, vB, lds, tid);
  }
  if (n & 1) tp_finish(dA, vA, lds, tid);
  __syncthreads();
}

__device__ __forceinline__ void phase_tiles_queue(const Ctx& c, float* lds, unsigned* qhead, int lo, int hi) {
  const int tid = phase_tid();
  volatile int* slot = (volatile int*)(lds + 64 * 65 + 16);
  WorkQ wq; wq_init(wq, qhead, slot, tid);
  const int nitems = (hi - lo + 7) >> 3;
  for (;;) {
    const int item = wq_next(wq, tid);
    if (item >= nitems) break;
    const int t0 = lo + item * 8, t1 = t0 + 8 < hi ? t0 + 8 : hi;
    prologue_tiles(c, lds, tid, t0, t1, 0, 1);
  }
}

__device__ __forceinline__ void phase_prologue(const Ctx& c, float* lds) {
  const int tid = phase_tid(), bid = blockIdx.x, G = gridDim.x;
  unsigned char* ws = c.ws;
  const size_t gtid = (size_t)bid * NTHREADS + tid, gstride = (size_t)G * NTHREADS;
  { const f32x4* x4 = (const f32x4*)c.in[0]; u32x2* o = (u32x2*)c.out;
    unsigned* o8 = (unsigned*)((unsigned char*)c.out + XF_OFF);
    for (size_t i = gtid; i < (size_t)T * DM / 4; i += gstride) { const f32x4 v = x4[i]; o[i] = (u32x2){pk2(v.x, v.y), pk2(v.z, v.w)}; o8[i] = cvt4_fp8(v.x, v.y, v.z, v.w); }
    const f32x4* m4 = (const f32x4*)c.in[1]; u32x2* om = (u32x2*)(ws + WS_MEMB);
    for (size_t i = gtid; i < (size_t)TM * DM / 4; i += gstride) { const f32x4 v = m4[i]; om[i] = (u32x2){pk2(v.x, v.y), pk2(v.z, v.w)}; } }
  { float* cs = (float*)(ws + WS_ROPE); float* sn = cs + SEQ * 32;
    for (size_t i = gtid; i < (size_t)SEQ * 32; i += gstride) { const int s = (int)(i >> 5), d = (int)(i & 31);
      const float inv = 1.0f / powf(10000.0f, (float)d / 32.0f); const float ang = (float)s * inv; float sv, cv; sincosf(ang, &sv, &cv); cs[i] = cv; sn[i] = sv; } }
  { bf16_t* wkv = (bf16_t*)(ws + WS_WKV); const float* g = c.in[3]; const float* wk = c.in[4]; const float* wv = c.in[5];
    for (size_t i = gtid; i < 128 * 128; i += gstride) { const int p = (int)(i >> 7), k = (int)(i & 127);
      const float w = p < 64 ? wk[k * 64 + ropeperm(p)] : wv[k * 64 + (p - 64)]; wkv[i] = f2bf(w * g[k]); }
    bf16_t* wr = (bf16_t*)(ws + WS_WR); const float* wg = c.in[16]; const float* wrt = c.in[18];
    for (size_t i = gtid; i < 80 * 1024; i += gstride) { const int o = (int)(i >> 10), k = (int)(i & 1023); wr[i] = f2bf(o < 8 ? wg[k * 8 + o] : o < 72 ? wrt[k * 64 + (o - 8)] : 0.f); } }
  prologue_tiles(c, lds, tid, 0, TP_WD0 - TP_D1, bid, G);
}

__device__ __forceinline__ int wave_incl_scan(int x);
__device__ __forceinline__ void expert_offsets(const Ctx& c, int* offs  , int* cnts  , int tid) {
  const unsigned* ctl = (const unsigned*)(c.ws + WS_CTL);
  __syncthreads();
  if (tid < 64) { const int n = (int)ctl[CW_CNT + tid]; const int pad = (n + 255) & ~255; const int incl = wave_incl_scan(pad); cnts[tid] = n; offs[tid] = incl - pad; if (tid == 63) offs[64] = incl; }
  __syncthreads();
}


namespace pg8 {
#define PG8_LAS __attribute__((address_space(3)))
typedef short bf16x8 __attribute__((ext_vector_type(8)));
constexpr int BM = 256, BK = 64, HALF = 128, HTB = HALF * BK * 2, STAGE_BYTES = 8 * HTB, NXCD = 8, WGM = 8, GN_STASH = STAGE_BYTES + 2048;
typedef unsigned u32x4s __attribute__((ext_vector_type(4)));
__host__ __device__ __forceinline__ int lds_byte(int r, int c) { const int st = (r >> 4) * 2 + (c >> 5), rr = r & 15, cc = c & 31, ob = rr * 64 + cc * 2; return st * 1024 + (ob ^ (((ob >> 9) & 1) << 5)); }
__host__ __device__ __forceinline__ void stage_rc(int b, int& R, int& C) { const int st = b / 1024, sb = b % 1024, swz = sb ^ (((sb >> 9) & 1) << 5); R = (st >> 1) * 16 + swz / 64; C = (st & 1) * 32 + (swz % 64) / 2; }
__host__ __device__ __forceinline__ int perm32(int rho) { const int n = rho >> 4, i = rho & 15; return 8 * (i >> 2) + 4 * n + (i & 3); }
typedef int i32x4v __attribute__((ext_vector_type(4))); typedef int i32x8 __attribute__((ext_vector_type(8))); typedef long i64x2 __attribute__((ext_vector_type(2)));
struct Unit { int pm, pn, e, mt, aux; };
struct Gemm { const bf16_t* A; const bf16_t* Bt; int K; };
struct StaticOrder {
    int nM, nN, nwg, G, c;
    __device__ void init(int M, int N, int G_, int c_) { nM = M / BM; nN = N / BM; nwg = nM * nN; G = G_; c = c_; }
    __device__ bool next(int i, Unit& u) const {
        const long L = (long)i * G + c; if (c < 0 || L >= nwg) return false;
        int wgid = (int)L; { const int q = nwg / NXCD, r = nwg % NXCD, xcd = wgid % NXCD, off = wgid / NXCD; wgid = (xcd < r ? xcd * (q + 1) : r * (q + 1) + (xcd - r) * q) + off; }
        const int nig = WGM * nN, gid = wgid / nig, fm = gid * WGM, gsz = (nM - fm) < WGM ? (nM - fm) : WGM;
        u.pm = fm + ((wgid % nig) % gsz); u.pn = (wgid % nig) / gsz; u.e = 0; u.mt = 0; u.aux = 0; return true;
    }
    __device__ __forceinline__ unsigned arow(const Unit&, int) const { return 0u; }
};
__device__ __forceinline__ unsigned cvt_pk_bf16(float lo, float hi) { unsigned r; asm volatile("v_cvt_pk_bf16_f32 %0, %1, %2" : "=v"(r) : "v"(lo), "v"(hi)); return r; }

template <class Epi, class Sched, bool ALIGN_EPI, bool GATHER, int FP8 = 0, bool BUF = false>
__device__ __forceinline__ void gemm_phase(PG8_LAS unsigned char* lds, const Gemm g, const Sched& S, const Epi& E, const int tid) {
    const int wid = __builtin_amdgcn_readfirstlane(tid >> 6), lane = tid & 63, wr = wid >> 2, wc = wid & 3, fr = lane & 15, fq = lane >> 4;
    const int K = g.K, nt = K / BK;
    unsigned voffA[2], voffB[2]; int RA[2], CA[2];
#pragma unroll
    for (int i = 0; i < 2; ++i) { int R, C; stage_rc(tid * 16 + i * 8192, R, C); const int Rb = Epi::PERM ? ((R & ~31) + perm32(R & 31)) : R;
        RA[i] = R; CA[i] = C; voffA[i] = (unsigned)(R * K + C) * 2u; voffB[i] = (unsigned)(Rb * K + C) * 2u; }
    const size_t kstep = (size_t)(BK * 2);
    const size_t hstep = (size_t)HALF * K * 2;
    const size_t tstep = 2 * hstep;
    const unsigned ldsw = (unsigned)wid * 1024u;
    const int aoff = lds_byte(wr * 64 + fr, fq * 8), boff = lds_byte(wc * 32 + fr, fq * 8);
#define PG8_FRESH_TID() ([&]() { int l_; asm volatile("v_mbcnt_lo_u32_b32 %0, -1, 0\n\tv_mbcnt_hi_u32_b32 %0, -1, %0" : "=v"(l_)); return wid * 64 + l_; }())
#define PG8_SA(b, h) (((b) * 2 + (h)) * HTB)
#define PG8_SB(b, h) ((4 + (b) * 2 + (h)) * HTB)
    const __amdgpu_buffer_rsrc_t rsA = __builtin_amdgcn_make_buffer_rsrc((void*)g.A, 0, -1, 0x00020000), rsB = __builtin_amdgcn_make_buffer_rsrc((void*)g.Bt, 0, -1, 0x00020000);
#define PG8_STAGE_X(rs, base0, bufoff, gbase, voff) do { _Pragma("unroll") for (int _i = 0; _i < 2; ++_i) { \
        if constexpr (BUF) __builtin_amdgcn_raw_ptr_buffer_load_lds(rs, (PG8_LAS void*)(lds + (bufoff) + ldsw + _i * 8192), 16, (int)(voff)[_i], (int)(unsigned)((const char*)(gbase) - (const char*)(base0)), 0, 0); \
        else __builtin_amdgcn_global_load_lds((const unsigned*)((const char*)(gbase) + (voff)[_i]), (PG8_LAS unsigned*)(lds + (bufoff) + ldsw + _i * 8192), 16, 0, 0); } } while (0)
#define PG8_STAGE(bufoff, gbase, voff) PG8_STAGE_X(rsB, g.Bt, bufoff, gbase, voff)
#define PG8_STAGE_A(bufoff, gbase, h, goff) do { if constexpr (GATHER) { PG8_STAGE_X(rsA, g.A, bufoff, gbase, (goff)[h]); } else { PG8_STAGE_X(rsA, g.A, bufoff, (gbase) + (h) * hstep, voffA); } } while (0)
#define PG8_LDA(dst, b, h) do { _Pragma("unroll") for (int m = 0; m < 4; ++m) _Pragma("unroll") for (int k = 0; k < 2; ++k) dst[m][k] = *(const PG8_LAS bf16x8*)(lds + PG8_SA(b, h) + aoff + m * 2048 + k * 1024); } while (0)
#define PG8_LDB(dst, b, h) do { _Pragma("unroll") for (int n = 0; n < 2; ++n) _Pragma("unroll") for (int k = 0; k < 2; ++k) dst[n][k] = *(const PG8_LAS bf16x8*)(lds + PG8_SB(b, h) + boff + n * 2048 + k * 1024); } while (0)
#define PG8_MMA(ai, bj, At, Bt) do { __builtin_amdgcn_s_setprio(1); \
        if constexpr (FP8 == 2) { _Pragma("unroll") for (int m = 0; m < 4; ++m) _Pragma("unroll") for (int n = 0; n < 2; ++n) { \
            const i32x8 b_ = __builtin_shufflevector(__builtin_bit_cast(i32x4v, Bt[n][0]), __builtin_bit_cast(i32x4v, Bt[n][1]), 0, 1, 2, 3, 4, 5, 6, 7), a_ = __builtin_shufflevector(__builtin_bit_cast(i32x4v, At[m][0]), __builtin_bit_cast(i32x4v, At[m][1]), 0, 1, 2, 3, 4, 5, 6, 7); \
            acc[ai][bj][m][n] = __builtin_amdgcn_mfma_scale_f32_16x16x128_f8f6f4(b_, a_, acc[ai][bj][m][n], 0, 0, 0, 0, 0, 0); } } \
        else if constexpr (FP8 == 1) { _Pragma("unroll") for (int k = 0; k < 2; ++k) _Pragma("unroll") for (int hf = 0; hf < 2; ++hf) _Pragma("unroll") for (int m = 0; m < 4; ++m) _Pragma("unroll") for (int n = 0; n < 2; ++n) { \
            const i64x2 b_ = __builtin_bit_cast(i64x2, Bt[n][k]), a_ = __builtin_bit_cast(i64x2, At[m][k]); \
            acc[ai][bj][m][n] = __builtin_amdgcn_mfma_f32_16x16x32_fp8_fp8(b_[hf], a_[hf], acc[ai][bj][m][n], 0, 0, 0); } } \
        else { _Pragma("unroll") for (int m = 0; m < 4; ++m) _Pragma("unroll") for (int n = 0; n < 2; ++n) _Pragma("unroll") for (int k = 0; k < 2; ++k) \
            acc[ai][bj][m][n] = __builtin_amdgcn_mfma_f32_16x16x32_bf16(Bt[n][k], At[m][k], acc[ai][bj][m][n], 0, 0, 0); } \
        __builtin_amdgcn_s_setprio(0); } while (0)
#define PG8_WAIT_V(n) asm volatile("s_waitcnt vmcnt(" #n ")" ::: "memory")
#define PG8_WAIT_L(n) asm volatile("s_waitcnt lgkmcnt(" #n ")" ::: "memory")
#define PG8_BAR __builtin_amdgcn_s_barrier()
#define PG8_SCHED __builtin_amdgcn_sched_barrier(0)
    Unit cur, nxt; int ui = 0;
    if (!S.next(0, cur)) return;
    f32x4 acc[2][2][4][2];
#pragma unroll
    for (int a = 0; a < 2; ++a)
#pragma unroll
        for (int b = 0; b < 2; ++b)
#pragma unroll
            for (int m = 0; m < 4; ++m)
#pragma unroll
                for (int n = 0; n < 2; ++n) acc[a][b][m][n] = (f32x4){0.f, 0.f, 0.f, 0.f};
    bf16x8 At[4][2], B0[2][2], B1[2][2];
    unsigned gc[2][2], gn[2][2];
    const char* cA; const char* cB = (const char*)g.Bt + (size_t)cur.pn * tstep;
    if constexpr (GATHER) { cA = (const char*)g.A;
#pragma unroll
        for (int h = 0; h < 2; ++h)
#pragma unroll
            for (int i = 0; i < 2; ++i) { gc[h][i] = (S.arow(cur, h * HALF + RA[i]) * (unsigned)K + (unsigned)CA[i]) * 2u; gn[h][i] = gc[h][i]; }
    } else { cA = (const char*)g.A + (size_t)cur.pm * tstep; }
    PG8_STAGE(PG8_SB(0, 0), cB, voffB); PG8_STAGE(PG8_SB(0, 1), cB + hstep, voffB); PG8_STAGE_A(PG8_SA(0, 0), cA, 0, gc); PG8_STAGE_A(PG8_SA(0, 1), cA, 1, gc);
    if (wr == 1) PG8_BAR;
    PG8_WAIT_V(2); PG8_BAR;
    PG8_STAGE(PG8_SB(1, 0), cB + kstep, voffB); PG8_STAGE_A(PG8_SA(1, 0), cA + kstep, 0, gc); PG8_STAGE(PG8_SB(1, 1), cB + hstep + kstep, voffB);
    PG8_WAIT_V(6); PG8_BAR;
    for (;;) {
        const bool has_next = S.next(ui + 1, nxt);
        const char* nA; const char* nB = has_next ? (const char*)g.Bt + (size_t)nxt.pn * tstep : cB;
        if constexpr (GATHER) { nA = cA;
            if (has_next) {
#pragma unroll
                for (int h = 0; h < 2; ++h)
#pragma unroll
                    for (int i = 0; i < 2; ++i) { int R_ = RA[i], C_ = CA[i]; if constexpr (BUF) { const int t2 = PG8_FRESH_TID(); stage_rc(t2 * 16 + i * 8192, R_, C_); }
                        gn[h][i] = (S.arow(nxt, h * HALF + R_) * (unsigned)K + (unsigned)C_) * 2u; }
                if constexpr (BUF) { *(PG8_LAS u32x4s*)(lds + GN_STASH + PG8_FRESH_TID() * 16) = (u32x4s){gn[0][0], gn[0][1], gn[1][0], gn[1][1]}; } }
        } else { nA = has_next ? (const char*)g.A + (size_t)nxt.pm * tstep : cA; }
        unsigned g2[2][2];
#pragma unroll 1
        for (int t = 0; t < nt; t += 2) {
            const bool last = (t == nt - 2);
            const char* a1 = cA + (size_t)(t + 1) * kstep;
            const char* a2 = last ? nA : cA + (size_t)(t + 2) * kstep; const char* b2 = last ? nB : cB + (size_t)(t + 2) * kstep;
            const char* a3 = a2 + kstep; const char* b3 = b2 + kstep;
            if constexpr (GATHER) {
              if constexpr (BUF) {
                if (last && has_next) { const u32x4s v_ = *(const PG8_LAS u32x4s*)(lds + GN_STASH + PG8_FRESH_TID() * 16); g2[0][0] = v_.x; g2[0][1] = v_.y; g2[1][0] = v_.z; g2[1][1] = v_.w; }
                else { g2[0][0] = gc[0][0]; g2[0][1] = gc[0][1]; g2[1][0] = gc[1][0]; g2[1][1] = gc[1][1]; }
              } else {
#pragma unroll
            for (int h = 0; h < 2; ++h)
#pragma unroll
                for (int i = 0; i < 2; ++i) g2[h][i] = last ? gn[h][i] : gc[h][i]; } }
            PG8_LDB(B0, 0, 0); PG8_LDB(B1, 0, 1); PG8_SCHED; PG8_LDA(At, 0, 0); PG8_STAGE_A(PG8_SA(1, 1), a1, 1, gc);
            PG8_WAIT_V(8); PG8_WAIT_L(0); PG8_BAR; PG8_MMA(0, 0, At, B0); PG8_MMA(0, 1, At, B1); PG8_BAR; PG8_SCHED;
            PG8_LDA(At, 0, 1); PG8_STAGE(PG8_SB(0, 0), b2, voffB); PG8_STAGE(PG8_SB(0, 1), b2 + hstep, voffB); PG8_STAGE_A(PG8_SA(0, 0), a2, 0, g2);
            PG8_WAIT_V(8); PG8_WAIT_L(0); PG8_BAR; PG8_MMA(1, 0, At, B0); PG8_MMA(1, 1, At, B1); PG8_BAR; PG8_SCHED;
            PG8_LDB(B0, 1, 0); PG8_LDB(B1, 1, 1); PG8_SCHED; PG8_LDA(At, 1, 0); PG8_STAGE_A(PG8_SA(0, 1), a2, 1, g2);
            PG8_WAIT_V(8); PG8_WAIT_L(0); PG8_BAR; PG8_MMA(0, 0, At, B0); PG8_MMA(0, 1, At, B1); PG8_BAR; PG8_SCHED;
            PG8_LDA(At, 1, 1); PG8_STAGE(PG8_SB(1, 0), b3, voffB); PG8_STAGE(PG8_SB(1, 1), b3 + hstep, voffB); PG8_STAGE_A(PG8_SA(1, 0), a3, 0, g2);
            PG8_WAIT_V(8); PG8_WAIT_L(0); PG8_BAR; PG8_MMA(1, 0, At, B0); PG8_MMA(1, 1, At, B1); PG8_BAR; PG8_SCHED;
        }
        if constexpr (ALIGN_EPI) { if (wr == 0) PG8_BAR; }
        if constexpr (BUF) { const int l2 = PG8_FRESH_TID(); E(acc, cur, wr, wc, l2 & 15, (l2 >> 4) & 3); }
        else E(acc, cur, wr, wc, fr, fq);
        if (!has_next) break;
#pragma unroll
        for (int a = 0; a < 2; ++a)
#pragma unroll
            for (int b = 0; b < 2; ++b)
#pragma unroll
                for (int m = 0; m < 4; ++m)
#pragma unroll
                    for (int n = 0; n < 2; ++n) acc[a][b][m][n] = (f32x4){0.f, 0.f, 0.f, 0.f};
        cur = nxt; cA = nA; cB = nB; ++ui;
        if constexpr (GATHER) {
#pragma unroll
        for (int h = 0; h < 2; ++h)
#pragma unroll
            for (int i = 0; i < 2; ++i) gc[h][i] = BUF ? g2[h][i] : gn[h][i]; }
        if constexpr (ALIGN_EPI) { if (wr == 1) PG8_BAR; }
    }
    PG8_WAIT_V(0);
    if constexpr (!ALIGN_EPI) { if (wr == 0) PG8_BAR; }
    PG8_BAR;
#undef PG8_SA
#undef PG8_FRESH_TID
#undef PG8_SB
#undef PG8_STAGE
#undef PG8_STAGE_X
#undef PG8_STAGE_A
#undef PG8_LDA
#undef PG8_LDB
#undef PG8_MMA
#undef PG8_WAIT_V
#undef PG8_WAIT_L
#undef PG8_BAR
#undef PG8_SCHED
}
}
typedef __attribute__((address_space(3))) unsigned char lds_u8;

__device__ __forceinline__ u32x4 pack8(const f32x4& a, const f32x4& b) { return (u32x4){pg8::cvt_pk_bf16(a.x, a.y), pg8::cvt_pk_bf16(a.z, a.w), pg8::cvt_pk_bf16(b.x, b.y), pg8::cvt_pk_bf16(b.z, b.w)}; }
__device__ __forceinline__ unsigned pk4_fp8(const f32x4& v) { unsigned w = __builtin_amdgcn_cvt_pk_fp8_f32(v.x, v.y, 0u, false); return __builtin_amdgcn_cvt_pk_fp8_f32(v.z, v.w, w, true); }
struct EpiInM {
  static constexpr bool PERM = true;
  unsigned char* ws; int pn0; float sc;
  __device__ __forceinline__ void operator()(const f32x4 (&acc)[2][2][4][2], const pg8::Unit& u, int wr, int wc, int fr, int fq) const {
    const float* cs = (const float*)(ws + WS_ROPE); const float* sn = cs + SEQ * 32;
    const int pn = tperm(u.pn + pn0);
#pragma unroll
    for (int ai = 0; ai < 2; ++ai)
#pragma unroll
      for (int m = 0; m < 4; ++m) {
        const int row = u.pm * 256 + ai * 128 + wr * 64 + m * 16 + fr, pos = row & (SEQ - 1);
#pragma unroll
        for (int bj = 0; bj < 2; ++bj) {
          const int w = bj * 128 + wc * 32 + 8 * fq;
          f32x4 v0 = acc[ai][bj][m][0] * sc, v1 = acc[ai][bj][m][1] * sc;
          const bool do_rope = (pn == 0) || (pn == 1 && bj == 0) || (pn == 2) || (pn == 3 && bj == 0 && wc < 2);
          if (do_rope) { const int d = (w & 63) >> 1; const f32x4 c4 = *(const f32x4*)(cs + pos * 32 + d), s4 = *(const f32x4*)(sn + pos * 32 + d);
            const f32x4 o0 = {v0.x * c4.x - v0.y * s4.x, v0.y * c4.x + v0.x * s4.x, v0.z * c4.y - v0.w * s4.y, v0.w * c4.y + v0.z * s4.y};
            const f32x4 o1 = {v1.x * c4.z - v1.y * s4.z, v1.y * c4.z + v1.x * s4.z, v1.z * c4.w - v1.w * s4.w, v1.w * c4.w + v1.z * s4.w};
            v0 = o0; v1 = o1; }
          if (pn == 0) { *(u32x2*)(ws + WS_QA + (size_t)row * 384 + w) = (u32x2){pk4_fp8(v0 * QSCALE), pk4_fp8(v1 * QSCALE)}; }
          else if (pn == 1) { if (bj == 0) *(u32x2*)(ws + WS_QA + (size_t)row * 384 + 256 + w) = (u32x2){pk4_fp8(v0 * QSCALE), pk4_fp8(v1 * QSCALE)};
                              else *(u32x4*)((bf16_t*)(ws + WS_CKV) + (size_t)row * 128 + (w - 128)) = pack8(v0, v1); }
          else if (pn == 2) { *(u32x4*)((bf16_t*)(ws + WS_IQ) + (size_t)row * 256 + w) = pack8(v0, v1); }
          else if (pn == 3) { if (bj == 0) { if (wc < 2) *(u32x4*)((bf16_t*)(ws + WS_IK) + (size_t)row * 64 + w) = pack8(v0, v1);
                                             else if (wc == 2 && fq < 2) { if (fq == 0) v0 = v0 * 0.0625f; float* o = (float*)(ws + WS_SM) + (size_t)row * 16 + 8 * fq; *(f32x4*)o = v0; *(f32x4*)(o + 4) = v1; } } }
          else if (pn == 4) { *(u32x2*)(ws + WS_QC + (size_t)row * 256 + w) = (u32x2){pk4_fp8(v0 * QSCALE), pk4_fp8(v1 * QSCALE)}; }
          else { *(u32x2*)(ws + WS_GB + (size_t)row * 1536 + (pn - 5) * 256 + w) = (u32x2){pk4_fp8(v0), pk4_fp8(v1)}; }
        }
      }
  }
};
struct EpiMemKVM {
  static constexpr bool PERM = true;
  unsigned char* ws;
  __device__ __forceinline__ void operator()(const f32x4 (&acc)[2][2][4][2], const pg8::Unit& u, int wr, int wc, int fr, int fq) const {
#pragma unroll
    for (int ai = 0; ai < 2; ++ai)
#pragma unroll
      for (int m = 0; m < 4; ++m) {
        const int row = u.pm * 256 + ai * 128 + wr * 64 + m * 16 + fr;
#pragma unroll
        for (int bj = 0; bj < 2; ++bj) {
          const int w = bj * 128 + wc * 32 + 8 * fq; const f32x4 v0 = acc[ai][bj][m][0], v1 = acc[ai][bj][m][1];
          const unsigned w0 = pk4_fp8(v0), w1 = pk4_fp8(v1);
          if (u.pn == 0) *(u32x2*)(ws + WS_MK + (size_t)row * 256 + w) = (u32x2){w0, w1};
          else { const int mem = row & 255, xx = mem & 31, mpos = (mem & ~31) + 8 * ((xx >> 2) & 3) + (xx & 3) + 4 * (xx >> 4);
            unsigned char* o = ws + WS_MVT + ((size_t)(row >> 8) * 256 + w) * 256 + mpos;
            o[0] = (unsigned char)w0; o[256] = (unsigned char)(w0 >> 8); o[512] = (unsigned char)(w0 >> 16); o[768] = (unsigned char)(w0 >> 24); o[1024] = (unsigned char)w1; o[1280] = (unsigned char)(w1 >> 8); o[1536] = (unsigned char)(w1 >> 16); o[1792] = (unsigned char)(w1 >> 24); }
        }
      }
  }
};
struct EpiOutM {
  static constexpr bool PERM = true;
  const bf16_t* x; bf16_t* y; float* lnsum;
  __device__ __forceinline__ void operator()(const f32x4 (&acc)[2][2][4][2], const pg8::Unit& u, int wr, int wc, int fr, int fq) const {
#pragma unroll
    for (int ai = 0; ai < 2; ++ai)
#pragma unroll
      for (int m = 0; m < 4; ++m) {
        const int row = u.pm * 256 + ai * 128 + wr * 64 + m * 16 + fr;
        const size_t rb = (size_t)row * 1024 + u.pn * 256 + wc * 32 + 8 * fq;
        float s1 = 0.f, s2 = 0.f;
#pragma unroll
        for (int bj = 0; bj < 2; ++bj) { const size_t o = rb + bj * 128; const u32x4 xv = *(const u32x4*)(x + o);
          const f32x4 x0 = {__uint_as_float(xv.x << 16), __uint_as_float(xv.x & 0xffff0000u), __uint_as_float(xv.y << 16), __uint_as_float(xv.y & 0xffff0000u)};
          const f32x4 x1 = {__uint_as_float(xv.z << 16), __uint_as_float(xv.z & 0xffff0000u), __uint_as_float(xv.w << 16), __uint_as_float(xv.w & 0xffff0000u)};
          const f32x4 y0 = x0 * ALPHA + acc[ai][bj][m][0] * (1.f / W8SCALE), y1 = x1 * ALPHA + acc[ai][bj][m][1] * (1.f / W8SCALE);
          s1 += y0.x; s1 += y0.y; s1 += y0.z; s1 += y0.w; s1 += y1.x; s1 += y1.y; s1 += y1.z; s1 += y1.w;
          s2 = fmaf(y0.x, y0.x, s2); s2 = fmaf(y0.y, y0.y, s2); s2 = fmaf(y0.z, y0.z, s2); s2 = fmaf(y0.w, y0.w, s2); s2 = fmaf(y1.x, y1.x, s2); s2 = fmaf(y1.y, y1.y, s2); s2 = fmaf(y1.z, y1.z, s2); s2 = fmaf(y1.w, y1.w, s2);
          *(u32x4*)(y + o) = pack8(y0, y1); }
        s1 += __shfl_xor(s1, 16); s1 += __shfl_xor(s1, 32); s2 += __shfl_xor(s2, 16); s2 += __shfl_xor(s2, 32);
        if (fq == 0) *(hw_f32x2*)(lnsum + ((size_t)row * 16 + u.pn * 4 + wc) * 2) = (hw_f32x2){s1, s2};
      }
  }
};
struct MoeOrder {
  const int* offs; const int* cnts; int npn, G, c; const unsigned* LIST;
  __device__ __forceinline__ bool next(int i, pg8::Unit& u) const {
    const int* offs = this->offs; asm volatile("" : "+s"(offs));
    const int L = i * G + c; const int ntiles = __builtin_amdgcn_readfirstlane(offs[64]) >> 8;
    if (L >= ntiles * npn) return false;
    const int rt = L / npn, pl = L - rt * npn;
    int e = 0, hi = 63;
#pragma unroll
    for (int st = 0; st < 6; ++st) { const int mid = (e + hi) >> 1; if (__builtin_amdgcn_readfirstlane(offs[mid + 1]) > rt * 256) hi = mid; else e = mid + 1; }
    u.pm = rt; u.mt = rt - (__builtin_amdgcn_readfirstlane(offs[e]) >> 8); u.e = e; u.pn = e * npn + pl; u.aux = __builtin_amdgcn_readfirstlane(cnts[e]); return true;
  }
  __device__ __forceinline__ unsigned arow(const pg8::Unit& u, int r) const { const int rank = u.mt * 256 + r; return rank < u.aux ? LIST[(size_t)u.e * 32768 + rank] : 0u; }
};
struct EpiMoeUpM {
  static constexpr bool PERM = true;
  unsigned char* H;
  __device__ __forceinline__ void operator()(const f32x4 (&acc)[2][2][4][2], const pg8::Unit& u, int wr, int wc, int fr, int fq) const {
    const int pl = u.pn & 1;
    int fr_ = fr, fq_ = fq; asm volatile("" : "+v"(fr_), "+v"(fq_));
#pragma unroll
    for (int ai = 0; ai < 2; ++ai)
#pragma unroll
      for (int m = 0; m < 4; ++m) {
        const int rl = ai * 128 + wr * 64 + m * 16 + fr_;
        if (u.mt * 256 + rl < u.aux) {
          f32x4 h0, h1; const float is = 1.f / W8SCALE, us = H8SCALE / W8SCALE; const f32x4 g0 = acc[ai][0][m][0] * is, g1 = acc[ai][0][m][1] * is, u0 = acc[ai][1][m][0] * us, u1 = acc[ai][1][m][1] * us;
          h0.x = silu_f(g0.x) * u0.x; h0.y = silu_f(g0.y) * u0.y; h0.z = silu_f(g0.z) * u0.z; h0.w = silu_f(g0.w) * u0.w;
          h1.x = silu_f(g1.x) * u1.x; h1.y = silu_f(g1.y) * u1.y; h1.z = silu_f(g1.z) * u1.z; h1.w = silu_f(g1.w) * u1.w;
          *(u32x2*)(H + (size_t)(u.pm * 256 + rl) * 256 + pl * 128 + wc * 32 + 8 * fq_) = (u32x2){pk4_fp8(h0), pk4_fp8(h1)};
        }
      }
  }
};
struct EpiMoeDownM {
  static constexpr bool PERM = true;
  unsigned char* Y; const float* GATEL;
  __device__ __forceinline__ void operator()(const f32x4 (&acc)[2][2][4][2], const pg8::Unit& u, int wr, int wc, int fr, int fq) const {
    const int pl = u.pn & 3;
    int fr_ = fr, fq_ = fq; asm volatile("" : "+v"(fr_), "+v"(fq_));
    unsigned char* yp = Y + (size_t)(u.pm * 256 + wr * 64 + fr_) * 1024 + pl * 256 + wc * 32 + 8 * fq_;
#pragma unroll
    for (int ai = 0; ai < 2; ++ai)
#pragma unroll
      for (int m = 0; m < 4; ++m) {
        const float gt = Y8SCALE / (W8SCALE * H8SCALE);
#pragma unroll
        for (int bj = 0; bj < 2; ++bj)
          *(u32x2*)(yp + (size_t)(ai * 128 + m * 16) * 1024 + bj * 128) = (u32x2){pk4_fp8(acc[ai][bj][m][0] * gt), pk4_fp8(acc[ai][bj][m][1] * gt)};
      }
  }
};

__device__ __forceinline__ void phase_inproj_mfma(const Ctx& c, lds_u8* lds) {
  unsigned char* ws = c.ws; const int tid = phase_tid();
  { pg8::Gemm g{(const bf16_t*)c.out, (const bf16_t*)(ws + WS_WIN), 1024}; pg8::StaticOrder S; S.init(T, IN_F8 * 256, gridDim.x, blockIdx.x); EpiInM E{ws, 0, 1.f};
    pg8::gemm_phase<EpiInM, pg8::StaticOrder, true, false>(lds, g, S, E, tid); }
  { pg8::Gemm g{(const bf16_t*)(ws + WS_MEMB), (const bf16_t*)(ws + WS_WMKV), 1024}; pg8::StaticOrder S; S.init(TM, 512, gridDim.x, (int)blockIdx.x - 128); EpiMemKVM E{ws};
    pg8::gemm_phase<EpiMemKVM, pg8::StaticOrder, true, false>(lds, g, S, E, tid); }
}
__device__ __forceinline__ void phase_inproj_f8(const Ctx& c, lds_u8* lds) {
  unsigned char* ws = c.ws; const int tid = phase_tid();
  pg8::Gemm g{(const bf16_t*)((const unsigned char*)c.out + XF_OFF), (const bf16_t*)(ws + WS_WIN8 + (size_t)IN_F8 * 256 * 1024), 512}; pg8::StaticOrder S; S.init(T, NIN - IN_F8 * 256, gridDim.x, blockIdx.x); EpiInM E{ws, IN_F8, 1.f / W8SCALE};
  pg8::gemm_phase<EpiInM, pg8::StaticOrder, true, false, 2, true>(lds, g, S, E, tid);
}
__device__ __forceinline__ void phase_outproj_mfma(const Ctx& c, lds_u8* lds) {
  unsigned char* ws = c.ws; const int tid = phase_tid();
  pg8::Gemm g{(const bf16_t*)(ws + WS_CAT), (const bf16_t*)(ws + WS_WO), 512}; pg8::StaticOrder S; S.init(T, 1024, gridDim.x, blockIdx.x); EpiOutM E{(const bf16_t*)c.out, (bf16_t*)(ws + WS_X1B), (float*)(ws + WS_LNSUM)};
  pg8::gemm_phase<EpiOutM, pg8::StaticOrder, true, false, 2, true>(lds, g, S, E, tid);
}
__device__ __forceinline__ void phase_moe_up_mfma(const Ctx& c, lds_u8* lds) {
  unsigned char* ws = c.ws; const int tid = phase_tid();
  int* offs = (int*)((unsigned char*)lds + pg8::STAGE_BYTES); int* cnts = offs + 65;
  expert_offsets(c, offs, cnts, tid);
  pg8::Gemm g{(const bf16_t*)(ws + WS_X1F), (const bf16_t*)(ws + WS_WGU), 512};
  MoeOrder S{offs, cnts, 2, (int)gridDim.x, (int)blockIdx.x, (const unsigned*)(ws + WS_LIST)}; EpiMoeUpM E{ws + WS_H};
  pg8::gemm_phase<EpiMoeUpM, MoeOrder, true, true, 2, true>(lds, g, S, E, tid);
}
__device__ __forceinline__ void phase_moe_down_mfma(const Ctx& c, lds_u8* lds) {
  unsigned char* ws = c.ws; const int tid = phase_tid();
  int* offs = (int*)((unsigned char*)lds + pg8::STAGE_BYTES); int* cnts = offs + 65;
  expert_offsets(c, offs, cnts, tid);
  pg8::Gemm g{(const bf16_t*)(ws + WS_H), (const bf16_t*)(ws + WS_WD), 128};
  MoeOrder S{offs, cnts, 4, (int)gridDim.x, (int)blockIdx.x, nullptr}; EpiMoeDownM E{(unsigned char*)(ws + WS_Y), (const float*)(ws + WS_GATEL)};
  pg8::gemm_phase<EpiMoeDownM, MoeOrder, true, false, 2, true>(lds, g, S, E, tid);
}

__device__ __forceinline__ void phase_kvup(const Ctx& c, float* lds) {
  unsigned char* ws = c.ws;
  const int tid = phase_tid(), lane = tid & 63, wave = tid >> 6, fr = lane & 15, fq = lane >> 4;
  const bf16_t* W = (const bf16_t*)(ws + WS_WKV);
  const bf16_t* CKV = (const bf16_t*)(ws + WS_CKV); bf16_t* KVA = (bf16_t*)(ws + WS_KVA);
  const float* cs = (const float*)(ws + WS_ROPE); const float* sn = cs + SEQ * 32;
  for (int tile = blockIdx.x * NWAVES + wave; tile < T / 16; tile += gridDim.x * NWAVES) {
    const int t = tile * 16 + fr, pos = t & (SEQ - 1);
    pg8::bf16x8 bx[4]; float ss = 0.f;
#pragma unroll
    for (int ks = 0; ks < 4; ++ks) { const u32x4 v = *(const u32x4*)(CKV + (size_t)t * 128 + ks * 32 + fq * 8); bx[ks] = __builtin_bit_cast(pg8::bf16x8, v);
      const float f[8] = {__uint_as_float(v.x << 16), __uint_as_float(v.x & 0xffff0000u), __uint_as_float(v.y << 16), __uint_as_float(v.y & 0xffff0000u), __uint_as_float(v.z << 16), __uint_as_float(v.z & 0xffff0000u), __uint_as_float(v.w << 16), __uint_as_float(v.w & 0xffff0000u)};
#pragma unroll
      for (int e = 0; e < 8; ++e) ss += f[e] * f[e]; }
    ss += __shfl_xor(ss, 16); ss += __shfl_xor(ss, 32);
    const float rstd = rsqrtf(ss * (1.f / 128.f) + 1e-6f);
#pragma unroll
    for (int nt = 0; nt < 8; ++nt) { f32x4 d = {0.f, 0.f, 0.f, 0.f};
#pragma unroll
      for (int ks = 0; ks < 4; ++ks) d = __builtin_amdgcn_mfma_f32_16x16x32_bf16(*(const pg8::bf16x8*)(W + (size_t)(nt * 16 + fr) * 128 + ks * 32 + fq * 8), bx[ks], d, 0, 0, 0);
      d = d * rstd;
      const int p0 = nt * 16 + fq * 4;
      if (nt < 4) { const int dd = p0 >> 1; const float c0 = cs[pos * 32 + dd], s0 = sn[pos * 32 + dd], c1 = cs[pos * 32 + dd + 1], s1 = sn[pos * 32 + dd + 1];
        const f32x4 o = {d.x * c0 - d.y * s0, d.y * c0 + d.x * s0, d.z * c1 - d.w * s1, d.w * c1 + d.z * s1}; d = o; }
      { int w8 = __builtin_amdgcn_cvt_pk_fp8_f32(d.x, d.y, 0, false); w8 = __builtin_amdgcn_cvt_pk_fp8_f32(d.z, d.w, w8, true);
        *(unsigned*)((unsigned char*)KVA + (size_t)t * 128 + p0) = (unsigned)w8; } }
  }
}


typedef _Float16 h16x2 __attribute__((ext_vector_type(2)));
constexpr int TK_KP = 4104;
constexpr int TK_KEYS = 0, TK_H1 = 16 * TK_KP * 2, TK_H2 = TK_H1 + 16 * 128 * 4, TK_MISC = TK_H2 + 8 * 128 * 4;
__device__ __forceinline__ unsigned mono16x2(unsigned u) { const unsigned m = ((u >> 15) & 0x00010001u) * 0xffffu; return u ^ (m | 0x80008000u); }
__device__ __forceinline__ int wave_incl_scan(int x) {
  x += __builtin_amdgcn_update_dpp(0, x, 0x111, 0xF, 0xF, true);
  x += __builtin_amdgcn_update_dpp(0, x, 0x112, 0xF, 0xF, true);
  x += __builtin_amdgcn_update_dpp(0, x, 0x114, 0xF, 0xF, true);
  x += __builtin_amdgcn_update_dpp(0, x, 0x118, 0xF, 0xF, true);
  x += __builtin_amdgcn_update_dpp(0, x, 0x142, 0xA, 0xF, false);
  x += __builtin_amdgcn_update_dpp(0, x, 0x143, 0xC, 0xF, false);
  return x;
}

__device__ __forceinline__ void hist_find(const unsigned* hw, int need, int lane, int& B, int& above) {
  const unsigned w0 = hw[127 - 2 * lane], w1 = hw[126 - 2 * lane];
  const int c0 = (int)(w0 >> 16), c1 = (int)(w0 & 0xffffu), c2 = (int)(w1 >> 16), c3 = (int)(w1 & 0xffffu);
  const int tl = c0 + c1 + c2 + c3;
  const int incl = wave_incl_scan(tl);
  const int excl = incl - tl;
  const bool hit = (excl < need) && (incl >= need);
  int b = 0, ab = 0;
  if (hit) { int a = excl; b = 255 - 4 * lane; ab = a;
    if (a + c0 < need) { a += c0; b = 254 - 4 * lane; ab = a; if (a + c1 < need) { a += c1; b = 253 - 4 * lane; ab = a; if (a + c2 < need) { a += c2; b = 252 - 4 * lane; ab = a; } } } }
  const unsigned long long m = __ballot(hit);
  const int src = __builtin_amdgcn_readfirstlane(m ? (__ffsll((long long)m) - 1) : 0);
  B = __builtin_amdgcn_readlane(b, src); above = __builtin_amdgcn_readlane(ab, src);
}
__device__ __forceinline__ void phase_topk_mfma(const Ctx& c, unsigned char* ldsb, unsigned* qhead) {
  unsigned char* ws = c.ws;
  const int tid = phase_tid(), lane = tid & 63, wave = tid >> 6, fr = lane & 15, fq = lane >> 4;
  unsigned short* keys = (unsigned short*)(ldsb + TK_KEYS);
  unsigned* h1 = (unsigned*)(ldsb + TK_H1); unsigned* h2 = (unsigned*)(ldsb + TK_H2) + wave * 128; int* misc = (int*)(ldsb + TK_MISC);
  const bf16_t* IQ = (const bf16_t*)(ws + WS_IQ); const bf16_t* IK = (const bf16_t*)(ws + WS_IK); const float* SM = (const float*)(ws + WS_SM);
  unsigned short* SEL = (unsigned short*)(ws + WS_SEL);
  WorkQ2 wq; wq2_init(wq, qhead, misc, tid);
  pg8::bf16x8 bq[4][2]; f32x4 iw = {0.f, 0.f, 0.f, 0.f};
#define TK_LOADQ(IT) do { const size_t qr_ = (size_t)((IT) & 7) * SEQ + (255 - ((IT) >> 3)) * 16 + fr; \
      _Pragma("unroll") for (int hh = 0; hh < 4; ++hh) _Pragma("unroll") for (int ks = 0; ks < 2; ++ks) bq[hh][ks] = *(const pg8::bf16x8*)(IQ + qr_ * 256 + hh * 64 + ks * 32 + fq * 8); \
      iw = *(const f32x4*)(SM + qr_ * 16); } while (0)
  bool primed = false;
  for (;;) {
    int item, nitem; wq2_next(wq, tid, item, nitem);
    if (item >= 240 * 8) break;
    const int b = item & 7, qb = 255 - (item >> 3), s0 = qb * 16;
    for (int i = tid; i < 16 * 128; i += NTHREADS) h1[i] = 0u;
    if (!primed) { TK_LOADQ(item); primed = true; }
    const int nkt = qb + 1, slim = s0 + fr;
    __syncthreads();
    pg8::bf16x8 a0n = {0, 0, 0, 0, 0, 0, 0, 0}, a1n = a0n;
    if (wave < nkt) { const bf16_t* kr = IK + ((size_t)b * SEQ + wave * 16 + fr) * 64 + fq * 8; a0n = *(const pg8::bf16x8*)kr; a1n = *(const pg8::bf16x8*)(kr + 32); }
    for (int kt = wave; kt < nkt; kt += NWAVES) {
      const pg8::bf16x8 a0 = a0n, a1 = a1n;
      if (kt + NWAVES < nkt) { const bf16_t* kr = IK + ((size_t)b * SEQ + (kt + NWAVES) * 16 + fr) * 64 + fq * 8; a0n = *(const pg8::bf16x8*)kr; a1n = *(const pg8::bf16x8*)(kr + 32); }
      f32x4 sc = {0.f, 0.f, 0.f, 0.f};
#pragma unroll
      for (int hh = 0; hh < 4; ++hh) { f32x4 d = {0.f, 0.f, 0.f, 0.f};
        d = __builtin_amdgcn_mfma_f32_16x16x32_bf16(a0, bq[hh][0], d, 0, 0, 0); d = __builtin_amdgcn_mfma_f32_16x16x32_bf16(a1, bq[hh][1], d, 0, 0, 0);
        const float w = hh == 0 ? iw.x : hh == 1 ? iw.y : hh == 2 ? iw.z : iw.w;
        sc.x = fmaf(w, fmaxf(d.x, 0.f), sc.x); sc.y = fmaf(w, fmaxf(d.y, 0.f), sc.y); sc.z = fmaf(w, fmaxf(d.z, 0.f), sc.z); sc.w = fmaf(w, fmaxf(d.w, 0.f), sc.w); }
      unsigned k01 = mono16x2(__builtin_bit_cast(unsigned, __builtin_amdgcn_cvt_pkrtz(sc.x, sc.y))), k23 = mono16x2(__builtin_bit_cast(unsigned, __builtin_amdgcn_cvt_pkrtz(sc.z, sc.w)));
      const int kbase = kt * 16 + fq * 4;
      unsigned* hq = h1 + fr * 128;
      if (kt + 1 < nkt) {
        *(u32x2*)(keys + fr * TK_KP + kbase) = (u32x2){k01, k23};
        { const unsigned kk = k01 & 0xffffu; atomicAdd(hq + (kk >> 9), 1u << ((kk >> 4) & 16)); }
        { const unsigned kk = k01 >> 16; atomicAdd(hq + (kk >> 9), 1u << ((kk >> 4) & 16)); }
        { const unsigned kk = k23 & 0xffffu; atomicAdd(hq + (kk >> 9), 1u << ((kk >> 4) & 16)); }
        { const unsigned kk = k23 >> 16; atomicAdd(hq + (kk >> 9), 1u << ((kk >> 4) & 16)); }
      } else {
        if (kbase + 0 > slim) k01 &= 0xffff0000u; if (kbase + 1 > slim) k01 &= 0x0000ffffu;
        if (kbase + 2 > slim) k23 &= 0xffff0000u; if (kbase + 3 > slim) k23 &= 0x0000ffffu;
        *(u32x2*)(keys + fr * TK_KP + kbase) = (u32x2){k01, k23};
        if (kbase + 0 <= slim) { const unsigned kk = k01 & 0xffffu; atomicAdd(hq + (kk >> 9), 1u << ((kk >> 4) & 16)); }
        if (kbase + 1 <= slim) { const unsigned kk = k01 >> 16; atomicAdd(hq + (kk >> 9), 1u << ((kk >> 4) & 16)); }
        if (kbase + 2 <= slim) { const unsigned kk = k23 & 0xffffu; atomicAdd(hq + (kk >> 9), 1u << ((kk >> 4) & 16)); }
        if (kbase + 3 <= slim) { const unsigned kk = k23 >> 16; atomicAdd(hq + (kk >> 9), 1u << ((kk >> 4) & 16)); }
      }
    }
    __syncthreads();
    if (nitem < 240 * 8) TK_LOADQ(nitem);
    for (int qi = 0; qi < 2; ++qi) {
      const int q = wave * 2 + qi, s = s0 + q, n = s + 1;
      int B1, above1; hist_find(h1 + q * 128, 256, lane, B1, above1);
      const int need1 = 256 - above1;
      h2[lane] = 0u; h2[64 + lane] = 0u;
      const unsigned short* kq = keys + q * TK_KP;
      const int niter = (n + 511) >> 9;
      for (int it = 0; it < niter; ++it) {
        const int i0 = (it * 64 + lane) * 8; const u32x4 kv = *(const u32x4*)(kq + i0);
        const unsigned k8[8] = {kv.x & 0xffffu, kv.x >> 16, kv.y & 0xffffu, kv.y >> 16, kv.z & 0xffffu, kv.z >> 16, kv.w & 0xffffu, kv.w >> 16};
#pragma unroll
        for (int e = 0; e < 8; ++e) if (i0 + e < n && (int)(k8[e] >> 8) == B1) atomicAdd(h2 + ((k8[e] & 255u) >> 1), 1u << ((k8[e] & 1u) * 16));
      }
      int B2, above2; hist_find(h2, need1, lane, B2, above2);
      const unsigned thr = (unsigned)((B1 << 8) | B2); const int need = need1 - above2;
      unsigned short* dummy = (unsigned short*)(misc + 8 + wave);
      unsigned short* sel = (unsigned short*)h2;
      asm volatile("s_waitcnt lgkmcnt(0)" ::: "memory");
      int tiebase = 0, outbase = 0;
      for (int it = 0; it < niter; ++it) {
        const int i0 = (it * 64 + lane) * 8; const u32x4 kv = *(const u32x4*)(kq + i0);
        const unsigned k8[8] = {kv.x & 0xffffu, kv.x >> 16, kv.y & 0xffffu, kv.y >> 16, kv.z & 0xffffu, kv.z >> 16, kv.w & 0xffffu, kv.w >> 16};
        int cg = 0, ce = 0;
#pragma unroll
        for (int e = 0; e < 8; ++e) { const bool v = i0 + e < n; cg += (v && k8[e] > thr) ? 1 : 0; ce += (v && k8[e] == thr) ? 1 : 0; }
        int tk = 0;
        if (__ballot(ce != 0)) {
          const int eincl = wave_incl_scan(ce); const int eg = tiebase + eincl - ce;
          tk = need - eg; tk = tk < 0 ? 0 : (tk > ce ? ce : tk);
          tiebase += __builtin_amdgcn_readlane(eincl, 63);
        }
        const int oc = cg + tk; const int oincl = wave_incl_scan(oc);
        int pos = outbase + oincl - oc; int tleft = tk;
#pragma unroll
        for (int e = 0; e < 8; ++e) { const bool v = i0 + e < n; const bool tie = v && k8[e] == thr && tleft > 0; const bool take = (v && k8[e] > thr) || tie;
          tleft -= tie ? 1 : 0;
          unsigned short* dst = (take && pos < 256) ? sel + pos : dummy;
          *dst = (unsigned short)(i0 + e); pos += take ? 1 : 0; }
        outbase += __builtin_amdgcn_readlane(oincl, 63);
      }
      asm volatile("s_waitcnt lgkmcnt(0)" ::: "memory");
      *(u32x2*)(SEL + ((size_t)b * SEQ + s) * 256 + lane * 4) = *(const u32x2*)(sel + lane * 4);
      asm volatile("s_waitcnt lgkmcnt(0)" ::: "memory");
    }
  }
}

typedef short s16x4 __attribute__((ext_vector_type(4)));
__device__ __forceinline__ s16x4 lds_tr16(const unsigned char* p) { return __builtin_bit_cast(s16x4, __builtin_amdgcn_ds_read_tr16_b64_v4i16((__attribute__((address_space(3))) s16x4*)(__attribute__((address_space(3))) unsigned char*)p)); }
typedef float f32x2_t __attribute__((ext_vector_type(2))); typedef __bf16 bf16x2_t __attribute__((ext_vector_type(2)));
__device__ __forceinline__ unsigned cvtpk_c(float lo, float hi) { const f32x2_t v = {lo, hi}; const bf16x2_t b = __builtin_convertvector(v, bf16x2_t); return __builtin_bit_cast(unsigned, b); }
__device__ __forceinline__ pg8::bf16x8 packp(const f32x4& a, const f32x4& b) {
  const u32x4 w = {cvtpk_c(a.x, a.y), cvtpk_c(a.z, a.w), cvtpk_c(b.x, b.y), cvtpk_c(b.z, b.w)}; return __builtin_bit_cast(pg8::bf16x8, w); }
constexpr int AT_WB = 9216 + 512;
typedef int v2i_t __attribute__((ext_vector_type(2)));
__device__ __forceinline__ long lds_tr8(const unsigned char* p) { const v2i_t r = __builtin_amdgcn_ds_read_tr8_b64_v2i32((__attribute__((address_space(3))) v2i_t*)(__attribute__((address_space(3))) unsigned char*)p); return (long)(((unsigned long)(unsigned)r.y << 32) | (unsigned long)(unsigned)r.x); }
__device__ __forceinline__ void phase_attn_sparse(const Ctx& c, unsigned char* ldsb, unsigned* qhead) {
  unsigned char* ws = c.ws;
  const int tid = phase_tid(), lane = tid & 63, wave = tid >> 6, fr = lane & 15, fq = lane >> 4;
  unsigned char* vl = ldsb + wave * AT_WB; unsigned short* sl = (unsigned short*)(vl + 9216);
  const unsigned char* QA = ws + WS_QA; const unsigned char* KVA = (const unsigned char*)(ws + WS_KVA); const unsigned short* SEL = (const unsigned short*)(ws + WS_SEL);
  unsigned char* CAT = ws + WS_CAT;
  const float* gA = c.in[10];
  __syncthreads();
  int* aq_slot = (int*)(ldsb + 8 * AT_WB);
  WorkQ wq; wq_init(wq, qhead, aq_slot, tid);
  const int st_off = (lane >> 3) * 144 + (lane & 7) * 16;
  const int kr_off = fr * 144 + fq * 16;
  const int tr_off = (fq * 4 + ((fr >> 1) & 3) + (fr >> 3) * 16) * 144 + 64 + (fr & 1) * 8;
  for (;;) {
  const int item = wq_next(wq, tid);
  if (item >= 512) break;
  for (int tj = 0; tj < 8; ++tj) {
    const int t = item * 64 + wave * 8 + tj;
    const int b = t >> 12, s = t & (SEQ - 1), n = s + 1 < 256 ? s + 1 : 256;
    { u32x2 v;
      if (s >= 256) v = *(const u32x2*)(SEL + (size_t)t * 256 + lane * 4);
      else { const int i0 = lane * 4; const unsigned e0 = i0 < n ? i0 : 0, e1 = i0 + 1 < n ? i0 + 1 : 0, e2 = i0 + 2 < n ? i0 + 2 : 0, e3 = i0 + 3 < n ? i0 + 3 : 0; v = (u32x2){e0 | (e1 << 16), e2 | (e3 << 16)}; }
      *(u32x2*)(sl + lane * 4) = v; }
    asm volatile("s_waitcnt lgkmcnt(0)" ::: "memory");
    const unsigned char* kvb = KVA + (size_t)b * SEQ * 128;
    u32x4 ra[8], rb[8];
#define KLOAD(R, CH) do { _Pragma("unroll") for (int i_ = 0; i_ < 8; ++i_) { const int key_ = sl[(CH) * 64 + i_ * 8 + (lane >> 3)]; R[i_] = *(const u32x4*)(kvb + (size_t)key_ * 128 + (lane & 7) * 16); } } while (0)
#define KSTORE(R) do { _Pragma("unroll") for (int i_ = 0; i_ < 8; ++i_) *(u32x4*)(vl + i_ * 8 * 144 + st_off) = R[i_]; } while (0)
    KLOAD(ra, 0); KLOAD(rb, 1);
    long q0 = 0, q1 = 0;
    if (fr < 6) { const u32x4 a = *(const u32x4*)(QA + (size_t)t * 384 + fr * 64 + fq * 16); q0 = mk64(a.x, a.y); q1 = mk64(a.z, a.w); }
    float m = -3.0e38f, l = 0.f;
    f32x4 ot[4];
#pragma unroll
    for (int mt = 0; mt < 4; ++mt) ot[mt] = (f32x4){0.f, 0.f, 0.f, 0.f};
#define KCHUNK(R, CH) do { \
      KSTORE(R); if ((CH) + 2 < 4) KLOAD(R, (CH) + 2); \
      asm volatile("s_waitcnt lgkmcnt(0)" ::: "memory"); \
      f32x4 st[4]; \
      _Pragma("unroll") for (int kt = 0; kt < 4; ++kt) { const u32x4 a_ = *(const u32x4*)(vl + kt * 16 * 144 + kr_off); f32x4 d_ = {0.f, 0.f, 0.f, 0.f}; \
        d_ = __builtin_amdgcn_mfma_f32_16x16x32_fp8_fp8(mk64(a_.x, a_.y), q0, d_, 0, 0, 0); st[kt] = __builtin_amdgcn_mfma_f32_16x16x32_fp8_fp8(mk64(a_.z, a_.w), q1, d_, 0, 0, 0); } \
      if (n < 256) { _Pragma("unroll") for (int kt = 0; kt < 4; ++kt) { const int sb = (CH) * 64 + kt * 16 + fq * 4; \
        if (sb + 0 >= n) st[kt].x = -3.0e38f; if (sb + 1 >= n) st[kt].y = -3.0e38f; if (sb + 2 >= n) st[kt].z = -3.0e38f; if (sb + 3 >= n) st[kt].w = -3.0e38f; } } \
      float cm = -3.0e38f; \
      _Pragma("unroll") for (int kt = 0; kt < 4; ++kt) cm = fmaxf(fmaxf(fmaxf(cm, st[kt].x), fmaxf(st[kt].y, st[kt].z)), st[kt].w); \
      cm = fmaxf(cm, __shfl_xor(cm, 16)); cm = fmaxf(cm, __shfl_xor(cm, 32)); \
      const float mn = fmaxf(m, cm), al = __builtin_amdgcn_exp2f(m - mn), mb = mn - 8.f; m = mn; \
      float ls = 0.f; \
      _Pragma("unroll") for (int kt = 0; kt < 4; ++kt) { st[kt].x = __builtin_amdgcn_exp2f(st[kt].x - mb); st[kt].y = __builtin_amdgcn_exp2f(st[kt].y - mb); st[kt].z = __builtin_amdgcn_exp2f(st[kt].z - mb); st[kt].w = __builtin_amdgcn_exp2f(st[kt].w - mb); \
        ls += (st[kt].x + st[kt].y) + (st[kt].z + st[kt].w); } \
      l = l * al + ls; \
      _Pragma("unroll") for (int mt = 0; mt < 4; ++mt) ot[mt] = ot[mt] * al; \
      _Pragma("unroll") for (int k2 = 0; k2 < 2; ++k2) { \
        const long pf = mk64(cvt4_fp8(st[2 * k2].x, st[2 * k2].y, st[2 * k2].z, st[2 * k2].w), cvt4_fp8(st[2 * k2 + 1].x, st[2 * k2 + 1].y, st[2 * k2 + 1].z, st[2 * k2 + 1].w)); \
        _Pragma("unroll") for (int mt = 0; mt < 4; ++mt) { const long af = lds_tr8(vl + k2 * 32 * 144 + tr_off + mt * 16); \
          ot[mt] = __builtin_amdgcn_mfma_f32_16x16x32_fp8_fp8(af, pf, ot[mt], 0, 0, 0); } } \
      asm volatile("s_waitcnt lgkmcnt(0)" ::: "memory"); } while (0)
    KCHUNK(ra, 0); KCHUNK(rb, 1); KCHUNK(ra, 2); KCHUNK(rb, 3);
#undef KLOAD
#undef KSTORE
#undef KCHUNK
    l += __shfl_xor(l, 16); l += __shfl_xor(l, 32);
    const float il = __builtin_amdgcn_rcpf(l); float ss = 0.f;
#pragma unroll
    for (int mt = 0; mt < 4; ++mt) { ot[mt] = ot[mt] * il; ss += (ot[mt].x * ot[mt].x + ot[mt].y * ot[mt].y) + (ot[mt].z * ot[mt].z + ot[mt].w * ot[mt].w); }
    if (fr >= 6) ss = 0.f;
#pragma unroll
    for (int o = 1; o < 64; o <<= 1) ss += __shfl_xor(ss, o);
    const float rstd = rsqrtf(ss * (1.f / 384.f) + 1e-6f);
    if (fr < 6) {
#pragma unroll
      for (int mt = 0; mt < 4; ++mt) { const int col = fr * 64 + mt * 16 + fq * 4; const f32x4 g = *(const f32x4*)(gA + col); const f32x4 o = ot[mt] * rstd * g;
        *(unsigned*)(CAT + (size_t)t * 1024 + col) = pk4_fp8(o); } }
  }
  }
}

__device__ __forceinline__ void phase_attn_mem(const Ctx& c, unsigned char* ldsb, unsigned* qhead) {
  unsigned char* ws = c.ws;
  const int tid = phase_tid(), lane = tid & 63, wave = tid >> 6, fr = lane & 15, fq = lane >> 4;
  const unsigned char* QC = ws + WS_QC; const unsigned char* MK = ws + WS_MK; const unsigned char* MVT = ws + WS_MVT;
  unsigned char* CAT = ws + WS_CAT;
  const float* gC = c.in[11];
  int* aq_slot = (int*)(ldsb + 70656 + 8 * 8192);
  WorkQ wq; wq_init(wq, qhead, aq_slot, tid);
  for (;;) {
  const int item = wq_next(wq, tid) + 512;
  if (item >= 768) break;
  {
    const int t0 = (item - 512) * 128 + wave * 16, b = t0 >> 12;
    unsigned char* mkl = ldsb; unsigned char* mvl = ldsb + 36864; unsigned char* ocl = ldsb + 70656 + wave * 8192;
    float ss = 0.f;
#pragma unroll 1
    for (int h = 0; h < 4; ++h) {
      const u32x4 qa = *(const u32x4*)(QC + (size_t)(t0 + fr) * 256 + h * 64 + fq * 16);
      __syncthreads();
#pragma unroll
      for (int i = 0; i < 2; ++i) { const int p = tid + 512 * i, row = p >> 2, cc = p & 3;
        *(u32x4*)(mkl + row * 80 + cc * 16) = *(const u32x4*)(MK + ((size_t)(b * 256 + row)) * 256 + h * 64 + cc * 16); }
#pragma unroll
      for (int i = 0; i < 2; ++i) { const int p = tid + 512 * i, row = p >> 4, cc = p & 15;
        *(u32x4*)(mvl + row * 272 + cc * 16) = *(const u32x4*)(MVT + ((size_t)(b * 256 + h * 64 + row)) * 256 + cc * 16); }
      const long q0 = mk64(qa.x, qa.y), q1 = mk64(qa.z, qa.w);
      __syncthreads();
      f32x4 oc[4];
      f32x4 st[16];
#pragma unroll
      for (int kt = 0; kt < 16; ++kt) { const u32x4 a_ = *(const u32x4*)(mkl + (kt * 16 + fr) * 80 + fq * 16);
        f32x4 d = {0.f, 0.f, 0.f, 0.f};
        d = __builtin_amdgcn_mfma_f32_16x16x32_fp8_fp8(mk64(a_.x, a_.y), q0, d, 0, 0, 0); st[kt] = __builtin_amdgcn_mfma_f32_16x16x32_fp8_fp8(mk64(a_.z, a_.w), q1, d, 0, 0, 0); }
      float mx = -3.0e38f;
#pragma unroll
      for (int kt = 0; kt < 16; ++kt) mx = fmaxf(fmaxf(fmaxf(mx, st[kt].x), fmaxf(st[kt].y, st[kt].z)), st[kt].w);
      mx = fmaxf(mx, __shfl_xor(mx, 16)); mx = fmaxf(mx, __shfl_xor(mx, 32));
      mx -= 8.f;
      float l = 0.f;
#pragma unroll
      for (int kt = 0; kt < 16; ++kt) { st[kt].x = __builtin_amdgcn_exp2f(st[kt].x - mx); st[kt].y = __builtin_amdgcn_exp2f(st[kt].y - mx); st[kt].z = __builtin_amdgcn_exp2f(st[kt].z - mx); st[kt].w = __builtin_amdgcn_exp2f(st[kt].w - mx);
        l += (st[kt].x + st[kt].y) + (st[kt].z + st[kt].w); }
      l += __shfl_xor(l, 16); l += __shfl_xor(l, 32);
#pragma unroll
      for (int mt = 0; mt < 4; ++mt) oc[mt] = (f32x4){0.f, 0.f, 0.f, 0.f};
#pragma unroll
      for (int kk = 0; kk < 8; ++kk) { const long pf = mk64(cvt4_fp8(st[2 * kk].x, st[2 * kk].y, st[2 * kk].z, st[2 * kk].w), cvt4_fp8(st[2 * kk + 1].x, st[2 * kk + 1].y, st[2 * kk + 1].z, st[2 * kk + 1].w));
#pragma unroll
        for (int mt = 0; mt < 4; ++mt) { const u32x2 a_ = *(const u32x2*)(mvl + (mt * 16 + fr) * 272 + (kk * 4 + fq) * 8);
          oc[mt] = __builtin_amdgcn_mfma_f32_16x16x32_fp8_fp8(mk64(a_.x, a_.y), pf, oc[mt], 0, 0, 0); } }
      const float il = __builtin_amdgcn_rcpf(l);
#pragma unroll
      for (int mt = 0; mt < 4; ++mt) { const f32x4 o = oc[mt] * il; ss += (o.x * o.x + o.y * o.y) + (o.z * o.z + o.w * o.w); *(u32x2*)(ocl + ((h * 4 + mt) * 64 + lane) * 8) = (u32x2){pg8::cvt_pk_bf16(o.x, o.y), pg8::cvt_pk_bf16(o.z, o.w)}; }
    }
    ss += __shfl_xor(ss, 16); ss += __shfl_xor(ss, 32);
    const float rstd = rsqrtf(ss * (1.f / 256.f) + 1e-6f);
#pragma unroll 1
    for (int h = 0; h < 4; ++h)
#pragma unroll
      for (int mt = 0; mt < 4; ++mt) { const int col = h * 64 + mt * 16 + fq * 4; const f32x4 g = *(const f32x4*)(gC + col); const u32x2 pp = *(const u32x2*)(ocl + ((h * 4 + mt) * 64 + lane) * 8);
        const f32x4 ov = {__uint_as_float(pp.x << 16), __uint_as_float(pp.x & 0xffff0000u), __uint_as_float(pp.y << 16), __uint_as_float(pp.y & 0xffff0000u)}; const f32x4 o = ov * rstd * g;
        *(unsigned*)(CAT + (size_t)(t0 + fr) * 1024 + 768 + col) = pk4_fp8(o); }
  }
  }
}

constexpr int GD_ITEM = 20544;
constexpr float GD_SW = 16.f, GD_SQ = 128.f, GD_SA = 128.f, GD_SK = 16.f, GD_SU = 4.f;
__device__ __forceinline__ unsigned char fp8_1(float v) { return (unsigned char)__builtin_amdgcn_cvt_pk_fp8_f32(v, v, 0, false); }
__device__ __forceinline__ unsigned char* gd_item(unsigned char* ws, int it) { return it < 1536 ? ws + WS_XB + (size_t)it * GD_ITEM : ws + WS_X1B + (size_t)(it - 1536) * GD_ITEM; }
__device__ __forceinline__ int kperm(int x) { return (x & 32) | (((x >> 2) & 3) << 3) | (x & 3) | (((x >> 4) & 1) << 2); }
constexpr int GP_KB = 0, GP_KBB = 9216, GP_QB = 18432, GP_VBT = 27648, GP_KBET = 36864, GP_XR = 46080  , GP_PR = 82944  , GP_OUT = 101376, GP_SC = 142336;
__device__ __forceinline__ pg8::bf16x8 ldsfrag(const unsigned char* base, int row, int ks, int fq) { return *(const pg8::bf16x8*)(base + row * 144 + ks * 64 + fq * 16); }
constexpr int G2_KB = 0, G2_KBB = 9216, G2_QB = 18432, G2_XR0 = 27648, G2_XT0 = 36864, G2_PR0 = 46080, G2_VBT = 55296, G2_KBET = 64512, G2_SC = 73728, G2_CW = 75264, G2_HALF = 78336;
__device__ __forceinline__ void phase_gdn_prep2(const Ctx& c, unsigned char* Lb) {
  unsigned char* ws = c.ws;
  const int tid = phase_tid(), lane = tid & 63, wave = tid >> 6, fr = lane & 15, fq = lane >> 4;
  const int hb = wave >> 2, w4 = wave & 3, htid = tid & 255;
  unsigned char* L = Lb + hb * G2_HALF;
  const unsigned char* GB = ws + WS_GB; const float* SM = (const float*)(ws + WS_SM);
  const float* convw = c.in[6];
  float* sc = (float*)(L + G2_SC);
  float* cw = (float*)(L + G2_CW);
  const int tt = htid >> 2, part = htid & 3;
  for (int it2 = blockIdx.x; it2 < 1536; it2 += gridDim.x) {
    int hto = htid; asm volatile("" : "+v"(hto));
    const int tt = hto >> 2, part = hto & 3;
    const int it = it2 * 2 + hb;
    const int n = it & 63, bh = it >> 6, b = bh / 6, h = bh % 6;
    const int t = n * 64 + tt; const size_t r = (size_t)b * SEQ + t;
    unsigned char* gb = gd_item(ws, it);
    __syncthreads();
    for (int i = htid; i < 768; i += 256) { const int j = i / 192, rr = i % 192; cw[i] = convw[j * 1152 + (rr >> 6) * 384 + h * 64 + (rr & 63)]; }
    if (part == 0) { const float a = SM[r * 16 + 4 + h], bb = SM[r * 16 + 10 + h]; const float xs = a + c.in[8][h]; const float sp = xs > 20.f ? xs : log1pf(__expf(xs));
      sc[tt] = -__expf(c.in[7][h]) * sp; sc[192 + tt] = 1.f / (1.f + __expf(-bb)); }
    __syncthreads();
    if (w4 == 0) { float v = sc[lane];
#pragma unroll
      for (int o = 1; o < 64; o <<= 1) { const float u = __shfl_up(v, o); if (lane >= o) v += u; }
      const float last = __shfl(v, 63);
      sc[64 + lane] = v; sc[128 + lane] = __expf(v); sc[256 + lane] = __expf(last - v); if (lane == 0) { sc[320] = __expf(last); *(float*)(gb + 20480) = __expf(last); } }
    float qv[16], kv[16], vv[16];
#pragma unroll
    for (int role = 0; role < 3; ++role) {
      asm volatile("" ::: "memory");
      float acc[16];
#pragma unroll
      for (int e = 0; e < 16; ++e) acc[e] = 0.f;
      u32x4 xr[4];
#pragma unroll
      for (int j = 0; j < 4; ++j) { const bool ok = t - 3 + j >= 0; const unsigned char* xp = GB + (r - 3 + j) * 1536 + role * 384 + h * 64 + part * 16;
        xr[j] = ok ? *(const u32x4*)xp : (u32x4){0u, 0u, 0u, 0u}; }
#pragma unroll
      for (int j = 0; j < 4; ++j)
#pragma unroll
        for (int hh = 0; hh < 2; ++hh) { const unsigned wa = hh == 0 ? xr[j].x : xr[j].z, wb = hh == 0 ? xr[j].y : xr[j].w; const float* wj = cw + j * 192 + role * 64 + part * 16 + hh * 8;
          const f32x4 w0 = *(const f32x4*)wj, w1 = *(const f32x4*)(wj + 4);
          const hw_f32x2 e01 = __builtin_amdgcn_cvt_pk_f32_fp8(wa, false), e23 = __builtin_amdgcn_cvt_pk_f32_fp8(wa, true), e45 = __builtin_amdgcn_cvt_pk_f32_fp8(wb, false), e67 = __builtin_amdgcn_cvt_pk_f32_fp8(wb, true);
          acc[hh * 8 + 0] += w0.x * e01.x; acc[hh * 8 + 1] += w0.y * e01.y; acc[hh * 8 + 2] += w0.z * e23.x; acc[hh * 8 + 3] += w0.w * e23.y;
          acc[hh * 8 + 4] += w1.x * e45.x; acc[hh * 8 + 5] += w1.y * e45.y; acc[hh * 8 + 6] += w1.z * e67.x; acc[hh * 8 + 7] += w1.w * e67.y; }
      float ss = 0.f;
#pragma unroll
      for (int e = 0; e < 16; ++e) { acc[e] = silu_f(acc[e]); ss += acc[e] * acc[e]; }
      if (role < 2) { ss += __shfl_xor(ss, 1); ss += __shfl_xor(ss, 2); const float scl = rsqrtf(ss + 1e-6f) * (role == 0 ? 0.125f : 1.f);
#pragma unroll
        for (int e = 0; e < 16; ++e) acc[e] *= scl; }
#pragma unroll
      for (int e = 0; e < 16; ++e) { if (role == 0) qv[e] = acc[e]; else if (role == 1) kv[e] = acc[e]; else vv[e] = acc[e]; }
    }
    __syncthreads();
    { const float beta = sc[192 + tt], eg = sc[128 + tt], ekl = sc[256 + tt];
      float kb[16];
#pragma unroll
      for (int e = 0; e < 16; ++e) kb[e] = kv[e] * beta;
#pragma unroll
      for (int hh = 0; hh < 2; ++hh) { const int o8 = hh * 8;
        *(u32x4*)(L + G2_KB + tt * 144 + part * 32 + hh * 16) = (u32x4){pk2(kv[o8], kv[o8 + 1]), pk2(kv[o8 + 2], kv[o8 + 3]), pk2(kv[o8 + 4], kv[o8 + 5]), pk2(kv[o8 + 6], kv[o8 + 7])};
        *(u32x4*)(L + G2_KBB + tt * 144 + part * 32 + hh * 16) = (u32x4){pk2(kb[o8], kb[o8 + 1]), pk2(kb[o8 + 2], kb[o8 + 3]), pk2(kb[o8 + 4], kb[o8 + 5]), pk2(kb[o8 + 6], kb[o8 + 7])};
        *(u32x4*)(L + G2_QB + tt * 144 + part * 32 + hh * 16) = (u32x4){pk2(qv[o8], qv[o8 + 1]), pk2(qv[o8 + 2], qv[o8 + 3]), pk2(qv[o8 + 4], qv[o8 + 5]), pk2(qv[o8 + 6], qv[o8 + 7])}; }
      const int ptt = kperm(tt);
#pragma unroll
      for (int e = 0; e < 16; ++e) { const int d = part * 16 + e;
        *(bf16_t*)(L + G2_VBT + d * 144 + tt * 2) = f2bf(vv[e] * beta);
        *(bf16_t*)(L + G2_KBET + d * 144 + tt * 2) = f2bf(kb[e] * eg);
        gb[4096 + tt * 64 + kperm(d)] = fp8_1(qv[e] * eg * GD_SQ);
        gb[3 * 4096 + d * 64 + ptt] = fp8_1(kv[e] * ekl * GD_SK); } }
    __syncthreads();
    const int rowb = (w4 * 16 + fq * 4) * 144 + fr * 2;
    const int colb = fr * 144 + (w4 * 16 + fq * 4) * 2;
    const int fa = (w4 * 16 + fr) * 144 + fq * 16;
    const int fb = fr * 144 + fq * 16;
    const int i0 = w4 * 16 + fq * 4;
#define G2F(buf, off) (*(const pg8::bf16x8*)(L + (buf) + (off)))
#define G2W16(buf, off, v) (*(bf16_t*)(L + (buf) + (off)) = f2bf(v))
    f32x4 Pt[4];
    { const float gi0 = sc[64 + i0], gi1 = sc[64 + i0 + 1], gi2 = sc[64 + i0 + 2], gi3 = sc[64 + i0 + 3];
#pragma unroll
    for (int u = 0; u < 4; ++u) {
      f32x4 dl = {0.f, 0.f, 0.f, 0.f}, da = {0.f, 0.f, 0.f, 0.f};
#pragma unroll
      for (int ks = 0; ks < 2; ++ks) { const pg8::bf16x8 bk = G2F(G2_KB, fb + u * 2304 + ks * 64);
        dl = __builtin_amdgcn_mfma_f32_16x16x32_bf16(G2F(G2_KBB, fa + ks * 64), bk, dl, 0, 0, 0);
        da = __builtin_amdgcn_mfma_f32_16x16x32_bf16(G2F(G2_QB, fa + ks * 64), bk, da, 0, 0, 0); }
      const int j = u * 16 + fr; const float gj = sc[64 + j]; const int pj = kperm(j);
      const float dec0 = __expf(fminf(gi0 - gj, 0.f)), dec1 = __expf(fminf(gi1 - gj, 0.f)), dec2 = __expf(fminf(gi2 - gj, 0.f)), dec3 = __expf(fminf(gi3 - gj, 0.f));
      const float l0 = i0 + 0 > j ? dl.x * dec0 : 0.f, l1 = i0 + 1 > j ? dl.y * dec1 : 0.f, l2 = i0 + 2 > j ? dl.z * dec2 : 0.f, l3 = i0 + 3 > j ? dl.w * dec3 : 0.f;
      const float a0 = i0 + 0 >= j ? da.x * dec0 : 0.f, a1 = i0 + 1 >= j ? da.y * dec1 : 0.f, a2 = i0 + 2 >= j ? da.z * dec2 : 0.f, a3 = i0 + 3 >= j ? da.w * dec3 : 0.f;
      const f32x4 pv = {(i0 + 0 == j ? 1.f : 0.f) - l0, (i0 + 1 == j ? 1.f : 0.f) - l1, (i0 + 2 == j ? 1.f : 0.f) - l2, (i0 + 3 == j ? 1.f : 0.f) - l3};
      G2W16(G2_XR0, rowb + u * 32, l0); G2W16(G2_XR0, rowb + 144 + u * 32, l1); G2W16(G2_XR0, rowb + 288 + u * 32, l2); G2W16(G2_XR0, rowb + 432 + u * 32, l3);
      G2W16(G2_PR0, rowb + u * 32, pv.x); G2W16(G2_PR0, rowb + 144 + u * 32, pv.y); G2W16(G2_PR0, rowb + 288 + u * 32, pv.z); G2W16(G2_PR0, rowb + 432 + u * 32, pv.w);
      *(u32x2*)(L + G2_XT0 + colb + u * 2304) = (u32x2){pk2(l0, l1), pk2(l2, l3)};
      unsigned char* am = gb + 2 * 4096 + i0 * 64 + pj;
      am[0] = fp8_1(a0 * GD_SA); am[64] = fp8_1(a1 * GD_SA); am[128] = fp8_1(a2 * GD_SA); am[192] = fp8_1(a3 * GD_SA);
      Pt[u] = pv; } }
    __syncthreads();
#pragma unroll
    for (int u = 0; u < 4; ++u) {
      f32x4 d = {0.f, 0.f, 0.f, 0.f};
#pragma unroll
      for (int ks = 0; ks < 2; ++ks) d = __builtin_amdgcn_mfma_f32_16x16x32_bf16(G2F(G2_XR0, fa + ks * 64), G2F(G2_XT0, fb + u * 2304 + ks * 64), d, 0, 0, 0);
      G2W16(G2_KB, rowb + u * 32, d.x); G2W16(G2_KB, rowb + 144 + u * 32, d.y); G2W16(G2_KB, rowb + 288 + u * 32, d.z); G2W16(G2_KB, rowb + 432 + u * 32, d.w);
      *(u32x2*)(L + G2_KBB + colb + u * 2304) = (u32x2){pk2(d.x, d.y), pk2(d.z, d.w)}; }
    __syncthreads();
#pragma unroll
    for (int itn = 0; itn < 4; ++itn) {
      const int XRc = (itn & 1) ? G2_XR0 : G2_KB, XTc = (itn & 1) ? G2_XT0 : G2_KBB, XRn = (itn & 1) ? G2_KB : G2_XR0, XTn = (itn & 1) ? G2_KBB : G2_XT0;
      const int PRc = (itn & 1) ? G2_QB : G2_PR0, PRn = (itn & 1) ? G2_PR0 : G2_QB;
#pragma unroll
      for (int u = 0; u < 4; ++u) {
        f32x4 d = {0.f, 0.f, 0.f, 0.f};
#pragma unroll
        for (int ks = 0; ks < 2; ++ks) { const pg8::bf16x8 bx = G2F(XTc, fb + u * 2304 + ks * 64);
          Pt[u] = __builtin_amdgcn_mfma_f32_16x16x32_bf16(G2F(PRc, fa + ks * 64), bx, Pt[u], 0, 0, 0);
          if (itn < 3) d = __builtin_amdgcn_mfma_f32_16x16x32_bf16(G2F(XRc, fa + ks * 64), bx, d, 0, 0, 0); }
        G2W16(PRn, rowb + u * 32, Pt[u].x); G2W16(PRn, rowb + 144 + u * 32, Pt[u].y); G2W16(PRn, rowb + 288 + u * 32, Pt[u].z); G2W16(PRn, rowb + 432 + u * 32, Pt[u].w);
        if (itn < 3) { G2W16(XRn, rowb + u * 32, d.x); G2W16(XRn, rowb + 144 + u * 32, d.y); G2W16(XRn, rowb + 288 + u * 32, d.z); G2W16(XRn, rowb + 432 + u * 32, d.w);
          *(u32x2*)(L + XTn + colb + u * 2304) = (u32x2){pk2(d.x, d.y), pk2(d.z, d.w)}; } }
      __syncthreads();
    }
#pragma unroll
    for (int u = 0; u < 4; ++u) {
      f32x4 du = {0.f, 0.f, 0.f, 0.f}, dw = {0.f, 0.f, 0.f, 0.f};
#pragma unroll
      for (int ks = 0; ks < 2; ++ks) { const pg8::bf16x8 a = G2F(G2_PR0, fa + ks * 64);
        du = __builtin_amdgcn_mfma_f32_16x16x32_bf16(a, G2F(G2_VBT, fb + u * 2304 + ks * 64), du, 0, 0, 0);
        dw = __builtin_amdgcn_mfma_f32_16x16x32_bf16(a, G2F(G2_KBET, fb + u * 2304 + ks * 64), dw, 0, 0, 0); }
      const int j = u * 16 + fr, pj = kperm(j);
      *(unsigned*)(gb + 4 * 4096 + j * 64 + i0) = cvt4_fp8(du.x * GD_SU, du.y * GD_SU, du.z * GD_SU, du.w * GD_SU);
      unsigned char* wn = gb + i0 * 64 + pj;
      wn[0] = fp8_1(-dw.x * GD_SW); wn[64] = fp8_1(-dw.y * GD_SW); wn[128] = fp8_1(-dw.z * GD_SW); wn[192] = fp8_1(-dw.w * GD_SW); }
#undef G2F
#undef G2W16
  }
}

constexpr int GS_SLOT = 46208, GS_OB = 2 * GS_SLOT;
__device__ __forceinline__ void phase_gdn_scan(const Ctx& c, unsigned char* L, int item) {
  unsigned char* ws = c.ws;
  const int tid = phase_tid(), lane = tid & 63, wave = tid >> 6, fr = lane & 15, fq = lane >> 4;
  const int b = item / 6, h = item % 6;
  const unsigned char* GB = ws + WS_GB; unsigned char* CAT = ws + WS_CAT; const float* gng = c.in[9];
  const int lt = tid - 256;
  u32x4 ra[10], rb[10]; float gla = 0.f, glb = 0.f;
  f32x4 S[4];
#pragma unroll
  for (int i = 0; i < 4; ++i) S[i] = (f32x4){0.f, 0.f, 0.f, 0.f};
#define GS_LOAD(R, G, n) do { if ((n) < 64) { const unsigned char* gb_ = gd_item(ws, item * 64 + (n)); _Pragma("unroll") for (int i_ = 0; i_ < 5; ++i_) R[i_] = *(const u32x4*)(gb_ + (size_t)(lt + 256 * i_) * 16); if (lt == 0) G = *(const float*)(gb_ + 20480); } } while (0)
#define GS_STORE(R, G, slot) do { _Pragma("unroll") for (int i_ = 0; i_ < 5; ++i_) { const float is_ = i_ == 0 ? 1.f / GD_SW : i_ == 1 ? 1.f / GD_SQ : i_ == 2 ? 1.f / GD_SA : i_ == 3 ? 1.f / GD_SK : 1.f / GD_SU; \
      const unsigned w_[4] = {R[i_].x, R[i_].y, R[i_].z, R[i_].w}; unsigned o_[8]; \
      _Pragma("unroll") for (int j_ = 0; j_ < 4; ++j_) { const hw_f32x2 a_ = __builtin_amdgcn_cvt_pk_f32_fp8(w_[j_], false), b_ = __builtin_amdgcn_cvt_pk_f32_fp8(w_[j_], true); o_[2 * j_] = pk2(a_.x * is_, a_.y * is_); o_[2 * j_ + 1] = pk2(b_.x * is_, b_.y * is_); } \
      unsigned char* d_ = L + (slot) * GS_SLOT + i_ * 9216 + (lt >> 2) * 144 + (lt & 3) * 32; \
      *(u32x4*)d_ = (u32x4){o_[0], o_[1], o_[2], o_[3]}; *(u32x4*)(d_ + 16) = (u32x4){o_[4], o_[5], o_[6], o_[7]}; } if (lt == 0) *(float*)(L + (slot) * GS_SLOT + 46080) = G; } while (0)
  float gnr[16];
#pragma unroll
  for (int e = 0; e < 16; ++e) gnr[e] = gng[((tid - 256) & 3) * 16 + e];
  auto zload = [&](int k, u32x4& z0, u32x4& z1) {
    const size_t r = (size_t)b * SEQ + k * 64 + (lt >> 2); const unsigned char* zp = GB + r * 1536 + 1152 + h * 64 + (lt & 3) * 16; z0 = *(const u32x4*)zp; z1 = z0; };
  auto post = [&](int k, const u32x4 z0, const u32x4 z1) {
    const unsigned char* ob = L + GS_OB + (k & 1) * 9216; const int tk = lt >> 2, part = lt & 3; const size_t r = (size_t)b * SEQ + k * 64 + tk;
    const u32x4 o0 = *(const u32x4*)(ob + tk * 144 + part * 32), o1 = *(const u32x4*)(ob + tk * 144 + part * 32 + 16);
    float ov[16] = {__uint_as_float(o0.x << 16), __uint_as_float(o0.x & 0xffff0000u), __uint_as_float(o0.y << 16), __uint_as_float(o0.y & 0xffff0000u), __uint_as_float(o0.z << 16), __uint_as_float(o0.z & 0xffff0000u), __uint_as_float(o0.w << 16), __uint_as_float(o0.w & 0xffff0000u),
                    __uint_as_float(o1.x << 16), __uint_as_float(o1.x & 0xffff0000u), __uint_as_float(o1.y << 16), __uint_as_float(o1.y & 0xffff0000u), __uint_as_float(o1.z << 16), __uint_as_float(o1.z & 0xffff0000u), __uint_as_float(o1.w << 16), __uint_as_float(o1.w & 0xffff0000u)};
    float ss = 0.f;
#pragma unroll
    for (int e = 0; e < 16; ++e) ss += ov[e] * ov[e];
    ss += __shfl_xor(ss, 1); ss += __shfl_xor(ss, 2);
    const float rstd = rsqrtf(ss * (1.f / 64.f) + 1e-6f);
    float zf[16];
    { const unsigned zw[4] = {z0.x, z0.y, z0.z, z0.w};
#pragma unroll
      for (int i = 0; i < 4; ++i) { const hw_f32x2 a = __builtin_amdgcn_cvt_pk_f32_fp8(zw[i], false), bq2 = __builtin_amdgcn_cvt_pk_f32_fp8(zw[i], true); zf[4 * i] = a.x; zf[4 * i + 1] = a.y; zf[4 * i + 2] = bq2.x; zf[4 * i + 3] = bq2.y; } }
#pragma unroll
    for (int e = 0; e < 16; ++e) ov[e] = ov[e] * rstd * gnr[e] * silu_f(zf[e]);
    unsigned char* op = CAT + r * 1024 + 384 + h * 64 + part * 16;
    *(u32x4*)op = (u32x4){cvt4_fp8(ov[0], ov[1], ov[2], ov[3]), cvt4_fp8(ov[4], ov[5], ov[6], ov[7]), cvt4_fp8(ov[8], ov[9], ov[10], ov[11]), cvt4_fp8(ov[12], ov[13], ov[14], ov[15])};
  };
  auto step = [&](int k) {
    const unsigned char* sb = L + (k & 1) * GS_SLOT; const float gl = *(const float*)(sb + 46080);
    const pg8::bf16x8 Sb0 = packp(S[0], S[1]), Sb1 = packp(S[2], S[3]);
    f32x4 vn[4], o[4];
#pragma unroll
    for (int mt = 0; mt < 4; ++mt) { const u32x2 uv = *(const u32x2*)(sb + 4 * 9216 + (wave * 16 + fr) * 144 + (mt * 16 + fq * 4) * 2);
      f32x4 a = {__uint_as_float(uv.x << 16), __uint_as_float(uv.x & 0xffff0000u), __uint_as_float(uv.y << 16), __uint_as_float(uv.y & 0xffff0000u)};
      a = __builtin_amdgcn_mfma_f32_16x16x32_bf16(ldsfrag(sb, mt * 16 + fr, 0, fq), Sb0, a, 0, 0, 0);
      vn[mt] = __builtin_amdgcn_mfma_f32_16x16x32_bf16(ldsfrag(sb, mt * 16 + fr, 1, fq), Sb1, a, 0, 0, 0);
      f32x4 q = {0.f, 0.f, 0.f, 0.f};
      q = __builtin_amdgcn_mfma_f32_16x16x32_bf16(ldsfrag(sb + 9216, mt * 16 + fr, 0, fq), Sb0, q, 0, 0, 0);
      o[mt] = __builtin_amdgcn_mfma_f32_16x16x32_bf16(ldsfrag(sb + 9216, mt * 16 + fr, 1, fq), Sb1, q, 0, 0, 0); }
    const pg8::bf16x8 Vb0 = packp(vn[0], vn[1]), Vb1 = packp(vn[2], vn[3]);
#pragma unroll
    for (int mt = 0; mt < 4; ++mt) { o[mt] = __builtin_amdgcn_mfma_f32_16x16x32_bf16(ldsfrag(sb + 2 * 9216, mt * 16 + fr, 0, fq), Vb0, o[mt], 0, 0, 0);
      o[mt] = __builtin_amdgcn_mfma_f32_16x16x32_bf16(ldsfrag(sb + 2 * 9216, mt * 16 + fr, 1, fq), Vb1, o[mt], 0, 0, 0); }
#pragma unroll
    for (int kt = 0; kt < 4; ++kt) { f32x4 sv = S[kt] * gl;
      sv = __builtin_amdgcn_mfma_f32_16x16x32_bf16(ldsfrag(sb + 3 * 9216, kt * 16 + fr, 0, fq), Vb0, sv, 0, 0, 0);
      S[kt] = __builtin_amdgcn_mfma_f32_16x16x32_bf16(ldsfrag(sb + 3 * 9216, kt * 16 + fr, 1, fq), Vb1, sv, 0, 0, 0); }
    unsigned char* ob = L + GS_OB + (k & 1) * 9216 + (wave * 16 + fr) * 2;
#pragma unroll
    for (int mt = 0; mt < 4; ++mt) { const int t0 = mt * 16 + fq * 4;
      *(bf16_t*)(ob + (t0 + 0) * 144) = f2bf(o[mt].x); *(bf16_t*)(ob + (t0 + 1) * 144) = f2bf(o[mt].y); *(bf16_t*)(ob + (t0 + 2) * 144) = f2bf(o[mt].z); *(bf16_t*)(ob + (t0 + 3) * 144) = f2bf(o[mt].w); }
  };
  __syncthreads();
  u32x4 z0a = {0u, 0u, 0u, 0u}, z0b = z0a, z1a = z0a, z1b = z0a;
  if (wave >= 4) { GS_LOAD(ra, gla, 0); GS_STORE(ra, gla, 0); GS_LOAD(ra, gla, 1); GS_LOAD(rb, glb, 2); zload(0, z0a, z0b); }
  __syncthreads();
#define SCAN_BAR() do { asm volatile("s_waitcnt lgkmcnt(0)" ::: "memory"); __builtin_amdgcn_s_barrier(); asm volatile("" ::: "memory"); } while (0)
  if (wave < 4) {
#pragma unroll 1
    for (int k = 0; k < 64; ++k) { step(k); SCAN_BAR(); }
  } else {
#define GS_LSTEP(R, G, ZA, ZB, kk) do { if ((kk) + 1 < 64) GS_STORE(R, G, ((kk) + 1) & 1); GS_LOAD(R, G, (kk) + 3); if ((kk) > 0) post((kk) - 1, ZA, ZB); if ((kk) + 1 < 64) zload((kk) + 1, ZA, ZB); SCAN_BAR(); } while (0)
#pragma unroll 1
    for (int k = 0; k < 64; k += 2) { GS_LSTEP(ra, gla, z1a, z1b, k); GS_LSTEP(rb, glb, z0a, z0b, k + 1); }
    post(63, z1a, z1b);
#undef GS_LSTEP
  }
#undef SCAN_BAR
#undef GS_LOAD
#undef GS_STORE
}

__device__ __forceinline__ f32x4 bf4(u32x2 p) { return (f32x4){__uint_as_float(p.x << 16), __uint_as_float(p.x & 0xffff0000u), __uint_as_float(p.y << 16), __uint_as_float(p.y & 0xffff0000u)}; }
__device__ __forceinline__ void phase_router(const Ctx& c, unsigned char* ldsb) {
  unsigned char* ws = c.ws;
  const int tid = phase_tid(), lane = tid & 63, wave = tid >> 6, fr = lane & 15, fq = lane >> 4;
  float* lg = (float*)(ldsb + wave * 5632);
  const float* bg = c.in[17]; const float* br = c.in[19]; const float* g1 = c.in[14]; const float* b1 = c.in[15];
  const bf16_t* WR = (const bf16_t*)(ws + WS_WR); bf16_t* X1B = (bf16_t*)(ws + WS_X1B);
  unsigned* ctl = (unsigned*)(ws + WS_CTL);
  unsigned* LIST = (unsigned*)(ws + WS_LIST); float* GATEL = (float*)(ws + WS_GATEL); unsigned* TSLOT = (unsigned*)(ws + WS_TSLOT);
  unsigned* cntl = (unsigned*)(ldsb + 46080); unsigned* basel = cntl + 64;
  __syncthreads();
  if (tid < 64) cntl[tid] = 0u;
  __syncthreads();
  for (int tile = blockIdx.x * NWAVES + wave; tile < T / 16; tile += gridDim.x * NWAVES) {
    const int t0 = tile * 16;
    float mean_t = 0.f, rstd_t = 0.f;
    { const f32x4* sp_ = (const f32x4*)((const float*)(ws + WS_LNSUM) + (size_t)(t0 + fr) * 32);
      float a1 = 0.f, a2 = 0.f;
#pragma unroll
      for (int i = 0; i < 8; ++i) { const f32x4 p = sp_[i]; a1 += p.x; a2 += p.y; a1 += p.z; a2 += p.w; }
      mean_t = a1 * (1.f / 1024.f); rstd_t = rsqrtf(fmaxf(a2 * (1.f / 1024.f) - mean_t * mean_t, 0.f) + 1e-5f); }
    if (fq == 0) *(hw_f32x2*)((float*)(ws + WS_LNST) + (size_t)(t0 + fr) * 2) = (hw_f32x2){mean_t, rstd_t};
    f32x4 acc[5];
#pragma unroll
    for (int nt = 0; nt < 5; ++nt) acc[nt] = (f32x4){0.f, 0.f, 0.f, 0.f};
    bf16_t* xp = X1B + (size_t)(t0 + fr) * 1024 + fq * 8; unsigned char* x8 = ws + WS_X1F + (size_t)(t0 + fr) * 1024 + fq * 8;
    unsigned char* wrl = ldsb + 47104;
    u32x4 wst[5];
#define WR_LOAD(CH) do { _Pragma("unroll") for (int i_ = 0; i_ < 5; ++i_) { const int p_ = tid + 512 * i_; wst[i_] = *(const u32x4*)(WR + (size_t)(p_ >> 5) * 1024 + (CH) * 256 + (p_ & 31) * 8); } } while (0)
#define WR_STORE(BUF) do { _Pragma("unroll") for (int i_ = 0; i_ < 5; ++i_) { const int p_ = tid + 512 * i_; *(u32x4*)(wrl + (BUF) * 42240 + (p_ >> 5) * 528 + (p_ & 31) * 16) = wst[i_]; } } while (0)
    WR_LOAD(0); WR_STORE(0);
    __syncthreads();
#pragma unroll 1
    for (int ch = 0; ch < 4; ++ch) {
      if (ch < 3) WR_LOAD(ch + 1);
      const unsigned char* wb = wrl + (ch & 1) * 42240 + fr * 528 + fq * 16;
#pragma unroll 2
      for (int k8 = 0; k8 < 8; ++k8) { const int ks = ch * 8 + k8;
        const u32x4 yv = *(const u32x4*)(xp + ks * 32);
        const f32x4 ga = *(const f32x4*)(g1 + ks * 32 + fq * 8), gb2 = *(const f32x4*)(g1 + ks * 32 + fq * 8 + 4), ba = *(const f32x4*)(b1 + ks * 32 + fq * 8), bb2 = *(const f32x4*)(b1 + ks * 32 + fq * 8 + 4);
        const f32x4 y0 = {__uint_as_float(yv.x << 16), __uint_as_float(yv.x & 0xffff0000u), __uint_as_float(yv.y << 16), __uint_as_float(yv.y & 0xffff0000u)};
        const f32x4 y1 = {__uint_as_float(yv.z << 16), __uint_as_float(yv.z & 0xffff0000u), __uint_as_float(yv.w << 16), __uint_as_float(yv.w & 0xffff0000u)};
        const f32x4 n0 = (y0 - mean_t) * rstd_t * ga + ba, n1 = (y1 - mean_t) * rstd_t * gb2 + bb2;
        const u32x4 xw = {cvtpk_c(n0.x, n0.y), cvtpk_c(n0.z, n0.w), cvtpk_c(n1.x, n1.y), cvtpk_c(n1.z, n1.w)};
        *(u32x2*)(x8 + ks * 32) = (u32x2){cvt4_fp8(n0.x, n0.y, n0.z, n0.w), cvt4_fp8(n1.x, n1.y, n1.z, n1.w)};
        const pg8::bf16x8 bx = __builtin_bit_cast(pg8::bf16x8, xw);
#pragma unroll
        for (int nt = 0; nt < 5; ++nt) acc[nt] = __builtin_amdgcn_mfma_f32_16x16x32_bf16(*(const pg8::bf16x8*)(wb + nt * 16 * 528 + k8 * 64), bx, acc[nt], 0, 0, 0); }
      if (ch < 3) WR_STORE((ch + 1) & 1);
      __syncthreads();
    }
#undef WR_LOAD
#undef WR_STORE
#pragma unroll
    for (int nt = 0; nt < 5; ++nt) { const int o = nt * 16 + fq * 4; *(f32x4*)(lg + fr * 88 + o) = acc[nt]; }
    asm volatile("s_waitcnt lgkmcnt(0)" ::: "memory");
    int ex1 = 0, ex2 = 0; float gt1 = 0.f, gt2 = 0.f; unsigned lr1 = 0u, lr2 = 0u;
    if (lane < 16) {
      const float* l = lg + lane * 88;
      int grp = 0; float gm = l[0] + bg[0];
      for (int i = 1; i < 8; ++i) { const float v = l[i] + bg[i]; if (v > gm) { gm = v; grp = i; } }
      float gs = 0.f; for (int i = 0; i < 8; ++i) gs += __expf(l[i] + bg[i] - gm);
      const float pgrp = 1.f / gs;
      const float* el = l + 8 + grp * 8; const float* eb = br + grp * 8;
      int i1 = 0; float m1 = el[0] + eb[0]; for (int i = 1; i < 8; ++i) { const float v = el[i] + eb[i]; if (v > m1) { m1 = v; i1 = i; } }
      int i2 = -1; float m2 = -3.0e38f; for (int i = 0; i < 8; ++i) { const float v = el[i] + eb[i]; if (i != i1 && v > m2) { m2 = v; i2 = i; } }
      const float e2 = __expf(m2 - m1), den = 1.f / (1.f + e2);
      gt1 = pgrp * den; gt2 = pgrp * e2 * den;
      ex1 = grp * 8 + i1; ex2 = grp * 8 + i2;
      lr1 = atomicAdd(&cntl[ex1], 1u); lr2 = atomicAdd(&cntl[ex2], 1u);
    }
    __syncthreads();
    if (wave == 0) { const unsigned nloc = cntl[lane]; basel[lane] = nloc ? atomicAdd(&ctl[CW_CNT + lane], nloc) : 0u; }
    __syncthreads();
    if (lane < 16) {
      const int t = t0 + lane; const unsigned r1 = basel[ex1] + lr1, r2 = basel[ex2] + lr2;
      LIST[(size_t)ex1 * 32768 + r1] = (unsigned)t; LIST[(size_t)ex2 * 32768 + r2] = (unsigned)t;
      *(hw_f32x2*)(GATEL + (size_t)t * 2) = (hw_f32x2){gt1, gt2};
      TSLOT[(size_t)t * 2 + 0] = ((unsigned)ex1 << 16) | r1; TSLOT[(size_t)t * 2 + 1] = ((unsigned)ex2 << 16) | r2;
    }
    __syncthreads();
    if (tid < 64) cntl[tid] = 0u;
    __syncthreads();
  }
}

__device__ __forceinline__ void phase_combine(const Ctx& c, float* lds) {
  unsigned char* ws = c.ws;
  const int tid = phase_tid(), lane = tid & 63, wave = tid >> 6;
  int* offs = (int*)lds; int* cnts = offs + 65;
  expert_offsets(c, offs, cnts, tid);
  const unsigned char* Y = (const unsigned char*)(ws + WS_Y); const unsigned* TSLOT = (const unsigned*)(ws + WS_TSLOT);
  const float* g2 = c.in[23]; const float* b2 = c.in[24]; const float* g1 = c.in[14]; const float* b1 = c.in[15];
  for (int t = blockIdx.x * NWAVES + wave; t < T; t += gridDim.x * NWAVES) {
    const unsigned s0 = TSLOT[(size_t)t * 2], s1 = TSLOT[(size_t)t * 2 + 1];
    const hw_f32x2 lst = *(const hw_f32x2*)((const float*)(ws + WS_LNST) + (size_t)t * 2); const float mean1 = lst.x, rstd1 = lst.y;
    const hw_f32x2 gts = *(const hw_f32x2*)((const float*)(ws + WS_GATEL) + (size_t)t * 2); const float ga = gts.x * (1.f / Y8SCALE), gb = gts.y * (1.f / Y8SCALE);
    const size_t r0 = (size_t)offs[s0 >> 16] + (s0 & 0xffffu), r1 = (size_t)offs[s1 >> 16] + (s1 & 0xffffu);
    f32x4* row = (f32x4*)(c.out + (size_t)t * 1024); const u32x2* xrow = (const u32x2*)((const bf16_t*)(ws + WS_X1B) + (size_t)t * 1024);
    f32x4 v[4]; float s = 0.f;
#pragma unroll
    for (int j = 0; j < 4; ++j) { const unsigned ya = ((const unsigned*)(Y + r0 * 1024))[lane + 64 * j], yb = ((const unsigned*)(Y + r1 * 1024))[lane + 64 * j];
      const f32x4 g1v = ((const f32x4*)g1)[lane + 64 * j], b1v = ((const f32x4*)b1)[lane + 64 * j];
      f32x4 x = ((bf4(xrow[lane + 64 * j]) - mean1) * rstd1 * g1v + b1v) * ALPHA;
      const hw_f32x2 a01 = __builtin_amdgcn_cvt_pk_f32_fp8(ya, false), a23 = __builtin_amdgcn_cvt_pk_f32_fp8(ya, true), b01 = __builtin_amdgcn_cvt_pk_f32_fp8(yb, false), b23 = __builtin_amdgcn_cvt_pk_f32_fp8(yb, true);
      x.x += a01.x * ga + b01.x * gb; x.y += a01.y * ga + b01.y * gb; x.z += a23.x * ga + b23.x * gb; x.w += a23.y * ga + b23.y * gb;
      v[j] = x; s += (x.x + x.y) + (x.z + x.w); }
    const float mean = wave_sum(s) * (1.f / 1024.f); float s2 = 0.f;
#pragma unroll
    for (int j = 0; j < 4; ++j) { v[j] = v[j] - mean; s2 += (v[j].x * v[j].x + v[j].y * v[j].y) + (v[j].z * v[j].z + v[j].w * v[j].w); }
    const float rstd = rsqrtf(wave_sum(s2) * (1.f / 1024.f) + 1e-5f);
#pragma unroll
    for (int j = 0; j < 4; ++j) { const f32x4 g = ((const f32x4*)g2)[lane + 64 * j], bb = ((const f32x4*)b2)[lane + 64 * j]; row[lane + 64 * j] = v[j] * rstd * g + bb; }
  }
}

constexpr int NPHASE = 11;
__global__ void __launch_bounds__(NTHREADS, 2) mega(Ctx c) {
  float* lds = (float*)lds_raw;
  unsigned* ctl = (unsigned*)(c.ws + WS_CTL);
  unsigned* bar = ctl + CW_BAR;
  if (threadIdx.x == 0) { *(volatile unsigned*)(lds_raw + LDS_WCTR) = 0u; *(volatile unsigned*)(lds_raw + LDS_XBST) = 0u; *(volatile unsigned*)(lds_raw + LDS_XBST + 4) = 0u;
    (void)xb_add(&bar[XB_XCNT(xb_xcc_id())], 1u); }
  __syncthreads();
  phase_prologue(c, lds);
  xcd_barrier(bar);
  phase_inproj_mfma(c, (lds_u8*)lds_raw);
  phase_inproj_f8(c, (lds_u8*)lds_raw);
  phase_tiles_queue(c, lds, ctl + CW_Q + 48, TP_WD0 - TP_D1, TP_WD0);
  xcd_barrier(bar);
  phase_gdn_prep2(c, lds_raw);
  phase_kvup(c, lds);
  phase_topk_mfma(c, lds_raw, ctl + CW_Q);
  xcd_barrier(bar);
  if (blockIdx.x < 48) phase_gdn_scan(c, lds_raw, blockIdx.x);
  phase_attn_sparse(c, lds_raw, ctl + CW_Q + 16);
  phase_attn_mem(c, lds_raw, ctl + CW_Q + 32);
  xcd_barrier(bar);
  phase_outproj_mfma(c, (lds_u8*)lds_raw);
  xcd_barrier(bar);
  phase_router(c, lds_raw);
  xcd_barrier(bar);
  phase_moe_up_mfma(c, (lds_u8*)lds_raw);
  phase_tiles_queue(c, lds, ctl + CW_Q + 64, TP_WD0, TP_TOTAL);
  xcd_barrier(bar);
  phase_moe_down_mfma(c, (lds_u8*)lds_raw);
  xcd_barrier(bar);
  phase_combine(c, lds);
}

extern "C" void kernel_launch(void* const* d_in, const int* in_sizes, int n_in, void* d_out, int out_size, void* d_ws, size_t ws_size, hipStream_t stream) {
  static int grid = 0;
  if (grid == 0) {
    if (n_in != 25 || ws_size < WS_END) { fprintf(stderr, "kernel_launch: unexpected n_in %d / ws %zu\n", n_in, ws_size); grid = -1; return; }
    int dev = 0, cus = 0, per_cu = 0;
    hipGetDevice(&dev); hipDeviceGetAttribute(&cus, hipDeviceAttributeMultiprocessorCount, dev);
    hipFuncSetAttribute((const void*)mega, hipFuncAttributeMaxDynamicSharedMemorySize, LDS_BYTES);
    hipOccupancyMaxActiveBlocksPerMultiprocessor(&per_cu, (const void*)mega, NTHREADS, LDS_BYTES);
    if (per_cu < 1) { fprintf(stderr, "kernel_launch: occupancy query says %d blocks/CU\n", per_cu); per_cu = 1; }
    grid = cus * (per_cu < 1 ? 1 : 1);
    (void)hipGetLastError();
  }
  if (grid < 0) return;
  hipMemsetAsync((char*)d_ws + WS_CTL, 0, 32 * 1024, stream);
  Ctx c; memset(&c, 0, sizeof(c));
  for (int i = 0; i < 25; ++i) c.in[i] = (const float*)d_in[i];
  c.out = (float*)d_out; c.ws = (unsigned char*)d_ws;
  hipLaunchKernelGGL(mega, dim3(grid), dim3(NTHREADS), LDS_BYTES, stream, c);
}
```
